# Optimizing an MI355X kernel written in HIP

```python
import jax
import jax.numpy as jnp
from jax import lax
import numpy as np

D_MODEL = 2048
BATCH = 2
SEQ = 16384
DEPTH = 1

EPS = 1e-6
HEAD_DIM = 128

GLA_HEADS = 4
GLA_DK = 64
GLA_DV = 128
GLA_GATE_RANK = 16
GLA_TAU = 16.0
GLA_CHUNK = 64

DIL_HEADS = 12
DIL_PATTERNS = ((128, 1), (512, 4), (2048, 16))
ROPE_THETA = 500000.0
ROPE_DIM = HEAD_DIM // 4
MASK_VALUE = -1e30

PEER_HEADS = 8
PEER_NKEYS = 128
PEER_NEXPERTS = PEER_NKEYS * PEER_NKEYS
PEER_QDIM = 256
PEER_TOPK = 16
PEER_TOKEN_BLOCK = 128

GLA_QK_W = GLA_HEADS * GLA_DK
GLA_V_W = GLA_HEADS * GLA_DV
DIL_W = DIL_HEADS * HEAD_DIM
MIX_W = GLA_V_W + DIL_W
IN_SPLITS = (GLA_QK_W, GLA_QK_W, GLA_V_W, GLA_GATE_RANK, GLA_GATE_RANK, GLA_V_W, DIL_W, DIL_W, DIL_W)
IN_W = sum(IN_SPLITS)

kernel_name = 'hybrid_gla_dilated_peer_encoder'


def rms_norm(x, g):
    xf = x.astype(jnp.float32)
    y = xf * lax.rsqrt(jnp.mean(xf * xf, axis=-1, keepdims=True) + EPS)
    return (y * g.astype(jnp.float32)).astype(x.dtype)


def partial_rope(t, positions):
    half = ROPE_DIM // 2
    inv_freq = ROPE_THETA ** (-jnp.arange(half, dtype=jnp.float32) / half)
    ang = positions.astype(jnp.float32)[:, None] * inv_freq[None, :]
    cos = jnp.cos(ang)[None, :, None, :]
    sin = jnp.sin(ang)[None, :, None, :]
    tf = t.astype(jnp.float32)
    x1 = tf[..., :half]
    x2 = tf[..., half:ROPE_DIM]
    return jnp.concatenate([x1 * cos - x2 * sin, x2 * cos + x1 * sin, tf[..., ROPE_DIM:]], axis=-1)


def gla_direction(q, k, v, log_a, include_diag):
    Bsz, H, S, dk = q.shape
    dv = v.shape[-1]
    C = GLA_CHUNK
    N = S // C
    q = q.reshape(Bsz, H, N, C, dk)
    k = k.reshape(Bsz, H, N, C, dk)
    v = v.reshape(Bsz, H, N, C, dv)
    b = jnp.cumsum(log_a.reshape(Bsz, H, N, C, dk), axis=3)
    b_last = b[:, :, :, -1:, :]
    q_in = q * jnp.exp(b)
    k_in = k * jnp.exp(-b)
    scores = jnp.einsum('bhnik,bhnjk->bhnij', q_in, k_in)
    mask = jnp.tril(jnp.ones((C, C), dtype=bool), k=0 if include_diag else -1)
    o_intra = jnp.einsum('bhnij,bhnjv->bhniv', jnp.where(mask, scores, 0.0), v)
    k_state = k * jnp.exp(b_last - b)
    inc = jnp.einsum('bhnjk,bhnjv->bhnkv', k_state, v)
    decay = jnp.exp(b_last[:, :, :, 0, :])

    def step(state, inp):
        dec, add = inp
        return dec[..., None] * state + add, state

    s0 = jnp.zeros((Bsz, H, dk, dv), jnp.float32)
    _, s_before = lax.scan(step, s0, (jnp.moveaxis(decay, 2, 0), jnp.moveaxis(inc, 2, 0)))
    s_before = jnp.moveaxis(s_before, 0, 2)
    o_inter = jnp.einsum('bhnik,bhnkv->bhniv', q_in, s_before)
    return (o_intra + o_inter).reshape(Bsz, H, S, dv)


def gla_mixer(q, k, v, gate_down_f, gate_down_b, r, up_f, bias_f, up_b, bias_b, out_g):
    Bsz, S, _ = q.shape
    f32 = jnp.float32

    def heads(t, d):
        return t.astype(f32).reshape(Bsz, S, GLA_HEADS, d).transpose(0, 2, 1, 3)

    qh = heads(q, GLA_DK) * (GLA_DK ** -0.5)
    kh = heads(k, GLA_DK)
    vh = heads(v, GLA_DV)
    la_f = heads(jax.nn.log_sigmoid(gate_down_f.astype(f32) @ up_f.astype(f32) + bias_f.astype(f32)) / GLA_TAU, GLA_DK)
    la_b = heads(jax.nn.log_sigmoid(gate_down_b.astype(f32) @ up_b.astype(f32) + bias_b.astype(f32)) / GLA_TAU, GLA_DK)

    def rev(t):
        return jnp.flip(t, axis=2)

    o_fwd = gla_direction(qh, kh, vh, la_f, True)
    o_bwd = rev(gla_direction(rev(qh), rev(kh), rev(vh), rev(la_b), False))
    o = (o_fwd + o_bwd).transpose(0, 2, 1, 3)
    o = rms_norm(o, out_g.reshape(GLA_HEADS, GLA_DV))
    return o.reshape(Bsz, S, GLA_V_W) * jax.nn.silu(r.astype(f32))


def dilated_window_attention(q, k, v, window, dilation):
    Bsz, S, H, hd = q.shape
    half = window // (2 * dilation)
    L = S // dilation
    nb = -(-L // half)
    Lp = nb * half

    def to_blocks(t):
        t = t.reshape(Bsz, L, dilation, H, hd)
        t = jnp.pad(t, ((0, 0), (0, Lp - L), (0, 0), (0, 0), (0, 0)))
        return t.reshape(Bsz, nb, half, dilation, H, hd)

    def with_neighbours(t):
        tp = jnp.pad(t, ((0, 0), (1, 1), (0, 0), (0, 0), (0, 0), (0, 0)))
        return jnp.concatenate([tp[:, :-2], tp[:, 1:-1], tp[:, 2:]], axis=2)

    qb = to_blocks(q)
    kn = with_neighbours(to_blocks(k))
    vn = with_neighbours(to_blocks(v))
    s = jnp.einsum('bnqrhe,bnkrhe->bnrhqk', qb, kn)
    qpos = jnp.arange(nb)[:, None] * half + jnp.arange(half)[None, :]
    kpos = jnp.arange(nb)[:, None] * half - half + jnp.arange(3 * half)[None, :]
    rel = kpos[:, None, :] - qpos[:, :, None]
    valid = (jnp.abs(rel) <= half) & (kpos[:, None, :] >= 0) & (kpos[:, None, :] < L)
    s = jnp.where(valid[None, :, None, None], s, MASK_VALUE)
    m = jnp.max(s, axis=-1)
    p = jnp.exp(s - m[..., None])
    den = jnp.sum(p, axis=-1)
    m_t = jnp.moveaxis(m, (2, 3, 4), (3, 4, 2))
    den_t = jnp.moveaxis(den, (2, 3, 4), (3, 4, 2))
    o = jnp.einsum('bnrhqk,bnkrhe->bnqrhe', p, vn) / den_t[..., None]

    def back(t):
        t = t.reshape((Bsz, Lp, dilation, H) + t.shape[5:])[:, :L]
        return t.reshape((Bsz, S, H) + t.shape[4:])

    return back(o), back(m_t), back(den_t)


def dilated_mixer(q, k, v, q_norm_g, k_norm_g, positions):
    Bsz, S, _ = q.shape
    shp = (Bsz, S, DIL_HEADS, HEAD_DIM)
    qh = partial_rope(rms_norm(q.reshape(shp), q_norm_g), positions) * (HEAD_DIM ** -0.5)
    kh = partial_rope(rms_norm(k.reshape(shp), k_norm_g), positions)
    vh = v.reshape(shp).astype(jnp.float32)
    outs, maxes, dens = [], [], []
    for window, dilation in DIL_PATTERNS:
        o, m, d = dilated_window_attention(qh, kh, vh, window, dilation)
        outs.append(o)
        maxes.append(m)
        dens.append(d)
    m_all = jnp.stack(maxes)
    w = jnp.stack(dens) * jnp.exp(m_all - jnp.max(m_all, axis=0, keepdims=True))
    w = w / jnp.sum(w, axis=0, keepdims=True)
    o = jnp.sum(w[..., None] * jnp.stack(outs), axis=0)
    return o.reshape(Bsz, S, DIL_W)


def peer_ffn(xn, w_query, sub_keys, expert_down, expert_up):
    Bsz, S, D = xn.shape
    f32 = jnp.float32
    T = Bsz * S
    xt = xn.reshape(T, D)
    qry = (xt @ w_query).reshape(T, PEER_HEADS, 2, PEER_QDIM // 2)
    sc = jnp.einsum('thcd,hckd->thck', qry.astype(f32), sub_keys.astype(f32))
    top_s, top_i = lax.top_k(sc, PEER_TOPK)
    kk = PEER_TOPK * PEER_TOPK
    cand_s = (top_s[:, :, 0, :, None] + top_s[:, :, 1, None, :]).reshape(T, PEER_HEADS, kk)
    cand_i = (top_i[:, :, 0, :, None] * PEER_NKEYS + top_i[:, :, 1, None, :]).reshape(T, PEER_HEADS, kk)
    best_s, best_pos = lax.top_k(cand_s, PEER_TOPK)
    idx = jnp.take_along_axis(cand_i, best_pos, axis=-1)
    gates = jax.nn.softmax(best_s, axis=-1)
    K = PEER_HEADS * PEER_TOPK
    nblk = T // PEER_TOKEN_BLOCK

    def block(args):
        xb, ib, gb = args
        u = expert_down[ib]
        act = jax.nn.gelu(jnp.einsum('tkd,td->tk', u, xb).astype(f32))
        vv = expert_up[ib]
        return jnp.einsum('tk,tkd->td', (gb * act).astype(vv.dtype), vv)

    out = lax.map(block, (xt.reshape(nblk, PEER_TOKEN_BLOCK, D),
                          idx.reshape(nblk, PEER_TOKEN_BLOCK, K),
                          gates.reshape(nblk, PEER_TOKEN_BLOCK, K)))
    return out.reshape(Bsz, S, D).astype(xn.dtype)


def setup_inputs(seed: int = 0) -> dict:
    key = jax.random.key(seed)
    ks = jax.random.split(key, 16)
    f32 = jnp.float32

    def nrm(k, shape, scale):
        return jax.random.normal(k, shape, f32) * scale

    def gain(k, shape):
        return 1.0 + 0.02 * jax.random.normal(k, shape, f32)

    L = DEPTH
    return {
        'x': nrm(ks[0], (BATCH, SEQ, D_MODEL), 1.0),
        'norm1_g': gain(ks[1], (L, D_MODEL)),
        'w_in': nrm(ks[2], (L, D_MODEL, IN_W), D_MODEL ** -0.5),
        'gla_up_f': nrm(ks[3], (L, GLA_GATE_RANK, GLA_QK_W), GLA_GATE_RANK ** -0.5),
        'gla_bias_f': nrm(ks[4], (L, GLA_QK_W), 0.1),
        'gla_up_b': nrm(ks[5], (L, GLA_GATE_RANK, GLA_QK_W), GLA_GATE_RANK ** -0.5),
        'gla_bias_b': nrm(ks[6], (L, GLA_QK_W), 0.1),
        'gla_out_g': gain(ks[7], (L, GLA_V_W)),
        'q_norm_g': gain(ks[8], (L, HEAD_DIM)),
        'k_norm_g': gain(ks[9], (L, HEAD_DIM)),
        'w_out': nrm(ks[10], (L, MIX_W, D_MODEL), MIX_W ** -0.5),
        'norm2_g': gain(ks[11], (L, D_MODEL)),
        'peer_w_query': nrm(ks[12], (L, D_MODEL, PEER_HEADS * PEER_QDIM), D_MODEL ** -0.5),
        'peer_sub_keys': nrm(ks[13], (L, PEER_HEADS, 2, PEER_NKEYS, PEER_QDIM // 2), (PEER_QDIM // 2) ** -0.5),
        'peer_down': nrm(ks[14], (L, PEER_NEXPERTS, D_MODEL), D_MODEL ** -0.5),
        'peer_up': nrm(ks[15], (L, PEER_NEXPERTS, D_MODEL), PEER_HEADS ** -0.5),
    }


def reference(x, norm1_g, w_in, gla_up_f, gla_bias_f, gla_up_b, gla_bias_b, gla_out_g, q_norm_g, k_norm_g, w_out, norm2_g, peer_w_query, peer_sub_keys, peer_down, peer_up):
    positions = jnp.arange(x.shape[1], dtype=jnp.int32)
    split_points = [int(c) for c in np.cumsum(IN_SPLITS)[:-1]]
    for l in range(DEPTH):
        xn = rms_norm(x, norm1_g[l])
        h = xn @ w_in[l]
        qa, ka, va, gdf, gdb, ra, qd, kd, vd = jnp.split(h, split_points, axis=-1)
        oa = gla_mixer(qa, ka, va, gdf, gdb, ra, gla_up_f[l], gla_bias_f[l], gla_up_b[l], gla_bias_b[l], gla_out_g[l])
        od = dilated_mixer(qd, kd, vd, q_norm_g[l], k_norm_g[l], positions)
        mixed = jnp.concatenate([oa, od], axis=-1).astype(x.dtype)
        x = x + mixed @ w_out[l]
        x = x + peer_ffn(rms_norm(x, norm2_g[l]), peer_w_query[l], peer_sub_keys[l], peer_down[l], peer_up[l])
    return x
```

```cpp
#include <hip/hip_runtime.h>
#include <hip/hip_cooperative_groups.h>
#include <cstdio>
#include <cstdint>
namespace cg = cooperative_groups;
namespace pg8 {
#define PG8_LAS __attribute__((address_space(3)))
typedef unsigned short bf16_t;
typedef short bf16x8 __attribute__((ext_vector_type(8)));
typedef float f32x4 __attribute__((ext_vector_type(4)));
typedef unsigned u32x4 __attribute__((ext_vector_type(4)));
constexpr int BM = 256, BK = 64, HALF = 128, HTB = HALF * BK * 2  , STAGE_BYTES = 8 * HTB, NXCD = 8, WGM = 8;

__host__ __device__ __forceinline__ int lds_byte(int r, int c) { const int st = (r >> 4) * 2 + (c >> 5), rr = r & 15, cc = c & 31, ob = rr * 64 + cc * 2; return st * 1024 + (ob ^ (((ob >> 9) & 1) << 5)); }
__host__ __device__ __forceinline__ void stage_rc(int b, int& R, int& C) { const int st = b / 1024, sb = b % 1024, swz = sb ^ (((sb >> 9) & 1) << 5); R = (st >> 1) * 16 + swz / 64; C = (st & 1) * 32 + (swz % 64) / 2; }
__host__ __device__ __forceinline__ int perm32(int rho) { const int n = rho >> 4, i = rho & 15; return 8 * (i >> 2) + 4 * n + (i & 3); }

struct Unit { int pm, pn; };
struct Gemm { const bf16_t* A; const bf16_t* Bt; int M, N, K; };

struct StaticOrder {
    int nM, nN, nwg, G, c;
    __host__ __device__ void init(int M, int N, int G_, int c_) { nM = M / BM; nN = N / BM; nwg = nM * nN; G = G_; c = c_; }
    __host__ __device__ bool next(int i, Unit& u) const {
        const long L = (long)i * G + c; if (L >= nwg) return false;
        int wgid = (int)L; { const int q = nwg / NXCD, r = nwg % NXCD, xcd = wgid % NXCD, off = wgid / NXCD; wgid = (xcd < r ? xcd * (q + 1) : r * (q + 1) + (xcd - r) * q) + off; }
        const int nig = WGM * nN, gid = wgid / nig, fm = gid * WGM, gsz = (nM - fm) < WGM ? (nM - fm) : WGM;
        u.pm = fm + ((wgid % nig) % gsz); u.pn = (wgid % nig) / gsz; return true;
    }
    __device__ __forceinline__ void a_ready(const Unit&) const {}
    __device__ __forceinline__ void done(const Unit&) const {}
};
__device__ __forceinline__ unsigned cvt_pk_bf16(float lo, float hi) { unsigned r; asm volatile("v_cvt_pk_bf16_f32 %0, %1, %2" : "=v"(r) : "v"(lo), "v"(hi)); return r; }
struct EpiRowScaleBf16 {
    static constexpr bool PERM = true, AFTER_DRAIN = false;
    bf16_t* O; int ldc; const float* rs;
    __device__ __forceinline__ void operator()(const f32x4 (&acc)[2][2][4][2], const Unit& u, int wr, int wc, int fr, int fq) const {
        const int row0 = u.pm * BM + wr * 64 + fr, col0 = u.pn * BM + wc * 32 + 8 * fq;
#pragma unroll
        for (int ai = 0; ai < 2; ++ai)
#pragma unroll
            for (int m = 0; m < 4; ++m) { const int row = row0 + ai * HALF + m * 16; const float s = rs ? rs[row] : 1.f; bf16_t* rowp = O + (size_t)row * ldc + col0;
#pragma unroll
                for (int bj = 0; bj < 2; ++bj) { const f32x4 v0 = acc[ai][bj][m][0] * s, v1 = acc[ai][bj][m][1] * s;
                    u32x4 w; w.x = cvt_pk_bf16(v0[0], v0[1]); w.y = cvt_pk_bf16(v0[2], v0[3]); w.z = cvt_pk_bf16(v1[0], v1[1]); w.w = cvt_pk_bf16(v1[2], v1[3]);
                    *(u32x4*)(rowp + bj * HALF) = w; } }
    }
};
struct EpiResid {
    static constexpr bool PERM = true, AFTER_DRAIN = false;
    const float* x; float* out; bf16_t* xb; float* ssp; int ldc;
    __device__ __forceinline__ void operator()(const f32x4 (&acc)[2][2][4][2], const Unit& u, int wr, int wc, int fr, int fq) const {
        const int row0 = u.pm * BM + wr * 64 + fr, col0 = u.pn * BM + wc * 32 + 8 * fq;
#pragma unroll
        for (int ai = 0; ai < 2; ++ai)
#pragma unroll
            for (int m = 0; m < 4; ++m) { const int row = row0 + ai * HALF + m * 16; const size_t off = (size_t)row * ldc + col0; float ss = 0.f;
#pragma unroll
                for (int bj = 0; bj < 2; ++bj) { const f32x4 xa = *(const f32x4*)(x + off + bj * HALF), xc = *(const f32x4*)(x + off + bj * HALF + 4);
                    const f32x4 v0 = acc[ai][bj][m][0] + xa, v1 = acc[ai][bj][m][1] + xc;
                    *(f32x4*)(out + off + bj * HALF) = v0; *(f32x4*)(out + off + bj * HALF + 4) = v1;
                    u32x4 w; w.x = cvt_pk_bf16(v0[0], v0[1]); w.y = cvt_pk_bf16(v0[2], v0[3]); w.z = cvt_pk_bf16(v1[0], v1[1]); w.w = cvt_pk_bf16(v1[2], v1[3]);
                    *(u32x4*)(xb + off + bj * HALF) = w;
                    ss += (v0[0] * v0[0] + v0[1] * v0[1]) + (v0[2] * v0[2] + v0[3] * v0[3]) + (v1[0] * v1[0] + v1[1] * v1[1]) + (v1[2] * v1[2] + v1[3] * v1[3]); }
                ss += __shfl_xor(ss, 16); ss += __shfl_xor(ss, 32);
                if (fq == 0) ssp[(size_t)row * 32 + u.pn * 4 + wc] = ss; }
    }
};
template <class Epi, class Sched, bool ALIGN_EPI = false, bool SP2 = false>
__device__ __forceinline__ void gemm_phase(PG8_LAS unsigned char* lds, const Gemm g, const Sched& S, const Epi& E) {
    const int tid = threadIdx.x, wid = __builtin_amdgcn_readfirstlane(tid >> 6), lane = tid & 63, wr = wid >> 2, wc = wid & 3, fr = lane & 15, fq = lane >> 4;
    const int K = g.K, nt = K / BK;
    unsigned voffA[2], voffB[2];
#pragma unroll
    for (int i = 0; i < 2; ++i) { int R, C; stage_rc(tid * 16 + i * 8192, R, C); const int Rb = Epi::PERM ? ((R & ~31) + perm32(R & 31)) : R;
        voffA[i] = (unsigned)(R * K + C) * 2u; voffB[i] = (unsigned)(Rb * K + C) * 2u; }
    const size_t kstep = (size_t)(BK * 2);
    const size_t hstep = (size_t)HALF * K * 2;
    const size_t tstep = 2 * hstep;
    const unsigned ldsw = (unsigned)wid * 1024u;
    const int aoff = lds_byte(wr * 64 + fr, fq * 8), boff = lds_byte(wc * 32 + fr, fq * 8);
#define PG8_SA(b, h) (((b) * 2 + (h)) * HTB)
#define PG8_SB(b, h) ((4 + (b) * 2 + (h)) * HTB)
#define PG8_STAGE(bufoff, gbase, voff) do { _Pragma("unroll") for (int _i = 0; _i < 2; ++_i) \
        __builtin_amdgcn_global_load_lds((const unsigned*)((const char*)(gbase) + (voff)[_i]), (PG8_LAS unsigned*)(lds + (bufoff) + ldsw + _i * 8192), 16, 0, 0); } while (0)
#define PG8_LDA(dst, b, h) do { _Pragma("unroll") for (int m = 0; m < 4; ++m) _Pragma("unroll") for (int k = 0; k < 2; ++k) dst[m][k] = *(const PG8_LAS bf16x8*)(lds + PG8_SA(b, h) + aoff + m * 2048 + k * 1024); } while (0)
#define PG8_LDB(dst, b, h) do { _Pragma("unroll") for (int n = 0; n < 2; ++n) _Pragma("unroll") for (int k = 0; k < 2; ++k) dst[n][k] = *(const PG8_LAS bf16x8*)(lds + PG8_SB(b, h) + boff + n * 2048 + k * 1024); } while (0)
#define PG8_MMA(ai, bj, At, Bt) do { __builtin_amdgcn_s_setprio(1); _Pragma("unroll") for (int m = 0; m < 4; ++m) _Pragma("unroll") for (int n = 0; n < 2; ++n) _Pragma("unroll") for (int k = 0; k < 2; ++k) \
        acc[ai][bj][m][n] = __builtin_amdgcn_mfma_f32_16x16x32_bf16(Bt[n][k], At[m][k], acc[ai][bj][m][n], 0, 0, 0); __builtin_amdgcn_s_setprio(0); } while (0)
#define PG8_WAIT_V(n) asm volatile("s_waitcnt vmcnt(" #n ")" ::: "memory")
#define PG8_WAIT_L(n) asm volatile("s_waitcnt lgkmcnt(" #n ")" ::: "memory")
#define PG8_BAR __builtin_amdgcn_s_barrier()
#define PG8_SCHED __builtin_amdgcn_sched_barrier(0)
    Unit cur, nxt; int ui = 0;
    if (!S.next(0, cur)) return;
    f32x4 acc[2][2][4][2];
#pragma unroll
    for (int a = 0; a < 2; ++a)
#pragma unroll
        for (int b = 0; b < 2; ++b)
#pragma unroll
            for (int m = 0; m < 4; ++m)
#pragma unroll
                for (int n = 0; n < 2; ++n) acc[a][b][m][n] = (f32x4){0.f, 0.f, 0.f, 0.f};
    bf16x8 At[4][2], B0[2][2], B1[2][2];
    const char* cA = (const char*)g.A + (size_t)cur.pm * tstep; const char* cB = (const char*)g.Bt + (size_t)cur.pn * tstep;
    S.a_ready(cur);
    if constexpr (SP2) {
        PG8_STAGE(PG8_SB(0, 0), cB, voffB); PG8_STAGE(PG8_SB(0, 1), cB + hstep, voffB); PG8_STAGE(PG8_SA(0, 0), cA, voffA); PG8_STAGE(PG8_SA(0, 1), cA + hstep, voffA);
        if (wr == 1) PG8_BAR;
        PG8_WAIT_V(2); PG8_BAR;
        PG8_STAGE(PG8_SB(1, 0), cB + kstep, voffB); PG8_STAGE(PG8_SA(1, 0), cA + kstep, voffA); PG8_STAGE(PG8_SB(1, 1), cB + hstep + kstep, voffB);
        PG8_WAIT_V(6); PG8_BAR;
    } else {
        PG8_STAGE(PG8_SB(0, 0), cB, voffB); PG8_STAGE(PG8_SA(0, 0), cA, voffA); PG8_STAGE(PG8_SB(0, 1), cB + hstep, voffB); PG8_STAGE(PG8_SA(0, 1), cA + hstep, voffA);
        if (wr == 1) PG8_BAR;
        PG8_WAIT_V(4); PG8_BAR;
        PG8_STAGE(PG8_SB(1, 0), cB + kstep, voffB); PG8_STAGE(PG8_SA(1, 0), cA + kstep, voffA); PG8_STAGE(PG8_SB(1, 1), cB + hstep + kstep, voffB);
        PG8_WAIT_V(6); PG8_BAR;
    }
    for (;;) {
        const bool has_next = S.next(ui + 1, nxt);
        const char* nA = has_next ? (const char*)g.A + (size_t)nxt.pm * tstep : cA; const char* nB = has_next ? (const char*)g.Bt + (size_t)nxt.pn * tstep : cB;
        for (int t = 0; t < nt; t += 2) {
            const bool last = (t == nt - 2);
            const char* a1 = cA + (size_t)(t + 1) * kstep;
            const char* a2 = last ? nA : cA + (size_t)(t + 2) * kstep; const char* b2 = last ? nB : cB + (size_t)(t + 2) * kstep;
            const char* a3 = a2 + kstep; const char* b3 = b2 + kstep;
            if (last && has_next) S.a_ready(nxt);
            if constexpr (SP2) {
            PG8_LDB(B0, 0, 0); PG8_LDB(B1, 0, 1); PG8_SCHED; PG8_LDA(At, 0, 0); PG8_STAGE(PG8_SA(1, 1), a1 + hstep, voffA);
            PG8_WAIT_V(8); PG8_WAIT_L(0); PG8_BAR; PG8_MMA(0, 0, At, B0); PG8_MMA(0, 1, At, B1); PG8_BAR; PG8_SCHED;
            PG8_LDA(At, 0, 1); PG8_STAGE(PG8_SB(0, 0), b2, voffB); PG8_STAGE(PG8_SB(0, 1), b2 + hstep, voffB); PG8_STAGE(PG8_SA(0, 0), a2, voffA);
            PG8_WAIT_V(8); PG8_WAIT_L(0); PG8_BAR; PG8_MMA(1, 0, At, B0); PG8_MMA(1, 1, At, B1); PG8_BAR; PG8_SCHED;
            PG8_LDB(B0, 1, 0); PG8_LDB(B1, 1, 1); PG8_SCHED; PG8_LDA(At, 1, 0); PG8_STAGE(PG8_SA(0, 1), a2 + hstep, voffA);
            PG8_WAIT_V(8); PG8_WAIT_L(0); PG8_BAR; PG8_MMA(0, 0, At, B0); PG8_MMA(0, 1, At, B1); PG8_BAR; PG8_SCHED;
            PG8_LDA(At, 1, 1); PG8_STAGE(PG8_SB(1, 0), b3, voffB); PG8_STAGE(PG8_SB(1, 1), b3 + hstep, voffB); PG8_STAGE(PG8_SA(1, 0), a3, voffA);
            PG8_WAIT_V(8); PG8_WAIT_L(0); PG8_BAR; PG8_MMA(1, 0, At, B0); PG8_MMA(1, 1, At, B1); PG8_BAR; PG8_SCHED;
            } else {
            PG8_LDB(B0, 0, 0); PG8_SCHED; PG8_LDA(At, 0, 0); PG8_STAGE(PG8_SA(1, 1), a1 + hstep, voffA);
            PG8_WAIT_L(8); PG8_BAR; PG8_WAIT_L(0); PG8_MMA(0, 0, At, B0); PG8_BAR; PG8_SCHED;
            PG8_LDB(B1, 0, 1); PG8_STAGE(PG8_SB(0, 0), b2, voffB);
            PG8_BAR; PG8_WAIT_L(0); PG8_MMA(0, 1, At, B1); PG8_BAR;
            PG8_LDA(At, 0, 1); PG8_STAGE(PG8_SA(0, 0), a2, voffA);
            PG8_BAR; PG8_WAIT_L(0); PG8_MMA(1, 0, At, B0); PG8_BAR; PG8_SCHED;
            PG8_STAGE(PG8_SB(0, 1), b2 + hstep, voffB);
            PG8_WAIT_V(6); PG8_BAR; PG8_MMA(1, 1, At, B1); PG8_BAR;
            PG8_LDB(B0, 1, 0); PG8_SCHED; PG8_LDA(At, 1, 0); PG8_STAGE(PG8_SA(0, 1), a2 + hstep, voffA);
            PG8_WAIT_L(8); PG8_BAR; PG8_WAIT_L(0); PG8_MMA(0, 0, At, B0); PG8_BAR; PG8_SCHED;
            PG8_LDB(B1, 1, 1); PG8_STAGE(PG8_SB(1, 0), b3, voffB);
            PG8_BAR; PG8_WAIT_L(0); PG8_MMA(0, 1, At, B1); PG8_BAR;
            PG8_LDA(At, 1, 1); PG8_STAGE(PG8_SA(1, 0), a3, voffA);
            PG8_BAR; PG8_WAIT_L(0); PG8_MMA(1, 0, At, B0); PG8_BAR; PG8_SCHED;
            PG8_STAGE(PG8_SB(1, 1), b3 + hstep, voffB);
            PG8_WAIT_V(6); PG8_BAR; PG8_MMA(1, 1, At, B1); PG8_BAR;
            }
        }
        if constexpr (ALIGN_EPI) { if (wr == 0) PG8_BAR; }
        if constexpr (!Epi::AFTER_DRAIN) { E(acc, cur, wr, wc, fr, fq); S.done(cur); }
        if (!has_next) break;
#pragma unroll
        for (int a = 0; a < 2; ++a)
#pragma unroll
            for (int b = 0; b < 2; ++b)
#pragma unroll
                for (int m = 0; m < 4; ++m)
#pragma unroll
                    for (int n = 0; n < 2; ++n) acc[a][b][m][n] = (f32x4){0.f, 0.f, 0.f, 0.f};
        cur = nxt; cA = nA; cB = nB; ++ui;
        if constexpr (ALIGN_EPI) { if (wr == 1) PG8_BAR; }
    }
    PG8_WAIT_V(0);
    if constexpr (!ALIGN_EPI) { if (wr == 0) PG8_BAR; }
    PG8_BAR;
    if constexpr (Epi::AFTER_DRAIN) { E.fused(acc, cur, wr, wc, fr, fq, lds, wid, lane); S.done(cur); }
#undef PG8_SA
#undef PG8_SB
#undef PG8_STAGE
#undef PG8_LDA
#undef PG8_LDB
#undef PG8_MMA
#undef PG8_WAIT_V
#undef PG8_WAIT_L
#undef PG8_BAR
#undef PG8_SCHED
}
}
#ifndef PG8_SP2
#define PG8_SP2 true
#endif
#ifndef PG8_ALIGN
#define PG8_ALIGN true
#endif

constexpr int BATCH = 2, SEQ = 16384, DM = 2048, T = BATCH * SEQ;
constexpr int INW = 6176, HP = 6400;
constexpr int C_QA = 0, C_KA = 256, C_VA = 512, C_RA = 1024, C_QD = 1536, C_KD = 3072, C_VD = 4608, C_GF = 6144;
constexpr int NHD = 12;
constexpr float EPS = 1e-6f;
constexpr float LOG2E = 1.4426950408889634f;
constexpr float QSCALE = 0.08838834764831845f * LOG2E;
constexpr int NPHASE = 9;

constexpr size_t MiB = 1u << 20;
constexpr size_t WS_CTL = 0, WS_ROPE = 1 * MiB, WS_RS1 = 3 * MiB, WS_RS2 = 3 * MiB + 512 * 1024, WS_SSP = 4 * MiB, WS_WIN = 8 * MiB, WS_WO = 33 * MiB, WS_WQ = 41 * MiB,
                 WS_SK = 49 * MiB, WS_DEC = 50 * MiB, WS_LP = 51 * MiB, WS_IDX = 56 * MiB, WS_GATE = 72 * MiB, WS_DOWN = 88 * MiB, WS_UP = 152 * MiB, WS_XB = 216 * MiB,
                 WS_H = 344 * MiB, WS_X1B = WS_H, WS_QRY = WS_H + 128 * MiB, WS_OP1 = 744 * MiB, WS_OP2 = 840 * MiB, WS_END = 936 * MiB;
constexpr size_t OUT_ST = 0, OUT_OP0 = 128 * MiB;
constexpr int LDS_BYTES = 147456;

#define LAS __attribute__((address_space(3)))
typedef unsigned short bf16_t;
typedef short bf16x8 __attribute__((ext_vector_type(8)));
typedef short s16x4 __attribute__((ext_vector_type(4)));
typedef float f32x4 __attribute__((ext_vector_type(4)));
typedef float f32x2 __attribute__((ext_vector_type(2)));
typedef float f32x16 __attribute__((ext_vector_type(16)));
typedef unsigned u32x4 __attribute__((ext_vector_type(4)));
typedef unsigned u32x2 __attribute__((ext_vector_type(2)));
#define LDS_WAIT() asm volatile("s_waitcnt lgkmcnt(0)" ::: "memory")
#define SBAR() __builtin_amdgcn_sched_barrier(0)

__device__ __forceinline__ float bf2f(unsigned short b) { return __uint_as_float(((unsigned)b) << 16); }
__device__ __forceinline__ float bflo(unsigned w) { return __uint_as_float(w << 16); }
__device__ __forceinline__ float bfhi(unsigned w) { return __uint_as_float(w & 0xffff0000u); }
__device__ __forceinline__ unsigned f2bf(float f) { unsigned u = __float_as_uint(f); return (u + 0x7fffu + ((u >> 16) & 1u)) >> 16; }
__device__ __forceinline__ unsigned pk2(float lo, float hi) { return pg8::cvt_pk_bf16(lo, hi); }
__device__ __forceinline__ float fexp(float x) { return __builtin_amdgcn_exp2f(x * LOG2E); }
__device__ __forceinline__ float flog(float x) { return __builtin_amdgcn_logf(x) * 0.6931471805599453f; }
__device__ __forceinline__ float wave_sum(float v) {
#pragma unroll
    for (int o = 1; o < 64; o <<= 1) v += __shfl_xor(v, o);
    return v;
}
__device__ __forceinline__ int crow(int r, int hi) { return (r & 3) + 8 * (r >> 2) + 4 * hi; }

struct Frame {
    LAS unsigned char* lds; char* ldsg; unsigned char* wsb;
    int tid, lane, wave, vcu, G;
    const float *x, *norm1_g, *w_in, *up_f, *bias_f, *up_b, *bias_b, *out_g, *qn_g, *kn_g, *w_out, *norm2_g, *w_query, *sub_keys, *peer_down, *peer_up;
    float* out;
    f32x2* rope; float *rs1, *rs2, *ssp, *dec, *lp, *gate, *state; int* idx;
    bf16_t *WinT, *WoT, *WqT, *SK, *down16, *up16, *xb, *mixed, *h, *x1b, *qry, *op0, *op1, *op2;
};

__device__ __forceinline__ void p0_transpose_item(const float* W, int K, int N, bf16_t* WT, int k0, int n0, int dst_row0, const float* g, LAS float* scr, int lane) {
#pragma unroll 8
    for (int i = 0; i < 32; ++i) { const int kk = 2 * i + (lane >> 5); float w = W[(size_t)(k0 + kk) * N + n0 + (lane & 31)]; if (g) w *= g[k0 + kk]; scr[kk * 33 + (lane & 31)] = w; }
    LDS_WAIT(); asm volatile("" ::: "memory");
    const int c = lane & 7;
#pragma unroll
    for (int j = 0; j < 4; ++j) { const int n = (lane >> 3) + 8 * j; const LAS float* s = scr + (8 * c) * 33 + n;
        u32x4 o; o.x = pk2(s[0 * 33], s[1 * 33]); o.y = pk2(s[2 * 33], s[3 * 33]); o.z = pk2(s[4 * 33], s[5 * 33]); o.w = pk2(s[6 * 33], s[7 * 33]);
        *(u32x4*)(WT + (size_t)(dst_row0 + n) * K + k0 + 8 * c) = o; }
    LDS_WAIT(); asm volatile("" ::: "memory");
}
__device__ __forceinline__ void phase0(const Frame& F) {
    LAS float* scr = (LAS float*)(F.lds + F.wave * 16384);
    const int gw = F.vcu * 8 + F.wave, NGW = F.G * 8, lane = F.lane;
    constexpr int I_IN = 32 * 193, I_O = 32 * 64, I_Q = 32 * 64;
    for (int it = gw; it < I_IN + I_O + I_Q; it += NGW) {
        int r = it;
        if (r < I_IN) { const int kb = r / 193, nb = r % 193; const int drow = nb < 32 ? nb * 32 : (nb == 32 ? C_GF : nb * 32 - 32);
            p0_transpose_item(F.w_in, DM, INW, F.WinT, kb * 64, nb * 32, drow, F.norm1_g, scr, lane); continue; }
        r -= I_IN;
        if (r < I_O) { const int kb = r / 64, nb = r % 64; p0_transpose_item(F.w_out, DM, DM, F.WoT, kb * 64, nb * 32, nb * 32, nullptr, scr, lane); continue; }
        r -= I_O;
        { const int kb = r / 64, nb = r % 64; p0_transpose_item(F.w_query, DM, DM, F.WqT, kb * 64, nb * 32, nb * 32, F.norm2_g, scr, lane); }
    }
    const size_t gt = (size_t)gw * 64 + lane, NT = (size_t)NGW * 64;
    { u32x4* z = (u32x4*)(F.WinT + (size_t)INW * DM); const u32x4 zero = {0u, 0u, 0u, 0u}; for (size_t i = gt; i < (size_t)(HP - INW) * DM / 8; i += NT) z[i] = zero; }
    for (size_t i = gt; i < (size_t)16384 * DM / 8; i += NT) { const int d = (int)((i * 8) & (DM - 1));
        const f32x4 a = *(const f32x4*)(F.peer_down + i * 8), b = *(const f32x4*)(F.peer_down + i * 8 + 4), ga = *(const f32x4*)(F.norm2_g + d), gb = *(const f32x4*)(F.norm2_g + d + 4);
        u32x4 o; o.x = pk2(a[0] * ga[0], a[1] * ga[1]); o.y = pk2(a[2] * ga[2], a[3] * ga[3]); o.z = pk2(b[0] * gb[0], b[1] * gb[1]); o.w = pk2(b[2] * gb[2], b[3] * gb[3]);
        *(u32x4*)(F.down16 + i * 8) = o; }
    for (size_t i = gt; i < (size_t)16384 * DM / 8; i += NT) { const f32x4 a = *(const f32x4*)(F.peer_up + i * 8), b = *(const f32x4*)(F.peer_up + i * 8 + 4);
        u32x4 o; o.x = pk2(a[0], a[1]); o.y = pk2(a[2], a[3]); o.z = pk2(b[0], b[1]); o.w = pk2(b[2], b[3]); *(u32x4*)(F.up16 + i * 8) = o; }
    for (size_t i = gt; i < (size_t)8 * 2 * 128 * 128 / 8; i += NT) { const f32x4 a = *(const f32x4*)(F.sub_keys + i * 8), b = *(const f32x4*)(F.sub_keys + i * 8 + 4);
        u32x4 o; o.x = pk2(a[0], a[1]); o.y = pk2(a[2], a[3]); o.z = pk2(b[0], b[1]); o.w = pk2(b[2], b[3]); *(u32x4*)(F.SK + i * 8) = o; }
    for (int m = gw; m < T; m += NGW) { const f32x4* xr = (const f32x4*)(F.x + (size_t)m * DM) + lane; f32x4 v[8]; float s = 0.f;
#pragma unroll
        for (int j = 0; j < 8; ++j) { v[j] = xr[64 * j]; s += (v[j][0] * v[j][0] + v[j][1] * v[j][1]) + (v[j][2] * v[j][2] + v[j][3] * v[j][3]); }
        s = wave_sum(s); u32x2* o8 = (u32x2*)(F.xb + (size_t)m * DM) + lane;
#pragma unroll
        for (int j = 0; j < 8; ++j) { u32x2 w; w.x = pk2(v[j][0], v[j][1]); w.y = pk2(v[j][2], v[j][3]); o8[64 * j] = w; }
        if (lane == 0) F.rs1[m] = __builtin_amdgcn_rsqf(s * (1.f / DM) + EPS); }
    { const double invf[16] = {1.0, 0.44036660267178046, 0.19392274474868576, 0.08539710028576561, 0.03760603093086393, 0.016560440080994446, 0.007292664737217109, 0.003211445994752591,
                               0.001414213562373095, 0.000622772421914596, 0.0002742481756762073, 0.00012076973741146504, 5.318295896944988e-05, 2.341999896140934e-05, 1.031338537721246e-05, 4.5416704806078695e-06};
      for (size_t i = gt; i < (size_t)SEQ * 16; i += NT) { const int pos = (int)(i >> 4), j = (int)(i & 15); double f = 1.0;
#pragma unroll
          for (int q = 0; q < 16; ++q) f = (j == q) ? invf[q] : f;
          const double rev = (double)pos * f * 0.15915494309189535; const float fr = (float)(rev - floor(rev));
          F.rope[i] = (f32x2){__builtin_amdgcn_cosf(fr), __builtin_amdgcn_sinf(fr)}; } }
}

__device__ __forceinline__ void qknorm_rope(const Frame& F) {
    const int gw = F.vcu * 8 + F.wave, NGW = F.G * 8, lane = F.lane, c = lane & 15;
    for (long it = gw; it < (long)T * 24 / 4; it += NGW) { const long row = it * 4 + (lane >> 4); const int t = (int)(row / 24), slot = (int)(row % 24);
        bf16_t* p = F.h + (size_t)t * HP + C_QD + slot * 128 + 8 * c;
        const u32x4 w = *(const u32x4*)p; float y[8] = {bflo(w.x), bfhi(w.x), bflo(w.y), bfhi(w.y), bflo(w.z), bfhi(w.z), bflo(w.w), bfhi(w.w)};
        float ss = 0.f;
#pragma unroll
        for (int e = 0; e < 8; ++e) ss += y[e] * y[e];
        ss += __shfl_xor(ss, 1); ss += __shfl_xor(ss, 2); ss += __shfl_xor(ss, 4); ss += __shfl_xor(ss, 8);
        const float rq = __builtin_amdgcn_rsqf(ss * (1.f / 128.f) + EPS); const float* g = (slot < 12 ? F.qn_g : F.kn_g) + 8 * c;
        const f32x4 g0 = *(const f32x4*)g, g1 = *(const f32x4*)(g + 4);
#pragma unroll
        for (int e = 0; e < 4; ++e) { y[e] *= rq * g0[e]; y[4 + e] *= rq * g1[e]; }
        const int pos = t & (SEQ - 1);
#pragma unroll
        for (int e = 0; e < 8; ++e) { const float partner = __shfl_xor(y[e], 2);
            if (c < 4) { const f32x2 cs = F.rope[(size_t)pos * 16 + 8 * (c & 1) + e]; y[e] = (c < 2) ? (y[e] * cs.x - partner * cs.y) : (y[e] * cs.x + partner * cs.y); } }
        if (slot < 12) {
#pragma unroll
            for (int e = 0; e < 8; ++e) y[e] *= QSCALE; }
        u32x4 o; o.x = pk2(y[0], y[1]); o.y = pk2(y[2], y[3]); o.z = pk2(y[4], y[5]); o.w = pk2(y[6], y[7]); *(u32x4*)p = o; }
}

constexpr int GL_GDS = 0, GL_TOT = 8192, GL_QF = 12288, GL_QB = 21504, GL_KF = 30720, GL_KB = 39936, GL_VT = 49152, GL_P = 67584, GL_SF = 76800, GL_SB = 95232, GL_OB = 12288;
constexpr int RS72 = 144;
__device__ __forceinline__ float logsig(float z) { return fminf(z, 0.f) - flog(1.f + fexp(-fabsf(z))); }
__device__ __forceinline__ void gla_gates(const Frame& F, int b, int hh, int n, float (&bf)[8], float (&bb)[8], float& totf, float& totb) {
    const int tid = F.tid, c = tid & 63, ig = F.wave; LAS float* gds = (LAS float*)(F.lds + GL_GDS); LAS float* tot = (LAS float*)(F.lds + GL_TOT);
    const size_t t0 = (size_t)b * SEQ + (size_t)n * 64;
    if (tid < 256) { const int tk = tid >> 2, part = tid & 3; const u32x4 w = *(const u32x4*)(F.h + (t0 + tk) * HP + C_GF + part * 8); LAS float* d = gds + tk * 32 + part * 8;
        d[0] = bflo(w.x); d[1] = bfhi(w.x); d[2] = bflo(w.y); d[3] = bfhi(w.y); d[4] = bflo(w.z); d[5] = bfhi(w.z); d[6] = bflo(w.w); d[7] = bfhi(w.w); }
    __syncthreads();
    const int hc = hh * 64 + c; float upf[16], upb[16];
#pragma unroll
    for (int r = 0; r < 16; ++r) { upf[r] = F.up_f[r * 256 + hc]; upb[r] = F.up_b[r * 256 + hc]; }
    const float biasf = F.bias_f[hc], biasb = F.bias_b[hc]; float laf[8], lab[8];
#pragma unroll
    for (int e = 0; e < 8; ++e) { const LAS float* gr = gds + (ig * 8 + e) * 32; float zf = biasf, zb = biasb;
#pragma unroll
        for (int r = 0; r < 16; ++r) { zf += gr[r] * upf[r]; zb += gr[16 + r] * upb[r]; }
        laf[e] = logsig(zf) * 0.0625f; lab[e] = logsig(zb) * 0.0625f; }
    bf[0] = laf[0];
#pragma unroll
    for (int e = 1; e < 8; ++e) bf[e] = bf[e - 1] + laf[e];
    bb[7] = lab[7];
#pragma unroll
    for (int e = 6; e >= 0; --e) bb[e] = bb[e + 1] + lab[e];
    tot[ig * 64 + c] = bf[7]; tot[512 + ig * 64 + c] = bb[0];
    __syncthreads();
    float offf = 0.f, offb = 0.f; totf = 0.f; totb = 0.f;
#pragma unroll
    for (int g = 0; g < 8; ++g) { const float tf = tot[g * 64 + c], tb = tot[512 + g * 64 + c]; totf += tf; totb += tb; offf += (g < ig) ? tf : 0.f; offb += (g > ig) ? tb : 0.f; }
#pragma unroll
    for (int e = 0; e < 8; ++e) { bf[e] += offf; bb[e] += offb; }
}
__device__ __forceinline__ void gla_stage_vT(const Frame& F, size_t t0, int hh) {
#pragma unroll
    for (int j = 0; j < 2; ++j) { const int q = F.tid + 512 * j, tk = q >> 4, vc = (q & 15) * 8; const bf16x8 v = *(const bf16x8*)(F.h + (t0 + tk) * HP + C_VA + hh * 128 + vc);
        LAS short* d = (LAS short*)(F.lds + GL_VT) + vc * 72 + tk;
#pragma unroll
        for (int e = 0; e < 8; ++e) d[e * 72] = v[e]; }
}
__device__ __forceinline__ bf16x8 ldfrag(const LAS unsigned char* base, int row, int s, int hi) { return *(const LAS bf16x8*)(base + row * RS72 + (16 * s + 8 * hi) * 2); }

__device__ __forceinline__ void gla_passA(const Frame& F, int item) {
    const int bh = item >> 8, n = item & 255, b = bh >> 2, hh = bh & 3, tid = F.tid, c = tid & 63, ig = F.wave, lane = F.lane, r32 = lane & 31, hi = lane >> 5;
    float bf[8], bb[8], totf, totb; gla_gates(F, b, hh, n, bf, bb, totf, totb);
    const size_t t0 = (size_t)b * SEQ + (size_t)n * 64;
    float kf[8], kb[8];
#pragma unroll
    for (int e = 0; e < 8; ++e) { const float k = bf2f(F.h[(t0 + ig * 8 + e) * HP + C_KA + hh * 64 + c]); kf[e] = k * fexp(totf - bf[e]); kb[e] = k * fexp(totb - bb[e]); }
    { u32x4 o; o.x = pk2(kf[0], kf[1]); o.y = pk2(kf[2], kf[3]); o.z = pk2(kf[4], kf[5]); o.w = pk2(kf[6], kf[7]); *(LAS u32x4*)(F.lds + GL_KF + c * RS72 + ig * 16) = o;
      o.x = pk2(kb[0], kb[1]); o.y = pk2(kb[2], kb[3]); o.z = pk2(kb[4], kb[5]); o.w = pk2(kb[6], kb[7]); *(LAS u32x4*)(F.lds + GL_KB + c * RS72 + ig * 16) = o; }
    gla_stage_vT(F, t0, hh);
    if (ig == 0) { F.dec[((size_t)(0 * 8 + bh) * 256 + n) * 64 + c] = fexp(totf); F.dec[((size_t)(1 * 8 + bh) * 256 + n) * 64 + c] = fexp(totb); }
    __syncthreads();
    const int dir = F.wave >> 2, vt = F.wave & 3; const LAS unsigned char* kimg = F.lds + (dir ? GL_KB : GL_KF);
    f32x16 a0 = {}, a1 = {};
#pragma unroll
    for (int s = 0; s < 4; ++s) { const bf16x8 av = ldfrag(F.lds + GL_VT, 32 * vt + r32, s, hi), b0 = ldfrag(kimg, r32, s, hi), b1 = ldfrag(kimg, 32 + r32, s, hi);
        a0 = __builtin_amdgcn_mfma_f32_32x32x16_bf16(av, b0, a0, 0, 0, 0); a1 = __builtin_amdgcn_mfma_f32_32x32x16_bf16(av, b1, a1, 0, 0, 0); }
    float* st = F.state + ((size_t)(dir * 8 + bh) * 256 + n) * 8192;
#pragma unroll
    for (int r = 0; r < 16; ++r) { const int v = 32 * vt + crow(r, hi); st[v * 64 + r32] = a0[r]; st[v * 64 + 32 + r32] = a1[r]; }
    __syncthreads();
}
__device__ __forceinline__ void gla_scan(const Frame& F, int item) {
    const int dir = item >> 7, bh = (item >> 4) & 7, e = (item & 15) * 512 + F.tid, c = e & 63;
    float* st = F.state + (size_t)(dir * 8 + bh) * 256 * 8192 + e; const float* dc = F.dec + (size_t)(dir * 8 + bh) * 256 * 64 + c; float S = 0.f;
    for (int g = 0; g < 32; ++g) { float inc[8], d[8];
#pragma unroll
        for (int j = 0; j < 8; ++j) { const int n = dir ? 255 - (g * 8 + j) : g * 8 + j; inc[j] = st[(size_t)n * 8192]; d[j] = dc[n * 64]; }
#pragma unroll
        for (int j = 0; j < 8; ++j) { const int n = dir ? 255 - (g * 8 + j) : g * 8 + j; st[(size_t)n * 8192] = S; S = d[j] * S + inc[j]; } }
}
__device__ __forceinline__ void gla_passC(const Frame& F, int item) {
    const int bh = item >> 8, n = item & 255, b = bh >> 2, hh = bh & 3, tid = F.tid, c = tid & 63, ig = F.wave, lane = F.lane, r32 = lane & 31, hi = lane >> 5;
    float bf[8], bb[8], totf, totb; gla_gates(F, b, hh, n, bf, bb, totf, totb);
    const size_t t0 = (size_t)b * SEQ + (size_t)n * 64;
#pragma unroll
    for (int e = 0; e < 8; ++e) { const int i = ig * 8 + e; const bf16_t* hr = F.h + (t0 + i) * HP + hh * 64 + c; const float q = bf2f(hr[C_QA]) * 0.125f, k = bf2f(hr[C_KA]);
        const float ef = fexp(bf[e]), eb = fexp(bb[e]), nf = fexp(-bf[e]), nb = fexp(-bb[e]);
        *(LAS unsigned short*)(F.lds + GL_QF + i * RS72 + c * 2) = (unsigned short)f2bf(q * ef); *(LAS unsigned short*)(F.lds + GL_QB + i * RS72 + c * 2) = (unsigned short)f2bf(q * eb);
        *(LAS unsigned short*)(F.lds + GL_KF + i * RS72 + c * 2) = (unsigned short)f2bf(k * nf); *(LAS unsigned short*)(F.lds + GL_KB + i * RS72 + c * 2) = (unsigned short)f2bf(k * nb); }
    gla_stage_vT(F, t0, hh);
#pragma unroll
    for (int dir = 0; dir < 2; ++dir) { const float* st = F.state + ((size_t)(dir * 8 + bh) * 256 + n) * 8192; LAS unsigned char* img = F.lds + (dir ? GL_SB : GL_SF);
#pragma unroll
        for (int j = 0; j < 4; ++j) { const int q4 = tid + 512 * j, v = q4 >> 4, c4 = (q4 & 15) * 4; const f32x4 s = *(const f32x4*)(st + v * 64 + c4);
            u32x2 w; w.x = pk2(s[0], s[1]); w.y = pk2(s[2], s[3]); *(LAS u32x2*)(img + v * RS72 + c4 * 2) = w; } }
    __syncthreads();
    if (F.wave < 4) { const int ti = F.wave >> 1, tj = F.wave & 1; f32x16 sf = {}, sb = {};
#pragma unroll
        for (int s = 0; s < 4; ++s) {
            sf = __builtin_amdgcn_mfma_f32_32x32x16_bf16(ldfrag(F.lds + GL_QF, 32 * ti + r32, s, hi), ldfrag(F.lds + GL_KF, 32 * tj + r32, s, hi), sf, 0, 0, 0);
            sb = __builtin_amdgcn_mfma_f32_32x32x16_bf16(ldfrag(F.lds + GL_QB, 32 * ti + r32, s, hi), ldfrag(F.lds + GL_KB, 32 * tj + r32, s, hi), sb, 0, 0, 0); }
#pragma unroll
        for (int r = 0; r < 16; ++r) { const int i = 32 * ti + crow(r, hi), j = 32 * tj + r32; const float p = (j <= i) ? sf[r] : sb[r];
            *(LAS unsigned short*)(F.lds + GL_P + i * RS72 + j * 2) = (unsigned short)f2bf(p); } }
    __syncthreads();
    const int ti = F.wave & 1, tv = F.wave >> 1; f32x16 o = {};
#pragma unroll
    for (int s = 0; s < 4; ++s) o = __builtin_amdgcn_mfma_f32_32x32x16_bf16(ldfrag(F.lds + GL_P, 32 * ti + r32, s, hi), ldfrag(F.lds + GL_VT, 32 * tv + r32, s, hi), o, 0, 0, 0);
#pragma unroll
    for (int s = 0; s < 4; ++s) o = __builtin_amdgcn_mfma_f32_32x32x16_bf16(ldfrag(F.lds + GL_QF, 32 * ti + r32, s, hi), ldfrag(F.lds + GL_SF, 32 * tv + r32, s, hi), o, 0, 0, 0);
#pragma unroll
    for (int s = 0; s < 4; ++s) o = __builtin_amdgcn_mfma_f32_32x32x16_bf16(ldfrag(F.lds + GL_QB, 32 * ti + r32, s, hi), ldfrag(F.lds + GL_SB, 32 * tv + r32, s, hi), o, 0, 0, 0);
    __syncthreads();
    LAS float* ob = (LAS float*)(F.lds + GL_OB);
#pragma unroll
    for (int r = 0; r < 16; ++r) ob[(32 * ti + crow(r, hi)) * 132 + 32 * tv + r32] = o[r];
    __syncthreads();
    { const int i = tid >> 3, part = tid & 7, v0 = part * 16; float ov[16], ss = 0.f;
#pragma unroll
      for (int e = 0; e < 16; ++e) { ov[e] = ob[i * 132 + v0 + e]; ss += ov[e] * ov[e]; }
      ss += __shfl_xor(ss, 1); ss += __shfl_xor(ss, 2); ss += __shfl_xor(ss, 4);
      const float rs = __builtin_amdgcn_rsqf(ss * (1.f / 128.f) + EPS); const size_t tok = t0 + i;
      const u32x4 r0 = *(const u32x4*)(F.h + tok * HP + C_RA + hh * 128 + v0), r1 = *(const u32x4*)(F.h + tok * HP + C_RA + hh * 128 + v0 + 8);
      const float rr[16] = {bflo(r0.x), bfhi(r0.x), bflo(r0.y), bfhi(r0.y), bflo(r0.z), bfhi(r0.z), bflo(r0.w), bfhi(r0.w), bflo(r1.x), bfhi(r1.x), bflo(r1.y), bfhi(r1.y), bflo(r1.z), bfhi(r1.z), bflo(r1.w), bfhi(r1.w)};
      float y[16];
#pragma unroll
      for (int e = 0; e < 16; ++e) { const float g = F.out_g[hh * 128 + v0 + e]; const float sil = rr[e] * __builtin_amdgcn_rcpf(1.f + fexp(-rr[e])); y[e] = ov[e] * rs * g * sil; }
      u32x4 w0, w1; w0.x = pk2(y[0], y[1]); w0.y = pk2(y[2], y[3]); w0.z = pk2(y[4], y[5]); w0.w = pk2(y[6], y[7]); w1.x = pk2(y[8], y[9]); w1.y = pk2(y[10], y[11]); w1.z = pk2(y[12], y[13]); w1.w = pk2(y[14], y[15]);
      bf16_t* mp = F.mixed + tok * DM + hh * 128 + v0; *(u32x4*)mp = w0; *(u32x4*)(mp + 8) = w1; }
    __syncthreads();
}

constexpr int AT_V = 0, AT_K = 32768, AT_O = 65536;
#define KSWZ(row, colB) ((row) * 256 + ((colB) ^ (((row) & 7) << 4)))
__device__ __forceinline__ int v_st(int k, int c) { const int kk = (k & ~0xC) | ((k & 4) << 1) | ((k & 8) >> 1); return ((kk >> 3) * 4 + (c >> 5)) * 512 + ((kk & 7) * 32 + (c & 31)) * 2; }
__device__ __forceinline__ int v_rd_base(int lane) { return ((lane & 3) << 3) | (((lane >> 2) & 3) << 6) | (((lane >> 4) & 1) << 5) | (((lane >> 5) & 1) << 8); }
constexpr int v_rd_off(int d0, int ks, int half) { return d0 * 512 + ks * 4096 + half * 2048; }
template <int OFF> __device__ __forceinline__ s16x4 tr_read(int vb) { s16x4 r; asm volatile("ds_read_b64_tr_b16 %0, %1 offset:%2" : "=&v"(r) : "v"(vb), "i"(OFF) : "memory"); return r; }
template <int D0> __device__ __forceinline__ void pv_one(f32x16& od, int vb, bf16x8 pa0, bf16x8 pa1, bf16x8 pa2, bf16x8 pa3) {
    const s16x4 l0 = tr_read<v_rd_off(D0, 0, 0)>(vb), h0 = tr_read<v_rd_off(D0, 0, 1)>(vb), l1 = tr_read<v_rd_off(D0, 1, 0)>(vb), h1 = tr_read<v_rd_off(D0, 1, 1)>(vb);
    const s16x4 l2 = tr_read<v_rd_off(D0, 2, 0)>(vb), h2 = tr_read<v_rd_off(D0, 2, 1)>(vb), l3 = tr_read<v_rd_off(D0, 3, 0)>(vb), h3 = tr_read<v_rd_off(D0, 3, 1)>(vb);
    asm volatile("s_waitcnt lgkmcnt(0)" ::: "memory"); SBAR();
#define PKV(L, H) (bf16x8){L[0], L[1], L[2], L[3], H[0], H[1], H[2], H[3]}
    od = __builtin_amdgcn_mfma_f32_32x32x16_bf16(pa0, PKV(l0, h0), od, 0, 0, 0);
    od = __builtin_amdgcn_mfma_f32_32x32x16_bf16(pa1, PKV(l1, h1), od, 0, 0, 0);
    od = __builtin_amdgcn_mfma_f32_32x32x16_bf16(pa2, PKV(l2, h2), od, 0, 0, 0);
    od = __builtin_amdgcn_mfma_f32_32x32x16_bf16(pa3, PKV(l3, h3), od, 0, 0, 0);
#undef PKV
}
__device__ __forceinline__ void attn_item(const Frame& F, int item) {
    const int tid = F.tid, wid = F.wave, lane = F.lane, r32 = lane & 31, hi = lane >> 5;
    const int p = item / 1536, rem = item % 1536, b = rem / 768, rem2 = rem % 768, head = rem2 >> 6, u = rem2 & 63;
    const int dsh = 2 * p, dil = 1 << dsh, L = SEQ >> dsh, runs = 64 >> dsh, res = u / runs, m0 = (u % runs) * 256;
    const size_t tokbase = (size_t)b * SEQ + res;
    bf16_t* Op = (bf16_t*)(p == 0 ? (unsigned char*)F.out + OUT_OP0 : F.wsb + (p == 1 ? WS_OP1 : WS_OP2));
    const bf16_t* hq = F.h + C_QD + head * 128; const bf16_t* hk = F.h + C_KD + head * 128; const bf16_t* hv = F.h + C_VD + head * 128;
    const int Q0 = m0 + 32 * wid;
    bf16x8 qr[8];
    { const bf16_t* qp = hq + (tokbase + (size_t)dil * (Q0 + r32)) * HP + hi * 8;
#pragma unroll
      for (int d0 = 0; d0 < 8; ++d0) qr[d0] = *(const bf16x8*)(qp + d0 * 16); }
    const int sr = tid >> 4, sc = (tid & 15) * 8, vst0 = v_st(sr, sc), vst1 = v_st(32 + sr, sc), kc = sc * 2;
    const int vb0 = (int)(unsigned)(uintptr_t)(F.ldsg + AT_V) + v_rd_base(lane);
    const int kt_lo = (m0 == 0) ? 1 : 0, kt_hi = (m0 + 256 >= L) ? 4 : 5;
    f32x16 o[4] = {}; float l_reg = 0.f;
    bf16x8 sv0, sv1, sk0, sk1;
#define AT_SLOAD(T0) do { const size_t ra = (tokbase + (size_t)dil * ((T0) + sr)) * HP + sc, rb = (tokbase + (size_t)dil * ((T0) + 32 + sr)) * HP + sc; \
        sv0 = *(const bf16x8*)(hv + ra); sv1 = *(const bf16x8*)(hv + rb); sk0 = *(const bf16x8*)(hk + ra); sk1 = *(const bf16x8*)(hk + rb); } while (0)
#define AT_SWRITE(B) do { *(LAS bf16x8*)(F.lds + AT_V + (B) * 16384 + vst0) = sv0; *(LAS bf16x8*)(F.lds + AT_V + (B) * 16384 + vst1) = sv1; \
        *(LAS bf16x8*)(F.lds + AT_K + (B) * 16384 + KSWZ(sr, kc)) = sk0; *(LAS bf16x8*)(F.lds + AT_K + (B) * 16384 + KSWZ(32 + sr, kc)) = sk1; } while (0)
    AT_SLOAD(m0 - 64 + 64 * kt_lo); AT_SWRITE(0); __syncthreads();
    int buf = 0;
    for (int kt = kt_lo; kt <= kt_hi; ++kt) {
        const int T0 = m0 - 64 + 64 * kt; const bool more = kt < kt_hi;
        if (more) AT_SLOAD(T0 + 64);
        if (T0 + 63 >= Q0 - 64 && T0 <= Q0 + 95) {
            const LAS unsigned char* Ks = F.lds + AT_K + buf * 16384; f32x16 p0 = {}, p1 = {};
#pragma unroll
            for (int d0 = 0; d0 < 8; ++d0) { const int cb = (d0 * 16 + hi * 8) * 2;
                const bf16x8 k0 = *(const LAS bf16x8*)(Ks + KSWZ(r32, cb)), k1 = *(const LAS bf16x8*)(Ks + KSWZ(32 + r32, cb));
                p0 = __builtin_amdgcn_mfma_f32_32x32x16_bf16(k0, qr[d0], p0, 0, 0, 0); p1 = __builtin_amdgcn_mfma_f32_32x32x16_bf16(k1, qr[d0], p1, 0, 0, 0); }
            const int dq = T0 - (Q0 + r32); float ps = 0.f;
#pragma unroll
            for (int r = 0; r < 16; ++r) { const int e0 = dq + crow(r, hi), e1 = e0 + 32;
                p0[r] = (e0 >= -64 && e0 <= 64) ? __builtin_amdgcn_exp2f(p0[r]) : 0.f; p1[r] = (e1 >= -64 && e1 <= 64) ? __builtin_amdgcn_exp2f(p1[r]) : 0.f; ps += p0[r] + p1[r]; }
            l_reg += ps;
            bf16x8 pa0, pa1, pa2, pa3;
#define PK4(P, BASE, OUT) do { unsigned a0_ = pk2(P[BASE + 0], P[BASE + 1]), a1_ = pk2(P[BASE + 2], P[BASE + 3]); unsigned b0_ = pk2(P[BASE + 4], P[BASE + 5]), b1_ = pk2(P[BASE + 6], P[BASE + 7]); \
        auto r0_ = __builtin_amdgcn_permlane32_swap(a0_, b0_, false, false); auto r1_ = __builtin_amdgcn_permlane32_swap(a1_, b1_, false, false); \
        u32x4 w_ = {r0_[0], r1_[0], r0_[1], r1_[1]}; OUT = __builtin_bit_cast(bf16x8, w_); } while (0)
            PK4(p0, 0, pa0); PK4(p0, 8, pa1); PK4(p1, 0, pa2); PK4(p1, 8, pa3);
#undef PK4
            const int vb = vb0 + buf * 16384;
            pv_one<0>(o[0], vb, pa0, pa1, pa2, pa3); pv_one<1>(o[1], vb, pa0, pa1, pa2, pa3); pv_one<2>(o[2], vb, pa0, pa1, pa2, pa3); pv_one<3>(o[3], vb, pa0, pa1, pa2, pa3);
        }
        if (more) AT_SWRITE(buf ^ 1);
        __syncthreads(); buf ^= 1;
    }
#undef AT_SLOAD
#undef AT_SWRITE
    l_reg += __shfl_xor(l_reg, 32);
    if (hi == 0) F.lp[((size_t)p * T + tokbase + (size_t)dil * (Q0 + r32)) * NHD + head] = l_reg;
    LAS unsigned char* stg = F.lds + AT_O + wid * 8192;
#pragma unroll
    for (int d0 = 0; d0 < 4; ++d0)
#pragma unroll
        for (int r = 0; r < 16; ++r) *(LAS unsigned short*)(stg + (crow(r, hi) * 128 + d0 * 32 + r32) * 2) = (unsigned short)f2bf(o[d0][r]);
    LDS_WAIT(); asm volatile("" ::: "memory");
#pragma unroll
    for (int it = 0; it < 8; ++it) { const int row = 4 * it + (lane >> 4), ch = lane & 15; const u32x4 w = *(const LAS u32x4*)(stg + row * 256 + ch * 16);
        *(u32x4*)(Op + (tokbase + (size_t)dil * (Q0 + row)) * (NHD * 128) + head * 128 + ch * 8) = w; }
    __syncthreads();
}
__device__ __forceinline__ void dil_combine(const Frame& F) {
    const int gw = F.vcu * 8 + F.wave, NGW = F.G * 8, lane = F.lane, c = lane & 15;
    for (long it = gw; it < (long)T * NHD / 4; it += NGW) { const long row = it * 4 + (lane >> 4); const size_t tok = (size_t)(row / NHD); const int head = (int)(row % NHD);
        const float l = F.lp[tok * NHD + head] + F.lp[((size_t)T + tok) * NHD + head] + F.lp[((size_t)2 * T + tok) * NHD + head]; const float inv = 1.f / l;
        const size_t off = tok * (NHD * 128) + head * 128 + 8 * c; const u32x4 a = *(const u32x4*)(F.op0 + off), b = *(const u32x4*)(F.op1 + off), d = *(const u32x4*)(F.op2 + off);
        u32x4 o; o.x = pk2((bflo(a.x) + bflo(b.x) + bflo(d.x)) * inv, (bfhi(a.x) + bfhi(b.x) + bfhi(d.x)) * inv); o.y = pk2((bflo(a.y) + bflo(b.y) + bflo(d.y)) * inv, (bfhi(a.y) + bfhi(b.y) + bfhi(d.y)) * inv);
        o.z = pk2((bflo(a.z) + bflo(b.z) + bflo(d.z)) * inv, (bfhi(a.z) + bfhi(b.z) + bfhi(d.z)) * inv); o.w = pk2((bflo(a.w) + bflo(b.w) + bflo(d.w)) * inv, (bfhi(a.w) + bfhi(b.w) + bfhi(d.w)) * inv);
        *(u32x4*)(F.mixed + tok * DM + 512 + head * 128 + 8 * c) = o; }
}

__device__ __forceinline__ unsigned fl_flip(float x) { const unsigned u = __float_as_uint(x); return u ^ ((unsigned)((int)u >> 31) | 0x80000000u); }
__device__ __forceinline__ float fl_unflip(unsigned w) { return __uint_as_float((w & 0x80000000u) ? (w ^ 0x80000000u) : ~w); }
#define CE_DESC(a, b) do { const unsigned x_ = max(a, b), y_ = min(a, b); a = x_; b = y_; } while (0)
__device__ __forceinline__ void sort16_desc(unsigned (&a)[16]) {
#pragma unroll
    for (int k = 2; k <= 16; k <<= 1)
#pragma unroll
        for (int j = k >> 1; j > 0; j >>= 1)
#pragma unroll
            for (int i = 0; i < 16; ++i) { const int l = i ^ j; if (l > i) { const unsigned x = max(a[i], a[l]), y = min(a[i], a[l]); if ((i & k) == 0) { a[i] = x; a[l] = y; } else { a[i] = y; a[l] = x; } } }
}
__device__ __forceinline__ void bmerge16_desc(unsigned (&a)[16]) {
#pragma unroll
    for (int j = 8; j > 0; j >>= 1)
#pragma unroll
        for (int i = 0; i < 16; ++i) { const int l = i ^ j; if (l > i) CE_DESC(a[i], a[l]); }
}
__device__ __forceinline__ void top16_merge(unsigned (&a)[16], const unsigned (&b)[16]) {
#pragma unroll
    for (int i = 0; i < 16; ++i) a[i] = max(a[i], b[15 - i]);
    bmerge16_desc(a);
}
__device__ __forceinline__ void top16_partner(unsigned (&a)[16]) {
    unsigned b[16];
#pragma unroll
    for (int i = 0; i < 16; ++i) b[i] = (unsigned)__shfl_xor((int)a[i], 32);
    top16_merge(a, b);
}
__device__ constexpr unsigned char stair(int n) {
    constexpr unsigned char L[64] = {0x00,0x01,0x02,0x03,0x04,0x05,0x06,0x07,0x08,0x09,0x0a,0x0b,0x0c,0x0d,0x0e,0x0f,0x10,0x11,0x12,0x13,0x14,0x15,0x16,0x17,0x20,0x21,0x22,0x23,0x24,0x30,0x31,0x32,
                                     0x33,0x40,0x41,0x42,0x50,0x51,0x60,0x61,0x70,0x71,0x80,0x90,0xa0,0xb0,0xc0,0xd0,0xe0,0xf0,0xff,0xff,0xff,0xff,0xff,0xff,0xff,0xff,0xff,0xff,0xff,0xff,0xff,0xff};
    return L[n];
}
__device__ __forceinline__ void topk_item(const Frame& F, int item) {
    const int lane = F.lane, r32 = lane & 31, hi = lane >> 5, hh = item & 7, tok0 = (item >> 3) * 32; const size_t tok = (size_t)tok0 + r32;
    LAS int* ktab = (LAS int*)(F.lds + F.wave * 4096) + r32 * 32;
    float ss = 0.f;
    { const f32x4* sp = (const f32x4*)(F.ssp + tok * 32 + hi * 16);
#pragma unroll
      for (int j = 0; j < 4; ++j) { const f32x4 v = sp[j]; ss += (v[0] + v[1]) + (v[2] + v[3]); } }
    ss += __shfl_xor(ss, 32);
    const float rs2 = __builtin_amdgcn_rsqf(ss * (1.f / DM) + EPS);
    if (hh == 0 && hi == 0) F.rs2[tok] = rs2;
    unsigned top[2][16];
#pragma unroll
    for (int cc = 0; cc < 2; ++cc) {
        f32x16 acc[4] = {};
        const bf16_t* qp = F.qry + tok * DM + hh * 256 + cc * 128 + hi * 8; const bf16_t* kp = F.SK + ((size_t)(hh * 2 + cc) * 128 + r32) * 128 + hi * 8;
#pragma unroll 2
        for (int s = 0; s < 8; ++s) { const bf16x8 qf = *(const bf16x8*)(qp + 16 * s);
#pragma unroll
            for (int kt = 0; kt < 4; ++kt) { const bf16x8 kf = *(const bf16x8*)(kp + (size_t)kt * 32 * 128 + 16 * s); acc[kt] = __builtin_amdgcn_mfma_f32_32x32x16_bf16(kf, qf, acc[kt], 0, 0, 0); } }
        unsigned g[4][16];
#pragma unroll
        for (int kt = 0; kt < 4; ++kt) {
#pragma unroll
            for (int r = 0; r < 16; ++r) g[kt][r] = (fl_flip(acc[kt][r]) & ~127u) | (unsigned)(127 - (32 * kt + crow(r, hi)));
            sort16_desc(g[kt]); }
        top16_merge(g[0], g[1]); top16_merge(g[2], g[3]); top16_merge(g[0], g[2]); top16_partner(g[0]);
#pragma unroll
        for (int i = 0; i < 16; ++i) top[cc][i] = g[0][i];
    }
#pragma unroll
    for (int i = 0; i < 16; ++i) ktab[hi * 16 + i] = 127 - (int)((hi ? top[1][i] : top[0][i]) & 127u);
    float s0[16], s1[16];
#pragma unroll
    for (int i = 0; i < 16; ++i) { s0[i] = fl_unflip(top[0][i] & ~127u); s1[i] = fl_unflip(top[1][i] & ~127u); }
    unsigned ca[16], cb[16];
#pragma unroll
    for (int n = 0; n < 32; ++n) { const int A = stair(n), B = stair(25 + n); unsigned va = 0u, vb = 0u;
        if (n < 25) { va = (fl_flip(s0[A >> 4] + s1[A & 15]) & ~255u) | (unsigned)(255 - A); vb = (fl_flip(s0[B >> 4] + s1[B & 15]) & ~255u) | (unsigned)(255 - B); }
        const unsigned v = hi ? vb : va; if (n < 16) ca[n] = v; else cb[n - 16] = v; }
    sort16_desc(ca); sort16_desc(cb); top16_merge(ca, cb); top16_partner(ca);
    float e[16], sum = 0.f; const float mx = fl_unflip(ca[0] & ~255u) * rs2;
#pragma unroll
    for (int i = 0; i < 16; ++i) { e[i] = fexp(fl_unflip(ca[i] & ~255u) * rs2 - mx); sum += e[i]; }
    const float inv = 1.f / sum;
    LDS_WAIT(); asm volatile("" ::: "memory");
    int oi[8]; float og[8];
#pragma unroll
    for (int k = 0; k < 8; ++k) { const unsigned cv = hi ? ca[8 + k] : ca[k]; const int code = 255 - (int)(cv & 255u); og[k] = (hi ? e[8 + k] : e[k]) * inv; oi[k] = ktab[code >> 4] * 128 + ktab[16 + (code & 15)]; }
    { int* ip = F.idx + tok * 128 + hh * 16 + hi * 8; float* gp = F.gate + tok * 128 + hh * 16 + hi * 8;
      *(int4*)ip = make_int4(oi[0], oi[1], oi[2], oi[3]); *(int4*)(ip + 4) = make_int4(oi[4], oi[5], oi[6], oi[7]);
      *(f32x4*)gp = (f32x4){og[0], og[1], og[2], og[3]}; *(f32x4*)(gp + 4) = (f32x4){og[4], og[5], og[6], og[7]}; }
    LDS_WAIT(); asm volatile("" ::: "memory");
}

__device__ __forceinline__ float gelu_tanh(float x) { const float u = 0.7978845608028654f * (x + 0.044715f * x * x * x); const float t = 1.f - 2.f * __builtin_amdgcn_rcpf(1.f + fexp(2.f * u)); return 0.5f * x * (1.f + t); }
__device__ __forceinline__ float dot8(u32x4 w, u32x4 xv, float acc) {
    acc += bflo(w.x) * bflo(xv.x); acc += bfhi(w.x) * bfhi(xv.x); acc += bflo(w.y) * bflo(xv.y); acc += bfhi(w.y) * bfhi(xv.y);
    acc += bflo(w.z) * bflo(xv.z); acc += bfhi(w.z) * bfhi(xv.z); acc += bflo(w.w) * bflo(xv.w); acc += bfhi(w.w) * bfhi(xv.w); return acc;
}
__device__ __forceinline__ void peer_token(const Frame& F, size_t tok) {
    const int lane = F.lane;
    u32x4 xv[4];
#pragma unroll
    for (int i = 0; i < 4; ++i) xv[i] = *(const u32x4*)(F.x1b + tok * DM + 512 * i + 8 * lane);
    const int i0 = F.idx[tok * 128 + lane], i1 = F.idx[tok * 128 + 64 + lane]; const float g0 = F.gate[tok * 128 + lane], g1 = F.gate[tok * 128 + 64 + lane]; const float rs2 = F.rs2[tok];
    float a0 = 0.f, a1 = 0.f;
#pragma unroll
    for (int half = 0; half < 2; ++half) {
        for (int g = 0; g < 16; ++g) { float p[4];
#pragma unroll
            for (int j = 0; j < 4; ++j) { const int e = __builtin_amdgcn_readlane(half ? i1 : i0, 4 * g + j); const bf16_t* rp = F.down16 + (size_t)e * DM + 8 * lane; float s = 0.f;
#pragma unroll
                for (int i = 0; i < 4; ++i) s = dot8(*(const u32x4*)(rp + 512 * i), xv[i], s);
                p[j] = s; }
            float a = (lane & 1) ? p[1] : p[0], bq = (lane & 1) ? p[0] : p[1], cq = (lane & 1) ? p[3] : p[2], dq = (lane & 1) ? p[2] : p[3];
            a += __shfl_xor(bq, 1); cq += __shfl_xor(dq, 1);
            float d = (lane & 2) ? cq : a, eo = (lane & 2) ? a : cq; d += __shfl_xor(eo, 2);
            d += __shfl_xor(d, 4); d += __shfl_xor(d, 8); d += __shfl_xor(d, 16); d += __shfl_xor(d, 32);
            if ((lane >> 2) == g) { if (half) a1 = d; else a0 = d; } } }
    const float c0 = g0 * gelu_tanh(a0 * rs2), c1 = g1 * gelu_tanh(a1 * rs2);
    float acc[32];
#pragma unroll
    for (int i = 0; i < 32; ++i) acc[i] = 0.f;
#pragma unroll
    for (int half = 0; half < 2; ++half) {
        for (int k = 0; k < 64; ++k) { const int e = __builtin_amdgcn_readlane(half ? i1 : i0, k); const float cf = __uint_as_float(__builtin_amdgcn_readlane(__float_as_uint(half ? c1 : c0), k));
            const bf16_t* rp = F.up16 + (size_t)e * DM + 8 * lane;
#pragma unroll
            for (int i = 0; i < 4; ++i) { const u32x4 w = *(const u32x4*)(rp + 512 * i);
                acc[8 * i + 0] += cf * bflo(w.x); acc[8 * i + 1] += cf * bfhi(w.x); acc[8 * i + 2] += cf * bflo(w.y); acc[8 * i + 3] += cf * bfhi(w.y);
                acc[8 * i + 4] += cf * bflo(w.z); acc[8 * i + 5] += cf * bfhi(w.z); acc[8 * i + 6] += cf * bflo(w.w); acc[8 * i + 7] += cf * bfhi(w.w); } } }
#pragma unroll
    for (int i = 0; i < 4; ++i) { float* op = F.out + tok * DM + 512 * i + 8 * lane; f32x4 v0 = *(const f32x4*)op, v1 = *(const f32x4*)(op + 4);
        v0[0] += acc[8 * i + 0]; v0[1] += acc[8 * i + 1]; v0[2] += acc[8 * i + 2]; v0[3] += acc[8 * i + 3]; v1[0] += acc[8 * i + 4]; v1[1] += acc[8 * i + 5]; v1[2] += acc[8 * i + 6]; v1[3] += acc[8 * i + 7];
        *(f32x4*)op = v0; *(f32x4*)(op + 4) = v1; }
}

struct Args { const float* in[16]; float* out; unsigned char* ws; int ph_lo, ph_hi, coop, pad; };
__global__ void __launch_bounds__(512, 2) fwd_kernel(Args args) {
    extern __shared__ __attribute__((aligned(16))) unsigned char lds_raw[];
    Frame F;
    F.lds = (LAS unsigned char*)lds_raw; F.ldsg = (char*)lds_raw;
    F.tid = threadIdx.x; F.lane = F.tid & 63; F.wave = __builtin_amdgcn_readfirstlane(F.tid >> 6);
    F.G = gridDim.x; { const int bx = blockIdx.x; F.vcu = (F.G % 8 == 0) ? (bx % 8) * (F.G / 8) + bx / 8 : bx; }
    F.x = args.in[0]; F.norm1_g = args.in[1]; F.w_in = args.in[2]; F.up_f = args.in[3]; F.bias_f = args.in[4]; F.up_b = args.in[5]; F.bias_b = args.in[6]; F.out_g = args.in[7];
    F.qn_g = args.in[8]; F.kn_g = args.in[9]; F.w_out = args.in[10]; F.norm2_g = args.in[11]; F.w_query = args.in[12]; F.sub_keys = args.in[13]; F.peer_down = args.in[14]; F.peer_up = args.in[15];
    F.out = args.out; unsigned char* ws = args.ws; F.wsb = ws;
    F.rope = (f32x2*)(ws + WS_ROPE); F.rs1 = (float*)(ws + WS_RS1); F.rs2 = (float*)(ws + WS_RS2); F.ssp = (float*)(ws + WS_SSP); F.dec = (float*)(ws + WS_DEC); F.lp = (float*)(ws + WS_LP);
    F.gate = (float*)(ws + WS_GATE); F.idx = (int*)(ws + WS_IDX); F.state = (float*)((unsigned char*)args.out + OUT_ST);
    F.WinT = (bf16_t*)(ws + WS_WIN); F.WoT = (bf16_t*)(ws + WS_WO); F.WqT = (bf16_t*)(ws + WS_WQ); F.SK = (bf16_t*)(ws + WS_SK); F.down16 = (bf16_t*)(ws + WS_DOWN); F.up16 = (bf16_t*)(ws + WS_UP);
    F.xb = (bf16_t*)(ws + WS_XB); F.mixed = (bf16_t*)(ws + WS_XB); F.h = (bf16_t*)(ws + WS_H); F.x1b = (bf16_t*)(ws + WS_X1B); F.qry = (bf16_t*)(ws + WS_QRY);
    F.op0 = (bf16_t*)((unsigned char*)args.out + OUT_OP0); F.op1 = (bf16_t*)(ws + WS_OP1); F.op2 = (bf16_t*)(ws + WS_OP2);
    const int lo = args.ph_lo, hi = args.ph_hi;
#ifndef PH_MASK
#define PH_MASK 0x1ff
#endif
#define IN(k) (((PH_MASK >> (k)) & 1) && lo <= (k) && (k) < hi)
#define SEAM(k) do { if (IN(k) && IN((k) + 1)) { if (args.coop) cg::this_grid().sync(); } } while (0)
    if (IN(0)) { phase0(F); } SEAM(0);
    if (IN(1)) { pg8::Gemm g{F.xb, F.WinT, T, HP, DM}; pg8::StaticOrder S; S.init(T, HP, F.G, (int)blockIdx.x); pg8::EpiRowScaleBf16 E{F.h, HP, F.rs1};
        pg8::gemm_phase<pg8::EpiRowScaleBf16, pg8::StaticOrder, PG8_ALIGN, PG8_SP2>(F.lds, g, S, E); } SEAM(1);
    if (IN(2)) { qknorm_rope(F); for (int it = F.vcu; it < 2048; it += F.G) gla_passA(F, it); } SEAM(2);
    if (IN(3)) { for (int it = F.vcu; it < 256; it += F.G) gla_scan(F, it); for (int it = F.vcu; it < 4608; it += F.G) attn_item(F, it); } SEAM(3);
    if (IN(4)) { for (int it = F.vcu; it < 2048; it += F.G) gla_passC(F, it); dil_combine(F); } SEAM(4);
    if (IN(5)) { pg8::Gemm g{F.mixed, F.WoT, T, DM, DM}; pg8::StaticOrder S; S.init(T, DM, F.G, (int)blockIdx.x); pg8::EpiResid E{F.x, F.out, F.x1b, F.ssp, DM};
        pg8::gemm_phase<pg8::EpiResid, pg8::StaticOrder, PG8_ALIGN, PG8_SP2>(F.lds, g, S, E); } SEAM(5);
    if (IN(6)) { pg8::Gemm g{F.x1b, F.WqT, T, DM, DM}; pg8::StaticOrder S; S.init(T, DM, F.G, (int)blockIdx.x); pg8::EpiRowScaleBf16 E{F.qry, DM, nullptr};
        pg8::gemm_phase<pg8::EpiRowScaleBf16, pg8::StaticOrder, PG8_ALIGN, PG8_SP2>(F.lds, g, S, E); } SEAM(6);
    if (IN(7)) { const int gw = F.vcu * 8 + F.wave, NGW = F.G * 8; for (int it = gw; it < (T / 32) * 8; it += NGW) topk_item(F, it); } SEAM(7);
    if (IN(8)) { const int gw = F.vcu * 8 + F.wave, NGW = F.G * 8; for (int tok = gw; tok < T; tok += NGW) peer_token(F, (size_t)tok); }
#undef IN
#undef SEAM
}

#ifndef MK_N_LAUNCHES
#define MK_N_LAUNCHES 1
#endif
extern "C" void kernel_launch(void* const* d_in, const int* in_sizes, int n_in, void* d_out, int out_size, void* d_ws, size_t ws_size, hipStream_t stream) {
    static int grid = 0;
    if (grid == 0) {
        if (n_in != 16 || in_sizes[0] != T * DM || out_size != T * DM || ws_size < WS_END) { fprintf(stderr, "kernel_launch: unexpected shapes (n_in %d, in0 %d, out %d, ws %zu)\n", n_in, n_in > 0 ? in_sizes[0] : -1, out_size, ws_size); grid = -1; return; }
        int dev = 0, cus = 0, per_cu = 0;
        if (hipGetDevice(&dev) != hipSuccess || hipDeviceGetAttribute(&cus, hipDeviceAttributeMultiprocessorCount, dev) != hipSuccess) { grid = -1; return; }
        if (hipFuncSetAttribute((const void*)fwd_kernel, hipFuncAttributeMaxDynamicSharedMemorySize, LDS_BYTES) != hipSuccess) { fprintf(stderr, "kernel_launch: hipFuncSetAttribute failed\n"); grid = -1; return; }
        if (hipOccupancyMaxActiveBlocksPerMultiprocessor(&per_cu, (const void*)fwd_kernel, 512, LDS_BYTES) != hipSuccess || per_cu < 1) { fprintf(stderr, "kernel_launch: occupancy query says %d\n", per_cu); per_cu = 1; }
        (void)hipGetLastError();
        grid = cus;
    }
    if (grid < 0) return;
    Args a{};
    for (int i = 0; i < 16; ++i) a.in[i] = (const float*)d_in[i];
    a.out = (float*)d_out; a.ws = (unsigned char*)d_ws;
    if (MK_N_LAUNCHES == 1) {
        a.ph_lo = 0; a.ph_hi = NPHASE; a.coop = 1; void* kargs[] = {&a};
        hipError_t e = hipLaunchCooperativeKernel((const void*)fwd_kernel, dim3(grid), dim3(512), kargs, LDS_BYTES, stream);
        if (e != hipSuccess) fprintf(stderr, "kernel_launch: cooperative launch failed: %s (grid %d)\n", hipGetErrorString(e), grid);
    } else {
        for (int p = 0; p < NPHASE; ++p) { a.ph_lo = p; a.ph_hi = p + 1; a.coop = 0; hipLaunchKernelGGL(fwd_kernel, dim3(grid), dim3(512), LDS_BYTES, stream, a); }
        const hipError_t le = hipPeekAtLastError(); if (le != hipSuccess) fprintf(stderr, "kernel_launch: launch failed: %s\n", hipGetErrorName(le));
    }
}
```

```cpp
#include <hip/hip_runtime.h>
#include <hip/hip_cooperative_groups.h>
#include <cstdio>
#include <cstdint>
namespace cg = cooperative_groups;
namespace pg8 {
#define PG8_LAS __attribute__((address_space(3)))
typedef unsigned short bf16_t;
typedef short bf16x8 __attribute__((ext_vector_type(8)));
typedef float f32x4 __attribute__((ext_vector_type(4)));
typedef unsigned u32x4 __attribute__((ext_vector_type(4)));
constexpr int BM = 256, BK = 64, HALF = 128, HTB = HALF * BK * 2  , STAGE_BYTES = 8 * HTB, NXCD = 8, WGM = 8;

__host__ __device__ __forceinline__ int lds_byte(int r, int c) { const int st = (r >> 4) * 2 + (c >> 5), rr = r & 15, cc = c & 31, ob = rr * 64 + cc * 2; return st * 1024 + (ob ^ (((ob >> 9) & 1) << 5)); }
__host__ __device__ __forceinline__ void stage_rc(int b, int& R, int& C) { const int st = b / 1024, sb = b % 1024, swz = sb ^ (((sb >> 9) & 1) << 5); R = (st >> 1) * 16 + swz / 64; C = (st & 1) * 32 + (swz % 64) / 2; }
__host__ __device__ __forceinline__ int perm32(int rho) { const int n = rho >> 4, i = rho & 15; return 8 * (i >> 2) + 4 * n + (i & 3); }

struct Unit { int pm, pn; };
struct Gemm { const bf16_t* A; const bf16_t* Bt; int M, N, K; };

struct StaticOrder {
    int nM, nN, nwg, G, c;
    __host__ __device__ void init(int M, int N, int G_, int c_) { nM = M / BM; nN = N / BM; nwg = nM * nN; G = G_; c = c_; }
    __host__ __device__ bool next(int i, Unit& u) const {
        const long L = (long)i * G + c; if (L >= nwg) return false;
        int wgid = (int)L; { const int q = nwg / NXCD, r = nwg % NXCD, xcd = wgid % NXCD, off = wgid / NXCD; wgid = (xcd < r ? xcd * (q + 1) : r * (q + 1) + (xcd - r) * q) + off; }
        const int nig = WGM * nN, gid = wgid / nig, fm = gid * WGM, gsz = (nM - fm) < WGM ? (nM - fm) : WGM;
        u.pm = fm + ((wgid % nig) % gsz); u.pn = (wgid % nig) / gsz; return true;
    }
    __device__ __forceinline__ void a_ready(const Unit&) const {}
    __device__ __forceinline__ void done(const Unit&) const {}
};
__device__ __forceinline__ unsigned cvt_pk_bf16(float lo, float hi) { unsigned r; asm volatile("v_cvt_pk_bf16_f32 %0, %1, %2" : "=v"(r) : "v"(lo), "v"(hi)); return r; }
struct EpiRowScaleBf16 {
    static constexpr bool PERM = true, AFTER_DRAIN = false;
    bf16_t* O; int ldc; const float* rs;
    __device__ __forceinline__ void operator()(const f32x4 (&acc)[2][2][4][2], const Unit& u, int wr, int wc, int fr, int fq) const {
        const int row0 = u.pm * BM + wr * 64 + fr, col0 = u.pn * BM + wc * 32 + 8 * fq;
#pragma unroll
        for (int ai = 0; ai < 2; ++ai)
#pragma unroll
            for (int m = 0; m < 4; ++m) { const int row = row0 + ai * HALF + m * 16; const float s = rs ? rs[row] : 1.f; bf16_t* rowp = O + (size_t)row * ldc + col0;
#pragma unroll
                for (int bj = 0; bj < 2; ++bj) { const f32x4 v0 = acc[ai][bj][m][0] * s, v1 = acc[ai][bj][m][1] * s;
                    u32x4 w; w.x = cvt_pk_bf16(v0[0], v0[1]); w.y = cvt_pk_bf16(v0[2], v0[3]); w.z = cvt_pk_bf16(v1[0], v1[1]); w.w = cvt_pk_bf16(v1[2], v1[3]);
                    *(u32x4*)(rowp + bj * HALF) = w; } }
    }
};
struct EpiResid {
    static constexpr bool PERM = true, AFTER_DRAIN = false;
    const float* x; float* out; bf16_t* xb; float* ssp; int ldc;
    __device__ __forceinline__ void operator()(const f32x4 (&acc)[2][2][4][2], const Unit& u, int wr, int wc, int fr, int fq) const {
        const int row0 = u.pm * BM + wr * 64 + fr, col0 = u.pn * BM + wc * 32 + 8 * fq;
#pragma unroll
        for (int ai = 0; ai < 2; ++ai)
#pragma unroll
            for (int m = 0; m < 4; ++m) { const int row = row0 + ai * HALF + m * 16; const size_t off = (size_t)row * ldc + col0; float ss = 0.f;
#pragma unroll
                for (int bj = 0; bj < 2; ++bj) { const f32x4 xa = *(const f32x4*)(x + off + bj * HALF), xc = *(const f32x4*)(x + off + bj * HALF + 4);
                    const f32x4 v0 = acc[ai][bj][m][0] + xa, v1 = acc[ai][bj][m][1] + xc;
                    *(f32x4*)(out + off + bj * HALF) = v0; *(f32x4*)(out + off + bj * HALF + 4) = v1;
                    u32x4 w; w.x = cvt_pk_bf16(v0[0], v0[1]); w.y = cvt_pk_bf16(v0[2], v0[3]); w.z = cvt_pk_bf16(v1[0], v1[1]); w.w = cvt_pk_bf16(v1[2], v1[3]);
                    *(u32x4*)(xb + off + bj * HALF) = w;
                    ss += (v0[0] * v0[0] + v0[1] * v0[1]) + (v0[2] * v0[2] + v0[3] * v0[3]) + (v1[0] * v1[0] + v1[1] * v1[1]) + (v1[2] * v1[2] + v1[3] * v1[3]); }
                ss += __shfl_xor(ss, 16); ss += __shfl_xor(ss, 32);
                if (fq == 0) ssp[(size_t)row * 32 + u.pn * 4 + wc] = ss; }
    }
};
template <class Epi, class Sched, bool ALIGN_EPI = false, bool SP2 = false>
__device__ __forceinline__ void gemm_phase(PG8_LAS unsigned char* lds, const Gemm g, const Sched& S, const Epi& E) {
    const int tid = threadIdx.x, wid = __builtin_amdgcn_readfirstlane(tid >> 6), lane = tid & 63, wr = wid >> 2, wc = wid & 3, fr = lane & 15, fq = lane >> 4;
    const int K = g.K, nt = K / BK;
    unsigned voffA[2], voffB[2];
#pragma unroll
    for (int i = 0; i < 2; ++i) { int R, C; stage_rc(tid * 16 + i * 8192, R, C); const int Rb = Epi::PERM ? ((R & ~31) + perm32(R & 31)) : R;
        voffA[i] = (unsigned)(R * K + C) * 2u; voffB[i] = (unsigned)(Rb * K + C) * 2u; }
    const size_t kstep = (size_t)(BK * 2);
    const size_t hstep = (size_t)HALF * K * 2;
    const size_t tstep = 2 * hstep;
    const unsigned ldsw = (unsigned)wid * 1024u;
    const int aoff = lds_byte(wr * 64 + fr, fq * 8), boff = lds_byte(wc * 32 + fr, fq * 8);
#define PG8_SA(b, h) (((b) * 2 + (h)) * HTB)
#define PG8_SB(b, h) ((4 + (b) * 2 + (h)) * HTB)
#define PG8_STAGE(bufoff, gbase, voff) do { _Pragma("unroll") for (int _i = 0; _i < 2; ++_i) \
        __builtin_amdgcn_global_load_lds((const unsigned*)((const char*)(gbase) + (voff)[_i]), (PG8_LAS unsigned*)(lds + (bufoff) + ldsw + _i * 8192), 16, 0, 0); } while (0)
#define PG8_LDA(dst, b, h) do { _Pragma("unroll") for (int m = 0; m < 4; ++m) _Pragma("unroll") for (int k = 0; k < 2; ++k) dst[m][k] = *(const PG8_LAS bf16x8*)(lds + PG8_SA(b, h) + aoff + m * 2048 + k * 1024); } while (0)
#define PG8_LDB(dst, b, h) do { _Pragma("unroll") for (int n = 0; n < 2; ++n) _Pragma("unroll") for (int k = 0; k < 2; ++k) dst[n][k] = *(const PG8_LAS bf16x8*)(lds + PG8_SB(b, h) + boff + n * 2048 + k * 1024); } while (0)
#define PG8_MMA(ai, bj, At, Bt) do { __builtin_amdgcn_s_setprio(1); _Pragma("unroll") for (int m = 0; m < 4; ++m) _Pragma("unroll") for (int n = 0; n < 2; ++n) _Pragma("unroll") for (int k = 0; k < 2; ++k) \
        acc[ai][bj][m][n] = __builtin_amdgcn_mfma_f32_16x16x32_bf16(Bt[n][k], At[m][k], acc[ai][bj][m][n], 0, 0, 0); __builtin_amdgcn_s_setprio(0); } while (0)
#define PG8_WAIT_V(n) asm volatile("s_waitcnt vmcnt(" #n ")" ::: "memory")
#define PG8_WAIT_L(n) asm volatile("s_waitcnt lgkmcnt(" #n ")" ::: "memory")
#define PG8_BAR __builtin_amdgcn_s_barrier()
#define PG8_SCHED __builtin_amdgcn_sched_barrier(0)
    Unit cur, nxt; int ui = 0;
    if (!S.next(0, cur)) return;
    f32x4 acc[2][2][4][2];
#pragma unroll
    for (int a = 0; a < 2; ++a)
#pragma unroll
        for (int b = 0; b < 2; ++b)
#pragma unroll
            for (int m = 0; m < 4; ++m)
#pragma unroll
                for (int n = 0; n < 2; ++n) acc[a][b][m][n] = (f32x4){0.f, 0.f, 0.f, 0.f};
    bf16x8 At[4][2], B0[2][2], B1[2][2];
    const char* cA = (const char*)g.A + (size_t)cur.pm * tstep; const char* cB = (const char*)g.Bt + (size_t)cur.pn * tstep;
    S.a_ready(cur);
    if constexpr (SP2) {
        PG8_STAGE(PG8_SB(0, 0), cB, voffB); PG8_STAGE(PG8_SB(0, 1), cB + hstep, voffB); PG8_STAGE(PG8_SA(0, 0), cA, voffA); PG8_STAGE(PG8_SA(0, 1), cA + hstep, voffA);
        if (wr == 1) PG8_BAR;
        PG8_WAIT_V(2); PG8_BAR;
        PG8_STAGE(PG8_SB(1, 0), cB + kstep, voffB); PG8_STAGE(PG8_SA(1, 0), cA + kstep, voffA); PG8_STAGE(PG8_SB(1, 1), cB + hstep + kstep, voffB);
        PG8_WAIT_V(6); PG8_BAR;
    } else {
        PG8_STAGE(PG8_SB(0, 0), cB, voffB); PG8_STAGE(PG8_SA(0, 0), cA, voffA); PG8_STAGE(PG8_SB(0, 1), cB + hstep, voffB); PG8_STAGE(PG8_SA(0, 1), cA + hstep, voffA);
        if (wr == 1) PG8_BAR;
        PG8_WAIT_V(4); PG8_BAR;
        PG8_STAGE(PG8_SB(1, 0), cB + kstep, voffB); PG8_STAGE(PG8_SA(1, 0), cA + kstep, voffA); PG8_STAGE(PG8_SB(1, 1), cB + hstep + kstep, voffB);
        PG8_WAIT_V(6); PG8_BAR;
    }
    for (;;) {
        const bool has_next = S.next(ui + 1, nxt);
        const char* nA = has_next ? (const char*)g.A + (size_t)nxt.pm * tstep : cA; const char* nB = has_next ? (const char*)g.Bt + (size_t)nxt.pn * tstep : cB;
        for (int t = 0; t < nt; t += 2) {
            const bool last = (t == nt - 2);
            const char* a1 = cA + (size_t)(t + 1) * kstep;
            const char* a2 = last ? nA : cA + (size_t)(t + 2) * kstep; const char* b2 = last ? nB : cB + (size_t)(t + 2) * kstep;
            const char* a3 = a2 + kstep; const char* b3 = b2 + kstep;
            if (last && has_next) S.a_ready(nxt);
            if constexpr (SP2) {
            PG8_LDB(B0, 0, 0); PG8_LDB(B1, 0, 1); PG8_SCHED; PG8_LDA(At, 0, 0); PG8_STAGE(PG8_SA(1, 1), a1 + hstep, voffA);
            PG8_WAIT_V(8); PG8_WAIT_L(0); PG8_BAR; PG8_MMA(0, 0, At, B0); PG8_MMA(0, 1, At, B1); PG8_BAR; PG8_SCHED;
            PG8_LDA(At, 0, 1); PG8_STAGE(PG8_SB(0, 0), b2, voffB); PG8_STAGE(PG8_SB(0, 1), b2 + hstep, voffB); PG8_STAGE(PG8_SA(0, 0), a2, voffA);
            PG8_WAIT_V(8); PG8_WAIT_L(0); PG8_BAR; PG8_MMA(1, 0, At, B0); PG8_MMA(1, 1, At, B1); PG8_BAR; PG8_SCHED;
            PG8_LDB(B0, 1, 0); PG8_LDB(B1, 1, 1); PG8_SCHED; PG8_LDA(At, 1, 0); PG8_STAGE(PG8_SA(0, 1), a2 + hstep, voffA);
            PG8_WAIT_V(8); PG8_WAIT_L(0); PG8_BAR; PG8_MMA(0, 0, At, B0); PG8_MMA(0, 1, At, B1); PG8_BAR; PG8_SCHED;
            PG8_LDA(At, 1, 1); PG8_STAGE(PG8_SB(1, 0), b3, voffB); PG8_STAGE(PG8_SB(1, 1), b3 + hstep, voffB); PG8_STAGE(PG8_SA(1, 0), a3, voffA);
            PG8_WAIT_V(8); PG8_WAIT_L(0); PG8_BAR; PG8_MMA(1, 0, At, B0); PG8_MMA(1, 1, At, B1); PG8_BAR; PG8_SCHED;
            } else {
            PG8_LDB(B0, 0, 0); PG8_SCHED; PG8_LDA(At, 0, 0); PG8_STAGE(PG8_SA(1, 1), a1 + hstep, voffA);
            PG8_WAIT_L(8); PG8_BAR; PG8_WAIT_L(0); PG8_MMA(0, 0, At, B0); PG8_BAR; PG8_SCHED;
            PG8_LDB(B1, 0, 1); PG8_STAGE(PG8_SB(0, 0), b2, voffB);
            PG8_BAR; PG8_WAIT_L(0); PG8_MMA(0, 1, At, B1); PG8_BAR;
            PG8_LDA(At, 0, 1); PG8_STAGE(PG8_SA(0, 0), a2, voffA);
            PG8_BAR; PG8_WAIT_L(0); PG8_MMA(1, 0, At, B0); PG8_BAR; PG8_SCHED;
            PG8_STAGE(PG8_SB(0, 1), b2 + hstep, voffB);
            PG8_WAIT_V(6); PG8_BAR; PG8_MMA(1, 1, At, B1); PG8_BAR;
            PG8_LDB(B0, 1, 0); PG8_SCHED; PG8_LDA(At, 1, 0); PG8_STAGE(PG8_SA(0, 1), a2 + hstep, voffA);
            PG8_WAIT_L(8); PG8_BAR; PG8_WAIT_L(0); PG8_MMA(0, 0, At, B0); PG8_BAR; PG8_SCHED;
            PG8_LDB(B1, 1, 1); PG8_STAGE(PG8_SB(1, 0), b3, voffB);
            PG8_BAR; PG8_WAIT_L(0); PG8_MMA(0, 1, At, B1); PG8_BAR;
            PG8_LDA(At, 1, 1); PG8_STAGE(PG8_SA(1, 0), a3, voffA);
            PG8_BAR; PG8_WAIT_L(0); PG8_MMA(1, 0, At, B0); PG8_BAR; PG8_SCHED;
            PG8_STAGE(PG8_SB(1, 1), b3 + hstep, voffB);
            PG8_WAIT_V(6); PG8_BAR; PG8_MMA(1, 1, At, B1); PG8_BAR;
            }
        }
        if constexpr (ALIGN_EPI) { if (wr == 0) PG8_BAR; }
        if constexpr (!Epi::AFTER_DRAIN) { E(acc, cur, wr, wc, fr, fq); S.done(cur); }
        if (!has_next) break;
#pragma unroll
        for (int a = 0; a < 2; ++a)
#pragma unroll
            for (int b = 0; b < 2; ++b)
#pragma unroll
                for (int m = 0; m < 4; ++m)
#pragma unroll
                    for (int n = 0; n < 2; ++n) acc[a][b][m][n] = (f32x4){0.f, 0.f, 0.f, 0.f};
        cur = nxt; cA = nA; cB = nB; ++ui;
        if constexpr (ALIGN_EPI) { if (wr == 1) PG8_BAR; }
    }
    PG8_WAIT_V(0);
    if constexpr (!ALIGN_EPI) { if (wr == 0) PG8_BAR; }
    PG8_BAR;
    if constexpr (Epi::AFTER_DRAIN) { E.fused(acc, cur, wr, wc, fr, fq, lds, wid, lane); S.done(cur); }
#undef PG8_SA
#undef PG8_SB
#undef PG8_STAGE
#undef PG8_LDA
#undef PG8_LDB
#undef PG8_MMA
#undef PG8_WAIT_V
#undef PG8_WAIT_L
#undef PG8_BAR
#undef PG8_SCHED
}
}
#ifndef PG8_SP2
#define PG8_SP2 true
#endif
#ifndef PG8_ALIGN
#define PG8_ALIGN true
#endif

constexpr int BATCH = 2, SEQ = 16384, DM = 2048, T = BATCH * SEQ;
constexpr int INW = 6176, HP = 6400;
constexpr int C_QA = 0, C_KA = 256, C_VA = 512, C_RA = 1024, C_QD = 1536, C_KD = 3072, C_VD = 4608, C_GF = 6144;
constexpr int NHD = 12;
constexpr float EPS = 1e-6f;
constexpr float LOG2E = 1.4426950408889634f;
constexpr float QSCALE = 0.08838834764831845f * LOG2E;
constexpr int NPHASE = 11;

constexpr size_t MiB = 1u << 20;
constexpr size_t WS_CTL = 0, WS_ROPE = 1 * MiB, WS_RS1 = 3 * MiB, WS_RS2 = 3 * MiB + 512 * 1024, WS_SSP = 4 * MiB, WS_WIN = 8 * MiB, WS_WO = 33 * MiB, WS_WQ = 41 * MiB,
                 WS_SK = 49 * MiB, WS_DEC = 50 * MiB, WS_LP = 51 * MiB, WS_IDX = 56 * MiB, WS_GATE = 72 * MiB, WS_DOWN = 88 * MiB, WS_UP = 152 * MiB, WS_XB = 216 * MiB,
                 WS_H = 344 * MiB, WS_X1B = WS_H, WS_QRY = WS_H + 128 * MiB, WS_OP1 = 744 * MiB, WS_OP2 = 840 * MiB, WS_PART = 472 * MiB  , WS_END = 984 * MiB;
constexpr size_t OUT_ST = 0, OUT_OP0 = 128 * MiB;
constexpr int LDS_BYTES = 147456;

#define LAS __attribute__((address_space(3)))
typedef unsigned short bf16_t;
typedef short bf16x8 __attribute__((ext_vector_type(8)));
typedef short s16x4 __attribute__((ext_vector_type(4)));
typedef float f32x4 __attribute__((ext_vector_type(4)));
typedef float f32x2 __attribute__((ext_vector_type(2)));
typedef float f32x16 __attribute__((ext_vector_type(16)));
typedef unsigned u32x4 __attribute__((ext_vector_type(4)));
typedef unsigned u32x2 __attribute__((ext_vector_type(2)));
#define LDS_WAIT() asm volatile("s_waitcnt lgkmcnt(0)" ::: "memory")
#define SBAR() __builtin_amdgcn_sched_barrier(0)

__device__ __forceinline__ float bf2f(unsigned short b) { return __uint_as_float(((unsigned)b) << 16); }
__device__ __forceinline__ float bflo(unsigned w) { return __uint_as_float(w << 16); }
__device__ __forceinline__ float bfhi(unsigned w) { return __uint_as_float(w & 0xffff0000u); }
__device__ __forceinline__ unsigned f2bf(float f) { unsigned u = __float_as_uint(f); return (u + 0x7fffu + ((u >> 16) & 1u)) >> 16; }
__device__ __forceinline__ unsigned pk2(float lo, float hi) { return pg8::cvt_pk_bf16(lo, hi); }
__device__ __forceinline__ float fexp(float x) { return __builtin_amdgcn_exp2f(x * LOG2E); }
__device__ __forceinline__ float flog(float x) { return __builtin_amdgcn_logf(x) * 0.6931471805599453f; }
__device__ __forceinline__ float wave_sum(float v) {
#pragma unroll
    for (int o = 1; o < 64; o <<= 1) v += __shfl_xor(v, o);
    return v;
}
__device__ __forceinline__ int crow(int r, int hi) { return (r & 3) + 8 * (r >> 2) + 4 * hi; }

struct Frame {
    LAS unsigned char* lds; char* ldsg; unsigned char* wsb;
    int tid, lane, wave, vcu, G;
    const float *x, *norm1_g, *w_in, *up_f, *bias_f, *up_b, *bias_b, *out_g, *qn_g, *kn_g, *w_out, *norm2_g, *w_query, *sub_keys, *peer_down, *peer_up;
    float* out;
    f32x2* rope; float *rs1, *rs2, *ssp, *dec, *lp, *gate, *state, *part; int* idx;
    bf16_t *WinT, *WoT, *WqT, *SK, *down16, *up16, *xb, *mixed, *h, *x1b, *qry, *op0, *op1, *op2;
};

__device__ __forceinline__ void p0_transpose_item(const float* W, int K, int N, bf16_t* WT, int k0, int n0, int dst_row0, const float* g, LAS float* scr, int lane) {
#pragma unroll 8
    for (int i = 0; i < 32; ++i) { const int kk = 2 * i + (lane >> 5); float w = W[(size_t)(k0 + kk) * N + n0 + (lane & 31)]; if (g) w *= g[k0 + kk]; scr[kk * 33 + (lane & 31)] = w; }
    LDS_WAIT(); asm volatile("" ::: "memory");
    const int c = lane & 7;
#pragma unroll
    for (int j = 0; j < 4; ++j) { const int n = (lane >> 3) + 8 * j; const LAS float* s = scr + (8 * c) * 33 + n;
        u32x4 o; o.x = pk2(s[0 * 33], s[1 * 33]); o.y = pk2(s[2 * 33], s[3 * 33]); o.z = pk2(s[4 * 33], s[5 * 33]); o.w = pk2(s[6 * 33], s[7 * 33]);
        *(u32x4*)(WT + (size_t)(dst_row0 + n) * K + k0 + 8 * c) = o; }
    LDS_WAIT(); asm volatile("" ::: "memory");
}
__device__ __forceinline__ void phase0(const Frame& F) {
    LAS float* scr = (LAS float*)(F.lds + F.wave * 16384);
    const int gw = F.vcu * 8 + F.wave, NGW = F.G * 8, lane = F.lane;
    if (F.vcu == 0) { unsigned* ctl = (unsigned*)(F.wsb + WS_CTL); for (int i = F.tid; i < 4096; i += 512) ctl[i] = 0u; }
    constexpr int I_IN = 32 * 193, I_O = 32 * 64, I_Q = 32 * 64;
    for (int it = gw; it < I_IN + I_O + I_Q; it += NGW) {
        int r = it;
        if (r < I_IN) { const int kb = r / 193, nb = r % 193; const int drow = nb < 32 ? nb * 32 : (nb == 32 ? C_GF : nb * 32 - 32);
            p0_transpose_item(F.w_in, DM, INW, F.WinT, kb * 64, nb * 32, drow, F.norm1_g, scr, lane); continue; }
        r -= I_IN;
        if (r < I_O) { const int kb = r / 64, nb = r % 64; p0_transpose_item(F.w_out, DM, DM, F.WoT, kb * 64, nb * 32, nb * 32, nullptr, scr, lane); continue; }
        r -= I_O;
        { const int kb = r / 64, nb = r % 64; p0_transpose_item(F.w_query, DM, DM, F.WqT, kb * 64, nb * 32, nb * 32, F.norm2_g, scr, lane); }
    }
    const size_t gt = (size_t)gw * 64 + lane, NT = (size_t)NGW * 64;
    { u32x4* z = (u32x4*)(F.WinT + (size_t)INW * DM); const u32x4 zero = {0u, 0u, 0u, 0u}; for (size_t i = gt; i < (size_t)(HP - INW) * DM / 8; i += NT) z[i] = zero; }
    for (size_t i = gt; i < (size_t)16384 * DM / 8; i += NT) { const int d = (int)((i * 8) & (DM - 1));
        const f32x4 a = *(const f32x4*)(F.peer_down + i * 8), b = *(const f32x4*)(F.peer_down + i * 8 + 4), ga = *(const f32x4*)(F.norm2_g + d), gb = *(const f32x4*)(F.norm2_g + d + 4);
        u32x4 o; o.x = pk2(a[0] * ga[0], a[1] * ga[1]); o.y = pk2(a[2] * ga[2], a[3] * ga[3]); o.z = pk2(b[0] * gb[0], b[1] * gb[1]); o.w = pk2(b[2] * gb[2], b[3] * gb[3]);
        *(u32x4*)(F.down16 + i * 8) = o; }
    for (size_t i = gt; i < (size_t)16384 * DM / 8; i += NT) { const f32x4 a = *(const f32x4*)(F.peer_up + i * 8), b = *(const f32x4*)(F.peer_up + i * 8 + 4);
        u32x4 o; o.x = pk2(a[0], a[1]); o.y = pk2(a[2], a[3]); o.z = pk2(b[0], b[1]); o.w = pk2(b[2], b[3]); *(u32x4*)(F.up16 + i * 8) = o; }
    for (size_t i = gt; i < (size_t)8 * 2 * 128 * 128 / 8; i += NT) { const f32x4 a = *(const f32x4*)(F.sub_keys + i * 8), b = *(const f32x4*)(F.sub_keys + i * 8 + 4);
        u32x4 o; o.x = pk2(a[0], a[1]); o.y = pk2(a[2], a[3]); o.z = pk2(b[0], b[1]); o.w = pk2(b[2], b[3]); *(u32x4*)(F.SK + i * 8) = o; }
    for (int m = gw; m < T; m += NGW) { const f32x4* xr = (const f32x4*)(F.x + (size_t)m * DM) + lane; f32x4 v[8]; float s = 0.f;
#pragma unroll
        for (int j = 0; j < 8; ++j) { v[j] = xr[64 * j]; s += (v[j][0] * v[j][0] + v[j][1] * v[j][1]) + (v[j][2] * v[j][2] + v[j][3] * v[j][3]); }
        s = wave_sum(s); u32x2* o8 = (u32x2*)(F.xb + (size_t)m * DM) + lane;
#pragma unroll
        for (int j = 0; j < 8; ++j) { u32x2 w; w.x = pk2(v[j][0], v[j][1]); w.y = pk2(v[j][2], v[j][3]); o8[64 * j] = w; }
        if (lane == 0) F.rs1[m] = __builtin_amdgcn_rsqf(s * (1.f / DM) + EPS); }
    { const double invf[16] = {1.0, 0.44036660267178046, 0.19392274474868576, 0.08539710028576561, 0.03760603093086393, 0.016560440080994446, 0.007292664737217109, 0.003211445994752591,
                               0.001414213562373095, 0.000622772421914596, 0.0002742481756762073, 0.00012076973741146504, 5.318295896944988e-05, 2.341999896140934e-05, 1.031338537721246e-05, 4.5416704806078695e-06};
      for (size_t i = gt; i < (size_t)SEQ * 16; i += NT) { const int pos = (int)(i >> 4), j = (int)(i & 15); double f = 1.0;
#pragma unroll
          for (int q = 0; q < 16; ++q) f = (j == q) ? invf[q] : f;
          const double rev = (double)pos * f * 0.15915494309189535; const float fr = (float)(rev - floor(rev));
          F.rope[i] = (f32x2){__builtin_amdgcn_cosf(fr), __builtin_amdgcn_sinf(fr)}; } }
}

__device__ __forceinline__ void qknorm_rope(const Frame& F) {
    const int gw = F.vcu * 8 + F.wave, NGW = F.G * 8, lane = F.lane, c = lane & 15;
    for (long it = gw; it < (long)T * 24 / 4; it += NGW) { const long row = it * 4 + (lane >> 4); const int t = (int)(row / 24), slot = (int)(row % 24);
        bf16_t* p = F.h + (size_t)t * HP + C_QD + slot * 128 + 8 * c;
        const u32x4 w = *(const u32x4*)p; float y[8] = {bflo(w.x), bfhi(w.x), bflo(w.y), bfhi(w.y), bflo(w.z), bfhi(w.z), bflo(w.w), bfhi(w.w)};
        float ss = 0.f;
#pragma unroll
        for (int e = 0; e < 8; ++e) ss += y[e] * y[e];
        ss += __shfl_xor(ss, 1); ss += __shfl_xor(ss, 2); ss += __shfl_xor(ss, 4); ss += __shfl_xor(ss, 8);
        const float rq = __builtin_amdgcn_rsqf(ss * (1.f / 128.f) + EPS); const float* g = (slot < 12 ? F.qn_g : F.kn_g) + 8 * c;
        const f32x4 g0 = *(const f32x4*)g, g1 = *(const f32x4*)(g + 4);
#pragma unroll
        for (int e = 0; e < 4; ++e) { y[e] *= rq * g0[e]; y[4 + e] *= rq * g1[e]; }
        const int pos = t & (SEQ - 1);
#pragma unroll
        for (int e = 0; e < 8; ++e) { const float partner = __shfl_xor(y[e], 2);
            if (c < 4) { const f32x2 cs = F.rope[(size_t)pos * 16 + 8 * (c & 1) + e]; y[e] = (c < 2) ? (y[e] * cs.x - partner * cs.y) : (y[e] * cs.x + partner * cs.y); } }
        if (slot < 12) {
#pragma unroll
            for (int e = 0; e < 8; ++e) y[e] *= QSCALE; }
        u32x4 o; o.x = pk2(y[0], y[1]); o.y = pk2(y[2], y[3]); o.z = pk2(y[4], y[5]); o.w = pk2(y[6], y[7]); *(u32x4*)p = o; }
}

constexpr int GL_GDS = 0, GL_TOT = 8192, GL_QF = 12288, GL_QB = 21504, GL_KF = 30720, GL_KB = 39936, GL_VT = 49152, GL_P = 67584, GL_SF = 76800, GL_SB = 95232, GL_OB = 12288;
constexpr int RS72 = 144;
__device__ __forceinline__ float logsig(float z) { return fminf(z, 0.f) - flog(1.f + fexp(-fabsf(z))); }
__device__ __forceinline__ void gla_gates(const Frame& F, int b, int hh, int n, float (&bf)[8], float (&bb)[8], float& totf, float& totb) {
    const int tid = F.tid, c = tid & 63, ig = F.wave; LAS float* gds = (LAS float*)(F.lds + GL_GDS); LAS float* tot = (LAS float*)(F.lds + GL_TOT);
    const size_t t0 = (size_t)b * SEQ + (size_t)n * 64;
    if (tid < 256) { const int tk = tid >> 2, part = tid & 3; const u32x4 w = *(const u32x4*)(F.h + (t0 + tk) * HP + C_GF + part * 8); LAS float* d = gds + tk * 32 + part * 8;
        d[0] = bflo(w.x); d[1] = bfhi(w.x); d[2] = bflo(w.y); d[3] = bfhi(w.y); d[4] = bflo(w.z); d[5] = bfhi(w.z); d[6] = bflo(w.w); d[7] = bfhi(w.w); }
    __syncthreads();
    const int hc = hh * 64 + c; float upf[16], upb[16];
#pragma unroll
    for (int r = 0; r < 16; ++r) { upf[r] = F.up_f[r * 256 + hc]; upb[r] = F.up_b[r * 256 + hc]; }
    const float biasf = F.bias_f[hc], biasb = F.bias_b[hc]; float laf[8], lab[8];
#pragma unroll
    for (int e = 0; e < 8; ++e) { const LAS float* gr = gds + (ig * 8 + e) * 32; float zf = biasf, zb = biasb;
#pragma unroll
        for (int r = 0; r < 16; ++r) { zf += gr[r] * upf[r]; zb += gr[16 + r] * upb[r]; }
        laf[e] = logsig(zf) * 0.0625f; lab[e] = logsig(zb) * 0.0625f; }
    bf[0] = laf[0];
#pragma unroll
    for (int e = 1; e < 8; ++e) bf[e] = bf[e - 1] + laf[e];
    bb[7] = lab[7];
#pragma unroll
    for (int e = 6; e >= 0; --e) bb[e] = bb[e + 1] + lab[e];
    tot[ig * 64 + c] = bf[7]; tot[512 + ig * 64 + c] = bb[0];
    __syncthreads();
    float offf = 0.f, offb = 0.f; totf = 0.f; totb = 0.f;
#pragma unroll
    for (int g = 0; g < 8; ++g) { const float tf = tot[g * 64 + c], tb = tot[512 + g * 64 + c]; totf += tf; totb += tb; offf += (g < ig) ? tf : 0.f; offb += (g > ig) ? tb : 0.f; }
#pragma unroll
    for (int e = 0; e < 8; ++e) { bf[e] += offf; bb[e] += offb; }
}
__device__ __forceinline__ void gla_stage_vT(const Frame& F, size_t t0, int hh) {
#pragma unroll
    for (int j = 0; j < 2; ++j) { const int q = F.tid + 512 * j, tk = q >> 4, vc = (q & 15) * 8; const bf16x8 v = *(const bf16x8*)(F.h + (t0 + tk) * HP + C_VA + hh * 128 + vc);
        LAS short* d = (LAS short*)(F.lds + GL_VT) + vc * 72 + tk;
#pragma unroll
        for (int e = 0; e < 8; ++e) d[e * 72] = v[e]; }
}
__device__ __forceinline__ bf16x8 ldfrag(const LAS unsigned char* base, int row, int s, int hi) { return *(const LAS bf16x8*)(base + row * RS72 + (16 * s + 8 * hi) * 2); }

__device__ __forceinline__ void gla_passA(const Frame& F, int item) {
    const int bh = item >> 8, n = item & 255, b = bh >> 2, hh = bh & 3, tid = F.tid, c = tid & 63, ig = F.wave, lane = F.lane, r32 = lane & 31, hi = lane >> 5;
    float bf[8], bb[8], totf, totb; gla_gates(F, b, hh, n, bf, bb, totf, totb);
    const size_t t0 = (size_t)b * SEQ + (size_t)n * 64;
    float kf[8], kb[8];
#pragma unroll
    for (int e = 0; e < 8; ++e) { const float k = bf2f(F.h[(t0 + ig * 8 + e) * HP + C_KA + hh * 64 + c]); kf[e] = k * fexp(totf - bf[e]); kb[e] = k * fexp(totb - bb[e]); }
    { u32x4 o; o.x = pk2(kf[0], kf[1]); o.y = pk2(kf[2], kf[3]); o.z = pk2(kf[4], kf[5]); o.w = pk2(kf[6], kf[7]); *(LAS u32x4*)(F.lds + GL_KF + c * RS72 + ig * 16) = o;
      o.x = pk2(kb[0], kb[1]); o.y = pk2(kb[2], kb[3]); o.z = pk2(kb[4], kb[5]); o.w = pk2(kb[6], kb[7]); *(LAS u32x4*)(F.lds + GL_KB + c * RS72 + ig * 16) = o; }
    gla_stage_vT(F, t0, hh);
    if (ig == 0) { F.dec[((size_t)(0 * 8 + bh) * 256 + n) * 64 + c] = fexp(totf); F.dec[((size_t)(1 * 8 + bh) * 256 + n) * 64 + c] = fexp(totb); }
    __syncthreads();
    const int dir = F.wave >> 2, vt = F.wave & 3; const LAS unsigned char* kimg = F.lds + (dir ? GL_KB : GL_KF);
    f32x16 a0 = {}, a1 = {};
#pragma unroll
    for (int s = 0; s < 4; ++s) { const bf16x8 av = ldfrag(F.lds + GL_VT, 32 * vt + r32, s, hi), b0 = ldfrag(kimg, r32, s, hi), b1 = ldfrag(kimg, 32 + r32, s, hi);
        a0 = __builtin_amdgcn_mfma_f32_32x32x16_bf16(av, b0, a0, 0, 0, 0); a1 = __builtin_amdgcn_mfma_f32_32x32x16_bf16(av, b1, a1, 0, 0, 0); }
    float* st = F.state + ((size_t)(dir * 8 + bh) * 256 + n) * 8192;
#pragma unroll
    for (int r = 0; r < 16; ++r) { const int v = 32 * vt + crow(r, hi); st[v * 64 + r32] = a0[r]; st[v * 64 + 32 + r32] = a1[r]; }
    __syncthreads();
}
__device__ __forceinline__ void gla_scan(const Frame& F, int item) {
    const int dir = item >> 7, bh = (item >> 4) & 7, e = (item & 15) * 512 + F.tid, c = e & 63;
    float* st = F.state + (size_t)(dir * 8 + bh) * 256 * 8192 + e; const float* dc = F.dec + (size_t)(dir * 8 + bh) * 256 * 64 + c; float S = 0.f;
    for (int g = 0; g < 32; ++g) { float inc[8], d[8];
#pragma unroll
        for (int j = 0; j < 8; ++j) { const int n = dir ? 255 - (g * 8 + j) : g * 8 + j; inc[j] = st[(size_t)n * 8192]; d[j] = dc[n * 64]; }
#pragma unroll
        for (int j = 0; j < 8; ++j) { const int n = dir ? 255 - (g * 8 + j) : g * 8 + j; st[(size_t)n * 8192] = S; S = d[j] * S + inc[j]; } }
}
__device__ __forceinline__ void gla_passC(const Frame& F, int item) {
    const int bh = item >> 8, n = item & 255, b = bh >> 2, hh = bh & 3, tid = F.tid, c = tid & 63, ig = F.wave, lane = F.lane, r32 = lane & 31, hi = lane >> 5;
    float bf[8], bb[8], totf, totb; gla_gates(F, b, hh, n, bf, bb, totf, totb);
    const size_t t0 = (size_t)b * SEQ + (size_t)n * 64;
#pragma unroll
    for (int e = 0; e < 8; ++e) { const int i = ig * 8 + e; const bf16_t* hr = F.h + (t0 + i) * HP + hh * 64 + c; const float q = bf2f(hr[C_QA]) * 0.125f, k = bf2f(hr[C_KA]);
        const float ef = fexp(bf[e]), eb = fexp(bb[e]), nf = fexp(-bf[e]), nb = fexp(-bb[e]);
        *(LAS unsigned short*)(F.lds + GL_QF + i * RS72 + c * 2) = (unsigned short)f2bf(q * ef); *(LAS unsigned short*)(F.lds + GL_QB + i * RS72 + c * 2) = (unsigned short)f2bf(q * eb);
        *(LAS unsigned short*)(F.lds + GL_KF + i * RS72 + c * 2) = (unsigned short)f2bf(k * nf); *(LAS unsigned short*)(F.lds + GL_KB + i * RS72 + c * 2) = (unsigned short)f2bf(k * nb); }
    gla_stage_vT(F, t0, hh);
#pragma unroll
    for (int dir = 0; dir < 2; ++dir) { const float* st = F.state + ((size_t)(dir * 8 + bh) * 256 + n) * 8192; LAS unsigned char* img = F.lds + (dir ? GL_SB : GL_SF);
#pragma unroll
        for (int j = 0; j < 4; ++j) { const int q4 = tid + 512 * j, v = q4 >> 4, c4 = (q4 & 15) * 4; const f32x4 s = *(const f32x4*)(st + v * 64 + c4);
            u32x2 w; w.x = pk2(s[0], s[1]); w.y = pk2(s[2], s[3]); *(LAS u32x2*)(img + v * RS72 + c4 * 2) = w; } }
    __syncthreads();
    if (F.wave < 4) { const int ti = F.wave >> 1, tj = F.wave & 1; f32x16 sf = {}, sb = {};
#pragma unroll
        for (int s = 0; s < 4; ++s) {
            sf = __builtin_amdgcn_mfma_f32_32x32x16_bf16(ldfrag(F.lds + GL_QF, 32 * ti + r32, s, hi), ldfrag(F.lds + GL_KF, 32 * tj + r32, s, hi), sf, 0, 0, 0);
            sb = __builtin_amdgcn_mfma_f32_32x32x16_bf16(ldfrag(F.lds + GL_QB, 32 * ti + r32, s, hi), ldfrag(F.lds + GL_KB, 32 * tj + r32, s, hi), sb, 0, 0, 0); }
#pragma unroll
        for (int r = 0; r < 16; ++r) { const int i = 32 * ti + crow(r, hi), j = 32 * tj + r32; const float p = (j <= i) ? sf[r] : sb[r];
            *(LAS unsigned short*)(F.lds + GL_P + i * RS72 + j * 2) = (unsigned short)f2bf(p); } }
    __syncthreads();
    const int ti = F.wave & 1, tv = F.wave >> 1; f32x16 o = {};
#pragma unroll
    for (int s = 0; s < 4; ++s) o = __builtin_amdgcn_mfma_f32_32x32x16_bf16(ldfrag(F.lds + GL_P, 32 * ti + r32, s, hi), ldfrag(F.lds + GL_VT, 32 * tv + r32, s, hi), o, 0, 0, 0);
#pragma unroll
    for (int s = 0; s < 4; ++s) o = __builtin_amdgcn_mfma_f32_32x32x16_bf16(ldfrag(F.lds + GL_QF, 32 * ti + r32, s, hi), ldfrag(F.lds + GL_SF, 32 * tv + r32, s, hi), o, 0, 0, 0);
#pragma unroll
    for (int s = 0; s < 4; ++s) o = __builtin_amdgcn_mfma_f32_32x32x16_bf16(ldfrag(F.lds + GL_QB, 32 * ti + r32, s, hi), ldfrag(F.lds + GL_SB, 32 * tv + r32, s, hi), o, 0, 0, 0);
    __syncthreads();
    LAS float* ob = (LAS float*)(F.lds + GL_OB);
#pragma unroll
    for (int r = 0; r < 16; ++r) ob[(32 * ti + crow(r, hi)) * 132 + 32 * tv + r32] = o[r];
    __syncthreads();
    { const int i = tid >> 3, part = tid & 7, v0 = part * 16; float ov[16], ss = 0.f;
#pragma unroll
      for (int e = 0; e < 16; ++e) { ov[e] = ob[i * 132 + v0 + e]; ss += ov[e] * ov[e]; }
      ss += __shfl_xor(ss, 1); ss += __shfl_xor(ss, 2); ss += __shfl_xor(ss, 4);
      const float rs = __builtin_amdgcn_rsqf(ss * (1.f / 128.f) + EPS); const size_t tok = t0 + i;
      const u32x4 r0 = *(const u32x4*)(F.h + tok * HP + C_RA + hh * 128 + v0), r1 = *(const u32x4*)(F.h + tok * HP + C_RA + hh * 128 + v0 + 8);
      const float rr[16] = {bflo(r0.x), bfhi(r0.x), bflo(r0.y), bfhi(r0.y), bflo(r0.z), bfhi(r0.z), bflo(r0.w), bfhi(r0.w), bflo(r1.x), bfhi(r1.x), bflo(r1.y), bfhi(r1.y), bflo(r1.z), bfhi(r1.z), bflo(r1.w), bfhi(r1.w)};
      float y[16];
#pragma unroll
      for (int e = 0; e < 16; ++e) { const float g = F.out_g[hh * 128 + v0 + e]; const float sil = rr[e] * __builtin_amdgcn_rcpf(1.f + fexp(-rr[e])); y[e] = ov[e] * rs * g * sil; }
      u32x4 w0, w1; w0.x = pk2(y[0], y[1]); w0.y = pk2(y[2], y[3]); w0.z = pk2(y[4], y[5]); w0.w = pk2(y[6], y[7]); w1.x = pk2(y[8], y[9]); w1.y = pk2(y[10], y[11]); w1.z = pk2(y[12], y[13]); w1.w = pk2(y[14], y[15]);
      bf16_t* mp = F.mixed + tok * DM + hh * 128 + v0; *(u32x4*)mp = w0; *(u32x4*)(mp + 8) = w1; }
    __syncthreads();
}

constexpr int AT_V = 0, AT_K = 32768, AT_O = 65536;
#define KSWZ(row, colB) ((row) * 256 + ((colB) ^ (((row) & 7) << 4)))
__device__ __forceinline__ int v_st(int k, int c) { const int kk = (k & ~0xC) | ((k & 4) << 1) | ((k & 8) >> 1); return ((kk >> 3) * 4 + (c >> 5)) * 512 + ((kk & 7) * 32 + (c & 31)) * 2; }
__device__ __forceinline__ int v_rd_base(int lane) { return ((lane & 3) << 3) | (((lane >> 2) & 3) << 6) | (((lane >> 4) & 1) << 5) | (((lane >> 5) & 1) << 8); }
constexpr int v_rd_off(int d0, int ks, int half) { return d0 * 512 + ks * 4096 + half * 2048; }
template <int OFF> __device__ __forceinline__ s16x4 tr_read(int vb) { s16x4 r; asm volatile("ds_read_b64_tr_b16 %0, %1 offset:%2" : "=&v"(r) : "v"(vb), "i"(OFF) : "memory"); return r; }
template <int D0> __device__ __forceinline__ void pv_one(f32x16& od, int vb, bf16x8 pa0, bf16x8 pa1, bf16x8 pa2, bf16x8 pa3) {
    const s16x4 l0 = tr_read<v_rd_off(D0, 0, 0)>(vb), h0 = tr_read<v_rd_off(D0, 0, 1)>(vb), l1 = tr_read<v_rd_off(D0, 1, 0)>(vb), h1 = tr_read<v_rd_off(D0, 1, 1)>(vb);
    const s16x4 l2 = tr_read<v_rd_off(D0, 2, 0)>(vb), h2 = tr_read<v_rd_off(D0, 2, 1)>(vb), l3 = tr_read<v_rd_off(D0, 3, 0)>(vb), h3 = tr_read<v_rd_off(D0, 3, 1)>(vb);
    asm volatile("s_waitcnt lgkmcnt(0)" ::: "memory"); SBAR();
#define PKV(L, H) (bf16x8){L[0], L[1], L[2], L[3], H[0], H[1], H[2], H[3]}
    od = __builtin_amdgcn_mfma_f32_32x32x16_bf16(pa0, PKV(l0, h0), od, 0, 0, 0);
    od = __builtin_amdgcn_mfma_f32_32x32x16_bf16(pa1, PKV(l1, h1), od, 0, 0, 0);
    od = __builtin_amdgcn_mfma_f32_32x32x16_bf16(pa2, PKV(l2, h2), od, 0, 0, 0);
    od = __builtin_amdgcn_mfma_f32_32x32x16_bf16(pa3, PKV(l3, h3), od, 0, 0, 0);
#undef PKV
}
__device__ __forceinline__ void attn_item(const Frame& F, int item) {
    const int tid = F.tid, wid = F.wave, lane = F.lane, r32 = lane & 31, hi = lane >> 5;
    const int p = item / 1536, rem = item % 1536, b = rem / 768, rem2 = rem % 768, head = rem2 >> 6, u = rem2 & 63;
    const int dsh = 2 * p, dil = 1 << dsh, L = SEQ >> dsh, runs = 64 >> dsh, res = u / runs, m0 = (u % runs) * 256;
    const size_t tokbase = (size_t)b * SEQ + res;
    bf16_t* Op = (bf16_t*)(p == 0 ? (unsigned char*)F.out + OUT_OP0 : F.wsb + (p == 1 ? WS_OP1 : WS_OP2));
    const bf16_t* hq = F.h + C_QD + head * 128; const bf16_t* hk = F.h + C_KD + head * 128; const bf16_t* hv = F.h + C_VD + head * 128;
    const int Q0 = m0 + 32 * wid;
    bf16x8 qr[8];
    { const bf16_t* qp = hq + (tokbase + (size_t)dil * (Q0 + r32)) * HP + hi * 8;
#pragma unroll
      for (int d0 = 0; d0 < 8; ++d0) qr[d0] = *(const bf16x8*)(qp + d0 * 16); }
    const int sr = tid >> 4, sc = (tid & 15) * 8, vst0 = v_st(sr, sc), vst1 = v_st(32 + sr, sc), kc = sc * 2;
    const int vb0 = (int)(unsigned)(uintptr_t)(F.ldsg + AT_V) + v_rd_base(lane);
    const int kt_lo = (m0 == 0) ? 1 : 0, kt_hi = (m0 + 256 >= L) ? 4 : 5;
    f32x16 o[4] = {}; float l_reg = 0.f;
    bf16x8 sv0, sv1, sk0, sk1;
#define AT_SLOAD(T0) do { const size_t ra = (tokbase + (size_t)dil * ((T0) + sr)) * HP + sc, rb = (tokbase + (size_t)dil * ((T0) + 32 + sr)) * HP + sc; \
        sv0 = *(const bf16x8*)(hv + ra); sv1 = *(const bf16x8*)(hv + rb); sk0 = *(const bf16x8*)(hk + ra); sk1 = *(const bf16x8*)(hk + rb); } while (0)
#define AT_SWRITE(B) do { *(LAS bf16x8*)(F.lds + AT_V + (B) * 16384 + vst0) = sv0; *(LAS bf16x8*)(F.lds + AT_V + (B) * 16384 + vst1) = sv1; \
        *(LAS bf16x8*)(F.lds + AT_K + (B) * 16384 + KSWZ(sr, kc)) = sk0; *(LAS bf16x8*)(F.lds + AT_K + (B) * 16384 + KSWZ(32 + sr, kc)) = sk1; } while (0)
    AT_SLOAD(m0 - 64 + 64 * kt_lo); AT_SWRITE(0); __syncthreads();
    int buf = 0;
    for (int kt = kt_lo; kt <= kt_hi; ++kt) {
        const int T0 = m0 - 64 + 64 * kt; const bool more = kt < kt_hi;
        if (more) AT_SLOAD(T0 + 64);
        if (T0 + 63 >= Q0 - 64 && T0 <= Q0 + 95) {
            const LAS unsigned char* Ks = F.lds + AT_K + buf * 16384; f32x16 p0 = {}, p1 = {};
#pragma unroll
            for (int d0 = 0; d0 < 8; ++d0) { const int cb = (d0 * 16 + hi * 8) * 2;
                const bf16x8 k0 = *(const LAS bf16x8*)(Ks + KSWZ(r32, cb)), k1 = *(const LAS bf16x8*)(Ks + KSWZ(32 + r32, cb));
                p0 = __builtin_amdgcn_mfma_f32_32x32x16_bf16(k0, qr[d0], p0, 0, 0, 0); p1 = __builtin_amdgcn_mfma_f32_32x32x16_bf16(k1, qr[d0], p1, 0, 0, 0); }
            const int dq = T0 - (Q0 + r32); float ps = 0.f;
#pragma unroll
            for (int r = 0; r < 16; ++r) { const int e0 = dq + crow(r, hi), e1 = e0 + 32;
                p0[r] = (e0 >= -64 && e0 <= 64) ? __builtin_amdgcn_exp2f(p0[r]) : 0.f; p1[r] = (e1 >= -64 && e1 <= 64) ? __builtin_amdgcn_exp2f(p1[r]) : 0.f; ps += p0[r] + p1[r]; }
            l_reg += ps;
            bf16x8 pa0, pa1, pa2, pa3;
#define PK4(P, BASE, OUT) do { unsigned a0_ = pk2(P[BASE + 0], P[BASE + 1]), a1_ = pk2(P[BASE + 2], P[BASE + 3]); unsigned b0_ = pk2(P[BASE + 4], P[BASE + 5]), b1_ = pk2(P[BASE + 6], P[BASE + 7]); \
        auto r0_ = __builtin_amdgcn_permlane32_swap(a0_, b0_, false, false); auto r1_ = __builtin_amdgcn_permlane32_swap(a1_, b1_, false, false); \
        u32x4 w_ = {r0_[0], r1_[0], r0_[1], r1_[1]}; OUT = __builtin_bit_cast(bf16x8, w_); } while (0)
            PK4(p0, 0, pa0); PK4(p0, 8, pa1); PK4(p1, 0, pa2); PK4(p1, 8, pa3);
#undef PK4
            const int vb = vb0 + buf * 16384;
            pv_one<0>(o[0], vb, pa0, pa1, pa2, pa3); pv_one<1>(o[1], vb, pa0, pa1, pa2, pa3); pv_one<2>(o[2], vb, pa0, pa1, pa2, pa3); pv_one<3>(o[3], vb, pa0, pa1, pa2, pa3);
        }
        if (more) AT_SWRITE(buf ^ 1);
        __syncthreads(); buf ^= 1;
    }
#undef AT_SLOAD
#undef AT_SWRITE
    l_reg += __shfl_xor(l_reg, 32);
    if (hi == 0) F.lp[((size_t)p * T + tokbase + (size_t)dil * (Q0 + r32)) * NHD + head] = l_reg;
    LAS unsigned char* stg = F.lds + AT_O + wid * 8192;
#pragma unroll
    for (int d0 = 0; d0 < 4; ++d0)
#pragma unroll
        for (int r = 0; r < 16; ++r) *(LAS unsigned short*)(stg + (crow(r, hi) * 128 + d0 * 32 + r32) * 2) = (unsigned short)f2bf(o[d0][r]);
    LDS_WAIT(); asm volatile("" ::: "memory");
#pragma unroll
    for (int it = 0; it < 8; ++it) { const int row = 4 * it + (lane >> 4), ch = lane & 15; const u32x4 w = *(const LAS u32x4*)(stg + row * 256 + ch * 16);
        *(u32x4*)(Op + (tokbase + (size_t)dil * (Q0 + row)) * (NHD * 128) + head * 128 + ch * 8) = w; }
    __syncthreads();
}
__device__ __forceinline__ void dil_combine(const Frame& F) {
    const int gw = F.vcu * 8 + F.wave, NGW = F.G * 8, lane = F.lane, c = lane & 15;
    for (long it = gw; it < (long)T * NHD / 4; it += NGW) { const long row = it * 4 + (lane >> 4); const size_t tok = (size_t)(row / NHD); const int head = (int)(row % NHD);
        const float l = F.lp[tok * NHD + head] + F.lp[((size_t)T + tok) * NHD + head] + F.lp[((size_t)2 * T + tok) * NHD + head]; const float inv = 1.f / l;
        const size_t off = tok * (NHD * 128) + head * 128 + 8 * c; const u32x4 a = *(const u32x4*)(F.op0 + off), b = *(const u32x4*)(F.op1 + off), d = *(const u32x4*)(F.op2 + off);
        u32x4 o; o.x = pk2((bflo(a.x) + bflo(b.x) + bflo(d.x)) * inv, (bfhi(a.x) + bfhi(b.x) + bfhi(d.x)) * inv); o.y = pk2((bflo(a.y) + bflo(b.y) + bflo(d.y)) * inv, (bfhi(a.y) + bfhi(b.y) + bfhi(d.y)) * inv);
        o.z = pk2((bflo(a.z) + bflo(b.z) + bflo(d.z)) * inv, (bfhi(a.z) + bfhi(b.z) + bfhi(d.z)) * inv); o.w = pk2((bflo(a.w) + bflo(b.w) + bflo(d.w)) * inv, (bfhi(a.w) + bfhi(b.w) + bfhi(d.w)) * inv);
        *(u32x4*)(F.mixed + tok * DM + 512 + head * 128 + 8 * c) = o; }
}

__device__ __forceinline__ unsigned fl_flip(float x) { const unsigned u = __float_as_uint(x); return u ^ ((unsigned)((int)u >> 31) | 0x80000000u); }
__device__ __forceinline__ float fl_unflip(unsigned w) { return __uint_as_float((w & 0x80000000u) ? (w ^ 0x80000000u) : ~w); }
#define CE_DESC(a, b) do { const unsigned x_ = max(a, b), y_ = min(a, b); a = x_; b = y_; } while (0)
__device__ __forceinline__ void sort16_desc(unsigned (&a)[16]) {
#pragma unroll
    for (int k = 2; k <= 16; k <<= 1)
#pragma unroll
        for (int j = k >> 1; j > 0; j >>= 1)
#pragma unroll
            for (int i = 0; i < 16; ++i) { const int l = i ^ j; if (l > i) { const unsigned x = max(a[i], a[l]), y = min(a[i], a[l]); if ((i & k) == 0) { a[i] = x; a[l] = y; } else { a[i] = y; a[l] = x; } } }
}
__device__ __forceinline__ void bmerge16_desc(unsigned (&a)[16]) {
#pragma unroll
    for (int j = 8; j > 0; j >>= 1)
#pragma unroll
        for (int i = 0; i < 16; ++i) { const int l = i ^ j; if (l > i) CE_DESC(a[i], a[l]); }
}
__device__ __forceinline__ void top16_merge(unsigned (&a)[16], const unsigned (&b)[16]) {
#pragma unroll
    for (int i = 0; i < 16; ++i) a[i] = max(a[i], b[15 - i]);
    bmerge16_desc(a);
}
__device__ __forceinline__ void top16_partner(unsigned (&a)[16]) {
    unsigned b[16];
#pragma unroll
    for (int i = 0; i < 16; ++i) b[i] = (unsigned)__shfl_xor((int)a[i], 32);
    top16_merge(a, b);
}
__device__ constexpr unsigned char stair(int n) {
    constexpr unsigned char L[64] = {0x00,0x01,0x02,0x03,0x04,0x05,0x06,0x07,0x08,0x09,0x0a,0x0b,0x0c,0x0d,0x0e,0x0f,0x10,0x11,0x12,0x13,0x14,0x15,0x16,0x17,0x20,0x21,0x22,0x23,0x24,0x30,0x31,0x32,
                                     0x33,0x40,0x41,0x42,0x50,0x51,0x60,0x61,0x70,0x71,0x80,0x90,0xa0,0xb0,0xc0,0xd0,0xe0,0xf0,0xff,0xff,0xff,0xff,0xff,0xff,0xff,0xff,0xff,0xff,0xff,0xff,0xff,0xff};
    return L[n];
}
__device__ __forceinline__ void topk_item(const Frame& F, int item) {
    const int lane = F.lane, r32 = lane & 31, hi = lane >> 5, hh = item & 7, tok0 = (item >> 3) * 32; const size_t tok = (size_t)tok0 + r32;
    LAS int* ktab = (LAS int*)(F.lds + F.wave * 4096) + r32 * 32;
    float ss = 0.f;
    { const f32x4* sp = (const f32x4*)(F.ssp + tok * 32 + hi * 16);
#pragma unroll
      for (int j = 0; j < 4; ++j) { const f32x4 v = sp[j]; ss += (v[0] + v[1]) + (v[2] + v[3]); } }
    ss += __shfl_xor(ss, 32);
    const float rs2 = __builtin_amdgcn_rsqf(ss * (1.f / DM) + EPS);
    if (hh == 0 && hi == 0) F.rs2[tok] = rs2;
    unsigned top[2][16];
#pragma unroll
    for (int cc = 0; cc < 2; ++cc) {
        f32x16 acc[4] = {};
        const bf16_t* qp = F.qry + tok * DM + hh * 256 + cc * 128 + hi * 8; const bf16_t* kp = F.SK + ((size_t)(hh * 2 + cc) * 128 + r32) * 128 + hi * 8;
#pragma unroll 2
        for (int s = 0; s < 8; ++s) { const bf16x8 qf = *(const bf16x8*)(qp + 16 * s);
#pragma unroll
            for (int kt = 0; kt < 4; ++kt) { const bf16x8 kf = *(const bf16x8*)(kp + (size_t)kt * 32 * 128 + 16 * s); acc[kt] = __builtin_amdgcn_mfma_f32_32x32x16_bf16(kf, qf, acc[kt], 0, 0, 0); } }
        unsigned g[4][16];
#pragma unroll
        for (int kt = 0; kt < 4; ++kt) {
#pragma unroll
            for (int r = 0; r < 16; ++r) g[kt][r] = (fl_flip(acc[kt][r]) & ~127u) | (unsigned)(127 - (32 * kt + crow(r, hi)));
            sort16_desc(g[kt]); }
        top16_merge(g[0], g[1]); top16_merge(g[2], g[3]); top16_merge(g[0], g[2]); top16_partner(g[0]);
#pragma unroll
        for (int i = 0; i < 16; ++i) top[cc][i] = g[0][i];
    }
#pragma unroll
    for (int i = 0; i < 16; ++i) ktab[hi * 16 + i] = 127 - (int)((hi ? top[1][i] : top[0][i]) & 127u);
    float s0[16], s1[16];
#pragma unroll
    for (int i = 0; i < 16; ++i) { s0[i] = fl_unflip(top[0][i] & ~127u); s1[i] = fl_unflip(top[1][i] & ~127u); }
    unsigned ca[16], cb[16];
#pragma unroll
    for (int n = 0; n < 32; ++n) { const int A = stair(n), B = stair(25 + n); unsigned va = 0u, vb = 0u;
        if (n < 25) { va = (fl_flip(s0[A >> 4] + s1[A & 15]) & ~255u) | (unsigned)(255 - A); vb = (fl_flip(s0[B >> 4] + s1[B & 15]) & ~255u) | (unsigned)(255 - B); }
        const unsigned v = hi ? vb : va; if (n < 16) ca[n] = v; else cb[n - 16] = v; }
    sort16_desc(ca); sort16_desc(cb); top16_merge(ca, cb); top16_partner(ca);
    float e[16], sum = 0.f; const float mx = fl_unflip(ca[0] & ~255u) * rs2;
#pragma unroll
    for (int i = 0; i < 16; ++i) { e[i] = fexp(fl_unflip(ca[i] & ~255u) * rs2 - mx); sum += e[i]; }
    const float inv = 1.f / sum;
    LDS_WAIT(); asm volatile("" ::: "memory");
    int oi[8]; float og[8];
#pragma unroll
    for (int k = 0; k < 8; ++k) { const unsigned cv = hi ? ca[8 + k] : ca[k]; const int code = 255 - (int)(cv & 255u); og[k] = (hi ? e[8 + k] : e[k]) * inv; oi[k] = ktab[code >> 4] * 128 + ktab[16 + (code & 15)]; }
    { int* ip = F.idx + tok * 128 + hh * 16 + hi * 8; float* gp = F.gate + tok * 128 + hh * 16 + hi * 8;
      *(int4*)ip = make_int4(oi[0], oi[1], oi[2], oi[3]); *(int4*)(ip + 4) = make_int4(oi[4], oi[5], oi[6], oi[7]);
      *(f32x4*)gp = (f32x4){og[0], og[1], og[2], og[3]}; *(f32x4*)(gp + 4) = (f32x4){og[4], og[5], og[6], og[7]}; }
    LDS_WAIT(); asm volatile("" ::: "memory");
}

constexpr int PS_NSL = 32, PS_CW = DM / PS_NSL, PS_SUB = PS_NSL / 8, PS_TG = 16, PS_NTG = T / PS_TG;
typedef __bf16 bf2_t __attribute__((ext_vector_type(2)));
__device__ __forceinline__ float gelu_tanh(float x) { const float u = 0.7978845608028654f * (x + 0.044715f * x * x * x); const float t = 1.f - 2.f * __builtin_amdgcn_rcpf(1.f + fexp(2.f * u)); return 0.5f * x * (1.f + t); }
typedef __bf16 bf8_t __attribute__((ext_vector_type(8)));
__device__ __forceinline__ float dot8(bf8_t w, bf8_t x) {
    float a = __builtin_amdgcn_fdot2_f32_bf16(__builtin_shufflevector(w, w, 0, 1), __builtin_shufflevector(x, x, 0, 1), 0.f, false);
    a = __builtin_amdgcn_fdot2_f32_bf16(__builtin_shufflevector(w, w, 2, 3), __builtin_shufflevector(x, x, 2, 3), a, false);
    a = __builtin_amdgcn_fdot2_f32_bf16(__builtin_shufflevector(w, w, 4, 5), __builtin_shufflevector(x, x, 4, 5), a, false);
    return __builtin_amdgcn_fdot2_f32_bf16(__builtin_shufflevector(w, w, 6, 7), __builtin_shufflevector(x, x, 6, 7), a, false);
}
__device__ __forceinline__ unsigned xcc_id() { return (unsigned)__builtin_amdgcn_s_getreg((3 << 11) | 20) & 7u; }
__device__ __forceinline__ bool peer_claim(unsigned* cnt, unsigned x, unsigned& d, int lane, int& q, int& tg) {
    while (d < 8u) { const unsigned xq = (x + d) & 7u; unsigned u = 0u;
        if (lane == 0) u = __hip_atomic_fetch_add(cnt + 64 * xq, 1u, __ATOMIC_RELAXED, __HIP_MEMORY_SCOPE_AGENT);
        u = (unsigned)__builtin_amdgcn_readfirstlane((int)u);
        if (u < (unsigned)(PS_SUB * PS_NTG)) { q = (int)(u / PS_NTG) * 8 + (int)xq; tg = (int)(u % PS_NTG); return true; }
        ++d; }
    return false;
}
__device__ __forceinline__ void peer_down(const Frame& F) {
    const int lane = F.lane, g = lane >> 3, c = lane & 7; const unsigned x = xcc_id(); unsigned d = 0u; int q, tg; unsigned* cnt = (unsigned*)(F.wsb + WS_CTL) + 1024;
    while (peer_claim(cnt, x, d, lane, q, tg)) {
        const int col0 = q * PS_CW + 8 * c; float* part = F.part + (size_t)q * T * 128;
        int e[16];
        { const int* ip = F.idx + (size_t)tg * PS_TG * 128 + g;
#pragma unroll
          for (int j = 0; j < 16; ++j) e[j] = ip[8 * j]; }
        for (int tt = 0; tt < PS_TG; ++tt) { const size_t tok = (size_t)tg * PS_TG + tt;
            bf8_t w[16];
#pragma unroll
            for (int j = 0; j < 16; ++j) w[j] = *(const bf8_t*)(F.down16 + (size_t)e[j] * DM + col0);
            const bf8_t xv = *(const bf8_t*)(F.x1b + tok * DM + col0);
            { const int* ip = F.idx + (tok + (tt + 1 < PS_TG ? 1 : 0)) * 128 + g;
#pragma unroll
              for (int j = 0; j < 16; ++j) e[j] = ip[8 * j]; }
            float p[16];
#pragma unroll
            for (int j = 0; j < 16; ++j) p[j] = dot8(w[j], xv);
            float a1[8], a2[4], a3[2];
#pragma unroll
            for (int i = 0; i < 8; ++i) { const float keep = (c & 1) ? p[2 * i + 1] : p[2 * i], give = (c & 1) ? p[2 * i] : p[2 * i + 1]; a1[i] = keep + __shfl_xor(give, 1); }
#pragma unroll
            for (int i = 0; i < 4; ++i) { const float keep = (c & 2) ? a1[2 * i + 1] : a1[2 * i], give = (c & 2) ? a1[2 * i] : a1[2 * i + 1]; a2[i] = keep + __shfl_xor(give, 2); }
#pragma unroll
            for (int i = 0; i < 2; ++i) { const float keep = (c & 4) ? a2[2 * i + 1] : a2[2 * i], give = (c & 4) ? a2[2 * i] : a2[2 * i + 1]; a3[i] = keep + __shfl_xor(give, 4); }
            part[tok * 128 + 8 * c + g] = a3[0]; part[tok * 128 + 64 + 8 * c + g] = a3[1];
        }
    }
}
__device__ __forceinline__ void peer_coef(const Frame& F) {
    const int gw = F.vcu * 8 + F.wave, NGW = F.G * 8, lane = F.lane;
    for (int tok = gw; tok < T; tok += NGW) { float a0 = 0.f, a1 = 0.f; const float* pp = F.part + (size_t)tok * 128 + lane;
#pragma unroll 8
        for (int q = 0; q < PS_NSL; ++q) { a0 += pp[(size_t)q * T * 128]; a1 += pp[(size_t)q * T * 128 + 64]; }
        const float rs2 = F.rs2[tok]; float* gp = F.gate + (size_t)tok * 128 + lane;
        gp[0] = gp[0] * gelu_tanh(a0 * rs2); gp[64] = gp[64] * gelu_tanh(a1 * rs2); }
}
__device__ __forceinline__ void peer_up(const Frame& F) {
    const int lane = F.lane, g = lane >> 3, c = lane & 7; const unsigned x = xcc_id(); unsigned d = 0u; int q, tg; unsigned* cnt = (unsigned*)(F.wsb + WS_CTL) + 2048;
    while (peer_claim(cnt, x, d, lane, q, tg)) {
        const int col0 = q * PS_CW + 8 * c;
        int e[16]; float cf[16];
        { const size_t o = (size_t)tg * PS_TG * 128 + g;
#pragma unroll
          for (int j = 0; j < 16; ++j) { e[j] = F.idx[o + 8 * j]; cf[j] = F.gate[o + 8 * j]; } }
        for (int tt = 0; tt < PS_TG; ++tt) { const size_t tok = (size_t)tg * PS_TG + tt;
            u32x4 w[16];
#pragma unroll
            for (int j = 0; j < 16; ++j) w[j] = *(const u32x4*)(F.up16 + (size_t)e[j] * DM + col0);
            float cc[16];
#pragma unroll
            for (int j = 0; j < 16; ++j) cc[j] = cf[j];
            { const size_t o = (tok + (tt + 1 < PS_TG ? 1 : 0)) * 128 + g;
#pragma unroll
              for (int j = 0; j < 16; ++j) { e[j] = F.idx[o + 8 * j]; cf[j] = F.gate[o + 8 * j]; } }
            float acc[8] = {0.f, 0.f, 0.f, 0.f, 0.f, 0.f, 0.f, 0.f};
#pragma unroll
            for (int j = 0; j < 16; ++j) { acc[0] += cc[j] * bflo(w[j].x); acc[1] += cc[j] * bfhi(w[j].x); acc[2] += cc[j] * bflo(w[j].y); acc[3] += cc[j] * bfhi(w[j].y);
                acc[4] += cc[j] * bflo(w[j].z); acc[5] += cc[j] * bfhi(w[j].z); acc[6] += cc[j] * bflo(w[j].w); acc[7] += cc[j] * bfhi(w[j].w); }
#pragma unroll
            for (int i = 0; i < 8; ++i) { acc[i] += __shfl_xor(acc[i], 8); acc[i] += __shfl_xor(acc[i], 16); acc[i] += __shfl_xor(acc[i], 32); }
            if (g == 0) { float* op = F.out + tok * DM + col0; f32x4 v0 = *(const f32x4*)op, v1 = *(const f32x4*)(op + 4);
                v0[0] += acc[0]; v0[1] += acc[1]; v0[2] += acc[2]; v0[3] += acc[3]; v1[0] += acc[4]; v1[1] += acc[5]; v1[2] += acc[6]; v1[3] += acc[7];
                *(f32x4*)op = v0; *(f32x4*)(op + 4) = v1; }
        }
    }
}

struct Args { const float* in[16]; float* out; unsigned char* ws; int ph_lo, ph_hi, coop, pad; };
__global__ void __launch_bounds__(512, 2) fwd_kernel(Args args) {
    extern __shared__ __attribute__((aligned(16))) unsigned char lds_raw[];
    Frame F;
    F.lds = (LAS unsigned char*)lds_raw; F.ldsg = (char*)lds_raw;
    F.tid = threadIdx.x; F.lane = F.tid & 63; F.wave = __builtin_amdgcn_readfirstlane(F.tid >> 6);
    F.G = gridDim.x; { const int bx = blockIdx.x; F.vcu = (F.G % 8 == 0) ? (bx % 8) * (F.G / 8) + bx / 8 : bx; }
    F.x = args.in[0]; F.norm1_g = args.in[1]; F.w_in = args.in[2]; F.up_f = args.in[3]; F.bias_f = args.in[4]; F.up_b = args.in[5]; F.bias_b = args.in[6]; F.out_g = args.in[7];
    F.qn_g = args.in[8]; F.kn_g = args.in[9]; F.w_out = args.in[10]; F.norm2_g = args.in[11]; F.w_query = args.in[12]; F.sub_keys = args.in[13]; F.peer_down = args.in[14]; F.peer_up = args.in[15];
    F.out = args.out; unsigned char* ws = args.ws; F.wsb = ws;
    F.rope = (f32x2*)(ws + WS_ROPE); F.rs1 = (float*)(ws + WS_RS1); F.rs2 = (float*)(ws + WS_RS2); F.ssp = (float*)(ws + WS_SSP); F.dec = (float*)(ws + WS_DEC); F.lp = (float*)(ws + WS_LP);
    F.gate = (float*)(ws + WS_GATE); F.part = (float*)(ws + WS_PART); F.idx = (int*)(ws + WS_IDX); F.state = (float*)((unsigned char*)args.out + OUT_ST);
    F.WinT = (bf16_t*)(ws + WS_WIN); F.WoT = (bf16_t*)(ws + WS_WO); F.WqT = (bf16_t*)(ws + WS_WQ); F.SK = (bf16_t*)(ws + WS_SK); F.down16 = (bf16_t*)(ws + WS_DOWN); F.up16 = (bf16_t*)(ws + WS_UP);
    F.xb = (bf16_t*)(ws + WS_XB); F.mixed = (bf16_t*)(ws + WS_XB); F.h = (bf16_t*)(ws + WS_H); F.x1b = (bf16_t*)(ws + WS_X1B); F.qry = (bf16_t*)(ws + WS_QRY);
    F.op0 = (bf16_t*)((unsigned char*)args.out + OUT_OP0); F.op1 = (bf16_t*)(ws + WS_OP1); F.op2 = (bf16_t*)(ws + WS_OP2);
    const int lo = args.ph_lo, hi = args.ph_hi;
#ifndef PH_MASK
#define PH_MASK 0x7ff
#endif
#ifndef PROBE_PHASE
#define PROBE_PHASE -1
#endif
#define REP(k) for (int rep_ = 0; rep_ < ((PROBE_PHASE == (k)) ? 2 : 1); ++rep_)
#define IN(k) (((PH_MASK >> (k)) & 1) && lo <= (k) && (k) < hi)
#define SEAM(k) do { if (IN(k) && IN((k) + 1)) { if (args.coop) cg::this_grid().sync(); } } while (0)
    if (IN(0)) { REP(0) phase0(F); } SEAM(0);
    if (IN(1)) REP(1) { pg8::Gemm g{F.xb, F.WinT, T, HP, DM}; pg8::StaticOrder S; S.init(T, HP, F.G, (int)blockIdx.x); pg8::EpiRowScaleBf16 E{F.h, HP, F.rs1};
        pg8::gemm_phase<pg8::EpiRowScaleBf16, pg8::StaticOrder, PG8_ALIGN, PG8_SP2>(F.lds, g, S, E); } SEAM(1);
    if (IN(2)) { qknorm_rope(F); for (int it = F.vcu; it < 2048; it += F.G) gla_passA(F, it); } SEAM(2);
    if (IN(3)) { for (int it = F.vcu; it < 256; it += F.G) gla_scan(F, it); REP(3) for (int it = F.vcu; it < 4608; it += F.G) attn_item(F, it); } SEAM(3);
    if (IN(4)) REP(4) { for (int it = F.vcu; it < 2048; it += F.G) gla_passC(F, it); dil_combine(F); } SEAM(4);
    if (IN(5)) REP(5) { pg8::Gemm g{F.mixed, F.WoT, T, DM, DM}; pg8::StaticOrder S; S.init(T, DM, F.G, (int)blockIdx.x); pg8::EpiResid E{F.x, F.out, F.x1b, F.ssp, DM};
        pg8::gemm_phase<pg8::EpiResid, pg8::StaticOrder, PG8_ALIGN, PG8_SP2>(F.lds, g, S, E); } SEAM(5);
    if (IN(6)) REP(6) { pg8::Gemm g{F.x1b, F.WqT, T, DM, DM}; pg8::StaticOrder S; S.init(T, DM, F.G, (int)blockIdx.x); pg8::EpiRowScaleBf16 E{F.qry, DM, nullptr};
        pg8::gemm_phase<pg8::EpiRowScaleBf16, pg8::StaticOrder, PG8_ALIGN, PG8_SP2>(F.lds, g, S, E); } SEAM(6);
    if (IN(7)) REP(7) { const int gw = F.vcu * 8 + F.wave, NGW = F.G * 8; for (int it = gw; it < (T / 32) * 8; it += NGW) topk_item(F, it); } SEAM(7);
    if (IN(8)) { peer_down(F); } SEAM(8);
    if (IN(9)) { peer_coef(F); } SEAM(9);
    if (IN(10)) { peer_up(F); }
#undef IN
#undef SEAM
}

#ifndef MK_N_LAUNCHES
#define MK_N_LAUNCHES 1
#endif
extern "C" void kernel_launch(void* const* d_in, const int* in_sizes, int n_in, void* d_out, int out_size, void* d_ws, size_t ws_size, hipStream_t stream) {
    static int grid = 0;
    if (grid == 0) {
        if (n_in != 16 || in_sizes[0] != T * DM || out_size != T * DM || ws_size < WS_END) { fprintf(stderr, "kernel_launch: unexpected shapes (n_in %d, in0 %d, out %d, ws %zu)\n", n_in, n_in > 0 ? in_sizes[0] : -1, out_size, ws_size); grid = -1; return; }
        int dev = 0, cus = 0, per_cu = 0;
        if (hipGetDevice(&dev) != hipSuccess || hipDeviceGetAttribute(&cus, hipDeviceAttributeMultiprocessorCount, dev) != hipSuccess) { grid = -1; return; }
        if (hipFuncSetAttribute((const void*)fwd_kernel, hipFuncAttributeMaxDynamicSharedMemorySize, LDS_BYTES) != hipSuccess) { fprintf(stderr, "kernel_launch: hipFuncSetAttribute failed\n"); grid = -1; return; }
        if (hipOccupancyMaxActiveBlocksPerMultiprocessor(&per_cu, (const void*)fwd_kernel, 512, LDS_BYTES) != hipSuccess || per_cu < 1) { fprintf(stderr, "kernel_launch: occupancy query says %d\n", per_cu); per_cu = 1; }
        (void)hipGetLastError();
        grid = cus;
    }
    if (grid < 0) return;
    Args a{};
    for (int i = 0; i < 16; ++i) a.in[i] = (const float*)d_in[i];
    a.out = (float*)d_out; a.ws = (unsigned char*)d_ws;
    if (MK_N_LAUNCHES == 1) {
        a.ph_lo = 0; a.ph_hi = NPHASE; a.coop = 1; void* kargs[] = {&a};
        hipError_t e = hipLaunchCooperativeKernel((const void*)fwd_kernel, dim3(grid), dim3(512), kargs, LDS_BYTES, stream);
        if (e != hipSuccess) fprintf(stderr, "kernel_launch: cooperative launch failed: %s (grid %d)\n", hipGetErrorString(e), grid);
    } else {
        for (int p = 0; p < NPHASE; ++p) { a.ph_lo = p; a.ph_hi = p + 1; a.coop = 0; hipLaunchKernelGGL(fwd_kernel, dim3(grid), dim3(512), LDS_BYTES, stream, a); }
        const hipError_t le = hipPeekAtLastError(); if (le != hipSuccess) fprintf(stderr, "kernel_launch: launch failed: %s\n", hipGetErrorName(le));
    }
}
```

```cpp
#include <hip/hip_runtime.h>
#include <hip/hip_cooperative_groups.h>
#include <cstdio>
#include <cstdint>
namespace cg = cooperative_groups;
namespace pg8 {
#define PG8_LAS __attribute__((address_space(3)))
typedef unsigned short bf16_t;
typedef short bf16x8 __attribute__((ext_vector_type(8)));
typedef float f32x4 __attribute__((ext_vector_type(4)));
typedef unsigned u32x4 __attribute__((ext_vector_type(4)));
constexpr int BM = 256, BK = 64, HALF = 128, HTB = HALF * BK * 2  , STAGE_BYTES = 8 * HTB, NXCD = 8, WGM = 8;

__host__ __device__ __forceinline__ int lds_byte(int r, int c) { const int st = (r >> 4) * 2 + (c >> 5), rr = r & 15, cc = c & 31, ob = rr * 64 + cc * 2; return st * 1024 + (ob ^ (((ob >> 9) & 1) << 5)); }
__host__ __device__ __forceinline__ void stage_rc(int b, int& R, int& C) { const int st = b / 1024, sb = b % 1024, swz = sb ^ (((sb >> 9) & 1) << 5); R = (st >> 1) * 16 + swz / 64; C = (st & 1) * 32 + (swz % 64) / 2; }
__host__ __device__ __forceinline__ int perm32(int rho) { const int n = rho >> 4, i = rho & 15; return 8 * (i >> 2) + 4 * n + (i & 3); }

struct Unit { int pm, pn; };
struct Gemm { const bf16_t* A; const bf16_t* Bt; int M, N, K; };

struct StaticOrder {
    int nM, nN, nwg, G, c;
    __host__ __device__ void init(int M, int N, int G_, int c_) { nM = M / BM; nN = N / BM; nwg = nM * nN; G = G_; c = c_; }
    __host__ __device__ bool next(int i, Unit& u) const {
        const long L = (long)i * G + c; if (L >= nwg) return false;
        int wgid = (int)L; { const int q = nwg / NXCD, r = nwg % NXCD, xcd = wgid % NXCD, off = wgid / NXCD; wgid = (xcd < r ? xcd * (q + 1) : r * (q + 1) + (xcd - r) * q) + off; }
        const int nig = WGM * nN, gid = wgid / nig, fm = gid * WGM, gsz = (nM - fm) < WGM ? (nM - fm) : WGM;
        u.pm = fm + ((wgid % nig) % gsz); u.pn = (wgid % nig) / gsz; return true;
    }
    __device__ __forceinline__ void a_ready(const Unit&) const {}
    __device__ __forceinline__ void done(const Unit&) const {}
};
__device__ __forceinline__ unsigned cvt_pk_bf16(float lo, float hi) { unsigned r; asm volatile("v_cvt_pk_bf16_f32 %0, %1, %2" : "=v"(r) : "v"(lo), "v"(hi)); return r; }
struct EpiRowScaleBf16 {
    static constexpr bool PERM = true, AFTER_DRAIN = false;
    bf16_t* O; int ldc; const float* rs;
    __device__ __forceinline__ void operator()(const f32x4 (&acc)[2][2][4][2], const Unit& u, int wr, int wc, int fr, int fq) const {
        const int row0 = u.pm * BM + wr * 64 + fr, col0 = u.pn * BM + wc * 32 + 8 * fq;
#pragma unroll
        for (int ai = 0; ai < 2; ++ai)
#pragma unroll
            for (int m = 0; m < 4; ++m) { const int row = row0 + ai * HALF + m * 16; const float s = rs ? rs[row] : 1.f; bf16_t* rowp = O + (size_t)row * ldc + col0;
#pragma unroll
                for (int bj = 0; bj < 2; ++bj) { const f32x4 v0 = acc[ai][bj][m][0] * s, v1 = acc[ai][bj][m][1] * s;
                    u32x4 w; w.x = cvt_pk_bf16(v0[0], v0[1]); w.y = cvt_pk_bf16(v0[2], v0[3]); w.z = cvt_pk_bf16(v1[0], v1[1]); w.w = cvt_pk_bf16(v1[2], v1[3]);
                    *(u32x4*)(rowp + bj * HALF) = w; } }
    }
};
struct EpiResid {
    static constexpr bool PERM = true, AFTER_DRAIN = false;
    const float* x; float* out; bf16_t* xb; float* ssp; int ldc;
    __device__ __forceinline__ void operator()(const f32x4 (&acc)[2][2][4][2], const Unit& u, int wr, int wc, int fr, int fq) const {
        const int row0 = u.pm * BM + wr * 64 + fr, col0 = u.pn * BM + wc * 32 + 8 * fq;
#pragma unroll
        for (int ai = 0; ai < 2; ++ai)
#pragma unroll
            for (int m = 0; m < 4; ++m) { const int row = row0 + ai * HALF + m * 16; const size_t off = (size_t)row * ldc + col0; float ss = 0.f;
#pragma unroll
                for (int bj = 0; bj < 2; ++bj) { const f32x4 xa = *(const f32x4*)(x + off + bj * HALF), xc = *(const f32x4*)(x + off + bj * HALF + 4);
                    const f32x4 v0 = acc[ai][bj][m][0] + xa, v1 = acc[ai][bj][m][1] + xc;
                    *(f32x4*)(out + off + bj * HALF) = v0; *(f32x4*)(out + off + bj * HALF + 4) = v1;
                    u32x4 w; w.x = cvt_pk_bf16(v0[0], v0[1]); w.y = cvt_pk_bf16(v0[2], v0[3]); w.z = cvt_pk_bf16(v1[0], v1[1]); w.w = cvt_pk_bf16(v1[2], v1[3]);
                    *(u32x4*)(xb + off + bj * HALF) = w;
                    ss += (v0[0] * v0[0] + v0[1] * v0[1]) + (v0[2] * v0[2] + v0[3] * v0[3]) + (v1[0] * v1[0] + v1[1] * v1[1]) + (v1[2] * v1[2] + v1[3] * v1[3]); }
                ss += __shfl_xor(ss, 16); ss += __shfl_xor(ss, 32);
                if (fq == 0) ssp[(size_t)row * 32 + u.pn * 4 + wc] = ss; }
    }
};
template <class Epi, class Sched, bool ALIGN_EPI = false, bool SP2 = false>
__device__ __forceinline__ void gemm_phase(PG8_LAS unsigned char* lds, const Gemm g, const Sched& S, const Epi& E) {
    const int tid = threadIdx.x, wid = __builtin_amdgcn_readfirstlane(tid >> 6), lane = tid & 63, wr = wid >> 2, wc = wid & 3, fr = lane & 15, fq = lane >> 4;
    const int K = g.K, nt = K / BK;
    unsigned voffA[2], voffB[2];
#pragma unroll
    for (int i = 0; i < 2; ++i) { int R, C; stage_rc(tid * 16 + i * 8192, R, C); const int Rb = Epi::PERM ? ((R & ~31) + perm32(R & 31)) : R;
        voffA[i] = (unsigned)(R * K + C) * 2u; voffB[i] = (unsigned)(Rb * K + C) * 2u; }
    const size_t kstep = (size_t)(BK * 2);
    const size_t hstep = (size_t)HALF * K * 2;
    const size_t tstep = 2 * hstep;
    const unsigned ldsw = (unsigned)wid * 1024u;
    const int aoff = lds_byte(wr * 64 + fr, fq * 8), boff = lds_byte(wc * 32 + fr, fq * 8);
#define PG8_SA(b, h) (((b) * 2 + (h)) * HTB)
#define PG8_SB(b, h) ((4 + (b) * 2 + (h)) * HTB)
#define PG8_STAGE(bufoff, gbase, voff) do { _Pragma("unroll") for (int _i = 0; _i < 2; ++_i) \
        __builtin_amdgcn_global_load_lds((const unsigned*)((const char*)(gbase) + (voff)[_i]), (PG8_LAS unsigned*)(lds + (bufoff) + ldsw + _i * 8192), 16, 0, 0); } while (0)
#define PG8_LDA(dst, b, h) do { _Pragma("unroll") for (int m = 0; m < 4; ++m) _Pragma("unroll") for (int k = 0; k < 2; ++k) dst[m][k] = *(const PG8_LAS bf16x8*)(lds + PG8_SA(b, h) + aoff + m * 2048 + k * 1024); } while (0)
#define PG8_LDB(dst, b, h) do { _Pragma("unroll") for (int n = 0; n < 2; ++n) _Pragma("unroll") for (int k = 0; k < 2; ++k) dst[n][k] = *(const PG8_LAS bf16x8*)(lds + PG8_SB(b, h) + boff + n * 2048 + k * 1024); } while (0)
#define PG8_MMA(ai, bj, At, Bt) do { __builtin_amdgcn_s_setprio(1); _Pragma("unroll") for (int m = 0; m < 4; ++m) _Pragma("unroll") for (int n = 0; n < 2; ++n) _Pragma("unroll") for (int k = 0; k < 2; ++k) \
        acc[ai][bj][m][n] = __builtin_amdgcn_mfma_f32_16x16x32_bf16(Bt[n][k], At[m][k], acc[ai][bj][m][n], 0, 0, 0); __builtin_amdgcn_s_setprio(0); } while (0)
#define PG8_WAIT_V(n) asm volatile("s_waitcnt vmcnt(" #n ")" ::: "memory")
#define PG8_WAIT_L(n) asm volatile("s_waitcnt lgkmcnt(" #n ")" ::: "memory")
#define PG8_BAR __builtin_amdgcn_s_barrier()
#define PG8_SCHED __builtin_amdgcn_sched_barrier(0)
    Unit cur, nxt; int ui = 0;
    if (!S.next(0, cur)) return;
    f32x4 acc[2][2][4][2];
#pragma unroll
    for (int a = 0; a < 2; ++a)
#pragma unroll
        for (int b = 0; b < 2; ++b)
#pragma unroll
            for (int m = 0; m < 4; ++m)
#pragma unroll
                for (int n = 0; n < 2; ++n) acc[a][b][m][n] = (f32x4){0.f, 0.f, 0.f, 0.f};
    bf16x8 At[4][2], B0[2][2], B1[2][2];
    const char* cA = (const char*)g.A + (size_t)cur.pm * tstep; const char* cB = (const char*)g.Bt + (size_t)cur.pn * tstep;
    S.a_ready(cur);
    if constexpr (SP2) {
        PG8_STAGE(PG8_SB(0, 0), cB, voffB); PG8_STAGE(PG8_SB(0, 1), cB + hstep, voffB); PG8_STAGE(PG8_SA(0, 0), cA, voffA); PG8_STAGE(PG8_SA(0, 1), cA + hstep, voffA);
        if (wr == 1) PG8_BAR;
        PG8_WAIT_V(2); PG8_BAR;
        PG8_STAGE(PG8_SB(1, 0), cB + kstep, voffB); PG8_STAGE(PG8_SA(1, 0), cA + kstep, voffA); PG8_STAGE(PG8_SB(1, 1), cB + hstep + kstep, voffB);
        PG8_WAIT_V(6); PG8_BAR;
    } else {
        PG8_STAGE(PG8_SB(0, 0), cB, voffB); PG8_STAGE(PG8_SA(0, 0), cA, voffA); PG8_STAGE(PG8_SB(0, 1), cB + hstep, voffB); PG8_STAGE(PG8_SA(0, 1), cA + hstep, voffA);
        if (wr == 1) PG8_BAR;
        PG8_WAIT_V(4); PG8_BAR;
        PG8_STAGE(PG8_SB(1, 0), cB + kstep, voffB); PG8_STAGE(PG8_SA(1, 0), cA + kstep, voffA); PG8_STAGE(PG8_SB(1, 1), cB + hstep + kstep, voffB);
        PG8_WAIT_V(6); PG8_BAR;
    }
    for (;;) {
        const bool has_next = S.next(ui + 1, nxt);
        const char* nA = has_next ? (const char*)g.A + (size_t)nxt.pm * tstep : cA; const char* nB = has_next ? (const char*)g.Bt + (size_t)nxt.pn * tstep : cB;
        for (int t = 0; t < nt; t += 2) {
            const bool last = (t == nt - 2);
            const char* a1 = cA + (size_t)(t + 1) * kstep;
            const char* a2 = last ? nA : cA + (size_t)(t + 2) * kstep; const char* b2 = last ? nB : cB + (size_t)(t + 2) * kstep;
            const char* a3 = a2 + kstep; const char* b3 = b2 + kstep;
            if (last && has_next) S.a_ready(nxt);
            if constexpr (SP2) {
            PG8_LDB(B0, 0, 0); PG8_LDB(B1, 0, 1); PG8_SCHED; PG8_LDA(At, 0, 0); PG8_STAGE(PG8_SA(1, 1), a1 + hstep, voffA);
            PG8_WAIT_V(8); PG8_WAIT_L(0); PG8_BAR; PG8_MMA(0, 0, At, B0); PG8_MMA(0, 1, At, B1); PG8_BAR; PG8_SCHED;
            PG8_LDA(At, 0, 1); PG8_STAGE(PG8_SB(0, 0), b2, voffB); PG8_STAGE(PG8_SB(0, 1), b2 + hstep, voffB); PG8_STAGE(PG8_SA(0, 0), a2, voffA);
            PG8_WAIT_V(8); PG8_WAIT_L(0); PG8_BAR; PG8_MMA(1, 0, At, B0); PG8_MMA(1, 1, At, B1); PG8_BAR; PG8_SCHED;
            PG8_LDB(B0, 1, 0); PG8_LDB(B1, 1, 1); PG8_SCHED; PG8_LDA(At, 1, 0); PG8_STAGE(PG8_SA(0, 1), a2 + hstep, voffA);
            PG8_WAIT_V(8); PG8_WAIT_L(0); PG8_BAR; PG8_MMA(0, 0, At, B0); PG8_MMA(0, 1, At, B1); PG8_BAR; PG8_SCHED;
            PG8_LDA(At, 1, 1); PG8_STAGE(PG8_SB(1, 0), b3, voffB); PG8_STAGE(PG8_SB(1, 1), b3 + hstep, voffB); PG8_STAGE(PG8_SA(1, 0), a3, voffA);
            PG8_WAIT_V(8); PG8_WAIT_L(0); PG8_BAR; PG8_MMA(1, 0, At, B0); PG8_MMA(1, 1, At, B1); PG8_BAR; PG8_SCHED;
            } else {
            PG8_LDB(B0, 0, 0); PG8_SCHED; PG8_LDA(At, 0, 0); PG8_STAGE(PG8_SA(1, 1), a1 + hstep, voffA);
            PG8_WAIT_L(8); PG8_BAR; PG8_WAIT_L(0); PG8_MMA(0, 0, At, B0); PG8_BAR; PG8_SCHED;
            PG8_LDB(B1, 0, 1); PG8_STAGE(PG8_SB(0, 0), b2, voffB);
            PG8_BAR; PG8_WAIT_L(0); PG8_MMA(0, 1, At, B1); PG8_BAR;
            PG8_LDA(At, 0, 1); PG8_STAGE(PG8_SA(0, 0), a2, voffA);
            PG8_BAR; PG8_WAIT_L(0); PG8_MMA(1, 0, At, B0); PG8_BAR; PG8_SCHED;
            PG8_STAGE(PG8_SB(0, 1), b2 + hstep, voffB);
            PG8_WAIT_V(6); PG8_BAR; PG8_MMA(1, 1, At, B1); PG8_BAR;
            PG8_LDB(B0, 1, 0); PG8_SCHED; PG8_LDA(At, 1, 0); PG8_STAGE(PG8_SA(0, 1), a2 + hstep, voffA);
            PG8_WAIT_L(8); PG8_BAR; PG8_WAIT_L(0); PG8_MMA(0, 0, At, B0); PG8_BAR; PG8_SCHED;
            PG8_LDB(B1, 1, 1); PG8_STAGE(PG8_SB(1, 0), b3, voffB);
            PG8_BAR; PG8_WAIT_L(0); PG8_MMA(0, 1, At, B1); PG8_BAR;
            PG8_LDA(At, 1, 1); PG8_STAGE(PG8_SA(1, 0), a3, voffA);
            PG8_BAR; PG8_WAIT_L(0); PG8_MMA(1, 0, At, B0); PG8_BAR; PG8_SCHED;
            PG8_STAGE(PG8_SB(1, 1), b3 + hstep, voffB);
            PG8_WAIT_V(6); PG8_BAR; PG8_MMA(1, 1, At, B1); PG8_BAR;
            }
        }
        if constexpr (ALIGN_EPI) { if (wr == 0) PG8_BAR; }
        if constexpr (!Epi::AFTER_DRAIN) { E(acc, cur, wr, wc, fr, fq); S.done(cur); }
        if (!has_next) break;
#pragma unroll
        for (int a = 0; a < 2; ++a)
#pragma unroll
            for (int b = 0; b < 2; ++b)
#pragma unroll
                for (int m = 0; m < 4; ++m)
#pragma unroll
                    for (int n = 0; n < 2; ++n) acc[a][b][m][n] = (f32x4){0.f, 0.f, 0.f, 0.f};
        cur = nxt; cA = nA; cB = nB; ++ui;
        if constexpr (ALIGN_EPI) { if (wr == 1) PG8_BAR; }
    }
    PG8_WAIT_V(0);
    if constexpr (!ALIGN_EPI) { if (wr == 0) PG8_BAR; }
    PG8_BAR;
    if constexpr (Epi::AFTER_DRAIN) { E.fused(acc, cur, wr, wc, fr, fq, lds, wid, lane); S.done(cur); }
#undef PG8_SA
#undef PG8_SB
#undef PG8_STAGE
#undef PG8_LDA
#undef PG8_LDB
#undef PG8_MMA
#undef PG8_WAIT_V
#undef PG8_WAIT_L
#undef PG8_BAR
#undef PG8_SCHED
}
}
#ifndef PG8_SP2
#define PG8_SP2 true
#endif
#ifndef PG8_ALIGN
#define PG8_ALIGN true
#endif

constexpr int BATCH = 2, SEQ = 16384, DM = 2048, T = BATCH * SEQ;
constexpr int INW = 6176, HP = 6400;
constexpr int C_QA = 0, C_KA = 256, C_VA = 512, C_RA = 1024, C_QD = 1536, C_KD = 3072, C_VD = 4608, C_GF = 6144;
constexpr int NHD = 12;
constexpr float EPS = 1e-6f;
constexpr float LOG2E = 1.4426950408889634f;
constexpr float QSCALE = 0.08838834764831845f * LOG2E;
constexpr int NPHASE = 11;

constexpr size_t MiB = 1u << 20;
constexpr size_t WS_CTL = 0, WS_ROPE = 1 * MiB, WS_RS1 = 3 * MiB, WS_RS2 = 3 * MiB + 512 * 1024, WS_SSP = 4 * MiB, WS_WIN = 8 * MiB, WS_WO = 33 * MiB, WS_WQ = 41 * MiB,
                 WS_SK = 49 * MiB, WS_DEC = 50 * MiB, WS_LP = 51 * MiB, WS_IDX = 56 * MiB, WS_GATE = 72 * MiB, WS_DOWN = 88 * MiB, WS_UP = 152 * MiB, WS_XB = 216 * MiB,
                 WS_H = 344 * MiB, WS_X1B = WS_H, WS_QRY = WS_H + 128 * MiB, WS_OP1 = 744 * MiB, WS_OP2 = 840 * MiB, WS_PART = 472 * MiB  , WS_END = 984 * MiB;
constexpr size_t OUT_ST = 0, OUT_OP0 = 128 * MiB;
constexpr int LDS_BYTES = 147456;

#define LAS __attribute__((address_space(3)))
typedef unsigned short bf16_t;
typedef short bf16x8 __attribute__((ext_vector_type(8)));
typedef short s16x4 __attribute__((ext_vector_type(4)));
typedef float f32x4 __attribute__((ext_vector_type(4)));
typedef float f32x2 __attribute__((ext_vector_type(2)));
typedef float f32x16 __attribute__((ext_vector_type(16)));
typedef unsigned u32x4 __attribute__((ext_vector_type(4)));
typedef unsigned u32x2 __attribute__((ext_vector_type(2)));
#define LDS_WAIT() asm volatile("s_waitcnt lgkmcnt(0)" ::: "memory")
#define SBAR() __builtin_amdgcn_sched_barrier(0)

__device__ __forceinline__ float bf2f(unsigned short b) { return __uint_as_float(((unsigned)b) << 16); }
__device__ __forceinline__ float bflo(unsigned w) { return __uint_as_float(w << 16); }
__device__ __forceinline__ float bfhi(unsigned w) { return __uint_as_float(w & 0xffff0000u); }
__device__ __forceinline__ unsigned f2bf(float f) { unsigned u = __float_as_uint(f); return (u + 0x7fffu + ((u >> 16) & 1u)) >> 16; }
__device__ __forceinline__ unsigned pk2(float lo, float hi) { return pg8::cvt_pk_bf16(lo, hi); }
__device__ __forceinline__ float fexp(float x) { return __builtin_amdgcn_exp2f(x * LOG2E); }
__device__ __forceinline__ float flog(float x) { return __builtin_amdgcn_logf(x) * 0.6931471805599453f; }
__device__ __forceinline__ float wave_sum(float v) {
#pragma unroll
    for (int o = 1; o < 64; o <<= 1) v += __shfl_xor(v, o);
    return v;
}
__device__ __forceinline__ int crow(int r, int hi) { return (r & 3) + 8 * (r >> 2) + 4 * hi; }

struct Frame {
    LAS unsigned char* lds; char* ldsg; unsigned char* wsb;
    int tid, lane, wave, vcu, G;
    const float *x, *norm1_g, *w_in, *up_f, *bias_f, *up_b, *bias_b, *out_g, *qn_g, *kn_g, *w_out, *norm2_g, *w_query, *sub_keys, *peer_down, *peer_up;
    float* out;
    f32x2* rope; float *rs1, *rs2, *ssp, *dec, *lp, *gate, *state, *sd, *su, *sx, *csum; int *idx, *part; unsigned char *down8, *up8, *xq8;
    bf16_t *WinT, *WoT, *WqT, *SK, *down16, *up16, *xb, *mixed, *h, *x1b, *qry, *op0, *op1, *op2;
};

__device__ __forceinline__ void p0_transpose_item(const float* W, int K, int N, bf16_t* WT, int k0, int n0, int dst_row0, const float* g, LAS float* scr, int lane) {
#pragma unroll 8
    for (int i = 0; i < 32; ++i) { const int kk = 2 * i + (lane >> 5); float w = W[(size_t)(k0 + kk) * N + n0 + (lane & 31)]; if (g) w *= g[k0 + kk]; scr[kk * 33 + (lane & 31)] = w; }
    LDS_WAIT(); asm volatile("" ::: "memory");
    const int c = lane & 7;
#pragma unroll
    for (int j = 0; j < 4; ++j) { const int n = (lane >> 3) + 8 * j; const LAS float* s = scr + (8 * c) * 33 + n;
        u32x4 o; o.x = pk2(s[0 * 33], s[1 * 33]); o.y = pk2(s[2 * 33], s[3 * 33]); o.z = pk2(s[4 * 33], s[5 * 33]); o.w = pk2(s[6 * 33], s[7 * 33]);
        *(u32x4*)(WT + (size_t)(dst_row0 + n) * K + k0 + 8 * c) = o; }
    LDS_WAIT(); asm volatile("" ::: "memory");
}
__device__ __forceinline__ void phase0(const Frame& F) {
    LAS float* scr = (LAS float*)(F.lds + F.wave * 16384);
    const int gw = F.vcu * 8 + F.wave, NGW = F.G * 8, lane = F.lane;
    if (F.vcu == 0) { unsigned* ctl = (unsigned*)(F.wsb + WS_CTL); for (int i = F.tid; i < 4096; i += 512) ctl[i] = 0u; }
    constexpr int I_IN = 32 * 193, I_O = 32 * 64, I_Q = 32 * 64;
    for (int it = gw; it < I_IN + I_O + I_Q; it += NGW) {
        int r = it;
        if (r < I_IN) { const int kb = r / 193, nb = r % 193; const int drow = nb < 32 ? nb * 32 : (nb == 32 ? C_GF : nb * 32 - 32);
            p0_transpose_item(F.w_in, DM, INW, F.WinT, kb * 64, nb * 32, drow, F.norm1_g, scr, lane); continue; }
        r -= I_IN;
        if (r < I_O) { const int kb = r / 64, nb = r % 64; p0_transpose_item(F.w_out, DM, DM, F.WoT, kb * 64, nb * 32, nb * 32, nullptr, scr, lane); continue; }
        r -= I_O;
        { const int kb = r / 64, nb = r % 64; p0_transpose_item(F.w_query, DM, DM, F.WqT, kb * 64, nb * 32, nb * 32, F.norm2_g, scr, lane); }
    }
    const size_t gt = (size_t)gw * 64 + lane, NT = (size_t)NGW * 64;
    { u32x4* z = (u32x4*)(F.WinT + (size_t)INW * DM); const u32x4 zero = {0u, 0u, 0u, 0u}; for (size_t i = gt; i < (size_t)(HP - INW) * DM / 8; i += NT) z[i] = zero; }
    for (int r = gw; r < 2 * 16384; r += NGW) { const bool isup = r >= 16384; const int e = r & 16383; const f32x4* src = (const f32x4*)((isup ? F.peer_up : F.peer_down) + (size_t)e * DM) + lane;
        f32x4 v[8]; float m = 0.f;
#pragma unroll
        for (int j = 0; j < 8; ++j) { v[j] = src[64 * j]; if (!isup) v[j] = v[j] * ((const f32x4*)F.norm2_g)[lane + 64 * j];
            m = fmaxf(fmaxf(m, fmaxf(fabsf(v[j][0]), fabsf(v[j][1]))), fmaxf(fabsf(v[j][2]), fabsf(v[j][3]))); }
#pragma unroll
        for (int o = 1; o < 64; o <<= 1) m = fmaxf(m, __shfl_xor(m, o));
        const float inv = m > 0.f ? 127.f / m : 0.f; unsigned char* dst = isup ? F.up8 : F.down8; const int bias = isup ? 128 : 0;
#pragma unroll
        for (int j = 0; j < 8; ++j) { unsigned w = 0u;
#pragma unroll
            for (int i = 0; i < 4; ++i) { const int qv = (int)rintf(v[j][i] * inv) + bias; w |= ((unsigned)qv & 0xffu) << (8 * i); }
            const int col = 4 * lane + 256 * j; *(unsigned*)(dst + ((size_t)(col >> 7) * 16384 + e) * 128 + (col & 127)) = w; }
        if (lane == 0) (isup ? F.su : F.sd)[e] = m * (1.f / 127.f); }
    for (size_t i = gt; i < (size_t)8 * 2 * 128 * 128 / 8; i += NT) { const f32x4 a = *(const f32x4*)(F.sub_keys + i * 8), b = *(const f32x4*)(F.sub_keys + i * 8 + 4);
        u32x4 o; o.x = pk2(a[0], a[1]); o.y = pk2(a[2], a[3]); o.z = pk2(b[0], b[1]); o.w = pk2(b[2], b[3]); *(u32x4*)(F.SK + i * 8) = o; }
    for (int m = gw; m < T; m += NGW) { const f32x4* xr = (const f32x4*)(F.x + (size_t)m * DM) + lane; f32x4 v[8]; float s = 0.f;
#pragma unroll
        for (int j = 0; j < 8; ++j) { v[j] = xr[64 * j]; s += (v[j][0] * v[j][0] + v[j][1] * v[j][1]) + (v[j][2] * v[j][2] + v[j][3] * v[j][3]); }
        s = wave_sum(s); u32x2* o8 = (u32x2*)(F.xb + (size_t)m * DM) + lane;
#pragma unroll
        for (int j = 0; j < 8; ++j) { u32x2 w; w.x = pk2(v[j][0], v[j][1]); w.y = pk2(v[j][2], v[j][3]); o8[64 * j] = w; }
        if (lane == 0) F.rs1[m] = __builtin_amdgcn_rsqf(s * (1.f / DM) + EPS); }
    { const double invf[16] = {1.0, 0.44036660267178046, 0.19392274474868576, 0.08539710028576561, 0.03760603093086393, 0.016560440080994446, 0.007292664737217109, 0.003211445994752591,
                               0.001414213562373095, 0.000622772421914596, 0.0002742481756762073, 0.00012076973741146504, 5.318295896944988e-05, 2.341999896140934e-05, 1.031338537721246e-05, 4.5416704806078695e-06};
      for (size_t i = gt; i < (size_t)SEQ * 16; i += NT) { const int pos = (int)(i >> 4), j = (int)(i & 15); double f = 1.0;
#pragma unroll
          for (int q = 0; q < 16; ++q) f = (j == q) ? invf[q] : f;
          const double rev = (double)pos * f * 0.15915494309189535; const float fr = (float)(rev - floor(rev));
          F.rope[i] = (f32x2){__builtin_amdgcn_cosf(fr), __builtin_amdgcn_sinf(fr)}; } }
}

__device__ __forceinline__ void qknorm_rope(const Frame& F) {
    const int gw = F.vcu * 8 + F.wave, NGW = F.G * 8, lane = F.lane, c = lane & 15;
    for (long it = gw; it < (long)T * 24 / 4; it += NGW) { const long row = it * 4 + (lane >> 4); const int t = (int)(row / 24), slot = (int)(row % 24);
        bf16_t* p = F.h + (size_t)t * HP + C_QD + slot * 128 + 8 * c;
        const u32x4 w = *(const u32x4*)p; float y[8] = {bflo(w.x), bfhi(w.x), bflo(w.y), bfhi(w.y), bflo(w.z), bfhi(w.z), bflo(w.w), bfhi(w.w)};
        float ss = 0.f;
#pragma unroll
        for (int e = 0; e < 8; ++e) ss += y[e] * y[e];
        ss += __shfl_xor(ss, 1); ss += __shfl_xor(ss, 2); ss += __shfl_xor(ss, 4); ss += __shfl_xor(ss, 8);
        const float rq = __builtin_amdgcn_rsqf(ss * (1.f / 128.f) + EPS); const float* g = (slot < 12 ? F.qn_g : F.kn_g) + 8 * c;
        const f32x4 g0 = *(const f32x4*)g, g1 = *(const f32x4*)(g + 4);
#pragma unroll
        for (int e = 0; e < 4; ++e) { y[e] *= rq * g0[e]; y[4 + e] *= rq * g1[e]; }
        const int pos = t & (SEQ - 1);
#pragma unroll
        for (int e = 0; e < 8; ++e) { const float partner = __shfl_xor(y[e], 2);
            if (c < 4) { const f32x2 cs = F.rope[(size_t)pos * 16 + 8 * (c & 1) + e]; y[e] = (c < 2) ? (y[e] * cs.x - partner * cs.y) : (y[e] * cs.x + partner * cs.y); } }
        if (slot < 12) {
#pragma unroll
            for (int e = 0; e < 8; ++e) y[e] *= QSCALE; }
        u32x4 o; o.x = pk2(y[0], y[1]); o.y = pk2(y[2], y[3]); o.z = pk2(y[4], y[5]); o.w = pk2(y[6], y[7]); *(u32x4*)p = o; }
}

constexpr int GL_GDS = 0, GL_TOT = 8192, GL_QF = 12288, GL_QB = 21504, GL_KF = 30720, GL_KB = 39936, GL_VT = 49152, GL_P = 67584, GL_SF = 76800, GL_SB = 95232, GL_OB = 12288;
constexpr int RS72 = 144;
__device__ __forceinline__ float logsig(float z) { return fminf(z, 0.f) - flog(1.f + fexp(-fabsf(z))); }
__device__ __forceinline__ void gla_gates(const Frame& F, int b, int hh, int n, float (&bf)[8], float (&bb)[8], float& totf, float& totb) {
    const int tid = F.tid, c = tid & 63, ig = F.wave; LAS float* gds = (LAS float*)(F.lds + GL_GDS); LAS float* tot = (LAS float*)(F.lds + GL_TOT);
    const size_t t0 = (size_t)b * SEQ + (size_t)n * 64;
    if (tid < 256) { const int tk = tid >> 2, part = tid & 3; const u32x4 w = *(const u32x4*)(F.h + (t0 + tk) * HP + C_GF + part * 8); LAS float* d = gds + tk * 32 + part * 8;
        d[0] = bflo(w.x); d[1] = bfhi(w.x); d[2] = bflo(w.y); d[3] = bfhi(w.y); d[4] = bflo(w.z); d[5] = bfhi(w.z); d[6] = bflo(w.w); d[7] = bfhi(w.w); }
    __syncthreads();
    const int hc = hh * 64 + c; float upf[16], upb[16];
#pragma unroll
    for (int r = 0; r < 16; ++r) { upf[r] = F.up_f[r * 256 + hc]; upb[r] = F.up_b[r * 256 + hc]; }
    const float biasf = F.bias_f[hc], biasb = F.bias_b[hc]; float laf[8], lab[8];
#pragma unroll
    for (int e = 0; e < 8; ++e) { const LAS float* gr = gds + (ig * 8 + e) * 32; float zf = biasf, zb = biasb;
#pragma unroll
        for (int r = 0; r < 16; ++r) { zf += gr[r] * upf[r]; zb += gr[16 + r] * upb[r]; }
        laf[e] = logsig(zf) * 0.0625f; lab[e] = logsig(zb) * 0.0625f; }
    bf[0] = laf[0];
#pragma unroll
    for (int e = 1; e < 8; ++e) bf[e] = bf[e - 1] + laf[e];
    bb[7] = lab[7];
#pragma unroll
    for (int e = 6; e >= 0; --e) bb[e] = bb[e + 1] + lab[e];
    tot[ig * 64 + c] = bf[7]; tot[512 + ig * 64 + c] = bb[0];
    __syncthreads();
    float offf = 0.f, offb = 0.f; totf = 0.f; totb = 0.f;
#pragma unroll
    for (int g = 0; g < 8; ++g) { const float tf = tot[g * 64 + c], tb = tot[512 + g * 64 + c]; totf += tf; totb += tb; offf += (g < ig) ? tf : 0.f; offb += (g > ig) ? tb : 0.f; }
#pragma unroll
    for (int e = 0; e < 8; ++e) { bf[e] += offf; bb[e] += offb; }
}
__device__ __forceinline__ void gla_stage_vT(const Frame& F, size_t t0, int hh) {
#pragma unroll
    for (int j = 0; j < 2; ++j) { const int q = F.tid + 512 * j, tk = q >> 4, vc = (q & 15) * 8; const bf16x8 v = *(const bf16x8*)(F.h + (t0 + tk) * HP + C_VA + hh * 128 + vc);
        LAS short* d = (LAS short*)(F.lds + GL_VT) + vc * 72 + tk;
#pragma unroll
        for (int e = 0; e < 8; ++e) d[e * 72] = v[e]; }
}
__device__ __forceinline__ bf16x8 ldfrag(const LAS unsigned char* base, int row, int s, int hi) { return *(const LAS bf16x8*)(base + row * RS72 + (16 * s + 8 * hi) * 2); }

__device__ __forceinline__ void gla_passA(const Frame& F, int item) {
    const int bh = item >> 8, n = item & 255, b = bh >> 2, hh = bh & 3, tid = F.tid, c = tid & 63, ig = F.wave, lane = F.lane, r32 = lane & 31, hi = lane >> 5;
    float bf[8], bb[8], totf, totb; gla_gates(F, b, hh, n, bf, bb, totf, totb);
    const size_t t0 = (size_t)b * SEQ + (size_t)n * 64;
    float kf[8], kb[8];
#pragma unroll
    for (int e = 0; e < 8; ++e) { const float k = bf2f(F.h[(t0 + ig * 8 + e) * HP + C_KA + hh * 64 + c]); kf[e] = k * fexp(totf - bf[e]); kb[e] = k * fexp(totb - bb[e]); }
    { u32x4 o; o.x = pk2(kf[0], kf[1]); o.y = pk2(kf[2], kf[3]); o.z = pk2(kf[4], kf[5]); o.w = pk2(kf[6], kf[7]); *(LAS u32x4*)(F.lds + GL_KF + c * RS72 + ig * 16) = o;
      o.x = pk2(kb[0], kb[1]); o.y = pk2(kb[2], kb[3]); o.z = pk2(kb[4], kb[5]); o.w = pk2(kb[6], kb[7]); *(LAS u32x4*)(F.lds + GL_KB + c * RS72 + ig * 16) = o; }
    gla_stage_vT(F, t0, hh);
    if (ig == 0) { F.dec[((size_t)(0 * 8 + bh) * 256 + n) * 64 + c] = fexp(totf); F.dec[((size_t)(1 * 8 + bh) * 256 + n) * 64 + c] = fexp(totb); }
    __syncthreads();
    const int dir = F.wave >> 2, vt = F.wave & 3; const LAS unsigned char* kimg = F.lds + (dir ? GL_KB : GL_KF);
    f32x16 a0 = {}, a1 = {};
#pragma unroll
    for (int s = 0; s < 4; ++s) { const bf16x8 av = ldfrag(F.lds + GL_VT, 32 * vt + r32, s, hi), b0 = ldfrag(kimg, r32, s, hi), b1 = ldfrag(kimg, 32 + r32, s, hi);
        a0 = __builtin_amdgcn_mfma_f32_32x32x16_bf16(av, b0, a0, 0, 0, 0); a1 = __builtin_amdgcn_mfma_f32_32x32x16_bf16(av, b1, a1, 0, 0, 0); }
    float* st = F.state + ((size_t)(dir * 8 + bh) * 256 + n) * 8192;
#pragma unroll
    for (int r = 0; r < 16; ++r) { const int v = 32 * vt + crow(r, hi); st[v * 64 + r32] = a0[r]; st[v * 64 + 32 + r32] = a1[r]; }
    __syncthreads();
}
__device__ __forceinline__ void gla_scan(const Frame& F, int item) {
    const int dir = item >> 7, bh = (item >> 4) & 7, e = (item & 15) * 512 + F.tid, c = e & 63;
    float* st = F.state + (size_t)(dir * 8 + bh) * 256 * 8192 + e; const float* dc = F.dec + (size_t)(dir * 8 + bh) * 256 * 64 + c; float S = 0.f;
    for (int g = 0; g < 32; ++g) { float inc[8], d[8];
#pragma unroll
        for (int j = 0; j < 8; ++j) { const int n = dir ? 255 - (g * 8 + j) : g * 8 + j; inc[j] = st[(size_t)n * 8192]; d[j] = dc[n * 64]; }
#pragma unroll
        for (int j = 0; j < 8; ++j) { const int n = dir ? 255 - (g * 8 + j) : g * 8 + j; st[(size_t)n * 8192] = S; S = d[j] * S + inc[j]; } }
}
__device__ __forceinline__ void gla_passC(const Frame& F, int item) {
    const int bh = item >> 8, n = item & 255, b = bh >> 2, hh = bh & 3, tid = F.tid, c = tid & 63, ig = F.wave, lane = F.lane, r32 = lane & 31, hi = lane >> 5;
    float bf[8], bb[8], totf, totb; gla_gates(F, b, hh, n, bf, bb, totf, totb);
    const size_t t0 = (size_t)b * SEQ + (size_t)n * 64;
#pragma unroll
    for (int e = 0; e < 8; ++e) { const int i = ig * 8 + e; const bf16_t* hr = F.h + (t0 + i) * HP + hh * 64 + c; const float q = bf2f(hr[C_QA]) * 0.125f, k = bf2f(hr[C_KA]);
        const float ef = fexp(bf[e]), eb = fexp(bb[e]), nf = fexp(-bf[e]), nb = fexp(-bb[e]);
        *(LAS unsigned short*)(F.lds + GL_QF + i * RS72 + c * 2) = (unsigned short)f2bf(q * ef); *(LAS unsigned short*)(F.lds + GL_QB + i * RS72 + c * 2) = (unsigned short)f2bf(q * eb);
        *(LAS unsigned short*)(F.lds + GL_KF + i * RS72 + c * 2) = (unsigned short)f2bf(k * nf); *(LAS unsigned short*)(F.lds + GL_KB + i * RS72 + c * 2) = (unsigned short)f2bf(k * nb); }
    gla_stage_vT(F, t0, hh);
#pragma unroll
    for (int dir = 0; dir < 2; ++dir) { const float* st = F.state + ((size_t)(dir * 8 + bh) * 256 + n) * 8192; LAS unsigned char* img = F.lds + (dir ? GL_SB : GL_SF);
#pragma unroll
        for (int j = 0; j < 4; ++j) { const int q4 = tid + 512 * j, v = q4 >> 4, c4 = (q4 & 15) * 4; const f32x4 s = *(const f32x4*)(st + v * 64 + c4);
            u32x2 w; w.x = pk2(s[0], s[1]); w.y = pk2(s[2], s[3]); *(LAS u32x2*)(img + v * RS72 + c4 * 2) = w; } }
    __syncthreads();
    if (F.wave < 4) { const int ti = F.wave >> 1, tj = F.wave & 1; f32x16 sf = {}, sb = {};
#pragma unroll
        for (int s = 0; s < 4; ++s) {
            sf = __builtin_amdgcn_mfma_f32_32x32x16_bf16(ldfrag(F.lds + GL_QF, 32 * ti + r32, s, hi), ldfrag(F.lds + GL_KF, 32 * tj + r32, s, hi), sf, 0, 0, 0);
            sb = __builtin_amdgcn_mfma_f32_32x32x16_bf16(ldfrag(F.lds + GL_QB, 32 * ti + r32, s, hi), ldfrag(F.lds + GL_KB, 32 * tj + r32, s, hi), sb, 0, 0, 0); }
#pragma unroll
        for (int r = 0; r < 16; ++r) { const int i = 32 * ti + crow(r, hi), j = 32 * tj + r32; const float p = (j <= i) ? sf[r] : sb[r];
            *(LAS unsigned short*)(F.lds + GL_P + i * RS72 + j * 2) = (unsigned short)f2bf(p); } }
    __syncthreads();
    const int ti = F.wave & 1, tv = F.wave >> 1; f32x16 o = {};
#pragma unroll
    for (int s = 0; s < 4; ++s) o = __builtin_amdgcn_mfma_f32_32x32x16_bf16(ldfrag(F.lds + GL_P, 32 * ti + r32, s, hi), ldfrag(F.lds + GL_VT, 32 * tv + r32, s, hi), o, 0, 0, 0);
#pragma unroll
    for (int s = 0; s < 4; ++s) o = __builtin_amdgcn_mfma_f32_32x32x16_bf16(ldfrag(F.lds + GL_QF, 32 * ti + r32, s, hi), ldfrag(F.lds + GL_SF, 32 * tv + r32, s, hi), o, 0, 0, 0);
#pragma unroll
    for (int s = 0; s < 4; ++s) o = __builtin_amdgcn_mfma_f32_32x32x16_bf16(ldfrag(F.lds + GL_QB, 32 * ti + r32, s, hi), ldfrag(F.lds + GL_SB, 32 * tv + r32, s, hi), o, 0, 0, 0);
    __syncthreads();
    LAS float* ob = (LAS float*)(F.lds + GL_OB);
#pragma unroll
    for (int r = 0; r < 16; ++r) ob[(32 * ti + crow(r, hi)) * 132 + 32 * tv + r32] = o[r];
    __syncthreads();
    { const int i = tid >> 3, part = tid & 7, v0 = part * 16; float ov[16], ss = 0.f;
#pragma unroll
      for (int e = 0; e < 16; ++e) { ov[e] = ob[i * 132 + v0 + e]; ss += ov[e] * ov[e]; }
      ss += __shfl_xor(ss, 1); ss += __shfl_xor(ss, 2); ss += __shfl_xor(ss, 4);
      const float rs = __builtin_amdgcn_rsqf(ss * (1.f / 128.f) + EPS); const size_t tok = t0 + i;
      const u32x4 r0 = *(const u32x4*)(F.h + tok * HP + C_RA + hh * 128 + v0), r1 = *(const u32x4*)(F.h + tok * HP + C_RA + hh * 128 + v0 + 8);
      const float rr[16] = {bflo(r0.x), bfhi(r0.x), bflo(r0.y), bfhi(r0.y), bflo(r0.z), bfhi(r0.z), bflo(r0.w), bfhi(r0.w), bflo(r1.x), bfhi(r1.x), bflo(r1.y), bfhi(r1.y), bflo(r1.z), bfhi(r1.z), bflo(r1.w), bfhi(r1.w)};
      float y[16];
#pragma unroll
      for (int e = 0; e < 16; ++e) { const float g = F.out_g[hh * 128 + v0 + e]; const float sil = rr[e] * __builtin_amdgcn_rcpf(1.f + fexp(-rr[e])); y[e] = ov[e] * rs * g * sil; }
      u32x4 w0, w1; w0.x = pk2(y[0], y[1]); w0.y = pk2(y[2], y[3]); w0.z = pk2(y[4], y[5]); w0.w = pk2(y[6], y[7]); w1.x = pk2(y[8], y[9]); w1.y = pk2(y[10], y[11]); w1.z = pk2(y[12], y[13]); w1.w = pk2(y[14], y[15]);
      bf16_t* mp = F.mixed + tok * DM + hh * 128 + v0; *(u32x4*)mp = w0; *(u32x4*)(mp + 8) = w1; }
    __syncthreads();
}

constexpr int AT_V = 0, AT_K = 32768, AT_O = 65536;
#define KSWZ(row, colB) ((row) * 256 + ((colB) ^ (((row) & 7) << 4)))
__device__ __forceinline__ int v_st(int k, int c) { const int kk = (k & ~0xC) | ((k & 4) << 1) | ((k & 8) >> 1); return ((kk >> 3) * 4 + (c >> 5)) * 512 + ((kk & 7) * 32 + (c & 31)) * 2; }
__device__ __forceinline__ int v_rd_base(int lane) { return ((lane & 3) << 3) | (((lane >> 2) & 3) << 6) | (((lane >> 4) & 1) << 5) | (((lane >> 5) & 1) << 8); }
constexpr int v_rd_off(int d0, int ks, int half) { return d0 * 512 + ks * 4096 + half * 2048; }
template <int OFF> __device__ __forceinline__ s16x4 tr_read(int vb) { s16x4 r; asm volatile("ds_read_b64_tr_b16 %0, %1 offset:%2" : "=&v"(r) : "v"(vb), "i"(OFF) : "memory"); return r; }
template <int D0> __device__ __forceinline__ void pv_one(f32x16& od, int vb, bf16x8 pa0, bf16x8 pa1, bf16x8 pa2, bf16x8 pa3) {
    const s16x4 l0 = tr_read<v_rd_off(D0, 0, 0)>(vb), h0 = tr_read<v_rd_off(D0, 0, 1)>(vb), l1 = tr_read<v_rd_off(D0, 1, 0)>(vb), h1 = tr_read<v_rd_off(D0, 1, 1)>(vb);
    const s16x4 l2 = tr_read<v_rd_off(D0, 2, 0)>(vb), h2 = tr_read<v_rd_off(D0, 2, 1)>(vb), l3 = tr_read<v_rd_off(D0, 3, 0)>(vb), h3 = tr_read<v_rd_off(D0, 3, 1)>(vb);
    asm volatile("s_waitcnt lgkmcnt(0)" ::: "memory"); SBAR();
#define PKV(L, H) (bf16x8){L[0], L[1], L[2], L[3], H[0], H[1], H[2], H[3]}
    od = __builtin_amdgcn_mfma_f32_32x32x16_bf16(pa0, PKV(l0, h0), od, 0, 0, 0);
    od = __builtin_amdgcn_mfma_f32_32x32x16_bf16(pa1, PKV(l1, h1), od, 0, 0, 0);
    od = __builtin_amdgcn_mfma_f32_32x32x16_bf16(pa2, PKV(l2, h2), od, 0, 0, 0);
    od = __builtin_amdgcn_mfma_f32_32x32x16_bf16(pa3, PKV(l3, h3), od, 0, 0, 0);
#undef PKV
}
__device__ __forceinline__ void attn_item(const Frame& F, int item) {
    const int tid = F.tid, wid = F.wave, lane = F.lane, r32 = lane & 31, hi = lane >> 5;
    const int p = item / 1536, rem = item % 1536, b = rem / 768, rem2 = rem % 768, head = rem2 >> 6, u = rem2 & 63;
    const int dsh = 2 * p, dil = 1 << dsh, L = SEQ >> dsh, runs = 64 >> dsh, res = u / runs, m0 = (u % runs) * 256;
    const size_t tokbase = (size_t)b * SEQ + res;
    bf16_t* Op = (bf16_t*)(p == 0 ? (unsigned char*)F.out + OUT_OP0 : F.wsb + (p == 1 ? WS_OP1 : WS_OP2));
    const bf16_t* hq = F.h + C_QD + head * 128; const bf16_t* hk = F.h + C_KD + head * 128; const bf16_t* hv = F.h + C_VD + head * 128;
    const int Q0 = m0 + 32 * wid;
    bf16x8 qr[8];
    { const bf16_t* qp = hq + (tokbase + (size_t)dil * (Q0 + r32)) * HP + hi * 8;
#pragma unroll
      for (int d0 = 0; d0 < 8; ++d0) qr[d0] = *(const bf16x8*)(qp + d0 * 16); }
    const int sr = tid >> 4, sc = (tid & 15) * 8, vst0 = v_st(sr, sc), vst1 = v_st(32 + sr, sc), kc = sc * 2;
    const int vb0 = (int)(unsigned)(uintptr_t)(F.ldsg + AT_V) + v_rd_base(lane);
    const int kt_lo = (m0 == 0) ? 1 : 0, kt_hi = (m0 + 256 >= L) ? 4 : 5;
    f32x16 o[4] = {}; float l_reg = 0.f;
    bf16x8 sv0, sv1, sk0, sk1;
#define AT_SLOAD(T0) do { const size_t ra = (tokbase + (size_t)dil * ((T0) + sr)) * HP + sc, rb = (tokbase + (size_t)dil * ((T0) + 32 + sr)) * HP + sc; \
        sv0 = *(const bf16x8*)(hv + ra); sv1 = *(const bf16x8*)(hv + rb); sk0 = *(const bf16x8*)(hk + ra); sk1 = *(const bf16x8*)(hk + rb); } while (0)
#define AT_SWRITE(B) do { *(LAS bf16x8*)(F.lds + AT_V + (B) * 16384 + vst0) = sv0; *(LAS bf16x8*)(F.lds + AT_V + (B) * 16384 + vst1) = sv1; \
        *(LAS bf16x8*)(F.lds + AT_K + (B) * 16384 + KSWZ(sr, kc)) = sk0; *(LAS bf16x8*)(F.lds + AT_K + (B) * 16384 + KSWZ(32 + sr, kc)) = sk1; } while (0)
    AT_SLOAD(m0 - 64 + 64 * kt_lo); AT_SWRITE(0); __syncthreads();
    int buf = 0;
    for (int kt = kt_lo; kt <= kt_hi; ++kt) {
        const int T0 = m0 - 64 + 64 * kt; const bool more = kt < kt_hi;
        if (more) AT_SLOAD(T0 + 64);
        if (T0 + 63 >= Q0 - 64 && T0 <= Q0 + 95) {
            const LAS unsigned char* Ks = F.lds + AT_K + buf * 16384; f32x16 p0 = {}, p1 = {};
#pragma unroll
            for (int d0 = 0; d0 < 8; ++d0) { const int cb = (d0 * 16 + hi * 8) * 2;
                const bf16x8 k0 = *(const LAS bf16x8*)(Ks + KSWZ(r32, cb)), k1 = *(const LAS bf16x8*)(Ks + KSWZ(32 + r32, cb));
                p0 = __builtin_amdgcn_mfma_f32_32x32x16_bf16(k0, qr[d0], p0, 0, 0, 0); p1 = __builtin_amdgcn_mfma_f32_32x32x16_bf16(k1, qr[d0], p1, 0, 0, 0); }
            const int dq = T0 - (Q0 + r32); float ps = 0.f;
#pragma unroll
            for (int r = 0; r < 16; ++r) { const int e0 = dq + crow(r, hi), e1 = e0 + 32;
                p0[r] = (e0 >= -64 && e0 <= 64) ? __builtin_amdgcn_exp2f(p0[r]) : 0.f; p1[r] = (e1 >= -64 && e1 <= 64) ? __builtin_amdgcn_exp2f(p1[r]) : 0.f; ps += p0[r] + p1[r]; }
            l_reg += ps;
            bf16x8 pa0, pa1, pa2, pa3;
#define PK4(P, BASE, OUT) do { unsigned a0_ = pk2(P[BASE + 0], P[BASE + 1]), a1_ = pk2(P[BASE + 2], P[BASE + 3]); unsigned b0_ = pk2(P[BASE + 4], P[BASE + 5]), b1_ = pk2(P[BASE + 6], P[BASE + 7]); \
        auto r0_ = __builtin_amdgcn_permlane32_swap(a0_, b0_, false, false); auto r1_ = __builtin_amdgcn_permlane32_swap(a1_, b1_, false, false); \
        u32x4 w_ = {r0_[0], r1_[0], r0_[1], r1_[1]}; OUT = __builtin_bit_cast(bf16x8, w_); } while (0)
            PK4(p0, 0, pa0); PK4(p0, 8, pa1); PK4(p1, 0, pa2); PK4(p1, 8, pa3);
#undef PK4
            const int vb = vb0 + buf * 16384;
            pv_one<0>(o[0], vb, pa0, pa1, pa2, pa3); pv_one<1>(o[1], vb, pa0, pa1, pa2, pa3); pv_one<2>(o[2], vb, pa0, pa1, pa2, pa3); pv_one<3>(o[3], vb, pa0, pa1, pa2, pa3);
        }
        if (more) AT_SWRITE(buf ^ 1);
        __syncthreads(); buf ^= 1;
    }
#undef AT_SLOAD
#undef AT_SWRITE
    l_reg += __shfl_xor(l_reg, 32);
    if (hi == 0) F.lp[((size_t)p * T + tokbase + (size_t)dil * (Q0 + r32)) * NHD + head] = l_reg;
    LAS unsigned char* stg = F.lds + AT_O + wid * 8192;
#pragma unroll
    for (int d0 = 0; d0 < 4; ++d0)
#pragma unroll
        for (int r = 0; r < 16; ++r) *(LAS unsigned short*)(stg + (crow(r, hi) * 128 + d0 * 32 + r32) * 2) = (unsigned short)f2bf(o[d0][r]);
    LDS_WAIT(); asm volatile("" ::: "memory");
#pragma unroll
    for (int it = 0; it < 8; ++it) { const int row = 4 * it + (lane >> 4), ch = lane & 15; const u32x4 w = *(const LAS u32x4*)(stg + row * 256 + ch * 16);
        *(u32x4*)(Op + (tokbase + (size_t)dil * (Q0 + row)) * (NHD * 128) + head * 128 + ch * 8) = w; }
    __syncthreads();
}
__device__ __forceinline__ void dil_combine(const Frame& F) {
    const int gw = F.vcu * 8 + F.wave, NGW = F.G * 8, lane = F.lane, c = lane & 15;
    for (long it = gw; it < (long)T * NHD / 4; it += NGW) { const long row = it * 4 + (lane >> 4); const size_t tok = (size_t)(row / NHD); const int head = (int)(row % NHD);
        const float l = F.lp[tok * NHD + head] + F.lp[((size_t)T + tok) * NHD + head] + F.lp[((size_t)2 * T + tok) * NHD + head]; const float inv = 1.f / l;
        const size_t off = tok * (NHD * 128) + head * 128 + 8 * c; const u32x4 a = *(const u32x4*)(F.op0 + off), b = *(const u32x4*)(F.op1 + off), d = *(const u32x4*)(F.op2 + off);
        u32x4 o; o.x = pk2((bflo(a.x) + bflo(b.x) + bflo(d.x)) * inv, (bfhi(a.x) + bfhi(b.x) + bfhi(d.x)) * inv); o.y = pk2((bflo(a.y) + bflo(b.y) + bflo(d.y)) * inv, (bfhi(a.y) + bfhi(b.y) + bfhi(d.y)) * inv);
        o.z = pk2((bflo(a.z) + bflo(b.z) + bflo(d.z)) * inv, (bfhi(a.z) + bfhi(b.z) + bfhi(d.z)) * inv); o.w = pk2((bflo(a.w) + bflo(b.w) + bflo(d.w)) * inv, (bfhi(a.w) + bfhi(b.w) + bfhi(d.w)) * inv);
        *(u32x4*)(F.mixed + tok * DM + 512 + head * 128 + 8 * c) = o; }
}

__device__ __forceinline__ unsigned fl_flip(float x) { const unsigned u = __float_as_uint(x); return u ^ ((unsigned)((int)u >> 31) | 0x80000000u); }
__device__ __forceinline__ float fl_unflip(unsigned w) { return __uint_as_float((w & 0x80000000u) ? (w ^ 0x80000000u) : ~w); }
#define CE_DESC(a, b) do { const unsigned x_ = max(a, b), y_ = min(a, b); a = x_; b = y_; } while (0)
__device__ __forceinline__ void sort16_desc(unsigned (&a)[16]) {
#pragma unroll
    for (int k = 2; k <= 16; k <<= 1)
#pragma unroll
        for (int j = k >> 1; j > 0; j >>= 1)
#pragma unroll
            for (int i = 0; i < 16; ++i) { const int l = i ^ j; if (l > i) { const unsigned x = max(a[i], a[l]), y = min(a[i], a[l]); if ((i & k) == 0) { a[i] = x; a[l] = y; } else { a[i] = y; a[l] = x; } } }
}
__device__ __forceinline__ void bmerge16_desc(unsigned (&a)[16]) {
#pragma unroll
    for (int j = 8; j > 0; j >>= 1)
#pragma unroll
        for (int i = 0; i < 16; ++i) { const int l = i ^ j; if (l > i) CE_DESC(a[i], a[l]); }
}
__device__ __forceinline__ void top16_merge(unsigned (&a)[16], const unsigned (&b)[16]) {
#pragma unroll
    for (int i = 0; i < 16; ++i) a[i] = max(a[i], b[15 - i]);
    bmerge16_desc(a);
}
__device__ __forceinline__ void top16_partner(unsigned (&a)[16]) {
    unsigned b[16];
#pragma unroll
    for (int i = 0; i < 16; ++i) b[i] = (unsigned)__shfl_xor((int)a[i], 32);
    top16_merge(a, b);
}
__device__ constexpr unsigned char stair(int n) {
    constexpr unsigned char L[64] = {0x00,0x01,0x02,0x03,0x04,0x05,0x06,0x07,0x08,0x09,0x0a,0x0b,0x0c,0x0d,0x0e,0x0f,0x10,0x11,0x12,0x13,0x14,0x15,0x16,0x17,0x20,0x21,0x22,0x23,0x24,0x30,0x31,0x32,
                                     0x33,0x40,0x41,0x42,0x50,0x51,0x60,0x61,0x70,0x71,0x80,0x90,0xa0,0xb0,0xc0,0xd0,0xe0,0xf0,0xff,0xff,0xff,0xff,0xff,0xff,0xff,0xff,0xff,0xff,0xff,0xff,0xff,0xff};
    return L[n];
}
__device__ __forceinline__ void topk_item(const Frame& F, int item) {
    const int lane = F.lane, r32 = lane & 31, hi = lane >> 5, hh = item & 7, tok0 = (item >> 3) * 32; const size_t tok = (size_t)tok0 + r32;
    LAS int* ktab = (LAS int*)(F.lds + F.wave * 4096) + r32 * 32;
    float ss = 0.f;
    { const f32x4* sp = (const f32x4*)(F.ssp + tok * 32 + hi * 16);
#pragma unroll
      for (int j = 0; j < 4; ++j) { const f32x4 v = sp[j]; ss += (v[0] + v[1]) + (v[2] + v[3]); } }
    ss += __shfl_xor(ss, 32);
    const float rs2 = __builtin_amdgcn_rsqf(ss * (1.f / DM) + EPS);
    if (hh == 0 && hi == 0) F.rs2[tok] = rs2;
    unsigned top[2][16];
#pragma unroll
    for (int cc = 0; cc < 2; ++cc) {
        f32x16 acc[4] = {};
        const bf16_t* qp = F.qry + tok * DM + hh * 256 + cc * 128 + hi * 8; const bf16_t* kp = F.SK + ((size_t)(hh * 2 + cc) * 128 + r32) * 128 + hi * 8;
#pragma unroll 2
        for (int s = 0; s < 8; ++s) { const bf16x8 qf = *(const bf16x8*)(qp + 16 * s);
#pragma unroll
            for (int kt = 0; kt < 4; ++kt) { const bf16x8 kf = *(const bf16x8*)(kp + (size_t)kt * 32 * 128 + 16 * s); acc[kt] = __builtin_amdgcn_mfma_f32_32x32x16_bf16(kf, qf, acc[kt], 0, 0, 0); } }
        unsigned g[4][16];
#pragma unroll
        for (int kt = 0; kt < 4; ++kt) {
#pragma unroll
            for (int r = 0; r < 16; ++r) g[kt][r] = (fl_flip(acc[kt][r]) & ~127u) | (unsigned)(127 - (32 * kt + crow(r, hi)));
            sort16_desc(g[kt]); }
        top16_merge(g[0], g[1]); top16_merge(g[2], g[3]); top16_merge(g[0], g[2]); top16_partner(g[0]);
#pragma unroll
        for (int i = 0; i < 16; ++i) top[cc][i] = g[0][i];
    }
#pragma unroll
    for (int i = 0; i < 16; ++i) ktab[hi * 16 + i] = 127 - (int)((hi ? top[1][i] : top[0][i]) & 127u);
    float s0[16], s1[16];
#pragma unroll
    for (int i = 0; i < 16; ++i) { s0[i] = fl_unflip(top[0][i] & ~127u); s1[i] = fl_unflip(top[1][i] & ~127u); }
    unsigned ca[16], cb[16];
#pragma unroll
    for (int n = 0; n < 32; ++n) { const int A = stair(n), B = stair(25 + n); unsigned va = 0u, vb = 0u;
        if (n < 25) { va = (fl_flip(s0[A >> 4] + s1[A & 15]) & ~255u) | (unsigned)(255 - A); vb = (fl_flip(s0[B >> 4] + s1[B & 15]) & ~255u) | (unsigned)(255 - B); }
        const unsigned v = hi ? vb : va; if (n < 16) ca[n] = v; else cb[n - 16] = v; }
    sort16_desc(ca); sort16_desc(cb); top16_merge(ca, cb); top16_partner(ca);
    float e[16], sum = 0.f; const float mx = fl_unflip(ca[0] & ~255u) * rs2;
#pragma unroll
    for (int i = 0; i < 16; ++i) { e[i] = fexp(fl_unflip(ca[i] & ~255u) * rs2 - mx); sum += e[i]; }
    const float inv = 1.f / sum;
    LDS_WAIT(); asm volatile("" ::: "memory");
    int oi[8]; float og[8];
#pragma unroll
    for (int k = 0; k < 8; ++k) { const unsigned cv = hi ? ca[8 + k] : ca[k]; const int code = 255 - (int)(cv & 255u); og[k] = (hi ? e[8 + k] : e[k]) * inv; oi[k] = ktab[code >> 4] * 128 + ktab[16 + (code & 15)]; }
    { int* ip = F.idx + tok * 128 + hh * 16 + hi * 8; float* gp = F.gate + tok * 128 + hh * 16 + hi * 8;
      *(int4*)ip = make_int4(oi[0], oi[1], oi[2], oi[3]); *(int4*)(ip + 4) = make_int4(oi[4], oi[5], oi[6], oi[7]);
      *(f32x4*)gp = (f32x4){og[0], og[1], og[2], og[3]}; *(f32x4*)(gp + 4) = (f32x4){og[4], og[5], og[6], og[7]}; }
    LDS_WAIT(); asm volatile("" ::: "memory");
}

constexpr int PS_NSL = 16, PS_CW = DM / PS_NSL, PS_SUB = PS_NSL / 8, PS_TG = 32, PS_NTG = T / PS_TG;
__device__ __forceinline__ float gelu_tanh(float x) { const float u = 0.7978845608028654f * (x + 0.044715f * x * x * x); const float t = 1.f - 2.f * __builtin_amdgcn_rcpf(1.f + fexp(2.f * u)); return 0.5f * x * (1.f + t); }
__device__ __forceinline__ int dot16i(u32x4 w, u32x4 x) { int p = __builtin_amdgcn_sdot4((int)w.x, (int)x.x, 0, false); p = __builtin_amdgcn_sdot4((int)w.y, (int)x.y, p, false); p = __builtin_amdgcn_sdot4((int)w.z, (int)x.z, p, false); return __builtin_amdgcn_sdot4((int)w.w, (int)x.w, p, false); }
__device__ __forceinline__ unsigned xcc_id() { return (unsigned)__builtin_amdgcn_s_getreg((3 << 11) | 20) & 7u; }
__device__ __forceinline__ bool peer_claim(unsigned* cnt, unsigned x, unsigned& d, int lane, int& q, int& tg) {
    while (d < 8u) { const unsigned xq = (x + d) & 7u; unsigned u = 0u;
        if (lane == 0) u = __hip_atomic_fetch_add(cnt + 64 * xq, 1u, __ATOMIC_RELAXED, __HIP_MEMORY_SCOPE_AGENT);
        u = (unsigned)__builtin_amdgcn_readfirstlane((int)u);
        if (u < (unsigned)(PS_SUB * PS_NTG)) { q = (int)(u / PS_NTG) * 8 + (int)xq; tg = (int)(u % PS_NTG); return true; }
        ++d; }
    return false;
}
template <int CTRL> __device__ __forceinline__ float dppmov(float x) { return __int_as_float(__builtin_amdgcn_update_dpp(0, __float_as_int(x), CTRL, 0xf, 0xf, true)); }
template <int CTRL> __device__ __forceinline__ int dppmovi(int x) { return __builtin_amdgcn_update_dpp(0, x, CTRL, 0xf, 0xf, true); }
__device__ __forceinline__ int bperm(int srclane, int v) { return __builtin_amdgcn_ds_bpermute(srclane << 2, v); }
__device__ __forceinline__ void peer_quant_x(const Frame& F) {
    const int gw = F.vcu * 8 + F.wave, NGW = F.G * 8, lane = F.lane;
    for (int tok = gw; tok < T; tok += NGW) { const u32x4* xr = (const u32x4*)(F.x1b + (size_t)tok * DM) + lane; float v[4][8]; float m = 0.f;
#pragma unroll
        for (int j = 0; j < 4; ++j) { const u32x4 w = xr[64 * j]; v[j][0] = bflo(w.x); v[j][1] = bfhi(w.x); v[j][2] = bflo(w.y); v[j][3] = bfhi(w.y); v[j][4] = bflo(w.z); v[j][5] = bfhi(w.z); v[j][6] = bflo(w.w); v[j][7] = bfhi(w.w);
#pragma unroll
            for (int i = 0; i < 8; ++i) m = fmaxf(m, fabsf(v[j][i])); }
#pragma unroll
        for (int o = 1; o < 64; o <<= 1) m = fmaxf(m, __shfl_xor(m, o));
        const float inv = m > 0.f ? 127.f / m : 0.f;
#pragma unroll
        for (int j = 0; j < 4; ++j) { u32x2 w = {0u, 0u};
#pragma unroll
            for (int i = 0; i < 4; ++i) { w.x |= ((unsigned)(int)rintf(v[j][i] * inv) & 0xffu) << (8 * i); w.y |= ((unsigned)(int)rintf(v[j][4 + i] * inv) & 0xffu) << (8 * i); }
            *(u32x2*)(F.xq8 + (size_t)tok * DM + 8 * lane + 512 * j) = w; }
        if (lane == 0) F.sx[tok] = m * (1.f / 127.f); }
}
__device__ __forceinline__ void peer_down(const Frame& F, int cntw = 1024) {
    const int lane = F.lane, g = lane >> 3, c = lane & 7; const unsigned x = xcc_id(); unsigned d = 0u; int q, tg; unsigned* cnt = (unsigned*)(F.wsb + WS_CTL) + cntw;
    const unsigned char* tab = F.down8; const unsigned char* xb = F.xq8;
    while (peer_claim(cnt, x, d, lane, q, tg)) {
        const unsigned colb = (unsigned)(q * PS_CW + 16 * c), slb = (unsigned)q * (16384u * 128u) + 16u * c; int* part = F.part + (size_t)q * T * 128; const size_t tok0 = (size_t)tg * PS_TG;
        u32x4 wA[16], wB[16], xA, xB; int iA0, iA1, iB0, iB1;
#define PD_IDX(i0, i1, tok) do { const int* ip_ = F.idx + (tok) * 128 + lane; i0 = ip_[0]; i1 = ip_[64]; } while (0)
#define PD_ROWS(W_, X_, i0, i1, tok) do { _Pragma("unroll") for (int j = 0; j < 16; ++j) { const unsigned e_ = (unsigned)bperm(8 * (j & 7) + g, j < 8 ? i0 : i1); \
            W_[j] = *(const u32x4*)(tab + (e_ * 128u + slb)); } X_ = *(const u32x4*)(xb + (tok) * DM + colb); } while (0)
#define PD_COMP(W_, X_, tok) do { int p[16]; _Pragma("unroll") for (int j = 0; j < 16; ++j) p[j] = dot16i(W_[j], X_); \
            int a1[8], a2[4], a3[2]; \
            _Pragma("unroll") for (int i = 0; i < 8; ++i) { const int keep = (c & 1) ? p[2 * i + 1] : p[2 * i], give = (c & 1) ? p[2 * i] : p[2 * i + 1]; a1[i] = keep + dppmovi<0xB1>(give); } \
            _Pragma("unroll") for (int i = 0; i < 4; ++i) { const int keep = (c & 2) ? a1[2 * i + 1] : a1[2 * i], give = (c & 2) ? a1[2 * i] : a1[2 * i + 1]; a2[i] = keep + dppmovi<0x4E>(give); } \
            _Pragma("unroll") for (int i = 0; i < 2; ++i) { const int keep = (c & 4) ? a2[2 * i + 1] : a2[2 * i], give = (c & 4) ? a2[2 * i] : a2[2 * i + 1]; a3[i] = keep + __shfl_xor(give, 4); } \
            part[(tok) * 128 + 8 * c + g] = a3[0]; part[(tok) * 128 + 64 + 8 * c + g] = a3[1]; } while (0)
        PD_IDX(iA0, iA1, tok0); PD_IDX(iB0, iB1, tok0 + 1);
        PD_ROWS(wA, xA, iA0, iA1, tok0);
        for (int tt = 0; tt < PS_TG; tt += 2) { const size_t tok = tok0 + tt;
            PD_ROWS(wB, xB, iB0, iB1, tok + 1);
            const size_t t2 = tok + (tt + 2 < PS_TG ? 2 : 0), t3 = tok + (tt + 2 < PS_TG ? 3 : 1);
            PD_IDX(iA0, iA1, t2);
            PD_COMP(wA, xA, tok);
            PD_ROWS(wA, xA, iA0, iA1, t2);
            PD_IDX(iB0, iB1, t3);
            PD_COMP(wB, xB, tok + 1);
        }
#undef PD_IDX
#undef PD_ROWS
#undef PD_COMP
    }
}
__device__ __forceinline__ void peer_coef_probe(const Frame& F, bool dry) {
    const int gw = F.vcu * 8 + F.wave, NGW = F.G * 8, lane = F.lane;
    for (int tok = gw; tok < T; tok += NGW) { int a0 = 0, a1 = 0; const int* pp = F.part + (size_t)tok * 128 + lane;
#pragma unroll
        for (int q = 0; q < PS_NSL; ++q) { a0 += pp[(size_t)q * T * 128]; a1 += pp[(size_t)q * T * 128 + 64]; }
        const float sc = F.rs2[tok] * F.sx[tok]; float* gp = F.gate + (size_t)tok * 128 + lane; const int e0 = F.idx[(size_t)tok * 128 + lane], e1 = F.idx[(size_t)tok * 128 + 64 + lane];
        const float c0 = gp[0] * gelu_tanh((float)a0 * sc * F.sd[e0]) * F.su[e0], c1 = gp[64] * gelu_tanh((float)a1 * sc * F.sd[e1]) * F.su[e1];
        float* wp = dry ? (float*)(F.wsb + WS_PART + 256 * MiB) + (size_t)tok * 128 + lane : gp; wp[0] = c0; wp[64] = c1;
        const float cs = wave_sum(c0 + c1); if (lane == 0 && !dry) F.csum[tok] = 128.f * cs; }
}
__device__ __forceinline__ void peer_up(const Frame& F, int cntw = 2048, bool dry = false) {
    const int lane = F.lane, g = lane >> 3, c = lane & 7; const unsigned x = xcc_id(); unsigned d = 0u; int q, tg; unsigned* cnt = (unsigned*)(F.wsb + WS_CTL) + cntw;
    const unsigned char* tab = F.up8;
    while (peer_claim(cnt, x, d, lane, q, tg)) {
        const unsigned slb = (unsigned)q * (16384u * 128u) + 16u * c; const int col0 = q * PS_CW + 16 * c; const size_t tok0 = (size_t)tg * PS_TG;
        u32x4 wA[16], wB[16]; int iA0, iA1, iB0, iB1; float cA0, cA1, cB0, cB1; float fA[16], fB[16];
#define PU_IDX(i0, i1, c0, c1, tok) do { const size_t o_ = (tok) * 128 + lane; i0 = F.idx[o_]; i1 = F.idx[o_ + 64]; c0 = F.gate[o_]; c1 = F.gate[o_ + 64]; } while (0)
#define PU_ROWS(W_, F_, i0, i1, c0, c1) do { _Pragma("unroll") for (int j = 0; j < 16; ++j) { const int src_ = 8 * (j & 7) + g; const unsigned e_ = (unsigned)bperm(src_, j < 8 ? i0 : i1); \
            F_[j] = __int_as_float(bperm(src_, __float_as_int(j < 8 ? c0 : c1))); W_[j] = *(const u32x4*)(tab + (e_ * 128u + slb)); } } while (0)
#define PU_B4(A_, WW_, FF_) do { A_[0] += FF_ * (float)((WW_) & 0xffu); A_[1] += FF_ * (float)(((WW_) >> 8) & 0xffu); A_[2] += FF_ * (float)(((WW_) >> 16) & 0xffu); A_[3] += FF_ * (float)((WW_) >> 24); } while (0)
#define PU_COMP(W_, F_, tok) do { float acc[4][4] = {}; \
            _Pragma("unroll") for (int j = 0; j < 16; ++j) { PU_B4(acc[0], W_[j].x, F_[j]); PU_B4(acc[1], W_[j].y, F_[j]); PU_B4(acc[2], W_[j].z, F_[j]); PU_B4(acc[3], W_[j].w, F_[j]); } \
            _Pragma("unroll") for (int i = 0; i < 4; ++i) _Pragma("unroll") for (int b_ = 0; b_ < 4; ++b_) { float v_ = acc[i][b_]; v_ += dppmov<0x128>(v_); v_ += __shfl_xor(v_, 16); v_ += __shfl_xor(v_, 32); acc[i][b_] = v_; } \
            if (g == 0) { const float cs_ = F.csum[tok]; float* op = F.out + (tok) * DM + col0; float* dp = dry ? (float*)(F.wsb + WS_PART) + ((tok) & 16383) * DM + col0 : op; \
                _Pragma("unroll") for (int i = 0; i < 4; ++i) { f32x4 v0 = *(const f32x4*)(op + 4 * i); v0[0] += acc[i][0] - cs_; v0[1] += acc[i][1] - cs_; v0[2] += acc[i][2] - cs_; v0[3] += acc[i][3] - cs_; *(f32x4*)(dp + 4 * i) = v0; } } } while (0)
        PU_IDX(iA0, iA1, cA0, cA1, tok0); PU_IDX(iB0, iB1, cB0, cB1, tok0 + 1);
        PU_ROWS(wA, fA, iA0, iA1, cA0, cA1);
        for (int tt = 0; tt < PS_TG; tt += 2) { const size_t tok = tok0 + tt;
            PU_ROWS(wB, fB, iB0, iB1, cB0, cB1);
            const size_t t2 = tok + (tt + 2 < PS_TG ? 2 : 0), t3 = tok + (tt + 2 < PS_TG ? 3 : 1);
            PU_IDX(iA0, iA1, cA0, cA1, t2);
            PU_COMP(wA, fA, tok);
            PU_ROWS(wA, fA, iA0, iA1, cA0, cA1);
            PU_IDX(iB0, iB1, cB0, cB1, t3);
            PU_COMP(wB, fB, tok + 1);
        }
#undef PU_IDX
#undef PU_ROWS
#undef PU_B4
#undef PU_COMP
    }
}

struct Args { const float* in[16]; float* out; unsigned char* ws; int ph_lo, ph_hi, coop, pad; };
__global__ void __launch_bounds__(512, 2) fwd_kernel(Args args) {
    extern __shared__ __attribute__((aligned(16))) unsigned char lds_raw[];
    Frame F;
    F.lds = (LAS unsigned char*)lds_raw; F.ldsg = (char*)lds_raw;
    F.tid = threadIdx.x; F.lane = F.tid & 63; F.wave = __builtin_amdgcn_readfirstlane(F.tid >> 6);
    F.G = gridDim.x; { const int bx = blockIdx.x; F.vcu = (F.G % 8 == 0) ? (bx % 8) * (F.G / 8) + bx / 8 : bx; }
    F.x = args.in[0]; F.norm1_g = args.in[1]; F.w_in = args.in[2]; F.up_f = args.in[3]; F.bias_f = args.in[4]; F.up_b = args.in[5]; F.bias_b = args.in[6]; F.out_g = args.in[7];
    F.qn_g = args.in[8]; F.kn_g = args.in[9]; F.w_out = args.in[10]; F.norm2_g = args.in[11]; F.w_query = args.in[12]; F.sub_keys = args.in[13]; F.peer_down = args.in[14]; F.peer_up = args.in[15];
    F.out = args.out; unsigned char* ws = args.ws; F.wsb = ws;
    F.rope = (f32x2*)(ws + WS_ROPE); F.rs1 = (float*)(ws + WS_RS1); F.rs2 = (float*)(ws + WS_RS2); F.ssp = (float*)(ws + WS_SSP); F.dec = (float*)(ws + WS_DEC); F.lp = (float*)(ws + WS_LP);
    F.gate = (float*)(ws + WS_GATE); F.part = (int*)(ws + WS_PART); F.sd = (float*)(ws + WS_CTL + 65536); F.su = (float*)(ws + WS_CTL + 131072); F.sx = (float*)(ws + WS_RS2 + 131072); F.csum = (float*)(ws + WS_RS2 + 262144);
    F.down8 = ws + WS_DOWN; F.up8 = ws + WS_UP; F.xq8 = ws + WS_XB; F.idx = (int*)(ws + WS_IDX); F.state = (float*)((unsigned char*)args.out + OUT_ST);
    F.WinT = (bf16_t*)(ws + WS_WIN); F.WoT = (bf16_t*)(ws + WS_WO); F.WqT = (bf16_t*)(ws + WS_WQ); F.SK = (bf16_t*)(ws + WS_SK); F.down16 = (bf16_t*)(ws + WS_DOWN); F.up16 = (bf16_t*)(ws + WS_UP);
    F.xb = (bf16_t*)(ws + WS_XB); F.mixed = (bf16_t*)(ws + WS_XB); F.h = (bf16_t*)(ws + WS_H); F.x1b = (bf16_t*)(ws + WS_X1B); F.qry = (bf16_t*)(ws + WS_QRY);
    F.op0 = (bf16_t*)((unsigned char*)args.out + OUT_OP0); F.op1 = (bf16_t*)(ws + WS_OP1); F.op2 = (bf16_t*)(ws + WS_OP2);
    const int lo = args.ph_lo, hi = args.ph_hi;
#ifndef PH_MASK
#define PH_MASK 0x7ff
#endif
#ifndef PROBE_PHASE
#define PROBE_PHASE -1
#endif
#define REP(k) for (int rep_ = 0; rep_ < ((PROBE_PHASE == (k)) ? 2 : 1); ++rep_)
#define IN(k) (((PH_MASK >> (k)) & 1) && lo <= (k) && (k) < hi)
#define SEAM(k) do { if (IN(k) && IN((k) + 1)) { if (args.coop) cg::this_grid().sync(); } } while (0)
    if (IN(0)) { REP(0) phase0(F); } SEAM(0);
    if (IN(1)) REP(1) { pg8::Gemm g{F.xb, F.WinT, T, HP, DM}; pg8::StaticOrder S; S.init(T, HP, F.G, (int)blockIdx.x); pg8::EpiRowScaleBf16 E{F.h, HP, F.rs1};
        pg8::gemm_phase<pg8::EpiRowScaleBf16, pg8::StaticOrder, PG8_ALIGN, PG8_SP2>(F.lds, g, S, E); } SEAM(1);
    if (IN(2)) { qknorm_rope(F); for (int it = F.vcu; it < 2048; it += F.G) gla_passA(F, it); } SEAM(2);
    if (IN(3)) { for (int it = F.vcu; it < 256; it += F.G) gla_scan(F, it); REP(3) for (int it = F.vcu; it < 4608; it += F.G) attn_item(F, it); } SEAM(3);
    if (IN(4)) REP(4) { for (int it = F.vcu; it < 2048; it += F.G) gla_passC(F, it); dil_combine(F); } SEAM(4);
    if (IN(5)) REP(5) { pg8::Gemm g{F.mixed, F.WoT, T, DM, DM}; pg8::StaticOrder S; S.init(T, DM, F.G, (int)blockIdx.x); pg8::EpiResid E{F.x, F.out, F.x1b, F.ssp, DM};
        pg8::gemm_phase<pg8::EpiResid, pg8::StaticOrder, PG8_ALIGN, PG8_SP2>(F.lds, g, S, E); } SEAM(5);
    if (IN(6)) REP(6) { pg8::Gemm g{F.x1b, F.WqT, T, DM, DM}; pg8::StaticOrder S; S.init(T, DM, F.G, (int)blockIdx.x); pg8::EpiRowScaleBf16 E{F.qry, DM, nullptr};
        pg8::gemm_phase<pg8::EpiRowScaleBf16, pg8::StaticOrder, PG8_ALIGN, PG8_SP2>(F.lds, g, S, E); } SEAM(6);
    if (IN(7)) REP(7) { const int gw = F.vcu * 8 + F.wave, NGW = F.G * 8; for (int it = gw; it < (T / 32) * 8; it += NGW) topk_item(F, it); if (rep_ == 0) peer_quant_x(F); } SEAM(7);
    if (IN(8)) { if (PROBE_PHASE == 8) peer_down(F, 3072); peer_down(F); } SEAM(8);
    if (IN(9)) { REP(9) peer_coef_probe(F, (PROBE_PHASE == 9) && rep_ == 0); } SEAM(9);
    if (IN(10)) { if (PROBE_PHASE == 10) peer_up(F, 3584, true); peer_up(F); }
#undef IN
#undef SEAM
}

#ifndef MK_N_LAUNCHES
#define MK_N_LAUNCHES 1
#endif
extern "C" void kernel_launch(void* const* d_in, const int* in_sizes, int n_in, void* d_out, int out_size, void* d_ws, size_t ws_size, hipStream_t stream) {
    static int grid = 0;
    if (grid == 0) {
        if (n_in != 16 || in_sizes[0] != T * DM || out_size != T * DM || ws_size < WS_END) { fprintf(stderr, "kernel_launch: unexpected shapes (n_in %d, in0 %d, out %d, ws %zu)\n", n_in, n_in > 0 ? in_sizes[0] : -1, out_size, ws_size); grid = -1; return; }
        int dev = 0, cus = 0, per_cu = 0;
        if (hipGetDevice(&dev) != hipSuccess || hipDeviceGetAttribute(&cus, hipDeviceAttributeMultiprocessorCount, dev) != hipSuccess) { grid = -1; return; }
        if (hipFuncSetAttribute((const void*)fwd_kernel, hipFuncAttributeMaxDynamicSharedMemorySize, LDS_BYTES) != hipSuccess) { fprintf(stderr, "kernel_launch: hipFuncSetAttribute failed\n"); grid = -1; return; }
        if (hipOccupancyMaxActiveBlocksPerMultiprocessor(&per_cu, (const void*)fwd_kernel, 512, LDS_BYTES) != hipSuccess || per_cu < 1) { fprintf(stderr, "kernel_launch: occupancy query says %d\n", per_cu); per_cu = 1; }
        (void)hipGetLastError();
        grid = cus;
    }
    if (grid < 0) return;
    Args a{};
    for (int i = 0; i < 16; ++i) a.in[i] = (const float*)d_in[i];
    a.out = (float*)d_out; a.ws = (unsigned char*)d_ws;
    if (MK_N_LAUNCHES == 1) {
        a.ph_lo = 0; a.ph_hi = NPHASE; a.coop = 1; void* kargs[] = {&a};
        hipError_t e = hipLaunchCooperativeKernel((const void*)fwd_kernel, dim3(grid), dim3(512), kargs, LDS_BYTES, stream);
        if (e != hipSuccess) fprintf(stderr, "kernel_launch: cooperative launch failed: %s (grid %d)\n", hipGetErrorString(e), grid);
    } else {
        for (int p = 0; p < NPHASE; ++p) { a.ph_lo = p; a.ph_hi = p + 1; a.coop = 0; hipLaunchKernelGGL(fwd_kernel, dim3(grid), dim3(512), LDS_BYTES, stream, a); }
        const hipError_t le = hipPeekAtLastError(); if (le != hipSuccess) fprintf(stderr, "kernel_launch: launch failed: %s\n", hipGetErrorName(le));
    }
}
```

```cpp
#include <hip/hip_runtime.h>
#include <hip/hip_cooperative_groups.h>
#include <cstdio>
#include <cstdint>
namespace cg = cooperative_groups;
namespace pg8 {
#define PG8_LAS __attribute__((address_space(3)))
typedef unsigned short bf16_t;
typedef short bf16x8 __attribute__((ext_vector_type(8)));
typedef float f32x4 __attribute__((ext_vector_type(4)));
typedef unsigned u32x4 __attribute__((ext_vector_type(4)));
constexpr int BM = 256, BK = 64, HALF = 128, HTB = HALF * BK * 2  , STAGE_BYTES = 8 * HTB, NXCD = 8, WGM = 8;

__host__ __device__ __forceinline__ int lds_byte(int r, int c) { const int st = (r >> 4) * 2 + (c >> 5), rr = r & 15, cc = c & 31, ob = rr * 64 + cc * 2; return st * 1024 + (ob ^ (((ob >> 9) & 1) << 5)); }
__host__ __device__ __forceinline__ void stage_rc(int b, int& R, int& C) { const int st = b / 1024, sb = b % 1024, swz = sb ^ (((sb >> 9) & 1) << 5); R = (st >> 1) * 16 + swz / 64; C = (st & 1) * 32 + (swz % 64) / 2; }
__host__ __device__ __forceinline__ int perm32(int rho) { const int n = rho >> 4, i = rho & 15; return 8 * (i >> 2) + 4 * n + (i & 3); }

struct Unit { int pm, pn; };
struct Gemm { const bf16_t* A; const bf16_t* Bt; int M, N, K; };

struct StaticOrder {
    int nM, nN, nwg, G, c;
    __host__ __device__ void init(int M, int N, int G_, int c_) { nM = M / BM; nN = N / BM; nwg = nM * nN; G = G_; c = c_; }
    __host__ __device__ bool next(int i, Unit& u) const {
        const long L = (long)i * G + c; if (L >= nwg) return false;
        int wgid = (int)L; { const int q = nwg / NXCD, r = nwg % NXCD, xcd = wgid % NXCD, off = wgid / NXCD; wgid = (xcd < r ? xcd * (q + 1) : r * (q + 1) + (xcd - r) * q) + off; }
        const int nig = WGM * nN, gid = wgid / nig, fm = gid * WGM, gsz = (nM - fm) < WGM ? (nM - fm) : WGM;
        u.pm = fm + ((wgid % nig) % gsz); u.pn = (wgid % nig) / gsz; return true;
    }
    __device__ __forceinline__ void a_ready(const Unit&) const {}
    __device__ __forceinline__ void done(const Unit&) const {}
};
__device__ __forceinline__ unsigned cvt_pk_bf16(float lo, float hi) { unsigned r; asm volatile("v_cvt_pk_bf16_f32 %0, %1, %2" : "=v"(r) : "v"(lo), "v"(hi)); return r; }
struct EpiRowScaleBf16 {
    static constexpr bool PERM = true, AFTER_DRAIN = false;
    bf16_t* O; int ldc; const float* rs;
    __device__ __forceinline__ void operator()(const f32x4 (&acc)[2][2][4][2], const Unit& u, int wr, int wc, int fr, int fq) const {
        const int row0 = u.pm * BM + wr * 64 + fr, col0 = u.pn * BM + wc * 32 + 8 * fq;
#pragma unroll
        for (int ai = 0; ai < 2; ++ai)
#pragma unroll
            for (int m = 0; m < 4; ++m) { const int row = row0 + ai * HALF + m * 16; const float s = rs ? rs[row] : 1.f; bf16_t* rowp = O + (size_t)row * ldc + col0;
#pragma unroll
                for (int bj = 0; bj < 2; ++bj) { const f32x4 v0 = acc[ai][bj][m][0] * s, v1 = acc[ai][bj][m][1] * s;
                    u32x4 w; w.x = cvt_pk_bf16(v0[0], v0[1]); w.y = cvt_pk_bf16(v0[2], v0[3]); w.z = cvt_pk_bf16(v1[0], v1[1]); w.w = cvt_pk_bf16(v1[2], v1[3]);
                    *(u32x4*)(rowp + bj * HALF) = w; } }
    }
};
struct EpiResid {
    static constexpr bool PERM = true, AFTER_DRAIN = false;
    const float* x; float* out; bf16_t* xb; float* ssp; int ldc;
    __device__ __forceinline__ void operator()(const f32x4 (&acc)[2][2][4][2], const Unit& u, int wr, int wc, int fr, int fq) const {
        const int row0 = u.pm * BM + wr * 64 + fr, col0 = u.pn * BM + wc * 32 + 8 * fq;
#pragma unroll
        for (int ai = 0; ai < 2; ++ai)
#pragma unroll
            for (int m = 0; m < 4; ++m) { const int row = row0 + ai * HALF + m * 16; const size_t off = (size_t)row * ldc + col0; float ss = 0.f;
#pragma unroll
                for (int bj = 0; bj < 2; ++bj) { const f32x4 xa = *(const f32x4*)(x + off + bj * HALF), xc = *(const f32x4*)(x + off + bj * HALF + 4);
                    const f32x4 v0 = acc[ai][bj][m][0] + xa, v1 = acc[ai][bj][m][1] + xc;
                    *(f32x4*)(out + off + bj * HALF) = v0; *(f32x4*)(out + off + bj * HALF + 4) = v1;
                    u32x4 w; w.x = cvt_pk_bf16(v0[0], v0[1]); w.y = cvt_pk_bf16(v0[2], v0[3]); w.z = cvt_pk_bf16(v1[0], v1[1]); w.w = cvt_pk_bf16(v1[2], v1[3]);
                    *(u32x4*)(xb + off + bj * HALF) = w;
                    ss += (v0[0] * v0[0] + v0[1] * v0[1]) + (v0[2] * v0[2] + v0[3] * v0[3]) + (v1[0] * v1[0] + v1[1] * v1[1]) + (v1[2] * v1[2] + v1[3] * v1[3]); }
                ss += __shfl_xor(ss, 16); ss += __shfl_xor(ss, 32);
                if (fq == 0) ssp[(size_t)row * 32 + u.pn * 4 + wc] = ss; }
    }
};
template <class Epi, class Sched, bool ALIGN_EPI = false, bool SP2 = false>
__device__ __forceinline__ void gemm_phase(PG8_LAS unsigned char* lds, const Gemm g, const Sched& S, const Epi& E) {
    const int tid = threadIdx.x, wid = __builtin_amdgcn_readfirstlane(tid >> 6), lane = tid & 63, wr = wid >> 2, wc = wid & 3, fr = lane & 15, fq = lane >> 4;
    const int K = g.K, nt = K / BK;
    unsigned voffA[2], voffB[2];
#pragma unroll
    for (int i = 0; i < 2; ++i) { int R, C; stage_rc(tid * 16 + i * 8192, R, C); const int Rb = Epi::PERM ? ((R & ~31) + perm32(R & 31)) : R;
        voffA[i] = (unsigned)(R * K + C) * 2u; voffB[i] = (unsigned)(Rb * K + C) * 2u; }
    const size_t kstep = (size_t)(BK * 2);
    const size_t hstep = (size_t)HALF * K * 2;
    const size_t tstep = 2 * hstep;
    const unsigned ldsw = (unsigned)wid * 1024u;
    const int aoff = lds_byte(wr * 64 + fr, fq * 8), boff = lds_byte(wc * 32 + fr, fq * 8);
#define PG8_SA(b, h) (((b) * 2 + (h)) * HTB)
#define PG8_SB(b, h) ((4 + (b) * 2 + (h)) * HTB)
#define PG8_STAGE(bufoff, gbase, voff) do { _Pragma("unroll") for (int _i = 0; _i < 2; ++_i) \
        __builtin_amdgcn_global_load_lds((const unsigned*)((const char*)(gbase) + (voff)[_i]), (PG8_LAS unsigned*)(lds + (bufoff) + ldsw + _i * 8192), 16, 0, 0); } while (0)
#define PG8_LDA(dst, b, h) do { _Pragma("unroll") for (int m = 0; m < 4; ++m) _Pragma("unroll") for (int k = 0; k < 2; ++k) dst[m][k] = *(const PG8_LAS bf16x8*)(lds + PG8_SA(b, h) + aoff + m * 2048 + k * 1024); } while (0)
#define PG8_LDB(dst, b, h) do { _Pragma("unroll") for (int n = 0; n < 2; ++n) _Pragma("unroll") for (int k = 0; k < 2; ++k) dst[n][k] = *(const PG8_LAS bf16x8*)(lds + PG8_SB(b, h) + boff + n * 2048 + k * 1024); } while (0)
#define PG8_MMA(ai, bj, At, Bt) do { __builtin_amdgcn_s_setprio(1); _Pragma("unroll") for (int m = 0; m < 4; ++m) _Pragma("unroll") for (int n = 0; n < 2; ++n) _Pragma("unroll") for (int k = 0; k < 2; ++k) \
        acc[ai][bj][m][n] = __builtin_amdgcn_mfma_f32_16x16x32_bf16(Bt[n][k], At[m][k], acc[ai][bj][m][n], 0, 0, 0); __builtin_amdgcn_s_setprio(0); } while (0)
#define PG8_WAIT_V(n) asm volatile("s_waitcnt vmcnt(" #n ")" ::: "memory")
#define PG8_WAIT_L(n) asm volatile("s_waitcnt lgkmcnt(" #n ")" ::: "memory")
#define PG8_BAR __builtin_amdgcn_s_barrier()
#define PG8_SCHED __builtin_amdgcn_sched_barrier(0)
    Unit cur, nxt; int ui = 0;
    if (!S.next(0, cur)) return;
    f32x4 acc[2][2][4][2];
#pragma unroll
    for (int a = 0; a < 2; ++a)
#pragma unroll
        for (int b = 0; b < 2; ++b)
#pragma unroll
            for (int m = 0; m < 4; ++m)
#pragma unroll
                for (int n = 0; n < 2; ++n) acc[a][b][m][n] = (f32x4){0.f, 0.f, 0.f, 0.f};
    bf16x8 At[4][2], B0[2][2], B1[2][2];
    const char* cA = (const char*)g.A + (size_t)cur.pm * tstep; const char* cB = (const char*)g.Bt + (size_t)cur.pn * tstep;
    S.a_ready(cur);
    if constexpr (SP2) {
        PG8_STAGE(PG8_SB(0, 0), cB, voffB); PG8_STAGE(PG8_SB(0, 1), cB + hstep, voffB); PG8_STAGE(PG8_SA(0, 0), cA, voffA); PG8_STAGE(PG8_SA(0, 1), cA + hstep, voffA);
        if (wr == 1) PG8_BAR;
        PG8_WAIT_V(2); PG8_BAR;
        PG8_STAGE(PG8_SB(1, 0), cB + kstep, voffB); PG8_STAGE(PG8_SA(1, 0), cA + kstep, voffA); PG8_STAGE(PG8_SB(1, 1), cB + hstep + kstep, voffB);
        PG8_WAIT_V(6); PG8_BAR;
    } else {
        PG8_STAGE(PG8_SB(0, 0), cB, voffB); PG8_STAGE(PG8_SA(0, 0), cA, voffA); PG8_STAGE(PG8_SB(0, 1), cB + hstep, voffB); PG8_STAGE(PG8_SA(0, 1), cA + hstep, voffA);
        if (wr == 1) PG8_BAR;
        PG8_WAIT_V(4); PG8_BAR;
        PG8_STAGE(PG8_SB(1, 0), cB + kstep, voffB); PG8_STAGE(PG8_SA(1, 0), cA + kstep, voffA); PG8_STAGE(PG8_SB(1, 1), cB + hstep + kstep, voffB);
        PG8_WAIT_V(6); PG8_BAR;
    }
    for (;;) {
        const bool has_next = S.next(ui + 1, nxt);
        const char* nA = has_next ? (const char*)g.A + (size_t)nxt.pm * tstep : cA; const char* nB = has_next ? (const char*)g.Bt + (size_t)nxt.pn * tstep : cB;
        for (int t = 0; t < nt; t += 2) {
            const bool last = (t == nt - 2);
            const char* a1 = cA + (size_t)(t + 1) * kstep;
            const char* a2 = last ? nA : cA + (size_t)(t + 2) * kstep; const char* b2 = last ? nB : cB + (size_t)(t + 2) * kstep;
            const char* a3 = a2 + kstep; const char* b3 = b2 + kstep;
            if (last && has_next) S.a_ready(nxt);
            if constexpr (SP2) {
            PG8_LDB(B0, 0, 0); PG8_LDB(B1, 0, 1); PG8_SCHED; PG8_LDA(At, 0, 0); PG8_STAGE(PG8_SA(1, 1), a1 + hstep, voffA);
            PG8_WAIT_V(8); PG8_WAIT_L(0); PG8_BAR; PG8_MMA(0, 0, At, B0); PG8_MMA(0, 1, At, B1); PG8_BAR; PG8_SCHED;
            PG8_LDA(At, 0, 1); PG8_STAGE(PG8_SB(0, 0), b2, voffB); PG8_STAGE(PG8_SB(0, 1), b2 + hstep, voffB); PG8_STAGE(PG8_SA(0, 0), a2, voffA);
            PG8_WAIT_V(8); PG8_WAIT_L(0); PG8_BAR; PG8_MMA(1, 0, At, B0); PG8_MMA(1, 1, At, B1); PG8_BAR; PG8_SCHED;
            PG8_LDB(B0, 1, 0); PG8_LDB(B1, 1, 1); PG8_SCHED; PG8_LDA(At, 1, 0); PG8_STAGE(PG8_SA(0, 1), a2 + hstep, voffA);
            PG8_WAIT_V(8); PG8_WAIT_L(0); PG8_BAR; PG8_MMA(0, 0, At, B0); PG8_MMA(0, 1, At, B1); PG8_BAR; PG8_SCHED;
            PG8_LDA(At, 1, 1); PG8_STAGE(PG8_SB(1, 0), b3, voffB); PG8_STAGE(PG8_SB(1, 1), b3 + hstep, voffB); PG8_STAGE(PG8_SA(1, 0), a3, voffA);
            PG8_WAIT_V(8); PG8_WAIT_L(0); PG8_BAR; PG8_MMA(1, 0, At, B0); PG8_MMA(1, 1, At, B1); PG8_BAR; PG8_SCHED;
            } else {
            PG8_LDB(B0, 0, 0); PG8_SCHED; PG8_LDA(At, 0, 0); PG8_STAGE(PG8_SA(1, 1), a1 + hstep, voffA);
            PG8_WAIT_L(8); PG8_BAR; PG8_WAIT_L(0); PG8_MMA(0, 0, At, B0); PG8_BAR; PG8_SCHED;
            PG8_LDB(B1, 0, 1); PG8_STAGE(PG8_SB(0, 0), b2, voffB);
            PG8_BAR; PG8_WAIT_L(0); PG8_MMA(0, 1, At, B1); PG8_BAR;
            PG8_LDA(At, 0, 1); PG8_STAGE(PG8_SA(0, 0), a2, voffA);
            PG8_BAR; PG8_WAIT_L(0); PG8_MMA(1, 0, At, B0); PG8_BAR; PG8_SCHED;
            PG8_STAGE(PG8_SB(0, 1), b2 + hstep, voffB);
            PG8_WAIT_V(6); PG8_BAR; PG8_MMA(1, 1, At, B1); PG8_BAR;
            PG8_LDB(B0, 1, 0); PG8_SCHED; PG8_LDA(At, 1, 0); PG8_STAGE(PG8_SA(0, 1), a2 + hstep, voffA);
            PG8_WAIT_L(8); PG8_BAR; PG8_WAIT_L(0); PG8_MMA(0, 0, At, B0); PG8_BAR; PG8_SCHED;
            PG8_LDB(B1, 1, 1); PG8_STAGE(PG8_SB(1, 0), b3, voffB);
            PG8_BAR; PG8_WAIT_L(0); PG8_MMA(0, 1, At, B1); PG8_BAR;
            PG8_LDA(At, 1, 1); PG8_STAGE(PG8_SA(1, 0), a3, voffA);
            PG8_BAR; PG8_WAIT_L(0); PG8_MMA(1, 0, At, B0); PG8_BAR; PG8_SCHED;
            PG8_STAGE(PG8_SB(1, 1), b3 + hstep, voffB);
            PG8_WAIT_V(6); PG8_BAR; PG8_MMA(1, 1, At, B1); PG8_BAR;
            }
        }
        if constexpr (ALIGN_EPI) { if (wr == 0) PG8_BAR; }
        if constexpr (!Epi::AFTER_DRAIN) { E(acc, cur, wr, wc, fr, fq); S.done(cur); }
        if (!has_next) break;
#pragma unroll
        for (int a = 0; a < 2; ++a)
#pragma unroll
            for (int b = 0; b < 2; ++b)
#pragma unroll
                for (int m = 0; m < 4; ++m)
#pragma unroll
                    for (int n = 0; n < 2; ++n) acc[a][b][m][n] = (f32x4){0.f, 0.f, 0.f, 0.f};
        cur = nxt; cA = nA; cB = nB; ++ui;
        if constexpr (ALIGN_EPI) { if (wr == 1) PG8_BAR; }
    }
    PG8_WAIT_V(0);
    if constexpr (!ALIGN_EPI) { if (wr == 0) PG8_BAR; }
    PG8_BAR;
    if constexpr (Epi::AFTER_DRAIN) { E.fused(acc, cur, wr, wc, fr, fq, lds, wid, lane); S.done(cur); }
#undef PG8_SA
#undef PG8_SB
#undef PG8_STAGE
#undef PG8_LDA
#undef PG8_LDB
#undef PG8_MMA
#undef PG8_WAIT_V
#undef PG8_WAIT_L
#undef PG8_BAR
#undef PG8_SCHED
}
}
#ifndef PG8_SP2
#define PG8_SP2 true
#endif
#ifndef PG8_ALIGN
#define PG8_ALIGN true
#endif

constexpr int BATCH = 2, SEQ = 16384, DM = 2048, T = BATCH * SEQ;
constexpr int INW = 6176, HP = 6400;
constexpr int C_QA = 0, C_KA = 256, C_VA = 512, C_RA = 1024, C_QD = 1536, C_KD = 3072, C_VD = 4608, C_GF = 6144;
constexpr int NHD = 12;
constexpr float EPS = 1e-6f;
constexpr float LOG2E = 1.4426950408889634f;
constexpr float QSCALE = 0.08838834764831845f * LOG2E;
constexpr int NPHASE = 11;

constexpr size_t MiB = 1u << 20;
constexpr size_t WS_CTL = 0, WS_ROPE = 1 * MiB, WS_RS1 = 3 * MiB, WS_RS2 = 3 * MiB + 512 * 1024, WS_SSP = 4 * MiB, WS_WIN = 8 * MiB, WS_WO = 33 * MiB, WS_WQ = 41 * MiB,
                 WS_SK = 49 * MiB, WS_DEC = 50 * MiB, WS_LP = 51 * MiB, WS_IDX = 56 * MiB, WS_GATE = 72 * MiB, WS_DOWN = 88 * MiB, WS_UP = 152 * MiB, WS_XB = 216 * MiB,
                 WS_H = 344 * MiB, WS_X1B = WS_H, WS_QRY = WS_H + 128 * MiB, WS_OP1 = 744 * MiB, WS_OP2 = 840 * MiB, WS_PART = 472 * MiB  , WS_END = 984 * MiB;
constexpr size_t OUT_ST = 0, OUT_OP0 = 128 * MiB;
constexpr int LDS_BYTES = 147456;

#define LAS __attribute__((address_space(3)))
typedef unsigned short bf16_t;
typedef short bf16x8 __attribute__((ext_vector_type(8)));
typedef short s16x4 __attribute__((ext_vector_type(4)));
typedef float f32x4 __attribute__((ext_vector_type(4)));
typedef float f32x2 __attribute__((ext_vector_type(2)));
typedef float f32x16 __attribute__((ext_vector_type(16)));
typedef unsigned u32x4 __attribute__((ext_vector_type(4)));
typedef unsigned u32x2 __attribute__((ext_vector_type(2)));
#define LDS_WAIT() asm volatile("s_waitcnt lgkmcnt(0)" ::: "memory")
#define SBAR() __builtin_amdgcn_sched_barrier(0)

__device__ __forceinline__ float bf2f(unsigned short b) { return __uint_as_float(((unsigned)b) << 16); }
__device__ __forceinline__ float bflo(unsigned w) { return __uint_as_float(w << 16); }
__device__ __forceinline__ float bfhi(unsigned w) { return __uint_as_float(w & 0xffff0000u); }
__device__ __forceinline__ unsigned f2bf(float f) { unsigned u = __float_as_uint(f); return (u + 0x7fffu + ((u >> 16) & 1u)) >> 16; }
__device__ __forceinline__ unsigned pk2(float lo, float hi) { return pg8::cvt_pk_bf16(lo, hi); }
__device__ __forceinline__ float fexp(float x) { return __builtin_amdgcn_exp2f(x * LOG2E); }
__device__ __forceinline__ float flog(float x) { return __builtin_amdgcn_logf(x) * 0.6931471805599453f; }
__device__ __forceinline__ float wave_sum(float v) {
#pragma unroll
    for (int o = 1; o < 64; o <<= 1) v += __shfl_xor(v, o);
    return v;
}
__device__ __forceinline__ int crow(int r, int hi) { return (r & 3) + 8 * (r >> 2) + 4 * hi; }

struct Frame {
    LAS unsigned char* lds; char* ldsg; unsigned char* wsb;
    int tid, lane, wave, vcu, G;
    const float *x, *norm1_g, *w_in, *up_f, *bias_f, *up_b, *bias_b, *out_g, *qn_g, *kn_g, *w_out, *norm2_g, *w_query, *sub_keys, *peer_down, *peer_up;
    float* out;
    f32x2* rope; float *rs1, *rs2, *ssp, *dec, *lp, *gate, *state, *sd, *su, *sx, *csum; int *idx, *part; unsigned char *down8, *up8, *xq8, *fq8;
    bf16_t *WinT, *WoT, *WqT, *SK, *down16, *up16, *xb, *mixed, *h, *x1b, *qry, *op0, *op1, *op2;
};

__device__ __forceinline__ void p0_transpose_item(const float* W, int K, int N, bf16_t* WT, int k0, int n0, int dst_row0, const float* g, LAS float* scr, int lane) {
#pragma unroll 8
    for (int i = 0; i < 32; ++i) { const int kk = 2 * i + (lane >> 5); float w = W[(size_t)(k0 + kk) * N + n0 + (lane & 31)]; if (g) w *= g[k0 + kk]; scr[kk * 33 + (lane & 31)] = w; }
    LDS_WAIT(); asm volatile("" ::: "memory");
    const int c = lane & 7;
#pragma unroll
    for (int j = 0; j < 4; ++j) { const int n = (lane >> 3) + 8 * j; const LAS float* s = scr + (8 * c) * 33 + n;
        u32x4 o; o.x = pk2(s[0 * 33], s[1 * 33]); o.y = pk2(s[2 * 33], s[3 * 33]); o.z = pk2(s[4 * 33], s[5 * 33]); o.w = pk2(s[6 * 33], s[7 * 33]);
        *(u32x4*)(WT + (size_t)(dst_row0 + n) * K + k0 + 8 * c) = o; }
    LDS_WAIT(); asm volatile("" ::: "memory");
}
__device__ __forceinline__ void phase0(const Frame& F) {
    LAS float* scr = (LAS float*)(F.lds + F.wave * 16384);
    const int gw = F.vcu * 8 + F.wave, NGW = F.G * 8, lane = F.lane;
    if (F.vcu == 0) { unsigned* ctl = (unsigned*)(F.wsb + WS_CTL); for (int i = F.tid; i < 4096; i += 512) ctl[i] = 0u; }
    constexpr int I_IN = 32 * 193, I_O = 32 * 64, I_Q = 32 * 64;
    for (int it = gw; it < I_IN + I_O + I_Q; it += NGW) {
        int r = it;
        if (r < I_IN) { const int kb = r / 193, nb = r % 193; const int drow = nb < 32 ? nb * 32 : (nb == 32 ? C_GF : nb * 32 - 32);
            p0_transpose_item(F.w_in, DM, INW, F.WinT, kb * 64, nb * 32, drow, F.norm1_g, scr, lane); continue; }
        r -= I_IN;
        if (r < I_O) { const int kb = r / 64, nb = r % 64; p0_transpose_item(F.w_out, DM, DM, F.WoT, kb * 64, nb * 32, nb * 32, nullptr, scr, lane); continue; }
        r -= I_O;
        { const int kb = r / 64, nb = r % 64; p0_transpose_item(F.w_query, DM, DM, F.WqT, kb * 64, nb * 32, nb * 32, F.norm2_g, scr, lane); }
    }
    const size_t gt = (size_t)gw * 64 + lane, NT = (size_t)NGW * 64;
    { u32x4* z = (u32x4*)(F.WinT + (size_t)INW * DM); const u32x4 zero = {0u, 0u, 0u, 0u}; for (size_t i = gt; i < (size_t)(HP - INW) * DM / 8; i += NT) z[i] = zero; }
    for (int r = gw; r < 2 * 16384; r += NGW) { const bool isup = r >= 16384; const int e = r & 16383; const f32x4* src = (const f32x4*)((isup ? F.peer_up : F.peer_down) + (size_t)e * DM) + lane;
        f32x4 v[8]; float m = 0.f;
#pragma unroll
        for (int j = 0; j < 8; ++j) { v[j] = src[64 * j]; if (!isup) v[j] = v[j] * ((const f32x4*)F.norm2_g)[lane + 64 * j];
            m = fmaxf(fmaxf(m, fmaxf(fabsf(v[j][0]), fabsf(v[j][1]))), fmaxf(fabsf(v[j][2]), fabsf(v[j][3]))); }
#pragma unroll
        for (int o = 1; o < 64; o <<= 1) m = fmaxf(m, __shfl_xor(m, o));
        const float inv = m > 0.f ? 127.f / m : 0.f; unsigned char* dst = isup ? F.up8 : F.down8; const int bias = 0;
#pragma unroll
        for (int j = 0; j < 8; ++j) { unsigned w = 0u;
#pragma unroll
            for (int i = 0; i < 4; ++i) { const int qv = (int)rintf(v[j][i] * inv) + bias; w |= ((unsigned)qv & 0xffu) << (8 * i); }
            const int col = 4 * lane + 256 * j; *(unsigned*)(dst + ((size_t)(col >> 7) * 16384 + e) * 128 + (col & 127)) = w; }
        if (lane == 0) (isup ? F.su : F.sd)[e] = m * (1.f / 127.f); }
    for (size_t i = gt; i < (size_t)8 * 2 * 128 * 128 / 8; i += NT) { const f32x4 a = *(const f32x4*)(F.sub_keys + i * 8), b = *(const f32x4*)(F.sub_keys + i * 8 + 4);
        u32x4 o; o.x = pk2(a[0], a[1]); o.y = pk2(a[2], a[3]); o.z = pk2(b[0], b[1]); o.w = pk2(b[2], b[3]); *(u32x4*)(F.SK + i * 8) = o; }
    for (int m = gw; m < T; m += NGW) { const f32x4* xr = (const f32x4*)(F.x + (size_t)m * DM) + lane; f32x4 v[8]; float s = 0.f;
#pragma unroll
        for (int j = 0; j < 8; ++j) { v[j] = xr[64 * j]; s += (v[j][0] * v[j][0] + v[j][1] * v[j][1]) + (v[j][2] * v[j][2] + v[j][3] * v[j][3]); }
        s = wave_sum(s); u32x2* o8 = (u32x2*)(F.xb + (size_t)m * DM) + lane;
#pragma unroll
        for (int j = 0; j < 8; ++j) { u32x2 w; w.x = pk2(v[j][0], v[j][1]); w.y = pk2(v[j][2], v[j][3]); o8[64 * j] = w; }
        if (lane == 0) F.rs1[m] = __builtin_amdgcn_rsqf(s * (1.f / DM) + EPS); }
    { const double invf[16] = {1.0, 0.44036660267178046, 0.19392274474868576, 0.08539710028576561, 0.03760603093086393, 0.016560440080994446, 0.007292664737217109, 0.003211445994752591,
                               0.001414213562373095, 0.000622772421914596, 0.0002742481756762073, 0.00012076973741146504, 5.318295896944988e-05, 2.341999896140934e-05, 1.031338537721246e-05, 4.5416704806078695e-06};
      for (size_t i = gt; i < (size_t)SEQ * 16; i += NT) { const int pos = (int)(i >> 4), j = (int)(i & 15); double f = 1.0;
#pragma unroll
          for (int q = 0; q < 16; ++q) f = (j == q) ? invf[q] : f;
          const double rev = (double)pos * f * 0.15915494309189535; const float fr = (float)(rev - floor(rev));
          F.rope[i] = (f32x2){__builtin_amdgcn_cosf(fr), __builtin_amdgcn_sinf(fr)}; } }
}

__device__ __forceinline__ void qknorm_rope(const Frame& F) {
    const int gw = F.vcu * 8 + F.wave, NGW = F.G * 8, lane = F.lane, c = lane & 15;
    for (long it = gw; it < (long)T * 24 / 4; it += NGW) { const long row = it * 4 + (lane >> 4); const int t = (int)(row / 24), slot = (int)(row % 24);
        bf16_t* p = F.h + (size_t)t * HP + C_QD + slot * 128 + 8 * c;
        const u32x4 w = *(const u32x4*)p; float y[8] = {bflo(w.x), bfhi(w.x), bflo(w.y), bfhi(w.y), bflo(w.z), bfhi(w.z), bflo(w.w), bfhi(w.w)};
        float ss = 0.f;
#pragma unroll
        for (int e = 0; e < 8; ++e) ss += y[e] * y[e];
        ss += __shfl_xor(ss, 1); ss += __shfl_xor(ss, 2); ss += __shfl_xor(ss, 4); ss += __shfl_xor(ss, 8);
        const float rq = __builtin_amdgcn_rsqf(ss * (1.f / 128.f) + EPS); const float* g = (slot < 12 ? F.qn_g : F.kn_g) + 8 * c;
        const f32x4 g0 = *(const f32x4*)g, g1 = *(const f32x4*)(g + 4);
#pragma unroll
        for (int e = 0; e < 4; ++e) { y[e] *= rq * g0[e]; y[4 + e] *= rq * g1[e]; }
        const int pos = t & (SEQ - 1);
#pragma unroll
        for (int e = 0; e < 8; ++e) { const float partner = __shfl_xor(y[e], 2);
            if (c < 4) { const f32x2 cs = F.rope[(size_t)pos * 16 + 8 * (c & 1) + e]; y[e] = (c < 2) ? (y[e] * cs.x - partner * cs.y) : (y[e] * cs.x + partner * cs.y); } }
        if (slot < 12) {
#pragma unroll
            for (int e = 0; e < 8; ++e) y[e] *= QSCALE; }
        u32x4 o; o.x = pk2(y[0], y[1]); o.y = pk2(y[2], y[3]); o.z = pk2(y[4], y[5]); o.w = pk2(y[6], y[7]); *(u32x4*)p = o; }
}

constexpr int GL_GDS = 0, GL_TOT = 8192, GL_QF = 12288, GL_QB = 21504, GL_KF = 30720, GL_KB = 39936, GL_VT = 49152, GL_P = 67584, GL_SF = 76800, GL_SB = 95232, GL_OB = 12288;
constexpr int RS72 = 144;
__device__ __forceinline__ float logsig(float z) { return fminf(z, 0.f) - flog(1.f + fexp(-fabsf(z))); }
__device__ __forceinline__ void gla_gates(const Frame& F, int b, int hh, int n, float (&bf)[8], float (&bb)[8], float& totf, float& totb) {
    const int tid = F.tid, c = tid & 63, ig = F.wave; LAS float* gds = (LAS float*)(F.lds + GL_GDS); LAS float* tot = (LAS float*)(F.lds + GL_TOT);
    const size_t t0 = (size_t)b * SEQ + (size_t)n * 64;
    if (tid < 256) { const int tk = tid >> 2, part = tid & 3; const u32x4 w = *(const u32x4*)(F.h + (t0 + tk) * HP + C_GF + part * 8); LAS float* d = gds + tk * 32 + part * 8;
        d[0] = bflo(w.x); d[1] = bfhi(w.x); d[2] = bflo(w.y); d[3] = bfhi(w.y); d[4] = bflo(w.z); d[5] = bfhi(w.z); d[6] = bflo(w.w); d[7] = bfhi(w.w); }
    __syncthreads();
    const int hc = hh * 64 + c; float upf[16], upb[16];
#pragma unroll
    for (int r = 0; r < 16; ++r) { upf[r] = F.up_f[r * 256 + hc]; upb[r] = F.up_b[r * 256 + hc]; }
    const float biasf = F.bias_f[hc], biasb = F.bias_b[hc]; float laf[8], lab[8];
#pragma unroll
    for (int e = 0; e < 8; ++e) { const LAS float* gr = gds + (ig * 8 + e) * 32; float zf = biasf, zb = biasb;
#pragma unroll
        for (int r = 0; r < 16; ++r) { zf += gr[r] * upf[r]; zb += gr[16 + r] * upb[r]; }
        laf[e] = logsig(zf) * 0.0625f; lab[e] = logsig(zb) * 0.0625f; }
    bf[0] = laf[0];
#pragma unroll
    for (int e = 1; e < 8; ++e) bf[e] = bf[e - 1] + laf[e];
    bb[7] = lab[7];
#pragma unroll
    for (int e = 6; e >= 0; --e) bb[e] = bb[e + 1] + lab[e];
    tot[ig * 64 + c] = bf[7]; tot[512 + ig * 64 + c] = bb[0];
    __syncthreads();
    float offf = 0.f, offb = 0.f; totf = 0.f; totb = 0.f;
#pragma unroll
    for (int g = 0; g < 8; ++g) { const float tf = tot[g * 64 + c], tb = tot[512 + g * 64 + c]; totf += tf; totb += tb; offf += (g < ig) ? tf : 0.f; offb += (g > ig) ? tb : 0.f; }
#pragma unroll
    for (int e = 0; e < 8; ++e) { bf[e] += offf; bb[e] += offb; }
}
__device__ __forceinline__ void gla_stage_vT(const Frame& F, size_t t0, int hh) {
#pragma unroll
    for (int j = 0; j < 2; ++j) { const int q = F.tid + 512 * j, tk = q >> 4, vc = (q & 15) * 8; const bf16x8 v = *(const bf16x8*)(F.h + (t0 + tk) * HP + C_VA + hh * 128 + vc);
        LAS short* d = (LAS short*)(F.lds + GL_VT) + vc * 72 + tk;
#pragma unroll
        for (int e = 0; e < 8; ++e) d[e * 72] = v[e]; }
}
__device__ __forceinline__ bf16x8 ldfrag(const LAS unsigned char* base, int row, int s, int hi) { return *(const LAS bf16x8*)(base + row * RS72 + (16 * s + 8 * hi) * 2); }

__device__ __forceinline__ void gla_passA(const Frame& F, int item) {
    const int bh = item >> 8, n = item & 255, b = bh >> 2, hh = bh & 3, tid = F.tid, c = tid & 63, ig = F.wave, lane = F.lane, r32 = lane & 31, hi = lane >> 5;
    float bf[8], bb[8], totf, totb; gla_gates(F, b, hh, n, bf, bb, totf, totb);
    const size_t t0 = (size_t)b * SEQ + (size_t)n * 64;
    float kf[8], kb[8];
#pragma unroll
    for (int e = 0; e < 8; ++e) { const float k = bf2f(F.h[(t0 + ig * 8 + e) * HP + C_KA + hh * 64 + c]); kf[e] = k * fexp(totf - bf[e]); kb[e] = k * fexp(totb - bb[e]); }
    { u32x4 o; o.x = pk2(kf[0], kf[1]); o.y = pk2(kf[2], kf[3]); o.z = pk2(kf[4], kf[5]); o.w = pk2(kf[6], kf[7]); *(LAS u32x4*)(F.lds + GL_KF + c * RS72 + ig * 16) = o;
      o.x = pk2(kb[0], kb[1]); o.y = pk2(kb[2], kb[3]); o.z = pk2(kb[4], kb[5]); o.w = pk2(kb[6], kb[7]); *(LAS u32x4*)(F.lds + GL_KB + c * RS72 + ig * 16) = o; }
    gla_stage_vT(F, t0, hh);
    if (ig == 0) { F.dec[((size_t)(0 * 8 + bh) * 256 + n) * 64 + c] = fexp(totf); F.dec[((size_t)(1 * 8 + bh) * 256 + n) * 64 + c] = fexp(totb); }
    __syncthreads();
    const int dir = F.wave >> 2, vt = F.wave & 3; const LAS unsigned char* kimg = F.lds + (dir ? GL_KB : GL_KF);
    f32x16 a0 = {}, a1 = {};
#pragma unroll
    for (int s = 0; s < 4; ++s) { const bf16x8 av = ldfrag(F.lds + GL_VT, 32 * vt + r32, s, hi), b0 = ldfrag(kimg, r32, s, hi), b1 = ldfrag(kimg, 32 + r32, s, hi);
        a0 = __builtin_amdgcn_mfma_f32_32x32x16_bf16(av, b0, a0, 0, 0, 0); a1 = __builtin_amdgcn_mfma_f32_32x32x16_bf16(av, b1, a1, 0, 0, 0); }
    float* st = F.state + ((size_t)(dir * 8 + bh) * 256 + n) * 8192;
#pragma unroll
    for (int r = 0; r < 16; ++r) { const int v = 32 * vt + crow(r, hi); st[v * 64 + r32] = a0[r]; st[v * 64 + 32 + r32] = a1[r]; }
    __syncthreads();
}
__device__ __forceinline__ void gla_scan(const Frame& F, int item) {
    const int dir = item >> 7, bh = (item >> 4) & 7, e = (item & 15) * 512 + F.tid, c = e & 63;
    float* st = F.state + (size_t)(dir * 8 + bh) * 256 * 8192 + e; const float* dc = F.dec + (size_t)(dir * 8 + bh) * 256 * 64 + c; float S = 0.f;
    for (int g = 0; g < 32; ++g) { float inc[8], d[8];
#pragma unroll
        for (int j = 0; j < 8; ++j) { const int n = dir ? 255 - (g * 8 + j) : g * 8 + j; inc[j] = st[(size_t)n * 8192]; d[j] = dc[n * 64]; }
#pragma unroll
        for (int j = 0; j < 8; ++j) { const int n = dir ? 255 - (g * 8 + j) : g * 8 + j; st[(size_t)n * 8192] = S; S = d[j] * S + inc[j]; } }
}
__device__ __forceinline__ void gla_passC(const Frame& F, int item) {
    const int bh = item >> 8, n = item & 255, b = bh >> 2, hh = bh & 3, tid = F.tid, c = tid & 63, ig = F.wave, lane = F.lane, r32 = lane & 31, hi = lane >> 5;
    float bf[8], bb[8], totf, totb; gla_gates(F, b, hh, n, bf, bb, totf, totb);
    const size_t t0 = (size_t)b * SEQ + (size_t)n * 64;
#pragma unroll
    for (int e = 0; e < 8; ++e) { const int i = ig * 8 + e; const bf16_t* hr = F.h + (t0 + i) * HP + hh * 64 + c; const float q = bf2f(hr[C_QA]) * 0.125f, k = bf2f(hr[C_KA]);
        const float ef = fexp(bf[e]), eb = fexp(bb[e]), nf = fexp(-bf[e]), nb = fexp(-bb[e]);
        *(LAS unsigned short*)(F.lds + GL_QF + i * RS72 + c * 2) = (unsigned short)f2bf(q * ef); *(LAS unsigned short*)(F.lds + GL_QB + i * RS72 + c * 2) = (unsigned short)f2bf(q * eb);
        *(LAS unsigned short*)(F.lds + GL_KF + i * RS72 + c * 2) = (unsigned short)f2bf(k * nf); *(LAS unsigned short*)(F.lds + GL_KB + i * RS72 + c * 2) = (unsigned short)f2bf(k * nb); }
    gla_stage_vT(F, t0, hh);
#pragma unroll
    for (int dir = 0; dir < 2; ++dir) { const float* st = F.state + ((size_t)(dir * 8 + bh) * 256 + n) * 8192; LAS unsigned char* img = F.lds + (dir ? GL_SB : GL_SF);
#pragma unroll
        for (int j = 0; j < 4; ++j) { const int q4 = tid + 512 * j, v = q4 >> 4, c4 = (q4 & 15) * 4; const f32x4 s = *(const f32x4*)(st + v * 64 + c4);
            u32x2 w; w.x = pk2(s[0], s[1]); w.y = pk2(s[2], s[3]); *(LAS u32x2*)(img + v * RS72 + c4 * 2) = w; } }
    __syncthreads();
    if (F.wave < 4) { const int ti = F.wave >> 1, tj = F.wave & 1; f32x16 sf = {}, sb = {};
#pragma unroll
        for (int s = 0; s < 4; ++s) {
            sf = __builtin_amdgcn_mfma_f32_32x32x16_bf16(ldfrag(F.lds + GL_QF, 32 * ti + r32, s, hi), ldfrag(F.lds + GL_KF, 32 * tj + r32, s, hi), sf, 0, 0, 0);
            sb = __builtin_amdgcn_mfma_f32_32x32x16_bf16(ldfrag(F.lds + GL_QB, 32 * ti + r32, s, hi), ldfrag(F.lds + GL_KB, 32 * tj + r32, s, hi), sb, 0, 0, 0); }
#pragma unroll
        for (int r = 0; r < 16; ++r) { const int i = 32 * ti + crow(r, hi), j = 32 * tj + r32; const float p = (j <= i) ? sf[r] : sb[r];
            *(LAS unsigned short*)(F.lds + GL_P + i * RS72 + j * 2) = (unsigned short)f2bf(p); } }
    __syncthreads();
    const int ti = F.wave & 1, tv = F.wave >> 1; f32x16 o = {};
#pragma unroll
    for (int s = 0; s < 4; ++s) o = __builtin_amdgcn_mfma_f32_32x32x16_bf16(ldfrag(F.lds + GL_P, 32 * ti + r32, s, hi), ldfrag(F.lds + GL_VT, 32 * tv + r32, s, hi), o, 0, 0, 0);
#pragma unroll
    for (int s = 0; s < 4; ++s) o = __builtin_amdgcn_mfma_f32_32x32x16_bf16(ldfrag(F.lds + GL_QF, 32 * ti + r32, s, hi), ldfrag(F.lds + GL_SF, 32 * tv + r32, s, hi), o, 0, 0, 0);
#pragma unroll
    for (int s = 0; s < 4; ++s) o = __builtin_amdgcn_mfma_f32_32x32x16_bf16(ldfrag(F.lds + GL_QB, 32 * ti + r32, s, hi), ldfrag(F.lds + GL_SB, 32 * tv + r32, s, hi), o, 0, 0, 0);
    __syncthreads();
    LAS float* ob = (LAS float*)(F.lds + GL_OB);
#pragma unroll
    for (int r = 0; r < 16; ++r) ob[(32 * ti + crow(r, hi)) * 132 + 32 * tv + r32] = o[r];
    __syncthreads();
    { const int i = tid >> 3, part = tid & 7, v0 = part * 16; float ov[16], ss = 0.f;
#pragma unroll
      for (int e = 0; e < 16; ++e) { ov[e] = ob[i * 132 + v0 + e]; ss += ov[e] * ov[e]; }
      ss += __shfl_xor(ss, 1); ss += __shfl_xor(ss, 2); ss += __shfl_xor(ss, 4);
      const float rs = __builtin_amdgcn_rsqf(ss * (1.f / 128.f) + EPS); const size_t tok = t0 + i;
      const u32x4 r0 = *(const u32x4*)(F.h + tok * HP + C_RA + hh * 128 + v0), r1 = *(const u32x4*)(F.h + tok * HP + C_RA + hh * 128 + v0 + 8);
      const float rr[16] = {bflo(r0.x), bfhi(r0.x), bflo(r0.y), bfhi(r0.y), bflo(r0.z), bfhi(r0.z), bflo(r0.w), bfhi(r0.w), bflo(r1.x), bfhi(r1.x), bflo(r1.y), bfhi(r1.y), bflo(r1.z), bfhi(r1.z), bflo(r1.w), bfhi(r1.w)};
      float y[16];
#pragma unroll
      for (int e = 0; e < 16; ++e) { const float g = F.out_g[hh * 128 + v0 + e]; const float sil = rr[e] * __builtin_amdgcn_rcpf(1.f + fexp(-rr[e])); y[e] = ov[e] * rs * g * sil; }
      u32x4 w0, w1; w0.x = pk2(y[0], y[1]); w0.y = pk2(y[2], y[3]); w0.z = pk2(y[4], y[5]); w0.w = pk2(y[6], y[7]); w1.x = pk2(y[8], y[9]); w1.y = pk2(y[10], y[11]); w1.z = pk2(y[12], y[13]); w1.w = pk2(y[14], y[15]);
      bf16_t* mp = F.mixed + tok * DM + hh * 128 + v0; *(u32x4*)mp = w0; *(u32x4*)(mp + 8) = w1; }
    __syncthreads();
}

constexpr int AT_V = 0, AT_K = 32768, AT_O = 65536;
#define KSWZ(row, colB) ((row) * 256 + ((colB) ^ (((row) & 7) << 4)))
__device__ __forceinline__ int v_st(int k, int c) { const int kk = (k & ~0xC) | ((k & 4) << 1) | ((k & 8) >> 1); return ((kk >> 3) * 4 + (c >> 5)) * 512 + ((kk & 7) * 32 + (c & 31)) * 2; }
__device__ __forceinline__ int v_rd_base(int lane) { return ((lane & 3) << 3) | (((lane >> 2) & 3) << 6) | (((lane >> 4) & 1) << 5) | (((lane >> 5) & 1) << 8); }
constexpr int v_rd_off(int d0, int ks, int half) { return d0 * 512 + ks * 4096 + half * 2048; }
template <int OFF> __device__ __forceinline__ s16x4 tr_read(int vb) { s16x4 r; asm volatile("ds_read_b64_tr_b16 %0, %1 offset:%2" : "=&v"(r) : "v"(vb), "i"(OFF) : "memory"); return r; }
template <int D0> __device__ __forceinline__ void pv_one(f32x16& od, int vb, bf16x8 pa0, bf16x8 pa1, bf16x8 pa2, bf16x8 pa3) {
    const s16x4 l0 = tr_read<v_rd_off(D0, 0, 0)>(vb), h0 = tr_read<v_rd_off(D0, 0, 1)>(vb), l1 = tr_read<v_rd_off(D0, 1, 0)>(vb), h1 = tr_read<v_rd_off(D0, 1, 1)>(vb);
    const s16x4 l2 = tr_read<v_rd_off(D0, 2, 0)>(vb), h2 = tr_read<v_rd_off(D0, 2, 1)>(vb), l3 = tr_read<v_rd_off(D0, 3, 0)>(vb), h3 = tr_read<v_rd_off(D0, 3, 1)>(vb);
    asm volatile("s_waitcnt lgkmcnt(0)" ::: "memory"); SBAR();
#define PKV(L, H) (bf16x8){L[0], L[1], L[2], L[3], H[0], H[1], H[2], H[3]}
    od = __builtin_amdgcn_mfma_f32_32x32x16_bf16(pa0, PKV(l0, h0), od, 0, 0, 0);
    od = __builtin_amdgcn_mfma_f32_32x32x16_bf16(pa1, PKV(l1, h1), od, 0, 0, 0);
    od = __builtin_amdgcn_mfma_f32_32x32x16_bf16(pa2, PKV(l2, h2), od, 0, 0, 0);
    od = __builtin_amdgcn_mfma_f32_32x32x16_bf16(pa3, PKV(l3, h3), od, 0, 0, 0);
#undef PKV
}
__device__ __forceinline__ void attn_item(const Frame& F, int item) {
    const int tid = F.tid, wid = F.wave, lane = F.lane, r32 = lane & 31, hi = lane >> 5;
    const int p = item / 1536, rem = item % 1536, b = rem / 768, rem2 = rem % 768, head = rem2 >> 6, u = rem2 & 63;
    const int dsh = 2 * p, dil = 1 << dsh, L = SEQ >> dsh, runs = 64 >> dsh, res = u / runs, m0 = (u % runs) * 256;
    const size_t tokbase = (size_t)b * SEQ + res;
    bf16_t* Op = (bf16_t*)(p == 0 ? (unsigned char*)F.out + OUT_OP0 : F.wsb + (p == 1 ? WS_OP1 : WS_OP2));
    const bf16_t* hq = F.h + C_QD + head * 128; const bf16_t* hk = F.h + C_KD + head * 128; const bf16_t* hv = F.h + C_VD + head * 128;
    const int Q0 = m0 + 32 * wid;
    bf16x8 qr[8];
    { const bf16_t* qp = hq + (tokbase + (size_t)dil * (Q0 + r32)) * HP + hi * 8;
#pragma unroll
      for (int d0 = 0; d0 < 8; ++d0) qr[d0] = *(const bf16x8*)(qp + d0 * 16); }
    const int sr = tid >> 4, sc = (tid & 15) * 8, vst0 = v_st(sr, sc), vst1 = v_st(32 + sr, sc), kc = sc * 2;
    const int vb0 = (int)(unsigned)(uintptr_t)(F.ldsg + AT_V) + v_rd_base(lane);
    const int kt_lo = (m0 == 0) ? 1 : 0, kt_hi = (m0 + 256 >= L) ? 4 : 5;
    f32x16 o[4] = {}; float l_reg = 0.f;
    bf16x8 sv0, sv1, sk0, sk1;
#define AT_SLOAD(T0) do { const size_t ra = (tokbase + (size_t)dil * ((T0) + sr)) * HP + sc, rb = (tokbase + (size_t)dil * ((T0) + 32 + sr)) * HP + sc; \
        sv0 = *(const bf16x8*)(hv + ra); sv1 = *(const bf16x8*)(hv + rb); sk0 = *(const bf16x8*)(hk + ra); sk1 = *(const bf16x8*)(hk + rb); } while (0)
#define AT_SWRITE(B) do { *(LAS bf16x8*)(F.lds + AT_V + (B) * 16384 + vst0) = sv0; *(LAS bf16x8*)(F.lds + AT_V + (B) * 16384 + vst1) = sv1; \
        *(LAS bf16x8*)(F.lds + AT_K + (B) * 16384 + KSWZ(sr, kc)) = sk0; *(LAS bf16x8*)(F.lds + AT_K + (B) * 16384 + KSWZ(32 + sr, kc)) = sk1; } while (0)
    AT_SLOAD(m0 - 64 + 64 * kt_lo); AT_SWRITE(0); __syncthreads();
    int buf = 0;
    for (int kt = kt_lo; kt <= kt_hi; ++kt) {
        const int T0 = m0 - 64 + 64 * kt; const bool more = kt < kt_hi;
        if (more) AT_SLOAD(T0 + 64);
        if (T0 + 63 >= Q0 - 64 && T0 <= Q0 + 95) {
            const LAS unsigned char* Ks = F.lds + AT_K + buf * 16384; f32x16 p0 = {}, p1 = {};
#pragma unroll
            for (int d0 = 0; d0 < 8; ++d0) { const int cb = (d0 * 16 + hi * 8) * 2;
                const bf16x8 k0 = *(const LAS bf16x8*)(Ks + KSWZ(r32, cb)), k1 = *(const LAS bf16x8*)(Ks + KSWZ(32 + r32, cb));
                p0 = __builtin_amdgcn_mfma_f32_32x32x16_bf16(k0, qr[d0], p0, 0, 0, 0); p1 = __builtin_amdgcn_mfma_f32_32x32x16_bf16(k1, qr[d0], p1, 0, 0, 0); }
            const int dq = T0 - (Q0 + r32); float ps = 0.f;
#pragma unroll
            for (int r = 0; r < 16; ++r) { const int e0 = dq + crow(r, hi), e1 = e0 + 32;
                p0[r] = (e0 >= -64 && e0 <= 64) ? __builtin_amdgcn_exp2f(p0[r]) : 0.f; p1[r] = (e1 >= -64 && e1 <= 64) ? __builtin_amdgcn_exp2f(p1[r]) : 0.f; ps += p0[r] + p1[r]; }
            l_reg += ps;
            bf16x8 pa0, pa1, pa2, pa3;
#define PK4(P, BASE, OUT) do { unsigned a0_ = pk2(P[BASE + 0], P[BASE + 1]), a1_ = pk2(P[BASE + 2], P[BASE + 3]); unsigned b0_ = pk2(P[BASE + 4], P[BASE + 5]), b1_ = pk2(P[BASE + 6], P[BASE + 7]); \
        auto r0_ = __builtin_amdgcn_permlane32_swap(a0_, b0_, false, false); auto r1_ = __builtin_amdgcn_permlane32_swap(a1_, b1_, false, false); \
        u32x4 w_ = {r0_[0], r1_[0], r0_[1], r1_[1]}; OUT = __builtin_bit_cast(bf16x8, w_); } while (0)
            PK4(p0, 0, pa0); PK4(p0, 8, pa1); PK4(p1, 0, pa2); PK4(p1, 8, pa3);
#undef PK4
            const int vb = vb0 + buf * 16384;
            pv_one<0>(o[0], vb, pa0, pa1, pa2, pa3); pv_one<1>(o[1], vb, pa0, pa1, pa2, pa3); pv_one<2>(o[2], vb, pa0, pa1, pa2, pa3); pv_one<3>(o[3], vb, pa0, pa1, pa2, pa3);
        }
        if (more) AT_SWRITE(buf ^ 1);
        __syncthreads(); buf ^= 1;
    }
#undef AT_SLOAD
#undef AT_SWRITE
    l_reg += __shfl_xor(l_reg, 32);
    if (hi == 0) F.lp[((size_t)p * T + tokbase + (size_t)dil * (Q0 + r32)) * NHD + head] = l_reg;
    LAS unsigned char* stg = F.lds + AT_O + wid * 8192;
#pragma unroll
    for (int d0 = 0; d0 < 4; ++d0)
#pragma unroll
        for (int r = 0; r < 16; ++r) *(LAS unsigned short*)(stg + (crow(r, hi) * 128 + d0 * 32 + r32) * 2) = (unsigned short)f2bf(o[d0][r]);
    LDS_WAIT(); asm volatile("" ::: "memory");
#pragma unroll
    for (int it = 0; it < 8; ++it) { const int row = 4 * it + (lane >> 4), ch = lane & 15; const u32x4 w = *(const LAS u32x4*)(stg + row * 256 + ch * 16);
        *(u32x4*)(Op + (tokbase + (size_t)dil * (Q0 + row)) * (NHD * 128) + head * 128 + ch * 8) = w; }
    __syncthreads();
}
__device__ __forceinline__ void dil_combine(const Frame& F) {
    const int gw = F.vcu * 8 + F.wave, NGW = F.G * 8, lane = F.lane, c = lane & 15;
    for (long it = gw; it < (long)T * NHD / 4; it += NGW) { const long row = it * 4 + (lane >> 4); const size_t tok = (size_t)(row / NHD); const int head = (int)(row % NHD);
        const float l = F.lp[tok * NHD + head] + F.lp[((size_t)T + tok) * NHD + head] + F.lp[((size_t)2 * T + tok) * NHD + head]; const float inv = 1.f / l;
        const size_t off = tok * (NHD * 128) + head * 128 + 8 * c; const u32x4 a = *(const u32x4*)(F.op0 + off), b = *(const u32x4*)(F.op1 + off), d = *(const u32x4*)(F.op2 + off);
        u32x4 o; o.x = pk2((bflo(a.x) + bflo(b.x) + bflo(d.x)) * inv, (bfhi(a.x) + bfhi(b.x) + bfhi(d.x)) * inv); o.y = pk2((bflo(a.y) + bflo(b.y) + bflo(d.y)) * inv, (bfhi(a.y) + bfhi(b.y) + bfhi(d.y)) * inv);
        o.z = pk2((bflo(a.z) + bflo(b.z) + bflo(d.z)) * inv, (bfhi(a.z) + bfhi(b.z) + bfhi(d.z)) * inv); o.w = pk2((bflo(a.w) + bflo(b.w) + bflo(d.w)) * inv, (bfhi(a.w) + bfhi(b.w) + bfhi(d.w)) * inv);
        *(u32x4*)(F.mixed + tok * DM + 512 + head * 128 + 8 * c) = o; }
}

__device__ __forceinline__ unsigned fl_flip(float x) { const unsigned u = __float_as_uint(x); return u ^ ((unsigned)((int)u >> 31) | 0x80000000u); }
__device__ __forceinline__ float fl_unflip(unsigned w) { return __uint_as_float((w & 0x80000000u) ? (w ^ 0x80000000u) : ~w); }
#define CE_DESC(a, b) do { const unsigned x_ = max(a, b), y_ = min(a, b); a = x_; b = y_; } while (0)
__device__ __forceinline__ void sort16_desc(unsigned (&a)[16]) {
#pragma unroll
    for (int k = 2; k <= 16; k <<= 1)
#pragma unroll
        for (int j = k >> 1; j > 0; j >>= 1)
#pragma unroll
            for (int i = 0; i < 16; ++i) { const int l = i ^ j; if (l > i) { const unsigned x = max(a[i], a[l]), y = min(a[i], a[l]); if ((i & k) == 0) { a[i] = x; a[l] = y; } else { a[i] = y; a[l] = x; } } }
}
__device__ __forceinline__ void bmerge16_desc(unsigned (&a)[16]) {
#pragma unroll
    for (int j = 8; j > 0; j >>= 1)
#pragma unroll
        for (int i = 0; i < 16; ++i) { const int l = i ^ j; if (l > i) CE_DESC(a[i], a[l]); }
}
__device__ __forceinline__ void top16_merge(unsigned (&a)[16], const unsigned (&b)[16]) {
#pragma unroll
    for (int i = 0; i < 16; ++i) a[i] = max(a[i], b[15 - i]);
    bmerge16_desc(a);
}
__device__ __forceinline__ void top16_partner(unsigned (&a)[16]) {
    unsigned b[16];
#pragma unroll
    for (int i = 0; i < 16; ++i) b[i] = (unsigned)__shfl_xor((int)a[i], 32);
    top16_merge(a, b);
}
__device__ constexpr unsigned char stair(int n) {
    constexpr unsigned char L[64] = {0x00,0x01,0x02,0x03,0x04,0x05,0x06,0x07,0x08,0x09,0x0a,0x0b,0x0c,0x0d,0x0e,0x0f,0x10,0x11,0x12,0x13,0x14,0x15,0x16,0x17,0x20,0x21,0x22,0x23,0x24,0x30,0x31,0x32,
                                     0x33,0x40,0x41,0x42,0x50,0x51,0x60,0x61,0x70,0x71,0x80,0x90,0xa0,0xb0,0xc0,0xd0,0xe0,0xf0,0xff,0xff,0xff,0xff,0xff,0xff,0xff,0xff,0xff,0xff,0xff,0xff,0xff,0xff};
    return L[n];
}
__device__ __forceinline__ void topk_item(const Frame& F, int item) {
    const int lane = F.lane, r32 = lane & 31, hi = lane >> 5, hh = item & 7, tok0 = (item >> 3) * 32; const size_t tok = (size_t)tok0 + r32;
    LAS int* ktab = (LAS int*)(F.lds + F.wave * 4096) + r32 * 32;
    float ss = 0.f;
    { const f32x4* sp = (const f32x4*)(F.ssp + tok * 32 + hi * 16);
#pragma unroll
      for (int j = 0; j < 4; ++j) { const f32x4 v = sp[j]; ss += (v[0] + v[1]) + (v[2] + v[3]); } }
    ss += __shfl_xor(ss, 32);
    const float rs2 = __builtin_amdgcn_rsqf(ss * (1.f / DM) + EPS);
    if (hh == 0 && hi == 0) F.rs2[tok] = rs2;
    unsigned top[2][16];
#pragma unroll
    for (int cc = 0; cc < 2; ++cc) {
        f32x16 acc[4] = {};
        const bf16_t* qp = F.qry + tok * DM + hh * 256 + cc * 128 + hi * 8; const bf16_t* kp = F.SK + ((size_t)(hh * 2 + cc) * 128 + r32) * 128 + hi * 8;
#pragma unroll 2
        for (int s = 0; s < 8; ++s) { const bf16x8 qf = *(const bf16x8*)(qp + 16 * s);
#pragma unroll
            for (int kt = 0; kt < 4; ++kt) { const bf16x8 kf = *(const bf16x8*)(kp + (size_t)kt * 32 * 128 + 16 * s); acc[kt] = __builtin_amdgcn_mfma_f32_32x32x16_bf16(kf, qf, acc[kt], 0, 0, 0); } }
        unsigned g[4][16];
#pragma unroll
        for (int kt = 0; kt < 4; ++kt) {
#pragma unroll
            for (int r = 0; r < 16; ++r) g[kt][r] = (fl_flip(acc[kt][r]) & ~127u) | (unsigned)(127 - (32 * kt + crow(r, hi)));
            sort16_desc(g[kt]); }
        top16_merge(g[0], g[1]); top16_merge(g[2], g[3]); top16_merge(g[0], g[2]); top16_partner(g[0]);
#pragma unroll
        for (int i = 0; i < 16; ++i) top[cc][i] = g[0][i];
    }
#pragma unroll
    for (int i = 0; i < 16; ++i) ktab[hi * 16 + i] = 127 - (int)((hi ? top[1][i] : top[0][i]) & 127u);
    float s0[16], s1[16];
#pragma unroll
    for (int i = 0; i < 16; ++i) { s0[i] = fl_unflip(top[0][i] & ~127u); s1[i] = fl_unflip(top[1][i] & ~127u); }
    unsigned ca[16], cb[16];
#pragma unroll
    for (int n = 0; n < 32; ++n) { const int A = stair(n), B = stair(25 + n); unsigned va = 0u, vb = 0u;
        if (n < 25) { va = (fl_flip(s0[A >> 4] + s1[A & 15]) & ~255u) | (unsigned)(255 - A); vb = (fl_flip(s0[B >> 4] + s1[B & 15]) & ~255u) | (unsigned)(255 - B); }
        const unsigned v = hi ? vb : va; if (n < 16) ca[n] = v; else cb[n - 16] = v; }
    sort16_desc(ca); sort16_desc(cb); top16_merge(ca, cb); top16_partner(ca);
    float e[16], sum = 0.f; const float mx = fl_unflip(ca[0] & ~255u) * rs2;
#pragma unroll
    for (int i = 0; i < 16; ++i) { e[i] = fexp(fl_unflip(ca[i] & ~255u) * rs2 - mx); sum += e[i]; }
    const float inv = 1.f / sum;
    LDS_WAIT(); asm volatile("" ::: "memory");
    int oi[8]; float og[8];
#pragma unroll
    for (int k = 0; k < 8; ++k) { const unsigned cv = hi ? ca[8 + k] : ca[k]; const int code = 255 - (int)(cv & 255u); og[k] = (hi ? e[8 + k] : e[k]) * inv; oi[k] = ktab[code >> 4] * 128 + ktab[16 + (code & 15)]; }
    { int* ip = F.idx + tok * 128 + hh * 16 + hi * 8; float* gp = F.gate + tok * 128 + hh * 16 + hi * 8;
      *(int4*)ip = make_int4(oi[0], oi[1], oi[2], oi[3]); *(int4*)(ip + 4) = make_int4(oi[4], oi[5], oi[6], oi[7]);
      *(f32x4*)gp = (f32x4){og[0], og[1], og[2], og[3]}; *(f32x4*)(gp + 4) = (f32x4){og[4], og[5], og[6], og[7]}; }
    LDS_WAIT(); asm volatile("" ::: "memory");
}

constexpr int PS_NSL = 16, PS_CW = DM / PS_NSL, PS_SUB = PS_NSL / 8, PS_TG = 32, PS_NTG = T / PS_TG;
__device__ __forceinline__ float gelu_tanh(float x) { const float u = 0.7978845608028654f * (x + 0.044715f * x * x * x); const float t = 1.f - 2.f * __builtin_amdgcn_rcpf(1.f + fexp(2.f * u)); return 0.5f * x * (1.f + t); }
__device__ __forceinline__ int dot16i(u32x4 w, u32x4 x) { int p = __builtin_amdgcn_sdot4((int)w.x, (int)x.x, 0, false); p = __builtin_amdgcn_sdot4((int)w.y, (int)x.y, p, false); p = __builtin_amdgcn_sdot4((int)w.z, (int)x.z, p, false); return __builtin_amdgcn_sdot4((int)w.w, (int)x.w, p, false); }
__device__ __forceinline__ unsigned xcc_id() { return (unsigned)__builtin_amdgcn_s_getreg((3 << 11) | 20) & 7u; }
__device__ __forceinline__ bool peer_claim(unsigned* cnt, unsigned x, unsigned& d, int lane, int& q, int& tg) {
    while (d < 8u) { const unsigned xq = (x + d) & 7u; unsigned u = 0u;
        if (lane == 0) u = __hip_atomic_fetch_add(cnt + 64 * xq, 1u, __ATOMIC_RELAXED, __HIP_MEMORY_SCOPE_AGENT);
        u = (unsigned)__builtin_amdgcn_readfirstlane((int)u);
        if (u < (unsigned)(PS_SUB * PS_NTG)) { q = (int)(u / PS_NTG) * 8 + (int)xq; tg = (int)(u % PS_NTG); return true; }
        ++d; }
    return false;
}
template <int CTRL> __device__ __forceinline__ float dppmov(float x) { return __int_as_float(__builtin_amdgcn_update_dpp(0, __float_as_int(x), CTRL, 0xf, 0xf, true)); }
template <int CTRL> __device__ __forceinline__ int dppmovi(int x) { return __builtin_amdgcn_update_dpp(0, x, CTRL, 0xf, 0xf, true); }
__device__ __forceinline__ int bperm(int srclane, int v) { return __builtin_amdgcn_ds_bpermute(srclane << 2, v); }
__device__ __forceinline__ void peer_quant_x(const Frame& F) {
    const int gw = F.vcu * 8 + F.wave, NGW = F.G * 8, lane = F.lane;
    for (int tok = gw; tok < T; tok += NGW) { const u32x4* xr = (const u32x4*)(F.x1b + (size_t)tok * DM) + lane; float v[4][8]; float m = 0.f;
#pragma unroll
        for (int j = 0; j < 4; ++j) { const u32x4 w = xr[64 * j]; v[j][0] = bflo(w.x); v[j][1] = bfhi(w.x); v[j][2] = bflo(w.y); v[j][3] = bfhi(w.y); v[j][4] = bflo(w.z); v[j][5] = bfhi(w.z); v[j][6] = bflo(w.w); v[j][7] = bfhi(w.w);
#pragma unroll
            for (int i = 0; i < 8; ++i) m = fmaxf(m, fabsf(v[j][i])); }
#pragma unroll
        for (int o = 1; o < 64; o <<= 1) m = fmaxf(m, __shfl_xor(m, o));
        const float inv = m > 0.f ? 127.f / m : 0.f;
#pragma unroll
        for (int j = 0; j < 4; ++j) { u32x2 w = {0u, 0u};
#pragma unroll
            for (int i = 0; i < 4; ++i) { w.x |= ((unsigned)(int)rintf(v[j][i] * inv) & 0xffu) << (8 * i); w.y |= ((unsigned)(int)rintf(v[j][4 + i] * inv) & 0xffu) << (8 * i); }
            *(u32x2*)(F.xq8 + (size_t)tok * DM + 8 * lane + 512 * j) = w; }
        if (lane == 0) F.sx[tok] = m * (1.f / 127.f); }
}
__device__ __forceinline__ void peer_down(const Frame& F, int cntw = 1024) {
    const int lane = F.lane, g = lane >> 3, c = lane & 7; const unsigned x = xcc_id(); unsigned d = 0u; int q, tg; unsigned* cnt = (unsigned*)(F.wsb + WS_CTL) + cntw;
    const unsigned char* tab = F.down8; const unsigned char* xb = F.xq8;
    while (peer_claim(cnt, x, d, lane, q, tg)) {
        const unsigned colb = (unsigned)(q * PS_CW + 16 * c), slb = (unsigned)q * (16384u * 128u) + 16u * c; int* part = F.part + (size_t)q * T * 128; const size_t tok0 = (size_t)tg * PS_TG;
        u32x4 wA[16], wB[16], xA, xB; int iA0, iA1, iB0, iB1;
#define PD_IDX(i0, i1, tok) do { const int* ip_ = F.idx + (tok) * 128 + lane; i0 = ip_[0]; i1 = ip_[64]; } while (0)
#define PD_ROWS(W_, X_, i0, i1, tok) do { _Pragma("unroll") for (int j = 0; j < 16; ++j) { const unsigned e_ = (unsigned)bperm(8 * (j & 7) + g, j < 8 ? i0 : i1); \
            W_[j] = *(const u32x4*)(tab + (e_ * 128u + slb)); } X_ = *(const u32x4*)(xb + (tok) * DM + colb); } while (0)
#define PD_COMP(W_, X_, tok) do { int p[16]; _Pragma("unroll") for (int j = 0; j < 16; ++j) p[j] = dot16i(W_[j], X_); \
            int a1[8], a2[4], a3[2]; \
            _Pragma("unroll") for (int i = 0; i < 8; ++i) { const int keep = (c & 1) ? p[2 * i + 1] : p[2 * i], give = (c & 1) ? p[2 * i] : p[2 * i + 1]; a1[i] = keep + dppmovi<0xB1>(give); } \
            _Pragma("unroll") for (int i = 0; i < 4; ++i) { const int keep = (c & 2) ? a1[2 * i + 1] : a1[2 * i], give = (c & 2) ? a1[2 * i] : a1[2 * i + 1]; a2[i] = keep + dppmovi<0x4E>(give); } \
            _Pragma("unroll") for (int i = 0; i < 2; ++i) { const int keep = (c & 4) ? a2[2 * i + 1] : a2[2 * i], give = (c & 4) ? a2[2 * i] : a2[2 * i + 1]; a3[i] = keep + __shfl_xor(give, 4); } \
            part[(tok) * 128 + 8 * c + g] = a3[0]; part[(tok) * 128 + 64 + 8 * c + g] = a3[1]; } while (0)
        PD_IDX(iA0, iA1, tok0); PD_IDX(iB0, iB1, tok0 + 1);
        PD_ROWS(wA, xA, iA0, iA1, tok0);
        for (int tt = 0; tt < PS_TG; tt += 2) { const size_t tok = tok0 + tt;
            PD_ROWS(wB, xB, iB0, iB1, tok + 1);
            const size_t t2 = tok + (tt + 2 < PS_TG ? 2 : 0), t3 = tok + (tt + 2 < PS_TG ? 3 : 1);
            PD_IDX(iA0, iA1, t2);
            PD_COMP(wA, xA, tok);
            if (tt + 2 < PS_TG) PD_ROWS(wA, xA, iA0, iA1, t2);
            PD_IDX(iB0, iB1, t3);
            PD_COMP(wB, xB, tok + 1);
        }
#undef PD_IDX
#undef PD_ROWS
#undef PD_COMP
    }
}
__device__ __forceinline__ void peer_coef_probe(const Frame& F, bool dry) {
    const int gw = F.vcu * 8 + F.wave, NGW = F.G * 8, lane = F.lane;
    for (int tok = gw; tok < T; tok += NGW) { int a0 = 0, a1 = 0; const int* pp = F.part + (size_t)tok * 128 + lane;
#pragma unroll
        for (int q = 0; q < PS_NSL; ++q) { a0 += pp[(size_t)q * T * 128]; a1 += pp[(size_t)q * T * 128 + 64]; }
        const float sc = F.rs2[tok] * F.sx[tok]; const float* gp = F.gate + (size_t)tok * 128 + lane; const int e0 = F.idx[(size_t)tok * 128 + lane], e1 = F.idx[(size_t)tok * 128 + 64 + lane];
        const float c0 = gp[0] * gelu_tanh((float)a0 * sc * F.sd[e0]) * F.su[e0], c1 = gp[64] * gelu_tanh((float)a1 * sc * F.sd[e1]) * F.su[e1];
        float m = fmaxf(fabsf(c0), fabsf(c1));
#pragma unroll
        for (int o = 1; o < 64; o <<= 1) m = fmaxf(m, __shfl_xor(m, o));
        const float inv = m > 0.f ? 127.f / m : 0.f; const int q0 = (int)rintf(c0 * inv), q1 = (int)rintf(c1 * inv);
        unsigned char* fp = (dry ? F.wsb + WS_PART + 256 * MiB : F.fq8) + (size_t)tok * 128;
        { const int k0 = lane, k1 = 64 + lane; fp[(8 * (k0 >> 5) + (k0 & 7)) * 4 + ((k0 >> 3) & 3)] = (unsigned char)q0; fp[(8 * (k1 >> 5) + (k1 & 7)) * 4 + ((k1 >> 3) & 3)] = (unsigned char)q1; }
        if (lane == 0 && !dry) F.csum[tok] = m * (1.f / 127.f); }
}
__device__ __forceinline__ void peer_up(const Frame& F, int cntw = 2048, bool dry = false) {
    const int lane = F.lane, g = lane >> 3, c = lane & 7; const unsigned x = xcc_id(); unsigned d = 0u; int q, tg; unsigned* cnt = (unsigned*)(F.wsb + WS_CTL) + cntw;
    const unsigned char* tab = F.up8;
    while (peer_claim(cnt, x, d, lane, q, tg)) {
        const unsigned slb = (unsigned)q * (16384u * 128u) + 16u * c; const int col0 = q * PS_CW + 16 * c; const size_t tok0 = (size_t)tg * PS_TG;
        u32x4 wA[16], wB[16]; int iA0, iA1, iB0, iB1, fqA, fqB, fA[4], fB[4]; float oA0, oA1, oB0, oB1;
#define PU_IDX(i0, i1, fq, o0, o1, tok) do { const size_t o_ = (tok) * 128; i0 = F.idx[o_ + lane]; i1 = F.idx[o_ + 64 + lane]; fq = *(const int*)(F.fq8 + o_ + 4 * (lane & 31)); \
            const float* op_ = F.out + (tok) * DM + col0 + g; o0 = op_[0]; o1 = op_[8]; } while (0)
#define PU_ROWS(W_, F_, i0, i1, fq) do { _Pragma("unroll") for (int j = 0; j < 16; ++j) { const unsigned e_ = (unsigned)bperm(8 * (j & 7) + g, j < 8 ? i0 : i1); W_[j] = *(const u32x4*)(tab + (e_ * 128u + slb)); } \
            _Pragma("unroll") for (int m_ = 0; m_ < 4; ++m_) F_[m_] = bperm(8 * m_ + g, fq); } while (0)
#define PU_T4(ACC_, R0, R1, R2, R3, FQ_) do { const unsigned t0_ = __builtin_amdgcn_perm(R1, R0, 0x05010400u), t1_ = __builtin_amdgcn_perm(R1, R0, 0x07030602u), t2_ = __builtin_amdgcn_perm(R3, R2, 0x05010400u), t3_ = __builtin_amdgcn_perm(R3, R2, 0x07030602u); \
            ACC_[0] = __builtin_amdgcn_sdot4((int)__builtin_amdgcn_perm(t2_, t0_, 0x05040100u), FQ_, ACC_[0], false); ACC_[1] = __builtin_amdgcn_sdot4((int)__builtin_amdgcn_perm(t2_, t0_, 0x07060302u), FQ_, ACC_[1], false); \
            ACC_[2] = __builtin_amdgcn_sdot4((int)__builtin_amdgcn_perm(t3_, t1_, 0x05040100u), FQ_, ACC_[2], false); ACC_[3] = __builtin_amdgcn_sdot4((int)__builtin_amdgcn_perm(t3_, t1_, 0x07060302u), FQ_, ACC_[3], false); } while (0)
#define PU_COMP(W_, F_, o0, o1, tok) do { int acc[16] = {}; \
            _Pragma("unroll") for (int m_ = 0; m_ < 4; ++m_) { int* a_ = acc; PU_T4(a_, W_[4 * m_].x, W_[4 * m_ + 1].x, W_[4 * m_ + 2].x, W_[4 * m_ + 3].x, F_[m_]); a_ = acc + 4; PU_T4(a_, W_[4 * m_].y, W_[4 * m_ + 1].y, W_[4 * m_ + 2].y, W_[4 * m_ + 3].y, F_[m_]); \
                a_ = acc + 8; PU_T4(a_, W_[4 * m_].z, W_[4 * m_ + 1].z, W_[4 * m_ + 2].z, W_[4 * m_ + 3].z, F_[m_]); a_ = acc + 12; PU_T4(a_, W_[4 * m_].w, W_[4 * m_ + 1].w, W_[4 * m_ + 2].w, W_[4 * m_ + 3].w, F_[m_]); } \
            int a1[8], a2[4], a3[2]; \
            _Pragma("unroll") for (int i = 0; i < 8; ++i) { const int keep = (g & 1) ? acc[2 * i + 1] : acc[2 * i], give = (g & 1) ? acc[2 * i] : acc[2 * i + 1]; a1[i] = keep + dppmovi<0x128>(give); } \
            _Pragma("unroll") for (int i = 0; i < 4; ++i) { const int keep = (g & 2) ? a1[2 * i + 1] : a1[2 * i], give = (g & 2) ? a1[2 * i] : a1[2 * i + 1]; a2[i] = keep + __shfl_xor(give, 16); } \
            _Pragma("unroll") for (int i = 0; i < 2; ++i) { const int keep = (g & 4) ? a2[2 * i + 1] : a2[2 * i], give = (g & 4) ? a2[2 * i] : a2[2 * i + 1]; a3[i] = keep + __shfl_xor(give, 32); } \
            const float sf_ = F.csum[tok]; float* dp_ = (dry ? (float*)(F.wsb + WS_PART) + ((tok) & 16383) * DM : F.out + (tok) * DM) + col0 + g; \
            dp_[0] = o0 + sf_ * (float)a3[0]; dp_[8] = o1 + sf_ * (float)a3[1]; } while (0)
        PU_IDX(iA0, iA1, fqA, oA0, oA1, tok0); PU_IDX(iB0, iB1, fqB, oB0, oB1, tok0 + 1);
        PU_ROWS(wA, fA, iA0, iA1, fqA);
        for (int tt = 0; tt < PS_TG; tt += 2) { const size_t tok = tok0 + tt;
            PU_ROWS(wB, fB, iB0, iB1, fqB);
            const float pA0 = oA0, pA1 = oA1;
            const bool more = tt + 2 < PS_TG; const size_t t2 = tok + (more ? 2 : 0), t3 = tok + (more ? 3 : 1);
            PU_IDX(iA0, iA1, fqA, oA0, oA1, t2);
            PU_COMP(wA, fA, pA0, pA1, tok);
            if (more) PU_ROWS(wA, fA, iA0, iA1, fqA);
            const float pB0 = oB0, pB1 = oB1;
            PU_IDX(iB0, iB1, fqB, oB0, oB1, t3);
            PU_COMP(wB, fB, pB0, pB1, tok + 1);
        }
#undef PU_IDX
#undef PU_ROWS
#undef PU_T4
#undef PU_COMP
    }
}

struct Args { const float* in[16]; float* out; unsigned char* ws; int ph_lo, ph_hi, coop, pad; };
__global__ void __launch_bounds__(512, 2) fwd_kernel(Args args) {
    extern __shared__ __attribute__((aligned(16))) unsigned char lds_raw[];
    Frame F;
    F.lds = (LAS unsigned char*)lds_raw; F.ldsg = (char*)lds_raw;
    F.tid = threadIdx.x; F.lane = F.tid & 63; F.wave = __builtin_amdgcn_readfirstlane(F.tid >> 6);
    F.G = gridDim.x; { const int bx = blockIdx.x; F.vcu = (F.G % 8 == 0) ? (bx % 8) * (F.G / 8) + bx / 8 : bx; }
    F.x = args.in[0]; F.norm1_g = args.in[1]; F.w_in = args.in[2]; F.up_f = args.in[3]; F.bias_f = args.in[4]; F.up_b = args.in[5]; F.bias_b = args.in[6]; F.out_g = args.in[7];
    F.qn_g = args.in[8]; F.kn_g = args.in[9]; F.w_out = args.in[10]; F.norm2_g = args.in[11]; F.w_query = args.in[12]; F.sub_keys = args.in[13]; F.peer_down = args.in[14]; F.peer_up = args.in[15];
    F.out = args.out; unsigned char* ws = args.ws; F.wsb = ws;
    F.rope = (f32x2*)(ws + WS_ROPE); F.rs1 = (float*)(ws + WS_RS1); F.rs2 = (float*)(ws + WS_RS2); F.ssp = (float*)(ws + WS_SSP); F.dec = (float*)(ws + WS_DEC); F.lp = (float*)(ws + WS_LP);
    F.gate = (float*)(ws + WS_GATE); F.part = (int*)(ws + WS_PART); F.sd = (float*)(ws + WS_CTL + 65536); F.su = (float*)(ws + WS_CTL + 131072); F.sx = (float*)(ws + WS_RS2 + 131072); F.csum = (float*)(ws + WS_RS2 + 262144);
    F.down8 = ws + WS_DOWN; F.up8 = ws + WS_UP; F.xq8 = ws + WS_XB; F.fq8 = ws + WS_XB + 64 * MiB; F.idx = (int*)(ws + WS_IDX); F.state = (float*)((unsigned char*)args.out + OUT_ST);
    F.WinT = (bf16_t*)(ws + WS_WIN); F.WoT = (bf16_t*)(ws + WS_WO); F.WqT = (bf16_t*)(ws + WS_WQ); F.SK = (bf16_t*)(ws + WS_SK); F.down16 = (bf16_t*)(ws + WS_DOWN); F.up16 = (bf16_t*)(ws + WS_UP);
    F.xb = (bf16_t*)(ws + WS_XB); F.mixed = (bf16_t*)(ws + WS_XB); F.h = (bf16_t*)(ws + WS_H); F.x1b = (bf16_t*)(ws + WS_X1B); F.qry = (bf16_t*)(ws + WS_QRY);
    F.op0 = (bf16_t*)((unsigned char*)args.out + OUT_OP0); F.op1 = (bf16_t*)(ws + WS_OP1); F.op2 = (bf16_t*)(ws + WS_OP2);
    const int lo = args.ph_lo, hi = args.ph_hi;
#ifndef PH_MASK
#define PH_MASK 0x7ff
#endif
#ifndef PROBE_PHASE
#define PROBE_PHASE -1
#endif
#define REP(k) for (int rep_ = 0; rep_ < ((PROBE_PHASE == (k)) ? 2 : 1); ++rep_)
#define IN(k) (((PH_MASK >> (k)) & 1) && lo <= (k) && (k) < hi)
#define SEAM(k) do { if (IN(k) && IN((k) + 1)) { if (args.coop) cg::this_grid().sync(); } } while (0)
    if (IN(0)) { REP(0) phase0(F); } SEAM(0);
#define GEMM1_BODY { pg8::Gemm g{F.xb, F.WinT, T, HP, DM}; pg8::StaticOrder S; S.init(T, HP, F.G, (int)blockIdx.x); pg8::EpiRowScaleBf16 E{F.h, HP, F.rs1}; \
        pg8::gemm_phase<pg8::EpiRowScaleBf16, pg8::StaticOrder, PG8_ALIGN, PG8_SP2>(F.lds, g, S, E); }
    if (IN(1)) { GEMM1_BODY; if (PROBE_PHASE == 1) GEMM1_BODY; } SEAM(1);
    if (IN(2)) { qknorm_rope(F); REP(2) for (int it = F.vcu; it < 2048; it += F.G) gla_passA(F, it); } SEAM(2);
    if (IN(3)) { for (int it = F.vcu; it < 256; it += F.G) gla_scan(F, it); REP(3) for (int it = F.vcu; it < 4608; it += F.G) attn_item(F, it); } SEAM(3);
    if (IN(4)) REP(4) { for (int it = F.vcu; it < 2048; it += F.G) gla_passC(F, it); dil_combine(F); } SEAM(4);
#define GEMM5_BODY { pg8::Gemm g{F.mixed, F.WoT, T, DM, DM}; pg8::StaticOrder S; S.init(T, DM, F.G, (int)blockIdx.x); pg8::EpiResid E{F.x, F.out, F.x1b, F.ssp, DM}; \
        pg8::gemm_phase<pg8::EpiResid, pg8::StaticOrder, PG8_ALIGN, PG8_SP2>(F.lds, g, S, E); }
#define GEMM6_BODY { pg8::Gemm g{F.x1b, F.WqT, T, DM, DM}; pg8::StaticOrder S; S.init(T, DM, F.G, (int)blockIdx.x); pg8::EpiRowScaleBf16 E{F.qry, DM, nullptr}; \
        pg8::gemm_phase<pg8::EpiRowScaleBf16, pg8::StaticOrder, PG8_ALIGN, PG8_SP2>(F.lds, g, S, E); }
    if (IN(5)) { GEMM5_BODY; if (PROBE_PHASE == 5) GEMM5_BODY; } SEAM(5);
    if (IN(6)) { GEMM6_BODY; if (PROBE_PHASE == 6) GEMM6_BODY; } SEAM(6);
    if (IN(7)) REP(7) { const int gw = F.vcu * 8 + F.wave, NGW = F.G * 8; for (int it = gw; it < (T / 32) * 8; it += NGW) topk_item(F, it); if (rep_ == 0) peer_quant_x(F); } SEAM(7);
    if (IN(8)) { if (PROBE_PHASE == 8) peer_down(F, 3072); peer_down(F); } SEAM(8);
    if (IN(9)) { REP(9) peer_coef_probe(F, (PROBE_PHASE == 9) && rep_ == 0); } SEAM(9);
    if (IN(10)) { if (PROBE_PHASE == 10) peer_up(F, 3584, true); peer_up(F); }
#undef IN
#undef SEAM
}

#ifndef MK_N_LAUNCHES
#define MK_N_LAUNCHES 1
#endif
extern "C" void kernel_launch(void* const* d_in, const int* in_sizes, int n_in, void* d_out, int out_size, void* d_ws, size_t ws_size, hipStream_t stream) {
    static int grid = 0;
    if (grid == 0) {
        if (n_in != 16 || in_sizes[0] != T * DM || out_size != T * DM || ws_size < WS_END) { fprintf(stderr, "kernel_launch: unexpected shapes (n_in %d, in0 %d, out %d, ws %zu)\n", n_in, n_in > 0 ? in_sizes[0] : -1, out_size, ws_size); grid = -1; return; }
        int dev = 0, cus = 0, per_cu = 0;
        if (hipGetDevice(&dev) != hipSuccess || hipDeviceGetAttribute(&cus, hipDeviceAttributeMultiprocessorCount, dev) != hipSuccess) { grid = -1; return; }
        if (hipFuncSetAttribute((const void*)fwd_kernel, hipFuncAttributeMaxDynamicSharedMemorySize, LDS_BYTES) != hipSuccess) { fprintf(stderr, "kernel_launch: hipFuncSetAttribute failed\n"); grid = -1; return; }
        if (hipOccupancyMaxActiveBlocksPerMultiprocessor(&per_cu, (const void*)fwd_kernel, 512, LDS_BYTES) != hipSuccess || per_cu < 1) { fprintf(stderr, "kernel_launch: occupancy query says %d\n", per_cu); per_cu = 1; }
        (void)hipGetLastError();
        grid = cus;
    }
    if (grid < 0) return;
    Args a{};
    for (int i = 0; i < 16; ++i) a.in[i] = (const float*)d_in[i];
    a.out = (float*)d_out; a.ws = (unsigned char*)d_ws;
    if (MK_N_LAUNCHES == 1) {
        a.ph_lo = 0; a.ph_hi = NPHASE; a.coop = 1; void* kargs[] = {&a};
        hipError_t e = hipLaunchCooperativeKernel((const void*)fwd_kernel, dim3(grid), dim3(512), kargs, LDS_BYTES, stream);
        if (e != hipSuccess) fprintf(stderr, "kernel_launch: cooperative launch failed: %s (grid %d)\n", hipGetErrorString(e), grid);
    } else {
        for (int p = 0; p < NPHASE; ++p) { a.ph_lo = p; a.ph_hi = p + 1; a.coop = 0; hipLaunchKernelGGL(fwd_kernel, dim3(grid), dim3(512), LDS_BYTES, stream, a); }
        const hipError_t le = hipPeekAtLastError(); if (le != hipSuccess) fprintf(stderr, "kernel_launch: launch failed: %s\n", hipGetErrorName(le));
    }
}
```

```cpp
#include <hip/hip_runtime.h>
#include <hip/hip_cooperative_groups.h>
#include <cstdio>
#include <cstdint>
namespace cg = cooperative_groups;
namespace pg8 {
#define PG8_LAS __attribute__((address_space(3)))
typedef unsigned short bf16_t;
typedef short bf16x8 __attribute__((ext_vector_type(8)));
typedef float f32x4 __attribute__((ext_vector_type(4)));
typedef unsigned u32x4 __attribute__((ext_vector_type(4)));
constexpr int BM = 256, BK = 64, HALF = 128, HTB = HALF * BK * 2  , STAGE_BYTES = 8 * HTB, NXCD = 8, WGM = 8;

__host__ __device__ __forceinline__ int lds_byte(int r, int c) { const int st = (r >> 4) * 2 + (c >> 5), rr = r & 15, cc = c & 31, ob = rr * 64 + cc * 2; return st * 1024 + (ob ^ (((ob >> 9) & 1) << 5)); }
__host__ __device__ __forceinline__ void stage_rc(int b, int& R, int& C) { const int st = b / 1024, sb = b % 1024, swz = sb ^ (((sb >> 9) & 1) << 5); R = (st >> 1) * 16 + swz / 64; C = (st & 1) * 32 + (swz % 64) / 2; }
__host__ __device__ __forceinline__ int perm32(int rho) { const int n = rho >> 4, i = rho & 15; return 8 * (i >> 2) + 4 * n + (i & 3); }

struct Unit { int pm, pn; };
struct Gemm { const bf16_t* A; const bf16_t* Bt; int M, N, K; };

struct StaticOrder {
    int nM, nN, nwg, G, c;
    __host__ __device__ void init(int M, int N, int G_, int c_) { nM = M / BM; nN = N / BM; nwg = nM * nN; G = G_; c = c_; }
    __host__ __device__ bool next(int i, Unit& u) const {
        const long L = (long)i * G + c; if (L >= nwg) return false;
        int wgid = (int)L; { const int q = nwg / NXCD, r = nwg % NXCD, xcd = wgid % NXCD, off = wgid / NXCD; wgid = (xcd < r ? xcd * (q + 1) : r * (q + 1) + (xcd - r) * q) + off; }
        const int nig = WGM * nN, gid = wgid / nig, fm = gid * WGM, gsz = (nM - fm) < WGM ? (nM - fm) : WGM;
        u.pm = fm + ((wgid % nig) % gsz); u.pn = (wgid % nig) / gsz; return true;
    }
    __device__ __forceinline__ void a_ready(const Unit&) const {}
    __device__ __forceinline__ void done(const Unit&) const {}
};
__device__ __forceinline__ unsigned cvt_pk_bf16(float lo, float hi) { unsigned r; asm volatile("v_cvt_pk_bf16_f32 %0, %1, %2" : "=v"(r) : "v"(lo), "v"(hi)); return r; }
struct EpiRowScaleBf16 {
    static constexpr bool PERM = true, AFTER_DRAIN = false;
    bf16_t* O; int ldc; const float* rs;
    __device__ __forceinline__ void operator()(const f32x4 (&acc)[2][2][4][2], const Unit& u, int wr, int wc, int fr, int fq) const {
        const int row0 = u.pm * BM + wr * 64 + fr, col0 = u.pn * BM + wc * 32 + 8 * fq;
#pragma unroll
        for (int ai = 0; ai < 2; ++ai)
#pragma unroll
            for (int m = 0; m < 4; ++m) { const int row = row0 + ai * HALF + m * 16; const float s = rs ? rs[row] : 1.f; bf16_t* rowp = O + (size_t)row * ldc + col0;
#pragma unroll
                for (int bj = 0; bj < 2; ++bj) { const f32x4 v0 = acc[ai][bj][m][0] * s, v1 = acc[ai][bj][m][1] * s;
                    u32x4 w; w.x = cvt_pk_bf16(v0[0], v0[1]); w.y = cvt_pk_bf16(v0[2], v0[3]); w.z = cvt_pk_bf16(v1[0], v1[1]); w.w = cvt_pk_bf16(v1[2], v1[3]);
                    *(u32x4*)(rowp + bj * HALF) = w; } }
    }
};
struct EpiResid {
    static constexpr bool PERM = true, AFTER_DRAIN = false;
    const float* x; float* out; bf16_t* xb; float* ssp; int ldc;
    __device__ __forceinline__ void operator()(const f32x4 (&acc)[2][2][4][2], const Unit& u, int wr, int wc, int fr, int fq) const {
        const int row0 = u.pm * BM + wr * 64 + fr, col0 = u.pn * BM + wc * 32 + 8 * fq;
#pragma unroll
        for (int ai = 0; ai < 2; ++ai)
#pragma unroll
            for (int m = 0; m < 4; ++m) { const int row = row0 + ai * HALF + m * 16; const size_t off = (size_t)row * ldc + col0; float ss = 0.f;
#pragma unroll
                for (int bj = 0; bj < 2; ++bj) { const f32x4 xa = *(const f32x4*)(x + off + bj * HALF), xc = *(const f32x4*)(x + off + bj * HALF + 4);
                    const f32x4 v0 = acc[ai][bj][m][0] + xa, v1 = acc[ai][bj][m][1] + xc;
                    *(f32x4*)(out + off + bj * HALF) = v0; *(f32x4*)(out + off + bj * HALF + 4) = v1;
                    u32x4 w; w.x = cvt_pk_bf16(v0[0], v0[1]); w.y = cvt_pk_bf16(v0[2], v0[3]); w.z = cvt_pk_bf16(v1[0], v1[1]); w.w = cvt_pk_bf16(v1[2], v1[3]);
                    *(u32x4*)(xb + off + bj * HALF) = w;
                    ss += (v0[0] * v0[0] + v0[1] * v0[1]) + (v0[2] * v0[2] + v0[3] * v0[3]) + (v1[0] * v1[0] + v1[1] * v1[1]) + (v1[2] * v1[2] + v1[3] * v1[3]); }
                ss += __shfl_xor(ss, 16); ss += __shfl_xor(ss, 32);
                if (fq == 0) ssp[(size_t)row * 32 + u.pn * 4 + wc] = ss; }
    }
};
template <class Epi, class Sched, bool ALIGN_EPI = false, bool SP2 = false>
__device__ __forceinline__ void gemm_phase(PG8_LAS unsigned char* lds, const Gemm g, const Sched& S, const Epi& E) {
    const int tid = threadIdx.x, wid = __builtin_amdgcn_readfirstlane(tid >> 6), lane = tid & 63, wr = wid >> 2, wc = wid & 3, fr = lane & 15, fq = lane >> 4;
    const int K = g.K, nt = K / BK;
    unsigned voffA[2], voffB[2];
#pragma unroll
    for (int i = 0; i < 2; ++i) { int R, C; stage_rc(tid * 16 + i * 8192, R, C); const int Rb = Epi::PERM ? ((R & ~31) + perm32(R & 31)) : R;
        voffA[i] = (unsigned)(R * K + C) * 2u; voffB[i] = (unsigned)(Rb * K + C) * 2u; }
    const size_t kstep = (size_t)(BK * 2);
    const size_t hstep = (size_t)HALF * K * 2;
    const size_t tstep = 2 * hstep;
    const unsigned ldsw = (unsigned)wid * 1024u;
    const int aoff = lds_byte(wr * 64 + fr, fq * 8), boff = lds_byte(wc * 32 + fr, fq * 8);
#define PG8_SA(b, h) (((b) * 2 + (h)) * HTB)
#define PG8_SB(b, h) ((4 + (b) * 2 + (h)) * HTB)
#define PG8_STAGE(bufoff, gbase, voff) do { _Pragma("unroll") for (int _i = 0; _i < 2; ++_i) \
        __builtin_amdgcn_global_load_lds((const unsigned*)((const char*)(gbase) + (voff)[_i]), (PG8_LAS unsigned*)(lds + (bufoff) + ldsw + _i * 8192), 16, 0, 0); } while (0)
#define PG8_LDA(dst, b, h) do { _Pragma("unroll") for (int m = 0; m < 4; ++m) _Pragma("unroll") for (int k = 0; k < 2; ++k) dst[m][k] = *(const PG8_LAS bf16x8*)(lds + PG8_SA(b, h) + aoff + m * 2048 + k * 1024); } while (0)
#define PG8_LDB(dst, b, h) do { _Pragma("unroll") for (int n = 0; n < 2; ++n) _Pragma("unroll") for (int k = 0; k < 2; ++k) dst[n][k] = *(const PG8_LAS bf16x8*)(lds + PG8_SB(b, h) + boff + n * 2048 + k * 1024); } while (0)
#define PG8_MMA(ai, bj, At, Bt) do { __builtin_amdgcn_s_setprio(1); _Pragma("unroll") for (int m = 0; m < 4; ++m) _Pragma("unroll") for (int n = 0; n < 2; ++n) _Pragma("unroll") for (int k = 0; k < 2; ++k) \
        acc[ai][bj][m][n] = __builtin_amdgcn_mfma_f32_16x16x32_bf16(Bt[n][k], At[m][k], acc[ai][bj][m][n], 0, 0, 0); __builtin_amdgcn_s_setprio(0); } while (0)
#define PG8_WAIT_V(n) asm volatile("s_waitcnt vmcnt(" #n ")" ::: "memory")
#define PG8_WAIT_L(n) asm volatile("s_waitcnt lgkmcnt(" #n ")" ::: "memory")
#define PG8_BAR __builtin_amdgcn_s_barrier()
#define PG8_SCHED __builtin_amdgcn_sched_barrier(0)
    Unit cur, nxt; int ui = 0;
    if (!S.next(0, cur)) return;
    f32x4 acc[2][2][4][2];
#pragma unroll
    for (int a = 0; a < 2; ++a)
#pragma unroll
        for (int b = 0; b < 2; ++b)
#pragma unroll
            for (int m = 0; m < 4; ++m)
#pragma unroll
                for (int n = 0; n < 2; ++n) acc[a][b][m][n] = (f32x4){0.f, 0.f, 0.f, 0.f};
    bf16x8 At[4][2], B0[2][2], B1[2][2];
    const char* cA = (const char*)g.A + (size_t)cur.pm * tstep; const char* cB = (const char*)g.Bt + (size_t)cur.pn * tstep;
    S.a_ready(cur);
    if constexpr (SP2) {
        PG8_STAGE(PG8_SB(0, 0), cB, voffB); PG8_STAGE(PG8_SB(0, 1), cB + hstep, voffB); PG8_STAGE(PG8_SA(0, 0), cA, voffA); PG8_STAGE(PG8_SA(0, 1), cA + hstep, voffA);
        if (wr == 1) PG8_BAR;
        PG8_WAIT_V(2); PG8_BAR;
        PG8_STAGE(PG8_SB(1, 0), cB + kstep, voffB); PG8_STAGE(PG8_SA(1, 0), cA + kstep, voffA); PG8_STAGE(PG8_SB(1, 1), cB + hstep + kstep, voffB);
        PG8_WAIT_V(6); PG8_BAR;
    } else {
        PG8_STAGE(PG8_SB(0, 0), cB, voffB); PG8_STAGE(PG8_SA(0, 0), cA, voffA); PG8_STAGE(PG8_SB(0, 1), cB + hstep, voffB); PG8_STAGE(PG8_SA(0, 1), cA + hstep, voffA);
        if (wr == 1) PG8_BAR;
        PG8_WAIT_V(4); PG8_BAR;
        PG8_STAGE(PG8_SB(1, 0), cB + kstep, voffB); PG8_STAGE(PG8_SA(1, 0), cA + kstep, voffA); PG8_STAGE(PG8_SB(1, 1), cB + hstep + kstep, voffB);
        PG8_WAIT_V(6); PG8_BAR;
    }
    for (;;) {
        const bool has_next = S.next(ui + 1, nxt);
        const char* nA = has_next ? (const char*)g.A + (size_t)nxt.pm * tstep : cA; const char* nB = has_next ? (const char*)g.Bt + (size_t)nxt.pn * tstep : cB;
        for (int t = 0; t < nt; t += 2) {
            const bool last = (t == nt - 2);
            const char* a1 = cA + (size_t)(t + 1) * kstep;
            const char* a2 = last ? nA : cA + (size_t)(t + 2) * kstep; const char* b2 = last ? nB : cB + (size_t)(t + 2) * kstep;
            const char* a3 = a2 + kstep; const char* b3 = b2 + kstep;
            if (last && has_next) S.a_ready(nxt);
            if constexpr (SP2) {
            PG8_LDB(B0, 0, 0); PG8_LDB(B1, 0, 1); PG8_SCHED; PG8_LDA(At, 0, 0); PG8_STAGE(PG8_SA(1, 1), a1 + hstep, voffA);
            PG8_WAIT_V(8); PG8_WAIT_L(0); PG8_BAR; PG8_MMA(0, 0, At, B0); PG8_MMA(0, 1, At, B1); PG8_BAR; PG8_SCHED;
            PG8_LDA(At, 0, 1); PG8_STAGE(PG8_SB(0, 0), b2, voffB); PG8_STAGE(PG8_SB(0, 1), b2 + hstep, voffB); PG8_STAGE(PG8_SA(0, 0), a2, voffA);
            PG8_WAIT_V(8); PG8_WAIT_L(0); PG8_BAR; PG8_MMA(1, 0, At, B0); PG8_MMA(1, 1, At, B1); PG8_BAR; PG8_SCHED;
            PG8_LDB(B0, 1, 0); PG8_LDB(B1, 1, 1); PG8_SCHED; PG8_LDA(At, 1, 0); PG8_STAGE(PG8_SA(0, 1), a2 + hstep, voffA);
            PG8_WAIT_V(8); PG8_WAIT_L(0); PG8_BAR; PG8_MMA(0, 0, At, B0); PG8_MMA(0, 1, At, B1); PG8_BAR; PG8_SCHED;
            PG8_LDA(At, 1, 1); PG8_STAGE(PG8_SB(1, 0), b3, voffB); PG8_STAGE(PG8_SB(1, 1), b3 + hstep, voffB); PG8_STAGE(PG8_SA(1, 0), a3, voffA);
            PG8_WAIT_V(8); PG8_WAIT_L(0); PG8_BAR; PG8_MMA(1, 0, At, B0); PG8_MMA(1, 1, At, B1); PG8_BAR; PG8_SCHED;
            } else {
            PG8_LDB(B0, 0, 0); PG8_SCHED; PG8_LDA(At, 0, 0); PG8_STAGE(PG8_SA(1, 1), a1 + hstep, voffA);
            PG8_WAIT_L(8); PG8_BAR; PG8_WAIT_L(0); PG8_MMA(0, 0, At, B0); PG8_BAR; PG8_SCHED;
            PG8_LDB(B1, 0, 1); PG8_STAGE(PG8_SB(0, 0), b2, voffB);
            PG8_BAR; PG8_WAIT_L(0); PG8_MMA(0, 1, At, B1); PG8_BAR;
            PG8_LDA(At, 0, 1); PG8_STAGE(PG8_SA(0, 0), a2, voffA);
            PG8_BAR; PG8_WAIT_L(0); PG8_MMA(1, 0, At, B0); PG8_BAR; PG8_SCHED;
            PG8_STAGE(PG8_SB(0, 1), b2 + hstep, voffB);
            PG8_WAIT_V(6); PG8_BAR; PG8_MMA(1, 1, At, B1); PG8_BAR;
            PG8_LDB(B0, 1, 0); PG8_SCHED; PG8_LDA(At, 1, 0); PG8_STAGE(PG8_SA(0, 1), a2 + hstep, voffA);
            PG8_WAIT_L(8); PG8_BAR; PG8_WAIT_L(0); PG8_MMA(0, 0, At, B0); PG8_BAR; PG8_SCHED;
            PG8_LDB(B1, 1, 1); PG8_STAGE(PG8_SB(1, 0), b3, voffB);
            PG8_BAR; PG8_WAIT_L(0); PG8_MMA(0, 1, At, B1); PG8_BAR;
            PG8_LDA(At, 1, 1); PG8_STAGE(PG8_SA(1, 0), a3, voffA);
            PG8_BAR; PG8_WAIT_L(0); PG8_MMA(1, 0, At, B0); PG8_BAR; PG8_SCHED;
            PG8_STAGE(PG8_SB(1, 1), b3 + hstep, voffB);
            PG8_WAIT_V(6); PG8_BAR; PG8_MMA(1, 1, At, B1); PG8_BAR;
            }
        }
        if constexpr (ALIGN_EPI) { if (wr == 0) PG8_BAR; }
        if constexpr (!Epi::AFTER_DRAIN) { E(acc, cur, wr, wc, fr, fq); S.done(cur); }
        if (!has_next) break;
#pragma unroll
        for (int a = 0; a < 2; ++a)
#pragma unroll
            for (int b = 0; b < 2; ++b)
#pragma unroll
                for (int m = 0; m < 4; ++m)
#pragma unroll
                    for (int n = 0; n < 2; ++n) acc[a][b][m][n] = (f32x4){0.f, 0.f, 0.f, 0.f};
        cur = nxt; cA = nA; cB = nB; ++ui;
        if constexpr (ALIGN_EPI) { if (wr == 1) PG8_BAR; }
    }
    PG8_WAIT_V(0);
    if constexpr (!ALIGN_EPI) { if (wr == 0) PG8_BAR; }
    PG8_BAR;
    if constexpr (Epi::AFTER_DRAIN) { E.fused(acc, cur, wr, wc, fr, fq, lds, wid, lane); S.done(cur); }
#undef PG8_SA
#undef PG8_SB
#undef PG8_STAGE
#undef PG8_LDA
#undef PG8_LDB
#undef PG8_MMA
#undef PG8_WAIT_V
#undef PG8_WAIT_L
#undef PG8_BAR
#undef PG8_SCHED
}
}
#ifndef PG8_SP2
#define PG8_SP2 true
#endif
#ifndef PG8_ALIGN
#define PG8_ALIGN true
#endif

constexpr int BATCH = 2, SEQ = 16384, DM = 2048, T = BATCH * SEQ;
constexpr int INW = 6176, HP = 6400;
constexpr int C_QA = 0, C_KA = 256, C_VA = 512, C_RA = 1024, C_QD = 1536, C_KD = 3072, C_VD = 4608, C_GF = 6144;
constexpr int NHD = 12;
constexpr float EPS = 1e-6f;
constexpr float LOG2E = 1.4426950408889634f;
constexpr float QSCALE = 0.08838834764831845f * LOG2E;
constexpr int NPHASE = 11;

constexpr size_t MiB = 1u << 20;
constexpr size_t WS_CTL = 0, WS_ROPE = 1 * MiB, WS_RS1 = 3 * MiB, WS_RS2 = 3 * MiB + 512 * 1024, WS_SSP = 4 * MiB, WS_WIN = 8 * MiB, WS_WO = 33 * MiB, WS_WQ = 41 * MiB,
                 WS_SK = 49 * MiB, WS_DEC = 50 * MiB, WS_LP = 51 * MiB, WS_IDX = 56 * MiB, WS_GATE = 72 * MiB, WS_DOWN = 88 * MiB, WS_UP = 152 * MiB, WS_XB = 216 * MiB,
                 WS_H = 344 * MiB, WS_X1B = WS_H, WS_QRY = WS_H + 128 * MiB, WS_OP1 = 744 * MiB, WS_OP2 = 840 * MiB, WS_PART = 472 * MiB  , WS_END = 984 * MiB;
constexpr size_t OUT_ST = 0, OUT_OP0 = 128 * MiB;
constexpr int LDS_BYTES = 147456;

#define LAS __attribute__((address_space(3)))
typedef unsigned short bf16_t;
typedef short bf16x8 __attribute__((ext_vector_type(8)));
typedef short s16x4 __attribute__((ext_vector_type(4)));
typedef float f32x4 __attribute__((ext_vector_type(4)));
typedef float f32x2 __attribute__((ext_vector_type(2)));
typedef float f32x16 __attribute__((ext_vector_type(16)));
typedef unsigned u32x4 __attribute__((ext_vector_type(4)));
typedef unsigned u32x2 __attribute__((ext_vector_type(2)));
#define LDS_WAIT() asm volatile("s_waitcnt lgkmcnt(0)" ::: "memory")
#define SBAR() __builtin_amdgcn_sched_barrier(0)

__device__ __forceinline__ float bf2f(unsigned short b) { return __uint_as_float(((unsigned)b) << 16); }
__device__ __forceinline__ float bflo(unsigned w) { return __uint_as_float(w << 16); }
__device__ __forceinline__ float bfhi(unsigned w) { return __uint_as_float(w & 0xffff0000u); }
__device__ __forceinline__ unsigned f2bf(float f) { unsigned u = __float_as_uint(f); return (u + 0x7fffu + ((u >> 16) & 1u)) >> 16; }
__device__ __forceinline__ unsigned pk2(float lo, float hi) { return pg8::cvt_pk_bf16(lo, hi); }
__device__ __forceinline__ float fexp(float x) { return __builtin_amdgcn_exp2f(x * LOG2E); }
__device__ __forceinline__ float flog(float x) { return __builtin_amdgcn_logf(x) * 0.6931471805599453f; }
__device__ __forceinline__ float wave_sum(float v) {
#pragma unroll
    for (int o = 1; o < 64; o <<= 1) v += __shfl_xor(v, o);
    return v;
}
__device__ __forceinline__ int crow(int r, int hi) { return (r & 3) + 8 * (r >> 2) + 4 * hi; }

struct Frame {
    LAS unsigned char* lds; char* ldsg; unsigned char* wsb;
    int tid, lane, wave, vcu, G;
    const float *x, *norm1_g, *w_in, *up_f, *bias_f, *up_b, *bias_b, *out_g, *qn_g, *kn_g, *w_out, *norm2_g, *w_query, *sub_keys, *peer_down, *peer_up;
    float* out;
    f32x2* rope; float *rs1, *rs2, *ssp, *dec, *lp, *gate, *state, *sd, *su, *sx, *csum; int *idx, *part; unsigned char *down8, *up8, *xq8, *fq8;
    bf16_t *WinT, *WoT, *WqT, *SK, *down16, *up16, *xb, *mixed, *h, *x1b, *qry, *op0, *op1, *op2;
};

__device__ __forceinline__ void p0_transpose_item(const float* W, int K, int N, bf16_t* WT, int k0, int n0, int dst_row0, const float* g, LAS float* scr, int lane) {
#pragma unroll 8
    for (int i = 0; i < 32; ++i) { const int kk = 2 * i + (lane >> 5); float w = W[(size_t)(k0 + kk) * N + n0 + (lane & 31)]; if (g) w *= g[k0 + kk]; scr[kk * 33 + (lane & 31)] = w; }
    LDS_WAIT(); asm volatile("" ::: "memory");
    const int c = lane & 7;
#pragma unroll
    for (int j = 0; j < 4; ++j) { const int n = (lane >> 3) + 8 * j; const LAS float* s = scr + (8 * c) * 33 + n;
        u32x4 o; o.x = pk2(s[0 * 33], s[1 * 33]); o.y = pk2(s[2 * 33], s[3 * 33]); o.z = pk2(s[4 * 33], s[5 * 33]); o.w = pk2(s[6 * 33], s[7 * 33]);
        *(u32x4*)(WT + (size_t)(dst_row0 + n) * K + k0 + 8 * c) = o; }
    LDS_WAIT(); asm volatile("" ::: "memory");
}
__device__ __forceinline__ void phase0(const Frame& F) {
    LAS float* scr = (LAS float*)(F.lds + F.wave * 16384);
    const int gw = F.vcu * 8 + F.wave, NGW = F.G * 8, lane = F.lane;
    constexpr int I_IN = 32 * 193, I_O = 32 * 64, I_Q = 32 * 64;
    for (int it = gw; it < I_IN + I_O + I_Q; it += NGW) {
        int r = it;
        if (r < I_IN) { const int kb = r / 193, nb = r % 193; const int drow = nb < 32 ? nb * 32 : (nb == 32 ? C_GF : nb * 32 - 32);
            p0_transpose_item(F.w_in, DM, INW, F.WinT, kb * 64, nb * 32, drow, F.norm1_g, scr, lane); continue; }
        r -= I_IN;
        if (r < I_O) { const int kb = r / 64, nb = r % 64; p0_transpose_item(F.w_out, DM, DM, F.WoT, kb * 64, nb * 32, nb * 32, nullptr, scr, lane); continue; }
        r -= I_O;
        { const int kb = r / 64, nb = r % 64; p0_transpose_item(F.w_query, DM, DM, F.WqT, kb * 64, nb * 32, nb * 32, F.norm2_g, scr, lane); }
    }
    const size_t gt = (size_t)gw * 64 + lane, NT = (size_t)NGW * 64;
    { u32x4* z = (u32x4*)(F.WinT + (size_t)INW * DM); const u32x4 zero = {0u, 0u, 0u, 0u}; for (size_t i = gt; i < (size_t)(HP - INW) * DM / 8; i += NT) z[i] = zero; }
    for (int r = gw; r < 2 * 16384; r += NGW) { const bool isup = r >= 16384; const int e = r & 16383; const f32x4* src = (const f32x4*)((isup ? F.peer_up : F.peer_down) + (size_t)e * DM) + lane;
        f32x4 v[8]; float m = 0.f;
#pragma unroll
        for (int j = 0; j < 8; ++j) { v[j] = src[64 * j]; if (!isup) v[j] = v[j] * ((const f32x4*)F.norm2_g)[lane + 64 * j];
            m = fmaxf(fmaxf(m, fmaxf(fabsf(v[j][0]), fabsf(v[j][1]))), fmaxf(fabsf(v[j][2]), fabsf(v[j][3]))); }
#pragma unroll
        for (int o = 1; o < 64; o <<= 1) m = fmaxf(m, __shfl_xor(m, o));
        const float inv = m > 0.f ? 127.f / m : 0.f; unsigned char* dst = isup ? F.up8 : F.down8; const int bias = 0;
#pragma unroll
        for (int j = 0; j < 8; ++j) { unsigned w = 0u;
#pragma unroll
            for (int i = 0; i < 4; ++i) { const int qv = (int)rintf(v[j][i] * inv) + bias; w |= ((unsigned)qv & 0xffu) << (8 * i); }
            const int col = 4 * lane + 256 * j; *(unsigned*)(dst + ((size_t)(col >> 7) * 16384 + e) * 128 + (col & 127)) = w; }
        if (lane == 0) (isup ? F.su : F.sd)[e] = m * (1.f / 127.f); }
    for (size_t i = gt; i < (size_t)8 * 2 * 128 * 128 / 8; i += NT) { const f32x4 a = *(const f32x4*)(F.sub_keys + i * 8), b = *(const f32x4*)(F.sub_keys + i * 8 + 4);
        u32x4 o; o.x = pk2(a[0], a[1]); o.y = pk2(a[2], a[3]); o.z = pk2(b[0], b[1]); o.w = pk2(b[2], b[3]); *(u32x4*)(F.SK + i * 8) = o; }
    for (int m = gw; m < T; m += NGW) { const f32x4* xr = (const f32x4*)(F.x + (size_t)m * DM) + lane; f32x4 v[8]; float s = 0.f;
#pragma unroll
        for (int j = 0; j < 8; ++j) { v[j] = xr[64 * j]; s += (v[j][0] * v[j][0] + v[j][1] * v[j][1]) + (v[j][2] * v[j][2] + v[j][3] * v[j][3]); }
        s = wave_sum(s); u32x2* o8 = (u32x2*)(F.xb + (size_t)m * DM) + lane;
#pragma unroll
        for (int j = 0; j < 8; ++j) { u32x2 w; w.x = pk2(v[j][0], v[j][1]); w.y = pk2(v[j][2], v[j][3]); o8[64 * j] = w; }
        if (lane == 0) F.rs1[m] = __builtin_amdgcn_rsqf(s * (1.f / DM) + EPS); }
    { const double invf[16] = {1.0, 0.44036660267178046, 0.19392274474868576, 0.08539710028576561, 0.03760603093086393, 0.016560440080994446, 0.007292664737217109, 0.003211445994752591,
                               0.001414213562373095, 0.000622772421914596, 0.0002742481756762073, 0.00012076973741146504, 5.318295896944988e-05, 2.341999896140934e-05, 1.031338537721246e-05, 4.5416704806078695e-06};
      for (size_t i = gt; i < (size_t)SEQ * 16; i += NT) { const int pos = (int)(i >> 4), j = (int)(i & 15); double f = 1.0;
#pragma unroll
          for (int q = 0; q < 16; ++q) f = (j == q) ? invf[q] : f;
          const double rev = (double)pos * f * 0.15915494309189535; const float fr = (float)(rev - floor(rev));
          F.rope[i] = (f32x2){__builtin_amdgcn_cosf(fr), __builtin_amdgcn_sinf(fr)}; } }
}

__device__ __forceinline__ void qknorm_rope(const Frame& F) {
    const int gw = F.vcu * 8 + F.wave, NGW = F.G * 8, lane = F.lane, c = lane & 15;
    for (long it = gw; it < (long)T * 24 / 4; it += NGW) { const long row = it * 4 + (lane >> 4); const int t = (int)(row / 24), slot = (int)(row % 24);
        bf16_t* p = F.h + (size_t)t * HP + C_QD + slot * 128 + 8 * c;
        const u32x4 w = *(const u32x4*)p; float y[8] = {bflo(w.x), bfhi(w.x), bflo(w.y), bfhi(w.y), bflo(w.z), bfhi(w.z), bflo(w.w), bfhi(w.w)};
        float ss = 0.f;
#pragma unroll
        for (int e = 0; e < 8; ++e) ss += y[e] * y[e];
        ss += __shfl_xor(ss, 1); ss += __shfl_xor(ss, 2); ss += __shfl_xor(ss, 4); ss += __shfl_xor(ss, 8);
        const float rq = __builtin_amdgcn_rsqf(ss * (1.f / 128.f) + EPS); const float* g = (slot < 12 ? F.qn_g : F.kn_g) + 8 * c;
        const f32x4 g0 = *(const f32x4*)g, g1 = *(const f32x4*)(g + 4);
#pragma unroll
        for (int e = 0; e < 4; ++e) { y[e] *= rq * g0[e]; y[4 + e] *= rq * g1[e]; }
        const int pos = t & (SEQ - 1);
#pragma unroll
        for (int e = 0; e < 8; ++e) { const float partner = __shfl_xor(y[e], 2);
            if (c < 4) { const f32x2 cs = F.rope[(size_t)pos * 16 + 8 * (c & 1) + e]; y[e] = (c < 2) ? (y[e] * cs.x - partner * cs.y) : (y[e] * cs.x + partner * cs.y); } }
        if (slot < 12) {
#pragma unroll
            for (int e = 0; e < 8; ++e) y[e] *= QSCALE; }
        u32x4 o; o.x = pk2(y[0], y[1]); o.y = pk2(y[2], y[3]); o.z = pk2(y[4], y[5]); o.w = pk2(y[6], y[7]); *(u32x4*)p = o; }
}

constexpr int GL_GDS = 0, GL_TOT = 8192, GL_QF = 12288, GL_QB = 21504, GL_KF = 30720, GL_KB = 39936, GL_VT = 49152, GL_P = 67584, GL_SF = 76800, GL_SB = 95232, GL_OB = 12288;
constexpr int RS72 = 144;
__device__ __forceinline__ float logsig(float z) { return fminf(z, 0.f) - flog(1.f + fexp(-fabsf(z))); }
__device__ __forceinline__ void gla_gates(const Frame& F, int b, int hh, int n, float (&bf)[8], float (&bb)[8], float& totf, float& totb) {
    const int tid = F.tid, c = tid & 63, ig = F.wave; LAS float* gds = (LAS float*)(F.lds + GL_GDS); LAS float* tot = (LAS float*)(F.lds + GL_TOT);
    const size_t t0 = (size_t)b * SEQ + (size_t)n * 64;
    if (tid < 256) { const int tk = tid >> 2, part = tid & 3; const u32x4 w = *(const u32x4*)(F.h + (t0 + tk) * HP + C_GF + part * 8); LAS float* d = gds + tk * 32 + part * 8;
        d[0] = bflo(w.x); d[1] = bfhi(w.x); d[2] = bflo(w.y); d[3] = bfhi(w.y); d[4] = bflo(w.z); d[5] = bfhi(w.z); d[6] = bflo(w.w); d[7] = bfhi(w.w); }
    __syncthreads();
    const int hc = hh * 64 + c; float upf[16], upb[16];
#pragma unroll
    for (int r = 0; r < 16; ++r) { upf[r] = F.up_f[r * 256 + hc]; upb[r] = F.up_b[r * 256 + hc]; }
    const float biasf = F.bias_f[hc], biasb = F.bias_b[hc]; float laf[8], lab[8];
#pragma unroll
    for (int e = 0; e < 8; ++e) { const LAS float* gr = gds + (ig * 8 + e) * 32; float zf = biasf, zb = biasb;
#pragma unroll
        for (int r = 0; r < 16; ++r) { zf += gr[r] * upf[r]; zb += gr[16 + r] * upb[r]; }
        laf[e] = logsig(zf) * 0.0625f; lab[e] = logsig(zb) * 0.0625f; }
    bf[0] = laf[0];
#pragma unroll
    for (int e = 1; e < 8; ++e) bf[e] = bf[e - 1] + laf[e];
    bb[7] = lab[7];
#pragma unroll
    for (int e = 6; e >= 0; --e) bb[e] = bb[e + 1] + lab[e];
    tot[ig * 64 + c] = bf[7]; tot[512 + ig * 64 + c] = bb[0];
    __syncthreads();
    float offf = 0.f, offb = 0.f; totf = 0.f; totb = 0.f;
#pragma unroll
    for (int g = 0; g < 8; ++g) { const float tf = tot[g * 64 + c], tb = tot[512 + g * 64 + c]; totf += tf; totb += tb; offf += (g < ig) ? tf : 0.f; offb += (g > ig) ? tb : 0.f; }
#pragma unroll
    for (int e = 0; e < 8; ++e) { bf[e] += offf; bb[e] += offb; }
}
__device__ __forceinline__ void gla_stage_vT(const Frame& F, size_t t0, int hh) {
#pragma unroll
    for (int j = 0; j < 2; ++j) { const int q = F.tid + 512 * j, tk = q >> 4, vc = (q & 15) * 8; const bf16x8 v = *(const bf16x8*)(F.h + (t0 + tk) * HP + C_VA + hh * 128 + vc);
        LAS short* d = (LAS short*)(F.lds + GL_VT) + vc * 72 + tk;
#pragma unroll
        for (int e = 0; e < 8; ++e) d[e * 72] = v[e]; }
}
__device__ __forceinline__ bf16x8 ldfrag(const LAS unsigned char* base, int row, int s, int hi) { return *(const LAS bf16x8*)(base + row * RS72 + (16 * s + 8 * hi) * 2); }

__device__ __forceinline__ void gla_passA(const Frame& F, int item) {
    const int bh = item >> 8, n = item & 255, b = bh >> 2, hh = bh & 3, tid = F.tid, c = tid & 63, ig = F.wave, lane = F.lane, r32 = lane & 31, hi = lane >> 5;
    float bf[8], bb[8], totf, totb; gla_gates(F, b, hh, n, bf, bb, totf, totb);
    const size_t t0 = (size_t)b * SEQ + (size_t)n * 64;
    float kf[8], kb[8];
#pragma unroll
    for (int e = 0; e < 8; ++e) { const float k = bf2f(F.h[(t0 + ig * 8 + e) * HP + C_KA + hh * 64 + c]); kf[e] = k * fexp(totf - bf[e]); kb[e] = k * fexp(totb - bb[e]); }
    { u32x4 o; o.x = pk2(kf[0], kf[1]); o.y = pk2(kf[2], kf[3]); o.z = pk2(kf[4], kf[5]); o.w = pk2(kf[6], kf[7]); *(LAS u32x4*)(F.lds + GL_KF + c * RS72 + ig * 16) = o;
      o.x = pk2(kb[0], kb[1]); o.y = pk2(kb[2], kb[3]); o.z = pk2(kb[4], kb[5]); o.w = pk2(kb[6], kb[7]); *(LAS u32x4*)(F.lds + GL_KB + c * RS72 + ig * 16) = o; }
    gla_stage_vT(F, t0, hh);
    if (ig == 0) { F.dec[((size_t)(0 * 8 + bh) * 256 + n) * 64 + c] = fexp(totf); F.dec[((size_t)(1 * 8 + bh) * 256 + n) * 64 + c] = fexp(totb); }
    __syncthreads();
    const int dir = F.wave >> 2, vt = F.wave & 3; const LAS unsigned char* kimg = F.lds + (dir ? GL_KB : GL_KF);
    f32x16 a0 = {}, a1 = {};
#pragma unroll
    for (int s = 0; s < 4; ++s) { const bf16x8 av = ldfrag(F.lds + GL_VT, 32 * vt + r32, s, hi), b0 = ldfrag(kimg, r32, s, hi), b1 = ldfrag(kimg, 32 + r32, s, hi);
        a0 = __builtin_amdgcn_mfma_f32_32x32x16_bf16(av, b0, a0, 0, 0, 0); a1 = __builtin_amdgcn_mfma_f32_32x32x16_bf16(av, b1, a1, 0, 0, 0); }
    float* st = F.state + ((size_t)(dir * 8 + bh) * 256 + n) * 8192;
#pragma unroll
    for (int r = 0; r < 16; ++r) { const int v = 32 * vt + crow(r, hi); st[v * 64 + r32] = a0[r]; st[v * 64 + 32 + r32] = a1[r]; }
    __syncthreads();
}
__device__ __forceinline__ void gla_scan(const Frame& F, int item) {
    const int dir = item >> 7, bh = (item >> 4) & 7, e = (item & 15) * 512 + F.tid, c = e & 63;
    float* st = F.state + (size_t)(dir * 8 + bh) * 256 * 8192 + e; const float* dc = F.dec + (size_t)(dir * 8 + bh) * 256 * 64 + c; float S = 0.f;
    for (int g = 0; g < 32; ++g) { float inc[8], d[8];
#pragma unroll
        for (int j = 0; j < 8; ++j) { const int n = dir ? 255 - (g * 8 + j) : g * 8 + j; inc[j] = st[(size_t)n * 8192]; d[j] = dc[n * 64]; }
#pragma unroll
        for (int j = 0; j < 8; ++j) { const int n = dir ? 255 - (g * 8 + j) : g * 8 + j; st[(size_t)n * 8192] = S; S = d[j] * S + inc[j]; } }
}
__device__ __forceinline__ void gla_passC(const Frame& F, int item) {
    const int bh = item >> 8, n = item & 255, b = bh >> 2, hh = bh & 3, tid = F.tid, c = tid & 63, ig = F.wave, lane = F.lane, r32 = lane & 31, hi = lane >> 5;
    float bf[8], bb[8], totf, totb; gla_gates(F, b, hh, n, bf, bb, totf, totb);
    const size_t t0 = (size_t)b * SEQ + (size_t)n * 64;
#pragma unroll
    for (int e = 0; e < 8; ++e) { const int i = ig * 8 + e; const bf16_t* hr = F.h + (t0 + i) * HP + hh * 64 + c; const float q = bf2f(hr[C_QA]) * 0.125f, k = bf2f(hr[C_KA]);
        const float ef = fexp(bf[e]), eb = fexp(bb[e]), nf = fexp(-bf[e]), nb = fexp(-bb[e]);
        *(LAS unsigned short*)(F.lds + GL_QF + i * RS72 + c * 2) = (unsigned short)f2bf(q * ef); *(LAS unsigned short*)(F.lds + GL_QB + i * RS72 + c * 2) = (unsigned short)f2bf(q * eb);
        *(LAS unsigned short*)(F.lds + GL_KF + i * RS72 + c * 2) = (unsigned short)f2bf(k * nf); *(LAS unsigned short*)(F.lds + GL_KB + i * RS72 + c * 2) = (unsigned short)f2bf(k * nb); }
    gla_stage_vT(F, t0, hh);
#pragma unroll
    for (int dir = 0; dir < 2; ++dir) { const float* st = F.state + ((size_t)(dir * 8 + bh) * 256 + n) * 8192; LAS unsigned char* img = F.lds + (dir ? GL_SB : GL_SF);
#pragma unroll
        for (int j = 0; j < 4; ++j) { const int q4 = tid + 512 * j, v = q4 >> 4, c4 = (q4 & 15) * 4; const f32x4 s = *(const f32x4*)(st + v * 64 + c4);
            u32x2 w; w.x = pk2(s[0], s[1]); w.y = pk2(s[2], s[3]); *(LAS u32x2*)(img + v * RS72 + c4 * 2) = w; } }
    __syncthreads();
    if (F.wave < 4) { const int ti = F.wave >> 1, tj = F.wave & 1; f32x16 sf = {}, sb = {};
#pragma unroll
        for (int s = 0; s < 4; ++s) {
            sf = __builtin_amdgcn_mfma_f32_32x32x16_bf16(ldfrag(F.lds + GL_QF, 32 * ti + r32, s, hi), ldfrag(F.lds + GL_KF, 32 * tj + r32, s, hi), sf, 0, 0, 0);
            sb = __builtin_amdgcn_mfma_f32_32x32x16_bf16(ldfrag(F.lds + GL_QB, 32 * ti + r32, s, hi), ldfrag(F.lds + GL_KB, 32 * tj + r32, s, hi), sb, 0, 0, 0); }
#pragma unroll
        for (int r = 0; r < 16; ++r) { const int i = 32 * ti + crow(r, hi), j = 32 * tj + r32; const float p = (j <= i) ? sf[r] : sb[r];
            *(LAS unsigned short*)(F.lds + GL_P + i * RS72 + j * 2) = (unsigned short)f2bf(p); } }
    __syncthreads();
    const int ti = F.wave & 1, tv = F.wave >> 1; f32x16 o = {};
#pragma unroll
    for (int s = 0; s < 4; ++s) o = __builtin_amdgcn_mfma_f32_32x32x16_bf16(ldfrag(F.lds + GL_P, 32 * ti + r32, s, hi), ldfrag(F.lds + GL_VT, 32 * tv + r32, s, hi), o, 0, 0, 0);
#pragma unroll
    for (int s = 0; s < 4; ++s) o = __builtin_amdgcn_mfma_f32_32x32x16_bf16(ldfrag(F.lds + GL_QF, 32 * ti + r32, s, hi), ldfrag(F.lds + GL_SF, 32 * tv + r32, s, hi), o, 0, 0, 0);
#pragma unroll
    for (int s = 0; s < 4; ++s) o = __builtin_amdgcn_mfma_f32_32x32x16_bf16(ldfrag(F.lds + GL_QB, 32 * ti + r32, s, hi), ldfrag(F.lds + GL_SB, 32 * tv + r32, s, hi), o, 0, 0, 0);
    __syncthreads();
    LAS float* ob = (LAS float*)(F.lds + GL_OB);
#pragma unroll
    for (int r = 0; r < 16; ++r) ob[(32 * ti + crow(r, hi)) * 132 + 32 * tv + r32] = o[r];
    __syncthreads();
    { const int i = tid >> 3, part = tid & 7, v0 = part * 16; float ov[16], ss = 0.f;
#pragma unroll
      for (int e = 0; e < 16; ++e) { ov[e] = ob[i * 132 + v0 + e]; ss += ov[e] * ov[e]; }
      ss += __shfl_xor(ss, 1); ss += __shfl_xor(ss, 2); ss += __shfl_xor(ss, 4);
      const float rs = __builtin_amdgcn_rsqf(ss * (1.f / 128.f) + EPS); const size_t tok = t0 + i;
      const u32x4 r0 = *(const u32x4*)(F.h + tok * HP + C_RA + hh * 128 + v0), r1 = *(const u32x4*)(F.h + tok * HP + C_RA + hh * 128 + v0 + 8);
      const float rr[16] = {bflo(r0.x), bfhi(r0.x), bflo(r0.y), bfhi(r0.y), bflo(r0.z), bfhi(r0.z), bflo(r0.w), bfhi(r0.w), bflo(r1.x), bfhi(r1.x), bflo(r1.y), bfhi(r1.y), bflo(r1.z), bfhi(r1.z), bflo(r1.w), bfhi(r1.w)};
      float y[16];
#pragma unroll
      for (int e = 0; e < 16; ++e) { const float g = F.out_g[hh * 128 + v0 + e]; const float sil = rr[e] * __builtin_amdgcn_rcpf(1.f + fexp(-rr[e])); y[e] = ov[e] * rs * g * sil; }
      u32x4 w0, w1; w0.x = pk2(y[0], y[1]); w0.y = pk2(y[2], y[3]); w0.z = pk2(y[4], y[5]); w0.w = pk2(y[6], y[7]); w1.x = pk2(y[8], y[9]); w1.y = pk2(y[10], y[11]); w1.z = pk2(y[12], y[13]); w1.w = pk2(y[14], y[15]);
      bf16_t* mp = F.mixed + tok * DM + hh * 128 + v0; *(u32x4*)mp = w0; *(u32x4*)(mp + 8) = w1; }
    __syncthreads();
}

constexpr int AT_V = 0, AT_K = 32768, AT_O = 65536;
#define KSWZ(row, colB) ((row) * 256 + ((colB) ^ (((row) & 7) << 4)))
__device__ __forceinline__ int v_st(int k, int c) { const int kk = (k & ~0xC) | ((k & 4) << 1) | ((k & 8) >> 1); return ((kk >> 3) * 4 + (c >> 5)) * 512 + ((kk & 7) * 32 + (c & 31)) * 2; }
__device__ __forceinline__ int v_rd_base(int lane) { return ((lane & 3) << 3) | (((lane >> 2) & 3) << 6) | (((lane >> 4) & 1) << 5) | (((lane >> 5) & 1) << 8); }
constexpr int v_rd_off(int d0, int ks, int half) { return d0 * 512 + ks * 4096 + half * 2048; }
template <int OFF> __device__ __forceinline__ s16x4 tr_read(int vb) { s16x4 r; asm volatile("ds_read_b64_tr_b16 %0, %1 offset:%2" : "=&v"(r) : "v"(vb), "i"(OFF) : "memory"); return r; }
template <int D0> __device__ __forceinline__ void pv_one(f32x16& od, int vb, bf16x8 pa0, bf16x8 pa1, bf16x8 pa2, bf16x8 pa3) {
    const s16x4 l0 = tr_read<v_rd_off(D0, 0, 0)>(vb), h0 = tr_read<v_rd_off(D0, 0, 1)>(vb), l1 = tr_read<v_rd_off(D0, 1, 0)>(vb), h1 = tr_read<v_rd_off(D0, 1, 1)>(vb);
    const s16x4 l2 = tr_read<v_rd_off(D0, 2, 0)>(vb), h2 = tr_read<v_rd_off(D0, 2, 1)>(vb), l3 = tr_read<v_rd_off(D0, 3, 0)>(vb), h3 = tr_read<v_rd_off(D0, 3, 1)>(vb);
    asm volatile("s_waitcnt lgkmcnt(0)" ::: "memory"); SBAR();
#define PKV(L, H) (bf16x8){L[0], L[1], L[2], L[3], H[0], H[1], H[2], H[3]}
    od = __builtin_amdgcn_mfma_f32_32x32x16_bf16(pa0, PKV(l0, h0), od, 0, 0, 0);
    od = __builtin_amdgcn_mfma_f32_32x32x16_bf16(pa1, PKV(l1, h1), od, 0, 0, 0);
    od = __builtin_amdgcn_mfma_f32_32x32x16_bf16(pa2, PKV(l2, h2), od, 0, 0, 0);
    od = __builtin_amdgcn_mfma_f32_32x32x16_bf16(pa3, PKV(l3, h3), od, 0, 0, 0);
#undef PKV
}
__device__ __forceinline__ void attn_item(const Frame& F, int item) {
    const int tid = F.tid, wid = F.wave, lane = F.lane, r32 = lane & 31, hi = lane >> 5;
    const int p = item / 1536, rem = item % 1536, b = rem / 768, rem2 = rem % 768, head = rem2 >> 6, u = rem2 & 63;
    const int dsh = 2 * p, dil = 1 << dsh, L = SEQ >> dsh, runs = 64 >> dsh, res = u / runs, m0 = (u % runs) * 256;
    const size_t tokbase = (size_t)b * SEQ + res;
    bf16_t* Op = (bf16_t*)(p == 0 ? (unsigned char*)F.out + OUT_OP0 : F.wsb + (p == 1 ? WS_OP1 : WS_OP2));
    const bf16_t* hq = F.h + C_QD + head * 128; const bf16_t* hk = F.h + C_KD + head * 128; const bf16_t* hv = F.h + C_VD + head * 128;
    const int Q0 = m0 + 32 * wid;
    bf16x8 qr[8];
    { const bf16_t* qp = hq + (tokbase + (size_t)dil * (Q0 + r32)) * HP + hi * 8;
#pragma unroll
      for (int d0 = 0; d0 < 8; ++d0) qr[d0] = *(const bf16x8*)(qp + d0 * 16); }
    const int sr = tid >> 4, sc = (tid & 15) * 8, vst0 = v_st(sr, sc), vst1 = v_st(32 + sr, sc), kc = sc * 2;
    const int vb0 = (int)(unsigned)(uintptr_t)(F.ldsg + AT_V) + v_rd_base(lane);
    const int kt_lo = (m0 == 0) ? 1 : 0, kt_hi = (m0 + 256 >= L) ? 4 : 5;
    f32x16 o[4] = {}; float l_reg = 0.f;
    bf16x8 sv0, sv1, sk0, sk1;
#define AT_SLOAD(T0) do { const size_t ra = (tokbase + (size_t)dil * ((T0) + sr)) * HP + sc, rb = (tokbase + (size_t)dil * ((T0) + 32 + sr)) * HP + sc; \
        sv0 = *(const bf16x8*)(hv + ra); sv1 = *(const bf16x8*)(hv + rb); sk0 = *(const bf16x8*)(hk + ra); sk1 = *(const bf16x8*)(hk + rb); } while (0)
#define AT_SWRITE(B) do { *(LAS bf16x8*)(F.lds + AT_V + (B) * 16384 + vst0) = sv0; *(LAS bf16x8*)(F.lds + AT_V + (B) * 16384 + vst1) = sv1; \
        *(LAS bf16x8*)(F.lds + AT_K + (B) * 16384 + KSWZ(sr, kc)) = sk0; *(LAS bf16x8*)(F.lds + AT_K + (B) * 16384 + KSWZ(32 + sr, kc)) = sk1; } while (0)
    AT_SLOAD(m0 - 64 + 64 * kt_lo); AT_SWRITE(0); __syncthreads();
    int buf = 0;
    for (int kt = kt_lo; kt <= kt_hi; ++kt) {
        const int T0 = m0 - 64 + 64 * kt; const bool more = kt < kt_hi;
        if (more) AT_SLOAD(T0 + 64);
        if (T0 + 63 >= Q0 - 64 && T0 <= Q0 + 95) {
            const LAS unsigned char* Ks = F.lds + AT_K + buf * 16384; f32x16 p0 = {}, p1 = {};
#pragma unroll
            for (int d0 = 0; d0 < 8; ++d0) { const int cb = (d0 * 16 + hi * 8) * 2;
                const bf16x8 k0 = *(const LAS bf16x8*)(Ks + KSWZ(r32, cb)), k1 = *(const LAS bf16x8*)(Ks + KSWZ(32 + r32, cb));
                p0 = __builtin_amdgcn_mfma_f32_32x32x16_bf16(k0, qr[d0], p0, 0, 0, 0); p1 = __builtin_amdgcn_mfma_f32_32x32x16_bf16(k1, qr[d0], p1, 0, 0, 0); }
            const int dq = T0 - (Q0 + r32); float ps = 0.f;
#pragma unroll
            for (int r = 0; r < 16; ++r) { const int e0 = dq + crow(r, hi), e1 = e0 + 32;
                p0[r] = (e0 >= -64 && e0 <= 64) ? __builtin_amdgcn_exp2f(p0[r]) : 0.f; p1[r] = (e1 >= -64 && e1 <= 64) ? __builtin_amdgcn_exp2f(p1[r]) : 0.f; ps += p0[r] + p1[r]; }
            l_reg += ps;
            bf16x8 pa0, pa1, pa2, pa3;
#define PK4(P, BASE, OUT) do { unsigned a0_ = pk2(P[BASE + 0], P[BASE + 1]), a1_ = pk2(P[BASE + 2], P[BASE + 3]); unsigned b0_ = pk2(P[BASE + 4], P[BASE + 5]), b1_ = pk2(P[BASE + 6], P[BASE + 7]); \
        auto r0_ = __builtin_amdgcn_permlane32_swap(a0_, b0_, false, false); auto r1_ = __builtin_amdgcn_permlane32_swap(a1_, b1_, false, false); \
        u32x4 w_ = {r0_[0], r1_[0], r0_[1], r1_[1]}; OUT = __builtin_bit_cast(bf16x8, w_); } while (0)
            PK4(p0, 0, pa0); PK4(p0, 8, pa1); PK4(p1, 0, pa2); PK4(p1, 8, pa3);
#undef PK4
            const int vb = vb0 + buf * 16384;
            pv_one<0>(o[0], vb, pa0, pa1, pa2, pa3); pv_one<1>(o[1], vb, pa0, pa1, pa2, pa3); pv_one<2>(o[2], vb, pa0, pa1, pa2, pa3); pv_one<3>(o[3], vb, pa0, pa1, pa2, pa3);
        }
        if (more) AT_SWRITE(buf ^ 1);
        __syncthreads(); buf ^= 1;
    }
#undef AT_SLOAD
#undef AT_SWRITE
    l_reg += __shfl_xor(l_reg, 32);
    if (hi == 0) F.lp[((size_t)p * T + tokbase + (size_t)dil * (Q0 + r32)) * NHD + head] = l_reg;
    LAS unsigned char* stg = F.lds + AT_O + wid * 8192;
#pragma unroll
    for (int d0 = 0; d0 < 4; ++d0)
#pragma unroll
        for (int r = 0; r < 16; ++r) *(LAS unsigned short*)(stg + (crow(r, hi) * 128 + d0 * 32 + r32) * 2) = (unsigned short)f2bf(o[d0][r]);
    LDS_WAIT(); asm volatile("" ::: "memory");
#pragma unroll
    for (int it = 0; it < 8; ++it) { const int row = 4 * it + (lane >> 4), ch = lane & 15; const u32x4 w = *(const LAS u32x4*)(stg + row * 256 + ch * 16);
        *(u32x4*)(Op + (tokbase + (size_t)dil * (Q0 + row)) * (NHD * 128) + head * 128 + ch * 8) = w; }
    __syncthreads();
}
__device__ __forceinline__ void dil_combine(const Frame& F) {
    const int gw = F.vcu * 8 + F.wave, NGW = F.G * 8, lane = F.lane, c = lane & 15;
    for (long it = gw; it < (long)T * NHD / 4; it += NGW) { const long row = it * 4 + (lane >> 4); const size_t tok = (size_t)(row / NHD); const int head = (int)(row % NHD);
        const float l = F.lp[tok * NHD + head] + F.lp[((size_t)T + tok) * NHD + head] + F.lp[((size_t)2 * T + tok) * NHD + head]; const float inv = 1.f / l;
        const size_t off = tok * (NHD * 128) + head * 128 + 8 * c; const u32x4 a = *(const u32x4*)(F.op0 + off), b = *(const u32x4*)(F.op1 + off), d = *(const u32x4*)(F.op2 + off);
        u32x4 o; o.x = pk2((bflo(a.x) + bflo(b.x) + bflo(d.x)) * inv, (bfhi(a.x) + bfhi(b.x) + bfhi(d.x)) * inv); o.y = pk2((bflo(a.y) + bflo(b.y) + bflo(d.y)) * inv, (bfhi(a.y) + bfhi(b.y) + bfhi(d.y)) * inv);
        o.z = pk2((bflo(a.z) + bflo(b.z) + bflo(d.z)) * inv, (bfhi(a.z) + bfhi(b.z) + bfhi(d.z)) * inv); o.w = pk2((bflo(a.w) + bflo(b.w) + bflo(d.w)) * inv, (bfhi(a.w) + bfhi(b.w) + bfhi(d.w)) * inv);
        *(u32x4*)(F.mixed + tok * DM + 512 + head * 128 + 8 * c) = o; }
}

__device__ __forceinline__ unsigned fl_flip(float x) { const unsigned u = __float_as_uint(x); return u ^ ((unsigned)((int)u >> 31) | 0x80000000u); }
__device__ __forceinline__ float fl_unflip(unsigned w) { return __uint_as_float((w & 0x80000000u) ? (w ^ 0x80000000u) : ~w); }
#define CE_DESC(a, b) do { const unsigned x_ = max(a, b), y_ = min(a, b); a = x_; b = y_; } while (0)
__device__ __forceinline__ void sort16_desc(unsigned (&a)[16]) {
#pragma unroll
    for (int k = 2; k <= 16; k <<= 1)
#pragma unroll
        for (int j = k >> 1; j > 0; j >>= 1)
#pragma unroll
            for (int i = 0; i < 16; ++i) { const int l = i ^ j; if (l > i) { const unsigned x = max(a[i], a[l]), y = min(a[i], a[l]); if ((i & k) == 0) { a[i] = x; a[l] = y; } else { a[i] = y; a[l] = x; } } }
}
__device__ __forceinline__ void bmerge16_desc(unsigned (&a)[16]) {
#pragma unroll
    for (int j = 8; j > 0; j >>= 1)
#pragma unroll
        for (int i = 0; i < 16; ++i) { const int l = i ^ j; if (l > i) CE_DESC(a[i], a[l]); }
}
__device__ __forceinline__ void top16_merge(unsigned (&a)[16], const unsigned (&b)[16]) {
#pragma unroll
    for (int i = 0; i < 16; ++i) a[i] = max(a[i], b[15 - i]);
    bmerge16_desc(a);
}
__device__ __forceinline__ void top16_partner(unsigned (&a)[16]) {
    unsigned b[16];
#pragma unroll
    for (int i = 0; i < 16; ++i) b[i] = (unsigned)__shfl_xor((int)a[i], 32);
    top16_merge(a, b);
}
__device__ constexpr unsigned char stair(int n) {
    constexpr unsigned char L[64] = {0x00,0x01,0x02,0x03,0x04,0x05,0x06,0x07,0x08,0x09,0x0a,0x0b,0x0c,0x0d,0x0e,0x0f,0x10,0x11,0x12,0x13,0x14,0x15,0x16,0x17,0x20,0x21,0x22,0x23,0x24,0x30,0x31,0x32,
                                     0x33,0x40,0x41,0x42,0x50,0x51,0x60,0x61,0x70,0x71,0x80,0x90,0xa0,0xb0,0xc0,0xd0,0xe0,0xf0,0xff,0xff,0xff,0xff,0xff,0xff,0xff,0xff,0xff,0xff,0xff,0xff,0xff,0xff};
    return L[n];
}
__device__ __forceinline__ void topk_item(const Frame& F, int item) {
    const int lane = F.lane, r32 = lane & 31, hi = lane >> 5, hh = item & 7, tok0 = (item >> 3) * 32; const size_t tok = (size_t)tok0 + r32;
    LAS int* ktab = (LAS int*)(F.lds + F.wave * 4096) + r32 * 32;
    float ss = 0.f;
    { const f32x4* sp = (const f32x4*)(F.ssp + tok * 32 + hi * 16);
#pragma unroll
      for (int j = 0; j < 4; ++j) { const f32x4 v = sp[j]; ss += (v[0] + v[1]) + (v[2] + v[3]); } }
    ss += __shfl_xor(ss, 32);
    const float rs2 = __builtin_amdgcn_rsqf(ss * (1.f / DM) + EPS);
    if (hh == 0 && hi == 0) F.rs2[tok] = rs2;
    unsigned top[2][16];
#pragma unroll
    for (int cc = 0; cc < 2; ++cc) {
        f32x16 acc[4] = {};
        const bf16_t* qp = F.qry + tok * DM + hh * 256 + cc * 128 + hi * 8; const bf16_t* kp = F.SK + ((size_t)(hh * 2 + cc) * 128 + r32) * 128 + hi * 8;
#pragma unroll 2
        for (int s = 0; s < 8; ++s) { const bf16x8 qf = *(const bf16x8*)(qp + 16 * s);
#pragma unroll
            for (int kt = 0; kt < 4; ++kt) { const bf16x8 kf = *(const bf16x8*)(kp + (size_t)kt * 32 * 128 + 16 * s); acc[kt] = __builtin_amdgcn_mfma_f32_32x32x16_bf16(kf, qf, acc[kt], 0, 0, 0); } }
        unsigned g[4][16];
#pragma unroll
        for (int kt = 0; kt < 4; ++kt) {
#pragma unroll
            for (int r = 0; r < 16; ++r) g[kt][r] = (fl_flip(acc[kt][r]) & ~127u) | (unsigned)(127 - (32 * kt + crow(r, hi)));
            sort16_desc(g[kt]); }
        top16_merge(g[0], g[1]); top16_merge(g[2], g[3]); top16_merge(g[0], g[2]); top16_partner(g[0]);
#pragma unroll
        for (int i = 0; i < 16; ++i) top[cc][i] = g[0][i];
    }
#pragma unroll
    for (int i = 0; i < 16; ++i) ktab[hi * 16 + i] = 127 - (int)((hi ? top[1][i] : top[0][i]) & 127u);
    float s0[16], s1[16];
#pragma unroll
    for (int i = 0; i < 16; ++i) { s0[i] = fl_unflip(top[0][i] & ~127u); s1[i] = fl_unflip(top[1][i] & ~127u); }
    unsigned ca[16], cb[16];
#pragma unroll
    for (int n = 0; n < 32; ++n) { const int A = stair(n), B = stair(25 + n); unsigned va = 0u, vb = 0u;
        if (n < 25) { va = (fl_flip(s0[A >> 4] + s1[A & 15]) & ~255u) | (unsigned)(255 - A); vb = (fl_flip(s0[B >> 4] + s1[B & 15]) & ~255u) | (unsigned)(255 - B); }
        const unsigned v = hi ? vb : va; if (n < 16) ca[n] = v; else cb[n - 16] = v; }
    sort16_desc(ca); sort16_desc(cb); top16_merge(ca, cb); top16_partner(ca);
    float e[16], sum = 0.f; const float mx = fl_unflip(ca[0] & ~255u) * rs2;
#pragma unroll
    for (int i = 0; i < 16; ++i) { e[i] = fexp(fl_unflip(ca[i] & ~255u) * rs2 - mx); sum += e[i]; }
    const float inv = 1.f / sum;
    LDS_WAIT(); asm volatile("" ::: "memory");
    int oi[8]; float og[8];
#pragma unroll
    for (int k = 0; k < 8; ++k) { const unsigned cv = hi ? ca[8 + k] : ca[k]; const int code = 255 - (int)(cv & 255u); og[k] = (hi ? e[8 + k] : e[k]) * inv; oi[k] = ktab[code >> 4] * 128 + ktab[16 + (code & 15)]; }
    { int* ip = F.idx + tok * 128 + hh * 16 + hi * 8; float* gp = F.gate + tok * 128 + hh * 16 + hi * 8;
      *(int4*)ip = make_int4(oi[0], oi[1], oi[2], oi[3]); *(int4*)(ip + 4) = make_int4(oi[4], oi[5], oi[6], oi[7]);
      *(f32x4*)gp = (f32x4){og[0], og[1], og[2], og[3]}; *(f32x4*)(gp + 4) = (f32x4){og[4], og[5], og[6], og[7]}; }
    LDS_WAIT(); asm volatile("" ::: "memory");
}

constexpr int PS_NSL = 16, PS_CW = DM / PS_NSL, PS_SUB = PS_NSL / 8, PS_TG = 32, PS_NTG = T / PS_TG;
__device__ __forceinline__ float gelu_tanh(float x) { const float u = 0.7978845608028654f * (x + 0.044715f * x * x * x); const float t = 1.f - 2.f * __builtin_amdgcn_rcpf(1.f + fexp(2.f * u)); return 0.5f * x * (1.f + t); }
__device__ __forceinline__ int dot16i(u32x4 w, u32x4 x) { int p = __builtin_amdgcn_sdot4((int)w.x, (int)x.x, 0, false); p = __builtin_amdgcn_sdot4((int)w.y, (int)x.y, p, false); p = __builtin_amdgcn_sdot4((int)w.z, (int)x.z, p, false); return __builtin_amdgcn_sdot4((int)w.w, (int)x.w, p, false); }
__device__ __forceinline__ unsigned xcc_id() { return (unsigned)__builtin_amdgcn_s_getreg((3 << 11) | 20) & 7u; }
__device__ __forceinline__ bool peer_claim(unsigned* cnt, unsigned x, unsigned& d, int lane, int& q, int& tg) {
    while (d < 8u) { const unsigned xq = (x + d) & 7u; unsigned u = 0u;
        if (lane == 0) u = __hip_atomic_fetch_add(cnt + 64 * xq, 1u, __ATOMIC_RELAXED, __HIP_MEMORY_SCOPE_AGENT);
        u = (unsigned)__builtin_amdgcn_readfirstlane((int)u);
        if (u < (unsigned)(PS_SUB * PS_NTG)) { q = (int)(u / PS_NTG) * 8 + (int)xq; tg = (int)(u % PS_NTG); return true; }
        ++d; }
    return false;
}
template <int CTRL> __device__ __forceinline__ float dppmov(float x) { return __int_as_float(__builtin_amdgcn_update_dpp(0, __float_as_int(x), CTRL, 0xf, 0xf, true)); }
template <int CTRL> __device__ __forceinline__ int dppmovi(int x) { return __builtin_amdgcn_update_dpp(0, x, CTRL, 0xf, 0xf, true); }
__device__ __forceinline__ int bperm(int srclane, int v) { return __builtin_amdgcn_ds_bpermute(srclane << 2, v); }
__device__ __forceinline__ void peer_quant_x(const Frame& F) {
    const int gw = F.vcu * 8 + F.wave, NGW = F.G * 8, lane = F.lane;
    for (int tok = gw; tok < T; tok += NGW) { const u32x4* xr = (const u32x4*)(F.x1b + (size_t)tok * DM) + lane; float v[4][8]; float m = 0.f;
#pragma unroll
        for (int j = 0; j < 4; ++j) { const u32x4 w = xr[64 * j]; v[j][0] = bflo(w.x); v[j][1] = bfhi(w.x); v[j][2] = bflo(w.y); v[j][3] = bfhi(w.y); v[j][4] = bflo(w.z); v[j][5] = bfhi(w.z); v[j][6] = bflo(w.w); v[j][7] = bfhi(w.w);
#pragma unroll
            for (int i = 0; i < 8; ++i) m = fmaxf(m, fabsf(v[j][i])); }
#pragma unroll
        for (int o = 1; o < 64; o <<= 1) m = fmaxf(m, __shfl_xor(m, o));
        const float inv = m > 0.f ? 127.f / m : 0.f;
#pragma unroll
        for (int j = 0; j < 4; ++j) { u32x2 w = {0u, 0u};
#pragma unroll
            for (int i = 0; i < 4; ++i) { w.x |= ((unsigned)(int)rintf(v[j][i] * inv) & 0xffu) << (8 * i); w.y |= ((unsigned)(int)rintf(v[j][4 + i] * inv) & 0xffu) << (8 * i); }
            *(u32x2*)(F.xq8 + (size_t)tok * DM + 8 * lane + 512 * j) = w; }
        if (lane == 0) F.sx[tok] = m * (1.f / 127.f); }
}
__device__ __forceinline__ void peer_down(const Frame& F, int cntw = 1024) {
    const int lane = F.lane, g = lane >> 3, c = lane & 7; const unsigned x = xcc_id(); unsigned d = 0u; int q, tg; unsigned* cnt = (unsigned*)(F.wsb + WS_CTL) + cntw;
    const unsigned char* tab = F.down8; const unsigned char* xb = F.xq8;
    while (peer_claim(cnt, x, d, lane, q, tg)) {
        const unsigned colb = (unsigned)(q * PS_CW + 16 * c), slb = (unsigned)q * (16384u * 128u) + 16u * c; int* part = F.part + (size_t)q * T * 128; const size_t tok0 = (size_t)tg * PS_TG;
        u32x4 wA[16], wB[16], xA, xB; int iA0, iA1, iB0, iB1;
#define PD_IDX(i0, i1, tok) do { const int* ip_ = F.idx + (tok) * 128 + lane; i0 = ip_[0]; i1 = ip_[64]; } while (0)
#define PD_ROWS(W_, X_, i0, i1, tok) do { _Pragma("unroll") for (int j = 0; j < 16; ++j) { const unsigned e_ = (unsigned)bperm(8 * (j & 7) + g, j < 8 ? i0 : i1); \
            W_[j] = *(const u32x4*)(tab + (e_ * 128u + slb)); } X_ = *(const u32x4*)(xb + (tok) * DM + colb); } while (0)
#define PD_COMP(W_, X_, tok) do { int p[16]; _Pragma("unroll") for (int j = 0; j < 16; ++j) p[j] = dot16i(W_[j], X_); \
            int a1[8], a2[4], a3[2]; \
            _Pragma("unroll") for (int i = 0; i < 8; ++i) { const int keep = (c & 1) ? p[2 * i + 1] : p[2 * i], give = (c & 1) ? p[2 * i] : p[2 * i + 1]; a1[i] = keep + dppmovi<0xB1>(give); } \
            _Pragma("unroll") for (int i = 0; i < 4; ++i) { const int keep = (c & 2) ? a1[2 * i + 1] : a1[2 * i], give = (c & 2) ? a1[2 * i] : a1[2 * i + 1]; a2[i] = keep + dppmovi<0x4E>(give); } \
            _Pragma("unroll") for (int i = 0; i < 2; ++i) { const int keep = (c & 4) ? a2[2 * i + 1] : a2[2 * i], give = (c & 4) ? a2[2 * i] : a2[2 * i + 1]; a3[i] = keep + __shfl_xor(give, 4); } \
            part[(tok) * 128 + 8 * c + g] = a3[0]; part[(tok) * 128 + 64 + 8 * c + g] = a3[1]; } while (0)
        PD_IDX(iA0, iA1, tok0); PD_IDX(iB0, iB1, tok0 + 1);
        PD_ROWS(wA, xA, iA0, iA1, tok0);
        for (int tt = 0; tt < PS_TG; tt += 2) { const size_t tok = tok0 + tt;
            PD_ROWS(wB, xB, iB0, iB1, tok + 1);
            const size_t t2 = tok + (tt + 2 < PS_TG ? 2 : 0), t3 = tok + (tt + 2 < PS_TG ? 3 : 1);
            PD_IDX(iA0, iA1, t2);
            PD_COMP(wA, xA, tok);
            if (tt + 2 < PS_TG) PD_ROWS(wA, xA, iA0, iA1, t2);
            PD_IDX(iB0, iB1, t3);
            PD_COMP(wB, xB, tok + 1);
        }
#undef PD_IDX
#undef PD_ROWS
#undef PD_COMP
    }
}
__device__ __forceinline__ void peer_coef_probe(const Frame& F, bool dry) {
    const int gw = F.vcu * 8 + F.wave, NGW = F.G * 8, lane = F.lane;
    for (int tok = gw; tok < T; tok += NGW) { int a0 = 0, a1 = 0; const int* pp = F.part + (size_t)tok * 128 + lane;
#pragma unroll
        for (int q = 0; q < PS_NSL; ++q) { a0 += pp[(size_t)q * T * 128]; a1 += pp[(size_t)q * T * 128 + 64]; }
        const float sc = F.rs2[tok] * F.sx[tok]; const float* gp = F.gate + (size_t)tok * 128 + lane; const int e0 = F.idx[(size_t)tok * 128 + lane], e1 = F.idx[(size_t)tok * 128 + 64 + lane];
        const float c0 = gp[0] * gelu_tanh((float)a0 * sc * F.sd[e0]) * F.su[e0], c1 = gp[64] * gelu_tanh((float)a1 * sc * F.sd[e1]) * F.su[e1];
        float m = fmaxf(fabsf(c0), fabsf(c1));
#pragma unroll
        for (int o = 1; o < 64; o <<= 1) m = fmaxf(m, __shfl_xor(m, o));
        const float inv = m > 0.f ? 127.f / m : 0.f; const int q0 = (int)rintf(c0 * inv), q1 = (int)rintf(c1 * inv);
        unsigned char* fp = (dry ? F.wsb + WS_PART + 256 * MiB : F.fq8) + (size_t)tok * 128;
        { const int k0 = lane, k1 = 64 + lane; fp[(8 * (k0 >> 5) + (k0 & 7)) * 4 + ((k0 >> 3) & 3)] = (unsigned char)q0; fp[(8 * (k1 >> 5) + (k1 & 7)) * 4 + ((k1 >> 3) & 3)] = (unsigned char)q1; }
        if (lane == 0 && !dry) F.csum[tok] = m * (1.f / 127.f); }
}
__device__ __forceinline__ void peer_up(const Frame& F, int cntw = 2048, bool dry = false) {
    const int lane = F.lane, g = lane >> 3, c = lane & 7; const unsigned x = xcc_id(); unsigned d = 0u; int q, tg; unsigned* cnt = (unsigned*)(F.wsb + WS_CTL) + cntw;
    const unsigned char* tab = F.up8;
    while (peer_claim(cnt, x, d, lane, q, tg)) {
        const unsigned slb = (unsigned)q * (16384u * 128u) + 16u * c; const int col0 = q * PS_CW + 16 * c; const size_t tok0 = (size_t)tg * PS_TG;
        u32x4 wA[16], wB[16]; int iA0, iA1, iB0, iB1, fqA, fqB, fA[4], fB[4]; float oA0, oA1, oB0, oB1;
#define PU_IDX(i0, i1, fq, o0, o1, tok) do { const size_t o_ = (tok) * 128; i0 = F.idx[o_ + lane]; i1 = F.idx[o_ + 64 + lane]; fq = *(const int*)(F.fq8 + o_ + 4 * (lane & 31)); \
            const float* op_ = F.out + (tok) * DM + col0 + g; o0 = op_[0]; o1 = op_[8]; } while (0)
#define PU_ROWS(W_, F_, i0, i1, fq) do { _Pragma("unroll") for (int j = 0; j < 16; ++j) { const unsigned e_ = (unsigned)bperm(8 * (j & 7) + g, j < 8 ? i0 : i1); W_[j] = *(const u32x4*)(tab + (e_ * 128u + slb)); } \
            _Pragma("unroll") for (int m_ = 0; m_ < 4; ++m_) F_[m_] = bperm(8 * m_ + g, fq); } while (0)
#define PU_T4(ACC_, R0, R1, R2, R3, FQ_) do { const unsigned t0_ = __builtin_amdgcn_perm(R1, R0, 0x05010400u), t1_ = __builtin_amdgcn_perm(R1, R0, 0x07030602u), t2_ = __builtin_amdgcn_perm(R3, R2, 0x05010400u), t3_ = __builtin_amdgcn_perm(R3, R2, 0x07030602u); \
            ACC_[0] = __builtin_amdgcn_sdot4((int)__builtin_amdgcn_perm(t2_, t0_, 0x05040100u), FQ_, ACC_[0], false); ACC_[1] = __builtin_amdgcn_sdot4((int)__builtin_amdgcn_perm(t2_, t0_, 0x07060302u), FQ_, ACC_[1], false); \
            ACC_[2] = __builtin_amdgcn_sdot4((int)__builtin_amdgcn_perm(t3_, t1_, 0x05040100u), FQ_, ACC_[2], false); ACC_[3] = __builtin_amdgcn_sdot4((int)__builtin_amdgcn_perm(t3_, t1_, 0x07060302u), FQ_, ACC_[3], false); } while (0)
#define PU_COMP(W_, F_, o0, o1, tok) do { int acc[16] = {}; \
            _Pragma("unroll") for (int m_ = 0; m_ < 4; ++m_) { int* a_ = acc; PU_T4(a_, W_[4 * m_].x, W_[4 * m_ + 1].x, W_[4 * m_ + 2].x, W_[4 * m_ + 3].x, F_[m_]); a_ = acc + 4; PU_T4(a_, W_[4 * m_].y, W_[4 * m_ + 1].y, W_[4 * m_ + 2].y, W_[4 * m_ + 3].y, F_[m_]); \
                a_ = acc + 8; PU_T4(a_, W_[4 * m_].z, W_[4 * m_ + 1].z, W_[4 * m_ + 2].z, W_[4 * m_ + 3].z, F_[m_]); a_ = acc + 12; PU_T4(a_, W_[4 * m_].w, W_[4 * m_ + 1].w, W_[4 * m_ + 2].w, W_[4 * m_ + 3].w, F_[m_]); } \
            int a1[8], a2[4], a3[2]; \
            _Pragma("unroll") for (int i = 0; i < 8; ++i) { const int keep = (g & 1) ? acc[2 * i + 1] : acc[2 * i], give = (g & 1) ? acc[2 * i] : acc[2 * i + 1]; a1[i] = keep + dppmovi<0x128>(give); } \
            _Pragma("unroll") for (int i = 0; i < 4; ++i) { const int keep = (g & 2) ? a1[2 * i + 1] : a1[2 * i], give = (g & 2) ? a1[2 * i] : a1[2 * i + 1]; a2[i] = keep + __shfl_xor(give, 16); } \
            _Pragma("unroll") for (int i = 0; i < 2; ++i) { const int keep = (g & 4) ? a2[2 * i + 1] : a2[2 * i], give = (g & 4) ? a2[2 * i] : a2[2 * i + 1]; a3[i] = keep + __shfl_xor(give, 32); } \
            const float sf_ = F.csum[tok]; float* dp_ = (dry ? (float*)(F.wsb + WS_PART) + ((tok) & 16383) * DM : F.out + (tok) * DM) + col0 + g; \
            dp_[0] = o0 + sf_ * (float)a3[0]; dp_[8] = o1 + sf_ * (float)a3[1]; } while (0)
        PU_IDX(iA0, iA1, fqA, oA0, oA1, tok0); PU_IDX(iB0, iB1, fqB, oB0, oB1, tok0 + 1);
        PU_ROWS(wA, fA, iA0, iA1, fqA);
        for (int tt = 0; tt < PS_TG; tt += 2) { const size_t tok = tok0 + tt;
            PU_ROWS(wB, fB, iB0, iB1, fqB);
            const float pA0 = oA0, pA1 = oA1;
            const bool more = tt + 2 < PS_TG; const size_t t2 = tok + (more ? 2 : 0), t3 = tok + (more ? 3 : 1);
            PU_IDX(iA0, iA1, fqA, oA0, oA1, t2);
            PU_COMP(wA, fA, pA0, pA1, tok);
            if (more) PU_ROWS(wA, fA, iA0, iA1, fqA);
            const float pB0 = oB0, pB1 = oB1;
            PU_IDX(iB0, iB1, fqB, oB0, oB1, t3);
            PU_COMP(wB, fB, pB0, pB1, tok + 1);
        }
#undef PU_IDX
#undef PU_ROWS
#undef PU_T4
#undef PU_COMP
    }
}

#define XB_TMO      128
#define XB_XCNT(j)  (256  + 64 * (j))
#define XB_XSUB(j)  (1280 + 64 * (j))
#define XB_XGEN(j)  (2304 + 64 * (j))
#define XB_TOP      3328
#define XB_TOPGEN   3392
#define XCD_BAR_WORDS 3456
#define XB_SPIN_CAP (1u << 18)

__device__ __forceinline__ unsigned xb_ld(unsigned* p)              { return __hip_atomic_load(p, __ATOMIC_RELAXED, __HIP_MEMORY_SCOPE_AGENT); }
__device__ __forceinline__ unsigned xb_add(unsigned* p, unsigned v) { return __hip_atomic_fetch_add(p, v, __ATOMIC_RELAXED, __HIP_MEMORY_SCOPE_AGENT); }
__device__ __forceinline__ unsigned xb_xcc_id() { return (unsigned)__builtin_amdgcn_s_getreg((3 << 11) | 20) & 0xFu; }
#define XB_SPIN(cond, bar) do { unsigned _sp = 0; while (cond) { __builtin_amdgcn_s_sleep(1); \
    if ((++_sp & 255u) == 0u) { if (xb_ld(&(bar)[XB_TMO])) break; if (_sp > XB_SPIN_CAP) { atomicAdd(&(bar)[XB_TMO], 1u); break; } } } } while (0)

struct XcdBarrier {
    unsigned* bar; unsigned x;
    volatile LAS unsigned* st;
};

__device__ __forceinline__ XcdBarrier xcd_barrier_post(unsigned* bar, volatile LAS unsigned* st) {
    XcdBarrier b; b.bar = bar; b.x = xb_xcc_id(); b.st = st;
    if (threadIdx.x == 0) (void)xb_add(&bar[XB_XCNT(b.x)], 1u);
    return b;
}
__device__ __forceinline__ void xcd_barrier_complete(unsigned* bar, unsigned x, unsigned& nloc, unsigned& nx) {
    const unsigned G = gridDim.x * gridDim.y * gridDim.z;
    unsigned sum, cnt, mine, sp = 0u;
    for (;;) {
        sum = 0u; cnt = 0u; mine = 0u;
#pragma unroll
        for (unsigned j = 0; j < 16; ++j) { const unsigned c = xb_ld(&bar[XB_XCNT(j)]); sum += c; cnt += (c > 0u) ? 1u : 0u; mine = (j == x) ? c : mine; }
        if (sum == G) break;
        __builtin_amdgcn_s_sleep(1);
        if ((++sp & 255u) == 0u) { if (xb_ld(&bar[XB_TMO])) break; if (sp > XB_SPIN_CAP) { atomicAdd(&bar[XB_TMO], 1u); break; } }
    }
    nloc = mine > 0u ? mine : 1u; nx = cnt > 0u ? cnt : 1u;
}

__device__ __forceinline__ void xcd_barrier(const XcdBarrier& b) {
    asm volatile("s_waitcnt vmcnt(0)" ::: "memory");
    __syncthreads();
    if (threadIdx.x == 0) {
        unsigned* bar = b.bar;
        __builtin_amdgcn_s_waitcnt(0);
        unsigned nloc = b.st[0], nx = b.st[1];
        if (nloc == 0u) { xcd_barrier_complete(bar, b.x, nloc, nx); b.st[0] = nloc; b.st[1] = nx; }
        const unsigned old = xb_add(&bar[XB_XSUB(b.x)], 1u);
        const unsigned gen = old / nloc;
        if (old + 1u == (gen + 1u) * nloc) {
            __builtin_amdgcn_fence(__ATOMIC_RELEASE, "agent");
            asm volatile("s_waitcnt vmcnt(0)" ::: "memory");
            const unsigned og = xb_add(&bar[XB_TOP], 1u);
            const unsigned tg = og / nx;
            if (og + 1u == (tg + 1u) * nx) xb_add(&bar[XB_TOPGEN], 1u);
            else XB_SPIN(xb_ld(&bar[XB_TOPGEN]) == tg, bar);
            __builtin_amdgcn_fence(__ATOMIC_ACQUIRE, "agent");
            xb_add(&bar[XB_XGEN(b.x)], 1u);
            asm volatile("s_waitcnt vmcnt(0)" ::: "memory");
        } else {
            XB_SPIN(xb_ld(&bar[XB_XGEN(b.x)]) == gen, bar);
            __builtin_amdgcn_fence(__ATOMIC_ACQUIRE, "agent");
            asm volatile("s_waitcnt vmcnt(0)" ::: "memory");
        }
    }
    __syncthreads();
}

struct Args { const float* in[16]; float* out; unsigned char* ws; int ph_lo, ph_hi, coop, pad; };
__global__ void __launch_bounds__(512, 2) fwd_kernel(Args args) {
    extern __shared__ __attribute__((aligned(16))) unsigned char lds_raw[];
    Frame F;
    F.lds = (LAS unsigned char*)lds_raw; F.ldsg = (char*)lds_raw;
    F.tid = threadIdx.x; F.lane = F.tid & 63; F.wave = __builtin_amdgcn_readfirstlane(F.tid >> 6);
    F.G = gridDim.x; { const int bx = blockIdx.x; F.vcu = (F.G % 8 == 0) ? (bx % 8) * (F.G / 8) + bx / 8 : bx; }
    F.x = args.in[0]; F.norm1_g = args.in[1]; F.w_in = args.in[2]; F.up_f = args.in[3]; F.bias_f = args.in[4]; F.up_b = args.in[5]; F.bias_b = args.in[6]; F.out_g = args.in[7];
    F.qn_g = args.in[8]; F.kn_g = args.in[9]; F.w_out = args.in[10]; F.norm2_g = args.in[11]; F.w_query = args.in[12]; F.sub_keys = args.in[13]; F.peer_down = args.in[14]; F.peer_up = args.in[15];
    F.out = args.out; unsigned char* ws = args.ws; F.wsb = ws;
    F.rope = (f32x2*)(ws + WS_ROPE); F.rs1 = (float*)(ws + WS_RS1); F.rs2 = (float*)(ws + WS_RS2); F.ssp = (float*)(ws + WS_SSP); F.dec = (float*)(ws + WS_DEC); F.lp = (float*)(ws + WS_LP);
    F.gate = (float*)(ws + WS_GATE); F.part = (int*)(ws + WS_PART); F.sd = (float*)(ws + WS_CTL + 65536); F.su = (float*)(ws + WS_CTL + 131072); F.sx = (float*)(ws + WS_RS2 + 131072); F.csum = (float*)(ws + WS_RS2 + 262144);
    F.down8 = ws + WS_DOWN; F.up8 = ws + WS_UP; F.xq8 = ws + WS_XB; F.fq8 = ws + WS_XB + 64 * MiB; F.idx = (int*)(ws + WS_IDX); F.state = (float*)((unsigned char*)args.out + OUT_ST);
    F.WinT = (bf16_t*)(ws + WS_WIN); F.WoT = (bf16_t*)(ws + WS_WO); F.WqT = (bf16_t*)(ws + WS_WQ); F.SK = (bf16_t*)(ws + WS_SK); F.down16 = (bf16_t*)(ws + WS_DOWN); F.up16 = (bf16_t*)(ws + WS_UP);
    F.xb = (bf16_t*)(ws + WS_XB); F.mixed = (bf16_t*)(ws + WS_XB); F.h = (bf16_t*)(ws + WS_H); F.x1b = (bf16_t*)(ws + WS_X1B); F.qry = (bf16_t*)(ws + WS_QRY);
    F.op0 = (bf16_t*)((unsigned char*)args.out + OUT_OP0); F.op1 = (bf16_t*)(ws + WS_OP1); F.op2 = (bf16_t*)(ws + WS_OP2);
    constexpr int MISC_OFF = 131072 + 320;
    for (int u = F.tid; u < 64; u += 512) ((LAS unsigned*)(F.lds + MISC_OFF))[u] = 0u;
    __syncthreads();
    XcdBarrier bar = xcd_barrier_post((unsigned*)(ws + WS_CTL) + 8192, (volatile LAS unsigned*)(F.lds + MISC_OFF) + 8);
    const int lo = args.ph_lo, hi = args.ph_hi;
#ifndef PH_MASK
#define PH_MASK 0x7ff
#endif
#ifndef PROBE_PHASE
#define PROBE_PHASE -1
#endif
#define REP(k) for (int rep_ = 0; rep_ < ((PROBE_PHASE == (k)) ? 2 : 1); ++rep_)
#define IN(k) (((PH_MASK >> (k)) & 1) && lo <= (k) && (k) < hi)
#define SEAM(k) do { if (IN(k) && IN((k) + 1)) { if (args.coop) { if ((k) == 0) cg::this_grid().sync(); else xcd_barrier(bar); } } } while (0)
    if (IN(0)) { REP(0) phase0(F); } SEAM(0);
#define GEMM1_BODY { pg8::Gemm g{F.xb, F.WinT, T, HP, DM}; pg8::StaticOrder S; S.init(T, HP, F.G, (int)blockIdx.x); pg8::EpiRowScaleBf16 E{F.h, HP, F.rs1}; \
        pg8::gemm_phase<pg8::EpiRowScaleBf16, pg8::StaticOrder, PG8_ALIGN, PG8_SP2>(F.lds, g, S, E); }
    if (IN(1)) { GEMM1_BODY; if (PROBE_PHASE == 1) GEMM1_BODY; } SEAM(1);
    if (IN(2)) { qknorm_rope(F); REP(2) for (int it = F.vcu; it < 2048; it += F.G) gla_passA(F, it); } SEAM(2);
    if (IN(3)) { for (int it = F.vcu; it < 256; it += F.G) gla_scan(F, it); REP(3) for (int it = F.vcu; it < 4608; it += F.G) attn_item(F, it); } SEAM(3);
    if (IN(4)) REP(4) { for (int it = F.vcu; it < 2048; it += F.G) gla_passC(F, it); dil_combine(F); } SEAM(4);
#define GEMM5_BODY { pg8::Gemm g{F.mixed, F.WoT, T, DM, DM}; pg8::StaticOrder S; S.init(T, DM, F.G, (int)blockIdx.x); pg8::EpiResid E{F.x, F.out, F.x1b, F.ssp, DM}; \
        pg8::gemm_phase<pg8::EpiResid, pg8::StaticOrder, PG8_ALIGN, PG8_SP2>(F.lds, g, S, E); }
#define GEMM6_BODY { pg8::Gemm g{F.x1b, F.WqT, T, DM, DM}; pg8::StaticOrder S; S.init(T, DM, F.G, (int)blockIdx.x); pg8::EpiRowScaleBf16 E{F.qry, DM, nullptr}; \
        pg8::gemm_phase<pg8::EpiRowScaleBf16, pg8::StaticOrder, PG8_ALIGN, PG8_SP2>(F.lds, g, S, E); }
    if (IN(5)) { GEMM5_BODY; if (PROBE_PHASE == 5) GEMM5_BODY; } SEAM(5);
    if (IN(6)) { GEMM6_BODY; if (PROBE_PHASE == 6) GEMM6_BODY; } SEAM(6);
    if (IN(7)) REP(7) { const int gw = F.vcu * 8 + F.wave, NGW = F.G * 8; for (int it = gw; it < (T / 32) * 8; it += NGW) topk_item(F, it); if (rep_ == 0) peer_quant_x(F); } SEAM(7);
    if (IN(8)) { if (PROBE_PHASE == 8) peer_down(F, 3072); peer_down(F); } SEAM(8);
    if (IN(9)) { REP(9) peer_coef_probe(F, (PROBE_PHASE == 9) && rep_ == 0); } SEAM(9);
    if (IN(10)) { if (PROBE_PHASE == 10) peer_up(F, 3584, true); peer_up(F); }
#undef IN
#undef SEAM
}

#ifndef MK_N_LAUNCHES
#define MK_N_LAUNCHES 1
#endif
extern "C" void kernel_launch(void* const* d_in, const int* in_sizes, int n_in, void* d_out, int out_size, void* d_ws, size_t ws_size, hipStream_t stream) {
    static int grid = 0;
    if (grid == 0) {
        if (n_in != 16 || in_sizes[0] != T * DM || out_size != T * DM || ws_size < WS_END) { fprintf(stderr, "kernel_launch: unexpected shapes (n_in %d, in0 %d, out %d, ws %zu)\n", n_in, n_in > 0 ? in_sizes[0] : -1, out_size, ws_size); grid = -1; return; }
        int dev = 0, cus = 0, per_cu = 0;
        if (hipGetDevice(&dev) != hipSuccess || hipDeviceGetAttribute(&cus, hipDeviceAttributeMultiprocessorCount, dev) != hipSuccess) { grid = -1; return; }
        if (hipFuncSetAttribute((const void*)fwd_kernel, hipFuncAttributeMaxDynamicSharedMemorySize, LDS_BYTES) != hipSuccess) { fprintf(stderr, "kernel_launch: hipFuncSetAttribute failed\n"); grid = -1; return; }
        if (hipOccupancyMaxActiveBlocksPerMultiprocessor(&per_cu, (const void*)fwd_kernel, 512, LDS_BYTES) != hipSuccess || per_cu < 1) { fprintf(stderr, "kernel_launch: occupancy query says %d\n", per_cu); per_cu = 1; }
        (void)hipGetLastError();
        grid = cus;
    }
    if (grid < 0) return;
    if (hipMemsetAsync(d_ws, 0, 65536, stream) != hipSuccess) { fprintf(stderr, "kernel_launch: hipMemsetAsync failed\n"); return; }
    Args a{};
    for (int i = 0; i < 16; ++i) a.in[i] = (const float*)d_in[i];
    a.out = (float*)d_out; a.ws = (unsigned char*)d_ws;
    if (MK_N_LAUNCHES == 1) {
        a.ph_lo = 0; a.ph_hi = NPHASE; a.coop = 1; void* kargs[] = {&a};
        hipError_t e = hipLaunchCooperativeKernel((const void*)fwd_kernel, dim3(grid), dim3(512), kargs, LDS_BYTES, stream);
        if (e != hipSuccess) fprintf(stderr, "kernel_launch: cooperative launch failed: %s (grid %d)\n", hipGetErrorString(e), grid);
    } else {
        for (int p = 0; p < NPHASE; ++p) { a.ph_lo = p; a.ph_hi = p + 1; a.coop = 0; hipLaunchKernelGGL(fwd_kernel, dim3(grid), dim3(512), LDS_BYTES, stream, a); }
        const hipError_t le = hipPeekAtLastError(); if (le != hipSuccess) fprintf(stderr, "kernel_launch: launch failed: %s\n", hipGetErrorName(le));
    }
}
```

```cpp
#include <hip/hip_runtime.h>
#include <hip/hip_cooperative_groups.h>
#include <cstdio>
#include <cstdint>
namespace cg = cooperative_groups;
namespace pg8 {
#define PG8_LAS __attribute__((address_space(3)))
typedef unsigned short bf16_t;
typedef short bf16x8 __attribute__((ext_vector_type(8)));
typedef float f32x4 __attribute__((ext_vector_type(4)));
typedef unsigned u32x4 __attribute__((ext_vector_type(4)));
constexpr int BM = 256, BK = 64, HALF = 128, HTB = HALF * BK * 2  , STAGE_BYTES = 8 * HTB, NXCD = 8, WGM = 8;

__host__ __device__ __forceinline__ int lds_byte(int r, int c) { const int st = (r >> 4) * 2 + (c >> 5), rr = r & 15, cc = c & 31, ob = rr * 64 + cc * 2; return st * 1024 + (ob ^ (((ob >> 9) & 1) << 5)); }
__host__ __device__ __forceinline__ void stage_rc(int b, int& R, int& C) { const int st = b / 1024, sb = b % 1024, swz = sb ^ (((sb >> 9) & 1) << 5); R = (st >> 1) * 16 + swz / 64; C = (st & 1) * 32 + (swz % 64) / 2; }
__host__ __device__ __forceinline__ int perm32(int rho) { const int n = rho >> 4, i = rho & 15; return 8 * (i >> 2) + 4 * n + (i & 3); }

struct Unit { int pm, pn; };
struct Gemm { const bf16_t* A; const bf16_t* Bt; int M, N, K; };

struct StaticOrder {
    int nM, nN, nwg, G, c;
    __host__ __device__ void init(int M, int N, int G_, int c_) { nM = M / BM; nN = N / BM; nwg = nM * nN; G = G_; c = c_; }
    __host__ __device__ bool next(int i, Unit& u) const {
        const long L = (long)i * G + c; if (L >= nwg) return false;
        int wgid = (int)L; { const int q = nwg / NXCD, r = nwg % NXCD, xcd = wgid % NXCD, off = wgid / NXCD; wgid = (xcd < r ? xcd * (q + 1) : r * (q + 1) + (xcd - r) * q) + off; }
        const int nig = WGM * nN, gid = wgid / nig, fm = gid * WGM, gsz = (nM - fm) < WGM ? (nM - fm) : WGM;
        u.pm = fm + ((wgid % nig) % gsz); u.pn = (wgid % nig) / gsz; return true;
    }
    __device__ __forceinline__ void a_ready(const Unit&) const {}
    __device__ __forceinline__ void done(const Unit&) const {}
};
__device__ __forceinline__ unsigned cvt_pk_bf16(float lo, float hi) { unsigned r; asm volatile("v_cvt_pk_bf16_f32 %0, %1, %2" : "=v"(r) : "v"(lo), "v"(hi)); return r; }
struct EpiRowScaleBf16 {
    static constexpr bool PERM = true, AFTER_DRAIN = false;
    bf16_t* O; int ldc; const float* rs;
    __device__ __forceinline__ void operator()(const f32x4 (&acc)[2][2][4][2], const Unit& u, int wr, int wc, int fr, int fq) const {
        const int row0 = u.pm * BM + wr * 64 + fr, col0 = u.pn * BM + wc * 32 + 8 * fq;
#pragma unroll
        for (int ai = 0; ai < 2; ++ai)
#pragma unroll
            for (int m = 0; m < 4; ++m) { const int row = row0 + ai * HALF + m * 16; const float s = rs ? rs[row] : 1.f; bf16_t* rowp = O + (size_t)row * ldc + col0;
#pragma unroll
                for (int bj = 0; bj < 2; ++bj) { const f32x4 v0 = acc[ai][bj][m][0] * s, v1 = acc[ai][bj][m][1] * s;
                    u32x4 w; w.x = cvt_pk_bf16(v0[0], v0[1]); w.y = cvt_pk_bf16(v0[2], v0[3]); w.z = cvt_pk_bf16(v1[0], v1[1]); w.w = cvt_pk_bf16(v1[2], v1[3]);
                    *(u32x4*)(rowp + bj * HALF) = w; } }
    }
};
struct EpiResid {
    static constexpr bool PERM = true, AFTER_DRAIN = false;
    const float* x; float* out; bf16_t* xb; float* ssp; int ldc;
    __device__ __forceinline__ void operator()(const f32x4 (&acc)[2][2][4][2], const Unit& u, int wr, int wc, int fr, int fq) const {
        const int row0 = u.pm * BM + wr * 64 + fr, col0 = u.pn * BM + wc * 32 + 8 * fq;
#pragma unroll
        for (int ai = 0; ai < 2; ++ai)
#pragma unroll
            for (int m = 0; m < 4; ++m) { const int row = row0 + ai * HALF + m * 16; const size_t off = (size_t)row * ldc + col0; float ss = 0.f;
#pragma unroll
                for (int bj = 0; bj < 2; ++bj) { const f32x4 xa = *(const f32x4*)(x + off + bj * HALF), xc = *(const f32x4*)(x + off + bj * HALF + 4);
                    const f32x4 v0 = acc[ai][bj][m][0] + xa, v1 = acc[ai][bj][m][1] + xc;
                    *(f32x4*)(out + off + bj * HALF) = v0; *(f32x4*)(out + off + bj * HALF + 4) = v1;
                    u32x4 w; w.x = cvt_pk_bf16(v0[0], v0[1]); w.y = cvt_pk_bf16(v0[2], v0[3]); w.z = cvt_pk_bf16(v1[0], v1[1]); w.w = cvt_pk_bf16(v1[2], v1[3]);
                    *(u32x4*)(xb + off + bj * HALF) = w;
                    ss += (v0[0] * v0[0] + v0[1] * v0[1]) + (v0[2] * v0[2] + v0[3] * v0[3]) + (v1[0] * v1[0] + v1[1] * v1[1]) + (v1[2] * v1[2] + v1[3] * v1[3]); }
                ss += __shfl_xor(ss, 16); ss += __shfl_xor(ss, 32);
                if (fq == 0) ssp[(size_t)row * 32 + u.pn * 4 + wc] = ss; }
    }
};
template <class Epi, class Sched, bool ALIGN_EPI = false, bool SP2 = false>
__device__ __forceinline__ void gemm_phase(PG8_LAS unsigned char* lds, const Gemm g, const Sched& S, const Epi& E) {
    const int tid = threadIdx.x, wid = __builtin_amdgcn_readfirstlane(tid >> 6), lane = tid & 63, wr = wid >> 2, wc = wid & 3, fr = lane & 15, fq = lane >> 4;
    const int K = g.K, nt = K / BK;
    unsigned voffA[2], voffB[2];
#pragma unroll
    for (int i = 0; i < 2; ++i) { int R, C; stage_rc(tid * 16 + i * 8192, R, C); const int Rb = Epi::PERM ? ((R & ~31) + perm32(R & 31)) : R;
        voffA[i] = (unsigned)(R * K + C) * 2u; voffB[i] = (unsigned)(Rb * K + C) * 2u; }
    const size_t kstep = (size_t)(BK * 2);
    const size_t hstep = (size_t)HALF * K * 2;
    const size_t tstep = 2 * hstep;
    const unsigned ldsw = (unsigned)wid * 1024u;
    const int aoff = lds_byte(wr * 64 + fr, fq * 8), boff = lds_byte(wc * 32 + fr, fq * 8);
#define PG8_SA(b, h) (((b) * 2 + (h)) * HTB)
#define PG8_SB(b, h) ((4 + (b) * 2 + (h)) * HTB)
#define PG8_STAGE(bufoff, gbase, voff) do { _Pragma("unroll") for (int _i = 0; _i < 2; ++_i) \
        __builtin_amdgcn_global_load_lds((const unsigned*)((const char*)(gbase) + (voff)[_i]), (PG8_LAS unsigned*)(lds + (bufoff) + ldsw + _i * 8192), 16, 0, 0); } while (0)
#define PG8_LDA(dst, b, h) do { _Pragma("unroll") for (int m = 0; m < 4; ++m) _Pragma("unroll") for (int k = 0; k < 2; ++k) dst[m][k] = *(const PG8_LAS bf16x8*)(lds + PG8_SA(b, h) + aoff + m * 2048 + k * 1024); } while (0)
#define PG8_LDB(dst, b, h) do { _Pragma("unroll") for (int n = 0; n < 2; ++n) _Pragma("unroll") for (int k = 0; k < 2; ++k) dst[n][k] = *(const PG8_LAS bf16x8*)(lds + PG8_SB(b, h) + boff + n * 2048 + k * 1024); } while (0)
#define PG8_MMA(ai, bj, At, Bt) do { __builtin_amdgcn_s_setprio(1); _Pragma("unroll") for (int m = 0; m < 4; ++m) _Pragma("unroll") for (int n = 0; n < 2; ++n) _Pragma("unroll") for (int k = 0; k < 2; ++k) \
        acc[ai][bj][m][n] = __builtin_amdgcn_mfma_f32_16x16x32_bf16(Bt[n][k], At[m][k], acc[ai][bj][m][n], 0, 0, 0); __builtin_amdgcn_s_setprio(0); } while (0)
#define PG8_WAIT_V(n) asm volatile("s_waitcnt vmcnt(" #n ")" ::: "memory")
#define PG8_WAIT_L(n) asm volatile("s_waitcnt lgkmcnt(" #n ")" ::: "memory")
#define PG8_BAR __builtin_amdgcn_s_barrier()
#define PG8_SCHED __builtin_amdgcn_sched_barrier(0)
    Unit cur, nxt; int ui = 0;
    if (!S.next(0, cur)) return;
    f32x4 acc[2][2][4][2];
#pragma unroll
    for (int a = 0; a < 2; ++a)
#pragma unroll
        for (int b = 0; b < 2; ++b)
#pragma unroll
            for (int m = 0; m < 4; ++m)
#pragma unroll
                for (int n = 0; n < 2; ++n) acc[a][b][m][n] = (f32x4){0.f, 0.f, 0.f, 0.f};
    bf16x8 At[4][2], B0[2][2], B1[2][2];
    const char* cA = (const char*)g.A + (size_t)cur.pm * tstep; const char* cB = (const char*)g.Bt + (size_t)cur.pn * tstep;
    S.a_ready(cur);
    if constexpr (SP2) {
        PG8_STAGE(PG8_SB(0, 0), cB, voffB); PG8_STAGE(PG8_SB(0, 1), cB + hstep, voffB); PG8_STAGE(PG8_SA(0, 0), cA, voffA); PG8_STAGE(PG8_SA(0, 1), cA + hstep, voffA);
        if (wr == 1) PG8_BAR;
        PG8_WAIT_V(2); PG8_BAR;
        PG8_STAGE(PG8_SB(1, 0), cB + kstep, voffB); PG8_STAGE(PG8_SA(1, 0), cA + kstep, voffA); PG8_STAGE(PG8_SB(1, 1), cB + hstep + kstep, voffB);
        PG8_WAIT_V(6); PG8_BAR;
    } else {
        PG8_STAGE(PG8_SB(0, 0), cB, voffB); PG8_STAGE(PG8_SA(0, 0), cA, voffA); PG8_STAGE(PG8_SB(0, 1), cB + hstep, voffB); PG8_STAGE(PG8_SA(0, 1), cA + hstep, voffA);
        if (wr == 1) PG8_BAR;
        PG8_WAIT_V(4); PG8_BAR;
        PG8_STAGE(PG8_SB(1, 0), cB + kstep, voffB); PG8_STAGE(PG8_SA(1, 0), cA + kstep, voffA); PG8_STAGE(PG8_SB(1, 1), cB + hstep + kstep, voffB);
        PG8_WAIT_V(6); PG8_BAR;
    }
    for (;;) {
        const bool has_next = S.next(ui + 1, nxt);
        const char* nA = has_next ? (const char*)g.A + (size_t)nxt.pm * tstep : cA; const char* nB = has_next ? (const char*)g.Bt + (size_t)nxt.pn * tstep : cB;
        for (int t = 0; t < nt; t += 2) {
            const bool last = (t == nt - 2);
            const char* a1 = cA + (size_t)(t + 1) * kstep;
            const char* a2 = last ? nA : cA + (size_t)(t + 2) * kstep; const char* b2 = last ? nB : cB + (size_t)(t + 2) * kstep;
            const char* a3 = a2 + kstep; const char* b3 = b2 + kstep;
            if (last && has_next) S.a_ready(nxt);
            if constexpr (SP2) {
            PG8_LDB(B0, 0, 0); PG8_LDB(B1, 0, 1); PG8_SCHED; PG8_LDA(At, 0, 0); PG8_STAGE(PG8_SA(1, 1), a1 + hstep, voffA);
            PG8_WAIT_V(8); PG8_WAIT_L(0); PG8_BAR; PG8_MMA(0, 0, At, B0); PG8_MMA(0, 1, At, B1); PG8_BAR; PG8_SCHED;
            PG8_LDA(At, 0, 1); PG8_STAGE(PG8_SB(0, 0), b2, voffB); PG8_STAGE(PG8_SB(0, 1), b2 + hstep, voffB); PG8_STAGE(PG8_SA(0, 0), a2, voffA);
            PG8_WAIT_V(8); PG8_WAIT_L(0); PG8_BAR; PG8_MMA(1, 0, At, B0); PG8_MMA(1, 1, At, B1); PG8_BAR; PG8_SCHED;
            PG8_LDB(B0, 1, 0); PG8_LDB(B1, 1, 1); PG8_SCHED; PG8_LDA(At, 1, 0); PG8_STAGE(PG8_SA(0, 1), a2 + hstep, voffA);
            PG8_WAIT_V(8); PG8_WAIT_L(0); PG8_BAR; PG8_MMA(0, 0, At, B0); PG8_MMA(0, 1, At, B1); PG8_BAR; PG8_SCHED;
            PG8_LDA(At, 1, 1); PG8_STAGE(PG8_SB(1, 0), b3, voffB); PG8_STAGE(PG8_SB(1, 1), b3 + hstep, voffB); PG8_STAGE(PG8_SA(1, 0), a3, voffA);
            PG8_WAIT_V(8); PG8_WAIT_L(0); PG8_BAR; PG8_MMA(1, 0, At, B0); PG8_MMA(1, 1, At, B1); PG8_BAR; PG8_SCHED;
            } else {
            PG8_LDB(B0, 0, 0); PG8_SCHED; PG8_LDA(At, 0, 0); PG8_STAGE(PG8_SA(1, 1), a1 + hstep, voffA);
            PG8_WAIT_L(8); PG8_BAR; PG8_WAIT_L(0); PG8_MMA(0, 0, At, B0); PG8_BAR; PG8_SCHED;
            PG8_LDB(B1, 0, 1); PG8_STAGE(PG8_SB(0, 0), b2, voffB);
            PG8_BAR; PG8_WAIT_L(0); PG8_MMA(0, 1, At, B1); PG8_BAR;
            PG8_LDA(At, 0, 1); PG8_STAGE(PG8_SA(0, 0), a2, voffA);
            PG8_BAR; PG8_WAIT_L(0); PG8_MMA(1, 0, At, B0); PG8_BAR; PG8_SCHED;
            PG8_STAGE(PG8_SB(0, 1), b2 + hstep, voffB);
            PG8_WAIT_V(6); PG8_BAR; PG8_MMA(1, 1, At, B1); PG8_BAR;
            PG8_LDB(B0, 1, 0); PG8_SCHED; PG8_LDA(At, 1, 0); PG8_STAGE(PG8_SA(0, 1), a2 + hstep, voffA);
            PG8_WAIT_L(8); PG8_BAR; PG8_WAIT_L(0); PG8_MMA(0, 0, At, B0); PG8_BAR; PG8_SCHED;
            PG8_LDB(B1, 1, 1); PG8_STAGE(PG8_SB(1, 0), b3, voffB);
            PG8_BAR; PG8_WAIT_L(0); PG8_MMA(0, 1, At, B1); PG8_BAR;
            PG8_LDA(At, 1, 1); PG8_STAGE(PG8_SA(1, 0), a3, voffA);
            PG8_BAR; PG8_WAIT_L(0); PG8_MMA(1, 0, At, B0); PG8_BAR; PG8_SCHED;
            PG8_STAGE(PG8_SB(1, 1), b3 + hstep, voffB);
            PG8_WAIT_V(6); PG8_BAR; PG8_MMA(1, 1, At, B1); PG8_BAR;
            }
        }
        if constexpr (ALIGN_EPI) { if (wr == 0) PG8_BAR; }
        if constexpr (!Epi::AFTER_DRAIN) { E(acc, cur, wr, wc, fr, fq); S.done(cur); }
        if (!has_next) break;
#pragma unroll
        for (int a = 0; a < 2; ++a)
#pragma unroll
            for (int b = 0; b < 2; ++b)
#pragma unroll
                for (int m = 0; m < 4; ++m)
#pragma unroll
                    for (int n = 0; n < 2; ++n) acc[a][b][m][n] = (f32x4){0.f, 0.f, 0.f, 0.f};
        cur = nxt; cA = nA; cB = nB; ++ui;
        if constexpr (ALIGN_EPI) { if (wr == 1) PG8_BAR; }
    }
    PG8_WAIT_V(0);
    if constexpr (!ALIGN_EPI) { if (wr == 0) PG8_BAR; }
    PG8_BAR;
    if constexpr (Epi::AFTER_DRAIN) { E.fused(acc, cur, wr, wc, fr, fq, lds, wid, lane); S.done(cur); }
#undef PG8_SA
#undef PG8_SB
#undef PG8_STAGE
#undef PG8_LDA
#undef PG8_LDB
#undef PG8_MMA
#undef PG8_WAIT_V
#undef PG8_WAIT_L
#undef PG8_BAR
#undef PG8_SCHED
}
}
#ifndef PG8_SP2
#define PG8_SP2 true
#endif
#ifndef PG8_ALIGN
#define PG8_ALIGN true
#endif

constexpr int BATCH = 2, SEQ = 16384, DM = 2048, T = BATCH * SEQ;
constexpr int INW = 6176, HP = 6400;
constexpr int C_QA = 0, C_KA = 256, C_VA = 512, C_RA = 1024, C_QD = 1536, C_KD = 3072, C_VD = 4608, C_GF = 6144;
constexpr int NHD = 12;
constexpr float EPS = 1e-6f;
constexpr float LOG2E = 1.4426950408889634f;
constexpr float QSCALE = 0.08838834764831845f * LOG2E;
constexpr int NPHASE = 11;

constexpr size_t MiB = 1u << 20;
constexpr size_t WS_CTL = 0, WS_ROPE = 1 * MiB, WS_RS1 = 3 * MiB, WS_RS2 = 3 * MiB + 512 * 1024, WS_SSP = 4 * MiB, WS_WIN = 8 * MiB, WS_WO = 33 * MiB, WS_WQ = 41 * MiB,
                 WS_SK = 49 * MiB, WS_DEC = 50 * MiB, WS_LP = 51 * MiB, WS_IDX = 56 * MiB, WS_GATE = 72 * MiB, WS_DOWN = 88 * MiB, WS_UP = 152 * MiB, WS_XB = 216 * MiB,
                 WS_H = 344 * MiB, WS_X1B = WS_H, WS_QRY = WS_H + 128 * MiB, WS_OP1 = 744 * MiB, WS_OP2 = 840 * MiB, WS_PART = 472 * MiB  , WS_END = 984 * MiB;
constexpr size_t OUT_ST = 0, OUT_OP0 = 128 * MiB;
constexpr int LDS_BYTES = 147456;

#define LAS __attribute__((address_space(3)))
typedef unsigned short bf16_t;
typedef short bf16x8 __attribute__((ext_vector_type(8)));
typedef short s16x4 __attribute__((ext_vector_type(4)));
typedef float f32x4 __attribute__((ext_vector_type(4)));
typedef float f32x2 __attribute__((ext_vector_type(2)));
typedef float f32x16 __attribute__((ext_vector_type(16)));
typedef unsigned u32x4 __attribute__((ext_vector_type(4)));
typedef unsigned u32x2 __attribute__((ext_vector_type(2)));
#define LDS_WAIT() asm volatile("s_waitcnt lgkmcnt(0)" ::: "memory")
#define SBAR() __builtin_amdgcn_sched_barrier(0)

__device__ __forceinline__ float bf2f(unsigned short b) { return __uint_as_float(((unsigned)b) << 16); }
__device__ __forceinline__ float bflo(unsigned w) { return __uint_as_float(w << 16); }
__device__ __forceinline__ float bfhi(unsigned w) { return __uint_as_float(w & 0xffff0000u); }
__device__ __forceinline__ unsigned f2bf(float f) { unsigned u = __float_as_uint(f); return (u + 0x7fffu + ((u >> 16) & 1u)) >> 16; }
__device__ __forceinline__ unsigned pk2(float lo, float hi) { return pg8::cvt_pk_bf16(lo, hi); }
__device__ __forceinline__ float fexp(float x) { return __builtin_amdgcn_exp2f(x * LOG2E); }
__device__ __forceinline__ float flog(float x) { return __builtin_amdgcn_logf(x) * 0.6931471805599453f; }
__device__ __forceinline__ float wave_sum(float v) {
#pragma unroll
    for (int o = 1; o < 64; o <<= 1) v += __shfl_xor(v, o);
    return v;
}
__device__ __forceinline__ int crow(int r, int hi) { return (r & 3) + 8 * (r >> 2) + 4 * hi; }

struct Frame {
    LAS unsigned char* lds; char* ldsg; unsigned char* wsb;
    int tid, lane, wave, vcu, G;
    const float *x, *norm1_g, *w_in, *up_f, *bias_f, *up_b, *bias_b, *out_g, *qn_g, *kn_g, *w_out, *norm2_g, *w_query, *sub_keys, *peer_down, *peer_up;
    float* out;
    f32x2* rope; float *rs1, *rs2, *ssp, *dec, *lp, *gate, *state, *sd, *su, *sx, *csum; int *idx, *part; unsigned char *down8, *up8, *xq8, *fq8;
    bf16_t *WinT, *WoT, *WqT, *SK, *down16, *up16, *xb, *mixed, *h, *x1b, *qry, *op0, *op1, *op2;
};

__device__ __forceinline__ void p0_transpose_item(const float* W, int K, int N, bf16_t* WT, int k0, int n0, int dst_row0, const float* g, LAS float* scr, int lane) {
#pragma unroll 8
    for (int i = 0; i < 32; ++i) { const int kk = 2 * i + (lane >> 5); float w = W[(size_t)(k0 + kk) * N + n0 + (lane & 31)]; if (g) w *= g[k0 + kk]; scr[kk * 33 + (lane & 31)] = w; }
    LDS_WAIT(); asm volatile("" ::: "memory");
    const int c = lane & 7;
#pragma unroll
    for (int j = 0; j < 4; ++j) { const int n = (lane >> 3) + 8 * j; const LAS float* s = scr + (8 * c) * 33 + n;
        u32x4 o; o.x = pk2(s[0 * 33], s[1 * 33]); o.y = pk2(s[2 * 33], s[3 * 33]); o.z = pk2(s[4 * 33], s[5 * 33]); o.w = pk2(s[6 * 33], s[7 * 33]);
        *(u32x4*)(WT + (size_t)(dst_row0 + n) * K + k0 + 8 * c) = o; }
    LDS_WAIT(); asm volatile("" ::: "memory");
}
__device__ __forceinline__ void phase0(const Frame& F) {
    LAS float* scr = (LAS float*)(F.lds + F.wave * 16384);
    const int gw = F.vcu * 8 + F.wave, NGW = F.G * 8, lane = F.lane;
    constexpr int I_IN = 32 * 193, I_O = 32 * 64, I_Q = 32 * 64;
    for (int it = gw; it < I_IN + I_O + I_Q; it += NGW) {
        int r = it;
        if (r < I_IN) { const int kb = r / 193, nb = r % 193; const int drow = nb < 32 ? nb * 32 : (nb == 32 ? C_GF : nb * 32 - 32);
            p0_transpose_item(F.w_in, DM, INW, F.WinT, kb * 64, nb * 32, drow, F.norm1_g, scr, lane); continue; }
        r -= I_IN;
        if (r < I_O) { const int kb = r / 64, nb = r % 64; p0_transpose_item(F.w_out, DM, DM, F.WoT, kb * 64, nb * 32, nb * 32, nullptr, scr, lane); continue; }
        r -= I_O;
        { const int kb = r / 64, nb = r % 64; p0_transpose_item(F.w_query, DM, DM, F.WqT, kb * 64, nb * 32, nb * 32, F.norm2_g, scr, lane); }
    }
    const size_t gt = (size_t)gw * 64 + lane, NT = (size_t)NGW * 64;
    { u32x4* z = (u32x4*)(F.WinT + (size_t)INW * DM); const u32x4 zero = {0u, 0u, 0u, 0u}; for (size_t i = gt; i < (size_t)(HP - INW) * DM / 8; i += NT) z[i] = zero; }
    for (int r = gw; r < 2 * 16384; r += NGW) { const bool isup = r >= 16384; const int e = r & 16383; const f32x4* src = (const f32x4*)((isup ? F.peer_up : F.peer_down) + (size_t)e * DM) + lane;
        f32x4 v[8]; float m = 0.f;
#pragma unroll
        for (int j = 0; j < 8; ++j) { v[j] = src[64 * j]; if (!isup) v[j] = v[j] * ((const f32x4*)F.norm2_g)[lane + 64 * j];
            m = fmaxf(fmaxf(m, fmaxf(fabsf(v[j][0]), fabsf(v[j][1]))), fmaxf(fabsf(v[j][2]), fabsf(v[j][3]))); }
#pragma unroll
        for (int o = 1; o < 64; o <<= 1) m = fmaxf(m, __shfl_xor(m, o));
        const float inv = m > 0.f ? 127.f / m : 0.f; unsigned char* dst = isup ? F.up8 : F.down8; const int bias = 0;
#pragma unroll
        for (int j = 0; j < 8; ++j) { unsigned w = 0u;
#pragma unroll
            for (int i = 0; i < 4; ++i) { const int qv = (int)rintf(v[j][i] * inv) + bias; w |= ((unsigned)qv & 0xffu) << (8 * i); }
            const int col = 4 * lane + 256 * j; *(unsigned*)(dst + ((size_t)(col >> 7) * 16384 + e) * 128 + (col & 127)) = w; }
        if (lane == 0) (isup ? F.su : F.sd)[e] = m * (1.f / 127.f); }
    for (size_t i = gt; i < (size_t)8 * 2 * 128 * 128 / 8; i += NT) { const f32x4 a = *(const f32x4*)(F.sub_keys + i * 8), b = *(const f32x4*)(F.sub_keys + i * 8 + 4);
        u32x4 o; o.x = pk2(a[0], a[1]); o.y = pk2(a[2], a[3]); o.z = pk2(b[0], b[1]); o.w = pk2(b[2], b[3]); *(u32x4*)(F.SK + i * 8) = o; }
    for (int m = gw; m < T; m += NGW) { const f32x4* xr = (const f32x4*)(F.x + (size_t)m * DM) + lane; f32x4 v[8]; float s = 0.f;
#pragma unroll
        for (int j = 0; j < 8; ++j) { v[j] = xr[64 * j]; s += (v[j][0] * v[j][0] + v[j][1] * v[j][1]) + (v[j][2] * v[j][2] + v[j][3] * v[j][3]); }
        s = wave_sum(s); u32x2* o8 = (u32x2*)(F.xb + (size_t)m * DM) + lane;
#pragma unroll
        for (int j = 0; j < 8; ++j) { u32x2 w; w.x = pk2(v[j][0], v[j][1]); w.y = pk2(v[j][2], v[j][3]); o8[64 * j] = w; }
        if (lane == 0) F.rs1[m] = __builtin_amdgcn_rsqf(s * (1.f / DM) + EPS); }
    { const double invf[16] = {1.0, 0.44036660267178046, 0.19392274474868576, 0.08539710028576561, 0.03760603093086393, 0.016560440080994446, 0.007292664737217109, 0.003211445994752591,
                               0.001414213562373095, 0.000622772421914596, 0.0002742481756762073, 0.00012076973741146504, 5.318295896944988e-05, 2.341999896140934e-05, 1.031338537721246e-05, 4.5416704806078695e-06};
      for (size_t i = gt; i < (size_t)SEQ * 16; i += NT) { const int pos = (int)(i >> 4), j = (int)(i & 15); double f = 1.0;
#pragma unroll
          for (int q = 0; q < 16; ++q) f = (j == q) ? invf[q] : f;
          const double rev = (double)pos * f * 0.15915494309189535; const float fr = (float)(rev - floor(rev));
          F.rope[i] = (f32x2){__builtin_amdgcn_cosf(fr), __builtin_amdgcn_sinf(fr)}; } }
}

__device__ __forceinline__ void qknorm_rope(const Frame& F) {
    const int gw = F.vcu * 8 + F.wave, NGW = F.G * 8, lane = F.lane, c = lane & 15;
    for (long it = gw; it < (long)T * 24 / 4; it += NGW) { const long row = it * 4 + (lane >> 4); const int t = (int)(row / 24), slot = (int)(row % 24);
        bf16_t* p = F.h + (size_t)t * HP + C_QD + slot * 128 + 8 * c;
        const u32x4 w = *(const u32x4*)p; float y[8] = {bflo(w.x), bfhi(w.x), bflo(w.y), bfhi(w.y), bflo(w.z), bfhi(w.z), bflo(w.w), bfhi(w.w)};
        float ss = 0.f;
#pragma unroll
        for (int e = 0; e < 8; ++e) ss += y[e] * y[e];
        ss += __shfl_xor(ss, 1); ss += __shfl_xor(ss, 2); ss += __shfl_xor(ss, 4); ss += __shfl_xor(ss, 8);
        const float rq = __builtin_amdgcn_rsqf(ss * (1.f / 128.f) + EPS); const float* g = (slot < 12 ? F.qn_g : F.kn_g) + 8 * c;
        const f32x4 g0 = *(const f32x4*)g, g1 = *(const f32x4*)(g + 4);
#pragma unroll
        for (int e = 0; e < 4; ++e) { y[e] *= rq * g0[e]; y[4 + e] *= rq * g1[e]; }
        const int pos = t & (SEQ - 1);
#pragma unroll
        for (int e = 0; e < 8; ++e) { const float partner = __shfl_xor(y[e], 2);
            if (c < 4) { const f32x2 cs = F.rope[(size_t)pos * 16 + 8 * (c & 1) + e]; y[e] = (c < 2) ? (y[e] * cs.x - partner * cs.y) : (y[e] * cs.x + partner * cs.y); } }
        if (slot < 12) {
#pragma unroll
            for (int e = 0; e < 8; ++e) y[e] *= QSCALE; }
        u32x4 o; o.x = pk2(y[0], y[1]); o.y = pk2(y[2], y[3]); o.z = pk2(y[4], y[5]); o.w = pk2(y[6], y[7]); *(u32x4*)p = o; }
}

constexpr int GL_GDS = 0, GL_TOT = 8192, GL_QF = 12288, GL_QB = 21504, GL_KF = 30720, GL_KB = 39936, GL_VT = 49152, GL_P = 67584, GL_SF = 76800, GL_SB = 95232, GL_OB = 12288;
constexpr int RS72 = 144;
__device__ __forceinline__ float logsig(float z) { return fminf(z, 0.f) - flog(1.f + fexp(-fabsf(z))); }
__device__ __forceinline__ void gla_gates(const Frame& F, int b, int hh, int n, float (&bf)[8], float (&bb)[8], float& totf, float& totb) {
    const int tid = F.tid, c = tid & 63, ig = F.wave; LAS float* gds = (LAS float*)(F.lds + GL_GDS); LAS float* tot = (LAS float*)(F.lds + GL_TOT);
    const size_t t0 = (size_t)b * SEQ + (size_t)n * 64;
    if (tid < 256) { const int tk = tid >> 2, part = tid & 3; const u32x4 w = *(const u32x4*)(F.h + (t0 + tk) * HP + C_GF + part * 8); LAS float* d = gds + tk * 32 + part * 8;
        d[0] = bflo(w.x); d[1] = bfhi(w.x); d[2] = bflo(w.y); d[3] = bfhi(w.y); d[4] = bflo(w.z); d[5] = bfhi(w.z); d[6] = bflo(w.w); d[7] = bfhi(w.w); }
    __syncthreads();
    const int hc = hh * 64 + c; float upf[16], upb[16];
#pragma unroll
    for (int r = 0; r < 16; ++r) { upf[r] = F.up_f[r * 256 + hc]; upb[r] = F.up_b[r * 256 + hc]; }
    const float biasf = F.bias_f[hc], biasb = F.bias_b[hc]; float laf[8], lab[8];
#pragma unroll
    for (int e = 0; e < 8; ++e) { const LAS float* gr = gds + (ig * 8 + e) * 32; float zf = biasf, zb = biasb;
#pragma unroll
        for (int r = 0; r < 16; ++r) { zf += gr[r] * upf[r]; zb += gr[16 + r] * upb[r]; }
        laf[e] = logsig(zf) * 0.0625f; lab[e] = logsig(zb) * 0.0625f; }
    bf[0] = laf[0];
#pragma unroll
    for (int e = 1; e < 8; ++e) bf[e] = bf[e - 1] + laf[e];
    bb[7] = lab[7];
#pragma unroll
    for (int e = 6; e >= 0; --e) bb[e] = bb[e + 1] + lab[e];
    tot[ig * 64 + c] = bf[7]; tot[512 + ig * 64 + c] = bb[0];
    __syncthreads();
    float offf = 0.f, offb = 0.f; totf = 0.f; totb = 0.f;
#pragma unroll
    for (int g = 0; g < 8; ++g) { const float tf = tot[g * 64 + c], tb = tot[512 + g * 64 + c]; totf += tf; totb += tb; offf += (g < ig) ? tf : 0.f; offb += (g > ig) ? tb : 0.f; }
#pragma unroll
    for (int e = 0; e < 8; ++e) { bf[e] += offf; bb[e] += offb; }
}
__device__ __forceinline__ void gla_stage_vT(const Frame& F, size_t t0, int hh) {
#pragma unroll
    for (int j = 0; j < 2; ++j) { const int q = F.tid + 512 * j, tk = q >> 4, vc = (q & 15) * 8; const bf16x8 v = *(const bf16x8*)(F.h + (t0 + tk) * HP + C_VA + hh * 128 + vc);
        LAS short* d = (LAS short*)(F.lds + GL_VT) + vc * 72 + tk;
#pragma unroll
        for (int e = 0; e < 8; ++e) d[e * 72] = v[e]; }
}
__device__ __forceinline__ bf16x8 ldfrag(const LAS unsigned char* base, int row, int s, int hi) { return *(const LAS bf16x8*)(base + row * RS72 + (16 * s + 8 * hi) * 2); }

__device__ __forceinline__ void gla_passA(const Frame& F, int item) {
    const int bh = item >> 8, n = item & 255, b = bh >> 2, hh = bh & 3, tid = F.tid, c = tid & 63, ig = F.wave, lane = F.lane, r32 = lane & 31, hi = lane >> 5;
    float bf[8], bb[8], totf, totb; gla_gates(F, b, hh, n, bf, bb, totf, totb);
    const size_t t0 = (size_t)b * SEQ + (size_t)n * 64;
    float kf[8], kb[8];
#pragma unroll
    for (int e = 0; e < 8; ++e) { const float k = bf2f(F.h[(t0 + ig * 8 + e) * HP + C_KA + hh * 64 + c]); kf[e] = k * fexp(totf - bf[e]); kb[e] = k * fexp(totb - bb[e]); }
    { u32x4 o; o.x = pk2(kf[0], kf[1]); o.y = pk2(kf[2], kf[3]); o.z = pk2(kf[4], kf[5]); o.w = pk2(kf[6], kf[7]); *(LAS u32x4*)(F.lds + GL_KF + c * RS72 + ig * 16) = o;
      o.x = pk2(kb[0], kb[1]); o.y = pk2(kb[2], kb[3]); o.z = pk2(kb[4], kb[5]); o.w = pk2(kb[6], kb[7]); *(LAS u32x4*)(F.lds + GL_KB + c * RS72 + ig * 16) = o; }
    gla_stage_vT(F, t0, hh);
    if (ig == 0) { F.dec[((size_t)(0 * 8 + bh) * 256 + n) * 64 + c] = fexp(totf); F.dec[((size_t)(1 * 8 + bh) * 256 + n) * 64 + c] = fexp(totb); }
    __syncthreads();
    const int dir = F.wave >> 2, vt = F.wave & 3; const LAS unsigned char* kimg = F.lds + (dir ? GL_KB : GL_KF);
    f32x16 a0 = {}, a1 = {};
#pragma unroll
    for (int s = 0; s < 4; ++s) { const bf16x8 av = ldfrag(F.lds + GL_VT, 32 * vt + r32, s, hi), b0 = ldfrag(kimg, r32, s, hi), b1 = ldfrag(kimg, 32 + r32, s, hi);
        a0 = __builtin_amdgcn_mfma_f32_32x32x16_bf16(av, b0, a0, 0, 0, 0); a1 = __builtin_amdgcn_mfma_f32_32x32x16_bf16(av, b1, a1, 0, 0, 0); }
    float* st = F.state + ((size_t)(dir * 8 + bh) * 256 + n) * 8192;
#pragma unroll
    for (int r = 0; r < 16; ++r) { const int v = 32 * vt + crow(r, hi); st[v * 64 + r32] = a0[r]; st[v * 64 + 32 + r32] = a1[r]; }
    __syncthreads();
}
__device__ __forceinline__ void gla_scan(const Frame& F, int item) {
    const int dir = item >> 7, bh = (item >> 4) & 7, e = (item & 15) * 512 + F.tid, c = e & 63;
    float* st = F.state + (size_t)(dir * 8 + bh) * 256 * 8192 + e; const float* dc = F.dec + (size_t)(dir * 8 + bh) * 256 * 64 + c; float S = 0.f;
    float iA[16], dA[16], iB[16], dB[16];
#define SC_N(g, j) (dir ? 255 - ((g) * 16 + (j)) : (g) * 16 + (j))
#define SC_LOAD(I_, D_, g) do { _Pragma("unroll") for (int j = 0; j < 16; ++j) { const int n_ = SC_N(g, j); I_[j] = st[(size_t)n_ * 8192]; D_[j] = dc[n_ * 64]; } } while (0)
#define SC_RUN(I_, D_, g) do { _Pragma("unroll") for (int j = 0; j < 16; ++j) { const int n_ = SC_N(g, j); st[(size_t)n_ * 8192] = S; S = D_[j] * S + I_[j]; } } while (0)
    SC_LOAD(iA, dA, 0);
    for (int g = 0; g < 16; g += 2) { SC_LOAD(iB, dB, g + 1); SC_RUN(iA, dA, g); if (g + 2 < 16) SC_LOAD(iA, dA, g + 2); SC_RUN(iB, dB, g + 1); }
#undef SC_N
#undef SC_LOAD
#undef SC_RUN
}
__device__ __forceinline__ void gla_passC(const Frame& F, int item) {
    const int bh = item >> 8, n = item & 255, b = bh >> 2, hh = bh & 3, tid = F.tid, c = tid & 63, ig = F.wave, lane = F.lane, r32 = lane & 31, hi = lane >> 5;
    float bf[8], bb[8], totf, totb; gla_gates(F, b, hh, n, bf, bb, totf, totb);
    const size_t t0 = (size_t)b * SEQ + (size_t)n * 64;
#pragma unroll
    for (int e = 0; e < 8; ++e) { const int i = ig * 8 + e; const bf16_t* hr = F.h + (t0 + i) * HP + hh * 64 + c; const float q = bf2f(hr[C_QA]) * 0.125f, k = bf2f(hr[C_KA]);
        const float ef = fexp(bf[e]), eb = fexp(bb[e]), nf = fexp(-bf[e]), nb = fexp(-bb[e]);
        *(LAS unsigned short*)(F.lds + GL_QF + i * RS72 + c * 2) = (unsigned short)f2bf(q * ef); *(LAS unsigned short*)(F.lds + GL_QB + i * RS72 + c * 2) = (unsigned short)f2bf(q * eb);
        *(LAS unsigned short*)(F.lds + GL_KF + i * RS72 + c * 2) = (unsigned short)f2bf(k * nf); *(LAS unsigned short*)(F.lds + GL_KB + i * RS72 + c * 2) = (unsigned short)f2bf(k * nb); }
    gla_stage_vT(F, t0, hh);
#pragma unroll
    for (int dir = 0; dir < 2; ++dir) { const float* st = F.state + ((size_t)(dir * 8 + bh) * 256 + n) * 8192; LAS unsigned char* img = F.lds + (dir ? GL_SB : GL_SF);
#pragma unroll
        for (int j = 0; j < 4; ++j) { const int q4 = tid + 512 * j, v = q4 >> 4, c4 = (q4 & 15) * 4; const f32x4 s = *(const f32x4*)(st + v * 64 + c4);
            u32x2 w; w.x = pk2(s[0], s[1]); w.y = pk2(s[2], s[3]); *(LAS u32x2*)(img + v * RS72 + c4 * 2) = w; } }
    __syncthreads();
    if (F.wave < 4) { const int ti = F.wave >> 1, tj = F.wave & 1; f32x16 sf = {}, sb = {};
#pragma unroll
        for (int s = 0; s < 4; ++s) {
            sf = __builtin_amdgcn_mfma_f32_32x32x16_bf16(ldfrag(F.lds + GL_QF, 32 * ti + r32, s, hi), ldfrag(F.lds + GL_KF, 32 * tj + r32, s, hi), sf, 0, 0, 0);
            sb = __builtin_amdgcn_mfma_f32_32x32x16_bf16(ldfrag(F.lds + GL_QB, 32 * ti + r32, s, hi), ldfrag(F.lds + GL_KB, 32 * tj + r32, s, hi), sb, 0, 0, 0); }
#pragma unroll
        for (int r = 0; r < 16; ++r) { const int i = 32 * ti + crow(r, hi), j = 32 * tj + r32; const float p = (j <= i) ? sf[r] : sb[r];
            *(LAS unsigned short*)(F.lds + GL_P + i * RS72 + j * 2) = (unsigned short)f2bf(p); } }
    __syncthreads();
    const int ti = F.wave & 1, tv = F.wave >> 1; f32x16 o = {};
#pragma unroll
    for (int s = 0; s < 4; ++s) o = __builtin_amdgcn_mfma_f32_32x32x16_bf16(ldfrag(F.lds + GL_P, 32 * ti + r32, s, hi), ldfrag(F.lds + GL_VT, 32 * tv + r32, s, hi), o, 0, 0, 0);
#pragma unroll
    for (int s = 0; s < 4; ++s) o = __builtin_amdgcn_mfma_f32_32x32x16_bf16(ldfrag(F.lds + GL_QF, 32 * ti + r32, s, hi), ldfrag(F.lds + GL_SF, 32 * tv + r32, s, hi), o, 0, 0, 0);
#pragma unroll
    for (int s = 0; s < 4; ++s) o = __builtin_amdgcn_mfma_f32_32x32x16_bf16(ldfrag(F.lds + GL_QB, 32 * ti + r32, s, hi), ldfrag(F.lds + GL_SB, 32 * tv + r32, s, hi), o, 0, 0, 0);
    __syncthreads();
    LAS float* ob = (LAS float*)(F.lds + GL_OB);
#pragma unroll
    for (int r = 0; r < 16; ++r) ob[(32 * ti + crow(r, hi)) * 132 + 32 * tv + r32] = o[r];
    __syncthreads();
    { const int i = tid >> 3, part = tid & 7, v0 = part * 16; float ov[16], ss = 0.f;
#pragma unroll
      for (int e = 0; e < 16; ++e) { ov[e] = ob[i * 132 + v0 + e]; ss += ov[e] * ov[e]; }
      ss += __shfl_xor(ss, 1); ss += __shfl_xor(ss, 2); ss += __shfl_xor(ss, 4);
      const float rs = __builtin_amdgcn_rsqf(ss * (1.f / 128.f) + EPS); const size_t tok = t0 + i;
      const u32x4 r0 = *(const u32x4*)(F.h + tok * HP + C_RA + hh * 128 + v0), r1 = *(const u32x4*)(F.h + tok * HP + C_RA + hh * 128 + v0 + 8);
      const float rr[16] = {bflo(r0.x), bfhi(r0.x), bflo(r0.y), bfhi(r0.y), bflo(r0.z), bfhi(r0.z), bflo(r0.w), bfhi(r0.w), bflo(r1.x), bfhi(r1.x), bflo(r1.y), bfhi(r1.y), bflo(r1.z), bfhi(r1.z), bflo(r1.w), bfhi(r1.w)};
      float y[16];
#pragma unroll
      for (int e = 0; e < 16; ++e) { const float g = F.out_g[hh * 128 + v0 + e]; const float sil = rr[e] * __builtin_amdgcn_rcpf(1.f + fexp(-rr[e])); y[e] = ov[e] * rs * g * sil; }
      u32x4 w0, w1; w0.x = pk2(y[0], y[1]); w0.y = pk2(y[2], y[3]); w0.z = pk2(y[4], y[5]); w0.w = pk2(y[6], y[7]); w1.x = pk2(y[8], y[9]); w1.y = pk2(y[10], y[11]); w1.z = pk2(y[12], y[13]); w1.w = pk2(y[14], y[15]);
      bf16_t* mp = F.mixed + tok * DM + hh * 128 + v0; *(u32x4*)mp = w0; *(u32x4*)(mp + 8) = w1; }
    __syncthreads();
}

constexpr int AT_V = 0, AT_K = 32768, AT_O = 65536;
#define KSWZ(row, colB) ((row) * 256 + ((colB) ^ (((row) & 7) << 4)))
__device__ __forceinline__ int v_st(int k, int c) { const int kk = (k & ~0xC) | ((k & 4) << 1) | ((k & 8) >> 1); return ((kk >> 3) * 4 + (c >> 5)) * 512 + ((kk & 7) * 32 + (c & 31)) * 2; }
__device__ __forceinline__ int v_rd_base(int lane) { return ((lane & 3) << 3) | (((lane >> 2) & 3) << 6) | (((lane >> 4) & 1) << 5) | (((lane >> 5) & 1) << 8); }
constexpr int v_rd_off(int d0, int ks, int half) { return d0 * 512 + ks * 4096 + half * 2048; }
template <int OFF> __device__ __forceinline__ s16x4 tr_read(int vb) { s16x4 r; asm volatile("ds_read_b64_tr_b16 %0, %1 offset:%2" : "=&v"(r) : "v"(vb), "i"(OFF) : "memory"); return r; }
template <int D0> __device__ __forceinline__ void pv_one(f32x16& od, int vb, bf16x8 pa0, bf16x8 pa1, bf16x8 pa2, bf16x8 pa3) {
    const s16x4 l0 = tr_read<v_rd_off(D0, 0, 0)>(vb), h0 = tr_read<v_rd_off(D0, 0, 1)>(vb), l1 = tr_read<v_rd_off(D0, 1, 0)>(vb), h1 = tr_read<v_rd_off(D0, 1, 1)>(vb);
    const s16x4 l2 = tr_read<v_rd_off(D0, 2, 0)>(vb), h2 = tr_read<v_rd_off(D0, 2, 1)>(vb), l3 = tr_read<v_rd_off(D0, 3, 0)>(vb), h3 = tr_read<v_rd_off(D0, 3, 1)>(vb);
    asm volatile("s_waitcnt lgkmcnt(0)" ::: "memory"); SBAR();
#define PKV(L, H) (bf16x8){L[0], L[1], L[2], L[3], H[0], H[1], H[2], H[3]}
    od = __builtin_amdgcn_mfma_f32_32x32x16_bf16(pa0, PKV(l0, h0), od, 0, 0, 0);
    od = __builtin_amdgcn_mfma_f32_32x32x16_bf16(pa1, PKV(l1, h1), od, 0, 0, 0);
    od = __builtin_amdgcn_mfma_f32_32x32x16_bf16(pa2, PKV(l2, h2), od, 0, 0, 0);
    od = __builtin_amdgcn_mfma_f32_32x32x16_bf16(pa3, PKV(l3, h3), od, 0, 0, 0);
#undef PKV
}
struct AtP { size_t tokbase; int dil, m0, Tf, nt, head, p; };
__device__ __forceinline__ AtP at_decode(int item) {
    AtP P; const int p = item / 1536, rem = item % 1536, b = rem / 768, rem2 = rem % 768, u = rem2 & 63; P.p = p; P.head = rem2 >> 6;
    const int dsh = 2 * p, L = SEQ >> dsh, runs = 64 >> dsh, res = u / runs; P.dil = 1 << dsh; P.m0 = (u % runs) * 256; P.tokbase = (size_t)b * SEQ + res;
    const int kt_lo = (P.m0 == 0) ? 1 : 0, kt_hi = (P.m0 + 256 >= L) ? 4 : 5; P.Tf = P.m0 - 64 + 64 * kt_lo; P.nt = kt_hi - kt_lo + 1; return P;
}
__device__ __forceinline__ void attn_phase(const Frame& F) {
    const int tid = F.tid, wid = F.wave, lane = F.lane, r32 = lane & 31, hi = lane >> 5, G = F.G;
    int ntot = 0; for (int it = F.vcu; it < 4608; it += G) ntot += at_decode(it).nt;
    if (ntot == 0) return;
    const int sr = tid >> 4, sc = (tid & 15) * 8, vst0 = v_st(sr, sc), vst1 = v_st(32 + sr, sc), kc = sc * 2;
    const int vb0 = (int)(unsigned)(uintptr_t)(F.ldsg + AT_V) + v_rd_base(lane);
    int it_ld = F.vcu, rl = 0, it_c = F.vcu, rc = 0; AtP ld = at_decode(it_ld), cur = ld;
    bf16x8 qr[8], qn[8]; f32x16 o[4]; float l_reg = 0.f;
    bf16x8 sA0, sA1, sA2, sA3;
#define AT_QLOAD() do { const bf16_t* qp_ = F.h + C_QD + ld.head * 128 + (ld.tokbase + (size_t)ld.dil * (ld.m0 + 32 * wid + r32)) * HP + hi * 8; \
        _Pragma("unroll") for (int d0 = 0; d0 < 8; ++d0) qn[d0] = *(const bf16x8*)(qp_ + d0 * 16); } while (0)
#define AT_SLOAD(S) do { const int T0_ = ld.Tf + 64 * rl; const size_t ra = (ld.tokbase + (size_t)ld.dil * (T0_ + sr)) * HP + ld.head * 128 + sc, rb = ra + (size_t)ld.dil * 32 * HP; \
        S##0 = *(const bf16x8*)(F.h + C_VD + ra); S##1 = *(const bf16x8*)(F.h + C_VD + rb); S##2 = *(const bf16x8*)(F.h + C_KD + ra); S##3 = *(const bf16x8*)(F.h + C_KD + rb); \
        if (++rl == ld.nt) { it_ld += G; rl = 0; if (it_ld < 4608) { ld = at_decode(it_ld); AT_QLOAD(); } } } while (0)
#define AT_SWRITE(S, B) do { *(LAS bf16x8*)(F.lds + AT_V + (B) * 16384 + vst0) = S##0; *(LAS bf16x8*)(F.lds + AT_V + (B) * 16384 + vst1) = S##1; \
        *(LAS bf16x8*)(F.lds + AT_K + (B) * 16384 + KSWZ(sr, kc)) = S##2; *(LAS bf16x8*)(F.lds + AT_K + (B) * 16384 + KSWZ(32 + sr, kc)) = S##3; } while (0)
#define PK4(P, BASE, OUT) do { unsigned a0_ = pk2(P[BASE + 0], P[BASE + 1]), a1_ = pk2(P[BASE + 2], P[BASE + 3]); unsigned b0_ = pk2(P[BASE + 4], P[BASE + 5]), b1_ = pk2(P[BASE + 6], P[BASE + 7]); \
        auto r0_ = __builtin_amdgcn_permlane32_swap(a0_, b0_, false, false); auto r1_ = __builtin_amdgcn_permlane32_swap(a1_, b1_, false, false); \
        u32x4 w_ = {r0_[0], r1_[0], r0_[1], r1_[1]}; OUT = __builtin_bit_cast(bf16x8, w_); } while (0)
#define AT_STEP(BUF) do { \
        if (rc == 0) { _Pragma("unroll") for (int d0 = 0; d0 < 8; ++d0) qr[d0] = qn[d0]; _Pragma("unroll") for (int d0 = 0; d0 < 4; ++d0) o[d0] = (f32x16){}; l_reg = 0.f; } \
        const int Q0 = cur.m0 + 32 * wid, T0 = cur.Tf + 64 * rc; \
        if (T0 + 63 >= Q0 - 64 && T0 <= Q0 + 95) {                                        \
            const LAS unsigned char* Ks = F.lds + AT_K + (BUF) * 16384; f32x16 p0 = {}, p1 = {}; \
            _Pragma("unroll") for (int d0 = 0; d0 < 8; ++d0) { const int cb = (d0 * 16 + hi * 8) * 2; \
                const bf16x8 k0 = *(const LAS bf16x8*)(Ks + KSWZ(r32, cb)), k1 = *(const LAS bf16x8*)(Ks + KSWZ(32 + r32, cb)); \
                p0 = __builtin_amdgcn_mfma_f32_32x32x16_bf16(k0, qr[d0], p0, 0, 0, 0); p1 = __builtin_amdgcn_mfma_f32_32x32x16_bf16(k1, qr[d0], p1, 0, 0, 0); } \
            const int dq = T0 - (Q0 + r32); float ps = 0.f;                                \
            _Pragma("unroll") for (int r = 0; r < 16; ++r) { const int e0 = dq + crow(r, hi), e1 = e0 + 32; \
                p0[r] = (e0 >= -64 && e0 <= 64) ? __builtin_amdgcn_exp2f(p0[r]) : 0.f; p1[r] = (e1 >= -64 && e1 <= 64) ? __builtin_amdgcn_exp2f(p1[r]) : 0.f; ps += p0[r] + p1[r]; } \
            l_reg += ps; \
            bf16x8 pa0, pa1, pa2, pa3; PK4(p0, 0, pa0); PK4(p0, 8, pa1); PK4(p1, 0, pa2); PK4(p1, 8, pa3); \
            const int vb = vb0 + (BUF) * 16384; \
            pv_one<0>(o[0], vb, pa0, pa1, pa2, pa3); pv_one<1>(o[1], vb, pa0, pa1, pa2, pa3); pv_one<2>(o[2], vb, pa0, pa1, pa2, pa3); pv_one<3>(o[3], vb, pa0, pa1, pa2, pa3); } \
        if (++rc == cur.nt) {                                                             \
            bf16_t* Op = (bf16_t*)(cur.p == 0 ? (unsigned char*)F.out + OUT_OP0 : F.wsb + (cur.p == 1 ? WS_OP1 : WS_OP2)); \
            const float lt = l_reg + __shfl_xor(l_reg, 32); \
            if (hi == 0) F.lp[((size_t)cur.p * T + cur.tokbase + (size_t)cur.dil * (Q0 + r32)) * NHD + cur.head] = lt; \
            LAS unsigned char* stg = F.lds + AT_O + wid * 8192; \
            _Pragma("unroll") for (int d0 = 0; d0 < 4; ++d0) _Pragma("unroll") for (int r = 0; r < 16; ++r) *(LAS unsigned short*)(stg + (crow(r, hi) * 128 + d0 * 32 + r32) * 2) = (unsigned short)f2bf(o[d0][r]); \
            LDS_WAIT(); asm volatile("" ::: "memory"); \
            _Pragma("unroll") for (int i_ = 0; i_ < 8; ++i_) { const int row = 4 * i_ + (lane >> 4), ch = lane & 15; const u32x4 w = *(const LAS u32x4*)(stg + row * 256 + ch * 16); \
                *(u32x4*)(Op + (cur.tokbase + (size_t)cur.dil * (Q0 + row)) * (NHD * 128) + cur.head * 128 + ch * 8) = w; } \
            LDS_WAIT(); asm volatile("" ::: "memory"); \
            rc = 0; it_c += G; if (it_c < 4608) cur = at_decode(it_c); } } while (0)
    AT_QLOAD();
    AT_SLOAD(sA); AT_SWRITE(sA, 0); AT_SLOAD(sA); __syncthreads();
    for (int g = 0; g < ntot; ++g) { const int buf = g & 1;
        AT_STEP(buf);
        if (g + 1 < ntot) AT_SWRITE(sA, buf ^ 1);
        if (it_ld < 4608) AT_SLOAD(sA);
        __syncthreads();
    }
#undef AT_QLOAD
#undef AT_SLOAD
#undef AT_SWRITE
#undef PK4
#undef AT_STEP
}
__device__ __forceinline__ void dil_combine(const Frame& F) {
    const int gw = F.vcu * 8 + F.wave, NGW = F.G * 8, lane = F.lane, c = lane & 15;
    for (long it = gw; it < (long)T * NHD / 4; it += NGW) { const long row = it * 4 + (lane >> 4); const size_t tok = (size_t)(row / NHD); const int head = (int)(row % NHD);
        const float l = F.lp[tok * NHD + head] + F.lp[((size_t)T + tok) * NHD + head] + F.lp[((size_t)2 * T + tok) * NHD + head]; const float inv = 1.f / l;
        const size_t off = tok * (NHD * 128) + head * 128 + 8 * c; const u32x4 a = *(const u32x4*)(F.op0 + off), b = *(const u32x4*)(F.op1 + off), d = *(const u32x4*)(F.op2 + off);
        u32x4 o; o.x = pk2((bflo(a.x) + bflo(b.x) + bflo(d.x)) * inv, (bfhi(a.x) + bfhi(b.x) + bfhi(d.x)) * inv); o.y = pk2((bflo(a.y) + bflo(b.y) + bflo(d.y)) * inv, (bfhi(a.y) + bfhi(b.y) + bfhi(d.y)) * inv);
        o.z = pk2((bflo(a.z) + bflo(b.z) + bflo(d.z)) * inv, (bfhi(a.z) + bfhi(b.z) + bfhi(d.z)) * inv); o.w = pk2((bflo(a.w) + bflo(b.w) + bflo(d.w)) * inv, (bfhi(a.w) + bfhi(b.w) + bfhi(d.w)) * inv);
        *(u32x4*)(F.mixed + tok * DM + 512 + head * 128 + 8 * c) = o; }
}

__device__ __forceinline__ unsigned fl_flip(float x) { const unsigned u = __float_as_uint(x); return u ^ ((unsigned)((int)u >> 31) | 0x80000000u); }
__device__ __forceinline__ float fl_unflip(unsigned w) { return __uint_as_float((w & 0x80000000u) ? (w ^ 0x80000000u) : ~w); }
#define CE_DESC(a, b) do { const unsigned x_ = max(a, b), y_ = min(a, b); a = x_; b = y_; } while (0)
__device__ __forceinline__ void sort16_desc(unsigned (&a)[16]) {
#pragma unroll
    for (int k = 2; k <= 16; k <<= 1)
#pragma unroll
        for (int j = k >> 1; j > 0; j >>= 1)
#pragma unroll
            for (int i = 0; i < 16; ++i) { const int l = i ^ j; if (l > i) { const unsigned x = max(a[i], a[l]), y = min(a[i], a[l]); if ((i & k) == 0) { a[i] = x; a[l] = y; } else { a[i] = y; a[l] = x; } } }
}
__device__ __forceinline__ void bmerge16_desc(unsigned (&a)[16]) {
#pragma unroll
    for (int j = 8; j > 0; j >>= 1)
#pragma unroll
        for (int i = 0; i < 16; ++i) { const int l = i ^ j; if (l > i) CE_DESC(a[i], a[l]); }
}
__device__ __forceinline__ void top16_merge(unsigned (&a)[16], const unsigned (&b)[16]) {
#pragma unroll
    for (int i = 0; i < 16; ++i) a[i] = max(a[i], b[15 - i]);
    bmerge16_desc(a);
}
__device__ __forceinline__ void top16_partner(unsigned (&a)[16]) {
    unsigned b[16];
#pragma unroll
    for (int i = 0; i < 16; ++i) b[i] = (unsigned)__shfl_xor((int)a[i], 32);
    top16_merge(a, b);
}
__device__ constexpr unsigned char stair(int n) {
    constexpr unsigned char L[64] = {0x00,0x01,0x02,0x03,0x04,0x05,0x06,0x07,0x08,0x09,0x0a,0x0b,0x0c,0x0d,0x0e,0x0f,0x10,0x11,0x12,0x13,0x14,0x15,0x16,0x17,0x20,0x21,0x22,0x23,0x24,0x30,0x31,0x32,
                                     0x33,0x40,0x41,0x42,0x50,0x51,0x60,0x61,0x70,0x71,0x80,0x90,0xa0,0xb0,0xc0,0xd0,0xe0,0xf0,0xff,0xff,0xff,0xff,0xff,0xff,0xff,0xff,0xff,0xff,0xff,0xff,0xff,0xff};
    return L[n];
}
__device__ __forceinline__ void topk_item(const Frame& F, int item) {
    const int lane = F.lane, r32 = lane & 31, hi = lane >> 5, hh = item & 7, tok0 = (item >> 3) * 32; const size_t tok = (size_t)tok0 + r32;
    LAS int* ktab = (LAS int*)(F.lds + F.wave * 4096) + r32 * 32;
    float ss = 0.f;
    { const f32x4* sp = (const f32x4*)(F.ssp + tok * 32 + hi * 16);
#pragma unroll
      for (int j = 0; j < 4; ++j) { const f32x4 v = sp[j]; ss += (v[0] + v[1]) + (v[2] + v[3]); } }
    ss += __shfl_xor(ss, 32);
    const float rs2 = __builtin_amdgcn_rsqf(ss * (1.f / DM) + EPS);
    if (hh == 0 && hi == 0) F.rs2[tok] = rs2;
    unsigned top[2][16];
#pragma unroll
    for (int cc = 0; cc < 2; ++cc) {
        f32x16 acc[4] = {};
        const bf16_t* qp = F.qry + tok * DM + hh * 256 + cc * 128 + hi * 8; const bf16_t* kp = F.SK + ((size_t)(hh * 2 + cc) * 128 + r32) * 128 + hi * 8;
#pragma unroll 2
        for (int s = 0; s < 8; ++s) { const bf16x8 qf = *(const bf16x8*)(qp + 16 * s);
#pragma unroll
            for (int kt = 0; kt < 4; ++kt) { const bf16x8 kf = *(const bf16x8*)(kp + (size_t)kt * 32 * 128 + 16 * s); acc[kt] = __builtin_amdgcn_mfma_f32_32x32x16_bf16(kf, qf, acc[kt], 0, 0, 0); } }
        unsigned g[4][16];
#pragma unroll
        for (int kt = 0; kt < 4; ++kt) {
#pragma unroll
            for (int r = 0; r < 16; ++r) g[kt][r] = (fl_flip(acc[kt][r]) & ~127u) | (unsigned)(127 - (32 * kt + crow(r, hi)));
            sort16_desc(g[kt]); }
        top16_merge(g[0], g[1]); top16_merge(g[2], g[3]); top16_merge(g[0], g[2]); top16_partner(g[0]);
#pragma unroll
        for (int i = 0; i < 16; ++i) top[cc][i] = g[0][i];
    }
#pragma unroll
    for (int i = 0; i < 16; ++i) ktab[hi * 16 + i] = 127 - (int)((hi ? top[1][i] : top[0][i]) & 127u);
    float s0[16], s1[16];
#pragma unroll
    for (int i = 0; i < 16; ++i) { s0[i] = fl_unflip(top[0][i] & ~127u); s1[i] = fl_unflip(top[1][i] & ~127u); }
    unsigned ca[16], cb[16];
#pragma unroll
    for (int n = 0; n < 32; ++n) { const int A = stair(n), B = stair(25 + n); unsigned va = 0u, vb = 0u;
        if (n < 25) { va = (fl_flip(s0[A >> 4] + s1[A & 15]) & ~255u) | (unsigned)(255 - A); vb = (fl_flip(s0[B >> 4] + s1[B & 15]) & ~255u) | (unsigned)(255 - B); }
        const unsigned v = hi ? vb : va; if (n < 16) ca[n] = v; else cb[n - 16] = v; }
    sort16_desc(ca); sort16_desc(cb); top16_merge(ca, cb); top16_partner(ca);
    float e[16], sum = 0.f; const float mx = fl_unflip(ca[0] & ~255u) * rs2;
#pragma unroll
    for (int i = 0; i < 16; ++i) { e[i] = fexp(fl_unflip(ca[i] & ~255u) * rs2 - mx); sum += e[i]; }
    const float inv = 1.f / sum;
    LDS_WAIT(); asm volatile("" ::: "memory");
    int oi[8]; float og[8];
#pragma unroll
    for (int k = 0; k < 8; ++k) { const unsigned cv = hi ? ca[8 + k] : ca[k]; const int code = 255 - (int)(cv & 255u); og[k] = (hi ? e[8 + k] : e[k]) * inv; oi[k] = ktab[code >> 4] * 128 + ktab[16 + (code & 15)]; }
    { int* ip = F.idx + tok * 128 + hh * 16 + hi * 8; float* gp = F.gate + tok * 128 + hh * 16 + hi * 8;
      *(int4*)ip = make_int4(oi[0], oi[1], oi[2], oi[3]); *(int4*)(ip + 4) = make_int4(oi[4], oi[5], oi[6], oi[7]);
      *(f32x4*)gp = (f32x4){og[0], og[1], og[2], og[3]}; *(f32x4*)(gp + 4) = (f32x4){og[4], og[5], og[6], og[7]}; }
    LDS_WAIT(); asm volatile("" ::: "memory");
}

constexpr int PS_NSL = 16, PS_CW = DM / PS_NSL, PS_SUB = PS_NSL / 8, PS_TG = 32, PS_NTG = T / PS_TG;
__device__ __forceinline__ float gelu_tanh(float x) { const float u = 0.7978845608028654f * (x + 0.044715f * x * x * x); const float t = 1.f - 2.f * __builtin_amdgcn_rcpf(1.f + fexp(2.f * u)); return 0.5f * x * (1.f + t); }
__device__ __forceinline__ int dot16i(u32x4 w, u32x4 x) { int p = __builtin_amdgcn_sdot4((int)w.x, (int)x.x, 0, false); p = __builtin_amdgcn_sdot4((int)w.y, (int)x.y, p, false); p = __builtin_amdgcn_sdot4((int)w.z, (int)x.z, p, false); return __builtin_amdgcn_sdot4((int)w.w, (int)x.w, p, false); }
__device__ __forceinline__ unsigned xcc_id() { return (unsigned)__builtin_amdgcn_s_getreg((3 << 11) | 20) & 7u; }
__device__ __forceinline__ bool peer_claim(unsigned* cnt, unsigned x, unsigned& d, int lane, int& q, int& tg) {
    while (d < 8u) { const unsigned xq = (x + d) & 7u; unsigned u = 0u;
        if (lane == 0) u = __hip_atomic_fetch_add(cnt + 64 * xq, 1u, __ATOMIC_RELAXED, __HIP_MEMORY_SCOPE_AGENT);
        u = (unsigned)__builtin_amdgcn_readfirstlane((int)u);
        if (u < (unsigned)(PS_SUB * PS_NTG)) { q = (int)(u / PS_NTG) * 8 + (int)xq; tg = (int)(u % PS_NTG); return true; }
        ++d; }
    return false;
}
template <int CTRL> __device__ __forceinline__ float dppmov(float x) { return __int_as_float(__builtin_amdgcn_update_dpp(0, __float_as_int(x), CTRL, 0xf, 0xf, true)); }
template <int CTRL> __device__ __forceinline__ int dppmovi(int x) { return __builtin_amdgcn_update_dpp(0, x, CTRL, 0xf, 0xf, true); }
__device__ __forceinline__ int bperm(int srclane, int v) { return __builtin_amdgcn_ds_bpermute(srclane << 2, v); }
__device__ __forceinline__ void peer_quant_x(const Frame& F) {
    const int gw = F.vcu * 8 + F.wave, NGW = F.G * 8, lane = F.lane;
    for (int tok = gw; tok < T; tok += NGW) { const u32x4* xr = (const u32x4*)(F.x1b + (size_t)tok * DM) + lane; float v[4][8]; float m = 0.f;
#pragma unroll
        for (int j = 0; j < 4; ++j) { const u32x4 w = xr[64 * j]; v[j][0] = bflo(w.x); v[j][1] = bfhi(w.x); v[j][2] = bflo(w.y); v[j][3] = bfhi(w.y); v[j][4] = bflo(w.z); v[j][5] = bfhi(w.z); v[j][6] = bflo(w.w); v[j][7] = bfhi(w.w);
#pragma unroll
            for (int i = 0; i < 8; ++i) m = fmaxf(m, fabsf(v[j][i])); }
#pragma unroll
        for (int o = 1; o < 64; o <<= 1) m = fmaxf(m, __shfl_xor(m, o));
        const float inv = m > 0.f ? 127.f / m : 0.f;
#pragma unroll
        for (int j = 0; j < 4; ++j) { u32x2 w = {0u, 0u};
#pragma unroll
            for (int i = 0; i < 4; ++i) { w.x |= ((unsigned)(int)rintf(v[j][i] * inv) & 0xffu) << (8 * i); w.y |= ((unsigned)(int)rintf(v[j][4 + i] * inv) & 0xffu) << (8 * i); }
            *(u32x2*)(F.xq8 + (size_t)tok * DM + 8 * lane + 512 * j) = w; }
        if (lane == 0) F.sx[tok] = m * (1.f / 127.f); }
}
__device__ __forceinline__ void peer_down(const Frame& F, int cntw = 1024) {
    const int lane = F.lane, g = lane >> 3, c = lane & 7; const unsigned x = xcc_id(); unsigned d = 0u; int q, tg; unsigned* cnt = (unsigned*)(F.wsb + WS_CTL) + cntw;
    const unsigned char* tab = F.down8; const unsigned char* xb = F.xq8;
    while (peer_claim(cnt, x, d, lane, q, tg)) {
        const unsigned colb = (unsigned)(q * PS_CW + 16 * c), slb = (unsigned)q * (16384u * 128u) + 16u * c; int* part = F.part + (size_t)q * T * 128; const size_t tok0 = (size_t)tg * PS_TG;
        u32x4 wA[16], wB[16], xA, xB; int iA0, iA1, iB0, iB1;
#define PD_IDX(i0, i1, tok) do { const int* ip_ = F.idx + (tok) * 128 + lane; i0 = ip_[0]; i1 = ip_[64]; } while (0)
#define PD_ROWS(W_, X_, i0, i1, tok) do { _Pragma("unroll") for (int j = 0; j < 16; ++j) { const unsigned e_ = (unsigned)bperm(8 * (j & 7) + g, j < 8 ? i0 : i1); \
            W_[j] = *(const u32x4*)(tab + (e_ * 128u + slb)); } X_ = *(const u32x4*)(xb + (tok) * DM + colb); } while (0)
#define PD_COMP(W_, X_, tok) do { int p[16]; _Pragma("unroll") for (int j = 0; j < 16; ++j) p[j] = dot16i(W_[j], X_); \
            int a1[8], a2[4], a3[2]; \
            _Pragma("unroll") for (int i = 0; i < 8; ++i) { const int keep = (c & 1) ? p[2 * i + 1] : p[2 * i], give = (c & 1) ? p[2 * i] : p[2 * i + 1]; a1[i] = keep + dppmovi<0xB1>(give); } \
            _Pragma("unroll") for (int i = 0; i < 4; ++i) { const int keep = (c & 2) ? a1[2 * i + 1] : a1[2 * i], give = (c & 2) ? a1[2 * i] : a1[2 * i + 1]; a2[i] = keep + dppmovi<0x4E>(give); } \
            _Pragma("unroll") for (int i = 0; i < 2; ++i) { const int keep = (c & 4) ? a2[2 * i + 1] : a2[2 * i], give = (c & 4) ? a2[2 * i] : a2[2 * i + 1]; a3[i] = keep + __shfl_xor(give, 4); } \
            part[(tok) * 128 + 8 * c + g] = a3[0]; part[(tok) * 128 + 64 + 8 * c + g] = a3[1]; } while (0)
        PD_IDX(iA0, iA1, tok0); PD_IDX(iB0, iB1, tok0 + 1);
        PD_ROWS(wA, xA, iA0, iA1, tok0);
        for (int tt = 0; tt < PS_TG; tt += 2) { const size_t tok = tok0 + tt;
            PD_ROWS(wB, xB, iB0, iB1, tok + 1);
            const size_t t2 = tok + (tt + 2 < PS_TG ? 2 : 0), t3 = tok + (tt + 2 < PS_TG ? 3 : 1);
            PD_IDX(iA0, iA1, t2);
            PD_COMP(wA, xA, tok);
            if (tt + 2 < PS_TG) PD_ROWS(wA, xA, iA0, iA1, t2);
            PD_IDX(iB0, iB1, t3);
            PD_COMP(wB, xB, tok + 1);
        }
#undef PD_IDX
#undef PD_ROWS
#undef PD_COMP
    }
}
__device__ __forceinline__ void peer_coef_probe(const Frame& F, bool dry) {
    const int gw = F.vcu * 8 + F.wave, NGW = F.G * 8, lane = F.lane;
    for (int tok = gw; tok < T; tok += NGW) { int a0 = 0, a1 = 0; const int* pp = F.part + (size_t)tok * 128 + lane;
#pragma unroll
        for (int q = 0; q < PS_NSL; ++q) { a0 += pp[(size_t)q * T * 128]; a1 += pp[(size_t)q * T * 128 + 64]; }
        const float sc = F.rs2[tok] * F.sx[tok]; const float* gp = F.gate + (size_t)tok * 128 + lane; const int e0 = F.idx[(size_t)tok * 128 + lane], e1 = F.idx[(size_t)tok * 128 + 64 + lane];
        const float c0 = gp[0] * gelu_tanh((float)a0 * sc * F.sd[e0]) * F.su[e0], c1 = gp[64] * gelu_tanh((float)a1 * sc * F.sd[e1]) * F.su[e1];
        float m = fmaxf(fabsf(c0), fabsf(c1));
#pragma unroll
        for (int o = 1; o < 64; o <<= 1) m = fmaxf(m, __shfl_xor(m, o));
        const float inv = m > 0.f ? 127.f / m : 0.f; const int q0 = (int)rintf(c0 * inv), q1 = (int)rintf(c1 * inv);
        unsigned char* fp = (dry ? F.wsb + WS_PART + 256 * MiB : F.fq8) + (size_t)tok * 128;
        { const int k0 = lane, k1 = 64 + lane; fp[(8 * (k0 >> 5) + (k0 & 7)) * 4 + ((k0 >> 3) & 3)] = (unsigned char)q0; fp[(8 * (k1 >> 5) + (k1 & 7)) * 4 + ((k1 >> 3) & 3)] = (unsigned char)q1; }
        if (lane == 0 && !dry) F.csum[tok] = m * (1.f / 127.f); }
}
__device__ __forceinline__ void peer_up(const Frame& F, int cntw = 2048, bool dry = false) {
    const int lane = F.lane, g = lane >> 3, c = lane & 7; const unsigned x = xcc_id(); unsigned d = 0u; int q, tg; unsigned* cnt = (unsigned*)(F.wsb + WS_CTL) + cntw;
    const unsigned char* tab = F.up8;
    while (peer_claim(cnt, x, d, lane, q, tg)) {
        const unsigned slb = (unsigned)q * (16384u * 128u) + 16u * c; const int col0 = q * PS_CW + 16 * c; const size_t tok0 = (size_t)tg * PS_TG;
        u32x4 wA[16], wB[16]; int iA0, iA1, iB0, iB1, fqA, fqB, fA[4], fB[4]; float oA0, oA1, oB0, oB1;
#define PU_IDX(i0, i1, fq, o0, o1, tok) do { const size_t o_ = (tok) * 128; i0 = F.idx[o_ + lane]; i1 = F.idx[o_ + 64 + lane]; fq = *(const int*)(F.fq8 + o_ + 4 * (lane & 31)); \
            const float* op_ = F.out + (tok) * DM + col0 + g; o0 = op_[0]; o1 = op_[8]; } while (0)
#define PU_ROWS(W_, F_, i0, i1, fq) do { _Pragma("unroll") for (int j = 0; j < 16; ++j) { const unsigned e_ = (unsigned)bperm(8 * (j & 7) + g, j < 8 ? i0 : i1); W_[j] = *(const u32x4*)(tab + (e_ * 128u + slb)); } \
            _Pragma("unroll") for (int m_ = 0; m_ < 4; ++m_) F_[m_] = bperm(8 * m_ + g, fq); } while (0)
#define PU_T4(ACC_, R0, R1, R2, R3, FQ_) do { const unsigned t0_ = __builtin_amdgcn_perm(R1, R0, 0x05010400u), t1_ = __builtin_amdgcn_perm(R1, R0, 0x07030602u), t2_ = __builtin_amdgcn_perm(R3, R2, 0x05010400u), t3_ = __builtin_amdgcn_perm(R3, R2, 0x07030602u); \
            ACC_[0] = __builtin_amdgcn_sdot4((int)__builtin_amdgcn_perm(t2_, t0_, 0x05040100u), FQ_, ACC_[0], false); ACC_[1] = __builtin_amdgcn_sdot4((int)__builtin_amdgcn_perm(t2_, t0_, 0x07060302u), FQ_, ACC_[1], false); \
            ACC_[2] = __builtin_amdgcn_sdot4((int)__builtin_amdgcn_perm(t3_, t1_, 0x05040100u), FQ_, ACC_[2], false); ACC_[3] = __builtin_amdgcn_sdot4((int)__builtin_amdgcn_perm(t3_, t1_, 0x07060302u), FQ_, ACC_[3], false); } while (0)
#define PU_COMP(W_, F_, o0, o1, tok) do { int acc[16] = {}; \
            _Pragma("unroll") for (int m_ = 0; m_ < 4; ++m_) { int* a_ = acc; PU_T4(a_, W_[4 * m_].x, W_[4 * m_ + 1].x, W_[4 * m_ + 2].x, W_[4 * m_ + 3].x, F_[m_]); a_ = acc + 4; PU_T4(a_, W_[4 * m_].y, W_[4 * m_ + 1].y, W_[4 * m_ + 2].y, W_[4 * m_ + 3].y, F_[m_]); \
                a_ = acc + 8; PU_T4(a_, W_[4 * m_].z, W_[4 * m_ + 1].z, W_[4 * m_ + 2].z, W_[4 * m_ + 3].z, F_[m_]); a_ = acc + 12; PU_T4(a_, W_[4 * m_].w, W_[4 * m_ + 1].w, W_[4 * m_ + 2].w, W_[4 * m_ + 3].w, F_[m_]); } \
            int a1[8], a2[4], a3[2]; \
            _Pragma("unroll") for (int i = 0; i < 8; ++i) { const int keep = (g & 1) ? acc[2 * i + 1] : acc[2 * i], give = (g & 1) ? acc[2 * i] : acc[2 * i + 1]; a1[i] = keep + dppmovi<0x128>(give); } \
            _Pragma("unroll") for (int i = 0; i < 4; ++i) { const int keep = (g & 2) ? a1[2 * i + 1] : a1[2 * i], give = (g & 2) ? a1[2 * i] : a1[2 * i + 1]; a2[i] = keep + __shfl_xor(give, 16); } \
            _Pragma("unroll") for (int i = 0; i < 2; ++i) { const int keep = (g & 4) ? a2[2 * i + 1] : a2[2 * i], give = (g & 4) ? a2[2 * i] : a2[2 * i + 1]; a3[i] = keep + __shfl_xor(give, 32); } \
            const float sf_ = F.csum[tok]; float* dp_ = (dry ? (float*)(F.wsb + WS_PART) + ((tok) & 16383) * DM : F.out + (tok) * DM) + col0 + g; \
            dp_[0] = o0 + sf_ * (float)a3[0]; dp_[8] = o1 + sf_ * (float)a3[1]; } while (0)
        PU_IDX(iA0, iA1, fqA, oA0, oA1, tok0); PU_IDX(iB0, iB1, fqB, oB0, oB1, tok0 + 1);
        PU_ROWS(wA, fA, iA0, iA1, fqA);
        for (int tt = 0; tt < PS_TG; tt += 2) { const size_t tok = tok0 + tt;
            PU_ROWS(wB, fB, iB0, iB1, fqB);
            const float pA0 = oA0, pA1 = oA1;
            const bool more = tt + 2 < PS_TG; const size_t t2 = tok + (more ? 2 : 0), t3 = tok + (more ? 3 : 1);
            PU_IDX(iA0, iA1, fqA, oA0, oA1, t2);
            PU_COMP(wA, fA, pA0, pA1, tok);
            if (more) PU_ROWS(wA, fA, iA0, iA1, fqA);
            const float pB0 = oB0, pB1 = oB1;
            PU_IDX(iB0, iB1, fqB, oB0, oB1, t3);
            PU_COMP(wB, fB, pB0, pB1, tok + 1);
        }
#undef PU_IDX
#undef PU_ROWS
#undef PU_T4
#undef PU_COMP
    }
}

#define XB_TMO      128
#define XB_XCNT(j)  (256  + 64 * (j))
#define XB_XSUB(j)  (1280 + 64 * (j))
#define XB_XGEN(j)  (2304 + 64 * (j))
#define XB_TOP      3328
#define XB_TOPGEN   3392
#define XCD_BAR_WORDS 3456
#define XB_SPIN_CAP (1u << 18)

__device__ __forceinline__ unsigned xb_ld(unsigned* p)              { return __hip_atomic_load(p, __ATOMIC_RELAXED, __HIP_MEMORY_SCOPE_AGENT); }
__device__ __forceinline__ unsigned xb_add(unsigned* p, unsigned v) { return __hip_atomic_fetch_add(p, v, __ATOMIC_RELAXED, __HIP_MEMORY_SCOPE_AGENT); }
__device__ __forceinline__ unsigned xb_xcc_id() { return (unsigned)__builtin_amdgcn_s_getreg((3 << 11) | 20) & 0xFu; }
#define XB_SPIN(cond, bar) do { unsigned _sp = 0; while (cond) { __builtin_amdgcn_s_sleep(1); \
    if ((++_sp & 255u) == 0u) { if (xb_ld(&(bar)[XB_TMO])) break; if (_sp > XB_SPIN_CAP) { atomicAdd(&(bar)[XB_TMO], 1u); break; } } } } while (0)

struct XcdBarrier {
    unsigned* bar; unsigned x;
    volatile LAS unsigned* st;
};

__device__ __forceinline__ XcdBarrier xcd_barrier_post(unsigned* bar, volatile LAS unsigned* st) {
    XcdBarrier b; b.bar = bar; b.x = xb_xcc_id(); b.st = st;
    if (threadIdx.x == 0) (void)xb_add(&bar[XB_XCNT(b.x)], 1u);
    return b;
}
__device__ __forceinline__ void xcd_barrier_complete(unsigned* bar, unsigned x, unsigned& nloc, unsigned& nx) {
    const unsigned G = gridDim.x * gridDim.y * gridDim.z;
    unsigned sum, cnt, mine, sp = 0u;
    for (;;) {
        sum = 0u; cnt = 0u; mine = 0u;
#pragma unroll
        for (unsigned j = 0; j < 16; ++j) { const unsigned c = xb_ld(&bar[XB_XCNT(j)]); sum += c; cnt += (c > 0u) ? 1u : 0u; mine = (j == x) ? c : mine; }
        if (sum == G) break;
        __builtin_amdgcn_s_sleep(1);
        if ((++sp & 255u) == 0u) { if (xb_ld(&bar[XB_TMO])) break; if (sp > XB_SPIN_CAP) { atomicAdd(&bar[XB_TMO], 1u); break; } }
    }
    nloc = mine > 0u ? mine : 1u; nx = cnt > 0u ? cnt : 1u;
}

__device__ __forceinline__ void xcd_barrier(const XcdBarrier& b) {
    asm volatile("s_waitcnt vmcnt(0)" ::: "memory");
    __syncthreads();
    if (threadIdx.x == 0) {
        unsigned* bar = b.bar;
        __builtin_amdgcn_s_waitcnt(0);
        unsigned nloc = b.st[0], nx = b.st[1];
        if (nloc == 0u) { xcd_barrier_complete(bar, b.x, nloc, nx); b.st[0] = nloc; b.st[1] = nx; }
        const unsigned old = xb_add(&bar[XB_XSUB(b.x)], 1u);
        const unsigned gen = old / nloc;
        if (old + 1u == (gen + 1u) * nloc) {
            __builtin_amdgcn_fence(__ATOMIC_RELEASE, "agent");
            asm volatile("s_waitcnt vmcnt(0)" ::: "memory");
            const unsigned og = xb_add(&bar[XB_TOP], 1u);
            const unsigned tg = og / nx;
            if (og + 1u == (tg + 1u) * nx) xb_add(&bar[XB_TOPGEN], 1u);
            else XB_SPIN(xb_ld(&bar[XB_TOPGEN]) == tg, bar);
            __builtin_amdgcn_fence(__ATOMIC_ACQUIRE, "agent");
            xb_add(&bar[XB_XGEN(b.x)], 1u);
            asm volatile("s_waitcnt vmcnt(0)" ::: "memory");
        } else {
            XB_SPIN(xb_ld(&bar[XB_XGEN(b.x)]) == gen, bar);
            __builtin_amdgcn_fence(__ATOMIC_ACQUIRE, "agent");
            asm volatile("s_waitcnt vmcnt(0)" ::: "memory");
        }
    }
    __syncthreads();
}

struct Args { const float* in[16]; float* out; unsigned char* ws; int ph_lo, ph_hi, coop, pad; };
__global__ void __launch_bounds__(512, 2) fwd_kernel(Args args) {
    extern __shared__ __attribute__((aligned(16))) unsigned char lds_raw[];
    Frame F;
    F.lds = (LAS unsigned char*)lds_raw; F.ldsg = (char*)lds_raw;
    F.tid = threadIdx.x; F.lane = F.tid & 63; F.wave = __builtin_amdgcn_readfirstlane(F.tid >> 6);
    F.G = gridDim.x; { const int bx = blockIdx.x; F.vcu = (F.G % 8 == 0) ? (bx % 8) * (F.G / 8) + bx / 8 : bx; }
    F.x = args.in[0]; F.norm1_g = args.in[1]; F.w_in = args.in[2]; F.up_f = args.in[3]; F.bias_f = args.in[4]; F.up_b = args.in[5]; F.bias_b = args.in[6]; F.out_g = args.in[7];
    F.qn_g = args.in[8]; F.kn_g = args.in[9]; F.w_out = args.in[10]; F.norm2_g = args.in[11]; F.w_query = args.in[12]; F.sub_keys = args.in[13]; F.peer_down = args.in[14]; F.peer_up = args.in[15];
    F.out = args.out; unsigned char* ws = args.ws; F.wsb = ws;
    F.rope = (f32x2*)(ws + WS_ROPE); F.rs1 = (float*)(ws + WS_RS1); F.rs2 = (float*)(ws + WS_RS2); F.ssp = (float*)(ws + WS_SSP); F.dec = (float*)(ws + WS_DEC); F.lp = (float*)(ws + WS_LP);
    F.gate = (float*)(ws + WS_GATE); F.part = (int*)(ws + WS_PART); F.sd = (float*)(ws + WS_CTL + 65536); F.su = (float*)(ws + WS_CTL + 131072); F.sx = (float*)(ws + WS_RS2 + 131072); F.csum = (float*)(ws + WS_RS2 + 262144);
    F.down8 = ws + WS_DOWN; F.up8 = ws + WS_UP; F.xq8 = ws + WS_XB; F.fq8 = ws + WS_XB + 64 * MiB; F.idx = (int*)(ws + WS_IDX); F.state = (float*)((unsigned char*)args.out + OUT_ST);
    F.WinT = (bf16_t*)(ws + WS_WIN); F.WoT = (bf16_t*)(ws + WS_WO); F.WqT = (bf16_t*)(ws + WS_WQ); F.SK = (bf16_t*)(ws + WS_SK); F.down16 = (bf16_t*)(ws + WS_DOWN); F.up16 = (bf16_t*)(ws + WS_UP);
    F.xb = (bf16_t*)(ws + WS_XB); F.mixed = (bf16_t*)(ws + WS_XB); F.h = (bf16_t*)(ws + WS_H); F.x1b = (bf16_t*)(ws + WS_X1B); F.qry = (bf16_t*)(ws + WS_QRY);
    F.op0 = (bf16_t*)((unsigned char*)args.out + OUT_OP0); F.op1 = (bf16_t*)(ws + WS_OP1); F.op2 = (bf16_t*)(ws + WS_OP2);
    constexpr int MISC_OFF = 131072 + 320;
    for (int u = F.tid; u < 64; u += 512) ((LAS unsigned*)(F.lds + MISC_OFF))[u] = 0u;
    __syncthreads();
    XcdBarrier bar = xcd_barrier_post((unsigned*)(ws + WS_CTL) + 8192, (volatile LAS unsigned*)(F.lds + MISC_OFF) + 8);
    const int lo = args.ph_lo, hi = args.ph_hi;
#ifndef PH_MASK
#define PH_MASK 0x7ff
#endif
#ifndef PROBE_PHASE
#define PROBE_PHASE -1
#endif
#define REP(k) for (int rep_ = 0; rep_ < ((PROBE_PHASE == (k)) ? 2 : 1); ++rep_)
#define IN(k) (((PH_MASK >> (k)) & 1) && lo <= (k) && (k) < hi)
#define SEAM(k) do { if (IN(k) && IN((k) + 1)) { if (args.coop) { if ((k) == 0) cg::this_grid().sync(); else xcd_barrier(bar); } } } while (0)
    if (IN(0)) { REP(0) phase0(F); } SEAM(0);
#define GEMM1_BODY { pg8::Gemm g{F.xb, F.WinT, T, HP, DM}; pg8::StaticOrder S; S.init(T, HP, F.G, (int)blockIdx.x); pg8::EpiRowScaleBf16 E{F.h, HP, F.rs1}; \
        pg8::gemm_phase<pg8::EpiRowScaleBf16, pg8::StaticOrder, PG8_ALIGN, PG8_SP2>(F.lds, g, S, E); }
    if (IN(1)) { GEMM1_BODY; if (PROBE_PHASE == 1) GEMM1_BODY; } SEAM(1);
    if (IN(2)) { qknorm_rope(F); REP(2) for (int it = F.vcu; it < 2048; it += F.G) gla_passA(F, it); } SEAM(2);
    if (IN(3)) { for (int it = F.vcu; it < 256; it += F.G) gla_scan(F, it); REP(3) attn_phase(F); } SEAM(3);
    if (IN(4)) REP(4) { for (int it = F.vcu; it < 2048; it += F.G) gla_passC(F, it); dil_combine(F); } SEAM(4);
#define GEMM5_BODY { pg8::Gemm g{F.mixed, F.WoT, T, DM, DM}; pg8::StaticOrder S; S.init(T, DM, F.G, (int)blockIdx.x); pg8::EpiResid E{F.x, F.out, F.x1b, F.ssp, DM}; \
        pg8::gemm_phase<pg8::EpiResid, pg8::StaticOrder, PG8_ALIGN, PG8_SP2>(F.lds, g, S, E); }
#define GEMM6_BODY { pg8::Gemm g{F.x1b, F.WqT, T, DM, DM}; pg8::StaticOrder S; S.init(T, DM, F.G, (int)blockIdx.x); pg8::EpiRowScaleBf16 E{F.qry, DM, nullptr}; \
        pg8::gemm_phase<pg8::EpiRowScaleBf16, pg8::StaticOrder, PG8_ALIGN, PG8_SP2>(F.lds, g, S, E); }
    if (IN(5)) { GEMM5_BODY; if (PROBE_PHASE == 5) GEMM5_BODY; } SEAM(5);
    if (IN(6)) { GEMM6_BODY; if (PROBE_PHASE == 6) GEMM6_BODY; } SEAM(6);
    if (IN(7)) REP(7) { const int gw = F.vcu * 8 + F.wave, NGW = F.G * 8; for (int it = gw; it < (T / 32) * 8; it += NGW) topk_item(F, it); if (rep_ == 0) peer_quant_x(F); } SEAM(7);
    if (IN(8)) { if (PROBE_PHASE == 8) peer_down(F, 3072); peer_down(F); } SEAM(8);
    if (IN(9)) { REP(9) peer_coef_probe(F, (PROBE_PHASE == 9) && rep_ == 0); } SEAM(9);
    if (IN(10)) { if (PROBE_PHASE == 10) peer_up(F, 3584, true); peer_up(F); }
#undef IN
#undef SEAM
}

#ifndef MK_N_LAUNCHES
#define MK_N_LAUNCHES 1
#endif
extern "C" void kernel_launch(void* const* d_in, const int* in_sizes, int n_in, void* d_out, int out_size, void* d_ws, size_t ws_size, hipStream_t stream) {
    static int grid = 0;
    if (grid == 0) {
        if (n_in != 16 || in_sizes[0] != T * DM || out_size != T * DM || ws_size < WS_END) { fprintf(stderr, "kernel_launch: unexpected shapes (n_in %d, in0 %d, out %d, ws %zu)\n", n_in, n_in > 0 ? in_sizes[0] : -1, out_size, ws_size); grid = -1; return; }
        int dev = 0, cus = 0, per_cu = 0;
        if (hipGetDevice(&dev) != hipSuccess || hipDeviceGetAttribute(&cus, hipDeviceAttributeMultiprocessorCount, dev) != hipSuccess) { grid = -1; return; }
        if (hipFuncSetAttribute((const void*)fwd_kernel, hipFuncAttributeMaxDynamicSharedMemorySize, LDS_BYTES) != hipSuccess) { fprintf(stderr, "kernel_launch: hipFuncSetAttribute failed\n"); grid = -1; return; }
        if (hipOccupancyMaxActiveBlocksPerMultiprocessor(&per_cu, (const void*)fwd_kernel, 512, LDS_BYTES) != hipSuccess || per_cu < 1) { fprintf(stderr, "kernel_launch: occupancy query says %d\n", per_cu); per_cu = 1; }
        (void)hipGetLastError();
        grid = cus;
    }
    if (grid < 0) return;
    if (hipMemsetAsync(d_ws, 0, 65536, stream) != hipSuccess) { fprintf(stderr, "kernel_launch: hipMemsetAsync failed\n"); return; }
    Args a{};
    for (int i = 0; i < 16; ++i) a.in[i] = (const float*)d_in[i];
    a.out = (float*)d_out; a.ws = (unsigned char*)d_ws;
    if (MK_N_LAUNCHES == 1) {
        a.ph_lo = 0; a.ph_hi = NPHASE; a.coop = 1; void* kargs[] = {&a};
        hipError_t e = hipLaunchCooperativeKernel((const void*)fwd_kernel, dim3(grid), dim3(512), kargs, LDS_BYTES, stream);
        if (e != hipSuccess) fprintf(stderr, "kernel_launch: cooperative launch failed: %s (grid %d)\n", hipGetErrorString(e), grid);
    } else {
        for (int p = 0; p < NPHASE; ++p) { a.ph_lo = p; a.ph_hi = p + 1; a.coop = 0; hipLaunchKernelGGL(fwd_kernel, dim3(grid), dim3(512), LDS_BYTES, stream, a); }
        const hipError_t le = hipPeekAtLastError(); if (le != hipSuccess) fprintf(stderr, "kernel_launch: launch failed: %s\n", hipGetErrorName(le));
    }
}
```

```cpp
#include <hip/hip_runtime.h>
#include <hip/hip_cooperative_groups.h>
#include <cstdio>
#include <cstdint>
namespace cg = cooperative_groups;
namespace pg8 {
#define PG8_LAS __attribute__((address_space(3)))
typedef unsigned short bf16_t;
typedef short bf16x8 __attribute__((ext_vector_type(8)));
typedef float f32x4 __attribute__((ext_vector_type(4)));
typedef unsigned u32x4 __attribute__((ext_vector_type(4)));
constexpr int BM = 256, BK = 64, HALF = 128, HTB = HALF * BK * 2  , STAGE_BYTES = 8 * HTB, NXCD = 8, WGM = 8;

__host__ __device__ __forceinline__ int lds_byte(int r, int c) { const int st = (r >> 4) * 2 + (c >> 5), rr = r & 15, cc = c & 31, ob = rr * 64 + cc * 2; return st * 1024 + (ob ^ (((ob >> 9) & 1) << 5)); }
__host__ __device__ __forceinline__ void stage_rc(int b, int& R, int& C) { const int st = b / 1024, sb = b % 1024, swz = sb ^ (((sb >> 9) & 1) << 5); R = (st >> 1) * 16 + swz / 64; C = (st & 1) * 32 + (swz % 64) / 2; }
__host__ __device__ __forceinline__ int perm32(int rho) { const int n = rho >> 4, i = rho & 15; return 8 * (i >> 2) + 4 * n + (i & 3); }

struct Unit { int pm, pn; };
struct Gemm { const bf16_t* A; const bf16_t* Bt; int M, N, K; };

struct StaticOrder {
    int nM, nN, nwg, G, c;
    __host__ __device__ void init(int M, int N, int G_, int c_) { nM = M / BM; nN = N / BM; nwg = nM * nN; G = G_; c = c_; }
    __host__ __device__ bool next(int i, Unit& u) const {
        const long L = (long)i * G + c; if (L >= nwg) return false;
        int wgid = (int)L; { const int q = nwg / NXCD, r = nwg % NXCD, xcd = wgid % NXCD, off = wgid / NXCD; wgid = (xcd < r ? xcd * (q + 1) : r * (q + 1) + (xcd - r) * q) + off; }
        const int nig = WGM * nN, gid = wgid / nig, fm = gid * WGM, gsz = (nM - fm) < WGM ? (nM - fm) : WGM;
        u.pm = fm + ((wgid % nig) % gsz); u.pn = (wgid % nig) / gsz; return true;
    }
    __device__ __forceinline__ void a_ready(const Unit&) const {}
    __device__ __forceinline__ void done(const Unit&) const {}
};
__device__ __forceinline__ unsigned cvt_pk_bf16(float lo, float hi) { unsigned r; asm volatile("v_cvt_pk_bf16_f32 %0, %1, %2" : "=v"(r) : "v"(lo), "v"(hi)); return r; }
typedef int i32x4 __attribute__((ext_vector_type(4)));
template <bool I8> struct AccT { typedef f32x4 type; };
template <> struct AccT<true> { typedef i32x4 type; };
struct EpiRowScaleBf16 {
    static constexpr bool PERM = true, AFTER_DRAIN = false;
    bf16_t* O; int ldc; const float* rs;
    __device__ __forceinline__ void operator()(const f32x4 (&acc)[2][2][4][2], const Unit& u, int wr, int wc, int fr, int fq) const {
        const int row0 = u.pm * BM + wr * 64 + fr, col0 = u.pn * BM + wc * 32 + 8 * fq;
#pragma unroll
        for (int ai = 0; ai < 2; ++ai)
#pragma unroll
            for (int m = 0; m < 4; ++m) { const int row = row0 + ai * HALF + m * 16; const float s = rs ? rs[row] : 1.f; bf16_t* rowp = O + (size_t)row * ldc + col0;
#pragma unroll
                for (int bj = 0; bj < 2; ++bj) { const f32x4 v0 = acc[ai][bj][m][0] * s, v1 = acc[ai][bj][m][1] * s;
                    u32x4 w; w.x = cvt_pk_bf16(v0[0], v0[1]); w.y = cvt_pk_bf16(v0[2], v0[3]); w.z = cvt_pk_bf16(v1[0], v1[1]); w.w = cvt_pk_bf16(v1[2], v1[3]);
                    *(u32x4*)(rowp + bj * HALF) = w; } }
    }
};
struct EpiI8Bf16 {
    static constexpr bool PERM = true, AFTER_DRAIN = false;
    bf16_t* O; int ldc; const float* rs; const float* cs;
    __device__ __forceinline__ void operator()(const i32x4 (&acc)[2][2][4][2], const Unit& u, int wr, int wc, int fr, int fq) const {
        const int row0 = u.pm * BM + wr * 64 + fr, col0 = u.pn * BM + wc * 32 + 8 * fq;
        f32x4 cv[2][2];
#pragma unroll
        for (int bj = 0; bj < 2; ++bj) { cv[bj][0] = *(const f32x4*)(cs + col0 + bj * HALF); cv[bj][1] = *(const f32x4*)(cs + col0 + bj * HALF + 4); }
#pragma unroll
        for (int ai = 0; ai < 2; ++ai)
#pragma unroll
            for (int m = 0; m < 4; ++m) { const int row = row0 + ai * HALF + m * 16; const float s = rs[row]; bf16_t* rowp = O + (size_t)row * ldc + col0;
#pragma unroll
                for (int bj = 0; bj < 2; ++bj) { const i32x4 a0 = acc[ai][bj][m][0], a1 = acc[ai][bj][m][1]; const f32x4 c0 = cv[bj][0] * s, c1 = cv[bj][1] * s;
                    u32x4 w; w.x = cvt_pk_bf16((float)a0[0] * c0[0], (float)a0[1] * c0[1]); w.y = cvt_pk_bf16((float)a0[2] * c0[2], (float)a0[3] * c0[3]);
                    w.z = cvt_pk_bf16((float)a1[0] * c1[0], (float)a1[1] * c1[1]); w.w = cvt_pk_bf16((float)a1[2] * c1[2], (float)a1[3] * c1[3]);
                    *(u32x4*)(rowp + bj * HALF) = w; } }
    }
};
struct EpiResid {
    static constexpr bool PERM = true, AFTER_DRAIN = false;
    const float* x; float* out; bf16_t* xb; float* ssp; int ldc;
    __device__ __forceinline__ void operator()(const f32x4 (&acc)[2][2][4][2], const Unit& u, int wr, int wc, int fr, int fq) const {
        const int row0 = u.pm * BM + wr * 64 + fr, col0 = u.pn * BM + wc * 32 + 8 * fq;
#pragma unroll
        for (int ai = 0; ai < 2; ++ai)
#pragma unroll
            for (int m = 0; m < 4; ++m) { const int row = row0 + ai * HALF + m * 16; const size_t off = (size_t)row * ldc + col0; float ss = 0.f;
#pragma unroll
                for (int bj = 0; bj < 2; ++bj) { const f32x4 xa = *(const f32x4*)(x + off + bj * HALF), xc = *(const f32x4*)(x + off + bj * HALF + 4);
                    const f32x4 v0 = acc[ai][bj][m][0] + xa, v1 = acc[ai][bj][m][1] + xc;
                    *(f32x4*)(out + off + bj * HALF) = v0; *(f32x4*)(out + off + bj * HALF + 4) = v1;
                    u32x4 w; w.x = cvt_pk_bf16(v0[0], v0[1]); w.y = cvt_pk_bf16(v0[2], v0[3]); w.z = cvt_pk_bf16(v1[0], v1[1]); w.w = cvt_pk_bf16(v1[2], v1[3]);
                    *(u32x4*)(xb + off + bj * HALF) = w;
                    ss += (v0[0] * v0[0] + v0[1] * v0[1]) + (v0[2] * v0[2] + v0[3] * v0[3]) + (v1[0] * v1[0] + v1[1] * v1[1]) + (v1[2] * v1[2] + v1[3] * v1[3]); }
                ss += __shfl_xor(ss, 16); ss += __shfl_xor(ss, 32);
                if (fq == 0) ssp[(size_t)row * 32 + u.pn * 4 + wc] = ss; }
    }
};
template <class Epi, class Sched, bool ALIGN_EPI = false, bool SP2 = false, bool I8 = false>
__device__ __forceinline__ void gemm_phase(PG8_LAS unsigned char* lds, const Gemm g, const Sched& S, const Epi& E) {
    const int tid = threadIdx.x, wid = __builtin_amdgcn_readfirstlane(tid >> 6), lane = tid & 63, wr = wid >> 2, wc = wid & 3, fr = lane & 15, fq = lane >> 4;
    const int K = g.K, nt = K / BK;
    unsigned voffA[2], voffB[2];
#pragma unroll
    for (int i = 0; i < 2; ++i) { int R, C; stage_rc(tid * 16 + i * 8192, R, C); const int Rb = Epi::PERM ? ((R & ~31) + perm32(R & 31)) : R;
        voffA[i] = (unsigned)(R * K + C) * 2u; voffB[i] = (unsigned)(Rb * K + C) * 2u; }
    const size_t kstep = (size_t)(BK * 2);
    const size_t hstep = (size_t)HALF * K * 2;
    const size_t tstep = 2 * hstep;
    const unsigned ldsw = (unsigned)wid * 1024u;
    const int aoff = lds_byte(wr * 64 + fr, fq * 8), boff = lds_byte(wc * 32 + fr, fq * 8);
#define PG8_SA(b, h) (((b) * 2 + (h)) * HTB)
#define PG8_SB(b, h) ((4 + (b) * 2 + (h)) * HTB)
#define PG8_STAGE(bufoff, gbase, voff) do { _Pragma("unroll") for (int _i = 0; _i < 2; ++_i) \
        __builtin_amdgcn_global_load_lds((const unsigned*)((const char*)(gbase) + (voff)[_i]), (PG8_LAS unsigned*)(lds + (bufoff) + ldsw + _i * 8192), 16, 0, 0); } while (0)
#define PG8_LDA(dst, b, h) do { _Pragma("unroll") for (int m = 0; m < 4; ++m) _Pragma("unroll") for (int k = 0; k < 2; ++k) dst[m][k] = *(const PG8_LAS bf16x8*)(lds + PG8_SA(b, h) + aoff + m * 2048 + k * 1024); } while (0)
#define PG8_LDB(dst, b, h) do { _Pragma("unroll") for (int n = 0; n < 2; ++n) _Pragma("unroll") for (int k = 0; k < 2; ++k) dst[n][k] = *(const PG8_LAS bf16x8*)(lds + PG8_SB(b, h) + boff + n * 2048 + k * 1024); } while (0)
#define PG8_MMA(ai, bj, At, Bt) do { __builtin_amdgcn_s_setprio(1); _Pragma("unroll") for (int m = 0; m < 4; ++m) _Pragma("unroll") for (int n = 0; n < 2; ++n) _Pragma("unroll") for (int k = 0; k < 2; ++k) { \
        if constexpr (I8) acc[ai][bj][m][n] = __builtin_amdgcn_mfma_i32_16x16x64_i8(__builtin_bit_cast(i32x4, Bt[n][k]), __builtin_bit_cast(i32x4, At[m][k]), acc[ai][bj][m][n], 0, 0, 0); \
        else acc[ai][bj][m][n] = __builtin_amdgcn_mfma_f32_16x16x32_bf16(Bt[n][k], At[m][k], acc[ai][bj][m][n], 0, 0, 0); } __builtin_amdgcn_s_setprio(0); } while (0)
#define PG8_WAIT_V(n) asm volatile("s_waitcnt vmcnt(" #n ")" ::: "memory")
#define PG8_WAIT_L(n) asm volatile("s_waitcnt lgkmcnt(" #n ")" ::: "memory")
#define PG8_BAR __builtin_amdgcn_s_barrier()
#define PG8_SCHED __builtin_amdgcn_sched_barrier(0)
    Unit cur, nxt; int ui = 0;
    if (!S.next(0, cur)) return;
    typename AccT<I8>::type acc[2][2][4][2];
#pragma unroll
    for (int a = 0; a < 2; ++a)
#pragma unroll
        for (int b = 0; b < 2; ++b)
#pragma unroll
            for (int m = 0; m < 4; ++m)
#pragma unroll
                for (int n = 0; n < 2; ++n) acc[a][b][m][n] = (typename AccT<I8>::type){};
    bf16x8 At[4][2], B0[2][2], B1[2][2];
    const char* cA = (const char*)g.A + (size_t)cur.pm * tstep; const char* cB = (const char*)g.Bt + (size_t)cur.pn * tstep;
    S.a_ready(cur);
    if constexpr (SP2) {
        PG8_STAGE(PG8_SB(0, 0), cB, voffB); PG8_STAGE(PG8_SB(0, 1), cB + hstep, voffB); PG8_STAGE(PG8_SA(0, 0), cA, voffA); PG8_STAGE(PG8_SA(0, 1), cA + hstep, voffA);
        if (wr == 1) PG8_BAR;
        PG8_WAIT_V(2); PG8_BAR;
        PG8_STAGE(PG8_SB(1, 0), cB + kstep, voffB); PG8_STAGE(PG8_SA(1, 0), cA + kstep, voffA); PG8_STAGE(PG8_SB(1, 1), cB + hstep + kstep, voffB);
        PG8_WAIT_V(6); PG8_BAR;
    } else {
        PG8_STAGE(PG8_SB(0, 0), cB, voffB); PG8_STAGE(PG8_SA(0, 0), cA, voffA); PG8_STAGE(PG8_SB(0, 1), cB + hstep, voffB); PG8_STAGE(PG8_SA(0, 1), cA + hstep, voffA);
        if (wr == 1) PG8_BAR;
        PG8_WAIT_V(4); PG8_BAR;
        PG8_STAGE(PG8_SB(1, 0), cB + kstep, voffB); PG8_STAGE(PG8_SA(1, 0), cA + kstep, voffA); PG8_STAGE(PG8_SB(1, 1), cB + hstep + kstep, voffB);
        PG8_WAIT_V(6); PG8_BAR;
    }
    for (;;) {
        const bool has_next = S.next(ui + 1, nxt);
        const char* nA = has_next ? (const char*)g.A + (size_t)nxt.pm * tstep : cA; const char* nB = has_next ? (const char*)g.Bt + (size_t)nxt.pn * tstep : cB;
        for (int t = 0; t < nt; t += 2) {
            const bool last = (t == nt - 2);
            const char* a1 = cA + (size_t)(t + 1) * kstep;
            const char* a2 = last ? nA : cA + (size_t)(t + 2) * kstep; const char* b2 = last ? nB : cB + (size_t)(t + 2) * kstep;
            const char* a3 = a2 + kstep; const char* b3 = b2 + kstep;
            if (last && has_next) S.a_ready(nxt);
            if constexpr (SP2) {
            PG8_LDB(B0, 0, 0); PG8_LDB(B1, 0, 1); PG8_SCHED; PG8_LDA(At, 0, 0); PG8_STAGE(PG8_SA(1, 1), a1 + hstep, voffA);
            PG8_WAIT_V(8); PG8_WAIT_L(0); PG8_BAR; PG8_MMA(0, 0, At, B0); PG8_MMA(0, 1, At, B1); PG8_BAR; PG8_SCHED;
            PG8_LDA(At, 0, 1); PG8_STAGE(PG8_SB(0, 0), b2, voffB); PG8_STAGE(PG8_SB(0, 1), b2 + hstep, voffB); PG8_STAGE(PG8_SA(0, 0), a2, voffA);
            PG8_WAIT_V(8); PG8_WAIT_L(0); PG8_BAR; PG8_MMA(1, 0, At, B0); PG8_MMA(1, 1, At, B1); PG8_BAR; PG8_SCHED;
            PG8_LDB(B0, 1, 0); PG8_LDB(B1, 1, 1); PG8_SCHED; PG8_LDA(At, 1, 0); PG8_STAGE(PG8_SA(0, 1), a2 + hstep, voffA);
            PG8_WAIT_V(8); PG8_WAIT_L(0); PG8_BAR; PG8_MMA(0, 0, At, B0); PG8_MMA(0, 1, At, B1); PG8_BAR; PG8_SCHED;
            PG8_LDA(At, 1, 1); PG8_STAGE(PG8_SB(1, 0), b3, voffB); PG8_STAGE(PG8_SB(1, 1), b3 + hstep, voffB); PG8_STAGE(PG8_SA(1, 0), a3, voffA);
            PG8_WAIT_V(8); PG8_WAIT_L(0); PG8_BAR; PG8_MMA(1, 0, At, B0); PG8_MMA(1, 1, At, B1); PG8_BAR; PG8_SCHED;
            } else {
            PG8_LDB(B0, 0, 0); PG8_SCHED; PG8_LDA(At, 0, 0); PG8_STAGE(PG8_SA(1, 1), a1 + hstep, voffA);
            PG8_WAIT_L(8); PG8_BAR; PG8_WAIT_L(0); PG8_MMA(0, 0, At, B0); PG8_BAR; PG8_SCHED;
            PG8_LDB(B1, 0, 1); PG8_STAGE(PG8_SB(0, 0), b2, voffB);
            PG8_BAR; PG8_WAIT_L(0); PG8_MMA(0, 1, At, B1); PG8_BAR;
            PG8_LDA(At, 0, 1); PG8_STAGE(PG8_SA(0, 0), a2, voffA);
            PG8_BAR; PG8_WAIT_L(0); PG8_MMA(1, 0, At, B0); PG8_BAR; PG8_SCHED;
            PG8_STAGE(PG8_SB(0, 1), b2 + hstep, voffB);
            PG8_WAIT_V(6); PG8_BAR; PG8_MMA(1, 1, At, B1); PG8_BAR;
            PG8_LDB(B0, 1, 0); PG8_SCHED; PG8_LDA(At, 1, 0); PG8_STAGE(PG8_SA(0, 1), a2 + hstep, voffA);
            PG8_WAIT_L(8); PG8_BAR; PG8_WAIT_L(0); PG8_MMA(0, 0, At, B0); PG8_BAR; PG8_SCHED;
            PG8_LDB(B1, 1, 1); PG8_STAGE(PG8_SB(1, 0), b3, voffB);
            PG8_BAR; PG8_WAIT_L(0); PG8_MMA(0, 1, At, B1); PG8_BAR;
            PG8_LDA(At, 1, 1); PG8_STAGE(PG8_SA(1, 0), a3, voffA);
            PG8_BAR; PG8_WAIT_L(0); PG8_MMA(1, 0, At, B0); PG8_BAR; PG8_SCHED;
            PG8_STAGE(PG8_SB(1, 1), b3 + hstep, voffB);
            PG8_WAIT_V(6); PG8_BAR; PG8_MMA(1, 1, At, B1); PG8_BAR;
            }
        }
        if constexpr (ALIGN_EPI) { if (wr == 0) PG8_BAR; }
        if constexpr (!Epi::AFTER_DRAIN) { E(acc, cur, wr, wc, fr, fq); S.done(cur); }
        if (!has_next) break;
#pragma unroll
        for (int a = 0; a < 2; ++a)
#pragma unroll
            for (int b = 0; b < 2; ++b)
#pragma unroll
                for (int m = 0; m < 4; ++m)
#pragma unroll
                    for (int n = 0; n < 2; ++n) acc[a][b][m][n] = (typename AccT<I8>::type){};
        cur = nxt; cA = nA; cB = nB; ++ui;
        if constexpr (ALIGN_EPI) { if (wr == 1) PG8_BAR; }
    }
    PG8_WAIT_V(0);
    if constexpr (!ALIGN_EPI) { if (wr == 0) PG8_BAR; }
    PG8_BAR;
    if constexpr (Epi::AFTER_DRAIN) { E.fused(acc, cur, wr, wc, fr, fq, lds, wid, lane); S.done(cur); }
#undef PG8_SA
#undef PG8_SB
#undef PG8_STAGE
#undef PG8_LDA
#undef PG8_LDB
#undef PG8_MMA
#undef PG8_WAIT_V
#undef PG8_WAIT_L
#undef PG8_BAR
#undef PG8_SCHED
}
}
#ifndef PG8_SP2
#define PG8_SP2 true
#endif
#ifndef PG8_ALIGN
#define PG8_ALIGN true
#endif

constexpr int BATCH = 2, SEQ = 16384, DM = 2048, T = BATCH * SEQ;
constexpr int INW = 6176, HP = 6400;
constexpr int C_QA = 0, C_KA = 256, C_VA = 512, C_RA = 1024, C_QD = 1536, C_KD = 3072, C_VD = 4608, C_GF = 6144;
constexpr int NHD = 12;
constexpr float EPS = 1e-6f;
constexpr float LOG2E = 1.4426950408889634f;
constexpr float QSCALE = 0.08838834764831845f * LOG2E;
constexpr int NPHASE = 11;

constexpr size_t MiB = 1u << 20;
constexpr size_t WS_CTL = 0, WS_ROPE = 1 * MiB, WS_RS1 = 3 * MiB, WS_RS2 = 3 * MiB + 512 * 1024, WS_SSP = 4 * MiB, WS_WIN = 8 * MiB, WS_WO = 33 * MiB, WS_WQ = 41 * MiB,
                 WS_SK = 49 * MiB, WS_DEC = 50 * MiB, WS_LP = 51 * MiB, WS_IDX = 56 * MiB, WS_GATE = 72 * MiB, WS_DOWN = 88 * MiB, WS_UP = 152 * MiB, WS_XB = 216 * MiB,
                 WS_H = 344 * MiB, WS_X1B = WS_H, WS_QRY = WS_H + 128 * MiB, WS_OP1 = 744 * MiB, WS_OP2 = 840 * MiB, WS_PART = 472 * MiB  , WS_END = 984 * MiB;
constexpr size_t OUT_ST = 0, OUT_OP0 = 128 * MiB;
constexpr int LDS_BYTES = 147456;

#define LAS __attribute__((address_space(3)))
typedef unsigned short bf16_t;
typedef short bf16x8 __attribute__((ext_vector_type(8)));
typedef short s16x4 __attribute__((ext_vector_type(4)));
typedef float f32x4 __attribute__((ext_vector_type(4)));
typedef float f32x2 __attribute__((ext_vector_type(2)));
typedef float f32x16 __attribute__((ext_vector_type(16)));
typedef unsigned u32x4 __attribute__((ext_vector_type(4)));
typedef unsigned u32x2 __attribute__((ext_vector_type(2)));
#define LDS_WAIT() asm volatile("s_waitcnt lgkmcnt(0)" ::: "memory")
#define SBAR() __builtin_amdgcn_sched_barrier(0)

__device__ __forceinline__ float bf2f(unsigned short b) { return __uint_as_float(((unsigned)b) << 16); }
__device__ __forceinline__ float bflo(unsigned w) { return __uint_as_float(w << 16); }
__device__ __forceinline__ float bfhi(unsigned w) { return __uint_as_float(w & 0xffff0000u); }
__device__ __forceinline__ unsigned f2bf(float f) { unsigned u = __float_as_uint(f); return (u + 0x7fffu + ((u >> 16) & 1u)) >> 16; }
__device__ __forceinline__ unsigned pk2(float lo, float hi) { return pg8::cvt_pk_bf16(lo, hi); }
__device__ __forceinline__ float fexp(float x) { return __builtin_amdgcn_exp2f(x * LOG2E); }
__device__ __forceinline__ float flog(float x) { return __builtin_amdgcn_logf(x) * 0.6931471805599453f; }
__device__ __forceinline__ float wave_sum(float v) {
#pragma unroll
    for (int o = 1; o < 64; o <<= 1) v += __shfl_xor(v, o);
    return v;
}
__device__ __forceinline__ int crow(int r, int hi) { return (r & 3) + 8 * (r >> 2) + 4 * hi; }

struct Frame {
    LAS unsigned char* lds; char* ldsg; unsigned char* wsb;
    int tid, lane, wave, vcu, G;
    const float *x, *norm1_g, *w_in, *up_f, *bias_f, *up_b, *bias_b, *out_g, *qn_g, *kn_g, *w_out, *norm2_g, *w_query, *sub_keys, *peer_down, *peer_up;
    float* out;
    f32x2* rope; float *rs1, *rs2, *ssp, *dec, *lp, *gate, *state, *sd, *su, *sx, *csum; int *idx, *part; unsigned char *down8, *up8, *xq8, *fq8;
    unsigned char *Win8, *xq1; float* sw; bf16_t *WinT, *WoT, *WqT, *SK, *down16, *up16, *xb, *mixed, *h, *x1b, *qry, *op0, *op1, *op2;
};

__device__ __forceinline__ void p0_transpose_item(const float* W, int K, int N, bf16_t* WT, int k0, int n0, int dst_row0, const float* g, LAS float* scr, int lane) {
#pragma unroll 8
    for (int i = 0; i < 32; ++i) { const int kk = 2 * i + (lane >> 5); float w = W[(size_t)(k0 + kk) * N + n0 + (lane & 31)]; if (g) w *= g[k0 + kk]; scr[kk * 33 + (lane & 31)] = w; }
    LDS_WAIT(); asm volatile("" ::: "memory");
    const int c = lane & 7;
#pragma unroll
    for (int j = 0; j < 4; ++j) { const int n = (lane >> 3) + 8 * j; const LAS float* s = scr + (8 * c) * 33 + n;
        u32x4 o; o.x = pk2(s[0 * 33], s[1 * 33]); o.y = pk2(s[2 * 33], s[3 * 33]); o.z = pk2(s[4 * 33], s[5 * 33]); o.w = pk2(s[6 * 33], s[7 * 33]);
        *(u32x4*)(WT + (size_t)(dst_row0 + n) * K + k0 + 8 * c) = o; }
    LDS_WAIT(); asm volatile("" ::: "memory");
}
__device__ __forceinline__ void phase0(const Frame& F) {
    LAS float* scr = (LAS float*)(F.lds + F.wave * 16384);
    const int gw = F.vcu * 8 + F.wave, NGW = F.G * 8, lane = F.lane;
    { LAS float* cmx = (LAS float*)(F.lds + 12288);
      for (int nb = F.vcu; nb < 193; nb += F.G) { const int n0 = nb * 32, drow = nb < 32 ? nb * 32 : (nb == 32 ? C_GF : nb * 32 - 32), kw = F.wave * 256;
        float m = 0.f;
#pragma unroll 8
        for (int i = 0; i < 128; ++i) { const int k = kw + 2 * i + (lane >> 5); m = fmaxf(m, fabsf(F.w_in[(size_t)k * INW + n0 + (lane & 31)] * F.norm1_g[k])); }
        m = fmaxf(m, __shfl_xor(m, 32)); if (lane < 32) cmx[F.wave * 32 + lane] = m;
        __syncthreads();
        if (F.tid < 32) { float mm = 0.f;
#pragma unroll
            for (int w = 0; w < 8; ++w) mm = fmaxf(mm, cmx[w * 32 + F.tid]);
            cmx[256 + F.tid] = mm > 0.f ? 127.f / mm : 0.f; F.sw[drow + F.tid] = mm * (1.f / 127.f); }
        __syncthreads();
        for (int ch = 0; ch < 4; ++ch) { const int k0 = kw + 64 * ch;
#pragma unroll 8
            for (int i = 0; i < 32; ++i) { const int kk = 2 * i + (lane >> 5); scr[kk * 33 + (lane & 31)] = F.w_in[(size_t)(k0 + kk) * INW + n0 + (lane & 31)] * F.norm1_g[k0 + kk] * cmx[256 + (lane & 31)]; }
            LDS_WAIT(); asm volatile("" ::: "memory");
            const int c = lane & 7;
#pragma unroll
            for (int j = 0; j < 4; ++j) { const int n = (lane >> 3) + 8 * j; const LAS float* sp = scr + (8 * c) * 33 + n; u32x2 w = {0u, 0u};
#pragma unroll
                for (int i = 0; i < 4; ++i) { w.x |= ((unsigned)(int)rintf(sp[i * 33]) & 0xffu) << (8 * i); w.y |= ((unsigned)(int)rintf(sp[(4 + i) * 33]) & 0xffu) << (8 * i); }
                *(u32x2*)(F.Win8 + (size_t)(drow + n) * DM + k0 + 8 * c) = w; }
            LDS_WAIT(); asm volatile("" ::: "memory"); }
        __syncthreads(); } }
    constexpr int I_O = 32 * 64, I_Q = 32 * 64;
    for (int it = gw; it < I_O + I_Q; it += NGW) {
        int r = it;
        if (r < I_O) { const int kb = r / 64, nb = r % 64; p0_transpose_item(F.w_out, DM, DM, F.WoT, kb * 64, nb * 32, nb * 32, nullptr, scr, lane); continue; }
        r -= I_O;
        { const int kb = r / 64, nb = r % 64; p0_transpose_item(F.w_query, DM, DM, F.WqT, kb * 64, nb * 32, nb * 32, F.norm2_g, scr, lane); }
    }
    const size_t gt = (size_t)gw * 64 + lane, NT = (size_t)NGW * 64;
    { u32x4* z = (u32x4*)(F.Win8 + (size_t)INW * DM); const u32x4 zero = {0u, 0u, 0u, 0u}; for (size_t i = gt; i < (size_t)(HP - INW) * DM / 16; i += NT) z[i] = zero; if (gt < (size_t)(HP - INW)) F.sw[INW + gt] = 0.f; }
    for (int r = gw; r < 2 * 16384; r += NGW) { const bool isup = r >= 16384; const int e = r & 16383; const f32x4* src = (const f32x4*)((isup ? F.peer_up : F.peer_down) + (size_t)e * DM) + lane;
        f32x4 v[8]; float m = 0.f;
#pragma unroll
        for (int j = 0; j < 8; ++j) { v[j] = src[64 * j]; if (!isup) v[j] = v[j] * ((const f32x4*)F.norm2_g)[lane + 64 * j];
            m = fmaxf(fmaxf(m, fmaxf(fabsf(v[j][0]), fabsf(v[j][1]))), fmaxf(fabsf(v[j][2]), fabsf(v[j][3]))); }
#pragma unroll
        for (int o = 1; o < 64; o <<= 1) m = fmaxf(m, __shfl_xor(m, o));
        const float inv = m > 0.f ? 127.f / m : 0.f; unsigned char* dst = isup ? F.up8 : F.down8; const int bias = 0;
#pragma unroll
        for (int j = 0; j < 8; ++j) { unsigned w = 0u;
#pragma unroll
            for (int i = 0; i < 4; ++i) { const int qv = (int)rintf(v[j][i] * inv) + bias; w |= ((unsigned)qv & 0xffu) << (8 * i); }
            const int col = 4 * lane + 256 * j; *(unsigned*)(dst + ((size_t)(col >> 7) * 16384 + e) * 128 + (col & 127)) = w; }
        if (lane == 0) (isup ? F.su : F.sd)[e] = m * (1.f / 127.f); }
    for (size_t i = gt; i < (size_t)8 * 2 * 128 * 128 / 8; i += NT) { const f32x4 a = *(const f32x4*)(F.sub_keys + i * 8), b = *(const f32x4*)(F.sub_keys + i * 8 + 4);
        u32x4 o; o.x = pk2(a[0], a[1]); o.y = pk2(a[2], a[3]); o.z = pk2(b[0], b[1]); o.w = pk2(b[2], b[3]); *(u32x4*)(F.SK + i * 8) = o; }
    for (int m = gw; m < T; m += NGW) { const f32x4* xr = (const f32x4*)(F.x + (size_t)m * DM) + lane; f32x4 v[8]; float s = 0.f, mx = 0.f;
#pragma unroll
        for (int j = 0; j < 8; ++j) { v[j] = xr[64 * j]; s += (v[j][0] * v[j][0] + v[j][1] * v[j][1]) + (v[j][2] * v[j][2] + v[j][3] * v[j][3]);
            mx = fmaxf(fmaxf(mx, fmaxf(fabsf(v[j][0]), fabsf(v[j][1]))), fmaxf(fabsf(v[j][2]), fabsf(v[j][3]))); }
        s = wave_sum(s);
#pragma unroll
        for (int o = 1; o < 64; o <<= 1) mx = fmaxf(mx, __shfl_xor(mx, o));
        const float inv = mx > 0.f ? 127.f / mx : 0.f; unsigned* o4 = (unsigned*)(F.xq1 + (size_t)m * DM) + lane;
#pragma unroll
        for (int j = 0; j < 8; ++j) { unsigned w = 0u;
#pragma unroll
            for (int i = 0; i < 4; ++i) w |= ((unsigned)(int)rintf(v[j][i] * inv) & 0xffu) << (8 * i);
            o4[64 * j] = w; }
        if (lane == 0) F.rs1[m] = __builtin_amdgcn_rsqf(s * (1.f / DM) + EPS) * (mx * (1.f / 127.f)); }
    { const double invf[16] = {1.0, 0.44036660267178046, 0.19392274474868576, 0.08539710028576561, 0.03760603093086393, 0.016560440080994446, 0.007292664737217109, 0.003211445994752591,
                               0.001414213562373095, 0.000622772421914596, 0.0002742481756762073, 0.00012076973741146504, 5.318295896944988e-05, 2.341999896140934e-05, 1.031338537721246e-05, 4.5416704806078695e-06};
      for (size_t i = gt; i < (size_t)SEQ * 16; i += NT) { const int pos = (int)(i >> 4), j = (int)(i & 15); double f = 1.0;
#pragma unroll
          for (int q = 0; q < 16; ++q) f = (j == q) ? invf[q] : f;
          const double rev = (double)pos * f * 0.15915494309189535; const float fr = (float)(rev - floor(rev));
          F.rope[i] = (f32x2){__builtin_amdgcn_cosf(fr), __builtin_amdgcn_sinf(fr)}; } }
}

__device__ __forceinline__ void qknorm_rope(const Frame& F) {
    const int gw = F.vcu * 8 + F.wave, NGW = F.G * 8, lane = F.lane, c = lane & 15;
    for (long it = gw; it < (long)T * 24 / 4; it += NGW) { const long row = it * 4 + (lane >> 4); const int t = (int)(row / 24), slot = (int)(row % 24);
        bf16_t* p = F.h + (size_t)t * HP + C_QD + slot * 128 + 8 * c;
        const u32x4 w = *(const u32x4*)p; float y[8] = {bflo(w.x), bfhi(w.x), bflo(w.y), bfhi(w.y), bflo(w.z), bfhi(w.z), bflo(w.w), bfhi(w.w)};
        float ss = 0.f;
#pragma unroll
        for (int e = 0; e < 8; ++e) ss += y[e] * y[e];
        ss += __shfl_xor(ss, 1); ss += __shfl_xor(ss, 2); ss += __shfl_xor(ss, 4); ss += __shfl_xor(ss, 8);
        const float rq = __builtin_amdgcn_rsqf(ss * (1.f / 128.f) + EPS); const float* g = (slot < 12 ? F.qn_g : F.kn_g) + 8 * c;
        const f32x4 g0 = *(const f32x4*)g, g1 = *(const f32x4*)(g + 4);
#pragma unroll
        for (int e = 0; e < 4; ++e) { y[e] *= rq * g0[e]; y[4 + e] *= rq * g1[e]; }
        const int pos = t & (SEQ - 1);
#pragma unroll
        for (int e = 0; e < 8; ++e) { const float partner = __shfl_xor(y[e], 2);
            if (c < 4) { const f32x2 cs = F.rope[(size_t)pos * 16 + 8 * (c & 1) + e]; y[e] = (c < 2) ? (y[e] * cs.x - partner * cs.y) : (y[e] * cs.x + partner * cs.y); } }
        if (slot < 12) {
#pragma unroll
            for (int e = 0; e < 8; ++e) y[e] *= QSCALE; }
        u32x4 o; o.x = pk2(y[0], y[1]); o.y = pk2(y[2], y[3]); o.z = pk2(y[4], y[5]); o.w = pk2(y[6], y[7]); *(u32x4*)p = o; }
}

constexpr int GL_GDS = 0, GL_TOT = 8192, GL_QF = 12288, GL_QB = 21504, GL_KF = 30720, GL_KB = 39936, GL_VT = 49152, GL_P = 67584, GL_SF = 76800, GL_SB = 95232, GL_OB = 12288;
constexpr int RS72 = 144;
__device__ __forceinline__ float logsig(float z) { return fminf(z, 0.f) - flog(1.f + fexp(-fabsf(z))); }
__device__ __forceinline__ void gla_gates(const Frame& F, int b, int hh, int n, float (&bf)[8], float (&bb)[8], float& totf, float& totb) {
    const int tid = F.tid, c = tid & 63, ig = F.wave; LAS float* gds = (LAS float*)(F.lds + GL_GDS); LAS float* tot = (LAS float*)(F.lds + GL_TOT);
    const size_t t0 = (size_t)b * SEQ + (size_t)n * 64;
    if (tid < 256) { const int tk = tid >> 2, part = tid & 3; const u32x4 w = *(const u32x4*)(F.h + (t0 + tk) * HP + C_GF + part * 8); LAS float* d = gds + tk * 32 + part * 8;
        d[0] = bflo(w.x); d[1] = bfhi(w.x); d[2] = bflo(w.y); d[3] = bfhi(w.y); d[4] = bflo(w.z); d[5] = bfhi(w.z); d[6] = bflo(w.w); d[7] = bfhi(w.w); }
    __syncthreads();
    const int hc = hh * 64 + c; float upf[16], upb[16];
#pragma unroll
    for (int r = 0; r < 16; ++r) { upf[r] = F.up_f[r * 256 + hc]; upb[r] = F.up_b[r * 256 + hc]; }
    const float biasf = F.bias_f[hc], biasb = F.bias_b[hc]; float laf[8], lab[8];
#pragma unroll
    for (int e = 0; e < 8; ++e) { const LAS float* gr = gds + (ig * 8 + e) * 32; float zf = biasf, zb = biasb;
#pragma unroll
        for (int r = 0; r < 16; ++r) { zf += gr[r] * upf[r]; zb += gr[16 + r] * upb[r]; }
        laf[e] = logsig(zf) * 0.0625f; lab[e] = logsig(zb) * 0.0625f; }
    bf[0] = laf[0];
#pragma unroll
    for (int e = 1; e < 8; ++e) bf[e] = bf[e - 1] + laf[e];
    bb[7] = lab[7];
#pragma unroll
    for (int e = 6; e >= 0; --e) bb[e] = bb[e + 1] + lab[e];
    tot[ig * 64 + c] = bf[7]; tot[512 + ig * 64 + c] = bb[0];
    __syncthreads();
    float offf = 0.f, offb = 0.f; totf = 0.f; totb = 0.f;
#pragma unroll
    for (int g = 0; g < 8; ++g) { const float tf = tot[g * 64 + c], tb = tot[512 + g * 64 + c]; totf += tf; totb += tb; offf += (g < ig) ? tf : 0.f; offb += (g > ig) ? tb : 0.f; }
#pragma unroll
    for (int e = 0; e < 8; ++e) { bf[e] += offf; bb[e] += offb; }
}
__device__ __forceinline__ void gla_stage_vT(const Frame& F, size_t t0, int hh) {
#pragma unroll
    for (int j = 0; j < 2; ++j) { const int q = F.tid + 512 * j, tk = q >> 4, vc = (q & 15) * 8; const bf16x8 v = *(const bf16x8*)(F.h + (t0 + tk) * HP + C_VA + hh * 128 + vc);
        LAS short* d = (LAS short*)(F.lds + GL_VT) + vc * 72 + tk;
#pragma unroll
        for (int e = 0; e < 8; ++e) d[e * 72] = v[e]; }
}
__device__ __forceinline__ bf16x8 ldfrag(const LAS unsigned char* base, int row, int s, int hi) { return *(const LAS bf16x8*)(base + row * RS72 + (16 * s + 8 * hi) * 2); }

__device__ __forceinline__ void gla_passA(const Frame& F, int item) {
    const int bh = item >> 8, n = item & 255, b = bh >> 2, hh = bh & 3, tid = F.tid, c = tid & 63, ig = F.wave, lane = F.lane, r32 = lane & 31, hi = lane >> 5;
    float bf[8], bb[8], totf, totb; gla_gates(F, b, hh, n, bf, bb, totf, totb);
    const size_t t0 = (size_t)b * SEQ + (size_t)n * 64;
    float kf[8], kb[8];
#pragma unroll
    for (int e = 0; e < 8; ++e) { const float k = bf2f(F.h[(t0 + ig * 8 + e) * HP + C_KA + hh * 64 + c]); kf[e] = k * fexp(totf - bf[e]); kb[e] = k * fexp(totb - bb[e]); }
    { u32x4 o; o.x = pk2(kf[0], kf[1]); o.y = pk2(kf[2], kf[3]); o.z = pk2(kf[4], kf[5]); o.w = pk2(kf[6], kf[7]); *(LAS u32x4*)(F.lds + GL_KF + c * RS72 + ig * 16) = o;
      o.x = pk2(kb[0], kb[1]); o.y = pk2(kb[2], kb[3]); o.z = pk2(kb[4], kb[5]); o.w = pk2(kb[6], kb[7]); *(LAS u32x4*)(F.lds + GL_KB + c * RS72 + ig * 16) = o; }
    gla_stage_vT(F, t0, hh);
    if (ig == 0) { F.dec[((size_t)(0 * 8 + bh) * 256 + n) * 64 + c] = fexp(totf); F.dec[((size_t)(1 * 8 + bh) * 256 + n) * 64 + c] = fexp(totb); }
    __syncthreads();
    const int dir = F.wave >> 2, vt = F.wave & 3; const LAS unsigned char* kimg = F.lds + (dir ? GL_KB : GL_KF);
    f32x16 a0 = {}, a1 = {};
#pragma unroll
    for (int s = 0; s < 4; ++s) { const bf16x8 av = ldfrag(F.lds + GL_VT, 32 * vt + r32, s, hi), b0 = ldfrag(kimg, r32, s, hi), b1 = ldfrag(kimg, 32 + r32, s, hi);
        a0 = __builtin_amdgcn_mfma_f32_32x32x16_bf16(av, b0, a0, 0, 0, 0); a1 = __builtin_amdgcn_mfma_f32_32x32x16_bf16(av, b1, a1, 0, 0, 0); }
    float* st = F.state + ((size_t)(dir * 8 + bh) * 256 + n) * 8192;
#pragma unroll
    for (int r = 0; r < 16; ++r) { const int v = 32 * vt + crow(r, hi); st[v * 64 + r32] = a0[r]; st[v * 64 + 32 + r32] = a1[r]; }
    __syncthreads();
}
__device__ __forceinline__ void gla_scan(const Frame& F, int item) {
    const int dir = item >> 7, bh = (item >> 4) & 7, e = (item & 15) * 512 + F.tid, c = e & 63;
    float* st = F.state + (size_t)(dir * 8 + bh) * 256 * 8192 + e; const float* dc = F.dec + (size_t)(dir * 8 + bh) * 256 * 64 + c; float S = 0.f;
    float iA[16], dA[16], iB[16], dB[16];
#define SC_N(g, j) (dir ? 255 - ((g) * 16 + (j)) : (g) * 16 + (j))
#define SC_LOAD(I_, D_, g) do { _Pragma("unroll") for (int j = 0; j < 16; ++j) { const int n_ = SC_N(g, j); I_[j] = st[(size_t)n_ * 8192]; D_[j] = dc[n_ * 64]; } } while (0)
#define SC_RUN(I_, D_, g) do { _Pragma("unroll") for (int j = 0; j < 16; ++j) { const int n_ = SC_N(g, j); st[(size_t)n_ * 8192] = S; S = D_[j] * S + I_[j]; } } while (0)
    SC_LOAD(iA, dA, 0);
    for (int g = 0; g < 16; g += 2) { SC_LOAD(iB, dB, g + 1); SC_RUN(iA, dA, g); if (g + 2 < 16) SC_LOAD(iA, dA, g + 2); SC_RUN(iB, dB, g + 1); }
#undef SC_N
#undef SC_LOAD
#undef SC_RUN
}
__device__ __forceinline__ void gla_passC(const Frame& F, int item) {
    const int bh = item >> 8, n = item & 255, b = bh >> 2, hh = bh & 3, tid = F.tid, c = tid & 63, ig = F.wave, lane = F.lane, r32 = lane & 31, hi = lane >> 5;
    float bf[8], bb[8], totf, totb; gla_gates(F, b, hh, n, bf, bb, totf, totb);
    const size_t t0 = (size_t)b * SEQ + (size_t)n * 64;
#pragma unroll
    for (int e = 0; e < 8; ++e) { const int i = ig * 8 + e; const bf16_t* hr = F.h + (t0 + i) * HP + hh * 64 + c; const float q = bf2f(hr[C_QA]) * 0.125f, k = bf2f(hr[C_KA]);
        const float ef = fexp(bf[e]), eb = fexp(bb[e]), nf = fexp(-bf[e]), nb = fexp(-bb[e]);
        *(LAS unsigned short*)(F.lds + GL_QF + i * RS72 + c * 2) = (unsigned short)f2bf(q * ef); *(LAS unsigned short*)(F.lds + GL_QB + i * RS72 + c * 2) = (unsigned short)f2bf(q * eb);
        *(LAS unsigned short*)(F.lds + GL_KF + i * RS72 + c * 2) = (unsigned short)f2bf(k * nf); *(LAS unsigned short*)(F.lds + GL_KB + i * RS72 + c * 2) = (unsigned short)f2bf(k * nb); }
    gla_stage_vT(F, t0, hh);
#pragma unroll
    for (int dir = 0; dir < 2; ++dir) { const float* st = F.state + ((size_t)(dir * 8 + bh) * 256 + n) * 8192; LAS unsigned char* img = F.lds + (dir ? GL_SB : GL_SF);
#pragma unroll
        for (int j = 0; j < 4; ++j) { const int q4 = tid + 512 * j, v = q4 >> 4, c4 = (q4 & 15) * 4; const f32x4 s = *(const f32x4*)(st + v * 64 + c4);
            u32x2 w; w.x = pk2(s[0], s[1]); w.y = pk2(s[2], s[3]); *(LAS u32x2*)(img + v * RS72 + c4 * 2) = w; } }
    __syncthreads();
    if (F.wave < 4) { const int ti = F.wave >> 1, tj = F.wave & 1; f32x16 sf = {}, sb = {};
#pragma unroll
        for (int s = 0; s < 4; ++s) {
            sf = __builtin_amdgcn_mfma_f32_32x32x16_bf16(ldfrag(F.lds + GL_QF, 32 * ti + r32, s, hi), ldfrag(F.lds + GL_KF, 32 * tj + r32, s, hi), sf, 0, 0, 0);
            sb = __builtin_amdgcn_mfma_f32_32x32x16_bf16(ldfrag(F.lds + GL_QB, 32 * ti + r32, s, hi), ldfrag(F.lds + GL_KB, 32 * tj + r32, s, hi), sb, 0, 0, 0); }
#pragma unroll
        for (int r = 0; r < 16; ++r) { const int i = 32 * ti + crow(r, hi), j = 32 * tj + r32; const float p = (j <= i) ? sf[r] : sb[r];
            *(LAS unsigned short*)(F.lds + GL_P + i * RS72 + j * 2) = (unsigned short)f2bf(p); } }
    __syncthreads();
    const int ti = F.wave & 1, tv = F.wave >> 1; f32x16 o = {};
#pragma unroll
    for (int s = 0; s < 4; ++s) o = __builtin_amdgcn_mfma_f32_32x32x16_bf16(ldfrag(F.lds + GL_P, 32 * ti + r32, s, hi), ldfrag(F.lds + GL_VT, 32 * tv + r32, s, hi), o, 0, 0, 0);
#pragma unroll
    for (int s = 0; s < 4; ++s) o = __builtin_amdgcn_mfma_f32_32x32x16_bf16(ldfrag(F.lds + GL_QF, 32 * ti + r32, s, hi), ldfrag(F.lds + GL_SF, 32 * tv + r32, s, hi), o, 0, 0, 0);
#pragma unroll
    for (int s = 0; s < 4; ++s) o = __builtin_amdgcn_mfma_f32_32x32x16_bf16(ldfrag(F.lds + GL_QB, 32 * ti + r32, s, hi), ldfrag(F.lds + GL_SB, 32 * tv + r32, s, hi), o, 0, 0, 0);
    __syncthreads();
    LAS float* ob = (LAS float*)(F.lds + GL_OB);
#pragma unroll
    for (int r = 0; r < 16; ++r) ob[(32 * ti + crow(r, hi)) * 132 + 32 * tv + r32] = o[r];
    __syncthreads();
    { const int i = tid >> 3, part = tid & 7, v0 = part * 16; float ov[16], ss = 0.f;
#pragma unroll
      for (int e = 0; e < 16; ++e) { ov[e] = ob[i * 132 + v0 + e]; ss += ov[e] * ov[e]; }
      ss += __shfl_xor(ss, 1); ss += __shfl_xor(ss, 2); ss += __shfl_xor(ss, 4);
      const float rs = __builtin_amdgcn_rsqf(ss * (1.f / 128.f) + EPS); const size_t tok = t0 + i;
      const u32x4 r0 = *(const u32x4*)(F.h + tok * HP + C_RA + hh * 128 + v0), r1 = *(const u32x4*)(F.h + tok * HP + C_RA + hh * 128 + v0 + 8);
      const float rr[16] = {bflo(r0.x), bfhi(r0.x), bflo(r0.y), bfhi(r0.y), bflo(r0.z), bfhi(r0.z), bflo(r0.w), bfhi(r0.w), bflo(r1.x), bfhi(r1.x), bflo(r1.y), bfhi(r1.y), bflo(r1.z), bfhi(r1.z), bflo(r1.w), bfhi(r1.w)};
      float y[16];
#pragma unroll
      for (int e = 0; e < 16; ++e) { const float g = F.out_g[hh * 128 + v0 + e]; const float sil = rr[e] * __builtin_amdgcn_rcpf(1.f + fexp(-rr[e])); y[e] = ov[e] * rs * g * sil; }
      u32x4 w0, w1; w0.x = pk2(y[0], y[1]); w0.y = pk2(y[2], y[3]); w0.z = pk2(y[4], y[5]); w0.w = pk2(y[6], y[7]); w1.x = pk2(y[8], y[9]); w1.y = pk2(y[10], y[11]); w1.z = pk2(y[12], y[13]); w1.w = pk2(y[14], y[15]);
      bf16_t* mp = F.mixed + tok * DM + hh * 128 + v0; *(u32x4*)mp = w0; *(u32x4*)(mp + 8) = w1; }
    __syncthreads();
}

constexpr int AT_V = 0, AT_K = 32768, AT_O = 65536;
#define KSWZ(row, colB) ((row) * 256 + ((colB) ^ (((row) & 7) << 4)))
__device__ __forceinline__ int v_st(int k, int c) { const int kk = (k & ~0xC) | ((k & 4) << 1) | ((k & 8) >> 1); return ((kk >> 3) * 4 + (c >> 5)) * 512 + ((kk & 7) * 32 + (c & 31)) * 2; }
__device__ __forceinline__ int v_rd_base(int lane) { return ((lane & 3) << 3) | (((lane >> 2) & 3) << 6) | (((lane >> 4) & 1) << 5) | (((lane >> 5) & 1) << 8); }
constexpr int v_rd_off(int d0, int ks, int half) { return d0 * 512 + ks * 4096 + half * 2048; }
template <int OFF> __device__ __forceinline__ s16x4 tr_read(int vb) { s16x4 r; asm volatile("ds_read_b64_tr_b16 %0, %1 offset:%2" : "=&v"(r) : "v"(vb), "i"(OFF) : "memory"); return r; }
template <int D0> __device__ __forceinline__ void pv_one(f32x16& od, int vb, bf16x8 pa0, bf16x8 pa1, bf16x8 pa2, bf16x8 pa3) {
    const s16x4 l0 = tr_read<v_rd_off(D0, 0, 0)>(vb), h0 = tr_read<v_rd_off(D0, 0, 1)>(vb), l1 = tr_read<v_rd_off(D0, 1, 0)>(vb), h1 = tr_read<v_rd_off(D0, 1, 1)>(vb);
    const s16x4 l2 = tr_read<v_rd_off(D0, 2, 0)>(vb), h2 = tr_read<v_rd_off(D0, 2, 1)>(vb), l3 = tr_read<v_rd_off(D0, 3, 0)>(vb), h3 = tr_read<v_rd_off(D0, 3, 1)>(vb);
    asm volatile("s_waitcnt lgkmcnt(0)" ::: "memory"); SBAR();
#define PKV(L, H) (bf16x8){L[0], L[1], L[2], L[3], H[0], H[1], H[2], H[3]}
    od = __builtin_amdgcn_mfma_f32_32x32x16_bf16(pa0, PKV(l0, h0), od, 0, 0, 0);
    od = __builtin_amdgcn_mfma_f32_32x32x16_bf16(pa1, PKV(l1, h1), od, 0, 0, 0);
    od = __builtin_amdgcn_mfma_f32_32x32x16_bf16(pa2, PKV(l2, h2), od, 0, 0, 0);
    od = __builtin_amdgcn_mfma_f32_32x32x16_bf16(pa3, PKV(l3, h3), od, 0, 0, 0);
#undef PKV
}
struct AtP { size_t tokbase; int dil, m0, Tf, nt, head, p; };
__device__ __forceinline__ AtP at_decode(int item) {
    AtP P; const int p = item / 1536, rem = item % 1536, b = rem / 768, rem2 = rem % 768, u = rem2 & 63; P.p = p; P.head = rem2 >> 6;
    const int dsh = 2 * p, L = SEQ >> dsh, runs = 64 >> dsh, res = u / runs; P.dil = 1 << dsh; P.m0 = (u % runs) * 256; P.tokbase = (size_t)b * SEQ + res;
    const int kt_lo = (P.m0 == 0) ? 1 : 0, kt_hi = (P.m0 + 256 >= L) ? 4 : 5; P.Tf = P.m0 - 64 + 64 * kt_lo; P.nt = kt_hi - kt_lo + 1; return P;
}
__device__ __forceinline__ void attn_phase(const Frame& F) {
    const int tid = F.tid, wid = F.wave, lane = F.lane, r32 = lane & 31, hi = lane >> 5, G = F.G;
    int ntot = 0; for (int it = F.vcu; it < 4608; it += G) ntot += at_decode(it).nt;
    if (ntot == 0) return;
    const int sr = tid >> 4, sc = (tid & 15) * 8, vst0 = v_st(sr, sc), vst1 = v_st(32 + sr, sc), kc = sc * 2;
    const int vb0 = (int)(unsigned)(uintptr_t)(F.ldsg + AT_V) + v_rd_base(lane);
    int it_ld = F.vcu, rl = 0, it_c = F.vcu, rc = 0; AtP ld = at_decode(it_ld), cur = ld;
    bf16x8 qr[8], qn[8]; f32x16 o[4]; float l_reg = 0.f;
    bf16x8 sA0, sA1, sA2, sA3;
#define AT_QLOAD() do { const bf16_t* qp_ = F.h + C_QD + ld.head * 128 + (ld.tokbase + (size_t)ld.dil * (ld.m0 + 32 * wid + r32)) * HP + hi * 8; \
        _Pragma("unroll") for (int d0 = 0; d0 < 8; ++d0) qn[d0] = *(const bf16x8*)(qp_ + d0 * 16); } while (0)
#define AT_SLOAD(S) do { const int T0_ = ld.Tf + 64 * rl; const size_t ra = (ld.tokbase + (size_t)ld.dil * (T0_ + sr)) * HP + ld.head * 128 + sc, rb = ra + (size_t)ld.dil * 32 * HP; \
        S##0 = *(const bf16x8*)(F.h + C_VD + ra); S##1 = *(const bf16x8*)(F.h + C_VD + rb); S##2 = *(const bf16x8*)(F.h + C_KD + ra); S##3 = *(const bf16x8*)(F.h + C_KD + rb); \
        if (++rl == ld.nt) { it_ld += G; rl = 0; if (it_ld < 4608) { ld = at_decode(it_ld); AT_QLOAD(); } } } while (0)
#define AT_SWRITE(S, B) do { *(LAS bf16x8*)(F.lds + AT_V + (B) * 16384 + vst0) = S##0; *(LAS bf16x8*)(F.lds + AT_V + (B) * 16384 + vst1) = S##1; \
        *(LAS bf16x8*)(F.lds + AT_K + (B) * 16384 + KSWZ(sr, kc)) = S##2; *(LAS bf16x8*)(F.lds + AT_K + (B) * 16384 + KSWZ(32 + sr, kc)) = S##3; } while (0)
#define PK4(P, BASE, OUT) do { unsigned a0_ = pk2(P[BASE + 0], P[BASE + 1]), a1_ = pk2(P[BASE + 2], P[BASE + 3]); unsigned b0_ = pk2(P[BASE + 4], P[BASE + 5]), b1_ = pk2(P[BASE + 6], P[BASE + 7]); \
        auto r0_ = __builtin_amdgcn_permlane32_swap(a0_, b0_, false, false); auto r1_ = __builtin_amdgcn_permlane32_swap(a1_, b1_, false, false); \
        u32x4 w_ = {r0_[0], r1_[0], r0_[1], r1_[1]}; OUT = __builtin_bit_cast(bf16x8, w_); } while (0)
#define AT_STEP(BUF) do { \
        if (rc == 0) { _Pragma("unroll") for (int d0 = 0; d0 < 8; ++d0) qr[d0] = qn[d0]; _Pragma("unroll") for (int d0 = 0; d0 < 4; ++d0) o[d0] = (f32x16){}; l_reg = 0.f; } \
        const int Q0 = cur.m0 + 32 * wid, T0 = cur.Tf + 64 * rc; \
        if (T0 + 63 >= Q0 - 64 && T0 <= Q0 + 95) {                                        \
            const LAS unsigned char* Ks = F.lds + AT_K + (BUF) * 16384; f32x16 p0 = {}, p1 = {}; \
            _Pragma("unroll") for (int d0 = 0; d0 < 8; ++d0) { const int cb = (d0 * 16 + hi * 8) * 2; \
                const bf16x8 k0 = *(const LAS bf16x8*)(Ks + KSWZ(r32, cb)), k1 = *(const LAS bf16x8*)(Ks + KSWZ(32 + r32, cb)); \
                p0 = __builtin_amdgcn_mfma_f32_32x32x16_bf16(k0, qr[d0], p0, 0, 0, 0); p1 = __builtin_amdgcn_mfma_f32_32x32x16_bf16(k1, qr[d0], p1, 0, 0, 0); } \
            const int dq = T0 - (Q0 + r32); float ps = 0.f;                                \
            _Pragma("unroll") for (int r = 0; r < 16; ++r) { const int e0 = dq + crow(r, hi), e1 = e0 + 32; \
                p0[r] = (e0 >= -64 && e0 <= 64) ? __builtin_amdgcn_exp2f(p0[r]) : 0.f; p1[r] = (e1 >= -64 && e1 <= 64) ? __builtin_amdgcn_exp2f(p1[r]) : 0.f; ps += p0[r] + p1[r]; } \
            l_reg += ps; \
            bf16x8 pa0, pa1, pa2, pa3; PK4(p0, 0, pa0); PK4(p0, 8, pa1); PK4(p1, 0, pa2); PK4(p1, 8, pa3); \
            const int vb = vb0 + (BUF) * 16384; \
            pv_one<0>(o[0], vb, pa0, pa1, pa2, pa3); pv_one<1>(o[1], vb, pa0, pa1, pa2, pa3); pv_one<2>(o[2], vb, pa0, pa1, pa2, pa3); pv_one<3>(o[3], vb, pa0, pa1, pa2, pa3); } \
        if (++rc == cur.nt) {                                                             \
            bf16_t* Op = (bf16_t*)(cur.p == 0 ? (unsigned char*)F.out + OUT_OP0 : F.wsb + (cur.p == 1 ? WS_OP1 : WS_OP2)); \
            const float lt = l_reg + __shfl_xor(l_reg, 32); \
            if (hi == 0) F.lp[((size_t)cur.p * T + cur.tokbase + (size_t)cur.dil * (Q0 + r32)) * NHD + cur.head] = lt; \
            LAS unsigned char* stg = F.lds + AT_O + wid * 8192; \
            _Pragma("unroll") for (int d0 = 0; d0 < 4; ++d0) _Pragma("unroll") for (int r = 0; r < 16; ++r) *(LAS unsigned short*)(stg + (crow(r, hi) * 128 + d0 * 32 + r32) * 2) = (unsigned short)f2bf(o[d0][r]); \
            LDS_WAIT(); asm volatile("" ::: "memory"); \
            _Pragma("unroll") for (int i_ = 0; i_ < 8; ++i_) { const int row = 4 * i_ + (lane >> 4), ch = lane & 15; const u32x4 w = *(const LAS u32x4*)(stg + row * 256 + ch * 16); \
                *(u32x4*)(Op + (cur.tokbase + (size_t)cur.dil * (Q0 + row)) * (NHD * 128) + cur.head * 128 + ch * 8) = w; } \
            LDS_WAIT(); asm volatile("" ::: "memory"); \
            rc = 0; it_c += G; if (it_c < 4608) cur = at_decode(it_c); } } while (0)
    AT_QLOAD();
    AT_SLOAD(sA); AT_SWRITE(sA, 0); AT_SLOAD(sA); __syncthreads();
    for (int g = 0; g < ntot; ++g) { const int buf = g & 1;
        AT_STEP(buf);
        if (g + 1 < ntot) AT_SWRITE(sA, buf ^ 1);
        if (it_ld < 4608) AT_SLOAD(sA);
        __syncthreads();
    }
#undef AT_QLOAD
#undef AT_SLOAD
#undef AT_SWRITE
#undef PK4
#undef AT_STEP
}
__device__ __forceinline__ void dil_combine(const Frame& F) {
    const int gw = F.vcu * 8 + F.wave, NGW = F.G * 8, lane = F.lane, c = lane & 15;
    for (long it = gw; it < (long)T * NHD / 4; it += NGW) { const long row = it * 4 + (lane >> 4); const size_t tok = (size_t)(row / NHD); const int head = (int)(row % NHD);
        const float l = F.lp[tok * NHD + head] + F.lp[((size_t)T + tok) * NHD + head] + F.lp[((size_t)2 * T + tok) * NHD + head]; const float inv = 1.f / l;
        const size_t off = tok * (NHD * 128) + head * 128 + 8 * c; const u32x4 a = *(const u32x4*)(F.op0 + off), b = *(const u32x4*)(F.op1 + off), d = *(const u32x4*)(F.op2 + off);
        u32x4 o; o.x = pk2((bflo(a.x) + bflo(b.x) + bflo(d.x)) * inv, (bfhi(a.x) + bfhi(b.x) + bfhi(d.x)) * inv); o.y = pk2((bflo(a.y) + bflo(b.y) + bflo(d.y)) * inv, (bfhi(a.y) + bfhi(b.y) + bfhi(d.y)) * inv);
        o.z = pk2((bflo(a.z) + bflo(b.z) + bflo(d.z)) * inv, (bfhi(a.z) + bfhi(b.z) + bfhi(d.z)) * inv); o.w = pk2((bflo(a.w) + bflo(b.w) + bflo(d.w)) * inv, (bfhi(a.w) + bfhi(b.w) + bfhi(d.w)) * inv);
        *(u32x4*)(F.mixed + tok * DM + 512 + head * 128 + 8 * c) = o; }
}

__device__ __forceinline__ unsigned fl_flip(float x) { const unsigned u = __float_as_uint(x); return u ^ ((unsigned)((int)u >> 31) | 0x80000000u); }
__device__ __forceinline__ float fl_unflip(unsigned w) { return __uint_as_float((w & 0x80000000u) ? (w ^ 0x80000000u) : ~w); }
#define CE_DESC(a, b) do { const unsigned x_ = max(a, b), y_ = min(a, b); a = x_; b = y_; } while (0)
__device__ __forceinline__ void sort16_desc(unsigned (&a)[16]) {
#pragma unroll
    for (int k = 2; k <= 16; k <<= 1)
#pragma unroll
        for (int j = k >> 1; j > 0; j >>= 1)
#pragma unroll
            for (int i = 0; i < 16; ++i) { const int l = i ^ j; if (l > i) { const unsigned x = max(a[i], a[l]), y = min(a[i], a[l]); if ((i & k) == 0) { a[i] = x; a[l] = y; } else { a[i] = y; a[l] = x; } } }
}
__device__ __forceinline__ void bmerge16_desc(unsigned (&a)[16]) {
#pragma unroll
    for (int j = 8; j > 0; j >>= 1)
#pragma unroll
        for (int i = 0; i < 16; ++i) { const int l = i ^ j; if (l > i) CE_DESC(a[i], a[l]); }
}
__device__ __forceinline__ void top16_merge(unsigned (&a)[16], const unsigned (&b)[16]) {
#pragma unroll
    for (int i = 0; i < 16; ++i) a[i] = max(a[i], b[15 - i]);
    bmerge16_desc(a);
}
__device__ __forceinline__ void top16_partner(unsigned (&a)[16]) {
    unsigned b[16];
#pragma unroll
    for (int i = 0; i < 16; ++i) b[i] = (unsigned)__shfl_xor((int)a[i], 32);
    top16_merge(a, b);
}
__device__ constexpr unsigned char stair(int n) {
    constexpr unsigned char L[64] = {0x00,0x01,0x02,0x03,0x04,0x05,0x06,0x07,0x08,0x09,0x0a,0x0b,0x0c,0x0d,0x0e,0x0f,0x10,0x11,0x12,0x13,0x14,0x15,0x16,0x17,0x20,0x21,0x22,0x23,0x24,0x30,0x31,0x32,
                                     0x33,0x40,0x41,0x42,0x50,0x51,0x60,0x61,0x70,0x71,0x80,0x90,0xa0,0xb0,0xc0,0xd0,0xe0,0xf0,0xff,0xff,0xff,0xff,0xff,0xff,0xff,0xff,0xff,0xff,0xff,0xff,0xff,0xff};
    return L[n];
}
__device__ __forceinline__ void topk_item(const Frame& F, int item) {
    const int lane = F.lane, r32 = lane & 31, hi = lane >> 5, hh = item & 7, tok0 = (item >> 3) * 32; const size_t tok = (size_t)tok0 + r32;
    LAS int* ktab = (LAS int*)(F.lds + F.wave * 4096) + r32 * 32;
    float ss = 0.f;
    { const f32x4* sp = (const f32x4*)(F.ssp + tok * 32 + hi * 16);
#pragma unroll
      for (int j = 0; j < 4; ++j) { const f32x4 v = sp[j]; ss += (v[0] + v[1]) + (v[2] + v[3]); } }
    ss += __shfl_xor(ss, 32);
    const float rs2 = __builtin_amdgcn_rsqf(ss * (1.f / DM) + EPS);
    if (hh == 0 && hi == 0) F.rs2[tok] = rs2;
    unsigned top[2][16];
#pragma unroll
    for (int cc = 0; cc < 2; ++cc) {
        f32x16 acc[4] = {};
        const bf16_t* qp = F.qry + tok * DM + hh * 256 + cc * 128 + hi * 8; const bf16_t* kp = F.SK + ((size_t)(hh * 2 + cc) * 128 + r32) * 128 + hi * 8;
#pragma unroll 2
        for (int s = 0; s < 8; ++s) { const bf16x8 qf = *(const bf16x8*)(qp + 16 * s);
#pragma unroll
            for (int kt = 0; kt < 4; ++kt) { const bf16x8 kf = *(const bf16x8*)(kp + (size_t)kt * 32 * 128 + 16 * s); acc[kt] = __builtin_amdgcn_mfma_f32_32x32x16_bf16(kf, qf, acc[kt], 0, 0, 0); } }
        unsigned g[4][16];
#pragma unroll
        for (int kt = 0; kt < 4; ++kt) {
#pragma unroll
            for (int r = 0; r < 16; ++r) g[kt][r] = (fl_flip(acc[kt][r]) & ~127u) | (unsigned)(127 - (32 * kt + crow(r, hi)));
            sort16_desc(g[kt]); }
        top16_merge(g[0], g[1]); top16_merge(g[2], g[3]); top16_merge(g[0], g[2]); top16_partner(g[0]);
#pragma unroll
        for (int i = 0; i < 16; ++i) top[cc][i] = g[0][i];
    }
#pragma unroll
    for (int i = 0; i < 16; ++i) ktab[hi * 16 + i] = 127 - (int)((hi ? top[1][i] : top[0][i]) & 127u);
    float s0[16], s1[16];
#pragma unroll
    for (int i = 0; i < 16; ++i) { s0[i] = fl_unflip(top[0][i] & ~127u); s1[i] = fl_unflip(top[1][i] & ~127u); }
    unsigned ca[16], cb[16];
#pragma unroll
    for (int n = 0; n < 32; ++n) { const int A = stair(n), B = stair(25 + n); unsigned va = 0u, vb = 0u;
        if (n < 25) { va = (fl_flip(s0[A >> 4] + s1[A & 15]) & ~255u) | (unsigned)(255 - A); vb = (fl_flip(s0[B >> 4] + s1[B & 15]) & ~255u) | (unsigned)(255 - B); }
        const unsigned v = hi ? vb : va; if (n < 16) ca[n] = v; else cb[n - 16] = v; }
    sort16_desc(ca); sort16_desc(cb); top16_merge(ca, cb); top16_partner(ca);
    float e[16], sum = 0.f; const float mx = fl_unflip(ca[0] & ~255u) * rs2;
#pragma unroll
    for (int i = 0; i < 16; ++i) { e[i] = fexp(fl_unflip(ca[i] & ~255u) * rs2 - mx); sum += e[i]; }
    const float inv = 1.f / sum;
    LDS_WAIT(); asm volatile("" ::: "memory");
    int oi[8]; float og[8];
#pragma unroll
    for (int k = 0; k < 8; ++k) { const unsigned cv = hi ? ca[8 + k] : ca[k]; const int code = 255 - (int)(cv & 255u); og[k] = (hi ? e[8 + k] : e[k]) * inv; oi[k] = ktab[code >> 4] * 128 + ktab[16 + (code & 15)]; }
    { int* ip = F.idx + tok * 128 + hh * 16 + hi * 8; float* gp = F.gate + tok * 128 + hh * 16 + hi * 8;
      *(int4*)ip = make_int4(oi[0], oi[1], oi[2], oi[3]); *(int4*)(ip + 4) = make_int4(oi[4], oi[5], oi[6], oi[7]);
      *(f32x4*)gp = (f32x4){og[0], og[1], og[2], og[3]}; *(f32x4*)(gp + 4) = (f32x4){og[4], og[5], og[6], og[7]}; }
    LDS_WAIT(); asm volatile("" ::: "memory");
}

constexpr int PS_NSL = 16, PS_CW = DM / PS_NSL, PS_SUB = PS_NSL / 8, PS_TG = 32, PS_NTG = T / PS_TG;
__device__ __forceinline__ float gelu_tanh(float x) { const float u = 0.7978845608028654f * (x + 0.044715f * x * x * x); const float t = 1.f - 2.f * __builtin_amdgcn_rcpf(1.f + fexp(2.f * u)); return 0.5f * x * (1.f + t); }
__device__ __forceinline__ int dot16i(u32x4 w, u32x4 x) { int p = __builtin_amdgcn_sdot4((int)w.x, (int)x.x, 0, false); p = __builtin_amdgcn_sdot4((int)w.y, (int)x.y, p, false); p = __builtin_amdgcn_sdot4((int)w.z, (int)x.z, p, false); return __builtin_amdgcn_sdot4((int)w.w, (int)x.w, p, false); }
__device__ __forceinline__ unsigned xcc_id() { return (unsigned)__builtin_amdgcn_s_getreg((3 << 11) | 20) & 7u; }
__device__ __forceinline__ bool peer_claim(unsigned* cnt, unsigned x, unsigned& d, int lane, int& q, int& tg) {
    while (d < 8u) { const unsigned xq = (x + d) & 7u; unsigned u = 0u;
        if (lane == 0) u = __hip_atomic_fetch_add(cnt + 64 * xq, 1u, __ATOMIC_RELAXED, __HIP_MEMORY_SCOPE_AGENT);
        u = (unsigned)__builtin_amdgcn_readfirstlane((int)u);
        if (u < (unsigned)(PS_SUB * PS_NTG)) { q = (int)(u / PS_NTG) * 8 + (int)xq; tg = (int)(u % PS_NTG); return true; }
        ++d; }
    return false;
}
template <int CTRL> __device__ __forceinline__ float dppmov(float x) { return __int_as_float(__builtin_amdgcn_update_dpp(0, __float_as_int(x), CTRL, 0xf, 0xf, true)); }
template <int CTRL> __device__ __forceinline__ int dppmovi(int x) { return __builtin_amdgcn_update_dpp(0, x, CTRL, 0xf, 0xf, true); }
__device__ __forceinline__ int bperm(int srclane, int v) { return __builtin_amdgcn_ds_bpermute(srclane << 2, v); }
__device__ __forceinline__ void peer_quant_x(const Frame& F) {
    const int gw = F.vcu * 8 + F.wave, NGW = F.G * 8, lane = F.lane;
    for (int tok = gw; tok < T; tok += NGW) { const u32x4* xr = (const u32x4*)(F.x1b + (size_t)tok * DM) + lane; float v[4][8]; float m = 0.f;
#pragma unroll
        for (int j = 0; j < 4; ++j) { const u32x4 w = xr[64 * j]; v[j][0] = bflo(w.x); v[j][1] = bfhi(w.x); v[j][2] = bflo(w.y); v[j][3] = bfhi(w.y); v[j][4] = bflo(w.z); v[j][5] = bfhi(w.z); v[j][6] = bflo(w.w); v[j][7] = bfhi(w.w);
#pragma unroll
            for (int i = 0; i < 8; ++i) m = fmaxf(m, fabsf(v[j][i])); }
#pragma unroll
        for (int o = 1; o < 64; o <<= 1) m = fmaxf(m, __shfl_xor(m, o));
        const float inv = m > 0.f ? 127.f / m : 0.f;
#pragma unroll
        for (int j = 0; j < 4; ++j) { u32x2 w = {0u, 0u};
#pragma unroll
            for (int i = 0; i < 4; ++i) { w.x |= ((unsigned)(int)rintf(v[j][i] * inv) & 0xffu) << (8 * i); w.y |= ((unsigned)(int)rintf(v[j][4 + i] * inv) & 0xffu) << (8 * i); }
            *(u32x2*)(F.xq8 + (size_t)tok * DM + 8 * lane + 512 * j) = w; }
        if (lane == 0) F.sx[tok] = m * (1.f / 127.f); }
}
__device__ __forceinline__ void peer_down(const Frame& F, int cntw = 1024) {
    const int lane = F.lane, g = lane >> 3, c = lane & 7; const unsigned x = xcc_id(); unsigned d = 0u; int q, tg; unsigned* cnt = (unsigned*)(F.wsb + WS_CTL) + cntw;
    const unsigned char* tab = F.down8; const unsigned char* xb = F.xq8;
    while (peer_claim(cnt, x, d, lane, q, tg)) {
        const unsigned colb = (unsigned)(q * PS_CW + 16 * c), slb = (unsigned)q * (16384u * 128u) + 16u * c; int* part = F.part + (size_t)q * T * 128; const size_t tok0 = (size_t)tg * PS_TG;
        u32x4 wA[16], wB[16], xA, xB; int iA0, iA1, iB0, iB1;
#define PD_IDX(i0, i1, tok) do { const int* ip_ = F.idx + (tok) * 128 + lane; i0 = ip_[0]; i1 = ip_[64]; } while (0)
#define PD_ROWS(W_, X_, i0, i1, tok) do { _Pragma("unroll") for (int j = 0; j < 16; ++j) { const unsigned e_ = (unsigned)bperm(8 * (j & 7) + g, j < 8 ? i0 : i1); \
            W_[j] = *(const u32x4*)(tab + (e_ * 128u + slb)); } X_ = *(const u32x4*)(xb + (tok) * DM + colb); } while (0)
#define PD_COMP(W_, X_, tok) do { int p[16]; _Pragma("unroll") for (int j = 0; j < 16; ++j) p[j] = dot16i(W_[j], X_); \
            int a1[8], a2[4], a3[2]; \
            _Pragma("unroll") for (int i = 0; i < 8; ++i) { const int keep = (c & 1) ? p[2 * i + 1] : p[2 * i], give = (c & 1) ? p[2 * i] : p[2 * i + 1]; a1[i] = keep + dppmovi<0xB1>(give); } \
            _Pragma("unroll") for (int i = 0; i < 4; ++i) { const int keep = (c & 2) ? a1[2 * i + 1] : a1[2 * i], give = (c & 2) ? a1[2 * i] : a1[2 * i + 1]; a2[i] = keep + dppmovi<0x4E>(give); } \
            _Pragma("unroll") for (int i = 0; i < 2; ++i) { const int keep = (c & 4) ? a2[2 * i + 1] : a2[2 * i], give = (c & 4) ? a2[2 * i] : a2[2 * i + 1]; a3[i] = keep + __shfl_xor(give, 4); } \
            part[(tok) * 128 + 8 * c + g] = a3[0]; part[(tok) * 128 + 64 + 8 * c + g] = a3[1]; } while (0)
        PD_IDX(iA0, iA1, tok0); PD_IDX(iB0, iB1, tok0 + 1);
        PD_ROWS(wA, xA, iA0, iA1, tok0);
        for (int tt = 0; tt < PS_TG; tt += 2) { const size_t tok = tok0 + tt;
            PD_ROWS(wB, xB, iB0, iB1, tok + 1);
            const size_t t2 = tok + (tt + 2 < PS_TG ? 2 : 0), t3 = tok + (tt + 2 < PS_TG ? 3 : 1);
            PD_IDX(iA0, iA1, t2);
            PD_COMP(wA, xA, tok);
            if (tt + 2 < PS_TG) PD_ROWS(wA, xA, iA0, iA1, t2);
            PD_IDX(iB0, iB1, t3);
            PD_COMP(wB, xB, tok + 1);
        }
#undef PD_IDX
#undef PD_ROWS
#undef PD_COMP
    }
}
__device__ __forceinline__ void peer_coef_probe(const Frame& F, bool dry) {
    const int gw = F.vcu * 8 + F.wave, NGW = F.G * 8, lane = F.lane;
    for (int tok = gw; tok < T; tok += NGW) { int a0 = 0, a1 = 0; const int* pp = F.part + (size_t)tok * 128 + lane;
#pragma unroll
        for (int q = 0; q < PS_NSL; ++q) { a0 += pp[(size_t)q * T * 128]; a1 += pp[(size_t)q * T * 128 + 64]; }
        const float sc = F.rs2[tok] * F.sx[tok]; const float* gp = F.gate + (size_t)tok * 128 + lane; const int e0 = F.idx[(size_t)tok * 128 + lane], e1 = F.idx[(size_t)tok * 128 + 64 + lane];
        const float c0 = gp[0] * gelu_tanh((float)a0 * sc * F.sd[e0]) * F.su[e0], c1 = gp[64] * gelu_tanh((float)a1 * sc * F.sd[e1]) * F.su[e1];
        float m = fmaxf(fabsf(c0), fabsf(c1));
#pragma unroll
        for (int o = 1; o < 64; o <<= 1) m = fmaxf(m, __shfl_xor(m, o));
        const float inv = m > 0.f ? 127.f / m : 0.f; const int q0 = (int)rintf(c0 * inv), q1 = (int)rintf(c1 * inv);
        unsigned char* fp = (dry ? F.wsb + WS_PART + 256 * MiB : F.fq8) + (size_t)tok * 128;
        { const int k0 = lane, k1 = 64 + lane; fp[(8 * (k0 >> 5) + (k0 & 7)) * 4 + ((k0 >> 3) & 3)] = (unsigned char)q0; fp[(8 * (k1 >> 5) + (k1 & 7)) * 4 + ((k1 >> 3) & 3)] = (unsigned char)q1; }
        if (lane == 0 && !dry) F.csum[tok] = m * (1.f / 127.f); }
}
__device__ __forceinline__ void peer_up(const Frame& F, int cntw = 2048, bool dry = false) {
    const int lane = F.lane, g = lane >> 3, c = lane & 7; const unsigned x = xcc_id(); unsigned d = 0u; int q, tg; unsigned* cnt = (unsigned*)(F.wsb + WS_CTL) + cntw;
    const unsigned char* tab = F.up8;
    while (peer_claim(cnt, x, d, lane, q, tg)) {
        const unsigned slb = (unsigned)q * (16384u * 128u) + 16u * c; const int col0 = q * PS_CW + 16 * c; const size_t tok0 = (size_t)tg * PS_TG;
        u32x4 wA[16], wB[16]; int iA0, iA1, iB0, iB1, fqA, fqB, fA[4], fB[4]; float oA0, oA1, oB0, oB1;
#define PU_IDX(i0, i1, fq, o0, o1, tok) do { const size_t o_ = (tok) * 128; i0 = F.idx[o_ + lane]; i1 = F.idx[o_ + 64 + lane]; fq = *(const int*)(F.fq8 + o_ + 4 * (lane & 31)); \
            const float* op_ = F.out + (tok) * DM + col0 + g; o0 = op_[0]; o1 = op_[8]; } while (0)
#define PU_ROWS(W_, F_, i0, i1, fq) do { _Pragma("unroll") for (int j = 0; j < 16; ++j) { const unsigned e_ = (unsigned)bperm(8 * (j & 7) + g, j < 8 ? i0 : i1); W_[j] = *(const u32x4*)(tab + (e_ * 128u + slb)); } \
            _Pragma("unroll") for (int m_ = 0; m_ < 4; ++m_) F_[m_] = bperm(8 * m_ + g, fq); } while (0)
#define PU_T4(ACC_, R0, R1, R2, R3, FQ_) do { const unsigned t0_ = __builtin_amdgcn_perm(R1, R0, 0x05010400u), t1_ = __builtin_amdgcn_perm(R1, R0, 0x07030602u), t2_ = __builtin_amdgcn_perm(R3, R2, 0x05010400u), t3_ = __builtin_amdgcn_perm(R3, R2, 0x07030602u); \
            ACC_[0] = __builtin_amdgcn_sdot4((int)__builtin_amdgcn_perm(t2_, t0_, 0x05040100u), FQ_, ACC_[0], false); ACC_[1] = __builtin_amdgcn_sdot4((int)__builtin_amdgcn_perm(t2_, t0_, 0x07060302u), FQ_, ACC_[1], false); \
            ACC_[2] = __builtin_amdgcn_sdot4((int)__builtin_amdgcn_perm(t3_, t1_, 0x05040100u), FQ_, ACC_[2], false); ACC_[3] = __builtin_amdgcn_sdot4((int)__builtin_amdgcn_perm(t3_, t1_, 0x07060302u), FQ_, ACC_[3], false); } while (0)
#define PU_COMP(W_, F_, o0, o1, tok) do { int acc[16] = {}; \
            _Pragma("unroll") for (int m_ = 0; m_ < 4; ++m_) { int* a_ = acc; PU_T4(a_, W_[4 * m_].x, W_[4 * m_ + 1].x, W_[4 * m_ + 2].x, W_[4 * m_ + 3].x, F_[m_]); a_ = acc + 4; PU_T4(a_, W_[4 * m_].y, W_[4 * m_ + 1].y, W_[4 * m_ + 2].y, W_[4 * m_ + 3].y, F_[m_]); \
                a_ = acc + 8; PU_T4(a_, W_[4 * m_].z, W_[4 * m_ + 1].z, W_[4 * m_ + 2].z, W_[4 * m_ + 3].z, F_[m_]); a_ = acc + 12; PU_T4(a_, W_[4 * m_].w, W_[4 * m_ + 1].w, W_[4 * m_ + 2].w, W_[4 * m_ + 3].w, F_[m_]); } \
            int a1[8], a2[4], a3[2]; \
            _Pragma("unroll") for (int i = 0; i < 8; ++i) { const int keep = (g & 1) ? acc[2 * i + 1] : acc[2 * i], give = (g & 1) ? acc[2 * i] : acc[2 * i + 1]; a1[i] = keep + dppmovi<0x128>(give); } \
            _Pragma("unroll") for (int i = 0; i < 4; ++i) { const int keep = (g & 2) ? a1[2 * i + 1] : a1[2 * i], give = (g & 2) ? a1[2 * i] : a1[2 * i + 1]; a2[i] = keep + __shfl_xor(give, 16); } \
            _Pragma("unroll") for (int i = 0; i < 2; ++i) { const int keep = (g & 4) ? a2[2 * i + 1] : a2[2 * i], give = (g & 4) ? a2[2 * i] : a2[2 * i + 1]; a3[i] = keep + __shfl_xor(give, 32); } \
            const float sf_ = F.csum[tok]; float* dp_ = (dry ? (float*)(F.wsb + WS_PART) + ((tok) & 16383) * DM : F.out + (tok) * DM) + col0 + g; \
            dp_[0] = o0 + sf_ * (float)a3[0]; dp_[8] = o1 + sf_ * (float)a3[1]; } while (0)
        PU_IDX(iA0, iA1, fqA, oA0, oA1, tok0); PU_IDX(iB0, iB1, fqB, oB0, oB1, tok0 + 1);
        PU_ROWS(wA, fA, iA0, iA1, fqA);
        for (int tt = 0; tt < PS_TG; tt += 2) { const size_t tok = tok0 + tt;
            PU_ROWS(wB, fB, iB0, iB1, fqB);
            const float pA0 = oA0, pA1 = oA1;
            const bool more = tt + 2 < PS_TG; const size_t t2 = tok + (more ? 2 : 0), t3 = tok + (more ? 3 : 1);
            PU_IDX(iA0, iA1, fqA, oA0, oA1, t2);
            PU_COMP(wA, fA, pA0, pA1, tok);
            if (more) PU_ROWS(wA, fA, iA0, iA1, fqA);
            const float pB0 = oB0, pB1 = oB1;
            PU_IDX(iB0, iB1, fqB, oB0, oB1, t3);
            PU_COMP(wB, fB, pB0, pB1, tok + 1);
        }
#undef PU_IDX
#undef PU_ROWS
#undef PU_T4
#undef PU_COMP
    }
}

#define XB_TMO      128
#define XB_XCNT(j)  (256  + 64 * (j))
#define XB_XSUB(j)  (1280 + 64 * (j))
#define XB_XGEN(j)  (2304 + 64 * (j))
#define XB_TOP      3328
#define XB_TOPGEN   3392
#define XCD_BAR_WORDS 3456
#define XB_SPIN_CAP (1u << 18)

__device__ __forceinline__ unsigned xb_ld(unsigned* p)              { return __hip_atomic_load(p, __ATOMIC_RELAXED, __HIP_MEMORY_SCOPE_AGENT); }
__device__ __forceinline__ unsigned xb_add(unsigned* p, unsigned v) { return __hip_atomic_fetch_add(p, v, __ATOMIC_RELAXED, __HIP_MEMORY_SCOPE_AGENT); }
__device__ __forceinline__ unsigned xb_xcc_id() { return (unsigned)__builtin_amdgcn_s_getreg((3 << 11) | 20) & 0xFu; }
#define XB_SPIN(cond, bar) do { unsigned _sp = 0; while (cond) { __builtin_amdgcn_s_sleep(1); \
    if ((++_sp & 255u) == 0u) { if (xb_ld(&(bar)[XB_TMO])) break; if (_sp > XB_SPIN_CAP) { atomicAdd(&(bar)[XB_TMO], 1u); break; } } } } while (0)

struct XcdBarrier {
    unsigned* bar; unsigned x;
    volatile LAS unsigned* st;
};

__device__ __forceinline__ XcdBarrier xcd_barrier_post(unsigned* bar, volatile LAS unsigned* st) {
    XcdBarrier b; b.bar = bar; b.x = xb_xcc_id(); b.st = st;
    if (threadIdx.x == 0) (void)xb_add(&bar[XB_XCNT(b.x)], 1u);
    return b;
}
__device__ __forceinline__ void xcd_barrier_complete(unsigned* bar, unsigned x, unsigned& nloc, unsigned& nx) {
    const unsigned G = gridDim.x * gridDim.y * gridDim.z;
    unsigned sum, cnt, mine, sp = 0u;
    for (;;) {
        sum = 0u; cnt = 0u; mine = 0u;
#pragma unroll
        for (unsigned j = 0; j < 16; ++j) { const unsigned c = xb_ld(&bar[XB_XCNT(j)]); sum += c; cnt += (c > 0u) ? 1u : 0u; mine = (j == x) ? c : mine; }
        if (sum == G) break;
        __builtin_amdgcn_s_sleep(1);
        if ((++sp & 255u) == 0u) { if (xb_ld(&bar[XB_TMO])) break; if (sp > XB_SPIN_CAP) { atomicAdd(&bar[XB_TMO], 1u); break; } }
    }
    nloc = mine > 0u ? mine : 1u; nx = cnt > 0u ? cnt : 1u;
}

__device__ __forceinline__ void xcd_barrier(const XcdBarrier& b) {
    asm volatile("s_waitcnt vmcnt(0)" ::: "memory");
    __syncthreads();
    if (threadIdx.x == 0) {
        unsigned* bar = b.bar;
        __builtin_amdgcn_s_waitcnt(0);
        unsigned nloc = b.st[0], nx = b.st[1];
        if (nloc == 0u) { xcd_barrier_complete(bar, b.x, nloc, nx); b.st[0] = nloc; b.st[1] = nx; }
        const unsigned old = xb_add(&bar[XB_XSUB(b.x)], 1u);
        const unsigned gen = old / nloc;
        if (old + 1u == (gen + 1u) * nloc) {
            __builtin_amdgcn_fence(__ATOMIC_RELEASE, "agent");
            asm volatile("s_waitcnt vmcnt(0)" ::: "memory");
            const unsigned og = xb_add(&bar[XB_TOP], 1u);
            const unsigned tg = og / nx;
            if (og + 1u == (tg + 1u) * nx) xb_add(&bar[XB_TOPGEN], 1u);
            else XB_SPIN(xb_ld(&bar[XB_TOPGEN]) == tg, bar);
            __builtin_amdgcn_fence(__ATOMIC_ACQUIRE, "agent");
            xb_add(&bar[XB_XGEN(b.x)], 1u);
            asm volatile("s_waitcnt vmcnt(0)" ::: "memory");
        } else {
            XB_SPIN(xb_ld(&bar[XB_XGEN(b.x)]) == gen, bar);
            __builtin_amdgcn_fence(__ATOMIC_ACQUIRE, "agent");
            asm volatile("s_waitcnt vmcnt(0)" ::: "memory");
        }
    }
    __syncthreads();
}

struct Args { const float* in[16]; float* out; unsigned char* ws; int ph_lo, ph_hi, coop, pad; };
__global__ void __launch_bounds__(512, 2) fwd_kernel(Args args) {
    extern __shared__ __attribute__((aligned(16))) unsigned char lds_raw[];
    Frame F;
    F.lds = (LAS unsigned char*)lds_raw; F.ldsg = (char*)lds_raw;
    F.tid = threadIdx.x; F.lane = F.tid & 63; F.wave = __builtin_amdgcn_readfirstlane(F.tid >> 6);
    F.G = gridDim.x; { const int bx = blockIdx.x; F.vcu = (F.G % 8 == 0) ? (bx % 8) * (F.G / 8) + bx / 8 : bx; }
    F.x = args.in[0]; F.norm1_g = args.in[1]; F.w_in = args.in[2]; F.up_f = args.in[3]; F.bias_f = args.in[4]; F.up_b = args.in[5]; F.bias_b = args.in[6]; F.out_g = args.in[7];
    F.qn_g = args.in[8]; F.kn_g = args.in[9]; F.w_out = args.in[10]; F.norm2_g = args.in[11]; F.w_query = args.in[12]; F.sub_keys = args.in[13]; F.peer_down = args.in[14]; F.peer_up = args.in[15];
    F.out = args.out; unsigned char* ws = args.ws; F.wsb = ws;
    F.rope = (f32x2*)(ws + WS_ROPE); F.rs1 = (float*)(ws + WS_RS1); F.rs2 = (float*)(ws + WS_RS2); F.ssp = (float*)(ws + WS_SSP); F.dec = (float*)(ws + WS_DEC); F.lp = (float*)(ws + WS_LP);
    F.gate = (float*)(ws + WS_GATE); F.part = (int*)(ws + WS_PART); F.sd = (float*)(ws + WS_CTL + 65536); F.su = (float*)(ws + WS_CTL + 131072); F.sx = (float*)(ws + WS_RS2 + 131072); F.csum = (float*)(ws + WS_RS2 + 262144);
    F.down8 = ws + WS_DOWN; F.up8 = ws + WS_UP; F.xq8 = ws + WS_XB; F.fq8 = ws + WS_XB + 64 * MiB; F.idx = (int*)(ws + WS_IDX); F.state = (float*)((unsigned char*)args.out + OUT_ST);
    F.WinT = (bf16_t*)(ws + WS_WIN); F.Win8 = ws + WS_WIN; F.xq1 = ws + WS_OP1; F.sw = (float*)(ws + WS_CTL + 196608); F.WoT = (bf16_t*)(ws + WS_WO); F.WqT = (bf16_t*)(ws + WS_WQ); F.SK = (bf16_t*)(ws + WS_SK); F.down16 = (bf16_t*)(ws + WS_DOWN); F.up16 = (bf16_t*)(ws + WS_UP);
    F.xb = (bf16_t*)(ws + WS_XB); F.mixed = (bf16_t*)(ws + WS_XB); F.h = (bf16_t*)(ws + WS_H); F.x1b = (bf16_t*)(ws + WS_X1B); F.qry = (bf16_t*)(ws + WS_QRY);
    F.op0 = (bf16_t*)((unsigned char*)args.out + OUT_OP0); F.op1 = (bf16_t*)(ws + WS_OP1); F.op2 = (bf16_t*)(ws + WS_OP2);
    constexpr int MISC_OFF = 131072 + 320;
    for (int u = F.tid; u < 64; u += 512) ((LAS unsigned*)(F.lds + MISC_OFF))[u] = 0u;
    __syncthreads();
    XcdBarrier bar = xcd_barrier_post((unsigned*)(ws + WS_CTL) + 8192, (volatile LAS unsigned*)(F.lds + MISC_OFF) + 8);
    const int lo = args.ph_lo, hi = args.ph_hi;
#ifndef PH_MASK
#define PH_MASK 0x7ff
#endif
#ifndef PROBE_PHASE
#define PROBE_PHASE -1
#endif
#define REP(k) for (int rep_ = 0; rep_ < ((PROBE_PHASE == (k)) ? 2 : 1); ++rep_)
#define IN(k) (((PH_MASK >> (k)) & 1) && lo <= (k) && (k) < hi)
#define SEAM(k) do { if (IN(k) && IN((k) + 1)) { if (args.coop) { if ((k) == 0) cg::this_grid().sync(); else xcd_barrier(bar); } } } while (0)
    if (IN(0)) { REP(0) phase0(F); } SEAM(0);
#define GEMM1_BODY { pg8::Gemm g{(const pg8::bf16_t*)F.xq1, (const pg8::bf16_t*)F.Win8, T, HP, DM / 2}; pg8::StaticOrder S; S.init(T, HP, F.G, (int)blockIdx.x); pg8::EpiI8Bf16 E{F.h, HP, F.rs1, F.sw}; \
        pg8::gemm_phase<pg8::EpiI8Bf16, pg8::StaticOrder, PG8_ALIGN, PG8_SP2, true>(F.lds, g, S, E); }
    if (IN(1)) { GEMM1_BODY; if (PROBE_PHASE == 1) GEMM1_BODY; } SEAM(1);
    if (IN(2)) { qknorm_rope(F); REP(2) for (int it = F.vcu; it < 2048; it += F.G) gla_passA(F, it); } SEAM(2);
    if (IN(3)) { for (int it = F.vcu; it < 256; it += F.G) gla_scan(F, it); REP(3) attn_phase(F); } SEAM(3);
    if (IN(4)) REP(4) { for (int it = F.vcu; it < 2048; it += F.G) gla_passC(F, it); dil_combine(F); } SEAM(4);
#define GEMM5_BODY { pg8::Gemm g{F.mixed, F.WoT, T, DM, DM}; pg8::StaticOrder S; S.init(T, DM, F.G, (int)blockIdx.x); pg8::EpiResid E{F.x, F.out, F.x1b, F.ssp, DM}; \
        pg8::gemm_phase<pg8::EpiResid, pg8::StaticOrder, PG8_ALIGN, PG8_SP2>(F.lds, g, S, E); }
#define GEMM6_BODY { pg8::Gemm g{F.x1b, F.WqT, T, DM, DM}; pg8::StaticOrder S; S.init(T, DM, F.G, (int)blockIdx.x); pg8::EpiRowScaleBf16 E{F.qry, DM, nullptr}; \
        pg8::gemm_phase<pg8::EpiRowScaleBf16, pg8::StaticOrder, PG8_ALIGN, PG8_SP2>(F.lds, g, S, E); }
    if (IN(5)) { GEMM5_BODY; if (PROBE_PHASE == 5) GEMM5_BODY; } SEAM(5);
    if (IN(6)) { GEMM6_BODY; if (PROBE_PHASE == 6) GEMM6_BODY; } SEAM(6);
    if (IN(7)) REP(7) { const int gw = F.vcu * 8 + F.wave, NGW = F.G * 8; for (int it = gw; it < (T / 32) * 8; it += NGW) topk_item(F, it); if (rep_ == 0) peer_quant_x(F); } SEAM(7);
    if (IN(8)) { if (PROBE_PHASE == 8) peer_down(F, 3072); peer_down(F); } SEAM(8);
    if (IN(9)) { REP(9) peer_coef_probe(F, (PROBE_PHASE == 9) && rep_ == 0); } SEAM(9);
    if (IN(10)) { if (PROBE_PHASE == 10) peer_up(F, 3584, true); peer_up(F); }
#undef IN
#undef SEAM
}

#ifndef MK_N_LAUNCHES
#define MK_N_LAUNCHES 1
#endif
extern "C" void kernel_launch(void* const* d_in, const int* in_sizes, int n_in, void* d_out, int out_size, void* d_ws, size_t ws_size, hipStream_t stream) {
    static int grid = 0;
    if (grid == 0) {
        if (n_in != 16 || in_sizes[0] != T * DM || out_size != T * DM || ws_size < WS_END) { fprintf(stderr, "kernel_launch: unexpected shapes (n_in %d, in0 %d, out %d, ws %zu)\n", n_in, n_in > 0 ? in_sizes[0] : -1, out_size, ws_size); grid = -1; return; }
        int dev = 0, cus = 0, per_cu = 0;
        if (hipGetDevice(&dev) != hipSuccess || hipDeviceGetAttribute(&cus, hipDeviceAttributeMultiprocessorCount, dev) != hipSuccess) { grid = -1; return; }
        if (hipFuncSetAttribute((const void*)fwd_kernel, hipFuncAttributeMaxDynamicSharedMemorySize, LDS_BYTES) != hipSuccess) { fprintf(stderr, "kernel_launch: hipFuncSetAttribute failed\n"); grid = -1; return; }
        if (hipOccupancyMaxActiveBlocksPerMultiprocessor(&per_cu, (const void*)fwd_kernel, 512, LDS_BYTES) != hipSuccess || per_cu < 1) { fprintf(stderr, "kernel_launch: occupancy query says %d\n", per_cu); per_cu = 1; }
        (void)hipGetLastError();
        grid = cus;
    }
    if (grid < 0) return;
    if (hipMemsetAsync(d_ws, 0, 65536, stream) != hipSuccess) { fprintf(stderr, "kernel_launch: hipMemsetAsync failed\n"); return; }
    Args a{};
    for (int i = 0; i < 16; ++i) a.in[i] = (const float*)d_in[i];
    a.out = (float*)d_out; a.ws = (unsigned char*)d_ws;
    if (MK_N_LAUNCHES == 1) {
        a.ph_lo = 0; a.ph_hi = NPHASE; a.coop = 1; void* kargs[] = {&a};
        hipError_t e = hipLaunchCooperativeKernel((const void*)fwd_kernel, dim3(grid), dim3(512), kargs, LDS_BYTES, stream);
        if (e != hipSuccess) fprintf(stderr, "kernel_launch: cooperative launch failed: %s (grid %d)\n", hipGetErrorString(e), grid);
    } else {
        for (int p = 0; p < NPHASE; ++p) { a.ph_lo = p; a.ph_hi = p + 1; a.coop = 0; hipLaunchKernelGGL(fwd_kernel, dim3(grid), dim3(512), LDS_BYTES, stream, a); }
        const hipError_t le = hipPeekAtLastError(); if (le != hipSuccess) fprintf(stderr, "kernel_launch: launch failed: %s\n", hipGetErrorName(le));
    }
}
```

```cpp
#include <hip/hip_runtime.h>
#include <hip/hip_cooperative_groups.h>
#include <cstdio>
#include <cstdint>
namespace cg = cooperative_groups;
namespace pg8 {
#define PG8_LAS __attribute__((address_space(3)))
typedef unsigned short bf16_t;
typedef short bf16x8 __attribute__((ext_vector_type(8)));
typedef float f32x4 __attribute__((ext_vector_type(4)));
typedef unsigned u32x4 __attribute__((ext_vector_type(4)));
constexpr int BM = 256, BK = 64, HALF = 128, HTB = HALF * BK * 2  , STAGE_BYTES = 8 * HTB, NXCD = 8, WGM = 8;

__host__ __device__ __forceinline__ int lds_byte(int r, int c) { const int st = (r >> 4) * 2 + (c >> 5), rr = r & 15, cc = c & 31, ob = rr * 64 + cc * 2; return st * 1024 + (ob ^ (((ob >> 9) & 1) << 5)); }
__host__ __device__ __forceinline__ void stage_rc(int b, int& R, int& C) { const int st = b / 1024, sb = b % 1024, swz = sb ^ (((sb >> 9) & 1) << 5); R = (st >> 1) * 16 + swz / 64; C = (st & 1) * 32 + (swz % 64) / 2; }
__host__ __device__ __forceinline__ int perm32(int rho) { const int n = rho >> 4, i = rho & 15; return 8 * (i >> 2) + 4 * n + (i & 3); }

struct Unit { int pm, pn; };
struct Gemm { const bf16_t* A; const bf16_t* Bt; int M, N, K; };

struct StaticOrder {
    int nM, nN, nwg, G, c;
    __host__ __device__ void init(int M, int N, int G_, int c_) { nM = M / BM; nN = N / BM; nwg = nM * nN; G = G_; c = c_; }
    __host__ __device__ bool next(int i, Unit& u) const {
        const long L = (long)i * G + c; if (L >= nwg) return false;
        int wgid = (int)L; { const int q = nwg / NXCD, r = nwg % NXCD, xcd = wgid % NXCD, off = wgid / NXCD; wgid = (xcd < r ? xcd * (q + 1) : r * (q + 1) + (xcd - r) * q) + off; }
        const int nig = WGM * nN, gid = wgid / nig, fm = gid * WGM, gsz = (nM - fm) < WGM ? (nM - fm) : WGM;
        u.pm = fm + ((wgid % nig) % gsz); u.pn = (wgid % nig) / gsz; return true;
    }
    __device__ __forceinline__ void a_ready(const Unit&) const {}
    __device__ __forceinline__ void done(const Unit&) const {}
};
__device__ __forceinline__ unsigned cvt_pk_bf16(float lo, float hi) { unsigned r; asm volatile("v_cvt_pk_bf16_f32 %0, %1, %2" : "=v"(r) : "v"(lo), "v"(hi)); return r; }
typedef int i32x4 __attribute__((ext_vector_type(4)));
template <bool I8> struct AccT { typedef f32x4 type; };
template <> struct AccT<true> { typedef i32x4 type; };
struct EpiRowScaleBf16 {
    static constexpr bool PERM = true, AFTER_DRAIN = false;
    bf16_t* O; int ldc; const float* rs;
    __device__ __forceinline__ void operator()(const f32x4 (&acc)[2][2][4][2], const Unit& u, int wr, int wc, int fr, int fq) const {
        const int row0 = u.pm * BM + wr * 64 + fr, col0 = u.pn * BM + wc * 32 + 8 * fq;
#pragma unroll
        for (int ai = 0; ai < 2; ++ai)
#pragma unroll
            for (int m = 0; m < 4; ++m) { const int row = row0 + ai * HALF + m * 16; const float s = rs ? rs[row] : 1.f; bf16_t* rowp = O + (size_t)row * ldc + col0;
#pragma unroll
                for (int bj = 0; bj < 2; ++bj) { const f32x4 v0 = acc[ai][bj][m][0] * s, v1 = acc[ai][bj][m][1] * s;
                    u32x4 w; w.x = cvt_pk_bf16(v0[0], v0[1]); w.y = cvt_pk_bf16(v0[2], v0[3]); w.z = cvt_pk_bf16(v1[0], v1[1]); w.w = cvt_pk_bf16(v1[2], v1[3]);
                    *(u32x4*)(rowp + bj * HALF) = w; } }
    }
};
struct EpiI8Bf16 {
    static constexpr bool PERM = true, AFTER_DRAIN = false;
    bf16_t* O; int ldc; const float* rs; const float* cs;
    __device__ __forceinline__ void operator()(const i32x4 (&acc)[2][2][4][2], const Unit& u, int wr, int wc, int fr, int fq) const {
        const int row0 = u.pm * BM + wr * 64 + fr, col0 = u.pn * BM + wc * 32 + 8 * fq;
        f32x4 cv[2][2];
#pragma unroll
        for (int bj = 0; bj < 2; ++bj) { cv[bj][0] = *(const f32x4*)(cs + col0 + bj * HALF); cv[bj][1] = *(const f32x4*)(cs + col0 + bj * HALF + 4); }
#pragma unroll
        for (int ai = 0; ai < 2; ++ai)
#pragma unroll
            for (int m = 0; m < 4; ++m) { const int row = row0 + ai * HALF + m * 16; const float s = rs[row]; bf16_t* rowp = O + (size_t)row * ldc + col0;
#pragma unroll
                for (int bj = 0; bj < 2; ++bj) { const i32x4 a0 = acc[ai][bj][m][0], a1 = acc[ai][bj][m][1]; const f32x4 c0 = cv[bj][0] * s, c1 = cv[bj][1] * s;
                    u32x4 w; w.x = cvt_pk_bf16((float)a0[0] * c0[0], (float)a0[1] * c0[1]); w.y = cvt_pk_bf16((float)a0[2] * c0[2], (float)a0[3] * c0[3]);
                    w.z = cvt_pk_bf16((float)a1[0] * c1[0], (float)a1[1] * c1[1]); w.w = cvt_pk_bf16((float)a1[2] * c1[2], (float)a1[3] * c1[3]);
                    *(u32x4*)(rowp + bj * HALF) = w; } }
    }
};
struct EpiResid {
    static constexpr bool PERM = true, AFTER_DRAIN = false;
    const float* x; float* out; bf16_t* xb; float* ssp; int ldc;
    __device__ __forceinline__ void operator()(const f32x4 (&acc)[2][2][4][2], const Unit& u, int wr, int wc, int fr, int fq) const {
        const int row0 = u.pm * BM + wr * 64 + fr, col0 = u.pn * BM + wc * 32 + 8 * fq;
#pragma unroll
        for (int ai = 0; ai < 2; ++ai)
#pragma unroll
            for (int m = 0; m < 4; ++m) { const int row = row0 + ai * HALF + m * 16; const size_t off = (size_t)row * ldc + col0; float ss = 0.f;
#pragma unroll
                for (int bj = 0; bj < 2; ++bj) { const f32x4 xa = *(const f32x4*)(x + off + bj * HALF), xc = *(const f32x4*)(x + off + bj * HALF + 4);
                    const f32x4 v0 = acc[ai][bj][m][0] + xa, v1 = acc[ai][bj][m][1] + xc;
                    *(f32x4*)(out + off + bj * HALF) = v0; *(f32x4*)(out + off + bj * HALF + 4) = v1;
                    u32x4 w; w.x = cvt_pk_bf16(v0[0], v0[1]); w.y = cvt_pk_bf16(v0[2], v0[3]); w.z = cvt_pk_bf16(v1[0], v1[1]); w.w = cvt_pk_bf16(v1[2], v1[3]);
                    *(u32x4*)(xb + off + bj * HALF) = w;
                    ss += (v0[0] * v0[0] + v0[1] * v0[1]) + (v0[2] * v0[2] + v0[3] * v0[3]) + (v1[0] * v1[0] + v1[1] * v1[1]) + (v1[2] * v1[2] + v1[3] * v1[3]); }
                ss += __shfl_xor(ss, 16); ss += __shfl_xor(ss, 32);
                if (fq == 0) ssp[(size_t)row * 32 + u.pn * 4 + wc] = ss; }
    }
};
template <class Epi, class Sched, bool ALIGN_EPI = false, bool SP2 = false, bool I8 = false>
__device__ __forceinline__ void gemm_phase(PG8_LAS unsigned char* lds, const Gemm g, const Sched& S, const Epi& E) {
    const int tid = threadIdx.x, wid = __builtin_amdgcn_readfirstlane(tid >> 6), lane = tid & 63, wr = wid >> 2, wc = wid & 3, fr = lane & 15, fq = lane >> 4;
    const int K = g.K, nt = K / BK;
    unsigned voffA[2], voffB[2];
#pragma unroll
    for (int i = 0; i < 2; ++i) { int R, C; stage_rc(tid * 16 + i * 8192, R, C); const int Rb = Epi::PERM ? ((R & ~31) + perm32(R & 31)) : R;
        voffA[i] = (unsigned)(R * K + C) * 2u; voffB[i] = (unsigned)(Rb * K + C) * 2u; }
    const size_t kstep = (size_t)(BK * 2);
    const size_t hstep = (size_t)HALF * K * 2;
    const size_t tstep = 2 * hstep;
    const unsigned ldsw = (unsigned)wid * 1024u;
    const int aoff = lds_byte(wr * 64 + fr, fq * 8), boff = lds_byte(wc * 32 + fr, fq * 8);
#define PG8_SA(b, h) (((b) * 2 + (h)) * HTB)
#define PG8_SB(b, h) ((4 + (b) * 2 + (h)) * HTB)
#define PG8_STAGE(bufoff, gbase, voff) do { _Pragma("unroll") for (int _i = 0; _i < 2; ++_i) \
        __builtin_amdgcn_global_load_lds((const unsigned*)((const char*)(gbase) + (voff)[_i]), (PG8_LAS unsigned*)(lds + (bufoff) + ldsw + _i * 8192), 16, 0, 0); } while (0)
#define PG8_LDA(dst, b, h) do { _Pragma("unroll") for (int m = 0; m < 4; ++m) _Pragma("unroll") for (int k = 0; k < 2; ++k) dst[m][k] = *(const PG8_LAS bf16x8*)(lds + PG8_SA(b, h) + aoff + m * 2048 + k * 1024); } while (0)
#define PG8_LDB(dst, b, h) do { _Pragma("unroll") for (int n = 0; n < 2; ++n) _Pragma("unroll") for (int k = 0; k < 2; ++k) dst[n][k] = *(const PG8_LAS bf16x8*)(lds + PG8_SB(b, h) + boff + n * 2048 + k * 1024); } while (0)
#define PG8_MMA(ai, bj, At, Bt) do { __builtin_amdgcn_s_setprio(1); _Pragma("unroll") for (int m = 0; m < 4; ++m) _Pragma("unroll") for (int n = 0; n < 2; ++n) _Pragma("unroll") for (int k = 0; k < 2; ++k) { \
        if constexpr (I8) acc[ai][bj][m][n] = __builtin_amdgcn_mfma_i32_16x16x64_i8(__builtin_bit_cast(i32x4, Bt[n][k]), __builtin_bit_cast(i32x4, At[m][k]), acc[ai][bj][m][n], 0, 0, 0); \
        else acc[ai][bj][m][n] = __builtin_amdgcn_mfma_f32_16x16x32_bf16(Bt[n][k], At[m][k], acc[ai][bj][m][n], 0, 0, 0); } __builtin_amdgcn_s_setprio(0); } while (0)
#define PG8_WAIT_V(n) asm volatile("s_waitcnt vmcnt(" #n ")" ::: "memory")
#define PG8_WAIT_L(n) asm volatile("s_waitcnt lgkmcnt(" #n ")" ::: "memory")
#define PG8_BAR __builtin_amdgcn_s_barrier()
#define PG8_SCHED __builtin_amdgcn_sched_barrier(0)
    Unit cur, nxt; int ui = 0;
    if (!S.next(0, cur)) return;
    typename AccT<I8>::type acc[2][2][4][2];
#pragma unroll
    for (int a = 0; a < 2; ++a)
#pragma unroll
        for (int b = 0; b < 2; ++b)
#pragma unroll
            for (int m = 0; m < 4; ++m)
#pragma unroll
                for (int n = 0; n < 2; ++n) acc[a][b][m][n] = (typename AccT<I8>::type){};
    bf16x8 At[4][2], B0[2][2], B1[2][2];
    const char* cA = (const char*)g.A + (size_t)cur.pm * tstep; const char* cB = (const char*)g.Bt + (size_t)cur.pn * tstep;
    S.a_ready(cur);
    if constexpr (SP2) {
        PG8_STAGE(PG8_SB(0, 0), cB, voffB); PG8_STAGE(PG8_SB(0, 1), cB + hstep, voffB); PG8_STAGE(PG8_SA(0, 0), cA, voffA); PG8_STAGE(PG8_SA(0, 1), cA + hstep, voffA);
        if (wr == 1) PG8_BAR;
        PG8_WAIT_V(2); PG8_BAR;
        PG8_STAGE(PG8_SB(1, 0), cB + kstep, voffB); PG8_STAGE(PG8_SA(1, 0), cA + kstep, voffA); PG8_STAGE(PG8_SB(1, 1), cB + hstep + kstep, voffB);
        PG8_WAIT_V(6); PG8_BAR;
    } else {
        PG8_STAGE(PG8_SB(0, 0), cB, voffB); PG8_STAGE(PG8_SA(0, 0), cA, voffA); PG8_STAGE(PG8_SB(0, 1), cB + hstep, voffB); PG8_STAGE(PG8_SA(0, 1), cA + hstep, voffA);
        if (wr == 1) PG8_BAR;
        PG8_WAIT_V(4); PG8_BAR;
        PG8_STAGE(PG8_SB(1, 0), cB + kstep, voffB); PG8_STAGE(PG8_SA(1, 0), cA + kstep, voffA); PG8_STAGE(PG8_SB(1, 1), cB + hstep + kstep, voffB);
        PG8_WAIT_V(6); PG8_BAR;
    }
    for (;;) {
        const bool has_next = S.next(ui + 1, nxt);
        const char* nA = has_next ? (const char*)g.A + (size_t)nxt.pm * tstep : cA; const char* nB = has_next ? (const char*)g.Bt + (size_t)nxt.pn * tstep : cB;
        for (int t = 0; t < nt; t += 2) {
            const bool last = (t == nt - 2);
            const char* a1 = cA + (size_t)(t + 1) * kstep;
            const char* a2 = last ? nA : cA + (size_t)(t + 2) * kstep; const char* b2 = last ? nB : cB + (size_t)(t + 2) * kstep;
            const char* a3 = a2 + kstep; const char* b3 = b2 + kstep;
            if (last && has_next) S.a_ready(nxt);
            if constexpr (SP2) {
            PG8_LDB(B0, 0, 0); PG8_LDB(B1, 0, 1); PG8_SCHED; PG8_LDA(At, 0, 0); PG8_STAGE(PG8_SA(1, 1), a1 + hstep, voffA);
            PG8_WAIT_V(8); PG8_WAIT_L(0); PG8_BAR; PG8_MMA(0, 0, At, B0); PG8_MMA(0, 1, At, B1); PG8_BAR; PG8_SCHED;
            PG8_LDA(At, 0, 1); PG8_STAGE(PG8_SB(0, 0), b2, voffB); PG8_STAGE(PG8_SB(0, 1), b2 + hstep, voffB); PG8_STAGE(PG8_SA(0, 0), a2, voffA);
            PG8_WAIT_V(8); PG8_WAIT_L(0); PG8_BAR; PG8_MMA(1, 0, At, B0); PG8_MMA(1, 1, At, B1); PG8_BAR; PG8_SCHED;
            PG8_LDB(B0, 1, 0); PG8_LDB(B1, 1, 1); PG8_SCHED; PG8_LDA(At, 1, 0); PG8_STAGE(PG8_SA(0, 1), a2 + hstep, voffA);
            PG8_WAIT_V(8); PG8_WAIT_L(0); PG8_BAR; PG8_MMA(0, 0, At, B0); PG8_MMA(0, 1, At, B1); PG8_BAR; PG8_SCHED;
            PG8_LDA(At, 1, 1); PG8_STAGE(PG8_SB(1, 0), b3, voffB); PG8_STAGE(PG8_SB(1, 1), b3 + hstep, voffB); PG8_STAGE(PG8_SA(1, 0), a3, voffA);
            PG8_WAIT_V(8); PG8_WAIT_L(0); PG8_BAR; PG8_MMA(1, 0, At, B0); PG8_MMA(1, 1, At, B1); PG8_BAR; PG8_SCHED;
            } else {
            PG8_LDB(B0, 0, 0); PG8_SCHED; PG8_LDA(At, 0, 0); PG8_STAGE(PG8_SA(1, 1), a1 + hstep, voffA);
            PG8_WAIT_L(8); PG8_BAR; PG8_WAIT_L(0); PG8_MMA(0, 0, At, B0); PG8_BAR; PG8_SCHED;
            PG8_LDB(B1, 0, 1); PG8_STAGE(PG8_SB(0, 0), b2, voffB);
            PG8_BAR; PG8_WAIT_L(0); PG8_MMA(0, 1, At, B1); PG8_BAR;
            PG8_LDA(At, 0, 1); PG8_STAGE(PG8_SA(0, 0), a2, voffA);
            PG8_BAR; PG8_WAIT_L(0); PG8_MMA(1, 0, At, B0); PG8_BAR; PG8_SCHED;
            PG8_STAGE(PG8_SB(0, 1), b2 + hstep, voffB);
            PG8_WAIT_V(6); PG8_BAR; PG8_MMA(1, 1, At, B1); PG8_BAR;
            PG8_LDB(B0, 1, 0); PG8_SCHED; PG8_LDA(At, 1, 0); PG8_STAGE(PG8_SA(0, 1), a2 + hstep, voffA);
            PG8_WAIT_L(8); PG8_BAR; PG8_WAIT_L(0); PG8_MMA(0, 0, At, B0); PG8_BAR; PG8_SCHED;
            PG8_LDB(B1, 1, 1); PG8_STAGE(PG8_SB(1, 0), b3, voffB);
            PG8_BAR; PG8_WAIT_L(0); PG8_MMA(0, 1, At, B1); PG8_BAR;
            PG8_LDA(At, 1, 1); PG8_STAGE(PG8_SA(1, 0), a3, voffA);
            PG8_BAR; PG8_WAIT_L(0); PG8_MMA(1, 0, At, B0); PG8_BAR; PG8_SCHED;
            PG8_STAGE(PG8_SB(1, 1), b3 + hstep, voffB);
            PG8_WAIT_V(6); PG8_BAR; PG8_MMA(1, 1, At, B1); PG8_BAR;
            }
        }
        if constexpr (ALIGN_EPI) { if (wr == 0) PG8_BAR; }
        if constexpr (!Epi::AFTER_DRAIN) { E(acc, cur, wr, wc, fr, fq); S.done(cur); }
        if (!has_next) break;
#pragma unroll
        for (int a = 0; a < 2; ++a)
#pragma unroll
            for (int b = 0; b < 2; ++b)
#pragma unroll
                for (int m = 0; m < 4; ++m)
#pragma unroll
                    for (int n = 0; n < 2; ++n) acc[a][b][m][n] = (typename AccT<I8>::type){};
        cur = nxt; cA = nA; cB = nB; ++ui;
        if constexpr (ALIGN_EPI) { if (wr == 1) PG8_BAR; }
    }
    PG8_WAIT_V(0);
    if constexpr (!ALIGN_EPI) { if (wr == 0) PG8_BAR; }
    PG8_BAR;
    if constexpr (Epi::AFTER_DRAIN) { E.fused(acc, cur, wr, wc, fr, fq, lds, wid, lane); S.done(cur); }
#undef PG8_SA
#undef PG8_SB
#undef PG8_STAGE
#undef PG8_LDA
#undef PG8_LDB
#undef PG8_MMA
#undef PG8_WAIT_V
#undef PG8_WAIT_L
#undef PG8_BAR
#undef PG8_SCHED
}
}
#ifndef PG8_SP2
#define PG8_SP2 true
#endif
#ifndef PG8_ALIGN
#define PG8_ALIGN true
#endif

constexpr int BATCH = 2, SEQ = 16384, DM = 2048, T = BATCH * SEQ;
constexpr int INW = 6176, HP = 6400;
constexpr int C_QA = 0, C_KA = 256, C_VA = 512, C_RA = 1024, C_QD = 1536, C_KD = 3072, C_VD = 4608, C_GF = 6144;
constexpr int NHD = 12;
constexpr float EPS = 1e-6f;
constexpr float LOG2E = 1.4426950408889634f;
constexpr float QSCALE = 0.08838834764831845f * LOG2E;
constexpr int NPHASE = 11;

constexpr size_t MiB = 1u << 20;
constexpr size_t WS_CTL = 0, WS_ROPE = 1 * MiB, WS_RS1 = 3 * MiB, WS_RS2 = 3 * MiB + 512 * 1024, WS_SSP = 4 * MiB, WS_WIN = 8 * MiB, WS_WO = 33 * MiB, WS_WQ = 41 * MiB,
                 WS_SK = 49 * MiB, WS_DEC = 50 * MiB, WS_LP = 51 * MiB, WS_IDX = 56 * MiB, WS_GATE = 72 * MiB, WS_DOWN = 88 * MiB, WS_UP = 152 * MiB, WS_XB = 216 * MiB,
                 WS_H = 344 * MiB, WS_X1B = WS_H, WS_QRY = WS_H + 128 * MiB, WS_OP1 = 744 * MiB, WS_OP2 = 840 * MiB, WS_PART = 472 * MiB  , WS_END = 984 * MiB;
constexpr size_t OUT_ST = 0, OUT_OP0 = 128 * MiB;
constexpr int LDS_BYTES = 147456;

#define LAS __attribute__((address_space(3)))
typedef unsigned short bf16_t;
typedef short bf16x8 __attribute__((ext_vector_type(8)));
typedef short s16x4 __attribute__((ext_vector_type(4)));
typedef float f32x4 __attribute__((ext_vector_type(4)));
typedef float f32x2 __attribute__((ext_vector_type(2)));
typedef float f32x16 __attribute__((ext_vector_type(16)));
typedef unsigned u32x4 __attribute__((ext_vector_type(4)));
typedef unsigned u32x2 __attribute__((ext_vector_type(2)));
#define LDS_WAIT() asm volatile("s_waitcnt lgkmcnt(0)" ::: "memory")
#define SBAR() __builtin_amdgcn_sched_barrier(0)

__device__ __forceinline__ float bf2f(unsigned short b) { return __uint_as_float(((unsigned)b) << 16); }
__device__ __forceinline__ float bflo(unsigned w) { return __uint_as_float(w << 16); }
__device__ __forceinline__ float bfhi(unsigned w) { return __uint_as_float(w & 0xffff0000u); }
__device__ __forceinline__ unsigned f2bf(float f) { unsigned u = __float_as_uint(f); return (u + 0x7fffu + ((u >> 16) & 1u)) >> 16; }
__device__ __forceinline__ unsigned pk2(float lo, float hi) { return pg8::cvt_pk_bf16(lo, hi); }
__device__ __forceinline__ float fexp(float x) { return __builtin_amdgcn_exp2f(x * LOG2E); }
__device__ __forceinline__ float flog(float x) { return __builtin_amdgcn_logf(x) * 0.6931471805599453f; }
__device__ __forceinline__ float wave_sum(float v) {
#pragma unroll
    for (int o = 1; o < 64; o <<= 1) v += __shfl_xor(v, o);
    return v;
}
__device__ __forceinline__ int crow(int r, int hi) { return (r & 3) + 8 * (r >> 2) + 4 * hi; }

struct Frame {
    LAS unsigned char* lds; char* ldsg; unsigned char* wsb;
    int tid, lane, wave, vcu, G;
    const float *x, *norm1_g, *w_in, *up_f, *bias_f, *up_b, *bias_b, *out_g, *qn_g, *kn_g, *w_out, *norm2_g, *w_query, *sub_keys, *peer_down, *peer_up;
    float* out;
    f32x2* rope; float *rs1, *rs2, *ssp, *dec, *lp, *gate, *state, *sd, *su, *sx, *csum; int *idx, *part; unsigned char *down8, *up8, *xq8, *fq8;
    unsigned char *Win8, *xq1; float* sw; bf16_t *WinT, *WoT, *WqT, *SK, *down16, *up16, *xb, *mixed, *h, *x1b, *qry, *op0, *op1, *op2;
};

__device__ __forceinline__ void p0_transpose_item(const float* W, int K, int N, bf16_t* WT, int k0, int n0, int dst_row0, const float* g, LAS float* scr, int lane) {
#pragma unroll 8
    for (int i = 0; i < 32; ++i) { const int kk = 2 * i + (lane >> 5); float w = W[(size_t)(k0 + kk) * N + n0 + (lane & 31)]; if (g) w *= g[k0 + kk]; scr[kk * 33 + (lane & 31)] = w; }
    LDS_WAIT(); asm volatile("" ::: "memory");
    const int c = lane & 7;
#pragma unroll
    for (int j = 0; j < 4; ++j) { const int n = (lane >> 3) + 8 * j; const LAS float* s = scr + (8 * c) * 33 + n;
        u32x4 o; o.x = pk2(s[0 * 33], s[1 * 33]); o.y = pk2(s[2 * 33], s[3 * 33]); o.z = pk2(s[4 * 33], s[5 * 33]); o.w = pk2(s[6 * 33], s[7 * 33]);
        *(u32x4*)(WT + (size_t)(dst_row0 + n) * K + k0 + 8 * c) = o; }
    LDS_WAIT(); asm volatile("" ::: "memory");
}
template <bool isup> __device__ __forceinline__ void peer_quant_row(const Frame& F, int e) {
    const int lane = F.lane; const f32x4* src = (const f32x4*)((isup ? F.peer_up : F.peer_down) + (size_t)e * DM) + lane;
    f32x4 v[8]; float m = 0.f;
#pragma unroll
    for (int j = 0; j < 8; ++j) { v[j] = src[64 * j]; if (!isup) v[j] = v[j] * ((const f32x4*)F.norm2_g)[lane + 64 * j];
        m = fmaxf(fmaxf(m, fmaxf(fabsf(v[j][0]), fabsf(v[j][1]))), fmaxf(fabsf(v[j][2]), fabsf(v[j][3]))); }
#pragma unroll
    for (int o = 1; o < 64; o <<= 1) m = fmaxf(m, __shfl_xor(m, o));
    const float inv = m > 0.f ? 127.f / m : 0.f; unsigned char* dst = isup ? F.up8 : F.down8;
#pragma unroll
    for (int j = 0; j < 8; ++j) { unsigned w = 0u;
#pragma unroll
        for (int i = 0; i < 4; ++i) { const int qv = (int)rintf(v[j][i] * inv); w |= ((unsigned)qv & 0xffu) << (8 * i); }
        const int col = 4 * lane + 256 * j; *(unsigned*)(dst + ((size_t)(col >> 7) * 16384 + e) * 128 + (col & 127)) = w; }
    if (lane == 0) (isup ? F.su : F.sd)[e] = m * (1.f / 127.f);
}
__device__ __forceinline__ void phase0(const Frame& F) {
    LAS float* scr = (LAS float*)(F.lds + F.wave * 16384);
    const int gw = F.vcu * 8 + F.wave, NGW = F.G * 8, lane = F.lane;
    { LAS float* cmx = (LAS float*)(F.lds + 12288);
      for (int nb = F.vcu; nb < 193; nb += F.G) { const int n0 = nb * 32, drow = nb < 32 ? nb * 32 : (nb == 32 ? C_GF : nb * 32 - 32), kw = F.wave * 256;
        float m = 0.f;
#pragma unroll 16
        for (int i = 0; i < 128; ++i) { const int k = kw + 2 * i + (lane >> 5); m = fmaxf(m, fabsf(F.w_in[(size_t)k * INW + n0 + (lane & 31)] * F.norm1_g[k])); }
        m = fmaxf(m, __shfl_xor(m, 32)); if (lane < 32) cmx[F.wave * 32 + lane] = m;
        __syncthreads();
        if (F.tid < 32) { float mm = 0.f;
#pragma unroll
            for (int w = 0; w < 8; ++w) mm = fmaxf(mm, cmx[w * 32 + F.tid]);
            cmx[256 + F.tid] = mm > 0.f ? 127.f / mm : 0.f; F.sw[drow + F.tid] = mm * (1.f / 127.f); }
        __syncthreads();
        for (int ch = 0; ch < 4; ++ch) { const int k0 = kw + 64 * ch;
#pragma unroll 8
            for (int i = 0; i < 32; ++i) { const int kk = 2 * i + (lane >> 5); scr[kk * 33 + (lane & 31)] = F.w_in[(size_t)(k0 + kk) * INW + n0 + (lane & 31)] * F.norm1_g[k0 + kk] * cmx[256 + (lane & 31)]; }
            LDS_WAIT(); asm volatile("" ::: "memory");
            const int c = lane & 7;
#pragma unroll
            for (int j = 0; j < 4; ++j) { const int n = (lane >> 3) + 8 * j; const LAS float* sp = scr + (8 * c) * 33 + n; u32x2 w = {0u, 0u};
#pragma unroll
                for (int i = 0; i < 4; ++i) { w.x |= ((unsigned)(int)rintf(sp[i * 33]) & 0xffu) << (8 * i); w.y |= ((unsigned)(int)rintf(sp[(4 + i) * 33]) & 0xffu) << (8 * i); }
                *(u32x2*)(F.Win8 + (size_t)(drow + n) * DM + k0 + 8 * c) = w; }
            LDS_WAIT(); asm volatile("" ::: "memory"); }
        __syncthreads(); } }
    constexpr int I_O = 32 * 64, I_Q = 32 * 64;
    for (int it = gw; it < I_O + I_Q; it += NGW) {
        int r = it;
        if (r < I_O) { const int kb = r / 64, nb = r % 64; p0_transpose_item(F.w_out, DM, DM, F.WoT, kb * 64, nb * 32, nb * 32, nullptr, scr, lane); continue; }
        r -= I_O;
        { const int kb = r / 64, nb = r % 64; p0_transpose_item(F.w_query, DM, DM, F.WqT, kb * 64, nb * 32, nb * 32, F.norm2_g, scr, lane); }
    }
    const size_t gt = (size_t)gw * 64 + lane, NT = (size_t)NGW * 64;
    { u32x4* z = (u32x4*)(F.Win8 + (size_t)INW * DM); const u32x4 zero = {0u, 0u, 0u, 0u}; for (size_t i = gt; i < (size_t)(HP - INW) * DM / 16; i += NT) z[i] = zero; if (gt < (size_t)(HP - INW)) F.sw[INW + gt] = 0.f; }
    for (int r = gw; r < 16384; r += NGW) peer_quant_row<false>(F, r);
    for (int r = gw; r < 16384; r += NGW) peer_quant_row<true>(F, r);
    for (size_t i = gt; i < (size_t)8 * 2 * 128 * 128 / 8; i += NT) { const f32x4 a = *(const f32x4*)(F.sub_keys + i * 8), b = *(const f32x4*)(F.sub_keys + i * 8 + 4);
        u32x4 o; o.x = pk2(a[0], a[1]); o.y = pk2(a[2], a[3]); o.z = pk2(b[0], b[1]); o.w = pk2(b[2], b[3]); *(u32x4*)(F.SK + i * 8) = o; }
    for (int m = gw; m < T; m += NGW) { const f32x4* xr = (const f32x4*)(F.x + (size_t)m * DM) + lane; f32x4 v[8]; float s = 0.f, mx = 0.f;
#pragma unroll
        for (int j = 0; j < 8; ++j) { v[j] = xr[64 * j]; s += (v[j][0] * v[j][0] + v[j][1] * v[j][1]) + (v[j][2] * v[j][2] + v[j][3] * v[j][3]);
            mx = fmaxf(fmaxf(mx, fmaxf(fabsf(v[j][0]), fabsf(v[j][1]))), fmaxf(fabsf(v[j][2]), fabsf(v[j][3]))); }
        s = wave_sum(s);
#pragma unroll
        for (int o = 1; o < 64; o <<= 1) mx = fmaxf(mx, __shfl_xor(mx, o));
        const float inv = mx > 0.f ? 127.f / mx : 0.f; unsigned* o4 = (unsigned*)(F.xq1 + (size_t)m * DM) + lane;
#pragma unroll
        for (int j = 0; j < 8; ++j) { unsigned w = 0u;
#pragma unroll
            for (int i = 0; i < 4; ++i) w |= ((unsigned)(int)rintf(v[j][i] * inv) & 0xffu) << (8 * i);
            o4[64 * j] = w; }
        if (lane == 0) F.rs1[m] = __builtin_amdgcn_rsqf(s * (1.f / DM) + EPS) * (mx * (1.f / 127.f)); }
    { const double invf[16] = {1.0, 0.44036660267178046, 0.19392274474868576, 0.08539710028576561, 0.03760603093086393, 0.016560440080994446, 0.007292664737217109, 0.003211445994752591,
                               0.001414213562373095, 0.000622772421914596, 0.0002742481756762073, 0.00012076973741146504, 5.318295896944988e-05, 2.341999896140934e-05, 1.031338537721246e-05, 4.5416704806078695e-06};
      for (size_t i = gt; i < (size_t)SEQ * 16; i += NT) { const int pos = (int)(i >> 4), j = (int)(i & 15); double f = 1.0;
#pragma unroll
          for (int q = 0; q < 16; ++q) f = (j == q) ? invf[q] : f;
          const double rev = (double)pos * f * 0.15915494309189535; const float fr = (float)(rev - floor(rev));
          F.rope[i] = (f32x2){__builtin_amdgcn_cosf(fr), __builtin_amdgcn_sinf(fr)}; } }
}

__device__ __forceinline__ void qknorm_rope(const Frame& F) {
    const int gw = F.vcu * 8 + F.wave, NGW = F.G * 8, lane = F.lane, c = lane & 15;
    for (long it = gw; it < (long)T * 24 / 4; it += NGW) { const long row = it * 4 + (lane >> 4); const int t = (int)(row / 24), slot = (int)(row % 24);
        bf16_t* p = F.h + (size_t)t * HP + C_QD + slot * 128 + 8 * c;
        const u32x4 w = *(const u32x4*)p; float y[8] = {bflo(w.x), bfhi(w.x), bflo(w.y), bfhi(w.y), bflo(w.z), bfhi(w.z), bflo(w.w), bfhi(w.w)};
        float ss = 0.f;
#pragma unroll
        for (int e = 0; e < 8; ++e) ss += y[e] * y[e];
        ss += __shfl_xor(ss, 1); ss += __shfl_xor(ss, 2); ss += __shfl_xor(ss, 4); ss += __shfl_xor(ss, 8);
        const float rq = __builtin_amdgcn_rsqf(ss * (1.f / 128.f) + EPS); const float* g = (slot < 12 ? F.qn_g : F.kn_g) + 8 * c;
        const f32x4 g0 = *(const f32x4*)g, g1 = *(const f32x4*)(g + 4);
#pragma unroll
        for (int e = 0; e < 4; ++e) { y[e] *= rq * g0[e]; y[4 + e] *= rq * g1[e]; }
        const int pos = t & (SEQ - 1);
#pragma unroll
        for (int e = 0; e < 8; ++e) { const float partner = __shfl_xor(y[e], 2);
            if (c < 4) { const f32x2 cs = F.rope[(size_t)pos * 16 + 8 * (c & 1) + e]; y[e] = (c < 2) ? (y[e] * cs.x - partner * cs.y) : (y[e] * cs.x + partner * cs.y); } }
        if (slot < 12) {
#pragma unroll
            for (int e = 0; e < 8; ++e) y[e] *= QSCALE; }
        u32x4 o; o.x = pk2(y[0], y[1]); o.y = pk2(y[2], y[3]); o.z = pk2(y[4], y[5]); o.w = pk2(y[6], y[7]); *(u32x4*)p = o; }
}

constexpr int GL_GDS = 0, GL_TOT = 8192, GL_QF = 12288, GL_QB = 21504, GL_KF = 30720, GL_KB = 39936, GL_VT = 49152, GL_P = 67584, GL_SF = 76800, GL_SB = 95232, GL_OB = 12288;
constexpr int RS72 = 144;
__device__ __forceinline__ float logsig(float z) { return fminf(z, 0.f) - flog(1.f + fexp(-fabsf(z))); }
__device__ __forceinline__ void gla_gates(const Frame& F, int b, int hh, int n, float (&bf)[8], float (&bb)[8], float& totf, float& totb) {
    const int tid = F.tid, c = tid & 63, ig = F.wave; LAS float* gds = (LAS float*)(F.lds + GL_GDS); LAS float* tot = (LAS float*)(F.lds + GL_TOT);
    const size_t t0 = (size_t)b * SEQ + (size_t)n * 64;
    if (tid < 256) { const int tk = tid >> 2, part = tid & 3; const u32x4 w = *(const u32x4*)(F.h + (t0 + tk) * HP + C_GF + part * 8); LAS float* d = gds + tk * 32 + part * 8;
        d[0] = bflo(w.x); d[1] = bfhi(w.x); d[2] = bflo(w.y); d[3] = bfhi(w.y); d[4] = bflo(w.z); d[5] = bfhi(w.z); d[6] = bflo(w.w); d[7] = bfhi(w.w); }
    __syncthreads();
    const int hc = hh * 64 + c; float upf[16], upb[16];
#pragma unroll
    for (int r = 0; r < 16; ++r) { upf[r] = F.up_f[r * 256 + hc]; upb[r] = F.up_b[r * 256 + hc]; }
    const float biasf = F.bias_f[hc], biasb = F.bias_b[hc]; float laf[8], lab[8];
#pragma unroll
    for (int e = 0; e < 8; ++e) { const LAS float* gr = gds + (ig * 8 + e) * 32; float zf = biasf, zb = biasb;
#pragma unroll
        for (int r = 0; r < 16; ++r) { zf += gr[r] * upf[r]; zb += gr[16 + r] * upb[r]; }
        laf[e] = logsig(zf) * 0.0625f; lab[e] = logsig(zb) * 0.0625f; }
    bf[0] = laf[0];
#pragma unroll
    for (int e = 1; e < 8; ++e) bf[e] = bf[e - 1] + laf[e];
    bb[7] = lab[7];
#pragma unroll
    for (int e = 6; e >= 0; --e) bb[e] = bb[e + 1] + lab[e];
    tot[ig * 64 + c] = bf[7]; tot[512 + ig * 64 + c] = bb[0];
    __syncthreads();
    float offf = 0.f, offb = 0.f; totf = 0.f; totb = 0.f;
#pragma unroll
    for (int g = 0; g < 8; ++g) { const float tf = tot[g * 64 + c], tb = tot[512 + g * 64 + c]; totf += tf; totb += tb; offf += (g < ig) ? tf : 0.f; offb += (g > ig) ? tb : 0.f; }
#pragma unroll
    for (int e = 0; e < 8; ++e) { bf[e] += offf; bb[e] += offb; }
}
__device__ __forceinline__ void gla_stage_vT(const Frame& F, size_t t0, int hh) {
#pragma unroll
    for (int j = 0; j < 2; ++j) { const int q = F.tid + 512 * j, tk = q >> 4, vc = (q & 15) * 8; const bf16x8 v = *(const bf16x8*)(F.h + (t0 + tk) * HP + C_VA + hh * 128 + vc);
        LAS short* d = (LAS short*)(F.lds + GL_VT) + vc * 72 + tk;
#pragma unroll
        for (int e = 0; e < 8; ++e) d[e * 72] = v[e]; }
}
__device__ __forceinline__ bf16x8 ldfrag(const LAS unsigned char* base, int row, int s, int hi) { return *(const LAS bf16x8*)(base + row * RS72 + (16 * s + 8 * hi) * 2); }

__device__ __forceinline__ void gla_passA(const Frame& F, int item) {
    const int bh = item >> 8, n = item & 255, b = bh >> 2, hh = bh & 3, tid = F.tid, c = tid & 63, ig = F.wave, lane = F.lane, r32 = lane & 31, hi = lane >> 5;
    float bf[8], bb[8], totf, totb; gla_gates(F, b, hh, n, bf, bb, totf, totb);
    const size_t t0 = (size_t)b * SEQ + (size_t)n * 64;
    float kf[8], kb[8];
#pragma unroll
    for (int e = 0; e < 8; ++e) { const float k = bf2f(F.h[(t0 + ig * 8 + e) * HP + C_KA + hh * 64 + c]); kf[e] = k * fexp(totf - bf[e]); kb[e] = k * fexp(totb - bb[e]); }
    { u32x4 o; o.x = pk2(kf[0], kf[1]); o.y = pk2(kf[2], kf[3]); o.z = pk2(kf[4], kf[5]); o.w = pk2(kf[6], kf[7]); *(LAS u32x4*)(F.lds + GL_KF + c * RS72 + ig * 16) = o;
      o.x = pk2(kb[0], kb[1]); o.y = pk2(kb[2], kb[3]); o.z = pk2(kb[4], kb[5]); o.w = pk2(kb[6], kb[7]); *(LAS u32x4*)(F.lds + GL_KB + c * RS72 + ig * 16) = o; }
    gla_stage_vT(F, t0, hh);
    if (ig == 0) { F.dec[((size_t)(0 * 8 + bh) * 256 + n) * 64 + c] = fexp(totf); F.dec[((size_t)(1 * 8 + bh) * 256 + n) * 64 + c] = fexp(totb); }
    __syncthreads();
    const int dir = F.wave >> 2, vt = F.wave & 3; const LAS unsigned char* kimg = F.lds + (dir ? GL_KB : GL_KF);
    f32x16 a0 = {}, a1 = {};
#pragma unroll
    for (int s = 0; s < 4; ++s) { const bf16x8 av = ldfrag(F.lds + GL_VT, 32 * vt + r32, s, hi), b0 = ldfrag(kimg, r32, s, hi), b1 = ldfrag(kimg, 32 + r32, s, hi);
        a0 = __builtin_amdgcn_mfma_f32_32x32x16_bf16(av, b0, a0, 0, 0, 0); a1 = __builtin_amdgcn_mfma_f32_32x32x16_bf16(av, b1, a1, 0, 0, 0); }
    float* st = F.state + ((size_t)(dir * 8 + bh) * 256 + n) * 8192;
#pragma unroll
    for (int r = 0; r < 16; ++r) { const int v = 32 * vt + crow(r, hi); st[v * 64 + r32] = a0[r]; st[v * 64 + 32 + r32] = a1[r]; }
    __syncthreads();
}
__device__ __forceinline__ void gla_scan(const Frame& F, int item) {
    const int dir = item >> 7, bh = (item >> 4) & 7, e = (item & 15) * 512 + F.tid, c = e & 63;
    float* st = F.state + (size_t)(dir * 8 + bh) * 256 * 8192 + e; const float* dc = F.dec + (size_t)(dir * 8 + bh) * 256 * 64 + c; float S = 0.f;
    float iA[16], dA[16], iB[16], dB[16];
#define SC_N(g, j) (dir ? 255 - ((g) * 16 + (j)) : (g) * 16 + (j))
#define SC_LOAD(I_, D_, g) do { _Pragma("unroll") for (int j = 0; j < 16; ++j) { const int n_ = SC_N(g, j); I_[j] = st[(size_t)n_ * 8192]; D_[j] = dc[n_ * 64]; } } while (0)
#define SC_RUN(I_, D_, g) do { _Pragma("unroll") for (int j = 0; j < 16; ++j) { const int n_ = SC_N(g, j); st[(size_t)n_ * 8192] = S; S = D_[j] * S + I_[j]; } } while (0)
    SC_LOAD(iA, dA, 0);
    for (int g = 0; g < 16; g += 2) { SC_LOAD(iB, dB, g + 1); SC_RUN(iA, dA, g); if (g + 2 < 16) SC_LOAD(iA, dA, g + 2); SC_RUN(iB, dB, g + 1); }
#undef SC_N
#undef SC_LOAD
#undef SC_RUN
}
__device__ __forceinline__ void gla_passC(const Frame& F, int item) {
    const int bh = item >> 8, n = item & 255, b = bh >> 2, hh = bh & 3, tid = F.tid, c = tid & 63, ig = F.wave, lane = F.lane, r32 = lane & 31, hi = lane >> 5;
    float bf[8], bb[8], totf, totb; gla_gates(F, b, hh, n, bf, bb, totf, totb);
    const size_t t0 = (size_t)b * SEQ + (size_t)n * 64;
#pragma unroll
    for (int e = 0; e < 8; ++e) { const int i = ig * 8 + e; const bf16_t* hr = F.h + (t0 + i) * HP + hh * 64 + c; const float q = bf2f(hr[C_QA]) * 0.125f, k = bf2f(hr[C_KA]);
        const float ef = fexp(bf[e]), eb = fexp(bb[e]), nf = fexp(-bf[e]), nb = fexp(-bb[e]);
        *(LAS unsigned short*)(F.lds + GL_QF + i * RS72 + c * 2) = (unsigned short)f2bf(q * ef); *(LAS unsigned short*)(F.lds + GL_QB + i * RS72 + c * 2) = (unsigned short)f2bf(q * eb);
        *(LAS unsigned short*)(F.lds + GL_KF + i * RS72 + c * 2) = (unsigned short)f2bf(k * nf); *(LAS unsigned short*)(F.lds + GL_KB + i * RS72 + c * 2) = (unsigned short)f2bf(k * nb); }
    gla_stage_vT(F, t0, hh);
#pragma unroll
    for (int dir = 0; dir < 2; ++dir) { const float* st = F.state + ((size_t)(dir * 8 + bh) * 256 + n) * 8192; LAS unsigned char* img = F.lds + (dir ? GL_SB : GL_SF);
#pragma unroll
        for (int j = 0; j < 4; ++j) { const int q4 = tid + 512 * j, v = q4 >> 4, c4 = (q4 & 15) * 4; const f32x4 s = *(const f32x4*)(st + v * 64 + c4);
            u32x2 w; w.x = pk2(s[0], s[1]); w.y = pk2(s[2], s[3]); *(LAS u32x2*)(img + v * RS72 + c4 * 2) = w; } }
    __syncthreads();
    if (F.wave < 4) { const int ti = F.wave >> 1, tj = F.wave & 1; f32x16 sf = {}, sb = {};
#pragma unroll
        for (int s = 0; s < 4; ++s) {
            sf = __builtin_amdgcn_mfma_f32_32x32x16_bf16(ldfrag(F.lds + GL_QF, 32 * ti + r32, s, hi), ldfrag(F.lds + GL_KF, 32 * tj + r32, s, hi), sf, 0, 0, 0);
            sb = __builtin_amdgcn_mfma_f32_32x32x16_bf16(ldfrag(F.lds + GL_QB, 32 * ti + r32, s, hi), ldfrag(F.lds + GL_KB, 32 * tj + r32, s, hi), sb, 0, 0, 0); }
#pragma unroll
        for (int r = 0; r < 16; ++r) { const int i = 32 * ti + crow(r, hi), j = 32 * tj + r32; const float p = (j <= i) ? sf[r] : sb[r];
            *(LAS unsigned short*)(F.lds + GL_P + i * RS72 + j * 2) = (unsigned short)f2bf(p); } }
    __syncthreads();
    const int ti = F.wave & 1, tv = F.wave >> 1; f32x16 o = {};
#pragma unroll
    for (int s = 0; s < 4; ++s) o = __builtin_amdgcn_mfma_f32_32x32x16_bf16(ldfrag(F.lds + GL_P, 32 * ti + r32, s, hi), ldfrag(F.lds + GL_VT, 32 * tv + r32, s, hi), o, 0, 0, 0);
#pragma unroll
    for (int s = 0; s < 4; ++s) o = __builtin_amdgcn_mfma_f32_32x32x16_bf16(ldfrag(F.lds + GL_QF, 32 * ti + r32, s, hi), ldfrag(F.lds + GL_SF, 32 * tv + r32, s, hi), o, 0, 0, 0);
#pragma unroll
    for (int s = 0; s < 4; ++s) o = __builtin_amdgcn_mfma_f32_32x32x16_bf16(ldfrag(F.lds + GL_QB, 32 * ti + r32, s, hi), ldfrag(F.lds + GL_SB, 32 * tv + r32, s, hi), o, 0, 0, 0);
    __syncthreads();
    LAS float* ob = (LAS float*)(F.lds + GL_OB);
#pragma unroll
    for (int r = 0; r < 16; ++r) ob[(32 * ti + crow(r, hi)) * 132 + 32 * tv + r32] = o[r];
    __syncthreads();
    { const int i = tid >> 3, part = tid & 7, v0 = part * 16; float ov[16], ss = 0.f;
#pragma unroll
      for (int e = 0; e < 16; ++e) { ov[e] = ob[i * 132 + v0 + e]; ss += ov[e] * ov[e]; }
      ss += __shfl_xor(ss, 1); ss += __shfl_xor(ss, 2); ss += __shfl_xor(ss, 4);
      const float rs = __builtin_amdgcn_rsqf(ss * (1.f / 128.f) + EPS); const size_t tok = t0 + i;
      const u32x4 r0 = *(const u32x4*)(F.h + tok * HP + C_RA + hh * 128 + v0), r1 = *(const u32x4*)(F.h + tok * HP + C_RA + hh * 128 + v0 + 8);
      const float rr[16] = {bflo(r0.x), bfhi(r0.x), bflo(r0.y), bfhi(r0.y), bflo(r0.z), bfhi(r0.z), bflo(r0.w), bfhi(r0.w), bflo(r1.x), bfhi(r1.x), bflo(r1.y), bfhi(r1.y), bflo(r1.z), bfhi(r1.z), bflo(r1.w), bfhi(r1.w)};
      float y[16];
#pragma unroll
      for (int e = 0; e < 16; ++e) { const float g = F.out_g[hh * 128 + v0 + e]; const float sil = rr[e] * __builtin_amdgcn_rcpf(1.f + fexp(-rr[e])); y[e] = ov[e] * rs * g * sil; }
      u32x4 w0, w1; w0.x = pk2(y[0], y[1]); w0.y = pk2(y[2], y[3]); w0.z = pk2(y[4], y[5]); w0.w = pk2(y[6], y[7]); w1.x = pk2(y[8], y[9]); w1.y = pk2(y[10], y[11]); w1.z = pk2(y[12], y[13]); w1.w = pk2(y[14], y[15]);
      bf16_t* mp = F.mixed + tok * DM + hh * 128 + v0; *(u32x4*)mp = w0; *(u32x4*)(mp + 8) = w1; }
    __syncthreads();
}

constexpr int AT_V = 0, AT_K = 32768, AT_O = 65536;
#define KSWZ(row, colB) ((row) * 256 + ((colB) ^ (((row) & 7) << 4)))
__device__ __forceinline__ int v_st(int k, int c) { const int kk = (k & ~0xC) | ((k & 4) << 1) | ((k & 8) >> 1); return ((kk >> 3) * 4 + (c >> 5)) * 512 + ((kk & 7) * 32 + (c & 31)) * 2; }
__device__ __forceinline__ int v_rd_base(int lane) { return ((lane & 3) << 3) | (((lane >> 2) & 3) << 6) | (((lane >> 4) & 1) << 5) | (((lane >> 5) & 1) << 8); }
constexpr int v_rd_off(int d0, int ks, int half) { return d0 * 512 + ks * 4096 + half * 2048; }
template <int OFF> __device__ __forceinline__ s16x4 tr_read(int vb) { s16x4 r; asm volatile("ds_read_b64_tr_b16 %0, %1 offset:%2" : "=&v"(r) : "v"(vb), "i"(OFF) : "memory"); return r; }
template <int D0> __device__ __forceinline__ void pv_one(f32x16& od, int vb, bf16x8 pa0, bf16x8 pa1, bf16x8 pa2, bf16x8 pa3) {
    const s16x4 l0 = tr_read<v_rd_off(D0, 0, 0)>(vb), h0 = tr_read<v_rd_off(D0, 0, 1)>(vb), l1 = tr_read<v_rd_off(D0, 1, 0)>(vb), h1 = tr_read<v_rd_off(D0, 1, 1)>(vb);
    const s16x4 l2 = tr_read<v_rd_off(D0, 2, 0)>(vb), h2 = tr_read<v_rd_off(D0, 2, 1)>(vb), l3 = tr_read<v_rd_off(D0, 3, 0)>(vb), h3 = tr_read<v_rd_off(D0, 3, 1)>(vb);
    asm volatile("s_waitcnt lgkmcnt(0)" ::: "memory"); SBAR();
#define PKV(L, H) (bf16x8){L[0], L[1], L[2], L[3], H[0], H[1], H[2], H[3]}
    od = __builtin_amdgcn_mfma_f32_32x32x16_bf16(pa0, PKV(l0, h0), od, 0, 0, 0);
    od = __builtin_amdgcn_mfma_f32_32x32x16_bf16(pa1, PKV(l1, h1), od, 0, 0, 0);
    od = __builtin_amdgcn_mfma_f32_32x32x16_bf16(pa2, PKV(l2, h2), od, 0, 0, 0);
    od = __builtin_amdgcn_mfma_f32_32x32x16_bf16(pa3, PKV(l3, h3), od, 0, 0, 0);
#undef PKV
}
struct AtP { size_t tokbase; int dil, m0, Tf, nt, head, p; };
__device__ __forceinline__ AtP at_decode(int item) {
    AtP P; const int p = item / 1536, rem = item % 1536, b = rem / 768, rem2 = rem % 768, u = rem2 & 63; P.p = p; P.head = rem2 >> 6;
    const int dsh = 2 * p, L = SEQ >> dsh, runs = 64 >> dsh, res = u / runs; P.dil = 1 << dsh; P.m0 = (u % runs) * 256; P.tokbase = (size_t)b * SEQ + res;
    const int kt_lo = (P.m0 == 0) ? 1 : 0, kt_hi = (P.m0 + 256 >= L) ? 4 : 5; P.Tf = P.m0 - 64 + 64 * kt_lo; P.nt = kt_hi - kt_lo + 1; return P;
}
__device__ __forceinline__ void attn_phase(const Frame& F) {
    const int tid = F.tid, wid = F.wave, lane = F.lane, r32 = lane & 31, hi = lane >> 5, G = F.G;
    int ntot = 0; for (int it = F.vcu; it < 4608; it += G) ntot += at_decode(it).nt;
    if (ntot == 0) return;
    const int sr = tid >> 4, sc = (tid & 15) * 8, vst0 = v_st(sr, sc), vst1 = v_st(32 + sr, sc), kc = sc * 2;
    const int vb0 = (int)(unsigned)(uintptr_t)(F.ldsg + AT_V) + v_rd_base(lane);
    int it_ld = F.vcu, rl = 0, it_c = F.vcu, rc = 0; AtP ld = at_decode(it_ld), cur = ld;
    bf16x8 qr[8], qn[8]; f32x16 o[4]; float l_reg = 0.f;
    bf16x8 sA0, sA1, sA2, sA3;
#define AT_QLOAD() do { const bf16_t* qp_ = F.h + C_QD + ld.head * 128 + (ld.tokbase + (size_t)ld.dil * (ld.m0 + 32 * wid + r32)) * HP + hi * 8; \
        _Pragma("unroll") for (int d0 = 0; d0 < 8; ++d0) qn[d0] = *(const bf16x8*)(qp_ + d0 * 16); } while (0)
#define AT_SLOAD(S) do { const int T0_ = ld.Tf + 64 * rl; const size_t ra = (ld.tokbase + (size_t)ld.dil * (T0_ + sr)) * HP + ld.head * 128 + sc, rb = ra + (size_t)ld.dil * 32 * HP; \
        S##0 = *(const bf16x8*)(F.h + C_VD + ra); S##1 = *(const bf16x8*)(F.h + C_VD + rb); S##2 = *(const bf16x8*)(F.h + C_KD + ra); S##3 = *(const bf16x8*)(F.h + C_KD + rb); \
        if (++rl == ld.nt) { it_ld += G; rl = 0; if (it_ld < 4608) { ld = at_decode(it_ld); AT_QLOAD(); } } } while (0)
#define AT_SWRITE(S, B) do { *(LAS bf16x8*)(F.lds + AT_V + (B) * 16384 + vst0) = S##0; *(LAS bf16x8*)(F.lds + AT_V + (B) * 16384 + vst1) = S##1; \
        *(LAS bf16x8*)(F.lds + AT_K + (B) * 16384 + KSWZ(sr, kc)) = S##2; *(LAS bf16x8*)(F.lds + AT_K + (B) * 16384 + KSWZ(32 + sr, kc)) = S##3; } while (0)
#define PK4(P, BASE, OUT) do { unsigned a0_ = pk2(P[BASE + 0], P[BASE + 1]), a1_ = pk2(P[BASE + 2], P[BASE + 3]); unsigned b0_ = pk2(P[BASE + 4], P[BASE + 5]), b1_ = pk2(P[BASE + 6], P[BASE + 7]); \
        auto r0_ = __builtin_amdgcn_permlane32_swap(a0_, b0_, false, false); auto r1_ = __builtin_amdgcn_permlane32_swap(a1_, b1_, false, false); \
        u32x4 w_ = {r0_[0], r1_[0], r0_[1], r1_[1]}; OUT = __builtin_bit_cast(bf16x8, w_); } while (0)
#define AT_STEP(BUF) do { \
        if (rc == 0) { _Pragma("unroll") for (int d0 = 0; d0 < 8; ++d0) qr[d0] = qn[d0]; _Pragma("unroll") for (int d0 = 0; d0 < 4; ++d0) o[d0] = (f32x16){}; l_reg = 0.f; } \
        const int Q0 = cur.m0 + 32 * wid, T0 = cur.Tf + 64 * rc; \
        if (T0 + 63 >= Q0 - 64 && T0 <= Q0 + 95) {                                        \
            const LAS unsigned char* Ks = F.lds + AT_K + (BUF) * 16384; f32x16 p0 = {}, p1 = {}; \
            _Pragma("unroll") for (int d0 = 0; d0 < 8; ++d0) { const int cb = (d0 * 16 + hi * 8) * 2; \
                const bf16x8 k0 = *(const LAS bf16x8*)(Ks + KSWZ(r32, cb)), k1 = *(const LAS bf16x8*)(Ks + KSWZ(32 + r32, cb)); \
                p0 = __builtin_amdgcn_mfma_f32_32x32x16_bf16(k0, qr[d0], p0, 0, 0, 0); p1 = __builtin_amdgcn_mfma_f32_32x32x16_bf16(k1, qr[d0], p1, 0, 0, 0); } \
            const int dq = T0 - (Q0 + r32); float ps = 0.f;                                \
            _Pragma("unroll") for (int r = 0; r < 16; ++r) { const int e0 = dq + crow(r, hi), e1 = e0 + 32; \
                p0[r] = (e0 >= -64 && e0 <= 64) ? __builtin_amdgcn_exp2f(p0[r]) : 0.f; p1[r] = (e1 >= -64 && e1 <= 64) ? __builtin_amdgcn_exp2f(p1[r]) : 0.f; ps += p0[r] + p1[r]; } \
            l_reg += ps; \
            bf16x8 pa0, pa1, pa2, pa3; PK4(p0, 0, pa0); PK4(p0, 8, pa1); PK4(p1, 0, pa2); PK4(p1, 8, pa3); \
            const int vb = vb0 + (BUF) * 16384; \
            pv_one<0>(o[0], vb, pa0, pa1, pa2, pa3); pv_one<1>(o[1], vb, pa0, pa1, pa2, pa3); pv_one<2>(o[2], vb, pa0, pa1, pa2, pa3); pv_one<3>(o[3], vb, pa0, pa1, pa2, pa3); } \
        if (++rc == cur.nt) {                                                             \
            bf16_t* Op = (bf16_t*)(cur.p == 0 ? (unsigned char*)F.out + OUT_OP0 : F.wsb + (cur.p == 1 ? WS_OP1 : WS_OP2)); \
            const float lt = l_reg + __shfl_xor(l_reg, 32); \
            if (hi == 0) F.lp[((size_t)cur.p * T + cur.tokbase + (size_t)cur.dil * (Q0 + r32)) * NHD + cur.head] = lt; \
            LAS unsigned char* stg = F.lds + AT_O + wid * 8192; \
            _Pragma("unroll") for (int d0 = 0; d0 < 4; ++d0) _Pragma("unroll") for (int r = 0; r < 16; ++r) *(LAS unsigned short*)(stg + (crow(r, hi) * 128 + d0 * 32 + r32) * 2) = (unsigned short)f2bf(o[d0][r]); \
            LDS_WAIT(); asm volatile("" ::: "memory"); \
            _Pragma("unroll") for (int i_ = 0; i_ < 8; ++i_) { const int row = 4 * i_ + (lane >> 4), ch = lane & 15; const u32x4 w = *(const LAS u32x4*)(stg + row * 256 + ch * 16); \
                *(u32x4*)(Op + (cur.tokbase + (size_t)cur.dil * (Q0 + row)) * (NHD * 128) + cur.head * 128 + ch * 8) = w; } \
            LDS_WAIT(); asm volatile("" ::: "memory"); \
            rc = 0; it_c += G; if (it_c < 4608) cur = at_decode(it_c); } } while (0)
    AT_QLOAD();
    AT_SLOAD(sA); AT_SWRITE(sA, 0); AT_SLOAD(sA); __syncthreads();
    for (int g = 0; g < ntot; ++g) { const int buf = g & 1;
        AT_STEP(buf);
        if (g + 1 < ntot) AT_SWRITE(sA, buf ^ 1);
        if (it_ld < 4608) AT_SLOAD(sA);
        __syncthreads();
    }
#undef AT_QLOAD
#undef AT_SLOAD
#undef AT_SWRITE
#undef PK4
#undef AT_STEP
}
__device__ __forceinline__ void dil_combine(const Frame& F) {
    const int gw = F.vcu * 8 + F.wave, NGW = F.G * 8, lane = F.lane, c = lane & 15;
    for (long it = gw; it < (long)T * NHD / 4; it += NGW) { const long row = it * 4 + (lane >> 4); const size_t tok = (size_t)(row / NHD); const int head = (int)(row % NHD);
        const float l = F.lp[tok * NHD + head] + F.lp[((size_t)T + tok) * NHD + head] + F.lp[((size_t)2 * T + tok) * NHD + head]; const float inv = 1.f / l;
        const size_t off = tok * (NHD * 128) + head * 128 + 8 * c; const u32x4 a = *(const u32x4*)(F.op0 + off), b = *(const u32x4*)(F.op1 + off), d = *(const u32x4*)(F.op2 + off);
        u32x4 o; o.x = pk2((bflo(a.x) + bflo(b.x) + bflo(d.x)) * inv, (bfhi(a.x) + bfhi(b.x) + bfhi(d.x)) * inv); o.y = pk2((bflo(a.y) + bflo(b.y) + bflo(d.y)) * inv, (bfhi(a.y) + bfhi(b.y) + bfhi(d.y)) * inv);
        o.z = pk2((bflo(a.z) + bflo(b.z) + bflo(d.z)) * inv, (bfhi(a.z) + bfhi(b.z) + bfhi(d.z)) * inv); o.w = pk2((bflo(a.w) + bflo(b.w) + bflo(d.w)) * inv, (bfhi(a.w) + bfhi(b.w) + bfhi(d.w)) * inv);
        *(u32x4*)(F.mixed + tok * DM + 512 + head * 128 + 8 * c) = o; }
}

__device__ __forceinline__ unsigned fl_flip(float x) { const unsigned u = __float_as_uint(x); return u ^ ((unsigned)((int)u >> 31) | 0x80000000u); }
__device__ __forceinline__ float fl_unflip(unsigned w) { return __uint_as_float((w & 0x80000000u) ? (w ^ 0x80000000u) : ~w); }
#define CE_DESC(a, b) do { const unsigned x_ = max(a, b), y_ = min(a, b); a = x_; b = y_; } while (0)
__device__ __forceinline__ void sort16_desc(unsigned (&a)[16]) {
#pragma unroll
    for (int k = 2; k <= 16; k <<= 1)
#pragma unroll
        for (int j = k >> 1; j > 0; j >>= 1)
#pragma unroll
            for (int i = 0; i < 16; ++i) { const int l = i ^ j; if (l > i) { const unsigned x = max(a[i], a[l]), y = min(a[i], a[l]); if ((i & k) == 0) { a[i] = x; a[l] = y; } else { a[i] = y; a[l] = x; } } }
}
__device__ __forceinline__ void bmerge16_desc(unsigned (&a)[16]) {
#pragma unroll
    for (int j = 8; j > 0; j >>= 1)
#pragma unroll
        for (int i = 0; i < 16; ++i) { const int l = i ^ j; if (l > i) CE_DESC(a[i], a[l]); }
}
__device__ __forceinline__ void top16_merge(unsigned (&a)[16], const unsigned (&b)[16]) {
#pragma unroll
    for (int i = 0; i < 16; ++i) a[i] = max(a[i], b[15 - i]);
    bmerge16_desc(a);
}
__device__ __forceinline__ void top16_partner(unsigned (&a)[16]) {
    unsigned b[16];
#pragma unroll
    for (int i = 0; i < 16; ++i) b[i] = (unsigned)__shfl_xor((int)a[i], 32);
    top16_merge(a, b);
}
__device__ constexpr unsigned char stair(int n) {
    constexpr unsigned char L[64] = {0x00,0x01,0x02,0x03,0x04,0x05,0x06,0x07,0x08,0x09,0x0a,0x0b,0x0c,0x0d,0x0e,0x0f,0x10,0x11,0x12,0x13,0x14,0x15,0x16,0x17,0x20,0x21,0x22,0x23,0x24,0x30,0x31,0x32,
                                     0x33,0x40,0x41,0x42,0x50,0x51,0x60,0x61,0x70,0x71,0x80,0x90,0xa0,0xb0,0xc0,0xd0,0xe0,0xf0,0xff,0xff,0xff,0xff,0xff,0xff,0xff,0xff,0xff,0xff,0xff,0xff,0xff,0xff};
    return L[n];
}
__device__ __forceinline__ void topk_item(const Frame& F, int item) {
    const int lane = F.lane, r32 = lane & 31, hi = lane >> 5, hh = item & 7, tok0 = (item >> 3) * 32; const size_t tok = (size_t)tok0 + r32;
    LAS int* ktab = (LAS int*)(F.lds + F.wave * 4096) + r32 * 32;
    float ss = 0.f;
    { const f32x4* sp = (const f32x4*)(F.ssp + tok * 32 + hi * 16);
#pragma unroll
      for (int j = 0; j < 4; ++j) { const f32x4 v = sp[j]; ss += (v[0] + v[1]) + (v[2] + v[3]); } }
    ss += __shfl_xor(ss, 32);
    const float rs2 = __builtin_amdgcn_rsqf(ss * (1.f / DM) + EPS);
    if (hh == 0 && hi == 0) F.rs2[tok] = rs2;
    unsigned top[2][16];
#pragma unroll
    for (int cc = 0; cc < 2; ++cc) {
        f32x16 acc[4] = {};
        const bf16_t* qp = F.qry + tok * DM + hh * 256 + cc * 128 + hi * 8; const bf16_t* kp = F.SK + ((size_t)(hh * 2 + cc) * 128 + r32) * 128 + hi * 8;
#pragma unroll 2
        for (int s = 0; s < 8; ++s) { const bf16x8 qf = *(const bf16x8*)(qp + 16 * s);
#pragma unroll
            for (int kt = 0; kt < 4; ++kt) { const bf16x8 kf = *(const bf16x8*)(kp + (size_t)kt * 32 * 128 + 16 * s); acc[kt] = __builtin_amdgcn_mfma_f32_32x32x16_bf16(kf, qf, acc[kt], 0, 0, 0); } }
        unsigned g[4][16];
#pragma unroll
        for (int kt = 0; kt < 4; ++kt) {
#pragma unroll
            for (int r = 0; r < 16; ++r) g[kt][r] = (fl_flip(acc[kt][r]) & ~127u) | (unsigned)(127 - (32 * kt + crow(r, hi)));
            sort16_desc(g[kt]); }
        top16_merge(g[0], g[1]); top16_merge(g[2], g[3]); top16_merge(g[0], g[2]); top16_partner(g[0]);
#pragma unroll
        for (int i = 0; i < 16; ++i) top[cc][i] = g[0][i];
    }
#pragma unroll
    for (int i = 0; i < 16; ++i) ktab[hi * 16 + i] = 127 - (int)((hi ? top[1][i] : top[0][i]) & 127u);
    float s0[16], s1[16];
#pragma unroll
    for (int i = 0; i < 16; ++i) { s0[i] = fl_unflip(top[0][i] & ~127u); s1[i] = fl_unflip(top[1][i] & ~127u); }
    unsigned ca[16], cb[16];
#pragma unroll
    for (int n = 0; n < 32; ++n) { const int A = stair(n), B = stair(25 + n); unsigned va = 0u, vb = 0u;
        if (n < 25) { va = (fl_flip(s0[A >> 4] + s1[A & 15]) & ~255u) | (unsigned)(255 - A); vb = (fl_flip(s0[B >> 4] + s1[B & 15]) & ~255u) | (unsigned)(255 - B); }
        const unsigned v = hi ? vb : va; if (n < 16) ca[n] = v; else cb[n - 16] = v; }
    sort16_desc(ca); sort16_desc(cb); top16_merge(ca, cb); top16_partner(ca);
    float e[16], sum = 0.f; const float mx = fl_unflip(ca[0] & ~255u) * rs2;
#pragma unroll
    for (int i = 0; i < 16; ++i) { e[i] = fexp(fl_unflip(ca[i] & ~255u) * rs2 - mx); sum += e[i]; }
    const float inv = 1.f / sum;
    LDS_WAIT(); asm volatile("" ::: "memory");
    int oi[8]; float og[8];
#pragma unroll
    for (int k = 0; k < 8; ++k) { const unsigned cv = hi ? ca[8 + k] : ca[k]; const int code = 255 - (int)(cv & 255u); og[k] = (hi ? e[8 + k] : e[k]) * inv; oi[k] = ktab[code >> 4] * 128 + ktab[16 + (code & 15)]; }
    { int* ip = F.idx + tok * 128 + hh * 16 + hi * 8; float* gp = F.gate + tok * 128 + hh * 16 + hi * 8;
      *(int4*)ip = make_int4(oi[0], oi[1], oi[2], oi[3]); *(int4*)(ip + 4) = make_int4(oi[4], oi[5], oi[6], oi[7]);
      *(f32x4*)gp = (f32x4){og[0], og[1], og[2], og[3]}; *(f32x4*)(gp + 4) = (f32x4){og[4], og[5], og[6], og[7]}; }
    LDS_WAIT(); asm volatile("" ::: "memory");
}

constexpr int PS_NSL = 16, PS_CW = DM / PS_NSL, PS_SUB = PS_NSL / 8, PS_TG = 32, PS_NTG = T / PS_TG;
__device__ __forceinline__ float gelu_tanh(float x) { const float u = 0.7978845608028654f * (x + 0.044715f * x * x * x); const float t = 1.f - 2.f * __builtin_amdgcn_rcpf(1.f + fexp(2.f * u)); return 0.5f * x * (1.f + t); }
__device__ __forceinline__ int dot16i(u32x4 w, u32x4 x) { int p = __builtin_amdgcn_sdot4((int)w.x, (int)x.x, 0, false); p = __builtin_amdgcn_sdot4((int)w.y, (int)x.y, p, false); p = __builtin_amdgcn_sdot4((int)w.z, (int)x.z, p, false); return __builtin_amdgcn_sdot4((int)w.w, (int)x.w, p, false); }
__device__ __forceinline__ unsigned xcc_id() { return (unsigned)__builtin_amdgcn_s_getreg((3 << 11) | 20) & 7u; }
__device__ __forceinline__ bool peer_claim(unsigned* cnt, unsigned x, unsigned& d, int lane, int& q, int& tg) {
    while (d < 8u) { const unsigned xq = (x + d) & 7u; unsigned u = 0u;
        if (lane == 0) u = __hip_atomic_fetch_add(cnt + 64 * xq, 1u, __ATOMIC_RELAXED, __HIP_MEMORY_SCOPE_AGENT);
        u = (unsigned)__builtin_amdgcn_readfirstlane((int)u);
        if (u < (unsigned)(PS_SUB * PS_NTG)) { q = (int)(u / PS_NTG) * 8 + (int)xq; tg = (int)(u % PS_NTG); return true; }
        ++d; }
    return false;
}
template <int CTRL> __device__ __forceinline__ float dppmov(float x) { return __int_as_float(__builtin_amdgcn_update_dpp(0, __float_as_int(x), CTRL, 0xf, 0xf, true)); }
template <int CTRL> __device__ __forceinline__ int dppmovi(int x) { return __builtin_amdgcn_update_dpp(0, x, CTRL, 0xf, 0xf, true); }
__device__ __forceinline__ int bperm(int srclane, int v) { return __builtin_amdgcn_ds_bpermute(srclane << 2, v); }
__device__ __forceinline__ void peer_quant_x(const Frame& F) {
    const int gw = F.vcu * 8 + F.wave, NGW = F.G * 8, lane = F.lane;
    for (int tok = gw; tok < T; tok += NGW) { const u32x4* xr = (const u32x4*)(F.x1b + (size_t)tok * DM) + lane; float v[4][8]; float m = 0.f;
#pragma unroll
        for (int j = 0; j < 4; ++j) { const u32x4 w = xr[64 * j]; v[j][0] = bflo(w.x); v[j][1] = bfhi(w.x); v[j][2] = bflo(w.y); v[j][3] = bfhi(w.y); v[j][4] = bflo(w.z); v[j][5] = bfhi(w.z); v[j][6] = bflo(w.w); v[j][7] = bfhi(w.w);
#pragma unroll
            for (int i = 0; i < 8; ++i) m = fmaxf(m, fabsf(v[j][i])); }
#pragma unroll
        for (int o = 1; o < 64; o <<= 1) m = fmaxf(m, __shfl_xor(m, o));
        const float inv = m > 0.f ? 127.f / m : 0.f;
#pragma unroll
        for (int j = 0; j < 4; ++j) { u32x2 w = {0u, 0u};
#pragma unroll
            for (int i = 0; i < 4; ++i) { w.x |= ((unsigned)(int)rintf(v[j][i] * inv) & 0xffu) << (8 * i); w.y |= ((unsigned)(int)rintf(v[j][4 + i] * inv) & 0xffu) << (8 * i); }
            *(u32x2*)(F.xq8 + (size_t)tok * DM + 8 * lane + 512 * j) = w; }
        if (lane == 0) F.sx[tok] = m * (1.f / 127.f); }
}
__device__ __forceinline__ void peer_down(const Frame& F, int cntw = 1024) {
    const int lane = F.lane, g = lane >> 3, c = lane & 7; const unsigned x = xcc_id(); unsigned d = 0u; int q, tg; unsigned* cnt = (unsigned*)(F.wsb + WS_CTL) + cntw;
    const unsigned char* tab = F.down8; const unsigned char* xb = F.xq8;
    while (peer_claim(cnt, x, d, lane, q, tg)) {
        const unsigned colb = (unsigned)(q * PS_CW + 16 * c), slb = (unsigned)q * (16384u * 128u) + 16u * c; int* part = F.part + (size_t)q * T * 128; const size_t tok0 = (size_t)tg * PS_TG;
        u32x4 wA[16], wB[16], xA, xB; int iA0, iA1, iB0, iB1;
#define PD_IDX(i0, i1, tok) do { const int* ip_ = F.idx + (tok) * 128 + lane; i0 = ip_[0]; i1 = ip_[64]; } while (0)
#define PD_ROWS(W_, X_, i0, i1, tok) do { _Pragma("unroll") for (int j = 0; j < 16; ++j) { const unsigned e_ = (unsigned)bperm(8 * (j & 7) + g, j < 8 ? i0 : i1); \
            W_[j] = *(const u32x4*)(tab + (e_ * 128u + slb)); } X_ = *(const u32x4*)(xb + (tok) * DM + colb); } while (0)
#define PD_COMP(W_, X_, tok) do { int p[16]; _Pragma("unroll") for (int j = 0; j < 16; ++j) p[j] = dot16i(W_[j], X_); \
            int a1[8], a2[4], a3[2]; \
            _Pragma("unroll") for (int i = 0; i < 8; ++i) { const int keep = (c & 1) ? p[2 * i + 1] : p[2 * i], give = (c & 1) ? p[2 * i] : p[2 * i + 1]; a1[i] = keep + dppmovi<0xB1>(give); } \
            _Pragma("unroll") for (int i = 0; i < 4; ++i) { const int keep = (c & 2) ? a1[2 * i + 1] : a1[2 * i], give = (c & 2) ? a1[2 * i] : a1[2 * i + 1]; a2[i] = keep + dppmovi<0x4E>(give); } \
            _Pragma("unroll") for (int i = 0; i < 2; ++i) { const int keep = (c & 4) ? a2[2 * i + 1] : a2[2 * i], give = (c & 4) ? a2[2 * i] : a2[2 * i + 1]; a3[i] = keep + __shfl_xor(give, 4); } \
            part[(tok) * 128 + 8 * c + g] = a3[0]; part[(tok) * 128 + 64 + 8 * c + g] = a3[1]; } while (0)
        PD_IDX(iA0, iA1, tok0); PD_IDX(iB0, iB1, tok0 + 1);
        PD_ROWS(wA, xA, iA0, iA1, tok0);
        for (int tt = 0; tt < PS_TG; tt += 2) { const size_t tok = tok0 + tt;
            PD_ROWS(wB, xB, iB0, iB1, tok + 1);
            const size_t t2 = tok + (tt + 2 < PS_TG ? 2 : 0), t3 = tok + (tt + 2 < PS_TG ? 3 : 1);
            PD_IDX(iA0, iA1, t2);
            PD_COMP(wA, xA, tok);
            if (tt + 2 < PS_TG) PD_ROWS(wA, xA, iA0, iA1, t2);
            PD_IDX(iB0, iB1, t3);
            PD_COMP(wB, xB, tok + 1);
        }
#undef PD_IDX
#undef PD_ROWS
#undef PD_COMP
    }
}
__device__ __forceinline__ void peer_coef_probe(const Frame& F, bool dry) {
    const int gw = F.vcu * 8 + F.wave, NGW = F.G * 8, lane = F.lane;
    for (int tok = gw; tok < T; tok += NGW) { int a0 = 0, a1 = 0; const int* pp = F.part + (size_t)tok * 128 + lane;
#pragma unroll
        for (int q = 0; q < PS_NSL; ++q) { a0 += pp[(size_t)q * T * 128]; a1 += pp[(size_t)q * T * 128 + 64]; }
        const float sc = F.rs2[tok] * F.sx[tok]; const float* gp = F.gate + (size_t)tok * 128 + lane; const int e0 = F.idx[(size_t)tok * 128 + lane], e1 = F.idx[(size_t)tok * 128 + 64 + lane];
        const float c0 = gp[0] * gelu_tanh((float)a0 * sc * F.sd[e0]) * F.su[e0], c1 = gp[64] * gelu_tanh((float)a1 * sc * F.sd[e1]) * F.su[e1];
        float m = fmaxf(fabsf(c0), fabsf(c1));
#pragma unroll
        for (int o = 1; o < 64; o <<= 1) m = fmaxf(m, __shfl_xor(m, o));
        const float inv = m > 0.f ? 127.f / m : 0.f; const int q0 = (int)rintf(c0 * inv), q1 = (int)rintf(c1 * inv);
        unsigned char* fp = (dry ? F.wsb + WS_PART + 256 * MiB : F.fq8) + (size_t)tok * 128;
        { const int k0 = lane, k1 = 64 + lane; fp[(8 * (k0 >> 5) + (k0 & 7)) * 4 + ((k0 >> 3) & 3)] = (unsigned char)q0; fp[(8 * (k1 >> 5) + (k1 & 7)) * 4 + ((k1 >> 3) & 3)] = (unsigned char)q1; }
        if (lane == 0 && !dry) F.csum[tok] = m * (1.f / 127.f); }
}
__device__ __forceinline__ void peer_up(const Frame& F, int cntw = 2048, bool dry = false) {
    const int lane = F.lane, g = lane >> 3, c = lane & 7; const unsigned x = xcc_id(); unsigned d = 0u; int q, tg; unsigned* cnt = (unsigned*)(F.wsb + WS_CTL) + cntw;
    const unsigned char* tab = F.up8;
    while (peer_claim(cnt, x, d, lane, q, tg)) {
        const unsigned slb = (unsigned)q * (16384u * 128u) + 16u * c; const int col0 = q * PS_CW + 16 * c; const size_t tok0 = (size_t)tg * PS_TG;
        u32x4 wA[16], wB[16]; int iA0, iA1, iB0, iB1, fqA, fqB, fA[4], fB[4]; float oA0, oA1, oB0, oB1;
#define PU_IDX(i0, i1, fq, o0, o1, tok) do { const size_t o_ = (tok) * 128; i0 = F.idx[o_ + lane]; i1 = F.idx[o_ + 64 + lane]; fq = *(const int*)(F.fq8 + o_ + 4 * (lane & 31)); \
            const float* op_ = F.out + (tok) * DM + col0 + g; o0 = op_[0]; o1 = op_[8]; } while (0)
#define PU_ROWS(W_, F_, i0, i1, fq) do { _Pragma("unroll") for (int j = 0; j < 16; ++j) { const unsigned e_ = (unsigned)bperm(8 * (j & 7) + g, j < 8 ? i0 : i1); W_[j] = *(const u32x4*)(tab + (e_ * 128u + slb)); } \
            _Pragma("unroll") for (int m_ = 0; m_ < 4; ++m_) F_[m_] = bperm(8 * m_ + g, fq); } while (0)
#define PU_T4(ACC_, R0, R1, R2, R3, FQ_) do { const unsigned t0_ = __builtin_amdgcn_perm(R1, R0, 0x05010400u), t1_ = __builtin_amdgcn_perm(R1, R0, 0x07030602u), t2_ = __builtin_amdgcn_perm(R3, R2, 0x05010400u), t3_ = __builtin_amdgcn_perm(R3, R2, 0x07030602u); \
            ACC_[0] = __builtin_amdgcn_sdot4((int)__builtin_amdgcn_perm(t2_, t0_, 0x05040100u), FQ_, ACC_[0], false); ACC_[1] = __builtin_amdgcn_sdot4((int)__builtin_amdgcn_perm(t2_, t0_, 0x07060302u), FQ_, ACC_[1], false); \
            ACC_[2] = __builtin_amdgcn_sdot4((int)__builtin_amdgcn_perm(t3_, t1_, 0x05040100u), FQ_, ACC_[2], false); ACC_[3] = __builtin_amdgcn_sdot4((int)__builtin_amdgcn_perm(t3_, t1_, 0x07060302u), FQ_, ACC_[3], false); } while (0)
#define PU_COMP(W_, F_, o0, o1, tok) do { int acc[16] = {}; \
            _Pragma("unroll") for (int m_ = 0; m_ < 4; ++m_) { int* a_ = acc; PU_T4(a_, W_[4 * m_].x, W_[4 * m_ + 1].x, W_[4 * m_ + 2].x, W_[4 * m_ + 3].x, F_[m_]); a_ = acc + 4; PU_T4(a_, W_[4 * m_].y, W_[4 * m_ + 1].y, W_[4 * m_ + 2].y, W_[4 * m_ + 3].y, F_[m_]); \
                a_ = acc + 8; PU_T4(a_, W_[4 * m_].z, W_[4 * m_ + 1].z, W_[4 * m_ + 2].z, W_[4 * m_ + 3].z, F_[m_]); a_ = acc + 12; PU_T4(a_, W_[4 * m_].w, W_[4 * m_ + 1].w, W_[4 * m_ + 2].w, W_[4 * m_ + 3].w, F_[m_]); } \
            int a1[8], a2[4], a3[2]; \
            _Pragma("unroll") for (int i = 0; i < 8; ++i) { const int keep = (g & 1) ? acc[2 * i + 1] : acc[2 * i], give = (g & 1) ? acc[2 * i] : acc[2 * i + 1]; a1[i] = keep + dppmovi<0x128>(give); } \
            _Pragma("unroll") for (int i = 0; i < 4; ++i) { const int keep = (g & 2) ? a1[2 * i + 1] : a1[2 * i], give = (g & 2) ? a1[2 * i] : a1[2 * i + 1]; a2[i] = keep + __shfl_xor(give, 16); } \
            _Pragma("unroll") for (int i = 0; i < 2; ++i) { const int keep = (g & 4) ? a2[2 * i + 1] : a2[2 * i], give = (g & 4) ? a2[2 * i] : a2[2 * i + 1]; a3[i] = keep + __shfl_xor(give, 32); } \
            const float sf_ = F.csum[tok]; float* dp_ = (dry ? (float*)(F.wsb + WS_PART) + ((tok) & 16383) * DM : F.out + (tok) * DM) + col0 + g; \
            dp_[0] = o0 + sf_ * (float)a3[0]; dp_[8] = o1 + sf_ * (float)a3[1]; } while (0)
        PU_IDX(iA0, iA1, fqA, oA0, oA1, tok0); PU_IDX(iB0, iB1, fqB, oB0, oB1, tok0 + 1);
        PU_ROWS(wA, fA, iA0, iA1, fqA);
        for (int tt = 0; tt < PS_TG; tt += 2) { const size_t tok = tok0 + tt;
            PU_ROWS(wB, fB, iB0, iB1, fqB);
            const float pA0 = oA0, pA1 = oA1;
            const bool more = tt + 2 < PS_TG; const size_t t2 = tok + (more ? 2 : 0), t3 = tok + (more ? 3 : 1);
            PU_IDX(iA0, iA1, fqA, oA0, oA1, t2);
            PU_COMP(wA, fA, pA0, pA1, tok);
            if (more) PU_ROWS(wA, fA, iA0, iA1, fqA);
            const float pB0 = oB0, pB1 = oB1;
            PU_IDX(iB0, iB1, fqB, oB0, oB1, t3);
            PU_COMP(wB, fB, pB0, pB1, tok + 1);
        }
#undef PU_IDX
#undef PU_ROWS
#undef PU_T4
#undef PU_COMP
    }
}

#define XB_TMO      128
#define XB_XCNT(j)  (256  + 64 * (j))
#define XB_XSUB(j)  (1280 + 64 * (j))
#define XB_XGEN(j)  (2304 + 64 * (j))
#define XB_TOP      3328
#define XB_TOPGEN   3392
#define XCD_BAR_WORDS 3456
#define XB_SPIN_CAP (1u << 18)

__device__ __forceinline__ unsigned xb_ld(unsigned* p)              { return __hip_atomic_load(p, __ATOMIC_RELAXED, __HIP_MEMORY_SCOPE_AGENT); }
__device__ __forceinline__ unsigned xb_add(unsigned* p, unsigned v) { return __hip_atomic_fetch_add(p, v, __ATOMIC_RELAXED, __HIP_MEMORY_SCOPE_AGENT); }
__device__ __forceinline__ unsigned xb_xcc_id() { return (unsigned)__builtin_amdgcn_s_getreg((3 << 11) | 20) & 0xFu; }
#define XB_SPIN(cond, bar) do { unsigned _sp = 0; while (cond) { __builtin_amdgcn_s_sleep(1); \
    if ((++_sp & 255u) == 0u) { if (xb_ld(&(bar)[XB_TMO])) break; if (_sp > XB_SPIN_CAP) { atomicAdd(&(bar)[XB_TMO], 1u); break; } } } } while (0)

struct XcdBarrier {
    unsigned* bar; unsigned x;
    volatile LAS unsigned* st;
};

__device__ __forceinline__ XcdBarrier xcd_barrier_post(unsigned* bar, volatile LAS unsigned* st) {
    XcdBarrier b; b.bar = bar; b.x = xb_xcc_id(); b.st = st;
    if (threadIdx.x == 0) (void)xb_add(&bar[XB_XCNT(b.x)], 1u);
    return b;
}
__device__ __forceinline__ void xcd_barrier_complete(unsigned* bar, unsigned x, unsigned& nloc, unsigned& nx) {
    const unsigned G = gridDim.x * gridDim.y * gridDim.z;
    unsigned sum, cnt, mine, sp = 0u;
    for (;;) {
        sum = 0u; cnt = 0u; mine = 0u;
#pragma unroll
        for (unsigned j = 0; j < 16; ++j) { const unsigned c = xb_ld(&bar[XB_XCNT(j)]); sum += c; cnt += (c > 0u) ? 1u : 0u; mine = (j == x) ? c : mine; }
        if (sum == G) break;
        __builtin_amdgcn_s_sleep(1);
        if ((++sp & 255u) == 0u) { if (xb_ld(&bar[XB_TMO])) break; if (sp > XB_SPIN_CAP) { atomicAdd(&bar[XB_TMO], 1u); break; } }
    }
    nloc = mine > 0u ? mine : 1u; nx = cnt > 0u ? cnt : 1u;
}

__device__ __forceinline__ void xcd_barrier(const XcdBarrier& b) {
    asm volatile("s_waitcnt vmcnt(0)" ::: "memory");
    __syncthreads();
    if (threadIdx.x == 0) {
        unsigned* bar = b.bar;
        __builtin_amdgcn_s_waitcnt(0);
        unsigned nloc = b.st[0], nx = b.st[1];
        if (nloc == 0u) { xcd_barrier_complete(bar, b.x, nloc, nx); b.st[0] = nloc; b.st[1] = nx; }
        const unsigned old = xb_add(&bar[XB_XSUB(b.x)], 1u);
        const unsigned gen = old / nloc;
        if (old + 1u == (gen + 1u) * nloc) {
            __builtin_amdgcn_fence(__ATOMIC_RELEASE, "agent");
            asm volatile("s_waitcnt vmcnt(0)" ::: "memory");
            const unsigned og = xb_add(&bar[XB_TOP], 1u);
            const unsigned tg = og / nx;
            if (og + 1u == (tg + 1u) * nx) xb_add(&bar[XB_TOPGEN], 1u);
            else XB_SPIN(xb_ld(&bar[XB_TOPGEN]) == tg, bar);
            __builtin_amdgcn_fence(__ATOMIC_ACQUIRE, "agent");
            xb_add(&bar[XB_XGEN(b.x)], 1u);
            asm volatile("s_waitcnt vmcnt(0)" ::: "memory");
        } else {
            XB_SPIN(xb_ld(&bar[XB_XGEN(b.x)]) == gen, bar);
            __builtin_amdgcn_fence(__ATOMIC_ACQUIRE, "agent");
            asm volatile("s_waitcnt vmcnt(0)" ::: "memory");
        }
    }
    __syncthreads();
}

struct Args { const float* in[16]; float* out; unsigned char* ws; int ph_lo, ph_hi, coop, pad; };
__global__ void __launch_bounds__(512, 2) fwd_kernel(Args args) {
    extern __shared__ __attribute__((aligned(16))) unsigned char lds_raw[];
    Frame F;
    F.lds = (LAS unsigned char*)lds_raw; F.ldsg = (char*)lds_raw;
    F.tid = threadIdx.x; F.lane = F.tid & 63; F.wave = __builtin_amdgcn_readfirstlane(F.tid >> 6);
    F.G = gridDim.x; { const int bx = blockIdx.x; F.vcu = (F.G % 8 == 0) ? (bx % 8) * (F.G / 8) + bx / 8 : bx; }
    F.x = args.in[0]; F.norm1_g = args.in[1]; F.w_in = args.in[2]; F.up_f = args.in[3]; F.bias_f = args.in[4]; F.up_b = args.in[5]; F.bias_b = args.in[6]; F.out_g = args.in[7];
    F.qn_g = args.in[8]; F.kn_g = args.in[9]; F.w_out = args.in[10]; F.norm2_g = args.in[11]; F.w_query = args.in[12]; F.sub_keys = args.in[13]; F.peer_down = args.in[14]; F.peer_up = args.in[15];
    F.out = args.out; unsigned char* ws = args.ws; F.wsb = ws;
    F.rope = (f32x2*)(ws + WS_ROPE); F.rs1 = (float*)(ws + WS_RS1); F.rs2 = (float*)(ws + WS_RS2); F.ssp = (float*)(ws + WS_SSP); F.dec = (float*)(ws + WS_DEC); F.lp = (float*)(ws + WS_LP);
    F.gate = (float*)(ws + WS_GATE); F.part = (int*)(ws + WS_PART); F.sd = (float*)(ws + WS_CTL + 65536); F.su = (float*)(ws + WS_CTL + 131072); F.sx = (float*)(ws + WS_RS2 + 131072); F.csum = (float*)(ws + WS_RS2 + 262144);
    F.down8 = ws + WS_DOWN; F.up8 = ws + WS_UP; F.xq8 = ws + WS_XB; F.fq8 = ws + WS_XB + 64 * MiB; F.idx = (int*)(ws + WS_IDX); F.state = (float*)((unsigned char*)args.out + OUT_ST);
    F.WinT = (bf16_t*)(ws + WS_WIN); F.Win8 = ws + WS_WIN; F.xq1 = ws + WS_OP1; F.sw = (float*)(ws + WS_CTL + 196608); F.WoT = (bf16_t*)(ws + WS_WO); F.WqT = (bf16_t*)(ws + WS_WQ); F.SK = (bf16_t*)(ws + WS_SK); F.down16 = (bf16_t*)(ws + WS_DOWN); F.up16 = (bf16_t*)(ws + WS_UP);
    F.xb = (bf16_t*)(ws + WS_XB); F.mixed = (bf16_t*)(ws + WS_XB); F.h = (bf16_t*)(ws + WS_H); F.x1b = (bf16_t*)(ws + WS_X1B); F.qry = (bf16_t*)(ws + WS_QRY);
    F.op0 = (bf16_t*)((unsigned char*)args.out + OUT_OP0); F.op1 = (bf16_t*)(ws + WS_OP1); F.op2 = (bf16_t*)(ws + WS_OP2);
    constexpr int MISC_OFF = 131072 + 320;
    for (int u = F.tid; u < 64; u += 512) ((LAS unsigned*)(F.lds + MISC_OFF))[u] = 0u;
    __syncthreads();
    XcdBarrier bar = xcd_barrier_post((unsigned*)(ws + WS_CTL) + 8192, (volatile LAS unsigned*)(F.lds + MISC_OFF) + 8);
    const int lo = args.ph_lo, hi = args.ph_hi;
#ifndef PH_MASK
#define PH_MASK 0x7ff
#endif
#ifndef PROBE_PHASE
#define PROBE_PHASE -1
#endif
#define REP(k) for (int rep_ = 0; rep_ < ((PROBE_PHASE == (k)) ? 2 : 1); ++rep_)
#define IN(k) (((PH_MASK >> (k)) & 1) && lo <= (k) && (k) < hi)
#define SEAM(k) do { if (IN(k) && IN((k) + 1)) { if (args.coop) { if ((k) == 0) cg::this_grid().sync(); else xcd_barrier(bar); } } } while (0)
    if (IN(0)) { REP(0) phase0(F); } SEAM(0);
#define GEMM1_BODY { pg8::Gemm g{(const pg8::bf16_t*)F.xq1, (const pg8::bf16_t*)F.Win8, T, HP, DM / 2}; pg8::StaticOrder S; S.init(T, HP, F.G, (int)blockIdx.x); pg8::EpiI8Bf16 E{F.h, HP, F.rs1, F.sw}; \
        pg8::gemm_phase<pg8::EpiI8Bf16, pg8::StaticOrder, PG8_ALIGN, PG8_SP2, true>(F.lds, g, S, E); }
    if (IN(1)) { GEMM1_BODY; if (PROBE_PHASE == 1) GEMM1_BODY; } SEAM(1);
    if (IN(2)) { qknorm_rope(F); REP(2) for (int it = F.vcu; it < 2048; it += F.G) gla_passA(F, it); } SEAM(2);
    if (IN(3)) { for (int it = F.vcu; it < 256; it += F.G) gla_scan(F, it); REP(3) attn_phase(F); } SEAM(3);
    if (IN(4)) REP(4) { for (int it = F.vcu; it < 2048; it += F.G) gla_passC(F, it); dil_combine(F); } SEAM(4);
#define GEMM5_BODY { pg8::Gemm g{F.mixed, F.WoT, T, DM, DM}; pg8::StaticOrder S; S.init(T, DM, F.G, (int)blockIdx.x); pg8::EpiResid E{F.x, F.out, F.x1b, F.ssp, DM}; \
        pg8::gemm_phase<pg8::EpiResid, pg8::StaticOrder, PG8_ALIGN, PG8_SP2>(F.lds, g, S, E); }
#define GEMM6_BODY { pg8::Gemm g{F.x1b, F.WqT, T, DM, DM}; pg8::StaticOrder S; S.init(T, DM, F.G, (int)blockIdx.x); pg8::EpiRowScaleBf16 E{F.qry, DM, nullptr}; \
        pg8::gemm_phase<pg8::EpiRowScaleBf16, pg8::StaticOrder, PG8_ALIGN, PG8_SP2>(F.lds, g, S, E); }
    if (IN(5)) { GEMM5_BODY; if (PROBE_PHASE == 5) GEMM5_BODY; } SEAM(5);
    if (IN(6)) { GEMM6_BODY; if (PROBE_PHASE == 6) GEMM6_BODY; } SEAM(6);
    if (IN(7)) REP(7) { const int gw = F.vcu * 8 + F.wave, NGW = F.G * 8; for (int it = gw; it < (T / 32) * 8; it += NGW) topk_item(F, it); if (rep_ == 0) peer_quant_x(F); } SEAM(7);
    if (IN(8)) { if (PROBE_PHASE == 8) peer_down(F, 3072); peer_down(F); } SEAM(8);
    if (IN(9)) { REP(9) peer_coef_probe(F, (PROBE_PHASE == 9) && rep_ == 0); } SEAM(9);
    if (IN(10)) { if (PROBE_PHASE == 10) peer_up(F, 3584, true); peer_up(F); }
#undef IN
#undef SEAM
}

#ifndef MK_N_LAUNCHES
#define MK_N_LAUNCHES 1
#endif
extern "C" void kernel_launch(void* const* d_in, const int* in_sizes, int n_in, void* d_out, int out_size, void* d_ws, size_t ws_size, hipStream_t stream) {
    static int grid = 0;
    if (grid == 0) {
        if (n_in != 16 || in_sizes[0] != T * DM || out_size != T * DM || ws_size < WS_END) { fprintf(stderr, "kernel_launch: unexpected shapes (n_in %d, in0 %d, out %d, ws %zu)\n", n_in, n_in > 0 ? in_sizes[0] : -1, out_size, ws_size); grid = -1; return; }
        int dev = 0, cus = 0, per_cu = 0;
        if (hipGetDevice(&dev) != hipSuccess || hipDeviceGetAttribute(&cus, hipDeviceAttributeMultiprocessorCount, dev) != hipSuccess) { grid = -1; return; }
        if (hipFuncSetAttribute((const void*)fwd_kernel, hipFuncAttributeMaxDynamicSharedMemorySize, LDS_BYTES) != hipSuccess) { fprintf(stderr, "kernel_launch: hipFuncSetAttribute failed\n"); grid = -1; return; }
        if (hipOccupancyMaxActiveBlocksPerMultiprocessor(&per_cu, (const void*)fwd_kernel, 512, LDS_BYTES) != hipSuccess || per_cu < 1) { fprintf(stderr, "kernel_launch: occupancy query says %d\n", per_cu); per_cu = 1; }
        (void)hipGetLastError();
        grid = cus;
    }
    if (grid < 0) return;
    if (hipMemsetAsync(d_ws, 0, 65536, stream) != hipSuccess) { fprintf(stderr, "kernel_launch: hipMemsetAsync failed\n"); return; }
    Args a{};
    for (int i = 0; i < 16; ++i) a.in[i] = (const float*)d_in[i];
    a.out = (float*)d_out; a.ws = (unsigned char*)d_ws;
    if (MK_N_LAUNCHES == 1) {
        a.ph_lo = 0; a.ph_hi = NPHASE; a.coop = 1; void* kargs[] = {&a};
        hipError_t e = hipLaunchCooperativeKernel((const void*)fwd_kernel, dim3(grid), dim3(512), kargs, LDS_BYTES, stream);
        if (e != hipSuccess) fprintf(stderr, "kernel_launch: cooperative launch failed: %s (grid %d)\n", hipGetErrorString(e), grid);
    } else {
        for (int p = 0; p < NPHASE; ++p) { a.ph_lo = p; a.ph_hi = p + 1; a.coop = 0; hipLaunchKernelGGL(fwd_kernel, dim3(grid), dim3(512), LDS_BYTES, stream, a); }
        const hipError_t le = hipPeekAtLastError(); if (le != hipSuccess) fprintf(stderr, "kernel_launch: launch failed: %s\n", hipGetErrorName(le));
    }
}
```

```cpp
#include <hip/hip_runtime.h>
#include <hip/hip_cooperative_groups.h>
#include <cstdio>
#include <cstdint>
namespace cg = cooperative_groups;
namespace pg8 {
#define PG8_LAS __attribute__((address_space(3)))
typedef unsigned short bf16_t;
typedef short bf16x8 __attribute__((ext_vector_type(8)));
typedef float f32x4 __attribute__((ext_vector_type(4)));
typedef unsigned u32x4 __attribute__((ext_vector_type(4)));
constexpr int BM = 256, BK = 64, HALF = 128, HTB = HALF * BK * 2  , STAGE_BYTES = 8 * HTB, NXCD = 8, WGM = 8;

__host__ __device__ __forceinline__ int lds_byte(int r, int c) { const int st = (r >> 4) * 2 + (c >> 5), rr = r & 15, cc = c & 31, ob = rr * 64 + cc * 2; return st * 1024 + (ob ^ (((ob >> 9) & 1) << 5)); }
__host__ __device__ __forceinline__ void stage_rc(int b, int& R, int& C) { const int st = b / 1024, sb = b % 1024, swz = sb ^ (((sb >> 9) & 1) << 5); R = (st >> 1) * 16 + swz / 64; C = (st & 1) * 32 + (swz % 64) / 2; }
__host__ __device__ __forceinline__ int perm32(int rho) { const int n = rho >> 4, i = rho & 15; return 8 * (i >> 2) + 4 * n + (i & 3); }

struct Unit { int pm, pn; };
struct Gemm { const bf16_t* A; const bf16_t* Bt; int M, N, K; };

struct StaticOrder {
    int nM, nN, nwg, G, c;
    __host__ __device__ void init(int M, int N, int G_, int c_) { nM = M / BM; nN = N / BM; nwg = nM * nN; G = G_; c = c_; }
    __host__ __device__ bool next(int i, Unit& u) const {
        const long L = (long)i * G + c; if (L >= nwg) return false;
        int wgid = (int)L; { const int q = nwg / NXCD, r = nwg % NXCD, xcd = wgid % NXCD, off = wgid / NXCD; wgid = (xcd < r ? xcd * (q + 1) : r * (q + 1) + (xcd - r) * q) + off; }
        const int nig = WGM * nN, gid = wgid / nig, fm = gid * WGM, gsz = (nM - fm) < WGM ? (nM - fm) : WGM;
        u.pm = fm + ((wgid % nig) % gsz); u.pn = (wgid % nig) / gsz; return true;
    }
    __device__ __forceinline__ void a_ready(const Unit&) const {}
    __device__ __forceinline__ void done(const Unit&) const {}
};
__device__ __forceinline__ unsigned cvt_pk_bf16(float lo, float hi) { unsigned r; asm volatile("v_cvt_pk_bf16_f32 %0, %1, %2" : "=v"(r) : "v"(lo), "v"(hi)); return r; }
typedef int i32x4 __attribute__((ext_vector_type(4)));
template <bool I8> struct AccT { typedef f32x4 type; };
template <> struct AccT<true> { typedef i32x4 type; };
struct EpiRowScaleBf16 {
    static constexpr bool PERM = true, AFTER_DRAIN = false;
    bf16_t* O; int ldc; const float* rs;
    __device__ __forceinline__ void operator()(const f32x4 (&acc)[2][2][4][2], const Unit& u, int wr, int wc, int fr, int fq) const {
        const int row0 = u.pm * BM + wr * 64 + fr, col0 = u.pn * BM + wc * 32 + 8 * fq;
#pragma unroll
        for (int ai = 0; ai < 2; ++ai)
#pragma unroll
            for (int m = 0; m < 4; ++m) { const int row = row0 + ai * HALF + m * 16; const float s = rs ? rs[row] : 1.f; bf16_t* rowp = O + (size_t)row * ldc + col0;
#pragma unroll
                for (int bj = 0; bj < 2; ++bj) { const f32x4 v0 = acc[ai][bj][m][0] * s, v1 = acc[ai][bj][m][1] * s;
                    u32x4 w; w.x = cvt_pk_bf16(v0[0], v0[1]); w.y = cvt_pk_bf16(v0[2], v0[3]); w.z = cvt_pk_bf16(v1[0], v1[1]); w.w = cvt_pk_bf16(v1[2], v1[3]);
                    *(u32x4*)(rowp + bj * HALF) = w; } }
    }
};
struct EpiI8Bf16 {
    static constexpr bool PERM = true, AFTER_DRAIN = false;
    bf16_t* O; int ldc; const float* rs; const float* cs;
    __device__ __forceinline__ void operator()(const i32x4 (&acc)[2][2][4][2], const Unit& u, int wr, int wc, int fr, int fq) const {
        const int row0 = u.pm * BM + wr * 64 + fr, col0 = u.pn * BM + wc * 32 + 8 * fq;
        f32x4 cv[2][2];
#pragma unroll
        for (int bj = 0; bj < 2; ++bj) { cv[bj][0] = *(const f32x4*)(cs + col0 + bj * HALF); cv[bj][1] = *(const f32x4*)(cs + col0 + bj * HALF + 4); }
#pragma unroll
        for (int ai = 0; ai < 2; ++ai)
#pragma unroll
            for (int m = 0; m < 4; ++m) { const int row = row0 + ai * HALF + m * 16; const float s = rs[row]; bf16_t* rowp = O + (size_t)row * ldc + col0;
#pragma unroll
                for (int bj = 0; bj < 2; ++bj) { const i32x4 a0 = acc[ai][bj][m][0], a1 = acc[ai][bj][m][1]; const f32x4 c0 = cv[bj][0] * s, c1 = cv[bj][1] * s;
                    u32x4 w; w.x = cvt_pk_bf16((float)a0[0] * c0[0], (float)a0[1] * c0[1]); w.y = cvt_pk_bf16((float)a0[2] * c0[2], (float)a0[3] * c0[3]);
                    w.z = cvt_pk_bf16((float)a1[0] * c1[0], (float)a1[1] * c1[1]); w.w = cvt_pk_bf16((float)a1[2] * c1[2], (float)a1[3] * c1[3]);
                    *(u32x4*)(rowp + bj * HALF) = w; } }
    }
};
struct EpiResid {
    static constexpr bool PERM = true, AFTER_DRAIN = false;
    const float* x; float* out; bf16_t* xb; float* ssp; int ldc;
    __device__ __forceinline__ void operator()(const f32x4 (&acc)[2][2][4][2], const Unit& u, int wr, int wc, int fr, int fq) const {
        const int row0 = u.pm * BM + wr * 64 + fr, col0 = u.pn * BM + wc * 32 + 8 * fq;
#pragma unroll
        for (int ai = 0; ai < 2; ++ai)
#pragma unroll
            for (int m = 0; m < 4; ++m) { const int row = row0 + ai * HALF + m * 16; const size_t off = (size_t)row * ldc + col0; float ss = 0.f;
#pragma unroll
                for (int bj = 0; bj < 2; ++bj) { const f32x4 xa = *(const f32x4*)(x + off + bj * HALF), xc = *(const f32x4*)(x + off + bj * HALF + 4);
                    const f32x4 v0 = acc[ai][bj][m][0] + xa, v1 = acc[ai][bj][m][1] + xc;
                    u32x4 w; w.x = cvt_pk_bf16(v0[0], v0[1]); w.y = cvt_pk_bf16(v0[2], v0[3]); w.z = cvt_pk_bf16(v1[0], v1[1]); w.w = cvt_pk_bf16(v1[2], v1[3]);
                    *(u32x4*)(xb + off + bj * HALF) = w;
                    ss += (v0[0] * v0[0] + v0[1] * v0[1]) + (v0[2] * v0[2] + v0[3] * v0[3]) + (v1[0] * v1[0] + v1[1] * v1[1]) + (v1[2] * v1[2] + v1[3] * v1[3]); }
                ss += __shfl_xor(ss, 16); ss += __shfl_xor(ss, 32);
                if (fq == 0) ssp[(size_t)row * 32 + u.pn * 4 + wc] = ss; }
    }
};
template <class Epi, class Sched, bool ALIGN_EPI = false, bool SP2 = false, bool I8 = false>
__device__ __forceinline__ void gemm_phase(PG8_LAS unsigned char* lds, const Gemm g, const Sched& S, const Epi& E) {
    const int tid = threadIdx.x, wid = __builtin_amdgcn_readfirstlane(tid >> 6), lane = tid & 63, wr = wid >> 2, wc = wid & 3, fr = lane & 15, fq = lane >> 4;
    const int K = g.K, nt = K / BK;
    unsigned voffA[2], voffB[2];
#pragma unroll
    for (int i = 0; i < 2; ++i) { int R, C; stage_rc(tid * 16 + i * 8192, R, C); const int Rb = Epi::PERM ? ((R & ~31) + perm32(R & 31)) : R;
        voffA[i] = (unsigned)(R * K + C) * 2u; voffB[i] = (unsigned)(Rb * K + C) * 2u; }
    const size_t kstep = (size_t)(BK * 2);
    const size_t hstep = (size_t)HALF * K * 2;
    const size_t tstep = 2 * hstep;
    const unsigned ldsw = (unsigned)wid * 1024u;
    const int aoff = lds_byte(wr * 64 + fr, fq * 8), boff = lds_byte(wc * 32 + fr, fq * 8);
#define PG8_SA(b, h) (((b) * 2 + (h)) * HTB)
#define PG8_SB(b, h) ((4 + (b) * 2 + (h)) * HTB)
#define PG8_STAGE(bufoff, gbase, voff) do { _Pragma("unroll") for (int _i = 0; _i < 2; ++_i) \
        __builtin_amdgcn_global_load_lds((const unsigned*)((const char*)(gbase) + (voff)[_i]), (PG8_LAS unsigned*)(lds + (bufoff) + ldsw + _i * 8192), 16, 0, 0); } while (0)
#define PG8_LDA(dst, b, h) do { _Pragma("unroll") for (int m = 0; m < 4; ++m) _Pragma("unroll") for (int k = 0; k < 2; ++k) dst[m][k] = *(const PG8_LAS bf16x8*)(lds + PG8_SA(b, h) + aoff + m * 2048 + k * 1024); } while (0)
#define PG8_LDB(dst, b, h) do { _Pragma("unroll") for (int n = 0; n < 2; ++n) _Pragma("unroll") for (int k = 0; k < 2; ++k) dst[n][k] = *(const PG8_LAS bf16x8*)(lds + PG8_SB(b, h) + boff + n * 2048 + k * 1024); } while (0)
#define PG8_MMA(ai, bj, At, Bt) do { __builtin_amdgcn_s_setprio(1); _Pragma("unroll") for (int m = 0; m < 4; ++m) _Pragma("unroll") for (int n = 0; n < 2; ++n) _Pragma("unroll") for (int k = 0; k < 2; ++k) { \
        if constexpr (I8) acc[ai][bj][m][n] = __builtin_amdgcn_mfma_i32_16x16x64_i8(__builtin_bit_cast(i32x4, Bt[n][k]), __builtin_bit_cast(i32x4, At[m][k]), acc[ai][bj][m][n], 0, 0, 0); \
        else acc[ai][bj][m][n] = __builtin_amdgcn_mfma_f32_16x16x32_bf16(Bt[n][k], At[m][k], acc[ai][bj][m][n], 0, 0, 0); } __builtin_amdgcn_s_setprio(0); } while (0)
#define PG8_WAIT_V(n) asm volatile("s_waitcnt vmcnt(" #n ")" ::: "memory")
#define PG8_WAIT_L(n) asm volatile("s_waitcnt lgkmcnt(" #n ")" ::: "memory")
#define PG8_BAR __builtin_amdgcn_s_barrier()
#define PG8_SCHED __builtin_amdgcn_sched_barrier(0)
    Unit cur, nxt; int ui = 0;
    if (!S.next(0, cur)) return;
    typename AccT<I8>::type acc[2][2][4][2];
#pragma unroll
    for (int a = 0; a < 2; ++a)
#pragma unroll
        for (int b = 0; b < 2; ++b)
#pragma unroll
            for (int m = 0; m < 4; ++m)
#pragma unroll
                for (int n = 0; n < 2; ++n) acc[a][b][m][n] = (typename AccT<I8>::type){};
    bf16x8 At[4][2], B0[2][2], B1[2][2];
    const char* cA = (const char*)g.A + (size_t)cur.pm * tstep; const char* cB = (const char*)g.Bt + (size_t)cur.pn * tstep;
    S.a_ready(cur);
    if constexpr (SP2) {
        PG8_STAGE(PG8_SB(0, 0), cB, voffB); PG8_STAGE(PG8_SB(0, 1), cB + hstep, voffB); PG8_STAGE(PG8_SA(0, 0), cA, voffA); PG8_STAGE(PG8_SA(0, 1), cA + hstep, voffA);
        if (wr == 1) PG8_BAR;
        PG8_WAIT_V(2); PG8_BAR;
        PG8_STAGE(PG8_SB(1, 0), cB + kstep, voffB); PG8_STAGE(PG8_SA(1, 0), cA + kstep, voffA); PG8_STAGE(PG8_SB(1, 1), cB + hstep + kstep, voffB);
        PG8_WAIT_V(6); PG8_BAR;
    } else {
        PG8_STAGE(PG8_SB(0, 0), cB, voffB); PG8_STAGE(PG8_SA(0, 0), cA, voffA); PG8_STAGE(PG8_SB(0, 1), cB + hstep, voffB); PG8_STAGE(PG8_SA(0, 1), cA + hstep, voffA);
        if (wr == 1) PG8_BAR;
        PG8_WAIT_V(4); PG8_BAR;
        PG8_STAGE(PG8_SB(1, 0), cB + kstep, voffB); PG8_STAGE(PG8_SA(1, 0), cA + kstep, voffA); PG8_STAGE(PG8_SB(1, 1), cB + hstep + kstep, voffB);
        PG8_WAIT_V(6); PG8_BAR;
    }
    for (;;) {
        const bool has_next = S.next(ui + 1, nxt);
        const char* nA = has_next ? (const char*)g.A + (size_t)nxt.pm * tstep : cA; const char* nB = has_next ? (const char*)g.Bt + (size_t)nxt.pn * tstep : cB;
        for (int t = 0; t < nt; t += 2) {
            const bool last = (t == nt - 2);
            const char* a1 = cA + (size_t)(t + 1) * kstep;
            const char* a2 = last ? nA : cA + (size_t)(t + 2) * kstep; const char* b2 = last ? nB : cB + (size_t)(t + 2) * kstep;
            const char* a3 = a2 + kstep; const char* b3 = b2 + kstep;
            if (last && has_next) S.a_ready(nxt);
            if constexpr (SP2) {
            PG8_LDB(B0, 0, 0); PG8_LDB(B1, 0, 1); PG8_SCHED; PG8_LDA(At, 0, 0); PG8_STAGE(PG8_SA(1, 1), a1 + hstep, voffA);
            PG8_WAIT_V(8); PG8_WAIT_L(0); PG8_BAR; PG8_MMA(0, 0, At, B0); PG8_MMA(0, 1, At, B1); PG8_BAR; PG8_SCHED;
            PG8_LDA(At, 0, 1); PG8_STAGE(PG8_SB(0, 0), b2, voffB); PG8_STAGE(PG8_SB(0, 1), b2 + hstep, voffB); PG8_STAGE(PG8_SA(0, 0), a2, voffA);
            PG8_WAIT_V(8); PG8_WAIT_L(0); PG8_BAR; PG8_MMA(1, 0, At, B0); PG8_MMA(1, 1, At, B1); PG8_BAR; PG8_SCHED;
            PG8_LDB(B0, 1, 0); PG8_LDB(B1, 1, 1); PG8_SCHED; PG8_LDA(At, 1, 0); PG8_STAGE(PG8_SA(0, 1), a2 + hstep, voffA);
            PG8_WAIT_V(8); PG8_WAIT_L(0); PG8_BAR; PG8_MMA(0, 0, At, B0); PG8_MMA(0, 1, At, B1); PG8_BAR; PG8_SCHED;
            PG8_LDA(At, 1, 1); PG8_STAGE(PG8_SB(1, 0), b3, voffB); PG8_STAGE(PG8_SB(1, 1), b3 + hstep, voffB); PG8_STAGE(PG8_SA(1, 0), a3, voffA);
            PG8_WAIT_V(8); PG8_WAIT_L(0); PG8_BAR; PG8_MMA(1, 0, At, B0); PG8_MMA(1, 1, At, B1); PG8_BAR; PG8_SCHED;
            } else {
            PG8_LDB(B0, 0, 0); PG8_SCHED; PG8_LDA(At, 0, 0); PG8_STAGE(PG8_SA(1, 1), a1 + hstep, voffA);
            PG8_WAIT_L(8); PG8_BAR; PG8_WAIT_L(0); PG8_MMA(0, 0, At, B0); PG8_BAR; PG8_SCHED;
            PG8_LDB(B1, 0, 1); PG8_STAGE(PG8_SB(0, 0), b2, voffB);
            PG8_BAR; PG8_WAIT_L(0); PG8_MMA(0, 1, At, B1); PG8_BAR;
            PG8_LDA(At, 0, 1); PG8_STAGE(PG8_SA(0, 0), a2, voffA);
            PG8_BAR; PG8_WAIT_L(0); PG8_MMA(1, 0, At, B0); PG8_BAR; PG8_SCHED;
            PG8_STAGE(PG8_SB(0, 1), b2 + hstep, voffB);
            PG8_WAIT_V(6); PG8_BAR; PG8_MMA(1, 1, At, B1); PG8_BAR;
            PG8_LDB(B0, 1, 0); PG8_SCHED; PG8_LDA(At, 1, 0); PG8_STAGE(PG8_SA(0, 1), a2 + hstep, voffA);
            PG8_WAIT_L(8); PG8_BAR; PG8_WAIT_L(0); PG8_MMA(0, 0, At, B0); PG8_BAR; PG8_SCHED;
            PG8_LDB(B1, 1, 1); PG8_STAGE(PG8_SB(1, 0), b3, voffB);
            PG8_BAR; PG8_WAIT_L(0); PG8_MMA(0, 1, At, B1); PG8_BAR;
            PG8_LDA(At, 1, 1); PG8_STAGE(PG8_SA(1, 0), a3, voffA);
            PG8_BAR; PG8_WAIT_L(0); PG8_MMA(1, 0, At, B0); PG8_BAR; PG8_SCHED;
            PG8_STAGE(PG8_SB(1, 1), b3 + hstep, voffB);
            PG8_WAIT_V(6); PG8_BAR; PG8_MMA(1, 1, At, B1); PG8_BAR;
            }
        }
        if constexpr (ALIGN_EPI) { if (wr == 0) PG8_BAR; }
        if constexpr (!Epi::AFTER_DRAIN) { E(acc, cur, wr, wc, fr, fq); S.done(cur); }
        if (!has_next) break;
#pragma unroll
        for (int a = 0; a < 2; ++a)
#pragma unroll
            for (int b = 0; b < 2; ++b)
#pragma unroll
                for (int m = 0; m < 4; ++m)
#pragma unroll
                    for (int n = 0; n < 2; ++n) acc[a][b][m][n] = (typename AccT<I8>::type){};
        cur = nxt; cA = nA; cB = nB; ++ui;
        if constexpr (ALIGN_EPI) { if (wr == 1) PG8_BAR; }
    }
    PG8_WAIT_V(0);
    if constexpr (!ALIGN_EPI) { if (wr == 0) PG8_BAR; }
    PG8_BAR;
    if constexpr (Epi::AFTER_DRAIN) { E.fused(acc, cur, wr, wc, fr, fq, lds, wid, lane); S.done(cur); }
#undef PG8_SA
#undef PG8_SB
#undef PG8_STAGE
#undef PG8_LDA
#undef PG8_LDB
#undef PG8_MMA
#undef PG8_WAIT_V
#undef PG8_WAIT_L
#undef PG8_BAR
#undef PG8_SCHED
}
}
#ifndef PG8_SP2
#define PG8_SP2 true
#endif
#ifndef PG8_ALIGN
#define PG8_ALIGN true
#endif

constexpr int BATCH = 2, SEQ = 16384, DM = 2048, T = BATCH * SEQ;
constexpr int INW = 6176, HP = 6400;
constexpr int C_QA = 0, C_KA = 256, C_VA = 512, C_RA = 1024, C_QD = 1536, C_KD = 3072, C_VD = 4608, C_GF = 6144;
constexpr int NHD = 12;
constexpr float EPS = 1e-6f;
constexpr float LOG2E = 1.4426950408889634f;
constexpr float QSCALE = 0.08838834764831845f * LOG2E;
constexpr int NPHASE = 11;

constexpr size_t MiB = 1u << 20;
constexpr size_t WS_CTL = 0, WS_ROPE = 1 * MiB, WS_RS1 = 3 * MiB, WS_RS2 = 3 * MiB + 512 * 1024, WS_SSP = 4 * MiB, WS_WIN = 8 * MiB, WS_WO = 33 * MiB, WS_WQ = 41 * MiB,
                 WS_SK = 49 * MiB, WS_DEC = 50 * MiB, WS_LP = 51 * MiB, WS_IDX = 56 * MiB, WS_GATE = 72 * MiB, WS_DOWN = 88 * MiB, WS_UP = 152 * MiB, WS_XB = 216 * MiB,
                 WS_H = 344 * MiB, WS_X1B = WS_H, WS_QRY = WS_H + 128 * MiB, WS_OP1 = 744 * MiB, WS_OP2 = 840 * MiB, WS_PART = 472 * MiB  , WS_END = 984 * MiB;
constexpr size_t OUT_ST = 0, OUT_OP0 = 128 * MiB;
constexpr int LDS_BYTES = 147456;

#define LAS __attribute__((address_space(3)))
typedef unsigned short bf16_t;
typedef short bf16x8 __attribute__((ext_vector_type(8)));
typedef short s16x4 __attribute__((ext_vector_type(4)));
typedef float f32x4 __attribute__((ext_vector_type(4)));
typedef float f32x2 __attribute__((ext_vector_type(2)));
typedef float f32x16 __attribute__((ext_vector_type(16)));
typedef unsigned u32x4 __attribute__((ext_vector_type(4)));
typedef unsigned u32x2 __attribute__((ext_vector_type(2)));
#define LDS_WAIT() asm volatile("s_waitcnt lgkmcnt(0)" ::: "memory")
#define SBAR() __builtin_amdgcn_sched_barrier(0)

__device__ __forceinline__ float bf2f(unsigned short b) { return __uint_as_float(((unsigned)b) << 16); }
__device__ __forceinline__ float bflo(unsigned w) { return __uint_as_float(w << 16); }
__device__ __forceinline__ float bfhi(unsigned w) { return __uint_as_float(w & 0xffff0000u); }
__device__ __forceinline__ unsigned f2bf(float f) { unsigned u = __float_as_uint(f); return (u + 0x7fffu + ((u >> 16) & 1u)) >> 16; }
__device__ __forceinline__ unsigned pk2(float lo, float hi) { return pg8::cvt_pk_bf16(lo, hi); }
__device__ __forceinline__ float fexp(float x) { return __builtin_amdgcn_exp2f(x * LOG2E); }
__device__ __forceinline__ float flog(float x) { return __builtin_amdgcn_logf(x) * 0.6931471805599453f; }
__device__ __forceinline__ float wave_sum(float v) {
#pragma unroll
    for (int o = 1; o < 64; o <<= 1) v += __shfl_xor(v, o);
    return v;
}
__device__ __forceinline__ int crow(int r, int hi) { return (r & 3) + 8 * (r >> 2) + 4 * hi; }

struct Frame {
    LAS unsigned char* lds; char* ldsg; unsigned char* wsb;
    int tid, lane, wave, vcu, G;
    const float *x, *norm1_g, *w_in, *up_f, *bias_f, *up_b, *bias_b, *out_g, *qn_g, *kn_g, *w_out, *norm2_g, *w_query, *sub_keys, *peer_down, *peer_up;
    float* out;
    f32x2* rope; float *rs1, *rs2, *ssp, *dec, *lp, *gate, *sd, *su, *sx, *csum; int *idx, *part; unsigned char *down8, *up8, *xq8, *fq8; unsigned short* state;
    unsigned char *Win8, *xq1; float* sw; bf16_t *WinT, *WoT, *WqT, *SK, *down16, *up16, *xb, *mixed, *h, *x1b, *qry, *op0, *op1, *op2;
};

__device__ __forceinline__ void p0_transpose_item(const float* W, int K, int N, bf16_t* WT, int k0, int n0, int dst_row0, const float* g, LAS float* scr, int lane) {
#pragma unroll 8
    for (int i = 0; i < 32; ++i) { const int kk = 2 * i + (lane >> 5); float w = W[(size_t)(k0 + kk) * N + n0 + (lane & 31)]; if (g) w *= g[k0 + kk]; scr[kk * 33 + (lane & 31)] = w; }
    LDS_WAIT(); asm volatile("" ::: "memory");
    const int c = lane & 7;
#pragma unroll
    for (int j = 0; j < 4; ++j) { const int n = (lane >> 3) + 8 * j; const LAS float* s = scr + (8 * c) * 33 + n;
        u32x4 o; o.x = pk2(s[0 * 33], s[1 * 33]); o.y = pk2(s[2 * 33], s[3 * 33]); o.z = pk2(s[4 * 33], s[5 * 33]); o.w = pk2(s[6 * 33], s[7 * 33]);
        *(u32x4*)(WT + (size_t)(dst_row0 + n) * K + k0 + 8 * c) = o; }
    LDS_WAIT(); asm volatile("" ::: "memory");
}
template <bool isup> __device__ __forceinline__ void peer_quant_row(const Frame& F, int e) {
    const int lane = F.lane; const f32x4* src = (const f32x4*)((isup ? F.peer_up : F.peer_down) + (size_t)e * DM) + lane;
    f32x4 v[8]; float m = 0.f;
#pragma unroll
    for (int j = 0; j < 8; ++j) { v[j] = src[64 * j]; if (!isup) v[j] = v[j] * ((const f32x4*)F.norm2_g)[lane + 64 * j];
        m = fmaxf(fmaxf(m, fmaxf(fabsf(v[j][0]), fabsf(v[j][1]))), fmaxf(fabsf(v[j][2]), fabsf(v[j][3]))); }
#pragma unroll
    for (int o = 1; o < 64; o <<= 1) m = fmaxf(m, __shfl_xor(m, o));
    const float inv = m > 0.f ? 127.f / m : 0.f; unsigned char* dst = isup ? F.up8 : F.down8;
#pragma unroll
    for (int j = 0; j < 8; ++j) { unsigned w = 0u;
#pragma unroll
        for (int i = 0; i < 4; ++i) { const int qv = (int)rintf(v[j][i] * inv); w |= ((unsigned)qv & 0xffu) << (8 * i); }
        const int col = 4 * lane + 256 * j; *(unsigned*)(dst + ((size_t)(col >> 7) * 16384 + e) * 128 + (col & 127)) = w; }
    if (lane == 0) (isup ? F.su : F.sd)[e] = m * (1.f / 127.f);
}
__device__ __forceinline__ void phase0(const Frame& F) {
    LAS float* scr = (LAS float*)(F.lds + F.wave * 16384);
    const int gw = F.vcu * 8 + F.wave, NGW = F.G * 8, lane = F.lane;
    { LAS float* cmx = (LAS float*)(F.lds + 12288);
      for (int nb = F.vcu; nb < 193; nb += F.G) { const int n0 = nb * 32, drow = nb < 32 ? nb * 32 : (nb == 32 ? C_GF : nb * 32 - 32), kw = F.wave * 256;
        float m = 0.f;
#pragma unroll 16
        for (int i = 0; i < 128; ++i) { const int k = kw + 2 * i + (lane >> 5); m = fmaxf(m, fabsf(F.w_in[(size_t)k * INW + n0 + (lane & 31)] * F.norm1_g[k])); }
        m = fmaxf(m, __shfl_xor(m, 32)); if (lane < 32) cmx[F.wave * 32 + lane] = m;
        __syncthreads();
        if (F.tid < 32) { float mm = 0.f;
#pragma unroll
            for (int w = 0; w < 8; ++w) mm = fmaxf(mm, cmx[w * 32 + F.tid]);
            cmx[256 + F.tid] = mm > 0.f ? 127.f / mm : 0.f; F.sw[drow + F.tid] = mm * (1.f / 127.f); }
        __syncthreads();
        for (int ch = 0; ch < 4; ++ch) { const int k0 = kw + 64 * ch;
#pragma unroll 8
            for (int i = 0; i < 32; ++i) { const int kk = 2 * i + (lane >> 5); scr[kk * 33 + (lane & 31)] = F.w_in[(size_t)(k0 + kk) * INW + n0 + (lane & 31)] * F.norm1_g[k0 + kk] * cmx[256 + (lane & 31)]; }
            LDS_WAIT(); asm volatile("" ::: "memory");
            const int c = lane & 7;
#pragma unroll
            for (int j = 0; j < 4; ++j) { const int n = (lane >> 3) + 8 * j; const LAS float* sp = scr + (8 * c) * 33 + n; u32x2 w = {0u, 0u};
#pragma unroll
                for (int i = 0; i < 4; ++i) { w.x |= ((unsigned)(int)rintf(sp[i * 33]) & 0xffu) << (8 * i); w.y |= ((unsigned)(int)rintf(sp[(4 + i) * 33]) & 0xffu) << (8 * i); }
                *(u32x2*)(F.Win8 + (size_t)(drow + n) * DM + k0 + 8 * c) = w; }
            LDS_WAIT(); asm volatile("" ::: "memory"); }
        __syncthreads(); } }
    constexpr int I_O = 32 * 64, I_Q = 32 * 64;
    for (int it = gw; it < I_O + I_Q; it += NGW) {
        int r = it;
        if (r < I_O) { const int kb = r / 64, nb = r % 64; p0_transpose_item(F.w_out, DM, DM, F.WoT, kb * 64, nb * 32, nb * 32, nullptr, scr, lane); continue; }
        r -= I_O;
        { const int kb = r / 64, nb = r % 64; p0_transpose_item(F.w_query, DM, DM, F.WqT, kb * 64, nb * 32, nb * 32, F.norm2_g, scr, lane); }
    }
    const size_t gt = (size_t)gw * 64 + lane, NT = (size_t)NGW * 64;
    { u32x4* z = (u32x4*)(F.Win8 + (size_t)INW * DM); const u32x4 zero = {0u, 0u, 0u, 0u}; for (size_t i = gt; i < (size_t)(HP - INW) * DM / 16; i += NT) z[i] = zero; if (gt < (size_t)(HP - INW)) F.sw[INW + gt] = 0.f; }
    for (int r = gw; r < 16384; r += NGW) peer_quant_row<false>(F, r);
    for (int r = gw; r < 16384; r += NGW) peer_quant_row<true>(F, r);
    for (size_t i = gt; i < (size_t)8 * 2 * 128 * 128 / 8; i += NT) { const f32x4 a = *(const f32x4*)(F.sub_keys + i * 8), b = *(const f32x4*)(F.sub_keys + i * 8 + 4);
        u32x4 o; o.x = pk2(a[0], a[1]); o.y = pk2(a[2], a[3]); o.z = pk2(b[0], b[1]); o.w = pk2(b[2], b[3]); *(u32x4*)(F.SK + i * 8) = o; }
    for (int m = gw; m < T; m += NGW) { const f32x4* xr = (const f32x4*)(F.x + (size_t)m * DM) + lane; f32x4 v[8]; float s = 0.f, mx = 0.f;
#pragma unroll
        for (int j = 0; j < 8; ++j) { v[j] = xr[64 * j]; s += (v[j][0] * v[j][0] + v[j][1] * v[j][1]) + (v[j][2] * v[j][2] + v[j][3] * v[j][3]);
            mx = fmaxf(fmaxf(mx, fmaxf(fabsf(v[j][0]), fabsf(v[j][1]))), fmaxf(fabsf(v[j][2]), fabsf(v[j][3]))); }
        s = wave_sum(s);
#pragma unroll
        for (int o = 1; o < 64; o <<= 1) mx = fmaxf(mx, __shfl_xor(mx, o));
        const float inv = mx > 0.f ? 127.f / mx : 0.f; unsigned* o4 = (unsigned*)(F.xq1 + (size_t)m * DM) + lane;
#pragma unroll
        for (int j = 0; j < 8; ++j) { unsigned w = 0u;
#pragma unroll
            for (int i = 0; i < 4; ++i) w |= ((unsigned)(int)rintf(v[j][i] * inv) & 0xffu) << (8 * i);
            o4[64 * j] = w; }
        if (lane == 0) F.rs1[m] = __builtin_amdgcn_rsqf(s * (1.f / DM) + EPS) * (mx * (1.f / 127.f)); }
    { const double invf[16] = {1.0, 0.44036660267178046, 0.19392274474868576, 0.08539710028576561, 0.03760603093086393, 0.016560440080994446, 0.007292664737217109, 0.003211445994752591,
                               0.001414213562373095, 0.000622772421914596, 0.0002742481756762073, 0.00012076973741146504, 5.318295896944988e-05, 2.341999896140934e-05, 1.031338537721246e-05, 4.5416704806078695e-06};
      for (size_t i = gt; i < (size_t)SEQ * 16; i += NT) { const int pos = (int)(i >> 4), j = (int)(i & 15); double f = 1.0;
#pragma unroll
          for (int q = 0; q < 16; ++q) f = (j == q) ? invf[q] : f;
          const double rev = (double)pos * f * 0.15915494309189535; const float fr = (float)(rev - floor(rev));
          F.rope[i] = (f32x2){__builtin_amdgcn_cosf(fr), __builtin_amdgcn_sinf(fr)}; } }
}

__device__ __forceinline__ void qknorm_rope(const Frame& F) {
    const int gw = F.vcu * 8 + F.wave, NGW = F.G * 8, lane = F.lane, c = lane & 15;
    for (long it = gw; it < (long)T * 24 / 4; it += NGW) { const long row = it * 4 + (lane >> 4); const int t = (int)(row / 24), slot = (int)(row % 24);
        bf16_t* p = F.h + (size_t)t * HP + C_QD + slot * 128 + 8 * c;
        const u32x4 w = *(const u32x4*)p; float y[8] = {bflo(w.x), bfhi(w.x), bflo(w.y), bfhi(w.y), bflo(w.z), bfhi(w.z), bflo(w.w), bfhi(w.w)};
        float ss = 0.f;
#pragma unroll
        for (int e = 0; e < 8; ++e) ss += y[e] * y[e];
        ss += __shfl_xor(ss, 1); ss += __shfl_xor(ss, 2); ss += __shfl_xor(ss, 4); ss += __shfl_xor(ss, 8);
        const float rq = __builtin_amdgcn_rsqf(ss * (1.f / 128.f) + EPS); const float* g = (slot < 12 ? F.qn_g : F.kn_g) + 8 * c;
        const f32x4 g0 = *(const f32x4*)g, g1 = *(const f32x4*)(g + 4);
#pragma unroll
        for (int e = 0; e < 4; ++e) { y[e] *= rq * g0[e]; y[4 + e] *= rq * g1[e]; }
        const int pos = t & (SEQ - 1);
#pragma unroll
        for (int e = 0; e < 8; ++e) { const float partner = __shfl_xor(y[e], 2);
            if (c < 4) { const f32x2 cs = F.rope[(size_t)pos * 16 + 8 * (c & 1) + e]; y[e] = (c < 2) ? (y[e] * cs.x - partner * cs.y) : (y[e] * cs.x + partner * cs.y); } }
        if (slot < 12) {
#pragma unroll
            for (int e = 0; e < 8; ++e) y[e] *= QSCALE; }
        u32x4 o; o.x = pk2(y[0], y[1]); o.y = pk2(y[2], y[3]); o.z = pk2(y[4], y[5]); o.w = pk2(y[6], y[7]); *(u32x4*)p = o; }
}

constexpr int GL_GDS = 0, GL_TOT = 8192, GL_QF = 12288, GL_QB = 21504, GL_KF = 30720, GL_KB = 39936, GL_VT = 49152, GL_P = 67584, GL_SF = 76800, GL_SB = 95232, GL_OB = 12288;
constexpr int RS72 = 144;
__device__ __forceinline__ float logsig(float z) { return fminf(z, 0.f) - flog(1.f + fexp(-fabsf(z))); }
__device__ __forceinline__ void gla_gates(const Frame& F, int b, int hh, int n, float (&bf)[8], float (&bb)[8], float& totf, float& totb) {
    const int tid = F.tid, c = tid & 63, ig = F.wave; LAS float* gds = (LAS float*)(F.lds + GL_GDS); LAS float* tot = (LAS float*)(F.lds + GL_TOT);
    const size_t t0 = (size_t)b * SEQ + (size_t)n * 64;
    if (tid < 256) { const int tk = tid >> 2, part = tid & 3; const u32x4 w = *(const u32x4*)(F.h + (t0 + tk) * HP + C_GF + part * 8); LAS float* d = gds + tk * 32 + part * 8;
        d[0] = bflo(w.x); d[1] = bfhi(w.x); d[2] = bflo(w.y); d[3] = bfhi(w.y); d[4] = bflo(w.z); d[5] = bfhi(w.z); d[6] = bflo(w.w); d[7] = bfhi(w.w); }
    __syncthreads();
    const int hc = hh * 64 + c; float upf[16], upb[16];
#pragma unroll
    for (int r = 0; r < 16; ++r) { upf[r] = F.up_f[r * 256 + hc]; upb[r] = F.up_b[r * 256 + hc]; }
    const float biasf = F.bias_f[hc], biasb = F.bias_b[hc]; float laf[8], lab[8];
#pragma unroll
    for (int e = 0; e < 8; ++e) { const LAS float* gr = gds + (ig * 8 + e) * 32; float zf = biasf, zb = biasb;
#pragma unroll
        for (int r = 0; r < 16; ++r) { zf += gr[r] * upf[r]; zb += gr[16 + r] * upb[r]; }
        laf[e] = logsig(zf) * 0.0625f; lab[e] = logsig(zb) * 0.0625f; }
    bf[0] = laf[0];
#pragma unroll
    for (int e = 1; e < 8; ++e) bf[e] = bf[e - 1] + laf[e];
    bb[7] = lab[7];
#pragma unroll
    for (int e = 6; e >= 0; --e) bb[e] = bb[e + 1] + lab[e];
    tot[ig * 64 + c] = bf[7]; tot[512 + ig * 64 + c] = bb[0];
    __syncthreads();
    float offf = 0.f, offb = 0.f; totf = 0.f; totb = 0.f;
#pragma unroll
    for (int g = 0; g < 8; ++g) { const float tf = tot[g * 64 + c], tb = tot[512 + g * 64 + c]; totf += tf; totb += tb; offf += (g < ig) ? tf : 0.f; offb += (g > ig) ? tb : 0.f; }
#pragma unroll
    for (int e = 0; e < 8; ++e) { bf[e] += offf; bb[e] += offb; }
}
__device__ __forceinline__ void gla_stage_vT(const Frame& F, const bf16x8 (&vraw)[2]) {
#pragma unroll
    for (int j = 0; j < 2; ++j) { const int q = F.tid + 512 * j, tk = q >> 4, vc = (q & 15) * 8; LAS short* d = (LAS short*)(F.lds + GL_VT) + vc * 72 + tk;
#pragma unroll
        for (int e = 0; e < 8; ++e) d[e * 72] = vraw[j][e]; }
}
__device__ __forceinline__ bf16x8 ldfrag(const LAS unsigned char* base, int row, int s, int hi) { return *(const LAS bf16x8*)(base + row * RS72 + (16 * s + 8 * hi) * 2); }

__device__ __forceinline__ void gla_passA(const Frame& F, int item) {
    const int bh = item >> 8, n = item & 255, b = bh >> 2, hh = bh & 3, tid = F.tid, c = tid & 63, ig = F.wave, lane = F.lane, r32 = lane & 31, hi = lane >> 5;
    const size_t t0 = (size_t)b * SEQ + (size_t)n * 64;
    unsigned short kraw[8]; bf16x8 vraw[2];
#pragma unroll
    for (int e = 0; e < 8; ++e) kraw[e] = F.h[(t0 + ig * 8 + e) * HP + C_KA + hh * 64 + c];
#pragma unroll
    for (int j = 0; j < 2; ++j) { const int q = tid + 512 * j; vraw[j] = *(const bf16x8*)(F.h + (t0 + (q >> 4)) * HP + C_VA + hh * 128 + (q & 15) * 8); }
    float bf[8], bb[8], totf, totb; gla_gates(F, b, hh, n, bf, bb, totf, totb);
    float kf[8], kb[8];
#pragma unroll
    for (int e = 0; e < 8; ++e) { const float k = bf2f(kraw[e]); kf[e] = k * fexp(totf - bf[e]); kb[e] = k * fexp(totb - bb[e]); }
    { u32x4 o; o.x = pk2(kf[0], kf[1]); o.y = pk2(kf[2], kf[3]); o.z = pk2(kf[4], kf[5]); o.w = pk2(kf[6], kf[7]); *(LAS u32x4*)(F.lds + GL_KF + c * RS72 + ig * 16) = o;
      o.x = pk2(kb[0], kb[1]); o.y = pk2(kb[2], kb[3]); o.z = pk2(kb[4], kb[5]); o.w = pk2(kb[6], kb[7]); *(LAS u32x4*)(F.lds + GL_KB + c * RS72 + ig * 16) = o; }
    gla_stage_vT(F, vraw);
    if (ig == 0) { F.dec[((size_t)(0 * 8 + bh) * 256 + n) * 64 + c] = fexp(totf); F.dec[((size_t)(1 * 8 + bh) * 256 + n) * 64 + c] = fexp(totb); }
    __syncthreads();
    const int dir = F.wave >> 2, vt = F.wave & 3; const LAS unsigned char* kimg = F.lds + (dir ? GL_KB : GL_KF);
    f32x16 a0 = {}, a1 = {};
#pragma unroll
    for (int s = 0; s < 4; ++s) { const bf16x8 av = ldfrag(F.lds + GL_VT, 32 * vt + r32, s, hi), b0 = ldfrag(kimg, r32, s, hi), b1 = ldfrag(kimg, 32 + r32, s, hi);
        a0 = __builtin_amdgcn_mfma_f32_32x32x16_bf16(av, b0, a0, 0, 0, 0); a1 = __builtin_amdgcn_mfma_f32_32x32x16_bf16(av, b1, a1, 0, 0, 0); }
    unsigned short* st = F.state + ((size_t)(dir * 8 + bh) * 256 + n) * 8192;
#pragma unroll
    for (int r = 0; r < 16; ++r) { const int v = 32 * vt + crow(r, hi); st[v * 64 + r32] = (unsigned short)f2bf(a0[r]); st[v * 64 + 32 + r32] = (unsigned short)f2bf(a1[r]); }
    __syncthreads();
}
__device__ __forceinline__ void gla_scan(const Frame& F, int item) {
    const int dir = item >> 7, bh = (item >> 4) & 7, e = (item & 15) * 512 + F.tid, c = e & 63;
    unsigned short* st = F.state + (size_t)(dir * 8 + bh) * 256 * 8192 + e; const float* dc = F.dec + (size_t)(dir * 8 + bh) * 256 * 64 + c; float S = 0.f;
    float iA[16], dA[16], iB[16], dB[16];
#define SC_N(g, j) (dir ? 255 - ((g) * 16 + (j)) : (g) * 16 + (j))
#define SC_LOAD(I_, D_, g) do { _Pragma("unroll") for (int j = 0; j < 16; ++j) { const int n_ = SC_N(g, j); I_[j] = bf2f(st[(size_t)n_ * 8192]); D_[j] = dc[n_ * 64]; } } while (0)
#define SC_RUN(I_, D_, g) do { _Pragma("unroll") for (int j = 0; j < 16; ++j) { const int n_ = SC_N(g, j); st[(size_t)n_ * 8192] = (unsigned short)f2bf(S); S = D_[j] * S + I_[j]; } } while (0)
    SC_LOAD(iA, dA, 0);
    for (int g = 0; g < 16; g += 2) { SC_LOAD(iB, dB, g + 1); SC_RUN(iA, dA, g); if (g + 2 < 16) SC_LOAD(iA, dA, g + 2); SC_RUN(iB, dB, g + 1); }
#undef SC_N
#undef SC_LOAD
#undef SC_RUN
}
__device__ __forceinline__ void gla_passC(const Frame& F, int item) {
    const int bh = item >> 8, n = item & 255, b = bh >> 2, hh = bh & 3, tid = F.tid, c = tid & 63, ig = F.wave, lane = F.lane, r32 = lane & 31, hi = lane >> 5;
    const size_t t0 = (size_t)b * SEQ + (size_t)n * 64;
    unsigned short qraw[8], kraw[8]; bf16x8 vraw[2]; u32x4 sraw[2][2];
#pragma unroll
    for (int e = 0; e < 8; ++e) { const bf16_t* hr = F.h + (t0 + ig * 8 + e) * HP + hh * 64 + c; qraw[e] = hr[C_QA]; kraw[e] = hr[C_KA]; }
#pragma unroll
    for (int j = 0; j < 2; ++j) { const int q = tid + 512 * j; vraw[j] = *(const bf16x8*)(F.h + (t0 + (q >> 4)) * HP + C_VA + hh * 128 + (q & 15) * 8);
#pragma unroll
        for (int dir = 0; dir < 2; ++dir) sraw[dir][j] = *(const u32x4*)(F.state + ((size_t)(dir * 8 + bh) * 256 + n) * 8192 + (q >> 3) * 64 + (q & 7) * 8); }
    float bf[8], bb[8], totf, totb; gla_gates(F, b, hh, n, bf, bb, totf, totb);
#pragma unroll
    for (int e = 0; e < 8; ++e) { const int i = ig * 8 + e; const float q = bf2f(qraw[e]) * 0.125f, k = bf2f(kraw[e]);
        const float ef = fexp(bf[e]), eb = fexp(bb[e]), nf = fexp(-bf[e]), nb = fexp(-bb[e]);
        *(LAS unsigned short*)(F.lds + GL_QF + i * RS72 + c * 2) = (unsigned short)f2bf(q * ef); *(LAS unsigned short*)(F.lds + GL_QB + i * RS72 + c * 2) = (unsigned short)f2bf(q * eb);
        *(LAS unsigned short*)(F.lds + GL_KF + i * RS72 + c * 2) = (unsigned short)f2bf(k * nf); *(LAS unsigned short*)(F.lds + GL_KB + i * RS72 + c * 2) = (unsigned short)f2bf(k * nb); }
    gla_stage_vT(F, vraw);
#pragma unroll
    for (int dir = 0; dir < 2; ++dir)
#pragma unroll
        for (int j = 0; j < 2; ++j) { const int q = tid + 512 * j; *(LAS u32x4*)(F.lds + (dir ? GL_SB : GL_SF) + (q >> 3) * RS72 + (q & 7) * 16) = sraw[dir][j]; }
    __syncthreads();
    if (F.wave < 4) { const int ti = F.wave >> 1, tj = F.wave & 1; f32x16 sf = {}, sb = {};
#pragma unroll
        for (int s = 0; s < 4; ++s) {
            sf = __builtin_amdgcn_mfma_f32_32x32x16_bf16(ldfrag(F.lds + GL_QF, 32 * ti + r32, s, hi), ldfrag(F.lds + GL_KF, 32 * tj + r32, s, hi), sf, 0, 0, 0);
            sb = __builtin_amdgcn_mfma_f32_32x32x16_bf16(ldfrag(F.lds + GL_QB, 32 * ti + r32, s, hi), ldfrag(F.lds + GL_KB, 32 * tj + r32, s, hi), sb, 0, 0, 0); }
#pragma unroll
        for (int r = 0; r < 16; ++r) { const int i = 32 * ti + crow(r, hi), j = 32 * tj + r32; const float p = (j <= i) ? sf[r] : sb[r];
            *(LAS unsigned short*)(F.lds + GL_P + i * RS72 + j * 2) = (unsigned short)f2bf(p); } }
    __syncthreads();
    const int ti = F.wave & 1, tv = F.wave >> 1; f32x16 o = {};
#pragma unroll
    for (int s = 0; s < 4; ++s) o = __builtin_amdgcn_mfma_f32_32x32x16_bf16(ldfrag(F.lds + GL_P, 32 * ti + r32, s, hi), ldfrag(F.lds + GL_VT, 32 * tv + r32, s, hi), o, 0, 0, 0);
#pragma unroll
    for (int s = 0; s < 4; ++s) o = __builtin_amdgcn_mfma_f32_32x32x16_bf16(ldfrag(F.lds + GL_QF, 32 * ti + r32, s, hi), ldfrag(F.lds + GL_SF, 32 * tv + r32, s, hi), o, 0, 0, 0);
#pragma unroll
    for (int s = 0; s < 4; ++s) o = __builtin_amdgcn_mfma_f32_32x32x16_bf16(ldfrag(F.lds + GL_QB, 32 * ti + r32, s, hi), ldfrag(F.lds + GL_SB, 32 * tv + r32, s, hi), o, 0, 0, 0);
    __syncthreads();
    LAS float* ob = (LAS float*)(F.lds + GL_OB);
#pragma unroll
    for (int r = 0; r < 16; ++r) ob[(32 * ti + crow(r, hi)) * 132 + 32 * tv + r32] = o[r];
    __syncthreads();
    { const int i = tid >> 3, part = tid & 7, v0 = part * 16; float ov[16], ss = 0.f;
#pragma unroll
      for (int e = 0; e < 16; ++e) { ov[e] = ob[i * 132 + v0 + e]; ss += ov[e] * ov[e]; }
      ss += __shfl_xor(ss, 1); ss += __shfl_xor(ss, 2); ss += __shfl_xor(ss, 4);
      const float rs = __builtin_amdgcn_rsqf(ss * (1.f / 128.f) + EPS); const size_t tok = t0 + i;
      const u32x4 r0 = *(const u32x4*)(F.h + tok * HP + C_RA + hh * 128 + v0), r1 = *(const u32x4*)(F.h + tok * HP + C_RA + hh * 128 + v0 + 8);
      const float rr[16] = {bflo(r0.x), bfhi(r0.x), bflo(r0.y), bfhi(r0.y), bflo(r0.z), bfhi(r0.z), bflo(r0.w), bfhi(r0.w), bflo(r1.x), bfhi(r1.x), bflo(r1.y), bfhi(r1.y), bflo(r1.z), bfhi(r1.z), bflo(r1.w), bfhi(r1.w)};
      float y[16];
#pragma unroll
      for (int e = 0; e < 16; ++e) { const float g = F.out_g[hh * 128 + v0 + e]; const float sil = rr[e] * __builtin_amdgcn_rcpf(1.f + fexp(-rr[e])); y[e] = ov[e] * rs * g * sil; }
      u32x4 w0, w1; w0.x = pk2(y[0], y[1]); w0.y = pk2(y[2], y[3]); w0.z = pk2(y[4], y[5]); w0.w = pk2(y[6], y[7]); w1.x = pk2(y[8], y[9]); w1.y = pk2(y[10], y[11]); w1.z = pk2(y[12], y[13]); w1.w = pk2(y[14], y[15]);
      bf16_t* mp = F.mixed + tok * DM + hh * 128 + v0; *(u32x4*)mp = w0; *(u32x4*)(mp + 8) = w1; }
    __syncthreads();
}

constexpr int AT_V = 0, AT_K = 32768, AT_O = 65536;
#define KSWZ(row, colB) ((row) * 256 + ((colB) ^ (((row) & 7) << 4)))
__device__ __forceinline__ int v_st(int k, int c) { const int kk = (k & ~0xC) | ((k & 4) << 1) | ((k & 8) >> 1); return ((kk >> 3) * 4 + (c >> 5)) * 512 + ((kk & 7) * 32 + (c & 31)) * 2; }
__device__ __forceinline__ int v_rd_base(int lane) { return ((lane & 3) << 3) | (((lane >> 2) & 3) << 6) | (((lane >> 4) & 1) << 5) | (((lane >> 5) & 1) << 8); }
constexpr int v_rd_off(int d0, int ks, int half) { return d0 * 512 + ks * 4096 + half * 2048; }
template <int OFF> __device__ __forceinline__ s16x4 tr_read(int vb) { s16x4 r; asm volatile("ds_read_b64_tr_b16 %0, %1 offset:%2" : "=&v"(r) : "v"(vb), "i"(OFF) : "memory"); return r; }
template <int D0> __device__ __forceinline__ void pv_one(f32x16& od, int vb, bf16x8 pa0, bf16x8 pa1, bf16x8 pa2, bf16x8 pa3) {
    const s16x4 l0 = tr_read<v_rd_off(D0, 0, 0)>(vb), h0 = tr_read<v_rd_off(D0, 0, 1)>(vb), l1 = tr_read<v_rd_off(D0, 1, 0)>(vb), h1 = tr_read<v_rd_off(D0, 1, 1)>(vb);
    const s16x4 l2 = tr_read<v_rd_off(D0, 2, 0)>(vb), h2 = tr_read<v_rd_off(D0, 2, 1)>(vb), l3 = tr_read<v_rd_off(D0, 3, 0)>(vb), h3 = tr_read<v_rd_off(D0, 3, 1)>(vb);
    asm volatile("s_waitcnt lgkmcnt(0)" ::: "memory"); SBAR();
#define PKV(L, H) (bf16x8){L[0], L[1], L[2], L[3], H[0], H[1], H[2], H[3]}
    od = __builtin_amdgcn_mfma_f32_32x32x16_bf16(pa0, PKV(l0, h0), od, 0, 0, 0);
    od = __builtin_amdgcn_mfma_f32_32x32x16_bf16(pa1, PKV(l1, h1), od, 0, 0, 0);
    od = __builtin_amdgcn_mfma_f32_32x32x16_bf16(pa2, PKV(l2, h2), od, 0, 0, 0);
    od = __builtin_amdgcn_mfma_f32_32x32x16_bf16(pa3, PKV(l3, h3), od, 0, 0, 0);
#undef PKV
}
struct AtP { size_t tokbase; int dil, m0, Tf, nt, head, p; };
__device__ __forceinline__ AtP at_decode(int item) {
    AtP P; const int p = item / 1536, rem = item % 1536, b = rem / 768, rem2 = rem % 768, u = rem2 & 63; P.p = p; P.head = rem2 >> 6;
    const int dsh = 2 * p, L = SEQ >> dsh, runs = 64 >> dsh, res = u / runs; P.dil = 1 << dsh; P.m0 = (u % runs) * 256; P.tokbase = (size_t)b * SEQ + res;
    const int kt_lo = (P.m0 == 0) ? 1 : 0, kt_hi = (P.m0 + 256 >= L) ? 4 : 5; P.Tf = P.m0 - 64 + 64 * kt_lo; P.nt = kt_hi - kt_lo + 1; return P;
}
__device__ __forceinline__ void attn_phase(const Frame& F) {
    const int tid = F.tid, wid = F.wave, lane = F.lane, r32 = lane & 31, hi = lane >> 5, G = F.G;
    int ntot = 0; for (int it = F.vcu; it < 4608; it += G) ntot += at_decode(it).nt;
    if (ntot == 0) return;
    const int sr = tid >> 4, sc = (tid & 15) * 8, vst0 = v_st(sr, sc), vst1 = v_st(32 + sr, sc), kc = sc * 2;
    const int vb0 = (int)(unsigned)(uintptr_t)(F.ldsg + AT_V) + v_rd_base(lane);
    int it_ld = F.vcu, rl = 0, it_c = F.vcu, rc = 0; AtP ld = at_decode(it_ld), cur = ld;
    bf16x8 qr[8], qn[8]; f32x16 o[4]; float l_reg = 0.f;
    bf16x8 sA0, sA1, sA2, sA3;
#define AT_QLOAD() do { const bf16_t* qp_ = F.h + C_QD + ld.head * 128 + (ld.tokbase + (size_t)ld.dil * (ld.m0 + 32 * wid + r32)) * HP + hi * 8; \
        _Pragma("unroll") for (int d0 = 0; d0 < 8; ++d0) qn[d0] = *(const bf16x8*)(qp_ + d0 * 16); } while (0)
#define AT_SLOAD(S) do { const int T0_ = ld.Tf + 64 * rl; const size_t ra = (ld.tokbase + (size_t)ld.dil * (T0_ + sr)) * HP + ld.head * 128 + sc, rb = ra + (size_t)ld.dil * 32 * HP; \
        S##0 = *(const bf16x8*)(F.h + C_VD + ra); S##1 = *(const bf16x8*)(F.h + C_VD + rb); S##2 = *(const bf16x8*)(F.h + C_KD + ra); S##3 = *(const bf16x8*)(F.h + C_KD + rb); \
        if (++rl == ld.nt) { it_ld += G; rl = 0; if (it_ld < 4608) { ld = at_decode(it_ld); AT_QLOAD(); } } } while (0)
#define AT_SWRITE(S, B) do { *(LAS bf16x8*)(F.lds + AT_V + (B) * 16384 + vst0) = S##0; *(LAS bf16x8*)(F.lds + AT_V + (B) * 16384 + vst1) = S##1; \
        *(LAS bf16x8*)(F.lds + AT_K + (B) * 16384 + KSWZ(sr, kc)) = S##2; *(LAS bf16x8*)(F.lds + AT_K + (B) * 16384 + KSWZ(32 + sr, kc)) = S##3; } while (0)
#define PK4(P, BASE, OUT) do { unsigned a0_ = pk2(P[BASE + 0], P[BASE + 1]), a1_ = pk2(P[BASE + 2], P[BASE + 3]); unsigned b0_ = pk2(P[BASE + 4], P[BASE + 5]), b1_ = pk2(P[BASE + 6], P[BASE + 7]); \
        auto r0_ = __builtin_amdgcn_permlane32_swap(a0_, b0_, false, false); auto r1_ = __builtin_amdgcn_permlane32_swap(a1_, b1_, false, false); \
        u32x4 w_ = {r0_[0], r1_[0], r0_[1], r1_[1]}; OUT = __builtin_bit_cast(bf16x8, w_); } while (0)
#define AT_STEP(BUF) do { \
        if (rc == 0) { _Pragma("unroll") for (int d0 = 0; d0 < 8; ++d0) qr[d0] = qn[d0]; _Pragma("unroll") for (int d0 = 0; d0 < 4; ++d0) o[d0] = (f32x16){}; l_reg = 0.f; } \
        const int Q0 = cur.m0 + 32 * wid, T0 = cur.Tf + 64 * rc; \
        if (T0 + 63 >= Q0 - 64 && T0 <= Q0 + 95) {                                        \
            const LAS unsigned char* Ks = F.lds + AT_K + (BUF) * 16384; f32x16 p0 = {}, p1 = {}; \
            _Pragma("unroll") for (int d0 = 0; d0 < 8; ++d0) { const int cb = (d0 * 16 + hi * 8) * 2; \
                const bf16x8 k0 = *(const LAS bf16x8*)(Ks + KSWZ(r32, cb)), k1 = *(const LAS bf16x8*)(Ks + KSWZ(32 + r32, cb)); \
                p0 = __builtin_amdgcn_mfma_f32_32x32x16_bf16(k0, qr[d0], p0, 0, 0, 0); p1 = __builtin_amdgcn_mfma_f32_32x32x16_bf16(k1, qr[d0], p1, 0, 0, 0); } \
            const int dq = T0 - (Q0 + r32); float ps = 0.f;                                \
            _Pragma("unroll") for (int r = 0; r < 16; ++r) { const int e0 = dq + crow(r, hi), e1 = e0 + 32; \
                p0[r] = (e0 >= -64 && e0 <= 64) ? __builtin_amdgcn_exp2f(p0[r]) : 0.f; p1[r] = (e1 >= -64 && e1 <= 64) ? __builtin_amdgcn_exp2f(p1[r]) : 0.f; ps += p0[r] + p1[r]; } \
            l_reg += ps; \
            bf16x8 pa0, pa1, pa2, pa3; PK4(p0, 0, pa0); PK4(p0, 8, pa1); PK4(p1, 0, pa2); PK4(p1, 8, pa3); \
            const int vb = vb0 + (BUF) * 16384; \
            pv_one<0>(o[0], vb, pa0, pa1, pa2, pa3); pv_one<1>(o[1], vb, pa0, pa1, pa2, pa3); pv_one<2>(o[2], vb, pa0, pa1, pa2, pa3); pv_one<3>(o[3], vb, pa0, pa1, pa2, pa3); } \
        if (++rc == cur.nt) {                                                             \
            bf16_t* Op = (bf16_t*)(cur.p == 0 ? (unsigned char*)F.out + OUT_OP0 : F.wsb + (cur.p == 1 ? WS_OP1 : WS_OP2)); \
            const float lt = l_reg + __shfl_xor(l_reg, 32); \
            if (hi == 0) F.lp[((size_t)cur.p * T + cur.tokbase + (size_t)cur.dil * (Q0 + r32)) * NHD + cur.head] = lt; \
            LAS unsigned char* stg = F.lds + AT_O + wid * 8192; \
            _Pragma("unroll") for (int d0 = 0; d0 < 4; ++d0) _Pragma("unroll") for (int r = 0; r < 16; ++r) *(LAS unsigned short*)(stg + (crow(r, hi) * 128 + d0 * 32 + r32) * 2) = (unsigned short)f2bf(o[d0][r]); \
            LDS_WAIT(); asm volatile("" ::: "memory"); \
            _Pragma("unroll") for (int i_ = 0; i_ < 8; ++i_) { const int row = 4 * i_ + (lane >> 4), ch = lane & 15; const u32x4 w = *(const LAS u32x4*)(stg + row * 256 + ch * 16); \
                *(u32x4*)(Op + (cur.tokbase + (size_t)cur.dil * (Q0 + row)) * (NHD * 128) + cur.head * 128 + ch * 8) = w; } \
            LDS_WAIT(); asm volatile("" ::: "memory"); \
            rc = 0; it_c += G; if (it_c < 4608) cur = at_decode(it_c); } } while (0)
    AT_QLOAD();
    AT_SLOAD(sA); AT_SWRITE(sA, 0); AT_SLOAD(sA); __syncthreads();
    for (int g = 0; g < ntot; ++g) { const int buf = g & 1;
        AT_STEP(buf);
        if (g + 1 < ntot) AT_SWRITE(sA, buf ^ 1);
        if (it_ld < 4608) AT_SLOAD(sA);
        __syncthreads();
    }
#undef AT_QLOAD
#undef AT_SLOAD
#undef AT_SWRITE
#undef PK4
#undef AT_STEP
}
__device__ __forceinline__ void dil_combine(const Frame& F) {
    const int gw = F.vcu * 8 + F.wave, NGW = F.G * 8, lane = F.lane, c = lane & 15;
    for (long it = gw; it < (long)T * NHD / 4; it += NGW) { const long row = it * 4 + (lane >> 4); const size_t tok = (size_t)(row / NHD); const int head = (int)(row % NHD);
        const float l = F.lp[tok * NHD + head] + F.lp[((size_t)T + tok) * NHD + head] + F.lp[((size_t)2 * T + tok) * NHD + head]; const float inv = 1.f / l;
        const size_t off = tok * (NHD * 128) + head * 128 + 8 * c; const u32x4 a = *(const u32x4*)(F.op0 + off), b = *(const u32x4*)(F.op1 + off), d = *(const u32x4*)(F.op2 + off);
        u32x4 o; o.x = pk2((bflo(a.x) + bflo(b.x) + bflo(d.x)) * inv, (bfhi(a.x) + bfhi(b.x) + bfhi(d.x)) * inv); o.y = pk2((bflo(a.y) + bflo(b.y) + bflo(d.y)) * inv, (bfhi(a.y) + bfhi(b.y) + bfhi(d.y)) * inv);
        o.z = pk2((bflo(a.z) + bflo(b.z) + bflo(d.z)) * inv, (bfhi(a.z) + bfhi(b.z) + bfhi(d.z)) * inv); o.w = pk2((bflo(a.w) + bflo(b.w) + bflo(d.w)) * inv, (bfhi(a.w) + bfhi(b.w) + bfhi(d.w)) * inv);
        *(u32x4*)(F.mixed + tok * DM + 512 + head * 128 + 8 * c) = o; }
}

__device__ __forceinline__ unsigned fl_flip(float x) { const unsigned u = __float_as_uint(x); return u ^ ((unsigned)((int)u >> 31) | 0x80000000u); }
__device__ __forceinline__ float fl_unflip(unsigned w) { return __uint_as_float((w & 0x80000000u) ? (w ^ 0x80000000u) : ~w); }
#define CE_DESC(a, b) do { const unsigned x_ = max(a, b), y_ = min(a, b); a = x_; b = y_; } while (0)
__device__ __forceinline__ void sort16_desc(unsigned (&a)[16]) {
#pragma unroll
    for (int k = 2; k <= 16; k <<= 1)
#pragma unroll
        for (int j = k >> 1; j > 0; j >>= 1)
#pragma unroll
            for (int i = 0; i < 16; ++i) { const int l = i ^ j; if (l > i) { const unsigned x = max(a[i], a[l]), y = min(a[i], a[l]); if ((i & k) == 0) { a[i] = x; a[l] = y; } else { a[i] = y; a[l] = x; } } }
}
__device__ __forceinline__ void bmerge16_desc(unsigned (&a)[16]) {
#pragma unroll
    for (int j = 8; j > 0; j >>= 1)
#pragma unroll
        for (int i = 0; i < 16; ++i) { const int l = i ^ j; if (l > i) CE_DESC(a[i], a[l]); }
}
__device__ __forceinline__ void top16_merge(unsigned (&a)[16], const unsigned (&b)[16]) {
#pragma unroll
    for (int i = 0; i < 16; ++i) a[i] = max(a[i], b[15 - i]);
    bmerge16_desc(a);
}
__device__ __forceinline__ void top16_partner(unsigned (&a)[16]) {
    unsigned b[16];
#pragma unroll
    for (int i = 0; i < 16; ++i) b[i] = (unsigned)__shfl_xor((int)a[i], 32);
    top16_merge(a, b);
}
__device__ constexpr unsigned char stair(int n) {
    constexpr unsigned char L[64] = {0x00,0x01,0x02,0x03,0x04,0x05,0x06,0x07,0x08,0x09,0x0a,0x0b,0x0c,0x0d,0x0e,0x0f,0x10,0x11,0x12,0x13,0x14,0x15,0x16,0x17,0x20,0x21,0x22,0x23,0x24,0x30,0x31,0x32,
                                     0x33,0x40,0x41,0x42,0x50,0x51,0x60,0x61,0x70,0x71,0x80,0x90,0xa0,0xb0,0xc0,0xd0,0xe0,0xf0,0xff,0xff,0xff,0xff,0xff,0xff,0xff,0xff,0xff,0xff,0xff,0xff,0xff,0xff};
    return L[n];
}
__device__ __forceinline__ void topk_item(const Frame& F, int item) {
    const int lane = F.lane, r32 = lane & 31, hi = lane >> 5, hh = item & 7, tok0 = (item >> 3) * 32; const size_t tok = (size_t)tok0 + r32;
    LAS int* ktab = (LAS int*)(F.lds + F.wave * 4096) + r32 * 32;
    float ss = 0.f;
    { const f32x4* sp = (const f32x4*)(F.ssp + tok * 32 + hi * 16);
#pragma unroll
      for (int j = 0; j < 4; ++j) { const f32x4 v = sp[j]; ss += (v[0] + v[1]) + (v[2] + v[3]); } }
    ss += __shfl_xor(ss, 32);
    const float rs2 = __builtin_amdgcn_rsqf(ss * (1.f / DM) + EPS);
    if (hh == 0 && hi == 0) F.rs2[tok] = rs2;
    unsigned top[2][16];
#pragma unroll
    for (int cc = 0; cc < 2; ++cc) {
        f32x16 acc[4] = {};
        const bf16_t* qp = F.qry + tok * DM + hh * 256 + cc * 128 + hi * 8; const bf16_t* kp = F.SK + ((size_t)(hh * 2 + cc) * 128 + r32) * 128 + hi * 8;
#pragma unroll 2
        for (int s = 0; s < 8; ++s) { const bf16x8 qf = *(const bf16x8*)(qp + 16 * s);
#pragma unroll
            for (int kt = 0; kt < 4; ++kt) { const bf16x8 kf = *(const bf16x8*)(kp + (size_t)kt * 32 * 128 + 16 * s); acc[kt] = __builtin_amdgcn_mfma_f32_32x32x16_bf16(kf, qf, acc[kt], 0, 0, 0); } }
        unsigned g[4][16];
#pragma unroll
        for (int kt = 0; kt < 4; ++kt) {
#pragma unroll
            for (int r = 0; r < 16; ++r) g[kt][r] = (fl_flip(acc[kt][r]) & ~127u) | (unsigned)(127 - (32 * kt + crow(r, hi)));
            sort16_desc(g[kt]); }
        top16_merge(g[0], g[1]); top16_merge(g[2], g[3]); top16_merge(g[0], g[2]); top16_partner(g[0]);
#pragma unroll
        for (int i = 0; i < 16; ++i) top[cc][i] = g[0][i];
    }
#pragma unroll
    for (int i = 0; i < 16; ++i) ktab[hi * 16 + i] = 127 - (int)((hi ? top[1][i] : top[0][i]) & 127u);
    float s0[16], s1[16];
#pragma unroll
    for (int i = 0; i < 16; ++i) { s0[i] = fl_unflip(top[0][i] & ~127u); s1[i] = fl_unflip(top[1][i] & ~127u); }
    unsigned ca[16], cb[16];
#pragma unroll
    for (int n = 0; n < 32; ++n) { const int A = stair(n), B = stair(25 + n); unsigned va = 0u, vb = 0u;
        if (n < 25) { va = (fl_flip(s0[A >> 4] + s1[A & 15]) & ~255u) | (unsigned)(255 - A); vb = (fl_flip(s0[B >> 4] + s1[B & 15]) & ~255u) | (unsigned)(255 - B); }
        const unsigned v = hi ? vb : va; if (n < 16) ca[n] = v; else cb[n - 16] = v; }
    sort16_desc(ca); sort16_desc(cb); top16_merge(ca, cb); top16_partner(ca);
    float e[16], sum = 0.f; const float mx = fl_unflip(ca[0] & ~255u) * rs2;
#pragma unroll
    for (int i = 0; i < 16; ++i) { e[i] = fexp(fl_unflip(ca[i] & ~255u) * rs2 - mx); sum += e[i]; }
    const float inv = 1.f / sum;
    LDS_WAIT(); asm volatile("" ::: "memory");
    int oi[8]; float og[8];
#pragma unroll
    for (int k = 0; k < 8; ++k) { const unsigned cv = hi ? ca[8 + k] : ca[k]; const int code = 255 - (int)(cv & 255u); og[k] = (hi ? e[8 + k] : e[k]) * inv; oi[k] = ktab[code >> 4] * 128 + ktab[16 + (code & 15)]; }
    { int* ip = F.idx + tok * 128 + hh * 16 + hi * 8; float* gp = F.gate + tok * 128 + hh * 16 + hi * 8;
      *(int4*)ip = make_int4(oi[0], oi[1], oi[2], oi[3]); *(int4*)(ip + 4) = make_int4(oi[4], oi[5], oi[6], oi[7]);
      *(f32x4*)gp = (f32x4){og[0], og[1], og[2], og[3]}; *(f32x4*)(gp + 4) = (f32x4){og[4], og[5], og[6], og[7]}; }
    LDS_WAIT(); asm volatile("" ::: "memory");
}

constexpr int PS_NSL = 16, PS_CW = DM / PS_NSL, PS_SUB = PS_NSL / 8, PS_TG = 32, PS_NTG = T / PS_TG;
__device__ __forceinline__ float gelu_tanh(float x) { const float u = 0.7978845608028654f * (x + 0.044715f * x * x * x); const float t = 1.f - 2.f * __builtin_amdgcn_rcpf(1.f + fexp(2.f * u)); return 0.5f * x * (1.f + t); }
__device__ __forceinline__ int dot16i(u32x4 w, u32x4 x) { int p = __builtin_amdgcn_sdot4((int)w.x, (int)x.x, 0, false); p = __builtin_amdgcn_sdot4((int)w.y, (int)x.y, p, false); p = __builtin_amdgcn_sdot4((int)w.z, (int)x.z, p, false); return __builtin_amdgcn_sdot4((int)w.w, (int)x.w, p, false); }
__device__ __forceinline__ unsigned xcc_id() { return (unsigned)__builtin_amdgcn_s_getreg((3 << 11) | 20) & 7u; }
__device__ __forceinline__ bool peer_claim(unsigned* cnt, unsigned x, unsigned& d, int lane, int& q, int& tg) {
    while (d < 8u) { const unsigned xq = (x + d) & 7u; unsigned u = 0u;
        if (lane == 0) u = __hip_atomic_fetch_add(cnt + 64 * xq, 1u, __ATOMIC_RELAXED, __HIP_MEMORY_SCOPE_AGENT);
        u = (unsigned)__builtin_amdgcn_readfirstlane((int)u);
        if (u < (unsigned)(PS_SUB * PS_NTG)) { q = (int)(u / PS_NTG) * 8 + (int)xq; tg = (int)(u % PS_NTG); return true; }
        ++d; }
    return false;
}
template <int CTRL> __device__ __forceinline__ float dppmov(float x) { return __int_as_float(__builtin_amdgcn_update_dpp(0, __float_as_int(x), CTRL, 0xf, 0xf, true)); }
template <int CTRL> __device__ __forceinline__ int dppmovi(int x) { return __builtin_amdgcn_update_dpp(0, x, CTRL, 0xf, 0xf, true); }
__device__ __forceinline__ int bperm(int srclane, int v) { return __builtin_amdgcn_ds_bpermute(srclane << 2, v); }
__device__ __forceinline__ void peer_quant_x(const Frame& F) {
    const int gw = F.vcu * 8 + F.wave, NGW = F.G * 8, lane = F.lane;
    for (int tok = gw; tok < T; tok += NGW) { const u32x4* xr = (const u32x4*)(F.x1b + (size_t)tok * DM) + lane; float v[4][8]; float m = 0.f;
#pragma unroll
        for (int j = 0; j < 4; ++j) { const u32x4 w = xr[64 * j]; v[j][0] = bflo(w.x); v[j][1] = bfhi(w.x); v[j][2] = bflo(w.y); v[j][3] = bfhi(w.y); v[j][4] = bflo(w.z); v[j][5] = bfhi(w.z); v[j][6] = bflo(w.w); v[j][7] = bfhi(w.w);
#pragma unroll
            for (int i = 0; i < 8; ++i) m = fmaxf(m, fabsf(v[j][i])); }
#pragma unroll
        for (int o = 1; o < 64; o <<= 1) m = fmaxf(m, __shfl_xor(m, o));
        const float inv = m > 0.f ? 127.f / m : 0.f;
#pragma unroll
        for (int j = 0; j < 4; ++j) { u32x2 w = {0u, 0u};
#pragma unroll
            for (int i = 0; i < 4; ++i) { w.x |= ((unsigned)(int)rintf(v[j][i] * inv) & 0xffu) << (8 * i); w.y |= ((unsigned)(int)rintf(v[j][4 + i] * inv) & 0xffu) << (8 * i); }
            *(u32x2*)(F.xq8 + (size_t)tok * DM + 8 * lane + 512 * j) = w; }
        if (lane == 0) F.sx[tok] = m * (1.f / 127.f); }
}
__device__ __forceinline__ void peer_down(const Frame& F, int cntw = 1024) {
    const int lane = F.lane, g = lane >> 3, c = lane & 7; const unsigned x = xcc_id(); unsigned d = 0u; int q, tg; unsigned* cnt = (unsigned*)(F.wsb + WS_CTL) + cntw;
    const unsigned char* tab = F.down8; const unsigned char* xb = F.xq8;
    while (peer_claim(cnt, x, d, lane, q, tg)) {
        const unsigned colb = (unsigned)(q * PS_CW + 16 * c), slb = (unsigned)q * (16384u * 128u) + 16u * c; int* part = F.part + (size_t)q * T * 128; const size_t tok0 = (size_t)tg * PS_TG;
        u32x4 wA[16], wB[16], xA, xB; int iA0, iA1, iB0, iB1;
#define PD_IDX(i0, i1, tok) do { const int* ip_ = F.idx + (tok) * 128 + lane; i0 = ip_[0]; i1 = ip_[64]; } while (0)
#define PD_ROWS(W_, X_, i0, i1, tok) do { _Pragma("unroll") for (int j = 0; j < 16; ++j) { const unsigned e_ = (unsigned)bperm(8 * (j & 7) + g, j < 8 ? i0 : i1); \
            W_[j] = *(const u32x4*)(tab + (e_ * 128u + slb)); } X_ = *(const u32x4*)(xb + (tok) * DM + colb); } while (0)
#define PD_COMP(W_, X_, tok) do { int p[16]; _Pragma("unroll") for (int j = 0; j < 16; ++j) p[j] = dot16i(W_[j], X_); \
            int a1[8], a2[4], a3[2]; \
            _Pragma("unroll") for (int i = 0; i < 8; ++i) { const int keep = (c & 1) ? p[2 * i + 1] : p[2 * i], give = (c & 1) ? p[2 * i] : p[2 * i + 1]; a1[i] = keep + dppmovi<0xB1>(give); } \
            _Pragma("unroll") for (int i = 0; i < 4; ++i) { const int keep = (c & 2) ? a1[2 * i + 1] : a1[2 * i], give = (c & 2) ? a1[2 * i] : a1[2 * i + 1]; a2[i] = keep + dppmovi<0x4E>(give); } \
            _Pragma("unroll") for (int i = 0; i < 2; ++i) { const int keep = (c & 4) ? a2[2 * i + 1] : a2[2 * i], give = (c & 4) ? a2[2 * i] : a2[2 * i + 1]; a3[i] = keep + __shfl_xor(give, 4); } \
            part[(tok) * 128 + 8 * c + g] = a3[0]; part[(tok) * 128 + 64 + 8 * c + g] = a3[1]; } while (0)
        PD_IDX(iA0, iA1, tok0); PD_IDX(iB0, iB1, tok0 + 1);
        PD_ROWS(wA, xA, iA0, iA1, tok0);
        for (int tt = 0; tt < PS_TG; tt += 2) { const size_t tok = tok0 + tt;
            PD_ROWS(wB, xB, iB0, iB1, tok + 1);
            const size_t t2 = tok + (tt + 2 < PS_TG ? 2 : 0), t3 = tok + (tt + 2 < PS_TG ? 3 : 1);
            PD_IDX(iA0, iA1, t2);
            PD_COMP(wA, xA, tok);
            if (tt + 2 < PS_TG) PD_ROWS(wA, xA, iA0, iA1, t2);
            PD_IDX(iB0, iB1, t3);
            PD_COMP(wB, xB, tok + 1);
        }
#undef PD_IDX
#undef PD_ROWS
#undef PD_COMP
    }
}
__device__ __forceinline__ void peer_coef_probe(const Frame& F, bool dry) {
    const int gw = F.vcu * 8 + F.wave, NGW = F.G * 8, lane = F.lane;
    for (int tok = gw; tok < T; tok += NGW) { int a0 = 0, a1 = 0; const int* pp = F.part + (size_t)tok * 128 + lane;
#pragma unroll
        for (int q = 0; q < PS_NSL; ++q) { a0 += pp[(size_t)q * T * 128]; a1 += pp[(size_t)q * T * 128 + 64]; }
        const float sc = F.rs2[tok] * F.sx[tok]; const float* gp = F.gate + (size_t)tok * 128 + lane; const int e0 = F.idx[(size_t)tok * 128 + lane], e1 = F.idx[(size_t)tok * 128 + 64 + lane];
        const float c0 = gp[0] * gelu_tanh((float)a0 * sc * F.sd[e0]) * F.su[e0], c1 = gp[64] * gelu_tanh((float)a1 * sc * F.sd[e1]) * F.su[e1];
        float m = fmaxf(fabsf(c0), fabsf(c1));
#pragma unroll
        for (int o = 1; o < 64; o <<= 1) m = fmaxf(m, __shfl_xor(m, o));
        const float inv = m > 0.f ? 127.f / m : 0.f; const int q0 = (int)rintf(c0 * inv), q1 = (int)rintf(c1 * inv);
        unsigned char* fp = (dry ? F.wsb + WS_PART + 256 * MiB : F.fq8) + (size_t)tok * 128;
        { const int k0 = lane, k1 = 64 + lane; fp[(8 * (k0 >> 5) + (k0 & 7)) * 4 + ((k0 >> 3) & 3)] = (unsigned char)q0; fp[(8 * (k1 >> 5) + (k1 & 7)) * 4 + ((k1 >> 3) & 3)] = (unsigned char)q1; }
        if (lane == 0 && !dry) F.csum[tok] = m * (1.f / 127.f); }
}
__device__ __forceinline__ void peer_up(const Frame& F, int cntw = 2048, bool dry = false) {
    const int lane = F.lane, g = lane >> 3, c = lane & 7; const unsigned x = xcc_id(); unsigned d = 0u; int q, tg; unsigned* cnt = (unsigned*)(F.wsb + WS_CTL) + cntw;
    const unsigned char* tab = F.up8;
    while (peer_claim(cnt, x, d, lane, q, tg)) {
        const unsigned slb = (unsigned)q * (16384u * 128u) + 16u * c; const int col0 = q * PS_CW + 16 * c; const size_t tok0 = (size_t)tg * PS_TG;
        u32x4 wA[16], wB[16]; int iA0, iA1, iB0, iB1, fqA, fqB, fA[4], fB[4]; float oA0, oA1, oB0, oB1;
#define PU_IDX(i0, i1, fq, o0, o1, tok) do { const size_t o_ = (tok) * 128; i0 = F.idx[o_ + lane]; i1 = F.idx[o_ + 64 + lane]; fq = *(const int*)(F.fq8 + o_ + 4 * (lane & 31)); \
            const bf16_t* op_ = F.x1b + (tok) * DM + col0 + g; o0 = bf2f(op_[0]); o1 = bf2f(op_[8]); } while (0)
#define PU_ROWS(W_, F_, i0, i1, fq) do { _Pragma("unroll") for (int j = 0; j < 16; ++j) { const unsigned e_ = (unsigned)bperm(8 * (j & 7) + g, j < 8 ? i0 : i1); W_[j] = *(const u32x4*)(tab + (e_ * 128u + slb)); } \
            _Pragma("unroll") for (int m_ = 0; m_ < 4; ++m_) F_[m_] = bperm(8 * m_ + g, fq); } while (0)
#define PU_T4(ACC_, R0, R1, R2, R3, FQ_) do { const unsigned t0_ = __builtin_amdgcn_perm(R1, R0, 0x05010400u), t1_ = __builtin_amdgcn_perm(R1, R0, 0x07030602u), t2_ = __builtin_amdgcn_perm(R3, R2, 0x05010400u), t3_ = __builtin_amdgcn_perm(R3, R2, 0x07030602u); \
            ACC_[0] = __builtin_amdgcn_sdot4((int)__builtin_amdgcn_perm(t2_, t0_, 0x05040100u), FQ_, ACC_[0], false); ACC_[1] = __builtin_amdgcn_sdot4((int)__builtin_amdgcn_perm(t2_, t0_, 0x07060302u), FQ_, ACC_[1], false); \
            ACC_[2] = __builtin_amdgcn_sdot4((int)__builtin_amdgcn_perm(t3_, t1_, 0x05040100u), FQ_, ACC_[2], false); ACC_[3] = __builtin_amdgcn_sdot4((int)__builtin_amdgcn_perm(t3_, t1_, 0x07060302u), FQ_, ACC_[3], false); } while (0)
#define PU_COMP(W_, F_, o0, o1, tok) do { int acc[16] = {}; \
            _Pragma("unroll") for (int m_ = 0; m_ < 4; ++m_) { int* a_ = acc; PU_T4(a_, W_[4 * m_].x, W_[4 * m_ + 1].x, W_[4 * m_ + 2].x, W_[4 * m_ + 3].x, F_[m_]); a_ = acc + 4; PU_T4(a_, W_[4 * m_].y, W_[4 * m_ + 1].y, W_[4 * m_ + 2].y, W_[4 * m_ + 3].y, F_[m_]); \
                a_ = acc + 8; PU_T4(a_, W_[4 * m_].z, W_[4 * m_ + 1].z, W_[4 * m_ + 2].z, W_[4 * m_ + 3].z, F_[m_]); a_ = acc + 12; PU_T4(a_, W_[4 * m_].w, W_[4 * m_ + 1].w, W_[4 * m_ + 2].w, W_[4 * m_ + 3].w, F_[m_]); } \
            int a1[8], a2[4], a3[2]; \
            _Pragma("unroll") for (int i = 0; i < 8; ++i) { const int keep = (g & 1) ? acc[2 * i + 1] : acc[2 * i], give = (g & 1) ? acc[2 * i] : acc[2 * i + 1]; a1[i] = keep + dppmovi<0x128>(give); } \
            _Pragma("unroll") for (int i = 0; i < 4; ++i) { const int keep = (g & 2) ? a1[2 * i + 1] : a1[2 * i], give = (g & 2) ? a1[2 * i] : a1[2 * i + 1]; a2[i] = keep + __shfl_xor(give, 16); } \
            _Pragma("unroll") for (int i = 0; i < 2; ++i) { const int keep = (g & 4) ? a2[2 * i + 1] : a2[2 * i], give = (g & 4) ? a2[2 * i] : a2[2 * i + 1]; a3[i] = keep + __shfl_xor(give, 32); } \
            const float sf_ = F.csum[tok]; float* dp_ = (dry ? (float*)(F.wsb + WS_PART) + ((tok) & 16383) * DM : F.out + (tok) * DM) + col0 + g; \
            dp_[0] = o0 + sf_ * (float)a3[0]; dp_[8] = o1 + sf_ * (float)a3[1]; } while (0)
        PU_IDX(iA0, iA1, fqA, oA0, oA1, tok0); PU_IDX(iB0, iB1, fqB, oB0, oB1, tok0 + 1);
        PU_ROWS(wA, fA, iA0, iA1, fqA);
        for (int tt = 0; tt < PS_TG; tt += 2) { const size_t tok = tok0 + tt;
            PU_ROWS(wB, fB, iB0, iB1, fqB);
            const float pA0 = oA0, pA1 = oA1;
            const bool more = tt + 2 < PS_TG; const size_t t2 = tok + (more ? 2 : 0), t3 = tok + (more ? 3 : 1);
            PU_IDX(iA0, iA1, fqA, oA0, oA1, t2);
            PU_COMP(wA, fA, pA0, pA1, tok);
            if (more) PU_ROWS(wA, fA, iA0, iA1, fqA);
            const float pB0 = oB0, pB1 = oB1;
            PU_IDX(iB0, iB1, fqB, oB0, oB1, t3);
            PU_COMP(wB, fB, pB0, pB1, tok + 1);
        }
#undef PU_IDX
#undef PU_ROWS
#undef PU_T4
#undef PU_COMP
    }
}

#define XB_TMO      128
#define XB_XCNT(j)  (256  + 64 * (j))
#define XB_XSUB(j)  (1280 + 64 * (j))
#define XB_XGEN(j)  (2304 + 64 * (j))
#define XB_TOP      3328
#define XB_TOPGEN   3392
#define XCD_BAR_WORDS 3456
#define XB_SPIN_CAP (1u << 18)

__device__ __forceinline__ unsigned xb_ld(unsigned* p)              { return __hip_atomic_load(p, __ATOMIC_RELAXED, __HIP_MEMORY_SCOPE_AGENT); }
__device__ __forceinline__ unsigned xb_add(unsigned* p, unsigned v) { return __hip_atomic_fetch_add(p, v, __ATOMIC_RELAXED, __HIP_MEMORY_SCOPE_AGENT); }
__device__ __forceinline__ unsigned xb_xcc_id() { return (unsigned)__builtin_amdgcn_s_getreg((3 << 11) | 20) & 0xFu; }
#define XB_SPIN(cond, bar) do { unsigned _sp = 0; while (cond) { __builtin_amdgcn_s_sleep(1); \
    if ((++_sp & 255u) == 0u) { if (xb_ld(&(bar)[XB_TMO])) break; if (_sp > XB_SPIN_CAP) { atomicAdd(&(bar)[XB_TMO], 1u); break; } } } } while (0)

struct XcdBarrier {
    unsigned* bar; unsigned x;
    volatile LAS unsigned* st;
};

__device__ __forceinline__ XcdBarrier xcd_barrier_post(unsigned* bar, volatile LAS unsigned* st) {
    XcdBarrier b; b.bar = bar; b.x = xb_xcc_id(); b.st = st;
    if (threadIdx.x == 0) (void)xb_add(&bar[XB_XCNT(b.x)], 1u);
    return b;
}
__device__ __forceinline__ void xcd_barrier_complete(unsigned* bar, unsigned x, unsigned& nloc, unsigned& nx) {
    const unsigned G = gridDim.x * gridDim.y * gridDim.z;
    unsigned sum, cnt, mine, sp = 0u;
    for (;;) {
        sum = 0u; cnt = 0u; mine = 0u;
#pragma unroll
        for (unsigned j = 0; j < 16; ++j) { const unsigned c = xb_ld(&bar[XB_XCNT(j)]); sum += c; cnt += (c > 0u) ? 1u : 0u; mine = (j == x) ? c : mine; }
        if (sum == G) break;
        __builtin_amdgcn_s_sleep(1);
        if ((++sp & 255u) == 0u) { if (xb_ld(&bar[XB_TMO])) break; if (sp > XB_SPIN_CAP) { atomicAdd(&bar[XB_TMO], 1u); break; } }
    }
    nloc = mine > 0u ? mine : 1u; nx = cnt > 0u ? cnt : 1u;
}

__device__ __forceinline__ void xcd_barrier(const XcdBarrier& b) {
    asm volatile("s_waitcnt vmcnt(0)" ::: "memory");
    __syncthreads();
    if (threadIdx.x == 0) {
        unsigned* bar = b.bar;
        __builtin_amdgcn_s_waitcnt(0);
        unsigned nloc = b.st[0], nx = b.st[1];
        if (nloc == 0u) { xcd_barrier_complete(bar, b.x, nloc, nx); b.st[0] = nloc; b.st[1] = nx; }
        const unsigned old = xb_add(&bar[XB_XSUB(b.x)], 1u);
        const unsigned gen = old / nloc;
        if (old + 1u == (gen + 1u) * nloc) {
            __builtin_amdgcn_fence(__ATOMIC_RELEASE, "agent");
            asm volatile("s_waitcnt vmcnt(0)" ::: "memory");
            const unsigned og = xb_add(&bar[XB_TOP], 1u);
            const unsigned tg = og / nx;
            if (og + 1u == (tg + 1u) * nx) xb_add(&bar[XB_TOPGEN], 1u);
            else XB_SPIN(xb_ld(&bar[XB_TOPGEN]) == tg, bar);
            __builtin_amdgcn_fence(__ATOMIC_ACQUIRE, "agent");
            xb_add(&bar[XB_XGEN(b.x)], 1u);
            asm volatile("s_waitcnt vmcnt(0)" ::: "memory");
        } else {
            XB_SPIN(xb_ld(&bar[XB_XGEN(b.x)]) == gen, bar);
            __builtin_amdgcn_fence(__ATOMIC_ACQUIRE, "agent");
            asm volatile("s_waitcnt vmcnt(0)" ::: "memory");
        }
    }
    __syncthreads();
}

struct Args { const float* in[16]; float* out; unsigned char* ws; int ph_lo, ph_hi, coop, pad; };
__global__ void __launch_bounds__(512, 2) fwd_kernel(Args args) {
    extern __shared__ __attribute__((aligned(16))) unsigned char lds_raw[];
    Frame F;
    F.lds = (LAS unsigned char*)lds_raw; F.ldsg = (char*)lds_raw;
    F.tid = threadIdx.x; F.lane = F.tid & 63; F.wave = __builtin_amdgcn_readfirstlane(F.tid >> 6);
    F.G = gridDim.x; { const int bx = blockIdx.x; F.vcu = (F.G % 8 == 0) ? (bx % 8) * (F.G / 8) + bx / 8 : bx; }
    F.x = args.in[0]; F.norm1_g = args.in[1]; F.w_in = args.in[2]; F.up_f = args.in[3]; F.bias_f = args.in[4]; F.up_b = args.in[5]; F.bias_b = args.in[6]; F.out_g = args.in[7];
    F.qn_g = args.in[8]; F.kn_g = args.in[9]; F.w_out = args.in[10]; F.norm2_g = args.in[11]; F.w_query = args.in[12]; F.sub_keys = args.in[13]; F.peer_down = args.in[14]; F.peer_up = args.in[15];
    F.out = args.out; unsigned char* ws = args.ws; F.wsb = ws;
    F.rope = (f32x2*)(ws + WS_ROPE); F.rs1 = (float*)(ws + WS_RS1); F.rs2 = (float*)(ws + WS_RS2); F.ssp = (float*)(ws + WS_SSP); F.dec = (float*)(ws + WS_DEC); F.lp = (float*)(ws + WS_LP);
    F.gate = (float*)(ws + WS_GATE); F.part = (int*)(ws + WS_PART); F.sd = (float*)(ws + WS_CTL + 65536); F.su = (float*)(ws + WS_CTL + 131072); F.sx = (float*)(ws + WS_RS2 + 131072); F.csum = (float*)(ws + WS_RS2 + 262144);
    F.down8 = ws + WS_DOWN; F.up8 = ws + WS_UP; F.xq8 = ws + WS_XB; F.fq8 = ws + WS_XB + 64 * MiB; F.idx = (int*)(ws + WS_IDX); F.state = (unsigned short*)((unsigned char*)args.out + OUT_ST);
    F.WinT = (bf16_t*)(ws + WS_WIN); F.Win8 = ws + WS_WIN; F.xq1 = ws + WS_OP1; F.sw = (float*)(ws + WS_CTL + 196608); F.WoT = (bf16_t*)(ws + WS_WO); F.WqT = (bf16_t*)(ws + WS_WQ); F.SK = (bf16_t*)(ws + WS_SK); F.down16 = (bf16_t*)(ws + WS_DOWN); F.up16 = (bf16_t*)(ws + WS_UP);
    F.xb = (bf16_t*)(ws + WS_XB); F.mixed = (bf16_t*)(ws + WS_XB); F.h = (bf16_t*)(ws + WS_H); F.x1b = (bf16_t*)(ws + WS_X1B); F.qry = (bf16_t*)(ws + WS_QRY);
    F.op0 = (bf16_t*)((unsigned char*)args.out + OUT_OP0); F.op1 = (bf16_t*)(ws + WS_OP1); F.op2 = (bf16_t*)(ws + WS_OP2);
    constexpr int MISC_OFF = 131072 + 320;
    for (int u = F.tid; u < 64; u += 512) ((LAS unsigned*)(F.lds + MISC_OFF))[u] = 0u;
    __syncthreads();
    XcdBarrier bar = xcd_barrier_post((unsigned*)(ws + WS_CTL) + 8192, (volatile LAS unsigned*)(F.lds + MISC_OFF) + 8);
    const int lo = args.ph_lo, hi = args.ph_hi;
#ifndef PH_MASK
#define PH_MASK 0x7ff
#endif
#ifndef PROBE_PHASE
#define PROBE_PHASE -1
#endif
#define REP(k) for (int rep_ = 0; rep_ < ((PROBE_PHASE == (k)) ? 2 : 1); ++rep_)
#define IN(k) (((PH_MASK >> (k)) & 1) && lo <= (k) && (k) < hi)
#define SEAM(k) do { if (IN(k) && IN((k) + 1)) { if (args.coop) { if ((k) == 0) cg::this_grid().sync(); else xcd_barrier(bar); } } } while (0)
    if (IN(0)) { REP(0) phase0(F); } SEAM(0);
#define GEMM1_BODY { pg8::Gemm g{(const pg8::bf16_t*)F.xq1, (const pg8::bf16_t*)F.Win8, T, HP, DM / 2}; pg8::StaticOrder S; S.init(T, HP, F.G, (int)blockIdx.x); pg8::EpiI8Bf16 E{F.h, HP, F.rs1, F.sw}; \
        pg8::gemm_phase<pg8::EpiI8Bf16, pg8::StaticOrder, PG8_ALIGN, PG8_SP2, true>(F.lds, g, S, E); }
    if (IN(1)) { GEMM1_BODY; if (PROBE_PHASE == 1) GEMM1_BODY; } SEAM(1);
    if (IN(2)) { qknorm_rope(F); REP(2) for (int it = F.vcu; it < 2048; it += F.G) gla_passA(F, it); } SEAM(2);
    if (IN(3)) { for (int it = F.vcu; it < 256; it += F.G) gla_scan(F, it); REP(3) attn_phase(F); } SEAM(3);
    if (IN(4)) REP(4) { for (int it = F.vcu; it < 2048; it += F.G) gla_passC(F, it); dil_combine(F); } SEAM(4);
#define GEMM5_BODY { pg8::Gemm g{F.mixed, F.WoT, T, DM, DM}; pg8::StaticOrder S; S.init(T, DM, F.G, (int)blockIdx.x); pg8::EpiResid E{F.x, F.out, F.x1b, F.ssp, DM}; \
        pg8::gemm_phase<pg8::EpiResid, pg8::StaticOrder, PG8_ALIGN, PG8_SP2>(F.lds, g, S, E); }
#define GEMM6_BODY { pg8::Gemm g{F.x1b, F.WqT, T, DM, DM}; pg8::StaticOrder S; S.init(T, DM, F.G, (int)blockIdx.x); pg8::EpiRowScaleBf16 E{F.qry, DM, nullptr}; \
        pg8::gemm_phase<pg8::EpiRowScaleBf16, pg8::StaticOrder, PG8_ALIGN, PG8_SP2>(F.lds, g, S, E); }
    if (IN(5)) { GEMM5_BODY; if (PROBE_PHASE == 5) GEMM5_BODY; } SEAM(5);
    if (IN(6)) { GEMM6_BODY; if (PROBE_PHASE == 6) GEMM6_BODY; } SEAM(6);
    if (IN(7)) REP(7) { const int gw = F.vcu * 8 + F.wave, NGW = F.G * 8; for (int it = gw; it < (T / 32) * 8; it += NGW) topk_item(F, it); if (rep_ == 0) peer_quant_x(F); } SEAM(7);
    if (IN(8)) { if (PROBE_PHASE == 8) peer_down(F, 3072); peer_down(F); } SEAM(8);
    if (IN(9)) { REP(9) peer_coef_probe(F, (PROBE_PHASE == 9) && rep_ == 0); } SEAM(9);
    if (IN(10)) { if (PROBE_PHASE == 10) peer_up(F, 3584, true); peer_up(F); }
#undef IN
#undef SEAM
}

#ifndef MK_N_LAUNCHES
#define MK_N_LAUNCHES 1
#endif
extern "C" void kernel_launch(void* const* d_in, const int* in_sizes, int n_in, void* d_out, int out_size, void* d_ws, size_t ws_size, hipStream_t stream) {
    static int grid = 0;
    if (grid == 0) {
        if (n_in != 16 || in_sizes[0] != T * DM || out_size != T * DM || ws_size < WS_END) { fprintf(stderr, "kernel_launch: unexpected shapes (n_in %d, in0 %d, out %d, ws %zu)\n", n_in, n_in > 0 ? in_sizes[0] : -1, out_size, ws_size); grid = -1; return; }
        int dev = 0, cus = 0, per_cu = 0;
        if (hipGetDevice(&dev) != hipSuccess || hipDeviceGetAttribute(&cus, hipDeviceAttributeMultiprocessorCount, dev) != hipSuccess) { grid = -1; return; }
        if (hipFuncSetAttribute((const void*)fwd_kernel, hipFuncAttributeMaxDynamicSharedMemorySize, LDS_BYTES) != hipSuccess) { fprintf(stderr, "kernel_launch: hipFuncSetAttribute failed\n"); grid = -1; return; }
        if (hipOccupancyMaxActiveBlocksPerMultiprocessor(&per_cu, (const void*)fwd_kernel, 512, LDS_BYTES) != hipSuccess || per_cu < 1) { fprintf(stderr, "kernel_launch: occupancy query says %d\n", per_cu); per_cu = 1; }
        (void)hipGetLastError();
        grid = cus;
    }
    if (grid < 0) return;
    if (hipMemsetAsync(d_ws, 0, 65536, stream) != hipSuccess) { fprintf(stderr, "kernel_launch: hipMemsetAsync failed\n"); return; }
    Args a{};
    for (int i = 0; i < 16; ++i) a.in[i] = (const float*)d_in[i];
    a.out = (float*)d_out; a.ws = (unsigned char*)d_ws;
    if (MK_N_LAUNCHES == 1) {
        a.ph_lo = 0; a.ph_hi = NPHASE; a.coop = 1; void* kargs[] = {&a};
        hipError_t e = hipLaunchCooperativeKernel((const void*)fwd_kernel, dim3(grid), dim3(512), kargs, LDS_BYTES, stream);
        if (e != hipSuccess) fprintf(stderr, "kernel_launch: cooperative launch failed: %s (grid %d)\n", hipGetErrorString(e), grid);
    } else {
        for (int p = 0; p < NPHASE; ++p) { a.ph_lo = p; a.ph_hi = p + 1; a.coop = 0; hipLaunchKernelGGL(fwd_kernel, dim3(grid), dim3(512), LDS_BYTES, stream, a); }
        const hipError_t le = hipPeekAtLastError(); if (le != hipSuccess) fprintf(stderr, "kernel_launch: launch failed: %s\n", hipGetErrorName(le));
    }
}
```

```cpp
#include <hip/hip_runtime.h>
#include <hip/hip_cooperative_groups.h>
#include <cstdio>
#include <cstdint>
namespace cg = cooperative_groups;
namespace pg8 {
#define PG8_LAS __attribute__((address_space(3)))
typedef unsigned short bf16_t;
typedef short bf16x8 __attribute__((ext_vector_type(8)));
typedef float f32x4 __attribute__((ext_vector_type(4)));
typedef unsigned u32x4 __attribute__((ext_vector_type(4)));
constexpr int BM = 256, BK = 64, HALF = 128, HTB = HALF * BK * 2  , STAGE_BYTES = 8 * HTB, NXCD = 8, WGM = 8;

__host__ __device__ __forceinline__ int lds_byte(int r, int c) { const int st = (r >> 4) * 2 + (c >> 5), rr = r & 15, cc = c & 31, ob = rr * 64 + cc * 2; return st * 1024 + (ob ^ (((ob >> 9) & 1) << 5)); }
__host__ __device__ __forceinline__ void stage_rc(int b, int& R, int& C) { const int st = b / 1024, sb = b % 1024, swz = sb ^ (((sb >> 9) & 1) << 5); R = (st >> 1) * 16 + swz / 64; C = (st & 1) * 32 + (swz % 64) / 2; }
__host__ __device__ __forceinline__ int perm32(int rho) { const int n = rho >> 4, i = rho & 15; return 8 * (i >> 2) + 4 * n + (i & 3); }

struct Unit { int pm, pn; };
struct Gemm { const bf16_t* A; const bf16_t* Bt; int M, N, K; };

struct StaticOrder {
    int nM, nN, nwg, G, c;
    __host__ __device__ void init(int M, int N, int G_, int c_) { nM = M / BM; nN = N / BM; nwg = nM * nN; G = G_; c = c_; }
    __host__ __device__ bool next(int i, Unit& u) const {
        const long L = (long)i * G + c; if (L >= nwg) return false;
        int wgid = (int)L; { const int q = nwg / NXCD, r = nwg % NXCD, xcd = wgid % NXCD, off = wgid / NXCD; wgid = (xcd < r ? xcd * (q + 1) : r * (q + 1) + (xcd - r) * q) + off; }
        const int nig = WGM * nN, gid = wgid / nig, fm = gid * WGM, gsz = (nM - fm) < WGM ? (nM - fm) : WGM;
        u.pm = fm + ((wgid % nig) % gsz); u.pn = (wgid % nig) / gsz; return true;
    }
    __device__ __forceinline__ void a_ready(const Unit&) const {}
    __device__ __forceinline__ void done(const Unit&) const {}
};
__device__ __forceinline__ unsigned cvt_pk_bf16(float lo, float hi) { unsigned r; asm volatile("v_cvt_pk_bf16_f32 %0, %1, %2" : "=v"(r) : "v"(lo), "v"(hi)); return r; }
typedef int i32x4 __attribute__((ext_vector_type(4)));
template <bool I8> struct AccT { typedef f32x4 type; };
template <> struct AccT<true> { typedef i32x4 type; };
struct EpiRowScaleBf16 {
    static constexpr bool PERM = true, AFTER_DRAIN = false;
    bf16_t* O; int ldc; const float* rs;
    __device__ __forceinline__ void operator()(const f32x4 (&acc)[2][2][4][2], const Unit& u, int wr, int wc, int fr, int fq) const {
        const int row0 = u.pm * BM + wr * 64 + fr, col0 = u.pn * BM + wc * 32 + 8 * fq;
#pragma unroll
        for (int ai = 0; ai < 2; ++ai)
#pragma unroll
            for (int m = 0; m < 4; ++m) { const int row = row0 + ai * HALF + m * 16; const float s = rs ? rs[row] : 1.f; bf16_t* rowp = O + (size_t)row * ldc + col0;
#pragma unroll
                for (int bj = 0; bj < 2; ++bj) { const f32x4 v0 = acc[ai][bj][m][0] * s, v1 = acc[ai][bj][m][1] * s;
                    u32x4 w; w.x = cvt_pk_bf16(v0[0], v0[1]); w.y = cvt_pk_bf16(v0[2], v0[3]); w.z = cvt_pk_bf16(v1[0], v1[1]); w.w = cvt_pk_bf16(v1[2], v1[3]);
                    *(u32x4*)(rowp + bj * HALF) = w; } }
    }
};
struct EpiI8Qk {
    static constexpr bool PERM = true, AFTER_DRAIN = false;
    bf16_t* O; int ldc; const float* rs; const float* cs; const float* qg; const float* kg; PG8_LAS float* P; int qk_lo, q_hi, qk_hi, seqmask; float qscale;
    __device__ __forceinline__ void operator()(const i32x4 (&acc)[2][2][4][2], const Unit& u, int wr, int wc, int fr, int fq) const {
        const int row0 = u.pm * BM + wr * 64 + fr, col0 = u.pn * BM + wc * 32 + 8 * fq;
        f32x4 cv[2][2];
#pragma unroll
        for (int bj = 0; bj < 2; ++bj) { cv[bj][0] = *(const f32x4*)(cs + col0 + bj * HALF); cv[bj][1] = *(const f32x4*)(cs + col0 + bj * HALF + 4); }
        const bool qk = u.pn >= qk_lo && u.pn < qk_hi;
        float rq[2][4][2];
        if (qk) {
#pragma unroll
            for (int ai = 0; ai < 2; ++ai)
#pragma unroll
                for (int m = 0; m < 4; ++m) { const float s = rs[row0 + ai * HALF + m * 16]; const int rl = ai * HALF + wr * 64 + m * 16 + fr;
#pragma unroll
                    for (int bj = 0; bj < 2; ++bj) { const i32x4 a0 = acc[ai][bj][m][0], a1 = acc[ai][bj][m][1]; const f32x4 c0 = cv[bj][0] * s, c1 = cv[bj][1] * s; float ss = 0.f;
#pragma unroll
                        for (int i = 0; i < 4; ++i) { const float x0 = (float)a0[i] * c0[i], x1 = (float)a1[i] * c1[i]; ss += x0 * x0 + x1 * x1; }
                        ss += __shfl_xor(ss, 16); ss += __shfl_xor(ss, 32);
                        if (fq == 0) P[rl * 8 + bj * 4 + wc] = ss; } }
            asm volatile("s_waitcnt lgkmcnt(0)" ::: "memory"); __builtin_amdgcn_s_barrier(); asm volatile("" ::: "memory");
#pragma unroll
            for (int ai = 0; ai < 2; ++ai)
#pragma unroll
                for (int m = 0; m < 4; ++m) { const int rl = ai * HALF + wr * 64 + m * 16 + fr;
#pragma unroll
                    for (int bj = 0; bj < 2; ++bj) { const f32x4 p = *(const PG8_LAS f32x4*)(P + rl * 8 + bj * 4); rq[ai][m][bj] = __builtin_amdgcn_rsqf(((p[0] + p[1]) + (p[2] + p[3])) * (1.f / 128.f) + 1e-6f); } }
        }
        const bool isq = u.pn < q_hi; const float* gp = (isq ? qg : kg) + wc * 32 + 8 * fq; f32x4 g0 = {1.f, 1.f, 1.f, 1.f}, g1 = g0;
        if (qk) { g0 = *(const f32x4*)gp; g1 = *(const f32x4*)(gp + 4); if (isq) { g0 = g0 * qscale; g1 = g1 * qscale; } }
        constexpr float RV[16] = {1.591549431e-01f, 7.008652159e-02f, 3.086376340e-02f, 1.359137064e-02f, 5.985185713e-03f, 2.635675899e-03f, 1.160663641e-03f, 5.111175045e-04f, 2.250790790e-04f, 9.911730937e-05f, 4.364795279e-05f, 1.922110068e-05f, 8.464330808e-06f, 3.727408602e-06f, 1.641426263e-06f, 7.228293069e-07f};
#pragma unroll
        for (int ai = 0; ai < 2; ++ai)
#pragma unroll
            for (int m = 0; m < 4; ++m) { const int row = row0 + ai * HALF + m * 16; const float s = rs[row]; bf16_t* rowp = O + (size_t)row * ldc + col0;
                float cs8[8], sn8[8];
                if (qk && wc == 0) { const float pos = (float)(row & seqmask);
#pragma unroll
                    for (int e8 = 0; e8 < 8; ++e8) { const float rev = pos * ((fq & 1) ? RV[8 + e8] : RV[e8]); const float fr_ = rev - __builtin_floorf(rev); cs8[e8] = __builtin_amdgcn_cosf(fr_); sn8[e8] = __builtin_amdgcn_sinf(fr_); } }
#pragma unroll
                for (int bj = 0; bj < 2; ++bj) { const i32x4 a0 = acc[ai][bj][m][0], a1 = acc[ai][bj][m][1]; const float sq = qk ? s * rq[ai][m][bj] : s; const f32x4 c0 = cv[bj][0] * sq * g0, c1 = cv[bj][1] * sq * g1;
                    float v[8];
#pragma unroll
                    for (int i = 0; i < 4; ++i) { v[i] = (float)a0[i] * c0[i]; v[4 + i] = (float)a1[i] * c1[i]; }
                    if (qk && wc == 0) {
#pragma unroll
                        for (int e8 = 0; e8 < 8; ++e8) { const float pr = __shfl_xor(v[e8], 32); v[e8] = (fq < 2) ? (v[e8] * cs8[e8] - pr * sn8[e8]) : (v[e8] * cs8[e8] + pr * sn8[e8]); } }
                    u32x4 w; w.x = cvt_pk_bf16(v[0], v[1]); w.y = cvt_pk_bf16(v[2], v[3]); w.z = cvt_pk_bf16(v[4], v[5]); w.w = cvt_pk_bf16(v[6], v[7]);
                    *(u32x4*)(rowp + bj * HALF) = w; } }
    }
};
struct EpiResid {
    static constexpr bool PERM = true, AFTER_DRAIN = false;
    const float* x; float* out; bf16_t* xb; float* ssp; int ldc;
    __device__ __forceinline__ void operator()(const f32x4 (&acc)[2][2][4][2], const Unit& u, int wr, int wc, int fr, int fq) const {
        const int row0 = u.pm * BM + wr * 64 + fr, col0 = u.pn * BM + wc * 32 + 8 * fq;
#pragma unroll
        for (int ai = 0; ai < 2; ++ai)
#pragma unroll
            for (int m = 0; m < 4; ++m) { const int row = row0 + ai * HALF + m * 16; const size_t off = (size_t)row * ldc + col0; float ss = 0.f;
#pragma unroll
                for (int bj = 0; bj < 2; ++bj) { const f32x4 xa = *(const f32x4*)(x + off + bj * HALF), xc = *(const f32x4*)(x + off + bj * HALF + 4);
                    const f32x4 v0 = acc[ai][bj][m][0] + xa, v1 = acc[ai][bj][m][1] + xc;
                    u32x4 w; w.x = cvt_pk_bf16(v0[0], v0[1]); w.y = cvt_pk_bf16(v0[2], v0[3]); w.z = cvt_pk_bf16(v1[0], v1[1]); w.w = cvt_pk_bf16(v1[2], v1[3]);
                    *(u32x4*)(xb + off + bj * HALF) = w;
                    ss += (v0[0] * v0[0] + v0[1] * v0[1]) + (v0[2] * v0[2] + v0[3] * v0[3]) + (v1[0] * v1[0] + v1[1] * v1[1]) + (v1[2] * v1[2] + v1[3] * v1[3]); }
                ss += __shfl_xor(ss, 16); ss += __shfl_xor(ss, 32);
                if (fq == 0) ssp[(size_t)row * 32 + u.pn * 4 + wc] = ss; }
    }
};
template <class Epi, class Sched, bool ALIGN_EPI = false, bool SP2 = false, bool I8 = false>
__device__ __forceinline__ void gemm_phase(PG8_LAS unsigned char* lds, const Gemm g, const Sched& S, const Epi& E) {
    const int tid = threadIdx.x, wid = __builtin_amdgcn_readfirstlane(tid >> 6), lane = tid & 63, wr = wid >> 2, wc = wid & 3, fr = lane & 15, fq = lane >> 4;
    const int K = g.K, nt = K / BK;
    unsigned voffA[2], voffB[2];
#pragma unroll
    for (int i = 0; i < 2; ++i) { int R, C; stage_rc(tid * 16 + i * 8192, R, C); const int Rb = Epi::PERM ? ((R & ~31) + perm32(R & 31)) : R;
        voffA[i] = (unsigned)(R * K + C) * 2u; voffB[i] = (unsigned)(Rb * K + C) * 2u; }
    const size_t kstep = (size_t)(BK * 2);
    const size_t hstep = (size_t)HALF * K * 2;
    const size_t tstep = 2 * hstep;
    const unsigned ldsw = (unsigned)wid * 1024u;
    const int aoff = lds_byte(wr * 64 + fr, fq * 8), boff = lds_byte(wc * 32 + fr, fq * 8);
#define PG8_SA(b, h) (((b) * 2 + (h)) * HTB)
#define PG8_SB(b, h) ((4 + (b) * 2 + (h)) * HTB)
#define PG8_STAGE(bufoff, gbase, voff) do { _Pragma("unroll") for (int _i = 0; _i < 2; ++_i) \
        __builtin_amdgcn_global_load_lds((const unsigned*)((const char*)(gbase) + (voff)[_i]), (PG8_LAS unsigned*)(lds + (bufoff) + ldsw + _i * 8192), 16, 0, 0); } while (0)
#define PG8_LDA(dst, b, h) do { _Pragma("unroll") for (int m = 0; m < 4; ++m) _Pragma("unroll") for (int k = 0; k < 2; ++k) dst[m][k] = *(const PG8_LAS bf16x8*)(lds + PG8_SA(b, h) + aoff + m * 2048 + k * 1024); } while (0)
#define PG8_LDB(dst, b, h) do { _Pragma("unroll") for (int n = 0; n < 2; ++n) _Pragma("unroll") for (int k = 0; k < 2; ++k) dst[n][k] = *(const PG8_LAS bf16x8*)(lds + PG8_SB(b, h) + boff + n * 2048 + k * 1024); } while (0)
#define PG8_MMA(ai, bj, At, Bt) do { __builtin_amdgcn_s_setprio(1); _Pragma("unroll") for (int m = 0; m < 4; ++m) _Pragma("unroll") for (int n = 0; n < 2; ++n) _Pragma("unroll") for (int k = 0; k < 2; ++k) { \
        if constexpr (I8) acc[ai][bj][m][n] = __builtin_amdgcn_mfma_i32_16x16x64_i8(__builtin_bit_cast(i32x4, Bt[n][k]), __builtin_bit_cast(i32x4, At[m][k]), acc[ai][bj][m][n], 0, 0, 0); \
        else acc[ai][bj][m][n] = __builtin_amdgcn_mfma_f32_16x16x32_bf16(Bt[n][k], At[m][k], acc[ai][bj][m][n], 0, 0, 0); } __builtin_amdgcn_s_setprio(0); } while (0)
#define PG8_WAIT_V(n) asm volatile("s_waitcnt vmcnt(" #n ")" ::: "memory")
#define PG8_WAIT_L(n) asm volatile("s_waitcnt lgkmcnt(" #n ")" ::: "memory")
#define PG8_BAR __builtin_amdgcn_s_barrier()
#define PG8_SCHED __builtin_amdgcn_sched_barrier(0)
    Unit cur, nxt; int ui = 0;
    if (!S.next(0, cur)) return;
    typename AccT<I8>::type acc[2][2][4][2];
#pragma unroll
    for (int a = 0; a < 2; ++a)
#pragma unroll
        for (int b = 0; b < 2; ++b)
#pragma unroll
            for (int m = 0; m < 4; ++m)
#pragma unroll
                for (int n = 0; n < 2; ++n) acc[a][b][m][n] = (typename AccT<I8>::type){};
    bf16x8 At[4][2], B0[2][2], B1[2][2];
    const char* cA = (const char*)g.A + (size_t)cur.pm * tstep; const char* cB = (const char*)g.Bt + (size_t)cur.pn * tstep;
    S.a_ready(cur);
    if constexpr (SP2) {
        PG8_STAGE(PG8_SB(0, 0), cB, voffB); PG8_STAGE(PG8_SB(0, 1), cB + hstep, voffB); PG8_STAGE(PG8_SA(0, 0), cA, voffA); PG8_STAGE(PG8_SA(0, 1), cA + hstep, voffA);
        if (wr == 1) PG8_BAR;
        PG8_WAIT_V(2); PG8_BAR;
        PG8_STAGE(PG8_SB(1, 0), cB + kstep, voffB); PG8_STAGE(PG8_SA(1, 0), cA + kstep, voffA); PG8_STAGE(PG8_SB(1, 1), cB + hstep + kstep, voffB);
        PG8_WAIT_V(6); PG8_BAR;
    } else {
        PG8_STAGE(PG8_SB(0, 0), cB, voffB); PG8_STAGE(PG8_SA(0, 0), cA, voffA); PG8_STAGE(PG8_SB(0, 1), cB + hstep, voffB); PG8_STAGE(PG8_SA(0, 1), cA + hstep, voffA);
        if (wr == 1) PG8_BAR;
        PG8_WAIT_V(4); PG8_BAR;
        PG8_STAGE(PG8_SB(1, 0), cB + kstep, voffB); PG8_STAGE(PG8_SA(1, 0), cA + kstep, voffA); PG8_STAGE(PG8_SB(1, 1), cB + hstep + kstep, voffB);
        PG8_WAIT_V(6); PG8_BAR;
    }
    for (;;) {
        const bool has_next = S.next(ui + 1, nxt);
        const char* nA = has_next ? (const char*)g.A + (size_t)nxt.pm * tstep : cA; const char* nB = has_next ? (const char*)g.Bt + (size_t)nxt.pn * tstep : cB;
        for (int t = 0; t < nt; t += 2) {
            const bool last = (t == nt - 2);
            const char* a1 = cA + (size_t)(t + 1) * kstep;
            const char* a2 = last ? nA : cA + (size_t)(t + 2) * kstep; const char* b2 = last ? nB : cB + (size_t)(t + 2) * kstep;
            const char* a3 = a2 + kstep; const char* b3 = b2 + kstep;
            if (last && has_next) S.a_ready(nxt);
            if constexpr (SP2) {
            PG8_LDB(B0, 0, 0); PG8_LDB(B1, 0, 1); PG8_SCHED; PG8_LDA(At, 0, 0); PG8_STAGE(PG8_SA(1, 1), a1 + hstep, voffA);
            PG8_WAIT_V(8); PG8_WAIT_L(0); PG8_BAR; PG8_MMA(0, 0, At, B0); PG8_MMA(0, 1, At, B1); PG8_BAR; PG8_SCHED;
            PG8_LDA(At, 0, 1); PG8_STAGE(PG8_SB(0, 0), b2, voffB); PG8_STAGE(PG8_SB(0, 1), b2 + hstep, voffB); PG8_STAGE(PG8_SA(0, 0), a2, voffA);
            PG8_WAIT_V(8); PG8_WAIT_L(0); PG8_BAR; PG8_MMA(1, 0, At, B0); PG8_MMA(1, 1, At, B1); PG8_BAR; PG8_SCHED;
            PG8_LDB(B0, 1, 0); PG8_LDB(B1, 1, 1); PG8_SCHED; PG8_LDA(At, 1, 0); PG8_STAGE(PG8_SA(0, 1), a2 + hstep, voffA);
            PG8_WAIT_V(8); PG8_WAIT_L(0); PG8_BAR; PG8_MMA(0, 0, At, B0); PG8_MMA(0, 1, At, B1); PG8_BAR; PG8_SCHED;
            PG8_LDA(At, 1, 1); PG8_STAGE(PG8_SB(1, 0), b3, voffB); PG8_STAGE(PG8_SB(1, 1), b3 + hstep, voffB); PG8_STAGE(PG8_SA(1, 0), a3, voffA);
            PG8_WAIT_V(8); PG8_WAIT_L(0); PG8_BAR; PG8_MMA(1, 0, At, B0); PG8_MMA(1, 1, At, B1); PG8_BAR; PG8_SCHED;
            } else {
            PG8_LDB(B0, 0, 0); PG8_SCHED; PG8_LDA(At, 0, 0); PG8_STAGE(PG8_SA(1, 1), a1 + hstep, voffA);
            PG8_WAIT_L(8); PG8_BAR; PG8_WAIT_L(0); PG8_MMA(0, 0, At, B0); PG8_BAR; PG8_SCHED;
            PG8_LDB(B1, 0, 1); PG8_STAGE(PG8_SB(0, 0), b2, voffB);
            PG8_BAR; PG8_WAIT_L(0); PG8_MMA(0, 1, At, B1); PG8_BAR;
            PG8_LDA(At, 0, 1); PG8_STAGE(PG8_SA(0, 0), a2, voffA);
            PG8_BAR; PG8_WAIT_L(0); PG8_MMA(1, 0, At, B0); PG8_BAR; PG8_SCHED;
            PG8_STAGE(PG8_SB(0, 1), b2 + hstep, voffB);
            PG8_WAIT_V(6); PG8_BAR; PG8_MMA(1, 1, At, B1); PG8_BAR;
            PG8_LDB(B0, 1, 0); PG8_SCHED; PG8_LDA(At, 1, 0); PG8_STAGE(PG8_SA(0, 1), a2 + hstep, voffA);
            PG8_WAIT_L(8); PG8_BAR; PG8_WAIT_L(0); PG8_MMA(0, 0, At, B0); PG8_BAR; PG8_SCHED;
            PG8_LDB(B1, 1, 1); PG8_STAGE(PG8_SB(1, 0), b3, voffB);
            PG8_BAR; PG8_WAIT_L(0); PG8_MMA(0, 1, At, B1); PG8_BAR;
            PG8_LDA(At, 1, 1); PG8_STAGE(PG8_SA(1, 0), a3, voffA);
            PG8_BAR; PG8_WAIT_L(0); PG8_MMA(1, 0, At, B0); PG8_BAR; PG8_SCHED;
            PG8_STAGE(PG8_SB(1, 1), b3 + hstep, voffB);
            PG8_WAIT_V(6); PG8_BAR; PG8_MMA(1, 1, At, B1); PG8_BAR;
            }
        }
        if constexpr (ALIGN_EPI) { if (wr == 0) PG8_BAR; }
        if constexpr (!Epi::AFTER_DRAIN) { E(acc, cur, wr, wc, fr, fq); S.done(cur); }
        if (!has_next) break;
#pragma unroll
        for (int a = 0; a < 2; ++a)
#pragma unroll
            for (int b = 0; b < 2; ++b)
#pragma unroll
                for (int m = 0; m < 4; ++m)
#pragma unroll
                    for (int n = 0; n < 2; ++n) acc[a][b][m][n] = (typename AccT<I8>::type){};
        cur = nxt; cA = nA; cB = nB; ++ui;
        if constexpr (ALIGN_EPI) { if (wr == 1) PG8_BAR; }
    }
    PG8_WAIT_V(0);
    if constexpr (!ALIGN_EPI) { if (wr == 0) PG8_BAR; }
    PG8_BAR;
    if constexpr (Epi::AFTER_DRAIN) { E.fused(acc, cur, wr, wc, fr, fq, lds, wid, lane); S.done(cur); }
#undef PG8_SA
#undef PG8_SB
#undef PG8_STAGE
#undef PG8_LDA
#undef PG8_LDB
#undef PG8_MMA
#undef PG8_WAIT_V
#undef PG8_WAIT_L
#undef PG8_BAR
#undef PG8_SCHED
}
}
#ifndef PG8_SP2
#define PG8_SP2 true
#endif
#ifndef PG8_ALIGN
#define PG8_ALIGN true
#endif

constexpr int BATCH = 2, SEQ = 16384, DM = 2048, T = BATCH * SEQ;
constexpr int INW = 6176, HP = 6400;
constexpr int C_QA = 0, C_KA = 256, C_VA = 512, C_RA = 1024, C_QD = 1536, C_KD = 3072, C_VD = 4608, C_GF = 6144;
constexpr int NHD = 12;
constexpr float EPS = 1e-6f;
constexpr float LOG2E = 1.4426950408889634f;
constexpr float QSCALE = 0.08838834764831845f * LOG2E;
constexpr int NPHASE = 11;

constexpr size_t MiB = 1u << 20;
constexpr size_t WS_CTL = 0, WS_ROPE = 1 * MiB, WS_RS1 = 3 * MiB, WS_RS2 = 3 * MiB + 512 * 1024, WS_SSP = 4 * MiB, WS_WIN = 8 * MiB, WS_WO = 33 * MiB, WS_WQ = 41 * MiB,
                 WS_SK = 49 * MiB, WS_DEC = 50 * MiB, WS_LP = 51 * MiB, WS_IDX = 56 * MiB, WS_GATE = 72 * MiB, WS_DOWN = 88 * MiB, WS_UP = 152 * MiB, WS_XB = 216 * MiB,
                 WS_H = 344 * MiB, WS_X1B = WS_H, WS_QRY = WS_H + 128 * MiB, WS_OP1 = 744 * MiB, WS_OP2 = 840 * MiB, WS_PART = 472 * MiB  , WS_END = 984 * MiB;
constexpr size_t OUT_ST = 0, OUT_OP0 = 128 * MiB;
constexpr int LDS_BYTES = 147456;

#define LAS __attribute__((address_space(3)))
typedef unsigned short bf16_t;
typedef short bf16x8 __attribute__((ext_vector_type(8)));
typedef short s16x4 __attribute__((ext_vector_type(4)));
typedef float f32x4 __attribute__((ext_vector_type(4)));
typedef float f32x2 __attribute__((ext_vector_type(2)));
typedef float f32x16 __attribute__((ext_vector_type(16)));
typedef unsigned u32x4 __attribute__((ext_vector_type(4)));
typedef unsigned u32x2 __attribute__((ext_vector_type(2)));
#define LDS_WAIT() asm volatile("s_waitcnt lgkmcnt(0)" ::: "memory")
#define SBAR() __builtin_amdgcn_sched_barrier(0)

__device__ __forceinline__ float bf2f(unsigned short b) { return __uint_as_float(((unsigned)b) << 16); }
__device__ __forceinline__ float bflo(unsigned w) { return __uint_as_float(w << 16); }
__device__ __forceinline__ float bfhi(unsigned w) { return __uint_as_float(w & 0xffff0000u); }
__device__ __forceinline__ unsigned f2bf(float f) { unsigned u = __float_as_uint(f); return (u + 0x7fffu + ((u >> 16) & 1u)) >> 16; }
__device__ __forceinline__ unsigned pk2(float lo, float hi) { return pg8::cvt_pk_bf16(lo, hi); }
__device__ __forceinline__ float fexp(float x) { return __builtin_amdgcn_exp2f(x * LOG2E); }
__device__ __forceinline__ float flog(float x) { return __builtin_amdgcn_logf(x) * 0.6931471805599453f; }
__device__ __forceinline__ float wave_sum(float v) {
#pragma unroll
    for (int o = 1; o < 64; o <<= 1) v += __shfl_xor(v, o);
    return v;
}
__device__ __forceinline__ int crow(int r, int hi) { return (r & 3) + 8 * (r >> 2) + 4 * hi; }

struct Frame {
    LAS unsigned char* lds; char* ldsg; unsigned char* wsb;
    int tid, lane, wave, vcu, G;
    const float *x, *norm1_g, *w_in, *up_f, *bias_f, *up_b, *bias_b, *out_g, *qn_g, *kn_g, *w_out, *norm2_g, *w_query, *sub_keys, *peer_down, *peer_up;
    float* out;
    f32x2* rope; float *rs1, *rs2, *ssp, *dec, *lp, *gate, *sd, *su, *sx, *csum; int *idx, *part; unsigned char *down8, *up8, *xq8, *fq8; unsigned short* state;
    unsigned char *Win8, *xq1; float* sw; bf16_t *WinT, *WoT, *WqT, *SK, *down16, *up16, *xb, *mixed, *h, *x1b, *qry, *op0, *op1, *op2;
};

__device__ __forceinline__ void p0_transpose_item(const float* W, int K, int N, bf16_t* WT, int k0, int n0, int dst_row0, const float* g, LAS float* scr, int lane) {
#pragma unroll 8
    for (int i = 0; i < 32; ++i) { const int kk = 2 * i + (lane >> 5); float w = W[(size_t)(k0 + kk) * N + n0 + (lane & 31)]; if (g) w *= g[k0 + kk]; scr[kk * 33 + (lane & 31)] = w; }
    LDS_WAIT(); asm volatile("" ::: "memory");
    const int c = lane & 7;
#pragma unroll
    for (int j = 0; j < 4; ++j) { const int n = (lane >> 3) + 8 * j; const LAS float* s = scr + (8 * c) * 33 + n;
        u32x4 o; o.x = pk2(s[0 * 33], s[1 * 33]); o.y = pk2(s[2 * 33], s[3 * 33]); o.z = pk2(s[4 * 33], s[5 * 33]); o.w = pk2(s[6 * 33], s[7 * 33]);
        *(u32x4*)(WT + (size_t)(dst_row0 + n) * K + k0 + 8 * c) = o; }
    LDS_WAIT(); asm volatile("" ::: "memory");
}
template <bool isup> __device__ __forceinline__ void peer_quant_row(const Frame& F, int e) {
    const int lane = F.lane; const f32x4* src = (const f32x4*)((isup ? F.peer_up : F.peer_down) + (size_t)e * DM) + lane;
    f32x4 v[8]; float m = 0.f;
#pragma unroll
    for (int j = 0; j < 8; ++j) { v[j] = src[64 * j]; if (!isup) v[j] = v[j] * ((const f32x4*)F.norm2_g)[lane + 64 * j];
        m = fmaxf(fmaxf(m, fmaxf(fabsf(v[j][0]), fabsf(v[j][1]))), fmaxf(fabsf(v[j][2]), fabsf(v[j][3]))); }
#pragma unroll
    for (int o = 1; o < 64; o <<= 1) m = fmaxf(m, __shfl_xor(m, o));
    const float inv = m > 0.f ? 127.f / m : 0.f; unsigned char* dst = isup ? F.up8 : F.down8;
#pragma unroll
    for (int j = 0; j < 8; ++j) { unsigned w = 0u;
#pragma unroll
        for (int i = 0; i < 4; ++i) { const int qv = (int)rintf(v[j][i] * inv); w |= ((unsigned)qv & 0xffu) << (8 * i); }
        const int col = 4 * lane + 256 * j; *(unsigned*)(dst + ((size_t)(col >> 7) * 16384 + e) * 128 + (col & 127)) = w; }
    if (lane == 0) (isup ? F.su : F.sd)[e] = m * (1.f / 127.f);
}
__device__ __forceinline__ void phase0(const Frame& F) {
    LAS float* scr = (LAS float*)(F.lds + F.wave * 16384);
    const int gw = F.vcu * 8 + F.wave, NGW = F.G * 8, lane = F.lane;
    { LAS float* cmx = (LAS float*)(F.lds + 12288);
      for (int nb = F.vcu; nb < 193; nb += F.G) { const int n0 = nb * 32, drow = nb < 32 ? nb * 32 : (nb == 32 ? C_GF : nb * 32 - 32), kw = F.wave * 256;
        float m = 0.f;
#pragma unroll 16
        for (int i = 0; i < 128; ++i) { const int k = kw + 2 * i + (lane >> 5); m = fmaxf(m, fabsf(F.w_in[(size_t)k * INW + n0 + (lane & 31)] * F.norm1_g[k])); }
        m = fmaxf(m, __shfl_xor(m, 32)); if (lane < 32) cmx[F.wave * 32 + lane] = m;
        __syncthreads();
        if (F.tid < 32) { float mm = 0.f;
#pragma unroll
            for (int w = 0; w < 8; ++w) mm = fmaxf(mm, cmx[w * 32 + F.tid]);
            cmx[256 + F.tid] = mm > 0.f ? 127.f / mm : 0.f; F.sw[drow + F.tid] = mm * (1.f / 127.f); }
        __syncthreads();
        for (int ch = 0; ch < 4; ++ch) { const int k0 = kw + 64 * ch;
#pragma unroll 8
            for (int i = 0; i < 32; ++i) { const int kk = 2 * i + (lane >> 5); scr[kk * 33 + (lane & 31)] = F.w_in[(size_t)(k0 + kk) * INW + n0 + (lane & 31)] * F.norm1_g[k0 + kk] * cmx[256 + (lane & 31)]; }
            LDS_WAIT(); asm volatile("" ::: "memory");
            const int c = lane & 7;
#pragma unroll
            for (int j = 0; j < 4; ++j) { const int n = (lane >> 3) + 8 * j; const LAS float* sp = scr + (8 * c) * 33 + n; u32x2 w = {0u, 0u};
#pragma unroll
                for (int i = 0; i < 4; ++i) { w.x |= ((unsigned)(int)rintf(sp[i * 33]) & 0xffu) << (8 * i); w.y |= ((unsigned)(int)rintf(sp[(4 + i) * 33]) & 0xffu) << (8 * i); }
                *(u32x2*)(F.Win8 + (size_t)(drow + n) * DM + k0 + 8 * c) = w; }
            LDS_WAIT(); asm volatile("" ::: "memory"); }
        __syncthreads(); } }
    constexpr int I_O = 32 * 64, I_Q = 32 * 64;
    for (int it = gw; it < I_O + I_Q; it += NGW) {
        int r = it;
        if (r < I_O) { const int kb = r / 64, nb = r % 64; p0_transpose_item(F.w_out, DM, DM, F.WoT, kb * 64, nb * 32, nb * 32, nullptr, scr, lane); continue; }
        r -= I_O;
        { const int kb = r / 64, nb = r % 64; p0_transpose_item(F.w_query, DM, DM, F.WqT, kb * 64, nb * 32, nb * 32, F.norm2_g, scr, lane); }
    }
    const size_t gt = (size_t)gw * 64 + lane, NT = (size_t)NGW * 64;
    { u32x4* z = (u32x4*)(F.Win8 + (size_t)INW * DM); const u32x4 zero = {0u, 0u, 0u, 0u}; for (size_t i = gt; i < (size_t)(HP - INW) * DM / 16; i += NT) z[i] = zero; if (gt < (size_t)(HP - INW)) F.sw[INW + gt] = 0.f; }
    for (int r = gw; r < 16384; r += NGW) peer_quant_row<false>(F, r);
    for (int r = gw; r < 16384; r += NGW) peer_quant_row<true>(F, r);
    for (size_t i = gt; i < (size_t)8 * 2 * 128 * 128 / 8; i += NT) { const f32x4 a = *(const f32x4*)(F.sub_keys + i * 8), b = *(const f32x4*)(F.sub_keys + i * 8 + 4);
        u32x4 o; o.x = pk2(a[0], a[1]); o.y = pk2(a[2], a[3]); o.z = pk2(b[0], b[1]); o.w = pk2(b[2], b[3]); *(u32x4*)(F.SK + i * 8) = o; }
    for (int m = gw; m < T; m += NGW) { const f32x4* xr = (const f32x4*)(F.x + (size_t)m * DM) + lane; f32x4 v[8]; float s = 0.f, mx = 0.f;
#pragma unroll
        for (int j = 0; j < 8; ++j) { v[j] = xr[64 * j]; s += (v[j][0] * v[j][0] + v[j][1] * v[j][1]) + (v[j][2] * v[j][2] + v[j][3] * v[j][3]);
            mx = fmaxf(fmaxf(mx, fmaxf(fabsf(v[j][0]), fabsf(v[j][1]))), fmaxf(fabsf(v[j][2]), fabsf(v[j][3]))); }
        s = wave_sum(s);
#pragma unroll
        for (int o = 1; o < 64; o <<= 1) mx = fmaxf(mx, __shfl_xor(mx, o));
        const float inv = mx > 0.f ? 127.f / mx : 0.f; unsigned* o4 = (unsigned*)(F.xq1 + (size_t)m * DM) + lane;
#pragma unroll
        for (int j = 0; j < 8; ++j) { unsigned w = 0u;
#pragma unroll
            for (int i = 0; i < 4; ++i) w |= ((unsigned)(int)rintf(v[j][i] * inv) & 0xffu) << (8 * i);
            o4[64 * j] = w; }
        if (lane == 0) F.rs1[m] = __builtin_amdgcn_rsqf(s * (1.f / DM) + EPS) * (mx * (1.f / 127.f)); }
    { const double invf[16] = {1.0, 0.44036660267178046, 0.19392274474868576, 0.08539710028576561, 0.03760603093086393, 0.016560440080994446, 0.007292664737217109, 0.003211445994752591,
                               0.001414213562373095, 0.000622772421914596, 0.0002742481756762073, 0.00012076973741146504, 5.318295896944988e-05, 2.341999896140934e-05, 1.031338537721246e-05, 4.5416704806078695e-06};
      for (size_t i = gt; i < (size_t)SEQ * 16; i += NT) { const int pos = (int)(i >> 4), j = (int)(i & 15); double f = 1.0;
#pragma unroll
          for (int q = 0; q < 16; ++q) f = (j == q) ? invf[q] : f;
          const double rev = (double)pos * f * 0.15915494309189535; const float fr = (float)(rev - floor(rev));
          F.rope[i] = (f32x2){__builtin_amdgcn_cosf(fr), __builtin_amdgcn_sinf(fr)}; } }
}

__device__ __forceinline__ void qknorm_rope(const Frame& F) {
    const int gw = F.vcu * 8 + F.wave, NGW = F.G * 8, lane = F.lane, c = lane & 15;
    for (long it = gw; it < (long)T * 24 / 4; it += NGW) { const long row = it * 4 + (lane >> 4); const int t = (int)(row / 24), slot = (int)(row % 24);
        bf16_t* p = F.h + (size_t)t * HP + C_QD + slot * 128 + 8 * c;
        const u32x4 w = *(const u32x4*)p; float y[8] = {bflo(w.x), bfhi(w.x), bflo(w.y), bfhi(w.y), bflo(w.z), bfhi(w.z), bflo(w.w), bfhi(w.w)};
        float ss = 0.f;
#pragma unroll
        for (int e = 0; e < 8; ++e) ss += y[e] * y[e];
        ss += __shfl_xor(ss, 1); ss += __shfl_xor(ss, 2); ss += __shfl_xor(ss, 4); ss += __shfl_xor(ss, 8);
        const float rq = __builtin_amdgcn_rsqf(ss * (1.f / 128.f) + EPS); const float* g = (slot < 12 ? F.qn_g : F.kn_g) + 8 * c;
        const f32x4 g0 = *(const f32x4*)g, g1 = *(const f32x4*)(g + 4);
#pragma unroll
        for (int e = 0; e < 4; ++e) { y[e] *= rq * g0[e]; y[4 + e] *= rq * g1[e]; }
        const int pos = t & (SEQ - 1);
#pragma unroll
        for (int e = 0; e < 8; ++e) { const float partner = __shfl_xor(y[e], 2);
            if (c < 4) { const f32x2 cs = F.rope[(size_t)pos * 16 + 8 * (c & 1) + e]; y[e] = (c < 2) ? (y[e] * cs.x - partner * cs.y) : (y[e] * cs.x + partner * cs.y); } }
        if (slot < 12) {
#pragma unroll
            for (int e = 0; e < 8; ++e) y[e] *= QSCALE; }
        u32x4 o; o.x = pk2(y[0], y[1]); o.y = pk2(y[2], y[3]); o.z = pk2(y[4], y[5]); o.w = pk2(y[6], y[7]); *(u32x4*)p = o; }
}

constexpr int GL_GDS = 0, GL_TOT = 8192, GL_QF = 12288, GL_QB = 21504, GL_KF = 30720, GL_KB = 39936, GL_VT = 49152, GL_P = 67584, GL_SF = 76800, GL_SB = 95232, GL_OB = 12288;
constexpr int RS72 = 144;
__device__ __forceinline__ float logsig(float z) { return fminf(z, 0.f) - flog(1.f + fexp(-fabsf(z))); }
__device__ __forceinline__ void gla_gates(const Frame& F, int b, int hh, int n, float (&bf)[8], float (&bb)[8], float& totf, float& totb) {
    const int tid = F.tid, c = tid & 63, ig = F.wave; LAS float* gds = (LAS float*)(F.lds + GL_GDS); LAS float* tot = (LAS float*)(F.lds + GL_TOT);
    const size_t t0 = (size_t)b * SEQ + (size_t)n * 64;
    if (tid < 256) { const int tk = tid >> 2, part = tid & 3; const u32x4 w = *(const u32x4*)(F.h + (t0 + tk) * HP + C_GF + part * 8); LAS float* d = gds + tk * 32 + part * 8;
        d[0] = bflo(w.x); d[1] = bfhi(w.x); d[2] = bflo(w.y); d[3] = bfhi(w.y); d[4] = bflo(w.z); d[5] = bfhi(w.z); d[6] = bflo(w.w); d[7] = bfhi(w.w); }
    __syncthreads();
    const int hc = hh * 64 + c; float upf[16], upb[16];
#pragma unroll
    for (int r = 0; r < 16; ++r) { upf[r] = F.up_f[r * 256 + hc]; upb[r] = F.up_b[r * 256 + hc]; }
    const float biasf = F.bias_f[hc], biasb = F.bias_b[hc]; float laf[8], lab[8];
#pragma unroll
    for (int e = 0; e < 8; ++e) { const LAS float* gr = gds + (ig * 8 + e) * 32; float zf = biasf, zb = biasb;
#pragma unroll
        for (int r = 0; r < 16; ++r) { zf += gr[r] * upf[r]; zb += gr[16 + r] * upb[r]; }
        laf[e] = logsig(zf) * 0.0625f; lab[e] = logsig(zb) * 0.0625f; }
    bf[0] = laf[0];
#pragma unroll
    for (int e = 1; e < 8; ++e) bf[e] = bf[e - 1] + laf[e];
    bb[7] = lab[7];
#pragma unroll
    for (int e = 6; e >= 0; --e) bb[e] = bb[e + 1] + lab[e];
    tot[ig * 64 + c] = bf[7]; tot[512 + ig * 64 + c] = bb[0];
    __syncthreads();
    float offf = 0.f, offb = 0.f; totf = 0.f; totb = 0.f;
#pragma unroll
    for (int g = 0; g < 8; ++g) { const float tf = tot[g * 64 + c], tb = tot[512 + g * 64 + c]; totf += tf; totb += tb; offf += (g < ig) ? tf : 0.f; offb += (g > ig) ? tb : 0.f; }
#pragma unroll
    for (int e = 0; e < 8; ++e) { bf[e] += offf; bb[e] += offb; }
}
__device__ __forceinline__ void gla_stage_vT(const Frame& F, const bf16x8 (&vraw)[2]) {
#pragma unroll
    for (int j = 0; j < 2; ++j) { const int q = F.tid + 512 * j, tk = q >> 4, vc = (q & 15) * 8; LAS short* d = (LAS short*)(F.lds + GL_VT) + vc * 72 + tk;
#pragma unroll
        for (int e = 0; e < 8; ++e) d[e * 72] = vraw[j][e]; }
}
__device__ __forceinline__ bf16x8 ldfrag(const LAS unsigned char* base, int row, int s, int hi) { return *(const LAS bf16x8*)(base + row * RS72 + (16 * s + 8 * hi) * 2); }

__device__ __forceinline__ void gla_passA(const Frame& F, int item) {
    const int bh = item >> 8, n = item & 255, b = bh >> 2, hh = bh & 3, tid = F.tid, c = tid & 63, ig = F.wave, lane = F.lane, r32 = lane & 31, hi = lane >> 5;
    const size_t t0 = (size_t)b * SEQ + (size_t)n * 64;
    unsigned short kraw[8]; bf16x8 vraw[2];
#pragma unroll
    for (int e = 0; e < 8; ++e) kraw[e] = F.h[(t0 + ig * 8 + e) * HP + C_KA + hh * 64 + c];
#pragma unroll
    for (int j = 0; j < 2; ++j) { const int q = tid + 512 * j; vraw[j] = *(const bf16x8*)(F.h + (t0 + (q >> 4)) * HP + C_VA + hh * 128 + (q & 15) * 8); }
    float bf[8], bb[8], totf, totb; gla_gates(F, b, hh, n, bf, bb, totf, totb);
    float kf[8], kb[8];
#pragma unroll
    for (int e = 0; e < 8; ++e) { const float k = bf2f(kraw[e]); kf[e] = k * fexp(totf - bf[e]); kb[e] = k * fexp(totb - bb[e]); }
    { u32x4 o; o.x = pk2(kf[0], kf[1]); o.y = pk2(kf[2], kf[3]); o.z = pk2(kf[4], kf[5]); o.w = pk2(kf[6], kf[7]); *(LAS u32x4*)(F.lds + GL_KF + c * RS72 + ig * 16) = o;
      o.x = pk2(kb[0], kb[1]); o.y = pk2(kb[2], kb[3]); o.z = pk2(kb[4], kb[5]); o.w = pk2(kb[6], kb[7]); *(LAS u32x4*)(F.lds + GL_KB + c * RS72 + ig * 16) = o; }
    gla_stage_vT(F, vraw);
    if (ig == 0) { F.dec[((size_t)(0 * 8 + bh) * 256 + n) * 64 + c] = fexp(totf); F.dec[((size_t)(1 * 8 + bh) * 256 + n) * 64 + c] = fexp(totb); }
    __syncthreads();
    const int dir = F.wave >> 2, vt = F.wave & 3; const LAS unsigned char* kimg = F.lds + (dir ? GL_KB : GL_KF);
    f32x16 a0 = {}, a1 = {};
#pragma unroll
    for (int s = 0; s < 4; ++s) { const bf16x8 av = ldfrag(F.lds + GL_VT, 32 * vt + r32, s, hi), b0 = ldfrag(kimg, r32, s, hi), b1 = ldfrag(kimg, 32 + r32, s, hi);
        a0 = __builtin_amdgcn_mfma_f32_32x32x16_bf16(av, b0, a0, 0, 0, 0); a1 = __builtin_amdgcn_mfma_f32_32x32x16_bf16(av, b1, a1, 0, 0, 0); }
    unsigned short* st = F.state + ((size_t)(dir * 8 + bh) * 256 + n) * 8192;
#pragma unroll
    for (int r = 0; r < 16; ++r) { const int v = 32 * vt + crow(r, hi); st[v * 64 + r32] = (unsigned short)f2bf(a0[r]); st[v * 64 + 32 + r32] = (unsigned short)f2bf(a1[r]); }
    __syncthreads();
}
__device__ __forceinline__ void gla_scan(const Frame& F, int item) {
    const int dir = item >> 7, bh = (item >> 4) & 7, e = (item & 15) * 512 + F.tid, c = e & 63;
    unsigned short* st = F.state + (size_t)(dir * 8 + bh) * 256 * 8192 + e; const float* dc = F.dec + (size_t)(dir * 8 + bh) * 256 * 64 + c; float S = 0.f;
    float iA[16], dA[16], iB[16], dB[16];
#define SC_N(g, j) (dir ? 255 - ((g) * 16 + (j)) : (g) * 16 + (j))
#define SC_LOAD(I_, D_, g) do { _Pragma("unroll") for (int j = 0; j < 16; ++j) { const int n_ = SC_N(g, j); I_[j] = bf2f(st[(size_t)n_ * 8192]); D_[j] = dc[n_ * 64]; } } while (0)
#define SC_RUN(I_, D_, g) do { _Pragma("unroll") for (int j = 0; j < 16; ++j) { const int n_ = SC_N(g, j); st[(size_t)n_ * 8192] = (unsigned short)f2bf(S); S = D_[j] * S + I_[j]; } } while (0)
    SC_LOAD(iA, dA, 0);
    for (int g = 0; g < 16; g += 2) { SC_LOAD(iB, dB, g + 1); SC_RUN(iA, dA, g); if (g + 2 < 16) SC_LOAD(iA, dA, g + 2); SC_RUN(iB, dB, g + 1); }
#undef SC_N
#undef SC_LOAD
#undef SC_RUN
}
__device__ __forceinline__ void gla_passC(const Frame& F, int item) {
    const int bh = item >> 8, n = item & 255, b = bh >> 2, hh = bh & 3, tid = F.tid, c = tid & 63, ig = F.wave, lane = F.lane, r32 = lane & 31, hi = lane >> 5;
    const size_t t0 = (size_t)b * SEQ + (size_t)n * 64;
    unsigned short qraw[8], kraw[8]; bf16x8 vraw[2]; u32x4 sraw[2][2];
#pragma unroll
    for (int e = 0; e < 8; ++e) { const bf16_t* hr = F.h + (t0 + ig * 8 + e) * HP + hh * 64 + c; qraw[e] = hr[C_QA]; kraw[e] = hr[C_KA]; }
#pragma unroll
    for (int j = 0; j < 2; ++j) { const int q = tid + 512 * j; vraw[j] = *(const bf16x8*)(F.h + (t0 + (q >> 4)) * HP + C_VA + hh * 128 + (q & 15) * 8);
#pragma unroll
        for (int dir = 0; dir < 2; ++dir) sraw[dir][j] = *(const u32x4*)(F.state + ((size_t)(dir * 8 + bh) * 256 + n) * 8192 + (q >> 3) * 64 + (q & 7) * 8); }
    float bf[8], bb[8], totf, totb; gla_gates(F, b, hh, n, bf, bb, totf, totb);
#pragma unroll
    for (int e = 0; e < 8; ++e) { const int i = ig * 8 + e; const float q = bf2f(qraw[e]) * 0.125f, k = bf2f(kraw[e]);
        const float ef = fexp(bf[e]), eb = fexp(bb[e]), nf = fexp(-bf[e]), nb = fexp(-bb[e]);
        *(LAS unsigned short*)(F.lds + GL_QF + i * RS72 + c * 2) = (unsigned short)f2bf(q * ef); *(LAS unsigned short*)(F.lds + GL_QB + i * RS72 + c * 2) = (unsigned short)f2bf(q * eb);
        *(LAS unsigned short*)(F.lds + GL_KF + i * RS72 + c * 2) = (unsigned short)f2bf(k * nf); *(LAS unsigned short*)(F.lds + GL_KB + i * RS72 + c * 2) = (unsigned short)f2bf(k * nb); }
    gla_stage_vT(F, vraw);
#pragma unroll
    for (int dir = 0; dir < 2; ++dir)
#pragma unroll
        for (int j = 0; j < 2; ++j) { const int q = tid + 512 * j; *(LAS u32x4*)(F.lds + (dir ? GL_SB : GL_SF) + (q >> 3) * RS72 + (q & 7) * 16) = sraw[dir][j]; }
    __syncthreads();
    if (F.wave < 4) { const int ti = F.wave >> 1, tj = F.wave & 1; f32x16 sf = {}, sb = {};
#pragma unroll
        for (int s = 0; s < 4; ++s) {
            sf = __builtin_amdgcn_mfma_f32_32x32x16_bf16(ldfrag(F.lds + GL_QF, 32 * ti + r32, s, hi), ldfrag(F.lds + GL_KF, 32 * tj + r32, s, hi), sf, 0, 0, 0);
            sb = __builtin_amdgcn_mfma_f32_32x32x16_bf16(ldfrag(F.lds + GL_QB, 32 * ti + r32, s, hi), ldfrag(F.lds + GL_KB, 32 * tj + r32, s, hi), sb, 0, 0, 0); }
#pragma unroll
        for (int r = 0; r < 16; ++r) { const int i = 32 * ti + crow(r, hi), j = 32 * tj + r32; const float p = (j <= i) ? sf[r] : sb[r];
            *(LAS unsigned short*)(F.lds + GL_P + i * RS72 + j * 2) = (unsigned short)f2bf(p); } }
    __syncthreads();
    const int ti = F.wave & 1, tv = F.wave >> 1; f32x16 o = {};
#pragma unroll
    for (int s = 0; s < 4; ++s) o = __builtin_amdgcn_mfma_f32_32x32x16_bf16(ldfrag(F.lds + GL_P, 32 * ti + r32, s, hi), ldfrag(F.lds + GL_VT, 32 * tv + r32, s, hi), o, 0, 0, 0);
#pragma unroll
    for (int s = 0; s < 4; ++s) o = __builtin_amdgcn_mfma_f32_32x32x16_bf16(ldfrag(F.lds + GL_QF, 32 * ti + r32, s, hi), ldfrag(F.lds + GL_SF, 32 * tv + r32, s, hi), o, 0, 0, 0);
#pragma unroll
    for (int s = 0; s < 4; ++s) o = __builtin_amdgcn_mfma_f32_32x32x16_bf16(ldfrag(F.lds + GL_QB, 32 * ti + r32, s, hi), ldfrag(F.lds + GL_SB, 32 * tv + r32, s, hi), o, 0, 0, 0);
    __syncthreads();
    LAS float* ob = (LAS float*)(F.lds + GL_OB);
#pragma unroll
    for (int r = 0; r < 16; ++r) ob[(32 * ti + crow(r, hi)) * 132 + 32 * tv + r32] = o[r];
    __syncthreads();
    { const int i = tid >> 3, part = tid & 7, v0 = part * 16; float ov[16], ss = 0.f;
#pragma unroll
      for (int e = 0; e < 16; ++e) { ov[e] = ob[i * 132 + v0 + e]; ss += ov[e] * ov[e]; }
      ss += __shfl_xor(ss, 1); ss += __shfl_xor(ss, 2); ss += __shfl_xor(ss, 4);
      const float rs = __builtin_amdgcn_rsqf(ss * (1.f / 128.f) + EPS); const size_t tok = t0 + i;
      const u32x4 r0 = *(const u32x4*)(F.h + tok * HP + C_RA + hh * 128 + v0), r1 = *(const u32x4*)(F.h + tok * HP + C_RA + hh * 128 + v0 + 8);
      const float rr[16] = {bflo(r0.x), bfhi(r0.x), bflo(r0.y), bfhi(r0.y), bflo(r0.z), bfhi(r0.z), bflo(r0.w), bfhi(r0.w), bflo(r1.x), bfhi(r1.x), bflo(r1.y), bfhi(r1.y), bflo(r1.z), bfhi(r1.z), bflo(r1.w), bfhi(r1.w)};
      float y[16];
#pragma unroll
      for (int e = 0; e < 16; ++e) { const float g = F.out_g[hh * 128 + v0 + e]; const float sil = rr[e] * __builtin_amdgcn_rcpf(1.f + fexp(-rr[e])); y[e] = ov[e] * rs * g * sil; }
      u32x4 w0, w1; w0.x = pk2(y[0], y[1]); w0.y = pk2(y[2], y[3]); w0.z = pk2(y[4], y[5]); w0.w = pk2(y[6], y[7]); w1.x = pk2(y[8], y[9]); w1.y = pk2(y[10], y[11]); w1.z = pk2(y[12], y[13]); w1.w = pk2(y[14], y[15]);
      bf16_t* mp = F.mixed + tok * DM + hh * 128 + v0; *(u32x4*)mp = w0; *(u32x4*)(mp + 8) = w1; }
    __syncthreads();
}

constexpr int AT_V = 0, AT_K = 32768, AT_O = 65536;
#define KSWZ(row, colB) ((row) * 256 + ((colB) ^ (((row) & 7) << 4)))
__device__ __forceinline__ int v_st(int k, int c) { const int kk = (k & ~0xC) | ((k & 4) << 1) | ((k & 8) >> 1); return ((kk >> 3) * 4 + (c >> 5)) * 512 + ((kk & 7) * 32 + (c & 31)) * 2; }
__device__ __forceinline__ int v_rd_base(int lane) { return ((lane & 3) << 3) | (((lane >> 2) & 3) << 6) | (((lane >> 4) & 1) << 5) | (((lane >> 5) & 1) << 8); }
constexpr int v_rd_off(int d0, int ks, int half) { return d0 * 512 + ks * 4096 + half * 2048; }
template <int OFF> __device__ __forceinline__ s16x4 tr_read(int vb) { s16x4 r; asm volatile("ds_read_b64_tr_b16 %0, %1 offset:%2" : "=&v"(r) : "v"(vb), "i"(OFF) : "memory"); return r; }
template <int D0> __device__ __forceinline__ void pv_one(f32x16& od, int vb, bf16x8 pa0, bf16x8 pa1, bf16x8 pa2, bf16x8 pa3) {
    const s16x4 l0 = tr_read<v_rd_off(D0, 0, 0)>(vb), h0 = tr_read<v_rd_off(D0, 0, 1)>(vb), l1 = tr_read<v_rd_off(D0, 1, 0)>(vb), h1 = tr_read<v_rd_off(D0, 1, 1)>(vb);
    const s16x4 l2 = tr_read<v_rd_off(D0, 2, 0)>(vb), h2 = tr_read<v_rd_off(D0, 2, 1)>(vb), l3 = tr_read<v_rd_off(D0, 3, 0)>(vb), h3 = tr_read<v_rd_off(D0, 3, 1)>(vb);
    asm volatile("s_waitcnt lgkmcnt(0)" ::: "memory"); SBAR();
#define PKV(L, H) (bf16x8){L[0], L[1], L[2], L[3], H[0], H[1], H[2], H[3]}
    od = __builtin_amdgcn_mfma_f32_32x32x16_bf16(pa0, PKV(l0, h0), od, 0, 0, 0);
    od = __builtin_amdgcn_mfma_f32_32x32x16_bf16(pa1, PKV(l1, h1), od, 0, 0, 0);
    od = __builtin_amdgcn_mfma_f32_32x32x16_bf16(pa2, PKV(l2, h2), od, 0, 0, 0);
    od = __builtin_amdgcn_mfma_f32_32x32x16_bf16(pa3, PKV(l3, h3), od, 0, 0, 0);
#undef PKV
}
struct AtP { size_t tokbase; int dil, m0, Tf, nt, head, p; };
__device__ __forceinline__ AtP at_decode(int item) {
    AtP P; const int p = item / 1536, rem = item % 1536, b = rem / 768, rem2 = rem % 768, u = rem2 & 63; P.p = p; P.head = rem2 >> 6;
    const int dsh = 2 * p, L = SEQ >> dsh, runs = 64 >> dsh, res = u / runs; P.dil = 1 << dsh; P.m0 = (u % runs) * 256; P.tokbase = (size_t)b * SEQ + res;
    const int kt_lo = (P.m0 == 0) ? 1 : 0, kt_hi = (P.m0 + 256 >= L) ? 4 : 5; P.Tf = P.m0 - 64 + 64 * kt_lo; P.nt = kt_hi - kt_lo + 1; return P;
}
__device__ __forceinline__ void attn_phase(const Frame& F) {
    const int tid = F.tid, wid = F.wave, lane = F.lane, r32 = lane & 31, hi = lane >> 5, G = F.G;
    int ntot = 0; for (int it = F.vcu; it < 4608; it += G) ntot += at_decode(it).nt;
    if (ntot == 0) return;
    const int sr = tid >> 4, sc = (tid & 15) * 8, vst0 = v_st(sr, sc), vst1 = v_st(32 + sr, sc), kc = sc * 2;
    const int vb0 = (int)(unsigned)(uintptr_t)(F.ldsg + AT_V) + v_rd_base(lane);
    int it_ld = F.vcu, rl = 0, it_c = F.vcu, rc = 0; AtP ld = at_decode(it_ld), cur = ld;
    bf16x8 qr[8], qn[8]; f32x16 o[4]; float l_reg = 0.f;
    bf16x8 sA0, sA1, sA2, sA3;
#define AT_QLOAD() do { const bf16_t* qp_ = F.h + C_QD + ld.head * 128 + (ld.tokbase + (size_t)ld.dil * (ld.m0 + 32 * wid + r32)) * HP + hi * 8; \
        _Pragma("unroll") for (int d0 = 0; d0 < 8; ++d0) qn[d0] = *(const bf16x8*)(qp_ + d0 * 16); } while (0)
#define AT_SLOAD(S) do { const int T0_ = ld.Tf + 64 * rl; const size_t ra = (ld.tokbase + (size_t)ld.dil * (T0_ + sr)) * HP + ld.head * 128 + sc, rb = ra + (size_t)ld.dil * 32 * HP; \
        S##0 = *(const bf16x8*)(F.h + C_VD + ra); S##1 = *(const bf16x8*)(F.h + C_VD + rb); S##2 = *(const bf16x8*)(F.h + C_KD + ra); S##3 = *(const bf16x8*)(F.h + C_KD + rb); \
        if (++rl == ld.nt) { it_ld += G; rl = 0; if (it_ld < 4608) { ld = at_decode(it_ld); AT_QLOAD(); } } } while (0)
#define AT_SWRITE(S, B) do { *(LAS bf16x8*)(F.lds + AT_V + (B) * 16384 + vst0) = S##0; *(LAS bf16x8*)(F.lds + AT_V + (B) * 16384 + vst1) = S##1; \
        *(LAS bf16x8*)(F.lds + AT_K + (B) * 16384 + KSWZ(sr, kc)) = S##2; *(LAS bf16x8*)(F.lds + AT_K + (B) * 16384 + KSWZ(32 + sr, kc)) = S##3; } while (0)
#define PK4(P, BASE, OUT) do { unsigned a0_ = pk2(P[BASE + 0], P[BASE + 1]), a1_ = pk2(P[BASE + 2], P[BASE + 3]); unsigned b0_ = pk2(P[BASE + 4], P[BASE + 5]), b1_ = pk2(P[BASE + 6], P[BASE + 7]); \
        auto r0_ = __builtin_amdgcn_permlane32_swap(a0_, b0_, false, false); auto r1_ = __builtin_amdgcn_permlane32_swap(a1_, b1_, false, false); \
        u32x4 w_ = {r0_[0], r1_[0], r0_[1], r1_[1]}; OUT = __builtin_bit_cast(bf16x8, w_); } while (0)
#define AT_STEP(BUF) do { \
        if (rc == 0) { _Pragma("unroll") for (int d0 = 0; d0 < 8; ++d0) qr[d0] = qn[d0]; _Pragma("unroll") for (int d0 = 0; d0 < 4; ++d0) o[d0] = (f32x16){}; l_reg = 0.f; } \
        const int Q0 = cur.m0 + 32 * wid, T0 = cur.Tf + 64 * rc; \
        if (T0 + 63 >= Q0 - 64 && T0 <= Q0 + 95) {                                        \
            const LAS unsigned char* Ks = F.lds + AT_K + (BUF) * 16384; f32x16 p0 = {}, p1 = {}; \
            _Pragma("unroll") for (int d0 = 0; d0 < 8; ++d0) { const int cb = (d0 * 16 + hi * 8) * 2; \
                const bf16x8 k0 = *(const LAS bf16x8*)(Ks + KSWZ(r32, cb)), k1 = *(const LAS bf16x8*)(Ks + KSWZ(32 + r32, cb)); \
                p0 = __builtin_amdgcn_mfma_f32_32x32x16_bf16(k0, qr[d0], p0, 0, 0, 0); p1 = __builtin_amdgcn_mfma_f32_32x32x16_bf16(k1, qr[d0], p1, 0, 0, 0); } \
            const int dq = T0 - (Q0 + r32); float ps = 0.f;                                \
            _Pragma("unroll") for (int r = 0; r < 16; ++r) { const int e0 = dq + crow(r, hi), e1 = e0 + 32; \
                p0[r] = (e0 >= -64 && e0 <= 64) ? __builtin_amdgcn_exp2f(p0[r]) : 0.f; p1[r] = (e1 >= -64 && e1 <= 64) ? __builtin_amdgcn_exp2f(p1[r]) : 0.f; ps += p0[r] + p1[r]; } \
            l_reg += ps; \
            bf16x8 pa0, pa1, pa2, pa3; PK4(p0, 0, pa0); PK4(p0, 8, pa1); PK4(p1, 0, pa2); PK4(p1, 8, pa3); \
            const int vb = vb0 + (BUF) * 16384; \
            pv_one<0>(o[0], vb, pa0, pa1, pa2, pa3); pv_one<1>(o[1], vb, pa0, pa1, pa2, pa3); pv_one<2>(o[2], vb, pa0, pa1, pa2, pa3); pv_one<3>(o[3], vb, pa0, pa1, pa2, pa3); } \
        if (++rc == cur.nt) {                                                             \
            bf16_t* Op = (bf16_t*)(cur.p == 0 ? (unsigned char*)F.out + OUT_OP0 : F.wsb + (cur.p == 1 ? WS_OP1 : WS_OP2)); \
            const float lt = l_reg + __shfl_xor(l_reg, 32); \
            if (hi == 0) F.lp[((size_t)cur.p * T + cur.tokbase + (size_t)cur.dil * (Q0 + r32)) * NHD + cur.head] = lt; \
            LAS unsigned char* stg = F.lds + AT_O + wid * 8192; \
            _Pragma("unroll") for (int d0 = 0; d0 < 4; ++d0) _Pragma("unroll") for (int r = 0; r < 16; ++r) *(LAS unsigned short*)(stg + (crow(r, hi) * 128 + d0 * 32 + r32) * 2) = (unsigned short)f2bf(o[d0][r]); \
            LDS_WAIT(); asm volatile("" ::: "memory"); \
            _Pragma("unroll") for (int i_ = 0; i_ < 8; ++i_) { const int row = 4 * i_ + (lane >> 4), ch = lane & 15; const u32x4 w = *(const LAS u32x4*)(stg + row * 256 + ch * 16); \
                *(u32x4*)(Op + (cur.tokbase + (size_t)cur.dil * (Q0 + row)) * (NHD * 128) + cur.head * 128 + ch * 8) = w; } \
            LDS_WAIT(); asm volatile("" ::: "memory"); \
            rc = 0; it_c += G; if (it_c < 4608) cur = at_decode(it_c); } } while (0)
    AT_QLOAD();
    AT_SLOAD(sA); AT_SWRITE(sA, 0); AT_SLOAD(sA); __syncthreads();
    for (int g = 0; g < ntot; ++g) { const int buf = g & 1;
        AT_STEP(buf);
        if (g + 1 < ntot) AT_SWRITE(sA, buf ^ 1);
        if (it_ld < 4608) AT_SLOAD(sA);
        __syncthreads();
    }
#undef AT_QLOAD
#undef AT_SLOAD
#undef AT_SWRITE
#undef PK4
#undef AT_STEP
}
__device__ __forceinline__ void dil_combine(const Frame& F) {
    const int gw = F.vcu * 8 + F.wave, NGW = F.G * 8, lane = F.lane, c = lane & 15;
    for (long it = gw; it < (long)T * NHD / 4; it += NGW) { const long row = it * 4 + (lane >> 4); const size_t tok = (size_t)(row / NHD); const int head = (int)(row % NHD);
        const float l = F.lp[tok * NHD + head] + F.lp[((size_t)T + tok) * NHD + head] + F.lp[((size_t)2 * T + tok) * NHD + head]; const float inv = 1.f / l;
        const size_t off = tok * (NHD * 128) + head * 128 + 8 * c; const u32x4 a = *(const u32x4*)(F.op0 + off), b = *(const u32x4*)(F.op1 + off), d = *(const u32x4*)(F.op2 + off);
        u32x4 o; o.x = pk2((bflo(a.x) + bflo(b.x) + bflo(d.x)) * inv, (bfhi(a.x) + bfhi(b.x) + bfhi(d.x)) * inv); o.y = pk2((bflo(a.y) + bflo(b.y) + bflo(d.y)) * inv, (bfhi(a.y) + bfhi(b.y) + bfhi(d.y)) * inv);
        o.z = pk2((bflo(a.z) + bflo(b.z) + bflo(d.z)) * inv, (bfhi(a.z) + bfhi(b.z) + bfhi(d.z)) * inv); o.w = pk2((bflo(a.w) + bflo(b.w) + bflo(d.w)) * inv, (bfhi(a.w) + bfhi(b.w) + bfhi(d.w)) * inv);
        *(u32x4*)(F.mixed + tok * DM + 512 + head * 128 + 8 * c) = o; }
}

__device__ __forceinline__ unsigned fl_flip(float x) { const unsigned u = __float_as_uint(x); return u ^ ((unsigned)((int)u >> 31) | 0x80000000u); }
__device__ __forceinline__ float fl_unflip(unsigned w) { return __uint_as_float((w & 0x80000000u) ? (w ^ 0x80000000u) : ~w); }
#define CE_DESC(a, b) do { const unsigned x_ = max(a, b), y_ = min(a, b); a = x_; b = y_; } while (0)
__device__ __forceinline__ void sort16_desc(unsigned (&a)[16]) {
#pragma unroll
    for (int k = 2; k <= 16; k <<= 1)
#pragma unroll
        for (int j = k >> 1; j > 0; j >>= 1)
#pragma unroll
            for (int i = 0; i < 16; ++i) { const int l = i ^ j; if (l > i) { const unsigned x = max(a[i], a[l]), y = min(a[i], a[l]); if ((i & k) == 0) { a[i] = x; a[l] = y; } else { a[i] = y; a[l] = x; } } }
}
__device__ __forceinline__ void bmerge16_desc(unsigned (&a)[16]) {
#pragma unroll
    for (int j = 8; j > 0; j >>= 1)
#pragma unroll
        for (int i = 0; i < 16; ++i) { const int l = i ^ j; if (l > i) CE_DESC(a[i], a[l]); }
}
__device__ __forceinline__ void top16_merge(unsigned (&a)[16], const unsigned (&b)[16]) {
#pragma unroll
    for (int i = 0; i < 16; ++i) a[i] = max(a[i], b[15 - i]);
    bmerge16_desc(a);
}
__device__ __forceinline__ void top16_partner(unsigned (&a)[16]) {
    unsigned b[16];
#pragma unroll
    for (int i = 0; i < 16; ++i) b[i] = (unsigned)__shfl_xor((int)a[i], 32);
    top16_merge(a, b);
}
__device__ constexpr unsigned char stair(int n) {
    constexpr unsigned char L[64] = {0x00,0x01,0x02,0x03,0x04,0x05,0x06,0x07,0x08,0x09,0x0a,0x0b,0x0c,0x0d,0x0e,0x0f,0x10,0x11,0x12,0x13,0x14,0x15,0x16,0x17,0x20,0x21,0x22,0x23,0x24,0x30,0x31,0x32,
                                     0x33,0x40,0x41,0x42,0x50,0x51,0x60,0x61,0x70,0x71,0x80,0x90,0xa0,0xb0,0xc0,0xd0,0xe0,0xf0,0xff,0xff,0xff,0xff,0xff,0xff,0xff,0xff,0xff,0xff,0xff,0xff,0xff,0xff};
    return L[n];
}
constexpr int TK_KEYS = 32768;
__device__ __forceinline__ void topk_item(const Frame& F, int hh, int tg) {
    const int lane = F.lane, r32 = lane & 31, hi = lane >> 5, tok0 = tg * 32; const size_t tok = (size_t)tok0 + r32;
    LAS int* ktab = (LAS int*)(F.lds + F.wave * 4096) + r32 * 32;
    float ss = 0.f;
    { const f32x4* sp = (const f32x4*)(F.ssp + tok * 32 + hi * 16);
#pragma unroll
      for (int j = 0; j < 4; ++j) { const f32x4 v = sp[j]; ss += (v[0] + v[1]) + (v[2] + v[3]); } }
    ss += __shfl_xor(ss, 32);
    const float rs2 = __builtin_amdgcn_rsqf(ss * (1.f / DM) + EPS);
    if (hh == 0 && hi == 0) F.rs2[tok] = rs2;
    unsigned top[2][16];
#pragma unroll
    for (int cc = 0; cc < 2; ++cc) {
        f32x16 acc[4] = {};
        const bf16_t* qp = F.qry + tok * DM + hh * 256 + cc * 128 + hi * 8; const LAS unsigned char* kl = F.lds + TK_KEYS + cc * 32768;
        bf16x8 qf[8];
#pragma unroll
        for (int s = 0; s < 8; ++s) qf[s] = *(const bf16x8*)(qp + 16 * s);
#pragma unroll
        for (int s = 0; s < 8; ++s) {
#pragma unroll
            for (int kt = 0; kt < 4; ++kt) { const bf16x8 kf = *(const LAS bf16x8*)(kl + KSWZ(kt * 32 + r32, (16 * s + 8 * hi) * 2)); acc[kt] = __builtin_amdgcn_mfma_f32_32x32x16_bf16(kf, qf[s], acc[kt], 0, 0, 0); } }
        unsigned g[4][16];
#pragma unroll
        for (int kt = 0; kt < 4; ++kt) {
#pragma unroll
            for (int r = 0; r < 16; ++r) g[kt][r] = (fl_flip(acc[kt][r]) & ~127u) | (unsigned)(127 - (32 * kt + crow(r, hi)));
            sort16_desc(g[kt]); }
        top16_merge(g[0], g[1]); top16_merge(g[2], g[3]); top16_merge(g[0], g[2]); top16_partner(g[0]);
#pragma unroll
        for (int i = 0; i < 16; ++i) top[cc][i] = g[0][i];
    }
#pragma unroll
    for (int i = 0; i < 16; ++i) ktab[hi * 16 + i] = 127 - (int)((hi ? top[1][i] : top[0][i]) & 127u);
    float s0[16], s1[16];
#pragma unroll
    for (int i = 0; i < 16; ++i) { s0[i] = fl_unflip(top[0][i] & ~127u); s1[i] = fl_unflip(top[1][i] & ~127u); }
    unsigned ca[16], cb[16];
#pragma unroll
    for (int n = 0; n < 32; ++n) { const int A = stair(n), B = stair(25 + n); unsigned va = 0u, vb = 0u;
        if (n < 25) { va = (fl_flip(s0[A >> 4] + s1[A & 15]) & ~255u) | (unsigned)(255 - A); vb = (fl_flip(s0[B >> 4] + s1[B & 15]) & ~255u) | (unsigned)(255 - B); }
        const unsigned v = hi ? vb : va; if (n < 16) ca[n] = v; else cb[n - 16] = v; }
    sort16_desc(ca); sort16_desc(cb); top16_merge(ca, cb); top16_partner(ca);
    float e[16], sum = 0.f; const float mx = fl_unflip(ca[0] & ~255u) * rs2;
#pragma unroll
    for (int i = 0; i < 16; ++i) { e[i] = fexp(fl_unflip(ca[i] & ~255u) * rs2 - mx); sum += e[i]; }
    const float inv = 1.f / sum;
    LDS_WAIT(); asm volatile("" ::: "memory");
    int oi[8]; float og[8];
#pragma unroll
    for (int k = 0; k < 8; ++k) { const unsigned cv = hi ? ca[8 + k] : ca[k]; const int code = 255 - (int)(cv & 255u); og[k] = (hi ? e[8 + k] : e[k]) * inv; oi[k] = ktab[code >> 4] * 128 + ktab[16 + (code & 15)]; }
    { int* ip = F.idx + tok * 128 + hh * 16 + hi * 8; float* gp = F.gate + tok * 128 + hh * 16 + hi * 8;
      *(int4*)ip = make_int4(oi[0], oi[1], oi[2], oi[3]); *(int4*)(ip + 4) = make_int4(oi[4], oi[5], oi[6], oi[7]);
      *(f32x4*)gp = (f32x4){og[0], og[1], og[2], og[3]}; *(f32x4*)(gp + 4) = (f32x4){og[4], og[5], og[6], og[7]}; }
    LDS_WAIT(); asm volatile("" ::: "memory");
}

constexpr int PS_NSL = 16, PS_CW = DM / PS_NSL, PS_SUB = PS_NSL / 8, PS_TG = 32, PS_NTG = T / PS_TG;
__device__ __forceinline__ float gelu_tanh(float x) { const float u = 0.7978845608028654f * (x + 0.044715f * x * x * x); const float t = 1.f - 2.f * __builtin_amdgcn_rcpf(1.f + fexp(2.f * u)); return 0.5f * x * (1.f + t); }
__device__ __forceinline__ int dot16i(u32x4 w, u32x4 x) { int p = __builtin_amdgcn_sdot4((int)w.x, (int)x.x, 0, false); p = __builtin_amdgcn_sdot4((int)w.y, (int)x.y, p, false); p = __builtin_amdgcn_sdot4((int)w.z, (int)x.z, p, false); return __builtin_amdgcn_sdot4((int)w.w, (int)x.w, p, false); }
__device__ __forceinline__ unsigned xcc_id() { return (unsigned)__builtin_amdgcn_s_getreg((3 << 11) | 20) & 7u; }
__device__ __forceinline__ bool peer_claim(unsigned* cnt, unsigned x, unsigned& d, int lane, int& q, int& tg) {
    while (d < 8u) { const unsigned xq = (x + d) & 7u; unsigned u = 0u;
        if (lane == 0) u = __hip_atomic_fetch_add(cnt + 64 * xq, 1u, __ATOMIC_RELAXED, __HIP_MEMORY_SCOPE_AGENT);
        u = (unsigned)__builtin_amdgcn_readfirstlane((int)u);
        if (u < (unsigned)(PS_SUB * PS_NTG)) { q = (int)(u / PS_NTG) * 8 + (int)xq; tg = (int)(u % PS_NTG); return true; }
        ++d; }
    return false;
}
template <int CTRL> __device__ __forceinline__ float dppmov(float x) { return __int_as_float(__builtin_amdgcn_update_dpp(0, __float_as_int(x), CTRL, 0xf, 0xf, true)); }
template <int CTRL> __device__ __forceinline__ int dppmovi(int x) { return __builtin_amdgcn_update_dpp(0, x, CTRL, 0xf, 0xf, true); }
__device__ __forceinline__ int bperm(int srclane, int v) { return __builtin_amdgcn_ds_bpermute(srclane << 2, v); }
__device__ __forceinline__ void peer_quant_x(const Frame& F) {
    const int gw = F.vcu * 8 + F.wave, NGW = F.G * 8, lane = F.lane;
    for (int tok = gw; tok < T; tok += NGW) { const u32x4* xr = (const u32x4*)(F.x1b + (size_t)tok * DM) + lane; float v[4][8]; float m = 0.f;
#pragma unroll
        for (int j = 0; j < 4; ++j) { const u32x4 w = xr[64 * j]; v[j][0] = bflo(w.x); v[j][1] = bfhi(w.x); v[j][2] = bflo(w.y); v[j][3] = bfhi(w.y); v[j][4] = bflo(w.z); v[j][5] = bfhi(w.z); v[j][6] = bflo(w.w); v[j][7] = bfhi(w.w);
#pragma unroll
            for (int i = 0; i < 8; ++i) m = fmaxf(m, fabsf(v[j][i])); }
#pragma unroll
        for (int o = 1; o < 64; o <<= 1) m = fmaxf(m, __shfl_xor(m, o));
        const float inv = m > 0.f ? 127.f / m : 0.f;
#pragma unroll
        for (int j = 0; j < 4; ++j) { u32x2 w = {0u, 0u};
#pragma unroll
            for (int i = 0; i < 4; ++i) { w.x |= ((unsigned)(int)rintf(v[j][i] * inv) & 0xffu) << (8 * i); w.y |= ((unsigned)(int)rintf(v[j][4 + i] * inv) & 0xffu) << (8 * i); }
            *(u32x2*)(F.xq8 + (size_t)tok * DM + 8 * lane + 512 * j) = w; }
        if (lane == 0) F.sx[tok] = m * (1.f / 127.f); }
}
__device__ __forceinline__ void peer_down(const Frame& F, int cntw = 1024) {
    const int lane = F.lane, g = lane >> 3, c = lane & 7; const unsigned x = xcc_id(); unsigned d = 0u; int q, tg; unsigned* cnt = (unsigned*)(F.wsb + WS_CTL) + cntw;
    const unsigned char* tab = F.down8; const unsigned char* xb = F.xq8;
    while (peer_claim(cnt, x, d, lane, q, tg)) {
        const unsigned colb = (unsigned)(q * PS_CW + 16 * c), slb = (unsigned)q * (16384u * 128u) + 16u * c; int* part = F.part + (size_t)q * T * 128; const size_t tok0 = (size_t)tg * PS_TG;
        u32x4 wA[16], wB[16], xA, xB; int iA0, iA1, iB0, iB1;
#define PD_IDX(i0, i1, tok) do { const int* ip_ = F.idx + (tok) * 128 + lane; i0 = ip_[0]; i1 = ip_[64]; } while (0)
#define PD_ROWS(W_, X_, i0, i1, tok) do { _Pragma("unroll") for (int j = 0; j < 16; ++j) { const unsigned e_ = (unsigned)bperm(8 * (j & 7) + g, j < 8 ? i0 : i1); \
            W_[j] = *(const u32x4*)(tab + (e_ * 128u + slb)); } X_ = *(const u32x4*)(xb + (tok) * DM + colb); } while (0)
#define PD_COMP(W_, X_, tok) do { int p[16]; _Pragma("unroll") for (int j = 0; j < 16; ++j) p[j] = dot16i(W_[j], X_); \
            int a1[8], a2[4], a3[2]; \
            _Pragma("unroll") for (int i = 0; i < 8; ++i) { const int keep = (c & 1) ? p[2 * i + 1] : p[2 * i], give = (c & 1) ? p[2 * i] : p[2 * i + 1]; a1[i] = keep + dppmovi<0xB1>(give); } \
            _Pragma("unroll") for (int i = 0; i < 4; ++i) { const int keep = (c & 2) ? a1[2 * i + 1] : a1[2 * i], give = (c & 2) ? a1[2 * i] : a1[2 * i + 1]; a2[i] = keep + dppmovi<0x4E>(give); } \
            _Pragma("unroll") for (int i = 0; i < 2; ++i) { const int keep = (c & 4) ? a2[2 * i + 1] : a2[2 * i], give = (c & 4) ? a2[2 * i] : a2[2 * i + 1]; a3[i] = keep + __shfl_xor(give, 4); } \
            part[(tok) * 128 + 8 * c + g] = a3[0]; part[(tok) * 128 + 64 + 8 * c + g] = a3[1]; } while (0)
        PD_IDX(iA0, iA1, tok0); PD_IDX(iB0, iB1, tok0 + 1);
        PD_ROWS(wA, xA, iA0, iA1, tok0);
        for (int tt = 0; tt < PS_TG; tt += 2) { const size_t tok = tok0 + tt;
            PD_ROWS(wB, xB, iB0, iB1, tok + 1);
            const size_t t2 = tok + (tt + 2 < PS_TG ? 2 : 0), t3 = tok + (tt + 2 < PS_TG ? 3 : 1);
            PD_IDX(iA0, iA1, t2);
            PD_COMP(wA, xA, tok);
            if (tt + 2 < PS_TG) PD_ROWS(wA, xA, iA0, iA1, t2);
            PD_IDX(iB0, iB1, t3);
            PD_COMP(wB, xB, tok + 1);
        }
#undef PD_IDX
#undef PD_ROWS
#undef PD_COMP
    }
}
__device__ __forceinline__ void peer_coef_probe(const Frame& F, bool dry) {
    const int gw = F.vcu * 8 + F.wave, NGW = F.G * 8, lane = F.lane;
    for (int tok = gw; tok < T; tok += NGW) { int a0 = 0, a1 = 0; const int* pp = F.part + (size_t)tok * 128 + lane;
#pragma unroll
        for (int q = 0; q < PS_NSL; ++q) { a0 += pp[(size_t)q * T * 128]; a1 += pp[(size_t)q * T * 128 + 64]; }
        const float sc = F.rs2[tok] * F.sx[tok]; const float* gp = F.gate + (size_t)tok * 128 + lane; const int e0 = F.idx[(size_t)tok * 128 + lane], e1 = F.idx[(size_t)tok * 128 + 64 + lane];
        const float c0 = gp[0] * gelu_tanh((float)a0 * sc * F.sd[e0]) * F.su[e0], c1 = gp[64] * gelu_tanh((float)a1 * sc * F.sd[e1]) * F.su[e1];
        float m = fmaxf(fabsf(c0), fabsf(c1));
#pragma unroll
        for (int o = 1; o < 64; o <<= 1) m = fmaxf(m, __shfl_xor(m, o));
        const float inv = m > 0.f ? 127.f / m : 0.f; const int q0 = (int)rintf(c0 * inv), q1 = (int)rintf(c1 * inv);
        unsigned char* fp = (dry ? F.wsb + WS_PART + 256 * MiB : F.fq8) + (size_t)tok * 128;
        { const int k0 = lane, k1 = 64 + lane; fp[(8 * (k0 >> 5) + (k0 & 7)) * 4 + ((k0 >> 3) & 3)] = (unsigned char)q0; fp[(8 * (k1 >> 5) + (k1 & 7)) * 4 + ((k1 >> 3) & 3)] = (unsigned char)q1; }
        if (lane == 0 && !dry) F.csum[tok] = m * (1.f / 127.f); }
}
__device__ __forceinline__ void peer_up(const Frame& F, int cntw = 2048, bool dry = false) {
    const int lane = F.lane, g = lane >> 3, c = lane & 7; const unsigned x = xcc_id(); unsigned d = 0u; int q, tg; unsigned* cnt = (unsigned*)(F.wsb + WS_CTL) + cntw;
    const unsigned char* tab = F.up8;
    while (peer_claim(cnt, x, d, lane, q, tg)) {
        const unsigned slb = (unsigned)q * (16384u * 128u) + 16u * c; const int col0 = q * PS_CW + 16 * c; const size_t tok0 = (size_t)tg * PS_TG;
        u32x4 wA[16], wB[16]; int iA0, iA1, iB0, iB1, fqA, fqB, fA[4], fB[4]; float oA0, oA1, oB0, oB1;
#define PU_IDX(i0, i1, fq, o0, o1, tok) do { const size_t o_ = (tok) * 128; i0 = F.idx[o_ + lane]; i1 = F.idx[o_ + 64 + lane]; fq = *(const int*)(F.fq8 + o_ + 4 * (lane & 31)); \
            const bf16_t* op_ = F.x1b + (tok) * DM + col0 + g; o0 = bf2f(op_[0]); o1 = bf2f(op_[8]); } while (0)
#define PU_ROWS(W_, F_, i0, i1, fq) do { _Pragma("unroll") for (int j = 0; j < 16; ++j) { const unsigned e_ = (unsigned)bperm(8 * (j & 7) + g, j < 8 ? i0 : i1); W_[j] = *(const u32x4*)(tab + (e_ * 128u + slb)); } \
            _Pragma("unroll") for (int m_ = 0; m_ < 4; ++m_) F_[m_] = bperm(8 * m_ + g, fq); } while (0)
#define PU_T4(ACC_, R0, R1, R2, R3, FQ_) do { const unsigned t0_ = __builtin_amdgcn_perm(R1, R0, 0x05010400u), t1_ = __builtin_amdgcn_perm(R1, R0, 0x07030602u), t2_ = __builtin_amdgcn_perm(R3, R2, 0x05010400u), t3_ = __builtin_amdgcn_perm(R3, R2, 0x07030602u); \
            ACC_[0] = __builtin_amdgcn_sdot4((int)__builtin_amdgcn_perm(t2_, t0_, 0x05040100u), FQ_, ACC_[0], false); ACC_[1] = __builtin_amdgcn_sdot4((int)__builtin_amdgcn_perm(t2_, t0_, 0x07060302u), FQ_, ACC_[1], false); \
            ACC_[2] = __builtin_amdgcn_sdot4((int)__builtin_amdgcn_perm(t3_, t1_, 0x05040100u), FQ_, ACC_[2], false); ACC_[3] = __builtin_amdgcn_sdot4((int)__builtin_amdgcn_perm(t3_, t1_, 0x07060302u), FQ_, ACC_[3], false); } while (0)
#define PU_COMP(W_, F_, o0, o1, tok) do { int acc[16] = {}; \
            _Pragma("unroll") for (int m_ = 0; m_ < 4; ++m_) { int* a_ = acc; PU_T4(a_, W_[4 * m_].x, W_[4 * m_ + 1].x, W_[4 * m_ + 2].x, W_[4 * m_ + 3].x, F_[m_]); a_ = acc + 4; PU_T4(a_, W_[4 * m_].y, W_[4 * m_ + 1].y, W_[4 * m_ + 2].y, W_[4 * m_ + 3].y, F_[m_]); \
                a_ = acc + 8; PU_T4(a_, W_[4 * m_].z, W_[4 * m_ + 1].z, W_[4 * m_ + 2].z, W_[4 * m_ + 3].z, F_[m_]); a_ = acc + 12; PU_T4(a_, W_[4 * m_].w, W_[4 * m_ + 1].w, W_[4 * m_ + 2].w, W_[4 * m_ + 3].w, F_[m_]); } \
            int a1[8], a2[4], a3[2]; \
            _Pragma("unroll") for (int i = 0; i < 8; ++i) { const int keep = (g & 1) ? acc[2 * i + 1] : acc[2 * i], give = (g & 1) ? acc[2 * i] : acc[2 * i + 1]; a1[i] = keep + dppmovi<0x128>(give); } \
            _Pragma("unroll") for (int i = 0; i < 4; ++i) { const int keep = (g & 2) ? a1[2 * i + 1] : a1[2 * i], give = (g & 2) ? a1[2 * i] : a1[2 * i + 1]; a2[i] = keep + __shfl_xor(give, 16); } \
            _Pragma("unroll") for (int i = 0; i < 2; ++i) { const int keep = (g & 4) ? a2[2 * i + 1] : a2[2 * i], give = (g & 4) ? a2[2 * i] : a2[2 * i + 1]; a3[i] = keep + __shfl_xor(give, 32); } \
            const float sf_ = F.csum[tok]; float* dp_ = (dry ? (float*)(F.wsb + WS_PART) + ((tok) & 16383) * DM : F.out + (tok) * DM) + col0 + g; \
            dp_[0] = o0 + sf_ * (float)a3[0]; dp_[8] = o1 + sf_ * (float)a3[1]; } while (0)
        PU_IDX(iA0, iA1, fqA, oA0, oA1, tok0); PU_IDX(iB0, iB1, fqB, oB0, oB1, tok0 + 1);
        PU_ROWS(wA, fA, iA0, iA1, fqA);
        for (int tt = 0; tt < PS_TG; tt += 2) { const size_t tok = tok0 + tt;
            PU_ROWS(wB, fB, iB0, iB1, fqB);
            const float pA0 = oA0, pA1 = oA1;
            const bool more = tt + 2 < PS_TG; const size_t t2 = tok + (more ? 2 : 0), t3 = tok + (more ? 3 : 1);
            PU_IDX(iA0, iA1, fqA, oA0, oA1, t2);
            PU_COMP(wA, fA, pA0, pA1, tok);
            if (more) PU_ROWS(wA, fA, iA0, iA1, fqA);
            const float pB0 = oB0, pB1 = oB1;
            PU_IDX(iB0, iB1, fqB, oB0, oB1, t3);
            PU_COMP(wB, fB, pB0, pB1, tok + 1);
        }
#undef PU_IDX
#undef PU_ROWS
#undef PU_T4
#undef PU_COMP
    }
}

#define XB_TMO      128
#define XB_XCNT(j)  (256  + 64 * (j))
#define XB_XSUB(j)  (1280 + 64 * (j))
#define XB_XGEN(j)  (2304 + 64 * (j))
#define XB_TOP      3328
#define XB_TOPGEN   3392
#define XCD_BAR_WORDS 3456
#define XB_SPIN_CAP (1u << 18)

__device__ __forceinline__ unsigned xb_ld(unsigned* p)              { return __hip_atomic_load(p, __ATOMIC_RELAXED, __HIP_MEMORY_SCOPE_AGENT); }
__device__ __forceinline__ unsigned xb_add(unsigned* p, unsigned v) { return __hip_atomic_fetch_add(p, v, __ATOMIC_RELAXED, __HIP_MEMORY_SCOPE_AGENT); }
__device__ __forceinline__ unsigned xb_xcc_id() { return (unsigned)__builtin_amdgcn_s_getreg((3 << 11) | 20) & 0xFu; }
#define XB_SPIN(cond, bar) do { unsigned _sp = 0; while (cond) { __builtin_amdgcn_s_sleep(1); \
    if ((++_sp & 255u) == 0u) { if (xb_ld(&(bar)[XB_TMO])) break; if (_sp > XB_SPIN_CAP) { atomicAdd(&(bar)[XB_TMO], 1u); break; } } } } while (0)

struct XcdBarrier {
    unsigned* bar; unsigned x;
    volatile LAS unsigned* st;
};

__device__ __forceinline__ XcdBarrier xcd_barrier_post(unsigned* bar, volatile LAS unsigned* st) {
    XcdBarrier b; b.bar = bar; b.x = xb_xcc_id(); b.st = st;
    if (threadIdx.x == 0) (void)xb_add(&bar[XB_XCNT(b.x)], 1u);
    return b;
}
__device__ __forceinline__ void xcd_barrier_complete(unsigned* bar, unsigned x, unsigned& nloc, unsigned& nx) {
    const unsigned G = gridDim.x * gridDim.y * gridDim.z;
    unsigned sum, cnt, mine, sp = 0u;
    for (;;) {
        sum = 0u; cnt = 0u; mine = 0u;
#pragma unroll
        for (unsigned j = 0; j < 16; ++j) { const unsigned c = xb_ld(&bar[XB_XCNT(j)]); sum += c; cnt += (c > 0u) ? 1u : 0u; mine = (j == x) ? c : mine; }
        if (sum == G) break;
        __builtin_amdgcn_s_sleep(1);
        if ((++sp & 255u) == 0u) { if (xb_ld(&bar[XB_TMO])) break; if (sp > XB_SPIN_CAP) { atomicAdd(&bar[XB_TMO], 1u); break; } }
    }
    nloc = mine > 0u ? mine : 1u; nx = cnt > 0u ? cnt : 1u;
}

__device__ __forceinline__ void xcd_barrier(const XcdBarrier& b) {
    asm volatile("s_waitcnt vmcnt(0)" ::: "memory");
    __syncthreads();
    if (threadIdx.x == 0) {
        unsigned* bar = b.bar;
        __builtin_amdgcn_s_waitcnt(0);
        unsigned nloc = b.st[0], nx = b.st[1];
        if (nloc == 0u) { xcd_barrier_complete(bar, b.x, nloc, nx); b.st[0] = nloc; b.st[1] = nx; }
        const unsigned old = xb_add(&bar[XB_XSUB(b.x)], 1u);
        const unsigned gen = old / nloc;
        if (old + 1u == (gen + 1u) * nloc) {
            __builtin_amdgcn_fence(__ATOMIC_RELEASE, "agent");
            asm volatile("s_waitcnt vmcnt(0)" ::: "memory");
            const unsigned og = xb_add(&bar[XB_TOP], 1u);
            const unsigned tg = og / nx;
            if (og + 1u == (tg + 1u) * nx) xb_add(&bar[XB_TOPGEN], 1u);
            else XB_SPIN(xb_ld(&bar[XB_TOPGEN]) == tg, bar);
            __builtin_amdgcn_fence(__ATOMIC_ACQUIRE, "agent");
            xb_add(&bar[XB_XGEN(b.x)], 1u);
            asm volatile("s_waitcnt vmcnt(0)" ::: "memory");
        } else {
            XB_SPIN(xb_ld(&bar[XB_XGEN(b.x)]) == gen, bar);
            __builtin_amdgcn_fence(__ATOMIC_ACQUIRE, "agent");
            asm volatile("s_waitcnt vmcnt(0)" ::: "memory");
        }
    }
    __syncthreads();
}

struct Args { const float* in[16]; float* out; unsigned char* ws; int ph_lo, ph_hi, coop, pad; };
__global__ void __launch_bounds__(512, 2) fwd_kernel(Args args) {
    extern __shared__ __attribute__((aligned(16))) unsigned char lds_raw[];
    Frame F;
    F.lds = (LAS unsigned char*)lds_raw; F.ldsg = (char*)lds_raw;
    F.tid = threadIdx.x; F.lane = F.tid & 63; F.wave = __builtin_amdgcn_readfirstlane(F.tid >> 6);
    F.G = gridDim.x; { const int bx = blockIdx.x; F.vcu = (F.G % 8 == 0) ? (bx % 8) * (F.G / 8) + bx / 8 : bx; }
    F.x = args.in[0]; F.norm1_g = args.in[1]; F.w_in = args.in[2]; F.up_f = args.in[3]; F.bias_f = args.in[4]; F.up_b = args.in[5]; F.bias_b = args.in[6]; F.out_g = args.in[7];
    F.qn_g = args.in[8]; F.kn_g = args.in[9]; F.w_out = args.in[10]; F.norm2_g = args.in[11]; F.w_query = args.in[12]; F.sub_keys = args.in[13]; F.peer_down = args.in[14]; F.peer_up = args.in[15];
    F.out = args.out; unsigned char* ws = args.ws; F.wsb = ws;
    F.rope = (f32x2*)(ws + WS_ROPE); F.rs1 = (float*)(ws + WS_RS1); F.rs2 = (float*)(ws + WS_RS2); F.ssp = (float*)(ws + WS_SSP); F.dec = (float*)(ws + WS_DEC); F.lp = (float*)(ws + WS_LP);
    F.gate = (float*)(ws + WS_GATE); F.part = (int*)(ws + WS_PART); F.sd = (float*)(ws + WS_CTL + 65536); F.su = (float*)(ws + WS_CTL + 131072); F.sx = (float*)(ws + WS_RS2 + 131072); F.csum = (float*)(ws + WS_RS2 + 262144);
    F.down8 = ws + WS_DOWN; F.up8 = ws + WS_UP; F.xq8 = ws + WS_XB; F.fq8 = ws + WS_XB + 64 * MiB; F.idx = (int*)(ws + WS_IDX); F.state = (unsigned short*)((unsigned char*)args.out + OUT_ST);
    F.WinT = (bf16_t*)(ws + WS_WIN); F.Win8 = ws + WS_WIN; F.xq1 = ws + WS_OP1; F.sw = (float*)(ws + WS_CTL + 196608); F.WoT = (bf16_t*)(ws + WS_WO); F.WqT = (bf16_t*)(ws + WS_WQ); F.SK = (bf16_t*)(ws + WS_SK); F.down16 = (bf16_t*)(ws + WS_DOWN); F.up16 = (bf16_t*)(ws + WS_UP);
    F.xb = (bf16_t*)(ws + WS_XB); F.mixed = (bf16_t*)(ws + WS_XB); F.h = (bf16_t*)(ws + WS_H); F.x1b = (bf16_t*)(ws + WS_X1B); F.qry = (bf16_t*)(ws + WS_QRY);
    F.op0 = (bf16_t*)((unsigned char*)args.out + OUT_OP0); F.op1 = (bf16_t*)(ws + WS_OP1); F.op2 = (bf16_t*)(ws + WS_OP2);
    constexpr int MISC_OFF = 131072 + 320;
    for (int u = F.tid; u < 64; u += 512) ((LAS unsigned*)(F.lds + MISC_OFF))[u] = 0u;
    __syncthreads();
    XcdBarrier bar = xcd_barrier_post((unsigned*)(ws + WS_CTL) + 8192, (volatile LAS unsigned*)(F.lds + MISC_OFF) + 8);
    const int lo = args.ph_lo, hi = args.ph_hi;
#ifndef PH_MASK
#define PH_MASK 0x7ff
#endif
#ifndef PROBE_PHASE
#define PROBE_PHASE -1
#endif
#define REP(k) for (int rep_ = 0; rep_ < ((PROBE_PHASE == (k)) ? 2 : 1); ++rep_)
#define IN(k) (((PH_MASK >> (k)) & 1) && lo <= (k) && (k) < hi)
#define SEAM(k) do { if (IN(k) && IN((k) + 1)) { if (args.coop) { if ((k) == 0) cg::this_grid().sync(); else xcd_barrier(bar); } } } while (0)
    if (IN(0)) { REP(0) phase0(F); } SEAM(0);
#define GEMM1_BODY { pg8::Gemm g{(const pg8::bf16_t*)F.xq1, (const pg8::bf16_t*)F.Win8, T, HP, DM / 2}; pg8::StaticOrder S; S.init(T, HP, F.G, (int)blockIdx.x); \
        pg8::EpiI8Qk E{F.h, HP, F.rs1, F.sw, F.qn_g, F.kn_g, (LAS float*)(F.lds + 131072 + 1024), C_QD / 256, C_KD / 256, C_VD / 256, SEQ - 1, QSCALE}; \
        pg8::gemm_phase<pg8::EpiI8Qk, pg8::StaticOrder, PG8_ALIGN, PG8_SP2, true>(F.lds, g, S, E); }
    if (IN(1)) { GEMM1_BODY; if (PROBE_PHASE == 1) GEMM1_BODY; } SEAM(1);
    if (IN(2)) { REP(2) for (int it = F.vcu; it < 2048; it += F.G) gla_passA(F, it); } SEAM(2);
    if (IN(3)) { for (int it = F.vcu; it < 256; it += F.G) gla_scan(F, it); REP(3) attn_phase(F); } SEAM(3);
    if (IN(4)) REP(4) { for (int it = F.vcu; it < 2048; it += F.G) gla_passC(F, it); dil_combine(F); } SEAM(4);
#define GEMM5_BODY { pg8::Gemm g{F.mixed, F.WoT, T, DM, DM}; pg8::StaticOrder S; S.init(T, DM, F.G, (int)blockIdx.x); pg8::EpiResid E{F.x, F.out, F.x1b, F.ssp, DM}; \
        pg8::gemm_phase<pg8::EpiResid, pg8::StaticOrder, PG8_ALIGN, PG8_SP2>(F.lds, g, S, E); }
#define GEMM6_BODY { pg8::Gemm g{F.x1b, F.WqT, T, DM, DM}; pg8::StaticOrder S; S.init(T, DM, F.G, (int)blockIdx.x); pg8::EpiRowScaleBf16 E{F.qry, DM, nullptr}; \
        pg8::gemm_phase<pg8::EpiRowScaleBf16, pg8::StaticOrder, PG8_ALIGN, PG8_SP2>(F.lds, g, S, E); }
    if (IN(5)) { GEMM5_BODY; if (PROBE_PHASE == 5) GEMM5_BODY; } SEAM(5);
    if (IN(6)) { GEMM6_BODY; if (PROBE_PHASE == 6) GEMM6_BODY; } SEAM(6);
    if (IN(7)) REP(7) { const int gw = F.vcu * 8 + F.wave, NGW = F.G * 8; for (int u = F.vcu; u < 256; u += F.G) { const int hh = u & 7, chunk = u >> 3;
            __syncthreads();
            for (int i = F.tid; i < 4096; i += 512) { const int row = i >> 4, ch = i & 15; *(LAS u32x4*)(F.lds + TK_KEYS + KSWZ(row, ch * 16)) = *(const u32x4*)(F.SK + ((size_t)hh * 256 + row) * 128 + ch * 8); }
            __syncthreads();
            for (int j = 0; j < 4; ++j) topk_item(F, hh, chunk * 32 + F.wave * 4 + j); }
        if (rep_ == 0) peer_quant_x(F); } SEAM(7);
    if (IN(8)) { if (PROBE_PHASE == 8) peer_down(F, 3072); peer_down(F); } SEAM(8);
    if (IN(9)) { REP(9) peer_coef_probe(F, (PROBE_PHASE == 9) && rep_ == 0); } SEAM(9);
    if (IN(10)) { if (PROBE_PHASE == 10) peer_up(F, 3584, true); peer_up(F); }
#undef IN
#undef SEAM
}

#ifndef MK_N_LAUNCHES
#define MK_N_LAUNCHES 1
#endif
extern "C" void kernel_launch(void* const* d_in, const int* in_sizes, int n_in, void* d_out, int out_size, void* d_ws, size_t ws_size, hipStream_t stream) {
    static int grid = 0;
    if (grid == 0) {
        if (n_in != 16 || in_sizes[0] != T * DM || out_size != T * DM || ws_size < WS_END) { fprintf(stderr, "kernel_launch: unexpected shapes (n_in %d, in0 %d, out %d, ws %zu)\n", n_in, n_in > 0 ? in_sizes[0] : -1, out_size, ws_size); grid = -1; return; }
        int dev = 0, cus = 0, per_cu = 0;
        if (hipGetDevice(&dev) != hipSuccess || hipDeviceGetAttribute(&cus, hipDeviceAttributeMultiprocessorCount, dev) != hipSuccess) { grid = -1; return; }
        if (hipFuncSetAttribute((const void*)fwd_kernel, hipFuncAttributeMaxDynamicSharedMemorySize, LDS_BYTES) != hipSuccess) { fprintf(stderr, "kernel_launch: hipFuncSetAttribute failed\n"); grid = -1; return; }
        if (hipOccupancyMaxActiveBlocksPerMultiprocessor(&per_cu, (const void*)fwd_kernel, 512, LDS_BYTES) != hipSuccess || per_cu < 1) { fprintf(stderr, "kernel_launch: occupancy query says %d\n", per_cu); per_cu = 1; }
        (void)hipGetLastError();
        grid = cus;
    }
    if (grid < 0) return;
    if (hipMemsetAsync(d_ws, 0, 65536, stream) != hipSuccess) { fprintf(stderr, "kernel_launch: hipMemsetAsync failed\n"); return; }
    Args a{};
    for (int i = 0; i < 16; ++i) a.in[i] = (const float*)d_in[i];
    a.out = (float*)d_out; a.ws = (unsigned char*)d_ws;
    if (MK_N_LAUNCHES == 1) {
        a.ph_lo = 0; a.ph_hi = NPHASE; a.coop = 1; void* kargs[] = {&a};
        hipError_t e = hipLaunchCooperativeKernel((const void*)fwd_kernel, dim3(grid), dim3(512), kargs, LDS_BYTES, stream);
        if (e != hipSuccess) fprintf(stderr, "kernel_launch: cooperative launch failed: %s (grid %d)\n", hipGetErrorString(e), grid);
    } else {
        for (int p = 0; p < NPHASE; ++p) { a.ph_lo = p; a.ph_hi = p + 1; a.coop = 0; hipLaunchKernelGGL(fwd_kernel, dim3(grid), dim3(512), LDS_BYTES, stream, a); }
        const hipError_t le = hipPeekAtLastError(); if (le != hipSuccess) fprintf(stderr, "kernel_launch: launch failed: %s\n", hipGetErrorName(le));
    }
}
```

```cpp
#include <hip/hip_runtime.h>
#include <hip/hip_cooperative_groups.h>
#include <cstdio>
#include <cstdint>
namespace cg = cooperative_groups;
namespace pg8 {
#define PG8_LAS __attribute__((address_space(3)))
typedef unsigned short bf16_t;
typedef short bf16x8 __attribute__((ext_vector_type(8)));
typedef float f32x4 __attribute__((ext_vector_type(4)));
typedef unsigned u32x4 __attribute__((ext_vector_type(4)));
constexpr int BM = 256, BK = 64, HALF = 128, HTB = HALF * BK * 2  , STAGE_BYTES = 8 * HTB, NXCD = 8, WGM = 8;

__host__ __device__ __forceinline__ int lds_byte(int r, int c) { const int st = (r >> 4) * 2 + (c >> 5), rr = r & 15, cc = c & 31, ob = rr * 64 + cc * 2; return st * 1024 + (ob ^ (((ob >> 9) & 1) << 5)); }
__host__ __device__ __forceinline__ void stage_rc(int b, int& R, int& C) { const int st = b / 1024, sb = b % 1024, swz = sb ^ (((sb >> 9) & 1) << 5); R = (st >> 1) * 16 + swz / 64; C = (st & 1) * 32 + (swz % 64) / 2; }
__host__ __device__ __forceinline__ int perm32(int rho) { const int n = rho >> 4, i = rho & 15; return 8 * (i >> 2) + 4 * n + (i & 3); }

struct Unit { int pm, pn; };
struct Gemm { const bf16_t* A; const bf16_t* Bt; int M, N, K; };

struct StaticOrder {
    int nM, nN, nwg, G, c;
    __host__ __device__ void init(int M, int N, int G_, int c_) { nM = M / BM; nN = N / BM; nwg = nM * nN; G = G_; c = c_; }
    __host__ __device__ bool next(int i, Unit& u) const {
        const long L = (long)i * G + c; if (L >= nwg) return false;
        int wgid = (int)L; { const int q = nwg / NXCD, r = nwg % NXCD, xcd = wgid % NXCD, off = wgid / NXCD; wgid = (xcd < r ? xcd * (q + 1) : r * (q + 1) + (xcd - r) * q) + off; }
        const int nig = WGM * nN, gid = wgid / nig, fm = gid * WGM, gsz = (nM - fm) < WGM ? (nM - fm) : WGM;
        u.pm = fm + ((wgid % nig) % gsz); u.pn = (wgid % nig) / gsz; return true;
    }
    __device__ __forceinline__ void a_ready(const Unit&) const {}
    __device__ __forceinline__ void done(const Unit&) const {}
};
__device__ __forceinline__ unsigned cvt_pk_bf16(float lo, float hi) { unsigned r; asm volatile("v_cvt_pk_bf16_f32 %0, %1, %2" : "=v"(r) : "v"(lo), "v"(hi)); return r; }
typedef int i32x4 __attribute__((ext_vector_type(4)));
template <bool I8> struct AccT { typedef f32x4 type; };
template <> struct AccT<true> { typedef i32x4 type; };
struct EpiRowScaleBf16 {
    static constexpr bool PERM = true, AFTER_DRAIN = false;
    bf16_t* O; int ldc; const float* rs;
    __device__ __forceinline__ void operator()(const f32x4 (&acc)[2][2][4][2], const Unit& u, int wr, int wc, int fr, int fq) const {
        const int row0 = u.pm * BM + wr * 64 + fr, col0 = u.pn * BM + wc * 32 + 8 * fq;
#pragma unroll
        for (int ai = 0; ai < 2; ++ai)
#pragma unroll
            for (int m = 0; m < 4; ++m) { const int row = row0 + ai * HALF + m * 16; const float s = rs ? rs[row] : 1.f; bf16_t* rowp = O + (size_t)row * ldc + col0;
#pragma unroll
                for (int bj = 0; bj < 2; ++bj) { const f32x4 v0 = acc[ai][bj][m][0] * s, v1 = acc[ai][bj][m][1] * s;
                    u32x4 w; w.x = cvt_pk_bf16(v0[0], v0[1]); w.y = cvt_pk_bf16(v0[2], v0[3]); w.z = cvt_pk_bf16(v1[0], v1[1]); w.w = cvt_pk_bf16(v1[2], v1[3]);
                    *(u32x4*)(rowp + bj * HALF) = w; } }
    }
};
struct EpiI8Qk {
    static constexpr bool PERM = true, AFTER_DRAIN = false;
    bf16_t* O; int ldc; const float* rs; const float* cs; const float* qg; const float* kg; PG8_LAS float* P; int qk_lo, q_hi, qk_hi, seqmask; float qscale;
    __device__ __forceinline__ void operator()(const i32x4 (&acc)[2][2][4][2], const Unit& u, int wr, int wc, int fr, int fq) const {
        const int row0 = u.pm * BM + wr * 64 + fr, col0 = u.pn * BM + wc * 32 + 8 * fq;
        f32x4 cv[2][2];
#pragma unroll
        for (int bj = 0; bj < 2; ++bj) { cv[bj][0] = *(const f32x4*)(cs + col0 + bj * HALF); cv[bj][1] = *(const f32x4*)(cs + col0 + bj * HALF + 4); }
        const bool qk = u.pn >= qk_lo && u.pn < qk_hi;
        float rq[2][4][2];
        if (qk) {
#pragma unroll
            for (int ai = 0; ai < 2; ++ai)
#pragma unroll
                for (int m = 0; m < 4; ++m) { const float s = rs[row0 + ai * HALF + m * 16]; const int rl = ai * HALF + wr * 64 + m * 16 + fr;
#pragma unroll
                    for (int bj = 0; bj < 2; ++bj) { const i32x4 a0 = acc[ai][bj][m][0], a1 = acc[ai][bj][m][1]; const f32x4 c0 = cv[bj][0] * s, c1 = cv[bj][1] * s; float ss = 0.f;
#pragma unroll
                        for (int i = 0; i < 4; ++i) { const float x0 = (float)a0[i] * c0[i], x1 = (float)a1[i] * c1[i]; ss += x0 * x0 + x1 * x1; }
                        ss += __shfl_xor(ss, 16); ss += __shfl_xor(ss, 32);
                        if (fq == 0) P[rl * 8 + bj * 4 + wc] = ss; } }
            asm volatile("s_waitcnt lgkmcnt(0)" ::: "memory"); __builtin_amdgcn_s_barrier(); asm volatile("" ::: "memory");
#pragma unroll
            for (int ai = 0; ai < 2; ++ai)
#pragma unroll
                for (int m = 0; m < 4; ++m) { const int rl = ai * HALF + wr * 64 + m * 16 + fr;
#pragma unroll
                    for (int bj = 0; bj < 2; ++bj) { const f32x4 p = *(const PG8_LAS f32x4*)(P + rl * 8 + bj * 4); rq[ai][m][bj] = __builtin_amdgcn_rsqf(((p[0] + p[1]) + (p[2] + p[3])) * (1.f / 128.f) + 1e-6f); } }
        }
        const bool isq = u.pn < q_hi; const float* gp = (isq ? qg : kg) + wc * 32 + 8 * fq; f32x4 g0 = {1.f, 1.f, 1.f, 1.f}, g1 = g0;
        if (qk) { g0 = *(const f32x4*)gp; g1 = *(const f32x4*)(gp + 4); if (isq) { g0 = g0 * qscale; g1 = g1 * qscale; } }
        constexpr float RV[16] = {1.591549431e-01f, 7.008652159e-02f, 3.086376340e-02f, 1.359137064e-02f, 5.985185713e-03f, 2.635675899e-03f, 1.160663641e-03f, 5.111175045e-04f, 2.250790790e-04f, 9.911730937e-05f, 4.364795279e-05f, 1.922110068e-05f, 8.464330808e-06f, 3.727408602e-06f, 1.641426263e-06f, 7.228293069e-07f};
#pragma unroll
        for (int ai = 0; ai < 2; ++ai)
#pragma unroll
            for (int m = 0; m < 4; ++m) { const int row = row0 + ai * HALF + m * 16; const float s = rs[row]; bf16_t* rowp = O + (size_t)row * ldc + col0;
                float cs8[8], sn8[8];
                if (qk && wc == 0) { const float pos = (float)(row & seqmask);
#pragma unroll
                    for (int e8 = 0; e8 < 8; ++e8) { const float rev = pos * ((fq & 1) ? RV[8 + e8] : RV[e8]); const float fr_ = rev - __builtin_floorf(rev); cs8[e8] = __builtin_amdgcn_cosf(fr_); sn8[e8] = __builtin_amdgcn_sinf(fr_); } }
#pragma unroll
                for (int bj = 0; bj < 2; ++bj) { const i32x4 a0 = acc[ai][bj][m][0], a1 = acc[ai][bj][m][1]; const float sq = qk ? s * rq[ai][m][bj] : s; const f32x4 c0 = cv[bj][0] * sq * g0, c1 = cv[bj][1] * sq * g1;
                    float v[8];
#pragma unroll
                    for (int i = 0; i < 4; ++i) { v[i] = (float)a0[i] * c0[i]; v[4 + i] = (float)a1[i] * c1[i]; }
                    if (qk && wc == 0) {
#pragma unroll
                        for (int e8 = 0; e8 < 8; ++e8) { const float pr = __shfl_xor(v[e8], 32); v[e8] = (fq < 2) ? (v[e8] * cs8[e8] - pr * sn8[e8]) : (v[e8] * cs8[e8] + pr * sn8[e8]); } }
                    u32x4 w; w.x = cvt_pk_bf16(v[0], v[1]); w.y = cvt_pk_bf16(v[2], v[3]); w.z = cvt_pk_bf16(v[4], v[5]); w.w = cvt_pk_bf16(v[6], v[7]);
                    *(u32x4*)(rowp + bj * HALF) = w; } }
    }
};
struct EpiResid {
    static constexpr bool PERM = true, AFTER_DRAIN = false;
    const float* x; float* out; bf16_t* xb; float* ssp; int ldc;
    __device__ __forceinline__ void operator()(const f32x4 (&acc)[2][2][4][2], const Unit& u, int wr, int wc, int fr, int fq) const {
        const int row0 = u.pm * BM + wr * 64 + fr, col0 = u.pn * BM + wc * 32 + 8 * fq;
#pragma unroll
        for (int ai = 0; ai < 2; ++ai)
#pragma unroll
            for (int m = 0; m < 4; ++m) { const int row = row0 + ai * HALF + m * 16; const size_t off = (size_t)row * ldc + col0; float ss = 0.f;
#pragma unroll
                for (int bj = 0; bj < 2; ++bj) { const f32x4 xa = *(const f32x4*)(x + off + bj * HALF), xc = *(const f32x4*)(x + off + bj * HALF + 4);
                    const f32x4 v0 = acc[ai][bj][m][0] + xa, v1 = acc[ai][bj][m][1] + xc;
                    u32x4 w; w.x = cvt_pk_bf16(v0[0], v0[1]); w.y = cvt_pk_bf16(v0[2], v0[3]); w.z = cvt_pk_bf16(v1[0], v1[1]); w.w = cvt_pk_bf16(v1[2], v1[3]);
                    *(u32x4*)(xb + off + bj * HALF) = w;
                    ss += (v0[0] * v0[0] + v0[1] * v0[1]) + (v0[2] * v0[2] + v0[3] * v0[3]) + (v1[0] * v1[0] + v1[1] * v1[1]) + (v1[2] * v1[2] + v1[3] * v1[3]); }
                ss += __shfl_xor(ss, 16); ss += __shfl_xor(ss, 32);
                if (fq == 0) ssp[(size_t)row * 32 + u.pn * 4 + wc] = ss; }
    }
};
template <class Epi, class Sched, bool ALIGN_EPI = false, bool SP2 = false, bool I8 = false>
__device__ __forceinline__ void gemm_phase(PG8_LAS unsigned char* lds, const Gemm g, const Sched& S, const Epi& E) {
    const int tid = threadIdx.x, wid = __builtin_amdgcn_readfirstlane(tid >> 6), lane = tid & 63, wr = wid >> 2, wc = wid & 3, fr = lane & 15, fq = lane >> 4;
    const int K = g.K, nt = K / BK;
    unsigned voffA[2], voffB[2];
#pragma unroll
    for (int i = 0; i < 2; ++i) { int R, C; stage_rc(tid * 16 + i * 8192, R, C); const int Rb = Epi::PERM ? ((R & ~31) + perm32(R & 31)) : R;
        voffA[i] = (unsigned)(R * K + C) * 2u; voffB[i] = (unsigned)(Rb * K + C) * 2u; }
    const size_t kstep = (size_t)(BK * 2);
    const size_t hstep = (size_t)HALF * K * 2;
    const size_t tstep = 2 * hstep;
    const unsigned ldsw = (unsigned)wid * 1024u;
    const int aoff = lds_byte(wr * 64 + fr, fq * 8), boff = lds_byte(wc * 32 + fr, fq * 8);
#define PG8_SA(b, h) (((b) * 2 + (h)) * HTB)
#define PG8_SB(b, h) ((4 + (b) * 2 + (h)) * HTB)
#define PG8_STAGE(bufoff, gbase, voff) do { _Pragma("unroll") for (int _i = 0; _i < 2; ++_i) \
        __builtin_amdgcn_global_load_lds((const unsigned*)((const char*)(gbase) + (voff)[_i]), (PG8_LAS unsigned*)(lds + (bufoff) + ldsw + _i * 8192), 16, 0, 0); } while (0)
#define PG8_LDA(dst, b, h) do { _Pragma("unroll") for (int m = 0; m < 4; ++m) _Pragma("unroll") for (int k = 0; k < 2; ++k) dst[m][k] = *(const PG8_LAS bf16x8*)(lds + PG8_SA(b, h) + aoff + m * 2048 + k * 1024); } while (0)
#define PG8_LDB(dst, b, h) do { _Pragma("unroll") for (int n = 0; n < 2; ++n) _Pragma("unroll") for (int k = 0; k < 2; ++k) dst[n][k] = *(const PG8_LAS bf16x8*)(lds + PG8_SB(b, h) + boff + n * 2048 + k * 1024); } while (0)
#define PG8_MMA(ai, bj, At, Bt) do { __builtin_amdgcn_s_setprio(1); _Pragma("unroll") for (int m = 0; m < 4; ++m) _Pragma("unroll") for (int n = 0; n < 2; ++n) _Pragma("unroll") for (int k = 0; k < 2; ++k) { \
        if constexpr (I8) acc[ai][bj][m][n] = __builtin_amdgcn_mfma_i32_16x16x64_i8(__builtin_bit_cast(i32x4, Bt[n][k]), __builtin_bit_cast(i32x4, At[m][k]), acc[ai][bj][m][n], 0, 0, 0); \
        else acc[ai][bj][m][n] = __builtin_amdgcn_mfma_f32_16x16x32_bf16(Bt[n][k], At[m][k], acc[ai][bj][m][n], 0, 0, 0); } __builtin_amdgcn_s_setprio(0); } while (0)
#define PG8_WAIT_V(n) asm volatile("s_waitcnt vmcnt(" #n ")" ::: "memory")
#define PG8_WAIT_L(n) asm volatile("s_waitcnt lgkmcnt(" #n ")" ::: "memory")
#define PG8_BAR __builtin_amdgcn_s_barrier()
#define PG8_SCHED __builtin_amdgcn_sched_barrier(0)
    Unit cur, nxt; int ui = 0;
    if (!S.next(0, cur)) return;
    typename AccT<I8>::type acc[2][2][4][2];
#pragma unroll
    for (int a = 0; a < 2; ++a)
#pragma unroll
        for (int b = 0; b < 2; ++b)
#pragma unroll
            for (int m = 0; m < 4; ++m)
#pragma unroll
                for (int n = 0; n < 2; ++n) acc[a][b][m][n] = (typename AccT<I8>::type){};
    bf16x8 At[4][2], B0[2][2], B1[2][2];
    const char* cA = (const char*)g.A + (size_t)cur.pm * tstep; const char* cB = (const char*)g.Bt + (size_t)cur.pn * tstep;
    S.a_ready(cur);
    if constexpr (SP2) {
        PG8_STAGE(PG8_SB(0, 0), cB, voffB); PG8_STAGE(PG8_SB(0, 1), cB + hstep, voffB); PG8_STAGE(PG8_SA(0, 0), cA, voffA); PG8_STAGE(PG8_SA(0, 1), cA + hstep, voffA);
        if (wr == 1) PG8_BAR;
        PG8_WAIT_V(2); PG8_BAR;
        PG8_STAGE(PG8_SB(1, 0), cB + kstep, voffB); PG8_STAGE(PG8_SA(1, 0), cA + kstep, voffA); PG8_STAGE(PG8_SB(1, 1), cB + hstep + kstep, voffB);
        PG8_WAIT_V(6); PG8_BAR;
    } else {
        PG8_STAGE(PG8_SB(0, 0), cB, voffB); PG8_STAGE(PG8_SA(0, 0), cA, voffA); PG8_STAGE(PG8_SB(0, 1), cB + hstep, voffB); PG8_STAGE(PG8_SA(0, 1), cA + hstep, voffA);
        if (wr == 1) PG8_BAR;
        PG8_WAIT_V(4); PG8_BAR;
        PG8_STAGE(PG8_SB(1, 0), cB + kstep, voffB); PG8_STAGE(PG8_SA(1, 0), cA + kstep, voffA); PG8_STAGE(PG8_SB(1, 1), cB + hstep + kstep, voffB);
        PG8_WAIT_V(6); PG8_BAR;
    }
    for (;;) {
        const bool has_next = S.next(ui + 1, nxt);
        const char* nA = has_next ? (const char*)g.A + (size_t)nxt.pm * tstep : cA; const char* nB = has_next ? (const char*)g.Bt + (size_t)nxt.pn * tstep : cB;
        for (int t = 0; t < nt; t += 2) {
            const bool last = (t == nt - 2);
            const char* a1 = cA + (size_t)(t + 1) * kstep;
            const char* a2 = last ? nA : cA + (size_t)(t + 2) * kstep; const char* b2 = last ? nB : cB + (size_t)(t + 2) * kstep;
            const char* a3 = a2 + kstep; const char* b3 = b2 + kstep;
            if (last && has_next) S.a_ready(nxt);
            if constexpr (SP2) {
            PG8_LDB(B0, 0, 0); PG8_LDB(B1, 0, 1); PG8_SCHED; PG8_LDA(At, 0, 0); PG8_STAGE(PG8_SA(1, 1), a1 + hstep, voffA);
            PG8_WAIT_V(8); PG8_WAIT_L(0); PG8_BAR; PG8_MMA(0, 0, At, B0); PG8_MMA(0, 1, At, B1); PG8_BAR; PG8_SCHED;
            PG8_LDA(At, 0, 1); PG8_STAGE(PG8_SB(0, 0), b2, voffB); PG8_STAGE(PG8_SB(0, 1), b2 + hstep, voffB); PG8_STAGE(PG8_SA(0, 0), a2, voffA);
            PG8_WAIT_V(8); PG8_WAIT_L(0); PG8_BAR; PG8_MMA(1, 0, At, B0); PG8_MMA(1, 1, At, B1); PG8_BAR; PG8_SCHED;
            PG8_LDB(B0, 1, 0); PG8_LDB(B1, 1, 1); PG8_SCHED; PG8_LDA(At, 1, 0); PG8_STAGE(PG8_SA(0, 1), a2 + hstep, voffA);
            PG8_WAIT_V(8); PG8_WAIT_L(0); PG8_BAR; PG8_MMA(0, 0, At, B0); PG8_MMA(0, 1, At, B1); PG8_BAR; PG8_SCHED;
            PG8_LDA(At, 1, 1); PG8_STAGE(PG8_SB(1, 0), b3, voffB); PG8_STAGE(PG8_SB(1, 1), b3 + hstep, voffB); PG8_STAGE(PG8_SA(1, 0), a3, voffA);
            PG8_WAIT_V(8); PG8_WAIT_L(0); PG8_BAR; PG8_MMA(1, 0, At, B0); PG8_MMA(1, 1, At, B1); PG8_BAR; PG8_SCHED;
            } else {
            PG8_LDB(B0, 0, 0); PG8_SCHED; PG8_LDA(At, 0, 0); PG8_STAGE(PG8_SA(1, 1), a1 + hstep, voffA);
            PG8_WAIT_L(8); PG8_BAR; PG8_WAIT_L(0); PG8_MMA(0, 0, At, B0); PG8_BAR; PG8_SCHED;
            PG8_LDB(B1, 0, 1); PG8_STAGE(PG8_SB(0, 0), b2, voffB);
            PG8_BAR; PG8_WAIT_L(0); PG8_MMA(0, 1, At, B1); PG8_BAR;
            PG8_LDA(At, 0, 1); PG8_STAGE(PG8_SA(0, 0), a2, voffA);
            PG8_BAR; PG8_WAIT_L(0); PG8_MMA(1, 0, At, B0); PG8_BAR; PG8_SCHED;
            PG8_STAGE(PG8_SB(0, 1), b2 + hstep, voffB);
            PG8_WAIT_V(6); PG8_BAR; PG8_MMA(1, 1, At, B1); PG8_BAR;
            PG8_LDB(B0, 1, 0); PG8_SCHED; PG8_LDA(At, 1, 0); PG8_STAGE(PG8_SA(0, 1), a2 + hstep, voffA);
            PG8_WAIT_L(8); PG8_BAR; PG8_WAIT_L(0); PG8_MMA(0, 0, At, B0); PG8_BAR; PG8_SCHED;
            PG8_LDB(B1, 1, 1); PG8_STAGE(PG8_SB(1, 0), b3, voffB);
            PG8_BAR; PG8_WAIT_L(0); PG8_MMA(0, 1, At, B1); PG8_BAR;
            PG8_LDA(At, 1, 1); PG8_STAGE(PG8_SA(1, 0), a3, voffA);
            PG8_BAR; PG8_WAIT_L(0); PG8_MMA(1, 0, At, B0); PG8_BAR; PG8_SCHED;
            PG8_STAGE(PG8_SB(1, 1), b3 + hstep, voffB);
            PG8_WAIT_V(6); PG8_BAR; PG8_MMA(1, 1, At, B1); PG8_BAR;
            }
        }
        if constexpr (ALIGN_EPI) { if (wr == 0) PG8_BAR; }
        if constexpr (!Epi::AFTER_DRAIN) { E(acc, cur, wr, wc, fr, fq); S.done(cur); }
        if (!has_next) break;
#pragma unroll
        for (int a = 0; a < 2; ++a)
#pragma unroll
            for (int b = 0; b < 2; ++b)
#pragma unroll
                for (int m = 0; m < 4; ++m)
#pragma unroll
                    for (int n = 0; n < 2; ++n) acc[a][b][m][n] = (typename AccT<I8>::type){};
        cur = nxt; cA = nA; cB = nB; ++ui;
        if constexpr (ALIGN_EPI) { if (wr == 1) PG8_BAR; }
    }
    PG8_WAIT_V(0);
    if constexpr (!ALIGN_EPI) { if (wr == 0) PG8_BAR; }
    PG8_BAR;
    if constexpr (Epi::AFTER_DRAIN) { E.fused(acc, cur, wr, wc, fr, fq, lds, wid, lane); S.done(cur); }
#undef PG8_SA
#undef PG8_SB
#undef PG8_STAGE
#undef PG8_LDA
#undef PG8_LDB
#undef PG8_MMA
#undef PG8_WAIT_V
#undef PG8_WAIT_L
#undef PG8_BAR
#undef PG8_SCHED
}
}
#ifndef PG8_SP2
#define PG8_SP2 true
#endif
#ifndef PG8_ALIGN
#define PG8_ALIGN true
#endif

constexpr int BATCH = 2, SEQ = 16384, DM = 2048, T = BATCH * SEQ;
constexpr int INW = 6176, HP = 6400;
constexpr int C_QA = 0, C_KA = 256, C_VA = 512, C_RA = 1024, C_QD = 1536, C_KD = 3072, C_VD = 4608, C_GF = 6144;
constexpr int NHD = 12;
constexpr float EPS = 1e-6f;
constexpr float LOG2E = 1.4426950408889634f;
constexpr float QSCALE = 0.08838834764831845f * LOG2E;
constexpr int NPHASE = 11;

constexpr size_t MiB = 1u << 20;
constexpr size_t WS_CTL = 0, WS_ROPE = 1 * MiB, WS_RS1 = 3 * MiB, WS_RS2 = 3 * MiB + 512 * 1024, WS_SSP = 4 * MiB, WS_WIN = 8 * MiB, WS_WO = 33 * MiB, WS_WQ = 41 * MiB,
                 WS_SK = 49 * MiB, WS_DEC = 50 * MiB, WS_LP = 51 * MiB, WS_IDX = 56 * MiB, WS_GATE = 72 * MiB, WS_DOWN = 88 * MiB, WS_UP = 152 * MiB, WS_XB = 216 * MiB,
                 WS_H = 344 * MiB, WS_X1B = WS_H, WS_QRY = WS_H + 128 * MiB, WS_OP1 = 744 * MiB, WS_OP2 = 840 * MiB, WS_PART = 472 * MiB  , WS_END = 984 * MiB;
constexpr size_t OUT_ST = 0, OUT_OP0 = 128 * MiB;
constexpr int LDS_BYTES = 147456;

#define LAS __attribute__((address_space(3)))
typedef unsigned short bf16_t;
typedef short bf16x8 __attribute__((ext_vector_type(8)));
typedef short s16x4 __attribute__((ext_vector_type(4)));
typedef float f32x4 __attribute__((ext_vector_type(4)));
typedef float f32x2 __attribute__((ext_vector_type(2)));
typedef float f32x16 __attribute__((ext_vector_type(16)));
typedef unsigned u32x4 __attribute__((ext_vector_type(4)));
typedef unsigned u32x2 __attribute__((ext_vector_type(2)));
#define LDS_WAIT() asm volatile("s_waitcnt lgkmcnt(0)" ::: "memory")
#define SBAR() __builtin_amdgcn_sched_barrier(0)

__device__ __forceinline__ float bf2f(unsigned short b) { return __uint_as_float(((unsigned)b) << 16); }
__device__ __forceinline__ float bflo(unsigned w) { return __uint_as_float(w << 16); }
__device__ __forceinline__ float bfhi(unsigned w) { return __uint_as_float(w & 0xffff0000u); }
__device__ __forceinline__ unsigned f2bf(float f) { unsigned u = __float_as_uint(f); return (u + 0x7fffu + ((u >> 16) & 1u)) >> 16; }
__device__ __forceinline__ unsigned pk2(float lo, float hi) { return pg8::cvt_pk_bf16(lo, hi); }
__device__ __forceinline__ float fexp(float x) { return __builtin_amdgcn_exp2f(x * LOG2E); }
__device__ __forceinline__ float flog(float x) { return __builtin_amdgcn_logf(x) * 0.6931471805599453f; }
__device__ __forceinline__ float wave_sum(float v) {
#pragma unroll
    for (int o = 1; o < 64; o <<= 1) v += __shfl_xor(v, o);
    return v;
}
__device__ __forceinline__ int crow(int r, int hi) { return (r & 3) + 8 * (r >> 2) + 4 * hi; }

struct Frame {
    LAS unsigned char* lds; char* ldsg; unsigned char* wsb;
    int tid, lane, wave, vcu, G;
    const float *x, *norm1_g, *w_in, *up_f, *bias_f, *up_b, *bias_b, *out_g, *qn_g, *kn_g, *w_out, *norm2_g, *w_query, *sub_keys, *peer_down, *peer_up;
    float* out;
    __device__ __forceinline__ f32x2* rope_() const { return (f32x2*)((f32x2*)(wsb + WS_ROPE)); }
    __device__ __forceinline__ float* rs1_() const { return (float*)((float*)(wsb + WS_RS1)); }
    __device__ __forceinline__ float* rs2_() const { return (float*)((float*)(wsb + WS_RS2)); }
    __device__ __forceinline__ float* ssp_() const { return (float*)((float*)(wsb + WS_SSP)); }
    __device__ __forceinline__ float* dec_() const { return (float*)((float*)(wsb + WS_DEC)); }
    __device__ __forceinline__ float* lp_() const { return (float*)((float*)(wsb + WS_LP)); }
    __device__ __forceinline__ float* gate_() const { return (float*)((float*)(wsb + WS_GATE)); }
    __device__ __forceinline__ int* part_() const { return (int*)((int*)(wsb + WS_PART)); }
    __device__ __forceinline__ float* sd_() const { return (float*)((float*)(wsb + WS_CTL + 65536)); }
    __device__ __forceinline__ float* su_() const { return (float*)((float*)(wsb + WS_CTL + 131072)); }
    __device__ __forceinline__ float* sx_() const { return (float*)((float*)(wsb + WS_RS2 + 131072)); }
    __device__ __forceinline__ float* csum_() const { return (float*)((float*)(wsb + WS_RS2 + 262144)); }
    __device__ __forceinline__ unsigned char* down8_() const { return (unsigned char*)(wsb + WS_DOWN); }
    __device__ __forceinline__ unsigned char* up8_() const { return (unsigned char*)(wsb + WS_UP); }
    __device__ __forceinline__ unsigned char* xq8_() const { return (unsigned char*)(wsb + WS_XB); }
    __device__ __forceinline__ unsigned char* fq8_() const { return (unsigned char*)(wsb + WS_XB + 64 * MiB); }
    __device__ __forceinline__ unsigned short* idxT_() const { return (unsigned short*)((unsigned short*)(wsb + WS_XB + 72 * MiB)); }
    __device__ __forceinline__ unsigned* fqT_() const { return (unsigned*)((unsigned*)(wsb + WS_XB + 80 * MiB)); }
    __device__ __forceinline__ int* idx_() const { return (int*)((int*)(wsb + WS_IDX)); }
    __device__ __forceinline__ unsigned short* state_() const { return (unsigned short*)((unsigned short*)((unsigned char*)out + OUT_ST)); }
    __device__ __forceinline__ bf16_t* WinT_() const { return (bf16_t*)((bf16_t*)(wsb + WS_WIN)); }
    __device__ __forceinline__ unsigned char* Win8_() const { return (unsigned char*)(wsb + WS_WIN); }
    __device__ __forceinline__ unsigned char* xq1_() const { return (unsigned char*)(wsb + WS_OP1); }
    __device__ __forceinline__ float* sw_() const { return (float*)((float*)(wsb + WS_CTL + 196608)); }
    __device__ __forceinline__ bf16_t* WoT_() const { return (bf16_t*)((bf16_t*)(wsb + WS_WO)); }
    __device__ __forceinline__ bf16_t* WqT_() const { return (bf16_t*)((bf16_t*)(wsb + WS_WQ)); }
    __device__ __forceinline__ bf16_t* SK_() const { return (bf16_t*)((bf16_t*)(wsb + WS_SK)); }
    __device__ __forceinline__ bf16_t* down16_() const { return (bf16_t*)((bf16_t*)(wsb + WS_DOWN)); }
    __device__ __forceinline__ bf16_t* up16_() const { return (bf16_t*)((bf16_t*)(wsb + WS_UP)); }
    __device__ __forceinline__ bf16_t* xb_() const { return (bf16_t*)((bf16_t*)(wsb + WS_XB)); }
    __device__ __forceinline__ bf16_t* mixed_() const { return (bf16_t*)((bf16_t*)(wsb + WS_XB)); }
    __device__ __forceinline__ bf16_t* h_() const { return (bf16_t*)((bf16_t*)(wsb + WS_H)); }
    __device__ __forceinline__ bf16_t* x1b_() const { return (bf16_t*)((bf16_t*)(wsb + WS_X1B)); }
    __device__ __forceinline__ bf16_t* qry_() const { return (bf16_t*)((bf16_t*)(wsb + WS_QRY)); }
    __device__ __forceinline__ bf16_t* op0_() const { return (bf16_t*)((bf16_t*)((unsigned char*)out + OUT_OP0)); }
    __device__ __forceinline__ bf16_t* op1_() const { return (bf16_t*)((bf16_t*)(wsb + WS_OP1)); }
    __device__ __forceinline__ bf16_t* op2_() const { return (bf16_t*)((bf16_t*)(wsb + WS_OP2)); }
};

__device__ __forceinline__ void p0_transpose_item(const float* W, int K, int N, bf16_t* WT, int k0, int n0, int dst_row0, const float* g, LAS float* scr, int lane) {
#pragma unroll 8
    for (int i = 0; i < 32; ++i) { const int kk = 2 * i + (lane >> 5); float w = W[(size_t)(k0 + kk) * N + n0 + (lane & 31)]; if (g) w *= g[k0 + kk]; scr[kk * 33 + (lane & 31)] = w; }
    LDS_WAIT(); asm volatile("" ::: "memory");
    const int c = lane & 7;
#pragma unroll
    for (int j = 0; j < 4; ++j) { const int n = (lane >> 3) + 8 * j; const LAS float* s = scr + (8 * c) * 33 + n;
        u32x4 o; o.x = pk2(s[0 * 33], s[1 * 33]); o.y = pk2(s[2 * 33], s[3 * 33]); o.z = pk2(s[4 * 33], s[5 * 33]); o.w = pk2(s[6 * 33], s[7 * 33]);
        *(u32x4*)(WT + (size_t)(dst_row0 + n) * K + k0 + 8 * c) = o; }
    LDS_WAIT(); asm volatile("" ::: "memory");
}
template <bool isup> __device__ __forceinline__ void peer_quant_row(const Frame& F, int e) {
    const int lane = F.lane; const f32x4* src = (const f32x4*)((isup ? F.peer_up : F.peer_down) + (size_t)e * DM) + lane;
    f32x4 v[8]; float m = 0.f;
#pragma unroll
    for (int j = 0; j < 8; ++j) { v[j] = src[64 * j]; if (!isup) v[j] = v[j] * ((const f32x4*)F.norm2_g)[lane + 64 * j];
        m = fmaxf(fmaxf(m, fmaxf(fabsf(v[j][0]), fabsf(v[j][1]))), fmaxf(fabsf(v[j][2]), fabsf(v[j][3]))); }
#pragma unroll
    for (int o = 1; o < 64; o <<= 1) m = fmaxf(m, __shfl_xor(m, o));
    const float inv = m > 0.f ? 127.f / m : 0.f; unsigned char* dst = isup ? F.up8_() : F.down8_();
#pragma unroll
    for (int j = 0; j < 8; ++j) { unsigned w = 0u;
#pragma unroll
        for (int i = 0; i < 4; ++i) { const int qv = (int)rintf(v[j][i] * inv); w |= ((unsigned)qv & 0xffu) << (8 * i); }
        const int col = 4 * lane + 256 * j; if (isup) *(unsigned*)(dst + (size_t)(col >> 3) * 131072 + (size_t)e * 8 + (col & 7)) = w;
            else *(unsigned*)(dst + ((size_t)(col >> 7) * 16384 + e) * 128 + (col & 127)) = w; }
    if (lane == 0) (isup ? F.su_() : F.sd_())[e] = m * (1.f / 127.f);
}
__device__ __forceinline__ void phase0(const Frame& F) {
    LAS float* scr = (LAS float*)(F.lds + F.wave * 16384);
    const int gw = F.vcu * 8 + F.wave, NGW = F.G * 8, lane = F.lane;
    { LAS float* cmx = (LAS float*)(F.lds + 12288);
      for (int nb = F.vcu; nb < 193; nb += F.G) { const int n0 = nb * 32, drow = nb < 32 ? nb * 32 : (nb == 32 ? C_GF : nb * 32 - 32), kw = F.wave * 256;
        float m = 0.f;
#pragma unroll 16
        for (int i = 0; i < 128; ++i) { const int k = kw + 2 * i + (lane >> 5); m = fmaxf(m, fabsf(F.w_in[(size_t)k * INW + n0 + (lane & 31)] * F.norm1_g[k])); }
        m = fmaxf(m, __shfl_xor(m, 32)); if (lane < 32) cmx[F.wave * 32 + lane] = m;
        __syncthreads();
        if (F.tid < 32) { float mm = 0.f;
#pragma unroll
            for (int w = 0; w < 8; ++w) mm = fmaxf(mm, cmx[w * 32 + F.tid]);
            cmx[256 + F.tid] = mm > 0.f ? 127.f / mm : 0.f; F.sw_()[drow + F.tid] = mm * (1.f / 127.f); }
        __syncthreads();
        for (int ch = 0; ch < 4; ++ch) { const int k0 = kw + 64 * ch;
#pragma unroll 8
            for (int i = 0; i < 32; ++i) { const int kk = 2 * i + (lane >> 5); scr[kk * 33 + (lane & 31)] = F.w_in[(size_t)(k0 + kk) * INW + n0 + (lane & 31)] * F.norm1_g[k0 + kk] * cmx[256 + (lane & 31)]; }
            LDS_WAIT(); asm volatile("" ::: "memory");
            const int c = lane & 7;
#pragma unroll
            for (int j = 0; j < 4; ++j) { const int n = (lane >> 3) + 8 * j; const LAS float* sp = scr + (8 * c) * 33 + n; u32x2 w = {0u, 0u};
#pragma unroll
                for (int i = 0; i < 4; ++i) { w.x |= ((unsigned)(int)rintf(sp[i * 33]) & 0xffu) << (8 * i); w.y |= ((unsigned)(int)rintf(sp[(4 + i) * 33]) & 0xffu) << (8 * i); }
                *(u32x2*)(F.Win8_() + (size_t)(drow + n) * DM + k0 + 8 * c) = w; }
            LDS_WAIT(); asm volatile("" ::: "memory"); }
        __syncthreads(); } }
    constexpr int I_O = 32 * 64, I_Q = 32 * 64;
    for (int it = gw; it < I_O + I_Q; it += NGW) {
        int r = it;
        if (r < I_O) { const int kb = r / 64, nb = r % 64; p0_transpose_item(F.w_out, DM, DM, F.WoT_(), kb * 64, nb * 32, nb * 32, nullptr, scr, lane); continue; }
        r -= I_O;
        { const int kb = r / 64, nb = r % 64; p0_transpose_item(F.w_query, DM, DM, F.WqT_(), kb * 64, nb * 32, nb * 32, F.norm2_g, scr, lane); }
    }
    const size_t gt = (size_t)gw * 64 + lane, NT = (size_t)NGW * 64;
    { u32x4* z = (u32x4*)(F.Win8_() + (size_t)INW * DM); const u32x4 zero = {0u, 0u, 0u, 0u}; for (size_t i = gt; i < (size_t)(HP - INW) * DM / 16; i += NT) z[i] = zero; if (gt < (size_t)(HP - INW)) F.sw_()[INW + gt] = 0.f; }
    for (int r = gw; r < 16384; r += NGW) peer_quant_row<false>(F, r);
    for (int r = gw; r < 16384; r += NGW) peer_quant_row<true>(F, r);
    for (size_t i = gt; i < (size_t)8 * 2 * 128 * 128 / 8; i += NT) { const f32x4 a = *(const f32x4*)(F.sub_keys + i * 8), b = *(const f32x4*)(F.sub_keys + i * 8 + 4);
        u32x4 o; o.x = pk2(a[0], a[1]); o.y = pk2(a[2], a[3]); o.z = pk2(b[0], b[1]); o.w = pk2(b[2], b[3]); *(u32x4*)(F.SK_() + i * 8) = o; }
    for (int m = gw; m < T; m += NGW) { const f32x4* xr = (const f32x4*)(F.x + (size_t)m * DM) + lane; f32x4 v[8]; float s = 0.f, mx = 0.f;
#pragma unroll
        for (int j = 0; j < 8; ++j) { v[j] = xr[64 * j]; s += (v[j][0] * v[j][0] + v[j][1] * v[j][1]) + (v[j][2] * v[j][2] + v[j][3] * v[j][3]);
            mx = fmaxf(fmaxf(mx, fmaxf(fabsf(v[j][0]), fabsf(v[j][1]))), fmaxf(fabsf(v[j][2]), fabsf(v[j][3]))); }
        s = wave_sum(s);
#pragma unroll
        for (int o = 1; o < 64; o <<= 1) mx = fmaxf(mx, __shfl_xor(mx, o));
        const float inv = mx > 0.f ? 127.f / mx : 0.f; unsigned* o4 = (unsigned*)(F.xq1_() + (size_t)m * DM) + lane;
#pragma unroll
        for (int j = 0; j < 8; ++j) { unsigned w = 0u;
#pragma unroll
            for (int i = 0; i < 4; ++i) w |= ((unsigned)(int)rintf(v[j][i] * inv) & 0xffu) << (8 * i);
            o4[64 * j] = w; }
        if (lane == 0) F.rs1_()[m] = __builtin_amdgcn_rsqf(s * (1.f / DM) + EPS) * (mx * (1.f / 127.f)); }
    { const double invf[16] = {1.0, 0.44036660267178046, 0.19392274474868576, 0.08539710028576561, 0.03760603093086393, 0.016560440080994446, 0.007292664737217109, 0.003211445994752591,
                               0.001414213562373095, 0.000622772421914596, 0.0002742481756762073, 0.00012076973741146504, 5.318295896944988e-05, 2.341999896140934e-05, 1.031338537721246e-05, 4.5416704806078695e-06};
      for (size_t i = gt; i < (size_t)SEQ * 16; i += NT) { const int pos = (int)(i >> 4), j = (int)(i & 15); double f = 1.0;
#pragma unroll
          for (int q = 0; q < 16; ++q) f = (j == q) ? invf[q] : f;
          const double rev = (double)pos * f * 0.15915494309189535; const float fr = (float)(rev - floor(rev));
          F.rope_()[i] = (f32x2){__builtin_amdgcn_cosf(fr), __builtin_amdgcn_sinf(fr)}; } }
}

__device__ __forceinline__ void qknorm_rope(const Frame& F) {
    const int gw = F.vcu * 8 + F.wave, NGW = F.G * 8, lane = F.lane, c = lane & 15;
    for (long it = gw; it < (long)T * 24 / 4; it += NGW) { const long row = it * 4 + (lane >> 4); const int t = (int)(row / 24), slot = (int)(row % 24);
        bf16_t* p = F.h_() + (size_t)t * HP + C_QD + slot * 128 + 8 * c;
        const u32x4 w = *(const u32x4*)p; float y[8] = {bflo(w.x), bfhi(w.x), bflo(w.y), bfhi(w.y), bflo(w.z), bfhi(w.z), bflo(w.w), bfhi(w.w)};
        float ss = 0.f;
#pragma unroll
        for (int e = 0; e < 8; ++e) ss += y[e] * y[e];
        ss += __shfl_xor(ss, 1); ss += __shfl_xor(ss, 2); ss += __shfl_xor(ss, 4); ss += __shfl_xor(ss, 8);
        const float rq = __builtin_amdgcn_rsqf(ss * (1.f / 128.f) + EPS); const float* g = (slot < 12 ? F.qn_g : F.kn_g) + 8 * c;
        const f32x4 g0 = *(const f32x4*)g, g1 = *(const f32x4*)(g + 4);
#pragma unroll
        for (int e = 0; e < 4; ++e) { y[e] *= rq * g0[e]; y[4 + e] *= rq * g1[e]; }
        const int pos = t & (SEQ - 1);
#pragma unroll
        for (int e = 0; e < 8; ++e) { const float partner = __shfl_xor(y[e], 2);
            if (c < 4) { const f32x2 cs = F.rope_()[(size_t)pos * 16 + 8 * (c & 1) + e]; y[e] = (c < 2) ? (y[e] * cs.x - partner * cs.y) : (y[e] * cs.x + partner * cs.y); } }
        if (slot < 12) {
#pragma unroll
            for (int e = 0; e < 8; ++e) y[e] *= QSCALE; }
        u32x4 o; o.x = pk2(y[0], y[1]); o.y = pk2(y[2], y[3]); o.z = pk2(y[4], y[5]); o.w = pk2(y[6], y[7]); *(u32x4*)p = o; }
}

constexpr int GL_GDS = 0, GL_TOT = 8192, GL_QF = 12288, GL_QB = 21504, GL_KF = 30720, GL_KB = 39936, GL_VT = 49152, GL_P = 67584, GL_SF = 76800, GL_SB = 95232, GL_OB = 12288;
constexpr int RS72 = 144;
__device__ __forceinline__ float logsig(float z) { return fminf(z, 0.f) - flog(1.f + fexp(-fabsf(z))); }
__device__ __forceinline__ void gla_gates(const Frame& F, int b, int hh, int n, float (&bf)[8], float (&bb)[8], float& totf, float& totb) {
    const int tid = F.tid, c = tid & 63, ig = F.wave; LAS float* gds = (LAS float*)(F.lds + GL_GDS); LAS float* tot = (LAS float*)(F.lds + GL_TOT);
    const size_t t0 = (size_t)b * SEQ + (size_t)n * 64;
    if (tid < 256) { const int tk = tid >> 2, part = tid & 3; const u32x4 w = *(const u32x4*)(F.h_() + (t0 + tk) * HP + C_GF + part * 8); LAS float* d = gds + tk * 32 + part * 8;
        d[0] = bflo(w.x); d[1] = bfhi(w.x); d[2] = bflo(w.y); d[3] = bfhi(w.y); d[4] = bflo(w.z); d[5] = bfhi(w.z); d[6] = bflo(w.w); d[7] = bfhi(w.w); }
    __syncthreads();
    const int hc = hh * 64 + c; float upf[16], upb[16];
#pragma unroll
    for (int r = 0; r < 16; ++r) { upf[r] = F.up_f[r * 256 + hc]; upb[r] = F.up_b[r * 256 + hc]; }
    const float biasf = F.bias_f[hc], biasb = F.bias_b[hc]; float laf[8], lab[8];
#pragma unroll
    for (int e = 0; e < 8; ++e) { const LAS float* gr = gds + (ig * 8 + e) * 32; float zf = biasf, zb = biasb;
#pragma unroll
        for (int r = 0; r < 16; ++r) { zf += gr[r] * upf[r]; zb += gr[16 + r] * upb[r]; }
        laf[e] = logsig(zf) * 0.0625f; lab[e] = logsig(zb) * 0.0625f; }
    bf[0] = laf[0];
#pragma unroll
    for (int e = 1; e < 8; ++e) bf[e] = bf[e - 1] + laf[e];
    bb[7] = lab[7];
#pragma unroll
    for (int e = 6; e >= 0; --e) bb[e] = bb[e + 1] + lab[e];
    tot[ig * 64 + c] = bf[7]; tot[512 + ig * 64 + c] = bb[0];
    __syncthreads();
    float offf = 0.f, offb = 0.f; totf = 0.f; totb = 0.f;
#pragma unroll
    for (int g = 0; g < 8; ++g) { const float tf = tot[g * 64 + c], tb = tot[512 + g * 64 + c]; totf += tf; totb += tb; offf += (g < ig) ? tf : 0.f; offb += (g > ig) ? tb : 0.f; }
#pragma unroll
    for (int e = 0; e < 8; ++e) { bf[e] += offf; bb[e] += offb; }
}
__device__ __forceinline__ void gla_stage_vT(const Frame& F, const bf16x8 (&vraw)[2]) {
#pragma unroll
    for (int j = 0; j < 2; ++j) { const int q = F.tid + 512 * j, tk = q >> 4, vc = (q & 15) * 8; LAS short* d = (LAS short*)(F.lds + GL_VT) + vc * 72 + tk;
#pragma unroll
        for (int e = 0; e < 8; ++e) d[e * 72] = vraw[j][e]; }
}
__device__ __forceinline__ bf16x8 ldfrag(const LAS unsigned char* base, int row, int s, int hi) { return *(const LAS bf16x8*)(base + row * RS72 + (16 * s + 8 * hi) * 2); }

__device__ __forceinline__ void gla_passA(const Frame& F, int item) {
    const int bh = item >> 8, n = item & 255, b = bh >> 2, hh = bh & 3, tid = F.tid, c = tid & 63, ig = F.wave, lane = F.lane, r32 = lane & 31, hi = lane >> 5;
    const size_t t0 = (size_t)b * SEQ + (size_t)n * 64;
    unsigned short kraw[8]; bf16x8 vraw[2];
#pragma unroll
    for (int e = 0; e < 8; ++e) kraw[e] = F.h_()[(t0 + ig * 8 + e) * HP + C_KA + hh * 64 + c];
#pragma unroll
    for (int j = 0; j < 2; ++j) { const int q = tid + 512 * j; vraw[j] = *(const bf16x8*)(F.h_() + (t0 + (q >> 4)) * HP + C_VA + hh * 128 + (q & 15) * 8); }
    float bf[8], bb[8], totf, totb; gla_gates(F, b, hh, n, bf, bb, totf, totb);
    float kf[8], kb[8];
#pragma unroll
    for (int e = 0; e < 8; ++e) { const float k = bf2f(kraw[e]); kf[e] = k * fexp(totf - bf[e]); kb[e] = k * fexp(totb - bb[e]); }
    { u32x4 o; o.x = pk2(kf[0], kf[1]); o.y = pk2(kf[2], kf[3]); o.z = pk2(kf[4], kf[5]); o.w = pk2(kf[6], kf[7]); *(LAS u32x4*)(F.lds + GL_KF + c * RS72 + ig * 16) = o;
      o.x = pk2(kb[0], kb[1]); o.y = pk2(kb[2], kb[3]); o.z = pk2(kb[4], kb[5]); o.w = pk2(kb[6], kb[7]); *(LAS u32x4*)(F.lds + GL_KB + c * RS72 + ig * 16) = o; }
    gla_stage_vT(F, vraw);
    if (ig == 0) { F.dec_()[((size_t)(0 * 8 + bh) * 256 + n) * 64 + c] = fexp(totf); F.dec_()[((size_t)(1 * 8 + bh) * 256 + n) * 64 + c] = fexp(totb); }
    __syncthreads();
    const int dir = F.wave >> 2, vt = F.wave & 3; const LAS unsigned char* kimg = F.lds + (dir ? GL_KB : GL_KF);
    f32x16 a0 = {}, a1 = {};
#pragma unroll
    for (int s = 0; s < 4; ++s) { const bf16x8 av = ldfrag(F.lds + GL_VT, 32 * vt + r32, s, hi), b0 = ldfrag(kimg, r32, s, hi), b1 = ldfrag(kimg, 32 + r32, s, hi);
        a0 = __builtin_amdgcn_mfma_f32_32x32x16_bf16(av, b0, a0, 0, 0, 0); a1 = __builtin_amdgcn_mfma_f32_32x32x16_bf16(av, b1, a1, 0, 0, 0); }
    unsigned short* st = F.state_() + ((size_t)(dir * 8 + bh) * 256 + n) * 8192;
#pragma unroll
    for (int r = 0; r < 16; ++r) { const int v = 32 * vt + crow(r, hi); st[v * 64 + r32] = (unsigned short)f2bf(a0[r]); st[v * 64 + 32 + r32] = (unsigned short)f2bf(a1[r]); }
    __syncthreads();
}
__device__ __forceinline__ void gla_scan(const Frame& F, int item) {
    const int dir = item >> 7, bh = (item >> 4) & 7, e = (item & 15) * 512 + F.tid, c = e & 63;
    unsigned short* st = F.state_() + (size_t)(dir * 8 + bh) * 256 * 8192 + e; const float* dc = F.dec_() + (size_t)(dir * 8 + bh) * 256 * 64 + c; float S = 0.f;
    float iA[16], dA[16], iB[16], dB[16];
#define SC_N(g, j) (dir ? 255 - ((g) * 16 + (j)) : (g) * 16 + (j))
#define SC_LOAD(I_, D_, g) do { _Pragma("unroll") for (int j = 0; j < 16; ++j) { const int n_ = SC_N(g, j); I_[j] = bf2f(st[(size_t)n_ * 8192]); D_[j] = dc[n_ * 64]; } } while (0)
#define SC_RUN(I_, D_, g) do { _Pragma("unroll") for (int j = 0; j < 16; ++j) { const int n_ = SC_N(g, j); st[(size_t)n_ * 8192] = (unsigned short)f2bf(S); S = D_[j] * S + I_[j]; } } while (0)
    SC_LOAD(iA, dA, 0);
    for (int g = 0; g < 16; g += 2) { SC_LOAD(iB, dB, g + 1); SC_RUN(iA, dA, g); if (g + 2 < 16) SC_LOAD(iA, dA, g + 2); SC_RUN(iB, dB, g + 1); }
#undef SC_N
#undef SC_LOAD
#undef SC_RUN
}
__device__ __forceinline__ void gla_passC(const Frame& F, int item) {
    const int bh = item >> 8, n = item & 255, b = bh >> 2, hh = bh & 3, tid = F.tid, c = tid & 63, ig = F.wave, lane = F.lane, r32 = lane & 31, hi = lane >> 5;
    const size_t t0 = (size_t)b * SEQ + (size_t)n * 64;
    unsigned short qraw[8], kraw[8]; bf16x8 vraw[2]; u32x4 sraw[2][2];
#pragma unroll
    for (int e = 0; e < 8; ++e) { const bf16_t* hr = F.h_() + (t0 + ig * 8 + e) * HP + hh * 64 + c; qraw[e] = hr[C_QA]; kraw[e] = hr[C_KA]; }
#pragma unroll
    for (int j = 0; j < 2; ++j) { const int q = tid + 512 * j; vraw[j] = *(const bf16x8*)(F.h_() + (t0 + (q >> 4)) * HP + C_VA + hh * 128 + (q & 15) * 8);
#pragma unroll
        for (int dir = 0; dir < 2; ++dir) sraw[dir][j] = *(const u32x4*)(F.state_() + ((size_t)(dir * 8 + bh) * 256 + n) * 8192 + (q >> 3) * 64 + (q & 7) * 8); }
    float bf[8], bb[8], totf, totb; gla_gates(F, b, hh, n, bf, bb, totf, totb);
#pragma unroll
    for (int e = 0; e < 8; ++e) { const int i = ig * 8 + e; const float q = bf2f(qraw[e]) * 0.125f, k = bf2f(kraw[e]);
        const float ef = fexp(bf[e]), eb = fexp(bb[e]), nf = fexp(-bf[e]), nb = fexp(-bb[e]);
        *(LAS unsigned short*)(F.lds + GL_QF + i * RS72 + c * 2) = (unsigned short)f2bf(q * ef); *(LAS unsigned short*)(F.lds + GL_QB + i * RS72 + c * 2) = (unsigned short)f2bf(q * eb);
        *(LAS unsigned short*)(F.lds + GL_KF + i * RS72 + c * 2) = (unsigned short)f2bf(k * nf); *(LAS unsigned short*)(F.lds + GL_KB + i * RS72 + c * 2) = (unsigned short)f2bf(k * nb); }
    gla_stage_vT(F, vraw);
#pragma unroll
    for (int dir = 0; dir < 2; ++dir)
#pragma unroll
        for (int j = 0; j < 2; ++j) { const int q = tid + 512 * j; *(LAS u32x4*)(F.lds + (dir ? GL_SB : GL_SF) + (q >> 3) * RS72 + (q & 7) * 16) = sraw[dir][j]; }
    __syncthreads();
    if (F.wave < 4) { const int ti = F.wave >> 1, tj = F.wave & 1; f32x16 sf = {}, sb = {};
#pragma unroll
        for (int s = 0; s < 4; ++s) {
            sf = __builtin_amdgcn_mfma_f32_32x32x16_bf16(ldfrag(F.lds + GL_QF, 32 * ti + r32, s, hi), ldfrag(F.lds + GL_KF, 32 * tj + r32, s, hi), sf, 0, 0, 0);
            sb = __builtin_amdgcn_mfma_f32_32x32x16_bf16(ldfrag(F.lds + GL_QB, 32 * ti + r32, s, hi), ldfrag(F.lds + GL_KB, 32 * tj + r32, s, hi), sb, 0, 0, 0); }
#pragma unroll
        for (int r = 0; r < 16; ++r) { const int i = 32 * ti + crow(r, hi), j = 32 * tj + r32; const float p = (j <= i) ? sf[r] : sb[r];
            *(LAS unsigned short*)(F.lds + GL_P + i * RS72 + j * 2) = (unsigned short)f2bf(p); } }
    __syncthreads();
    const int ti = F.wave & 1, tv = F.wave >> 1; f32x16 o = {};
#pragma unroll
    for (int s = 0; s < 4; ++s) o = __builtin_amdgcn_mfma_f32_32x32x16_bf16(ldfrag(F.lds + GL_P, 32 * ti + r32, s, hi), ldfrag(F.lds + GL_VT, 32 * tv + r32, s, hi), o, 0, 0, 0);
#pragma unroll
    for (int s = 0; s < 4; ++s) o = __builtin_amdgcn_mfma_f32_32x32x16_bf16(ldfrag(F.lds + GL_QF, 32 * ti + r32, s, hi), ldfrag(F.lds + GL_SF, 32 * tv + r32, s, hi), o, 0, 0, 0);
#pragma unroll
    for (int s = 0; s < 4; ++s) o = __builtin_amdgcn_mfma_f32_32x32x16_bf16(ldfrag(F.lds + GL_QB, 32 * ti + r32, s, hi), ldfrag(F.lds + GL_SB, 32 * tv + r32, s, hi), o, 0, 0, 0);
    __syncthreads();
    LAS float* ob = (LAS float*)(F.lds + GL_OB);
#pragma unroll
    for (int r = 0; r < 16; ++r) ob[(32 * ti + crow(r, hi)) * 132 + 32 * tv + r32] = o[r];
    __syncthreads();
    { const int i = tid >> 3, part = tid & 7, v0 = part * 16; float ov[16], ss = 0.f;
#pragma unroll
      for (int e = 0; e < 16; ++e) { ov[e] = ob[i * 132 + v0 + e]; ss += ov[e] * ov[e]; }
      ss += __shfl_xor(ss, 1); ss += __shfl_xor(ss, 2); ss += __shfl_xor(ss, 4);
      const float rs = __builtin_amdgcn_rsqf(ss * (1.f / 128.f) + EPS); const size_t tok = t0 + i;
      const u32x4 r0 = *(const u32x4*)(F.h_() + tok * HP + C_RA + hh * 128 + v0), r1 = *(const u32x4*)(F.h_() + tok * HP + C_RA + hh * 128 + v0 + 8);
      const float rr[16] = {bflo(r0.x), bfhi(r0.x), bflo(r0.y), bfhi(r0.y), bflo(r0.z), bfhi(r0.z), bflo(r0.w), bfhi(r0.w), bflo(r1.x), bfhi(r1.x), bflo(r1.y), bfhi(r1.y), bflo(r1.z), bfhi(r1.z), bflo(r1.w), bfhi(r1.w)};
      float y[16];
#pragma unroll
      for (int e = 0; e < 16; ++e) { const float g = F.out_g[hh * 128 + v0 + e]; const float sil = rr[e] * __builtin_amdgcn_rcpf(1.f + fexp(-rr[e])); y[e] = ov[e] * rs * g * sil; }
      u32x4 w0, w1; w0.x = pk2(y[0], y[1]); w0.y = pk2(y[2], y[3]); w0.z = pk2(y[4], y[5]); w0.w = pk2(y[6], y[7]); w1.x = pk2(y[8], y[9]); w1.y = pk2(y[10], y[11]); w1.z = pk2(y[12], y[13]); w1.w = pk2(y[14], y[15]);
      bf16_t* mp = F.mixed_() + tok * DM + hh * 128 + v0; *(u32x4*)mp = w0; *(u32x4*)(mp + 8) = w1; }
    __syncthreads();
}

constexpr int AT_V = 0, AT_K = 32768, AT_O = 65536;
#define KSWZ(row, colB) ((row) * 256 + ((colB) ^ (((row) & 7) << 4)))
__device__ __forceinline__ int v_st(int k, int c) { const int kk = (k & ~0xC) | ((k & 4) << 1) | ((k & 8) >> 1); return ((kk >> 3) * 4 + (c >> 5)) * 512 + ((kk & 7) * 32 + (c & 31)) * 2; }
__device__ __forceinline__ int v_rd_base(int lane) { return ((lane & 3) << 3) | (((lane >> 2) & 3) << 6) | (((lane >> 4) & 1) << 5) | (((lane >> 5) & 1) << 8); }
constexpr int v_rd_off(int d0, int ks, int half) { return d0 * 512 + ks * 4096 + half * 2048; }
template <int OFF> __device__ __forceinline__ s16x4 tr_read(int vb) { s16x4 r; asm volatile("ds_read_b64_tr_b16 %0, %1 offset:%2" : "=&v"(r) : "v"(vb), "i"(OFF) : "memory"); return r; }
template <int D0> __device__ __forceinline__ void pv_one(f32x16& od, int vb, bf16x8 pa0, bf16x8 pa1, bf16x8 pa2, bf16x8 pa3) {
    const s16x4 l0 = tr_read<v_rd_off(D0, 0, 0)>(vb), h0 = tr_read<v_rd_off(D0, 0, 1)>(vb), l1 = tr_read<v_rd_off(D0, 1, 0)>(vb), h1 = tr_read<v_rd_off(D0, 1, 1)>(vb);
    const s16x4 l2 = tr_read<v_rd_off(D0, 2, 0)>(vb), h2 = tr_read<v_rd_off(D0, 2, 1)>(vb), l3 = tr_read<v_rd_off(D0, 3, 0)>(vb), h3 = tr_read<v_rd_off(D0, 3, 1)>(vb);
    asm volatile("s_waitcnt lgkmcnt(0)" ::: "memory"); SBAR();
#define PKV(L, H) (bf16x8){L[0], L[1], L[2], L[3], H[0], H[1], H[2], H[3]}
    od = __builtin_amdgcn_mfma_f32_32x32x16_bf16(pa0, PKV(l0, h0), od, 0, 0, 0);
    od = __builtin_amdgcn_mfma_f32_32x32x16_bf16(pa1, PKV(l1, h1), od, 0, 0, 0);
    od = __builtin_amdgcn_mfma_f32_32x32x16_bf16(pa2, PKV(l2, h2), od, 0, 0, 0);
    od = __builtin_amdgcn_mfma_f32_32x32x16_bf16(pa3, PKV(l3, h3), od, 0, 0, 0);
#undef PKV
}
struct AtP { size_t tokbase; int dil, m0, Tf, nt, head, p; };
__device__ __forceinline__ AtP at_decode(int item) {
    AtP P; const int p = item / 1536, rem = item % 1536, b = rem / 768, rem2 = rem % 768, u = rem2 & 63; P.p = p; P.head = rem2 >> 6;
    const int dsh = 2 * p, L = SEQ >> dsh, runs = 64 >> dsh, res = u / runs; P.dil = 1 << dsh; P.m0 = (u % runs) * 256; P.tokbase = (size_t)b * SEQ + res;
    const int kt_lo = (P.m0 == 0) ? 1 : 0, kt_hi = (P.m0 + 256 >= L) ? 4 : 5; P.Tf = P.m0 - 64 + 64 * kt_lo; P.nt = kt_hi - kt_lo + 1; return P;
}
__device__ __forceinline__ void attn_phase(const Frame& F) {
    const int tid = F.tid, wid = F.wave, lane = F.lane, r32 = lane & 31, hi = lane >> 5, G = F.G;
    int ntot = 0; for (int it = F.vcu; it < 4608; it += G) ntot += at_decode(it).nt;
    if (ntot == 0) return;
    const int sr = tid >> 4, sc = (tid & 15) * 8, vst0 = v_st(sr, sc), vst1 = v_st(32 + sr, sc), kc = sc * 2;
    const int vb0 = (int)(unsigned)(uintptr_t)(F.ldsg + AT_V) + v_rd_base(lane);
    int it_ld = F.vcu, rl = 0, it_c = F.vcu, rc = 0; AtP ld = at_decode(it_ld), cur = ld;
    bf16x8 qr[8], qn[8]; f32x16 o[4]; float l_reg = 0.f;
    bf16x8 sA0, sA1, sA2, sA3;
#define AT_QLOAD() do { const bf16_t* qp_ = F.h_() + C_QD + ld.head * 128 + (ld.tokbase + (size_t)ld.dil * (ld.m0 + 32 * wid + r32)) * HP + hi * 8; \
        _Pragma("unroll") for (int d0 = 0; d0 < 8; ++d0) qn[d0] = *(const bf16x8*)(qp_ + d0 * 16); } while (0)
#define AT_SLOAD(S) do { const int T0_ = ld.Tf + 64 * rl; const size_t ra = (ld.tokbase + (size_t)ld.dil * (T0_ + sr)) * HP + ld.head * 128 + sc, rb = ra + (size_t)ld.dil * 32 * HP; \
        S##0 = *(const bf16x8*)(F.h_() + C_VD + ra); S##1 = *(const bf16x8*)(F.h_() + C_VD + rb); S##2 = *(const bf16x8*)(F.h_() + C_KD + ra); S##3 = *(const bf16x8*)(F.h_() + C_KD + rb); \
        if (++rl == ld.nt) { it_ld += G; rl = 0; if (it_ld < 4608) { ld = at_decode(it_ld); AT_QLOAD(); } } } while (0)
#define AT_SWRITE(S, B) do { *(LAS bf16x8*)(F.lds + AT_V + (B) * 16384 + vst0) = S##0; *(LAS bf16x8*)(F.lds + AT_V + (B) * 16384 + vst1) = S##1; \
        *(LAS bf16x8*)(F.lds + AT_K + (B) * 16384 + KSWZ(sr, kc)) = S##2; *(LAS bf16x8*)(F.lds + AT_K + (B) * 16384 + KSWZ(32 + sr, kc)) = S##3; } while (0)
#define PK4(P, BASE, OUT) do { unsigned a0_ = pk2(P[BASE + 0], P[BASE + 1]), a1_ = pk2(P[BASE + 2], P[BASE + 3]); unsigned b0_ = pk2(P[BASE + 4], P[BASE + 5]), b1_ = pk2(P[BASE + 6], P[BASE + 7]); \
        auto r0_ = __builtin_amdgcn_permlane32_swap(a0_, b0_, false, false); auto r1_ = __builtin_amdgcn_permlane32_swap(a1_, b1_, false, false); \
        u32x4 w_ = {r0_[0], r1_[0], r0_[1], r1_[1]}; OUT = __builtin_bit_cast(bf16x8, w_); } while (0)
#define AT_STEP(BUF) do { \
        if (rc == 0) { _Pragma("unroll") for (int d0 = 0; d0 < 8; ++d0) qr[d0] = qn[d0]; _Pragma("unroll") for (int d0 = 0; d0 < 4; ++d0) o[d0] = (f32x16){}; l_reg = 0.f; } \
        const int Q0 = cur.m0 + 32 * wid, T0 = cur.Tf + 64 * rc; \
        if (T0 + 63 >= Q0 - 64 && T0 <= Q0 + 95) {                                        \
            const LAS unsigned char* Ks = F.lds + AT_K + (BUF) * 16384; f32x16 p0 = {}, p1 = {}; \
            _Pragma("unroll") for (int d0 = 0; d0 < 8; ++d0) { const int cb = (d0 * 16 + hi * 8) * 2; \
                const bf16x8 k0 = *(const LAS bf16x8*)(Ks + KSWZ(r32, cb)), k1 = *(const LAS bf16x8*)(Ks + KSWZ(32 + r32, cb)); \
                p0 = __builtin_amdgcn_mfma_f32_32x32x16_bf16(k0, qr[d0], p0, 0, 0, 0); p1 = __builtin_amdgcn_mfma_f32_32x32x16_bf16(k1, qr[d0], p1, 0, 0, 0); } \
            const int dq = T0 - (Q0 + r32); float ps = 0.f;                                \
            _Pragma("unroll") for (int r = 0; r < 16; ++r) { const int e0 = dq + crow(r, hi), e1 = e0 + 32; \
                p0[r] = (e0 >= -64 && e0 <= 64) ? __builtin_amdgcn_exp2f(p0[r]) : 0.f; p1[r] = (e1 >= -64 && e1 <= 64) ? __builtin_amdgcn_exp2f(p1[r]) : 0.f; ps += p0[r] + p1[r]; } \
            l_reg += ps; \
            bf16x8 pa0, pa1, pa2, pa3; PK4(p0, 0, pa0); PK4(p0, 8, pa1); PK4(p1, 0, pa2); PK4(p1, 8, pa3); \
            const int vb = vb0 + (BUF) * 16384; \
            pv_one<0>(o[0], vb, pa0, pa1, pa2, pa3); pv_one<1>(o[1], vb, pa0, pa1, pa2, pa3); pv_one<2>(o[2], vb, pa0, pa1, pa2, pa3); pv_one<3>(o[3], vb, pa0, pa1, pa2, pa3); } \
        if (++rc == cur.nt) {                                                             \
            bf16_t* Op = (bf16_t*)(cur.p == 0 ? (unsigned char*)F.out + OUT_OP0 : F.wsb + (cur.p == 1 ? WS_OP1 : WS_OP2)); \
            const float lt = l_reg + __shfl_xor(l_reg, 32); \
            if (hi == 0) F.lp_()[((size_t)cur.p * T + cur.tokbase + (size_t)cur.dil * (Q0 + r32)) * NHD + cur.head] = lt; \
            LAS unsigned char* stg = F.lds + AT_O + wid * 8192; \
            _Pragma("unroll") for (int d0 = 0; d0 < 4; ++d0) _Pragma("unroll") for (int r = 0; r < 16; ++r) *(LAS unsigned short*)(stg + (crow(r, hi) * 128 + d0 * 32 + r32) * 2) = (unsigned short)f2bf(o[d0][r]); \
            LDS_WAIT(); asm volatile("" ::: "memory"); \
            _Pragma("unroll") for (int i_ = 0; i_ < 8; ++i_) { const int row = 4 * i_ + (lane >> 4), ch = lane & 15; const u32x4 w = *(const LAS u32x4*)(stg + row * 256 + ch * 16); \
                *(u32x4*)(Op + (cur.tokbase + (size_t)cur.dil * (Q0 + row)) * (NHD * 128) + cur.head * 128 + ch * 8) = w; } \
            LDS_WAIT(); asm volatile("" ::: "memory"); \
            rc = 0; it_c += G; if (it_c < 4608) cur = at_decode(it_c); } } while (0)
    AT_QLOAD();
    AT_SLOAD(sA); AT_SWRITE(sA, 0); AT_SLOAD(sA); __syncthreads();
    for (int g = 0; g < ntot; ++g) { const int buf = g & 1;
        AT_STEP(buf);
        if (g + 1 < ntot) AT_SWRITE(sA, buf ^ 1);
        if (it_ld < 4608) AT_SLOAD(sA);
        __syncthreads();
    }
#undef AT_QLOAD
#undef AT_SLOAD
#undef AT_SWRITE
#undef PK4
#undef AT_STEP
}
__device__ __forceinline__ void dil_combine(const Frame& F) {
    const int gw = F.vcu * 8 + F.wave, NGW = F.G * 8, lane = F.lane, c = lane & 15;
    for (long it = gw; it < (long)T * NHD / 4; it += NGW) { const long row = it * 4 + (lane >> 4); const size_t tok = (size_t)(row / NHD); const int head = (int)(row % NHD);
        const float l = F.lp_()[tok * NHD + head] + F.lp_()[((size_t)T + tok) * NHD + head] + F.lp_()[((size_t)2 * T + tok) * NHD + head]; const float inv = 1.f / l;
        const size_t off = tok * (NHD * 128) + head * 128 + 8 * c; const u32x4 a = *(const u32x4*)(F.op0_() + off), b = *(const u32x4*)(F.op1_() + off), d = *(const u32x4*)(F.op2_() + off);
        u32x4 o; o.x = pk2((bflo(a.x) + bflo(b.x) + bflo(d.x)) * inv, (bfhi(a.x) + bfhi(b.x) + bfhi(d.x)) * inv); o.y = pk2((bflo(a.y) + bflo(b.y) + bflo(d.y)) * inv, (bfhi(a.y) + bfhi(b.y) + bfhi(d.y)) * inv);
        o.z = pk2((bflo(a.z) + bflo(b.z) + bflo(d.z)) * inv, (bfhi(a.z) + bfhi(b.z) + bfhi(d.z)) * inv); o.w = pk2((bflo(a.w) + bflo(b.w) + bflo(d.w)) * inv, (bfhi(a.w) + bfhi(b.w) + bfhi(d.w)) * inv);
        *(u32x4*)(F.mixed_() + tok * DM + 512 + head * 128 + 8 * c) = o; }
}

__device__ __forceinline__ unsigned fl_flip(float x) { const unsigned u = __float_as_uint(x); return u ^ ((unsigned)((int)u >> 31) | 0x80000000u); }
__device__ __forceinline__ float fl_unflip(unsigned w) { return __uint_as_float((w & 0x80000000u) ? (w ^ 0x80000000u) : ~w); }
#define CE_DESC(a, b) do { const unsigned x_ = max(a, b), y_ = min(a, b); a = x_; b = y_; } while (0)
__device__ __forceinline__ void sort16_desc(unsigned (&a)[16]) {
#pragma unroll
    for (int k = 2; k <= 16; k <<= 1)
#pragma unroll
        for (int j = k >> 1; j > 0; j >>= 1)
#pragma unroll
            for (int i = 0; i < 16; ++i) { const int l = i ^ j; if (l > i) { const unsigned x = max(a[i], a[l]), y = min(a[i], a[l]); if ((i & k) == 0) { a[i] = x; a[l] = y; } else { a[i] = y; a[l] = x; } } }
}
__device__ __forceinline__ void bmerge16_desc(unsigned (&a)[16]) {
#pragma unroll
    for (int j = 8; j > 0; j >>= 1)
#pragma unroll
        for (int i = 0; i < 16; ++i) { const int l = i ^ j; if (l > i) CE_DESC(a[i], a[l]); }
}
__device__ __forceinline__ void top16_merge(unsigned (&a)[16], const unsigned (&b)[16]) {
#pragma unroll
    for (int i = 0; i < 16; ++i) a[i] = max(a[i], b[15 - i]);
    bmerge16_desc(a);
}
__device__ __forceinline__ void top16_partner(unsigned (&a)[16]) {
    unsigned b[16];
#pragma unroll
    for (int i = 0; i < 16; ++i) b[i] = (unsigned)__shfl_xor((int)a[i], 32);
    top16_merge(a, b);
}
__device__ constexpr unsigned char stair(int n) {
    constexpr unsigned char L[64] = {0x00,0x01,0x02,0x03,0x04,0x05,0x06,0x07,0x08,0x09,0x0a,0x0b,0x0c,0x0d,0x0e,0x0f,0x10,0x11,0x12,0x13,0x14,0x15,0x16,0x17,0x20,0x21,0x22,0x23,0x24,0x30,0x31,0x32,
                                     0x33,0x40,0x41,0x42,0x50,0x51,0x60,0x61,0x70,0x71,0x80,0x90,0xa0,0xb0,0xc0,0xd0,0xe0,0xf0,0xff,0xff,0xff,0xff,0xff,0xff,0xff,0xff,0xff,0xff,0xff,0xff,0xff,0xff};
    return L[n];
}
constexpr int TK_KEYS = 32768;
__device__ __forceinline__ void topk_item(const Frame& F, int hh, int tg) {
    const int lane = F.lane, r32 = lane & 31, hi = lane >> 5, tok0 = tg * 32; const size_t tok = (size_t)tok0 + r32;
    LAS int* ktab = (LAS int*)(F.lds + F.wave * 4096) + r32 * 32;
    float ss = 0.f;
    { const f32x4* sp = (const f32x4*)(F.ssp_() + tok * 32 + hi * 16);
#pragma unroll
      for (int j = 0; j < 4; ++j) { const f32x4 v = sp[j]; ss += (v[0] + v[1]) + (v[2] + v[3]); } }
    ss += __shfl_xor(ss, 32);
    const float rs2 = __builtin_amdgcn_rsqf(ss * (1.f / DM) + EPS);
    if (hh == 0 && hi == 0) F.rs2_()[tok] = rs2;
    unsigned top[2][16];
#pragma unroll
    for (int cc = 0; cc < 2; ++cc) {
        f32x16 acc[4] = {};
        const bf16_t* qp = F.qry_() + tok * DM + hh * 256 + cc * 128 + hi * 8; const LAS unsigned char* kl = F.lds + TK_KEYS + cc * 32768;
        bf16x8 qf[8];
#pragma unroll
        for (int s = 0; s < 8; ++s) qf[s] = *(const bf16x8*)(qp + 16 * s);
#pragma unroll
        for (int s = 0; s < 8; ++s) {
#pragma unroll
            for (int kt = 0; kt < 4; ++kt) { const bf16x8 kf = *(const LAS bf16x8*)(kl + KSWZ(kt * 32 + r32, (16 * s + 8 * hi) * 2)); acc[kt] = __builtin_amdgcn_mfma_f32_32x32x16_bf16(kf, qf[s], acc[kt], 0, 0, 0); } }
        unsigned g[4][16];
#pragma unroll
        for (int kt = 0; kt < 4; ++kt) {
#pragma unroll
            for (int r = 0; r < 16; ++r) g[kt][r] = (fl_flip(acc[kt][r]) & ~127u) | (unsigned)(127 - (32 * kt + crow(r, hi)));
            sort16_desc(g[kt]); }
        top16_merge(g[0], g[1]); top16_merge(g[2], g[3]); top16_merge(g[0], g[2]); top16_partner(g[0]);
#pragma unroll
        for (int i = 0; i < 16; ++i) top[cc][i] = g[0][i];
    }
#pragma unroll
    for (int i = 0; i < 16; ++i) ktab[hi * 16 + i] = 127 - (int)((hi ? top[1][i] : top[0][i]) & 127u);
    float s0[16], s1[16];
#pragma unroll
    for (int i = 0; i < 16; ++i) { s0[i] = fl_unflip(top[0][i] & ~127u); s1[i] = fl_unflip(top[1][i] & ~127u); }
    unsigned ca[16], cb[16];
#pragma unroll
    for (int n = 0; n < 32; ++n) { const int A = stair(n), B = stair(25 + n); unsigned va = 0u, vb = 0u;
        if (n < 25) { va = (fl_flip(s0[A >> 4] + s1[A & 15]) & ~255u) | (unsigned)(255 - A); vb = (fl_flip(s0[B >> 4] + s1[B & 15]) & ~255u) | (unsigned)(255 - B); }
        const unsigned v = hi ? vb : va; if (n < 16) ca[n] = v; else cb[n - 16] = v; }
    sort16_desc(ca); sort16_desc(cb); top16_merge(ca, cb); top16_partner(ca);
    float e[16], sum = 0.f; const float mx = fl_unflip(ca[0] & ~255u) * rs2;
#pragma unroll
    for (int i = 0; i < 16; ++i) { e[i] = fexp(fl_unflip(ca[i] & ~255u) * rs2 - mx); sum += e[i]; }
    const float inv = 1.f / sum;
    LDS_WAIT(); asm volatile("" ::: "memory");
    int oi[8]; float og[8];
#pragma unroll
    for (int k = 0; k < 8; ++k) { const unsigned cv = hi ? ca[8 + k] : ca[k]; const int code = 255 - (int)(cv & 255u); og[k] = (hi ? e[8 + k] : e[k]) * inv; oi[k] = ktab[code >> 4] * 128 + ktab[16 + (code & 15)]; }
    { int* ip = F.idx_() + tok * 128 + hh * 16 + hi * 8; float* gp = F.gate_() + tok * 128 + hh * 16 + hi * 8;
      *(int4*)ip = make_int4(oi[0], oi[1], oi[2], oi[3]); *(int4*)(ip + 4) = make_int4(oi[4], oi[5], oi[6], oi[7]);
      { const int g0 = hh * 4 + hi * 2;
        *(u32x2*)(F.idxT_() + ((size_t)g0 * T + tok) * 4) = (u32x2){(unsigned)oi[0] | ((unsigned)oi[1] << 16), (unsigned)oi[2] | ((unsigned)oi[3] << 16)};
        *(u32x2*)(F.idxT_() + ((size_t)(g0 + 1) * T + tok) * 4) = (u32x2){(unsigned)oi[4] | ((unsigned)oi[5] << 16), (unsigned)oi[6] | ((unsigned)oi[7] << 16)}; }
      *(f32x4*)gp = (f32x4){og[0], og[1], og[2], og[3]}; *(f32x4*)(gp + 4) = (f32x4){og[4], og[5], og[6], og[7]}; }
    LDS_WAIT(); asm volatile("" ::: "memory");
}

constexpr int PS_NSL = 16, PS_CW = DM / PS_NSL, PS_SUB = PS_NSL / 8, PS_TG = 32, PS_NTG = T / PS_TG;
__device__ __forceinline__ float gelu_tanh(float x) { const float u = 0.7978845608028654f * (x + 0.044715f * x * x * x); const float t = 1.f - 2.f * __builtin_amdgcn_rcpf(1.f + fexp(2.f * u)); return 0.5f * x * (1.f + t); }
__device__ __forceinline__ int dot16i(u32x4 w, u32x4 x) { int p = __builtin_amdgcn_sdot4((int)w.x, (int)x.x, 0, false); p = __builtin_amdgcn_sdot4((int)w.y, (int)x.y, p, false); p = __builtin_amdgcn_sdot4((int)w.z, (int)x.z, p, false); return __builtin_amdgcn_sdot4((int)w.w, (int)x.w, p, false); }
__device__ __forceinline__ unsigned xcc_id() { return (unsigned)__builtin_amdgcn_s_getreg((3 << 11) | 20) & 7u; }
__device__ __forceinline__ bool peer_claim(unsigned* cnt, unsigned x, unsigned& d, int lane, int& q, int& tg) {
    while (d < 8u) { const unsigned xq = (x + d) & 7u; unsigned u = 0u;
        if (lane == 0) u = __hip_atomic_fetch_add(cnt + 64 * xq, 1u, __ATOMIC_RELAXED, __HIP_MEMORY_SCOPE_AGENT);
        u = (unsigned)__builtin_amdgcn_readfirstlane((int)u);
        if (u < (unsigned)(PS_SUB * PS_NTG)) { q = (int)(u / PS_NTG) * 8 + (int)xq; tg = (int)(u % PS_NTG); return true; }
        ++d; }
    return false;
}
template <int CTRL> __device__ __forceinline__ float dppmov(float x) { return __int_as_float(__builtin_amdgcn_update_dpp(0, __float_as_int(x), CTRL, 0xf, 0xf, true)); }
template <int CTRL> __device__ __forceinline__ int dppmovi(int x) { return __builtin_amdgcn_update_dpp(0, x, CTRL, 0xf, 0xf, true); }
__device__ __forceinline__ int bperm(int srclane, int v) { return __builtin_amdgcn_ds_bpermute(srclane << 2, v); }
__device__ __forceinline__ void peer_quant_x(const Frame& F) {
    const int gw = F.vcu * 8 + F.wave, NGW = F.G * 8, lane = F.lane;
    for (int tok = gw; tok < T; tok += NGW) { const u32x4* xr = (const u32x4*)(F.x1b_() + (size_t)tok * DM) + lane; float v[4][8]; float m = 0.f;
#pragma unroll
        for (int j = 0; j < 4; ++j) { const u32x4 w = xr[64 * j]; v[j][0] = bflo(w.x); v[j][1] = bfhi(w.x); v[j][2] = bflo(w.y); v[j][3] = bfhi(w.y); v[j][4] = bflo(w.z); v[j][5] = bfhi(w.z); v[j][6] = bflo(w.w); v[j][7] = bfhi(w.w);
#pragma unroll
            for (int i = 0; i < 8; ++i) m = fmaxf(m, fabsf(v[j][i])); }
#pragma unroll
        for (int o = 1; o < 64; o <<= 1) m = fmaxf(m, __shfl_xor(m, o));
        const float inv = m > 0.f ? 127.f / m : 0.f;
#pragma unroll
        for (int j = 0; j < 4; ++j) { u32x2 w = {0u, 0u};
#pragma unroll
            for (int i = 0; i < 4; ++i) { w.x |= ((unsigned)(int)rintf(v[j][i] * inv) & 0xffu) << (8 * i); w.y |= ((unsigned)(int)rintf(v[j][4 + i] * inv) & 0xffu) << (8 * i); }
            *(u32x2*)(F.xq8_() + (size_t)tok * DM + 8 * lane + 512 * j) = w; }
        if (lane == 0) F.sx_()[tok] = m * (1.f / 127.f); }
}
__device__ __forceinline__ void peer_down(const Frame& F, int cntw = 1024) {
    const int lane = F.lane, g = lane >> 3, c = lane & 7; const unsigned x = xcc_id(); unsigned d = 0u; int q, tg; unsigned* cnt = (unsigned*)(F.wsb + WS_CTL) + cntw;
    const unsigned char* tab = F.down8_(); const unsigned char* xb = F.xq8_();
    while (peer_claim(cnt, x, d, lane, q, tg)) {
        const unsigned colb = (unsigned)(q * PS_CW + 16 * c), slb = (unsigned)q * (16384u * 128u) + 16u * c; int* part = F.part_() + (size_t)q * T * 128; const size_t tok0 = (size_t)tg * PS_TG;
        u32x4 wA[16], wB[16], xA, xB; int iA0, iA1, iB0, iB1;
#define PD_IDX(i0, i1, tok) do { const int* ip_ = F.idx_() + (tok) * 128 + lane; i0 = ip_[0]; i1 = ip_[64]; } while (0)
#define PD_ROWS(W_, X_, i0, i1, tok) do { _Pragma("unroll") for (int j = 0; j < 16; ++j) { const unsigned e_ = (unsigned)bperm(8 * (j & 7) + g, j < 8 ? i0 : i1); \
            W_[j] = *(const u32x4*)(tab + (e_ * 128u + slb)); } X_ = *(const u32x4*)(xb + (tok) * DM + colb); } while (0)
#define PD_COMP(W_, X_, tok) do { int p[16]; _Pragma("unroll") for (int j = 0; j < 16; ++j) p[j] = dot16i(W_[j], X_); \
            int a1[8], a2[4], a3[2]; \
            _Pragma("unroll") for (int i = 0; i < 8; ++i) { const int keep = (c & 1) ? p[2 * i + 1] : p[2 * i], give = (c & 1) ? p[2 * i] : p[2 * i + 1]; a1[i] = keep + dppmovi<0xB1>(give); } \
            _Pragma("unroll") for (int i = 0; i < 4; ++i) { const int keep = (c & 2) ? a1[2 * i + 1] : a1[2 * i], give = (c & 2) ? a1[2 * i] : a1[2 * i + 1]; a2[i] = keep + dppmovi<0x4E>(give); } \
            _Pragma("unroll") for (int i = 0; i < 2; ++i) { const int keep = (c & 4) ? a2[2 * i + 1] : a2[2 * i], give = (c & 4) ? a2[2 * i] : a2[2 * i + 1]; a3[i] = keep + __shfl_xor(give, 4); } \
            part[(tok) * 128 + 8 * c + g] = a3[0]; part[(tok) * 128 + 64 + 8 * c + g] = a3[1]; } while (0)
        PD_IDX(iA0, iA1, tok0); PD_IDX(iB0, iB1, tok0 + 1);
        PD_ROWS(wA, xA, iA0, iA1, tok0);
        for (int tt = 0; tt < PS_TG; tt += 2) { const size_t tok = tok0 + tt;
            PD_ROWS(wB, xB, iB0, iB1, tok + 1);
            const size_t t2 = tok + (tt + 2 < PS_TG ? 2 : 0), t3 = tok + (tt + 2 < PS_TG ? 3 : 1);
            PD_IDX(iA0, iA1, t2);
            PD_COMP(wA, xA, tok);
            if (tt + 2 < PS_TG) PD_ROWS(wA, xA, iA0, iA1, t2);
            PD_IDX(iB0, iB1, t3);
            PD_COMP(wB, xB, tok + 1);
        }
#undef PD_IDX
#undef PD_ROWS
#undef PD_COMP
    }
}
__device__ __forceinline__ void peer_coef_probe(const Frame& F, bool dry) {
    const int gw = F.vcu * 8 + F.wave, NGW = F.G * 8, lane = F.lane;
    for (int tok = gw; tok < T; tok += NGW) { int a0 = 0, a1 = 0; const int* pp = F.part_() + (size_t)tok * 128 + lane;
#pragma unroll
        for (int q = 0; q < PS_NSL; ++q) { a0 += pp[(size_t)q * T * 128]; a1 += pp[(size_t)q * T * 128 + 64]; }
        const float sc = F.rs2_()[tok] * F.sx_()[tok]; const float* gp = F.gate_() + (size_t)tok * 128 + lane; const int e0 = F.idx_()[(size_t)tok * 128 + lane], e1 = F.idx_()[(size_t)tok * 128 + 64 + lane];
        const float c0 = gp[0] * gelu_tanh((float)a0 * sc * F.sd_()[e0]) * F.su_()[e0], c1 = gp[64] * gelu_tanh((float)a1 * sc * F.sd_()[e1]) * F.su_()[e1];
        float m = fmaxf(fabsf(c0), fabsf(c1));
#pragma unroll
        for (int o = 1; o < 64; o <<= 1) m = fmaxf(m, __shfl_xor(m, o));
        const float inv = m > 0.f ? 127.f / m : 0.f; const int q0 = (int)rintf(c0 * inv), q1 = (int)rintf(c1 * inv);
        unsigned char* fp = dry ? F.wsb + WS_PART + 256 * MiB : (unsigned char*)F.fqT_();
        { const int k0 = lane, k1 = 64 + lane; fp[((size_t)(k0 >> 2) * T + tok) * 4 + (k0 & 3)] = (unsigned char)q0; fp[((size_t)(k1 >> 2) * T + tok) * 4 + (k1 & 3)] = (unsigned char)q1; }
        if (lane == 0 && !dry) F.csum_()[tok] = m * (1.f / 127.f); }
}
#define PU_T4(ACC_, R0, R1, R2, R3, FQ_) do { const unsigned t0_ = __builtin_amdgcn_perm(R1, R0, 0x05010400u), t1_ = __builtin_amdgcn_perm(R1, R0, 0x07030602u), t2_ = __builtin_amdgcn_perm(R3, R2, 0x05010400u), t3_ = __builtin_amdgcn_perm(R3, R2, 0x07030602u); \
            ACC_[0] = __builtin_amdgcn_sdot4((int)__builtin_amdgcn_perm(t2_, t0_, 0x05040100u), FQ_, ACC_[0], false); ACC_[1] = __builtin_amdgcn_sdot4((int)__builtin_amdgcn_perm(t2_, t0_, 0x07060302u), FQ_, ACC_[1], false); \
            ACC_[2] = __builtin_amdgcn_sdot4((int)__builtin_amdgcn_perm(t3_, t1_, 0x05040100u), FQ_, ACC_[2], false); ACC_[3] = __builtin_amdgcn_sdot4((int)__builtin_amdgcn_perm(t3_, t1_, 0x07060302u), FQ_, ACC_[3], false); } while (0)
__device__ __forceinline__ void peer_up(const Frame& F, int   = 0, bool dry = false) {
    const int lane = F.lane;
    for (int cg = F.vcu; cg < 256; cg += F.G) {
        __syncthreads();
        { const u32x4* src = (const u32x4*)(F.up8_() + (size_t)cg * 131072);
#pragma unroll 4
          for (int i = 0; i < 16; ++i) { const int o = F.tid + 512 * i; *(LAS u32x4*)(F.lds + o * 16) = src[o]; } }
        __syncthreads();
        u32x2 iA[16], iB[16]; int fA[16], fB[16];
        const __amdgpu_buffer_rsrc_t rsI = __builtin_amdgcn_make_buffer_rsrc((void*)F.idxT_(), 0, 32 * T * 8, 0x00020000), rsF = __builtin_amdgcn_make_buffer_rsrc((void*)F.fqT_(), 0, 32 * T * 4, 0x00020000);
#define U2_FENCE() do { asm volatile("" ::: "memory"); SBAR(); } while (0)
#define U2_LOAD(I_, F_, tok_, g0_) do { const unsigned vo_ = (unsigned)(tok_) * 8u; _Pragma("unroll") for (int g = 0; g < 16; ++g) { I_[g] = __builtin_amdgcn_raw_buffer_load_b64(rsI, vo_, ((g0_) + g) * (T * 8), 0); \
            F_[g] = (int)__builtin_amdgcn_raw_buffer_load_b32(rsF, vo_ >> 1, ((g0_) + g) * (T * 4), 0); } U2_FENCE(); } while (0)
#define U2_COMP(I_, F_) do { _Pragma("unroll") for (int g = 0; g < 16; ++g) { const u32x2 id = I_[g]; const int fq = F_[g]; \
                const u32x2 r0 = *(const LAS u32x2*)(F.lds + (id.x & 0xffffu) * 8u), r1 = *(const LAS u32x2*)(F.lds + (id.x >> 16) * 8u), r2 = *(const LAS u32x2*)(F.lds + (id.y & 0xffffu) * 8u), r3 = *(const LAS u32x2*)(F.lds + (id.y >> 16) * 8u); \
                int* a_ = acc; PU_T4(a_, r0.x, r1.x, r2.x, r3.x, fq); a_ = acc + 4; PU_T4(a_, r0.y, r1.y, r2.y, r3.y, fq); if ((g & 3) == 3) U2_FENCE(); } } while (0)
        const int nb = (T / 64 - F.wave + 7) / 8;
        const unsigned lane_ = __builtin_amdgcn_mbcnt_hi(~0u, __builtin_amdgcn_mbcnt_lo(~0u, 0u));
        if (nb > 0) U2_LOAD(iA, fA, (unsigned)F.wave * 64u + lane_, 0);
#pragma unroll 1
        for (int i = 0; i < nb; ++i) { const unsigned tok = (unsigned)(F.wave + 8 * i) * 64u + lane_; int acc[8] = {0, 0, 0, 0, 0, 0, 0, 0};
            U2_LOAD(iB, fB, tok, 16);
            U2_COMP(iA, fA);
            if (i + 1 < nb) U2_LOAD(iA, fA, tok + 512u, 0);
            U2_COMP(iB, fB);
            const u32x4 xo = *(const u32x4*)(F.x1b_() + (size_t)(tok * DM + cg * 8)); const float sf = F.csum_()[tok];
            f32x4 v0 = {bflo(xo.x), bfhi(xo.x), bflo(xo.y), bfhi(xo.y)}, v1 = {bflo(xo.z), bfhi(xo.z), bflo(xo.w), bfhi(xo.w)};
            v0[0] += sf * (float)acc[0]; v0[1] += sf * (float)acc[1]; v0[2] += sf * (float)acc[2]; v0[3] += sf * (float)acc[3]; v1[0] += sf * (float)acc[4]; v1[1] += sf * (float)acc[5]; v1[2] += sf * (float)acc[6]; v1[3] += sf * (float)acc[7];
            float* dp = (dry ? (float*)(F.wsb + WS_PART) + (size_t)((tok & 16383u) * DM) : F.out + (size_t)(tok * DM)) + cg * 8; *(f32x4*)dp = v0; *(f32x4*)(dp + 4) = v1; U2_FENCE(); }
#undef U2_FENCE
#undef U2_LOAD
#undef U2_COMP
    }
}
#undef PU_T4

#define XB_TMO      128
#define XB_XCNT(j)  (256  + 64 * (j))
#define XB_XSUB(j)  (1280 + 64 * (j))
#define XB_XGEN(j)  (2304 + 64 * (j))
#define XB_TOP      3328
#define XB_TOPGEN   3392
#define XCD_BAR_WORDS 3456
#define XB_SPIN_CAP (1u << 18)

__device__ __forceinline__ unsigned xb_ld(unsigned* p)              { return __hip_atomic_load(p, __ATOMIC_RELAXED, __HIP_MEMORY_SCOPE_AGENT); }
__device__ __forceinline__ unsigned xb_add(unsigned* p, unsigned v) { return __hip_atomic_fetch_add(p, v, __ATOMIC_RELAXED, __HIP_MEMORY_SCOPE_AGENT); }
__device__ __forceinline__ unsigned xb_xcc_id() { return (unsigned)__builtin_amdgcn_s_getreg((3 << 11) | 20) & 0xFu; }
#define XB_SPIN(cond, bar) do { unsigned _sp = 0; while (cond) { __builtin_amdgcn_s_sleep(1); \
    if ((++_sp & 255u) == 0u) { if (xb_ld(&(bar)[XB_TMO])) break; if (_sp > XB_SPIN_CAP) { atomicAdd(&(bar)[XB_TMO], 1u); break; } } } } while (0)

struct XcdBarrier {
    unsigned* bar; unsigned x;
    volatile LAS unsigned* st;
};

__device__ __forceinline__ XcdBarrier xcd_barrier_post(unsigned* bar, volatile LAS unsigned* st) {
    XcdBarrier b; b.bar = bar; b.x = xb_xcc_id(); b.st = st;
    if (threadIdx.x == 0) (void)xb_add(&bar[XB_XCNT(b.x)], 1u);
    return b;
}
__device__ __forceinline__ void xcd_barrier_complete(unsigned* bar, unsigned x, unsigned& nloc, unsigned& nx) {
    const unsigned G = gridDim.x * gridDim.y * gridDim.z;
    unsigned sum, cnt, mine, sp = 0u;
    for (;;) {
        sum = 0u; cnt = 0u; mine = 0u;
#pragma unroll
        for (unsigned j = 0; j < 16; ++j) { const unsigned c = xb_ld(&bar[XB_XCNT(j)]); sum += c; cnt += (c > 0u) ? 1u : 0u; mine = (j == x) ? c : mine; }
        if (sum == G) break;
        __builtin_amdgcn_s_sleep(1);
        if ((++sp & 255u) == 0u) { if (xb_ld(&bar[XB_TMO])) break; if (sp > XB_SPIN_CAP) { atomicAdd(&bar[XB_TMO], 1u); break; } }
    }
    nloc = mine > 0u ? mine : 1u; nx = cnt > 0u ? cnt : 1u;
}

__device__ __forceinline__ void xcd_barrier(const XcdBarrier& b) {
    asm volatile("s_waitcnt vmcnt(0)" ::: "memory");
    __syncthreads();
    if (threadIdx.x == 0) {
        unsigned* bar = b.bar;
        __builtin_amdgcn_s_waitcnt(0);
        unsigned nloc = b.st[0], nx = b.st[1];
        if (nloc == 0u) { xcd_barrier_complete(bar, b.x, nloc, nx); b.st[0] = nloc; b.st[1] = nx; }
        const unsigned old = xb_add(&bar[XB_XSUB(b.x)], 1u);
        const unsigned gen = old / nloc;
        if (old + 1u == (gen + 1u) * nloc) {
            __builtin_amdgcn_fence(__ATOMIC_RELEASE, "agent");
            asm volatile("s_waitcnt vmcnt(0)" ::: "memory");
            const unsigned og = xb_add(&bar[XB_TOP], 1u);
            const unsigned tg = og / nx;
            if (og + 1u == (tg + 1u) * nx) xb_add(&bar[XB_TOPGEN], 1u);
            else XB_SPIN(xb_ld(&bar[XB_TOPGEN]) == tg, bar);
            __builtin_amdgcn_fence(__ATOMIC_ACQUIRE, "agent");
            xb_add(&bar[XB_XGEN(b.x)], 1u);
            asm volatile("s_waitcnt vmcnt(0)" ::: "memory");
        } else {
            XB_SPIN(xb_ld(&bar[XB_XGEN(b.x)]) == gen, bar);
            __builtin_amdgcn_fence(__ATOMIC_ACQUIRE, "agent");
            asm volatile("s_waitcnt vmcnt(0)" ::: "memory");
        }
    }
    __syncthreads();
}

struct Args { const float* in[16]; float* out; unsigned char* ws; int ph_lo, ph_hi, coop, pad; };
__global__ void __launch_bounds__(512, 2) fwd_kernel(Args args) {
    extern __shared__ __attribute__((aligned(16))) unsigned char lds_raw[];
    Frame F;
    F.lds = (LAS unsigned char*)lds_raw; F.ldsg = (char*)lds_raw;
    F.tid = threadIdx.x; F.lane = F.tid & 63; F.wave = __builtin_amdgcn_readfirstlane(F.tid >> 6);
    F.G = gridDim.x; { const int bx = blockIdx.x; F.vcu = (F.G % 8 == 0) ? (bx % 8) * (F.G / 8) + bx / 8 : bx; }
    F.x = args.in[0]; F.norm1_g = args.in[1]; F.w_in = args.in[2]; F.up_f = args.in[3]; F.bias_f = args.in[4]; F.up_b = args.in[5]; F.bias_b = args.in[6]; F.out_g = args.in[7];
    F.qn_g = args.in[8]; F.kn_g = args.in[9]; F.w_out = args.in[10]; F.norm2_g = args.in[11]; F.w_query = args.in[12]; F.sub_keys = args.in[13]; F.peer_down = args.in[14]; F.peer_up = args.in[15];
    F.out = args.out; unsigned char* ws = args.ws; F.wsb = ws;
    constexpr int MISC_OFF = 131072 + 320;
    for (int u = F.tid; u < 64; u += 512) ((LAS unsigned*)(F.lds + MISC_OFF))[u] = 0u;
    __syncthreads();
    XcdBarrier bar = xcd_barrier_post((unsigned*)(ws + WS_CTL) + 8192, (volatile LAS unsigned*)(F.lds + MISC_OFF) + 8);
    const int lo = args.ph_lo, hi = args.ph_hi;
#ifndef PH_MASK
#define PH_MASK 0x7ff
#endif
#ifndef PROBE_PHASE
#define PROBE_PHASE -1
#endif
#define REP(k) for (int rep_ = 0; rep_ < ((PROBE_PHASE == (k)) ? 2 : 1); ++rep_)
#define IN(k) (((PH_MASK >> (k)) & 1) && lo <= (k) && (k) < hi)
#define SEAM(k) do { if (IN(k) && IN((k) + 1)) { if (args.coop) { if ((k) == 0) cg::this_grid().sync(); else xcd_barrier(bar); } } } while (0)
    if (IN(0)) { REP(0) phase0(F); } SEAM(0);
#define GEMM1_BODY { pg8::Gemm g{(const pg8::bf16_t*)F.xq1_(), (const pg8::bf16_t*)F.Win8_(), T, HP, DM / 2}; pg8::StaticOrder S; S.init(T, HP, F.G, (int)blockIdx.x); \
        pg8::EpiI8Qk E{F.h_(), HP, F.rs1_(), F.sw_(), F.qn_g, F.kn_g, (LAS float*)(F.lds + 131072 + 1024), C_QD / 256, C_KD / 256, C_VD / 256, SEQ - 1, QSCALE}; \
        pg8::gemm_phase<pg8::EpiI8Qk, pg8::StaticOrder, PG8_ALIGN, PG8_SP2, true>(F.lds, g, S, E); }
    if (IN(1)) { GEMM1_BODY; if (PROBE_PHASE == 1) GEMM1_BODY; } SEAM(1);
    if (IN(2)) { REP(2) for (int it = F.vcu; it < 2048; it += F.G) gla_passA(F, it); } SEAM(2);
    if (IN(3)) { for (int it = F.vcu; it < 256; it += F.G) gla_scan(F, it); REP(3) attn_phase(F); } SEAM(3);
    if (IN(4)) REP(4) { for (int it = F.vcu; it < 2048; it += F.G) gla_passC(F, it); dil_combine(F); } SEAM(4);
#define GEMM5_BODY { pg8::Gemm g{F.mixed_(), F.WoT_(), T, DM, DM}; pg8::StaticOrder S; S.init(T, DM, F.G, (int)blockIdx.x); pg8::EpiResid E{F.x, F.out, F.x1b_(), F.ssp_(), DM}; \
        pg8::gemm_phase<pg8::EpiResid, pg8::StaticOrder, PG8_ALIGN, PG8_SP2>(F.lds, g, S, E); }
#define GEMM6_BODY { pg8::Gemm g{F.x1b_(), F.WqT_(), T, DM, DM}; pg8::StaticOrder S; S.init(T, DM, F.G, (int)blockIdx.x); pg8::EpiRowScaleBf16 E{F.qry_(), DM, nullptr}; \
        pg8::gemm_phase<pg8::EpiRowScaleBf16, pg8::StaticOrder, PG8_ALIGN, PG8_SP2>(F.lds, g, S, E); }
    if (IN(5)) { GEMM5_BODY; if (PROBE_PHASE == 5) GEMM5_BODY; } SEAM(5);
    if (IN(6)) { GEMM6_BODY; if (PROBE_PHASE == 6) GEMM6_BODY; } SEAM(6);
    if (IN(7)) REP(7) { const int gw = F.vcu * 8 + F.wave, NGW = F.G * 8; for (int u = F.vcu; u < 256; u += F.G) { const int hh = u & 7, chunk = u >> 3;
            __syncthreads();
            for (int i = F.tid; i < 4096; i += 512) { const int row = i >> 4, ch = i & 15; *(LAS u32x4*)(F.lds + TK_KEYS + KSWZ(row, ch * 16)) = *(const u32x4*)(F.SK_() + ((size_t)hh * 256 + row) * 128 + ch * 8); }
            __syncthreads();
            for (int j = 0; j < 4; ++j) topk_item(F, hh, chunk * 32 + F.wave * 4 + j); }
        if (rep_ == 0) peer_quant_x(F); } SEAM(7);
    if (IN(8)) { if (PROBE_PHASE == 8) peer_down(F, 3072); peer_down(F); } SEAM(8);
    if (IN(9)) { REP(9) peer_coef_probe(F, (PROBE_PHASE == 9) && rep_ == 0); } SEAM(9);
    if (IN(10)) { if (PROBE_PHASE == 10) peer_up(F, 3584, true); peer_up(F); }
#undef IN
#undef SEAM
}

#ifndef MK_N_LAUNCHES
#define MK_N_LAUNCHES 1
#endif
extern "C" void kernel_launch(void* const* d_in, const int* in_sizes, int n_in, void* d_out, int out_size, void* d_ws, size_t ws_size, hipStream_t stream) {
    static int grid = 0;
    if (grid == 0) {
        if (n_in != 16 || in_sizes[0] != T * DM || out_size != T * DM || ws_size < WS_END) { fprintf(stderr, "kernel_launch: unexpected shapes (n_in %d, in0 %d, out %d, ws %zu)\n", n_in, n_in > 0 ? in_sizes[0] : -1, out_size, ws_size); grid = -1; return; }
        int dev = 0, cus = 0, per_cu = 0;
        if (hipGetDevice(&dev) != hipSuccess || hipDeviceGetAttribute(&cus, hipDeviceAttributeMultiprocessorCount, dev) != hipSuccess) { grid = -1; return; }
        if (hipFuncSetAttribute((const void*)fwd_kernel, hipFuncAttributeMaxDynamicSharedMemorySize, LDS_BYTES) != hipSuccess) { fprintf(stderr, "kernel_launch: hipFuncSetAttribute failed\n"); grid = -1; return; }
        if (hipOccupancyMaxActiveBlocksPerMultiprocessor(&per_cu, (const void*)fwd_kernel, 512, LDS_BYTES) != hipSuccess || per_cu < 1) { fprintf(stderr, "kernel_launch: occupancy query says %d\n", per_cu); per_cu = 1; }
        (void)hipGetLastError();
        grid = cus;
    }
    if (grid < 0) return;
    if (hipMemsetAsync(d_ws, 0, 65536, stream) != hipSuccess) { fprintf(stderr, "kernel_launch: hipMemsetAsync failed\n"); return; }
    Args a{};
    for (int i = 0; i < 16; ++i) a.in[i] = (const float*)d_in[i];
    a.out = (float*)d_out; a.ws = (unsigned char*)d_ws;
    if (MK_N_LAUNCHES == 1) {
        a.ph_lo = 0; a.ph_hi = NPHASE; a.coop = 1; void* kargs[] = {&a};
        hipError_t e = hipLaunchCooperativeKernel((const void*)fwd_kernel, dim3(grid), dim3(512), kargs, LDS_BYTES, stream);
        if (e != hipSuccess) fprintf(stderr, "kernel_launch: cooperative launch failed: %s (grid %d)\n", hipGetErrorString(e), grid);
    } else {
        for (int p = 0; p < NPHASE; ++p) { a.ph_lo = p; a.ph_hi = p + 1; a.coop = 0; hipLaunchKernelGGL(fwd_kernel, dim3(grid), dim3(512), LDS_BYTES, stream, a); }
        const hipError_t le = hipPeekAtLastError(); if (le != hipSuccess) fprintf(stderr, "kernel_launch: launch failed: %s\n", hipGetErrorName(le));
    }
}
```

```cpp
#include <hip/hip_runtime.h>
#include <hip/hip_cooperative_groups.h>
#include <cstdio>
#include <cstdint>
namespace cg = cooperative_groups;
namespace pg8 {
#define PG8_LAS __attribute__((address_space(3)))
typedef unsigned short bf16_t;
typedef short bf16x8 __attribute__((ext_vector_type(8)));
typedef float f32x4 __attribute__((ext_vector_type(4)));
typedef unsigned u32x4 __attribute__((ext_vector_type(4)));
constexpr int BM = 256, BK = 64, HALF = 128, HTB = HALF * BK * 2  , STAGE_BYTES = 8 * HTB, NXCD = 8, WGM = 8;

__host__ __device__ __forceinline__ int lds_byte(int r, int c) { const int st = (r >> 4) * 2 + (c >> 5), rr = r & 15, cc = c & 31, ob = rr * 64 + cc * 2; return st * 1024 + (ob ^ (((ob >> 9) & 1) << 5)); }
__host__ __device__ __forceinline__ void stage_rc(int b, int& R, int& C) { const int st = b / 1024, sb = b % 1024, swz = sb ^ (((sb >> 9) & 1) << 5); R = (st >> 1) * 16 + swz / 64; C = (st & 1) * 32 + (swz % 64) / 2; }
__host__ __device__ __forceinline__ int perm32(int rho) { const int n = rho >> 4, i = rho & 15; return 8 * (i >> 2) + 4 * n + (i & 3); }

struct Unit { int pm, pn; };
struct Gemm { const bf16_t* A; const bf16_t* Bt; int M, N, K; };

struct StaticOrder {
    int nM, nN, nwg, G, c;
    __host__ __device__ void init(int M, int N, int G_, int c_) { nM = M / BM; nN = N / BM; nwg = nM * nN; G = G_; c = c_; }
    __host__ __device__ bool next(int i, Unit& u) const {
        const long L = (long)i * G + c; if (L >= nwg) return false;
        int wgid = (int)L; { const int q = nwg / NXCD, r = nwg % NXCD, xcd = wgid % NXCD, off = wgid / NXCD; wgid = (xcd < r ? xcd * (q + 1) : r * (q + 1) + (xcd - r) * q) + off; }
        const int nig = WGM * nN, gid = wgid / nig, fm = gid * WGM, gsz = (nM - fm) < WGM ? (nM - fm) : WGM;
        u.pm = fm + ((wgid % nig) % gsz); u.pn = (wgid % nig) / gsz; return true;
    }
    __device__ __forceinline__ void a_ready(const Unit&) const {}
    __device__ __forceinline__ void done(const Unit&) const {}
};
__device__ __forceinline__ unsigned cvt_pk_bf16(float lo, float hi) { unsigned r; asm volatile("v_cvt_pk_bf16_f32 %0, %1, %2" : "=v"(r) : "v"(lo), "v"(hi)); return r; }
typedef int i32x4 __attribute__((ext_vector_type(4)));
template <bool I8> struct AccT { typedef f32x4 type; };
template <> struct AccT<true> { typedef i32x4 type; };
struct EpiRowScaleBf16 {
    static constexpr bool PERM = true, AFTER_DRAIN = false;
    bf16_t* O; int ldc; const float* rs;
    __device__ __forceinline__ void operator()(const f32x4 (&acc)[2][2][4][2], const Unit& u, int wr, int wc, int fr, int fq) const {
        const int row0 = u.pm * BM + wr * 64 + fr, col0 = u.pn * BM + wc * 32 + 8 * fq;
#pragma unroll
        for (int ai = 0; ai < 2; ++ai)
#pragma unroll
            for (int m = 0; m < 4; ++m) { const int row = row0 + ai * HALF + m * 16; const float s = rs ? rs[row] : 1.f; bf16_t* rowp = O + (size_t)row * ldc + col0;
#pragma unroll
                for (int bj = 0; bj < 2; ++bj) { const f32x4 v0 = acc[ai][bj][m][0] * s, v1 = acc[ai][bj][m][1] * s;
                    u32x4 w; w.x = cvt_pk_bf16(v0[0], v0[1]); w.y = cvt_pk_bf16(v0[2], v0[3]); w.z = cvt_pk_bf16(v1[0], v1[1]); w.w = cvt_pk_bf16(v1[2], v1[3]);
                    *(u32x4*)(rowp + bj * HALF) = w; } }
    }
};
struct EpiI8Qk {
    static constexpr bool PERM = true, AFTER_DRAIN = false;
    bf16_t* O; int ldc; const float* rs; const float* cs; const float* qg; const float* kg; PG8_LAS float* P; int qk_lo, q_hi, qk_hi, seqmask; float qscale;
    __device__ __forceinline__ void operator()(const i32x4 (&acc)[2][2][4][2], const Unit& u, int wr, int wc, int fr, int fq) const {
        const int row0 = u.pm * BM + wr * 64 + fr, col0 = u.pn * BM + wc * 32 + 8 * fq;
        f32x4 cv[2][2];
#pragma unroll
        for (int bj = 0; bj < 2; ++bj) { cv[bj][0] = *(const f32x4*)(cs + col0 + bj * HALF); cv[bj][1] = *(const f32x4*)(cs + col0 + bj * HALF + 4); }
        const bool qk = u.pn >= qk_lo && u.pn < qk_hi;
        float rq[2][4][2];
        if (qk) {
#pragma unroll
            for (int ai = 0; ai < 2; ++ai)
#pragma unroll
                for (int m = 0; m < 4; ++m) { const float s = rs[row0 + ai * HALF + m * 16]; const int rl = ai * HALF + wr * 64 + m * 16 + fr;
#pragma unroll
                    for (int bj = 0; bj < 2; ++bj) { const i32x4 a0 = acc[ai][bj][m][0], a1 = acc[ai][bj][m][1]; const f32x4 c0 = cv[bj][0] * s, c1 = cv[bj][1] * s; float ss = 0.f;
#pragma unroll
                        for (int i = 0; i < 4; ++i) { const float x0 = (float)a0[i] * c0[i], x1 = (float)a1[i] * c1[i]; ss += x0 * x0 + x1 * x1; }
                        ss += __shfl_xor(ss, 16); ss += __shfl_xor(ss, 32);
                        if (fq == 0) P[rl * 8 + bj * 4 + wc] = ss; } }
            asm volatile("s_waitcnt lgkmcnt(0)" ::: "memory"); __builtin_amdgcn_s_barrier(); asm volatile("" ::: "memory");
#pragma unroll
            for (int ai = 0; ai < 2; ++ai)
#pragma unroll
                for (int m = 0; m < 4; ++m) { const int rl = ai * HALF + wr * 64 + m * 16 + fr;
#pragma unroll
                    for (int bj = 0; bj < 2; ++bj) { const f32x4 p = *(const PG8_LAS f32x4*)(P + rl * 8 + bj * 4); rq[ai][m][bj] = __builtin_amdgcn_rsqf(((p[0] + p[1]) + (p[2] + p[3])) * (1.f / 128.f) + 1e-6f); } }
        }
        const bool isq = u.pn < q_hi; const float* gp = (isq ? qg : kg) + wc * 32 + 8 * fq; f32x4 g0 = {1.f, 1.f, 1.f, 1.f}, g1 = g0;
        if (qk) { g0 = *(const f32x4*)gp; g1 = *(const f32x4*)(gp + 4); if (isq) { g0 = g0 * qscale; g1 = g1 * qscale; } }
        constexpr float RV[16] = {1.591549431e-01f, 7.008652159e-02f, 3.086376340e-02f, 1.359137064e-02f, 5.985185713e-03f, 2.635675899e-03f, 1.160663641e-03f, 5.111175045e-04f, 2.250790790e-04f, 9.911730937e-05f, 4.364795279e-05f, 1.922110068e-05f, 8.464330808e-06f, 3.727408602e-06f, 1.641426263e-06f, 7.228293069e-07f};
#pragma unroll
        for (int ai = 0; ai < 2; ++ai)
#pragma unroll
            for (int m = 0; m < 4; ++m) { const int row = row0 + ai * HALF + m * 16; const float s = rs[row]; bf16_t* rowp = O + (size_t)row * ldc + col0;
                float cs8[8], sn8[8];
                if (qk && wc == 0) { const float pos = (float)(row & seqmask);
#pragma unroll
                    for (int e8 = 0; e8 < 8; ++e8) { const float rev = pos * ((fq & 1) ? RV[8 + e8] : RV[e8]); const float fr_ = rev - __builtin_floorf(rev); cs8[e8] = __builtin_amdgcn_cosf(fr_); sn8[e8] = __builtin_amdgcn_sinf(fr_); } }
#pragma unroll
                for (int bj = 0; bj < 2; ++bj) { const i32x4 a0 = acc[ai][bj][m][0], a1 = acc[ai][bj][m][1]; const float sq = qk ? s * rq[ai][m][bj] : s; const f32x4 c0 = cv[bj][0] * sq * g0, c1 = cv[bj][1] * sq * g1;
                    float v[8];
#pragma unroll
                    for (int i = 0; i < 4; ++i) { v[i] = (float)a0[i] * c0[i]; v[4 + i] = (float)a1[i] * c1[i]; }
                    if (qk && wc == 0) {
#pragma unroll
                        for (int e8 = 0; e8 < 8; ++e8) { const float pr = __shfl_xor(v[e8], 32); v[e8] = (fq < 2) ? (v[e8] * cs8[e8] - pr * sn8[e8]) : (v[e8] * cs8[e8] + pr * sn8[e8]); } }
                    u32x4 w; w.x = cvt_pk_bf16(v[0], v[1]); w.y = cvt_pk_bf16(v[2], v[3]); w.z = cvt_pk_bf16(v[4], v[5]); w.w = cvt_pk_bf16(v[6], v[7]);
                    *(u32x4*)(rowp + bj * HALF) = w; } }
    }
};
struct EpiResid {
    static constexpr bool PERM = true, AFTER_DRAIN = false;
    const float* x; float* out; bf16_t* xb; float* ssp; int ldc;
    __device__ __forceinline__ void operator()(const f32x4 (&acc)[2][2][4][2], const Unit& u, int wr, int wc, int fr, int fq) const {
        const int row0 = u.pm * BM + wr * 64 + fr, col0 = u.pn * BM + wc * 32 + 8 * fq;
#pragma unroll
        for (int ai = 0; ai < 2; ++ai)
#pragma unroll
            for (int m = 0; m < 4; ++m) { const int row = row0 + ai * HALF + m * 16; const size_t off = (size_t)row * ldc + col0; float ss = 0.f;
#pragma unroll
                for (int bj = 0; bj < 2; ++bj) { const f32x4 xa = *(const f32x4*)(x + off + bj * HALF), xc = *(const f32x4*)(x + off + bj * HALF + 4);
                    const f32x4 v0 = acc[ai][bj][m][0] + xa, v1 = acc[ai][bj][m][1] + xc;
                    u32x4 w; w.x = cvt_pk_bf16(v0[0], v0[1]); w.y = cvt_pk_bf16(v0[2], v0[3]); w.z = cvt_pk_bf16(v1[0], v1[1]); w.w = cvt_pk_bf16(v1[2], v1[3]);
                    *(u32x4*)(xb + off + bj * HALF) = w;
                    ss += (v0[0] * v0[0] + v0[1] * v0[1]) + (v0[2] * v0[2] + v0[3] * v0[3]) + (v1[0] * v1[0] + v1[1] * v1[1]) + (v1[2] * v1[2] + v1[3] * v1[3]); }
                ss += __shfl_xor(ss, 16); ss += __shfl_xor(ss, 32);
                if (fq == 0) ssp[(size_t)row * 32 + u.pn * 4 + wc] = ss; }
    }
};
template <class Epi, class Sched, bool ALIGN_EPI = false, bool SP2 = false, bool I8 = false>
__device__ __forceinline__ void gemm_phase(PG8_LAS unsigned char* lds, const Gemm g, const Sched& S, const Epi& E) {
    const int tid = threadIdx.x, wid = __builtin_amdgcn_readfirstlane(tid >> 6), lane = tid & 63, wr = wid >> 2, wc = wid & 3, fr = lane & 15, fq = lane >> 4;
    const int K = g.K, nt = K / BK;
    unsigned voffA[2], voffB[2];
#pragma unroll
    for (int i = 0; i < 2; ++i) { int R, C; stage_rc(tid * 16 + i * 8192, R, C); const int Rb = Epi::PERM ? ((R & ~31) + perm32(R & 31)) : R;
        voffA[i] = (unsigned)(R * K + C) * 2u; voffB[i] = (unsigned)(Rb * K + C) * 2u; }
    const size_t kstep = (size_t)(BK * 2);
    const size_t hstep = (size_t)HALF * K * 2;
    const size_t tstep = 2 * hstep;
    const unsigned ldsw = (unsigned)wid * 1024u;
    const int aoff = lds_byte(wr * 64 + fr, fq * 8), boff = lds_byte(wc * 32 + fr, fq * 8);
#define PG8_SA(b, h) (((b) * 2 + (h)) * HTB)
#define PG8_SB(b, h) ((4 + (b) * 2 + (h)) * HTB)
#define PG8_STAGE(bufoff, gbase, voff) do { _Pragma("unroll") for (int _i = 0; _i < 2; ++_i) \
        __builtin_amdgcn_global_load_lds((const unsigned*)((const char*)(gbase) + (voff)[_i]), (PG8_LAS unsigned*)(lds + (bufoff) + ldsw + _i * 8192), 16, 0, 0); } while (0)
#define PG8_LDA(dst, b, h) do { _Pragma("unroll") for (int m = 0; m < 4; ++m) _Pragma("unroll") for (int k = 0; k < 2; ++k) dst[m][k] = *(const PG8_LAS bf16x8*)(lds + PG8_SA(b, h) + aoff + m * 2048 + k * 1024); } while (0)
#define PG8_LDB(dst, b, h) do { _Pragma("unroll") for (int n = 0; n < 2; ++n) _Pragma("unroll") for (int k = 0; k < 2; ++k) dst[n][k] = *(const PG8_LAS bf16x8*)(lds + PG8_SB(b, h) + boff + n * 2048 + k * 1024); } while (0)
#define PG8_MMA(ai, bj, At, Bt) do { __builtin_amdgcn_s_setprio(1); _Pragma("unroll") for (int m = 0; m < 4; ++m) _Pragma("unroll") for (int n = 0; n < 2; ++n) _Pragma("unroll") for (int k = 0; k < 2; ++k) { \
        if constexpr (I8) acc[ai][bj][m][n] = __builtin_amdgcn_mfma_i32_16x16x64_i8(__builtin_bit_cast(i32x4, Bt[n][k]), __builtin_bit_cast(i32x4, At[m][k]), acc[ai][bj][m][n], 0, 0, 0); \
        else acc[ai][bj][m][n] = __builtin_amdgcn_mfma_f32_16x16x32_bf16(Bt[n][k], At[m][k], acc[ai][bj][m][n], 0, 0, 0); } __builtin_amdgcn_s_setprio(0); } while (0)
#define PG8_WAIT_V(n) asm volatile("s_waitcnt vmcnt(" #n ")" ::: "memory")
#define PG8_WAIT_L(n) asm volatile("s_waitcnt lgkmcnt(" #n ")" ::: "memory")
#define PG8_BAR __builtin_amdgcn_s_barrier()
#define PG8_SCHED __builtin_amdgcn_sched_barrier(0)
    Unit cur, nxt; int ui = 0;
    if (!S.next(0, cur)) return;
    typename AccT<I8>::type acc[2][2][4][2];
#pragma unroll
    for (int a = 0; a < 2; ++a)
#pragma unroll
        for (int b = 0; b < 2; ++b)
#pragma unroll
            for (int m = 0; m < 4; ++m)
#pragma unroll
                for (int n = 0; n < 2; ++n) acc[a][b][m][n] = (typename AccT<I8>::type){};
    bf16x8 At[4][2], B0[2][2], B1[2][2];
    const char* cA = (const char*)g.A + (size_t)cur.pm * tstep; const char* cB = (const char*)g.Bt + (size_t)cur.pn * tstep;
    S.a_ready(cur);
    if constexpr (SP2) {
        PG8_STAGE(PG8_SB(0, 0), cB, voffB); PG8_STAGE(PG8_SB(0, 1), cB + hstep, voffB); PG8_STAGE(PG8_SA(0, 0), cA, voffA); PG8_STAGE(PG8_SA(0, 1), cA + hstep, voffA);
        if (wr == 1) PG8_BAR;
        PG8_WAIT_V(2); PG8_BAR;
        PG8_STAGE(PG8_SB(1, 0), cB + kstep, voffB); PG8_STAGE(PG8_SA(1, 0), cA + kstep, voffA); PG8_STAGE(PG8_SB(1, 1), cB + hstep + kstep, voffB);
        PG8_WAIT_V(6); PG8_BAR;
    } else {
        PG8_STAGE(PG8_SB(0, 0), cB, voffB); PG8_STAGE(PG8_SA(0, 0), cA, voffA); PG8_STAGE(PG8_SB(0, 1), cB + hstep, voffB); PG8_STAGE(PG8_SA(0, 1), cA + hstep, voffA);
        if (wr == 1) PG8_BAR;
        PG8_WAIT_V(4); PG8_BAR;
        PG8_STAGE(PG8_SB(1, 0), cB + kstep, voffB); PG8_STAGE(PG8_SA(1, 0), cA + kstep, voffA); PG8_STAGE(PG8_SB(1, 1), cB + hstep + kstep, voffB);
        PG8_WAIT_V(6); PG8_BAR;
    }
    for (;;) {
        const bool has_next = S.next(ui + 1, nxt);
        const char* nA = has_next ? (const char*)g.A + (size_t)nxt.pm * tstep : cA; const char* nB = has_next ? (const char*)g.Bt + (size_t)nxt.pn * tstep : cB;
        for (int t = 0; t < nt; t += 2) {
            const bool last = (t == nt - 2);
            const char* a1 = cA + (size_t)(t + 1) * kstep;
            const char* a2 = last ? nA : cA + (size_t)(t + 2) * kstep; const char* b2 = last ? nB : cB + (size_t)(t + 2) * kstep;
            const char* a3 = a2 + kstep; const char* b3 = b2 + kstep;
            if (last && has_next) S.a_ready(nxt);
            if constexpr (SP2) {
            PG8_LDB(B0, 0, 0); PG8_LDB(B1, 0, 1); PG8_SCHED; PG8_LDA(At, 0, 0); PG8_STAGE(PG8_SA(1, 1), a1 + hstep, voffA);
            PG8_WAIT_V(8); PG8_WAIT_L(0); PG8_BAR; PG8_MMA(0, 0, At, B0); PG8_MMA(0, 1, At, B1); PG8_BAR; PG8_SCHED;
            PG8_LDA(At, 0, 1); PG8_STAGE(PG8_SB(0, 0), b2, voffB); PG8_STAGE(PG8_SB(0, 1), b2 + hstep, voffB); PG8_STAGE(PG8_SA(0, 0), a2, voffA);
            PG8_WAIT_V(8); PG8_WAIT_L(0); PG8_BAR; PG8_MMA(1, 0, At, B0); PG8_MMA(1, 1, At, B1); PG8_BAR; PG8_SCHED;
            PG8_LDB(B0, 1, 0); PG8_LDB(B1, 1, 1); PG8_SCHED; PG8_LDA(At, 1, 0); PG8_STAGE(PG8_SA(0, 1), a2 + hstep, voffA);
            PG8_WAIT_V(8); PG8_WAIT_L(0); PG8_BAR; PG8_MMA(0, 0, At, B0); PG8_MMA(0, 1, At, B1); PG8_BAR; PG8_SCHED;
            PG8_LDA(At, 1, 1); PG8_STAGE(PG8_SB(1, 0), b3, voffB); PG8_STAGE(PG8_SB(1, 1), b3 + hstep, voffB); PG8_STAGE(PG8_SA(1, 0), a3, voffA);
            PG8_WAIT_V(8); PG8_WAIT_L(0); PG8_BAR; PG8_MMA(1, 0, At, B0); PG8_MMA(1, 1, At, B1); PG8_BAR; PG8_SCHED;
            } else {
            PG8_LDB(B0, 0, 0); PG8_SCHED; PG8_LDA(At, 0, 0); PG8_STAGE(PG8_SA(1, 1), a1 + hstep, voffA);
            PG8_WAIT_L(8); PG8_BAR; PG8_WAIT_L(0); PG8_MMA(0, 0, At, B0); PG8_BAR; PG8_SCHED;
            PG8_LDB(B1, 0, 1); PG8_STAGE(PG8_SB(0, 0), b2, voffB);
            PG8_BAR; PG8_WAIT_L(0); PG8_MMA(0, 1, At, B1); PG8_BAR;
            PG8_LDA(At, 0, 1); PG8_STAGE(PG8_SA(0, 0), a2, voffA);
            PG8_BAR; PG8_WAIT_L(0); PG8_MMA(1, 0, At, B0); PG8_BAR; PG8_SCHED;
            PG8_STAGE(PG8_SB(0, 1), b2 + hstep, voffB);
            PG8_WAIT_V(6); PG8_BAR; PG8_MMA(1, 1, At, B1); PG8_BAR;
            PG8_LDB(B0, 1, 0); PG8_SCHED; PG8_LDA(At, 1, 0); PG8_STAGE(PG8_SA(0, 1), a2 + hstep, voffA);
            PG8_WAIT_L(8); PG8_BAR; PG8_WAIT_L(0); PG8_MMA(0, 0, At, B0); PG8_BAR; PG8_SCHED;
            PG8_LDB(B1, 1, 1); PG8_STAGE(PG8_SB(1, 0), b3, voffB);
            PG8_BAR; PG8_WAIT_L(0); PG8_MMA(0, 1, At, B1); PG8_BAR;
            PG8_LDA(At, 1, 1); PG8_STAGE(PG8_SA(1, 0), a3, voffA);
            PG8_BAR; PG8_WAIT_L(0); PG8_MMA(1, 0, At, B0); PG8_BAR; PG8_SCHED;
            PG8_STAGE(PG8_SB(1, 1), b3 + hstep, voffB);
            PG8_WAIT_V(6); PG8_BAR; PG8_MMA(1, 1, At, B1); PG8_BAR;
            }
        }
        if constexpr (ALIGN_EPI) { if (wr == 0) PG8_BAR; }
        if constexpr (!Epi::AFTER_DRAIN) { E(acc, cur, wr, wc, fr, fq); S.done(cur); }
        if (!has_next) break;
#pragma unroll
        for (int a = 0; a < 2; ++a)
#pragma unroll
            for (int b = 0; b < 2; ++b)
#pragma unroll
                for (int m = 0; m < 4; ++m)
#pragma unroll
                    for (int n = 0; n < 2; ++n) acc[a][b][m][n] = (typename AccT<I8>::type){};
        cur = nxt; cA = nA; cB = nB; ++ui;
        if constexpr (ALIGN_EPI) { if (wr == 1) PG8_BAR; }
    }
    PG8_WAIT_V(0);
    if constexpr (!ALIGN_EPI) { if (wr == 0) PG8_BAR; }
    PG8_BAR;
    if constexpr (Epi::AFTER_DRAIN) { E.fused(acc, cur, wr, wc, fr, fq, lds, wid, lane); S.done(cur); }
#undef PG8_SA
#undef PG8_SB
#undef PG8_STAGE
#undef PG8_LDA
#undef PG8_LDB
#undef PG8_MMA
#undef PG8_WAIT_V
#undef PG8_WAIT_L
#undef PG8_BAR
#undef PG8_SCHED
}
}
#ifndef PG8_SP2
#define PG8_SP2 true
#endif
#ifndef PG8_ALIGN
#define PG8_ALIGN true
#endif

constexpr int BATCH = 2, SEQ = 16384, DM = 2048, T = BATCH * SEQ;
constexpr int INW = 6176, HP = 6400;
constexpr int C_QA = 0, C_KA = 256, C_VA = 512, C_RA = 1024, C_QD = 1536, C_KD = 3072, C_VD = 4608, C_GF = 6144;
constexpr int NHD = 12;
constexpr float EPS = 1e-6f;
constexpr float LOG2E = 1.4426950408889634f;
constexpr float QSCALE = 0.08838834764831845f * LOG2E;
constexpr int NPHASE = 11;

constexpr size_t MiB = 1u << 20;
constexpr size_t WS_CTL = 0, WS_ROPE = 1 * MiB, WS_RS1 = 3 * MiB, WS_RS2 = 3 * MiB + 512 * 1024, WS_SSP = 4 * MiB, WS_WIN = 8 * MiB, WS_WO = 33 * MiB, WS_WQ = 41 * MiB,
                 WS_SK = 49 * MiB, WS_DEC = 50 * MiB, WS_LP = 51 * MiB, WS_IDX = 56 * MiB, WS_GATE = 72 * MiB, WS_DOWN = 88 * MiB, WS_UP = 152 * MiB, WS_XB = 216 * MiB,
                 WS_H = 344 * MiB, WS_X1B = WS_H, WS_QRY = WS_H + 128 * MiB, WS_OP1 = 744 * MiB, WS_OP2 = 840 * MiB, WS_PART = 472 * MiB  , WS_END = 984 * MiB;
constexpr size_t OUT_ST = 0, OUT_OP0 = 128 * MiB;
constexpr int LDS_BYTES = 147456;

#define LAS __attribute__((address_space(3)))
typedef unsigned short bf16_t;
typedef short bf16x8 __attribute__((ext_vector_type(8)));
typedef short s16x4 __attribute__((ext_vector_type(4)));
typedef float f32x4 __attribute__((ext_vector_type(4)));
typedef float f32x2 __attribute__((ext_vector_type(2)));
typedef float f32x16 __attribute__((ext_vector_type(16)));
typedef unsigned u32x4 __attribute__((ext_vector_type(4)));
typedef unsigned u32x2 __attribute__((ext_vector_type(2)));
#define LDS_WAIT() asm volatile("s_waitcnt lgkmcnt(0)" ::: "memory")
#define SBAR() __builtin_amdgcn_sched_barrier(0)

__device__ __forceinline__ float bf2f(unsigned short b) { return __uint_as_float(((unsigned)b) << 16); }
__device__ __forceinline__ float bflo(unsigned w) { return __uint_as_float(w << 16); }
__device__ __forceinline__ float bfhi(unsigned w) { return __uint_as_float(w & 0xffff0000u); }
__device__ __forceinline__ unsigned f2bf(float f) { unsigned u = __float_as_uint(f); return (u + 0x7fffu + ((u >> 16) & 1u)) >> 16; }
__device__ __forceinline__ unsigned pk2(float lo, float hi) { return pg8::cvt_pk_bf16(lo, hi); }
__device__ __forceinline__ float fexp(float x) { return __builtin_amdgcn_exp2f(x * LOG2E); }
__device__ __forceinline__ float flog(float x) { return __builtin_amdgcn_logf(x) * 0.6931471805599453f; }
__device__ __forceinline__ float wave_sum(float v) {
#pragma unroll
    for (int o = 1; o < 64; o <<= 1) v += __shfl_xor(v, o);
    return v;
}
__device__ __forceinline__ int crow(int r, int hi) { return (r & 3) + 8 * (r >> 2) + 4 * hi; }

struct Frame {
    LAS unsigned char* lds; char* ldsg; unsigned char* wsb;
    int tid, lane, wave, vcu, G;
    const float *x, *norm1_g, *w_in, *up_f, *bias_f, *up_b, *bias_b, *out_g, *qn_g, *kn_g, *w_out, *norm2_g, *w_query, *sub_keys, *peer_down, *peer_up;
    float* out;
    __device__ __forceinline__ f32x2* rope_() const { return (f32x2*)((f32x2*)(wsb + WS_ROPE)); }
    __device__ __forceinline__ float* rs1_() const { return (float*)((float*)(wsb + WS_RS1)); }
    __device__ __forceinline__ float* rs2_() const { return (float*)((float*)(wsb + WS_RS2)); }
    __device__ __forceinline__ float* ssp_() const { return (float*)((float*)(wsb + WS_SSP)); }
    __device__ __forceinline__ float* dec_() const { return (float*)((float*)(wsb + WS_DEC)); }
    __device__ __forceinline__ float* lp_() const { return (float*)((float*)(wsb + WS_LP)); }
    __device__ __forceinline__ float* gate_() const { return (float*)((float*)(wsb + WS_GATE)); }
    __device__ __forceinline__ short* part_() const { return (short*)(wsb + WS_PART); }
    __device__ __forceinline__ float* sd_() const { return (float*)((float*)(wsb + WS_CTL + 65536)); }
    __device__ __forceinline__ float* su_() const { return (float*)((float*)(wsb + WS_CTL + 131072)); }
    __device__ __forceinline__ float* sx_() const { return (float*)((float*)(wsb + WS_RS2 + 131072)); }
    __device__ __forceinline__ float* csum_() const { return (float*)((float*)(wsb + WS_RS2 + 262144)); }
    __device__ __forceinline__ unsigned char* down8_() const { return (unsigned char*)(wsb + WS_DOWN); }
    __device__ __forceinline__ unsigned char* up8_() const { return (unsigned char*)(wsb + WS_UP); }
    __device__ __forceinline__ unsigned char* xq8_() const { return (unsigned char*)(wsb + WS_XB); }
    __device__ __forceinline__ unsigned char* fq8_() const { return (unsigned char*)(wsb + WS_XB + 64 * MiB); }
    __device__ __forceinline__ unsigned short* idxT_() const { return (unsigned short*)((unsigned short*)(wsb + WS_XB + 72 * MiB)); }
    __device__ __forceinline__ unsigned* fqT_() const { return (unsigned*)((unsigned*)(wsb + WS_XB + 80 * MiB)); }
    __device__ __forceinline__ unsigned short* idx_() const { return (unsigned short*)(wsb + WS_IDX); }
    __device__ __forceinline__ unsigned short* state_() const { return (unsigned short*)((unsigned short*)((unsigned char*)out + OUT_ST)); }
    __device__ __forceinline__ bf16_t* WinT_() const { return (bf16_t*)((bf16_t*)(wsb + WS_WIN)); }
    __device__ __forceinline__ unsigned char* Win8_() const { return (unsigned char*)(wsb + WS_WIN); }
    __device__ __forceinline__ unsigned char* xq1_() const { return (unsigned char*)(wsb + WS_OP1); }
    __device__ __forceinline__ float* sw_() const { return (float*)((float*)(wsb + WS_CTL + 196608)); }
    __device__ __forceinline__ bf16_t* WoT_() const { return (bf16_t*)((bf16_t*)(wsb + WS_WO)); }
    __device__ __forceinline__ bf16_t* WqT_() const { return (bf16_t*)((bf16_t*)(wsb + WS_WQ)); }
    __device__ __forceinline__ bf16_t* SK_() const { return (bf16_t*)((bf16_t*)(wsb + WS_SK)); }
    __device__ __forceinline__ bf16_t* down16_() const { return (bf16_t*)((bf16_t*)(wsb + WS_DOWN)); }
    __device__ __forceinline__ bf16_t* up16_() const { return (bf16_t*)((bf16_t*)(wsb + WS_UP)); }
    __device__ __forceinline__ bf16_t* xb_() const { return (bf16_t*)((bf16_t*)(wsb + WS_XB)); }
    __device__ __forceinline__ bf16_t* mixed_() const { return (bf16_t*)((bf16_t*)(wsb + WS_XB)); }
    __device__ __forceinline__ bf16_t* h_() const { return (bf16_t*)((bf16_t*)(wsb + WS_H)); }
    __device__ __forceinline__ bf16_t* x1b_() const { return (bf16_t*)((bf16_t*)(wsb + WS_X1B)); }
    __device__ __forceinline__ bf16_t* qry_() const { return (bf16_t*)((bf16_t*)(wsb + WS_QRY)); }
    __device__ __forceinline__ bf16_t* op0_() const { return (bf16_t*)((bf16_t*)((unsigned char*)out + OUT_OP0)); }
    __device__ __forceinline__ bf16_t* op1_() const { return (bf16_t*)((bf16_t*)(wsb + WS_OP1)); }
    __device__ __forceinline__ bf16_t* op2_() const { return (bf16_t*)((bf16_t*)(wsb + WS_OP2)); }
};

__device__ __forceinline__ void p0_transpose_item(const float* W, int K, int N, bf16_t* WT, int k0, int n0, int dst_row0, const float* g, LAS float* scr, int lane) {
#pragma unroll 8
    for (int i = 0; i < 32; ++i) { const int kk = 2 * i + (lane >> 5); float w = W[(size_t)(k0 + kk) * N + n0 + (lane & 31)]; if (g) w *= g[k0 + kk]; scr[kk * 33 + (lane & 31)] = w; }
    LDS_WAIT(); asm volatile("" ::: "memory");
    const int c = lane & 7;
#pragma unroll
    for (int j = 0; j < 4; ++j) { const int n = (lane >> 3) + 8 * j; const LAS float* s = scr + (8 * c) * 33 + n;
        u32x4 o; o.x = pk2(s[0 * 33], s[1 * 33]); o.y = pk2(s[2 * 33], s[3 * 33]); o.z = pk2(s[4 * 33], s[5 * 33]); o.w = pk2(s[6 * 33], s[7 * 33]);
        *(u32x4*)(WT + (size_t)(dst_row0 + n) * K + k0 + 8 * c) = o; }
    LDS_WAIT(); asm volatile("" ::: "memory");
}
template <bool isup> __device__ __forceinline__ void peer_quant_row(const Frame& F, int e) {
    const int lane = F.lane; const f32x4* src = (const f32x4*)((isup ? F.peer_up : F.peer_down) + (size_t)e * DM) + lane;
    f32x4 v[8]; float m = 0.f;
#pragma unroll
    for (int j = 0; j < 8; ++j) { v[j] = src[64 * j]; if (!isup) v[j] = v[j] * ((const f32x4*)F.norm2_g)[lane + 64 * j];
        m = fmaxf(fmaxf(m, fmaxf(fabsf(v[j][0]), fabsf(v[j][1]))), fmaxf(fabsf(v[j][2]), fabsf(v[j][3]))); }
#pragma unroll
    for (int o = 1; o < 64; o <<= 1) m = fmaxf(m, __shfl_xor(m, o));
    const float inv = m > 0.f ? 127.f / m : 0.f; unsigned char* dst = isup ? F.up8_() : F.down8_();
#pragma unroll
    for (int j = 0; j < 8; ++j) { unsigned w = 0u;
#pragma unroll
        for (int i = 0; i < 4; ++i) { const int qv = (int)rintf(v[j][i] * inv); w |= ((unsigned)qv & 0xffu) << (8 * i); }
        const int col = 4 * lane + 256 * j; if (isup) *(unsigned*)(dst + (size_t)(col >> 3) * 131072 + (size_t)e * 8 + (col & 7)) = w;
            else *(unsigned*)(dst + ((size_t)(col >> 7) * 16384 + e) * 128 + (col & 127)) = w; }
    if (lane == 0) (isup ? F.su_() : F.sd_())[e] = m * (1.f / 127.f);
}
__device__ __forceinline__ void phase0(const Frame& F) {
    LAS float* scr = (LAS float*)(F.lds + F.wave * 16384);
    const int gw = F.vcu * 8 + F.wave, NGW = F.G * 8, lane = F.lane;
    { LAS float* cmx = (LAS float*)(F.lds + 12288);
      for (int nb = F.vcu; nb < 193; nb += F.G) { const int n0 = nb * 32, drow = nb < 32 ? nb * 32 : (nb == 32 ? C_GF : nb * 32 - 32), kw = F.wave * 256;
        float m = 0.f;
#pragma unroll 16
        for (int i = 0; i < 128; ++i) { const int k = kw + 2 * i + (lane >> 5); m = fmaxf(m, fabsf(F.w_in[(size_t)k * INW + n0 + (lane & 31)] * F.norm1_g[k])); }
        m = fmaxf(m, __shfl_xor(m, 32)); if (lane < 32) cmx[F.wave * 32 + lane] = m;
        __syncthreads();
        if (F.tid < 32) { float mm = 0.f;
#pragma unroll
            for (int w = 0; w < 8; ++w) mm = fmaxf(mm, cmx[w * 32 + F.tid]);
            cmx[256 + F.tid] = mm > 0.f ? 127.f / mm : 0.f; F.sw_()[drow + F.tid] = mm * (1.f / 127.f); }
        __syncthreads();
        for (int ch = 0; ch < 4; ++ch) { const int k0 = kw + 64 * ch;
#pragma unroll 8
            for (int i = 0; i < 32; ++i) { const int kk = 2 * i + (lane >> 5); scr[kk * 33 + (lane & 31)] = F.w_in[(size_t)(k0 + kk) * INW + n0 + (lane & 31)] * F.norm1_g[k0 + kk] * cmx[256 + (lane & 31)]; }
            LDS_WAIT(); asm volatile("" ::: "memory");
            const int c = lane & 7;
#pragma unroll
            for (int j = 0; j < 4; ++j) { const int n = (lane >> 3) + 8 * j; const LAS float* sp = scr + (8 * c) * 33 + n; u32x2 w = {0u, 0u};
#pragma unroll
                for (int i = 0; i < 4; ++i) { w.x |= ((unsigned)(int)rintf(sp[i * 33]) & 0xffu) << (8 * i); w.y |= ((unsigned)(int)rintf(sp[(4 + i) * 33]) & 0xffu) << (8 * i); }
                *(u32x2*)(F.Win8_() + (size_t)(drow + n) * DM + k0 + 8 * c) = w; }
            LDS_WAIT(); asm volatile("" ::: "memory"); }
        __syncthreads(); } }
    constexpr int I_O = 32 * 64, I_Q = 32 * 64;
    for (int it = gw; it < I_O + I_Q; it += NGW) {
        int r = it;
        if (r < I_O) { const int kb = r / 64, nb = r % 64; p0_transpose_item(F.w_out, DM, DM, F.WoT_(), kb * 64, nb * 32, nb * 32, nullptr, scr, lane); continue; }
        r -= I_O;
        { const int kb = r / 64, nb = r % 64; p0_transpose_item(F.w_query, DM, DM, F.WqT_(), kb * 64, nb * 32, nb * 32, F.norm2_g, scr, lane); }
    }
    const size_t gt = (size_t)gw * 64 + lane, NT = (size_t)NGW * 64;
    { u32x4* z = (u32x4*)(F.Win8_() + (size_t)INW * DM); const u32x4 zero = {0u, 0u, 0u, 0u}; for (size_t i = gt; i < (size_t)(HP - INW) * DM / 16; i += NT) z[i] = zero; if (gt < (size_t)(HP - INW)) F.sw_()[INW + gt] = 0.f; }
    for (int r = gw; r < 16384; r += NGW) peer_quant_row<false>(F, r);
    for (int r = gw; r < 16384; r += NGW) peer_quant_row<true>(F, r);
    for (size_t i = gt; i < (size_t)8 * 2 * 128 * 128 / 8; i += NT) { const f32x4 a = *(const f32x4*)(F.sub_keys + i * 8), b = *(const f32x4*)(F.sub_keys + i * 8 + 4);
        u32x4 o; o.x = pk2(a[0], a[1]); o.y = pk2(a[2], a[3]); o.z = pk2(b[0], b[1]); o.w = pk2(b[2], b[3]); *(u32x4*)(F.SK_() + i * 8) = o; }
    for (int m = gw; m < T; m += NGW) { const f32x4* xr = (const f32x4*)(F.x + (size_t)m * DM) + lane; f32x4 v[8]; float s = 0.f, mx = 0.f;
#pragma unroll
        for (int j = 0; j < 8; ++j) { v[j] = xr[64 * j]; s += (v[j][0] * v[j][0] + v[j][1] * v[j][1]) + (v[j][2] * v[j][2] + v[j][3] * v[j][3]);
            mx = fmaxf(fmaxf(mx, fmaxf(fabsf(v[j][0]), fabsf(v[j][1]))), fmaxf(fabsf(v[j][2]), fabsf(v[j][3]))); }
        s = wave_sum(s);
#pragma unroll
        for (int o = 1; o < 64; o <<= 1) mx = fmaxf(mx, __shfl_xor(mx, o));
        const float inv = mx > 0.f ? 127.f / mx : 0.f; unsigned* o4 = (unsigned*)(F.xq1_() + (size_t)m * DM) + lane;
#pragma unroll
        for (int j = 0; j < 8; ++j) { unsigned w = 0u;
#pragma unroll
            for (int i = 0; i < 4; ++i) w |= ((unsigned)(int)rintf(v[j][i] * inv) & 0xffu) << (8 * i);
            o4[64 * j] = w; }
        if (lane == 0) F.rs1_()[m] = __builtin_amdgcn_rsqf(s * (1.f / DM) + EPS) * (mx * (1.f / 127.f)); }
    { const double invf[16] = {1.0, 0.44036660267178046, 0.19392274474868576, 0.08539710028576561, 0.03760603093086393, 0.016560440080994446, 0.007292664737217109, 0.003211445994752591,
                               0.001414213562373095, 0.000622772421914596, 0.0002742481756762073, 0.00012076973741146504, 5.318295896944988e-05, 2.341999896140934e-05, 1.031338537721246e-05, 4.5416704806078695e-06};
      for (size_t i = gt; i < (size_t)SEQ * 16; i += NT) { const int pos = (int)(i >> 4), j = (int)(i & 15); double f = 1.0;
#pragma unroll
          for (int q = 0; q < 16; ++q) f = (j == q) ? invf[q] : f;
          const double rev = (double)pos * f * 0.15915494309189535; const float fr = (float)(rev - floor(rev));
          F.rope_()[i] = (f32x2){__builtin_amdgcn_cosf(fr), __builtin_amdgcn_sinf(fr)}; } }
}

__device__ __forceinline__ void qknorm_rope(const Frame& F) {
    const int gw = F.vcu * 8 + F.wave, NGW = F.G * 8, lane = F.lane, c = lane & 15;
    for (long it = gw; it < (long)T * 24 / 4; it += NGW) { const long row = it * 4 + (lane >> 4); const int t = (int)(row / 24), slot = (int)(row % 24);
        bf16_t* p = F.h_() + (size_t)t * HP + C_QD + slot * 128 + 8 * c;
        const u32x4 w = *(const u32x4*)p; float y[8] = {bflo(w.x), bfhi(w.x), bflo(w.y), bfhi(w.y), bflo(w.z), bfhi(w.z), bflo(w.w), bfhi(w.w)};
        float ss = 0.f;
#pragma unroll
        for (int e = 0; e < 8; ++e) ss += y[e] * y[e];
        ss += __shfl_xor(ss, 1); ss += __shfl_xor(ss, 2); ss += __shfl_xor(ss, 4); ss += __shfl_xor(ss, 8);
        const float rq = __builtin_amdgcn_rsqf(ss * (1.f / 128.f) + EPS); const float* g = (slot < 12 ? F.qn_g : F.kn_g) + 8 * c;
        const f32x4 g0 = *(const f32x4*)g, g1 = *(const f32x4*)(g + 4);
#pragma unroll
        for (int e = 0; e < 4; ++e) { y[e] *= rq * g0[e]; y[4 + e] *= rq * g1[e]; }
        const int pos = t & (SEQ - 1);
#pragma unroll
        for (int e = 0; e < 8; ++e) { const float partner = __shfl_xor(y[e], 2);
            if (c < 4) { const f32x2 cs = F.rope_()[(size_t)pos * 16 + 8 * (c & 1) + e]; y[e] = (c < 2) ? (y[e] * cs.x - partner * cs.y) : (y[e] * cs.x + partner * cs.y); } }
        if (slot < 12) {
#pragma unroll
            for (int e = 0; e < 8; ++e) y[e] *= QSCALE; }
        u32x4 o; o.x = pk2(y[0], y[1]); o.y = pk2(y[2], y[3]); o.z = pk2(y[4], y[5]); o.w = pk2(y[6], y[7]); *(u32x4*)p = o; }
}

constexpr int GL_GDS = 0, GL_TOT = 8192, GL_QF = 12288, GL_QB = 21504, GL_KF = 30720, GL_KB = 39936, GL_VT = 49152, GL_P = 67584, GL_SF = 76800, GL_SB = 95232, GL_OB = 12288;
constexpr int RS72 = 144;
__device__ __forceinline__ float logsig(float z) { return fminf(z, 0.f) - flog(1.f + fexp(-fabsf(z))); }
__device__ __forceinline__ void gla_gates(const Frame& F, int b, int hh, int n, float (&bf)[8], float (&bb)[8], float& totf, float& totb) {
    const int tid = F.tid, c = tid & 63, ig = F.wave; LAS float* gds = (LAS float*)(F.lds + GL_GDS); LAS float* tot = (LAS float*)(F.lds + GL_TOT);
    const size_t t0 = (size_t)b * SEQ + (size_t)n * 64;
    if (tid < 256) { const int tk = tid >> 2, part = tid & 3; const u32x4 w = *(const u32x4*)(F.h_() + (t0 + tk) * HP + C_GF + part * 8); LAS float* d = gds + tk * 32 + part * 8;
        d[0] = bflo(w.x); d[1] = bfhi(w.x); d[2] = bflo(w.y); d[3] = bfhi(w.y); d[4] = bflo(w.z); d[5] = bfhi(w.z); d[6] = bflo(w.w); d[7] = bfhi(w.w); }
    __syncthreads();
    const int hc = hh * 64 + c; float upf[16], upb[16];
#pragma unroll
    for (int r = 0; r < 16; ++r) { upf[r] = F.up_f[r * 256 + hc]; upb[r] = F.up_b[r * 256 + hc]; }
    const float biasf = F.bias_f[hc], biasb = F.bias_b[hc]; float laf[8], lab[8];
#pragma unroll
    for (int e = 0; e < 8; ++e) { const LAS float* gr = gds + (ig * 8 + e) * 32; float zf = biasf, zb = biasb;
#pragma unroll
        for (int r = 0; r < 16; ++r) { zf += gr[r] * upf[r]; zb += gr[16 + r] * upb[r]; }
        laf[e] = logsig(zf) * 0.0625f; lab[e] = logsig(zb) * 0.0625f; }
    bf[0] = laf[0];
#pragma unroll
    for (int e = 1; e < 8; ++e) bf[e] = bf[e - 1] + laf[e];
    bb[7] = lab[7];
#pragma unroll
    for (int e = 6; e >= 0; --e) bb[e] = bb[e + 1] + lab[e];
    tot[ig * 64 + c] = bf[7]; tot[512 + ig * 64 + c] = bb[0];
    __syncthreads();
    float offf = 0.f, offb = 0.f; totf = 0.f; totb = 0.f;
#pragma unroll
    for (int g = 0; g < 8; ++g) { const float tf = tot[g * 64 + c], tb = tot[512 + g * 64 + c]; totf += tf; totb += tb; offf += (g < ig) ? tf : 0.f; offb += (g > ig) ? tb : 0.f; }
#pragma unroll
    for (int e = 0; e < 8; ++e) { bf[e] += offf; bb[e] += offb; }
}
__device__ __forceinline__ void gla_stage_vT(const Frame& F, const bf16x8 (&vraw)[2]) {
#pragma unroll
    for (int j = 0; j < 2; ++j) { const int q = F.tid + 512 * j, tk = q >> 4, vc = (q & 15) * 8; LAS short* d = (LAS short*)(F.lds + GL_VT) + vc * 72 + tk;
#pragma unroll
        for (int e = 0; e < 8; ++e) d[e * 72] = vraw[j][e]; }
}
__device__ __forceinline__ bf16x8 ldfrag(const LAS unsigned char* base, int row, int s, int hi) { return *(const LAS bf16x8*)(base + row * RS72 + (16 * s + 8 * hi) * 2); }

__device__ __forceinline__ void gla_passA(const Frame& F, int item) {
    const int bh = item >> 8, n = item & 255, b = bh >> 2, hh = bh & 3, tid = F.tid, c = tid & 63, ig = F.wave, lane = F.lane, r32 = lane & 31, hi = lane >> 5;
    const size_t t0 = (size_t)b * SEQ + (size_t)n * 64;
    unsigned short kraw[8]; bf16x8 vraw[2];
#pragma unroll
    for (int e = 0; e < 8; ++e) kraw[e] = F.h_()[(t0 + ig * 8 + e) * HP + C_KA + hh * 64 + c];
#pragma unroll
    for (int j = 0; j < 2; ++j) { const int q = tid + 512 * j; vraw[j] = *(const bf16x8*)(F.h_() + (t0 + (q >> 4)) * HP + C_VA + hh * 128 + (q & 15) * 8); }
    float bf[8], bb[8], totf, totb; gla_gates(F, b, hh, n, bf, bb, totf, totb);
    float kf[8], kb[8];
#pragma unroll
    for (int e = 0; e < 8; ++e) { const float k = bf2f(kraw[e]); kf[e] = k * fexp(totf - bf[e]); kb[e] = k * fexp(totb - bb[e]); }
    { u32x4 o; o.x = pk2(kf[0], kf[1]); o.y = pk2(kf[2], kf[3]); o.z = pk2(kf[4], kf[5]); o.w = pk2(kf[6], kf[7]); *(LAS u32x4*)(F.lds + GL_KF + c * RS72 + ig * 16) = o;
      o.x = pk2(kb[0], kb[1]); o.y = pk2(kb[2], kb[3]); o.z = pk2(kb[4], kb[5]); o.w = pk2(kb[6], kb[7]); *(LAS u32x4*)(F.lds + GL_KB + c * RS72 + ig * 16) = o; }
    gla_stage_vT(F, vraw);
    if (ig == 0) { F.dec_()[((size_t)(0 * 8 + bh) * 256 + n) * 64 + c] = fexp(totf); F.dec_()[((size_t)(1 * 8 + bh) * 256 + n) * 64 + c] = fexp(totb); }
    __syncthreads();
    const int dir = F.wave >> 2, vt = F.wave & 3; const LAS unsigned char* kimg = F.lds + (dir ? GL_KB : GL_KF);
    f32x16 a0 = {}, a1 = {};
#pragma unroll
    for (int s = 0; s < 4; ++s) { const bf16x8 av = ldfrag(F.lds + GL_VT, 32 * vt + r32, s, hi), b0 = ldfrag(kimg, r32, s, hi), b1 = ldfrag(kimg, 32 + r32, s, hi);
        a0 = __builtin_amdgcn_mfma_f32_32x32x16_bf16(av, b0, a0, 0, 0, 0); a1 = __builtin_amdgcn_mfma_f32_32x32x16_bf16(av, b1, a1, 0, 0, 0); }
    unsigned short* st = F.state_() + ((size_t)(dir * 8 + bh) * 256 + n) * 8192;
#pragma unroll
    for (int r = 0; r < 16; ++r) { const int v = 32 * vt + crow(r, hi); st[v * 64 + r32] = (unsigned short)f2bf(a0[r]); st[v * 64 + 32 + r32] = (unsigned short)f2bf(a1[r]); }
    __syncthreads();
}
__device__ __forceinline__ void gla_scan(const Frame& F, int item) {
    const int dir = item >> 7, bh = (item >> 4) & 7, e = (item & 15) * 512 + F.tid, c = e & 63;
    unsigned short* st = F.state_() + (size_t)(dir * 8 + bh) * 256 * 8192 + e; const float* dc = F.dec_() + (size_t)(dir * 8 + bh) * 256 * 64 + c; float S = 0.f;
    float iA[16], dA[16], iB[16], dB[16];
#define SC_N(g, j) (dir ? 255 - ((g) * 16 + (j)) : (g) * 16 + (j))
#define SC_LOAD(I_, D_, g) do { _Pragma("unroll") for (int j = 0; j < 16; ++j) { const int n_ = SC_N(g, j); I_[j] = bf2f(st[(size_t)n_ * 8192]); D_[j] = dc[n_ * 64]; } } while (0)
#define SC_RUN(I_, D_, g) do { _Pragma("unroll") for (int j = 0; j < 16; ++j) { const int n_ = SC_N(g, j); st[(size_t)n_ * 8192] = (unsigned short)f2bf(S); S = D_[j] * S + I_[j]; } } while (0)
    SC_LOAD(iA, dA, 0);
    for (int g = 0; g < 16; g += 2) { SC_LOAD(iB, dB, g + 1); SC_RUN(iA, dA, g); if (g + 2 < 16) SC_LOAD(iA, dA, g + 2); SC_RUN(iB, dB, g + 1); }
#undef SC_N
#undef SC_LOAD
#undef SC_RUN
}
__device__ __forceinline__ void gla_passC(const Frame& F, int item) {
    const int bh = item >> 8, n = item & 255, b = bh >> 2, hh = bh & 3, tid = F.tid, c = tid & 63, ig = F.wave, lane = F.lane, r32 = lane & 31, hi = lane >> 5;
    const size_t t0 = (size_t)b * SEQ + (size_t)n * 64;
    unsigned short qraw[8], kraw[8]; bf16x8 vraw[2]; u32x4 sraw[2][2];
#pragma unroll
    for (int e = 0; e < 8; ++e) { const bf16_t* hr = F.h_() + (t0 + ig * 8 + e) * HP + hh * 64 + c; qraw[e] = hr[C_QA]; kraw[e] = hr[C_KA]; }
#pragma unroll
    for (int j = 0; j < 2; ++j) { const int q = tid + 512 * j; vraw[j] = *(const bf16x8*)(F.h_() + (t0 + (q >> 4)) * HP + C_VA + hh * 128 + (q & 15) * 8);
#pragma unroll
        for (int dir = 0; dir < 2; ++dir) sraw[dir][j] = *(const u32x4*)(F.state_() + ((size_t)(dir * 8 + bh) * 256 + n) * 8192 + (q >> 3) * 64 + (q & 7) * 8); }
    float bf[8], bb[8], totf, totb; gla_gates(F, b, hh, n, bf, bb, totf, totb);
#pragma unroll
    for (int e = 0; e < 8; ++e) { const int i = ig * 8 + e; const float q = bf2f(qraw[e]) * 0.125f, k = bf2f(kraw[e]);
        const float ef = fexp(bf[e]), eb = fexp(bb[e]), nf = fexp(-bf[e]), nb = fexp(-bb[e]);
        *(LAS unsigned short*)(F.lds + GL_QF + i * RS72 + c * 2) = (unsigned short)f2bf(q * ef); *(LAS unsigned short*)(F.lds + GL_QB + i * RS72 + c * 2) = (unsigned short)f2bf(q * eb);
        *(LAS unsigned short*)(F.lds + GL_KF + i * RS72 + c * 2) = (unsigned short)f2bf(k * nf); *(LAS unsigned short*)(F.lds + GL_KB + i * RS72 + c * 2) = (unsigned short)f2bf(k * nb); }
    gla_stage_vT(F, vraw);
#pragma unroll
    for (int dir = 0; dir < 2; ++dir)
#pragma unroll
        for (int j = 0; j < 2; ++j) { const int q = tid + 512 * j; *(LAS u32x4*)(F.lds + (dir ? GL_SB : GL_SF) + (q >> 3) * RS72 + (q & 7) * 16) = sraw[dir][j]; }
    __syncthreads();
    if (F.wave < 4) { const int ti = F.wave >> 1, tj = F.wave & 1; f32x16 sf = {}, sb = {};
#pragma unroll
        for (int s = 0; s < 4; ++s) {
            sf = __builtin_amdgcn_mfma_f32_32x32x16_bf16(ldfrag(F.lds + GL_QF, 32 * ti + r32, s, hi), ldfrag(F.lds + GL_KF, 32 * tj + r32, s, hi), sf, 0, 0, 0);
            sb = __builtin_amdgcn_mfma_f32_32x32x16_bf16(ldfrag(F.lds + GL_QB, 32 * ti + r32, s, hi), ldfrag(F.lds + GL_KB, 32 * tj + r32, s, hi), sb, 0, 0, 0); }
#pragma unroll
        for (int r = 0; r < 16; ++r) { const int i = 32 * ti + crow(r, hi), j = 32 * tj + r32; const float p = (j <= i) ? sf[r] : sb[r];
            *(LAS unsigned short*)(F.lds + GL_P + i * RS72 + j * 2) = (unsigned short)f2bf(p); } }
    __syncthreads();
    const int ti = F.wave & 1, tv = F.wave >> 1; f32x16 o = {};
#pragma unroll
    for (int s = 0; s < 4; ++s) o = __builtin_amdgcn_mfma_f32_32x32x16_bf16(ldfrag(F.lds + GL_P, 32 * ti + r32, s, hi), ldfrag(F.lds + GL_VT, 32 * tv + r32, s, hi), o, 0, 0, 0);
#pragma unroll
    for (int s = 0; s < 4; ++s) o = __builtin_amdgcn_mfma_f32_32x32x16_bf16(ldfrag(F.lds + GL_QF, 32 * ti + r32, s, hi), ldfrag(F.lds + GL_SF, 32 * tv + r32, s, hi), o, 0, 0, 0);
#pragma unroll
    for (int s = 0; s < 4; ++s) o = __builtin_amdgcn_mfma_f32_32x32x16_bf16(ldfrag(F.lds + GL_QB, 32 * ti + r32, s, hi), ldfrag(F.lds + GL_SB, 32 * tv + r32, s, hi), o, 0, 0, 0);
    __syncthreads();
    LAS float* ob = (LAS float*)(F.lds + GL_OB);
#pragma unroll
    for (int r = 0; r < 16; ++r) ob[(32 * ti + crow(r, hi)) * 132 + 32 * tv + r32] = o[r];
    __syncthreads();
    { const int i = tid >> 3, part = tid & 7, v0 = part * 16; float ov[16], ss = 0.f;
#pragma unroll
      for (int e = 0; e < 16; ++e) { ov[e] = ob[i * 132 + v0 + e]; ss += ov[e] * ov[e]; }
      ss += __shfl_xor(ss, 1); ss += __shfl_xor(ss, 2); ss += __shfl_xor(ss, 4);
      const float rs = __builtin_amdgcn_rsqf(ss * (1.f / 128.f) + EPS); const size_t tok = t0 + i;
      const u32x4 r0 = *(const u32x4*)(F.h_() + tok * HP + C_RA + hh * 128 + v0), r1 = *(const u32x4*)(F.h_() + tok * HP + C_RA + hh * 128 + v0 + 8);
      const float rr[16] = {bflo(r0.x), bfhi(r0.x), bflo(r0.y), bfhi(r0.y), bflo(r0.z), bfhi(r0.z), bflo(r0.w), bfhi(r0.w), bflo(r1.x), bfhi(r1.x), bflo(r1.y), bfhi(r1.y), bflo(r1.z), bfhi(r1.z), bflo(r1.w), bfhi(r1.w)};
      float y[16];
#pragma unroll
      for (int e = 0; e < 16; ++e) { const float g = F.out_g[hh * 128 + v0 + e]; const float sil = rr[e] * __builtin_amdgcn_rcpf(1.f + fexp(-rr[e])); y[e] = ov[e] * rs * g * sil; }
      u32x4 w0, w1; w0.x = pk2(y[0], y[1]); w0.y = pk2(y[2], y[3]); w0.z = pk2(y[4], y[5]); w0.w = pk2(y[6], y[7]); w1.x = pk2(y[8], y[9]); w1.y = pk2(y[10], y[11]); w1.z = pk2(y[12], y[13]); w1.w = pk2(y[14], y[15]);
      bf16_t* mp = F.mixed_() + tok * DM + hh * 128 + v0; *(u32x4*)mp = w0; *(u32x4*)(mp + 8) = w1; }
    __syncthreads();
}

constexpr int AT_V = 0, AT_K = 32768, AT_O = 65536;
#define KSWZ(row, colB) ((row) * 256 + ((colB) ^ (((row) & 7) << 4)))
__device__ __forceinline__ int v_st(int k, int c) { const int kk = (k & ~0xC) | ((k & 4) << 1) | ((k & 8) >> 1); return ((kk >> 3) * 4 + (c >> 5)) * 512 + ((kk & 7) * 32 + (c & 31)) * 2; }
__device__ __forceinline__ int v_rd_base(int lane) { return ((lane & 3) << 3) | (((lane >> 2) & 3) << 6) | (((lane >> 4) & 1) << 5) | (((lane >> 5) & 1) << 8); }
constexpr int v_rd_off(int d0, int ks, int half) { return d0 * 512 + ks * 4096 + half * 2048; }
template <int OFF> __device__ __forceinline__ s16x4 tr_read(int vb) { s16x4 r; asm volatile("ds_read_b64_tr_b16 %0, %1 offset:%2" : "=&v"(r) : "v"(vb), "i"(OFF) : "memory"); return r; }
template <int D0> __device__ __forceinline__ void pv_one(f32x16& od, int vb, bf16x8 pa0, bf16x8 pa1, bf16x8 pa2, bf16x8 pa3) {
    const s16x4 l0 = tr_read<v_rd_off(D0, 0, 0)>(vb), h0 = tr_read<v_rd_off(D0, 0, 1)>(vb), l1 = tr_read<v_rd_off(D0, 1, 0)>(vb), h1 = tr_read<v_rd_off(D0, 1, 1)>(vb);
    const s16x4 l2 = tr_read<v_rd_off(D0, 2, 0)>(vb), h2 = tr_read<v_rd_off(D0, 2, 1)>(vb), l3 = tr_read<v_rd_off(D0, 3, 0)>(vb), h3 = tr_read<v_rd_off(D0, 3, 1)>(vb);
    asm volatile("s_waitcnt lgkmcnt(0)" ::: "memory"); SBAR();
#define PKV(L, H) (bf16x8){L[0], L[1], L[2], L[3], H[0], H[1], H[2], H[3]}
    od = __builtin_amdgcn_mfma_f32_32x32x16_bf16(pa0, PKV(l0, h0), od, 0, 0, 0);
    od = __builtin_amdgcn_mfma_f32_32x32x16_bf16(pa1, PKV(l1, h1), od, 0, 0, 0);
    od = __builtin_amdgcn_mfma_f32_32x32x16_bf16(pa2, PKV(l2, h2), od, 0, 0, 0);
    od = __builtin_amdgcn_mfma_f32_32x32x16_bf16(pa3, PKV(l3, h3), od, 0, 0, 0);
#undef PKV
}
struct AtP { size_t tokbase; int dil, m0, Tf, nt, head, p; };
__device__ __forceinline__ AtP at_decode(int item) {
    AtP P; const int p = item / 1536, rem = item % 1536, b = rem / 768, rem2 = rem % 768, u = rem2 & 63; P.p = p; P.head = rem2 >> 6;
    const int dsh = 2 * p, L = SEQ >> dsh, runs = 64 >> dsh, res = u / runs; P.dil = 1 << dsh; P.m0 = (u % runs) * 256; P.tokbase = (size_t)b * SEQ + res;
    const int kt_lo = (P.m0 == 0) ? 1 : 0, kt_hi = (P.m0 + 256 >= L) ? 4 : 5; P.Tf = P.m0 - 64 + 64 * kt_lo; P.nt = kt_hi - kt_lo + 1; return P;
}
__device__ __forceinline__ void attn_phase(const Frame& F) {
    const int tid = F.tid, wid = F.wave, lane = F.lane, r32 = lane & 31, hi = lane >> 5, G = F.G;
    int ntot = 0; for (int it = F.vcu; it < 4608; it += G) ntot += at_decode(it).nt;
    if (ntot == 0) return;
    const int sr = tid >> 4, sc = (tid & 15) * 8, vst0 = v_st(sr, sc), vst1 = v_st(32 + sr, sc), kc = sc * 2;
    const int vb0 = (int)(unsigned)(uintptr_t)(F.ldsg + AT_V) + v_rd_base(lane);
    int it_ld = F.vcu, rl = 0, it_c = F.vcu, rc = 0; AtP ld = at_decode(it_ld), cur = ld;
    bf16x8 qr[8], qn[8]; f32x16 o[4]; float l_reg = 0.f;
    bf16x8 sA0, sA1, sA2, sA3;
#define AT_QLOAD() do { const bf16_t* qp_ = F.h_() + C_QD + ld.head * 128 + (ld.tokbase + (size_t)ld.dil * (ld.m0 + 32 * wid + r32)) * HP + hi * 8; \
        _Pragma("unroll") for (int d0 = 0; d0 < 8; ++d0) qn[d0] = *(const bf16x8*)(qp_ + d0 * 16); } while (0)
#define AT_SLOAD(S) do { const int T0_ = ld.Tf + 64 * rl; const size_t ra = (ld.tokbase + (size_t)ld.dil * (T0_ + sr)) * HP + ld.head * 128 + sc, rb = ra + (size_t)ld.dil * 32 * HP; \
        S##0 = *(const bf16x8*)(F.h_() + C_VD + ra); S##1 = *(const bf16x8*)(F.h_() + C_VD + rb); S##2 = *(const bf16x8*)(F.h_() + C_KD + ra); S##3 = *(const bf16x8*)(F.h_() + C_KD + rb); \
        if (++rl == ld.nt) { it_ld += G; rl = 0; if (it_ld < 4608) { ld = at_decode(it_ld); AT_QLOAD(); } } } while (0)
#define AT_SWRITE(S, B) do { *(LAS bf16x8*)(F.lds + AT_V + (B) * 16384 + vst0) = S##0; *(LAS bf16x8*)(F.lds + AT_V + (B) * 16384 + vst1) = S##1; \
        *(LAS bf16x8*)(F.lds + AT_K + (B) * 16384 + KSWZ(sr, kc)) = S##2; *(LAS bf16x8*)(F.lds + AT_K + (B) * 16384 + KSWZ(32 + sr, kc)) = S##3; } while (0)
#define PK4(P, BASE, OUT) do { unsigned a0_ = pk2(P[BASE + 0], P[BASE + 1]), a1_ = pk2(P[BASE + 2], P[BASE + 3]); unsigned b0_ = pk2(P[BASE + 4], P[BASE + 5]), b1_ = pk2(P[BASE + 6], P[BASE + 7]); \
        auto r0_ = __builtin_amdgcn_permlane32_swap(a0_, b0_, false, false); auto r1_ = __builtin_amdgcn_permlane32_swap(a1_, b1_, false, false); \
        u32x4 w_ = {r0_[0], r1_[0], r0_[1], r1_[1]}; OUT = __builtin_bit_cast(bf16x8, w_); } while (0)
#define AT_STEP(BUF) do { \
        if (rc == 0) { _Pragma("unroll") for (int d0 = 0; d0 < 8; ++d0) qr[d0] = qn[d0]; _Pragma("unroll") for (int d0 = 0; d0 < 4; ++d0) o[d0] = (f32x16){}; l_reg = 0.f; } \
        const int Q0 = cur.m0 + 32 * wid, T0 = cur.Tf + 64 * rc; \
        if (T0 + 63 >= Q0 - 64 && T0 <= Q0 + 95) {                                        \
            const LAS unsigned char* Ks = F.lds + AT_K + (BUF) * 16384; f32x16 p0 = {}, p1 = {}; \
            _Pragma("unroll") for (int d0 = 0; d0 < 8; ++d0) { const int cb = (d0 * 16 + hi * 8) * 2; \
                const bf16x8 k0 = *(const LAS bf16x8*)(Ks + KSWZ(r32, cb)), k1 = *(const LAS bf16x8*)(Ks + KSWZ(32 + r32, cb)); \
                p0 = __builtin_amdgcn_mfma_f32_32x32x16_bf16(k0, qr[d0], p0, 0, 0, 0); p1 = __builtin_amdgcn_mfma_f32_32x32x16_bf16(k1, qr[d0], p1, 0, 0, 0); } \
            const int dq = T0 - (Q0 + r32); float ps = 0.f;                                \
            _Pragma("unroll") for (int r = 0; r < 16; ++r) { const int e0 = dq + crow(r, hi), e1 = e0 + 32; \
                p0[r] = (e0 >= -64 && e0 <= 64) ? __builtin_amdgcn_exp2f(p0[r]) : 0.f; p1[r] = (e1 >= -64 && e1 <= 64) ? __builtin_amdgcn_exp2f(p1[r]) : 0.f; ps += p0[r] + p1[r]; } \
            l_reg += ps; \
            bf16x8 pa0, pa1, pa2, pa3; PK4(p0, 0, pa0); PK4(p0, 8, pa1); PK4(p1, 0, pa2); PK4(p1, 8, pa3); \
            const int vb = vb0 + (BUF) * 16384; \
            pv_one<0>(o[0], vb, pa0, pa1, pa2, pa3); pv_one<1>(o[1], vb, pa0, pa1, pa2, pa3); pv_one<2>(o[2], vb, pa0, pa1, pa2, pa3); pv_one<3>(o[3], vb, pa0, pa1, pa2, pa3); } \
        if (++rc == cur.nt) {                                                             \
            unsigned char* Op = (cur.p == 0 ? (unsigned char*)F.out + OUT_OP0 : F.wsb + (cur.p == 1 ? WS_OP1 : WS_OP2)); \
            const float lt = l_reg + __shfl_xor(l_reg, 32); \
            LAS unsigned char* stg = F.lds + AT_O + wid * 8192; \
            if (hi == 0) { F.lp_()[((size_t)cur.p * T + cur.tokbase + (size_t)cur.dil * (Q0 + r32)) * NHD + cur.head] = lt; *(LAS float*)(stg + 4096 + r32 * 4) = lt; } \
            LDS_WAIT(); asm volatile("" ::: "memory"); \
            float rli[16]; _Pragma("unroll") for (int r = 0; r < 16; ++r) rli[r] = __builtin_amdgcn_rcpf(*(const LAS float*)(stg + 4096 + crow(r, hi) * 4)); \
            _Pragma("unroll") for (int d0 = 0; d0 < 4; ++d0) _Pragma("unroll") for (int r = 0; r < 16; ++r) *(LAS unsigned char*)(stg + crow(r, hi) * 128 + d0 * 32 + r32) = (unsigned char)__builtin_amdgcn_cvt_pk_fp8_f32(o[d0][r] * rli[r], 0.f, 0, false); \
            LDS_WAIT(); asm volatile("" ::: "memory"); \
            _Pragma("unroll") for (int i_ = 0; i_ < 4; ++i_) { const int row = 8 * i_ + (lane >> 3), ch = lane & 7; const u32x4 w = *(const LAS u32x4*)(stg + row * 128 + ch * 16); \
                *(u32x4*)(Op + (cur.tokbase + (size_t)cur.dil * (Q0 + row)) * (NHD * 128) + cur.head * 128 + ch * 16) = w; } \
            LDS_WAIT(); asm volatile("" ::: "memory"); \
            rc = 0; it_c += G; if (it_c < 4608) cur = at_decode(it_c); } } while (0)
    AT_QLOAD();
    AT_SLOAD(sA); AT_SWRITE(sA, 0); AT_SLOAD(sA); __syncthreads();
    for (int g = 0; g < ntot; ++g) { const int buf = g & 1;
        AT_STEP(buf);
        if (g + 1 < ntot) AT_SWRITE(sA, buf ^ 1);
        if (it_ld < 4608) AT_SLOAD(sA);
        __syncthreads();
    }
#undef AT_QLOAD
#undef AT_SLOAD
#undef AT_SWRITE
#undef PK4
#undef AT_STEP
}
__device__ __forceinline__ void dil_combine(const Frame& F) {
    const int gw = F.vcu * 8 + F.wave, NGW = F.G * 8, lane = F.lane, c = lane & 15;
    const unsigned char* o0 = (const unsigned char*)F.op0_(); const unsigned char* o1 = (const unsigned char*)F.op1_(); const unsigned char* o2 = (const unsigned char*)F.op2_();
    for (long it = gw; it < (long)T * NHD / 4; it += NGW) { const long row = it * 4 + (lane >> 4); const size_t tok = (size_t)(row / NHD); const int head = (int)(row % NHD);
        const float l0 = F.lp_()[tok * NHD + head], l1 = F.lp_()[((size_t)T + tok) * NHD + head], l2 = F.lp_()[((size_t)2 * T + tok) * NHD + head]; const float inv = 1.f / (l0 + l1 + l2), w0 = l0 * inv, w1 = l1 * inv, w2 = l2 * inv;
        const size_t off = tok * (NHD * 128) + head * 128 + 8 * c; const u32x2 a = *(const u32x2*)(o0 + off), b = *(const u32x2*)(o1 + off), d = *(const u32x2*)(o2 + off);
#define DC2(AW, BW, DW, SEL) ({ const f32x2 x_ = __builtin_amdgcn_cvt_pk_f32_fp8((int)(AW), SEL), y_ = __builtin_amdgcn_cvt_pk_f32_fp8((int)(BW), SEL), z_ = __builtin_amdgcn_cvt_pk_f32_fp8((int)(DW), SEL); \
            pk2(w0 * x_[0] + w1 * y_[0] + w2 * z_[0], w0 * x_[1] + w1 * y_[1] + w2 * z_[1]); })
        u32x4 o; o.x = DC2(a.x, b.x, d.x, false); o.y = DC2(a.x, b.x, d.x, true); o.z = DC2(a.y, b.y, d.y, false); o.w = DC2(a.y, b.y, d.y, true);
#undef DC2
        *(u32x4*)(F.mixed_() + tok * DM + 512 + head * 128 + 8 * c) = o; }
}

__device__ __forceinline__ unsigned fl_flip(float x) { const unsigned u = __float_as_uint(x); return u ^ ((unsigned)((int)u >> 31) | 0x80000000u); }
__device__ __forceinline__ float fl_unflip(unsigned w) { return __uint_as_float((w & 0x80000000u) ? (w ^ 0x80000000u) : ~w); }
#define CE_DESC(a, b) do { const unsigned x_ = max(a, b), y_ = min(a, b); a = x_; b = y_; } while (0)
__device__ __forceinline__ void sort16_desc(unsigned (&a)[16]) {
#pragma unroll
    for (int k = 2; k <= 16; k <<= 1)
#pragma unroll
        for (int j = k >> 1; j > 0; j >>= 1)
#pragma unroll
            for (int i = 0; i < 16; ++i) { const int l = i ^ j; if (l > i) { const unsigned x = max(a[i], a[l]), y = min(a[i], a[l]); if ((i & k) == 0) { a[i] = x; a[l] = y; } else { a[i] = y; a[l] = x; } } }
}
__device__ __forceinline__ void bmerge16_desc(unsigned (&a)[16]) {
#pragma unroll
    for (int j = 8; j > 0; j >>= 1)
#pragma unroll
        for (int i = 0; i < 16; ++i) { const int l = i ^ j; if (l > i) CE_DESC(a[i], a[l]); }
}
__device__ __forceinline__ void top16_merge(unsigned (&a)[16], const unsigned (&b)[16]) {
#pragma unroll
    for (int i = 0; i < 16; ++i) a[i] = max(a[i], b[15 - i]);
    bmerge16_desc(a);
}
__device__ __forceinline__ void top16_partner(unsigned (&a)[16]) {
    unsigned b[16];
#pragma unroll
    for (int i = 0; i < 16; ++i) b[i] = (unsigned)__shfl_xor((int)a[i], 32);
    top16_merge(a, b);
}
__device__ constexpr unsigned char stair(int n) {
    constexpr unsigned char L[64] = {0x00,0x01,0x02,0x03,0x04,0x05,0x06,0x07,0x08,0x09,0x0a,0x0b,0x0c,0x0d,0x0e,0x0f,0x10,0x11,0x12,0x13,0x14,0x15,0x16,0x17,0x20,0x21,0x22,0x23,0x24,0x30,0x31,0x32,
                                     0x33,0x40,0x41,0x42,0x50,0x51,0x60,0x61,0x70,0x71,0x80,0x90,0xa0,0xb0,0xc0,0xd0,0xe0,0xf0,0xff,0xff,0xff,0xff,0xff,0xff,0xff,0xff,0xff,0xff,0xff,0xff,0xff,0xff};
    return L[n];
}
constexpr int TK_KEYS = 32768;
__device__ __forceinline__ void topk_item(const Frame& F, int hh, int tg) {
    const int lane = F.lane, r32 = lane & 31, hi = lane >> 5, tok0 = tg * 32; const size_t tok = (size_t)tok0 + r32;
    LAS int* ktab = (LAS int*)(F.lds + F.wave * 4096) + r32 * 32;
    float ss = 0.f;
    { const f32x4* sp = (const f32x4*)(F.ssp_() + tok * 32 + hi * 16);
#pragma unroll
      for (int j = 0; j < 4; ++j) { const f32x4 v = sp[j]; ss += (v[0] + v[1]) + (v[2] + v[3]); } }
    ss += __shfl_xor(ss, 32);
    const float rs2 = __builtin_amdgcn_rsqf(ss * (1.f / DM) + EPS);
    if (hh == 0 && hi == 0) F.rs2_()[tok] = rs2;
    unsigned top[2][16];
#pragma unroll
    for (int cc = 0; cc < 2; ++cc) {
        f32x16 acc[4] = {};
        const bf16_t* qp = F.qry_() + tok * DM + hh * 256 + cc * 128 + hi * 8; const LAS unsigned char* kl = F.lds + TK_KEYS + cc * 32768;
        bf16x8 qf[8];
#pragma unroll
        for (int s = 0; s < 8; ++s) qf[s] = *(const bf16x8*)(qp + 16 * s);
#pragma unroll
        for (int s = 0; s < 8; ++s) {
#pragma unroll
            for (int kt = 0; kt < 4; ++kt) { const bf16x8 kf = *(const LAS bf16x8*)(kl + KSWZ(kt * 32 + r32, (16 * s + 8 * hi) * 2)); acc[kt] = __builtin_amdgcn_mfma_f32_32x32x16_bf16(kf, qf[s], acc[kt], 0, 0, 0); } }
        unsigned g[4][16];
#pragma unroll
        for (int kt = 0; kt < 4; ++kt) {
#pragma unroll
            for (int r = 0; r < 16; ++r) g[kt][r] = (fl_flip(acc[kt][r]) & ~127u) | (unsigned)(127 - (32 * kt + crow(r, hi)));
            sort16_desc(g[kt]); }
        top16_merge(g[0], g[1]); top16_merge(g[2], g[3]); top16_merge(g[0], g[2]); top16_partner(g[0]);
#pragma unroll
        for (int i = 0; i < 16; ++i) top[cc][i] = g[0][i];
    }
#pragma unroll
    for (int i = 0; i < 16; ++i) ktab[hi * 16 + i] = 127 - (int)((hi ? top[1][i] : top[0][i]) & 127u);
    float s0[16], s1[16];
#pragma unroll
    for (int i = 0; i < 16; ++i) { s0[i] = fl_unflip(top[0][i] & ~127u); s1[i] = fl_unflip(top[1][i] & ~127u); }
    unsigned ca[16], cb[16];
#pragma unroll
    for (int n = 0; n < 32; ++n) { const int A = stair(n), B = stair(25 + n); unsigned va = 0u, vb = 0u;
        if (n < 25) { va = (fl_flip(s0[A >> 4] + s1[A & 15]) & ~255u) | (unsigned)(255 - A); vb = (fl_flip(s0[B >> 4] + s1[B & 15]) & ~255u) | (unsigned)(255 - B); }
        const unsigned v = hi ? vb : va; if (n < 16) ca[n] = v; else cb[n - 16] = v; }
    sort16_desc(ca); sort16_desc(cb); top16_merge(ca, cb); top16_partner(ca);
    float e[16], sum = 0.f; const float mx = fl_unflip(ca[0] & ~255u) * rs2;
#pragma unroll
    for (int i = 0; i < 16; ++i) { e[i] = fexp(fl_unflip(ca[i] & ~255u) * rs2 - mx); sum += e[i]; }
    const float inv = 1.f / sum;
    LDS_WAIT(); asm volatile("" ::: "memory");
    int oi[8]; float og[8];
#pragma unroll
    for (int k = 0; k < 8; ++k) { const unsigned cv = hi ? ca[8 + k] : ca[k]; const int code = 255 - (int)(cv & 255u); og[k] = (hi ? e[8 + k] : e[k]) * inv; oi[k] = ktab[code >> 4] * 128 + ktab[16 + (code & 15)]; }
    { unsigned short* ip = F.idx_() + tok * 128 + hh * 16 + hi * 8; float* gp = F.gate_() + tok * 128 + hh * 16 + hi * 8;
      *(u32x4*)ip = (u32x4){(unsigned)oi[0] | ((unsigned)oi[1] << 16), (unsigned)oi[2] | ((unsigned)oi[3] << 16), (unsigned)oi[4] | ((unsigned)oi[5] << 16), (unsigned)oi[6] | ((unsigned)oi[7] << 16)};
      { const int g0 = hh * 4 + hi * 2;
        *(u32x2*)(F.idxT_() + ((size_t)g0 * T + tok) * 4) = (u32x2){(unsigned)oi[0] | ((unsigned)oi[1] << 16), (unsigned)oi[2] | ((unsigned)oi[3] << 16)};
        *(u32x2*)(F.idxT_() + ((size_t)(g0 + 1) * T + tok) * 4) = (u32x2){(unsigned)oi[4] | ((unsigned)oi[5] << 16), (unsigned)oi[6] | ((unsigned)oi[7] << 16)}; }
      *(f32x4*)gp = (f32x4){og[0], og[1], og[2], og[3]}; *(f32x4*)(gp + 4) = (f32x4){og[4], og[5], og[6], og[7]}; }
    LDS_WAIT(); asm volatile("" ::: "memory");
}

constexpr int PS_NSL = 16, PS_CW = DM / PS_NSL, PS_SUB = PS_NSL / 8, PS_TG = 32, PS_NTG = T / PS_TG;
__device__ __forceinline__ float gelu_tanh(float x) { const float u = 0.7978845608028654f * (x + 0.044715f * x * x * x); const float t = 1.f - 2.f * __builtin_amdgcn_rcpf(1.f + fexp(2.f * u)); return 0.5f * x * (1.f + t); }
__device__ __forceinline__ int dot16i(u32x4 w, u32x4 x) { int p = __builtin_amdgcn_sdot4((int)w.x, (int)x.x, 0, false); p = __builtin_amdgcn_sdot4((int)w.y, (int)x.y, p, false); p = __builtin_amdgcn_sdot4((int)w.z, (int)x.z, p, false); return __builtin_amdgcn_sdot4((int)w.w, (int)x.w, p, false); }
__device__ __forceinline__ unsigned xcc_id() { return (unsigned)__builtin_amdgcn_s_getreg((3 << 11) | 20) & 7u; }
__device__ __forceinline__ bool peer_claim(unsigned* cnt, unsigned x, unsigned& d, int lane, int& q, int& tg) {
    while (d < 8u) { const unsigned xq = (x + d) & 7u; unsigned u = 0u;
        if (lane == 0) u = __hip_atomic_fetch_add(cnt + 64 * xq, 1u, __ATOMIC_RELAXED, __HIP_MEMORY_SCOPE_AGENT);
        u = (unsigned)__builtin_amdgcn_readfirstlane((int)u);
        if (u < (unsigned)(PS_SUB * PS_NTG)) { q = (int)(u / PS_NTG) * 8 + (int)xq; tg = (int)(u % PS_NTG); return true; }
        ++d; }
    return false;
}
template <int CTRL> __device__ __forceinline__ float dppmov(float x) { return __int_as_float(__builtin_amdgcn_update_dpp(0, __float_as_int(x), CTRL, 0xf, 0xf, true)); }
template <int CTRL> __device__ __forceinline__ int dppmovi(int x) { return __builtin_amdgcn_update_dpp(0, x, CTRL, 0xf, 0xf, true); }
__device__ __forceinline__ int bperm(int srclane, int v) { return __builtin_amdgcn_ds_bpermute(srclane << 2, v); }
__device__ __forceinline__ void peer_quant_x(const Frame& F) {
    const int gw = F.vcu * 8 + F.wave, NGW = F.G * 8, lane = F.lane;
    for (int tok = gw; tok < T; tok += NGW) { const u32x4* xr = (const u32x4*)(F.x1b_() + (size_t)tok * DM) + lane; float v[4][8]; float m = 0.f;
#pragma unroll
        for (int j = 0; j < 4; ++j) { const u32x4 w = xr[64 * j]; v[j][0] = bflo(w.x); v[j][1] = bfhi(w.x); v[j][2] = bflo(w.y); v[j][3] = bfhi(w.y); v[j][4] = bflo(w.z); v[j][5] = bfhi(w.z); v[j][6] = bflo(w.w); v[j][7] = bfhi(w.w);
#pragma unroll
            for (int i = 0; i < 8; ++i) m = fmaxf(m, fabsf(v[j][i])); }
#pragma unroll
        for (int o = 1; o < 64; o <<= 1) m = fmaxf(m, __shfl_xor(m, o));
        const float inv = m > 0.f ? 127.f / m : 0.f;
#pragma unroll
        for (int j = 0; j < 4; ++j) { u32x2 w = {0u, 0u};
#pragma unroll
            for (int i = 0; i < 4; ++i) { w.x |= ((unsigned)(int)rintf(v[j][i] * inv) & 0xffu) << (8 * i); w.y |= ((unsigned)(int)rintf(v[j][4 + i] * inv) & 0xffu) << (8 * i); }
            *(u32x2*)(F.xq8_() + (size_t)tok * DM + 8 * lane + 512 * j) = w; }
        if (lane == 0) F.sx_()[tok] = m * (1.f / 127.f); }
}
__device__ __forceinline__ void peer_down(const Frame& F, int cntw = 1024) {
    const int lane = F.lane, g = lane >> 3, c = lane & 7; const unsigned x = xcc_id(); unsigned d = 0u; int q, tg; unsigned* cnt = (unsigned*)(F.wsb + WS_CTL) + cntw;
    const unsigned char* tab = F.down8_(); const unsigned char* xb = F.xq8_();
    while (peer_claim(cnt, x, d, lane, q, tg)) {
        const unsigned colb = (unsigned)(q * PS_CW + 16 * c), slb = (unsigned)q * (16384u * 128u) + 16u * c; short* part = F.part_() + (size_t)q * T * 128; const size_t tok0 = (size_t)tg * PS_TG;
        u32x4 wA[16], wB[16], xA, xB; int iA0, iA1, iB0, iB1;
#define PD_IDX(i0, i1, tok) do { const unsigned short* ip_ = F.idx_() + (tok) * 128 + lane; i0 = ip_[0]; i1 = ip_[64]; } while (0)
#define PD_ROWS(W_, X_, i0, i1, tok) do { _Pragma("unroll") for (int j = 0; j < 16; ++j) { const unsigned e_ = (unsigned)bperm(8 * (j & 7) + g, j < 8 ? i0 : i1); \
            W_[j] = *(const u32x4*)(tab + (e_ * 128u + slb)); } X_ = *(const u32x4*)(xb + (tok) * DM + colb); } while (0)
#define PD_COMP(W_, X_, tok) do { int p[16]; _Pragma("unroll") for (int j = 0; j < 16; ++j) p[j] = dot16i(W_[j], X_); \
            int a1[8], a2[4], a3[2]; \
            _Pragma("unroll") for (int i = 0; i < 8; ++i) { const int keep = (c & 1) ? p[2 * i + 1] : p[2 * i], give = (c & 1) ? p[2 * i] : p[2 * i + 1]; a1[i] = keep + dppmovi<0xB1>(give); } \
            _Pragma("unroll") for (int i = 0; i < 4; ++i) { const int keep = (c & 2) ? a1[2 * i + 1] : a1[2 * i], give = (c & 2) ? a1[2 * i] : a1[2 * i + 1]; a2[i] = keep + dppmovi<0x4E>(give); } \
            _Pragma("unroll") for (int i = 0; i < 2; ++i) { const int keep = (c & 4) ? a2[2 * i + 1] : a2[2 * i], give = (c & 4) ? a2[2 * i] : a2[2 * i + 1]; a3[i] = keep + __shfl_xor(give, 4); } \
            part[(tok) * 128 + 8 * c + g] = (short)min(max(a3[0] >> 2, -32768), 32767); part[(tok) * 128 + 64 + 8 * c + g] = (short)min(max(a3[1] >> 2, -32768), 32767); } while (0)
        PD_IDX(iA0, iA1, tok0); PD_IDX(iB0, iB1, tok0 + 1);
        PD_ROWS(wA, xA, iA0, iA1, tok0);
        for (int tt = 0; tt < PS_TG; tt += 2) { const size_t tok = tok0 + tt;
            PD_ROWS(wB, xB, iB0, iB1, tok + 1);
            const size_t t2 = tok + (tt + 2 < PS_TG ? 2 : 0), t3 = tok + (tt + 2 < PS_TG ? 3 : 1);
            PD_IDX(iA0, iA1, t2);
            PD_COMP(wA, xA, tok);
            if (tt + 2 < PS_TG) PD_ROWS(wA, xA, iA0, iA1, t2);
            PD_IDX(iB0, iB1, t3);
            PD_COMP(wB, xB, tok + 1);
        }
#undef PD_IDX
#undef PD_ROWS
#undef PD_COMP
    }
}
__device__ __forceinline__ void peer_coef_probe(const Frame& F, bool dry) {
    const int gw = F.vcu * 8 + F.wave, NGW = F.G * 8, lane = F.lane;
    for (int tok = gw; tok < T; tok += NGW) { int a0 = 0, a1 = 0; const short* pp = F.part_() + (size_t)tok * 128 + lane;
#pragma unroll
        for (int q = 0; q < PS_NSL; ++q) { a0 += pp[(size_t)q * T * 128]; a1 += pp[(size_t)q * T * 128 + 64]; }
        const float sc = F.rs2_()[tok] * F.sx_()[tok] * 4.f; const float* gp = F.gate_() + (size_t)tok * 128 + lane; const int e0 = F.idx_()[(size_t)tok * 128 + lane], e1 = F.idx_()[(size_t)tok * 128 + 64 + lane];
        const float c0 = gp[0] * gelu_tanh((float)a0 * sc * F.sd_()[e0]) * F.su_()[e0], c1 = gp[64] * gelu_tanh((float)a1 * sc * F.sd_()[e1]) * F.su_()[e1];
        float m = fmaxf(fabsf(c0), fabsf(c1));
#pragma unroll
        for (int o = 1; o < 64; o <<= 1) m = fmaxf(m, __shfl_xor(m, o));
        const float inv = m > 0.f ? 127.f / m : 0.f; const int q0 = (int)rintf(c0 * inv), q1 = (int)rintf(c1 * inv);
        unsigned char* fp = dry ? F.wsb + WS_PART + 256 * MiB : (unsigned char*)F.fqT_();
        { const int k0 = lane, k1 = 64 + lane; fp[((size_t)(k0 >> 2) * T + tok) * 4 + (k0 & 3)] = (unsigned char)q0; fp[((size_t)(k1 >> 2) * T + tok) * 4 + (k1 & 3)] = (unsigned char)q1; }
        if (lane == 0 && !dry) F.csum_()[tok] = m * (1.f / 127.f); }
}
#define PU_T4(ACC_, R0, R1, R2, R3, FQ_) do { const unsigned t0_ = __builtin_amdgcn_perm(R1, R0, 0x05010400u), t1_ = __builtin_amdgcn_perm(R1, R0, 0x07030602u), t2_ = __builtin_amdgcn_perm(R3, R2, 0x05010400u), t3_ = __builtin_amdgcn_perm(R3, R2, 0x07030602u); \
            ACC_[0] = __builtin_amdgcn_sdot4((int)__builtin_amdgcn_perm(t2_, t0_, 0x05040100u), FQ_, ACC_[0], false); ACC_[1] = __builtin_amdgcn_sdot4((int)__builtin_amdgcn_perm(t2_, t0_, 0x07060302u), FQ_, ACC_[1], false); \
            ACC_[2] = __builtin_amdgcn_sdot4((int)__builtin_amdgcn_perm(t3_, t1_, 0x05040100u), FQ_, ACC_[2], false); ACC_[3] = __builtin_amdgcn_sdot4((int)__builtin_amdgcn_perm(t3_, t1_, 0x07060302u), FQ_, ACC_[3], false); } while (0)
__device__ __forceinline__ void peer_up(const Frame& F, int   = 0, bool dry = false) {
    const int lane = F.lane;
    for (int cg = F.vcu; cg < 256; cg += F.G) {
        __syncthreads();
        { const u32x4* src = (const u32x4*)(F.up8_() + (size_t)cg * 131072);
#pragma unroll 4
          for (int i = 0; i < 16; ++i) { const int o = F.tid + 512 * i; *(LAS u32x4*)(F.lds + o * 16) = src[o]; } }
        __syncthreads();
        u32x2 iA[16], iB[16]; int fA[16], fB[16];
        const __amdgpu_buffer_rsrc_t rsI = __builtin_amdgcn_make_buffer_rsrc((void*)F.idxT_(), 0, 32 * T * 8, 0x00020000), rsF = __builtin_amdgcn_make_buffer_rsrc((void*)F.fqT_(), 0, 32 * T * 4, 0x00020000);
#define U2_FENCE() do { asm volatile("" ::: "memory"); SBAR(); } while (0)
#define U2_LOAD(I_, F_, tok_, g0_) do { const unsigned vo_ = (unsigned)(tok_) * 8u; _Pragma("unroll") for (int g = 0; g < 16; ++g) { I_[g] = __builtin_amdgcn_raw_buffer_load_b64(rsI, vo_, ((g0_) + g) * (T * 8), 0); \
            F_[g] = (int)__builtin_amdgcn_raw_buffer_load_b32(rsF, vo_ >> 1, ((g0_) + g) * (T * 4), 0); } U2_FENCE(); } while (0)
#define U2_COMP(I_, F_) do { _Pragma("unroll") for (int g = 0; g < 16; ++g) { const u32x2 id = I_[g]; const int fq = F_[g]; \
                const u32x2 r0 = *(const LAS u32x2*)(F.lds + (id.x & 0xffffu) * 8u), r1 = *(const LAS u32x2*)(F.lds + (id.x >> 16) * 8u), r2 = *(const LAS u32x2*)(F.lds + (id.y & 0xffffu) * 8u), r3 = *(const LAS u32x2*)(F.lds + (id.y >> 16) * 8u); \
                int* a_ = acc; PU_T4(a_, r0.x, r1.x, r2.x, r3.x, fq); a_ = acc + 4; PU_T4(a_, r0.y, r1.y, r2.y, r3.y, fq); if ((g & 3) == 3) U2_FENCE(); } } while (0)
        const int nb = (T / 64 - F.wave + 7) / 8;
        const unsigned lane_ = __builtin_amdgcn_mbcnt_hi(~0u, __builtin_amdgcn_mbcnt_lo(~0u, 0u));
        if (nb > 0) U2_LOAD(iA, fA, (unsigned)F.wave * 64u + lane_, 0);
#pragma unroll 1
        for (int i = 0; i < nb; ++i) { const unsigned tok = (unsigned)(F.wave + 8 * i) * 64u + lane_; int acc[8] = {0, 0, 0, 0, 0, 0, 0, 0};
            U2_LOAD(iB, fB, tok, 16);
            U2_COMP(iA, fA);
            if (i + 1 < nb) U2_LOAD(iA, fA, tok + 512u, 0);
            U2_COMP(iB, fB);
            const u32x4 xo = *(const u32x4*)(F.x1b_() + (size_t)(tok * DM + cg * 8)); const float sf = F.csum_()[tok];
            f32x4 v0 = {bflo(xo.x), bfhi(xo.x), bflo(xo.y), bfhi(xo.y)}, v1 = {bflo(xo.z), bfhi(xo.z), bflo(xo.w), bfhi(xo.w)};
            v0[0] += sf * (float)acc[0]; v0[1] += sf * (float)acc[1]; v0[2] += sf * (float)acc[2]; v0[3] += sf * (float)acc[3]; v1[0] += sf * (float)acc[4]; v1[1] += sf * (float)acc[5]; v1[2] += sf * (float)acc[6]; v1[3] += sf * (float)acc[7];
            float* dp = (dry ? (float*)(F.wsb + WS_PART) + (size_t)((tok & 16383u) * DM) : F.out + (size_t)(tok * DM)) + cg * 8; *(f32x4*)dp = v0; *(f32x4*)(dp + 4) = v1; U2_FENCE(); }
#undef U2_FENCE
#undef U2_LOAD
#undef U2_COMP
    }
}
#undef PU_T4

#define XB_TMO      128
#define XB_XCNT(j)  (256  + 64 * (j))
#define XB_XSUB(j)  (1280 + 64 * (j))
#define XB_XGEN(j)  (2304 + 64 * (j))
#define XB_TOP      3328
#define XB_TOPGEN   3392
#define XCD_BAR_WORDS 3456
#define XB_SPIN_CAP (1u << 18)

__device__ __forceinline__ unsigned xb_ld(unsigned* p)              { return __hip_atomic_load(p, __ATOMIC_RELAXED, __HIP_MEMORY_SCOPE_AGENT); }
__device__ __forceinline__ unsigned xb_add(unsigned* p, unsigned v) { return __hip_atomic_fetch_add(p, v, __ATOMIC_RELAXED, __HIP_MEMORY_SCOPE_AGENT); }
__device__ __forceinline__ unsigned xb_xcc_id() { return (unsigned)__builtin_amdgcn_s_getreg((3 << 11) | 20) & 0xFu; }
#define XB_SPIN(cond, bar) do { unsigned _sp = 0; while (cond) { __builtin_amdgcn_s_sleep(1); \
    if ((++_sp & 255u) == 0u) { if (xb_ld(&(bar)[XB_TMO])) break; if (_sp > XB_SPIN_CAP) { atomicAdd(&(bar)[XB_TMO], 1u); break; } } } } while (0)

struct XcdBarrier {
    unsigned* bar; unsigned x;
    volatile LAS unsigned* st;
};

__device__ __forceinline__ XcdBarrier xcd_barrier_post(unsigned* bar, volatile LAS unsigned* st) {
    XcdBarrier b; b.bar = bar; b.x = xb_xcc_id(); b.st = st;
    if (threadIdx.x == 0) (void)xb_add(&bar[XB_XCNT(b.x)], 1u);
    return b;
}
__device__ __forceinline__ void xcd_barrier_complete(unsigned* bar, unsigned x, unsigned& nloc, unsigned& nx) {
    const unsigned G = gridDim.x * gridDim.y * gridDim.z;
    unsigned sum, cnt, mine, sp = 0u;
    for (;;) {
        sum = 0u; cnt = 0u; mine = 0u;
#pragma unroll
        for (unsigned j = 0; j < 16; ++j) { const unsigned c = xb_ld(&bar[XB_XCNT(j)]); sum += c; cnt += (c > 0u) ? 1u : 0u; mine = (j == x) ? c : mine; }
        if (sum == G) break;
        __builtin_amdgcn_s_sleep(1);
        if ((++sp & 255u) == 0u) { if (xb_ld(&bar[XB_TMO])) break; if (sp > XB_SPIN_CAP) { atomicAdd(&bar[XB_TMO], 1u); break; } }
    }
    nloc = mine > 0u ? mine : 1u; nx = cnt > 0u ? cnt : 1u;
}

__device__ __forceinline__ void xcd_barrier(const XcdBarrier& b) {
    asm volatile("s_waitcnt vmcnt(0)" ::: "memory");
    __syncthreads();
    if (threadIdx.x == 0) {
        unsigned* bar = b.bar;
        __builtin_amdgcn_s_waitcnt(0);
        unsigned nloc = b.st[0], nx = b.st[1];
        if (nloc == 0u) { xcd_barrier_complete(bar, b.x, nloc, nx); b.st[0] = nloc; b.st[1] = nx; }
        const unsigned old = xb_add(&bar[XB_XSUB(b.x)], 1u);
        const unsigned gen = old / nloc;
        if (old + 1u == (gen + 1u) * nloc) {
            __builtin_amdgcn_fence(__ATOMIC_RELEASE, "agent");
            asm volatile("s_waitcnt vmcnt(0)" ::: "memory");
            const unsigned og = xb_add(&bar[XB_TOP], 1u);
            const unsigned tg = og / nx;
            if (og + 1u == (tg + 1u) * nx) xb_add(&bar[XB_TOPGEN], 1u);
            else XB_SPIN(xb_ld(&bar[XB_TOPGEN]) == tg, bar);
            __builtin_amdgcn_fence(__ATOMIC_ACQUIRE, "agent");
            xb_add(&bar[XB_XGEN(b.x)], 1u);
            asm volatile("s_waitcnt vmcnt(0)" ::: "memory");
        } else {
            XB_SPIN(xb_ld(&bar[XB_XGEN(b.x)]) == gen, bar);
            __builtin_amdgcn_fence(__ATOMIC_ACQUIRE, "agent");
            asm volatile("s_waitcnt vmcnt(0)" ::: "memory");
        }
    }
    __syncthreads();
}

struct Args { const float* in[16]; float* out; unsigned char* ws; int ph_lo, ph_hi, coop, pad; };
__global__ void __launch_bounds__(512, 2) fwd_kernel(Args args) {
    extern __shared__ __attribute__((aligned(16))) unsigned char lds_raw[];
    Frame F;
    F.lds = (LAS unsigned char*)lds_raw; F.ldsg = (char*)lds_raw;
    F.tid = threadIdx.x; F.lane = F.tid & 63; F.wave = __builtin_amdgcn_readfirstlane(F.tid >> 6);
    F.G = gridDim.x; { const int bx = blockIdx.x; F.vcu = (F.G % 8 == 0) ? (bx % 8) * (F.G / 8) + bx / 8 : bx; }
    F.x = args.in[0]; F.norm1_g = args.in[1]; F.w_in = args.in[2]; F.up_f = args.in[3]; F.bias_f = args.in[4]; F.up_b = args.in[5]; F.bias_b = args.in[6]; F.out_g = args.in[7];
    F.qn_g = args.in[8]; F.kn_g = args.in[9]; F.w_out = args.in[10]; F.norm2_g = args.in[11]; F.w_query = args.in[12]; F.sub_keys = args.in[13]; F.peer_down = args.in[14]; F.peer_up = args.in[15];
    F.out = args.out; unsigned char* ws = args.ws; F.wsb = ws;
    constexpr int MISC_OFF = 131072 + 320;
    for (int u = F.tid; u < 64; u += 512) ((LAS unsigned*)(F.lds + MISC_OFF))[u] = 0u;
    __syncthreads();
    XcdBarrier bar = xcd_barrier_post((unsigned*)(ws + WS_CTL) + 8192, (volatile LAS unsigned*)(F.lds + MISC_OFF) + 8);
    const int lo = args.ph_lo, hi = args.ph_hi;
#ifndef PH_MASK
#define PH_MASK 0x7ff
#endif
#ifndef PROBE_PHASE
#define PROBE_PHASE -1
#endif
#define REP(k) for (int rep_ = 0; rep_ < ((PROBE_PHASE == (k)) ? 2 : 1); ++rep_)
#define IN(k) (((PH_MASK >> (k)) & 1) && lo <= (k) && (k) < hi)
#define SEAM(k) do { if (IN(k) && IN((k) + 1)) { if (args.coop) { if ((k) == 0) cg::this_grid().sync(); else xcd_barrier(bar); } } } while (0)
    if (IN(0)) { REP(0) phase0(F); } SEAM(0);
#define GEMM1_BODY { pg8::Gemm g{(const pg8::bf16_t*)F.xq1_(), (const pg8::bf16_t*)F.Win8_(), T, HP, DM / 2}; pg8::StaticOrder S; S.init(T, HP, F.G, (int)blockIdx.x); \
        pg8::EpiI8Qk E{F.h_(), HP, F.rs1_(), F.sw_(), F.qn_g, F.kn_g, (LAS float*)(F.lds + 131072 + 1024), C_QD / 256, C_KD / 256, C_VD / 256, SEQ - 1, QSCALE}; \
        pg8::gemm_phase<pg8::EpiI8Qk, pg8::StaticOrder, PG8_ALIGN, PG8_SP2, true>(F.lds, g, S, E); }
    if (IN(1)) { GEMM1_BODY; if (PROBE_PHASE == 1) GEMM1_BODY; } SEAM(1);
    if (IN(2)) { REP(2) for (int it = F.vcu; it < 2048; it += F.G) gla_passA(F, it); } SEAM(2);
    if (IN(3)) { for (int it = F.vcu; it < 256; it += F.G) gla_scan(F, it); REP(3) attn_phase(F); } SEAM(3);
    if (IN(4)) REP(4) { for (int it = F.vcu; it < 2048; it += F.G) gla_passC(F, it); dil_combine(F); } SEAM(4);
#define GEMM5_BODY { pg8::Gemm g{F.mixed_(), F.WoT_(), T, DM, DM}; pg8::StaticOrder S; S.init(T, DM, F.G, (int)blockIdx.x); pg8::EpiResid E{F.x, F.out, F.x1b_(), F.ssp_(), DM}; \
        pg8::gemm_phase<pg8::EpiResid, pg8::StaticOrder, PG8_ALIGN, PG8_SP2>(F.lds, g, S, E); }
#define GEMM6_BODY { pg8::Gemm g{F.x1b_(), F.WqT_(), T, DM, DM}; pg8::StaticOrder S; S.init(T, DM, F.G, (int)blockIdx.x); pg8::EpiRowScaleBf16 E{F.qry_(), DM, nullptr}; \
        pg8::gemm_phase<pg8::EpiRowScaleBf16, pg8::StaticOrder, PG8_ALIGN, PG8_SP2>(F.lds, g, S, E); }
    if (IN(5)) { GEMM5_BODY; if (PROBE_PHASE == 5) GEMM5_BODY; } SEAM(5);
    if (IN(6)) { GEMM6_BODY; if (PROBE_PHASE == 6) GEMM6_BODY; } SEAM(6);
    if (IN(7)) REP(7) { const int gw = F.vcu * 8 + F.wave, NGW = F.G * 8; for (int u = F.vcu; u < 256; u += F.G) { const int hh = u & 7, chunk = u >> 3;
            __syncthreads();
            for (int i = F.tid; i < 4096; i += 512) { const int row = i >> 4, ch = i & 15; *(LAS u32x4*)(F.lds + TK_KEYS + KSWZ(row, ch * 16)) = *(const u32x4*)(F.SK_() + ((size_t)hh * 256 + row) * 128 + ch * 8); }
            __syncthreads();
            for (int j = 0; j < 4; ++j) topk_item(F, hh, chunk * 32 + F.wave * 4 + j); }
        if (rep_ == 0) peer_quant_x(F); } SEAM(7);
    if (IN(8)) { if (PROBE_PHASE == 8) peer_down(F, 3072); peer_down(F); } SEAM(8);
    if (IN(9)) { REP(9) peer_coef_probe(F, (PROBE_PHASE == 9) && rep_ == 0); } SEAM(9);
    if (IN(10)) { if (PROBE_PHASE == 10) peer_up(F, 3584, true); peer_up(F); }
#undef IN
#undef SEAM
}

#ifndef MK_N_LAUNCHES
#define MK_N_LAUNCHES 1
#endif
extern "C" void kernel_launch(void* const* d_in, const int* in_sizes, int n_in, void* d_out, int out_size, void* d_ws, size_t ws_size, hipStream_t stream) {
    static int grid = 0;
    if (grid == 0) {
        if (n_in != 16 || in_sizes[0] != T * DM || out_size != T * DM || ws_size < WS_END) { fprintf(stderr, "kernel_launch: unexpected shapes (n_in %d, in0 %d, out %d, ws %zu)\n", n_in, n_in > 0 ? in_sizes[0] : -1, out_size, ws_size); grid = -1; return; }
        int dev = 0, cus = 0, per_cu = 0;
        if (hipGetDevice(&dev) != hipSuccess || hipDeviceGetAttribute(&cus, hipDeviceAttributeMultiprocessorCount, dev) != hipSuccess) { grid = -1; return; }
        if (hipFuncSetAttribute((const void*)fwd_kernel, hipFuncAttributeMaxDynamicSharedMemorySize, LDS_BYTES) != hipSuccess) { fprintf(stderr, "kernel_launch: hipFuncSetAttribute failed\n"); grid = -1; return; }
        if (hipOccupancyMaxActiveBlocksPerMultiprocessor(&per_cu, (const void*)fwd_kernel, 512, LDS_BYTES) != hipSuccess || per_cu < 1) { fprintf(stderr, "kernel_launch: occupancy query says %d\n", per_cu); per_cu = 1; }
        (void)hipGetLastError();
        grid = cus;
    }
    if (grid < 0) return;
    if (hipMemsetAsync(d_ws, 0, 65536, stream) != hipSuccess) { fprintf(stderr, "kernel_launch: hipMemsetAsync failed\n"); return; }
    Args a{};
    for (int i = 0; i < 16; ++i) a.in[i] = (const float*)d_in[i];
    a.out = (float*)d_out; a.ws = (unsigned char*)d_ws;
    if (MK_N_LAUNCHES == 1) {
        a.ph_lo = 0; a.ph_hi = NPHASE; a.coop = 1; void* kargs[] = {&a};
        hipError_t e = hipLaunchCooperativeKernel((const void*)fwd_kernel, dim3(grid), dim3(512), kargs, LDS_BYTES, stream);
        if (e != hipSuccess) fprintf(stderr, "kernel_launch: cooperative launch failed: %s (grid %d)\n", hipGetErrorString(e), grid);
    } else {
        for (int p = 0; p < NPHASE; ++p) { a.ph_lo = p; a.ph_hi = p + 1; a.coop = 0; hipLaunchKernelGGL(fwd_kernel, dim3(grid), dim3(512), LDS_BYTES, stream, a); }
        const hipError_t le = hipPeekAtLastError(); if (le != hipSuccess) fprintf(stderr, "kernel_launch: launch failed: %s\n", hipGetErrorName(le));
    }
}
```

```cpp
#include <hip/hip_runtime.h>
#include <hip/hip_cooperative_groups.h>
#include <cstdio>
#include <cstdint>
namespace cg = cooperative_groups;
namespace pg8 {
#define PG8_LAS __attribute__((address_space(3)))
typedef unsigned short bf16_t;
typedef short bf16x8 __attribute__((ext_vector_type(8)));
typedef float f32x4 __attribute__((ext_vector_type(4)));
typedef unsigned u32x4 __attribute__((ext_vector_type(4)));
constexpr int BM = 256, BK = 64, HALF = 128, HTB = HALF * BK * 2  , STAGE_BYTES = 8 * HTB, NXCD = 8, WGM = 8;

__host__ __device__ __forceinline__ int lds_byte(int r, int c) { const int st = (r >> 4) * 2 + (c >> 5), rr = r & 15, cc = c & 31, ob = rr * 64 + cc * 2; return st * 1024 + (ob ^ (((ob >> 9) & 1) << 5)); }
__host__ __device__ __forceinline__ void stage_rc(int b, int& R, int& C) { const int st = b / 1024, sb = b % 1024, swz = sb ^ (((sb >> 9) & 1) << 5); R = (st >> 1) * 16 + swz / 64; C = (st & 1) * 32 + (swz % 64) / 2; }
__host__ __device__ __forceinline__ int perm32(int rho) { const int n = rho >> 4, i = rho & 15; return 8 * (i >> 2) + 4 * n + (i & 3); }

struct Unit { int pm, pn; };
struct Gemm { const bf16_t* A; const bf16_t* Bt; int M, N, K; };

struct StaticOrder {
    int nM, nN, nwg, G, c;
    __host__ __device__ void init(int M, int N, int G_, int c_) { nM = M / BM; nN = N / BM; nwg = nM * nN; G = G_; c = c_; }
    __host__ __device__ bool next(int i, Unit& u) const {
        const long L = (long)i * G + c; if (L >= nwg) return false;
        int wgid = (int)L; { const int q = nwg / NXCD, r = nwg % NXCD, xcd = wgid % NXCD, off = wgid / NXCD; wgid = (xcd < r ? xcd * (q + 1) : r * (q + 1) + (xcd - r) * q) + off; }
        const int nig = WGM * nN, gid = wgid / nig, fm = gid * WGM, gsz = (nM - fm) < WGM ? (nM - fm) : WGM;
        u.pm = fm + ((wgid % nig) % gsz); u.pn = (wgid % nig) / gsz; return true;
    }
    __device__ __forceinline__ void a_ready(const Unit&) const {}
    __device__ __forceinline__ void done(const Unit&) const {}
};
__device__ __forceinline__ unsigned cvt_pk_bf16(float lo, float hi) { unsigned r; asm volatile("v_cvt_pk_bf16_f32 %0, %1, %2" : "=v"(r) : "v"(lo), "v"(hi)); return r; }
typedef int i32x4 __attribute__((ext_vector_type(4)));
template <bool I8> struct AccT { typedef f32x4 type; };
template <> struct AccT<true> { typedef i32x4 type; };
struct EpiRowScaleBf16 {
    static constexpr bool PERM = true, AFTER_DRAIN = false;
    bf16_t* O; int ldc; const float* rs;
    __device__ __forceinline__ void operator()(const f32x4 (&acc)[2][2][4][2], const Unit& u, int wr, int wc, int fr, int fq) const {
        const int row0 = u.pm * BM + wr * 64 + fr, col0 = u.pn * BM + wc * 32 + 8 * fq;
#pragma unroll
        for (int ai = 0; ai < 2; ++ai)
#pragma unroll
            for (int m = 0; m < 4; ++m) { const int row = row0 + ai * HALF + m * 16; const float s = rs ? rs[row] : 1.f; bf16_t* rowp = O + (size_t)row * ldc + col0;
#pragma unroll
                for (int bj = 0; bj < 2; ++bj) { const f32x4 v0 = acc[ai][bj][m][0] * s, v1 = acc[ai][bj][m][1] * s;
                    u32x4 w; w.x = cvt_pk_bf16(v0[0], v0[1]); w.y = cvt_pk_bf16(v0[2], v0[3]); w.z = cvt_pk_bf16(v1[0], v1[1]); w.w = cvt_pk_bf16(v1[2], v1[3]);
                    *(u32x4*)(rowp + bj * HALF) = w; } }
    }
};
struct EpiI8Qk {
    static constexpr bool PERM = true, AFTER_DRAIN = false;
    bf16_t* O; int ldc; const float* rs; const float* cs; const float* qg; const float* kg; PG8_LAS float* P; int qk_lo, q_hi, qk_hi, seqmask; float qscale;
    __device__ __forceinline__ void operator()(const i32x4 (&acc)[2][2][4][2], const Unit& u, int wr, int wc, int fr, int fq) const {
        const int row0 = u.pm * BM + wr * 64 + fr, col0 = u.pn * BM + wc * 32 + 8 * fq;
        f32x4 cv[2][2];
#pragma unroll
        for (int bj = 0; bj < 2; ++bj) { cv[bj][0] = *(const f32x4*)(cs + col0 + bj * HALF); cv[bj][1] = *(const f32x4*)(cs + col0 + bj * HALF + 4); }
        const bool qk = u.pn >= qk_lo && u.pn < qk_hi;
        float rq[2][4][2];
        if (qk) {
#pragma unroll
            for (int ai = 0; ai < 2; ++ai)
#pragma unroll
                for (int m = 0; m < 4; ++m) { const float s = rs[row0 + ai * HALF + m * 16]; const int rl = ai * HALF + wr * 64 + m * 16 + fr;
#pragma unroll
                    for (int bj = 0; bj < 2; ++bj) { const i32x4 a0 = acc[ai][bj][m][0], a1 = acc[ai][bj][m][1]; const f32x4 c0 = cv[bj][0] * s, c1 = cv[bj][1] * s; float ss = 0.f;
#pragma unroll
                        for (int i = 0; i < 4; ++i) { const float x0 = (float)a0[i] * c0[i], x1 = (float)a1[i] * c1[i]; ss += x0 * x0 + x1 * x1; }
                        ss += __shfl_xor(ss, 16); ss += __shfl_xor(ss, 32);
                        if (fq == 0) P[rl * 8 + bj * 4 + wc] = ss; } }
            asm volatile("s_waitcnt lgkmcnt(0)" ::: "memory"); __builtin_amdgcn_s_barrier(); asm volatile("" ::: "memory");
#pragma unroll
            for (int ai = 0; ai < 2; ++ai)
#pragma unroll
                for (int m = 0; m < 4; ++m) { const int rl = ai * HALF + wr * 64 + m * 16 + fr;
#pragma unroll
                    for (int bj = 0; bj < 2; ++bj) { const f32x4 p = *(const PG8_LAS f32x4*)(P + rl * 8 + bj * 4); rq[ai][m][bj] = __builtin_amdgcn_rsqf(((p[0] + p[1]) + (p[2] + p[3])) * (1.f / 128.f) + 1e-6f); } }
        }
        const bool isq = u.pn < q_hi; const float* gp = (isq ? qg : kg) + wc * 32 + 8 * fq; f32x4 g0 = {1.f, 1.f, 1.f, 1.f}, g1 = g0;
        if (qk) { g0 = *(const f32x4*)gp; g1 = *(const f32x4*)(gp + 4); if (isq) { g0 = g0 * qscale; g1 = g1 * qscale; } }
        constexpr float RV[16] = {1.591549431e-01f, 7.008652159e-02f, 3.086376340e-02f, 1.359137064e-02f, 5.985185713e-03f, 2.635675899e-03f, 1.160663641e-03f, 5.111175045e-04f, 2.250790790e-04f, 9.911730937e-05f, 4.364795279e-05f, 1.922110068e-05f, 8.464330808e-06f, 3.727408602e-06f, 1.641426263e-06f, 7.228293069e-07f};
#pragma unroll
        for (int ai = 0; ai < 2; ++ai)
#pragma unroll
            for (int m = 0; m < 4; ++m) { const int row = row0 + ai * HALF + m * 16; const float s = rs[row]; bf16_t* rowp = O + (size_t)row * ldc + col0;
                float cs8[8], sn8[8];
                if (qk && wc == 0) { const float pos = (float)(row & seqmask);
#pragma unroll
                    for (int e8 = 0; e8 < 8; ++e8) { const float rev = pos * ((fq & 1) ? RV[8 + e8] : RV[e8]); const float fr_ = rev - __builtin_floorf(rev); cs8[e8] = __builtin_amdgcn_cosf(fr_); sn8[e8] = __builtin_amdgcn_sinf(fr_); } }
#pragma unroll
                for (int bj = 0; bj < 2; ++bj) { const i32x4 a0 = acc[ai][bj][m][0], a1 = acc[ai][bj][m][1]; const float sq = qk ? s * rq[ai][m][bj] : s; const f32x4 c0 = cv[bj][0] * sq * g0, c1 = cv[bj][1] * sq * g1;
                    float v[8];
#pragma unroll
                    for (int i = 0; i < 4; ++i) { v[i] = (float)a0[i] * c0[i]; v[4 + i] = (float)a1[i] * c1[i]; }
                    if (qk && wc == 0) {
#pragma unroll
                        for (int e8 = 0; e8 < 8; ++e8) { const float pr = __shfl_xor(v[e8], 32); v[e8] = (fq < 2) ? (v[e8] * cs8[e8] - pr * sn8[e8]) : (v[e8] * cs8[e8] + pr * sn8[e8]); } }
                    u32x4 w; w.x = cvt_pk_bf16(v[0], v[1]); w.y = cvt_pk_bf16(v[2], v[3]); w.z = cvt_pk_bf16(v[4], v[5]); w.w = cvt_pk_bf16(v[6], v[7]);
                    *(u32x4*)(rowp + bj * HALF) = w; } }
    }
};
struct EpiResid {
    static constexpr bool PERM = true, AFTER_DRAIN = false;
    const float* x; float* out; bf16_t* xb; float* ssp; int ldc;
    __device__ __forceinline__ void operator()(const f32x4 (&acc)[2][2][4][2], const Unit& u, int wr, int wc, int fr, int fq) const {
        const int row0 = u.pm * BM + wr * 64 + fr, col0 = u.pn * BM + wc * 32 + 8 * fq;
#pragma unroll
        for (int ai = 0; ai < 2; ++ai)
#pragma unroll
            for (int m = 0; m < 4; ++m) { const int row = row0 + ai * HALF + m * 16; const size_t off = (size_t)row * ldc + col0; float ss = 0.f;
#pragma unroll
                for (int bj = 0; bj < 2; ++bj) { const f32x4 xa = *(const f32x4*)(x + off + bj * HALF), xc = *(const f32x4*)(x + off + bj * HALF + 4);
                    const f32x4 v0 = acc[ai][bj][m][0] + xa, v1 = acc[ai][bj][m][1] + xc;
                    u32x4 w; w.x = cvt_pk_bf16(v0[0], v0[1]); w.y = cvt_pk_bf16(v0[2], v0[3]); w.z = cvt_pk_bf16(v1[0], v1[1]); w.w = cvt_pk_bf16(v1[2], v1[3]);
                    *(u32x4*)(xb + off + bj * HALF) = w;
                    ss += (v0[0] * v0[0] + v0[1] * v0[1]) + (v0[2] * v0[2] + v0[3] * v0[3]) + (v1[0] * v1[0] + v1[1] * v1[1]) + (v1[2] * v1[2] + v1[3] * v1[3]); }
                ss += __shfl_xor(ss, 16); ss += __shfl_xor(ss, 32);
                if (fq == 0) ssp[(size_t)row * 32 + u.pn * 4 + wc] = ss; }
    }
};
template <class Epi, class Sched, bool ALIGN_EPI = false, bool SP2 = false, bool I8 = false>
__device__ __forceinline__ void gemm_phase(PG8_LAS unsigned char* lds, const Gemm g, const Sched& S, const Epi& E) {
    const int tid = threadIdx.x, wid = __builtin_amdgcn_readfirstlane(tid >> 6), lane = tid & 63, wr = wid >> 2, wc = wid & 3, fr = lane & 15, fq = lane >> 4;
    const int K = g.K, nt = K / BK;
    unsigned voffA[2], voffB[2];
#pragma unroll
    for (int i = 0; i < 2; ++i) { int R, C; stage_rc(tid * 16 + i * 8192, R, C); const int Rb = Epi::PERM ? ((R & ~31) + perm32(R & 31)) : R;
        voffA[i] = (unsigned)(R * K + C) * 2u; voffB[i] = (unsigned)(Rb * K + C) * 2u; }
    const size_t kstep = (size_t)(BK * 2);
    const size_t hstep = (size_t)HALF * K * 2;
    const size_t tstep = 2 * hstep;
    const unsigned ldsw = (unsigned)wid * 1024u;
    const int aoff = lds_byte(wr * 64 + fr, fq * 8), boff = lds_byte(wc * 32 + fr, fq * 8);
#define PG8_SA(b, h) (((b) * 2 + (h)) * HTB)
#define PG8_SB(b, h) ((4 + (b) * 2 + (h)) * HTB)
#define PG8_STAGE(bufoff, gbase, voff) do { _Pragma("unroll") for (int _i = 0; _i < 2; ++_i) \
        __builtin_amdgcn_global_load_lds((const unsigned*)((const char*)(gbase) + (voff)[_i]), (PG8_LAS unsigned*)(lds + (bufoff) + ldsw + _i * 8192), 16, 0, 0); } while (0)
#define PG8_LDA(dst, b, h) do { _Pragma("unroll") for (int m = 0; m < 4; ++m) _Pragma("unroll") for (int k = 0; k < 2; ++k) dst[m][k] = *(const PG8_LAS bf16x8*)(lds + PG8_SA(b, h) + aoff + m * 2048 + k * 1024); } while (0)
#define PG8_LDB(dst, b, h) do { _Pragma("unroll") for (int n = 0; n < 2; ++n) _Pragma("unroll") for (int k = 0; k < 2; ++k) dst[n][k] = *(const PG8_LAS bf16x8*)(lds + PG8_SB(b, h) + boff + n * 2048 + k * 1024); } while (0)
#define PG8_MMA(ai, bj, At, Bt) do { __builtin_amdgcn_s_setprio(1); _Pragma("unroll") for (int m = 0; m < 4; ++m) _Pragma("unroll") for (int n = 0; n < 2; ++n) _Pragma("unroll") for (int k = 0; k < 2; ++k) { \
        if constexpr (I8) acc[ai][bj][m][n] = __builtin_amdgcn_mfma_i32_16x16x64_i8(__builtin_bit_cast(i32x4, Bt[n][k]), __builtin_bit_cast(i32x4, At[m][k]), acc[ai][bj][m][n], 0, 0, 0); \
        else acc[ai][bj][m][n] = __builtin_amdgcn_mfma_f32_16x16x32_bf16(Bt[n][k], At[m][k], acc[ai][bj][m][n], 0, 0, 0); } __builtin_amdgcn_s_setprio(0); } while (0)
#define PG8_WAIT_V(n) asm volatile("s_waitcnt vmcnt(" #n ")" ::: "memory")
#define PG8_WAIT_L(n) asm volatile("s_waitcnt lgkmcnt(" #n ")" ::: "memory")
#define PG8_BAR __builtin_amdgcn_s_barrier()
#define PG8_SCHED __builtin_amdgcn_sched_barrier(0)
    Unit cur, nxt; int ui = 0;
    if (!S.next(0, cur)) return;
    typename AccT<I8>::type acc[2][2][4][2];
#pragma unroll
    for (int a = 0; a < 2; ++a)
#pragma unroll
        for (int b = 0; b < 2; ++b)
#pragma unroll
            for (int m = 0; m < 4; ++m)
#pragma unroll
                for (int n = 0; n < 2; ++n) acc[a][b][m][n] = (typename AccT<I8>::type){};
    bf16x8 At[4][2], B0[2][2], B1[2][2];
    const char* cA = (const char*)g.A + (size_t)cur.pm * tstep; const char* cB = (const char*)g.Bt + (size_t)cur.pn * tstep;
    S.a_ready(cur);
    if constexpr (SP2) {
        PG8_STAGE(PG8_SB(0, 0), cB, voffB); PG8_STAGE(PG8_SB(0, 1), cB + hstep, voffB); PG8_STAGE(PG8_SA(0, 0), cA, voffA); PG8_STAGE(PG8_SA(0, 1), cA + hstep, voffA);
        if (wr == 1) PG8_BAR;
        PG8_WAIT_V(2); PG8_BAR;
        PG8_STAGE(PG8_SB(1, 0), cB + kstep, voffB); PG8_STAGE(PG8_SA(1, 0), cA + kstep, voffA); PG8_STAGE(PG8_SB(1, 1), cB + hstep + kstep, voffB);
        PG8_WAIT_V(6); PG8_BAR;
    } else {
        PG8_STAGE(PG8_SB(0, 0), cB, voffB); PG8_STAGE(PG8_SA(0, 0), cA, voffA); PG8_STAGE(PG8_SB(0, 1), cB + hstep, voffB); PG8_STAGE(PG8_SA(0, 1), cA + hstep, voffA);
        if (wr == 1) PG8_BAR;
        PG8_WAIT_V(4); PG8_BAR;
        PG8_STAGE(PG8_SB(1, 0), cB + kstep, voffB); PG8_STAGE(PG8_SA(1, 0), cA + kstep, voffA); PG8_STAGE(PG8_SB(1, 1), cB + hstep + kstep, voffB);
        PG8_WAIT_V(6); PG8_BAR;
    }
    for (;;) {
        const bool has_next = S.next(ui + 1, nxt);
        const char* nA = has_next ? (const char*)g.A + (size_t)nxt.pm * tstep : cA; const char* nB = has_next ? (const char*)g.Bt + (size_t)nxt.pn * tstep : cB;
        for (int t = 0; t < nt; t += 2) {
            const bool last = (t == nt - 2);
            const char* a1 = cA + (size_t)(t + 1) * kstep;
            const char* a2 = last ? nA : cA + (size_t)(t + 2) * kstep; const char* b2 = last ? nB : cB + (size_t)(t + 2) * kstep;
            const char* a3 = a2 + kstep; const char* b3 = b2 + kstep;
            if (last && has_next) S.a_ready(nxt);
            if constexpr (SP2) {
            PG8_LDB(B0, 0, 0); PG8_LDB(B1, 0, 1); PG8_SCHED; PG8_LDA(At, 0, 0); PG8_STAGE(PG8_SA(1, 1), a1 + hstep, voffA);
            PG8_WAIT_V(8); PG8_WAIT_L(0); PG8_BAR; PG8_MMA(0, 0, At, B0); PG8_MMA(0, 1, At, B1); PG8_BAR; PG8_SCHED;
            PG8_LDA(At, 0, 1); PG8_STAGE(PG8_SB(0, 0), b2, voffB); PG8_STAGE(PG8_SB(0, 1), b2 + hstep, voffB); PG8_STAGE(PG8_SA(0, 0), a2, voffA);
            PG8_WAIT_V(8); PG8_WAIT_L(0); PG8_BAR; PG8_MMA(1, 0, At, B0); PG8_MMA(1, 1, At, B1); PG8_BAR; PG8_SCHED;
            PG8_LDB(B0, 1, 0); PG8_LDB(B1, 1, 1); PG8_SCHED; PG8_LDA(At, 1, 0); PG8_STAGE(PG8_SA(0, 1), a2 + hstep, voffA);
            PG8_WAIT_V(8); PG8_WAIT_L(0); PG8_BAR; PG8_MMA(0, 0, At, B0); PG8_MMA(0, 1, At, B1); PG8_BAR; PG8_SCHED;
            PG8_LDA(At, 1, 1); PG8_STAGE(PG8_SB(1, 0), b3, voffB); PG8_STAGE(PG8_SB(1, 1), b3 + hstep, voffB); PG8_STAGE(PG8_SA(1, 0), a3, voffA);
            PG8_WAIT_V(8); PG8_WAIT_L(0); PG8_BAR; PG8_MMA(1, 0, At, B0); PG8_MMA(1, 1, At, B1); PG8_BAR; PG8_SCHED;
            } else {
            PG8_LDB(B0, 0, 0); PG8_SCHED; PG8_LDA(At, 0, 0); PG8_STAGE(PG8_SA(1, 1), a1 + hstep, voffA);
            PG8_WAIT_L(8); PG8_BAR; PG8_WAIT_L(0); PG8_MMA(0, 0, At, B0); PG8_BAR; PG8_SCHED;
            PG8_LDB(B1, 0, 1); PG8_STAGE(PG8_SB(0, 0), b2, voffB);
            PG8_BAR; PG8_WAIT_L(0); PG8_MMA(0, 1, At, B1); PG8_BAR;
            PG8_LDA(At, 0, 1); PG8_STAGE(PG8_SA(0, 0), a2, voffA);
            PG8_BAR; PG8_WAIT_L(0); PG8_MMA(1, 0, At, B0); PG8_BAR; PG8_SCHED;
            PG8_STAGE(PG8_SB(0, 1), b2 + hstep, voffB);
            PG8_WAIT_V(6); PG8_BAR; PG8_MMA(1, 1, At, B1); PG8_BAR;
            PG8_LDB(B0, 1, 0); PG8_SCHED; PG8_LDA(At, 1, 0); PG8_STAGE(PG8_SA(0, 1), a2 + hstep, voffA);
            PG8_WAIT_L(8); PG8_BAR; PG8_WAIT_L(0); PG8_MMA(0, 0, At, B0); PG8_BAR; PG8_SCHED;
            PG8_LDB(B1, 1, 1); PG8_STAGE(PG8_SB(1, 0), b3, voffB);
            PG8_BAR; PG8_WAIT_L(0); PG8_MMA(0, 1, At, B1); PG8_BAR;
            PG8_LDA(At, 1, 1); PG8_STAGE(PG8_SA(1, 0), a3, voffA);
            PG8_BAR; PG8_WAIT_L(0); PG8_MMA(1, 0, At, B0); PG8_BAR; PG8_SCHED;
            PG8_STAGE(PG8_SB(1, 1), b3 + hstep, voffB);
            PG8_WAIT_V(6); PG8_BAR; PG8_MMA(1, 1, At, B1); PG8_BAR;
            }
        }
        if constexpr (ALIGN_EPI) { if (wr == 0) PG8_BAR; }
        if constexpr (!Epi::AFTER_DRAIN) { E(acc, cur, wr, wc, fr, fq); S.done(cur); }
        if (!has_next) break;
#pragma unroll
        for (int a = 0; a < 2; ++a)
#pragma unroll
            for (int b = 0; b < 2; ++b)
#pragma unroll
                for (int m = 0; m < 4; ++m)
#pragma unroll
                    for (int n = 0; n < 2; ++n) acc[a][b][m][n] = (typename AccT<I8>::type){};
        cur = nxt; cA = nA; cB = nB; ++ui;
        if constexpr (ALIGN_EPI) { if (wr == 1) PG8_BAR; }
    }
    PG8_WAIT_V(0);
    if constexpr (!ALIGN_EPI) { if (wr == 0) PG8_BAR; }
    PG8_BAR;
    if constexpr (Epi::AFTER_DRAIN) { E.fused(acc, cur, wr, wc, fr, fq, lds, wid, lane); S.done(cur); }
#undef PG8_SA
#undef PG8_SB
#undef PG8_STAGE
#undef PG8_LDA
#undef PG8_LDB
#undef PG8_MMA
#undef PG8_WAIT_V
#undef PG8_WAIT_L
#undef PG8_BAR
#undef PG8_SCHED
}
}
#ifndef PG8_SP2
#define PG8_SP2 true
#endif
#ifndef PG8_ALIGN
#define PG8_ALIGN true
#endif

constexpr int BATCH = 2, SEQ = 16384, DM = 2048, T = BATCH * SEQ;
constexpr int INW = 6176, HP = 6400;
constexpr int C_QA = 0, C_KA = 256, C_VA = 512, C_RA = 1024, C_QD = 1536, C_KD = 3072, C_VD = 4608, C_GF = 6144;
constexpr int NHD = 12;
constexpr float EPS = 1e-6f;
constexpr float LOG2E = 1.4426950408889634f;
constexpr float QSCALE = 0.08838834764831845f * LOG2E;
constexpr int NPHASE = 11;

constexpr size_t MiB = 1u << 20;
constexpr size_t WS_CTL = 0, WS_ROPE = 1 * MiB, WS_RS1 = 3 * MiB, WS_RS2 = 3 * MiB + 512 * 1024, WS_SSP = 4 * MiB, WS_WIN = 8 * MiB, WS_WO = 33 * MiB, WS_WQ = 41 * MiB,
                 WS_SK = 49 * MiB, WS_DEC = 50 * MiB, WS_LP = 51 * MiB, WS_IDX = 56 * MiB, WS_GATE = 72 * MiB, WS_DOWN = 88 * MiB, WS_UP = 152 * MiB, WS_XB = 216 * MiB,
                 WS_H = 344 * MiB, WS_X1B = WS_H, WS_QRY = WS_H + 128 * MiB, WS_OP1 = 744 * MiB, WS_OP2 = 840 * MiB, WS_PART = 472 * MiB  , WS_END = 984 * MiB;
constexpr size_t OUT_ST = 0, OUT_OP0 = 128 * MiB;
constexpr int LDS_BYTES = 147456;

#define LAS __attribute__((address_space(3)))
typedef unsigned short bf16_t;
typedef short bf16x8 __attribute__((ext_vector_type(8)));
typedef short s16x4 __attribute__((ext_vector_type(4)));
typedef float f32x4 __attribute__((ext_vector_type(4)));
typedef float f32x2 __attribute__((ext_vector_type(2)));
typedef float f32x16 __attribute__((ext_vector_type(16)));
typedef unsigned u32x4 __attribute__((ext_vector_type(4)));
typedef unsigned u32x2 __attribute__((ext_vector_type(2)));
#define LDS_WAIT() asm volatile("s_waitcnt lgkmcnt(0)" ::: "memory")
#define SBAR() __builtin_amdgcn_sched_barrier(0)

__device__ __forceinline__ float bf2f(unsigned short b) { return __uint_as_float(((unsigned)b) << 16); }
__device__ __forceinline__ float bflo(unsigned w) { return __uint_as_float(w << 16); }
__device__ __forceinline__ float bfhi(unsigned w) { return __uint_as_float(w & 0xffff0000u); }
__device__ __forceinline__ unsigned f2bf(float f) { unsigned u = __float_as_uint(f); return (u + 0x7fffu + ((u >> 16) & 1u)) >> 16; }
__device__ __forceinline__ unsigned pk2(float lo, float hi) { return pg8::cvt_pk_bf16(lo, hi); }
__device__ __forceinline__ float fexp(float x) { return __builtin_amdgcn_exp2f(x * LOG2E); }
__device__ __forceinline__ float flog(float x) { return __builtin_amdgcn_logf(x) * 0.6931471805599453f; }
__device__ __forceinline__ float wave_sum(float v) {
#pragma unroll
    for (int o = 1; o < 64; o <<= 1) v += __shfl_xor(v, o);
    return v;
}
__device__ __forceinline__ int crow(int r, int hi) { return (r & 3) + 8 * (r >> 2) + 4 * hi; }

struct Frame {
    LAS unsigned char* lds; char* ldsg; unsigned char* wsb;
    int tid, lane, wave, vcu, G;
    const float *x, *norm1_g, *w_in, *up_f, *bias_f, *up_b, *bias_b, *out_g, *qn_g, *kn_g, *w_out, *norm2_g, *w_query, *sub_keys, *peer_down, *peer_up;
    float* out;
    __device__ __forceinline__ f32x2* rope_() const { return (f32x2*)((f32x2*)(wsb + WS_ROPE)); }
    __device__ __forceinline__ float* rs1_() const { return (float*)((float*)(wsb + WS_RS1)); }
    __device__ __forceinline__ float* rs2_() const { return (float*)((float*)(wsb + WS_RS2)); }
    __device__ __forceinline__ float* ssp_() const { return (float*)((float*)(wsb + WS_SSP)); }
    __device__ __forceinline__ float* dec_() const { return (float*)((float*)(wsb + WS_DEC)); }
    __device__ __forceinline__ float* lp_() const { return (float*)((float*)(wsb + WS_LP)); }
    __device__ __forceinline__ float* gate_() const { return (float*)((float*)(wsb + WS_GATE)); }
    __device__ __forceinline__ short* part_() const { return (short*)(wsb + WS_PART); }
    __device__ __forceinline__ float* sd_() const { return (float*)((float*)(wsb + WS_CTL + 65536)); }
    __device__ __forceinline__ float* su_() const { return (float*)((float*)(wsb + WS_CTL + 131072)); }
    __device__ __forceinline__ float* sx_() const { return (float*)((float*)(wsb + WS_RS2 + 131072)); }
    __device__ __forceinline__ float* csum_() const { return (float*)((float*)(wsb + WS_RS2 + 262144)); }
    __device__ __forceinline__ unsigned char* down8_() const { return (unsigned char*)(wsb + WS_DOWN); }
    __device__ __forceinline__ unsigned char* up8_() const { return (unsigned char*)(wsb + WS_UP); }
    __device__ __forceinline__ unsigned char* xq8_() const { return (unsigned char*)(wsb + WS_XB); }
    __device__ __forceinline__ unsigned char* fq8_() const { return (unsigned char*)(wsb + WS_XB + 64 * MiB); }
    __device__ __forceinline__ unsigned short* idxT_() const { return (unsigned short*)((unsigned short*)(wsb + WS_XB + 72 * MiB)); }
    __device__ __forceinline__ unsigned* fqT_() const { return (unsigned*)((unsigned*)(wsb + WS_XB + 80 * MiB)); }
    __device__ __forceinline__ unsigned short* idx_() const { return (unsigned short*)(wsb + WS_IDX); }
    __device__ __forceinline__ unsigned short* state_() const { return (unsigned short*)((unsigned short*)((unsigned char*)out + OUT_ST)); }
    __device__ __forceinline__ bf16_t* WinT_() const { return (bf16_t*)((bf16_t*)(wsb + WS_WIN)); }
    __device__ __forceinline__ unsigned char* Win8_() const { return (unsigned char*)(wsb + WS_WIN); }
    __device__ __forceinline__ unsigned char* xq1_() const { return (unsigned char*)(wsb + WS_OP1); }
    __device__ __forceinline__ float* sw_() const { return (float*)((float*)(wsb + WS_CTL + 196608)); }
    __device__ __forceinline__ bf16_t* WoT_() const { return (bf16_t*)((bf16_t*)(wsb + WS_WO)); }
    __device__ __forceinline__ bf16_t* WqT_() const { return (bf16_t*)((bf16_t*)(wsb + WS_WQ)); }
    __device__ __forceinline__ bf16_t* SK_() const { return (bf16_t*)((bf16_t*)(wsb + WS_SK)); }
    __device__ __forceinline__ bf16_t* down16_() const { return (bf16_t*)((bf16_t*)(wsb + WS_DOWN)); }
    __device__ __forceinline__ bf16_t* up16_() const { return (bf16_t*)((bf16_t*)(wsb + WS_UP)); }
    __device__ __forceinline__ bf16_t* xb_() const { return (bf16_t*)((bf16_t*)(wsb + WS_XB)); }
    __device__ __forceinline__ bf16_t* mixed_() const { return (bf16_t*)((bf16_t*)(wsb + WS_XB)); }
    __device__ __forceinline__ bf16_t* h_() const { return (bf16_t*)((bf16_t*)(wsb + WS_H)); }
    __device__ __forceinline__ bf16_t* x1b_() const { return (bf16_t*)((bf16_t*)(wsb + WS_X1B)); }
    __device__ __forceinline__ bf16_t* qry_() const { return (bf16_t*)((bf16_t*)(wsb + WS_QRY)); }
    __device__ __forceinline__ bf16_t* op0_() const { return (bf16_t*)((bf16_t*)((unsigned char*)out + OUT_OP0)); }
    __device__ __forceinline__ bf16_t* op1_() const { return (bf16_t*)((bf16_t*)(wsb + WS_OP1)); }
    __device__ __forceinline__ bf16_t* op2_() const { return (bf16_t*)((bf16_t*)(wsb + WS_OP2)); }
};

__device__ __forceinline__ void p0_transpose_item(const float* W, int K, int N, bf16_t* WT, int k0, int n0, int dst_row0, const float* g, LAS float* scr, int lane) {
#pragma unroll 8
    for (int i = 0; i < 32; ++i) { const int kk = 2 * i + (lane >> 5); float w = W[(size_t)(k0 + kk) * N + n0 + (lane & 31)]; if (g) w *= g[k0 + kk]; scr[kk * 33 + (lane & 31)] = w; }
    LDS_WAIT(); asm volatile("" ::: "memory");
    const int c = lane & 7;
#pragma unroll
    for (int j = 0; j < 4; ++j) { const int n = (lane >> 3) + 8 * j; const LAS float* s = scr + (8 * c) * 33 + n;
        u32x4 o; o.x = pk2(s[0 * 33], s[1 * 33]); o.y = pk2(s[2 * 33], s[3 * 33]); o.z = pk2(s[4 * 33], s[5 * 33]); o.w = pk2(s[6 * 33], s[7 * 33]);
        *(u32x4*)(WT + (size_t)(dst_row0 + n) * K + k0 + 8 * c) = o; }
    LDS_WAIT(); asm volatile("" ::: "memory");
}
template <bool isup> __device__ __forceinline__ void peer_quant_row(const Frame& F, int e) {
    const int lane = F.lane; const f32x4* src = (const f32x4*)((isup ? F.peer_up : F.peer_down) + (size_t)e * DM) + lane;
    f32x4 v[8]; float m = 0.f;
#pragma unroll
    for (int j = 0; j < 8; ++j) { v[j] = src[64 * j]; if (!isup) v[j] = v[j] * ((const f32x4*)F.norm2_g)[lane + 64 * j];
        m = fmaxf(fmaxf(m, fmaxf(fabsf(v[j][0]), fabsf(v[j][1]))), fmaxf(fabsf(v[j][2]), fabsf(v[j][3]))); }
#pragma unroll
    for (int o = 1; o < 64; o <<= 1) m = fmaxf(m, __shfl_xor(m, o));
    const float inv = m > 0.f ? 127.f / m : 0.f; unsigned char* dst = isup ? F.up8_() : F.down8_();
#pragma unroll
    for (int j = 0; j < 8; ++j) { unsigned w = 0u;
#pragma unroll
        for (int i = 0; i < 4; ++i) { const int qv = (int)rintf(v[j][i] * inv); w |= ((unsigned)qv & 0xffu) << (8 * i); }
        const int col = 4 * lane + 256 * j; if (isup) *(unsigned*)(dst + (size_t)(col >> 3) * 131072 + (size_t)e * 8 + (col & 7)) = w;
            else *(unsigned*)(dst + ((size_t)(col >> 7) * 16384 + e) * 128 + (col & 127)) = w; }
    if (lane == 0) (isup ? F.su_() : F.sd_())[e] = m * (1.f / 127.f);
}
__device__ __forceinline__ void phase0(const Frame& F) {
    LAS float* scr = (LAS float*)(F.lds + F.wave * 16384);
    const int gw = F.vcu * 8 + F.wave, NGW = F.G * 8, lane = F.lane;
#ifndef P0_DUP
#define P0_DUP 0
#endif
    for (int dupA = 0; dupA < (P0_DUP == 1 ? 2 : 1); ++dupA)
    { LAS float* cmx = (LAS float*)(F.lds + 12288);
      for (int nb = F.vcu; nb < 193; nb += F.G) { const int n0 = nb * 32, drow = nb < 32 ? nb * 32 : (nb == 32 ? C_GF : nb * 32 - 32), kw = F.wave * 256;
        float m = 0.f;
#pragma unroll 16
        for (int i = 0; i < 128; ++i) { const int k = kw + 2 * i + (lane >> 5); m = fmaxf(m, fabsf(F.w_in[(size_t)k * INW + n0 + (lane & 31)] * F.norm1_g[k])); }
        m = fmaxf(m, __shfl_xor(m, 32)); if (lane < 32) cmx[F.wave * 32 + lane] = m;
        __syncthreads();
        if (F.tid < 32) { float mm = 0.f;
#pragma unroll
            for (int w = 0; w < 8; ++w) mm = fmaxf(mm, cmx[w * 32 + F.tid]);
            cmx[256 + F.tid] = mm > 0.f ? 127.f / mm : 0.f; F.sw_()[drow + F.tid] = mm * (1.f / 127.f); }
        __syncthreads();
        for (int ch = 0; ch < 4; ++ch) { const int k0 = kw + 64 * ch;
#pragma unroll 8
            for (int i = 0; i < 32; ++i) { const int kk = 2 * i + (lane >> 5); scr[kk * 33 + (lane & 31)] = F.w_in[(size_t)(k0 + kk) * INW + n0 + (lane & 31)] * F.norm1_g[k0 + kk] * cmx[256 + (lane & 31)]; }
            LDS_WAIT(); asm volatile("" ::: "memory");
            const int c = lane & 7;
#pragma unroll
            for (int j = 0; j < 4; ++j) { const int n = (lane >> 3) + 8 * j; const LAS float* sp = scr + (8 * c) * 33 + n; u32x2 w = {0u, 0u};
#pragma unroll
                for (int i = 0; i < 4; ++i) { w.x |= ((unsigned)(int)rintf(sp[i * 33]) & 0xffu) << (8 * i); w.y |= ((unsigned)(int)rintf(sp[(4 + i) * 33]) & 0xffu) << (8 * i); }
                *(u32x2*)(F.Win8_() + (size_t)(drow + n) * DM + k0 + 8 * c) = w; }
            LDS_WAIT(); asm volatile("" ::: "memory"); }
        __syncthreads(); } }
    constexpr int I_O = 32 * 64, I_Q = 32 * 64;
    for (int dupB = 0; dupB < (P0_DUP == 2 ? 2 : 1); ++dupB)
    for (int it = gw; it < I_O + I_Q; it += NGW) {
        int r = it;
        if (r < I_O) { const int kb = r / 64, nb = r % 64; p0_transpose_item(F.w_out, DM, DM, F.WoT_(), kb * 64, nb * 32, nb * 32, nullptr, scr, lane); continue; }
        r -= I_O;
        { const int kb = r / 64, nb = r % 64; p0_transpose_item(F.w_query, DM, DM, F.WqT_(), kb * 64, nb * 32, nb * 32, F.norm2_g, scr, lane); }
    }
    const size_t gt = (size_t)gw * 64 + lane, NT = (size_t)NGW * 64;
    { u32x4* z = (u32x4*)(F.Win8_() + (size_t)INW * DM); const u32x4 zero = {0u, 0u, 0u, 0u}; for (size_t i = gt; i < (size_t)(HP - INW) * DM / 16; i += NT) z[i] = zero; if (gt < (size_t)(HP - INW)) F.sw_()[INW + gt] = 0.f; }
    for (int dupC = 0; dupC < (P0_DUP == 3 ? 2 : 1); ++dupC) {
    for (int r = gw; r < 16384; r += NGW) peer_quant_row<false>(F, r);
    for (int r = gw; r < 16384; r += NGW) peer_quant_row<true>(F, r); }
    for (size_t i = gt; i < (size_t)8 * 2 * 128 * 128 / 8; i += NT) { const f32x4 a = *(const f32x4*)(F.sub_keys + i * 8), b = *(const f32x4*)(F.sub_keys + i * 8 + 4);
        u32x4 o; o.x = pk2(a[0], a[1]); o.y = pk2(a[2], a[3]); o.z = pk2(b[0], b[1]); o.w = pk2(b[2], b[3]); *(u32x4*)(F.SK_() + i * 8) = o; }
    for (int dupD = 0; dupD < (P0_DUP == 4 ? 2 : 1); ++dupD)
    for (int m = gw; m < T; m += NGW) { const f32x4* xr = (const f32x4*)(F.x + (size_t)m * DM) + lane; f32x4 v[8]; float s = 0.f, mx = 0.f;
#pragma unroll
        for (int j = 0; j < 8; ++j) { v[j] = xr[64 * j]; s += (v[j][0] * v[j][0] + v[j][1] * v[j][1]) + (v[j][2] * v[j][2] + v[j][3] * v[j][3]);
            mx = fmaxf(fmaxf(mx, fmaxf(fabsf(v[j][0]), fabsf(v[j][1]))), fmaxf(fabsf(v[j][2]), fabsf(v[j][3]))); }
        s = wave_sum(s);
#pragma unroll
        for (int o = 1; o < 64; o <<= 1) mx = fmaxf(mx, __shfl_xor(mx, o));
        const float inv = mx > 0.f ? 127.f / mx : 0.f; unsigned* o4 = (unsigned*)(F.xq1_() + (size_t)m * DM) + lane;
#pragma unroll
        for (int j = 0; j < 8; ++j) { unsigned w = 0u;
#pragma unroll
            for (int i = 0; i < 4; ++i) w |= ((unsigned)(int)rintf(v[j][i] * inv) & 0xffu) << (8 * i);
            o4[64 * j] = w; }
        if (lane == 0) F.rs1_()[m] = __builtin_amdgcn_rsqf(s * (1.f / DM) + EPS) * (mx * (1.f / 127.f)); }
    { const double invf[16] = {1.0, 0.44036660267178046, 0.19392274474868576, 0.08539710028576561, 0.03760603093086393, 0.016560440080994446, 0.007292664737217109, 0.003211445994752591,
                               0.001414213562373095, 0.000622772421914596, 0.0002742481756762073, 0.00012076973741146504, 5.318295896944988e-05, 2.341999896140934e-05, 1.031338537721246e-05, 4.5416704806078695e-06};
      for (size_t i = gt; i < (size_t)SEQ * 16; i += NT) { const int pos = (int)(i >> 4), j = (int)(i & 15); double f = 1.0;
#pragma unroll
          for (int q = 0; q < 16; ++q) f = (j == q) ? invf[q] : f;
          const double rev = (double)pos * f * 0.15915494309189535; const float fr = (float)(rev - floor(rev));
          F.rope_()[i] = (f32x2){__builtin_amdgcn_cosf(fr), __builtin_amdgcn_sinf(fr)}; } }
}

__device__ __forceinline__ void qknorm_rope(const Frame& F) {
    const int gw = F.vcu * 8 + F.wave, NGW = F.G * 8, lane = F.lane, c = lane & 15;
    for (long it = gw; it < (long)T * 24 / 4; it += NGW) { const long row = it * 4 + (lane >> 4); const int t = (int)(row / 24), slot = (int)(row % 24);
        bf16_t* p = F.h_() + (size_t)t * HP + C_QD + slot * 128 + 8 * c;
        const u32x4 w = *(const u32x4*)p; float y[8] = {bflo(w.x), bfhi(w.x), bflo(w.y), bfhi(w.y), bflo(w.z), bfhi(w.z), bflo(w.w), bfhi(w.w)};
        float ss = 0.f;
#pragma unroll
        for (int e = 0; e < 8; ++e) ss += y[e] * y[e];
        ss += __shfl_xor(ss, 1); ss += __shfl_xor(ss, 2); ss += __shfl_xor(ss, 4); ss += __shfl_xor(ss, 8);
        const float rq = __builtin_amdgcn_rsqf(ss * (1.f / 128.f) + EPS); const float* g = (slot < 12 ? F.qn_g : F.kn_g) + 8 * c;
        const f32x4 g0 = *(const f32x4*)g, g1 = *(const f32x4*)(g + 4);
#pragma unroll
        for (int e = 0; e < 4; ++e) { y[e] *= rq * g0[e]; y[4 + e] *= rq * g1[e]; }
        const int pos = t & (SEQ - 1);
#pragma unroll
        for (int e = 0; e < 8; ++e) { const float partner = __shfl_xor(y[e], 2);
            if (c < 4) { const f32x2 cs = F.rope_()[(size_t)pos * 16 + 8 * (c & 1) + e]; y[e] = (c < 2) ? (y[e] * cs.x - partner * cs.y) : (y[e] * cs.x + partner * cs.y); } }
        if (slot < 12) {
#pragma unroll
            for (int e = 0; e < 8; ++e) y[e] *= QSCALE; }
        u32x4 o; o.x = pk2(y[0], y[1]); o.y = pk2(y[2], y[3]); o.z = pk2(y[4], y[5]); o.w = pk2(y[6], y[7]); *(u32x4*)p = o; }
}

constexpr int GL_GDS = 0, GL_TOT = 8192, GL_QF = 12288, GL_QB = 21504, GL_KF = 30720, GL_KB = 39936, GL_VT = 49152, GL_P = 67584, GL_SF = 76800, GL_SB = 95232, GL_OB = 12288;
constexpr int RS72 = 144;
__device__ __forceinline__ float logsig(float z) { return fminf(z, 0.f) - flog(1.f + fexp(-fabsf(z))); }
__device__ __forceinline__ void gla_gates(const Frame& F, int b, int hh, int n, float (&bf)[8], float (&bb)[8], float& totf, float& totb) {
    const int tid = F.tid, c = tid & 63, ig = F.wave; LAS float* gds = (LAS float*)(F.lds + GL_GDS); LAS float* tot = (LAS float*)(F.lds + GL_TOT);
    const size_t t0 = (size_t)b * SEQ + (size_t)n * 64;
    if (tid < 256) { const int tk = tid >> 2, part = tid & 3; const u32x4 w = *(const u32x4*)(F.h_() + (t0 + tk) * HP + C_GF + part * 8); LAS float* d = gds + tk * 32 + part * 8;
        d[0] = bflo(w.x); d[1] = bfhi(w.x); d[2] = bflo(w.y); d[3] = bfhi(w.y); d[4] = bflo(w.z); d[5] = bfhi(w.z); d[6] = bflo(w.w); d[7] = bfhi(w.w); }
    __syncthreads();
    const int hc = hh * 64 + c; float upf[16], upb[16];
#pragma unroll
    for (int r = 0; r < 16; ++r) { upf[r] = F.up_f[r * 256 + hc]; upb[r] = F.up_b[r * 256 + hc]; }
    const float biasf = F.bias_f[hc], biasb = F.bias_b[hc]; float laf[8], lab[8];
#pragma unroll
    for (int e = 0; e < 8; ++e) { const LAS float* gr = gds + (ig * 8 + e) * 32; float zf = biasf, zb = biasb;
#pragma unroll
        for (int r = 0; r < 16; ++r) { zf += gr[r] * upf[r]; zb += gr[16 + r] * upb[r]; }
        laf[e] = logsig(zf) * 0.0625f; lab[e] = logsig(zb) * 0.0625f; }
    bf[0] = laf[0];
#pragma unroll
    for (int e = 1; e < 8; ++e) bf[e] = bf[e - 1] + laf[e];
    bb[7] = lab[7];
#pragma unroll
    for (int e = 6; e >= 0; --e) bb[e] = bb[e + 1] + lab[e];
    tot[ig * 64 + c] = bf[7]; tot[512 + ig * 64 + c] = bb[0];
    __syncthreads();
    float offf = 0.f, offb = 0.f; totf = 0.f; totb = 0.f;
#pragma unroll
    for (int g = 0; g < 8; ++g) { const float tf = tot[g * 64 + c], tb = tot[512 + g * 64 + c]; totf += tf; totb += tb; offf += (g < ig) ? tf : 0.f; offb += (g > ig) ? tb : 0.f; }
#pragma unroll
    for (int e = 0; e < 8; ++e) { bf[e] += offf; bb[e] += offb; }
}
__device__ __forceinline__ void gla_stage_vT(const Frame& F, const bf16x8 (&vraw)[2]) {
#pragma unroll
    for (int j = 0; j < 2; ++j) { const int q = F.tid + 512 * j, tk = q >> 4, vc = (q & 15) * 8; LAS short* d = (LAS short*)(F.lds + GL_VT) + vc * 72 + tk;
#pragma unroll
        for (int e = 0; e < 8; ++e) d[e * 72] = vraw[j][e]; }
}
__device__ __forceinline__ bf16x8 ldfrag(const LAS unsigned char* base, int row, int s, int hi) { return *(const LAS bf16x8*)(base + row * RS72 + (16 * s + 8 * hi) * 2); }

__device__ __forceinline__ void gla_passA(const Frame& F, int item) {
    const int bh = item >> 8, n = item & 255, b = bh >> 2, hh = bh & 3, tid = F.tid, c = tid & 63, ig = F.wave, lane = F.lane, r32 = lane & 31, hi = lane >> 5;
    const size_t t0 = (size_t)b * SEQ + (size_t)n * 64;
    unsigned short kraw[8]; bf16x8 vraw[2];
#pragma unroll
    for (int e = 0; e < 8; ++e) kraw[e] = F.h_()[(t0 + ig * 8 + e) * HP + C_KA + hh * 64 + c];
#pragma unroll
    for (int j = 0; j < 2; ++j) { const int q = tid + 512 * j; vraw[j] = *(const bf16x8*)(F.h_() + (t0 + (q >> 4)) * HP + C_VA + hh * 128 + (q & 15) * 8); }
    float bf[8], bb[8], totf, totb; gla_gates(F, b, hh, n, bf, bb, totf, totb);
    float kf[8], kb[8];
#pragma unroll
    for (int e = 0; e < 8; ++e) { const float k = bf2f(kraw[e]); kf[e] = k * fexp(totf - bf[e]); kb[e] = k * fexp(totb - bb[e]); }
    { u32x4 o; o.x = pk2(kf[0], kf[1]); o.y = pk2(kf[2], kf[3]); o.z = pk2(kf[4], kf[5]); o.w = pk2(kf[6], kf[7]); *(LAS u32x4*)(F.lds + GL_KF + c * RS72 + ig * 16) = o;
      o.x = pk2(kb[0], kb[1]); o.y = pk2(kb[2], kb[3]); o.z = pk2(kb[4], kb[5]); o.w = pk2(kb[6], kb[7]); *(LAS u32x4*)(F.lds + GL_KB + c * RS72 + ig * 16) = o; }
    gla_stage_vT(F, vraw);
    if (ig == 0) { F.dec_()[((size_t)(0 * 8 + bh) * 256 + n) * 64 + c] = fexp(totf); F.dec_()[((size_t)(1 * 8 + bh) * 256 + n) * 64 + c] = fexp(totb); }
    __syncthreads();
    const int dir = F.wave >> 2, vt = F.wave & 3; const LAS unsigned char* kimg = F.lds + (dir ? GL_KB : GL_KF);
    f32x16 a0 = {}, a1 = {};
#pragma unroll
    for (int s = 0; s < 4; ++s) { const bf16x8 av = ldfrag(F.lds + GL_VT, 32 * vt + r32, s, hi), b0 = ldfrag(kimg, r32, s, hi), b1 = ldfrag(kimg, 32 + r32, s, hi);
        a0 = __builtin_amdgcn_mfma_f32_32x32x16_bf16(av, b0, a0, 0, 0, 0); a1 = __builtin_amdgcn_mfma_f32_32x32x16_bf16(av, b1, a1, 0, 0, 0); }
    unsigned short* st = F.state_() + ((size_t)(dir * 8 + bh) * 256 + n) * 8192;
#pragma unroll
    for (int r = 0; r < 16; ++r) { const int v = 32 * vt + crow(r, hi); st[v * 64 + r32] = (unsigned short)f2bf(a0[r]); st[v * 64 + 32 + r32] = (unsigned short)f2bf(a1[r]); }
    __syncthreads();
}
__device__ __forceinline__ void gla_scan(const Frame& F, int item) {
    const int dir = item >> 7, bh = (item >> 4) & 7, e = (item & 15) * 512 + F.tid, c = e & 63;
    unsigned short* st = F.state_() + (size_t)(dir * 8 + bh) * 256 * 8192 + e; const float* dc = F.dec_() + (size_t)(dir * 8 + bh) * 256 * 64 + c; float S = 0.f;
    float iA[16], dA[16], iB[16], dB[16];
#define SC_N(g, j) (dir ? 255 - ((g) * 16 + (j)) : (g) * 16 + (j))
#define SC_LOAD(I_, D_, g) do { _Pragma("unroll") for (int j = 0; j < 16; ++j) { const int n_ = SC_N(g, j); I_[j] = bf2f(st[(size_t)n_ * 8192]); D_[j] = dc[n_ * 64]; } } while (0)
#define SC_RUN(I_, D_, g) do { _Pragma("unroll") for (int j = 0; j < 16; ++j) { const int n_ = SC_N(g, j); st[(size_t)n_ * 8192] = (unsigned short)f2bf(S); S = D_[j] * S + I_[j]; } } while (0)
    SC_LOAD(iA, dA, 0);
    for (int g = 0; g < 16; g += 2) { SC_LOAD(iB, dB, g + 1); SC_RUN(iA, dA, g); if (g + 2 < 16) SC_LOAD(iA, dA, g + 2); SC_RUN(iB, dB, g + 1); }
#undef SC_N
#undef SC_LOAD
#undef SC_RUN
}
__device__ __forceinline__ void gla_passC(const Frame& F, int item) {
    const int bh = item >> 8, n = item & 255, b = bh >> 2, hh = bh & 3, tid = F.tid, c = tid & 63, ig = F.wave, lane = F.lane, r32 = lane & 31, hi = lane >> 5;
    const size_t t0 = (size_t)b * SEQ + (size_t)n * 64;
    unsigned short qraw[8], kraw[8]; bf16x8 vraw[2]; u32x4 sraw[2][2];
#pragma unroll
    for (int e = 0; e < 8; ++e) { const bf16_t* hr = F.h_() + (t0 + ig * 8 + e) * HP + hh * 64 + c; qraw[e] = hr[C_QA]; kraw[e] = hr[C_KA]; }
#pragma unroll
    for (int j = 0; j < 2; ++j) { const int q = tid + 512 * j; vraw[j] = *(const bf16x8*)(F.h_() + (t0 + (q >> 4)) * HP + C_VA + hh * 128 + (q & 15) * 8);
#pragma unroll
        for (int dir = 0; dir < 2; ++dir) sraw[dir][j] = *(const u32x4*)(F.state_() + ((size_t)(dir * 8 + bh) * 256 + n) * 8192 + (q >> 3) * 64 + (q & 7) * 8); }
    float bf[8], bb[8], totf, totb; gla_gates(F, b, hh, n, bf, bb, totf, totb);
#pragma unroll
    for (int e = 0; e < 8; ++e) { const int i = ig * 8 + e; const float q = bf2f(qraw[e]) * 0.125f, k = bf2f(kraw[e]);
        const float ef = fexp(bf[e]), eb = fexp(bb[e]), nf = fexp(-bf[e]), nb = fexp(-bb[e]);
        *(LAS unsigned short*)(F.lds + GL_QF + i * RS72 + c * 2) = (unsigned short)f2bf(q * ef); *(LAS unsigned short*)(F.lds + GL_QB + i * RS72 + c * 2) = (unsigned short)f2bf(q * eb);
        *(LAS unsigned short*)(F.lds + GL_KF + i * RS72 + c * 2) = (unsigned short)f2bf(k * nf); *(LAS unsigned short*)(F.lds + GL_KB + i * RS72 + c * 2) = (unsigned short)f2bf(k * nb); }
    gla_stage_vT(F, vraw);
#pragma unroll
    for (int dir = 0; dir < 2; ++dir)
#pragma unroll
        for (int j = 0; j < 2; ++j) { const int q = tid + 512 * j; *(LAS u32x4*)(F.lds + (dir ? GL_SB : GL_SF) + (q >> 3) * RS72 + (q & 7) * 16) = sraw[dir][j]; }
    __syncthreads();
    if (F.wave < 4) { const int ti = F.wave >> 1, tj = F.wave & 1; f32x16 sf = {}, sb = {};
#pragma unroll
        for (int s = 0; s < 4; ++s) {
            sf = __builtin_amdgcn_mfma_f32_32x32x16_bf16(ldfrag(F.lds + GL_QF, 32 * ti + r32, s, hi), ldfrag(F.lds + GL_KF, 32 * tj + r32, s, hi), sf, 0, 0, 0);
            sb = __builtin_amdgcn_mfma_f32_32x32x16_bf16(ldfrag(F.lds + GL_QB, 32 * ti + r32, s, hi), ldfrag(F.lds + GL_KB, 32 * tj + r32, s, hi), sb, 0, 0, 0); }
#pragma unroll
        for (int r = 0; r < 16; ++r) { const int i = 32 * ti + crow(r, hi), j = 32 * tj + r32; const float p = (j <= i) ? sf[r] : sb[r];
            *(LAS unsigned short*)(F.lds + GL_P + i * RS72 + j * 2) = (unsigned short)f2bf(p); } }
    __syncthreads();
    const int ti = F.wave & 1, tv = F.wave >> 1; f32x16 o = {};
#pragma unroll
    for (int s = 0; s < 4; ++s) o = __builtin_amdgcn_mfma_f32_32x32x16_bf16(ldfrag(F.lds + GL_P, 32 * ti + r32, s, hi), ldfrag(F.lds + GL_VT, 32 * tv + r32, s, hi), o, 0, 0, 0);
#pragma unroll
    for (int s = 0; s < 4; ++s) o = __builtin_amdgcn_mfma_f32_32x32x16_bf16(ldfrag(F.lds + GL_QF, 32 * ti + r32, s, hi), ldfrag(F.lds + GL_SF, 32 * tv + r32, s, hi), o, 0, 0, 0);
#pragma unroll
    for (int s = 0; s < 4; ++s) o = __builtin_amdgcn_mfma_f32_32x32x16_bf16(ldfrag(F.lds + GL_QB, 32 * ti + r32, s, hi), ldfrag(F.lds + GL_SB, 32 * tv + r32, s, hi), o, 0, 0, 0);
    __syncthreads();
    LAS float* ob = (LAS float*)(F.lds + GL_OB);
#pragma unroll
    for (int r = 0; r < 16; ++r) ob[(32 * ti + crow(r, hi)) * 132 + 32 * tv + r32] = o[r];
    __syncthreads();
    { const int i = tid >> 3, part = tid & 7, v0 = part * 16; float ov[16], ss = 0.f;
#pragma unroll
      for (int e = 0; e < 16; ++e) { ov[e] = ob[i * 132 + v0 + e]; ss += ov[e] * ov[e]; }
      ss += __shfl_xor(ss, 1); ss += __shfl_xor(ss, 2); ss += __shfl_xor(ss, 4);
      const float rs = __builtin_amdgcn_rsqf(ss * (1.f / 128.f) + EPS); const size_t tok = t0 + i;
      const u32x4 r0 = *(const u32x4*)(F.h_() + tok * HP + C_RA + hh * 128 + v0), r1 = *(const u32x4*)(F.h_() + tok * HP + C_RA + hh * 128 + v0 + 8);
      const float rr[16] = {bflo(r0.x), bfhi(r0.x), bflo(r0.y), bfhi(r0.y), bflo(r0.z), bfhi(r0.z), bflo(r0.w), bfhi(r0.w), bflo(r1.x), bfhi(r1.x), bflo(r1.y), bfhi(r1.y), bflo(r1.z), bfhi(r1.z), bflo(r1.w), bfhi(r1.w)};
      float y[16];
#pragma unroll
      for (int e = 0; e < 16; ++e) { const float g = F.out_g[hh * 128 + v0 + e]; const float sil = rr[e] * __builtin_amdgcn_rcpf(1.f + fexp(-rr[e])); y[e] = ov[e] * rs * g * sil; }
      u32x4 w0, w1; w0.x = pk2(y[0], y[1]); w0.y = pk2(y[2], y[3]); w0.z = pk2(y[4], y[5]); w0.w = pk2(y[6], y[7]); w1.x = pk2(y[8], y[9]); w1.y = pk2(y[10], y[11]); w1.z = pk2(y[12], y[13]); w1.w = pk2(y[14], y[15]);
      bf16_t* mp = F.mixed_() + tok * DM + hh * 128 + v0; *(u32x4*)mp = w0; *(u32x4*)(mp + 8) = w1; }
    __syncthreads();
}

constexpr int AT_V = 0, AT_K = 32768, AT_O = 65536;
#define KSWZ(row, colB) ((row) * 256 + ((colB) ^ (((row) & 7) << 4)))
__device__ __forceinline__ int v_st(int k, int c) { const int kk = (k & ~0xC) | ((k & 4) << 1) | ((k & 8) >> 1); return ((kk >> 3) * 4 + (c >> 5)) * 512 + ((kk & 7) * 32 + (c & 31)) * 2; }
__device__ __forceinline__ int v_rd_base(int lane) { return ((lane & 3) << 3) | (((lane >> 2) & 3) << 6) | (((lane >> 4) & 1) << 5) | (((lane >> 5) & 1) << 8); }
constexpr int v_rd_off(int d0, int ks, int half) { return d0 * 512 + ks * 4096 + half * 2048; }
template <int OFF> __device__ __forceinline__ s16x4 tr_read(int vb) { s16x4 r; asm volatile("ds_read_b64_tr_b16 %0, %1 offset:%2" : "=&v"(r) : "v"(vb), "i"(OFF) : "memory"); return r; }
template <int D0> __device__ __forceinline__ void pv_one(f32x16& od, int vb, bf16x8 pa0, bf16x8 pa1, bf16x8 pa2, bf16x8 pa3) {
    const s16x4 l0 = tr_read<v_rd_off(D0, 0, 0)>(vb), h0 = tr_read<v_rd_off(D0, 0, 1)>(vb), l1 = tr_read<v_rd_off(D0, 1, 0)>(vb), h1 = tr_read<v_rd_off(D0, 1, 1)>(vb);
    const s16x4 l2 = tr_read<v_rd_off(D0, 2, 0)>(vb), h2 = tr_read<v_rd_off(D0, 2, 1)>(vb), l3 = tr_read<v_rd_off(D0, 3, 0)>(vb), h3 = tr_read<v_rd_off(D0, 3, 1)>(vb);
    asm volatile("s_waitcnt lgkmcnt(0)" ::: "memory"); SBAR();
#define PKV(L, H) (bf16x8){L[0], L[1], L[2], L[3], H[0], H[1], H[2], H[3]}
    od = __builtin_amdgcn_mfma_f32_32x32x16_bf16(pa0, PKV(l0, h0), od, 0, 0, 0);
    od = __builtin_amdgcn_mfma_f32_32x32x16_bf16(pa1, PKV(l1, h1), od, 0, 0, 0);
    od = __builtin_amdgcn_mfma_f32_32x32x16_bf16(pa2, PKV(l2, h2), od, 0, 0, 0);
    od = __builtin_amdgcn_mfma_f32_32x32x16_bf16(pa3, PKV(l3, h3), od, 0, 0, 0);
#undef PKV
}
struct AtP { size_t tokbase; int dil, m0, Tf, nt, head, p; };
__device__ __forceinline__ AtP at_decode(int item) {
    AtP P; const int p = item / 1536, rem = item % 1536, b = rem / 768, rem2 = rem % 768, u = rem2 & 63; P.p = p; P.head = rem2 >> 6;
    const int dsh = 2 * p, L = SEQ >> dsh, runs = 64 >> dsh, res = u / runs; P.dil = 1 << dsh; P.m0 = (u % runs) * 256; P.tokbase = (size_t)b * SEQ + res;
    const int kt_lo = (P.m0 == 0) ? 1 : 0, kt_hi = (P.m0 + 256 >= L) ? 4 : 5; P.Tf = P.m0 - 64 + 64 * kt_lo; P.nt = kt_hi - kt_lo + 1; return P;
}
__device__ __forceinline__ void attn_phase(const Frame& F) {
    const int tid = F.tid, wid = F.wave, lane = F.lane, r32 = lane & 31, hi = lane >> 5, G = F.G;
    int ntot = 0; for (int it = F.vcu; it < 4608; it += G) ntot += at_decode(it).nt;
    if (ntot == 0) return;
    const int sr = tid >> 4, sc = (tid & 15) * 8, vst0 = v_st(sr, sc), vst1 = v_st(32 + sr, sc), kc = sc * 2;
    const int vb0 = (int)(unsigned)(uintptr_t)(F.ldsg + AT_V) + v_rd_base(lane);
    int it_ld = F.vcu, rl = 0, it_c = F.vcu, rc = 0; AtP ld = at_decode(it_ld), cur = ld;
    bf16x8 qr[8], qn[8]; f32x16 o[4]; float l_reg = 0.f;
    bf16x8 sA0, sA1, sA2, sA3;
#define AT_QLOAD() do { const bf16_t* qp_ = F.h_() + C_QD + ld.head * 128 + (ld.tokbase + (size_t)ld.dil * (ld.m0 + 32 * wid + r32)) * HP + hi * 8; \
        _Pragma("unroll") for (int d0 = 0; d0 < 8; ++d0) qn[d0] = *(const bf16x8*)(qp_ + d0 * 16); } while (0)
#define AT_SLOAD(S) do { const int T0_ = ld.Tf + 64 * rl; const size_t ra = (ld.tokbase + (size_t)ld.dil * (T0_ + sr)) * HP + ld.head * 128 + sc, rb = ra + (size_t)ld.dil * 32 * HP; \
        S##0 = *(const bf16x8*)(F.h_() + C_VD + ra); S##1 = *(const bf16x8*)(F.h_() + C_VD + rb); S##2 = *(const bf16x8*)(F.h_() + C_KD + ra); S##3 = *(const bf16x8*)(F.h_() + C_KD + rb); \
        if (++rl == ld.nt) { it_ld += G; rl = 0; if (it_ld < 4608) { ld = at_decode(it_ld); AT_QLOAD(); } } } while (0)
#define AT_SWRITE(S, B) do { *(LAS bf16x8*)(F.lds + AT_V + (B) * 16384 + vst0) = S##0; *(LAS bf16x8*)(F.lds + AT_V + (B) * 16384 + vst1) = S##1; \
        *(LAS bf16x8*)(F.lds + AT_K + (B) * 16384 + KSWZ(sr, kc)) = S##2; *(LAS bf16x8*)(F.lds + AT_K + (B) * 16384 + KSWZ(32 + sr, kc)) = S##3; } while (0)
#define PK4(P, BASE, OUT) do { unsigned a0_ = pk2(P[BASE + 0], P[BASE + 1]), a1_ = pk2(P[BASE + 2], P[BASE + 3]); unsigned b0_ = pk2(P[BASE + 4], P[BASE + 5]), b1_ = pk2(P[BASE + 6], P[BASE + 7]); \
        auto r0_ = __builtin_amdgcn_permlane32_swap(a0_, b0_, false, false); auto r1_ = __builtin_amdgcn_permlane32_swap(a1_, b1_, false, false); \
        u32x4 w_ = {r0_[0], r1_[0], r0_[1], r1_[1]}; OUT = __builtin_bit_cast(bf16x8, w_); } while (0)
#define AT_STEP(BUF) do { \
        if (rc == 0) { _Pragma("unroll") for (int d0 = 0; d0 < 8; ++d0) qr[d0] = qn[d0]; _Pragma("unroll") for (int d0 = 0; d0 < 4; ++d0) o[d0] = (f32x16){}; l_reg = 0.f; } \
        const int Q0 = cur.m0 + 32 * wid, T0 = cur.Tf + 64 * rc; \
        if (T0 + 63 >= Q0 - 64 && T0 <= Q0 + 95) {                                        \
            const LAS unsigned char* Ks = F.lds + AT_K + (BUF) * 16384; f32x16 p0 = {}, p1 = {}; \
            _Pragma("unroll") for (int d0 = 0; d0 < 8; ++d0) { const int cb = (d0 * 16 + hi * 8) * 2; \
                const bf16x8 k0 = *(const LAS bf16x8*)(Ks + KSWZ(r32, cb)), k1 = *(const LAS bf16x8*)(Ks + KSWZ(32 + r32, cb)); \
                p0 = __builtin_amdgcn_mfma_f32_32x32x16_bf16(k0, qr[d0], p0, 0, 0, 0); p1 = __builtin_amdgcn_mfma_f32_32x32x16_bf16(k1, qr[d0], p1, 0, 0, 0); } \
            const int dq = T0 - (Q0 + r32); float ps = 0.f;                                \
            _Pragma("unroll") for (int r = 0; r < 16; ++r) { const int e0 = dq + crow(r, hi), e1 = e0 + 32; \
                p0[r] = (e0 >= -64 && e0 <= 64) ? __builtin_amdgcn_exp2f(p0[r]) : 0.f; p1[r] = (e1 >= -64 && e1 <= 64) ? __builtin_amdgcn_exp2f(p1[r]) : 0.f; ps += p0[r] + p1[r]; } \
            l_reg += ps; \
            bf16x8 pa0, pa1, pa2, pa3; PK4(p0, 0, pa0); PK4(p0, 8, pa1); PK4(p1, 0, pa2); PK4(p1, 8, pa3); \
            const int vb = vb0 + (BUF) * 16384; \
            pv_one<0>(o[0], vb, pa0, pa1, pa2, pa3); pv_one<1>(o[1], vb, pa0, pa1, pa2, pa3); pv_one<2>(o[2], vb, pa0, pa1, pa2, pa3); pv_one<3>(o[3], vb, pa0, pa1, pa2, pa3); } \
        if (++rc == cur.nt) {                                                             \
            unsigned char* Op = (cur.p == 0 ? (unsigned char*)F.out + OUT_OP0 : F.wsb + (cur.p == 1 ? WS_OP1 : WS_OP2)); \
            const float lt = l_reg + __shfl_xor(l_reg, 32); \
            LAS unsigned char* stg = F.lds + AT_O + wid * 8192; \
            if (hi == 0) { F.lp_()[((size_t)cur.p * T + cur.tokbase + (size_t)cur.dil * (Q0 + r32)) * NHD + cur.head] = lt; *(LAS float*)(stg + 4096 + r32 * 4) = lt; } \
            LDS_WAIT(); asm volatile("" ::: "memory"); \
            float rli[16]; _Pragma("unroll") for (int r = 0; r < 16; ++r) rli[r] = __builtin_amdgcn_rcpf(*(const LAS float*)(stg + 4096 + crow(r, hi) * 4)); \
            _Pragma("unroll") for (int d0 = 0; d0 < 4; ++d0) _Pragma("unroll") for (int r = 0; r < 16; ++r) *(LAS unsigned char*)(stg + crow(r, hi) * 128 + d0 * 32 + r32) = (unsigned char)__builtin_amdgcn_cvt_pk_fp8_f32(o[d0][r] * rli[r], 0.f, 0, false); \
            LDS_WAIT(); asm volatile("" ::: "memory"); \
            _Pragma("unroll") for (int i_ = 0; i_ < 4; ++i_) { const int row = 8 * i_ + (lane >> 3), ch = lane & 7; const u32x4 w = *(const LAS u32x4*)(stg + row * 128 + ch * 16); \
                *(u32x4*)(Op + (cur.tokbase + (size_t)cur.dil * (Q0 + row)) * (NHD * 128) + cur.head * 128 + ch * 16) = w; } \
            LDS_WAIT(); asm volatile("" ::: "memory"); \
            rc = 0; it_c += G; if (it_c < 4608) cur = at_decode(it_c); } } while (0)
    AT_QLOAD();
    AT_SLOAD(sA); AT_SWRITE(sA, 0); AT_SLOAD(sA); __syncthreads();
    for (int g = 0; g < ntot; ++g) { const int buf = g & 1;
        AT_STEP(buf);
        if (g + 1 < ntot) AT_SWRITE(sA, buf ^ 1);
        if (it_ld < 4608) AT_SLOAD(sA);
        __syncthreads();
    }
#undef AT_QLOAD
#undef AT_SLOAD
#undef AT_SWRITE
#undef PK4
#undef AT_STEP
}
__device__ __forceinline__ void dil_combine(const Frame& F) {
    const int gw = F.vcu * 8 + F.wave, NGW = F.G * 8, lane = F.lane, c = lane & 15;
    const unsigned char* o0 = (const unsigned char*)F.op0_(); const unsigned char* o1 = (const unsigned char*)F.op1_(); const unsigned char* o2 = (const unsigned char*)F.op2_();
    for (long it = gw; it < (long)T * NHD / 4; it += NGW) { const long row = it * 4 + (lane >> 4); const size_t tok = (size_t)(row / NHD); const int head = (int)(row % NHD);
        const float l0 = F.lp_()[tok * NHD + head], l1 = F.lp_()[((size_t)T + tok) * NHD + head], l2 = F.lp_()[((size_t)2 * T + tok) * NHD + head]; const float inv = 1.f / (l0 + l1 + l2), w0 = l0 * inv, w1 = l1 * inv, w2 = l2 * inv;
        const size_t off = tok * (NHD * 128) + head * 128 + 8 * c; const u32x2 a = *(const u32x2*)(o0 + off), b = *(const u32x2*)(o1 + off), d = *(const u32x2*)(o2 + off);
#define DC2(AW, BW, DW, SEL) ({ const f32x2 x_ = __builtin_amdgcn_cvt_pk_f32_fp8((int)(AW), SEL), y_ = __builtin_amdgcn_cvt_pk_f32_fp8((int)(BW), SEL), z_ = __builtin_amdgcn_cvt_pk_f32_fp8((int)(DW), SEL); \
            pk2(w0 * x_[0] + w1 * y_[0] + w2 * z_[0], w0 * x_[1] + w1 * y_[1] + w2 * z_[1]); })
        u32x4 o; o.x = DC2(a.x, b.x, d.x, false); o.y = DC2(a.x, b.x, d.x, true); o.z = DC2(a.y, b.y, d.y, false); o.w = DC2(a.y, b.y, d.y, true);
#undef DC2
        *(u32x4*)(F.mixed_() + tok * DM + 512 + head * 128 + 8 * c) = o; }
}

__device__ __forceinline__ unsigned fl_flip(float x) { const unsigned u = __float_as_uint(x); return u ^ ((unsigned)((int)u >> 31) | 0x80000000u); }
__device__ __forceinline__ float fl_unflip(unsigned w) { return __uint_as_float((w & 0x80000000u) ? (w ^ 0x80000000u) : ~w); }
#define CE_DESC(a, b) do { const unsigned x_ = max(a, b), y_ = min(a, b); a = x_; b = y_; } while (0)
__device__ __forceinline__ void sort16_desc(unsigned (&a)[16]) {
#pragma unroll
    for (int k = 2; k <= 16; k <<= 1)
#pragma unroll
        for (int j = k >> 1; j > 0; j >>= 1)
#pragma unroll
            for (int i = 0; i < 16; ++i) { const int l = i ^ j; if (l > i) { const unsigned x = max(a[i], a[l]), y = min(a[i], a[l]); if ((i & k) == 0) { a[i] = x; a[l] = y; } else { a[i] = y; a[l] = x; } } }
}
__device__ __forceinline__ void bmerge16_desc(unsigned (&a)[16]) {
#pragma unroll
    for (int j = 8; j > 0; j >>= 1)
#pragma unroll
        for (int i = 0; i < 16; ++i) { const int l = i ^ j; if (l > i) CE_DESC(a[i], a[l]); }
}
__device__ __forceinline__ void top16_merge(unsigned (&a)[16], const unsigned (&b)[16]) {
#pragma unroll
    for (int i = 0; i < 16; ++i) a[i] = max(a[i], b[15 - i]);
    bmerge16_desc(a);
}
__device__ __forceinline__ void top16_partner(unsigned (&a)[16]) {
    unsigned b[16];
#pragma unroll
    for (int i = 0; i < 16; ++i) b[i] = (unsigned)__shfl_xor((int)a[i], 32);
    top16_merge(a, b);
}
__device__ constexpr unsigned char stair(int n) {
    constexpr unsigned char L[64] = {0x00,0x01,0x02,0x03,0x04,0x05,0x06,0x07,0x08,0x09,0x0a,0x0b,0x0c,0x0d,0x0e,0x0f,0x10,0x11,0x12,0x13,0x14,0x15,0x16,0x17,0x20,0x21,0x22,0x23,0x24,0x30,0x31,0x32,
                                     0x33,0x40,0x41,0x42,0x50,0x51,0x60,0x61,0x70,0x71,0x80,0x90,0xa0,0xb0,0xc0,0xd0,0xe0,0xf0,0xff,0xff,0xff,0xff,0xff,0xff,0xff,0xff,0xff,0xff,0xff,0xff,0xff,0xff};
    return L[n];
}
constexpr int TK_KEYS = 32768;
__device__ __forceinline__ void topk_item(const Frame& F, int hh, int tg) {
    const int lane = F.lane, r32 = lane & 31, hi = lane >> 5, tok0 = tg * 32; const size_t tok = (size_t)tok0 + r32;
    LAS int* ktab = (LAS int*)(F.lds + F.wave * 4096) + r32 * 32;
    float ss = 0.f;
    { const f32x4* sp = (const f32x4*)(F.ssp_() + tok * 32 + hi * 16);
#pragma unroll
      for (int j = 0; j < 4; ++j) { const f32x4 v = sp[j]; ss += (v[0] + v[1]) + (v[2] + v[3]); } }
    ss += __shfl_xor(ss, 32);
    const float rs2 = __builtin_amdgcn_rsqf(ss * (1.f / DM) + EPS);
    if (hh == 0 && hi == 0) F.rs2_()[tok] = rs2;
    unsigned top[2][16];
#pragma unroll
    for (int cc = 0; cc < 2; ++cc) {
        f32x16 acc[4] = {};
        const bf16_t* qp = F.qry_() + tok * DM + hh * 256 + cc * 128 + hi * 8; const LAS unsigned char* kl = F.lds + TK_KEYS + cc * 32768;
        bf16x8 qf[8];
#pragma unroll
        for (int s = 0; s < 8; ++s) qf[s] = *(const bf16x8*)(qp + 16 * s);
#pragma unroll
        for (int s = 0; s < 8; ++s) {
#pragma unroll
            for (int kt = 0; kt < 4; ++kt) { const bf16x8 kf = *(const LAS bf16x8*)(kl + KSWZ(kt * 32 + r32, (16 * s + 8 * hi) * 2)); acc[kt] = __builtin_amdgcn_mfma_f32_32x32x16_bf16(kf, qf[s], acc[kt], 0, 0, 0); } }
        unsigned g[4][16];
#pragma unroll
        for (int kt = 0; kt < 4; ++kt) {
#pragma unroll
            for (int r = 0; r < 16; ++r) g[kt][r] = (fl_flip(acc[kt][r]) & ~127u) | (unsigned)(127 - (32 * kt + crow(r, hi)));
            sort16_desc(g[kt]); }
        top16_merge(g[0], g[1]); top16_merge(g[2], g[3]); top16_merge(g[0], g[2]); top16_partner(g[0]);
#pragma unroll
        for (int i = 0; i < 16; ++i) top[cc][i] = g[0][i];
    }
#pragma unroll
    for (int i = 0; i < 16; ++i) ktab[hi * 16 + i] = 127 - (int)((hi ? top[1][i] : top[0][i]) & 127u);
    float s0[16], s1[16];
#pragma unroll
    for (int i = 0; i < 16; ++i) { s0[i] = fl_unflip(top[0][i] & ~127u); s1[i] = fl_unflip(top[1][i] & ~127u); }
    unsigned ca[16], cb[16];
#pragma unroll
    for (int n = 0; n < 32; ++n) { const int A = stair(n), B = stair(25 + n); unsigned va = 0u, vb = 0u;
        if (n < 25) { va = (fl_flip(s0[A >> 4] + s1[A & 15]) & ~255u) | (unsigned)(255 - A); vb = (fl_flip(s0[B >> 4] + s1[B & 15]) & ~255u) | (unsigned)(255 - B); }
        const unsigned v = hi ? vb : va; if (n < 16) ca[n] = v; else cb[n - 16] = v; }
    sort16_desc(ca); sort16_desc(cb); top16_merge(ca, cb); top16_partner(ca);
    float e[16], sum = 0.f; const float mx = fl_unflip(ca[0] & ~255u) * rs2;
#pragma unroll
    for (int i = 0; i < 16; ++i) { e[i] = fexp(fl_unflip(ca[i] & ~255u) * rs2 - mx); sum += e[i]; }
    const float inv = 1.f / sum;
    LDS_WAIT(); asm volatile("" ::: "memory");
    int oi[8]; float og[8];
#pragma unroll
    for (int k = 0; k < 8; ++k) { const unsigned cv = hi ? ca[8 + k] : ca[k]; const int code = 255 - (int)(cv & 255u); og[k] = (hi ? e[8 + k] : e[k]) * inv; oi[k] = ktab[code >> 4] * 128 + ktab[16 + (code & 15)]; }
    { unsigned short* ip = F.idx_() + tok * 128 + hh * 16 + hi * 8; float* gp = F.gate_() + tok * 128 + hh * 16 + hi * 8;
      *(u32x4*)ip = (u32x4){(unsigned)oi[0] | ((unsigned)oi[1] << 16), (unsigned)oi[2] | ((unsigned)oi[3] << 16), (unsigned)oi[4] | ((unsigned)oi[5] << 16), (unsigned)oi[6] | ((unsigned)oi[7] << 16)};
      { const int g0 = hh * 4 + hi * 2;
        *(u32x2*)(F.idxT_() + ((size_t)g0 * T + tok) * 4) = (u32x2){(unsigned)oi[0] | ((unsigned)oi[1] << 16), (unsigned)oi[2] | ((unsigned)oi[3] << 16)};
        *(u32x2*)(F.idxT_() + ((size_t)(g0 + 1) * T + tok) * 4) = (u32x2){(unsigned)oi[4] | ((unsigned)oi[5] << 16), (unsigned)oi[6] | ((unsigned)oi[7] << 16)}; }
      *(f32x4*)gp = (f32x4){og[0], og[1], og[2], og[3]}; *(f32x4*)(gp + 4) = (f32x4){og[4], og[5], og[6], og[7]}; }
    LDS_WAIT(); asm volatile("" ::: "memory");
}

constexpr int PS_NSL = 16, PS_CW = DM / PS_NSL, PS_SUB = PS_NSL / 8, PS_TG = 32, PS_NTG = T / PS_TG;
__device__ __forceinline__ float gelu_tanh(float x) { const float u = 0.7978845608028654f * (x + 0.044715f * x * x * x); const float t = 1.f - 2.f * __builtin_amdgcn_rcpf(1.f + fexp(2.f * u)); return 0.5f * x * (1.f + t); }
__device__ __forceinline__ int dot16i(u32x4 w, u32x4 x) { int p = __builtin_amdgcn_sdot4((int)w.x, (int)x.x, 0, false); p = __builtin_amdgcn_sdot4((int)w.y, (int)x.y, p, false); p = __builtin_amdgcn_sdot4((int)w.z, (int)x.z, p, false); return __builtin_amdgcn_sdot4((int)w.w, (int)x.w, p, false); }
__device__ __forceinline__ unsigned xcc_id() { return (unsigned)__builtin_amdgcn_s_getreg((3 << 11) | 20) & 7u; }
__device__ __forceinline__ bool peer_claim(unsigned* cnt, unsigned x, unsigned& d, int lane, int& q, int& tg) {
    while (d < 8u) { const unsigned xq = (x + d) & 7u; unsigned u = 0u;
        if (lane == 0) u = __hip_atomic_fetch_add(cnt + 64 * xq, 1u, __ATOMIC_RELAXED, __HIP_MEMORY_SCOPE_AGENT);
        u = (unsigned)__builtin_amdgcn_readfirstlane((int)u);
        if (u < (unsigned)(PS_SUB * PS_NTG)) { q = (int)(u / PS_NTG) * 8 + (int)xq; tg = (int)(u % PS_NTG); return true; }
        ++d; }
    return false;
}
template <int CTRL> __device__ __forceinline__ float dppmov(float x) { return __int_as_float(__builtin_amdgcn_update_dpp(0, __float_as_int(x), CTRL, 0xf, 0xf, true)); }
template <int CTRL> __device__ __forceinline__ int dppmovi(int x) { return __builtin_amdgcn_update_dpp(0, x, CTRL, 0xf, 0xf, true); }
__device__ __forceinline__ int bperm(int srclane, int v) { return __builtin_amdgcn_ds_bpermute(srclane << 2, v); }
__device__ __forceinline__ void peer_quant_x(const Frame& F) {
    const int gw = F.vcu * 8 + F.wave, NGW = F.G * 8, lane = F.lane;
    for (int tok = gw; tok < T; tok += NGW) { const u32x4* xr = (const u32x4*)(F.x1b_() + (size_t)tok * DM) + lane; float v[4][8]; float m = 0.f;
#pragma unroll
        for (int j = 0; j < 4; ++j) { const u32x4 w = xr[64 * j]; v[j][0] = bflo(w.x); v[j][1] = bfhi(w.x); v[j][2] = bflo(w.y); v[j][3] = bfhi(w.y); v[j][4] = bflo(w.z); v[j][5] = bfhi(w.z); v[j][6] = bflo(w.w); v[j][7] = bfhi(w.w);
#pragma unroll
            for (int i = 0; i < 8; ++i) m = fmaxf(m, fabsf(v[j][i])); }
#pragma unroll
        for (int o = 1; o < 64; o <<= 1) m = fmaxf(m, __shfl_xor(m, o));
        const float inv = m > 0.f ? 127.f / m : 0.f;
#pragma unroll
        for (int j = 0; j < 4; ++j) { u32x2 w = {0u, 0u};
#pragma unroll
            for (int i = 0; i < 4; ++i) { w.x |= ((unsigned)(int)rintf(v[j][i] * inv) & 0xffu) << (8 * i); w.y |= ((unsigned)(int)rintf(v[j][4 + i] * inv) & 0xffu) << (8 * i); }
            *(u32x2*)(F.xq8_() + (size_t)tok * DM + 8 * lane + 512 * j) = w; }
        if (lane == 0) F.sx_()[tok] = m * (1.f / 127.f); }
}
__device__ __forceinline__ void peer_down(const Frame& F, int cntw = 1024) {
    const int lane = F.lane, g = lane >> 3, c = lane & 7; const unsigned x = xcc_id(); unsigned d = 0u; int q, tg; unsigned* cnt = (unsigned*)(F.wsb + WS_CTL) + cntw;
    const unsigned char* tab = F.down8_(); const unsigned char* xb = F.xq8_();
    while (peer_claim(cnt, x, d, lane, q, tg)) {
        const unsigned colb = (unsigned)(q * PS_CW + 16 * c), slb = (unsigned)q * (16384u * 128u) + 16u * c; short* part = F.part_() + (size_t)q * T * 128; const size_t tok0 = (size_t)tg * PS_TG;
        u32x4 wA[16], wB[16], xA, xB; int iA0, iA1, iB0, iB1;
#define PD_IDX(i0, i1, tok) do { const unsigned short* ip_ = F.idx_() + (tok) * 128 + lane; i0 = ip_[0]; i1 = ip_[64]; } while (0)
#define PD_ROWS(W_, X_, i0, i1, tok) do { _Pragma("unroll") for (int j = 0; j < 16; ++j) { const unsigned e_ = (unsigned)bperm(8 * (j & 7) + g, j < 8 ? i0 : i1); \
            W_[j] = *(const u32x4*)(tab + (e_ * 128u + slb)); } X_ = *(const u32x4*)(xb + (tok) * DM + colb); } while (0)
#define PD_COMP(W_, X_, tok) do { int p[16]; _Pragma("unroll") for (int j = 0; j < 16; ++j) p[j] = dot16i(W_[j], X_); \
            int a1[8], a2[4], a3[2]; \
            _Pragma("unroll") for (int i = 0; i < 8; ++i) { const int keep = (c & 1) ? p[2 * i + 1] : p[2 * i], give = (c & 1) ? p[2 * i] : p[2 * i + 1]; a1[i] = keep + dppmovi<0xB1>(give); } \
            _Pragma("unroll") for (int i = 0; i < 4; ++i) { const int keep = (c & 2) ? a1[2 * i + 1] : a1[2 * i], give = (c & 2) ? a1[2 * i] : a1[2 * i + 1]; a2[i] = keep + dppmovi<0x4E>(give); } \
            _Pragma("unroll") for (int i = 0; i < 2; ++i) { const int keep = (c & 4) ? a2[2 * i + 1] : a2[2 * i], give = (c & 4) ? a2[2 * i] : a2[2 * i + 1]; a3[i] = keep + __shfl_xor(give, 4); } \
            part[(tok) * 128 + 8 * c + g] = (short)min(max(a3[0] >> 2, -32768), 32767); part[(tok) * 128 + 64 + 8 * c + g] = (short)min(max(a3[1] >> 2, -32768), 32767); } while (0)
        PD_IDX(iA0, iA1, tok0); PD_IDX(iB0, iB1, tok0 + 1);
        PD_ROWS(wA, xA, iA0, iA1, tok0);
        for (int tt = 0; tt < PS_TG; tt += 2) { const size_t tok = tok0 + tt;
            PD_ROWS(wB, xB, iB0, iB1, tok + 1);
            const size_t t2 = tok + (tt + 2 < PS_TG ? 2 : 0), t3 = tok + (tt + 2 < PS_TG ? 3 : 1);
            PD_IDX(iA0, iA1, t2);
            PD_COMP(wA, xA, tok);
            if (tt + 2 < PS_TG) PD_ROWS(wA, xA, iA0, iA1, t2);
            PD_IDX(iB0, iB1, t3);
            PD_COMP(wB, xB, tok + 1);
        }
#undef PD_IDX
#undef PD_ROWS
#undef PD_COMP
    }
}
__device__ __forceinline__ void peer_coef_probe(const Frame& F, bool dry) {
    const int gw = F.vcu * 8 + F.wave, NGW = F.G * 8, lane = F.lane;
    for (int tok = gw; tok < T; tok += NGW) { int a0 = 0, a1 = 0; const short* pp = F.part_() + (size_t)tok * 128 + lane;
#pragma unroll
        for (int q = 0; q < PS_NSL; ++q) { a0 += pp[(size_t)q * T * 128]; a1 += pp[(size_t)q * T * 128 + 64]; }
        const float sc = F.rs2_()[tok] * F.sx_()[tok] * 4.f; const float* gp = F.gate_() + (size_t)tok * 128 + lane; const int e0 = F.idx_()[(size_t)tok * 128 + lane], e1 = F.idx_()[(size_t)tok * 128 + 64 + lane];
        const float c0 = gp[0] * gelu_tanh((float)a0 * sc * F.sd_()[e0]) * F.su_()[e0], c1 = gp[64] * gelu_tanh((float)a1 * sc * F.sd_()[e1]) * F.su_()[e1];
        float m = fmaxf(fabsf(c0), fabsf(c1));
#pragma unroll
        for (int o = 1; o < 64; o <<= 1) m = fmaxf(m, __shfl_xor(m, o));
        const float inv = m > 0.f ? 127.f / m : 0.f; const int q0 = (int)rintf(c0 * inv), q1 = (int)rintf(c1 * inv);
        unsigned char* fp = dry ? F.wsb + WS_PART + 256 * MiB : (unsigned char*)F.fqT_();
        { const int k0 = lane, k1 = 64 + lane; fp[((size_t)(k0 >> 2) * T + tok) * 4 + (k0 & 3)] = (unsigned char)q0; fp[((size_t)(k1 >> 2) * T + tok) * 4 + (k1 & 3)] = (unsigned char)q1; }
        if (lane == 0 && !dry) F.csum_()[tok] = m * (1.f / 127.f); }
}
#ifndef PROBE_PHASE
#define PROBE_PHASE -1
#endif
#define UP_NREP ((PROBE_PHASE == 10) ? 2 : 1)
constexpr int U2_XO = 131072 + 2048, U2_SF = U2_XO + 8192;
#define PU_T4(ACC_, R0, R1, R2, R3, FQ_) do { const unsigned t0_ = __builtin_amdgcn_perm(R1, R0, 0x05010400u), t1_ = __builtin_amdgcn_perm(R1, R0, 0x07030602u), t2_ = __builtin_amdgcn_perm(R3, R2, 0x05010400u), t3_ = __builtin_amdgcn_perm(R3, R2, 0x07030602u); \
            ACC_[0] = __builtin_amdgcn_sdot4((int)__builtin_amdgcn_perm(t2_, t0_, 0x05040100u), FQ_, ACC_[0], false); ACC_[1] = __builtin_amdgcn_sdot4((int)__builtin_amdgcn_perm(t2_, t0_, 0x07060302u), FQ_, ACC_[1], false); \
            ACC_[2] = __builtin_amdgcn_sdot4((int)__builtin_amdgcn_perm(t3_, t1_, 0x05040100u), FQ_, ACC_[2], false); ACC_[3] = __builtin_amdgcn_sdot4((int)__builtin_amdgcn_perm(t3_, t1_, 0x07060302u), FQ_, ACC_[3], false); } while (0)
__device__ __forceinline__ unsigned u2_addr_lo(unsigned w, unsigned base) { unsigned a; asm("v_mad_u32_u16 %0, %1, 8, %2" : "=v"(a) : "v"(w), "s"(base)); return a; }
__device__ __forceinline__ unsigned u2_addr_hi(unsigned w, unsigned base) { unsigned a; asm("v_mad_u32_u16 %0, %1, 8, %2 op_sel:[1,0,0,0]" : "=v"(a) : "v"(w), "s"(base)); return a; }
__device__ __forceinline__ void peer_up(const Frame& F) {
    const int lane = F.lane;
    for (int cgi = F.vcu; cgi < 256 * UP_NREP; cgi += F.G) { const int cg = cgi & 255; const bool dry = cgi >= 256; float* const ob_ = dry ? (float*)(F.wsb + WS_PART) : F.out; const unsigned tmask_ = dry ? 16383u : 0xffffffffu;
        __syncthreads();
        { const u32x4* src = (const u32x4*)(F.up8_() + (size_t)cg * 131072);
#pragma unroll 4
          for (int i = 0; i < 16; ++i) { const int o = F.tid + 512 * i; *(LAS u32x4*)(F.lds + o * 16) = src[o]; } }
        __syncthreads();
        u32x2 S0i[8], S1i[8], S2i[8], S3i[8]; int S0f[8], S1f[8], S2f[8], S3f[8]; u32x2 R0[16], R1[16];
        const __amdgpu_buffer_rsrc_t rsI = __builtin_amdgcn_make_buffer_rsrc((void*)F.idxT_(), 0, 32 * T * 8, 0x00020000), rsF = __builtin_amdgcn_make_buffer_rsrc((void*)F.fqT_(), 0, 32 * T * 4, 0x00020000),
            rsX = __builtin_amdgcn_make_buffer_rsrc((void*)F.x1b_(), 0, T * DM * 2, 0x00020000), rsC = __builtin_amdgcn_make_buffer_rsrc((void*)F.csum_(), 0, T * 4, 0x00020000);
#define U2_FENCE() do { asm volatile("" ::: "memory"); SBAR(); } while (0)
#ifdef UP_PROBE_NOCONF
#define U2_IDMASK(id) do { id.x &= idmask_; id.y &= idmask_; } while (0)
        const unsigned idmask_ = dry ? 0u : 0xffffffffu;
#else
#define U2_IDMASK(id) do { } while (0)
#endif
#define U2_LOAD(S_, tok_, s_) do { const unsigned vo_ = (unsigned)(tok_) * 8u; _Pragma("unroll") for (int g = 0; g < 8; ++g) { S_##i[g] = __builtin_amdgcn_raw_buffer_load_b64(rsI, vo_, ((s_) * 8 + g) * (T * 8), 0); \
            S_##f[g] = (int)__builtin_amdgcn_raw_buffer_load_b32(rsF, vo_ >> 1, ((s_) * 8 + g) * (T * 4), 0); } U2_FENCE(); } while (0)
#define U2_ISSUE(R_, S_, h_) do { _Pragma("unroll") for (int g = 0; g < 4; ++g) { u32x2 id = S_##i[(h_) * 4 + g]; U2_IDMASK(id); \
                R_[4 * g + 0] = *(const LAS u32x2*)(uintptr_t)u2_addr_lo(id.x, lbase_); R_[4 * g + 1] = *(const LAS u32x2*)(uintptr_t)u2_addr_hi(id.x, lbase_); \
                R_[4 * g + 2] = *(const LAS u32x2*)(uintptr_t)u2_addr_lo(id.y, lbase_); R_[4 * g + 3] = *(const LAS u32x2*)(uintptr_t)u2_addr_hi(id.y, lbase_); } U2_FENCE(); } while (0)
#define U2_FOLD(R_, S_, h_) do { _Pragma("unroll") for (int g = 0; g < 4; ++g) { const int fq = S_##f[(h_) * 4 + g]; \
                int* a_ = acc; PU_T4(a_, R_[4 * g + 0].x, R_[4 * g + 1].x, R_[4 * g + 2].x, R_[4 * g + 3].x, fq); a_ = acc + 4; PU_T4(a_, R_[4 * g + 0].y, R_[4 * g + 1].y, R_[4 * g + 2].y, R_[4 * g + 3].y, fq); } U2_FENCE(); } while (0)
        const int nb = (T / 64 - F.wave + 7) / 8;
        const unsigned lbase_ = (unsigned)__builtin_amdgcn_readfirstlane((int)(unsigned)(uintptr_t)F.ldsg);
        unsigned lane_; asm volatile("v_mbcnt_lo_u32_b32 %0, -1, 0\n\tv_mbcnt_hi_u32_b32 %0, -1, %0" : "=v"(lane_));
        { const unsigned t0_ = (unsigned)F.wave * 64u + lane_; U2_LOAD(S0, t0_, 0); U2_LOAD(S1, t0_, 1); U2_LOAD(S2, t0_, 2); U2_LOAD(S3, t0_, 3); U2_ISSUE(R0, S0, 0); }
#pragma unroll 1
        for (int i = 0; i < nb; ++i) { const unsigned tok = (unsigned)(F.wave + 8 * i) * 64u + lane_; const unsigned tokn = tok + (i + 1 < nb ? 512u : 0u); int acc[8] = {0, 0, 0, 0, 0, 0, 0, 0};
            __builtin_amdgcn_raw_ptr_buffer_load_lds(rsX, (LAS unsigned*)(F.lds + U2_XO + F.wave * 1024), 16, tok << 12, cg * 16, 0, 0);
            __builtin_amdgcn_raw_ptr_buffer_load_lds(rsC, (LAS unsigned*)(F.lds + U2_SF + F.wave * 256), 4, tok << 2, 0, 0, 0);
            U2_FENCE();
            U2_ISSUE(R1, S0, 1); U2_FOLD(R0, S0, 0);
            U2_ISSUE(R0, S1, 0); U2_FOLD(R1, S0, 1); U2_LOAD(S0, tokn, 0);
            U2_ISSUE(R1, S1, 1); U2_FOLD(R0, S1, 0);
            U2_ISSUE(R0, S2, 0); U2_FOLD(R1, S1, 1); U2_LOAD(S1, tokn, 1);
            U2_ISSUE(R1, S2, 1); U2_FOLD(R0, S2, 0);
            U2_ISSUE(R0, S3, 0); U2_FOLD(R1, S2, 1); U2_LOAD(S2, tokn, 2);
            U2_ISSUE(R1, S3, 1); U2_FOLD(R0, S3, 0);
            U2_ISSUE(R0, S0, 0); U2_FOLD(R1, S3, 1); U2_LOAD(S3, tokn, 3);
            asm volatile("s_waitcnt vmcnt(48)" ::: "memory");
            const u32x4 xo = *(const LAS u32x4*)(F.lds + U2_XO + F.wave * 1024 + lane_ * 16); const float sf = *(const LAS float*)(F.lds + U2_SF + F.wave * 256 + lane_ * 4);
            f32x4 v0 = {bflo(xo.x), bfhi(xo.x), bflo(xo.y), bfhi(xo.y)}, v1 = {bflo(xo.z), bfhi(xo.z), bflo(xo.w), bfhi(xo.w)};
            v0[0] += sf * (float)acc[0]; v0[1] += sf * (float)acc[1]; v0[2] += sf * (float)acc[2]; v0[3] += sf * (float)acc[3]; v1[0] += sf * (float)acc[4]; v1[1] += sf * (float)acc[5]; v1[2] += sf * (float)acc[6]; v1[3] += sf * (float)acc[7];
            float* dp = ob_ + (size_t)((tok & tmask_) * DM) + cg * 8; *(f32x4*)dp = v0; *(f32x4*)(dp + 4) = v1; U2_FENCE(); }
        LDS_WAIT();
#undef U2_ISSUE
#undef U2_FOLD
#undef U2_FENCE
#undef U2_LOAD
    }
}
#undef PU_T4


#ifdef VALU_PROBE
__device__ __forceinline__ void valu_probe(const Frame& F) {
    unsigned a[16];
#pragma unroll
    for (int j = 0; j < 16; ++j) a[j] = F.tid * 17u + j * 0x01010101u;
    unsigned b = F.tid * 3u + 0x05040100u, c = 0x3c003c00u ^ F.tid;
#pragma unroll 1
    for (int it = 0; it < 1024; ++it) {
#pragma unroll
        for (int r = 0; r < 4; ++r) {
#pragma unroll
            for (int j = 0; j < 16; ++j) {
#if VALU_PROBE == 0
                asm volatile("v_add_u32 %0, %0, %1" : "+v"(a[j]) : "v"(b));
#elif VALU_PROBE == 1
                asm volatile("v_perm_b32 %0, %0, %1, %2" : "+v"(a[j]) : "v"(b), "v"(c));
#elif VALU_PROBE == 2
                asm volatile("v_dot4c_i32_i8 %0, %1, %2" : "+v"(a[j]) : "v"(b), "v"(c));
#elif VALU_PROBE == 3
                asm volatile("v_mad_u32_u16 %0, %1, %2, %0 op_sel:[1,0,0,0]" : "+v"(a[j]) : "v"(b), "v"(c));
#elif VALU_PROBE == 4
                asm volatile("v_and_b32 %0, %0, %1" : "+v"(a[j]) : "v"(b));
#elif VALU_PROBE == 5
                asm volatile("v_lshl_add_u32 %0, %0, 3, %1" : "+v"(a[j]) : "v"(b));
#elif VALU_PROBE == 6
                asm volatile("v_bfe_u32 %0, %0, 3, 14" : "+v"(a[j]));
#elif VALU_PROBE == 7
                asm volatile("v_dot4_i32_i8 %0, %1, %2, %0" : "+v"(a[j]) : "v"(b), "v"(c));
#endif
            } } }
    unsigned s = 0;
#pragma unroll
    for (int j = 0; j < 16; ++j) s ^= a[j];
    ((unsigned*)(F.wsb + WS_PART))[(size_t)F.vcu * 512 + F.tid] = s;
}
#endif

#define XB_TMO      128
#define XB_XCNT(j)  (256  + 64 * (j))
#define XB_XSUB(j)  (1280 + 64 * (j))
#define XB_XGEN(j)  (2304 + 64 * (j))
#define XB_TOP      3328
#define XB_TOPGEN   3392
#define XCD_BAR_WORDS 3456
#define XB_SPIN_CAP (1u << 18)

__device__ __forceinline__ unsigned xb_ld(unsigned* p)              { return __hip_atomic_load(p, __ATOMIC_RELAXED, __HIP_MEMORY_SCOPE_AGENT); }
__device__ __forceinline__ unsigned xb_add(unsigned* p, unsigned v) { return __hip_atomic_fetch_add(p, v, __ATOMIC_RELAXED, __HIP_MEMORY_SCOPE_AGENT); }
__device__ __forceinline__ unsigned xb_xcc_id() { return (unsigned)__builtin_amdgcn_s_getreg((3 << 11) | 20) & 0xFu; }
#define XB_SPIN(cond, bar) do { unsigned _sp = 0; while (cond) { __builtin_amdgcn_s_sleep(1); \
    if ((++_sp & 255u) == 0u) { if (xb_ld(&(bar)[XB_TMO])) break; if (_sp > XB_SPIN_CAP) { atomicAdd(&(bar)[XB_TMO], 1u); break; } } } } while (0)

struct XcdBarrier {
    unsigned* bar; unsigned x;
    volatile LAS unsigned* st;
};

__device__ __forceinline__ XcdBarrier xcd_barrier_post(unsigned* bar, volatile LAS unsigned* st) {
    XcdBarrier b; b.bar = bar; b.x = xb_xcc_id(); b.st = st;
    if (threadIdx.x == 0) (void)xb_add(&bar[XB_XCNT(b.x)], 1u);
    return b;
}
__device__ __forceinline__ void xcd_barrier_complete(unsigned* bar, unsigned x, unsigned& nloc, unsigned& nx) {
    const unsigned G = gridDim.x * gridDim.y * gridDim.z;
    unsigned sum, cnt, mine, sp = 0u;
    for (;;) {
        sum = 0u; cnt = 0u; mine = 0u;
#pragma unroll
        for (unsigned j = 0; j < 16; ++j) { const unsigned c = xb_ld(&bar[XB_XCNT(j)]); sum += c; cnt += (c > 0u) ? 1u : 0u; mine = (j == x) ? c : mine; }
        if (sum == G) break;
        __builtin_amdgcn_s_sleep(1);
        if ((++sp & 255u) == 0u) { if (xb_ld(&bar[XB_TMO])) break; if (sp > XB_SPIN_CAP) { atomicAdd(&bar[XB_TMO], 1u); break; } }
    }
    nloc = mine > 0u ? mine : 1u; nx = cnt > 0u ? cnt : 1u;
}

__device__ __forceinline__ void xcd_barrier(const XcdBarrier& b) {
    asm volatile("s_waitcnt vmcnt(0)" ::: "memory");
    __syncthreads();
    if (threadIdx.x == 0) {
        unsigned* bar = b.bar;
        __builtin_amdgcn_s_waitcnt(0);
        unsigned nloc = b.st[0], nx = b.st[1];
        if (nloc == 0u) { xcd_barrier_complete(bar, b.x, nloc, nx); b.st[0] = nloc; b.st[1] = nx; }
        const unsigned old = xb_add(&bar[XB_XSUB(b.x)], 1u);
        const unsigned gen = old / nloc;
        if (old + 1u == (gen + 1u) * nloc) {
            __builtin_amdgcn_fence(__ATOMIC_RELEASE, "agent");
            asm volatile("s_waitcnt vmcnt(0)" ::: "memory");
            const unsigned og = xb_add(&bar[XB_TOP], 1u);
            const unsigned tg = og / nx;
            if (og + 1u == (tg + 1u) * nx) xb_add(&bar[XB_TOPGEN], 1u);
            else XB_SPIN(xb_ld(&bar[XB_TOPGEN]) == tg, bar);
            __builtin_amdgcn_fence(__ATOMIC_ACQUIRE, "agent");
            xb_add(&bar[XB_XGEN(b.x)], 1u);
            asm volatile("s_waitcnt vmcnt(0)" ::: "memory");
        } else {
            XB_SPIN(xb_ld(&bar[XB_XGEN(b.x)]) == gen, bar);
            __builtin_amdgcn_fence(__ATOMIC_ACQUIRE, "agent");
            asm volatile("s_waitcnt vmcnt(0)" ::: "memory");
        }
    }
    __syncthreads();
}

struct Args { const float* in[16]; float* out; unsigned char* ws; int ph_lo, ph_hi, coop, pad; };
__global__ void __launch_bounds__(512, 2) fwd_kernel(Args args) {
    extern __shared__ __attribute__((aligned(16))) unsigned char lds_raw[];
    Frame F;
    F.lds = (LAS unsigned char*)lds_raw; F.ldsg = (char*)lds_raw;
    F.tid = threadIdx.x; F.lane = F.tid & 63; F.wave = __builtin_amdgcn_readfirstlane(F.tid >> 6);
    F.G = gridDim.x; { const int bx = blockIdx.x; F.vcu = (F.G % 8 == 0) ? (bx % 8) * (F.G / 8) + bx / 8 : bx; }
    F.x = args.in[0]; F.norm1_g = args.in[1]; F.w_in = args.in[2]; F.up_f = args.in[3]; F.bias_f = args.in[4]; F.up_b = args.in[5]; F.bias_b = args.in[6]; F.out_g = args.in[7];
    F.qn_g = args.in[8]; F.kn_g = args.in[9]; F.w_out = args.in[10]; F.norm2_g = args.in[11]; F.w_query = args.in[12]; F.sub_keys = args.in[13]; F.peer_down = args.in[14]; F.peer_up = args.in[15];
    F.out = args.out; unsigned char* ws = args.ws; F.wsb = ws;
    constexpr int MISC_OFF = 131072 + 320;
    for (int u = F.tid; u < 64; u += 512) ((LAS unsigned*)(F.lds + MISC_OFF))[u] = 0u;
    __syncthreads();
    XcdBarrier bar = xcd_barrier_post((unsigned*)(ws + WS_CTL) + 8192, (volatile LAS unsigned*)(F.lds + MISC_OFF) + 8);
    const int lo = args.ph_lo, hi = args.ph_hi;
#ifndef PH_MASK
#define PH_MASK 0x7ff
#endif
#ifndef PROBE_PHASE
#define PROBE_PHASE -1
#endif
#define REP(k) for (int rep_ = 0; rep_ < ((PROBE_PHASE == (k)) ? 2 : 1); ++rep_)
#define IN(k) (((PH_MASK >> (k)) & 1) && lo <= (k) && (k) < hi)
#define SEAM(k) do { if (IN(k) && IN((k) + 1)) { if (args.coop) { if ((k) == 0) cg::this_grid().sync(); else xcd_barrier(bar); } } } while (0)
    if (IN(0)) { REP(0) phase0(F); } SEAM(0);
#define GEMM1_BODY { pg8::Gemm g{(const pg8::bf16_t*)F.xq1_(), (const pg8::bf16_t*)F.Win8_(), T, HP, DM / 2}; pg8::StaticOrder S; S.init(T, HP, F.G, (int)blockIdx.x); \
        pg8::EpiI8Qk E{F.h_(), HP, F.rs1_(), F.sw_(), F.qn_g, F.kn_g, (LAS float*)(F.lds + 131072 + 1024), C_QD / 256, C_KD / 256, C_VD / 256, SEQ - 1, QSCALE}; \
        pg8::gemm_phase<pg8::EpiI8Qk, pg8::StaticOrder, PG8_ALIGN, PG8_SP2, true>(F.lds, g, S, E); }
    if (IN(1)) { GEMM1_BODY; if (PROBE_PHASE == 1) GEMM1_BODY; } SEAM(1);
    if (IN(2)) { REP(2) for (int it = F.vcu; it < 2048; it += F.G) gla_passA(F, it); } SEAM(2);
    if (IN(3)) { for (int it = F.vcu; it < 256; it += F.G) gla_scan(F, it); REP(3) attn_phase(F); } SEAM(3);
    if (IN(4)) REP(4) { for (int it = F.vcu; it < 2048; it += F.G) gla_passC(F, it); dil_combine(F); } SEAM(4);
#define GEMM5_BODY { pg8::Gemm g{F.mixed_(), F.WoT_(), T, DM, DM}; pg8::StaticOrder S; S.init(T, DM, F.G, (int)blockIdx.x); pg8::EpiResid E{F.x, F.out, F.x1b_(), F.ssp_(), DM}; \
        pg8::gemm_phase<pg8::EpiResid, pg8::StaticOrder, PG8_ALIGN, PG8_SP2>(F.lds, g, S, E); }
#define GEMM6_BODY { pg8::Gemm g{F.x1b_(), F.WqT_(), T, DM, DM}; pg8::StaticOrder S; S.init(T, DM, F.G, (int)blockIdx.x); pg8::EpiRowScaleBf16 E{F.qry_(), DM, nullptr}; \
        pg8::gemm_phase<pg8::EpiRowScaleBf16, pg8::StaticOrder, PG8_ALIGN, PG8_SP2>(F.lds, g, S, E); }
    if (IN(5)) { GEMM5_BODY; if (PROBE_PHASE == 5) GEMM5_BODY; } SEAM(5);
    if (IN(6)) { GEMM6_BODY; if (PROBE_PHASE == 6) GEMM6_BODY; } SEAM(6);
    if (IN(7)) REP(7) { const int gw = F.vcu * 8 + F.wave, NGW = F.G * 8; for (int u = F.vcu; u < 256; u += F.G) { const int hh = u & 7, chunk = u >> 3;
            __syncthreads();
            for (int i = F.tid; i < 4096; i += 512) { const int row = i >> 4, ch = i & 15; *(LAS u32x4*)(F.lds + TK_KEYS + KSWZ(row, ch * 16)) = *(const u32x4*)(F.SK_() + ((size_t)hh * 256 + row) * 128 + ch * 8); }
            __syncthreads();
            for (int j = 0; j < 4; ++j) topk_item(F, hh, chunk * 32 + F.wave * 4 + j); }
        if (rep_ == 0) peer_quant_x(F); } SEAM(7);
    if (IN(8)) { if (PROBE_PHASE == 8) peer_down(F, 3072); peer_down(F); } SEAM(8);
    if (IN(9)) { REP(9) peer_coef_probe(F, (PROBE_PHASE == 9) && rep_ == 0); } SEAM(9);
    if (IN(10)) peer_up(F);
#ifdef VALU_PROBE
    valu_probe(F);
#endif
#undef IN
#undef SEAM
}

#ifndef MK_N_LAUNCHES
#define MK_N_LAUNCHES 1
#endif
extern "C" void kernel_launch(void* const* d_in, const int* in_sizes, int n_in, void* d_out, int out_size, void* d_ws, size_t ws_size, hipStream_t stream) {
    static int grid = 0;
    if (grid == 0) {
        if (n_in != 16 || in_sizes[0] != T * DM || out_size != T * DM || ws_size < WS_END) { fprintf(stderr, "kernel_launch: unexpected shapes (n_in %d, in0 %d, out %d, ws %zu)\n", n_in, n_in > 0 ? in_sizes[0] : -1, out_size, ws_size); grid = -1; return; }
        int dev = 0, cus = 0, per_cu = 0;
        if (hipGetDevice(&dev) != hipSuccess || hipDeviceGetAttribute(&cus, hipDeviceAttributeMultiprocessorCount, dev) != hipSuccess) { grid = -1; return; }
        if (hipFuncSetAttribute((const void*)fwd_kernel, hipFuncAttributeMaxDynamicSharedMemorySize, LDS_BYTES) != hipSuccess) { fprintf(stderr, "kernel_launch: hipFuncSetAttribute failed\n"); grid = -1; return; }
        if (hipOccupancyMaxActiveBlocksPerMultiprocessor(&per_cu, (const void*)fwd_kernel, 512, LDS_BYTES) != hipSuccess || per_cu < 1) { fprintf(stderr, "kernel_launch: occupancy query says %d\n", per_cu); per_cu = 1; }
        (void)hipGetLastError();
        grid = cus;
    }
    if (grid < 0) return;
    if (hipMemsetAsync(d_ws, 0, 65536, stream) != hipSuccess) { fprintf(stderr, "kernel_launch: hipMemsetAsync failed\n"); return; }
    Args a{};
    for (int i = 0; i < 16; ++i) a.in[i] = (const float*)d_in[i];
    a.out = (float*)d_out; a.ws = (unsigned char*)d_ws;
    if (MK_N_LAUNCHES == 1) {
        a.ph_lo = 0; a.ph_hi = NPHASE; a.coop = 1; void* kargs[] = {&a};
        hipError_t e = hipLaunchCooperativeKernel((const void*)fwd_kernel, dim3(grid), dim3(512), kargs, LDS_BYTES, stream);
        if (e != hipSuccess) fprintf(stderr, "kernel_launch: cooperative launch failed: %s (grid %d)\n", hipGetErrorString(e), grid);
    } else {
        for (int p = 0; p < NPHASE; ++p) { a.ph_lo = p; a.ph_hi = p + 1; a.coop = 0; hipLaunchKernelGGL(fwd_kernel, dim3(grid), dim3(512), LDS_BYTES, stream, a); }
        const hipError_t le = hipPeekAtLastError(); if (le != hipSuccess) fprintf(stderr, "kernel_launch: launch failed: %s\n", hipGetErrorName(le));
    }
}
```

```cpp
#include <hip/hip_runtime.h>
#include <hip/hip_cooperative_groups.h>
#include <cstdio>
#include <cstdint>
namespace cg = cooperative_groups;
namespace pg8 {
#define PG8_LAS __attribute__((address_space(3)))
typedef unsigned short bf16_t;
typedef short bf16x8 __attribute__((ext_vector_type(8)));
typedef float f32x4 __attribute__((ext_vector_type(4)));
typedef unsigned u32x4 __attribute__((ext_vector_type(4)));
constexpr int BM = 256, BK = 64, HALF = 128, HTB = HALF * BK * 2  , STAGE_BYTES = 8 * HTB, NXCD = 8, WGM = 8;

__host__ __device__ __forceinline__ int lds_byte(int r, int c) { const int st = (r >> 4) * 2 + (c >> 5), rr = r & 15, cc = c & 31, ob = rr * 64 + cc * 2; return st * 1024 + (ob ^ (((ob >> 9) & 1) << 5)); }
__host__ __device__ __forceinline__ void stage_rc(int b, int& R, int& C) { const int st = b / 1024, sb = b % 1024, swz = sb ^ (((sb >> 9) & 1) << 5); R = (st >> 1) * 16 + swz / 64; C = (st & 1) * 32 + (swz % 64) / 2; }
__host__ __device__ __forceinline__ int perm32(int rho) { const int n = rho >> 4, i = rho & 15; return 8 * (i >> 2) + 4 * n + (i & 3); }

struct Unit { int pm, pn; };
struct Gemm { const bf16_t* A; const bf16_t* Bt; int M, N, K; };

struct StaticOrder {
    int nM, nN, nwg, G, c;
    __host__ __device__ void init(int M, int N, int G_, int c_) { nM = M / BM; nN = N / BM; nwg = nM * nN; G = G_; c = c_; }
    __host__ __device__ bool next(int i, Unit& u) const {
        const long L = (long)i * G + c; if (L >= nwg) return false;
        int wgid = (int)L; { const int q = nwg / NXCD, r = nwg % NXCD, xcd = wgid % NXCD, off = wgid / NXCD; wgid = (xcd < r ? xcd * (q + 1) : r * (q + 1) + (xcd - r) * q) + off; }
        const int nig = WGM * nN, gid = wgid / nig, fm = gid * WGM, gsz = (nM - fm) < WGM ? (nM - fm) : WGM;
        u.pm = fm + ((wgid % nig) % gsz); u.pn = (wgid % nig) / gsz; return true;
    }
    __device__ __forceinline__ void a_ready(const Unit&) const {}
    __device__ __forceinline__ void done(const Unit&) const {}
};
__device__ __forceinline__ unsigned cvt_pk_bf16(float lo, float hi) { unsigned r; asm volatile("v_cvt_pk_bf16_f32 %0, %1, %2" : "=v"(r) : "v"(lo), "v"(hi)); return r; }
typedef int i32x4 __attribute__((ext_vector_type(4)));
template <bool I8> struct AccT { typedef f32x4 type; };
template <> struct AccT<true> { typedef i32x4 type; };
struct EpiRowScaleBf16 {
    static constexpr bool PERM = true, AFTER_DRAIN = false;
    bf16_t* O; int ldc; const float* rs;
    __device__ __forceinline__ void operator()(const f32x4 (&acc)[2][2][4][2], const Unit& u, int wr, int wc, int fr, int fq) const {
        const int row0 = u.pm * BM + wr * 64 + fr, col0 = u.pn * BM + wc * 32 + 8 * fq;
#pragma unroll
        for (int ai = 0; ai < 2; ++ai)
#pragma unroll
            for (int m = 0; m < 4; ++m) { const int row = row0 + ai * HALF + m * 16; const float s = rs ? rs[row] : 1.f; bf16_t* rowp = O + (size_t)row * ldc + col0;
#pragma unroll
                for (int bj = 0; bj < 2; ++bj) { const f32x4 v0 = acc[ai][bj][m][0] * s, v1 = acc[ai][bj][m][1] * s;
                    u32x4 w; w.x = cvt_pk_bf16(v0[0], v0[1]); w.y = cvt_pk_bf16(v0[2], v0[3]); w.z = cvt_pk_bf16(v1[0], v1[1]); w.w = cvt_pk_bf16(v1[2], v1[3]);
                    *(u32x4*)(rowp + bj * HALF) = w; } }
    }
};
struct EpiI8Qk {
    static constexpr bool PERM = true, AFTER_DRAIN = false;
    bf16_t* O; int ldc; const float* rs; const float* cs; const float* qg; const float* kg; PG8_LAS float* P; int qk_lo, q_hi, qk_hi, seqmask; float qscale;
    __device__ __forceinline__ void operator()(const i32x4 (&acc)[2][2][4][2], const Unit& u, int wr, int wc, int fr, int fq) const {
        const int row0 = u.pm * BM + wr * 64 + fr, col0 = u.pn * BM + wc * 32 + 8 * fq;
        f32x4 cv[2][2];
#pragma unroll
        for (int bj = 0; bj < 2; ++bj) { cv[bj][0] = *(const f32x4*)(cs + col0 + bj * HALF); cv[bj][1] = *(const f32x4*)(cs + col0 + bj * HALF + 4); }
        const bool qk = u.pn >= qk_lo && u.pn < qk_hi;
        float rq[2][4][2];
        if (qk) {
#pragma unroll
            for (int ai = 0; ai < 2; ++ai)
#pragma unroll
                for (int m = 0; m < 4; ++m) { const float s = rs[row0 + ai * HALF + m * 16]; const int rl = ai * HALF + wr * 64 + m * 16 + fr;
#pragma unroll
                    for (int bj = 0; bj < 2; ++bj) { const i32x4 a0 = acc[ai][bj][m][0], a1 = acc[ai][bj][m][1]; const f32x4 c0 = cv[bj][0] * s, c1 = cv[bj][1] * s; float ss = 0.f;
#pragma unroll
                        for (int i = 0; i < 4; ++i) { const float x0 = (float)a0[i] * c0[i], x1 = (float)a1[i] * c1[i]; ss += x0 * x0 + x1 * x1; }
                        ss += __shfl_xor(ss, 16); ss += __shfl_xor(ss, 32);
                        if (fq == 0) P[rl * 8 + bj * 4 + wc] = ss; } }
            asm volatile("s_waitcnt lgkmcnt(0)" ::: "memory"); __builtin_amdgcn_s_barrier(); asm volatile("" ::: "memory");
#pragma unroll
            for (int ai = 0; ai < 2; ++ai)
#pragma unroll
                for (int m = 0; m < 4; ++m) { const int rl = ai * HALF + wr * 64 + m * 16 + fr;
#pragma unroll
                    for (int bj = 0; bj < 2; ++bj) { const f32x4 p = *(const PG8_LAS f32x4*)(P + rl * 8 + bj * 4); rq[ai][m][bj] = __builtin_amdgcn_rsqf(((p[0] + p[1]) + (p[2] + p[3])) * (1.f / 128.f) + 1e-6f); } }
        }
        const bool isq = u.pn < q_hi; const float* gp = (isq ? qg : kg) + wc * 32 + 8 * fq; f32x4 g0 = {1.f, 1.f, 1.f, 1.f}, g1 = g0;
        if (qk) { g0 = *(const f32x4*)gp; g1 = *(const f32x4*)(gp + 4); if (isq) { g0 = g0 * qscale; g1 = g1 * qscale; } }
        constexpr float RV[16] = {1.591549431e-01f, 7.008652159e-02f, 3.086376340e-02f, 1.359137064e-02f, 5.985185713e-03f, 2.635675899e-03f, 1.160663641e-03f, 5.111175045e-04f, 2.250790790e-04f, 9.911730937e-05f, 4.364795279e-05f, 1.922110068e-05f, 8.464330808e-06f, 3.727408602e-06f, 1.641426263e-06f, 7.228293069e-07f};
#pragma unroll
        for (int ai = 0; ai < 2; ++ai)
#pragma unroll
            for (int m = 0; m < 4; ++m) { const int row = row0 + ai * HALF + m * 16; const float s = rs[row]; bf16_t* rowp = O + (size_t)row * ldc + col0;
                float cs8[8], sn8[8];
                if (qk && wc == 0) { const float pos = (float)(row & seqmask);
#pragma unroll
                    for (int e8 = 0; e8 < 8; ++e8) { const float rev = pos * ((fq & 1) ? RV[8 + e8] : RV[e8]); const float fr_ = rev - __builtin_floorf(rev); cs8[e8] = __builtin_amdgcn_cosf(fr_); sn8[e8] = __builtin_amdgcn_sinf(fr_); } }
#pragma unroll
                for (int bj = 0; bj < 2; ++bj) { const i32x4 a0 = acc[ai][bj][m][0], a1 = acc[ai][bj][m][1]; const float sq = qk ? s * rq[ai][m][bj] : s; const f32x4 c0 = cv[bj][0] * sq * g0, c1 = cv[bj][1] * sq * g1;
                    float v[8];
#pragma unroll
                    for (int i = 0; i < 4; ++i) { v[i] = (float)a0[i] * c0[i]; v[4 + i] = (float)a1[i] * c1[i]; }
                    if (qk && wc == 0) {
#pragma unroll
                        for (int e8 = 0; e8 < 8; ++e8) { const float pr = __shfl_xor(v[e8], 32); v[e8] = (fq < 2) ? (v[e8] * cs8[e8] - pr * sn8[e8]) : (v[e8] * cs8[e8] + pr * sn8[e8]); } }
                    u32x4 w; w.x = cvt_pk_bf16(v[0], v[1]); w.y = cvt_pk_bf16(v[2], v[3]); w.z = cvt_pk_bf16(v[4], v[5]); w.w = cvt_pk_bf16(v[6], v[7]);
                    *(u32x4*)(rowp + bj * HALF) = w; } }
    }
};
struct EpiResid {
    static constexpr bool PERM = true, AFTER_DRAIN = false;
    const float* x; float* out; bf16_t* xb; float* ssp; int ldc;
    __device__ __forceinline__ void operator()(const f32x4 (&acc)[2][2][4][2], const Unit& u, int wr, int wc, int fr, int fq) const {
        const int row0 = u.pm * BM + wr * 64 + fr, col0 = u.pn * BM + wc * 32 + 8 * fq;
#pragma unroll
        for (int ai = 0; ai < 2; ++ai)
#pragma unroll
            for (int m = 0; m < 4; ++m) { const int row = row0 + ai * HALF + m * 16; const size_t off = (size_t)row * ldc + col0; float ss = 0.f;
#pragma unroll
                for (int bj = 0; bj < 2; ++bj) { const f32x4 xa = *(const f32x4*)(x + off + bj * HALF), xc = *(const f32x4*)(x + off + bj * HALF + 4);
                    const f32x4 v0 = acc[ai][bj][m][0] + xa, v1 = acc[ai][bj][m][1] + xc;
                    u32x4 w; w.x = cvt_pk_bf16(v0[0], v0[1]); w.y = cvt_pk_bf16(v0[2], v0[3]); w.z = cvt_pk_bf16(v1[0], v1[1]); w.w = cvt_pk_bf16(v1[2], v1[3]);
                    *(u32x4*)(xb + off + bj * HALF) = w;
                    ss += (v0[0] * v0[0] + v0[1] * v0[1]) + (v0[2] * v0[2] + v0[3] * v0[3]) + (v1[0] * v1[0] + v1[1] * v1[1]) + (v1[2] * v1[2] + v1[3] * v1[3]); }
                ss += __shfl_xor(ss, 16); ss += __shfl_xor(ss, 32);
                if (fq == 0) ssp[(size_t)row * 32 + u.pn * 4 + wc] = ss; }
    }
};
template <class Epi, class Sched, bool ALIGN_EPI = false, bool SP2 = false, bool I8 = false>
__device__ __forceinline__ void gemm_phase(PG8_LAS unsigned char* lds, const Gemm g, const Sched& S, const Epi& E) {
    const int tid = threadIdx.x, wid = __builtin_amdgcn_readfirstlane(tid >> 6), lane = tid & 63, wr = wid >> 2, wc = wid & 3, fr = lane & 15, fq = lane >> 4;
    const int K = g.K, nt = K / BK;
    unsigned voffA[2], voffB[2];
#pragma unroll
    for (int i = 0; i < 2; ++i) { int R, C; stage_rc(tid * 16 + i * 8192, R, C); const int Rb = Epi::PERM ? ((R & ~31) + perm32(R & 31)) : R;
        voffA[i] = (unsigned)(R * K + C) * 2u; voffB[i] = (unsigned)(Rb * K + C) * 2u; }
    const size_t kstep = (size_t)(BK * 2);
    const size_t hstep = (size_t)HALF * K * 2;
    const size_t tstep = 2 * hstep;
    const unsigned ldsw = (unsigned)wid * 1024u;
    const int aoff = lds_byte(wr * 64 + fr, fq * 8), boff = lds_byte(wc * 32 + fr, fq * 8);
#define PG8_SA(b, h) (((b) * 2 + (h)) * HTB)
#define PG8_SB(b, h) ((4 + (b) * 2 + (h)) * HTB)
#define PG8_STAGE(bufoff, gbase, voff) do { _Pragma("unroll") for (int _i = 0; _i < 2; ++_i) \
        __builtin_amdgcn_global_load_lds((const unsigned*)((const char*)(gbase) + (voff)[_i]), (PG8_LAS unsigned*)(lds + (bufoff) + ldsw + _i * 8192), 16, 0, 0); } while (0)
#define PG8_LDA(dst, b, h) do { _Pragma("unroll") for (int m = 0; m < 4; ++m) _Pragma("unroll") for (int k = 0; k < 2; ++k) dst[m][k] = *(const PG8_LAS bf16x8*)(lds + PG8_SA(b, h) + aoff + m * 2048 + k * 1024); } while (0)
#define PG8_LDB(dst, b, h) do { _Pragma("unroll") for (int n = 0; n < 2; ++n) _Pragma("unroll") for (int k = 0; k < 2; ++k) dst[n][k] = *(const PG8_LAS bf16x8*)(lds + PG8_SB(b, h) + boff + n * 2048 + k * 1024); } while (0)
#define PG8_MMA(ai, bj, At, Bt) do { __builtin_amdgcn_s_setprio(1); _Pragma("unroll") for (int m = 0; m < 4; ++m) _Pragma("unroll") for (int n = 0; n < 2; ++n) _Pragma("unroll") for (int k = 0; k < 2; ++k) { \
        if constexpr (I8) acc[ai][bj][m][n] = __builtin_amdgcn_mfma_i32_16x16x64_i8(__builtin_bit_cast(i32x4, Bt[n][k]), __builtin_bit_cast(i32x4, At[m][k]), acc[ai][bj][m][n], 0, 0, 0); \
        else acc[ai][bj][m][n] = __builtin_amdgcn_mfma_f32_16x16x32_bf16(Bt[n][k], At[m][k], acc[ai][bj][m][n], 0, 0, 0); } __builtin_amdgcn_s_setprio(0); } while (0)
#define PG8_WAIT_V(n) asm volatile("s_waitcnt vmcnt(" #n ")" ::: "memory")
#define PG8_WAIT_L(n) asm volatile("s_waitcnt lgkmcnt(" #n ")" ::: "memory")
#define PG8_BAR __builtin_amdgcn_s_barrier()
#define PG8_SCHED __builtin_amdgcn_sched_barrier(0)
    Unit cur, nxt; int ui = 0;
    if (!S.next(0, cur)) return;
    typename AccT<I8>::type acc[2][2][4][2];
#pragma unroll
    for (int a = 0; a < 2; ++a)
#pragma unroll
        for (int b = 0; b < 2; ++b)
#pragma unroll
            for (int m = 0; m < 4; ++m)
#pragma unroll
                for (int n = 0; n < 2; ++n) acc[a][b][m][n] = (typename AccT<I8>::type){};
    bf16x8 At[4][2], B0[2][2], B1[2][2];
    const char* cA = (const char*)g.A + (size_t)cur.pm * tstep; const char* cB = (const char*)g.Bt + (size_t)cur.pn * tstep;
    S.a_ready(cur);
    if constexpr (SP2) {
        PG8_STAGE(PG8_SB(0, 0), cB, voffB); PG8_STAGE(PG8_SB(0, 1), cB + hstep, voffB); PG8_STAGE(PG8_SA(0, 0), cA, voffA); PG8_STAGE(PG8_SA(0, 1), cA + hstep, voffA);
        if (wr == 1) PG8_BAR;
        PG8_WAIT_V(2); PG8_BAR;
        PG8_STAGE(PG8_SB(1, 0), cB + kstep, voffB); PG8_STAGE(PG8_SA(1, 0), cA + kstep, voffA); PG8_STAGE(PG8_SB(1, 1), cB + hstep + kstep, voffB);
        PG8_WAIT_V(6); PG8_BAR;
    } else {
        PG8_STAGE(PG8_SB(0, 0), cB, voffB); PG8_STAGE(PG8_SA(0, 0), cA, voffA); PG8_STAGE(PG8_SB(0, 1), cB + hstep, voffB); PG8_STAGE(PG8_SA(0, 1), cA + hstep, voffA);
        if (wr == 1) PG8_BAR;
        PG8_WAIT_V(4); PG8_BAR;
        PG8_STAGE(PG8_SB(1, 0), cB + kstep, voffB); PG8_STAGE(PG8_SA(1, 0), cA + kstep, voffA); PG8_STAGE(PG8_SB(1, 1), cB + hstep + kstep, voffB);
        PG8_WAIT_V(6); PG8_BAR;
    }
    for (;;) {
        const bool has_next = S.next(ui + 1, nxt);
        const char* nA = has_next ? (const char*)g.A + (size_t)nxt.pm * tstep : cA; const char* nB = has_next ? (const char*)g.Bt + (size_t)nxt.pn * tstep : cB;
        for (int t = 0; t < nt; t += 2) {
            const bool last = (t == nt - 2);
            const char* a1 = cA + (size_t)(t + 1) * kstep;
            const char* a2 = last ? nA : cA + (size_t)(t + 2) * kstep; const char* b2 = last ? nB : cB + (size_t)(t + 2) * kstep;
            const char* a3 = a2 + kstep; const char* b3 = b2 + kstep;
            if (last && has_next) S.a_ready(nxt);
            if constexpr (SP2) {
            PG8_LDB(B0, 0, 0); PG8_LDB(B1, 0, 1); PG8_SCHED; PG8_LDA(At, 0, 0); PG8_STAGE(PG8_SA(1, 1), a1 + hstep, voffA);
            PG8_WAIT_V(8); PG8_WAIT_L(0); PG8_BAR; PG8_MMA(0, 0, At, B0); PG8_MMA(0, 1, At, B1); PG8_BAR; PG8_SCHED;
            PG8_LDA(At, 0, 1); PG8_STAGE(PG8_SB(0, 0), b2, voffB); PG8_STAGE(PG8_SB(0, 1), b2 + hstep, voffB); PG8_STAGE(PG8_SA(0, 0), a2, voffA);
            PG8_WAIT_V(8); PG8_WAIT_L(0); PG8_BAR; PG8_MMA(1, 0, At, B0); PG8_MMA(1, 1, At, B1); PG8_BAR; PG8_SCHED;
            PG8_LDB(B0, 1, 0); PG8_LDB(B1, 1, 1); PG8_SCHED; PG8_LDA(At, 1, 0); PG8_STAGE(PG8_SA(0, 1), a2 + hstep, voffA);
            PG8_WAIT_V(8); PG8_WAIT_L(0); PG8_BAR; PG8_MMA(0, 0, At, B0); PG8_MMA(0, 1, At, B1); PG8_BAR; PG8_SCHED;
            PG8_LDA(At, 1, 1); PG8_STAGE(PG8_SB(1, 0), b3, voffB); PG8_STAGE(PG8_SB(1, 1), b3 + hstep, voffB); PG8_STAGE(PG8_SA(1, 0), a3, voffA);
            PG8_WAIT_V(8); PG8_WAIT_L(0); PG8_BAR; PG8_MMA(1, 0, At, B0); PG8_MMA(1, 1, At, B1); PG8_BAR; PG8_SCHED;
            } else {
            PG8_LDB(B0, 0, 0); PG8_SCHED; PG8_LDA(At, 0, 0); PG8_STAGE(PG8_SA(1, 1), a1 + hstep, voffA);
            PG8_WAIT_L(8); PG8_BAR; PG8_WAIT_L(0); PG8_MMA(0, 0, At, B0); PG8_BAR; PG8_SCHED;
            PG8_LDB(B1, 0, 1); PG8_STAGE(PG8_SB(0, 0), b2, voffB);
            PG8_BAR; PG8_WAIT_L(0); PG8_MMA(0, 1, At, B1); PG8_BAR;
            PG8_LDA(At, 0, 1); PG8_STAGE(PG8_SA(0, 0), a2, voffA);
            PG8_BAR; PG8_WAIT_L(0); PG8_MMA(1, 0, At, B0); PG8_BAR; PG8_SCHED;
            PG8_STAGE(PG8_SB(0, 1), b2 + hstep, voffB);
            PG8_WAIT_V(6); PG8_BAR; PG8_MMA(1, 1, At, B1); PG8_BAR;
            PG8_LDB(B0, 1, 0); PG8_SCHED; PG8_LDA(At, 1, 0); PG8_STAGE(PG8_SA(0, 1), a2 + hstep, voffA);
            PG8_WAIT_L(8); PG8_BAR; PG8_WAIT_L(0); PG8_MMA(0, 0, At, B0); PG8_BAR; PG8_SCHED;
            PG8_LDB(B1, 1, 1); PG8_STAGE(PG8_SB(1, 0), b3, voffB);
            PG8_BAR; PG8_WAIT_L(0); PG8_MMA(0, 1, At, B1); PG8_BAR;
            PG8_LDA(At, 1, 1); PG8_STAGE(PG8_SA(1, 0), a3, voffA);
            PG8_BAR; PG8_WAIT_L(0); PG8_MMA(1, 0, At, B0); PG8_BAR; PG8_SCHED;
            PG8_STAGE(PG8_SB(1, 1), b3 + hstep, voffB);
            PG8_WAIT_V(6); PG8_BAR; PG8_MMA(1, 1, At, B1); PG8_BAR;
            }
        }
        if constexpr (ALIGN_EPI) { if (wr == 0) PG8_BAR; }
        if constexpr (!Epi::AFTER_DRAIN) { E(acc, cur, wr, wc, fr, fq); S.done(cur); }
        if (!has_next) break;
#pragma unroll
        for (int a = 0; a < 2; ++a)
#pragma unroll
            for (int b = 0; b < 2; ++b)
#pragma unroll
                for (int m = 0; m < 4; ++m)
#pragma unroll
                    for (int n = 0; n < 2; ++n) acc[a][b][m][n] = (typename AccT<I8>::type){};
        cur = nxt; cA = nA; cB = nB; ++ui;
        if constexpr (ALIGN_EPI) { if (wr == 1) PG8_BAR; }
    }
    PG8_WAIT_V(0);
    if constexpr (!ALIGN_EPI) { if (wr == 0) PG8_BAR; }
    PG8_BAR;
    if constexpr (Epi::AFTER_DRAIN) { E.fused(acc, cur, wr, wc, fr, fq, lds, wid, lane); S.done(cur); }
#undef PG8_SA
#undef PG8_SB
#undef PG8_STAGE
#undef PG8_LDA
#undef PG8_LDB
#undef PG8_MMA
#undef PG8_WAIT_V
#undef PG8_WAIT_L
#undef PG8_BAR
#undef PG8_SCHED
}
}
#ifndef PG8_SP2
#define PG8_SP2 true
#endif
#ifndef PG8_ALIGN
#define PG8_ALIGN true
#endif

constexpr int BATCH = 2, SEQ = 16384, DM = 2048, T = BATCH * SEQ;
constexpr int INW = 6176, HP = 6400;
constexpr int C_QA = 0, C_KA = 256, C_VA = 512, C_RA = 1024, C_QD = 1536, C_KD = 3072, C_VD = 4608, C_GF = 6144;
constexpr int NHD = 12;
constexpr float EPS = 1e-6f;
constexpr float LOG2E = 1.4426950408889634f;
constexpr float QSCALE = 0.08838834764831845f * LOG2E;
constexpr int NPHASE = 11;

constexpr size_t MiB = 1u << 20;
constexpr size_t WS_CTL = 0, WS_ROPE = 1 * MiB, WS_RS1 = 3 * MiB, WS_RS2 = 3 * MiB + 512 * 1024, WS_SSP = 4 * MiB, WS_WIN = 8 * MiB, WS_WO = 33 * MiB, WS_WQ = 41 * MiB,
                 WS_SK = 49 * MiB, WS_DEC = 50 * MiB, WS_LP = 51 * MiB, WS_IDX = 56 * MiB, WS_GATE = 72 * MiB, WS_DOWN = 88 * MiB, WS_UP = 152 * MiB, WS_XB = 216 * MiB,
                 WS_H = 344 * MiB, WS_X1B = WS_H, WS_QRY = WS_H + 128 * MiB, WS_OP1 = 744 * MiB, WS_OP2 = 840 * MiB, WS_PART = 472 * MiB  , WS_END = 984 * MiB;
constexpr size_t OUT_ST = 0, OUT_OP0 = 128 * MiB;
constexpr int LDS_BYTES = 147456;

#define LAS __attribute__((address_space(3)))
typedef unsigned short bf16_t;
typedef short bf16x8 __attribute__((ext_vector_type(8)));
typedef short s16x4 __attribute__((ext_vector_type(4)));
typedef float f32x4 __attribute__((ext_vector_type(4)));
typedef float f32x2 __attribute__((ext_vector_type(2)));
typedef float f32x16 __attribute__((ext_vector_type(16)));
typedef unsigned u32x4 __attribute__((ext_vector_type(4)));
typedef unsigned u32x2 __attribute__((ext_vector_type(2)));
#define LDS_WAIT() asm volatile("s_waitcnt lgkmcnt(0)" ::: "memory")
#define SBAR() __builtin_amdgcn_sched_barrier(0)

__device__ __forceinline__ float bf2f(unsigned short b) { return __uint_as_float(((unsigned)b) << 16); }
__device__ __forceinline__ float bflo(unsigned w) { return __uint_as_float(w << 16); }
__device__ __forceinline__ float bfhi(unsigned w) { return __uint_as_float(w & 0xffff0000u); }
__device__ __forceinline__ unsigned f2bf(float f) { unsigned u = __float_as_uint(f); return (u + 0x7fffu + ((u >> 16) & 1u)) >> 16; }
__device__ __forceinline__ unsigned pk2(float lo, float hi) { return pg8::cvt_pk_bf16(lo, hi); }
__device__ __forceinline__ float fexp(float x) { return __builtin_amdgcn_exp2f(x * LOG2E); }
__device__ __forceinline__ float flog(float x) { return __builtin_amdgcn_logf(x) * 0.6931471805599453f; }
__device__ __forceinline__ float wave_sum(float v) {
#pragma unroll
    for (int o = 1; o < 64; o <<= 1) v += __shfl_xor(v, o);
    return v;
}
__device__ __forceinline__ int crow(int r, int hi) { return (r & 3) + 8 * (r >> 2) + 4 * hi; }

struct Frame {
    LAS unsigned char* lds; char* ldsg; unsigned char* wsb;
    int tid, lane, wave, vcu, G;
    const float *x, *norm1_g, *w_in, *up_f, *bias_f, *up_b, *bias_b, *out_g, *qn_g, *kn_g, *w_out, *norm2_g, *w_query, *sub_keys, *peer_down, *peer_up;
    float* out;
    __device__ __forceinline__ f32x2* rope_() const { return (f32x2*)((f32x2*)(wsb + WS_ROPE)); }
    __device__ __forceinline__ float* rs1_() const { return (float*)((float*)(wsb + WS_RS1)); }
    __device__ __forceinline__ float* rs2_() const { return (float*)((float*)(wsb + WS_RS2)); }
    __device__ __forceinline__ float* ssp_() const { return (float*)((float*)(wsb + WS_SSP)); }
    __device__ __forceinline__ float* dec_() const { return (float*)((float*)(wsb + WS_DEC)); }
    __device__ __forceinline__ float* lp_() const { return (float*)((float*)(wsb + WS_LP)); }
    __device__ __forceinline__ float* gate_() const { return (float*)((float*)(wsb + WS_GATE)); }
    __device__ __forceinline__ short* part_() const { return (short*)(wsb + WS_PART); }
    __device__ __forceinline__ float* sd_() const { return (float*)((float*)(wsb + WS_CTL + 65536)); }
    __device__ __forceinline__ float* su_() const { return (float*)((float*)(wsb + WS_CTL + 131072)); }
    __device__ __forceinline__ float* sx_() const { return (float*)((float*)(wsb + WS_RS2 + 131072)); }
    __device__ __forceinline__ float* csum_() const { return (float*)((float*)(wsb + WS_RS2 + 262144)); }
    __device__ __forceinline__ unsigned char* down8_() const { return (unsigned char*)(wsb + WS_DOWN); }
    __device__ __forceinline__ unsigned char* up8_() const { return (unsigned char*)(wsb + WS_UP); }
    __device__ __forceinline__ unsigned char* xq8_() const { return (unsigned char*)(wsb + WS_XB); }
    __device__ __forceinline__ unsigned char* fq8_() const { return (unsigned char*)(wsb + WS_XB + 64 * MiB); }
    __device__ __forceinline__ unsigned short* idxT_() const { return (unsigned short*)((unsigned short*)(wsb + WS_XB + 72 * MiB)); }
    __device__ __forceinline__ unsigned* fqT_() const { return (unsigned*)((unsigned*)(wsb + WS_XB + 80 * MiB)); }
    __device__ __forceinline__ unsigned short* idx_() const { return (unsigned short*)(wsb + WS_IDX); }
    __device__ __forceinline__ unsigned short* state_() const { return (unsigned short*)((unsigned short*)((unsigned char*)out + OUT_ST)); }
    __device__ __forceinline__ bf16_t* WinT_() const { return (bf16_t*)((bf16_t*)(wsb + WS_WIN)); }
    __device__ __forceinline__ unsigned char* Win8_() const { return (unsigned char*)(wsb + WS_WIN); }
    __device__ __forceinline__ unsigned char* xq1_() const { return (unsigned char*)(wsb + WS_OP1); }
    __device__ __forceinline__ float* sw_() const { return (float*)((float*)(wsb + WS_CTL + 196608)); }
    __device__ __forceinline__ bf16_t* WoT_() const { return (bf16_t*)((bf16_t*)(wsb + WS_WO)); }
    __device__ __forceinline__ bf16_t* WqT_() const { return (bf16_t*)((bf16_t*)(wsb + WS_WQ)); }
    __device__ __forceinline__ bf16_t* SK_() const { return (bf16_t*)((bf16_t*)(wsb + WS_SK)); }
    __device__ __forceinline__ bf16_t* down16_() const { return (bf16_t*)((bf16_t*)(wsb + WS_DOWN)); }
    __device__ __forceinline__ bf16_t* up16_() const { return (bf16_t*)((bf16_t*)(wsb + WS_UP)); }
    __device__ __forceinline__ bf16_t* xb_() const { return (bf16_t*)((bf16_t*)(wsb + WS_XB)); }
    __device__ __forceinline__ bf16_t* mixed_() const { return (bf16_t*)((bf16_t*)(wsb + WS_XB)); }
    __device__ __forceinline__ bf16_t* h_() const { return (bf16_t*)((bf16_t*)(wsb + WS_H)); }
    __device__ __forceinline__ bf16_t* x1b_() const { return (bf16_t*)((bf16_t*)(wsb + WS_X1B)); }
    __device__ __forceinline__ bf16_t* qry_() const { return (bf16_t*)((bf16_t*)(wsb + WS_QRY)); }
    __device__ __forceinline__ bf16_t* op0_() const { return (bf16_t*)((bf16_t*)((unsigned char*)out + OUT_OP0)); }
    __device__ __forceinline__ bf16_t* op1_() const { return (bf16_t*)((bf16_t*)(wsb + WS_OP1)); }
    __device__ __forceinline__ bf16_t* op2_() const { return (bf16_t*)((bf16_t*)(wsb + WS_OP2)); }
};

__device__ __forceinline__ void p0_transpose_item(const float* W, int K, int N, bf16_t* WT, int k0, int n0, int dst_row0, const float* g, LAS float* scr, int lane) {
#pragma unroll 8
    for (int i = 0; i < 32; ++i) { const int kk = 2 * i + (lane >> 5); float w = W[(size_t)(k0 + kk) * N + n0 + (lane & 31)]; if (g) w *= g[k0 + kk]; scr[kk * 33 + (lane & 31)] = w; }
    LDS_WAIT(); asm volatile("" ::: "memory");
    const int c = lane & 7;
#pragma unroll
    for (int j = 0; j < 4; ++j) { const int n = (lane >> 3) + 8 * j; const LAS float* s = scr + (8 * c) * 33 + n;
        u32x4 o; o.x = pk2(s[0 * 33], s[1 * 33]); o.y = pk2(s[2 * 33], s[3 * 33]); o.z = pk2(s[4 * 33], s[5 * 33]); o.w = pk2(s[6 * 33], s[7 * 33]);
        *(u32x4*)(WT + (size_t)(dst_row0 + n) * K + k0 + 8 * c) = o; }
    LDS_WAIT(); asm volatile("" ::: "memory");
}
__device__ __forceinline__ unsigned pack_nib(unsigned a, unsigned b) { return (a & 0x0F0F0F0Fu) | ((b & 0x0F0F0F0Fu) << 4); }
__device__ __forceinline__ unsigned pack_i8x4(const f32x4 v, float inv, float lim) { unsigned w = 0u;
#pragma unroll
    for (int i = 0; i < 4; ++i) { const int qv = (int)fminf(fmaxf(rintf(v[i] * inv), -lim), lim); w |= ((unsigned)qv & 0xffu) << (8 * i); }
    return w; }
template <bool isup> __device__ __forceinline__ void peer_quant_row(const Frame& F, int e) {
    const int lane = F.lane;
    if constexpr (isup) {
        const f32x4* src = (const f32x4*)(F.peer_up + (size_t)e * DM) + lane;
        f32x4 v[8]; float m = 0.f;
#pragma unroll
        for (int j = 0; j < 8; ++j) { v[j] = src[64 * j];
            m = fmaxf(fmaxf(m, fmaxf(fabsf(v[j][0]), fabsf(v[j][1]))), fmaxf(fabsf(v[j][2]), fabsf(v[j][3]))); }
#pragma unroll
        for (int o = 1; o < 64; o <<= 1) m = fmaxf(m, __shfl_xor(m, o));
        const float inv = m > 0.f ? 127.f / m : 0.f; unsigned char* dst = F.up8_();
#pragma unroll
        for (int j = 0; j < 8; ++j) { const unsigned w = pack_i8x4(v[j], inv, 127.f);
            const int col = 4 * lane + 256 * j; *(unsigned*)(dst + (size_t)(col >> 3) * 131072 + (size_t)e * 8 + (col & 7)) = w; }
        if (lane == 0) F.su_()[e] = m * (1.f / 127.f);
    } else {
        const f32x4* src = (const f32x4*)(F.peer_down + (size_t)e * DM) + 2 * lane; const f32x4* gs = (const f32x4*)F.norm2_g + 2 * lane;
        f32x4 v[8]; float ss = 0.f;
#pragma unroll
        for (int j = 0; j < 4; ++j) { v[2 * j] = src[128 * j] * gs[128 * j]; v[2 * j + 1] = src[128 * j + 1] * gs[128 * j + 1];
#pragma unroll
            for (int i = 0; i < 4; ++i) ss += v[2 * j][i] * v[2 * j][i] + v[2 * j + 1][i] * v[2 * j + 1][i]; }
        ss = wave_sum(ss);
        const float step = 0.345f * sqrtf(ss * (1.f / DM)), inv = step > 0.f ? 1.f / step : 0.f; unsigned char* dst = F.down8_();
#pragma unroll
        for (int j = 0; j < 4; ++j) { const unsigned w = pack_nib(pack_i8x4(v[2 * j], inv, 7.f), pack_i8x4(v[2 * j + 1], inv, 7.f));
            const int col = 8 * lane + 512 * j; *(unsigned*)(dst + ((size_t)(col >> 8) * 16384 + e) * 128 + ((col & 255) >> 3) * 4) = w; }
        if (lane == 0) F.sd_()[e] = step;
    }
}
__device__ __forceinline__ void phase0(const Frame& F) {
    LAS float* scr = (LAS float*)(F.lds + F.wave * 16384);
    const int gw = F.vcu * 8 + F.wave, NGW = F.G * 8, lane = F.lane;
#ifndef P0_DUP
#define P0_DUP 0
#endif
    for (int dupA = 0; dupA < (P0_DUP == 1 ? 2 : 1); ++dupA)
    { LAS float* cmx = (LAS float*)(F.lds + 12288);
      for (int nb = F.vcu; nb < 193; nb += F.G) { const int n0 = nb * 32, drow = nb < 32 ? nb * 32 : (nb == 32 ? C_GF : nb * 32 - 32), kw = F.wave * 256;
        float m = 0.f;
#pragma unroll 16
        for (int i = 0; i < 128; ++i) { const int k = kw + 2 * i + (lane >> 5); m = fmaxf(m, fabsf(F.w_in[(size_t)k * INW + n0 + (lane & 31)] * F.norm1_g[k])); }
        m = fmaxf(m, __shfl_xor(m, 32)); if (lane < 32) cmx[F.wave * 32 + lane] = m;
        __syncthreads();
        if (F.tid < 32) { float mm = 0.f;
#pragma unroll
            for (int w = 0; w < 8; ++w) mm = fmaxf(mm, cmx[w * 32 + F.tid]);
            cmx[256 + F.tid] = mm > 0.f ? 127.f / mm : 0.f; F.sw_()[drow + F.tid] = mm * (1.f / 127.f); }
        __syncthreads();
        for (int ch = 0; ch < 4; ++ch) { const int k0 = kw + 64 * ch;
#pragma unroll 8
            for (int i = 0; i < 32; ++i) { const int kk = 2 * i + (lane >> 5); scr[kk * 33 + (lane & 31)] = F.w_in[(size_t)(k0 + kk) * INW + n0 + (lane & 31)] * F.norm1_g[k0 + kk] * cmx[256 + (lane & 31)]; }
            LDS_WAIT(); asm volatile("" ::: "memory");
            const int c = lane & 7;
#pragma unroll
            for (int j = 0; j < 4; ++j) { const int n = (lane >> 3) + 8 * j; const LAS float* sp = scr + (8 * c) * 33 + n; u32x2 w = {0u, 0u};
#pragma unroll
                for (int i = 0; i < 4; ++i) { w.x |= ((unsigned)(int)rintf(sp[i * 33]) & 0xffu) << (8 * i); w.y |= ((unsigned)(int)rintf(sp[(4 + i) * 33]) & 0xffu) << (8 * i); }
                *(u32x2*)(F.Win8_() + (size_t)(drow + n) * DM + k0 + 8 * c) = w; }
            LDS_WAIT(); asm volatile("" ::: "memory"); }
        __syncthreads(); } }
    constexpr int I_O = 32 * 64, I_Q = 32 * 64;
    for (int dupB = 0; dupB < (P0_DUP == 2 ? 2 : 1); ++dupB)
    for (int it = gw; it < I_O + I_Q; it += NGW) {
        int r = it;
        if (r < I_O) { const int kb = r / 64, nb = r % 64; p0_transpose_item(F.w_out, DM, DM, F.WoT_(), kb * 64, nb * 32, nb * 32, nullptr, scr, lane); continue; }
        r -= I_O;
        { const int kb = r / 64, nb = r % 64; p0_transpose_item(F.w_query, DM, DM, F.WqT_(), kb * 64, nb * 32, nb * 32, F.norm2_g, scr, lane); }
    }
    const size_t gt = (size_t)gw * 64 + lane, NT = (size_t)NGW * 64;
    { u32x4* z = (u32x4*)(F.Win8_() + (size_t)INW * DM); const u32x4 zero = {0u, 0u, 0u, 0u}; for (size_t i = gt; i < (size_t)(HP - INW) * DM / 16; i += NT) z[i] = zero; if (gt < (size_t)(HP - INW)) F.sw_()[INW + gt] = 0.f; }
    for (int dupC = 0; dupC < (P0_DUP == 3 ? 2 : 1); ++dupC) {
    for (int r = gw; r < 16384; r += NGW) peer_quant_row<false>(F, r);
    for (int r = gw; r < 16384; r += NGW) peer_quant_row<true>(F, r); }
    for (size_t i = gt; i < (size_t)8 * 2 * 128 * 128 / 8; i += NT) { const f32x4 a = *(const f32x4*)(F.sub_keys + i * 8), b = *(const f32x4*)(F.sub_keys + i * 8 + 4);
        u32x4 o; o.x = pk2(a[0], a[1]); o.y = pk2(a[2], a[3]); o.z = pk2(b[0], b[1]); o.w = pk2(b[2], b[3]); *(u32x4*)(F.SK_() + i * 8) = o; }
    for (int dupD = 0; dupD < (P0_DUP == 4 ? 2 : 1); ++dupD)
    for (int m = gw; m < T; m += NGW) { const f32x4* xr = (const f32x4*)(F.x + (size_t)m * DM) + lane; f32x4 v[8]; float s = 0.f, mx = 0.f;
#pragma unroll
        for (int j = 0; j < 8; ++j) { v[j] = xr[64 * j]; s += (v[j][0] * v[j][0] + v[j][1] * v[j][1]) + (v[j][2] * v[j][2] + v[j][3] * v[j][3]);
            mx = fmaxf(fmaxf(mx, fmaxf(fabsf(v[j][0]), fabsf(v[j][1]))), fmaxf(fabsf(v[j][2]), fabsf(v[j][3]))); }
        s = wave_sum(s);
#pragma unroll
        for (int o = 1; o < 64; o <<= 1) mx = fmaxf(mx, __shfl_xor(mx, o));
        const float inv = mx > 0.f ? 127.f / mx : 0.f; unsigned* o4 = (unsigned*)(F.xq1_() + (size_t)m * DM) + lane;
#pragma unroll
        for (int j = 0; j < 8; ++j) { unsigned w = 0u;
#pragma unroll
            for (int i = 0; i < 4; ++i) w |= ((unsigned)(int)rintf(v[j][i] * inv) & 0xffu) << (8 * i);
            o4[64 * j] = w; }
        if (lane == 0) F.rs1_()[m] = __builtin_amdgcn_rsqf(s * (1.f / DM) + EPS) * (mx * (1.f / 127.f)); }
    { const double invf[16] = {1.0, 0.44036660267178046, 0.19392274474868576, 0.08539710028576561, 0.03760603093086393, 0.016560440080994446, 0.007292664737217109, 0.003211445994752591,
                               0.001414213562373095, 0.000622772421914596, 0.0002742481756762073, 0.00012076973741146504, 5.318295896944988e-05, 2.341999896140934e-05, 1.031338537721246e-05, 4.5416704806078695e-06};
      for (size_t i = gt; i < (size_t)SEQ * 16; i += NT) { const int pos = (int)(i >> 4), j = (int)(i & 15); double f = 1.0;
#pragma unroll
          for (int q = 0; q < 16; ++q) f = (j == q) ? invf[q] : f;
          const double rev = (double)pos * f * 0.15915494309189535; const float fr = (float)(rev - floor(rev));
          F.rope_()[i] = (f32x2){__builtin_amdgcn_cosf(fr), __builtin_amdgcn_sinf(fr)}; } }
}

__device__ __forceinline__ void qknorm_rope(const Frame& F) {
    const int gw = F.vcu * 8 + F.wave, NGW = F.G * 8, lane = F.lane, c = lane & 15;
    for (long it = gw; it < (long)T * 24 / 4; it += NGW) { const long row = it * 4 + (lane >> 4); const int t = (int)(row / 24), slot = (int)(row % 24);
        bf16_t* p = F.h_() + (size_t)t * HP + C_QD + slot * 128 + 8 * c;
        const u32x4 w = *(const u32x4*)p; float y[8] = {bflo(w.x), bfhi(w.x), bflo(w.y), bfhi(w.y), bflo(w.z), bfhi(w.z), bflo(w.w), bfhi(w.w)};
        float ss = 0.f;
#pragma unroll
        for (int e = 0; e < 8; ++e) ss += y[e] * y[e];
        ss += __shfl_xor(ss, 1); ss += __shfl_xor(ss, 2); ss += __shfl_xor(ss, 4); ss += __shfl_xor(ss, 8);
        const float rq = __builtin_amdgcn_rsqf(ss * (1.f / 128.f) + EPS); const float* g = (slot < 12 ? F.qn_g : F.kn_g) + 8 * c;
        const f32x4 g0 = *(const f32x4*)g, g1 = *(const f32x4*)(g + 4);
#pragma unroll
        for (int e = 0; e < 4; ++e) { y[e] *= rq * g0[e]; y[4 + e] *= rq * g1[e]; }
        const int pos = t & (SEQ - 1);
#pragma unroll
        for (int e = 0; e < 8; ++e) { const float partner = __shfl_xor(y[e], 2);
            if (c < 4) { const f32x2 cs = F.rope_()[(size_t)pos * 16 + 8 * (c & 1) + e]; y[e] = (c < 2) ? (y[e] * cs.x - partner * cs.y) : (y[e] * cs.x + partner * cs.y); } }
        if (slot < 12) {
#pragma unroll
            for (int e = 0; e < 8; ++e) y[e] *= QSCALE; }
        u32x4 o; o.x = pk2(y[0], y[1]); o.y = pk2(y[2], y[3]); o.z = pk2(y[4], y[5]); o.w = pk2(y[6], y[7]); *(u32x4*)p = o; }
}

constexpr int GL_GDS = 0, GL_TOT = 8192, GL_QF = 12288, GL_QB = 21504, GL_KF = 30720, GL_KB = 39936, GL_VT = 49152, GL_P = 67584, GL_SF = 76800, GL_SB = 95232, GL_OB = 12288;
constexpr int RS72 = 144;
__device__ __forceinline__ float logsig(float z) { return fminf(z, 0.f) - flog(1.f + fexp(-fabsf(z))); }
__device__ __forceinline__ void gla_gates(const Frame& F, int b, int hh, int n, float (&bf)[8], float (&bb)[8], float& totf, float& totb) {
    const int tid = F.tid, c = tid & 63, ig = F.wave; LAS float* gds = (LAS float*)(F.lds + GL_GDS); LAS float* tot = (LAS float*)(F.lds + GL_TOT);
    const size_t t0 = (size_t)b * SEQ + (size_t)n * 64;
    if (tid < 256) { const int tk = tid >> 2, part = tid & 3; const u32x4 w = *(const u32x4*)(F.h_() + (t0 + tk) * HP + C_GF + part * 8); LAS float* d = gds + tk * 32 + part * 8;
        d[0] = bflo(w.x); d[1] = bfhi(w.x); d[2] = bflo(w.y); d[3] = bfhi(w.y); d[4] = bflo(w.z); d[5] = bfhi(w.z); d[6] = bflo(w.w); d[7] = bfhi(w.w); }
    __syncthreads();
    const int hc = hh * 64 + c; float upf[16], upb[16];
#pragma unroll
    for (int r = 0; r < 16; ++r) { upf[r] = F.up_f[r * 256 + hc]; upb[r] = F.up_b[r * 256 + hc]; }
    const float biasf = F.bias_f[hc], biasb = F.bias_b[hc]; float laf[8], lab[8];
#pragma unroll
    for (int e = 0; e < 8; ++e) { const LAS float* gr = gds + (ig * 8 + e) * 32; float zf = biasf, zb = biasb;
#pragma unroll
        for (int r = 0; r < 16; ++r) { zf += gr[r] * upf[r]; zb += gr[16 + r] * upb[r]; }
        laf[e] = logsig(zf) * 0.0625f; lab[e] = logsig(zb) * 0.0625f; }
    bf[0] = laf[0];
#pragma unroll
    for (int e = 1; e < 8; ++e) bf[e] = bf[e - 1] + laf[e];
    bb[7] = lab[7];
#pragma unroll
    for (int e = 6; e >= 0; --e) bb[e] = bb[e + 1] + lab[e];
    tot[ig * 64 + c] = bf[7]; tot[512 + ig * 64 + c] = bb[0];
    __syncthreads();
    float offf = 0.f, offb = 0.f; totf = 0.f; totb = 0.f;
#pragma unroll
    for (int g = 0; g < 8; ++g) { const float tf = tot[g * 64 + c], tb = tot[512 + g * 64 + c]; totf += tf; totb += tb; offf += (g < ig) ? tf : 0.f; offb += (g > ig) ? tb : 0.f; }
#pragma unroll
    for (int e = 0; e < 8; ++e) { bf[e] += offf; bb[e] += offb; }
}
__device__ __forceinline__ void gla_stage_vT(const Frame& F, const bf16x8 (&vraw)[2]) {
#pragma unroll
    for (int j = 0; j < 2; ++j) { const int q = F.tid + 512 * j, tk = q >> 4, vc = (q & 15) * 8; LAS short* d = (LAS short*)(F.lds + GL_VT) + vc * 72 + tk;
#pragma unroll
        for (int e = 0; e < 8; ++e) d[e * 72] = vraw[j][e]; }
}
__device__ __forceinline__ bf16x8 ldfrag(const LAS unsigned char* base, int row, int s, int hi) { return *(const LAS bf16x8*)(base + row * RS72 + (16 * s + 8 * hi) * 2); }

__device__ __forceinline__ void gla_passA(const Frame& F, int item) {
    const int bh = item >> 8, n = item & 255, b = bh >> 2, hh = bh & 3, tid = F.tid, c = tid & 63, ig = F.wave, lane = F.lane, r32 = lane & 31, hi = lane >> 5;
    const size_t t0 = (size_t)b * SEQ + (size_t)n * 64;
    unsigned short kraw[8]; bf16x8 vraw[2];
#pragma unroll
    for (int e = 0; e < 8; ++e) kraw[e] = F.h_()[(t0 + ig * 8 + e) * HP + C_KA + hh * 64 + c];
#pragma unroll
    for (int j = 0; j < 2; ++j) { const int q = tid + 512 * j; vraw[j] = *(const bf16x8*)(F.h_() + (t0 + (q >> 4)) * HP + C_VA + hh * 128 + (q & 15) * 8); }
    float bf[8], bb[8], totf, totb; gla_gates(F, b, hh, n, bf, bb, totf, totb);
    float kf[8], kb[8];
#pragma unroll
    for (int e = 0; e < 8; ++e) { const float k = bf2f(kraw[e]); kf[e] = k * fexp(totf - bf[e]); kb[e] = k * fexp(totb - bb[e]); }
    { u32x4 o; o.x = pk2(kf[0], kf[1]); o.y = pk2(kf[2], kf[3]); o.z = pk2(kf[4], kf[5]); o.w = pk2(kf[6], kf[7]); *(LAS u32x4*)(F.lds + GL_KF + c * RS72 + ig * 16) = o;
      o.x = pk2(kb[0], kb[1]); o.y = pk2(kb[2], kb[3]); o.z = pk2(kb[4], kb[5]); o.w = pk2(kb[6], kb[7]); *(LAS u32x4*)(F.lds + GL_KB + c * RS72 + ig * 16) = o; }
    gla_stage_vT(F, vraw);
    if (ig == 0) { F.dec_()[((size_t)(0 * 8 + bh) * 256 + n) * 64 + c] = fexp(totf); F.dec_()[((size_t)(1 * 8 + bh) * 256 + n) * 64 + c] = fexp(totb); }
    __syncthreads();
    const int dir = F.wave >> 2, vt = F.wave & 3; const LAS unsigned char* kimg = F.lds + (dir ? GL_KB : GL_KF);
    f32x16 a0 = {}, a1 = {};
#pragma unroll
    for (int s = 0; s < 4; ++s) { const bf16x8 av = ldfrag(F.lds + GL_VT, 32 * vt + r32, s, hi), b0 = ldfrag(kimg, r32, s, hi), b1 = ldfrag(kimg, 32 + r32, s, hi);
        a0 = __builtin_amdgcn_mfma_f32_32x32x16_bf16(av, b0, a0, 0, 0, 0); a1 = __builtin_amdgcn_mfma_f32_32x32x16_bf16(av, b1, a1, 0, 0, 0); }
    unsigned short* st = F.state_() + ((size_t)(dir * 8 + bh) * 256 + n) * 8192;
#pragma unroll
    for (int r = 0; r < 16; ++r) { const int v = 32 * vt + crow(r, hi); st[v * 64 + r32] = (unsigned short)f2bf(a0[r]); st[v * 64 + 32 + r32] = (unsigned short)f2bf(a1[r]); }
    __syncthreads();
}
__device__ __forceinline__ void gla_scan(const Frame& F, int item) {
    const int dir = item >> 7, bh = (item >> 4) & 7, e = (item & 15) * 512 + F.tid, c = e & 63;
    unsigned short* st = F.state_() + (size_t)(dir * 8 + bh) * 256 * 8192 + e; const float* dc = F.dec_() + (size_t)(dir * 8 + bh) * 256 * 64 + c; float S = 0.f;
    float iA[16], dA[16], iB[16], dB[16];
#define SC_N(g, j) (dir ? 255 - ((g) * 16 + (j)) : (g) * 16 + (j))
#define SC_LOAD(I_, D_, g) do { _Pragma("unroll") for (int j = 0; j < 16; ++j) { const int n_ = SC_N(g, j); I_[j] = bf2f(st[(size_t)n_ * 8192]); D_[j] = dc[n_ * 64]; } } while (0)
#define SC_RUN(I_, D_, g) do { _Pragma("unroll") for (int j = 0; j < 16; ++j) { const int n_ = SC_N(g, j); st[(size_t)n_ * 8192] = (unsigned short)f2bf(S); S = D_[j] * S + I_[j]; } } while (0)
    SC_LOAD(iA, dA, 0);
    for (int g = 0; g < 16; g += 2) { SC_LOAD(iB, dB, g + 1); SC_RUN(iA, dA, g); if (g + 2 < 16) SC_LOAD(iA, dA, g + 2); SC_RUN(iB, dB, g + 1); }
#undef SC_N
#undef SC_LOAD
#undef SC_RUN
}
__device__ __forceinline__ void gla_passC(const Frame& F, int item) {
    const int bh = item >> 8, n = item & 255, b = bh >> 2, hh = bh & 3, tid = F.tid, c = tid & 63, ig = F.wave, lane = F.lane, r32 = lane & 31, hi = lane >> 5;
    const size_t t0 = (size_t)b * SEQ + (size_t)n * 64;
    unsigned short qraw[8], kraw[8]; bf16x8 vraw[2]; u32x4 sraw[2][2];
#pragma unroll
    for (int e = 0; e < 8; ++e) { const bf16_t* hr = F.h_() + (t0 + ig * 8 + e) * HP + hh * 64 + c; qraw[e] = hr[C_QA]; kraw[e] = hr[C_KA]; }
#pragma unroll
    for (int j = 0; j < 2; ++j) { const int q = tid + 512 * j; vraw[j] = *(const bf16x8*)(F.h_() + (t0 + (q >> 4)) * HP + C_VA + hh * 128 + (q & 15) * 8);
#pragma unroll
        for (int dir = 0; dir < 2; ++dir) sraw[dir][j] = *(const u32x4*)(F.state_() + ((size_t)(dir * 8 + bh) * 256 + n) * 8192 + (q >> 3) * 64 + (q & 7) * 8); }
    float bf[8], bb[8], totf, totb; gla_gates(F, b, hh, n, bf, bb, totf, totb);
#pragma unroll
    for (int e = 0; e < 8; ++e) { const int i = ig * 8 + e; const float q = bf2f(qraw[e]) * 0.125f, k = bf2f(kraw[e]);
        const float ef = fexp(bf[e]), eb = fexp(bb[e]), nf = fexp(-bf[e]), nb = fexp(-bb[e]);
        *(LAS unsigned short*)(F.lds + GL_QF + i * RS72 + c * 2) = (unsigned short)f2bf(q * ef); *(LAS unsigned short*)(F.lds + GL_QB + i * RS72 + c * 2) = (unsigned short)f2bf(q * eb);
        *(LAS unsigned short*)(F.lds + GL_KF + i * RS72 + c * 2) = (unsigned short)f2bf(k * nf); *(LAS unsigned short*)(F.lds + GL_KB + i * RS72 + c * 2) = (unsigned short)f2bf(k * nb); }
    gla_stage_vT(F, vraw);
#pragma unroll
    for (int dir = 0; dir < 2; ++dir)
#pragma unroll
        for (int j = 0; j < 2; ++j) { const int q = tid + 512 * j; *(LAS u32x4*)(F.lds + (dir ? GL_SB : GL_SF) + (q >> 3) * RS72 + (q & 7) * 16) = sraw[dir][j]; }
    __syncthreads();
    if (F.wave < 4) { const int ti = F.wave >> 1, tj = F.wave & 1; f32x16 sf = {}, sb = {};
#pragma unroll
        for (int s = 0; s < 4; ++s) {
            sf = __builtin_amdgcn_mfma_f32_32x32x16_bf16(ldfrag(F.lds + GL_QF, 32 * ti + r32, s, hi), ldfrag(F.lds + GL_KF, 32 * tj + r32, s, hi), sf, 0, 0, 0);
            sb = __builtin_amdgcn_mfma_f32_32x32x16_bf16(ldfrag(F.lds + GL_QB, 32 * ti + r32, s, hi), ldfrag(F.lds + GL_KB, 32 * tj + r32, s, hi), sb, 0, 0, 0); }
#pragma unroll
        for (int r = 0; r < 16; ++r) { const int i = 32 * ti + crow(r, hi), j = 32 * tj + r32; const float p = (j <= i) ? sf[r] : sb[r];
            *(LAS unsigned short*)(F.lds + GL_P + i * RS72 + j * 2) = (unsigned short)f2bf(p); } }
    __syncthreads();
    const int ti = F.wave & 1, tv = F.wave >> 1; f32x16 o = {};
#pragma unroll
    for (int s = 0; s < 4; ++s) o = __builtin_amdgcn_mfma_f32_32x32x16_bf16(ldfrag(F.lds + GL_P, 32 * ti + r32, s, hi), ldfrag(F.lds + GL_VT, 32 * tv + r32, s, hi), o, 0, 0, 0);
#pragma unroll
    for (int s = 0; s < 4; ++s) o = __builtin_amdgcn_mfma_f32_32x32x16_bf16(ldfrag(F.lds + GL_QF, 32 * ti + r32, s, hi), ldfrag(F.lds + GL_SF, 32 * tv + r32, s, hi), o, 0, 0, 0);
#pragma unroll
    for (int s = 0; s < 4; ++s) o = __builtin_amdgcn_mfma_f32_32x32x16_bf16(ldfrag(F.lds + GL_QB, 32 * ti + r32, s, hi), ldfrag(F.lds + GL_SB, 32 * tv + r32, s, hi), o, 0, 0, 0);
    __syncthreads();
    LAS float* ob = (LAS float*)(F.lds + GL_OB);
#pragma unroll
    for (int r = 0; r < 16; ++r) ob[(32 * ti + crow(r, hi)) * 132 + 32 * tv + r32] = o[r];
    __syncthreads();
    { const int i = tid >> 3, part = tid & 7, v0 = part * 16; float ov[16], ss = 0.f;
#pragma unroll
      for (int e = 0; e < 16; ++e) { ov[e] = ob[i * 132 + v0 + e]; ss += ov[e] * ov[e]; }
      ss += __shfl_xor(ss, 1); ss += __shfl_xor(ss, 2); ss += __shfl_xor(ss, 4);
      const float rs = __builtin_amdgcn_rsqf(ss * (1.f / 128.f) + EPS); const size_t tok = t0 + i;
      const u32x4 r0 = *(const u32x4*)(F.h_() + tok * HP + C_RA + hh * 128 + v0), r1 = *(const u32x4*)(F.h_() + tok * HP + C_RA + hh * 128 + v0 + 8);
      const float rr[16] = {bflo(r0.x), bfhi(r0.x), bflo(r0.y), bfhi(r0.y), bflo(r0.z), bfhi(r0.z), bflo(r0.w), bfhi(r0.w), bflo(r1.x), bfhi(r1.x), bflo(r1.y), bfhi(r1.y), bflo(r1.z), bfhi(r1.z), bflo(r1.w), bfhi(r1.w)};
      float y[16];
#pragma unroll
      for (int e = 0; e < 16; ++e) { const float g = F.out_g[hh * 128 + v0 + e]; const float sil = rr[e] * __builtin_amdgcn_rcpf(1.f + fexp(-rr[e])); y[e] = ov[e] * rs * g * sil; }
      u32x4 w0, w1; w0.x = pk2(y[0], y[1]); w0.y = pk2(y[2], y[3]); w0.z = pk2(y[4], y[5]); w0.w = pk2(y[6], y[7]); w1.x = pk2(y[8], y[9]); w1.y = pk2(y[10], y[11]); w1.z = pk2(y[12], y[13]); w1.w = pk2(y[14], y[15]);
      bf16_t* mp = F.mixed_() + tok * DM + hh * 128 + v0; *(u32x4*)mp = w0; *(u32x4*)(mp + 8) = w1; }
    __syncthreads();
}

constexpr int AT_V = 0, AT_K = 32768, AT_O = 65536;
#define KSWZ(row, colB) ((row) * 256 + ((colB) ^ (((row) & 7) << 4)))
__device__ __forceinline__ int v_st(int k, int c) { const int kk = (k & ~0xC) | ((k & 4) << 1) | ((k & 8) >> 1); return ((kk >> 3) * 4 + (c >> 5)) * 512 + ((kk & 7) * 32 + (c & 31)) * 2; }
__device__ __forceinline__ int v_rd_base(int lane) { return ((lane & 3) << 3) | (((lane >> 2) & 3) << 6) | (((lane >> 4) & 1) << 5) | (((lane >> 5) & 1) << 8); }
constexpr int v_rd_off(int d0, int ks, int half) { return d0 * 512 + ks * 4096 + half * 2048; }
template <int OFF> __device__ __forceinline__ s16x4 tr_read(int vb) { s16x4 r; asm volatile("ds_read_b64_tr_b16 %0, %1 offset:%2" : "=&v"(r) : "v"(vb), "i"(OFF) : "memory"); return r; }
template <int D0> __device__ __forceinline__ void pv_one(f32x16& od, int vb, bf16x8 pa0, bf16x8 pa1, bf16x8 pa2, bf16x8 pa3) {
    const s16x4 l0 = tr_read<v_rd_off(D0, 0, 0)>(vb), h0 = tr_read<v_rd_off(D0, 0, 1)>(vb), l1 = tr_read<v_rd_off(D0, 1, 0)>(vb), h1 = tr_read<v_rd_off(D0, 1, 1)>(vb);
    const s16x4 l2 = tr_read<v_rd_off(D0, 2, 0)>(vb), h2 = tr_read<v_rd_off(D0, 2, 1)>(vb), l3 = tr_read<v_rd_off(D0, 3, 0)>(vb), h3 = tr_read<v_rd_off(D0, 3, 1)>(vb);
    asm volatile("s_waitcnt lgkmcnt(0)" ::: "memory"); SBAR();
#define PKV(L, H) (bf16x8){L[0], L[1], L[2], L[3], H[0], H[1], H[2], H[3]}
    od = __builtin_amdgcn_mfma_f32_32x32x16_bf16(pa0, PKV(l0, h0), od, 0, 0, 0);
    od = __builtin_amdgcn_mfma_f32_32x32x16_bf16(pa1, PKV(l1, h1), od, 0, 0, 0);
    od = __builtin_amdgcn_mfma_f32_32x32x16_bf16(pa2, PKV(l2, h2), od, 0, 0, 0);
    od = __builtin_amdgcn_mfma_f32_32x32x16_bf16(pa3, PKV(l3, h3), od, 0, 0, 0);
#undef PKV
}
struct AtP { size_t tokbase; int dil, m0, Tf, nt, head, p; };
__device__ __forceinline__ AtP at_decode(int item) {
    AtP P; const int p = item / 1536, rem = item % 1536, b = rem / 768, rem2 = rem % 768, u = rem2 & 63; P.p = p; P.head = rem2 >> 6;
    const int dsh = 2 * p, L = SEQ >> dsh, runs = 64 >> dsh, res = u / runs; P.dil = 1 << dsh; P.m0 = (u % runs) * 256; P.tokbase = (size_t)b * SEQ + res;
    const int kt_lo = (P.m0 == 0) ? 1 : 0, kt_hi = (P.m0 + 256 >= L) ? 4 : 5; P.Tf = P.m0 - 64 + 64 * kt_lo; P.nt = kt_hi - kt_lo + 1; return P;
}
__device__ __forceinline__ void attn_phase(const Frame& F) {
    const int tid = F.tid, wid = F.wave, lane = F.lane, r32 = lane & 31, hi = lane >> 5, G = F.G;
    int ntot = 0; for (int it = F.vcu; it < 4608; it += G) ntot += at_decode(it).nt;
    if (ntot == 0) return;
    const int sr = tid >> 4, sc = (tid & 15) * 8, vst0 = v_st(sr, sc), vst1 = v_st(32 + sr, sc), kc = sc * 2;
    const int vb0 = (int)(unsigned)(uintptr_t)(F.ldsg + AT_V) + v_rd_base(lane);
    int it_ld = F.vcu, rl = 0, it_c = F.vcu, rc = 0; AtP ld = at_decode(it_ld), cur = ld;
    bf16x8 qr[8], qn[8]; f32x16 o[4]; float l_reg = 0.f;
    bf16x8 sA0, sA1, sA2, sA3;
#define AT_QLOAD() do { const bf16_t* qp_ = F.h_() + C_QD + ld.head * 128 + (ld.tokbase + (size_t)ld.dil * (ld.m0 + 32 * wid + r32)) * HP + hi * 8; \
        _Pragma("unroll") for (int d0 = 0; d0 < 8; ++d0) qn[d0] = *(const bf16x8*)(qp_ + d0 * 16); } while (0)
#define AT_SLOAD(S) do { const int T0_ = ld.Tf + 64 * rl; const size_t ra = (ld.tokbase + (size_t)ld.dil * (T0_ + sr)) * HP + ld.head * 128 + sc, rb = ra + (size_t)ld.dil * 32 * HP; \
        S##0 = *(const bf16x8*)(F.h_() + C_VD + ra); S##1 = *(const bf16x8*)(F.h_() + C_VD + rb); S##2 = *(const bf16x8*)(F.h_() + C_KD + ra); S##3 = *(const bf16x8*)(F.h_() + C_KD + rb); \
        if (++rl == ld.nt) { it_ld += G; rl = 0; if (it_ld < 4608) { ld = at_decode(it_ld); AT_QLOAD(); } } } while (0)
#define AT_SWRITE(S, B) do { *(LAS bf16x8*)(F.lds + AT_V + (B) * 16384 + vst0) = S##0; *(LAS bf16x8*)(F.lds + AT_V + (B) * 16384 + vst1) = S##1; \
        *(LAS bf16x8*)(F.lds + AT_K + (B) * 16384 + KSWZ(sr, kc)) = S##2; *(LAS bf16x8*)(F.lds + AT_K + (B) * 16384 + KSWZ(32 + sr, kc)) = S##3; } while (0)
#define PK4(P, BASE, OUT) do { unsigned a0_ = pk2(P[BASE + 0], P[BASE + 1]), a1_ = pk2(P[BASE + 2], P[BASE + 3]); unsigned b0_ = pk2(P[BASE + 4], P[BASE + 5]), b1_ = pk2(P[BASE + 6], P[BASE + 7]); \
        auto r0_ = __builtin_amdgcn_permlane32_swap(a0_, b0_, false, false); auto r1_ = __builtin_amdgcn_permlane32_swap(a1_, b1_, false, false); \
        u32x4 w_ = {r0_[0], r1_[0], r0_[1], r1_[1]}; OUT = __builtin_bit_cast(bf16x8, w_); } while (0)
#define AT_STEP(BUF) do { \
        if (rc == 0) { _Pragma("unroll") for (int d0 = 0; d0 < 8; ++d0) qr[d0] = qn[d0]; _Pragma("unroll") for (int d0 = 0; d0 < 4; ++d0) o[d0] = (f32x16){}; l_reg = 0.f; } \
        const int Q0 = cur.m0 + 32 * wid, T0 = cur.Tf + 64 * rc; \
        if (T0 + 63 >= Q0 - 64 && T0 <= Q0 + 95) {                                        \
            const LAS unsigned char* Ks = F.lds + AT_K + (BUF) * 16384; f32x16 p0 = {}, p1 = {}; \
            _Pragma("unroll") for (int d0 = 0; d0 < 8; ++d0) { const int cb = (d0 * 16 + hi * 8) * 2; \
                const bf16x8 k0 = *(const LAS bf16x8*)(Ks + KSWZ(r32, cb)), k1 = *(const LAS bf16x8*)(Ks + KSWZ(32 + r32, cb)); \
                p0 = __builtin_amdgcn_mfma_f32_32x32x16_bf16(k0, qr[d0], p0, 0, 0, 0); p1 = __builtin_amdgcn_mfma_f32_32x32x16_bf16(k1, qr[d0], p1, 0, 0, 0); } \
            const int dq = T0 - (Q0 + r32); float ps = 0.f;                                \
            _Pragma("unroll") for (int r = 0; r < 16; ++r) { const int e0 = dq + crow(r, hi), e1 = e0 + 32; \
                p0[r] = (e0 >= -64 && e0 <= 64) ? __builtin_amdgcn_exp2f(p0[r]) : 0.f; p1[r] = (e1 >= -64 && e1 <= 64) ? __builtin_amdgcn_exp2f(p1[r]) : 0.f; ps += p0[r] + p1[r]; } \
            l_reg += ps; \
            bf16x8 pa0, pa1, pa2, pa3; PK4(p0, 0, pa0); PK4(p0, 8, pa1); PK4(p1, 0, pa2); PK4(p1, 8, pa3); \
            const int vb = vb0 + (BUF) * 16384; \
            pv_one<0>(o[0], vb, pa0, pa1, pa2, pa3); pv_one<1>(o[1], vb, pa0, pa1, pa2, pa3); pv_one<2>(o[2], vb, pa0, pa1, pa2, pa3); pv_one<3>(o[3], vb, pa0, pa1, pa2, pa3); } \
        if (++rc == cur.nt) {                                                             \
            unsigned char* Op = (cur.p == 0 ? (unsigned char*)F.out + OUT_OP0 : F.wsb + (cur.p == 1 ? WS_OP1 : WS_OP2)); \
            const float lt = l_reg + __shfl_xor(l_reg, 32); \
            LAS unsigned char* stg = F.lds + AT_O + wid * 8192; \
            if (hi == 0) { F.lp_()[((size_t)cur.p * T + cur.tokbase + (size_t)cur.dil * (Q0 + r32)) * NHD + cur.head] = lt; *(LAS float*)(stg + 4096 + r32 * 4) = lt; } \
            LDS_WAIT(); asm volatile("" ::: "memory"); \
            float rli[16]; _Pragma("unroll") for (int r = 0; r < 16; ++r) rli[r] = __builtin_amdgcn_rcpf(*(const LAS float*)(stg + 4096 + crow(r, hi) * 4)); \
            _Pragma("unroll") for (int d0 = 0; d0 < 4; ++d0) _Pragma("unroll") for (int r = 0; r < 16; ++r) *(LAS unsigned char*)(stg + crow(r, hi) * 128 + d0 * 32 + r32) = (unsigned char)__builtin_amdgcn_cvt_pk_fp8_f32(o[d0][r] * rli[r], 0.f, 0, false); \
            LDS_WAIT(); asm volatile("" ::: "memory"); \
            _Pragma("unroll") for (int i_ = 0; i_ < 4; ++i_) { const int row = 8 * i_ + (lane >> 3), ch = lane & 7; const u32x4 w = *(const LAS u32x4*)(stg + row * 128 + ch * 16); \
                *(u32x4*)(Op + (cur.tokbase + (size_t)cur.dil * (Q0 + row)) * (NHD * 128) + cur.head * 128 + ch * 16) = w; } \
            LDS_WAIT(); asm volatile("" ::: "memory"); \
            rc = 0; it_c += G; if (it_c < 4608) cur = at_decode(it_c); } } while (0)
    AT_QLOAD();
    AT_SLOAD(sA); AT_SWRITE(sA, 0); AT_SLOAD(sA); __syncthreads();
    for (int g = 0; g < ntot; ++g) { const int buf = g & 1;
        AT_STEP(buf);
        if (g + 1 < ntot) AT_SWRITE(sA, buf ^ 1);
        if (it_ld < 4608) AT_SLOAD(sA);
        __syncthreads();
    }
#undef AT_QLOAD
#undef AT_SLOAD
#undef AT_SWRITE
#undef PK4
#undef AT_STEP
}
__device__ __forceinline__ void dil_combine(const Frame& F) {
    const int gw = F.vcu * 8 + F.wave, NGW = F.G * 8, lane = F.lane, c = lane & 15;
    const unsigned char* o0 = (const unsigned char*)F.op0_(); const unsigned char* o1 = (const unsigned char*)F.op1_(); const unsigned char* o2 = (const unsigned char*)F.op2_();
    for (long it = gw; it < (long)T * NHD / 4; it += NGW) { const long row = it * 4 + (lane >> 4); const size_t tok = (size_t)(row / NHD); const int head = (int)(row % NHD);
        const float l0 = F.lp_()[tok * NHD + head], l1 = F.lp_()[((size_t)T + tok) * NHD + head], l2 = F.lp_()[((size_t)2 * T + tok) * NHD + head]; const float inv = 1.f / (l0 + l1 + l2), w0 = l0 * inv, w1 = l1 * inv, w2 = l2 * inv;
        const size_t off = tok * (NHD * 128) + head * 128 + 8 * c; const u32x2 a = *(const u32x2*)(o0 + off), b = *(const u32x2*)(o1 + off), d = *(const u32x2*)(o2 + off);
#define DC2(AW, BW, DW, SEL) ({ const f32x2 x_ = __builtin_amdgcn_cvt_pk_f32_fp8((int)(AW), SEL), y_ = __builtin_amdgcn_cvt_pk_f32_fp8((int)(BW), SEL), z_ = __builtin_amdgcn_cvt_pk_f32_fp8((int)(DW), SEL); \
            pk2(w0 * x_[0] + w1 * y_[0] + w2 * z_[0], w0 * x_[1] + w1 * y_[1] + w2 * z_[1]); })
        u32x4 o; o.x = DC2(a.x, b.x, d.x, false); o.y = DC2(a.x, b.x, d.x, true); o.z = DC2(a.y, b.y, d.y, false); o.w = DC2(a.y, b.y, d.y, true);
#undef DC2
        *(u32x4*)(F.mixed_() + tok * DM + 512 + head * 128 + 8 * c) = o; }
}

__device__ __forceinline__ unsigned fl_flip(float x) { const unsigned u = __float_as_uint(x); return u ^ ((unsigned)((int)u >> 31) | 0x80000000u); }
__device__ __forceinline__ float fl_unflip(unsigned w) { return __uint_as_float((w & 0x80000000u) ? (w ^ 0x80000000u) : ~w); }
#define CE_DESC(a, b) do { const unsigned x_ = max(a, b), y_ = min(a, b); a = x_; b = y_; } while (0)
__device__ __forceinline__ void sort16_desc(unsigned (&a)[16]) {
#pragma unroll
    for (int k = 2; k <= 16; k <<= 1)
#pragma unroll
        for (int j = k >> 1; j > 0; j >>= 1)
#pragma unroll
            for (int i = 0; i < 16; ++i) { const int l = i ^ j; if (l > i) { const unsigned x = max(a[i], a[l]), y = min(a[i], a[l]); if ((i & k) == 0) { a[i] = x; a[l] = y; } else { a[i] = y; a[l] = x; } } }
}
__device__ __forceinline__ void bmerge16_desc(unsigned (&a)[16]) {
#pragma unroll
    for (int j = 8; j > 0; j >>= 1)
#pragma unroll
        for (int i = 0; i < 16; ++i) { const int l = i ^ j; if (l > i) CE_DESC(a[i], a[l]); }
}
__device__ __forceinline__ void top16_merge(unsigned (&a)[16], const unsigned (&b)[16]) {
#pragma unroll
    for (int i = 0; i < 16; ++i) a[i] = max(a[i], b[15 - i]);
    bmerge16_desc(a);
}
__device__ __forceinline__ void top16_partner(unsigned (&a)[16]) {
    unsigned b[16];
#pragma unroll
    for (int i = 0; i < 16; ++i) b[i] = (unsigned)__shfl_xor((int)a[i], 32);
    top16_merge(a, b);
}
__device__ constexpr unsigned char stair(int n) {
    constexpr unsigned char L[64] = {0x00,0x01,0x02,0x03,0x04,0x05,0x06,0x07,0x08,0x09,0x0a,0x0b,0x0c,0x0d,0x0e,0x0f,0x10,0x11,0x12,0x13,0x14,0x15,0x16,0x17,0x20,0x21,0x22,0x23,0x24,0x30,0x31,0x32,
                                     0x33,0x40,0x41,0x42,0x50,0x51,0x60,0x61,0x70,0x71,0x80,0x90,0xa0,0xb0,0xc0,0xd0,0xe0,0xf0,0xff,0xff,0xff,0xff,0xff,0xff,0xff,0xff,0xff,0xff,0xff,0xff,0xff,0xff};
    return L[n];
}
constexpr int TK_KEYS = 32768;
__device__ __forceinline__ void topk_item(const Frame& F, int hh, int tg) {
    const int lane = F.lane, r32 = lane & 31, hi = lane >> 5, tok0 = tg * 32; const size_t tok = (size_t)tok0 + r32;
    LAS int* ktab = (LAS int*)(F.lds + F.wave * 4096) + r32 * 32;
    float ss = 0.f;
    { const f32x4* sp = (const f32x4*)(F.ssp_() + tok * 32 + hi * 16);
#pragma unroll
      for (int j = 0; j < 4; ++j) { const f32x4 v = sp[j]; ss += (v[0] + v[1]) + (v[2] + v[3]); } }
    ss += __shfl_xor(ss, 32);
    const float rs2 = __builtin_amdgcn_rsqf(ss * (1.f / DM) + EPS);
    if (hh == 0 && hi == 0) F.rs2_()[tok] = rs2;
    unsigned top[2][16];
#pragma unroll
    for (int cc = 0; cc < 2; ++cc) {
        f32x16 acc[4] = {};
        const bf16_t* qp = F.qry_() + tok * DM + hh * 256 + cc * 128 + hi * 8; const LAS unsigned char* kl = F.lds + TK_KEYS + cc * 32768;
        bf16x8 qf[8];
#pragma unroll
        for (int s = 0; s < 8; ++s) qf[s] = *(const bf16x8*)(qp + 16 * s);
#pragma unroll
        for (int s = 0; s < 8; ++s) {
#pragma unroll
            for (int kt = 0; kt < 4; ++kt) { const bf16x8 kf = *(const LAS bf16x8*)(kl + KSWZ(kt * 32 + r32, (16 * s + 8 * hi) * 2)); acc[kt] = __builtin_amdgcn_mfma_f32_32x32x16_bf16(kf, qf[s], acc[kt], 0, 0, 0); } }
        unsigned g[4][16];
#pragma unroll
        for (int kt = 0; kt < 4; ++kt) {
#pragma unroll
            for (int r = 0; r < 16; ++r) g[kt][r] = (fl_flip(acc[kt][r]) & ~127u) | (unsigned)(127 - (32 * kt + crow(r, hi)));
            sort16_desc(g[kt]); }
        top16_merge(g[0], g[1]); top16_merge(g[2], g[3]); top16_merge(g[0], g[2]); top16_partner(g[0]);
#pragma unroll
        for (int i = 0; i < 16; ++i) top[cc][i] = g[0][i];
    }
#pragma unroll
    for (int i = 0; i < 16; ++i) ktab[hi * 16 + i] = 127 - (int)((hi ? top[1][i] : top[0][i]) & 127u);
    float s0[16], s1[16];
#pragma unroll
    for (int i = 0; i < 16; ++i) { s0[i] = fl_unflip(top[0][i] & ~127u); s1[i] = fl_unflip(top[1][i] & ~127u); }
    unsigned ca[16], cb[16];
#pragma unroll
    for (int n = 0; n < 32; ++n) { const int A = stair(n), B = stair(25 + n); unsigned va = 0u, vb = 0u;
        if (n < 25) { va = (fl_flip(s0[A >> 4] + s1[A & 15]) & ~255u) | (unsigned)(255 - A); vb = (fl_flip(s0[B >> 4] + s1[B & 15]) & ~255u) | (unsigned)(255 - B); }
        const unsigned v = hi ? vb : va; if (n < 16) ca[n] = v; else cb[n - 16] = v; }
    sort16_desc(ca); sort16_desc(cb); top16_merge(ca, cb); top16_partner(ca);
    float e[16], sum = 0.f; const float mx = fl_unflip(ca[0] & ~255u) * rs2;
#pragma unroll
    for (int i = 0; i < 16; ++i) { e[i] = fexp(fl_unflip(ca[i] & ~255u) * rs2 - mx); sum += e[i]; }
    const float inv = 1.f / sum;
    LDS_WAIT(); asm volatile("" ::: "memory");
    int oi[8]; float og[8];
#pragma unroll
    for (int k = 0; k < 8; ++k) { const unsigned cv = hi ? ca[8 + k] : ca[k]; const int code = 255 - (int)(cv & 255u); og[k] = (hi ? e[8 + k] : e[k]) * inv; oi[k] = ktab[code >> 4] * 128 + ktab[16 + (code & 15)]; }
    { unsigned short* ip = F.idx_() + tok * 128 + hh * 16 + hi * 8; float* gp = F.gate_() + tok * 128 + hh * 16 + hi * 8;
      *(u32x4*)ip = (u32x4){(unsigned)oi[0] | ((unsigned)oi[1] << 16), (unsigned)oi[2] | ((unsigned)oi[3] << 16), (unsigned)oi[4] | ((unsigned)oi[5] << 16), (unsigned)oi[6] | ((unsigned)oi[7] << 16)};
      { const int g0 = hh * 4 + hi * 2;
        *(u32x2*)(F.idxT_() + ((size_t)g0 * T + tok) * 4) = (u32x2){(unsigned)oi[0] | ((unsigned)oi[1] << 16), (unsigned)oi[2] | ((unsigned)oi[3] << 16)};
        *(u32x2*)(F.idxT_() + ((size_t)(g0 + 1) * T + tok) * 4) = (u32x2){(unsigned)oi[4] | ((unsigned)oi[5] << 16), (unsigned)oi[6] | ((unsigned)oi[7] << 16)}; }
      *(f32x4*)gp = (f32x4){og[0], og[1], og[2], og[3]}; *(f32x4*)(gp + 4) = (f32x4){og[4], og[5], og[6], og[7]}; }
    LDS_WAIT(); asm volatile("" ::: "memory");
}

constexpr int PS_NSL = 8, PS_CW = DM / PS_NSL, PS_SUB = PS_NSL / 8, PS_TG = 32, PS_NTG = T / PS_TG;
__device__ __forceinline__ float gelu_tanh(float x) { const float u = 0.7978845608028654f * (x + 0.044715f * x * x * x); const float t = 1.f - 2.f * __builtin_amdgcn_rcpf(1.f + fexp(2.f * u)); return 0.5f * x * (1.f + t); }
__device__ __forceinline__ int dot32n(u32x4 w, u32x4 xh, u32x4 xl) {
    int ph = __builtin_amdgcn_sdot8((int)w.x, (int)xh.x, 0, false); ph = __builtin_amdgcn_sdot8((int)w.y, (int)xh.y, ph, false); ph = __builtin_amdgcn_sdot8((int)w.z, (int)xh.z, ph, false); ph = __builtin_amdgcn_sdot8((int)w.w, (int)xh.w, ph, false);
    int pl = __builtin_amdgcn_sdot8((int)w.x, (int)xl.x, 0, false); pl = __builtin_amdgcn_sdot8((int)w.y, (int)xl.y, pl, false); pl = __builtin_amdgcn_sdot8((int)w.z, (int)xl.z, pl, false); pl = __builtin_amdgcn_sdot8((int)w.w, (int)xl.w, pl, false);
    return (ph << 4) + pl; }
__device__ __forceinline__ unsigned xcc_id() { return (unsigned)__builtin_amdgcn_s_getreg((3 << 11) | 20) & 7u; }
__device__ __forceinline__ bool peer_claim(unsigned* cnt, unsigned x, unsigned& d, int lane, int& q, int& tg) {
    while (d < 8u) { const unsigned xq = (x + d) & 7u; unsigned u = 0u;
        if (lane == 0) u = __hip_atomic_fetch_add(cnt + 64 * xq, 1u, __ATOMIC_RELAXED, __HIP_MEMORY_SCOPE_AGENT);
        u = (unsigned)__builtin_amdgcn_readfirstlane((int)u);
        if (u < (unsigned)(PS_SUB * PS_NTG)) { q = (int)(u / PS_NTG) * 8 + (int)xq; tg = (int)(u % PS_NTG); return true; }
        ++d; }
    return false;
}
template <int CTRL> __device__ __forceinline__ float dppmov(float x) { return __int_as_float(__builtin_amdgcn_update_dpp(0, __float_as_int(x), CTRL, 0xf, 0xf, true)); }
template <int CTRL> __device__ __forceinline__ int dppmovi(int x) { return __builtin_amdgcn_update_dpp(0, x, CTRL, 0xf, 0xf, true); }
__device__ __forceinline__ int bperm(int srclane, int v) { return __builtin_amdgcn_ds_bpermute(srclane << 2, v); }
__device__ __forceinline__ unsigned swar_add8(unsigned q) { return ((q & 0x7f7f7f7fu) + 0x08080808u) ^ (q & 0x80808080u); }
__device__ __forceinline__ void peer_quant_x(const Frame& F) {
    const int gw = F.vcu * 8 + F.wave, NGW = F.G * 8, lane = F.lane;
    for (int tok = gw; tok < T; tok += NGW) { const u32x4* xr = (const u32x4*)(F.x1b_() + (size_t)tok * DM) + lane; f32x4 v[4][2]; float m = 0.f;
#pragma unroll
        for (int j = 0; j < 4; ++j) { const u32x4 w = xr[64 * j]; v[j][0] = (f32x4){bflo(w.x), bfhi(w.x), bflo(w.y), bfhi(w.y)}; v[j][1] = (f32x4){bflo(w.z), bfhi(w.z), bflo(w.w), bfhi(w.w)};
#pragma unroll
            for (int i = 0; i < 4; ++i) m = fmaxf(m, fmaxf(fabsf(v[j][0][i]), fabsf(v[j][1][i]))); }
#pragma unroll
        for (int o = 1; o < 64; o <<= 1) m = fmaxf(m, __shfl_xor(m, o));
        const float inv = m > 0.f ? 119.f / m : 0.f;
#pragma unroll
        for (int j = 0; j < 4; ++j) { const unsigned qa = pack_i8x4(v[j][0], inv, 119.f), qb = pack_i8x4(v[j][1], inv, 119.f);
            const unsigned wl = pack_nib(qa, qb), wh = pack_nib(swar_add8(qa) >> 4, swar_add8(qb) >> 4);
            const int col = 8 * lane + 512 * j; unsigned char* p = F.xq8_() + (size_t)tok * DM + (col >> 8) * 256 + ((col & 255) >> 5) * 32 + ((col & 31) >> 3) * 4;
            *(unsigned*)p = wh; *(unsigned*)(p + 16) = wl; }
        if (lane == 0) F.sx_()[tok] = m * (1.f / 119.f); }
}
__device__ __forceinline__ void peer_down(const Frame& F, int cntw = 1024) {
    const int lane = F.lane, g = lane >> 3, c = lane & 7; const unsigned x = xcc_id(); unsigned d = 0u; int q, tg; unsigned* cnt = (unsigned*)(F.wsb + WS_CTL) + cntw;
    const unsigned char* tab = F.down8_(); const unsigned char* xb = F.xq8_();
    while (peer_claim(cnt, x, d, lane, q, tg)) {
        const unsigned colb = (unsigned)(q * PS_CW + 32 * c), slb = (unsigned)q * (16384u * 128u) + 16u * c; short* part = F.part_() + (size_t)q * T * 128; const size_t tok0 = (size_t)tg * PS_TG;
        u32x4 wA[16], wB[16], xA, xB, yA, yB; int iA0, iA1, iB0, iB1;
#define PD_IDX(i0, i1, tok) do { const unsigned short* ip_ = F.idx_() + (tok) * 128 + lane; i0 = ip_[0]; i1 = ip_[64]; } while (0)
#define PD_ROWS(W_, X_, Y_, i0, i1, tok) do { _Pragma("unroll") for (int j = 0; j < 16; ++j) { const unsigned e_ = (unsigned)bperm(8 * (j & 7) + g, j < 8 ? i0 : i1); \
            W_[j] = *(const u32x4*)(tab + (e_ * 128u + slb)); } X_ = *(const u32x4*)(xb + (tok) * DM + colb); Y_ = *(const u32x4*)(xb + (tok) * DM + colb + 16); } while (0)
#define PD_COMP(W_, X_, Y_, tok) do { int p[16]; _Pragma("unroll") for (int j = 0; j < 16; ++j) p[j] = dot32n(W_[j], X_, Y_); \
            int a1[8], a2[4], a3[2]; \
            _Pragma("unroll") for (int i = 0; i < 8; ++i) { const int keep = (c & 1) ? p[2 * i + 1] : p[2 * i], give = (c & 1) ? p[2 * i] : p[2 * i + 1]; a1[i] = keep + dppmovi<0xB1>(give); } \
            _Pragma("unroll") for (int i = 0; i < 4; ++i) { const int keep = (c & 2) ? a1[2 * i + 1] : a1[2 * i], give = (c & 2) ? a1[2 * i] : a1[2 * i + 1]; a2[i] = keep + dppmovi<0x4E>(give); } \
            _Pragma("unroll") for (int i = 0; i < 2; ++i) { const int keep = (c & 4) ? a2[2 * i + 1] : a2[2 * i], give = (c & 4) ? a2[2 * i] : a2[2 * i + 1]; a3[i] = keep + __shfl_xor(give, 4); } \
            part[(tok) * 128 + 8 * c + g] = (short)min(max(a3[0], -32768), 32767); part[(tok) * 128 + 64 + 8 * c + g] = (short)min(max(a3[1], -32768), 32767); } while (0)
        PD_IDX(iA0, iA1, tok0); PD_IDX(iB0, iB1, tok0 + 1);
        PD_ROWS(wA, xA, yA, iA0, iA1, tok0);
        for (int tt = 0; tt < PS_TG; tt += 2) { const size_t tok = tok0 + tt;
            PD_ROWS(wB, xB, yB, iB0, iB1, tok + 1);
            const size_t t2 = tok + (tt + 2 < PS_TG ? 2 : 0), t3 = tok + (tt + 2 < PS_TG ? 3 : 1);
            PD_IDX(iA0, iA1, t2);
            PD_COMP(wA, xA, yA, tok);
            if (tt + 2 < PS_TG) PD_ROWS(wA, xA, yA, iA0, iA1, t2);
            PD_IDX(iB0, iB1, t3);
            PD_COMP(wB, xB, yB, tok + 1);
        }
#undef PD_IDX
#undef PD_ROWS
#undef PD_COMP
    }
}
__device__ __forceinline__ void peer_coef_probe(const Frame& F, bool dry) {
    const int gw = F.vcu * 8 + F.wave, NGW = F.G * 8, lane = F.lane;
    for (int tok = gw; tok < T; tok += NGW) { int a0 = 0, a1 = 0; const short* pp = F.part_() + (size_t)tok * 128 + lane;
#pragma unroll
        for (int q = 0; q < PS_NSL; ++q) { a0 += pp[(size_t)q * T * 128]; a1 += pp[(size_t)q * T * 128 + 64]; }
        const float sc = F.rs2_()[tok] * F.sx_()[tok]; const float* gp = F.gate_() + (size_t)tok * 128 + lane; const int e0 = F.idx_()[(size_t)tok * 128 + lane], e1 = F.idx_()[(size_t)tok * 128 + 64 + lane];
        const float c0 = gp[0] * gelu_tanh((float)a0 * sc * F.sd_()[e0]) * F.su_()[e0], c1 = gp[64] * gelu_tanh((float)a1 * sc * F.sd_()[e1]) * F.su_()[e1];
        float m = fmaxf(fabsf(c0), fabsf(c1));
#pragma unroll
        for (int o = 1; o < 64; o <<= 1) m = fmaxf(m, __shfl_xor(m, o));
        const float inv = m > 0.f ? 127.f / m : 0.f; const int q0 = (int)rintf(c0 * inv), q1 = (int)rintf(c1 * inv);
        unsigned char* fp = dry ? F.wsb + WS_PART + 256 * MiB : (unsigned char*)F.fqT_();
        { const int k0 = lane, k1 = 64 + lane; fp[((size_t)(k0 >> 2) * T + tok) * 4 + (k0 & 3)] = (unsigned char)q0; fp[((size_t)(k1 >> 2) * T + tok) * 4 + (k1 & 3)] = (unsigned char)q1; }
        if (lane == 0 && !dry) F.csum_()[tok] = m * (1.f / 127.f); }
}
#ifndef PROBE_PHASE
#define PROBE_PHASE -1
#endif
#define UP_NREP ((PROBE_PHASE == 10) ? 2 : 1)
constexpr int U2_XO = 131072 + 2048, U2_SF = U2_XO + 8192;
#define PU_T4(ACC_, R0, R1, R2, R3, FQ_) do { const unsigned t0_ = __builtin_amdgcn_perm(R1, R0, 0x05010400u), t1_ = __builtin_amdgcn_perm(R1, R0, 0x07030602u), t2_ = __builtin_amdgcn_perm(R3, R2, 0x05010400u), t3_ = __builtin_amdgcn_perm(R3, R2, 0x07030602u); \
            ACC_[0] = __builtin_amdgcn_sdot4((int)__builtin_amdgcn_perm(t2_, t0_, 0x05040100u), FQ_, ACC_[0], false); ACC_[1] = __builtin_amdgcn_sdot4((int)__builtin_amdgcn_perm(t2_, t0_, 0x07060302u), FQ_, ACC_[1], false); \
            ACC_[2] = __builtin_amdgcn_sdot4((int)__builtin_amdgcn_perm(t3_, t1_, 0x05040100u), FQ_, ACC_[2], false); ACC_[3] = __builtin_amdgcn_sdot4((int)__builtin_amdgcn_perm(t3_, t1_, 0x07060302u), FQ_, ACC_[3], false); } while (0)
__device__ __forceinline__ unsigned u2_addr_lo(unsigned w, unsigned base) { unsigned a; asm("v_mad_u32_u16 %0, %1, 8, %2" : "=v"(a) : "v"(w), "s"(base)); return a; }
__device__ __forceinline__ unsigned u2_addr_hi(unsigned w, unsigned base) { unsigned a; asm("v_mad_u32_u16 %0, %1, 8, %2 op_sel:[1,0,0,0]" : "=v"(a) : "v"(w), "s"(base)); return a; }
__device__ __forceinline__ void peer_up(const Frame& F) {
    const int lane = F.lane;
    for (int cgi = F.vcu; cgi < 256 * UP_NREP; cgi += F.G) { const int cg = cgi & 255; const bool dry = cgi >= 256; float* const ob_ = dry ? (float*)(F.wsb + WS_PART) : F.out; const unsigned tmask_ = dry ? 16383u : 0xffffffffu;
        __syncthreads();
        { const u32x4* src = (const u32x4*)(F.up8_() + (size_t)cg * 131072);
#pragma unroll 4
          for (int i = 0; i < 16; ++i) { const int o = F.tid + 512 * i; *(LAS u32x4*)(F.lds + o * 16) = src[o]; } }
        __syncthreads();
        u32x2 S0i[8], S1i[8], S2i[8], S3i[8]; int S0f[8], S1f[8], S2f[8], S3f[8]; u32x2 R0[16], R1[16];
        const __amdgpu_buffer_rsrc_t rsI = __builtin_amdgcn_make_buffer_rsrc((void*)F.idxT_(), 0, 32 * T * 8, 0x00020000), rsF = __builtin_amdgcn_make_buffer_rsrc((void*)F.fqT_(), 0, 32 * T * 4, 0x00020000),
            rsX = __builtin_amdgcn_make_buffer_rsrc((void*)F.x1b_(), 0, T * DM * 2, 0x00020000), rsC = __builtin_amdgcn_make_buffer_rsrc((void*)F.csum_(), 0, T * 4, 0x00020000);
#define U2_FENCE() do { asm volatile("" ::: "memory"); SBAR(); } while (0)
#ifdef UP_PROBE_NOCONF
#define U2_IDMASK(id) do { id.x &= idmask_; id.y &= idmask_; } while (0)
        const unsigned idmask_ = dry ? 0u : 0xffffffffu;
#else
#define U2_IDMASK(id) do { } while (0)
#endif
#define U2_LOAD(S_, tok_, s_) do { const unsigned vo_ = (unsigned)(tok_) * 8u; _Pragma("unroll") for (int g = 0; g < 8; ++g) { S_##i[g] = __builtin_amdgcn_raw_buffer_load_b64(rsI, vo_, ((s_) * 8 + g) * (T * 8), 0); \
            S_##f[g] = (int)__builtin_amdgcn_raw_buffer_load_b32(rsF, vo_ >> 1, ((s_) * 8 + g) * (T * 4), 0); } U2_FENCE(); } while (0)
#define U2_ISSUE(R_, S_, h_) do { _Pragma("unroll") for (int g = 0; g < 4; ++g) { u32x2 id = S_##i[(h_) * 4 + g]; U2_IDMASK(id); \
                R_[4 * g + 0] = *(const LAS u32x2*)(uintptr_t)u2_addr_lo(id.x, lbase_); R_[4 * g + 1] = *(const LAS u32x2*)(uintptr_t)u2_addr_hi(id.x, lbase_); \
                R_[4 * g + 2] = *(const LAS u32x2*)(uintptr_t)u2_addr_lo(id.y, lbase_); R_[4 * g + 3] = *(const LAS u32x2*)(uintptr_t)u2_addr_hi(id.y, lbase_); } U2_FENCE(); } while (0)
#define U2_FOLD(R_, S_, h_) do { _Pragma("unroll") for (int g = 0; g < 4; ++g) { const int fq = S_##f[(h_) * 4 + g]; \
                int* a_ = acc; PU_T4(a_, R_[4 * g + 0].x, R_[4 * g + 1].x, R_[4 * g + 2].x, R_[4 * g + 3].x, fq); a_ = acc + 4; PU_T4(a_, R_[4 * g + 0].y, R_[4 * g + 1].y, R_[4 * g + 2].y, R_[4 * g + 3].y, fq); } U2_FENCE(); } while (0)
        const int nb = (T / 64 - F.wave + 7) / 8;
        const unsigned lbase_ = (unsigned)__builtin_amdgcn_readfirstlane((int)(unsigned)(uintptr_t)F.ldsg);
        unsigned lane_; asm volatile("v_mbcnt_lo_u32_b32 %0, -1, 0\n\tv_mbcnt_hi_u32_b32 %0, -1, %0" : "=v"(lane_));
        { const unsigned t0_ = (unsigned)F.wave * 64u + lane_; U2_LOAD(S0, t0_, 0); U2_LOAD(S1, t0_, 1); U2_LOAD(S2, t0_, 2); U2_LOAD(S3, t0_, 3); U2_ISSUE(R0, S0, 0); }
#pragma unroll 1
        for (int i = 0; i < nb; ++i) { const unsigned tok = (unsigned)(F.wave + 8 * i) * 64u + lane_; const unsigned tokn = tok + (i + 1 < nb ? 512u : 0u); int acc[8] = {0, 0, 0, 0, 0, 0, 0, 0};
            __builtin_amdgcn_raw_ptr_buffer_load_lds(rsX, (LAS unsigned*)(F.lds + U2_XO + F.wave * 1024), 16, tok << 12, cg * 16, 0, 0);
            __builtin_amdgcn_raw_ptr_buffer_load_lds(rsC, (LAS unsigned*)(F.lds + U2_SF + F.wave * 256), 4, tok << 2, 0, 0, 0);
            U2_FENCE();
            U2_ISSUE(R1, S0, 1); U2_FOLD(R0, S0, 0);
            U2_ISSUE(R0, S1, 0); U2_FOLD(R1, S0, 1); U2_LOAD(S0, tokn, 0);
            U2_ISSUE(R1, S1, 1); U2_FOLD(R0, S1, 0);
            U2_ISSUE(R0, S2, 0); U2_FOLD(R1, S1, 1); U2_LOAD(S1, tokn, 1);
            U2_ISSUE(R1, S2, 1); U2_FOLD(R0, S2, 0);
            U2_ISSUE(R0, S3, 0); U2_FOLD(R1, S2, 1); U2_LOAD(S2, tokn, 2);
            U2_ISSUE(R1, S3, 1); U2_FOLD(R0, S3, 0);
            U2_ISSUE(R0, S0, 0); U2_FOLD(R1, S3, 1); U2_LOAD(S3, tokn, 3);
            asm volatile("s_waitcnt vmcnt(48)" ::: "memory");
            const u32x4 xo = *(const LAS u32x4*)(F.lds + U2_XO + F.wave * 1024 + lane_ * 16); const float sf = *(const LAS float*)(F.lds + U2_SF + F.wave * 256 + lane_ * 4);
            f32x4 v0 = {bflo(xo.x), bfhi(xo.x), bflo(xo.y), bfhi(xo.y)}, v1 = {bflo(xo.z), bfhi(xo.z), bflo(xo.w), bfhi(xo.w)};
            v0[0] += sf * (float)acc[0]; v0[1] += sf * (float)acc[1]; v0[2] += sf * (float)acc[2]; v0[3] += sf * (float)acc[3]; v1[0] += sf * (float)acc[4]; v1[1] += sf * (float)acc[5]; v1[2] += sf * (float)acc[6]; v1[3] += sf * (float)acc[7];
            float* dp = ob_ + (size_t)((tok & tmask_) * DM) + cg * 8; *(f32x4*)dp = v0; *(f32x4*)(dp + 4) = v1; U2_FENCE(); }
        LDS_WAIT();
#undef U2_ISSUE
#undef U2_FOLD
#undef U2_FENCE
#undef U2_LOAD
    }
}
#undef PU_T4


#ifdef VALU_PROBE
__device__ __forceinline__ void valu_probe(const Frame& F) {
    unsigned a[16];
#pragma unroll
    for (int j = 0; j < 16; ++j) a[j] = F.tid * 17u + j * 0x01010101u;
    unsigned b = F.tid * 3u + 0x05040100u, c = 0x3c003c00u ^ F.tid;
#pragma unroll 1
    for (int it = 0; it < 1024; ++it) {
#pragma unroll
        for (int r = 0; r < 4; ++r) {
#pragma unroll
            for (int j = 0; j < 16; ++j) {
#if VALU_PROBE == 0
                asm volatile("v_add_u32 %0, %0, %1" : "+v"(a[j]) : "v"(b));
#elif VALU_PROBE == 1
                asm volatile("v_perm_b32 %0, %0, %1, %2" : "+v"(a[j]) : "v"(b), "v"(c));
#elif VALU_PROBE == 2
                asm volatile("v_dot4c_i32_i8 %0, %1, %2" : "+v"(a[j]) : "v"(b), "v"(c));
#elif VALU_PROBE == 3
                asm volatile("v_mad_u32_u16 %0, %1, %2, %0 op_sel:[1,0,0,0]" : "+v"(a[j]) : "v"(b), "v"(c));
#elif VALU_PROBE == 4
                asm volatile("v_and_b32 %0, %0, %1" : "+v"(a[j]) : "v"(b));
#elif VALU_PROBE == 5
                asm volatile("v_lshl_add_u32 %0, %0, 3, %1" : "+v"(a[j]) : "v"(b));
#elif VALU_PROBE == 6
                asm volatile("v_bfe_u32 %0, %0, 3, 14" : "+v"(a[j]));
#elif VALU_PROBE == 7
                asm volatile("v_dot4_i32_i8 %0, %1, %2, %0" : "+v"(a[j]) : "v"(b), "v"(c));
#endif
            } } }
    unsigned s = 0;
#pragma unroll
    for (int j = 0; j < 16; ++j) s ^= a[j];
    ((unsigned*)(F.wsb + WS_PART))[(size_t)F.vcu * 512 + F.tid] = s;
}
#endif

#define XB_TMO      128
#define XB_XCNT(j)  (256  + 64 * (j))
#define XB_XSUB(j)  (1280 + 64 * (j))
#define XB_XGEN(j)  (2304 + 64 * (j))
#define XB_TOP      3328
#define XB_TOPGEN   3392
#define XCD_BAR_WORDS 3456
#define XB_SPIN_CAP (1u << 18)

__device__ __forceinline__ unsigned xb_ld(unsigned* p)              { return __hip_atomic_load(p, __ATOMIC_RELAXED, __HIP_MEMORY_SCOPE_AGENT); }
__device__ __forceinline__ unsigned xb_add(unsigned* p, unsigned v) { return __hip_atomic_fetch_add(p, v, __ATOMIC_RELAXED, __HIP_MEMORY_SCOPE_AGENT); }
__device__ __forceinline__ unsigned xb_xcc_id() { return (unsigned)__builtin_amdgcn_s_getreg((3 << 11) | 20) & 0xFu; }
#define XB_SPIN(cond, bar) do { unsigned _sp = 0; while (cond) { __builtin_amdgcn_s_sleep(1); \
    if ((++_sp & 255u) == 0u) { if (xb_ld(&(bar)[XB_TMO])) break; if (_sp > XB_SPIN_CAP) { atomicAdd(&(bar)[XB_TMO], 1u); break; } } } } while (0)

struct XcdBarrier {
    unsigned* bar; unsigned x;
    volatile LAS unsigned* st;
};

__device__ __forceinline__ XcdBarrier xcd_barrier_post(unsigned* bar, volatile LAS unsigned* st) {
    XcdBarrier b; b.bar = bar; b.x = xb_xcc_id(); b.st = st;
    if (threadIdx.x == 0) (void)xb_add(&bar[XB_XCNT(b.x)], 1u);
    return b;
}
__device__ __forceinline__ void xcd_barrier_complete(unsigned* bar, unsigned x, unsigned& nloc, unsigned& nx) {
    const unsigned G = gridDim.x * gridDim.y * gridDim.z;
    unsigned sum, cnt, mine, sp = 0u;
    for (;;) {
        sum = 0u; cnt = 0u; mine = 0u;
#pragma unroll
        for (unsigned j = 0; j < 16; ++j) { const unsigned c = xb_ld(&bar[XB_XCNT(j)]); sum += c; cnt += (c > 0u) ? 1u : 0u; mine = (j == x) ? c : mine; }
        if (sum == G) break;
        __builtin_amdgcn_s_sleep(1);
        if ((++sp & 255u) == 0u) { if (xb_ld(&bar[XB_TMO])) break; if (sp > XB_SPIN_CAP) { atomicAdd(&bar[XB_TMO], 1u); break; } }
    }
    nloc = mine > 0u ? mine : 1u; nx = cnt > 0u ? cnt : 1u;
}

__device__ __forceinline__ void xcd_barrier(const XcdBarrier& b) {
    asm volatile("s_waitcnt vmcnt(0)" ::: "memory");
    __syncthreads();
    if (threadIdx.x == 0) {
        unsigned* bar = b.bar;
        __builtin_amdgcn_s_waitcnt(0);
        unsigned nloc = b.st[0], nx = b.st[1];
        if (nloc == 0u) { xcd_barrier_complete(bar, b.x, nloc, nx); b.st[0] = nloc; b.st[1] = nx; }
        const unsigned old = xb_add(&bar[XB_XSUB(b.x)], 1u);
        const unsigned gen = old / nloc;
        if (old + 1u == (gen + 1u) * nloc) {
            __builtin_amdgcn_fence(__ATOMIC_RELEASE, "agent");
            asm volatile("s_waitcnt vmcnt(0)" ::: "memory");
            const unsigned og = xb_add(&bar[XB_TOP], 1u);
            const unsigned tg = og / nx;
            if (og + 1u == (tg + 1u) * nx) xb_add(&bar[XB_TOPGEN], 1u);
            else XB_SPIN(xb_ld(&bar[XB_TOPGEN]) == tg, bar);
            __builtin_amdgcn_fence(__ATOMIC_ACQUIRE, "agent");
            xb_add(&bar[XB_XGEN(b.x)], 1u);
            asm volatile("s_waitcnt vmcnt(0)" ::: "memory");
        } else {
            XB_SPIN(xb_ld(&bar[XB_XGEN(b.x)]) == gen, bar);
            __builtin_amdgcn_fence(__ATOMIC_ACQUIRE, "agent");
            asm volatile("s_waitcnt vmcnt(0)" ::: "memory");
        }
    }
    __syncthreads();
}

struct Args { const float* in[16]; float* out; unsigned char* ws; int ph_lo, ph_hi, coop, pad; };
__global__ void __launch_bounds__(512, 2) fwd_kernel(Args args) {
    extern __shared__ __attribute__((aligned(16))) unsigned char lds_raw[];
    Frame F;
    F.lds = (LAS unsigned char*)lds_raw; F.ldsg = (char*)lds_raw;
    F.tid = threadIdx.x; F.lane = F.tid & 63; F.wave = __builtin_amdgcn_readfirstlane(F.tid >> 6);
    F.G = gridDim.x; { const int bx = blockIdx.x; F.vcu = (F.G % 8 == 0) ? (bx % 8) * (F.G / 8) + bx / 8 : bx; }
    F.x = args.in[0]; F.norm1_g = args.in[1]; F.w_in = args.in[2]; F.up_f = args.in[3]; F.bias_f = args.in[4]; F.up_b = args.in[5]; F.bias_b = args.in[6]; F.out_g = args.in[7];
    F.qn_g = args.in[8]; F.kn_g = args.in[9]; F.w_out = args.in[10]; F.norm2_g = args.in[11]; F.w_query = args.in[12]; F.sub_keys = args.in[13]; F.peer_down = args.in[14]; F.peer_up = args.in[15];
    F.out = args.out; unsigned char* ws = args.ws; F.wsb = ws;
    constexpr int MISC_OFF = 131072 + 320;
    for (int u = F.tid; u < 64; u += 512) ((LAS unsigned*)(F.lds + MISC_OFF))[u] = 0u;
    __syncthreads();
    XcdBarrier bar = xcd_barrier_post((unsigned*)(ws + WS_CTL) + 8192, (volatile LAS unsigned*)(F.lds + MISC_OFF) + 8);
    const int lo = args.ph_lo, hi = args.ph_hi;
#ifndef PH_MASK
#define PH_MASK 0x7ff
#endif
#ifndef PROBE_PHASE
#define PROBE_PHASE -1
#endif
#define REP(k) for (int rep_ = 0; rep_ < ((PROBE_PHASE == (k)) ? 2 : 1); ++rep_)
#define IN(k) (((PH_MASK >> (k)) & 1) && lo <= (k) && (k) < hi)
#define SEAM(k) do { if (IN(k) && IN((k) + 1)) { if (args.coop) { if ((k) == 0) cg::this_grid().sync(); else xcd_barrier(bar); } } } while (0)
    if (IN(0)) { REP(0) phase0(F); } SEAM(0);
#define GEMM1_BODY { pg8::Gemm g{(const pg8::bf16_t*)F.xq1_(), (const pg8::bf16_t*)F.Win8_(), T, HP, DM / 2}; pg8::StaticOrder S; S.init(T, HP, F.G, (int)blockIdx.x); \
        pg8::EpiI8Qk E{F.h_(), HP, F.rs1_(), F.sw_(), F.qn_g, F.kn_g, (LAS float*)(F.lds + 131072 + 1024), C_QD / 256, C_KD / 256, C_VD / 256, SEQ - 1, QSCALE}; \
        pg8::gemm_phase<pg8::EpiI8Qk, pg8::StaticOrder, PG8_ALIGN, PG8_SP2, true>(F.lds, g, S, E); }
    if (IN(1)) { GEMM1_BODY; if (PROBE_PHASE == 1) GEMM1_BODY; } SEAM(1);
    if (IN(2)) { REP(2) for (int it = F.vcu; it < 2048; it += F.G) gla_passA(F, it); } SEAM(2);
    if (IN(3)) { for (int it = F.vcu; it < 256; it += F.G) gla_scan(F, it); REP(3) attn_phase(F); } SEAM(3);
    if (IN(4)) REP(4) { for (int it = F.vcu; it < 2048; it += F.G) gla_passC(F, it); dil_combine(F); } SEAM(4);
#define GEMM5_BODY { pg8::Gemm g{F.mixed_(), F.WoT_(), T, DM, DM}; pg8::StaticOrder S; S.init(T, DM, F.G, (int)blockIdx.x); pg8::EpiResid E{F.x, F.out, F.x1b_(), F.ssp_(), DM}; \
        pg8::gemm_phase<pg8::EpiResid, pg8::StaticOrder, PG8_ALIGN, PG8_SP2>(F.lds, g, S, E); }
#define GEMM6_BODY { pg8::Gemm g{F.x1b_(), F.WqT_(), T, DM, DM}; pg8::StaticOrder S; S.init(T, DM, F.G, (int)blockIdx.x); pg8::EpiRowScaleBf16 E{F.qry_(), DM, nullptr}; \
        pg8::gemm_phase<pg8::EpiRowScaleBf16, pg8::StaticOrder, PG8_ALIGN, PG8_SP2>(F.lds, g, S, E); }
    if (IN(5)) { GEMM5_BODY; if (PROBE_PHASE == 5) GEMM5_BODY; } SEAM(5);
    if (IN(6)) { GEMM6_BODY; if (PROBE_PHASE == 6) GEMM6_BODY; } SEAM(6);
    if (IN(7)) REP(7) { const int gw = F.vcu * 8 + F.wave, NGW = F.G * 8; for (int u = F.vcu; u < 256; u += F.G) { const int hh = u & 7, chunk = u >> 3;
            __syncthreads();
            for (int i = F.tid; i < 4096; i += 512) { const int row = i >> 4, ch = i & 15; *(LAS u32x4*)(F.lds + TK_KEYS + KSWZ(row, ch * 16)) = *(const u32x4*)(F.SK_() + ((size_t)hh * 256 + row) * 128 + ch * 8); }
            __syncthreads();
            for (int j = 0; j < 4; ++j) topk_item(F, hh, chunk * 32 + F.wave * 4 + j); }
        if (rep_ == 0) peer_quant_x(F); } SEAM(7);
    if (IN(8)) { if (PROBE_PHASE == 8) peer_down(F, 3072); peer_down(F); } SEAM(8);
    if (IN(9)) { REP(9) peer_coef_probe(F, (PROBE_PHASE == 9) && rep_ == 0); } SEAM(9);
    if (IN(10)) peer_up(F);
#ifdef VALU_PROBE
    valu_probe(F);
#endif
#undef IN
#undef SEAM
}

#ifndef MK_N_LAUNCHES
#define MK_N_LAUNCHES 1
#endif
extern "C" void kernel_launch(void* const* d_in, const int* in_sizes, int n_in, void* d_out, int out_size, void* d_ws, size_t ws_size, hipStream_t stream) {
    static int grid = 0;
    if (grid == 0) {
        if (n_in != 16 || in_sizes[0] != T * DM || out_size != T * DM || ws_size < WS_END) { fprintf(stderr, "kernel_launch: unexpected shapes (n_in %d, in0 %d, out %d, ws %zu)\n", n_in, n_in > 0 ? in_sizes[0] : -1, out_size, ws_size); grid = -1; return; }
        int dev = 0, cus = 0, per_cu = 0;
        if (hipGetDevice(&dev) != hipSuccess || hipDeviceGetAttribute(&cus, hipDeviceAttributeMultiprocessorCount, dev) != hipSuccess) { grid = -1; return; }
        if (hipFuncSetAttribute((const void*)fwd_kernel, hipFuncAttributeMaxDynamicSharedMemorySize, LDS_BYTES) != hipSuccess) { fprintf(stderr, "kernel_launch: hipFuncSetAttribute failed\n"); grid = -1; return; }
        if (hipOccupancyMaxActiveBlocksPerMultiprocessor(&per_cu, (const void*)fwd_kernel, 512, LDS_BYTES) != hipSuccess || per_cu < 1) { fprintf(stderr, "kernel_launch: occupancy query says %d\n", per_cu); per_cu = 1; }
        (void)hipGetLastError();
        grid = cus;
    }
    if (grid < 0) return;
    if (hipMemsetAsync(d_ws, 0, 65536, stream) != hipSuccess) { fprintf(stderr, "kernel_launch: hipMemsetAsync failed\n"); return; }
    Args a{};
    for (int i = 0; i < 16; ++i) a.in[i] = (const float*)d_in[i];
    a.out = (float*)d_out; a.ws = (unsigned char*)d_ws;
    if (MK_N_LAUNCHES == 1) {
        a.ph_lo = 0; a.ph_hi = NPHASE; a.coop = 1; void* kargs[] = {&a};
        hipError_t e = hipLaunchCooperativeKernel((const void*)fwd_kernel, dim3(grid), dim3(512), kargs, LDS_BYTES, stream);
        if (e != hipSuccess) fprintf(stderr, "kernel_launch: cooperative launch failed: %s (grid %d)\n", hipGetErrorString(e), grid);
    } else {
        for (int p = 0; p < NPHASE; ++p) { a.ph_lo = p; a.ph_hi = p + 1; a.coop = 0; hipLaunchKernelGGL(fwd_kernel, dim3(grid), dim3(512), LDS_BYTES, stream, a); }
        const hipError_t le = hipPeekAtLastError(); if (le != hipSuccess) fprintf(stderr, "kernel_launch: launch failed: %s\n", hipGetErrorName(le));
    }
}
```

```cpp
#include <hip/hip_runtime.h>
#include <hip/hip_cooperative_groups.h>
#include <cstdio>
#include <cstdint>
namespace cg = cooperative_groups;
namespace pg8 {
#define PG8_LAS __attribute__((address_space(3)))
typedef unsigned short bf16_t;
typedef short bf16x8 __attribute__((ext_vector_type(8)));
typedef float f32x4 __attribute__((ext_vector_type(4)));
typedef unsigned u32x4 __attribute__((ext_vector_type(4)));
constexpr int BM = 256, BK = 64, HALF = 128, HTB = HALF * BK * 2  , STAGE_BYTES = 8 * HTB, NXCD = 8, WGM = 8;

__host__ __device__ __forceinline__ int lds_byte(int r, int c) { const int st = (r >> 4) * 2 + (c >> 5), rr = r & 15, cc = c & 31, ob = rr * 64 + cc * 2; return st * 1024 + (ob ^ (((ob >> 9) & 1) << 5)); }
__host__ __device__ __forceinline__ void stage_rc(int b, int& R, int& C) { const int st = b / 1024, sb = b % 1024, swz = sb ^ (((sb >> 9) & 1) << 5); R = (st >> 1) * 16 + swz / 64; C = (st & 1) * 32 + (swz % 64) / 2; }
__host__ __device__ __forceinline__ int perm32(int rho) { const int n = rho >> 4, i = rho & 15; return 8 * (i >> 2) + 4 * n + (i & 3); }

struct Unit { int pm, pn; };
struct Gemm { const bf16_t* A; const bf16_t* Bt; int M, N, K; };

struct StaticOrder {
    int nM, nN, nwg, G, c;
    __host__ __device__ void init(int M, int N, int G_, int c_) { nM = M / BM; nN = N / BM; nwg = nM * nN; G = G_; c = c_; }
    __host__ __device__ bool next(int i, Unit& u) const {
        const long L = (long)i * G + c; if (L >= nwg) return false;
        int wgid = (int)L; { const int q = nwg / NXCD, r = nwg % NXCD, xcd = wgid % NXCD, off = wgid / NXCD; wgid = (xcd < r ? xcd * (q + 1) : r * (q + 1) + (xcd - r) * q) + off; }
        const int nig = WGM * nN, gid = wgid / nig, fm = gid * WGM, gsz = (nM - fm) < WGM ? (nM - fm) : WGM;
        u.pm = fm + ((wgid % nig) % gsz); u.pn = (wgid % nig) / gsz; return true;
    }
    __device__ __forceinline__ void a_ready(const Unit&) const {}
    __device__ __forceinline__ void done(const Unit&) const {}
};
__device__ __forceinline__ unsigned cvt_pk_bf16(float lo, float hi) { unsigned r; asm volatile("v_cvt_pk_bf16_f32 %0, %1, %2" : "=v"(r) : "v"(lo), "v"(hi)); return r; }
typedef int i32x4 __attribute__((ext_vector_type(4)));
template <bool I8> struct AccT { typedef f32x4 type; };
template <> struct AccT<true> { typedef i32x4 type; };
struct EpiRowScaleBf16 {
    static constexpr bool PERM = true, AFTER_DRAIN = false;
    bf16_t* O; int ldc; const float* rs;
    __device__ __forceinline__ void operator()(const f32x4 (&acc)[2][2][4][2], const Unit& u, int wr, int wc, int fr, int fq) const {
        const int row0 = u.pm * BM + wr * 64 + fr, col0 = u.pn * BM + wc * 32 + 8 * fq;
#pragma unroll
        for (int ai = 0; ai < 2; ++ai)
#pragma unroll
            for (int m = 0; m < 4; ++m) { const int row = row0 + ai * HALF + m * 16; const float s = rs ? rs[row] : 1.f; bf16_t* rowp = O + (size_t)row * ldc + col0;
#pragma unroll
                for (int bj = 0; bj < 2; ++bj) { const f32x4 v0 = acc[ai][bj][m][0] * s, v1 = acc[ai][bj][m][1] * s;
                    u32x4 w; w.x = cvt_pk_bf16(v0[0], v0[1]); w.y = cvt_pk_bf16(v0[2], v0[3]); w.z = cvt_pk_bf16(v1[0], v1[1]); w.w = cvt_pk_bf16(v1[2], v1[3]);
                    *(u32x4*)(rowp + bj * HALF) = w; } }
    }
};
struct EpiI8Qk {
    static constexpr bool PERM = true, AFTER_DRAIN = false;
    bf16_t* O; int ldc; const float* rs; const float* cs; const float* qg; const float* kg; PG8_LAS float* P; int qk_lo, q_hi, qk_hi, seqmask; float qscale;
    __device__ __forceinline__ void operator()(const i32x4 (&acc)[2][2][4][2], const Unit& u, int wr, int wc, int fr, int fq) const {
        const int row0 = u.pm * BM + wr * 64 + fr, col0 = u.pn * BM + wc * 32 + 8 * fq;
        f32x4 cv[2][2];
#pragma unroll
        for (int bj = 0; bj < 2; ++bj) { cv[bj][0] = *(const f32x4*)(cs + col0 + bj * HALF); cv[bj][1] = *(const f32x4*)(cs + col0 + bj * HALF + 4); }
        const bool qk = u.pn >= qk_lo && u.pn < qk_hi;
        float rq[2][4][2];
        if (qk) {
#pragma unroll
            for (int ai = 0; ai < 2; ++ai)
#pragma unroll
                for (int m = 0; m < 4; ++m) { const float s = rs[row0 + ai * HALF + m * 16]; const int rl = ai * HALF + wr * 64 + m * 16 + fr;
#pragma unroll
                    for (int bj = 0; bj < 2; ++bj) { const i32x4 a0 = acc[ai][bj][m][0], a1 = acc[ai][bj][m][1]; const f32x4 c0 = cv[bj][0] * s, c1 = cv[bj][1] * s; float ss = 0.f;
#pragma unroll
                        for (int i = 0; i < 4; ++i) { const float x0 = (float)a0[i] * c0[i], x1 = (float)a1[i] * c1[i]; ss += x0 * x0 + x1 * x1; }
                        ss += __shfl_xor(ss, 16); ss += __shfl_xor(ss, 32);
                        if (fq == 0) P[rl * 8 + bj * 4 + wc] = ss; } }
            asm volatile("s_waitcnt lgkmcnt(0)" ::: "memory"); __builtin_amdgcn_s_barrier(); asm volatile("" ::: "memory");
#pragma unroll
            for (int ai = 0; ai < 2; ++ai)
#pragma unroll
                for (int m = 0; m < 4; ++m) { const int rl = ai * HALF + wr * 64 + m * 16 + fr;
#pragma unroll
                    for (int bj = 0; bj < 2; ++bj) { const f32x4 p = *(const PG8_LAS f32x4*)(P + rl * 8 + bj * 4); rq[ai][m][bj] = __builtin_amdgcn_rsqf(((p[0] + p[1]) + (p[2] + p[3])) * (1.f / 128.f) + 1e-6f); } }
        }
        const bool isq = u.pn < q_hi; const float* gp = (isq ? qg : kg) + wc * 32 + 8 * fq; f32x4 g0 = {1.f, 1.f, 1.f, 1.f}, g1 = g0;
        if (qk) { g0 = *(const f32x4*)gp; g1 = *(const f32x4*)(gp + 4); if (isq) { g0 = g0 * qscale; g1 = g1 * qscale; } }
        constexpr float RV[16] = {1.591549431e-01f, 7.008652159e-02f, 3.086376340e-02f, 1.359137064e-02f, 5.985185713e-03f, 2.635675899e-03f, 1.160663641e-03f, 5.111175045e-04f, 2.250790790e-04f, 9.911730937e-05f, 4.364795279e-05f, 1.922110068e-05f, 8.464330808e-06f, 3.727408602e-06f, 1.641426263e-06f, 7.228293069e-07f};
#pragma unroll
        for (int ai = 0; ai < 2; ++ai)
#pragma unroll
            for (int m = 0; m < 4; ++m) { const int row = row0 + ai * HALF + m * 16; const float s = rs[row]; bf16_t* rowp = O + (size_t)row * ldc + col0;
                float cs8[8], sn8[8];
                if (qk && wc == 0) { const float pos = (float)(row & seqmask);
#pragma unroll
                    for (int e8 = 0; e8 < 8; ++e8) { const float rev = pos * ((fq & 1) ? RV[8 + e8] : RV[e8]); const float fr_ = rev - __builtin_floorf(rev); cs8[e8] = __builtin_amdgcn_cosf(fr_); sn8[e8] = __builtin_amdgcn_sinf(fr_); } }
#pragma unroll
                for (int bj = 0; bj < 2; ++bj) { const i32x4 a0 = acc[ai][bj][m][0], a1 = acc[ai][bj][m][1]; const float sq = qk ? s * rq[ai][m][bj] : s; const f32x4 c0 = cv[bj][0] * sq * g0, c1 = cv[bj][1] * sq * g1;
                    float v[8];
#pragma unroll
                    for (int i = 0; i < 4; ++i) { v[i] = (float)a0[i] * c0[i]; v[4 + i] = (float)a1[i] * c1[i]; }
                    if (qk && wc == 0) {
#pragma unroll
                        for (int e8 = 0; e8 < 8; ++e8) { const float pr = __shfl_xor(v[e8], 32); v[e8] = (fq < 2) ? (v[e8] * cs8[e8] - pr * sn8[e8]) : (v[e8] * cs8[e8] + pr * sn8[e8]); } }
                    u32x4 w; w.x = cvt_pk_bf16(v[0], v[1]); w.y = cvt_pk_bf16(v[2], v[3]); w.z = cvt_pk_bf16(v[4], v[5]); w.w = cvt_pk_bf16(v[6], v[7]);
                    *(u32x4*)(rowp + bj * HALF) = w; } }
    }
};
struct EpiResid {
    static constexpr bool PERM = true, AFTER_DRAIN = false;
    const float* x; float* out; bf16_t* xb; float* ssp; int ldc;
    __device__ __forceinline__ void operator()(const f32x4 (&acc)[2][2][4][2], const Unit& u, int wr, int wc, int fr, int fq) const {
        const int row0 = u.pm * BM + wr * 64 + fr, col0 = u.pn * BM + wc * 32 + 8 * fq;
#pragma unroll
        for (int ai = 0; ai < 2; ++ai)
#pragma unroll
            for (int m = 0; m < 4; ++m) { const int row = row0 + ai * HALF + m * 16; const size_t off = (size_t)row * ldc + col0; float ss = 0.f;
#pragma unroll
                for (int bj = 0; bj < 2; ++bj) { const f32x4 xa = *(const f32x4*)(x + off + bj * HALF), xc = *(const f32x4*)(x + off + bj * HALF + 4);
                    const f32x4 v0 = acc[ai][bj][m][0] + xa, v1 = acc[ai][bj][m][1] + xc;
                    u32x4 w; w.x = cvt_pk_bf16(v0[0], v0[1]); w.y = cvt_pk_bf16(v0[2], v0[3]); w.z = cvt_pk_bf16(v1[0], v1[1]); w.w = cvt_pk_bf16(v1[2], v1[3]);
                    *(u32x4*)(xb + off + bj * HALF) = w;
                    ss += (v0[0] * v0[0] + v0[1] * v0[1]) + (v0[2] * v0[2] + v0[3] * v0[3]) + (v1[0] * v1[0] + v1[1] * v1[1]) + (v1[2] * v1[2] + v1[3] * v1[3]); }
                ss += __shfl_xor(ss, 16); ss += __shfl_xor(ss, 32);
                if (fq == 0) ssp[(size_t)row * 32 + u.pn * 4 + wc] = ss; }
    }
};
template <class Epi, class Sched, bool ALIGN_EPI = false, bool SP2 = false, bool I8 = false>
__device__ __forceinline__ void gemm_phase(PG8_LAS unsigned char* lds, const Gemm g, const Sched& S, const Epi& E) {
    const int tid = threadIdx.x, wid = __builtin_amdgcn_readfirstlane(tid >> 6), lane = tid & 63, wr = wid >> 2, wc = wid & 3, fr = lane & 15, fq = lane >> 4;
    const int K = g.K, nt = K / BK;
    unsigned voffA[2], voffB[2];
#pragma unroll
    for (int i = 0; i < 2; ++i) { int R, C; stage_rc(tid * 16 + i * 8192, R, C); const int Rb = Epi::PERM ? ((R & ~31) + perm32(R & 31)) : R;
        voffA[i] = (unsigned)(R * K + C) * 2u; voffB[i] = (unsigned)(Rb * K + C) * 2u; }
    const size_t kstep = (size_t)(BK * 2);
    const size_t hstep = (size_t)HALF * K * 2;
    const size_t tstep = 2 * hstep;
    const unsigned ldsw = (unsigned)wid * 1024u;
    const int aoff = lds_byte(wr * 64 + fr, fq * 8), boff = lds_byte(wc * 32 + fr, fq * 8);
#define PG8_SA(b, h) (((b) * 2 + (h)) * HTB)
#define PG8_SB(b, h) ((4 + (b) * 2 + (h)) * HTB)
#define PG8_STAGE(bufoff, gbase, voff) do { _Pragma("unroll") for (int _i = 0; _i < 2; ++_i) \
        __builtin_amdgcn_global_load_lds((const unsigned*)((const char*)(gbase) + (voff)[_i]), (PG8_LAS unsigned*)(lds + (bufoff) + ldsw + _i * 8192), 16, 0, 0); } while (0)
#define PG8_LDA(dst, b, h) do { _Pragma("unroll") for (int m = 0; m < 4; ++m) _Pragma("unroll") for (int k = 0; k < 2; ++k) dst[m][k] = *(const PG8_LAS bf16x8*)(lds + PG8_SA(b, h) + aoff + m * 2048 + k * 1024); } while (0)
#define PG8_LDB(dst, b, h) do { _Pragma("unroll") for (int n = 0; n < 2; ++n) _Pragma("unroll") for (int k = 0; k < 2; ++k) dst[n][k] = *(const PG8_LAS bf16x8*)(lds + PG8_SB(b, h) + boff + n * 2048 + k * 1024); } while (0)
#define PG8_MMA(ai, bj, At, Bt) do { __builtin_amdgcn_s_setprio(1); _Pragma("unroll") for (int m = 0; m < 4; ++m) _Pragma("unroll") for (int n = 0; n < 2; ++n) _Pragma("unroll") for (int k = 0; k < 2; ++k) { \
        if constexpr (I8) acc[ai][bj][m][n] = __builtin_amdgcn_mfma_i32_16x16x64_i8(__builtin_bit_cast(i32x4, Bt[n][k]), __builtin_bit_cast(i32x4, At[m][k]), acc[ai][bj][m][n], 0, 0, 0); \
        else acc[ai][bj][m][n] = __builtin_amdgcn_mfma_f32_16x16x32_bf16(Bt[n][k], At[m][k], acc[ai][bj][m][n], 0, 0, 0); } __builtin_amdgcn_s_setprio(0); } while (0)
#define PG8_WAIT_V(n) asm volatile("s_waitcnt vmcnt(" #n ")" ::: "memory")
#define PG8_WAIT_L(n) asm volatile("s_waitcnt lgkmcnt(" #n ")" ::: "memory")
#define PG8_BAR __builtin_amdgcn_s_barrier()
#define PG8_SCHED __builtin_amdgcn_sched_barrier(0)
    Unit cur, nxt; int ui = 0;
    if (!S.next(0, cur)) return;
    typename AccT<I8>::type acc[2][2][4][2];
#pragma unroll
    for (int a = 0; a < 2; ++a)
#pragma unroll
        for (int b = 0; b < 2; ++b)
#pragma unroll
            for (int m = 0; m < 4; ++m)
#pragma unroll
                for (int n = 0; n < 2; ++n) acc[a][b][m][n] = (typename AccT<I8>::type){};
    bf16x8 At[4][2], B0[2][2], B1[2][2];
    const char* cA = (const char*)g.A + (size_t)cur.pm * tstep; const char* cB = (const char*)g.Bt + (size_t)cur.pn * tstep;
    S.a_ready(cur);
    if constexpr (SP2) {
        PG8_STAGE(PG8_SB(0, 0), cB, voffB); PG8_STAGE(PG8_SB(0, 1), cB + hstep, voffB); PG8_STAGE(PG8_SA(0, 0), cA, voffA); PG8_STAGE(PG8_SA(0, 1), cA + hstep, voffA);
        if (wr == 1) PG8_BAR;
        PG8_WAIT_V(2); PG8_BAR;
        PG8_STAGE(PG8_SB(1, 0), cB + kstep, voffB); PG8_STAGE(PG8_SA(1, 0), cA + kstep, voffA); PG8_STAGE(PG8_SB(1, 1), cB + hstep + kstep, voffB);
        PG8_WAIT_V(6); PG8_BAR;
    } else {
        PG8_STAGE(PG8_SB(0, 0), cB, voffB); PG8_STAGE(PG8_SA(0, 0), cA, voffA); PG8_STAGE(PG8_SB(0, 1), cB + hstep, voffB); PG8_STAGE(PG8_SA(0, 1), cA + hstep, voffA);
        if (wr == 1) PG8_BAR;
        PG8_WAIT_V(4); PG8_BAR;
        PG8_STAGE(PG8_SB(1, 0), cB + kstep, voffB); PG8_STAGE(PG8_SA(1, 0), cA + kstep, voffA); PG8_STAGE(PG8_SB(1, 1), cB + hstep + kstep, voffB);
        PG8_WAIT_V(6); PG8_BAR;
    }
    for (;;) {
        const bool has_next = S.next(ui + 1, nxt);
        const char* nA = has_next ? (const char*)g.A + (size_t)nxt.pm * tstep : cA; const char* nB = has_next ? (const char*)g.Bt + (size_t)nxt.pn * tstep : cB;
        for (int t = 0; t < nt; t += 2) {
            const bool last = (t == nt - 2);
            const char* a1 = cA + (size_t)(t + 1) * kstep;
            const char* a2 = last ? nA : cA + (size_t)(t + 2) * kstep; const char* b2 = last ? nB : cB + (size_t)(t + 2) * kstep;
            const char* a3 = a2 + kstep; const char* b3 = b2 + kstep;
            if (last && has_next) S.a_ready(nxt);
            if constexpr (SP2) {
            PG8_LDB(B0, 0, 0); PG8_LDB(B1, 0, 1); PG8_SCHED; PG8_LDA(At, 0, 0); PG8_STAGE(PG8_SA(1, 1), a1 + hstep, voffA);
            PG8_WAIT_V(8); PG8_WAIT_L(0); PG8_BAR; PG8_MMA(0, 0, At, B0); PG8_MMA(0, 1, At, B1); PG8_BAR; PG8_SCHED;
            PG8_LDA(At, 0, 1); PG8_STAGE(PG8_SB(0, 0), b2, voffB); PG8_STAGE(PG8_SB(0, 1), b2 + hstep, voffB); PG8_STAGE(PG8_SA(0, 0), a2, voffA);
            PG8_WAIT_V(8); PG8_WAIT_L(0); PG8_BAR; PG8_MMA(1, 0, At, B0); PG8_MMA(1, 1, At, B1); PG8_BAR; PG8_SCHED;
            PG8_LDB(B0, 1, 0); PG8_LDB(B1, 1, 1); PG8_SCHED; PG8_LDA(At, 1, 0); PG8_STAGE(PG8_SA(0, 1), a2 + hstep, voffA);
            PG8_WAIT_V(8); PG8_WAIT_L(0); PG8_BAR; PG8_MMA(0, 0, At, B0); PG8_MMA(0, 1, At, B1); PG8_BAR; PG8_SCHED;
            PG8_LDA(At, 1, 1); PG8_STAGE(PG8_SB(1, 0), b3, voffB); PG8_STAGE(PG8_SB(1, 1), b3 + hstep, voffB); PG8_STAGE(PG8_SA(1, 0), a3, voffA);
            PG8_WAIT_V(8); PG8_WAIT_L(0); PG8_BAR; PG8_MMA(1, 0, At, B0); PG8_MMA(1, 1, At, B1); PG8_BAR; PG8_SCHED;
            } else {
            PG8_LDB(B0, 0, 0); PG8_SCHED; PG8_LDA(At, 0, 0); PG8_STAGE(PG8_SA(1, 1), a1 + hstep, voffA);
            PG8_WAIT_L(8); PG8_BAR; PG8_WAIT_L(0); PG8_MMA(0, 0, At, B0); PG8_BAR; PG8_SCHED;
            PG8_LDB(B1, 0, 1); PG8_STAGE(PG8_SB(0, 0), b2, voffB);
            PG8_BAR; PG8_WAIT_L(0); PG8_MMA(0, 1, At, B1); PG8_BAR;
            PG8_LDA(At, 0, 1); PG8_STAGE(PG8_SA(0, 0), a2, voffA);
            PG8_BAR; PG8_WAIT_L(0); PG8_MMA(1, 0, At, B0); PG8_BAR; PG8_SCHED;
            PG8_STAGE(PG8_SB(0, 1), b2 + hstep, voffB);
            PG8_WAIT_V(6); PG8_BAR; PG8_MMA(1, 1, At, B1); PG8_BAR;
            PG8_LDB(B0, 1, 0); PG8_SCHED; PG8_LDA(At, 1, 0); PG8_STAGE(PG8_SA(0, 1), a2 + hstep, voffA);
            PG8_WAIT_L(8); PG8_BAR; PG8_WAIT_L(0); PG8_MMA(0, 0, At, B0); PG8_BAR; PG8_SCHED;
            PG8_LDB(B1, 1, 1); PG8_STAGE(PG8_SB(1, 0), b3, voffB);
            PG8_BAR; PG8_WAIT_L(0); PG8_MMA(0, 1, At, B1); PG8_BAR;
            PG8_LDA(At, 1, 1); PG8_STAGE(PG8_SA(1, 0), a3, voffA);
            PG8_BAR; PG8_WAIT_L(0); PG8_MMA(1, 0, At, B0); PG8_BAR; PG8_SCHED;
            PG8_STAGE(PG8_SB(1, 1), b3 + hstep, voffB);
            PG8_WAIT_V(6); PG8_BAR; PG8_MMA(1, 1, At, B1); PG8_BAR;
            }
        }
        if constexpr (ALIGN_EPI) { if (wr == 0) PG8_BAR; }
        if constexpr (!Epi::AFTER_DRAIN) { E(acc, cur, wr, wc, fr, fq); S.done(cur); }
        if (!has_next) break;
#pragma unroll
        for (int a = 0; a < 2; ++a)
#pragma unroll
            for (int b = 0; b < 2; ++b)
#pragma unroll
                for (int m = 0; m < 4; ++m)
#pragma unroll
                    for (int n = 0; n < 2; ++n) acc[a][b][m][n] = (typename AccT<I8>::type){};
        cur = nxt; cA = nA; cB = nB; ++ui;
        if constexpr (ALIGN_EPI) { if (wr == 1) PG8_BAR; }
    }
    PG8_WAIT_V(0);
    if constexpr (!ALIGN_EPI) { if (wr == 0) PG8_BAR; }
    PG8_BAR;
    if constexpr (Epi::AFTER_DRAIN) { E.fused(acc, cur, wr, wc, fr, fq, lds, wid, lane); S.done(cur); }
#undef PG8_SA
#undef PG8_SB
#undef PG8_STAGE
#undef PG8_LDA
#undef PG8_LDB
#undef PG8_MMA
#undef PG8_WAIT_V
#undef PG8_WAIT_L
#undef PG8_BAR
#undef PG8_SCHED
}
}
#ifndef PG8_SP2
#define PG8_SP2 true
#endif
#ifndef PG8_ALIGN
#define PG8_ALIGN true
#endif

constexpr int BATCH = 2, SEQ = 16384, DM = 2048, T = BATCH * SEQ;
constexpr int INW = 6176, HP = 6400;
constexpr int C_QA = 0, C_KA = 256, C_VA = 512, C_RA = 1024, C_QD = 1536, C_KD = 3072, C_VD = 4608, C_GF = 6144;
constexpr int NHD = 12;
constexpr float EPS = 1e-6f;
constexpr float LOG2E = 1.4426950408889634f;
constexpr float QSCALE = 0.08838834764831845f * LOG2E;
constexpr int NPHASE = 11;

constexpr size_t MiB = 1u << 20;
constexpr size_t WS_CTL = 0, WS_ROPE = 1 * MiB, WS_RS1 = 3 * MiB, WS_RS2 = 3 * MiB + 512 * 1024, WS_SSP = 4 * MiB, WS_WIN = 8 * MiB, WS_WO = 33 * MiB, WS_WQ = 41 * MiB,
                 WS_SK = 49 * MiB, WS_DEC = 50 * MiB, WS_LP = 51 * MiB, WS_IDX = 56 * MiB, WS_GATE = 72 * MiB, WS_DOWN = 88 * MiB, WS_UP = 152 * MiB, WS_XB = 216 * MiB,
                 WS_H = 344 * MiB, WS_X1B = WS_H, WS_QRY = WS_H + 128 * MiB, WS_OP1 = 744 * MiB, WS_OP2 = 840 * MiB, WS_PART = 472 * MiB  , WS_END = 984 * MiB;
constexpr size_t OUT_ST = 0, OUT_OP0 = 128 * MiB;
constexpr int LDS_BYTES = 147456;

#define LAS __attribute__((address_space(3)))
typedef unsigned short bf16_t;
typedef short bf16x8 __attribute__((ext_vector_type(8)));
typedef short s16x4 __attribute__((ext_vector_type(4)));
typedef float f32x4 __attribute__((ext_vector_type(4)));
typedef float f32x2 __attribute__((ext_vector_type(2)));
typedef float f32x16 __attribute__((ext_vector_type(16)));
typedef unsigned u32x4 __attribute__((ext_vector_type(4)));
typedef unsigned u32x2 __attribute__((ext_vector_type(2)));
#define LDS_WAIT() asm volatile("s_waitcnt lgkmcnt(0)" ::: "memory")
#define SBAR() __builtin_amdgcn_sched_barrier(0)

__device__ __forceinline__ float bf2f(unsigned short b) { return __uint_as_float(((unsigned)b) << 16); }
__device__ __forceinline__ float bflo(unsigned w) { return __uint_as_float(w << 16); }
__device__ __forceinline__ float bfhi(unsigned w) { return __uint_as_float(w & 0xffff0000u); }
__device__ __forceinline__ unsigned f2bf(float f) { unsigned u = __float_as_uint(f); return (u + 0x7fffu + ((u >> 16) & 1u)) >> 16; }
__device__ __forceinline__ unsigned pk2(float lo, float hi) { return pg8::cvt_pk_bf16(lo, hi); }
__device__ __forceinline__ float fexp(float x) { return __builtin_amdgcn_exp2f(x * LOG2E); }
__device__ __forceinline__ float flog(float x) { return __builtin_amdgcn_logf(x) * 0.6931471805599453f; }
__device__ __forceinline__ float wave_sum(float v) {
#pragma unroll
    for (int o = 1; o < 64; o <<= 1) v += __shfl_xor(v, o);
    return v;
}
__device__ __forceinline__ int crow(int r, int hi) { return (r & 3) + 8 * (r >> 2) + 4 * hi; }

struct Frame {
    LAS unsigned char* lds; char* ldsg; unsigned char* wsb;
    int tid, lane, wave, vcu, G;
    const float *x, *norm1_g, *w_in, *up_f, *bias_f, *up_b, *bias_b, *out_g, *qn_g, *kn_g, *w_out, *norm2_g, *w_query, *sub_keys, *peer_down, *peer_up;
    float* out;
    __device__ __forceinline__ f32x2* rope_() const { return (f32x2*)((f32x2*)(wsb + WS_ROPE)); }
    __device__ __forceinline__ float* rs1_() const { return (float*)((float*)(wsb + WS_RS1)); }
    __device__ __forceinline__ float* rs2_() const { return (float*)((float*)(wsb + WS_RS2)); }
    __device__ __forceinline__ float* ssp_() const { return (float*)((float*)(wsb + WS_SSP)); }
    __device__ __forceinline__ float* dec_() const { return (float*)((float*)(wsb + WS_DEC)); }
    __device__ __forceinline__ float* lp_() const { return (float*)((float*)(wsb + WS_LP)); }
    __device__ __forceinline__ float* gate_() const { return (float*)((float*)(wsb + WS_GATE)); }
    __device__ __forceinline__ short* part_() const { return (short*)(wsb + WS_PART); }
    __device__ __forceinline__ float* sd_() const { return (float*)((float*)(wsb + WS_CTL + 65536)); }
    __device__ __forceinline__ float* su_() const { return (float*)((float*)(wsb + WS_CTL + 131072)); }
    __device__ __forceinline__ float* sx_() const { return (float*)((float*)(wsb + WS_RS2 + 131072)); }
    __device__ __forceinline__ float* csum_() const { return (float*)((float*)(wsb + WS_RS2 + 262144)); }
    __device__ __forceinline__ unsigned char* down8_() const { return (unsigned char*)(wsb + WS_DOWN); }
    __device__ __forceinline__ unsigned char* up8_() const { return (unsigned char*)(wsb + WS_UP); }
    __device__ __forceinline__ unsigned char* xq8_() const { return (unsigned char*)(wsb + WS_XB); }
    __device__ __forceinline__ unsigned char* fq8_() const { return (unsigned char*)(wsb + WS_XB + 64 * MiB); }
    __device__ __forceinline__ unsigned short* idxT_() const { return (unsigned short*)((unsigned short*)(wsb + WS_XB + 72 * MiB)); }
    __device__ __forceinline__ unsigned* fqT_() const { return (unsigned*)((unsigned*)(wsb + WS_XB + 80 * MiB)); }
    __device__ __forceinline__ unsigned short* idx_() const { return (unsigned short*)(wsb + WS_IDX); }
    __device__ __forceinline__ unsigned short* state_() const { return (unsigned short*)((unsigned short*)((unsigned char*)out + OUT_ST)); }
    __device__ __forceinline__ bf16_t* WinT_() const { return (bf16_t*)((bf16_t*)(wsb + WS_WIN)); }
    __device__ __forceinline__ unsigned char* Win8_() const { return (unsigned char*)(wsb + WS_WIN); }
    __device__ __forceinline__ unsigned char* xq1_() const { return (unsigned char*)(wsb + WS_OP1); }
    __device__ __forceinline__ float* sw_() const { return (float*)((float*)(wsb + WS_CTL + 196608)); }
    __device__ __forceinline__ bf16_t* WoT_() const { return (bf16_t*)((bf16_t*)(wsb + WS_WO)); }
    __device__ __forceinline__ bf16_t* WqT_() const { return (bf16_t*)((bf16_t*)(wsb + WS_WQ)); }
    __device__ __forceinline__ bf16_t* SK_() const { return (bf16_t*)((bf16_t*)(wsb + WS_SK)); }
    __device__ __forceinline__ bf16_t* down16_() const { return (bf16_t*)((bf16_t*)(wsb + WS_DOWN)); }
    __device__ __forceinline__ bf16_t* up16_() const { return (bf16_t*)((bf16_t*)(wsb + WS_UP)); }
    __device__ __forceinline__ bf16_t* xb_() const { return (bf16_t*)((bf16_t*)(wsb + WS_XB)); }
    __device__ __forceinline__ bf16_t* mixed_() const { return (bf16_t*)((bf16_t*)(wsb + WS_XB)); }
    __device__ __forceinline__ bf16_t* h_() const { return (bf16_t*)((bf16_t*)(wsb + WS_H)); }
    __device__ __forceinline__ bf16_t* x1b_() const { return (bf16_t*)((bf16_t*)(wsb + WS_X1B)); }
    __device__ __forceinline__ bf16_t* qry_() const { return (bf16_t*)((bf16_t*)(wsb + WS_QRY)); }
    __device__ __forceinline__ bf16_t* op0_() const { return (bf16_t*)((bf16_t*)((unsigned char*)out + OUT_OP0)); }
    __device__ __forceinline__ bf16_t* op1_() const { return (bf16_t*)((bf16_t*)(wsb + WS_OP1)); }
    __device__ __forceinline__ bf16_t* op2_() const { return (bf16_t*)((bf16_t*)(wsb + WS_OP2)); }
};

__device__ __forceinline__ void p0_transpose_item(const float* W, int K, int N, bf16_t* WT, int k0, int n0, int dst_row0, const float* g, LAS float* scr, int lane) {
#pragma unroll 8
    for (int i = 0; i < 32; ++i) { const int kk = 2 * i + (lane >> 5); float w = W[(size_t)(k0 + kk) * N + n0 + (lane & 31)]; if (g) w *= g[k0 + kk]; scr[kk * 33 + (lane & 31)] = w; }
    LDS_WAIT(); asm volatile("" ::: "memory");
    const int c = lane & 7;
#pragma unroll
    for (int j = 0; j < 4; ++j) { const int n = (lane >> 3) + 8 * j; const LAS float* s = scr + (8 * c) * 33 + n;
        u32x4 o; o.x = pk2(s[0 * 33], s[1 * 33]); o.y = pk2(s[2 * 33], s[3 * 33]); o.z = pk2(s[4 * 33], s[5 * 33]); o.w = pk2(s[6 * 33], s[7 * 33]);
        *(u32x4*)(WT + (size_t)(dst_row0 + n) * K + k0 + 8 * c) = o; }
    LDS_WAIT(); asm volatile("" ::: "memory");
}
__device__ __forceinline__ unsigned pack_nib(unsigned a, unsigned b) { return (a & 0x0F0F0F0Fu) | ((b & 0x0F0F0F0Fu) << 4); }
__device__ __forceinline__ unsigned pack_i8x4(const f32x4 v, float inv, float lim) { unsigned w = 0u;
#pragma unroll
    for (int i = 0; i < 4; ++i) { const int qv = (int)fminf(fmaxf(rintf(v[i] * inv), -lim), lim); w |= ((unsigned)qv & 0xffu) << (8 * i); }
    return w; }
template <bool isup> __device__ __forceinline__ void peer_quant_row(const Frame& F, int e) {
    const int lane = F.lane;
    if constexpr (isup) {
        const f32x4* src = (const f32x4*)(F.peer_up + (size_t)e * DM) + lane;
        f32x4 v[8]; float m = 0.f;
#pragma unroll
        for (int j = 0; j < 8; ++j) { v[j] = src[64 * j];
            m = fmaxf(fmaxf(m, fmaxf(fabsf(v[j][0]), fabsf(v[j][1]))), fmaxf(fabsf(v[j][2]), fabsf(v[j][3]))); }
#pragma unroll
        for (int o = 1; o < 64; o <<= 1) m = fmaxf(m, __shfl_xor(m, o));
        const float inv = m > 0.f ? 127.f / m : 0.f; unsigned char* dst = F.up8_();
#pragma unroll
        for (int j = 0; j < 8; ++j) { const unsigned w = pack_i8x4(v[j], inv, 127.f);
            const int col = 4 * lane + 256 * j; *(unsigned*)(dst + (size_t)(col >> 3) * 131072 + (size_t)e * 8 + (col & 7)) = w; }
        if (lane == 0) F.su_()[e] = m * (1.f / 127.f);
    } else {
        const f32x4* src = (const f32x4*)(F.peer_down + (size_t)e * DM) + 2 * lane; const f32x4* gs = (const f32x4*)F.norm2_g + 2 * lane;
        f32x4 v[8]; float ss = 0.f;
#pragma unroll
        for (int j = 0; j < 4; ++j) { v[2 * j] = src[128 * j] * gs[128 * j]; v[2 * j + 1] = src[128 * j + 1] * gs[128 * j + 1];
#pragma unroll
            for (int i = 0; i < 4; ++i) ss += v[2 * j][i] * v[2 * j][i] + v[2 * j + 1][i] * v[2 * j + 1][i]; }
        ss = wave_sum(ss);
        const float step = 0.345f * sqrtf(ss * (1.f / DM)), inv = step > 0.f ? 1.f / step : 0.f; unsigned char* dst = F.down8_();
#pragma unroll
        for (int j = 0; j < 4; ++j) { const unsigned w = pack_nib(pack_i8x4(v[2 * j], inv, 7.f), pack_i8x4(v[2 * j + 1], inv, 7.f));
            const int col = 8 * lane + 512 * j; *(unsigned*)(dst + ((size_t)(col >> 8) * 16384 + e) * 128 + ((col & 255) >> 3) * 4) = w; }
        if (lane == 0) F.sd_()[e] = step;
    }
}
__device__ __forceinline__ void phase0(const Frame& F) {
    LAS float* scr = (LAS float*)(F.lds + F.wave * 16384);
    const int gw = F.vcu * 8 + F.wave, NGW = F.G * 8, lane = F.lane;
#ifndef P0_DUP
#define P0_DUP 0
#endif
    for (int dupA = 0; dupA < (P0_DUP == 1 ? 2 : 1); ++dupA)
    { LAS float* cmx = (LAS float*)(F.lds + 12288);
      for (int nb = F.vcu; nb < 193; nb += F.G) { const int n0 = nb * 32, drow = nb < 32 ? nb * 32 : (nb == 32 ? C_GF : nb * 32 - 32), kw = F.wave * 256;
        float m = 0.f;
#pragma unroll 16
        for (int i = 0; i < 128; ++i) { const int k = kw + 2 * i + (lane >> 5); m = fmaxf(m, fabsf(F.w_in[(size_t)k * INW + n0 + (lane & 31)] * F.norm1_g[k])); }
        m = fmaxf(m, __shfl_xor(m, 32)); if (lane < 32) cmx[F.wave * 32 + lane] = m;
        __syncthreads();
        if (F.tid < 32) { float mm = 0.f;
#pragma unroll
            for (int w = 0; w < 8; ++w) mm = fmaxf(mm, cmx[w * 32 + F.tid]);
            cmx[256 + F.tid] = mm > 0.f ? 127.f / mm : 0.f; F.sw_()[drow + F.tid] = mm * (1.f / 127.f); }
        __syncthreads();
        for (int ch = 0; ch < 4; ++ch) { const int k0 = kw + 64 * ch;
#pragma unroll 8
            for (int i = 0; i < 32; ++i) { const int kk = 2 * i + (lane >> 5); scr[kk * 33 + (lane & 31)] = F.w_in[(size_t)(k0 + kk) * INW + n0 + (lane & 31)] * F.norm1_g[k0 + kk] * cmx[256 + (lane & 31)]; }
            LDS_WAIT(); asm volatile("" ::: "memory");
            const int c = lane & 7;
#pragma unroll
            for (int j = 0; j < 4; ++j) { const int n = (lane >> 3) + 8 * j; const LAS float* sp = scr + (8 * c) * 33 + n; u32x2 w = {0u, 0u};
#pragma unroll
                for (int i = 0; i < 4; ++i) { w.x |= ((unsigned)(int)rintf(sp[i * 33]) & 0xffu) << (8 * i); w.y |= ((unsigned)(int)rintf(sp[(4 + i) * 33]) & 0xffu) << (8 * i); }
                *(u32x2*)(F.Win8_() + (size_t)(drow + n) * DM + k0 + 8 * c) = w; }
            LDS_WAIT(); asm volatile("" ::: "memory"); }
        __syncthreads(); } }
    constexpr int I_O = 32 * 64, I_Q = 32 * 64;
    for (int dupB = 0; dupB < (P0_DUP == 2 ? 2 : 1); ++dupB)
    for (int it = gw; it < I_O + I_Q; it += NGW) {
        int r = it;
        if (r < I_O) { const int kb = r / 64, nb = r % 64; p0_transpose_item(F.w_out, DM, DM, F.WoT_(), kb * 64, nb * 32, nb * 32, nullptr, scr, lane); continue; }
        r -= I_O;
        { const int kb = r / 64, nb = r % 64; p0_transpose_item(F.w_query, DM, DM, F.WqT_(), kb * 64, nb * 32, nb * 32, F.norm2_g, scr, lane); }
    }
    const size_t gt = (size_t)gw * 64 + lane, NT = (size_t)NGW * 64;
    { u32x4* z = (u32x4*)(F.Win8_() + (size_t)INW * DM); const u32x4 zero = {0u, 0u, 0u, 0u}; for (size_t i = gt; i < (size_t)(HP - INW) * DM / 16; i += NT) z[i] = zero; if (gt < (size_t)(HP - INW)) F.sw_()[INW + gt] = 0.f; }
    for (int dupC = 0; dupC < (P0_DUP == 3 ? 2 : 1); ++dupC) {
    for (int r = gw; r < 16384; r += NGW) peer_quant_row<false>(F, r);
    for (int r = gw; r < 16384; r += NGW) peer_quant_row<true>(F, r); }
    for (size_t i = gt; i < (size_t)8 * 2 * 128 * 128 / 8; i += NT) { const f32x4 a = *(const f32x4*)(F.sub_keys + i * 8), b = *(const f32x4*)(F.sub_keys + i * 8 + 4);
        u32x4 o; o.x = pk2(a[0], a[1]); o.y = pk2(a[2], a[3]); o.z = pk2(b[0], b[1]); o.w = pk2(b[2], b[3]); *(u32x4*)(F.SK_() + i * 8) = o; }
    for (int dupD = 0; dupD < (P0_DUP == 4 ? 2 : 1); ++dupD)
    for (int m = gw; m < T; m += NGW) { const f32x4* xr = (const f32x4*)(F.x + (size_t)m * DM) + lane; f32x4 v[8]; float s = 0.f, mx = 0.f;
#pragma unroll
        for (int j = 0; j < 8; ++j) { v[j] = xr[64 * j]; s += (v[j][0] * v[j][0] + v[j][1] * v[j][1]) + (v[j][2] * v[j][2] + v[j][3] * v[j][3]);
            mx = fmaxf(fmaxf(mx, fmaxf(fabsf(v[j][0]), fabsf(v[j][1]))), fmaxf(fabsf(v[j][2]), fabsf(v[j][3]))); }
        s = wave_sum(s);
#pragma unroll
        for (int o = 1; o < 64; o <<= 1) mx = fmaxf(mx, __shfl_xor(mx, o));
        const float inv = mx > 0.f ? 127.f / mx : 0.f; unsigned* o4 = (unsigned*)(F.xq1_() + (size_t)m * DM) + lane;
#pragma unroll
        for (int j = 0; j < 8; ++j) { unsigned w = 0u;
#pragma unroll
            for (int i = 0; i < 4; ++i) w |= ((unsigned)(int)rintf(v[j][i] * inv) & 0xffu) << (8 * i);
            o4[64 * j] = w; }
        if (lane == 0) F.rs1_()[m] = __builtin_amdgcn_rsqf(s * (1.f / DM) + EPS) * (mx * (1.f / 127.f)); }
    { const double invf[16] = {1.0, 0.44036660267178046, 0.19392274474868576, 0.08539710028576561, 0.03760603093086393, 0.016560440080994446, 0.007292664737217109, 0.003211445994752591,
                               0.001414213562373095, 0.000622772421914596, 0.0002742481756762073, 0.00012076973741146504, 5.318295896944988e-05, 2.341999896140934e-05, 1.031338537721246e-05, 4.5416704806078695e-06};
      for (size_t i = gt; i < (size_t)SEQ * 16; i += NT) { const int pos = (int)(i >> 4), j = (int)(i & 15); double f = 1.0;
#pragma unroll
          for (int q = 0; q < 16; ++q) f = (j == q) ? invf[q] : f;
          const double rev = (double)pos * f * 0.15915494309189535; const float fr = (float)(rev - floor(rev));
          F.rope_()[i] = (f32x2){__builtin_amdgcn_cosf(fr), __builtin_amdgcn_sinf(fr)}; } }
}

__device__ __forceinline__ void qknorm_rope(const Frame& F) {
    const int gw = F.vcu * 8 + F.wave, NGW = F.G * 8, lane = F.lane, c = lane & 15;
    for (long it = gw; it < (long)T * 24 / 4; it += NGW) { const long row = it * 4 + (lane >> 4); const int t = (int)(row / 24), slot = (int)(row % 24);
        bf16_t* p = F.h_() + (size_t)t * HP + C_QD + slot * 128 + 8 * c;
        const u32x4 w = *(const u32x4*)p; float y[8] = {bflo(w.x), bfhi(w.x), bflo(w.y), bfhi(w.y), bflo(w.z), bfhi(w.z), bflo(w.w), bfhi(w.w)};
        float ss = 0.f;
#pragma unroll
        for (int e = 0; e < 8; ++e) ss += y[e] * y[e];
        ss += __shfl_xor(ss, 1); ss += __shfl_xor(ss, 2); ss += __shfl_xor(ss, 4); ss += __shfl_xor(ss, 8);
        const float rq = __builtin_amdgcn_rsqf(ss * (1.f / 128.f) + EPS); const float* g = (slot < 12 ? F.qn_g : F.kn_g) + 8 * c;
        const f32x4 g0 = *(const f32x4*)g, g1 = *(const f32x4*)(g + 4);
#pragma unroll
        for (int e = 0; e < 4; ++e) { y[e] *= rq * g0[e]; y[4 + e] *= rq * g1[e]; }
        const int pos = t & (SEQ - 1);
#pragma unroll
        for (int e = 0; e < 8; ++e) { const float partner = __shfl_xor(y[e], 2);
            if (c < 4) { const f32x2 cs = F.rope_()[(size_t)pos * 16 + 8 * (c & 1) + e]; y[e] = (c < 2) ? (y[e] * cs.x - partner * cs.y) : (y[e] * cs.x + partner * cs.y); } }
        if (slot < 12) {
#pragma unroll
            for (int e = 0; e < 8; ++e) y[e] *= QSCALE; }
        u32x4 o; o.x = pk2(y[0], y[1]); o.y = pk2(y[2], y[3]); o.z = pk2(y[4], y[5]); o.w = pk2(y[6], y[7]); *(u32x4*)p = o; }
}

constexpr int GL_GDS = 0, GL_TOT = 8192, GL_QF = 12288, GL_QB = 21504, GL_KF = 30720, GL_KB = 39936, GL_VT = 49152, GL_P = 67584, GL_SF = 76800, GL_SB = 95232, GL_OB = 12288;
constexpr int RS72 = 144;
__device__ __forceinline__ float logsig(float z) { return fminf(z, 0.f) - flog(1.f + fexp(-fabsf(z))); }
__device__ __forceinline__ void gla_gates(const Frame& F, int b, int hh, int n, float (&bf)[8], float (&bb)[8], float& totf, float& totb) {
    const int tid = F.tid, c = tid & 63, ig = F.wave; LAS float* gds = (LAS float*)(F.lds + GL_GDS); LAS float* tot = (LAS float*)(F.lds + GL_TOT);
    const size_t t0 = (size_t)b * SEQ + (size_t)n * 64;
    if (tid < 256) { const int tk = tid >> 2, part = tid & 3; const u32x4 w = *(const u32x4*)(F.h_() + (t0 + tk) * HP + C_GF + part * 8); LAS float* d = gds + tk * 32 + part * 8;
        d[0] = bflo(w.x); d[1] = bfhi(w.x); d[2] = bflo(w.y); d[3] = bfhi(w.y); d[4] = bflo(w.z); d[5] = bfhi(w.z); d[6] = bflo(w.w); d[7] = bfhi(w.w); }
    __syncthreads();
    const int hc = hh * 64 + c; float upf[16], upb[16];
#pragma unroll
    for (int r = 0; r < 16; ++r) { upf[r] = F.up_f[r * 256 + hc]; upb[r] = F.up_b[r * 256 + hc]; }
    const float biasf = F.bias_f[hc], biasb = F.bias_b[hc]; float laf[8], lab[8];
#pragma unroll
    for (int e = 0; e < 8; ++e) { const LAS float* gr = gds + (ig * 8 + e) * 32; float zf = biasf, zb = biasb;
#pragma unroll
        for (int r = 0; r < 16; ++r) { zf += gr[r] * upf[r]; zb += gr[16 + r] * upb[r]; }
        laf[e] = logsig(zf) * 0.0625f; lab[e] = logsig(zb) * 0.0625f; }
    bf[0] = laf[0];
#pragma unroll
    for (int e = 1; e < 8; ++e) bf[e] = bf[e - 1] + laf[e];
    bb[7] = lab[7];
#pragma unroll
    for (int e = 6; e >= 0; --e) bb[e] = bb[e + 1] + lab[e];
    tot[ig * 64 + c] = bf[7]; tot[512 + ig * 64 + c] = bb[0];
    __syncthreads();
    float offf = 0.f, offb = 0.f; totf = 0.f; totb = 0.f;
#pragma unroll
    for (int g = 0; g < 8; ++g) { const float tf = tot[g * 64 + c], tb = tot[512 + g * 64 + c]; totf += tf; totb += tb; offf += (g < ig) ? tf : 0.f; offb += (g > ig) ? tb : 0.f; }
#pragma unroll
    for (int e = 0; e < 8; ++e) { bf[e] += offf; bb[e] += offb; }
}
__device__ __forceinline__ void gla_stage_vT(const Frame& F, const bf16x8 (&vraw)[2]) {
#pragma unroll
    for (int j = 0; j < 2; ++j) { const int q = F.tid + 512 * j, tk = q >> 4, vc = (q & 15) * 8; LAS short* d = (LAS short*)(F.lds + GL_VT) + vc * 72 + tk;
#pragma unroll
        for (int e = 0; e < 8; ++e) d[e * 72] = vraw[j][e]; }
}
__device__ __forceinline__ bf16x8 ldfrag(const LAS unsigned char* base, int row, int s, int hi) { return *(const LAS bf16x8*)(base + row * RS72 + (16 * s + 8 * hi) * 2); }

__device__ __forceinline__ void gla_passA(const Frame& F, int item) {
    const int bh = item >> 8, n = item & 255, b = bh >> 2, hh = bh & 3, tid = F.tid, c = tid & 63, ig = F.wave, lane = F.lane, r32 = lane & 31, hi = lane >> 5;
    const size_t t0 = (size_t)b * SEQ + (size_t)n * 64;
    unsigned short kraw[8]; bf16x8 vraw[2];
#pragma unroll
    for (int e = 0; e < 8; ++e) kraw[e] = F.h_()[(t0 + ig * 8 + e) * HP + C_KA + hh * 64 + c];
#pragma unroll
    for (int j = 0; j < 2; ++j) { const int q = tid + 512 * j; vraw[j] = *(const bf16x8*)(F.h_() + (t0 + (q >> 4)) * HP + C_VA + hh * 128 + (q & 15) * 8); }
    float bf[8], bb[8], totf, totb; gla_gates(F, b, hh, n, bf, bb, totf, totb);
    float kf[8], kb[8];
#pragma unroll
    for (int e = 0; e < 8; ++e) { const float k = bf2f(kraw[e]); kf[e] = k * fexp(totf - bf[e]); kb[e] = k * fexp(totb - bb[e]); }
    { u32x4 o; o.x = pk2(kf[0], kf[1]); o.y = pk2(kf[2], kf[3]); o.z = pk2(kf[4], kf[5]); o.w = pk2(kf[6], kf[7]); *(LAS u32x4*)(F.lds + GL_KF + c * RS72 + ig * 16) = o;
      o.x = pk2(kb[0], kb[1]); o.y = pk2(kb[2], kb[3]); o.z = pk2(kb[4], kb[5]); o.w = pk2(kb[6], kb[7]); *(LAS u32x4*)(F.lds + GL_KB + c * RS72 + ig * 16) = o; }
    gla_stage_vT(F, vraw);
    if (ig == 0) { F.dec_()[((size_t)(0 * 8 + bh) * 256 + n) * 64 + c] = fexp(totf); F.dec_()[((size_t)(1 * 8 + bh) * 256 + n) * 64 + c] = fexp(totb); }
    __syncthreads();
    const int dir = F.wave >> 2, vt = F.wave & 3; const LAS unsigned char* kimg = F.lds + (dir ? GL_KB : GL_KF);
    f32x16 a0 = {}, a1 = {};
#pragma unroll
    for (int s = 0; s < 4; ++s) { const bf16x8 av = ldfrag(F.lds + GL_VT, 32 * vt + r32, s, hi), b0 = ldfrag(kimg, r32, s, hi), b1 = ldfrag(kimg, 32 + r32, s, hi);
        a0 = __builtin_amdgcn_mfma_f32_32x32x16_bf16(av, b0, a0, 0, 0, 0); a1 = __builtin_amdgcn_mfma_f32_32x32x16_bf16(av, b1, a1, 0, 0, 0); }
    unsigned short* st = F.state_() + ((size_t)(dir * 8 + bh) * 256 + n) * 8192;
#pragma unroll
    for (int r = 0; r < 16; ++r) { const int v = 32 * vt + crow(r, hi); st[v * 64 + r32] = (unsigned short)f2bf(a0[r]); st[v * 64 + 32 + r32] = (unsigned short)f2bf(a1[r]); }
    __syncthreads();
}
__device__ __forceinline__ void gla_scan(const Frame& F, int item) {
    const int dir = item >> 7, bh = (item >> 4) & 7, e = (item & 15) * 512 + F.tid, c = e & 63;
    unsigned short* st = F.state_() + (size_t)(dir * 8 + bh) * 256 * 8192 + e; const float* dc = F.dec_() + (size_t)(dir * 8 + bh) * 256 * 64 + c; float S = 0.f;
    float iA[16], dA[16], iB[16], dB[16];
#define SC_N(g, j) (dir ? 255 - ((g) * 16 + (j)) : (g) * 16 + (j))
#define SC_LOAD(I_, D_, g) do { _Pragma("unroll") for (int j = 0; j < 16; ++j) { const int n_ = SC_N(g, j); I_[j] = bf2f(st[(size_t)n_ * 8192]); D_[j] = dc[n_ * 64]; } } while (0)
#define SC_RUN(I_, D_, g) do { _Pragma("unroll") for (int j = 0; j < 16; ++j) { const int n_ = SC_N(g, j); st[(size_t)n_ * 8192] = (unsigned short)f2bf(S); S = D_[j] * S + I_[j]; } } while (0)
    SC_LOAD(iA, dA, 0);
    for (int g = 0; g < 16; g += 2) { SC_LOAD(iB, dB, g + 1); SC_RUN(iA, dA, g); if (g + 2 < 16) SC_LOAD(iA, dA, g + 2); SC_RUN(iB, dB, g + 1); }
#undef SC_N
#undef SC_LOAD
#undef SC_RUN
}
__device__ __forceinline__ void gla_passC(const Frame& F, int item) {
    const int bh = item >> 8, n = item & 255, b = bh >> 2, hh = bh & 3, tid = F.tid, c = tid & 63, ig = F.wave, lane = F.lane, r32 = lane & 31, hi = lane >> 5;
    const size_t t0 = (size_t)b * SEQ + (size_t)n * 64;
    unsigned short qraw[8], kraw[8]; bf16x8 vraw[2]; u32x4 sraw[2][2];
#pragma unroll
    for (int e = 0; e < 8; ++e) { const bf16_t* hr = F.h_() + (t0 + ig * 8 + e) * HP + hh * 64 + c; qraw[e] = hr[C_QA]; kraw[e] = hr[C_KA]; }
#pragma unroll
    for (int j = 0; j < 2; ++j) { const int q = tid + 512 * j; vraw[j] = *(const bf16x8*)(F.h_() + (t0 + (q >> 4)) * HP + C_VA + hh * 128 + (q & 15) * 8);
#pragma unroll
        for (int dir = 0; dir < 2; ++dir) sraw[dir][j] = *(const u32x4*)(F.state_() + ((size_t)(dir * 8 + bh) * 256 + n) * 8192 + (q >> 3) * 64 + (q & 7) * 8); }
    float bf[8], bb[8], totf, totb; gla_gates(F, b, hh, n, bf, bb, totf, totb);
#pragma unroll
    for (int e = 0; e < 8; ++e) { const int i = ig * 8 + e; const float q = bf2f(qraw[e]) * 0.125f, k = bf2f(kraw[e]);
        const float ef = fexp(bf[e]), eb = fexp(bb[e]), nf = fexp(-bf[e]), nb = fexp(-bb[e]);
        *(LAS unsigned short*)(F.lds + GL_QF + i * RS72 + c * 2) = (unsigned short)f2bf(q * ef); *(LAS unsigned short*)(F.lds + GL_QB + i * RS72 + c * 2) = (unsigned short)f2bf(q * eb);
        *(LAS unsigned short*)(F.lds + GL_KF + i * RS72 + c * 2) = (unsigned short)f2bf(k * nf); *(LAS unsigned short*)(F.lds + GL_KB + i * RS72 + c * 2) = (unsigned short)f2bf(k * nb); }
    gla_stage_vT(F, vraw);
#pragma unroll
    for (int dir = 0; dir < 2; ++dir)
#pragma unroll
        for (int j = 0; j < 2; ++j) { const int q = tid + 512 * j; *(LAS u32x4*)(F.lds + (dir ? GL_SB : GL_SF) + (q >> 3) * RS72 + (q & 7) * 16) = sraw[dir][j]; }
    __syncthreads();
    if (F.wave < 4) { const int ti = F.wave >> 1, tj = F.wave & 1; f32x16 sf = {}, sb = {};
#pragma unroll
        for (int s = 0; s < 4; ++s) {
            sf = __builtin_amdgcn_mfma_f32_32x32x16_bf16(ldfrag(F.lds + GL_QF, 32 * ti + r32, s, hi), ldfrag(F.lds + GL_KF, 32 * tj + r32, s, hi), sf, 0, 0, 0);
            sb = __builtin_amdgcn_mfma_f32_32x32x16_bf16(ldfrag(F.lds + GL_QB, 32 * ti + r32, s, hi), ldfrag(F.lds + GL_KB, 32 * tj + r32, s, hi), sb, 0, 0, 0); }
#pragma unroll
        for (int r = 0; r < 16; ++r) { const int i = 32 * ti + crow(r, hi), j = 32 * tj + r32; const float p = (j <= i) ? sf[r] : sb[r];
            *(LAS unsigned short*)(F.lds + GL_P + i * RS72 + j * 2) = (unsigned short)f2bf(p); } }
    __syncthreads();
    const int ti = F.wave & 1, tv = F.wave >> 1; f32x16 o = {};
#pragma unroll
    for (int s = 0; s < 4; ++s) o = __builtin_amdgcn_mfma_f32_32x32x16_bf16(ldfrag(F.lds + GL_P, 32 * ti + r32, s, hi), ldfrag(F.lds + GL_VT, 32 * tv + r32, s, hi), o, 0, 0, 0);
#pragma unroll
    for (int s = 0; s < 4; ++s) o = __builtin_amdgcn_mfma_f32_32x32x16_bf16(ldfrag(F.lds + GL_QF, 32 * ti + r32, s, hi), ldfrag(F.lds + GL_SF, 32 * tv + r32, s, hi), o, 0, 0, 0);
#pragma unroll
    for (int s = 0; s < 4; ++s) o = __builtin_amdgcn_mfma_f32_32x32x16_bf16(ldfrag(F.lds + GL_QB, 32 * ti + r32, s, hi), ldfrag(F.lds + GL_SB, 32 * tv + r32, s, hi), o, 0, 0, 0);
    __syncthreads();
    LAS float* ob = (LAS float*)(F.lds + GL_OB);
#pragma unroll
    for (int r = 0; r < 16; ++r) ob[(32 * ti + crow(r, hi)) * 132 + 32 * tv + r32] = o[r];
    __syncthreads();
    { const int i = tid >> 3, part = tid & 7, v0 = part * 16; float ov[16], ss = 0.f;
#pragma unroll
      for (int e = 0; e < 16; ++e) { ov[e] = ob[i * 132 + v0 + e]; ss += ov[e] * ov[e]; }
      ss += __shfl_xor(ss, 1); ss += __shfl_xor(ss, 2); ss += __shfl_xor(ss, 4);
      const float rs = __builtin_amdgcn_rsqf(ss * (1.f / 128.f) + EPS); const size_t tok = t0 + i;
      const u32x4 r0 = *(const u32x4*)(F.h_() + tok * HP + C_RA + hh * 128 + v0), r1 = *(const u32x4*)(F.h_() + tok * HP + C_RA + hh * 128 + v0 + 8);
      const float rr[16] = {bflo(r0.x), bfhi(r0.x), bflo(r0.y), bfhi(r0.y), bflo(r0.z), bfhi(r0.z), bflo(r0.w), bfhi(r0.w), bflo(r1.x), bfhi(r1.x), bflo(r1.y), bfhi(r1.y), bflo(r1.z), bfhi(r1.z), bflo(r1.w), bfhi(r1.w)};
      float y[16];
#pragma unroll
      for (int e = 0; e < 16; ++e) { const float g = F.out_g[hh * 128 + v0 + e]; const float sil = rr[e] * __builtin_amdgcn_rcpf(1.f + fexp(-rr[e])); y[e] = ov[e] * rs * g * sil; }
      u32x4 w0, w1; w0.x = pk2(y[0], y[1]); w0.y = pk2(y[2], y[3]); w0.z = pk2(y[4], y[5]); w0.w = pk2(y[6], y[7]); w1.x = pk2(y[8], y[9]); w1.y = pk2(y[10], y[11]); w1.z = pk2(y[12], y[13]); w1.w = pk2(y[14], y[15]);
      bf16_t* mp = F.mixed_() + tok * DM + hh * 128 + v0; *(u32x4*)mp = w0; *(u32x4*)(mp + 8) = w1; }
    __syncthreads();
}

constexpr int AT_V = 0, AT_K = 49152, AT_O = 81920, AT_OSZ = 4352;
#define KSWZ(row, colB) ((row) * 256 + ((colB) ^ (((row) & 7) << 4)))
__device__ __forceinline__ int v_st(int k, int c) { const int kk = (k & ~0xC) | ((k & 4) << 1) | ((k & 8) >> 1); return ((kk >> 3) * 4 + (c >> 5)) * 512 + ((kk & 7) * 32 + (c & 31)) * 2; }
__device__ __forceinline__ int v_rd_base(int lane) { return ((lane & 3) << 3) | (((lane >> 2) & 3) << 6) | (((lane >> 4) & 1) << 5) | (((lane >> 5) & 1) << 8); }
constexpr int v_rd_off(int d0, int ks, int half) { return d0 * 512 + ks * 4096 + half * 2048; }
template <int OFF> __device__ __forceinline__ s16x4 tr_read(int vb) { s16x4 r; asm volatile("ds_read_b64_tr_b16 %0, %1 offset:%2" : "=&v"(r) : "v"(vb), "i"(OFF) : "memory"); return r; }
template <int D0> __device__ __forceinline__ void pv_one(f32x16& od, int vb, bf16x8 pa0, bf16x8 pa1, bf16x8 pa2, bf16x8 pa3) {
    const s16x4 l0 = tr_read<v_rd_off(D0, 0, 0)>(vb), h0 = tr_read<v_rd_off(D0, 0, 1)>(vb), l1 = tr_read<v_rd_off(D0, 1, 0)>(vb), h1 = tr_read<v_rd_off(D0, 1, 1)>(vb);
    const s16x4 l2 = tr_read<v_rd_off(D0, 2, 0)>(vb), h2 = tr_read<v_rd_off(D0, 2, 1)>(vb), l3 = tr_read<v_rd_off(D0, 3, 0)>(vb), h3 = tr_read<v_rd_off(D0, 3, 1)>(vb);
    asm volatile("s_waitcnt lgkmcnt(0)" ::: "memory"); SBAR();
#define PKV(L, H) (bf16x8){L[0], L[1], L[2], L[3], H[0], H[1], H[2], H[3]}
    od = __builtin_amdgcn_mfma_f32_32x32x16_bf16(pa0, PKV(l0, h0), od, 0, 0, 0);
    od = __builtin_amdgcn_mfma_f32_32x32x16_bf16(pa1, PKV(l1, h1), od, 0, 0, 0);
    od = __builtin_amdgcn_mfma_f32_32x32x16_bf16(pa2, PKV(l2, h2), od, 0, 0, 0);
    od = __builtin_amdgcn_mfma_f32_32x32x16_bf16(pa3, PKV(l3, h3), od, 0, 0, 0);
#undef PKV
}
struct AtP { size_t tokbase; int dil, m0, Tf, nt, head, p; };
__device__ __forceinline__ AtP at_decode(int item) {
    AtP P; const int round = item >> 8, w = item & 255, p = round % 3, bh = round / 3, b = bh / 3, u = w & 63; P.p = p; P.head = (bh % 3) * 4 + (w >> 6);
    const int dsh = 2 * p, L = SEQ >> dsh, runs = 64 >> dsh, res = u / runs; P.dil = 1 << dsh; P.m0 = (u % runs) * 256; P.tokbase = (size_t)b * SEQ + res;
    const int kt_lo = (P.m0 == 0) ? 1 : 0, kt_hi = (P.m0 + 256 >= L) ? 4 : 5; P.Tf = P.m0 - 64 + 64 * kt_lo; P.nt = kt_hi - kt_lo + 1; return P;
}
__device__ __forceinline__ void attn_phase(const Frame& F) {
    const int tid = F.tid, wid = F.wave, lane = F.lane, r32 = lane & 31, hi = lane >> 5, G = F.G;
    int ntot = 0; for (int it = F.vcu; it < 4608; it += G) ntot += at_decode(it).nt;
    if (ntot == 0) return;
    const int sr = tid >> 4, sc = (tid & 15) * 8, vst0 = v_st(sr, sc), vst1 = v_st(32 + sr, sc), kc = sc * 2;
    const int vb0 = (int)(unsigned)(uintptr_t)(F.ldsg + AT_V) + v_rd_base(lane);
    int it_ld = F.vcu, rl = 0, it_c = F.vcu, rc = 0; AtP ld = at_decode(it_ld), cur = ld;
    bf16x8 qr[8], qn[8]; f32x16 o[4]; float l_reg = 0.f;
    bf16x8 sA0, sA1, sA2, sA3, sB0, sB1, sB2, sB3;
    const bool rot = false;
    bf16x8 pa0, pa1, pa2, pa3;
    bool pend = false, pend_last = false; int vprev = 0, prvQ0 = 0; AtP prv = cur;
#pragma unroll
    for (int d0 = 0; d0 < 4; ++d0) o[d0] = (f32x16){};
#define AT_QLOAD() do { const bf16_t* qp_ = F.h_() + C_QD + ld.head * 128 + (ld.tokbase + (size_t)ld.dil * (ld.m0 + 32 * wid + r32)) * HP + hi * 8; \
        _Pragma("unroll") for (int d0 = 0; d0 < 8; ++d0) qn[d0] = *(const bf16x8*)(qp_ + d0 * 16); } while (0)
#define AT_SLOAD(S) do { const int T0_ = ld.Tf + 64 * rl; const size_t ra = (ld.tokbase + (size_t)ld.dil * (T0_ + sr)) * HP + ld.head * 128 + sc, rb = ra + (size_t)ld.dil * 32 * HP; \
        S##0 = *(const bf16x8*)(F.h_() + C_VD + ra); S##1 = *(const bf16x8*)(F.h_() + C_VD + rb); S##2 = *(const bf16x8*)(F.h_() + C_KD + ra); S##3 = *(const bf16x8*)(F.h_() + C_KD + rb); \
        if (++rl == ld.nt) { it_ld += G; rl = 0; if (it_ld < 4608) { ld = at_decode(it_ld); AT_QLOAD(); } } } while (0)
#define AT_SWRITE(S, KB, VB) do { *(LAS bf16x8*)(F.lds + AT_V + (VB) * 16384 + vst0) = S##0; *(LAS bf16x8*)(F.lds + AT_V + (VB) * 16384 + vst1) = S##1; \
        *(LAS bf16x8*)(F.lds + AT_K + (KB) * 16384 + KSWZ(sr, kc)) = S##2; *(LAS bf16x8*)(F.lds + AT_K + (KB) * 16384 + KSWZ(32 + sr, kc)) = S##3; } while (0)
#define PK4(P, BASE, OUT) do { unsigned a0_ = pk2(P[BASE + 0], P[BASE + 1]), a1_ = pk2(P[BASE + 2], P[BASE + 3]); unsigned b0_ = pk2(P[BASE + 4], P[BASE + 5]), b1_ = pk2(P[BASE + 6], P[BASE + 7]); \
        auto r0_ = __builtin_amdgcn_permlane32_swap(a0_, b0_, false, false); auto r1_ = __builtin_amdgcn_permlane32_swap(a1_, b1_, false, false); \
        u32x4 w_ = {r0_[0], r1_[0], r0_[1], r1_[1]}; OUT = __builtin_bit_cast(bf16x8, w_); } while (0)
#define AT_TRD(OFF) __builtin_amdgcn_ds_read_tr16_b64_v4i16((LAS s16x4*)(uintptr_t)(unsigned)(vb_ + (OFF)))
#define AT_PVR(D0, R) do { R[0] = AT_TRD(v_rd_off(D0, 0, 0)); R[1] = AT_TRD(v_rd_off(D0, 0, 1)); R[2] = AT_TRD(v_rd_off(D0, 1, 0)); R[3] = AT_TRD(v_rd_off(D0, 1, 1)); \
        R[4] = AT_TRD(v_rd_off(D0, 2, 0)); R[5] = AT_TRD(v_rd_off(D0, 2, 1)); R[6] = AT_TRD(v_rd_off(D0, 3, 0)); R[7] = AT_TRD(v_rd_off(D0, 3, 1)); } while (0)
#define AT_PKV(L, H) (bf16x8){L[0], L[1], L[2], L[3], H[0], H[1], H[2], H[3]}
#define AT_MF(OD, R) do { OD = __builtin_amdgcn_mfma_f32_32x32x16_bf16(pa0, AT_PKV(R[0], R[1]), OD, 0, 0, 0); OD = __builtin_amdgcn_mfma_f32_32x32x16_bf16(pa1, AT_PKV(R[2], R[3]), OD, 0, 0, 0); \
        OD = __builtin_amdgcn_mfma_f32_32x32x16_bf16(pa2, AT_PKV(R[4], R[5]), OD, 0, 0, 0); OD = __builtin_amdgcn_mfma_f32_32x32x16_bf16(pa3, AT_PKV(R[6], R[7]), OD, 0, 0, 0); } while (0)
#define AT_PV(VB) do { const int vb_ = vb0 + (VB) * 16384; s16x4 RA[8], RB[8]; \
        AT_PVR(0, RA); AT_PVR(1, RB); SBAR(); AT_MF(o[0], RA); SBAR(); AT_PVR(2, RA); SBAR(); AT_MF(o[1], RB); SBAR(); AT_PVR(3, RB); SBAR(); AT_MF(o[2], RA); AT_MF(o[3], RB); } while (0)
#define AT_EPI(P_, Q0_) do { \
            unsigned char* Op = (P_.p == 0 ? (unsigned char*)F.out + OUT_OP0 : F.wsb + (P_.p == 1 ? WS_OP1 : WS_OP2)); \
            const float lt = l_reg + __shfl_xor(l_reg, 32); \
            LAS unsigned char* stg = F.lds + AT_O + wid * AT_OSZ; \
            if (hi == 0) { F.lp_()[((size_t)P_.p * T + P_.tokbase + (size_t)P_.dil * ((Q0_) + r32)) * NHD + P_.head] = lt; *(LAS float*)(stg + 4096 + r32 * 4) = lt; } \
            LDS_WAIT(); asm volatile("" ::: "memory"); \
            float rli[16]; _Pragma("unroll") for (int r = 0; r < 16; ++r) rli[r] = __builtin_amdgcn_rcpf(*(const LAS float*)(stg + 4096 + crow(r, hi) * 4)); \
            _Pragma("unroll") for (int d0 = 0; d0 < 4; ++d0) _Pragma("unroll") for (int r = 0; r < 16; ++r) *(LAS unsigned char*)(stg + crow(r, hi) * 128 + d0 * 32 + r32) = (unsigned char)__builtin_amdgcn_cvt_pk_fp8_f32(o[d0][r] * rli[r], 0.f, 0, false); \
            LDS_WAIT(); asm volatile("" ::: "memory"); \
            _Pragma("unroll") for (int i_ = 0; i_ < 4; ++i_) { const int row = 8 * i_ + (lane >> 3), ch = lane & 7; const u32x4 w = *(const LAS u32x4*)(stg + row * 128 + ch * 16); \
                *(u32x4*)(Op + (P_.tokbase + (size_t)P_.dil * ((Q0_) + row)) * (NHD * 128) + P_.head * 128 + ch * 16) = w; } \
            LDS_WAIT(); asm volatile("" ::: "memory"); \
            _Pragma("unroll") for (int d0 = 0; d0 < 4; ++d0) o[d0] = (f32x16){}; l_reg = 0.f; } while (0)
#define AT_STEP(KB, VB) do { \
        if (rot && pend) AT_PV(vprev);                                                           \
        if (pend_last) AT_EPI(prv, prvQ0);                                                       \
        if (rc == 0) { _Pragma("unroll") for (int d0 = 0; d0 < 8; ++d0) qr[d0] = qn[d0]; } \
        const int Q0 = cur.m0 + 32 * wid, T0 = cur.Tf + 64 * rc; \
        const bool act = T0 + 63 >= Q0 - 64 && T0 <= Q0 + 95;                                \
        if (act) { \
            const LAS unsigned char* Ks = F.lds + AT_K + (KB) * 16384; f32x16 p0 = {}, p1 = {}; \
            _Pragma("unroll") for (int d0 = 0; d0 < 8; ++d0) { const int cb = (d0 * 16 + hi * 8) * 2; \
                const bf16x8 k0 = *(const LAS bf16x8*)(Ks + KSWZ(r32, cb)), k1 = *(const LAS bf16x8*)(Ks + KSWZ(32 + r32, cb)); \
                p0 = __builtin_amdgcn_mfma_f32_32x32x16_bf16(k0, qr[d0], p0, 0, 0, 0); p1 = __builtin_amdgcn_mfma_f32_32x32x16_bf16(k1, qr[d0], p1, 0, 0, 0); } \
            const int dq = T0 - (Q0 + r32); float ps = 0.f;                                \
            _Pragma("unroll") for (int r = 0; r < 16; ++r) { const int e0 = dq + crow(r, hi), e1 = e0 + 32; \
                p0[r] = (e0 >= -64 && e0 <= 64) ? __builtin_amdgcn_exp2f(p0[r]) : 0.f; p1[r] = (e1 >= -64 && e1 <= 64) ? __builtin_amdgcn_exp2f(p1[r]) : 0.f; ps += p0[r] + p1[r]; } \
            l_reg += ps; \
            PK4(p0, 0, pa0); PK4(p0, 8, pa1); PK4(p1, 0, pa2); PK4(p1, 8, pa3); } \
        const bool last = rc + 1 == cur.nt; \
        if (!rot) { if (act) AT_PV(VB); } else { pend = act; vprev = (VB); } \
        pend_last = last; if (last) { prv = cur; prvQ0 = Q0; } \
        if (last) { rc = 0; it_c += G; if (it_c < 4608) cur = at_decode(it_c); } else ++rc; } while (0)
    AT_QLOAD();
    AT_SLOAD(sA); AT_SLOAD(sB); AT_SWRITE(sA, 0, 0); AT_SLOAD(sA); __syncthreads();
    int v3 = 0;
    for (int g = 0; g < ntot; g += 2) { int v3n = v3 == 2 ? 0 : v3 + 1;
        AT_STEP(0, v3);
        if (g + 1 < ntot) AT_SWRITE(sB, 1, v3n);
        if (it_ld < 4608) AT_SLOAD(sB);
        v3 = v3n; v3n = v3 == 2 ? 0 : v3 + 1;
        __syncthreads();
        if (g + 1 < ntot) {
            AT_STEP(1, v3);
            if (g + 2 < ntot) AT_SWRITE(sA, 0, v3n);
            if (it_ld < 4608) AT_SLOAD(sA);
            v3 = v3n;
            __syncthreads(); }
    }
    if (rot && pend) AT_PV(vprev);
    if (pend_last) AT_EPI(prv, prvQ0);
#undef AT_QLOAD
#undef AT_SLOAD
#undef AT_SWRITE
#undef PK4
#undef AT_PV
#undef AT_TRD
#undef AT_PVR
#undef AT_PKV
#undef AT_MF
#undef AT_EPI
#undef AT_STEP
}
__device__ __forceinline__ void dil_combine(const Frame& F) {
    const int gw = F.vcu * 8 + F.wave, NGW = F.G * 8, lane = F.lane, c = lane & 15;
    const unsigned char* o0 = (const unsigned char*)F.op0_(); const unsigned char* o1 = (const unsigned char*)F.op1_(); const unsigned char* o2 = (const unsigned char*)F.op2_();
    for (long it = gw; it < (long)T * NHD / 4; it += NGW) { const long row = it * 4 + (lane >> 4); const size_t tok = (size_t)(row / NHD); const int head = (int)(row % NHD);
        const float l0 = F.lp_()[tok * NHD + head], l1 = F.lp_()[((size_t)T + tok) * NHD + head], l2 = F.lp_()[((size_t)2 * T + tok) * NHD + head]; const float inv = 1.f / (l0 + l1 + l2), w0 = l0 * inv, w1 = l1 * inv, w2 = l2 * inv;
        const size_t off = tok * (NHD * 128) + head * 128 + 8 * c; const u32x2 a = *(const u32x2*)(o0 + off), b = *(const u32x2*)(o1 + off), d = *(const u32x2*)(o2 + off);
#define DC2(AW, BW, DW, SEL) ({ const f32x2 x_ = __builtin_amdgcn_cvt_pk_f32_fp8((int)(AW), SEL), y_ = __builtin_amdgcn_cvt_pk_f32_fp8((int)(BW), SEL), z_ = __builtin_amdgcn_cvt_pk_f32_fp8((int)(DW), SEL); \
            pk2(w0 * x_[0] + w1 * y_[0] + w2 * z_[0], w0 * x_[1] + w1 * y_[1] + w2 * z_[1]); })
        u32x4 o; o.x = DC2(a.x, b.x, d.x, false); o.y = DC2(a.x, b.x, d.x, true); o.z = DC2(a.y, b.y, d.y, false); o.w = DC2(a.y, b.y, d.y, true);
#undef DC2
        *(u32x4*)(F.mixed_() + tok * DM + 512 + head * 128 + 8 * c) = o; }
}

__device__ __forceinline__ unsigned fl_flip(float x) { const unsigned u = __float_as_uint(x); return u ^ ((unsigned)((int)u >> 31) | 0x80000000u); }
__device__ __forceinline__ float fl_unflip(unsigned w) { return __uint_as_float((w & 0x80000000u) ? (w ^ 0x80000000u) : ~w); }
#define CE_DESC(a, b) do { const unsigned x_ = max(a, b), y_ = min(a, b); a = x_; b = y_; } while (0)
__device__ __forceinline__ void sort16_desc(unsigned (&a)[16]) {
#pragma unroll
    for (int k = 2; k <= 16; k <<= 1)
#pragma unroll
        for (int j = k >> 1; j > 0; j >>= 1)
#pragma unroll
            for (int i = 0; i < 16; ++i) { const int l = i ^ j; if (l > i) { const unsigned x = max(a[i], a[l]), y = min(a[i], a[l]); if ((i & k) == 0) { a[i] = x; a[l] = y; } else { a[i] = y; a[l] = x; } } }
}
__device__ __forceinline__ void bmerge16_desc(unsigned (&a)[16]) {
#pragma unroll
    for (int j = 8; j > 0; j >>= 1)
#pragma unroll
        for (int i = 0; i < 16; ++i) { const int l = i ^ j; if (l > i) CE_DESC(a[i], a[l]); }
}
__device__ __forceinline__ void top16_merge(unsigned (&a)[16], const unsigned (&b)[16]) {
#pragma unroll
    for (int i = 0; i < 16; ++i) a[i] = max(a[i], b[15 - i]);
    bmerge16_desc(a);
}
__device__ __forceinline__ void top16_partner(unsigned (&a)[16]) {
    unsigned b[16];
#pragma unroll
    for (int i = 0; i < 16; ++i) b[i] = (unsigned)__shfl_xor((int)a[i], 32);
    top16_merge(a, b);
}
__device__ constexpr unsigned char stair(int n) {
    constexpr unsigned char L[64] = {0x00,0x01,0x02,0x03,0x04,0x05,0x06,0x07,0x08,0x09,0x0a,0x0b,0x0c,0x0d,0x0e,0x0f,0x10,0x11,0x12,0x13,0x14,0x15,0x16,0x17,0x20,0x21,0x22,0x23,0x24,0x30,0x31,0x32,
                                     0x33,0x40,0x41,0x42,0x50,0x51,0x60,0x61,0x70,0x71,0x80,0x90,0xa0,0xb0,0xc0,0xd0,0xe0,0xf0,0xff,0xff,0xff,0xff,0xff,0xff,0xff,0xff,0xff,0xff,0xff,0xff,0xff,0xff};
    return L[n];
}
constexpr int TK_KEYS = 32768;
__device__ __forceinline__ void topk_item(const Frame& F, int hh, int tg) {
    const int lane = F.lane, r32 = lane & 31, hi = lane >> 5, tok0 = tg * 32; const size_t tok = (size_t)tok0 + r32;
    LAS int* ktab = (LAS int*)(F.lds + F.wave * 4096) + r32 * 32;
    float ss = 0.f;
    { const f32x4* sp = (const f32x4*)(F.ssp_() + tok * 32 + hi * 16);
#pragma unroll
      for (int j = 0; j < 4; ++j) { const f32x4 v = sp[j]; ss += (v[0] + v[1]) + (v[2] + v[3]); } }
    ss += __shfl_xor(ss, 32);
    const float rs2 = __builtin_amdgcn_rsqf(ss * (1.f / DM) + EPS);
    if (hh == 0 && hi == 0) F.rs2_()[tok] = rs2;
    unsigned top[2][16];
#pragma unroll
    for (int cc = 0; cc < 2; ++cc) {
        f32x16 acc[4] = {};
        const bf16_t* qp = F.qry_() + tok * DM + hh * 256 + cc * 128 + hi * 8; const LAS unsigned char* kl = F.lds + TK_KEYS + cc * 32768;
        bf16x8 qf[8];
#pragma unroll
        for (int s = 0; s < 8; ++s) qf[s] = *(const bf16x8*)(qp + 16 * s);
#pragma unroll
        for (int s = 0; s < 8; ++s) {
#pragma unroll
            for (int kt = 0; kt < 4; ++kt) { const bf16x8 kf = *(const LAS bf16x8*)(kl + KSWZ(kt * 32 + r32, (16 * s + 8 * hi) * 2)); acc[kt] = __builtin_amdgcn_mfma_f32_32x32x16_bf16(kf, qf[s], acc[kt], 0, 0, 0); } }
        unsigned g[4][16];
#pragma unroll
        for (int kt = 0; kt < 4; ++kt) {
#pragma unroll
            for (int r = 0; r < 16; ++r) g[kt][r] = (fl_flip(acc[kt][r]) & ~127u) | (unsigned)(127 - (32 * kt + crow(r, hi)));
            sort16_desc(g[kt]); }
        top16_merge(g[0], g[1]); top16_merge(g[2], g[3]); top16_merge(g[0], g[2]); top16_partner(g[0]);
#pragma unroll
        for (int i = 0; i < 16; ++i) top[cc][i] = g[0][i];
    }
#pragma unroll
    for (int i = 0; i < 16; ++i) ktab[hi * 16 + i] = 127 - (int)((hi ? top[1][i] : top[0][i]) & 127u);
    float s0[16], s1[16];
#pragma unroll
    for (int i = 0; i < 16; ++i) { s0[i] = fl_unflip(top[0][i] & ~127u); s1[i] = fl_unflip(top[1][i] & ~127u); }
    unsigned ca[16], cb[16];
#pragma unroll
    for (int n = 0; n < 32; ++n) { const int A = stair(n), B = stair(25 + n); unsigned va = 0u, vb = 0u;
        if (n < 25) { va = (fl_flip(s0[A >> 4] + s1[A & 15]) & ~255u) | (unsigned)(255 - A); vb = (fl_flip(s0[B >> 4] + s1[B & 15]) & ~255u) | (unsigned)(255 - B); }
        const unsigned v = hi ? vb : va; if (n < 16) ca[n] = v; else cb[n - 16] = v; }
    sort16_desc(ca); sort16_desc(cb); top16_merge(ca, cb); top16_partner(ca);
    float e[16], sum = 0.f; const float mx = fl_unflip(ca[0] & ~255u) * rs2;
#pragma unroll
    for (int i = 0; i < 16; ++i) { e[i] = fexp(fl_unflip(ca[i] & ~255u) * rs2 - mx); sum += e[i]; }
    const float inv = 1.f / sum;
    LDS_WAIT(); asm volatile("" ::: "memory");
    int oi[8]; float og[8];
#pragma unroll
    for (int k = 0; k < 8; ++k) { const unsigned cv = hi ? ca[8 + k] : ca[k]; const int code = 255 - (int)(cv & 255u); og[k] = (hi ? e[8 + k] : e[k]) * inv; oi[k] = ktab[code >> 4] * 128 + ktab[16 + (code & 15)]; }
    { unsigned short* ip = F.idx_() + tok * 128 + hh * 16 + hi * 8; float* gp = F.gate_() + tok * 128 + hh * 16 + hi * 8;
      *(u32x4*)ip = (u32x4){(unsigned)oi[0] | ((unsigned)oi[1] << 16), (unsigned)oi[2] | ((unsigned)oi[3] << 16), (unsigned)oi[4] | ((unsigned)oi[5] << 16), (unsigned)oi[6] | ((unsigned)oi[7] << 16)};
      { const int g0 = hh * 4 + hi * 2;
        *(u32x2*)(F.idxT_() + ((size_t)g0 * T + tok) * 4) = (u32x2){(unsigned)oi[0] | ((unsigned)oi[1] << 16), (unsigned)oi[2] | ((unsigned)oi[3] << 16)};
        *(u32x2*)(F.idxT_() + ((size_t)(g0 + 1) * T + tok) * 4) = (u32x2){(unsigned)oi[4] | ((unsigned)oi[5] << 16), (unsigned)oi[6] | ((unsigned)oi[7] << 16)}; }
      *(f32x4*)gp = (f32x4){og[0], og[1], og[2], og[3]}; *(f32x4*)(gp + 4) = (f32x4){og[4], og[5], og[6], og[7]}; }
    LDS_WAIT(); asm volatile("" ::: "memory");
}

constexpr int PS_NSL = 8, PS_CW = DM / PS_NSL, PS_SUB = PS_NSL / 8, PS_TG = 32, PS_NTG = T / PS_TG;
__device__ __forceinline__ float gelu_tanh(float x) { const float u = 0.7978845608028654f * (x + 0.044715f * x * x * x); const float t = 1.f - 2.f * __builtin_amdgcn_rcpf(1.f + fexp(2.f * u)); return 0.5f * x * (1.f + t); }
__device__ __forceinline__ int dot32n(u32x4 w, u32x4 xh, u32x4 xl) {
    int ph = __builtin_amdgcn_sdot8((int)w.x, (int)xh.x, 0, false); ph = __builtin_amdgcn_sdot8((int)w.y, (int)xh.y, ph, false); ph = __builtin_amdgcn_sdot8((int)w.z, (int)xh.z, ph, false); ph = __builtin_amdgcn_sdot8((int)w.w, (int)xh.w, ph, false);
    int pl = __builtin_amdgcn_sdot8((int)w.x, (int)xl.x, 0, false); pl = __builtin_amdgcn_sdot8((int)w.y, (int)xl.y, pl, false); pl = __builtin_amdgcn_sdot8((int)w.z, (int)xl.z, pl, false); pl = __builtin_amdgcn_sdot8((int)w.w, (int)xl.w, pl, false);
    return (ph << 4) + pl; }
__device__ __forceinline__ unsigned xcc_id() { return (unsigned)__builtin_amdgcn_s_getreg((3 << 11) | 20) & 7u; }
__device__ __forceinline__ bool peer_claim(unsigned* cnt, unsigned x, unsigned& d, int lane, int& q, int& tg) {
    while (d < 8u) { const unsigned xq = (x + d) & 7u; unsigned u = 0u;
        if (lane == 0) u = __hip_atomic_fetch_add(cnt + 64 * xq, 1u, __ATOMIC_RELAXED, __HIP_MEMORY_SCOPE_AGENT);
        u = (unsigned)__builtin_amdgcn_readfirstlane((int)u);
        if (u < (unsigned)(PS_SUB * PS_NTG)) { q = (int)(u / PS_NTG) * 8 + (int)xq; tg = (int)(u % PS_NTG); return true; }
        ++d; }
    return false;
}
template <int CTRL> __device__ __forceinline__ float dppmov(float x) { return __int_as_float(__builtin_amdgcn_update_dpp(0, __float_as_int(x), CTRL, 0xf, 0xf, true)); }
template <int CTRL> __device__ __forceinline__ int dppmovi(int x) { return __builtin_amdgcn_update_dpp(0, x, CTRL, 0xf, 0xf, true); }
__device__ __forceinline__ int bperm(int srclane, int v) { return __builtin_amdgcn_ds_bpermute(srclane << 2, v); }
__device__ __forceinline__ unsigned swar_add8(unsigned q) { return ((q & 0x7f7f7f7fu) + 0x08080808u) ^ (q & 0x80808080u); }
__device__ __forceinline__ void peer_quant_x(const Frame& F) {
    const int gw = F.vcu * 8 + F.wave, NGW = F.G * 8, lane = F.lane;
    for (int tok = gw; tok < T; tok += NGW) { const u32x4* xr = (const u32x4*)(F.x1b_() + (size_t)tok * DM) + lane; f32x4 v[4][2]; float m = 0.f;
#pragma unroll
        for (int j = 0; j < 4; ++j) { const u32x4 w = xr[64 * j]; v[j][0] = (f32x4){bflo(w.x), bfhi(w.x), bflo(w.y), bfhi(w.y)}; v[j][1] = (f32x4){bflo(w.z), bfhi(w.z), bflo(w.w), bfhi(w.w)};
#pragma unroll
            for (int i = 0; i < 4; ++i) m = fmaxf(m, fmaxf(fabsf(v[j][0][i]), fabsf(v[j][1][i]))); }
#pragma unroll
        for (int o = 1; o < 64; o <<= 1) m = fmaxf(m, __shfl_xor(m, o));
        const float inv = m > 0.f ? 119.f / m : 0.f;
#pragma unroll
        for (int j = 0; j < 4; ++j) { const unsigned qa = pack_i8x4(v[j][0], inv, 119.f), qb = pack_i8x4(v[j][1], inv, 119.f);
            const unsigned wl = pack_nib(qa, qb), wh = pack_nib(swar_add8(qa) >> 4, swar_add8(qb) >> 4);
            const int col = 8 * lane + 512 * j; unsigned char* p = F.xq8_() + (size_t)tok * DM + (col >> 8) * 256 + ((col & 255) >> 5) * 32 + ((col & 31) >> 3) * 4;
            *(unsigned*)p = wh; *(unsigned*)(p + 16) = wl; }
        if (lane == 0) F.sx_()[tok] = m * (1.f / 119.f); }
}
__device__ __forceinline__ void peer_down(const Frame& F, int cntw = 1024) {
    const int lane = F.lane, g = lane >> 3, c = lane & 7; const unsigned x = xcc_id(); unsigned d = 0u; int q, tg; unsigned* cnt = (unsigned*)(F.wsb + WS_CTL) + cntw;
    const unsigned char* tab = F.down8_(); const unsigned char* xb = F.xq8_();
    while (peer_claim(cnt, x, d, lane, q, tg)) {
        const unsigned colb = (unsigned)(q * PS_CW + 32 * c), slb = (unsigned)q * (16384u * 128u) + 16u * c; short* part = F.part_() + (size_t)q * T * 128; const size_t tok0 = (size_t)tg * PS_TG;
        u32x4 wA[16], wB[16], xA, xB, yA, yB; int iA0, iA1, iB0, iB1;
#define PD_IDX(i0, i1, tok) do { const unsigned short* ip_ = F.idx_() + (tok) * 128 + lane; i0 = ip_[0]; i1 = ip_[64]; } while (0)
#define PD_ROWS(W_, X_, Y_, i0, i1, tok) do { _Pragma("unroll") for (int j = 0; j < 16; ++j) { const unsigned e_ = (unsigned)bperm(8 * (j & 7) + g, j < 8 ? i0 : i1); \
            W_[j] = *(const u32x4*)(tab + (e_ * 128u + slb)); } X_ = *(const u32x4*)(xb + (tok) * DM + colb); Y_ = *(const u32x4*)(xb + (tok) * DM + colb + 16); } while (0)
#define PD_COMP(W_, X_, Y_, tok) do { int p[16]; _Pragma("unroll") for (int j = 0; j < 16; ++j) p[j] = dot32n(W_[j], X_, Y_); \
            int a1[8], a2[4], a3[2]; \
            _Pragma("unroll") for (int i = 0; i < 8; ++i) { const int keep = (c & 1) ? p[2 * i + 1] : p[2 * i], give = (c & 1) ? p[2 * i] : p[2 * i + 1]; a1[i] = keep + dppmovi<0xB1>(give); } \
            _Pragma("unroll") for (int i = 0; i < 4; ++i) { const int keep = (c & 2) ? a1[2 * i + 1] : a1[2 * i], give = (c & 2) ? a1[2 * i] : a1[2 * i + 1]; a2[i] = keep + dppmovi<0x4E>(give); } \
            _Pragma("unroll") for (int i = 0; i < 2; ++i) { const int keep = (c & 4) ? a2[2 * i + 1] : a2[2 * i], give = (c & 4) ? a2[2 * i] : a2[2 * i + 1]; a3[i] = keep + __shfl_xor(give, 4); } \
            part[(tok) * 128 + 8 * c + g] = (short)min(max(a3[0], -32768), 32767); part[(tok) * 128 + 64 + 8 * c + g] = (short)min(max(a3[1], -32768), 32767); } while (0)
        PD_IDX(iA0, iA1, tok0); PD_IDX(iB0, iB1, tok0 + 1);
        PD_ROWS(wA, xA, yA, iA0, iA1, tok0);
        for (int tt = 0; tt < PS_TG; tt += 2) { const size_t tok = tok0 + tt;
            PD_ROWS(wB, xB, yB, iB0, iB1, tok + 1);
            const size_t t2 = tok + (tt + 2 < PS_TG ? 2 : 0), t3 = tok + (tt + 2 < PS_TG ? 3 : 1);
            PD_IDX(iA0, iA1, t2);
            PD_COMP(wA, xA, yA, tok);
            if (tt + 2 < PS_TG) PD_ROWS(wA, xA, yA, iA0, iA1, t2);
            PD_IDX(iB0, iB1, t3);
            PD_COMP(wB, xB, yB, tok + 1);
        }
#undef PD_IDX
#undef PD_ROWS
#undef PD_COMP
    }
}
__device__ __forceinline__ void peer_coef_probe(const Frame& F, bool dry) {
    const int gw = F.vcu * 8 + F.wave, NGW = F.G * 8, lane = F.lane;
    for (int tok = gw; tok < T; tok += NGW) { int a0 = 0, a1 = 0; const short* pp = F.part_() + (size_t)tok * 128 + lane;
#pragma unroll
        for (int q = 0; q < PS_NSL; ++q) { a0 += pp[(size_t)q * T * 128]; a1 += pp[(size_t)q * T * 128 + 64]; }
        const float sc = F.rs2_()[tok] * F.sx_()[tok]; const float* gp = F.gate_() + (size_t)tok * 128 + lane; const int e0 = F.idx_()[(size_t)tok * 128 + lane], e1 = F.idx_()[(size_t)tok * 128 + 64 + lane];
        const float c0 = gp[0] * gelu_tanh((float)a0 * sc * F.sd_()[e0]) * F.su_()[e0], c1 = gp[64] * gelu_tanh((float)a1 * sc * F.sd_()[e1]) * F.su_()[e1];
        float m = fmaxf(fabsf(c0), fabsf(c1));
#pragma unroll
        for (int o = 1; o < 64; o <<= 1) m = fmaxf(m, __shfl_xor(m, o));
        const float inv = m > 0.f ? 127.f / m : 0.f; const int q0 = (int)rintf(c0 * inv), q1 = (int)rintf(c1 * inv);
        unsigned char* fp = dry ? F.wsb + WS_PART + 256 * MiB : (unsigned char*)F.fqT_();
        { const int k0 = lane, k1 = 64 + lane; fp[((size_t)(k0 >> 2) * T + tok) * 4 + (k0 & 3)] = (unsigned char)q0; fp[((size_t)(k1 >> 2) * T + tok) * 4 + (k1 & 3)] = (unsigned char)q1; }
        if (lane == 0 && !dry) F.csum_()[tok] = m * (1.f / 127.f); }
}
#ifndef PROBE_PHASE
#define PROBE_PHASE -1
#endif
#define UP_NREP ((PROBE_PHASE == 10) ? 2 : 1)
constexpr int U2_XO = 131072 + 2048, U2_SF = U2_XO + 8192;
#define PU_T4(ACC_, R0, R1, R2, R3, FQ_) do { const unsigned t0_ = __builtin_amdgcn_perm(R1, R0, 0x05010400u), t1_ = __builtin_amdgcn_perm(R1, R0, 0x07030602u), t2_ = __builtin_amdgcn_perm(R3, R2, 0x05010400u), t3_ = __builtin_amdgcn_perm(R3, R2, 0x07030602u); \
            ACC_[0] = __builtin_amdgcn_sdot4((int)__builtin_amdgcn_perm(t2_, t0_, 0x05040100u), FQ_, ACC_[0], false); ACC_[1] = __builtin_amdgcn_sdot4((int)__builtin_amdgcn_perm(t2_, t0_, 0x07060302u), FQ_, ACC_[1], false); \
            ACC_[2] = __builtin_amdgcn_sdot4((int)__builtin_amdgcn_perm(t3_, t1_, 0x05040100u), FQ_, ACC_[2], false); ACC_[3] = __builtin_amdgcn_sdot4((int)__builtin_amdgcn_perm(t3_, t1_, 0x07060302u), FQ_, ACC_[3], false); } while (0)
__device__ __forceinline__ unsigned u2_addr_lo(unsigned w, unsigned base) { unsigned a; asm("v_mad_u32_u16 %0, %1, 8, %2" : "=v"(a) : "v"(w), "s"(base)); return a; }
__device__ __forceinline__ unsigned u2_addr_hi(unsigned w, unsigned base) { unsigned a; asm("v_mad_u32_u16 %0, %1, 8, %2 op_sel:[1,0,0,0]" : "=v"(a) : "v"(w), "s"(base)); return a; }
__device__ __forceinline__ void peer_up(const Frame& F) {
    const int lane = F.lane;
    for (int cgi = F.vcu; cgi < 256 * UP_NREP; cgi += F.G) { const int cg = cgi & 255; const bool dry = cgi >= 256; float* const ob_ = dry ? (float*)(F.wsb + WS_PART) : F.out; const unsigned tmask_ = dry ? 16383u : 0xffffffffu;
        __syncthreads();
        { const u32x4* src = (const u32x4*)(F.up8_() + (size_t)cg * 131072);
#pragma unroll 4
          for (int i = 0; i < 16; ++i) { const int o = F.tid + 512 * i; *(LAS u32x4*)(F.lds + o * 16) = src[o]; } }
        __syncthreads();
        u32x2 S0i[8], S1i[8], S2i[8], S3i[8]; int S0f[8], S1f[8], S2f[8], S3f[8]; u32x2 R0[16], R1[16];
        const __amdgpu_buffer_rsrc_t rsI = __builtin_amdgcn_make_buffer_rsrc((void*)F.idxT_(), 0, 32 * T * 8, 0x00020000), rsF = __builtin_amdgcn_make_buffer_rsrc((void*)F.fqT_(), 0, 32 * T * 4, 0x00020000),
            rsX = __builtin_amdgcn_make_buffer_rsrc((void*)F.x1b_(), 0, T * DM * 2, 0x00020000), rsC = __builtin_amdgcn_make_buffer_rsrc((void*)F.csum_(), 0, T * 4, 0x00020000);
#define U2_FENCE() do { asm volatile("" ::: "memory"); SBAR(); } while (0)
#ifdef UP_PROBE_NOCONF
#define U2_IDMASK(id) do { id.x &= idmask_; id.y &= idmask_; } while (0)
        const unsigned idmask_ = dry ? 0u : 0xffffffffu;
#else
#define U2_IDMASK(id) do { } while (0)
#endif
#define U2_LOAD(S_, tok_, s_) do { const unsigned vo_ = (unsigned)(tok_) * 8u; _Pragma("unroll") for (int g = 0; g < 8; ++g) { S_##i[g] = __builtin_amdgcn_raw_buffer_load_b64(rsI, vo_, ((s_) * 8 + g) * (T * 8), 0); \
            S_##f[g] = (int)__builtin_amdgcn_raw_buffer_load_b32(rsF, vo_ >> 1, ((s_) * 8 + g) * (T * 4), 0); } U2_FENCE(); } while (0)
#define U2_ISSUE(R_, S_, h_) do { _Pragma("unroll") for (int g = 0; g < 4; ++g) { u32x2 id = S_##i[(h_) * 4 + g]; U2_IDMASK(id); \
                R_[4 * g + 0] = *(const LAS u32x2*)(uintptr_t)u2_addr_lo(id.x, lbase_); R_[4 * g + 1] = *(const LAS u32x2*)(uintptr_t)u2_addr_hi(id.x, lbase_); \
                R_[4 * g + 2] = *(const LAS u32x2*)(uintptr_t)u2_addr_lo(id.y, lbase_); R_[4 * g + 3] = *(const LAS u32x2*)(uintptr_t)u2_addr_hi(id.y, lbase_); } U2_FENCE(); } while (0)
#define U2_FOLD(R_, S_, h_) do { _Pragma("unroll") for (int g = 0; g < 4; ++g) { const int fq = S_##f[(h_) * 4 + g]; \
                int* a_ = acc; PU_T4(a_, R_[4 * g + 0].x, R_[4 * g + 1].x, R_[4 * g + 2].x, R_[4 * g + 3].x, fq); a_ = acc + 4; PU_T4(a_, R_[4 * g + 0].y, R_[4 * g + 1].y, R_[4 * g + 2].y, R_[4 * g + 3].y, fq); } U2_FENCE(); } while (0)
        const int nb = (T / 64 - F.wave + 7) / 8;
        const unsigned lbase_ = (unsigned)__builtin_amdgcn_readfirstlane((int)(unsigned)(uintptr_t)F.ldsg);
        unsigned lane_; asm volatile("v_mbcnt_lo_u32_b32 %0, -1, 0\n\tv_mbcnt_hi_u32_b32 %0, -1, %0" : "=v"(lane_));
        { const unsigned t0_ = (unsigned)F.wave * 64u + lane_; U2_LOAD(S0, t0_, 0); U2_LOAD(S1, t0_, 1); U2_LOAD(S2, t0_, 2); U2_LOAD(S3, t0_, 3); U2_ISSUE(R0, S0, 0); }
#pragma unroll 1
        for (int i = 0; i < nb; ++i) { const unsigned tok = (unsigned)(F.wave + 8 * i) * 64u + lane_; const unsigned tokn = tok + (i + 1 < nb ? 512u : 0u); int acc[8] = {0, 0, 0, 0, 0, 0, 0, 0};
            __builtin_amdgcn_raw_ptr_buffer_load_lds(rsX, (LAS unsigned*)(F.lds + U2_XO + F.wave * 1024), 16, tok << 12, cg * 16, 0, 0);
            __builtin_amdgcn_raw_ptr_buffer_load_lds(rsC, (LAS unsigned*)(F.lds + U2_SF + F.wave * 256), 4, tok << 2, 0, 0, 0);
            U2_FENCE();
            U2_ISSUE(R1, S0, 1); U2_FOLD(R0, S0, 0);
            U2_ISSUE(R0, S1, 0); U2_FOLD(R1, S0, 1); U2_LOAD(S0, tokn, 0);
            U2_ISSUE(R1, S1, 1); U2_FOLD(R0, S1, 0);
            U2_ISSUE(R0, S2, 0); U2_FOLD(R1, S1, 1); U2_LOAD(S1, tokn, 1);
            U2_ISSUE(R1, S2, 1); U2_FOLD(R0, S2, 0);
            U2_ISSUE(R0, S3, 0); U2_FOLD(R1, S2, 1); U2_LOAD(S2, tokn, 2);
            U2_ISSUE(R1, S3, 1); U2_FOLD(R0, S3, 0);
            U2_ISSUE(R0, S0, 0); U2_FOLD(R1, S3, 1); U2_LOAD(S3, tokn, 3);
            asm volatile("s_waitcnt vmcnt(48)" ::: "memory");
            const u32x4 xo = *(const LAS u32x4*)(F.lds + U2_XO + F.wave * 1024 + lane_ * 16); const float sf = *(const LAS float*)(F.lds + U2_SF + F.wave * 256 + lane_ * 4);
            f32x4 v0 = {bflo(xo.x), bfhi(xo.x), bflo(xo.y), bfhi(xo.y)}, v1 = {bflo(xo.z), bfhi(xo.z), bflo(xo.w), bfhi(xo.w)};
            v0[0] += sf * (float)acc[0]; v0[1] += sf * (float)acc[1]; v0[2] += sf * (float)acc[2]; v0[3] += sf * (float)acc[3]; v1[0] += sf * (float)acc[4]; v1[1] += sf * (float)acc[5]; v1[2] += sf * (float)acc[6]; v1[3] += sf * (float)acc[7];
            float* dp = ob_ + (size_t)((tok & tmask_) * DM) + cg * 8; *(f32x4*)dp = v0; *(f32x4*)(dp + 4) = v1; U2_FENCE(); }
        LDS_WAIT();
#undef U2_ISSUE
#undef U2_FOLD
#undef U2_FENCE
#undef U2_LOAD
    }
}
#undef PU_T4


#ifdef VALU_PROBE
__device__ __forceinline__ void valu_probe(const Frame& F) {
    unsigned a[16];
#pragma unroll
    for (int j = 0; j < 16; ++j) a[j] = F.tid * 17u + j * 0x01010101u;
    unsigned b = F.tid * 3u + 0x05040100u, c = 0x3c003c00u ^ F.tid;
#pragma unroll 1
    for (int it = 0; it < 1024; ++it) {
#pragma unroll
        for (int r = 0; r < 4; ++r) {
#pragma unroll
            for (int j = 0; j < 16; ++j) {
#if VALU_PROBE == 0
                asm volatile("v_add_u32 %0, %0, %1" : "+v"(a[j]) : "v"(b));
#elif VALU_PROBE == 1
                asm volatile("v_perm_b32 %0, %0, %1, %2" : "+v"(a[j]) : "v"(b), "v"(c));
#elif VALU_PROBE == 2
                asm volatile("v_dot4c_i32_i8 %0, %1, %2" : "+v"(a[j]) : "v"(b), "v"(c));
#elif VALU_PROBE == 3
                asm volatile("v_mad_u32_u16 %0, %1, %2, %0 op_sel:[1,0,0,0]" : "+v"(a[j]) : "v"(b), "v"(c));
#elif VALU_PROBE == 4
                asm volatile("v_and_b32 %0, %0, %1" : "+v"(a[j]) : "v"(b));
#elif VALU_PROBE == 5
                asm volatile("v_lshl_add_u32 %0, %0, 3, %1" : "+v"(a[j]) : "v"(b));
#elif VALU_PROBE == 6
                asm volatile("v_bfe_u32 %0, %0, 3, 14" : "+v"(a[j]));
#elif VALU_PROBE == 7
                asm volatile("v_dot4_i32_i8 %0, %1, %2, %0" : "+v"(a[j]) : "v"(b), "v"(c));
#endif
            } } }
    unsigned s = 0;
#pragma unroll
    for (int j = 0; j < 16; ++j) s ^= a[j];
    ((unsigned*)(F.wsb + WS_PART))[(size_t)F.vcu * 512 + F.tid] = s;
}
#endif

#define XB_TMO      128
#define XB_XCNT(j)  (256  + 64 * (j))
#define XB_XSUB(j)  (1280 + 64 * (j))
#define XB_XGEN(j)  (2304 + 64 * (j))
#define XB_TOP      3328
#define XB_TOPGEN   3392
#define XCD_BAR_WORDS 3456
#define XB_SPIN_CAP (1u << 18)

__device__ __forceinline__ unsigned xb_ld(unsigned* p)              { return __hip_atomic_load(p, __ATOMIC_RELAXED, __HIP_MEMORY_SCOPE_AGENT); }
__device__ __forceinline__ unsigned xb_add(unsigned* p, unsigned v) { return __hip_atomic_fetch_add(p, v, __ATOMIC_RELAXED, __HIP_MEMORY_SCOPE_AGENT); }
__device__ __forceinline__ unsigned xb_xcc_id() { return (unsigned)__builtin_amdgcn_s_getreg((3 << 11) | 20) & 0xFu; }
#define XB_SPIN(cond, bar) do { unsigned _sp = 0; while (cond) { __builtin_amdgcn_s_sleep(1); \
    if ((++_sp & 255u) == 0u) { if (xb_ld(&(bar)[XB_TMO])) break; if (_sp > XB_SPIN_CAP) { atomicAdd(&(bar)[XB_TMO], 1u); break; } } } } while (0)

struct XcdBarrier {
    unsigned* bar; unsigned x;
    volatile LAS unsigned* st;
};

__device__ __forceinline__ XcdBarrier xcd_barrier_post(unsigned* bar, volatile LAS unsigned* st) {
    XcdBarrier b; b.bar = bar; b.x = xb_xcc_id(); b.st = st;
    if (threadIdx.x == 0) (void)xb_add(&bar[XB_XCNT(b.x)], 1u);
    return b;
}
__device__ __forceinline__ void xcd_barrier_complete(unsigned* bar, unsigned x, unsigned& nloc, unsigned& nx) {
    const unsigned G = gridDim.x * gridDim.y * gridDim.z;
    unsigned sum, cnt, mine, sp = 0u;
    for (;;) {
        sum = 0u; cnt = 0u; mine = 0u;
#pragma unroll
        for (unsigned j = 0; j < 16; ++j) { const unsigned c = xb_ld(&bar[XB_XCNT(j)]); sum += c; cnt += (c > 0u) ? 1u : 0u; mine = (j == x) ? c : mine; }
        if (sum == G) break;
        __builtin_amdgcn_s_sleep(1);
        if ((++sp & 255u) == 0u) { if (xb_ld(&bar[XB_TMO])) break; if (sp > XB_SPIN_CAP) { atomicAdd(&bar[XB_TMO], 1u); break; } }
    }
    nloc = mine > 0u ? mine : 1u; nx = cnt > 0u ? cnt : 1u;
}

__device__ __forceinline__ void xcd_barrier(const XcdBarrier& b) {
    asm volatile("s_waitcnt vmcnt(0)" ::: "memory");
    __syncthreads();
    if (threadIdx.x == 0) {
        unsigned* bar = b.bar;
        __builtin_amdgcn_s_waitcnt(0);
        unsigned nloc = b.st[0], nx = b.st[1];
        if (nloc == 0u) { xcd_barrier_complete(bar, b.x, nloc, nx); b.st[0] = nloc; b.st[1] = nx; }
        const unsigned old = xb_add(&bar[XB_XSUB(b.x)], 1u);
        const unsigned gen = old / nloc;
        if (old + 1u == (gen + 1u) * nloc) {
            __builtin_amdgcn_fence(__ATOMIC_RELEASE, "agent");
            asm volatile("s_waitcnt vmcnt(0)" ::: "memory");
            const unsigned og = xb_add(&bar[XB_TOP], 1u);
            const unsigned tg = og / nx;
            if (og + 1u == (tg + 1u) * nx) xb_add(&bar[XB_TOPGEN], 1u);
            else XB_SPIN(xb_ld(&bar[XB_TOPGEN]) == tg, bar);
            __builtin_amdgcn_fence(__ATOMIC_ACQUIRE, "agent");
            xb_add(&bar[XB_XGEN(b.x)], 1u);
            asm volatile("s_waitcnt vmcnt(0)" ::: "memory");
        } else {
            XB_SPIN(xb_ld(&bar[XB_XGEN(b.x)]) == gen, bar);
            __builtin_amdgcn_fence(__ATOMIC_ACQUIRE, "agent");
            asm volatile("s_waitcnt vmcnt(0)" ::: "memory");
        }
    }
    __syncthreads();
}

struct Args { const float* in[16]; float* out; unsigned char* ws; int ph_lo, ph_hi, coop, pad; };
__global__ void __launch_bounds__(512, 2) fwd_kernel(Args args) {
    extern __shared__ __attribute__((aligned(16))) unsigned char lds_raw[];
    Frame F;
    F.lds = (LAS unsigned char*)lds_raw; F.ldsg = (char*)lds_raw;
    F.tid = threadIdx.x; F.lane = F.tid & 63; F.wave = __builtin_amdgcn_readfirstlane(F.tid >> 6);
    F.G = gridDim.x; { const int bx = blockIdx.x; F.vcu = (F.G % 8 == 0) ? (bx % 8) * (F.G / 8) + bx / 8 : bx; }
    F.x = args.in[0]; F.norm1_g = args.in[1]; F.w_in = args.in[2]; F.up_f = args.in[3]; F.bias_f = args.in[4]; F.up_b = args.in[5]; F.bias_b = args.in[6]; F.out_g = args.in[7];
    F.qn_g = args.in[8]; F.kn_g = args.in[9]; F.w_out = args.in[10]; F.norm2_g = args.in[11]; F.w_query = args.in[12]; F.sub_keys = args.in[13]; F.peer_down = args.in[14]; F.peer_up = args.in[15];
    F.out = args.out; unsigned char* ws = args.ws; F.wsb = ws;
    constexpr int MISC_OFF = 131072 + 320;
    for (int u = F.tid; u < 64; u += 512) ((LAS unsigned*)(F.lds + MISC_OFF))[u] = 0u;
    __syncthreads();
    XcdBarrier bar = xcd_barrier_post((unsigned*)(ws + WS_CTL) + 8192, (volatile LAS unsigned*)(F.lds + MISC_OFF) + 8);
    const int lo = args.ph_lo, hi = args.ph_hi;
#ifndef PH_MASK
#define PH_MASK 0x7ff
#endif
#ifndef PROBE_PHASE
#define PROBE_PHASE -1
#endif
#define REP(k) for (int rep_ = 0; rep_ < ((PROBE_PHASE == (k)) ? 2 : 1); ++rep_)
#define IN(k) (((PH_MASK >> (k)) & 1) && lo <= (k) && (k) < hi)
#define SEAM(k) do { if (IN(k) && IN((k) + 1)) { if (args.coop) { if ((k) == 0) cg::this_grid().sync(); else xcd_barrier(bar); } } } while (0)
    if (IN(0)) { REP(0) phase0(F); } SEAM(0);
#define GEMM1_BODY { pg8::Gemm g{(const pg8::bf16_t*)F.xq1_(), (const pg8::bf16_t*)F.Win8_(), T, HP, DM / 2}; pg8::StaticOrder S; S.init(T, HP, F.G, (int)blockIdx.x); \
        pg8::EpiI8Qk E{F.h_(), HP, F.rs1_(), F.sw_(), F.qn_g, F.kn_g, (LAS float*)(F.lds + 131072 + 1024), C_QD / 256, C_KD / 256, C_VD / 256, SEQ - 1, QSCALE}; \
        pg8::gemm_phase<pg8::EpiI8Qk, pg8::StaticOrder, PG8_ALIGN, PG8_SP2, true>(F.lds, g, S, E); }
    if (IN(1)) { GEMM1_BODY; if (PROBE_PHASE == 1) GEMM1_BODY; } SEAM(1);
    if (IN(2)) { REP(2) for (int it = F.vcu; it < 2048; it += F.G) gla_passA(F, it); } SEAM(2);
    if (IN(3)) { for (int it = F.vcu; it < 256; it += F.G) gla_scan(F, it); REP(3) attn_phase(F); } SEAM(3);
    if (IN(4)) REP(4) { for (int it = F.vcu; it < 2048; it += F.G) gla_passC(F, it); dil_combine(F); } SEAM(4);
#define GEMM5_BODY { pg8::Gemm g{F.mixed_(), F.WoT_(), T, DM, DM}; pg8::StaticOrder S; S.init(T, DM, F.G, (int)blockIdx.x); pg8::EpiResid E{F.x, F.out, F.x1b_(), F.ssp_(), DM}; \
        pg8::gemm_phase<pg8::EpiResid, pg8::StaticOrder, PG8_ALIGN, PG8_SP2>(F.lds, g, S, E); }
#define GEMM6_BODY { pg8::Gemm g{F.x1b_(), F.WqT_(), T, DM, DM}; pg8::StaticOrder S; S.init(T, DM, F.G, (int)blockIdx.x); pg8::EpiRowScaleBf16 E{F.qry_(), DM, nullptr}; \
        pg8::gemm_phase<pg8::EpiRowScaleBf16, pg8::StaticOrder, PG8_ALIGN, PG8_SP2>(F.lds, g, S, E); }
    if (IN(5)) { GEMM5_BODY; if (PROBE_PHASE == 5) GEMM5_BODY; } SEAM(5);
    if (IN(6)) { GEMM6_BODY; if (PROBE_PHASE == 6) GEMM6_BODY; } SEAM(6);
    if (IN(7)) REP(7) { const int gw = F.vcu * 8 + F.wave, NGW = F.G * 8; for (int u = F.vcu; u < 256; u += F.G) { const int hh = u & 7, chunk = u >> 3;
            __syncthreads();
            for (int i = F.tid; i < 4096; i += 512) { const int row = i >> 4, ch = i & 15; *(LAS u32x4*)(F.lds + TK_KEYS + KSWZ(row, ch * 16)) = *(const u32x4*)(F.SK_() + ((size_t)hh * 256 + row) * 128 + ch * 8); }
            __syncthreads();
            for (int j = 0; j < 4; ++j) topk_item(F, hh, chunk * 32 + F.wave * 4 + j); }
        if (rep_ == 0) peer_quant_x(F); } SEAM(7);
    if (IN(8)) { if (PROBE_PHASE == 8) peer_down(F, 3072); peer_down(F); } SEAM(8);
    if (IN(9)) { REP(9) peer_coef_probe(F, (PROBE_PHASE == 9) && rep_ == 0); } SEAM(9);
    if (IN(10)) peer_up(F);
#ifdef VALU_PROBE
    valu_probe(F);
#endif
#undef IN
#undef SEAM
}

#ifndef MK_N_LAUNCHES
#define MK_N_LAUNCHES 1
#endif
extern "C" void kernel_launch(void* const* d_in, const int* in_sizes, int n_in, void* d_out, int out_size, void* d_ws, size_t ws_size, hipStream_t stream) {
    static int grid = 0;
    if (grid == 0) {
        if (n_in != 16 || in_sizes[0] != T * DM || out_size != T * DM || ws_size < WS_END) { fprintf(stderr, "kernel_launch: unexpected shapes (n_in %d, in0 %d, out %d, ws %zu)\n", n_in, n_in > 0 ? in_sizes[0] : -1, out_size, ws_size); grid = -1; return; }
        int dev = 0, cus = 0, per_cu = 0;
        if (hipGetDevice(&dev) != hipSuccess || hipDeviceGetAttribute(&cus, hipDeviceAttributeMultiprocessorCount, dev) != hipSuccess) { grid = -1; return; }
        if (hipFuncSetAttribute((const void*)fwd_kernel, hipFuncAttributeMaxDynamicSharedMemorySize, LDS_BYTES) != hipSuccess) { fprintf(stderr, "kernel_launch: hipFuncSetAttribute failed\n"); grid = -1; return; }
        if (hipOccupancyMaxActiveBlocksPerMultiprocessor(&per_cu, (const void*)fwd_kernel, 512, LDS_BYTES) != hipSuccess || per_cu < 1) { fprintf(stderr, "kernel_launch: occupancy query says %d\n", per_cu); per_cu = 1; }
        (void)hipGetLastError();
        grid = cus;
    }
    if (grid < 0) return;
    if (hipMemsetAsync(d_ws, 0, 65536, stream) != hipSuccess) { fprintf(stderr, "kernel_launch: hipMemsetAsync failed\n"); return; }
    Args a{};
    for (int i = 0; i < 16; ++i) a.in[i] = (const float*)d_in[i];
    a.out = (float*)d_out; a.ws = (unsigned char*)d_ws;
    if (MK_N_LAUNCHES == 1) {
        a.ph_lo = 0; a.ph_hi = NPHASE; a.coop = 1; void* kargs[] = {&a};
        hipError_t e = hipLaunchCooperativeKernel((const void*)fwd_kernel, dim3(grid), dim3(512), kargs, LDS_BYTES, stream);
        if (e != hipSuccess) fprintf(stderr, "kernel_launch: cooperative launch failed: %s (grid %d)\n", hipGetErrorString(e), grid);
    } else {
        for (int p = 0; p < NPHASE; ++p) { a.ph_lo = p; a.ph_hi = p + 1; a.coop = 0; hipLaunchKernelGGL(fwd_kernel, dim3(grid), dim3(512), LDS_BYTES, stream, a); }
        const hipError_t le = hipPeekAtLastError(); if (le != hipSuccess) fprintf(stderr, "kernel_launch: launch failed: %s\n", hipGetErrorName(le));
    }
}
```

```cpp
#include <hip/hip_runtime.h>
#include <hip/hip_cooperative_groups.h>
#include <cstdio>
#include <cstdint>
namespace cg = cooperative_groups;
namespace pg8 {
#define PG8_LAS __attribute__((address_space(3)))
typedef unsigned short bf16_t;
typedef short bf16x8 __attribute__((ext_vector_type(8)));
typedef float f32x4 __attribute__((ext_vector_type(4)));
typedef unsigned u32x4 __attribute__((ext_vector_type(4)));
constexpr int BM = 256, BK = 64, HALF = 128, HTB = HALF * BK * 2  , STAGE_BYTES = 8 * HTB, NXCD = 8, WGM = 8;

__host__ __device__ __forceinline__ int lds_byte(int r, int c) { const int st = (r >> 4) * 2 + (c >> 5), rr = r & 15, cc = c & 31, ob = rr * 64 + cc * 2; return st * 1024 + (ob ^ (((ob >> 9) & 1) << 5)); }
__host__ __device__ __forceinline__ void stage_rc(int b, int& R, int& C) { const int st = b / 1024, sb = b % 1024, swz = sb ^ (((sb >> 9) & 1) << 5); R = (st >> 1) * 16 + swz / 64; C = (st & 1) * 32 + (swz % 64) / 2; }
__host__ __device__ __forceinline__ int perm32(int rho) { const int n = rho >> 4, i = rho & 15; return 8 * (i >> 2) + 4 * n + (i & 3); }

struct Unit { int pm, pn; };
struct Gemm { const bf16_t* A; const bf16_t* Bt; int M, N, K; };

struct StaticOrder {
    int nM, nN, nwg, G, c;
    __host__ __device__ void init(int M, int N, int G_, int c_) { nM = M / BM; nN = N / BM; nwg = nM * nN; G = G_; c = c_; }
    __host__ __device__ bool next(int i, Unit& u) const {
        const long L = (long)i * G + c; if (L >= nwg) return false;
        int wgid = (int)L; { const int q = nwg / NXCD, r = nwg % NXCD, xcd = wgid % NXCD, off = wgid / NXCD; wgid = (xcd < r ? xcd * (q + 1) : r * (q + 1) + (xcd - r) * q) + off; }
        const int nig = WGM * nN, gid = wgid / nig, fm = gid * WGM, gsz = (nM - fm) < WGM ? (nM - fm) : WGM;
        u.pm = fm + ((wgid % nig) % gsz); u.pn = (wgid % nig) / gsz; return true;
    }
    __device__ __forceinline__ void a_ready(const Unit&) const {}
    __device__ __forceinline__ void done(const Unit&) const {}
};
__device__ __forceinline__ unsigned cvt_pk_bf16(float lo, float hi) { unsigned r; asm volatile("v_cvt_pk_bf16_f32 %0, %1, %2" : "=v"(r) : "v"(lo), "v"(hi)); return r; }
typedef int i32x4 __attribute__((ext_vector_type(4)));
template <bool I8> struct AccT { typedef f32x4 type; };
template <> struct AccT<true> { typedef i32x4 type; };
struct EpiRowScaleBf16 {
    static constexpr bool PERM = true, AFTER_DRAIN = false;
    bf16_t* O; int ldc; const float* rs;
    __device__ __forceinline__ void operator()(const f32x4 (&acc)[2][2][4][2], const Unit& u, int wr, int wc, int fr, int fq) const {
        const int row0 = u.pm * BM + wr * 64 + fr, col0 = u.pn * BM + wc * 32 + 8 * fq;
#pragma unroll
        for (int ai = 0; ai < 2; ++ai)
#pragma unroll
            for (int m = 0; m < 4; ++m) { const int row = row0 + ai * HALF + m * 16; const float s = rs ? rs[row] : 1.f; bf16_t* rowp = O + (size_t)row * ldc + col0;
#pragma unroll
                for (int bj = 0; bj < 2; ++bj) { const f32x4 v0 = acc[ai][bj][m][0] * s, v1 = acc[ai][bj][m][1] * s;
                    u32x4 w; w.x = cvt_pk_bf16(v0[0], v0[1]); w.y = cvt_pk_bf16(v0[2], v0[3]); w.z = cvt_pk_bf16(v1[0], v1[1]); w.w = cvt_pk_bf16(v1[2], v1[3]);
                    *(u32x4*)(rowp + bj * HALF) = w; } }
    }
};
struct EpiI8Qk {
    static constexpr bool PERM = true, AFTER_DRAIN = false;
    bf16_t* O; int ldc; const float* rs; const float* cs; const float* qg; const float* kg; PG8_LAS float* P; int qk_lo, q_hi, qk_hi, seqmask; float qscale;
    __device__ __forceinline__ void operator()(const i32x4 (&acc)[2][2][4][2], const Unit& u, int wr, int wc, int fr, int fq) const {
        const int row0 = u.pm * BM + wr * 64 + fr, col0 = u.pn * BM + wc * 32 + 8 * fq;
        f32x4 cv[2][2];
#pragma unroll
        for (int bj = 0; bj < 2; ++bj) { cv[bj][0] = *(const f32x4*)(cs + col0 + bj * HALF); cv[bj][1] = *(const f32x4*)(cs + col0 + bj * HALF + 4); }
        const bool qk = u.pn >= qk_lo && u.pn < qk_hi;
        float rq[2][4][2];
        if (qk) {
#pragma unroll
            for (int ai = 0; ai < 2; ++ai)
#pragma unroll
                for (int m = 0; m < 4; ++m) { const float s = rs[row0 + ai * HALF + m * 16]; const int rl = ai * HALF + wr * 64 + m * 16 + fr;
#pragma unroll
                    for (int bj = 0; bj < 2; ++bj) { const i32x4 a0 = acc[ai][bj][m][0], a1 = acc[ai][bj][m][1]; const f32x4 c0 = cv[bj][0] * s, c1 = cv[bj][1] * s; float ss = 0.f;
#pragma unroll
                        for (int i = 0; i < 4; ++i) { const float x0 = (float)a0[i] * c0[i], x1 = (float)a1[i] * c1[i]; ss += x0 * x0 + x1 * x1; }
                        ss += __shfl_xor(ss, 16); ss += __shfl_xor(ss, 32);
                        if (fq == 0) P[rl * 8 + bj * 4 + wc] = ss; } }
            asm volatile("s_waitcnt lgkmcnt(0)" ::: "memory"); __builtin_amdgcn_s_barrier(); asm volatile("" ::: "memory");
#pragma unroll
            for (int ai = 0; ai < 2; ++ai)
#pragma unroll
                for (int m = 0; m < 4; ++m) { const int rl = ai * HALF + wr * 64 + m * 16 + fr;
#pragma unroll
                    for (int bj = 0; bj < 2; ++bj) { const f32x4 p = *(const PG8_LAS f32x4*)(P + rl * 8 + bj * 4); rq[ai][m][bj] = __builtin_amdgcn_rsqf(((p[0] + p[1]) + (p[2] + p[3])) * (1.f / 128.f) + 1e-6f); } }
        }
        const bool isq = u.pn < q_hi; const float* gp = (isq ? qg : kg) + wc * 32 + 8 * fq; f32x4 g0 = {1.f, 1.f, 1.f, 1.f}, g1 = g0;
        if (qk) { g0 = *(const f32x4*)gp; g1 = *(const f32x4*)(gp + 4); if (isq) { g0 = g0 * qscale; g1 = g1 * qscale; } }
        constexpr float RV[16] = {1.591549431e-01f, 7.008652159e-02f, 3.086376340e-02f, 1.359137064e-02f, 5.985185713e-03f, 2.635675899e-03f, 1.160663641e-03f, 5.111175045e-04f, 2.250790790e-04f, 9.911730937e-05f, 4.364795279e-05f, 1.922110068e-05f, 8.464330808e-06f, 3.727408602e-06f, 1.641426263e-06f, 7.228293069e-07f};
#pragma unroll
        for (int ai = 0; ai < 2; ++ai)
#pragma unroll
            for (int m = 0; m < 4; ++m) { const int row = row0 + ai * HALF + m * 16; const float s = rs[row]; bf16_t* rowp = O + (size_t)row * ldc + col0;
                float cs8[8], sn8[8];
                if (qk && wc == 0) { const float pos = (float)(row & seqmask);
#pragma unroll
                    for (int e8 = 0; e8 < 8; ++e8) { const float rev = pos * ((fq & 1) ? RV[8 + e8] : RV[e8]); const float fr_ = rev - __builtin_floorf(rev); cs8[e8] = __builtin_amdgcn_cosf(fr_); sn8[e8] = __builtin_amdgcn_sinf(fr_); } }
#pragma unroll
                for (int bj = 0; bj < 2; ++bj) { const i32x4 a0 = acc[ai][bj][m][0], a1 = acc[ai][bj][m][1]; const float sq = qk ? s * rq[ai][m][bj] : s; const f32x4 c0 = cv[bj][0] * sq * g0, c1 = cv[bj][1] * sq * g1;
                    float v[8];
#pragma unroll
                    for (int i = 0; i < 4; ++i) { v[i] = (float)a0[i] * c0[i]; v[4 + i] = (float)a1[i] * c1[i]; }
                    if (qk && wc == 0) {
#pragma unroll
                        for (int e8 = 0; e8 < 8; ++e8) { const float pr = __shfl_xor(v[e8], 32); v[e8] = (fq < 2) ? (v[e8] * cs8[e8] - pr * sn8[e8]) : (v[e8] * cs8[e8] + pr * sn8[e8]); } }
                    u32x4 w; w.x = cvt_pk_bf16(v[0], v[1]); w.y = cvt_pk_bf16(v[2], v[3]); w.z = cvt_pk_bf16(v[4], v[5]); w.w = cvt_pk_bf16(v[6], v[7]);
                    *(u32x4*)(rowp + bj * HALF) = w; } }
    }
};
__device__ __forceinline__ unsigned epi_pack8(const f32x4 v, float inv) { unsigned w = 0u;
#pragma unroll
    for (int i = 0; i < 4; ++i) { const int qv = (int)fminf(fmaxf(rintf(v[i] * inv), -119.f), 119.f); w |= ((unsigned)qv & 0xffu) << (8 * i); }
    return w; }
__device__ __forceinline__ unsigned epi_add8(unsigned q) { return ((q & 0x7f7f7f7fu) + 0x08080808u) ^ (q & 0x80808080u); }
__device__ __forceinline__ unsigned epi_nib(unsigned a, unsigned b) { return (a & 0x0F0F0F0Fu) | ((b & 0x0F0F0F0Fu) << 4); }
struct EpiResid {
    static constexpr bool PERM = true, AFTER_DRAIN = false;
    const float* x; float* out; bf16_t* xb; float* ssp; int ldc; const float* sx; unsigned char* xq;
    __device__ __forceinline__ void operator()(const f32x4 (&acc)[2][2][4][2], const Unit& u, int wr, int wc, int fr, int fq) const {
        const int row0 = u.pm * BM + wr * 64 + fr, col0 = u.pn * BM + wc * 32 + 8 * fq;
#pragma unroll
        for (int ai = 0; ai < 2; ++ai)
#pragma unroll
            for (int m = 0; m < 4; ++m) { const int row = row0 + ai * HALF + m * 16; const size_t off = (size_t)row * ldc + col0; float ss = 0.f; const float sxr = sx[row], inv = sxr > 0.f ? 1.f / sxr : 0.f;
#pragma unroll
                for (int bj = 0; bj < 2; ++bj) { const f32x4 xa = *(const f32x4*)(x + off + bj * HALF), xc = *(const f32x4*)(x + off + bj * HALF + 4);
                    const f32x4 v0 = acc[ai][bj][m][0] + xa, v1 = acc[ai][bj][m][1] + xc;
                    u32x4 w; w.x = cvt_pk_bf16(v0[0], v0[1]); w.y = cvt_pk_bf16(v0[2], v0[3]); w.z = cvt_pk_bf16(v1[0], v1[1]); w.w = cvt_pk_bf16(v1[2], v1[3]);
                    *(u32x4*)(xb + off + bj * HALF) = w;
                    const unsigned qa = epi_pack8(v0, inv), qb = epi_pack8(v1, inv);
                    { typedef unsigned u32x2e __attribute__((ext_vector_type(2))); *(u32x2e*)(xq + off + bj * HALF) = (u32x2e){qa, qb}; }
                    ss += (v0[0] * v0[0] + v0[1] * v0[1]) + (v0[2] * v0[2] + v0[3] * v0[3]) + (v1[0] * v1[0] + v1[1] * v1[1]) + (v1[2] * v1[2] + v1[3] * v1[3]); }
                ss += __shfl_xor(ss, 16); ss += __shfl_xor(ss, 32);
                if (fq == 0) ssp[(size_t)row * 32 + u.pn * 4 + wc] = ss; }
    }
};
template <class Epi, class Sched, bool ALIGN_EPI = false, bool SP2 = false, bool I8 = false>
__device__ __forceinline__ void gemm_phase(PG8_LAS unsigned char* lds, const Gemm g, const Sched& S, const Epi& E) {
    const int tid = threadIdx.x, wid = __builtin_amdgcn_readfirstlane(tid >> 6), lane = tid & 63, wr = wid >> 2, wc = wid & 3, fr = lane & 15, fq = lane >> 4;
    const int K = g.K, nt = K / BK;
    unsigned voffA[2], voffB[2];
#pragma unroll
    for (int i = 0; i < 2; ++i) { int R, C; stage_rc(tid * 16 + i * 8192, R, C); const int Rb = Epi::PERM ? ((R & ~31) + perm32(R & 31)) : R;
        voffA[i] = (unsigned)(R * K + C) * 2u; voffB[i] = (unsigned)(Rb * K + C) * 2u; }
    const size_t kstep = (size_t)(BK * 2);
    const size_t hstep = (size_t)HALF * K * 2;
    const size_t tstep = 2 * hstep;
    const unsigned ldsw = (unsigned)wid * 1024u;
    const int aoff = lds_byte(wr * 64 + fr, fq * 8), boff = lds_byte(wc * 32 + fr, fq * 8);
#define PG8_SA(b, h) (((b) * 2 + (h)) * HTB)
#define PG8_SB(b, h) ((4 + (b) * 2 + (h)) * HTB)
#define PG8_STAGE(bufoff, gbase, voff) do { _Pragma("unroll") for (int _i = 0; _i < 2; ++_i) \
        __builtin_amdgcn_global_load_lds((const unsigned*)((const char*)(gbase) + (voff)[_i]), (PG8_LAS unsigned*)(lds + (bufoff) + ldsw + _i * 8192), 16, 0, 0); } while (0)
#define PG8_LDA(dst, b, h) do { _Pragma("unroll") for (int m = 0; m < 4; ++m) _Pragma("unroll") for (int k = 0; k < 2; ++k) dst[m][k] = *(const PG8_LAS bf16x8*)(lds + PG8_SA(b, h) + aoff + m * 2048 + k * 1024); } while (0)
#define PG8_LDB(dst, b, h) do { _Pragma("unroll") for (int n = 0; n < 2; ++n) _Pragma("unroll") for (int k = 0; k < 2; ++k) dst[n][k] = *(const PG8_LAS bf16x8*)(lds + PG8_SB(b, h) + boff + n * 2048 + k * 1024); } while (0)
#define PG8_MMA(ai, bj, At, Bt) do { __builtin_amdgcn_s_setprio(1); _Pragma("unroll") for (int m = 0; m < 4; ++m) _Pragma("unroll") for (int n = 0; n < 2; ++n) _Pragma("unroll") for (int k = 0; k < 2; ++k) { \
        if constexpr (I8) acc[ai][bj][m][n] = __builtin_amdgcn_mfma_i32_16x16x64_i8(__builtin_bit_cast(i32x4, Bt[n][k]), __builtin_bit_cast(i32x4, At[m][k]), acc[ai][bj][m][n], 0, 0, 0); \
        else acc[ai][bj][m][n] = __builtin_amdgcn_mfma_f32_16x16x32_bf16(Bt[n][k], At[m][k], acc[ai][bj][m][n], 0, 0, 0); } __builtin_amdgcn_s_setprio(0); } while (0)
#define PG8_WAIT_V(n) asm volatile("s_waitcnt vmcnt(" #n ")" ::: "memory")
#define PG8_WAIT_L(n) asm volatile("s_waitcnt lgkmcnt(" #n ")" ::: "memory")
#define PG8_BAR __builtin_amdgcn_s_barrier()
#define PG8_SCHED __builtin_amdgcn_sched_barrier(0)
    Unit cur, nxt; int ui = 0;
    if (!S.next(0, cur)) return;
    typename AccT<I8>::type acc[2][2][4][2];
#pragma unroll
    for (int a = 0; a < 2; ++a)
#pragma unroll
        for (int b = 0; b < 2; ++b)
#pragma unroll
            for (int m = 0; m < 4; ++m)
#pragma unroll
                for (int n = 0; n < 2; ++n) acc[a][b][m][n] = (typename AccT<I8>::type){};
    bf16x8 At[4][2], B0[2][2], B1[2][2];
    const char* cA = (const char*)g.A + (size_t)cur.pm * tstep; const char* cB = (const char*)g.Bt + (size_t)cur.pn * tstep;
    S.a_ready(cur);
    if constexpr (SP2) {
        PG8_STAGE(PG8_SB(0, 0), cB, voffB); PG8_STAGE(PG8_SB(0, 1), cB + hstep, voffB); PG8_STAGE(PG8_SA(0, 0), cA, voffA); PG8_STAGE(PG8_SA(0, 1), cA + hstep, voffA);
        if (wr == 1) PG8_BAR;
        PG8_WAIT_V(2); PG8_BAR;
        PG8_STAGE(PG8_SB(1, 0), cB + kstep, voffB); PG8_STAGE(PG8_SA(1, 0), cA + kstep, voffA); PG8_STAGE(PG8_SB(1, 1), cB + hstep + kstep, voffB);
        PG8_WAIT_V(6); PG8_BAR;
    } else {
        PG8_STAGE(PG8_SB(0, 0), cB, voffB); PG8_STAGE(PG8_SA(0, 0), cA, voffA); PG8_STAGE(PG8_SB(0, 1), cB + hstep, voffB); PG8_STAGE(PG8_SA(0, 1), cA + hstep, voffA);
        if (wr == 1) PG8_BAR;
        PG8_WAIT_V(4); PG8_BAR;
        PG8_STAGE(PG8_SB(1, 0), cB + kstep, voffB); PG8_STAGE(PG8_SA(1, 0), cA + kstep, voffA); PG8_STAGE(PG8_SB(1, 1), cB + hstep + kstep, voffB);
        PG8_WAIT_V(6); PG8_BAR;
    }
    for (;;) {
        const bool has_next = S.next(ui + 1, nxt);
        const char* nA = has_next ? (const char*)g.A + (size_t)nxt.pm * tstep : cA; const char* nB = has_next ? (const char*)g.Bt + (size_t)nxt.pn * tstep : cB;
        for (int t = 0; t < nt; t += 2) {
            const bool last = (t == nt - 2);
            const char* a1 = cA + (size_t)(t + 1) * kstep;
            const char* a2 = last ? nA : cA + (size_t)(t + 2) * kstep; const char* b2 = last ? nB : cB + (size_t)(t + 2) * kstep;
            const char* a3 = a2 + kstep; const char* b3 = b2 + kstep;
            if (last && has_next) S.a_ready(nxt);
            if constexpr (SP2) {
            PG8_LDB(B0, 0, 0); PG8_LDB(B1, 0, 1); PG8_SCHED; PG8_LDA(At, 0, 0); PG8_STAGE(PG8_SA(1, 1), a1 + hstep, voffA);
            PG8_WAIT_V(8); PG8_WAIT_L(0); PG8_BAR; PG8_MMA(0, 0, At, B0); PG8_MMA(0, 1, At, B1); PG8_BAR; PG8_SCHED;
            PG8_LDA(At, 0, 1); PG8_STAGE(PG8_SB(0, 0), b2, voffB); PG8_STAGE(PG8_SB(0, 1), b2 + hstep, voffB); PG8_STAGE(PG8_SA(0, 0), a2, voffA);
            PG8_WAIT_V(8); PG8_WAIT_L(0); PG8_BAR; PG8_MMA(1, 0, At, B0); PG8_MMA(1, 1, At, B1); PG8_BAR; PG8_SCHED;
            PG8_LDB(B0, 1, 0); PG8_LDB(B1, 1, 1); PG8_SCHED; PG8_LDA(At, 1, 0); PG8_STAGE(PG8_SA(0, 1), a2 + hstep, voffA);
            PG8_WAIT_V(8); PG8_WAIT_L(0); PG8_BAR; PG8_MMA(0, 0, At, B0); PG8_MMA(0, 1, At, B1); PG8_BAR; PG8_SCHED;
            PG8_LDA(At, 1, 1); PG8_STAGE(PG8_SB(1, 0), b3, voffB); PG8_STAGE(PG8_SB(1, 1), b3 + hstep, voffB); PG8_STAGE(PG8_SA(1, 0), a3, voffA);
            PG8_WAIT_V(8); PG8_WAIT_L(0); PG8_BAR; PG8_MMA(1, 0, At, B0); PG8_MMA(1, 1, At, B1); PG8_BAR; PG8_SCHED;
            } else {
            PG8_LDB(B0, 0, 0); PG8_SCHED; PG8_LDA(At, 0, 0); PG8_STAGE(PG8_SA(1, 1), a1 + hstep, voffA);
            PG8_WAIT_L(8); PG8_BAR; PG8_WAIT_L(0); PG8_MMA(0, 0, At, B0); PG8_BAR; PG8_SCHED;
            PG8_LDB(B1, 0, 1); PG8_STAGE(PG8_SB(0, 0), b2, voffB);
            PG8_BAR; PG8_WAIT_L(0); PG8_MMA(0, 1, At, B1); PG8_BAR;
            PG8_LDA(At, 0, 1); PG8_STAGE(PG8_SA(0, 0), a2, voffA);
            PG8_BAR; PG8_WAIT_L(0); PG8_MMA(1, 0, At, B0); PG8_BAR; PG8_SCHED;
            PG8_STAGE(PG8_SB(0, 1), b2 + hstep, voffB);
            PG8_WAIT_V(6); PG8_BAR; PG8_MMA(1, 1, At, B1); PG8_BAR;
            PG8_LDB(B0, 1, 0); PG8_SCHED; PG8_LDA(At, 1, 0); PG8_STAGE(PG8_SA(0, 1), a2 + hstep, voffA);
            PG8_WAIT_L(8); PG8_BAR; PG8_WAIT_L(0); PG8_MMA(0, 0, At, B0); PG8_BAR; PG8_SCHED;
            PG8_LDB(B1, 1, 1); PG8_STAGE(PG8_SB(1, 0), b3, voffB);
            PG8_BAR; PG8_WAIT_L(0); PG8_MMA(0, 1, At, B1); PG8_BAR;
            PG8_LDA(At, 1, 1); PG8_STAGE(PG8_SA(1, 0), a3, voffA);
            PG8_BAR; PG8_WAIT_L(0); PG8_MMA(1, 0, At, B0); PG8_BAR; PG8_SCHED;
            PG8_STAGE(PG8_SB(1, 1), b3 + hstep, voffB);
            PG8_WAIT_V(6); PG8_BAR; PG8_MMA(1, 1, At, B1); PG8_BAR;
            }
        }
        if constexpr (ALIGN_EPI) { if (wr == 0) PG8_BAR; }
        if constexpr (!Epi::AFTER_DRAIN) { E(acc, cur, wr, wc, fr, fq); S.done(cur); }
        if (!has_next) break;
#pragma unroll
        for (int a = 0; a < 2; ++a)
#pragma unroll
            for (int b = 0; b < 2; ++b)
#pragma unroll
                for (int m = 0; m < 4; ++m)
#pragma unroll
                    for (int n = 0; n < 2; ++n) acc[a][b][m][n] = (typename AccT<I8>::type){};
        cur = nxt; cA = nA; cB = nB; ++ui;
        if constexpr (ALIGN_EPI) { if (wr == 1) PG8_BAR; }
    }
    PG8_WAIT_V(0);
    if constexpr (!ALIGN_EPI) { if (wr == 0) PG8_BAR; }
    PG8_BAR;
    if constexpr (Epi::AFTER_DRAIN) { E.fused(acc, cur, wr, wc, fr, fq, lds, wid, lane); S.done(cur); }
#undef PG8_SA
#undef PG8_SB
#undef PG8_STAGE
#undef PG8_LDA
#undef PG8_LDB
#undef PG8_MMA
#undef PG8_WAIT_V
#undef PG8_WAIT_L
#undef PG8_BAR
#undef PG8_SCHED
}
}
#ifndef PG8_SP2
#define PG8_SP2 true
#endif
#ifndef PG8_ALIGN
#define PG8_ALIGN true
#endif

constexpr int BATCH = 2, SEQ = 16384, DM = 2048, T = BATCH * SEQ;
constexpr int INW = 6176, HP = 6400;
constexpr int C_QA = 0, C_KA = 256, C_VA = 512, C_RA = 1024, C_QD = 1536, C_KD = 3072, C_VD = 4608, C_GF = 6144;
constexpr int NHD = 12;
constexpr float EPS = 1e-6f;
constexpr float LOG2E = 1.4426950408889634f;
constexpr float QSCALE = 0.08838834764831845f * LOG2E;
constexpr int NPHASE = 11;

constexpr size_t MiB = 1u << 20;
constexpr size_t WS_CTL = 0, WS_ROPE = 1 * MiB, WS_RS1 = 3 * MiB, WS_RS2 = 3 * MiB + 512 * 1024, WS_SSP = 4 * MiB, WS_WIN = 8 * MiB, WS_WO = 33 * MiB, WS_WQ = 41 * MiB,
                 WS_SK = 49 * MiB, WS_DEC = 50 * MiB, WS_LP = 51 * MiB, WS_IDX = 56 * MiB, WS_GATE = 72 * MiB, WS_DOWN = 88 * MiB, WS_UP = 152 * MiB, WS_XB = 216 * MiB,
                 WS_H = 344 * MiB, WS_X1B = WS_H, WS_QRY = WS_H + 128 * MiB, WS_OP1 = 744 * MiB, WS_OP2 = 840 * MiB, WS_PART = 472 * MiB  , WS_END = 984 * MiB;
constexpr size_t OUT_ST = 0, OUT_OP0 = 128 * MiB;
constexpr int LDS_BYTES = 147456;

#define LAS __attribute__((address_space(3)))
typedef unsigned short bf16_t;
typedef short bf16x8 __attribute__((ext_vector_type(8)));
typedef short s16x4 __attribute__((ext_vector_type(4)));
typedef float f32x4 __attribute__((ext_vector_type(4)));
typedef float f32x2 __attribute__((ext_vector_type(2)));
typedef float f32x16 __attribute__((ext_vector_type(16)));
typedef unsigned u32x4 __attribute__((ext_vector_type(4)));
typedef unsigned u32x2 __attribute__((ext_vector_type(2)));
#define LDS_WAIT() asm volatile("s_waitcnt lgkmcnt(0)" ::: "memory")
#define SBAR() __builtin_amdgcn_sched_barrier(0)

__device__ __forceinline__ float bf2f(unsigned short b) { return __uint_as_float(((unsigned)b) << 16); }
__device__ __forceinline__ float bflo(unsigned w) { return __uint_as_float(w << 16); }
__device__ __forceinline__ float bfhi(unsigned w) { return __uint_as_float(w & 0xffff0000u); }
__device__ __forceinline__ unsigned f2bf(float f) { unsigned u = __float_as_uint(f); return (u + 0x7fffu + ((u >> 16) & 1u)) >> 16; }
__device__ __forceinline__ unsigned pk2(float lo, float hi) { return pg8::cvt_pk_bf16(lo, hi); }
__device__ __forceinline__ float fexp(float x) { return __builtin_amdgcn_exp2f(x * LOG2E); }
__device__ __forceinline__ float flog(float x) { return __builtin_amdgcn_logf(x) * 0.6931471805599453f; }
__device__ __forceinline__ float wave_sum(float v) {
#pragma unroll
    for (int o = 1; o < 64; o <<= 1) v += __shfl_xor(v, o);
    return v;
}
__device__ __forceinline__ int crow(int r, int hi) { return (r & 3) + 8 * (r >> 2) + 4 * hi; }

struct Frame {
    LAS unsigned char* lds; char* ldsg; unsigned char* wsb;
    int tid, lane, wave, vcu, G;
    const float *x, *norm1_g, *w_in, *up_f, *bias_f, *up_b, *bias_b, *out_g, *qn_g, *kn_g, *w_out, *norm2_g, *w_query, *sub_keys, *peer_down, *peer_up;
    float* out;
    __device__ __forceinline__ f32x2* rope_() const { return (f32x2*)((f32x2*)(wsb + WS_ROPE)); }
    __device__ __forceinline__ float* rs1_() const { return (float*)((float*)(wsb + WS_RS1)); }
    __device__ __forceinline__ float* rs2_() const { return (float*)((float*)(wsb + WS_RS2)); }
    __device__ __forceinline__ float* ssp_() const { return (float*)((float*)(wsb + WS_SSP)); }
    __device__ __forceinline__ float* dec_() const { return (float*)((float*)(wsb + WS_DEC)); }
    __device__ __forceinline__ float* lp_() const { return (float*)((float*)(wsb + WS_LP)); }
    __device__ __forceinline__ float* gate_() const { return (float*)((float*)(wsb + WS_GATE)); }
    __device__ __forceinline__ short* part_() const { return (short*)(wsb + WS_PART); }
    __device__ __forceinline__ float* sd_() const { return (float*)((float*)(wsb + WS_CTL + 65536)); }
    __device__ __forceinline__ float* su_() const { return (float*)((float*)(wsb + WS_CTL + 131072)); }
    __device__ __forceinline__ float* sx_() const { return (float*)((float*)(wsb + WS_RS2 + 131072)); }
    __device__ __forceinline__ float* csum_() const { return (float*)((float*)(wsb + WS_RS2 + 262144)); }
    __device__ __forceinline__ unsigned char* down8_() const { return (unsigned char*)(wsb + WS_DOWN); }
    __device__ __forceinline__ unsigned char* up8_() const { return (unsigned char*)(wsb + WS_UP); }
    __device__ __forceinline__ unsigned char* xq8_() const { return (unsigned char*)(wsb + WS_OP2); }
    __device__ __forceinline__ unsigned char* fq8_() const { return (unsigned char*)(wsb + WS_XB + 64 * MiB); }
    __device__ __forceinline__ unsigned short* idxT_() const { return (unsigned short*)((unsigned short*)(wsb + WS_XB + 72 * MiB)); }
    __device__ __forceinline__ unsigned* fqT_() const { return (unsigned*)((unsigned*)(wsb + WS_XB + 80 * MiB)); }
    __device__ __forceinline__ unsigned short* idx_() const { return (unsigned short*)(wsb + WS_IDX); }
    __device__ __forceinline__ unsigned short* state_() const { return (unsigned short*)((unsigned short*)((unsigned char*)out + OUT_ST)); }
    __device__ __forceinline__ bf16_t* WinT_() const { return (bf16_t*)((bf16_t*)(wsb + WS_WIN)); }
    __device__ __forceinline__ unsigned char* Win8_() const { return (unsigned char*)(wsb + WS_WIN); }
    __device__ __forceinline__ unsigned char* xq1_() const { return (unsigned char*)(wsb + WS_OP1); }
    __device__ __forceinline__ float* sw_() const { return (float*)((float*)(wsb + WS_CTL + 196608)); }
    __device__ __forceinline__ unsigned* wqmax_() const { return (unsigned*)(wsb + WS_CTL) + 4608; }
    __device__ __forceinline__ float* swq_() const { return (float*)(wsb + WS_CTL + 229376); }
    __device__ __forceinline__ unsigned char* Wq8_() const { return (unsigned char*)(wsb + WS_WQ); }
    __device__ __forceinline__ unsigned char* xq6_() const { return (unsigned char*)(wsb + WS_OP1); }
    __device__ __forceinline__ bf16_t* WoT_() const { return (bf16_t*)((bf16_t*)(wsb + WS_WO)); }
    __device__ __forceinline__ bf16_t* WqT_() const { return (bf16_t*)((bf16_t*)(wsb + WS_WQ)); }
    __device__ __forceinline__ bf16_t* SK_() const { return (bf16_t*)((bf16_t*)(wsb + WS_SK)); }
    __device__ __forceinline__ bf16_t* down16_() const { return (bf16_t*)((bf16_t*)(wsb + WS_DOWN)); }
    __device__ __forceinline__ bf16_t* up16_() const { return (bf16_t*)((bf16_t*)(wsb + WS_UP)); }
    __device__ __forceinline__ bf16_t* xb_() const { return (bf16_t*)((bf16_t*)(wsb + WS_XB)); }
    __device__ __forceinline__ bf16_t* mixed_() const { return (bf16_t*)((bf16_t*)(wsb + WS_XB)); }
    __device__ __forceinline__ bf16_t* h_() const { return (bf16_t*)((bf16_t*)(wsb + WS_H)); }
    __device__ __forceinline__ bf16_t* x1b_() const { return (bf16_t*)((bf16_t*)(wsb + WS_X1B)); }
    __device__ __forceinline__ bf16_t* qry_() const { return (bf16_t*)((bf16_t*)(wsb + WS_QRY)); }
    __device__ __forceinline__ bf16_t* op0_() const { return (bf16_t*)((bf16_t*)((unsigned char*)out + OUT_OP0)); }
    __device__ __forceinline__ bf16_t* op1_() const { return (bf16_t*)((bf16_t*)(wsb + WS_OP1)); }
    __device__ __forceinline__ bf16_t* op2_() const { return (bf16_t*)((bf16_t*)(wsb + WS_OP2)); }
};

__device__ __forceinline__ void p0_transpose_item(const float* W, int K, int N, bf16_t* WT, int k0, int n0, int dst_row0, const float* g, LAS float* scr, int lane) {
#pragma unroll 8
    for (int i = 0; i < 32; ++i) { const int kk = 2 * i + (lane >> 5); float w = W[(size_t)(k0 + kk) * N + n0 + (lane & 31)]; if (g) w *= g[k0 + kk]; scr[kk * 33 + (lane & 31)] = w; }
    LDS_WAIT(); asm volatile("" ::: "memory");
    const int c = lane & 7;
#pragma unroll
    for (int j = 0; j < 4; ++j) { const int n = (lane >> 3) + 8 * j; const LAS float* s = scr + (8 * c) * 33 + n;
        u32x4 o; o.x = pk2(s[0 * 33], s[1 * 33]); o.y = pk2(s[2 * 33], s[3 * 33]); o.z = pk2(s[4 * 33], s[5 * 33]); o.w = pk2(s[6 * 33], s[7 * 33]);
        *(u32x4*)(WT + (size_t)(dst_row0 + n) * K + k0 + 8 * c) = o; }
    LDS_WAIT(); asm volatile("" ::: "memory");
}
__device__ __forceinline__ unsigned pack_nib(unsigned a, unsigned b) { return (a & 0x0F0F0F0Fu) | ((b & 0x0F0F0F0Fu) << 4); }
__device__ __forceinline__ unsigned pack_i8x4(const f32x4 v, float inv, float lim) { unsigned w = 0u;
#pragma unroll
    for (int i = 0; i < 4; ++i) { const int qv = (int)fminf(fmaxf(rintf(v[i] * inv), -lim), lim); w |= ((unsigned)qv & 0xffu) << (8 * i); }
    return w; }
template <bool isup> __device__ __forceinline__ void peer_quant_row(const Frame& F, int e) {
    const int lane = F.lane;
    if constexpr (isup) {
        const f32x4* src = (const f32x4*)(F.peer_up + (size_t)e * DM) + lane;
        f32x4 v[8]; float m = 0.f;
#pragma unroll
        for (int j = 0; j < 8; ++j) { v[j] = src[64 * j];
            m = fmaxf(fmaxf(m, fmaxf(fabsf(v[j][0]), fabsf(v[j][1]))), fmaxf(fabsf(v[j][2]), fabsf(v[j][3]))); }
#pragma unroll
        for (int o = 1; o < 64; o <<= 1) m = fmaxf(m, __shfl_xor(m, o));
        const float inv = m > 0.f ? 127.f / m : 0.f; unsigned char* dst = F.up8_();
#pragma unroll
        for (int j = 0; j < 8; ++j) { const unsigned w = pack_i8x4(v[j], inv, 127.f);
            const int col = 4 * lane + 256 * j; *(unsigned*)(dst + (size_t)(col >> 3) * 131072 + (size_t)e * 8 + (col & 7)) = w; }
        if (lane == 0) F.su_()[e] = m * (1.f / 127.f);
    } else {
        const f32x4* src = (const f32x4*)(F.peer_down + (size_t)e * DM) + 2 * lane; const f32x4* gs = (const f32x4*)F.norm2_g + 2 * lane;
        f32x4 v[8]; float ss = 0.f;
#pragma unroll
        for (int j = 0; j < 4; ++j) { v[2 * j] = src[128 * j] * gs[128 * j]; v[2 * j + 1] = src[128 * j + 1] * gs[128 * j + 1];
#pragma unroll
            for (int i = 0; i < 4; ++i) ss += v[2 * j][i] * v[2 * j][i] + v[2 * j + 1][i] * v[2 * j + 1][i]; }
        ss = wave_sum(ss);
        const float step = 0.345f * sqrtf(ss * (1.f / DM)), inv = step > 0.f ? 1.f / step : 0.f; unsigned char* dst = F.down8_();
#pragma unroll
        for (int j = 0; j < 4; ++j) { const unsigned w = pack_nib(pack_i8x4(v[2 * j], inv, 7.f), pack_i8x4(v[2 * j + 1], inv, 7.f));
            const int col = 8 * lane + 512 * j; *(unsigned*)(dst + ((size_t)(col >> 8) * 16384 + e) * 128 + ((col & 255) >> 3) * 4) = w; }
        if (lane == 0) F.sd_()[e] = step;
    }
}
__device__ __forceinline__ void w_quant_item(const Frame& F, const float* W, int ldw, int n0, const float* gain, unsigned char* W8, int drow, float* sw) {
    LAS float* scr = (LAS float*)(F.lds + F.wave * 16384); LAS float* cmx = (LAS float*)(F.lds + 12288);
    const int lane = F.lane, kw = F.wave * 256;
    float m = 0.f;
#pragma unroll 16
    for (int i = 0; i < 128; ++i) { const int k = kw + 2 * i + (lane >> 5); m = fmaxf(m, fabsf(W[(size_t)k * ldw + n0 + (lane & 31)] * gain[k])); }
    m = fmaxf(m, __shfl_xor(m, 32)); if (lane < 32) cmx[F.wave * 32 + lane] = m;
    __syncthreads();
    if (F.tid < 32) { float mm = 0.f;
#pragma unroll
        for (int w = 0; w < 8; ++w) mm = fmaxf(mm, cmx[w * 32 + F.tid]);
        cmx[256 + F.tid] = mm > 0.f ? 127.f / mm : 0.f; sw[drow + F.tid] = mm * (1.f / 127.f); }
    __syncthreads();
    for (int ch = 0; ch < 4; ++ch) { const int k0 = kw + 64 * ch;
#pragma unroll 8
        for (int i = 0; i < 32; ++i) { const int kk = 2 * i + (lane >> 5); scr[kk * 33 + (lane & 31)] = W[(size_t)(k0 + kk) * ldw + n0 + (lane & 31)] * gain[k0 + kk] * cmx[256 + (lane & 31)]; }
        LDS_WAIT(); asm volatile("" ::: "memory");
        const int c = lane & 7;
#pragma unroll
        for (int j = 0; j < 4; ++j) { const int n = (lane >> 3) + 8 * j; const LAS float* sp = scr + (8 * c) * 33 + n; u32x2 w = {0u, 0u};
#pragma unroll
            for (int i = 0; i < 4; ++i) { w.x |= ((unsigned)(int)rintf(sp[i * 33]) & 0xffu) << (8 * i); w.y |= ((unsigned)(int)rintf(sp[(4 + i) * 33]) & 0xffu) << (8 * i); }
            *(u32x2*)(W8 + (size_t)(drow + n) * DM + k0 + 8 * c) = w; }
        LDS_WAIT(); asm volatile("" ::: "memory"); }
    __syncthreads();
}
__device__ __forceinline__ void x_quant_row(const Frame& F, int m) {
    const int lane = F.lane; const f32x4* xr = (const f32x4*)(F.x + (size_t)m * DM) + lane; f32x4 v[8]; float s = 0.f, mx = 0.f;
#pragma unroll
    for (int j = 0; j < 8; ++j) { v[j] = xr[64 * j]; s += (v[j][0] * v[j][0] + v[j][1] * v[j][1]) + (v[j][2] * v[j][2] + v[j][3] * v[j][3]);
        mx = fmaxf(fmaxf(mx, fmaxf(fabsf(v[j][0]), fabsf(v[j][1]))), fmaxf(fabsf(v[j][2]), fabsf(v[j][3]))); }
    s = wave_sum(s);
#pragma unroll
    for (int o = 1; o < 64; o <<= 1) mx = fmaxf(mx, __shfl_xor(mx, o));
    const float inv = mx > 0.f ? 127.f / mx : 0.f; unsigned* o4 = (unsigned*)(F.xq1_() + (size_t)m * DM) + lane;
#pragma unroll
    for (int j = 0; j < 8; ++j) o4[64 * j] = pack_i8x4(v[j], inv, 127.f);
    if (lane == 0) { F.rs1_()[m] = __builtin_amdgcn_rsqf(s * (1.f / DM) + EPS) * (mx * (1.f / 127.f)); F.sx_()[m] = mx * (1.25f / 119.f); }
}
__device__ __forceinline__ void phase0(const Frame& F) {
    LAS float* scr = (LAS float*)(F.lds + F.wave * 16384);
    const int gw = F.vcu * 8 + F.wave, NGW = F.G * 8, lane = F.lane;
    for (int nb = F.vcu; nb < 193; nb += F.G) w_quant_item(F, F.w_in, INW, nb * 32, F.norm1_g, F.Win8_(), nb < 32 ? nb * 32 : (nb == 32 ? C_GF : nb * 32 - 32), F.sw_());
    { LAS float* rm = (LAS float*)(F.lds);
      for (int k0 = F.vcu * 8; k0 < DM; k0 += F.G * 8) { const int k = k0 + F.wave; const float g = F.norm2_g[k]; const f32x4* wr = (const f32x4*)(F.w_query + (size_t)k * DM) + lane;
          __syncthreads();
#pragma unroll
          for (int j = 0; j < 8; ++j) { const f32x4 v = wr[64 * j]; *(LAS f32x4*)(rm + F.wave * 2048 + 4 * (lane + 64 * j)) = (f32x4){fabsf(v[0] * g), fabsf(v[1] * g), fabsf(v[2] * g), fabsf(v[3] * g)}; }
          __syncthreads();
          { f32x4 m = *(const LAS f32x4*)(rm + 4 * F.tid);
#pragma unroll
            for (int w = 1; w < 8; ++w) { const f32x4 o = *(const LAS f32x4*)(rm + w * 2048 + 4 * F.tid); m[0] = fmaxf(m[0], o[0]); m[1] = fmaxf(m[1], o[1]); m[2] = fmaxf(m[2], o[2]); m[3] = fmaxf(m[3], o[3]); }
            unsigned* cm = F.wqmax_() + 4 * F.tid;
#pragma unroll
            for (int i = 0; i < 4; ++i) (void)__hip_atomic_fetch_max(cm + i, __float_as_uint(m[i]), __ATOMIC_RELAXED, __HIP_MEMORY_SCOPE_AGENT); } }
      __syncthreads(); }
    for (int it = gw; it < 32 * 64; it += NGW) { const int kb = it / 64, nb = it % 64; p0_transpose_item(F.w_out, DM, DM, F.WoT_(), kb * 64, nb * 32, nb * 32, nullptr, scr, lane); }
    const size_t gt = (size_t)gw * 64 + lane, NT = (size_t)NGW * 64;
    { u32x4* z = (u32x4*)(F.Win8_() + (size_t)INW * DM); const u32x4 zero = {0u, 0u, 0u, 0u}; for (size_t i = gt; i < (size_t)(HP - INW) * DM / 16; i += NT) z[i] = zero; if (gt < (size_t)(HP - INW)) F.sw_()[INW + gt] = 0.f; }
    for (int r = gw; r < 16384; r += NGW) peer_quant_row<false>(F, r);
    for (int r = gw; r < 16384; r += NGW) peer_quant_row<true>(F, r);
    for (size_t i = gt; i < (size_t)8 * 2 * 128 * 128 / 8; i += NT) { const f32x4 a = *(const f32x4*)(F.sub_keys + i * 8), b = *(const f32x4*)(F.sub_keys + i * 8 + 4);
        u32x4 o; o.x = pk2(a[0], a[1]); o.y = pk2(a[2], a[3]); o.z = pk2(b[0], b[1]); o.w = pk2(b[2], b[3]); *(u32x4*)(F.SK_() + i * 8) = o; }
    for (int m = gw; m < T; m += NGW) x_quant_row(F, m);
}
__device__ __forceinline__ void wq_quant_transpose(const Frame& F) {
    LAS float* scr = (LAS float*)(F.lds + F.wave * 16384); const int gw = F.vcu * 8 + F.wave, NGW = F.G * 8, lane = F.lane;
    for (int it = gw; it < 32 * 64; it += NGW) { const int k0 = (it / 64) * 64, n0 = (it % 64) * 32;
        const float cmx = __uint_as_float(F.wqmax_()[n0 + (lane & 31)]), inv = cmx > 0.f ? 127.f / cmx : 0.f;
        if (k0 == 0 && lane < 32) F.swq_()[n0 + lane] = cmx * (1.f / 127.f);
#pragma unroll 8
        for (int i = 0; i < 32; ++i) { const int kk = 2 * i + (lane >> 5); scr[kk * 33 + (lane & 31)] = F.w_query[(size_t)(k0 + kk) * DM + n0 + (lane & 31)] * F.norm2_g[k0 + kk] * inv; }
        LDS_WAIT(); asm volatile("" ::: "memory");
        const int c = lane & 7;
#pragma unroll
        for (int j = 0; j < 4; ++j) { const int n = (lane >> 3) + 8 * j; const LAS float* sp = scr + (8 * c) * 33 + n; u32x2 w = {0u, 0u};
#pragma unroll
            for (int i = 0; i < 4; ++i) { w.x |= ((unsigned)(int)rintf(sp[i * 33]) & 0xffu) << (8 * i); w.y |= ((unsigned)(int)rintf(sp[(4 + i) * 33]) & 0xffu) << (8 * i); }
            *(u32x2*)(F.Wq8_() + (size_t)(n0 + n) * DM + k0 + 8 * c) = w; }
        LDS_WAIT(); asm volatile("" ::: "memory"); }
    __syncthreads();
}

__device__ __forceinline__ void qknorm_rope(const Frame& F) {
    const int gw = F.vcu * 8 + F.wave, NGW = F.G * 8, lane = F.lane, c = lane & 15;
    for (long it = gw; it < (long)T * 24 / 4; it += NGW) { const long row = it * 4 + (lane >> 4); const int t = (int)(row / 24), slot = (int)(row % 24);
        bf16_t* p = F.h_() + (size_t)t * HP + C_QD + slot * 128 + 8 * c;
        const u32x4 w = *(const u32x4*)p; float y[8] = {bflo(w.x), bfhi(w.x), bflo(w.y), bfhi(w.y), bflo(w.z), bfhi(w.z), bflo(w.w), bfhi(w.w)};
        float ss = 0.f;
#pragma unroll
        for (int e = 0; e < 8; ++e) ss += y[e] * y[e];
        ss += __shfl_xor(ss, 1); ss += __shfl_xor(ss, 2); ss += __shfl_xor(ss, 4); ss += __shfl_xor(ss, 8);
        const float rq = __builtin_amdgcn_rsqf(ss * (1.f / 128.f) + EPS); const float* g = (slot < 12 ? F.qn_g : F.kn_g) + 8 * c;
        const f32x4 g0 = *(const f32x4*)g, g1 = *(const f32x4*)(g + 4);
#pragma unroll
        for (int e = 0; e < 4; ++e) { y[e] *= rq * g0[e]; y[4 + e] *= rq * g1[e]; }
        const int pos = t & (SEQ - 1);
#pragma unroll
        for (int e = 0; e < 8; ++e) { const float partner = __shfl_xor(y[e], 2);
            if (c < 4) { const f32x2 cs = F.rope_()[(size_t)pos * 16 + 8 * (c & 1) + e]; y[e] = (c < 2) ? (y[e] * cs.x - partner * cs.y) : (y[e] * cs.x + partner * cs.y); } }
        if (slot < 12) {
#pragma unroll
            for (int e = 0; e < 8; ++e) y[e] *= QSCALE; }
        u32x4 o; o.x = pk2(y[0], y[1]); o.y = pk2(y[2], y[3]); o.z = pk2(y[4], y[5]); o.w = pk2(y[6], y[7]); *(u32x4*)p = o; }
}

constexpr int GL_GDS = 0, GL_TOT = 8192, GL_QF = 12288, GL_QB = 21504, GL_KF = 30720, GL_KB = 39936, GL_VT = 49152, GL_P = 67584, GL_SF = 76800, GL_SB = 95232, GL_OB = 12288;
constexpr int RS72 = 144;
__device__ __forceinline__ float logsig(float z) { return fminf(z, 0.f) - flog(1.f + fexp(-fabsf(z))); }
__device__ __forceinline__ void gla_gates(const Frame& F, int b, int hh, int n, float (&bf)[8], float (&bb)[8], float& totf, float& totb) {
    const int tid = F.tid, c = tid & 63, ig = F.wave; LAS float* gds = (LAS float*)(F.lds + GL_GDS); LAS float* tot = (LAS float*)(F.lds + GL_TOT);
    const size_t t0 = (size_t)b * SEQ + (size_t)n * 64;
    if (tid < 256) { const int tk = tid >> 2, part = tid & 3; const u32x4 w = *(const u32x4*)(F.h_() + (t0 + tk) * HP + C_GF + part * 8); LAS float* d = gds + tk * 32 + part * 8;
        d[0] = bflo(w.x); d[1] = bfhi(w.x); d[2] = bflo(w.y); d[3] = bfhi(w.y); d[4] = bflo(w.z); d[5] = bfhi(w.z); d[6] = bflo(w.w); d[7] = bfhi(w.w); }
    __syncthreads();
    const int hc = hh * 64 + c; float upf[16], upb[16];
#pragma unroll
    for (int r = 0; r < 16; ++r) { upf[r] = F.up_f[r * 256 + hc]; upb[r] = F.up_b[r * 256 + hc]; }
    const float biasf = F.bias_f[hc], biasb = F.bias_b[hc]; float laf[8], lab[8];
#pragma unroll
    for (int e = 0; e < 8; ++e) { const LAS float* gr = gds + (ig * 8 + e) * 32; float zf = biasf, zb = biasb;
#pragma unroll
        for (int r = 0; r < 16; ++r) { zf += gr[r] * upf[r]; zb += gr[16 + r] * upb[r]; }
        laf[e] = logsig(zf) * 0.0625f; lab[e] = logsig(zb) * 0.0625f; }
    bf[0] = laf[0];
#pragma unroll
    for (int e = 1; e < 8; ++e) bf[e] = bf[e - 1] + laf[e];
    bb[7] = lab[7];
#pragma unroll
    for (int e = 6; e >= 0; --e) bb[e] = bb[e + 1] + lab[e];
    tot[ig * 64 + c] = bf[7]; tot[512 + ig * 64 + c] = bb[0];
    __syncthreads();
    float offf = 0.f, offb = 0.f; totf = 0.f; totb = 0.f;
#pragma unroll
    for (int g = 0; g < 8; ++g) { const float tf = tot[g * 64 + c], tb = tot[512 + g * 64 + c]; totf += tf; totb += tb; offf += (g < ig) ? tf : 0.f; offb += (g > ig) ? tb : 0.f; }
#pragma unroll
    for (int e = 0; e < 8; ++e) { bf[e] += offf; bb[e] += offb; }
}
__device__ __forceinline__ void gla_stage_vT(const Frame& F, const bf16x8 (&vraw)[2]) {
#pragma unroll
    for (int j = 0; j < 2; ++j) { const int q = F.tid + 512 * j, tk = q >> 4, vc = (q & 15) * 8; LAS short* d = (LAS short*)(F.lds + GL_VT) + vc * 72 + tk;
#pragma unroll
        for (int e = 0; e < 8; ++e) d[e * 72] = vraw[j][e]; }
}
__device__ __forceinline__ bf16x8 ldfrag(const LAS unsigned char* base, int row, int s, int hi) { return *(const LAS bf16x8*)(base + row * RS72 + (16 * s + 8 * hi) * 2); }

__device__ __forceinline__ void gla_passA(const Frame& F, int item) {
    const int bh = item >> 8, n = item & 255, b = bh >> 2, hh = bh & 3, tid = F.tid, c = tid & 63, ig = F.wave, lane = F.lane, r32 = lane & 31, hi = lane >> 5;
    const size_t t0 = (size_t)b * SEQ + (size_t)n * 64;
    unsigned short kraw[8]; bf16x8 vraw[2];
#pragma unroll
    for (int e = 0; e < 8; ++e) kraw[e] = F.h_()[(t0 + ig * 8 + e) * HP + C_KA + hh * 64 + c];
#pragma unroll
    for (int j = 0; j < 2; ++j) { const int q = tid + 512 * j; vraw[j] = *(const bf16x8*)(F.h_() + (t0 + (q >> 4)) * HP + C_VA + hh * 128 + (q & 15) * 8); }
    float bf[8], bb[8], totf, totb; gla_gates(F, b, hh, n, bf, bb, totf, totb);
    float kf[8], kb[8];
#pragma unroll
    for (int e = 0; e < 8; ++e) { const float k = bf2f(kraw[e]); kf[e] = k * fexp(totf - bf[e]); kb[e] = k * fexp(totb - bb[e]); }
    { u32x4 o; o.x = pk2(kf[0], kf[1]); o.y = pk2(kf[2], kf[3]); o.z = pk2(kf[4], kf[5]); o.w = pk2(kf[6], kf[7]); *(LAS u32x4*)(F.lds + GL_KF + c * RS72 + ig * 16) = o;
      o.x = pk2(kb[0], kb[1]); o.y = pk2(kb[2], kb[3]); o.z = pk2(kb[4], kb[5]); o.w = pk2(kb[6], kb[7]); *(LAS u32x4*)(F.lds + GL_KB + c * RS72 + ig * 16) = o; }
    gla_stage_vT(F, vraw);
    if (ig == 0) { F.dec_()[((size_t)(0 * 8 + bh) * 256 + n) * 64 + c] = fexp(totf); F.dec_()[((size_t)(1 * 8 + bh) * 256 + n) * 64 + c] = fexp(totb); }
    __syncthreads();
    const int dir = F.wave >> 2, vt = F.wave & 3; const LAS unsigned char* kimg = F.lds + (dir ? GL_KB : GL_KF);
    f32x16 a0 = {}, a1 = {};
#pragma unroll
    for (int s = 0; s < 4; ++s) { const bf16x8 av = ldfrag(F.lds + GL_VT, 32 * vt + r32, s, hi), b0 = ldfrag(kimg, r32, s, hi), b1 = ldfrag(kimg, 32 + r32, s, hi);
        a0 = __builtin_amdgcn_mfma_f32_32x32x16_bf16(av, b0, a0, 0, 0, 0); a1 = __builtin_amdgcn_mfma_f32_32x32x16_bf16(av, b1, a1, 0, 0, 0); }
    unsigned short* st = F.state_() + ((size_t)(dir * 8 + bh) * 256 + n) * 8192;
#pragma unroll
    for (int r = 0; r < 16; ++r) { const int v = 32 * vt + crow(r, hi); st[v * 64 + r32] = (unsigned short)f2bf(a0[r]); st[v * 64 + 32 + r32] = (unsigned short)f2bf(a1[r]); }
    __syncthreads();
}
__device__ __forceinline__ void gla_scan(const Frame& F, int item) {
    const int dir = item >> 7, bh = (item >> 4) & 7, e = (item & 15) * 512 + F.tid, c = e & 63;
    unsigned short* st = F.state_() + (size_t)(dir * 8 + bh) * 256 * 8192 + e; const float* dc = F.dec_() + (size_t)(dir * 8 + bh) * 256 * 64 + c; float S = 0.f;
    float iA[16], dA[16], iB[16], dB[16];
#define SC_N(g, j) (dir ? 255 - ((g) * 16 + (j)) : (g) * 16 + (j))
#define SC_LOAD(I_, D_, g) do { _Pragma("unroll") for (int j = 0; j < 16; ++j) { const int n_ = SC_N(g, j); I_[j] = bf2f(st[(size_t)n_ * 8192]); D_[j] = dc[n_ * 64]; } } while (0)
#define SC_RUN(I_, D_, g) do { _Pragma("unroll") for (int j = 0; j < 16; ++j) { const int n_ = SC_N(g, j); st[(size_t)n_ * 8192] = (unsigned short)f2bf(S); S = D_[j] * S + I_[j]; } } while (0)
    SC_LOAD(iA, dA, 0);
    for (int g = 0; g < 16; g += 2) { SC_LOAD(iB, dB, g + 1); SC_RUN(iA, dA, g); if (g + 2 < 16) SC_LOAD(iA, dA, g + 2); SC_RUN(iB, dB, g + 1); }
#undef SC_N
#undef SC_LOAD
#undef SC_RUN
}
__device__ __forceinline__ void gla_passC(const Frame& F, int item) {
    const int bh = item >> 8, n = item & 255, b = bh >> 2, hh = bh & 3, tid = F.tid, c = tid & 63, ig = F.wave, lane = F.lane, r32 = lane & 31, hi = lane >> 5;
    const size_t t0 = (size_t)b * SEQ + (size_t)n * 64;
    unsigned short qraw[8], kraw[8]; bf16x8 vraw[2]; u32x4 sraw[2][2];
#pragma unroll
    for (int e = 0; e < 8; ++e) { const bf16_t* hr = F.h_() + (t0 + ig * 8 + e) * HP + hh * 64 + c; qraw[e] = hr[C_QA]; kraw[e] = hr[C_KA]; }
#pragma unroll
    for (int j = 0; j < 2; ++j) { const int q = tid + 512 * j; vraw[j] = *(const bf16x8*)(F.h_() + (t0 + (q >> 4)) * HP + C_VA + hh * 128 + (q & 15) * 8);
#pragma unroll
        for (int dir = 0; dir < 2; ++dir) sraw[dir][j] = *(const u32x4*)(F.state_() + ((size_t)(dir * 8 + bh) * 256 + n) * 8192 + (q >> 3) * 64 + (q & 7) * 8); }
    float bf[8], bb[8], totf, totb; gla_gates(F, b, hh, n, bf, bb, totf, totb);
#pragma unroll
    for (int e = 0; e < 8; ++e) { const int i = ig * 8 + e; const float q = bf2f(qraw[e]) * 0.125f, k = bf2f(kraw[e]);
        const float ef = fexp(bf[e]), eb = fexp(bb[e]), nf = fexp(-bf[e]), nb = fexp(-bb[e]);
        *(LAS unsigned short*)(F.lds + GL_QF + i * RS72 + c * 2) = (unsigned short)f2bf(q * ef); *(LAS unsigned short*)(F.lds + GL_QB + i * RS72 + c * 2) = (unsigned short)f2bf(q * eb);
        *(LAS unsigned short*)(F.lds + GL_KF + i * RS72 + c * 2) = (unsigned short)f2bf(k * nf); *(LAS unsigned short*)(F.lds + GL_KB + i * RS72 + c * 2) = (unsigned short)f2bf(k * nb); }
    gla_stage_vT(F, vraw);
#pragma unroll
    for (int dir = 0; dir < 2; ++dir)
#pragma unroll
        for (int j = 0; j < 2; ++j) { const int q = tid + 512 * j; *(LAS u32x4*)(F.lds + (dir ? GL_SB : GL_SF) + (q >> 3) * RS72 + (q & 7) * 16) = sraw[dir][j]; }
    __syncthreads();
    if (F.wave < 4) { const int ti = F.wave >> 1, tj = F.wave & 1; f32x16 sf = {}, sb = {};
#pragma unroll
        for (int s = 0; s < 4; ++s) {
            sf = __builtin_amdgcn_mfma_f32_32x32x16_bf16(ldfrag(F.lds + GL_QF, 32 * ti + r32, s, hi), ldfrag(F.lds + GL_KF, 32 * tj + r32, s, hi), sf, 0, 0, 0);
            sb = __builtin_amdgcn_mfma_f32_32x32x16_bf16(ldfrag(F.lds + GL_QB, 32 * ti + r32, s, hi), ldfrag(F.lds + GL_KB, 32 * tj + r32, s, hi), sb, 0, 0, 0); }
#pragma unroll
        for (int r = 0; r < 16; ++r) { const int i = 32 * ti + crow(r, hi), j = 32 * tj + r32; const float p = (j <= i) ? sf[r] : sb[r];
            *(LAS unsigned short*)(F.lds + GL_P + i * RS72 + j * 2) = (unsigned short)f2bf(p); } }
    __syncthreads();
    const int ti = F.wave & 1, tv = F.wave >> 1; f32x16 o = {};
#pragma unroll
    for (int s = 0; s < 4; ++s) o = __builtin_amdgcn_mfma_f32_32x32x16_bf16(ldfrag(F.lds + GL_P, 32 * ti + r32, s, hi), ldfrag(F.lds + GL_VT, 32 * tv + r32, s, hi), o, 0, 0, 0);
#pragma unroll
    for (int s = 0; s < 4; ++s) o = __builtin_amdgcn_mfma_f32_32x32x16_bf16(ldfrag(F.lds + GL_QF, 32 * ti + r32, s, hi), ldfrag(F.lds + GL_SF, 32 * tv + r32, s, hi), o, 0, 0, 0);
#pragma unroll
    for (int s = 0; s < 4; ++s) o = __builtin_amdgcn_mfma_f32_32x32x16_bf16(ldfrag(F.lds + GL_QB, 32 * ti + r32, s, hi), ldfrag(F.lds + GL_SB, 32 * tv + r32, s, hi), o, 0, 0, 0);
    __syncthreads();
    LAS float* ob = (LAS float*)(F.lds + GL_OB);
#pragma unroll
    for (int r = 0; r < 16; ++r) ob[(32 * ti + crow(r, hi)) * 132 + 32 * tv + r32] = o[r];
    __syncthreads();
    { const int i = tid >> 3, part = tid & 7, v0 = part * 16; float ov[16], ss = 0.f;
#pragma unroll
      for (int e = 0; e < 16; ++e) { ov[e] = ob[i * 132 + v0 + e]; ss += ov[e] * ov[e]; }
      ss += __shfl_xor(ss, 1); ss += __shfl_xor(ss, 2); ss += __shfl_xor(ss, 4);
      const float rs = __builtin_amdgcn_rsqf(ss * (1.f / 128.f) + EPS); const size_t tok = t0 + i;
      const u32x4 r0 = *(const u32x4*)(F.h_() + tok * HP + C_RA + hh * 128 + v0), r1 = *(const u32x4*)(F.h_() + tok * HP + C_RA + hh * 128 + v0 + 8);
      const float rr[16] = {bflo(r0.x), bfhi(r0.x), bflo(r0.y), bfhi(r0.y), bflo(r0.z), bfhi(r0.z), bflo(r0.w), bfhi(r0.w), bflo(r1.x), bfhi(r1.x), bflo(r1.y), bfhi(r1.y), bflo(r1.z), bfhi(r1.z), bflo(r1.w), bfhi(r1.w)};
      float y[16];
#pragma unroll
      for (int e = 0; e < 16; ++e) { const float g = F.out_g[hh * 128 + v0 + e]; const float sil = rr[e] * __builtin_amdgcn_rcpf(1.f + fexp(-rr[e])); y[e] = ov[e] * rs * g * sil; }
      u32x4 w0, w1; w0.x = pk2(y[0], y[1]); w0.y = pk2(y[2], y[3]); w0.z = pk2(y[4], y[5]); w0.w = pk2(y[6], y[7]); w1.x = pk2(y[8], y[9]); w1.y = pk2(y[10], y[11]); w1.z = pk2(y[12], y[13]); w1.w = pk2(y[14], y[15]);
      bf16_t* mp = F.mixed_() + tok * DM + hh * 128 + v0; *(u32x4*)mp = w0; *(u32x4*)(mp + 8) = w1; }
    __syncthreads();
}

constexpr int AT_V = 0, AT_K = 49152, AT_O = 81920, AT_OSZ = 4608;
#define KSWZ(row, colB) ((row) * 256 + ((colB) ^ (((row) & 7) << 4)))
__device__ __forceinline__ int v_st(int k, int c) { const int kk = (k & ~0xC) | ((k & 4) << 1) | ((k & 8) >> 1); return ((kk >> 3) * 4 + (c >> 5)) * 512 + ((kk & 7) * 32 + (c & 31)) * 2; }
__device__ __forceinline__ int v_rd_base(int lane) { return ((lane & 3) << 3) | (((lane >> 2) & 3) << 6) | (((lane >> 4) & 1) << 5) | (((lane >> 5) & 1) << 8); }
constexpr int v_rd_off(int d0, int ks, int half) { return d0 * 512 + ks * 4096 + half * 2048; }
template <int OFF> __device__ __forceinline__ s16x4 tr_read(int vb) { s16x4 r; asm volatile("ds_read_b64_tr_b16 %0, %1 offset:%2" : "=&v"(r) : "v"(vb), "i"(OFF) : "memory"); return r; }
template <int D0> __device__ __forceinline__ void pv_one(f32x16& od, int vb, bf16x8 pa0, bf16x8 pa1, bf16x8 pa2, bf16x8 pa3) {
    const s16x4 l0 = tr_read<v_rd_off(D0, 0, 0)>(vb), h0 = tr_read<v_rd_off(D0, 0, 1)>(vb), l1 = tr_read<v_rd_off(D0, 1, 0)>(vb), h1 = tr_read<v_rd_off(D0, 1, 1)>(vb);
    const s16x4 l2 = tr_read<v_rd_off(D0, 2, 0)>(vb), h2 = tr_read<v_rd_off(D0, 2, 1)>(vb), l3 = tr_read<v_rd_off(D0, 3, 0)>(vb), h3 = tr_read<v_rd_off(D0, 3, 1)>(vb);
    asm volatile("s_waitcnt lgkmcnt(0)" ::: "memory"); SBAR();
#define PKV(L, H) (bf16x8){L[0], L[1], L[2], L[3], H[0], H[1], H[2], H[3]}
    od = __builtin_amdgcn_mfma_f32_32x32x16_bf16(pa0, PKV(l0, h0), od, 0, 0, 0);
    od = __builtin_amdgcn_mfma_f32_32x32x16_bf16(pa1, PKV(l1, h1), od, 0, 0, 0);
    od = __builtin_amdgcn_mfma_f32_32x32x16_bf16(pa2, PKV(l2, h2), od, 0, 0, 0);
    od = __builtin_amdgcn_mfma_f32_32x32x16_bf16(pa3, PKV(l3, h3), od, 0, 0, 0);
#undef PKV
}
struct AtP { size_t tokbase; int dil, m0, Tf, nt, head, p; };
__device__ __forceinline__ AtP at_decode(int item) {
    AtP P; const int round = item >> 8, w = item & 255, p = round % 3, bh = round / 3, b = bh / 3, u = w & 63; P.p = p; P.head = (bh % 3) * 4 + (w >> 6);
    const int dsh = 2 * p, L = SEQ >> dsh, runs = 64 >> dsh, res = u / runs; P.dil = 1 << dsh; P.m0 = (u % runs) * 256; P.tokbase = (size_t)b * SEQ + res;
    const int kt_lo = (P.m0 == 0) ? 1 : 0, kt_hi = (P.m0 + 256 >= L) ? 4 : 5; P.Tf = P.m0 - 64 + 64 * kt_lo; P.nt = kt_hi - kt_lo + 1; return P;
}
__device__ __forceinline__ void attn_phase(const Frame& F) {
    const int tid = F.tid, wid = F.wave, lane = F.lane, r32 = lane & 31, hi = lane >> 5, G = F.G;
    int ntot = 0; for (int it = F.vcu; it < 4608; it += G) ntot += at_decode(it).nt;
    if (ntot == 0) return;
    const int sr = tid >> 4, sc = (tid & 15) * 8, vst0 = v_st(sr, sc), vst1 = v_st(32 + sr, sc), kc = sc * 2;
    const int vb0 = (int)(unsigned)(uintptr_t)(F.ldsg + AT_V) + v_rd_base(lane);
    int it_ld = F.vcu, rl = 0, it_c = F.vcu, rc = 0; AtP ld = at_decode(it_ld), cur = ld;
    bf16x8 qr[8], qn[8]; f32x16 o[4]; float l_reg = 0.f;
    bf16x8 sA0, sA1, sA2, sA3, sB0, sB1, sB2, sB3;
    const bool rot = false;
    bf16x8 pa0, pa1, pa2, pa3;
    bool pend = false, pend_last = false; int vprev = 0, prvQ0 = 0; AtP prv = cur;
#pragma unroll
    for (int d0 = 0; d0 < 4; ++d0) o[d0] = (f32x16){};
#define AT_QLOAD() do { const bf16_t* qp_ = F.h_() + C_QD + ld.head * 128 + (ld.tokbase + (size_t)ld.dil * (ld.m0 + 32 * wid + r32)) * HP + hi * 8; \
        _Pragma("unroll") for (int d0 = 0; d0 < 8; ++d0) qn[d0] = *(const bf16x8*)(qp_ + d0 * 16); } while (0)
#define AT_SLOAD(S) do { const int T0_ = ld.Tf + 64 * rl; const size_t ra = (ld.tokbase + (size_t)ld.dil * (T0_ + sr)) * HP + ld.head * 128 + sc, rb = ra + (size_t)ld.dil * 32 * HP; \
        S##0 = *(const bf16x8*)(F.h_() + C_VD + ra); S##1 = *(const bf16x8*)(F.h_() + C_VD + rb); S##2 = *(const bf16x8*)(F.h_() + C_KD + ra); S##3 = *(const bf16x8*)(F.h_() + C_KD + rb); \
        if (++rl == ld.nt) { it_ld += G; rl = 0; if (it_ld < 4608) { ld = at_decode(it_ld); AT_QLOAD(); } } } while (0)
#define AT_SWRITE(S, KB, VB) do { *(LAS bf16x8*)(F.lds + AT_V + (VB) * 16384 + vst0) = S##0; *(LAS bf16x8*)(F.lds + AT_V + (VB) * 16384 + vst1) = S##1; \
        *(LAS bf16x8*)(F.lds + AT_K + (KB) * 16384 + KSWZ(sr, kc)) = S##2; *(LAS bf16x8*)(F.lds + AT_K + (KB) * 16384 + KSWZ(32 + sr, kc)) = S##3; } while (0)
#define PK4(P, BASE, OUT) do { unsigned a0_ = pk2(P[BASE + 0], P[BASE + 1]), a1_ = pk2(P[BASE + 2], P[BASE + 3]); unsigned b0_ = pk2(P[BASE + 4], P[BASE + 5]), b1_ = pk2(P[BASE + 6], P[BASE + 7]); \
        auto r0_ = __builtin_amdgcn_permlane32_swap(a0_, b0_, false, false); auto r1_ = __builtin_amdgcn_permlane32_swap(a1_, b1_, false, false); \
        u32x4 w_ = {r0_[0], r1_[0], r0_[1], r1_[1]}; OUT = __builtin_bit_cast(bf16x8, w_); } while (0)
#define AT_TRD(OFF) __builtin_amdgcn_ds_read_tr16_b64_v4i16((LAS s16x4*)(uintptr_t)(unsigned)(vb_ + (OFF)))
#define AT_PVR(D0, R) do { R[0] = AT_TRD(v_rd_off(D0, 0, 0)); R[1] = AT_TRD(v_rd_off(D0, 0, 1)); R[2] = AT_TRD(v_rd_off(D0, 1, 0)); R[3] = AT_TRD(v_rd_off(D0, 1, 1)); \
        R[4] = AT_TRD(v_rd_off(D0, 2, 0)); R[5] = AT_TRD(v_rd_off(D0, 2, 1)); R[6] = AT_TRD(v_rd_off(D0, 3, 0)); R[7] = AT_TRD(v_rd_off(D0, 3, 1)); } while (0)
#define AT_PKV(L, H) (bf16x8){L[0], L[1], L[2], L[3], H[0], H[1], H[2], H[3]}
#define AT_MF(OD, R) do { OD = __builtin_amdgcn_mfma_f32_32x32x16_bf16(AT_PKV(R[0], R[1]), pa0, OD, 0, 0, 0); OD = __builtin_amdgcn_mfma_f32_32x32x16_bf16(AT_PKV(R[2], R[3]), pa1, OD, 0, 0, 0); \
        OD = __builtin_amdgcn_mfma_f32_32x32x16_bf16(AT_PKV(R[4], R[5]), pa2, OD, 0, 0, 0); OD = __builtin_amdgcn_mfma_f32_32x32x16_bf16(AT_PKV(R[6], R[7]), pa3, OD, 0, 0, 0); } while (0)
#define AT_PV(VB) do { const int vb_ = vb0 + (VB) * 16384; s16x4 RA[8], RB[8]; \
        AT_PVR(0, RA); AT_PVR(1, RB); SBAR(); AT_MF(o[0], RA); SBAR(); AT_PVR(2, RA); SBAR(); AT_MF(o[1], RB); SBAR(); AT_PVR(3, RB); SBAR(); AT_MF(o[2], RA); AT_MF(o[3], RB); } while (0)
#define AT_EPI(P_, Q0_) do { \
            unsigned char* Op = (P_.p == 0 ? (unsigned char*)F.out + OUT_OP0 : F.wsb + (P_.p == 1 ? WS_OP1 : WS_OP2)); \
            const float lt = l_reg + __shfl_xor(l_reg, 32), rl_ = __builtin_amdgcn_rcpf(lt);                      \
            LAS unsigned char* stg = F.lds + AT_O + wid * AT_OSZ; \
            if (hi == 0) F.lp_()[((size_t)P_.p * T + P_.tokbase + (size_t)P_.dil * ((Q0_) + r32)) * NHD + P_.head] = lt; \
            _Pragma("unroll") for (int d0 = 0; d0 < 4; ++d0) _Pragma("unroll") for (int k = 0; k < 4; ++k) { \
                int w_ = __builtin_amdgcn_cvt_pk_fp8_f32(o[d0][4 * k] * rl_, o[d0][4 * k + 1] * rl_, 0, false); w_ = __builtin_amdgcn_cvt_pk_fp8_f32(o[d0][4 * k + 2] * rl_, o[d0][4 * k + 3] * rl_, w_, true); \
                *(LAS int*)(stg + r32 * 144 + d0 * 32 + k * 8 + hi * 4) = w_; }                                     \
            LDS_WAIT(); asm volatile("" ::: "memory"); \
            _Pragma("unroll") for (int i_ = 0; i_ < 4; ++i_) { const int row = 8 * i_ + (lane >> 3), ch = lane & 7; const u32x4 w = *(const LAS u32x4*)(stg + row * 144 + ch * 16); \
                *(u32x4*)(Op + (P_.tokbase + (size_t)P_.dil * ((Q0_) + row)) * (NHD * 128) + P_.head * 128 + ch * 16) = w; } \
            LDS_WAIT(); asm volatile("" ::: "memory"); \
            _Pragma("unroll") for (int d0 = 0; d0 < 4; ++d0) o[d0] = (f32x16){}; l_reg = 0.f; } while (0)
#define AT_STEP(KB, VB) do { \
        if (rot && pend) AT_PV(vprev);                                                           \
        if (pend_last) AT_EPI(prv, prvQ0);                                                       \
        if (rc == 0) { _Pragma("unroll") for (int d0 = 0; d0 < 8; ++d0) qr[d0] = qn[d0]; } \
        const int Q0 = cur.m0 + 32 * wid, T0 = cur.Tf + 64 * rc; \
        const bool act = T0 + 63 >= Q0 - 64 && T0 <= Q0 + 95;                                \
        if (act) { \
            const LAS unsigned char* Ks = F.lds + AT_K + (KB) * 16384; f32x16 p0 = {}, p1 = {}; \
            _Pragma("unroll") for (int d0 = 0; d0 < 8; ++d0) { const int cb = (d0 * 16 + hi * 8) * 2; \
                const bf16x8 k0 = *(const LAS bf16x8*)(Ks + KSWZ(r32, cb)), k1 = *(const LAS bf16x8*)(Ks + KSWZ(32 + r32, cb)); \
                p0 = __builtin_amdgcn_mfma_f32_32x32x16_bf16(k0, qr[d0], p0, 0, 0, 0); p1 = __builtin_amdgcn_mfma_f32_32x32x16_bf16(k1, qr[d0], p1, 0, 0, 0); } \
            const int dq = T0 - (Q0 + r32); float ps = 0.f;                                \
            _Pragma("unroll") for (int r = 0; r < 16; ++r) { const int e0 = dq + crow(r, hi), e1 = e0 + 32; \
                p0[r] = (e0 >= -64 && e0 <= 64) ? __builtin_amdgcn_exp2f(p0[r]) : 0.f; p1[r] = (e1 >= -64 && e1 <= 64) ? __builtin_amdgcn_exp2f(p1[r]) : 0.f; ps += p0[r] + p1[r]; } \
            l_reg += ps; \
            PK4(p0, 0, pa0); PK4(p0, 8, pa1); PK4(p1, 0, pa2); PK4(p1, 8, pa3); } \
        const bool last = rc + 1 == cur.nt; \
        if (!rot) { if (act) AT_PV(VB); } else { pend = act; vprev = (VB); } \
        pend_last = last; if (last) { prv = cur; prvQ0 = Q0; } \
        if (last) { rc = 0; it_c += G; if (it_c < 4608) cur = at_decode(it_c); } else ++rc; } while (0)
    AT_QLOAD();
    AT_SLOAD(sA); AT_SLOAD(sB); AT_SWRITE(sA, 0, 0); AT_SLOAD(sA); __syncthreads();
    int v3 = 0;
    for (int g = 0; g < ntot; g += 2) { int v3n = v3 == 2 ? 0 : v3 + 1;
        AT_STEP(0, v3);
        if (g + 1 < ntot) AT_SWRITE(sB, 1, v3n);
        if (it_ld < 4608) AT_SLOAD(sB);
        v3 = v3n; v3n = v3 == 2 ? 0 : v3 + 1;
        __syncthreads();
        if (g + 1 < ntot) {
            AT_STEP(1, v3);
            if (g + 2 < ntot) AT_SWRITE(sA, 0, v3n);
            if (it_ld < 4608) AT_SLOAD(sA);
            v3 = v3n;
            __syncthreads(); }
    }
    if (rot && pend) AT_PV(vprev);
    if (pend_last) AT_EPI(prv, prvQ0);
#undef AT_QLOAD
#undef AT_SLOAD
#undef AT_SWRITE
#undef PK4
#undef AT_PV
#undef AT_TRD
#undef AT_PVR
#undef AT_PKV
#undef AT_MF
#undef AT_EPI
#undef AT_STEP
}
__device__ __forceinline__ void dil_combine(const Frame& F) {
    const int gw = F.vcu * 8 + F.wave, NGW = F.G * 8, lane = F.lane, c = lane & 15;
    const unsigned char* o0 = (const unsigned char*)F.op0_(); const unsigned char* o1 = (const unsigned char*)F.op1_(); const unsigned char* o2 = (const unsigned char*)F.op2_();
    for (long it = gw; it < (long)T * NHD / 4; it += NGW) { const long row = it * 4 + (lane >> 4); const size_t tok = (size_t)(row / NHD); const int head = (int)(row % NHD);
        const float l0 = F.lp_()[tok * NHD + head], l1 = F.lp_()[((size_t)T + tok) * NHD + head], l2 = F.lp_()[((size_t)2 * T + tok) * NHD + head]; const float inv = 1.f / (l0 + l1 + l2), w0 = l0 * inv, w1 = l1 * inv, w2 = l2 * inv;
        const size_t off = tok * (NHD * 128) + head * 128 + 8 * c; const u32x2 a = *(const u32x2*)(o0 + off), b = *(const u32x2*)(o1 + off), d = *(const u32x2*)(o2 + off);
#define DC2(AW, BW, DW, SEL) ({ const f32x2 x_ = __builtin_amdgcn_cvt_pk_f32_fp8((int)(AW), SEL), y_ = __builtin_amdgcn_cvt_pk_f32_fp8((int)(BW), SEL), z_ = __builtin_amdgcn_cvt_pk_f32_fp8((int)(DW), SEL); \
            pk2(w0 * x_[0] + w1 * y_[0] + w2 * z_[0], w0 * x_[1] + w1 * y_[1] + w2 * z_[1]); })
        u32x4 o; o.x = DC2(a.x, b.x, d.x, false); o.y = DC2(a.x, b.x, d.x, true); o.z = DC2(a.y, b.y, d.y, false); o.w = DC2(a.y, b.y, d.y, true);
#undef DC2
        *(u32x4*)(F.mixed_() + tok * DM + 512 + head * 128 + 8 * c) = o; }
}

__device__ __forceinline__ unsigned fl_flip(float x) { const unsigned u = __float_as_uint(x); return u ^ ((unsigned)((int)u >> 31) | 0x80000000u); }
__device__ __forceinline__ float fl_unflip(unsigned w) { return __uint_as_float((w & 0x80000000u) ? (w ^ 0x80000000u) : ~w); }
#define CE_DESC(a, b) do { const unsigned x_ = max(a, b), y_ = min(a, b); a = x_; b = y_; } while (0)
__device__ __forceinline__ void sort16_desc(unsigned (&a)[16]) {
#pragma unroll
    for (int k = 2; k <= 16; k <<= 1)
#pragma unroll
        for (int j = k >> 1; j > 0; j >>= 1)
#pragma unroll
            for (int i = 0; i < 16; ++i) { const int l = i ^ j; if (l > i) { const unsigned x = max(a[i], a[l]), y = min(a[i], a[l]); if ((i & k) == 0) { a[i] = x; a[l] = y; } else { a[i] = y; a[l] = x; } } }
}
__device__ __forceinline__ void bmerge16_desc(unsigned (&a)[16]) {
#pragma unroll
    for (int j = 8; j > 0; j >>= 1)
#pragma unroll
        for (int i = 0; i < 16; ++i) { const int l = i ^ j; if (l > i) CE_DESC(a[i], a[l]); }
}
__device__ __forceinline__ void top16_merge(unsigned (&a)[16], const unsigned (&b)[16]) {
#pragma unroll
    for (int i = 0; i < 16; ++i) a[i] = max(a[i], b[15 - i]);
    bmerge16_desc(a);
}
__device__ __forceinline__ void top16_partner(unsigned (&a)[16]) {
    unsigned b[16];
#pragma unroll
    for (int i = 0; i < 16; ++i) b[i] = (unsigned)__shfl_xor((int)a[i], 32);
    top16_merge(a, b);
}
__device__ constexpr unsigned char stair(int n) {
    constexpr unsigned char L[64] = {0x00,0x01,0x02,0x03,0x04,0x05,0x06,0x07,0x08,0x09,0x0a,0x0b,0x0c,0x0d,0x0e,0x0f,0x10,0x11,0x12,0x13,0x14,0x15,0x16,0x17,0x20,0x21,0x22,0x23,0x24,0x30,0x31,0x32,
                                     0x33,0x40,0x41,0x42,0x50,0x51,0x60,0x61,0x70,0x71,0x80,0x90,0xa0,0xb0,0xc0,0xd0,0xe0,0xf0,0xff,0xff,0xff,0xff,0xff,0xff,0xff,0xff,0xff,0xff,0xff,0xff,0xff,0xff};
    return L[n];
}
constexpr int TK_KEYS = 32768;
__device__ __forceinline__ void topk_item(const Frame& F, int hh, int tg) {
    const int lane = F.lane, r32 = lane & 31, hi = lane >> 5, tok0 = tg * 32; const size_t tok = (size_t)tok0 + r32;
    LAS int* ktab = (LAS int*)(F.lds + F.wave * 4096) + r32 * 32;
    float ss = 0.f;
    { const f32x4* sp = (const f32x4*)(F.ssp_() + tok * 32 + hi * 16);
#pragma unroll
      for (int j = 0; j < 4; ++j) { const f32x4 v = sp[j]; ss += (v[0] + v[1]) + (v[2] + v[3]); } }
    ss += __shfl_xor(ss, 32);
    const float rs2 = __builtin_amdgcn_rsqf(ss * (1.f / DM) + EPS);
    if (hh == 0 && hi == 0) F.rs2_()[tok] = rs2;
    unsigned top[2][16];
#pragma unroll
    for (int cc = 0; cc < 2; ++cc) {
        f32x16 acc[4] = {};
        const bf16_t* qp = F.qry_() + tok * DM + hh * 256 + cc * 128 + hi * 8; const LAS unsigned char* kl = F.lds + TK_KEYS + cc * 32768;
        bf16x8 qf[8];
#pragma unroll
        for (int s = 0; s < 8; ++s) qf[s] = *(const bf16x8*)(qp + 16 * s);
#pragma unroll
        for (int s = 0; s < 8; ++s) {
#pragma unroll
            for (int kt = 0; kt < 4; ++kt) { const bf16x8 kf = *(const LAS bf16x8*)(kl + KSWZ(kt * 32 + r32, (16 * s + 8 * hi) * 2)); acc[kt] = __builtin_amdgcn_mfma_f32_32x32x16_bf16(kf, qf[s], acc[kt], 0, 0, 0); } }
        unsigned g[4][16];
#pragma unroll
        for (int kt = 0; kt < 4; ++kt) {
#pragma unroll
            for (int r = 0; r < 16; ++r) g[kt][r] = (fl_flip(acc[kt][r]) & ~127u) | (unsigned)(127 - (32 * kt + crow(r, hi)));
            sort16_desc(g[kt]); }
        top16_merge(g[0], g[1]); top16_merge(g[2], g[3]); top16_merge(g[0], g[2]); top16_partner(g[0]);
#pragma unroll
        for (int i = 0; i < 16; ++i) top[cc][i] = g[0][i];
    }
#pragma unroll
    for (int i = 0; i < 16; ++i) ktab[hi * 16 + i] = 127 - (int)((hi ? top[1][i] : top[0][i]) & 127u);
    float s0[16], s1[16];
#pragma unroll
    for (int i = 0; i < 16; ++i) { s0[i] = fl_unflip(top[0][i] & ~127u); s1[i] = fl_unflip(top[1][i] & ~127u); }
    unsigned ca[16], cb[16];
#pragma unroll
    for (int n = 0; n < 32; ++n) { const int A = stair(n), B = stair(25 + n); unsigned va = 0u, vb = 0u;
        if (n < 25) { va = (fl_flip(s0[A >> 4] + s1[A & 15]) & ~255u) | (unsigned)(255 - A); vb = (fl_flip(s0[B >> 4] + s1[B & 15]) & ~255u) | (unsigned)(255 - B); }
        const unsigned v = hi ? vb : va; if (n < 16) ca[n] = v; else cb[n - 16] = v; }
    sort16_desc(ca); sort16_desc(cb); top16_merge(ca, cb); top16_partner(ca);
    float e[16], sum = 0.f; const float mx = fl_unflip(ca[0] & ~255u) * rs2;
#pragma unroll
    for (int i = 0; i < 16; ++i) { e[i] = fexp(fl_unflip(ca[i] & ~255u) * rs2 - mx); sum += e[i]; }
    const float inv = 1.f / sum;
    LDS_WAIT(); asm volatile("" ::: "memory");
    int oi[8]; float og[8];
#pragma unroll
    for (int k = 0; k < 8; ++k) { const unsigned cv = hi ? ca[8 + k] : ca[k]; const int code = 255 - (int)(cv & 255u); og[k] = (hi ? e[8 + k] : e[k]) * inv; oi[k] = ktab[code >> 4] * 128 + ktab[16 + (code & 15)]; }
    { unsigned short* ip = F.idx_() + tok * 128 + hh * 16 + hi * 8; float* gp = F.gate_() + tok * 128 + hh * 16 + hi * 8;
      *(u32x4*)ip = (u32x4){(unsigned)oi[0] | ((unsigned)oi[1] << 16), (unsigned)oi[2] | ((unsigned)oi[3] << 16), (unsigned)oi[4] | ((unsigned)oi[5] << 16), (unsigned)oi[6] | ((unsigned)oi[7] << 16)};
      { const int g0 = hh * 4 + hi * 2;
        *(u32x2*)(F.idxT_() + ((size_t)g0 * T + tok) * 4) = (u32x2){(unsigned)oi[0] | ((unsigned)oi[1] << 16), (unsigned)oi[2] | ((unsigned)oi[3] << 16)};
        *(u32x2*)(F.idxT_() + ((size_t)(g0 + 1) * T + tok) * 4) = (u32x2){(unsigned)oi[4] | ((unsigned)oi[5] << 16), (unsigned)oi[6] | ((unsigned)oi[7] << 16)}; }
      *(f32x4*)gp = (f32x4){og[0], og[1], og[2], og[3]}; *(f32x4*)(gp + 4) = (f32x4){og[4], og[5], og[6], og[7]}; }
    LDS_WAIT(); asm volatile("" ::: "memory");
}

constexpr int PS_NSL = 8, PS_CW = DM / PS_NSL, PS_SUB = PS_NSL / 8, PS_TG = 32, PS_NTG = T / PS_TG;
__device__ __forceinline__ float gelu_tanh(float x) { const float u = 0.7978845608028654f * (x + 0.044715f * x * x * x); const float t = 1.f - 2.f * __builtin_amdgcn_rcpf(1.f + fexp(2.f * u)); return 0.5f * x * (1.f + t); }
__device__ __forceinline__ int dot32n(u32x4 w, u32x4 xh, u32x4 xl) {
    int ph = __builtin_amdgcn_sdot8((int)w.x, (int)xh.x, 0, false); ph = __builtin_amdgcn_sdot8((int)w.y, (int)xh.y, ph, false); ph = __builtin_amdgcn_sdot8((int)w.z, (int)xh.z, ph, false); ph = __builtin_amdgcn_sdot8((int)w.w, (int)xh.w, ph, false);
    int pl = __builtin_amdgcn_sdot8((int)w.x, (int)xl.x, 0, false); pl = __builtin_amdgcn_sdot8((int)w.y, (int)xl.y, pl, false); pl = __builtin_amdgcn_sdot8((int)w.z, (int)xl.z, pl, false); pl = __builtin_amdgcn_sdot8((int)w.w, (int)xl.w, pl, false);
    return (ph << 4) + pl; }
__device__ __forceinline__ unsigned xcc_id() { return (unsigned)__builtin_amdgcn_s_getreg((3 << 11) | 20) & 7u; }
__device__ __forceinline__ bool peer_claim(unsigned* cnt, unsigned x, unsigned& d, int lane, int& q, int& tg) {
    while (d < 8u) { const unsigned xq = (x + d) & 7u; unsigned u = 0u;
        if (lane == 0) u = __hip_atomic_fetch_add(cnt + 64 * xq, 1u, __ATOMIC_RELAXED, __HIP_MEMORY_SCOPE_AGENT);
        u = (unsigned)__builtin_amdgcn_readfirstlane((int)u);
        if (u < (unsigned)(PS_SUB * PS_NTG)) { q = (int)(u / PS_NTG) * 8 + (int)xq; tg = (int)(u % PS_NTG); return true; }
        ++d; }
    return false;
}
template <int CTRL> __device__ __forceinline__ float dppmov(float x) { return __int_as_float(__builtin_amdgcn_update_dpp(0, __float_as_int(x), CTRL, 0xf, 0xf, true)); }
template <int CTRL> __device__ __forceinline__ int dppmovi(int x) { return __builtin_amdgcn_update_dpp(0, x, CTRL, 0xf, 0xf, true); }
__device__ __forceinline__ int bperm(int srclane, int v) { return __builtin_amdgcn_ds_bpermute(srclane << 2, v); }
__device__ __forceinline__ unsigned swar_add8(unsigned q) { return ((q & 0x7f7f7f7fu) + 0x08080808u) ^ (q & 0x80808080u); }
__device__ __forceinline__ void peer_quant_x(const Frame& F) {
    const int gw = F.vcu * 8 + F.wave, NGW = F.G * 8, lane = F.lane;
    for (int tok = gw; tok < T; tok += NGW) { const u32x4* xr = (const u32x4*)(F.x1b_() + (size_t)tok * DM) + lane; f32x4 v[4][2]; float m = 0.f;
#pragma unroll
        for (int j = 0; j < 4; ++j) { const u32x4 w = xr[64 * j]; v[j][0] = (f32x4){bflo(w.x), bfhi(w.x), bflo(w.y), bfhi(w.y)}; v[j][1] = (f32x4){bflo(w.z), bfhi(w.z), bflo(w.w), bfhi(w.w)};
#pragma unroll
            for (int i = 0; i < 4; ++i) m = fmaxf(m, fmaxf(fabsf(v[j][0][i]), fabsf(v[j][1][i]))); }
#pragma unroll
        for (int o = 1; o < 64; o <<= 1) m = fmaxf(m, __shfl_xor(m, o));
        const float inv = m > 0.f ? 119.f / m : 0.f;
#pragma unroll
        for (int j = 0; j < 4; ++j) { const unsigned qa = pack_i8x4(v[j][0], inv, 119.f), qb = pack_i8x4(v[j][1], inv, 119.f);
            const unsigned wl = pack_nib(qa, qb), wh = pack_nib(swar_add8(qa) >> 4, swar_add8(qb) >> 4);
            const int col = 8 * lane + 512 * j; unsigned char* p = F.xq8_() + (size_t)tok * DM + (col >> 8) * 256 + ((col & 255) >> 5) * 32 + ((col & 31) >> 3) * 4;
            *(unsigned*)p = wh; *(unsigned*)(p + 16) = wl; }
        if (lane == 0) F.sx_()[tok] = m * (1.f / 119.f); }
}
__device__ __forceinline__ void peer_down(const Frame& F, int cntw = 1024) {
    const int lane = F.lane, g = lane >> 3, c = lane & 7; const unsigned x = xcc_id(); unsigned d = 0u; int q, tg; unsigned* cnt = (unsigned*)(F.wsb + WS_CTL) + cntw;
    const unsigned char* tab = F.down8_(); const unsigned char* xb = F.xq6_();
    while (peer_claim(cnt, x, d, lane, q, tg)) {
        const unsigned colb = (unsigned)(q * PS_CW + 32 * c), slb = (unsigned)q * (16384u * 128u) + 16u * c; short* part = F.part_() + (size_t)q * T * 128; const size_t tok0 = (size_t)tg * PS_TG;
        u32x4 wA[16], wB[16], xA, xB, yA, yB; int iA0, iA1, iB0, iB1;
#define PD_IDX(i0, i1, tok) do { const unsigned short* ip_ = F.idx_() + (tok) * 128 + lane; i0 = ip_[0]; i1 = ip_[64]; } while (0)
#define PD_ROWS(W_, X_, Y_, i0, i1, tok) do { _Pragma("unroll") for (int j = 0; j < 16; ++j) { const unsigned e_ = (unsigned)bperm(8 * (j & 7) + g, j < 8 ? i0 : i1); \
            W_[j] = *(const u32x4*)(tab + (e_ * 128u + slb)); } X_ = *(const u32x4*)(xb + (tok) * DM + colb); Y_ = *(const u32x4*)(xb + (tok) * DM + colb + 16); } while (0)
#define PD_COMP(W_, X_, Y_, tok) do { u32x4 xh_, xl_;                   \
            xl_.x = pack_nib(X_.x, X_.y); xl_.y = pack_nib(X_.z, X_.w); xl_.z = pack_nib(Y_.x, Y_.y); xl_.w = pack_nib(Y_.z, Y_.w); \
            xh_.x = pack_nib(swar_add8(X_.x) >> 4, swar_add8(X_.y) >> 4); xh_.y = pack_nib(swar_add8(X_.z) >> 4, swar_add8(X_.w) >> 4); xh_.z = pack_nib(swar_add8(Y_.x) >> 4, swar_add8(Y_.y) >> 4); xh_.w = pack_nib(swar_add8(Y_.z) >> 4, swar_add8(Y_.w) >> 4); \
            int p[16]; _Pragma("unroll") for (int j = 0; j < 16; ++j) p[j] = dot32n(W_[j], xh_, xl_); \
            int a1[8], a2[4], a3[2]; \
            _Pragma("unroll") for (int i = 0; i < 8; ++i) { const int keep = (c & 1) ? p[2 * i + 1] : p[2 * i], give = (c & 1) ? p[2 * i] : p[2 * i + 1]; a1[i] = keep + dppmovi<0xB1>(give); } \
            _Pragma("unroll") for (int i = 0; i < 4; ++i) { const int keep = (c & 2) ? a1[2 * i + 1] : a1[2 * i], give = (c & 2) ? a1[2 * i] : a1[2 * i + 1]; a2[i] = keep + dppmovi<0x4E>(give); } \
            _Pragma("unroll") for (int i = 0; i < 2; ++i) { const int keep = (c & 4) ? a2[2 * i + 1] : a2[2 * i], give = (c & 4) ? a2[2 * i] : a2[2 * i + 1]; a3[i] = keep + __shfl_xor(give, 4); } \
            part[(tok) * 128 + 8 * c + g] = (short)min(max(a3[0], -32768), 32767); part[(tok) * 128 + 64 + 8 * c + g] = (short)min(max(a3[1], -32768), 32767); } while (0)
        PD_IDX(iA0, iA1, tok0); PD_IDX(iB0, iB1, tok0 + 1);
        PD_ROWS(wA, xA, yA, iA0, iA1, tok0);
        for (int tt = 0; tt < PS_TG; tt += 2) { const size_t tok = tok0 + tt;
            PD_ROWS(wB, xB, yB, iB0, iB1, tok + 1);
            const size_t t2 = tok + (tt + 2 < PS_TG ? 2 : 0), t3 = tok + (tt + 2 < PS_TG ? 3 : 1);
            PD_IDX(iA0, iA1, t2);
            PD_COMP(wA, xA, yA, tok);
            if (tt + 2 < PS_TG) PD_ROWS(wA, xA, yA, iA0, iA1, t2);
            PD_IDX(iB0, iB1, t3);
            PD_COMP(wB, xB, yB, tok + 1);
        }
#undef PD_IDX
#undef PD_ROWS
#undef PD_COMP
    }
}
__device__ __forceinline__ void peer_coef_probe(const Frame& F, bool dry) {
    const int gw = F.vcu * 8 + F.wave, NGW = F.G * 8, lane = F.lane;
    for (int tok = gw; tok < T; tok += NGW) { int a0 = 0, a1 = 0; const short* pp = F.part_() + (size_t)tok * 128 + lane;
#pragma unroll
        for (int q = 0; q < PS_NSL; ++q) { a0 += pp[(size_t)q * T * 128]; a1 += pp[(size_t)q * T * 128 + 64]; }
        const float sc = F.rs2_()[tok] * F.sx_()[tok]; const float* gp = F.gate_() + (size_t)tok * 128 + lane; const int e0 = F.idx_()[(size_t)tok * 128 + lane], e1 = F.idx_()[(size_t)tok * 128 + 64 + lane];
        const float c0 = gp[0] * gelu_tanh((float)a0 * sc * F.sd_()[e0]) * F.su_()[e0], c1 = gp[64] * gelu_tanh((float)a1 * sc * F.sd_()[e1]) * F.su_()[e1];
        float m = fmaxf(fabsf(c0), fabsf(c1));
#pragma unroll
        for (int o = 1; o < 64; o <<= 1) m = fmaxf(m, __shfl_xor(m, o));
        const float inv = m > 0.f ? 127.f / m : 0.f; const int q0 = (int)rintf(c0 * inv), q1 = (int)rintf(c1 * inv);
        unsigned char* fp = dry ? F.wsb + WS_PART + 256 * MiB : (unsigned char*)F.fqT_();
        { const int k0 = lane, k1 = 64 + lane; fp[((size_t)(k0 >> 2) * T + tok) * 4 + (k0 & 3)] = (unsigned char)q0; fp[((size_t)(k1 >> 2) * T + tok) * 4 + (k1 & 3)] = (unsigned char)q1; }
        if (lane == 0 && !dry) F.csum_()[tok] = m * (1.f / 127.f); }
}
#ifndef PROBE_PHASE
#define PROBE_PHASE -1
#endif
#define UP_NREP ((PROBE_PHASE == 10) ? 2 : 1)
constexpr int U2_XO = 131072 + 2048, U2_SF = U2_XO + 8192;
#define PU_T4(ACC_, R0, R1, R2, R3, FQ_) do { const unsigned t0_ = __builtin_amdgcn_perm(R1, R0, 0x05010400u), t1_ = __builtin_amdgcn_perm(R1, R0, 0x07030602u), t2_ = __builtin_amdgcn_perm(R3, R2, 0x05010400u), t3_ = __builtin_amdgcn_perm(R3, R2, 0x07030602u); \
            ACC_[0] = __builtin_amdgcn_sdot4((int)__builtin_amdgcn_perm(t2_, t0_, 0x05040100u), FQ_, ACC_[0], false); ACC_[1] = __builtin_amdgcn_sdot4((int)__builtin_amdgcn_perm(t2_, t0_, 0x07060302u), FQ_, ACC_[1], false); \
            ACC_[2] = __builtin_amdgcn_sdot4((int)__builtin_amdgcn_perm(t3_, t1_, 0x05040100u), FQ_, ACC_[2], false); ACC_[3] = __builtin_amdgcn_sdot4((int)__builtin_amdgcn_perm(t3_, t1_, 0x07060302u), FQ_, ACC_[3], false); } while (0)
__device__ __forceinline__ unsigned u2_addr_lo(unsigned w, unsigned base) { unsigned a; asm("v_mad_u32_u16 %0, %1, 8, %2" : "=v"(a) : "v"(w), "s"(base)); return a; }
__device__ __forceinline__ unsigned u2_addr_hi(unsigned w, unsigned base) { unsigned a; asm("v_mad_u32_u16 %0, %1, 8, %2 op_sel:[1,0,0,0]" : "=v"(a) : "v"(w), "s"(base)); return a; }
__device__ __forceinline__ void peer_up(const Frame& F) {
    const int lane = F.lane;
    for (int cgi = F.vcu; cgi < 256 * UP_NREP; cgi += F.G) { const int cg = cgi & 255; const bool dry = cgi >= 256; float* const ob_ = dry ? (float*)(F.wsb + WS_PART) : F.out; const unsigned tmask_ = dry ? 16383u : 0xffffffffu;
        __syncthreads();
        { const u32x4* src = (const u32x4*)(F.up8_() + (size_t)cg * 131072);
#pragma unroll 4
          for (int i = 0; i < 16; ++i) { const int o = F.tid + 512 * i; *(LAS u32x4*)(F.lds + o * 16) = src[o]; } }
        __syncthreads();
        u32x2 S0i[8], S1i[8], S2i[8], S3i[8]; int S0f[8], S1f[8], S2f[8], S3f[8]; u32x2 R0[16], R1[16];
        const __amdgpu_buffer_rsrc_t rsI = __builtin_amdgcn_make_buffer_rsrc((void*)F.idxT_(), 0, 32 * T * 8, 0x00020000), rsF = __builtin_amdgcn_make_buffer_rsrc((void*)F.fqT_(), 0, 32 * T * 4, 0x00020000),
            rsX = __builtin_amdgcn_make_buffer_rsrc((void*)F.x1b_(), 0, T * DM * 2, 0x00020000), rsC = __builtin_amdgcn_make_buffer_rsrc((void*)F.csum_(), 0, T * 4, 0x00020000);
#define U2_FENCE() do { asm volatile("" ::: "memory"); SBAR(); } while (0)
#ifdef UP_PROBE_NOCONF
#define U2_IDMASK(id) do { id.x &= idmask_; id.y &= idmask_; } while (0)
        const unsigned idmask_ = dry ? 0u : 0xffffffffu;
#else
#define U2_IDMASK(id) do { } while (0)
#endif
#define U2_LOAD(S_, tok_, s_) do { const unsigned vo_ = (unsigned)(tok_) * 8u; _Pragma("unroll") for (int g = 0; g < 8; ++g) { S_##i[g] = __builtin_amdgcn_raw_buffer_load_b64(rsI, vo_, ((s_) * 8 + g) * (T * 8), 0); \
            S_##f[g] = (int)__builtin_amdgcn_raw_buffer_load_b32(rsF, vo_ >> 1, ((s_) * 8 + g) * (T * 4), 0); } U2_FENCE(); } while (0)
#define U2_ISSUE(R_, S_, h_) do { _Pragma("unroll") for (int g = 0; g < 4; ++g) { u32x2 id = S_##i[(h_) * 4 + g]; U2_IDMASK(id); \
                R_[4 * g + 0] = *(const LAS u32x2*)(uintptr_t)u2_addr_lo(id.x, lbase_); R_[4 * g + 1] = *(const LAS u32x2*)(uintptr_t)u2_addr_hi(id.x, lbase_); \
                R_[4 * g + 2] = *(const LAS u32x2*)(uintptr_t)u2_addr_lo(id.y, lbase_); R_[4 * g + 3] = *(const LAS u32x2*)(uintptr_t)u2_addr_hi(id.y, lbase_); } U2_FENCE(); } while (0)
#define U2_FOLD(R_, S_, h_) do { _Pragma("unroll") for (int g = 0; g < 4; ++g) { const int fq = S_##f[(h_) * 4 + g]; \
                int* a_ = acc; PU_T4(a_, R_[4 * g + 0].x, R_[4 * g + 1].x, R_[4 * g + 2].x, R_[4 * g + 3].x, fq); a_ = acc + 4; PU_T4(a_, R_[4 * g + 0].y, R_[4 * g + 1].y, R_[4 * g + 2].y, R_[4 * g + 3].y, fq); } U2_FENCE(); } while (0)
        const int nb = (T / 64 - F.wave + 7) / 8;
        const unsigned lbase_ = (unsigned)__builtin_amdgcn_readfirstlane((int)(unsigned)(uintptr_t)F.ldsg);
        unsigned lane_; asm volatile("v_mbcnt_lo_u32_b32 %0, -1, 0\n\tv_mbcnt_hi_u32_b32 %0, -1, %0" : "=v"(lane_));
        { const unsigned t0_ = (unsigned)F.wave * 64u + lane_; U2_LOAD(S0, t0_, 0); U2_LOAD(S1, t0_, 1); U2_LOAD(S2, t0_, 2); U2_LOAD(S3, t0_, 3); U2_ISSUE(R0, S0, 0); }
#pragma unroll 1
        for (int i = 0; i < nb; ++i) { const unsigned tok = (unsigned)(F.wave + 8 * i) * 64u + lane_; const unsigned tokn = tok + (i + 1 < nb ? 512u : 0u); int acc[8] = {0, 0, 0, 0, 0, 0, 0, 0};
            __builtin_amdgcn_raw_ptr_buffer_load_lds(rsX, (LAS unsigned*)(F.lds + U2_XO + F.wave * 1024), 16, tok << 12, cg * 16, 0, 0);
            __builtin_amdgcn_raw_ptr_buffer_load_lds(rsC, (LAS unsigned*)(F.lds + U2_SF + F.wave * 256), 4, tok << 2, 0, 0, 0);
            U2_FENCE();
            U2_ISSUE(R1, S0, 1); U2_FOLD(R0, S0, 0);
            U2_ISSUE(R0, S1, 0); U2_FOLD(R1, S0, 1); U2_LOAD(S0, tokn, 0);
            U2_ISSUE(R1, S1, 1); U2_FOLD(R0, S1, 0);
            U2_ISSUE(R0, S2, 0); U2_FOLD(R1, S1, 1); U2_LOAD(S1, tokn, 1);
            U2_ISSUE(R1, S2, 1); U2_FOLD(R0, S2, 0);
            U2_ISSUE(R0, S3, 0); U2_FOLD(R1, S2, 1); U2_LOAD(S2, tokn, 2);
            U2_ISSUE(R1, S3, 1); U2_FOLD(R0, S3, 0);
            U2_ISSUE(R0, S0, 0); U2_FOLD(R1, S3, 1); U2_LOAD(S3, tokn, 3);
            asm volatile("s_waitcnt vmcnt(48)" ::: "memory");
            const u32x4 xo = *(const LAS u32x4*)(F.lds + U2_XO + F.wave * 1024 + lane_ * 16); const float sf = *(const LAS float*)(F.lds + U2_SF + F.wave * 256 + lane_ * 4);
            f32x4 v0 = {bflo(xo.x), bfhi(xo.x), bflo(xo.y), bfhi(xo.y)}, v1 = {bflo(xo.z), bfhi(xo.z), bflo(xo.w), bfhi(xo.w)};
            v0[0] += sf * (float)acc[0]; v0[1] += sf * (float)acc[1]; v0[2] += sf * (float)acc[2]; v0[3] += sf * (float)acc[3]; v1[0] += sf * (float)acc[4]; v1[1] += sf * (float)acc[5]; v1[2] += sf * (float)acc[6]; v1[3] += sf * (float)acc[7];
            float* dp = ob_ + (size_t)((tok & tmask_) * DM) + cg * 8; *(f32x4*)dp = v0; *(f32x4*)(dp + 4) = v1; U2_FENCE(); }
        LDS_WAIT();
#undef U2_ISSUE
#undef U2_FOLD
#undef U2_FENCE
#undef U2_LOAD
    }
}
#undef PU_T4


#ifdef VALU_PROBE
__device__ __forceinline__ void valu_probe(const Frame& F) {
    unsigned a[16];
#pragma unroll
    for (int j = 0; j < 16; ++j) a[j] = F.tid * 17u + j * 0x01010101u;
    unsigned b = F.tid * 3u + 0x05040100u, c = 0x3c003c00u ^ F.tid;
#pragma unroll 1
    for (int it = 0; it < 1024; ++it) {
#pragma unroll
        for (int r = 0; r < 4; ++r) {
#pragma unroll
            for (int j = 0; j < 16; ++j) {
#if VALU_PROBE == 0
                asm volatile("v_add_u32 %0, %0, %1" : "+v"(a[j]) : "v"(b));
#elif VALU_PROBE == 1
                asm volatile("v_perm_b32 %0, %0, %1, %2" : "+v"(a[j]) : "v"(b), "v"(c));
#elif VALU_PROBE == 2
                asm volatile("v_dot4c_i32_i8 %0, %1, %2" : "+v"(a[j]) : "v"(b), "v"(c));
#elif VALU_PROBE == 3
                asm volatile("v_mad_u32_u16 %0, %1, %2, %0 op_sel:[1,0,0,0]" : "+v"(a[j]) : "v"(b), "v"(c));
#elif VALU_PROBE == 4
                asm volatile("v_and_b32 %0, %0, %1" : "+v"(a[j]) : "v"(b));
#elif VALU_PROBE == 5
                asm volatile("v_lshl_add_u32 %0, %0, 3, %1" : "+v"(a[j]) : "v"(b));
#elif VALU_PROBE == 6
                asm volatile("v_bfe_u32 %0, %0, 3, 14" : "+v"(a[j]));
#elif VALU_PROBE == 7
                asm volatile("v_dot4_i32_i8 %0, %1, %2, %0" : "+v"(a[j]) : "v"(b), "v"(c));
#endif
            } } }
    unsigned s = 0;
#pragma unroll
    for (int j = 0; j < 16; ++j) s ^= a[j];
    ((unsigned*)(F.wsb + WS_PART))[(size_t)F.vcu * 512 + F.tid] = s;
}
#endif

#define XB_TMO      128
#define XB_XCNT(j)  (256  + 64 * (j))
#define XB_XSUB(j)  (1280 + 64 * (j))
#define XB_XGEN(j)  (2304 + 64 * (j))
#define XB_TOP      3328
#define XB_TOPGEN   3392
#define XCD_BAR_WORDS 3456
#define XB_SPIN_CAP (1u << 18)

__device__ __forceinline__ unsigned xb_ld(unsigned* p)              { return __hip_atomic_load(p, __ATOMIC_RELAXED, __HIP_MEMORY_SCOPE_AGENT); }
__device__ __forceinline__ unsigned xb_add(unsigned* p, unsigned v) { return __hip_atomic_fetch_add(p, v, __ATOMIC_RELAXED, __HIP_MEMORY_SCOPE_AGENT); }
__device__ __forceinline__ unsigned xb_xcc_id() { return (unsigned)__builtin_amdgcn_s_getreg((3 << 11) | 20) & 0xFu; }
#define XB_SPIN(cond, bar) do { unsigned _sp = 0; while (cond) { __builtin_amdgcn_s_sleep(1); \
    if ((++_sp & 255u) == 0u) { if (xb_ld(&(bar)[XB_TMO])) break; if (_sp > XB_SPIN_CAP) { atomicAdd(&(bar)[XB_TMO], 1u); break; } } } } while (0)

struct XcdBarrier {
    unsigned* bar; unsigned x;
    volatile LAS unsigned* st;
};

__device__ __forceinline__ XcdBarrier xcd_barrier_post(unsigned* bar, volatile LAS unsigned* st) {
    XcdBarrier b; b.bar = bar; b.x = xb_xcc_id(); b.st = st;
    if (threadIdx.x == 0) (void)xb_add(&bar[XB_XCNT(b.x)], 1u);
    return b;
}
__device__ __forceinline__ void xcd_barrier_complete(unsigned* bar, unsigned x, unsigned& nloc, unsigned& nx) {
    const unsigned G = gridDim.x * gridDim.y * gridDim.z;
    unsigned sum, cnt, mine, sp = 0u;
    for (;;) {
        sum = 0u; cnt = 0u; mine = 0u;
#pragma unroll
        for (unsigned j = 0; j < 16; ++j) { const unsigned c = xb_ld(&bar[XB_XCNT(j)]); sum += c; cnt += (c > 0u) ? 1u : 0u; mine = (j == x) ? c : mine; }
        if (sum == G) break;
        __builtin_amdgcn_s_sleep(1);
        if ((++sp & 255u) == 0u) { if (xb_ld(&bar[XB_TMO])) break; if (sp > XB_SPIN_CAP) { atomicAdd(&bar[XB_TMO], 1u); break; } }
    }
    nloc = mine > 0u ? mine : 1u; nx = cnt > 0u ? cnt : 1u;
}

__device__ __forceinline__ void xcd_barrier(const XcdBarrier& b) {
    asm volatile("s_waitcnt vmcnt(0)" ::: "memory");
    __syncthreads();
    if (threadIdx.x == 0) {
        unsigned* bar = b.bar;
        __builtin_amdgcn_s_waitcnt(0);
        unsigned nloc = b.st[0], nx = b.st[1];
        if (nloc == 0u) { xcd_barrier_complete(bar, b.x, nloc, nx); b.st[0] = nloc; b.st[1] = nx; }
        const unsigned old = xb_add(&bar[XB_XSUB(b.x)], 1u);
        const unsigned gen = old / nloc;
        if (old + 1u == (gen + 1u) * nloc) {
            __builtin_amdgcn_fence(__ATOMIC_RELEASE, "agent");
            asm volatile("s_waitcnt vmcnt(0)" ::: "memory");
            const unsigned og = xb_add(&bar[XB_TOP], 1u);
            const unsigned tg = og / nx;
            if (og + 1u == (tg + 1u) * nx) xb_add(&bar[XB_TOPGEN], 1u);
            else XB_SPIN(xb_ld(&bar[XB_TOPGEN]) == tg, bar);
            __builtin_amdgcn_fence(__ATOMIC_ACQUIRE, "agent");
            xb_add(&bar[XB_XGEN(b.x)], 1u);
            asm volatile("s_waitcnt vmcnt(0)" ::: "memory");
        } else {
            XB_SPIN(xb_ld(&bar[XB_XGEN(b.x)]) == gen, bar);
            __builtin_amdgcn_fence(__ATOMIC_ACQUIRE, "agent");
            asm volatile("s_waitcnt vmcnt(0)" ::: "memory");
        }
    }
    __syncthreads();
}

struct Args { const float* in[16]; float* out; unsigned char* ws; int ph_lo, ph_hi, coop, pad; };
__global__ void __launch_bounds__(512, 2) fwd_kernel(Args args) {
    extern __shared__ __attribute__((aligned(16))) unsigned char lds_raw[];
    Frame F;
    F.lds = (LAS unsigned char*)lds_raw; F.ldsg = (char*)lds_raw;
    F.tid = threadIdx.x; F.lane = F.tid & 63; F.wave = __builtin_amdgcn_readfirstlane(F.tid >> 6);
    F.G = gridDim.x; { const int bx = blockIdx.x; F.vcu = (F.G % 8 == 0) ? (bx % 8) * (F.G / 8) + bx / 8 : bx; }
    F.x = args.in[0]; F.norm1_g = args.in[1]; F.w_in = args.in[2]; F.up_f = args.in[3]; F.bias_f = args.in[4]; F.up_b = args.in[5]; F.bias_b = args.in[6]; F.out_g = args.in[7];
    F.qn_g = args.in[8]; F.kn_g = args.in[9]; F.w_out = args.in[10]; F.norm2_g = args.in[11]; F.w_query = args.in[12]; F.sub_keys = args.in[13]; F.peer_down = args.in[14]; F.peer_up = args.in[15];
    F.out = args.out; unsigned char* ws = args.ws; F.wsb = ws;
    constexpr int MISC_OFF = 131072 + 320;
    for (int u = F.tid; u < 64; u += 512) ((LAS unsigned*)(F.lds + MISC_OFF))[u] = 0u;
    __syncthreads();
    XcdBarrier bar = xcd_barrier_post((unsigned*)(ws + WS_CTL) + 8192, (volatile LAS unsigned*)(F.lds + MISC_OFF) + 8);
    const int lo = args.ph_lo, hi = args.ph_hi;
#ifndef PH_MASK
#define PH_MASK 0x7ff
#endif
#ifndef PROBE_PHASE
#define PROBE_PHASE -1
#endif
#define REP(k) for (int rep_ = 0; rep_ < ((PROBE_PHASE == (k)) ? 2 : 1); ++rep_)
#define IN(k) (((PH_MASK >> (k)) & 1) && lo <= (k) && (k) < hi)
#define SEAM(k) do { if (IN(k) && IN((k) + 1)) { if (args.coop) { if ((k) == 0) cg::this_grid().sync(); else xcd_barrier(bar); } } } while (0)
    if (IN(0)) { REP(0) phase0(F); } SEAM(0);
#define GEMM1_BODY { pg8::Gemm g{(const pg8::bf16_t*)F.xq1_(), (const pg8::bf16_t*)F.Win8_(), T, HP, DM / 2}; pg8::StaticOrder S; S.init(T, HP, F.G, (int)blockIdx.x); \
        pg8::EpiI8Qk E{F.h_(), HP, F.rs1_(), F.sw_(), F.qn_g, F.kn_g, (LAS float*)(F.lds + 131072 + 1024), C_QD / 256, C_KD / 256, C_VD / 256, SEQ - 1, QSCALE}; \
        pg8::gemm_phase<pg8::EpiI8Qk, pg8::StaticOrder, PG8_ALIGN, PG8_SP2, true>(F.lds, g, S, E); }
    if (IN(1)) { wq_quant_transpose(F); GEMM1_BODY; if (PROBE_PHASE == 1) GEMM1_BODY; } SEAM(1);
    if (IN(2)) { REP(2) for (int it = F.vcu; it < 2048; it += F.G) gla_passA(F, it); } SEAM(2);
    if (IN(3)) { for (int it = F.vcu; it < 256; it += F.G) gla_scan(F, it); REP(3) attn_phase(F); } SEAM(3);
    if (IN(4)) REP(4) { for (int it = F.vcu; it < 2048; it += F.G) gla_passC(F, it); dil_combine(F); } SEAM(4);
#define GEMM5_BODY { pg8::Gemm g{F.mixed_(), F.WoT_(), T, DM, DM}; pg8::StaticOrder S; S.init(T, DM, F.G, (int)blockIdx.x); pg8::EpiResid E{F.x, F.out, F.x1b_(), F.ssp_(), DM, F.sx_(), F.xq6_()}; \
        pg8::gemm_phase<pg8::EpiResid, pg8::StaticOrder, PG8_ALIGN, PG8_SP2>(F.lds, g, S, E); }
#define GEMM6_BODY { pg8::Gemm g{(const pg8::bf16_t*)F.xq6_(), (const pg8::bf16_t*)F.Wq8_(), T, DM, DM / 2}; pg8::StaticOrder S; S.init(T, DM, F.G, (int)blockIdx.x); \
        pg8::EpiI8Qk E{F.qry_(), DM, F.sx_(), F.swq_(), nullptr, nullptr, (LAS float*)(F.lds + 131072 + 1024), 0, 0, 0, 0, 0.f}; \
        pg8::gemm_phase<pg8::EpiI8Qk, pg8::StaticOrder, PG8_ALIGN, PG8_SP2, true>(F.lds, g, S, E); }
    if (IN(5)) { GEMM5_BODY; if (PROBE_PHASE == 5) GEMM5_BODY; } SEAM(5);
    if (IN(6)) { GEMM6_BODY; if (PROBE_PHASE == 6) GEMM6_BODY; } SEAM(6);
    if (IN(7)) REP(7) { const int gw = F.vcu * 8 + F.wave, NGW = F.G * 8; for (int u = F.vcu; u < 256; u += F.G) { const int hh = u & 7, chunk = u >> 3;
            __syncthreads();
            for (int i = F.tid; i < 4096; i += 512) { const int row = i >> 4, ch = i & 15; *(LAS u32x4*)(F.lds + TK_KEYS + KSWZ(row, ch * 16)) = *(const u32x4*)(F.SK_() + ((size_t)hh * 256 + row) * 128 + ch * 8); }
            __syncthreads();
            for (int j = 0; j < 4; ++j) topk_item(F, hh, chunk * 32 + F.wave * 4 + j); }
    } SEAM(7);
    if (IN(8)) { if (PROBE_PHASE == 8) peer_down(F, 3072); peer_down(F); } SEAM(8);
    if (IN(9)) { REP(9) peer_coef_probe(F, (PROBE_PHASE == 9) && rep_ == 0); } SEAM(9);
    if (IN(10)) peer_up(F);
#ifdef VALU_PROBE
    valu_probe(F);
#endif
#undef IN
#undef SEAM
}

#ifndef MK_N_LAUNCHES
#define MK_N_LAUNCHES 1
#endif
extern "C" void kernel_launch(void* const* d_in, const int* in_sizes, int n_in, void* d_out, int out_size, void* d_ws, size_t ws_size, hipStream_t stream) {
    static int grid = 0;
    if (grid == 0) {
        if (n_in != 16 || in_sizes[0] != T * DM || out_size != T * DM || ws_size < WS_END) { fprintf(stderr, "kernel_launch: unexpected shapes (n_in %d, in0 %d, out %d, ws %zu)\n", n_in, n_in > 0 ? in_sizes[0] : -1, out_size, ws_size); grid = -1; return; }
        int dev = 0, cus = 0, per_cu = 0;
        if (hipGetDevice(&dev) != hipSuccess || hipDeviceGetAttribute(&cus, hipDeviceAttributeMultiprocessorCount, dev) != hipSuccess) { grid = -1; return; }
        if (hipFuncSetAttribute((const void*)fwd_kernel, hipFuncAttributeMaxDynamicSharedMemorySize, LDS_BYTES) != hipSuccess) { fprintf(stderr, "kernel_launch: hipFuncSetAttribute failed\n"); grid = -1; return; }
        if (hipOccupancyMaxActiveBlocksPerMultiprocessor(&per_cu, (const void*)fwd_kernel, 512, LDS_BYTES) != hipSuccess || per_cu < 1) { fprintf(stderr, "kernel_launch: occupancy query says %d\n", per_cu); per_cu = 1; }
        (void)hipGetLastError();
        grid = cus;
    }
    if (grid < 0) return;
    if (hipMemsetAsync(d_ws, 0, 65536, stream) != hipSuccess) { fprintf(stderr, "kernel_launch: hipMemsetAsync failed\n"); return; }
    Args a{};
    for (int i = 0; i < 16; ++i) a.in[i] = (const float*)d_in[i];
    a.out = (float*)d_out; a.ws = (unsigned char*)d_ws;
    if (MK_N_LAUNCHES == 1) {
        a.ph_lo = 0; a.ph_hi = NPHASE; a.coop = 1; void* kargs[] = {&a};
        hipError_t e = hipLaunchCooperativeKernel((const void*)fwd_kernel, dim3(grid), dim3(512), kargs, LDS_BYTES, stream);
        if (e != hipSuccess) fprintf(stderr, "kernel_launch: cooperative launch failed: %s (grid %d)\n", hipGetErrorString(e), grid);
    } else {
        for (int p = 0; p < NPHASE; ++p) { a.ph_lo = p; a.ph_hi = p + 1; a.coop = 0; hipLaunchKernelGGL(fwd_kernel, dim3(grid), dim3(512), LDS_BYTES, stream, a); }
        const hipError_t le = hipPeekAtLastError(); if (le != hipSuccess) fprintf(stderr, "kernel_launch: launch failed: %s\n", hipGetErrorName(le));
    }
}
```

```cpp
#include <hip/hip_runtime.h>
#include <hip/hip_cooperative_groups.h>
#include <cstdio>
#include <cstdint>
namespace cg = cooperative_groups;
namespace pg8 {
#define PG8_LAS __attribute__((address_space(3)))
typedef unsigned short bf16_t;
typedef short bf16x8 __attribute__((ext_vector_type(8)));
typedef float f32x4 __attribute__((ext_vector_type(4)));
typedef unsigned u32x4 __attribute__((ext_vector_type(4)));
constexpr int BM = 256, BK = 64, HALF = 128, HTB = HALF * BK * 2  , STAGE_BYTES = 8 * HTB, NXCD = 8, WGM = 8;

__host__ __device__ __forceinline__ int lds_byte(int r, int c) { const int st = (r >> 4) * 2 + (c >> 5), rr = r & 15, cc = c & 31, ob = rr * 64 + cc * 2; return st * 1024 + (ob ^ (((ob >> 9) & 1) << 5)); }
__host__ __device__ __forceinline__ void stage_rc(int b, int& R, int& C) { const int st = b / 1024, sb = b % 1024, swz = sb ^ (((sb >> 9) & 1) << 5); R = (st >> 1) * 16 + swz / 64; C = (st & 1) * 32 + (swz % 64) / 2; }
__host__ __device__ __forceinline__ int perm32(int rho) { const int n = rho >> 4, i = rho & 15; return 8 * (i >> 2) + 4 * n + (i & 3); }

struct Unit { int pm, pn; };
struct Gemm { const bf16_t* A; const bf16_t* Bt; int M, N, K; };

struct StaticOrder {
    int nM, nN, nwg, G, c;
    __host__ __device__ void init(int M, int N, int G_, int c_) { nM = M / BM; nN = N / BM; nwg = nM * nN; G = G_; c = c_; }
    __host__ __device__ bool next(int i, Unit& u) const {
        const long L = (long)i * G + c; if (L >= nwg) return false;
        int wgid = (int)L; { const int q = nwg / NXCD, r = nwg % NXCD, xcd = wgid % NXCD, off = wgid / NXCD; wgid = (xcd < r ? xcd * (q + 1) : r * (q + 1) + (xcd - r) * q) + off; }
        const int nig = WGM * nN, gid = wgid / nig, fm = gid * WGM, gsz = (nM - fm) < WGM ? (nM - fm) : WGM;
        u.pm = fm + ((wgid % nig) % gsz); u.pn = (wgid % nig) / gsz; return true;
    }
    __device__ __forceinline__ void a_ready(const Unit&) const {}
    __device__ __forceinline__ void done(const Unit&) const {}
};
__device__ __forceinline__ unsigned cvt_pk_bf16(float lo, float hi) { unsigned r; asm volatile("v_cvt_pk_bf16_f32 %0, %1, %2" : "=v"(r) : "v"(lo), "v"(hi)); return r; }
typedef int i32x4 __attribute__((ext_vector_type(4)));
template <bool I8> struct AccT { typedef f32x4 type; };
template <> struct AccT<true> { typedef i32x4 type; };
struct EpiRowScaleBf16 {
    static constexpr bool PERM = true, AFTER_DRAIN = false;
    bf16_t* O; int ldc; const float* rs;
    __device__ __forceinline__ void operator()(const f32x4 (&acc)[2][2][4][2], const Unit& u, int wr, int wc, int fr, int fq) const {
        const int row0 = u.pm * BM + wr * 64 + fr, col0 = u.pn * BM + wc * 32 + 8 * fq;
#pragma unroll
        for (int ai = 0; ai < 2; ++ai)
#pragma unroll
            for (int m = 0; m < 4; ++m) { const int row = row0 + ai * HALF + m * 16; const float s = rs ? rs[row] : 1.f; bf16_t* rowp = O + (size_t)row * ldc + col0;
#pragma unroll
                for (int bj = 0; bj < 2; ++bj) { const f32x4 v0 = acc[ai][bj][m][0] * s, v1 = acc[ai][bj][m][1] * s;
                    u32x4 w; w.x = cvt_pk_bf16(v0[0], v0[1]); w.y = cvt_pk_bf16(v0[2], v0[3]); w.z = cvt_pk_bf16(v1[0], v1[1]); w.w = cvt_pk_bf16(v1[2], v1[3]);
                    *(u32x4*)(rowp + bj * HALF) = w; } }
    }
};
struct EpiI8Qk {
    static constexpr bool PERM = true, AFTER_DRAIN = false;
    bf16_t* O; int ldc; const float* rs; const float* cs; const float* qg; const float* kg; PG8_LAS float* P; int qk_lo, q_hi, qk_hi, seqmask; float qscale;
    __device__ __forceinline__ void operator()(const i32x4 (&acc)[2][2][4][2], const Unit& u, int wr, int wc, int fr, int fq) const {
        const int row0 = u.pm * BM + wr * 64 + fr, col0 = u.pn * BM + wc * 32 + 8 * fq;
        f32x4 cv[2][2];
#pragma unroll
        for (int bj = 0; bj < 2; ++bj) { cv[bj][0] = *(const f32x4*)(cs + col0 + bj * HALF); cv[bj][1] = *(const f32x4*)(cs + col0 + bj * HALF + 4); }
        const bool qk = u.pn >= qk_lo && u.pn < qk_hi;
        float rq[2][4][2];
        if (qk) {
#pragma unroll
            for (int ai = 0; ai < 2; ++ai)
#pragma unroll
                for (int m = 0; m < 4; ++m) { const float s = rs[row0 + ai * HALF + m * 16]; const int rl = ai * HALF + wr * 64 + m * 16 + fr;
#pragma unroll
                    for (int bj = 0; bj < 2; ++bj) { const i32x4 a0 = acc[ai][bj][m][0], a1 = acc[ai][bj][m][1]; const f32x4 c0 = cv[bj][0] * s, c1 = cv[bj][1] * s; float ss = 0.f;
#pragma unroll
                        for (int i = 0; i < 4; ++i) { const float x0 = (float)a0[i] * c0[i], x1 = (float)a1[i] * c1[i]; ss += x0 * x0 + x1 * x1; }
                        ss += __shfl_xor(ss, 16); ss += __shfl_xor(ss, 32);
                        if (fq == 0) P[rl * 8 + bj * 4 + wc] = ss; } }
            asm volatile("s_waitcnt lgkmcnt(0)" ::: "memory"); __builtin_amdgcn_s_barrier(); asm volatile("" ::: "memory");
#pragma unroll
            for (int ai = 0; ai < 2; ++ai)
#pragma unroll
                for (int m = 0; m < 4; ++m) { const int rl = ai * HALF + wr * 64 + m * 16 + fr;
#pragma unroll
                    for (int bj = 0; bj < 2; ++bj) { const f32x4 p = *(const PG8_LAS f32x4*)(P + rl * 8 + bj * 4); rq[ai][m][bj] = __builtin_amdgcn_rsqf(((p[0] + p[1]) + (p[2] + p[3])) * (1.f / 128.f) + 1e-6f); } }
        }
        const bool isq = u.pn < q_hi; const float* gp = (isq ? qg : kg) + wc * 32 + 8 * fq; f32x4 g0 = {1.f, 1.f, 1.f, 1.f}, g1 = g0;
        if (qk) { g0 = *(const f32x4*)gp; g1 = *(const f32x4*)(gp + 4); if (isq) { g0 = g0 * qscale; g1 = g1 * qscale; } }
        constexpr float RV[16] = {1.591549431e-01f, 7.008652159e-02f, 3.086376340e-02f, 1.359137064e-02f, 5.985185713e-03f, 2.635675899e-03f, 1.160663641e-03f, 5.111175045e-04f, 2.250790790e-04f, 9.911730937e-05f, 4.364795279e-05f, 1.922110068e-05f, 8.464330808e-06f, 3.727408602e-06f, 1.641426263e-06f, 7.228293069e-07f};
#pragma unroll
        for (int ai = 0; ai < 2; ++ai)
#pragma unroll
            for (int m = 0; m < 4; ++m) { const int row = row0 + ai * HALF + m * 16; const float s = rs[row]; bf16_t* rowp = O + (size_t)row * ldc + col0;
                float cs8[8], sn8[8];
                if (qk && wc == 0) { const float pos = (float)(row & seqmask);
#pragma unroll
                    for (int e8 = 0; e8 < 8; ++e8) { const float rev = pos * ((fq & 1) ? RV[8 + e8] : RV[e8]); const float fr_ = rev - __builtin_floorf(rev); cs8[e8] = __builtin_amdgcn_cosf(fr_); sn8[e8] = __builtin_amdgcn_sinf(fr_); } }
#pragma unroll
                for (int bj = 0; bj < 2; ++bj) { const i32x4 a0 = acc[ai][bj][m][0], a1 = acc[ai][bj][m][1]; const float sq = qk ? s * rq[ai][m][bj] : s; const f32x4 c0 = cv[bj][0] * sq * g0, c1 = cv[bj][1] * sq * g1;
                    float v[8];
#pragma unroll
                    for (int i = 0; i < 4; ++i) { v[i] = (float)a0[i] * c0[i]; v[4 + i] = (float)a1[i] * c1[i]; }
                    if (qk && wc == 0) {
#pragma unroll
                        for (int e8 = 0; e8 < 8; ++e8) { const float pr = __shfl_xor(v[e8], 32); v[e8] = (fq < 2) ? (v[e8] * cs8[e8] - pr * sn8[e8]) : (v[e8] * cs8[e8] + pr * sn8[e8]); } }
                    u32x4 w; w.x = cvt_pk_bf16(v[0], v[1]); w.y = cvt_pk_bf16(v[2], v[3]); w.z = cvt_pk_bf16(v[4], v[5]); w.w = cvt_pk_bf16(v[6], v[7]);
                    *(u32x4*)(rowp + bj * HALF) = w; } }
    }
};
__device__ __forceinline__ unsigned epi_pack8(const f32x4 v, float inv) { unsigned w = 0u;
#pragma unroll
    for (int i = 0; i < 4; ++i) { const int qv = (int)fminf(fmaxf(rintf(v[i] * inv), -119.f), 119.f); w |= ((unsigned)qv & 0xffu) << (8 * i); }
    return w; }
__device__ __forceinline__ unsigned epi_add8(unsigned q) { return ((q & 0x7f7f7f7fu) + 0x08080808u) ^ (q & 0x80808080u); }
__device__ __forceinline__ unsigned epi_nib(unsigned a, unsigned b) { return (a & 0x0F0F0F0Fu) | ((b & 0x0F0F0F0Fu) << 4); }
struct EpiResid {
    static constexpr bool PERM = true, AFTER_DRAIN = false;
    const float* x; float* out; bf16_t* xb; float* ssp; int ldc; const float* sx; unsigned char* xq;
    __device__ __forceinline__ void operator()(const f32x4 (&acc)[2][2][4][2], const Unit& u, int wr, int wc, int fr, int fq) const {
        const int row0 = u.pm * BM + wr * 64 + fr, col0 = u.pn * BM + wc * 32 + 8 * fq;
#pragma unroll
        for (int ai = 0; ai < 2; ++ai)
#pragma unroll
            for (int m = 0; m < 4; ++m) { const int row = row0 + ai * HALF + m * 16; const size_t off = (size_t)row * ldc + col0; float ss = 0.f; const float sxr = sx[row], inv = sxr > 0.f ? 1.f / sxr : 0.f;
#pragma unroll
                for (int bj = 0; bj < 2; ++bj) { const f32x4 xa = *(const f32x4*)(x + off + bj * HALF), xc = *(const f32x4*)(x + off + bj * HALF + 4);
                    const f32x4 v0 = acc[ai][bj][m][0] + xa, v1 = acc[ai][bj][m][1] + xc;
                    u32x4 w; w.x = cvt_pk_bf16(v0[0], v0[1]); w.y = cvt_pk_bf16(v0[2], v0[3]); w.z = cvt_pk_bf16(v1[0], v1[1]); w.w = cvt_pk_bf16(v1[2], v1[3]);
                    *(u32x4*)(xb + off + bj * HALF) = w;
                    const unsigned qa = epi_pack8(v0, inv), qb = epi_pack8(v1, inv);
                    { typedef unsigned u32x2e __attribute__((ext_vector_type(2))); *(u32x2e*)(xq + off + bj * HALF) = (u32x2e){qa, qb}; }
                    ss += (v0[0] * v0[0] + v0[1] * v0[1]) + (v0[2] * v0[2] + v0[3] * v0[3]) + (v1[0] * v1[0] + v1[1] * v1[1]) + (v1[2] * v1[2] + v1[3] * v1[3]); }
                ss += __shfl_xor(ss, 16); ss += __shfl_xor(ss, 32);
                if (fq == 0) ssp[(size_t)row * 32 + u.pn * 4 + wc] = ss; }
    }
};
template <class Epi, class Sched, bool ALIGN_EPI = false, bool SP2 = false, bool I8 = false>
__device__ __forceinline__ void gemm_phase(PG8_LAS unsigned char* lds, const Gemm g, const Sched& S, const Epi& E) {
    const int tid = threadIdx.x, wid = __builtin_amdgcn_readfirstlane(tid >> 6), lane = tid & 63, wr = wid >> 2, wc = wid & 3, fr = lane & 15, fq = lane >> 4;
    const int K = g.K, nt = K / BK;
    unsigned voffA[2], voffB[2];
#pragma unroll
    for (int i = 0; i < 2; ++i) { int R, C; stage_rc(tid * 16 + i * 8192, R, C); const int Rb = Epi::PERM ? ((R & ~31) + perm32(R & 31)) : R;
        voffA[i] = (unsigned)(R * K + C) * 2u; voffB[i] = (unsigned)(Rb * K + C) * 2u; }
    const size_t kstep = (size_t)(BK * 2);
    const size_t hstep = (size_t)HALF * K * 2;
    const size_t tstep = 2 * hstep;
    const unsigned ldsw = (unsigned)wid * 1024u;
    const int aoff = lds_byte(wr * 64 + fr, fq * 8), boff = lds_byte(wc * 32 + fr, fq * 8);
#define PG8_SA(b, h) (((b) * 2 + (h)) * HTB)
#define PG8_SB(b, h) ((4 + (b) * 2 + (h)) * HTB)
#define PG8_STAGE(bufoff, gbase, voff) do { _Pragma("unroll") for (int _i = 0; _i < 2; ++_i) \
        __builtin_amdgcn_global_load_lds((const unsigned*)((const char*)(gbase) + (voff)[_i]), (PG8_LAS unsigned*)(lds + (bufoff) + ldsw + _i * 8192), 16, 0, 0); } while (0)
#define PG8_LDA(dst, b, h) do { _Pragma("unroll") for (int m = 0; m < 4; ++m) _Pragma("unroll") for (int k = 0; k < 2; ++k) dst[m][k] = *(const PG8_LAS bf16x8*)(lds + PG8_SA(b, h) + aoff + m * 2048 + k * 1024); } while (0)
#define PG8_LDB(dst, b, h) do { _Pragma("unroll") for (int n = 0; n < 2; ++n) _Pragma("unroll") for (int k = 0; k < 2; ++k) dst[n][k] = *(const PG8_LAS bf16x8*)(lds + PG8_SB(b, h) + boff + n * 2048 + k * 1024); } while (0)
#define PG8_MMA(ai, bj, At, Bt) do { __builtin_amdgcn_s_setprio(1); _Pragma("unroll") for (int m = 0; m < 4; ++m) _Pragma("unroll") for (int n = 0; n < 2; ++n) _Pragma("unroll") for (int k = 0; k < 2; ++k) { \
        if constexpr (I8) acc[ai][bj][m][n] = __builtin_amdgcn_mfma_i32_16x16x64_i8(__builtin_bit_cast(i32x4, Bt[n][k]), __builtin_bit_cast(i32x4, At[m][k]), acc[ai][bj][m][n], 0, 0, 0); \
        else acc[ai][bj][m][n] = __builtin_amdgcn_mfma_f32_16x16x32_bf16(Bt[n][k], At[m][k], acc[ai][bj][m][n], 0, 0, 0); } __builtin_amdgcn_s_setprio(0); } while (0)
#define PG8_WAIT_V(n) asm volatile("s_waitcnt vmcnt(" #n ")" ::: "memory")
#define PG8_WAIT_L(n) asm volatile("s_waitcnt lgkmcnt(" #n ")" ::: "memory")
#define PG8_BAR __builtin_amdgcn_s_barrier()
#define PG8_SCHED __builtin_amdgcn_sched_barrier(0)
    Unit cur, nxt; int ui = 0;
    if (!S.next(0, cur)) return;
    typename AccT<I8>::type acc[2][2][4][2];
#pragma unroll
    for (int a = 0; a < 2; ++a)
#pragma unroll
        for (int b = 0; b < 2; ++b)
#pragma unroll
            for (int m = 0; m < 4; ++m)
#pragma unroll
                for (int n = 0; n < 2; ++n) acc[a][b][m][n] = (typename AccT<I8>::type){};
    bf16x8 At[4][2], B0[2][2], B1[2][2];
    const char* cA = (const char*)g.A + (size_t)cur.pm * tstep; const char* cB = (const char*)g.Bt + (size_t)cur.pn * tstep;
    S.a_ready(cur);
    if constexpr (SP2) {
        PG8_STAGE(PG8_SB(0, 0), cB, voffB); PG8_STAGE(PG8_SB(0, 1), cB + hstep, voffB); PG8_STAGE(PG8_SA(0, 0), cA, voffA); PG8_STAGE(PG8_SA(0, 1), cA + hstep, voffA);
        if (wr == 1) PG8_BAR;
        PG8_WAIT_V(2); PG8_BAR;
        PG8_STAGE(PG8_SB(1, 0), cB + kstep, voffB); PG8_STAGE(PG8_SA(1, 0), cA + kstep, voffA); PG8_STAGE(PG8_SB(1, 1), cB + hstep + kstep, voffB);
        PG8_WAIT_V(6); PG8_BAR;
    } else {
        PG8_STAGE(PG8_SB(0, 0), cB, voffB); PG8_STAGE(PG8_SA(0, 0), cA, voffA); PG8_STAGE(PG8_SB(0, 1), cB + hstep, voffB); PG8_STAGE(PG8_SA(0, 1), cA + hstep, voffA);
        if (wr == 1) PG8_BAR;
        PG8_WAIT_V(4); PG8_BAR;
        PG8_STAGE(PG8_SB(1, 0), cB + kstep, voffB); PG8_STAGE(PG8_SA(1, 0), cA + kstep, voffA); PG8_STAGE(PG8_SB(1, 1), cB + hstep + kstep, voffB);
        PG8_WAIT_V(6); PG8_BAR;
    }
    for (;;) {
        const bool has_next = S.next(ui + 1, nxt);
        const char* nA = has_next ? (const char*)g.A + (size_t)nxt.pm * tstep : cA; const char* nB = has_next ? (const char*)g.Bt + (size_t)nxt.pn * tstep : cB;
        for (int t = 0; t < nt; t += 2) {
            const bool last = (t == nt - 2);
            const char* a1 = cA + (size_t)(t + 1) * kstep;
            const char* a2 = last ? nA : cA + (size_t)(t + 2) * kstep; const char* b2 = last ? nB : cB + (size_t)(t + 2) * kstep;
            const char* a3 = a2 + kstep; const char* b3 = b2 + kstep;
            if (last && has_next) S.a_ready(nxt);
            if constexpr (SP2) {
            PG8_LDB(B0, 0, 0); PG8_LDB(B1, 0, 1); PG8_SCHED; PG8_LDA(At, 0, 0); PG8_STAGE(PG8_SA(1, 1), a1 + hstep, voffA);
            PG8_WAIT_V(8); PG8_WAIT_L(0); PG8_BAR; PG8_MMA(0, 0, At, B0); PG8_MMA(0, 1, At, B1); PG8_BAR; PG8_SCHED;
            PG8_LDA(At, 0, 1); PG8_STAGE(PG8_SB(0, 0), b2, voffB); PG8_STAGE(PG8_SB(0, 1), b2 + hstep, voffB); PG8_STAGE(PG8_SA(0, 0), a2, voffA);
            PG8_WAIT_V(8); PG8_WAIT_L(0); PG8_BAR; PG8_MMA(1, 0, At, B0); PG8_MMA(1, 1, At, B1); PG8_BAR; PG8_SCHED;
            PG8_LDB(B0, 1, 0); PG8_LDB(B1, 1, 1); PG8_SCHED; PG8_LDA(At, 1, 0); PG8_STAGE(PG8_SA(0, 1), a2 + hstep, voffA);
            PG8_WAIT_V(8); PG8_WAIT_L(0); PG8_BAR; PG8_MMA(0, 0, At, B0); PG8_MMA(0, 1, At, B1); PG8_BAR; PG8_SCHED;
            PG8_LDA(At, 1, 1); PG8_STAGE(PG8_SB(1, 0), b3, voffB); PG8_STAGE(PG8_SB(1, 1), b3 + hstep, voffB); PG8_STAGE(PG8_SA(1, 0), a3, voffA);
            PG8_WAIT_V(8); PG8_WAIT_L(0); PG8_BAR; PG8_MMA(1, 0, At, B0); PG8_MMA(1, 1, At, B1); PG8_BAR; PG8_SCHED;
            } else {
            PG8_LDB(B0, 0, 0); PG8_SCHED; PG8_LDA(At, 0, 0); PG8_STAGE(PG8_SA(1, 1), a1 + hstep, voffA);
            PG8_WAIT_L(8); PG8_BAR; PG8_WAIT_L(0); PG8_MMA(0, 0, At, B0); PG8_BAR; PG8_SCHED;
            PG8_LDB(B1, 0, 1); PG8_STAGE(PG8_SB(0, 0), b2, voffB);
            PG8_BAR; PG8_WAIT_L(0); PG8_MMA(0, 1, At, B1); PG8_BAR;
            PG8_LDA(At, 0, 1); PG8_STAGE(PG8_SA(0, 0), a2, voffA);
            PG8_BAR; PG8_WAIT_L(0); PG8_MMA(1, 0, At, B0); PG8_BAR; PG8_SCHED;
            PG8_STAGE(PG8_SB(0, 1), b2 + hstep, voffB);
            PG8_WAIT_V(6); PG8_BAR; PG8_MMA(1, 1, At, B1); PG8_BAR;
            PG8_LDB(B0, 1, 0); PG8_SCHED; PG8_LDA(At, 1, 0); PG8_STAGE(PG8_SA(0, 1), a2 + hstep, voffA);
            PG8_WAIT_L(8); PG8_BAR; PG8_WAIT_L(0); PG8_MMA(0, 0, At, B0); PG8_BAR; PG8_SCHED;
            PG8_LDB(B1, 1, 1); PG8_STAGE(PG8_SB(1, 0), b3, voffB);
            PG8_BAR; PG8_WAIT_L(0); PG8_MMA(0, 1, At, B1); PG8_BAR;
            PG8_LDA(At, 1, 1); PG8_STAGE(PG8_SA(1, 0), a3, voffA);
            PG8_BAR; PG8_WAIT_L(0); PG8_MMA(1, 0, At, B0); PG8_BAR; PG8_SCHED;
            PG8_STAGE(PG8_SB(1, 1), b3 + hstep, voffB);
            PG8_WAIT_V(6); PG8_BAR; PG8_MMA(1, 1, At, B1); PG8_BAR;
            }
        }
        if constexpr (ALIGN_EPI) { if (wr == 0) PG8_BAR; }
        if constexpr (!Epi::AFTER_DRAIN) { E(acc, cur, wr, wc, fr, fq); S.done(cur); }
        if (!has_next) break;
#pragma unroll
        for (int a = 0; a < 2; ++a)
#pragma unroll
            for (int b = 0; b < 2; ++b)
#pragma unroll
                for (int m = 0; m < 4; ++m)
#pragma unroll
                    for (int n = 0; n < 2; ++n) acc[a][b][m][n] = (typename AccT<I8>::type){};
        cur = nxt; cA = nA; cB = nB; ++ui;
        if constexpr (ALIGN_EPI) { if (wr == 1) PG8_BAR; }
    }
    PG8_WAIT_V(0);
    if constexpr (!ALIGN_EPI) { if (wr == 0) PG8_BAR; }
    PG8_BAR;
    if constexpr (Epi::AFTER_DRAIN) { E.fused(acc, cur, wr, wc, fr, fq, lds, wid, lane); S.done(cur); }
#undef PG8_SA
#undef PG8_SB
#undef PG8_STAGE
#undef PG8_LDA
#undef PG8_LDB
#undef PG8_MMA
#undef PG8_WAIT_V
#undef PG8_WAIT_L
#undef PG8_BAR
#undef PG8_SCHED
}
}
#ifndef PG8_SP2
#define PG8_SP2 true
#endif
#ifndef PG8_ALIGN
#define PG8_ALIGN true
#endif

constexpr int BATCH = 2, SEQ = 16384, DM = 2048, T = BATCH * SEQ;
constexpr int INW = 6176, HP = 6400;
constexpr int C_QA = 0, C_KA = 256, C_VA = 512, C_RA = 1024, C_QD = 1536, C_KD = 3072, C_VD = 4608, C_GF = 6144;
constexpr int NHD = 12;
constexpr float EPS = 1e-6f;
constexpr float LOG2E = 1.4426950408889634f;
constexpr float QSCALE = 0.08838834764831845f * LOG2E;
constexpr int NPHASE = 11;

constexpr size_t MiB = 1u << 20;
constexpr size_t WS_CTL = 0, WS_ROPE = 1 * MiB, WS_RS1 = 3 * MiB, WS_RS2 = 3 * MiB + 512 * 1024, WS_SSP = 4 * MiB, WS_WIN = 8 * MiB, WS_WO = 33 * MiB, WS_WQ = 41 * MiB,
                 WS_SK = 49 * MiB, WS_DEC = 50 * MiB, WS_LP = 51 * MiB, WS_IDX = 56 * MiB, WS_GATE = 72 * MiB, WS_DOWN = 88 * MiB, WS_UP = 152 * MiB, WS_XB = 216 * MiB,
                 WS_H = 344 * MiB, WS_X1B = WS_H, WS_QRY = WS_H + 128 * MiB, WS_OP1 = 744 * MiB, WS_OP2 = 840 * MiB, WS_PART = 472 * MiB  , WS_END = 984 * MiB;
constexpr size_t OUT_ST = 0, OUT_OP0 = 128 * MiB;
constexpr int LDS_BYTES = 147456;

#define LAS __attribute__((address_space(3)))
typedef unsigned short bf16_t;
typedef short bf16x8 __attribute__((ext_vector_type(8)));
typedef short s16x4 __attribute__((ext_vector_type(4)));
typedef float f32x4 __attribute__((ext_vector_type(4)));
typedef float f32x2 __attribute__((ext_vector_type(2)));
typedef float f32x16 __attribute__((ext_vector_type(16)));
typedef unsigned u32x4 __attribute__((ext_vector_type(4)));
typedef unsigned u32x2 __attribute__((ext_vector_type(2)));
#define LDS_WAIT() asm volatile("s_waitcnt lgkmcnt(0)" ::: "memory")
#define SBAR() __builtin_amdgcn_sched_barrier(0)

__device__ __forceinline__ float bf2f(unsigned short b) { return __uint_as_float(((unsigned)b) << 16); }
__device__ __forceinline__ float bflo(unsigned w) { return __uint_as_float(w << 16); }
__device__ __forceinline__ float bfhi(unsigned w) { return __uint_as_float(w & 0xffff0000u); }
__device__ __forceinline__ unsigned f2bf(float f) { unsigned u = __float_as_uint(f); return (u + 0x7fffu + ((u >> 16) & 1u)) >> 16; }
__device__ __forceinline__ unsigned pk2(float lo, float hi) { return pg8::cvt_pk_bf16(lo, hi); }
__device__ __forceinline__ float fexp(float x) { return __builtin_amdgcn_exp2f(x * LOG2E); }
__device__ __forceinline__ float flog(float x) { return __builtin_amdgcn_logf(x) * 0.6931471805599453f; }
__device__ __forceinline__ float wave_sum(float v) {
#pragma unroll
    for (int o = 1; o < 64; o <<= 1) v += __shfl_xor(v, o);
    return v;
}
__device__ __forceinline__ int crow(int r, int hi) { return (r & 3) + 8 * (r >> 2) + 4 * hi; }

struct Frame {
    LAS unsigned char* lds; char* ldsg; unsigned char* wsb;
    int tid, lane, wave, vcu, G;
    const float *x, *norm1_g, *w_in, *up_f, *bias_f, *up_b, *bias_b, *out_g, *qn_g, *kn_g, *w_out, *norm2_g, *w_query, *sub_keys, *peer_down, *peer_up;
    float* out;
    __device__ __forceinline__ f32x2* rope_() const { return (f32x2*)((f32x2*)(wsb + WS_ROPE)); }
    __device__ __forceinline__ float* rs1_() const { return (float*)((float*)(wsb + WS_RS1)); }
    __device__ __forceinline__ float* rs2_() const { return (float*)((float*)(wsb + WS_RS2)); }
    __device__ __forceinline__ float* ssp_() const { return (float*)((float*)(wsb + WS_SSP)); }
    __device__ __forceinline__ float* dec_() const { return (float*)((float*)(wsb + WS_DEC)); }
    __device__ __forceinline__ float* lp_() const { return (float*)((float*)(wsb + WS_LP)); }
    __device__ __forceinline__ float* gate_() const { return (float*)((float*)(wsb + WS_GATE)); }
    __device__ __forceinline__ short* part_() const { return (short*)(wsb + WS_PART); }
    __device__ __forceinline__ float* sd_() const { return (float*)((float*)(wsb + WS_CTL + 65536)); }
    __device__ __forceinline__ float* su_() const { return (float*)((float*)(wsb + WS_CTL + 131072)); }
    __device__ __forceinline__ float* sx_() const { return (float*)((float*)(wsb + WS_RS2 + 131072)); }
    __device__ __forceinline__ float* csum_() const { return (float*)((float*)(wsb + WS_RS2 + 262144)); }
    __device__ __forceinline__ unsigned char* down8_() const { return (unsigned char*)(wsb + WS_DOWN); }
    __device__ __forceinline__ unsigned char* up8_() const { return (unsigned char*)(wsb + WS_UP); }
    __device__ __forceinline__ unsigned char* xq8_() const { return (unsigned char*)(wsb + WS_OP2); }
    __device__ __forceinline__ unsigned char* fq8_() const { return (unsigned char*)(wsb + WS_XB + 64 * MiB); }
    __device__ __forceinline__ unsigned short* idxT_() const { return (unsigned short*)((unsigned short*)(wsb + WS_XB + 72 * MiB)); }
    __device__ __forceinline__ unsigned* fqT_() const { return (unsigned*)((unsigned*)(wsb + WS_XB + 80 * MiB)); }
    __device__ __forceinline__ unsigned short* idx_() const { return (unsigned short*)(wsb + WS_IDX); }
    __device__ __forceinline__ unsigned short* state_() const { return (unsigned short*)((unsigned short*)((unsigned char*)out + OUT_ST)); }
    __device__ __forceinline__ bf16_t* WinT_() const { return (bf16_t*)((bf16_t*)(wsb + WS_WIN)); }
    __device__ __forceinline__ unsigned char* Win8_() const { return (unsigned char*)(wsb + WS_WIN); }
    __device__ __forceinline__ unsigned char* xq1_() const { return (unsigned char*)(wsb + WS_OP1); }
    __device__ __forceinline__ float* sw_() const { return (float*)((float*)(wsb + WS_CTL + 196608)); }
    __device__ __forceinline__ unsigned* wqmax_() const { return (unsigned*)(wsb + WS_CTL) + 4608; }
    __device__ __forceinline__ float* swq_() const { return (float*)(wsb + WS_CTL + 229376); }
    __device__ __forceinline__ unsigned char* Wq8_() const { return (unsigned char*)(wsb + WS_WQ); }
    __device__ __forceinline__ unsigned char* xq6_() const { return (unsigned char*)(wsb + WS_OP1); }
    __device__ __forceinline__ bf16_t* WoT_() const { return (bf16_t*)((bf16_t*)(wsb + WS_WO)); }
    __device__ __forceinline__ bf16_t* WqT_() const { return (bf16_t*)((bf16_t*)(wsb + WS_WQ)); }
    __device__ __forceinline__ bf16_t* SK_() const { return (bf16_t*)((bf16_t*)(wsb + WS_SK)); }
    __device__ __forceinline__ bf16_t* down16_() const { return (bf16_t*)((bf16_t*)(wsb + WS_DOWN)); }
    __device__ __forceinline__ bf16_t* up16_() const { return (bf16_t*)((bf16_t*)(wsb + WS_UP)); }
    __device__ __forceinline__ bf16_t* xb_() const { return (bf16_t*)((bf16_t*)(wsb + WS_XB)); }
    __device__ __forceinline__ bf16_t* mixed_() const { return (bf16_t*)((bf16_t*)(wsb + WS_XB)); }
    __device__ __forceinline__ bf16_t* h_() const { return (bf16_t*)((bf16_t*)(wsb + WS_H)); }
    __device__ __forceinline__ bf16_t* x1b_() const { return (bf16_t*)((bf16_t*)(wsb + WS_X1B)); }
    __device__ __forceinline__ bf16_t* qry_() const { return (bf16_t*)((bf16_t*)(wsb + WS_QRY)); }
    __device__ __forceinline__ bf16_t* op0_() const { return (bf16_t*)((bf16_t*)((unsigned char*)out + OUT_OP0)); }
    __device__ __forceinline__ bf16_t* op1_() const { return (bf16_t*)((bf16_t*)(wsb + WS_OP1)); }
    __device__ __forceinline__ bf16_t* op2_() const { return (bf16_t*)((bf16_t*)(wsb + WS_OP2)); }
};

__device__ __forceinline__ void p0_transpose_item(const float* W, int K, int N, bf16_t* WT, int k0, int n0, int dst_row0, const float* g, LAS float* scr, int lane) {
#pragma unroll 8
    for (int i = 0; i < 32; ++i) { const int kk = 2 * i + (lane >> 5); float w = W[(size_t)(k0 + kk) * N + n0 + (lane & 31)]; if (g) w *= g[k0 + kk]; scr[kk * 33 + (lane & 31)] = w; }
    LDS_WAIT(); asm volatile("" ::: "memory");
    const int c = lane & 7;
#pragma unroll
    for (int j = 0; j < 4; ++j) { const int n = (lane >> 3) + 8 * j; const LAS float* s = scr + (8 * c) * 33 + n;
        u32x4 o; o.x = pk2(s[0 * 33], s[1 * 33]); o.y = pk2(s[2 * 33], s[3 * 33]); o.z = pk2(s[4 * 33], s[5 * 33]); o.w = pk2(s[6 * 33], s[7 * 33]);
        *(u32x4*)(WT + (size_t)(dst_row0 + n) * K + k0 + 8 * c) = o; }
    LDS_WAIT(); asm volatile("" ::: "memory");
}
__device__ __forceinline__ unsigned pack_nib(unsigned a, unsigned b) { return (a & 0x0F0F0F0Fu) | ((b & 0x0F0F0F0Fu) << 4); }
__device__ __forceinline__ unsigned pack_i8x4(const f32x4 v, float inv, float lim) { unsigned w = 0u;
#pragma unroll
    for (int i = 0; i < 4; ++i) { const int qv = (int)fminf(fmaxf(rintf(v[i] * inv), -lim), lim); w |= ((unsigned)qv & 0xffu) << (8 * i); }
    return w; }
template <bool isup> __device__ __forceinline__ void peer_quant_row(const Frame& F, int e) {
    const int lane = F.lane;
    if constexpr (isup) {
        const f32x4* src = (const f32x4*)(F.peer_up + (size_t)e * DM) + lane;
        f32x4 v[8]; float m = 0.f;
#pragma unroll
        for (int j = 0; j < 8; ++j) { v[j] = src[64 * j];
            m = fmaxf(fmaxf(m, fmaxf(fabsf(v[j][0]), fabsf(v[j][1]))), fmaxf(fabsf(v[j][2]), fabsf(v[j][3]))); }
#pragma unroll
        for (int o = 1; o < 64; o <<= 1) m = fmaxf(m, __shfl_xor(m, o));
        const float inv = m > 0.f ? 127.f / m : 0.f; unsigned char* dst = F.up8_();
#pragma unroll
        for (int j = 0; j < 8; ++j) { const unsigned w = pack_i8x4(v[j], inv, 127.f);
            const int col = 4 * lane + 256 * j; *(unsigned*)(dst + ((size_t)(col >> 6) * 16384 + e) * 64 + (col & 63)) = w; }
        if (lane == 0) F.su_()[e] = m * (1.f / 127.f);
    } else {
        const f32x4* src = (const f32x4*)(F.peer_down + (size_t)e * DM) + 2 * lane; const f32x4* gs = (const f32x4*)F.norm2_g + 2 * lane;
        f32x4 v[8]; float ss = 0.f;
#pragma unroll
        for (int j = 0; j < 4; ++j) { v[2 * j] = src[128 * j] * gs[128 * j]; v[2 * j + 1] = src[128 * j + 1] * gs[128 * j + 1];
#pragma unroll
            for (int i = 0; i < 4; ++i) ss += v[2 * j][i] * v[2 * j][i] + v[2 * j + 1][i] * v[2 * j + 1][i]; }
        ss = wave_sum(ss);
        const float step = 0.345f * sqrtf(ss * (1.f / DM)), inv = step > 0.f ? 1.f / step : 0.f; unsigned char* dst = F.down8_();
#pragma unroll
        for (int j = 0; j < 4; ++j) { const unsigned w = pack_nib(pack_i8x4(v[2 * j], inv, 7.f), pack_i8x4(v[2 * j + 1], inv, 7.f));
            const int col = 8 * lane + 512 * j; *(unsigned*)(dst + ((size_t)(col >> 8) * 16384 + e) * 128 + ((col & 255) >> 3) * 4) = w; }
        if (lane == 0) F.sd_()[e] = step;
    }
}
__device__ __forceinline__ void w_quant_item(const Frame& F, const float* W, int ldw, int n0, const float* gain, unsigned char* W8, int drow, float* sw) {
    LAS float* scr = (LAS float*)(F.lds + F.wave * 16384); LAS float* cmx = (LAS float*)(F.lds + 12288);
    const int lane = F.lane, kw = F.wave * 256;
    float m = 0.f;
#pragma unroll 16
    for (int i = 0; i < 128; ++i) { const int k = kw + 2 * i + (lane >> 5); m = fmaxf(m, fabsf(W[(size_t)k * ldw + n0 + (lane & 31)] * gain[k])); }
    m = fmaxf(m, __shfl_xor(m, 32)); if (lane < 32) cmx[F.wave * 32 + lane] = m;
    __syncthreads();
    if (F.tid < 32) { float mm = 0.f;
#pragma unroll
        for (int w = 0; w < 8; ++w) mm = fmaxf(mm, cmx[w * 32 + F.tid]);
        cmx[256 + F.tid] = mm > 0.f ? 127.f / mm : 0.f; sw[drow + F.tid] = mm * (1.f / 127.f); }
    __syncthreads();
    for (int ch = 0; ch < 4; ++ch) { const int k0 = kw + 64 * ch;
#pragma unroll 8
        for (int i = 0; i < 32; ++i) { const int kk = 2 * i + (lane >> 5); scr[kk * 33 + (lane & 31)] = W[(size_t)(k0 + kk) * ldw + n0 + (lane & 31)] * gain[k0 + kk] * cmx[256 + (lane & 31)]; }
        LDS_WAIT(); asm volatile("" ::: "memory");
        const int c = lane & 7;
#pragma unroll
        for (int j = 0; j < 4; ++j) { const int n = (lane >> 3) + 8 * j; const LAS float* sp = scr + (8 * c) * 33 + n; u32x2 w = {0u, 0u};
#pragma unroll
            for (int i = 0; i < 4; ++i) { w.x |= ((unsigned)(int)rintf(sp[i * 33]) & 0xffu) << (8 * i); w.y |= ((unsigned)(int)rintf(sp[(4 + i) * 33]) & 0xffu) << (8 * i); }
            *(u32x2*)(W8 + (size_t)(drow + n) * DM + k0 + 8 * c) = w; }
        LDS_WAIT(); asm volatile("" ::: "memory"); }
    __syncthreads();
}
__device__ __forceinline__ void x_quant_row(const Frame& F, int m) {
    const int lane = F.lane; const f32x4* xr = (const f32x4*)(F.x + (size_t)m * DM) + lane; f32x4 v[8]; float s = 0.f, mx = 0.f;
#pragma unroll
    for (int j = 0; j < 8; ++j) { v[j] = xr[64 * j]; s += (v[j][0] * v[j][0] + v[j][1] * v[j][1]) + (v[j][2] * v[j][2] + v[j][3] * v[j][3]);
        mx = fmaxf(fmaxf(mx, fmaxf(fabsf(v[j][0]), fabsf(v[j][1]))), fmaxf(fabsf(v[j][2]), fabsf(v[j][3]))); }
    s = wave_sum(s);
#pragma unroll
    for (int o = 1; o < 64; o <<= 1) mx = fmaxf(mx, __shfl_xor(mx, o));
    const float inv = mx > 0.f ? 127.f / mx : 0.f; unsigned* o4 = (unsigned*)(F.xq1_() + (size_t)m * DM) + lane;
#pragma unroll
    for (int j = 0; j < 8; ++j) o4[64 * j] = pack_i8x4(v[j], inv, 127.f);
    if (lane == 0) { F.rs1_()[m] = __builtin_amdgcn_rsqf(s * (1.f / DM) + EPS) * (mx * (1.f / 127.f)); F.sx_()[m] = mx * (1.25f / 119.f); }
}
__device__ __forceinline__ void phase0(const Frame& F) {
    LAS float* scr = (LAS float*)(F.lds + F.wave * 16384);
    const int gw = F.vcu * 8 + F.wave, NGW = F.G * 8, lane = F.lane;
    for (int nb = F.vcu; nb < 193; nb += F.G) w_quant_item(F, F.w_in, INW, nb * 32, F.norm1_g, F.Win8_(), nb < 32 ? nb * 32 : (nb == 32 ? C_GF : nb * 32 - 32), F.sw_());
    { LAS float* rm = (LAS float*)(F.lds);
      for (int k0 = F.vcu * 8; k0 < DM; k0 += F.G * 8) { const int k = k0 + F.wave; const float g = F.norm2_g[k]; const f32x4* wr = (const f32x4*)(F.w_query + (size_t)k * DM) + lane;
          __syncthreads();
#pragma unroll
          for (int j = 0; j < 8; ++j) { const f32x4 v = wr[64 * j]; *(LAS f32x4*)(rm + F.wave * 2048 + 4 * (lane + 64 * j)) = (f32x4){fabsf(v[0] * g), fabsf(v[1] * g), fabsf(v[2] * g), fabsf(v[3] * g)}; }
          __syncthreads();
          { f32x4 m = *(const LAS f32x4*)(rm + 4 * F.tid);
#pragma unroll
            for (int w = 1; w < 8; ++w) { const f32x4 o = *(const LAS f32x4*)(rm + w * 2048 + 4 * F.tid); m[0] = fmaxf(m[0], o[0]); m[1] = fmaxf(m[1], o[1]); m[2] = fmaxf(m[2], o[2]); m[3] = fmaxf(m[3], o[3]); }
            unsigned* cm = F.wqmax_() + 4 * F.tid;
#pragma unroll
            for (int i = 0; i < 4; ++i) (void)__hip_atomic_fetch_max(cm + i, __float_as_uint(m[i]), __ATOMIC_RELAXED, __HIP_MEMORY_SCOPE_AGENT); } }
      __syncthreads(); }
    for (int it = gw; it < 32 * 64; it += NGW) { const int kb = it / 64, nb = it % 64; p0_transpose_item(F.w_out, DM, DM, F.WoT_(), kb * 64, nb * 32, nb * 32, nullptr, scr, lane); }
    const size_t gt = (size_t)gw * 64 + lane, NT = (size_t)NGW * 64;
    { u32x4* z = (u32x4*)(F.Win8_() + (size_t)INW * DM); const u32x4 zero = {0u, 0u, 0u, 0u}; for (size_t i = gt; i < (size_t)(HP - INW) * DM / 16; i += NT) z[i] = zero; if (gt < (size_t)(HP - INW)) F.sw_()[INW + gt] = 0.f; }
    for (int r = gw; r < 16384; r += NGW) peer_quant_row<false>(F, r);
    for (int r = gw; r < 16384; r += NGW) peer_quant_row<true>(F, r);
    for (size_t i = gt; i < (size_t)8 * 2 * 128 * 128 / 8; i += NT) { const f32x4 a = *(const f32x4*)(F.sub_keys + i * 8), b = *(const f32x4*)(F.sub_keys + i * 8 + 4);
        u32x4 o; o.x = pk2(a[0], a[1]); o.y = pk2(a[2], a[3]); o.z = pk2(b[0], b[1]); o.w = pk2(b[2], b[3]); *(u32x4*)(F.SK_() + i * 8) = o; }
    for (int m = gw; m < T; m += NGW) x_quant_row(F, m);
}
__device__ __forceinline__ void wq_quant_transpose(const Frame& F) {
    LAS float* scr = (LAS float*)(F.lds + F.wave * 16384); const int gw = F.vcu * 8 + F.wave, NGW = F.G * 8, lane = F.lane;
    for (int it = gw; it < 32 * 64; it += NGW) { const int k0 = (it / 64) * 64, n0 = (it % 64) * 32;
        const float cmx = __uint_as_float(F.wqmax_()[n0 + (lane & 31)]), inv = cmx > 0.f ? 127.f / cmx : 0.f;
        if (k0 == 0 && lane < 32) F.swq_()[n0 + lane] = cmx * (1.f / 127.f);
#pragma unroll 8
        for (int i = 0; i < 32; ++i) { const int kk = 2 * i + (lane >> 5); scr[kk * 33 + (lane & 31)] = F.w_query[(size_t)(k0 + kk) * DM + n0 + (lane & 31)] * F.norm2_g[k0 + kk] * inv; }
        LDS_WAIT(); asm volatile("" ::: "memory");
        const int c = lane & 7;
#pragma unroll
        for (int j = 0; j < 4; ++j) { const int n = (lane >> 3) + 8 * j; const LAS float* sp = scr + (8 * c) * 33 + n; u32x2 w = {0u, 0u};
#pragma unroll
            for (int i = 0; i < 4; ++i) { w.x |= ((unsigned)(int)rintf(sp[i * 33]) & 0xffu) << (8 * i); w.y |= ((unsigned)(int)rintf(sp[(4 + i) * 33]) & 0xffu) << (8 * i); }
            *(u32x2*)(F.Wq8_() + (size_t)(n0 + n) * DM + k0 + 8 * c) = w; }
        LDS_WAIT(); asm volatile("" ::: "memory"); }
    __syncthreads();
}

__device__ __forceinline__ void qknorm_rope(const Frame& F) {
    const int gw = F.vcu * 8 + F.wave, NGW = F.G * 8, lane = F.lane, c = lane & 15;
    for (long it = gw; it < (long)T * 24 / 4; it += NGW) { const long row = it * 4 + (lane >> 4); const int t = (int)(row / 24), slot = (int)(row % 24);
        bf16_t* p = F.h_() + (size_t)t * HP + C_QD + slot * 128 + 8 * c;
        const u32x4 w = *(const u32x4*)p; float y[8] = {bflo(w.x), bfhi(w.x), bflo(w.y), bfhi(w.y), bflo(w.z), bfhi(w.z), bflo(w.w), bfhi(w.w)};
        float ss = 0.f;
#pragma unroll
        for (int e = 0; e < 8; ++e) ss += y[e] * y[e];
        ss += __shfl_xor(ss, 1); ss += __shfl_xor(ss, 2); ss += __shfl_xor(ss, 4); ss += __shfl_xor(ss, 8);
        const float rq = __builtin_amdgcn_rsqf(ss * (1.f / 128.f) + EPS); const float* g = (slot < 12 ? F.qn_g : F.kn_g) + 8 * c;
        const f32x4 g0 = *(const f32x4*)g, g1 = *(const f32x4*)(g + 4);
#pragma unroll
        for (int e = 0; e < 4; ++e) { y[e] *= rq * g0[e]; y[4 + e] *= rq * g1[e]; }
        const int pos = t & (SEQ - 1);
#pragma unroll
        for (int e = 0; e < 8; ++e) { const float partner = __shfl_xor(y[e], 2);
            if (c < 4) { const f32x2 cs = F.rope_()[(size_t)pos * 16 + 8 * (c & 1) + e]; y[e] = (c < 2) ? (y[e] * cs.x - partner * cs.y) : (y[e] * cs.x + partner * cs.y); } }
        if (slot < 12) {
#pragma unroll
            for (int e = 0; e < 8; ++e) y[e] *= QSCALE; }
        u32x4 o; o.x = pk2(y[0], y[1]); o.y = pk2(y[2], y[3]); o.z = pk2(y[4], y[5]); o.w = pk2(y[6], y[7]); *(u32x4*)p = o; }
}

constexpr int GL_GDS = 0, GL_TOT = 8192, GL_QF = 12288, GL_QB = 21504, GL_KF = 30720, GL_KB = 39936, GL_VT = 49152, GL_P = 67584, GL_SF = 76800, GL_SB = 95232, GL_OB = 12288;
constexpr int RS72 = 144;
__device__ __forceinline__ float logsig(float z) { return fminf(z, 0.f) - flog(1.f + fexp(-fabsf(z))); }
__device__ __forceinline__ void gla_gates(const Frame& F, int b, int hh, int n, float (&bf)[8], float (&bb)[8], float& totf, float& totb) {
    const int tid = F.tid, c = tid & 63, ig = F.wave; LAS float* gds = (LAS float*)(F.lds + GL_GDS); LAS float* tot = (LAS float*)(F.lds + GL_TOT);
    const size_t t0 = (size_t)b * SEQ + (size_t)n * 64;
    if (tid < 256) { const int tk = tid >> 2, part = tid & 3; const u32x4 w = *(const u32x4*)(F.h_() + (t0 + tk) * HP + C_GF + part * 8); LAS float* d = gds + tk * 32 + part * 8;
        d[0] = bflo(w.x); d[1] = bfhi(w.x); d[2] = bflo(w.y); d[3] = bfhi(w.y); d[4] = bflo(w.z); d[5] = bfhi(w.z); d[6] = bflo(w.w); d[7] = bfhi(w.w); }
    __syncthreads();
    const int hc = hh * 64 + c; float upf[16], upb[16];
#pragma unroll
    for (int r = 0; r < 16; ++r) { upf[r] = F.up_f[r * 256 + hc]; upb[r] = F.up_b[r * 256 + hc]; }
    const float biasf = F.bias_f[hc], biasb = F.bias_b[hc]; float laf[8], lab[8];
#pragma unroll
    for (int e = 0; e < 8; ++e) { const LAS float* gr = gds + (ig * 8 + e) * 32; float zf = biasf, zb = biasb;
#pragma unroll
        for (int r = 0; r < 16; ++r) { zf += gr[r] * upf[r]; zb += gr[16 + r] * upb[r]; }
        laf[e] = logsig(zf) * 0.0625f; lab[e] = logsig(zb) * 0.0625f; }
    bf[0] = laf[0];
#pragma unroll
    for (int e = 1; e < 8; ++e) bf[e] = bf[e - 1] + laf[e];
    bb[7] = lab[7];
#pragma unroll
    for (int e = 6; e >= 0; --e) bb[e] = bb[e + 1] + lab[e];
    tot[ig * 64 + c] = bf[7]; tot[512 + ig * 64 + c] = bb[0];
    __syncthreads();
    float offf = 0.f, offb = 0.f; totf = 0.f; totb = 0.f;
#pragma unroll
    for (int g = 0; g < 8; ++g) { const float tf = tot[g * 64 + c], tb = tot[512 + g * 64 + c]; totf += tf; totb += tb; offf += (g < ig) ? tf : 0.f; offb += (g > ig) ? tb : 0.f; }
#pragma unroll
    for (int e = 0; e < 8; ++e) { bf[e] += offf; bb[e] += offb; }
}
__device__ __forceinline__ void gla_stage_vT(const Frame& F, const bf16x8 (&vraw)[2]) {
#pragma unroll
    for (int j = 0; j < 2; ++j) { const int q = F.tid + 512 * j, tk = q >> 4, vc = (q & 15) * 8; LAS short* d = (LAS short*)(F.lds + GL_VT) + vc * 72 + tk;
#pragma unroll
        for (int e = 0; e < 8; ++e) d[e * 72] = vraw[j][e]; }
}
__device__ __forceinline__ bf16x8 ldfrag(const LAS unsigned char* base, int row, int s, int hi) { return *(const LAS bf16x8*)(base + row * RS72 + (16 * s + 8 * hi) * 2); }

__device__ __forceinline__ void gla_passA(const Frame& F, int item) {
    const int bh = item >> 8, n = item & 255, b = bh >> 2, hh = bh & 3, tid = F.tid, c = tid & 63, ig = F.wave, lane = F.lane, r32 = lane & 31, hi = lane >> 5;
    const size_t t0 = (size_t)b * SEQ + (size_t)n * 64;
    unsigned short kraw[8]; bf16x8 vraw[2];
#pragma unroll
    for (int e = 0; e < 8; ++e) kraw[e] = F.h_()[(t0 + ig * 8 + e) * HP + C_KA + hh * 64 + c];
#pragma unroll
    for (int j = 0; j < 2; ++j) { const int q = tid + 512 * j; vraw[j] = *(const bf16x8*)(F.h_() + (t0 + (q >> 4)) * HP + C_VA + hh * 128 + (q & 15) * 8); }
    float bf[8], bb[8], totf, totb; gla_gates(F, b, hh, n, bf, bb, totf, totb);
    float kf[8], kb[8];
#pragma unroll
    for (int e = 0; e < 8; ++e) { const float k = bf2f(kraw[e]); kf[e] = k * fexp(totf - bf[e]); kb[e] = k * fexp(totb - bb[e]); }
    { u32x4 o; o.x = pk2(kf[0], kf[1]); o.y = pk2(kf[2], kf[3]); o.z = pk2(kf[4], kf[5]); o.w = pk2(kf[6], kf[7]); *(LAS u32x4*)(F.lds + GL_KF + c * RS72 + ig * 16) = o;
      o.x = pk2(kb[0], kb[1]); o.y = pk2(kb[2], kb[3]); o.z = pk2(kb[4], kb[5]); o.w = pk2(kb[6], kb[7]); *(LAS u32x4*)(F.lds + GL_KB + c * RS72 + ig * 16) = o; }
    gla_stage_vT(F, vraw);
    if (ig == 0) { F.dec_()[((size_t)(0 * 8 + bh) * 256 + n) * 64 + c] = fexp(totf); F.dec_()[((size_t)(1 * 8 + bh) * 256 + n) * 64 + c] = fexp(totb); }
    __syncthreads();
    const int dir = F.wave >> 2, vt = F.wave & 3; const LAS unsigned char* kimg = F.lds + (dir ? GL_KB : GL_KF);
    f32x16 a0 = {}, a1 = {};
#pragma unroll
    for (int s = 0; s < 4; ++s) { const bf16x8 av = ldfrag(F.lds + GL_VT, 32 * vt + r32, s, hi), b0 = ldfrag(kimg, r32, s, hi), b1 = ldfrag(kimg, 32 + r32, s, hi);
        a0 = __builtin_amdgcn_mfma_f32_32x32x16_bf16(av, b0, a0, 0, 0, 0); a1 = __builtin_amdgcn_mfma_f32_32x32x16_bf16(av, b1, a1, 0, 0, 0); }
    unsigned short* st = F.state_() + ((size_t)(dir * 8 + bh) * 256 + n) * 8192;
#pragma unroll
    for (int r = 0; r < 16; ++r) { const int v = 32 * vt + crow(r, hi); st[v * 64 + r32] = (unsigned short)f2bf(a0[r]); st[v * 64 + 32 + r32] = (unsigned short)f2bf(a1[r]); }
    __syncthreads();
}
__device__ __forceinline__ void gla_scan(const Frame& F, int item) {
    const int dir = item >> 7, bh = (item >> 4) & 7, e = (item & 15) * 512 + F.tid, c = e & 63;
    unsigned short* st = F.state_() + (size_t)(dir * 8 + bh) * 256 * 8192 + e; const float* dc = F.dec_() + (size_t)(dir * 8 + bh) * 256 * 64 + c; float S = 0.f;
    float iA[16], dA[16], iB[16], dB[16];
#define SC_N(g, j) (dir ? 255 - ((g) * 16 + (j)) : (g) * 16 + (j))
#define SC_LOAD(I_, D_, g) do { _Pragma("unroll") for (int j = 0; j < 16; ++j) { const int n_ = SC_N(g, j); I_[j] = bf2f(st[(size_t)n_ * 8192]); D_[j] = dc[n_ * 64]; } } while (0)
#define SC_RUN(I_, D_, g) do { _Pragma("unroll") for (int j = 0; j < 16; ++j) { const int n_ = SC_N(g, j); st[(size_t)n_ * 8192] = (unsigned short)f2bf(S); S = D_[j] * S + I_[j]; } } while (0)
    SC_LOAD(iA, dA, 0);
    for (int g = 0; g < 16; g += 2) { SC_LOAD(iB, dB, g + 1); SC_RUN(iA, dA, g); if (g + 2 < 16) SC_LOAD(iA, dA, g + 2); SC_RUN(iB, dB, g + 1); }
#undef SC_N
#undef SC_LOAD
#undef SC_RUN
}
__device__ __forceinline__ void gla_passC(const Frame& F, int item) {
    const int bh = item >> 8, n = item & 255, b = bh >> 2, hh = bh & 3, tid = F.tid, c = tid & 63, ig = F.wave, lane = F.lane, r32 = lane & 31, hi = lane >> 5;
    const size_t t0 = (size_t)b * SEQ + (size_t)n * 64;
    unsigned short qraw[8], kraw[8]; bf16x8 vraw[2]; u32x4 sraw[2][2];
#pragma unroll
    for (int e = 0; e < 8; ++e) { const bf16_t* hr = F.h_() + (t0 + ig * 8 + e) * HP + hh * 64 + c; qraw[e] = hr[C_QA]; kraw[e] = hr[C_KA]; }
#pragma unroll
    for (int j = 0; j < 2; ++j) { const int q = tid + 512 * j; vraw[j] = *(const bf16x8*)(F.h_() + (t0 + (q >> 4)) * HP + C_VA + hh * 128 + (q & 15) * 8);
#pragma unroll
        for (int dir = 0; dir < 2; ++dir) sraw[dir][j] = *(const u32x4*)(F.state_() + ((size_t)(dir * 8 + bh) * 256 + n) * 8192 + (q >> 3) * 64 + (q & 7) * 8); }
    float bf[8], bb[8], totf, totb; gla_gates(F, b, hh, n, bf, bb, totf, totb);
#pragma unroll
    for (int e = 0; e < 8; ++e) { const int i = ig * 8 + e; const float q = bf2f(qraw[e]) * 0.125f, k = bf2f(kraw[e]);
        const float ef = fexp(bf[e]), eb = fexp(bb[e]), nf = fexp(-bf[e]), nb = fexp(-bb[e]);
        *(LAS unsigned short*)(F.lds + GL_QF + i * RS72 + c * 2) = (unsigned short)f2bf(q * ef); *(LAS unsigned short*)(F.lds + GL_QB + i * RS72 + c * 2) = (unsigned short)f2bf(q * eb);
        *(LAS unsigned short*)(F.lds + GL_KF + i * RS72 + c * 2) = (unsigned short)f2bf(k * nf); *(LAS unsigned short*)(F.lds + GL_KB + i * RS72 + c * 2) = (unsigned short)f2bf(k * nb); }
    gla_stage_vT(F, vraw);
#pragma unroll
    for (int dir = 0; dir < 2; ++dir)
#pragma unroll
        for (int j = 0; j < 2; ++j) { const int q = tid + 512 * j; *(LAS u32x4*)(F.lds + (dir ? GL_SB : GL_SF) + (q >> 3) * RS72 + (q & 7) * 16) = sraw[dir][j]; }
    __syncthreads();
    if (F.wave < 4) { const int ti = F.wave >> 1, tj = F.wave & 1; f32x16 sf = {}, sb = {};
#pragma unroll
        for (int s = 0; s < 4; ++s) {
            sf = __builtin_amdgcn_mfma_f32_32x32x16_bf16(ldfrag(F.lds + GL_QF, 32 * ti + r32, s, hi), ldfrag(F.lds + GL_KF, 32 * tj + r32, s, hi), sf, 0, 0, 0);
            sb = __builtin_amdgcn_mfma_f32_32x32x16_bf16(ldfrag(F.lds + GL_QB, 32 * ti + r32, s, hi), ldfrag(F.lds + GL_KB, 32 * tj + r32, s, hi), sb, 0, 0, 0); }
#pragma unroll
        for (int r = 0; r < 16; ++r) { const int i = 32 * ti + crow(r, hi), j = 32 * tj + r32; const float p = (j <= i) ? sf[r] : sb[r];
            *(LAS unsigned short*)(F.lds + GL_P + i * RS72 + j * 2) = (unsigned short)f2bf(p); } }
    __syncthreads();
    const int ti = F.wave & 1, tv = F.wave >> 1; f32x16 o = {};
#pragma unroll
    for (int s = 0; s < 4; ++s) o = __builtin_amdgcn_mfma_f32_32x32x16_bf16(ldfrag(F.lds + GL_P, 32 * ti + r32, s, hi), ldfrag(F.lds + GL_VT, 32 * tv + r32, s, hi), o, 0, 0, 0);
#pragma unroll
    for (int s = 0; s < 4; ++s) o = __builtin_amdgcn_mfma_f32_32x32x16_bf16(ldfrag(F.lds + GL_QF, 32 * ti + r32, s, hi), ldfrag(F.lds + GL_SF, 32 * tv + r32, s, hi), o, 0, 0, 0);
#pragma unroll
    for (int s = 0; s < 4; ++s) o = __builtin_amdgcn_mfma_f32_32x32x16_bf16(ldfrag(F.lds + GL_QB, 32 * ti + r32, s, hi), ldfrag(F.lds + GL_SB, 32 * tv + r32, s, hi), o, 0, 0, 0);
    __syncthreads();
    LAS float* ob = (LAS float*)(F.lds + GL_OB);
#pragma unroll
    for (int r = 0; r < 16; ++r) ob[(32 * ti + crow(r, hi)) * 132 + 32 * tv + r32] = o[r];
    __syncthreads();
    { const int i = tid >> 3, part = tid & 7, v0 = part * 16; float ov[16], ss = 0.f;
#pragma unroll
      for (int e = 0; e < 16; ++e) { ov[e] = ob[i * 132 + v0 + e]; ss += ov[e] * ov[e]; }
      ss += __shfl_xor(ss, 1); ss += __shfl_xor(ss, 2); ss += __shfl_xor(ss, 4);
      const float rs = __builtin_amdgcn_rsqf(ss * (1.f / 128.f) + EPS); const size_t tok = t0 + i;
      const u32x4 r0 = *(const u32x4*)(F.h_() + tok * HP + C_RA + hh * 128 + v0), r1 = *(const u32x4*)(F.h_() + tok * HP + C_RA + hh * 128 + v0 + 8);
      const float rr[16] = {bflo(r0.x), bfhi(r0.x), bflo(r0.y), bfhi(r0.y), bflo(r0.z), bfhi(r0.z), bflo(r0.w), bfhi(r0.w), bflo(r1.x), bfhi(r1.x), bflo(r1.y), bfhi(r1.y), bflo(r1.z), bfhi(r1.z), bflo(r1.w), bfhi(r1.w)};
      float y[16];
#pragma unroll
      for (int e = 0; e < 16; ++e) { const float g = F.out_g[hh * 128 + v0 + e]; const float sil = rr[e] * __builtin_amdgcn_rcpf(1.f + fexp(-rr[e])); y[e] = ov[e] * rs * g * sil; }
      u32x4 w0, w1; w0.x = pk2(y[0], y[1]); w0.y = pk2(y[2], y[3]); w0.z = pk2(y[4], y[5]); w0.w = pk2(y[6], y[7]); w1.x = pk2(y[8], y[9]); w1.y = pk2(y[10], y[11]); w1.z = pk2(y[12], y[13]); w1.w = pk2(y[14], y[15]);
      bf16_t* mp = F.mixed_() + tok * DM + hh * 128 + v0; *(u32x4*)mp = w0; *(u32x4*)(mp + 8) = w1; }
    __syncthreads();
}

constexpr int AT_V = 0, AT_K = 49152, AT_O = 81920, AT_OSZ = 4608;
#define KSWZ(row, colB) ((row) * 256 + ((colB) ^ (((row) & 7) << 4)))
__device__ __forceinline__ int v_st(int k, int c) { const int kk = (k & ~0xC) | ((k & 4) << 1) | ((k & 8) >> 1); return ((kk >> 3) * 4 + (c >> 5)) * 512 + ((kk & 7) * 32 + (c & 31)) * 2; }
__device__ __forceinline__ int v_rd_base(int lane) { return ((lane & 3) << 3) | (((lane >> 2) & 3) << 6) | (((lane >> 4) & 1) << 5) | (((lane >> 5) & 1) << 8); }
constexpr int v_rd_off(int d0, int ks, int half) { return d0 * 512 + ks * 4096 + half * 2048; }
template <int OFF> __device__ __forceinline__ s16x4 tr_read(int vb) { s16x4 r; asm volatile("ds_read_b64_tr_b16 %0, %1 offset:%2" : "=&v"(r) : "v"(vb), "i"(OFF) : "memory"); return r; }
template <int D0> __device__ __forceinline__ void pv_one(f32x16& od, int vb, bf16x8 pa0, bf16x8 pa1, bf16x8 pa2, bf16x8 pa3) {
    const s16x4 l0 = tr_read<v_rd_off(D0, 0, 0)>(vb), h0 = tr_read<v_rd_off(D0, 0, 1)>(vb), l1 = tr_read<v_rd_off(D0, 1, 0)>(vb), h1 = tr_read<v_rd_off(D0, 1, 1)>(vb);
    const s16x4 l2 = tr_read<v_rd_off(D0, 2, 0)>(vb), h2 = tr_read<v_rd_off(D0, 2, 1)>(vb), l3 = tr_read<v_rd_off(D0, 3, 0)>(vb), h3 = tr_read<v_rd_off(D0, 3, 1)>(vb);
    asm volatile("s_waitcnt lgkmcnt(0)" ::: "memory"); SBAR();
#define PKV(L, H) (bf16x8){L[0], L[1], L[2], L[3], H[0], H[1], H[2], H[3]}
    od = __builtin_amdgcn_mfma_f32_32x32x16_bf16(pa0, PKV(l0, h0), od, 0, 0, 0);
    od = __builtin_amdgcn_mfma_f32_32x32x16_bf16(pa1, PKV(l1, h1), od, 0, 0, 0);
    od = __builtin_amdgcn_mfma_f32_32x32x16_bf16(pa2, PKV(l2, h2), od, 0, 0, 0);
    od = __builtin_amdgcn_mfma_f32_32x32x16_bf16(pa3, PKV(l3, h3), od, 0, 0, 0);
#undef PKV
}
struct AtP { size_t tokbase; int dil, m0, Tf, nt, head, p; };
__device__ __forceinline__ AtP at_decode(int item) {
    AtP P; const int round = item >> 8, w = item & 255, p = round % 3, bh = round / 3, b = bh / 3, u = w & 63; P.p = p; P.head = (bh % 3) * 4 + (w >> 6);
    const int dsh = 2 * p, L = SEQ >> dsh, runs = 64 >> dsh, res = u / runs; P.dil = 1 << dsh; P.m0 = (u % runs) * 256; P.tokbase = (size_t)b * SEQ + res;
    const int kt_lo = (P.m0 == 0) ? 1 : 0, kt_hi = (P.m0 + 256 >= L) ? 4 : 5; P.Tf = P.m0 - 64 + 64 * kt_lo; P.nt = kt_hi - kt_lo + 1; return P;
}
__device__ __forceinline__ void attn_phase(const Frame& F) {
    const int tid = F.tid, wid = F.wave, lane = F.lane, r32 = lane & 31, hi = lane >> 5, G = F.G;
    int ntot = 0; for (int it = F.vcu; it < 4608; it += G) ntot += at_decode(it).nt;
    if (ntot == 0) return;
    const int sr = tid >> 4, sc = (tid & 15) * 8, vst0 = v_st(sr, sc), vst1 = v_st(32 + sr, sc), kc = sc * 2;
    const int vb0 = (int)(unsigned)(uintptr_t)(F.ldsg + AT_V) + v_rd_base(lane);
    int it_ld = F.vcu, rl = 0, it_c = F.vcu, rc = 0; AtP ld = at_decode(it_ld), cur = ld;
    bf16x8 qr[8], qn[8]; f32x16 o[4]; float l_reg = 0.f;
    bf16x8 sA0, sA1, sA2, sA3, sB0, sB1, sB2, sB3;
    const bool rot = false;
    bf16x8 pa0, pa1, pa2, pa3;
    bool pend = false, pend_last = false; int vprev = 0, prvQ0 = 0; AtP prv = cur;
#pragma unroll
    for (int d0 = 0; d0 < 4; ++d0) o[d0] = (f32x16){};
#define AT_QLOAD() do { const bf16_t* qp_ = F.h_() + C_QD + ld.head * 128 + (ld.tokbase + (size_t)ld.dil * (ld.m0 + 32 * wid + r32)) * HP + hi * 8; \
        _Pragma("unroll") for (int d0 = 0; d0 < 8; ++d0) qn[d0] = *(const bf16x8*)(qp_ + d0 * 16); } while (0)
#define AT_SLOAD(S) do { const int T0_ = ld.Tf + 64 * rl; const size_t ra = (ld.tokbase + (size_t)ld.dil * (T0_ + sr)) * HP + ld.head * 128 + sc, rb = ra + (size_t)ld.dil * 32 * HP; \
        S##0 = *(const bf16x8*)(F.h_() + C_VD + ra); S##1 = *(const bf16x8*)(F.h_() + C_VD + rb); S##2 = *(const bf16x8*)(F.h_() + C_KD + ra); S##3 = *(const bf16x8*)(F.h_() + C_KD + rb); \
        if (++rl == ld.nt) { it_ld += G; rl = 0; if (it_ld < 4608) { ld = at_decode(it_ld); AT_QLOAD(); } } } while (0)
#define AT_SWRITE(S, KB, VB) do { *(LAS bf16x8*)(F.lds + AT_V + (VB) * 16384 + vst0) = S##0; *(LAS bf16x8*)(F.lds + AT_V + (VB) * 16384 + vst1) = S##1; \
        *(LAS bf16x8*)(F.lds + AT_K + (KB) * 16384 + KSWZ(sr, kc)) = S##2; *(LAS bf16x8*)(F.lds + AT_K + (KB) * 16384 + KSWZ(32 + sr, kc)) = S##3; } while (0)
#define PK4(P, BASE, OUT) do { unsigned a0_ = pk2(P[BASE + 0], P[BASE + 1]), a1_ = pk2(P[BASE + 2], P[BASE + 3]); unsigned b0_ = pk2(P[BASE + 4], P[BASE + 5]), b1_ = pk2(P[BASE + 6], P[BASE + 7]); \
        auto r0_ = __builtin_amdgcn_permlane32_swap(a0_, b0_, false, false); auto r1_ = __builtin_amdgcn_permlane32_swap(a1_, b1_, false, false); \
        u32x4 w_ = {r0_[0], r1_[0], r0_[1], r1_[1]}; OUT = __builtin_bit_cast(bf16x8, w_); } while (0)
#define AT_TRD(OFF) __builtin_amdgcn_ds_read_tr16_b64_v4i16((LAS s16x4*)(uintptr_t)(unsigned)(vb_ + (OFF)))
#define AT_PVR(D0, R) do { R[0] = AT_TRD(v_rd_off(D0, 0, 0)); R[1] = AT_TRD(v_rd_off(D0, 0, 1)); R[2] = AT_TRD(v_rd_off(D0, 1, 0)); R[3] = AT_TRD(v_rd_off(D0, 1, 1)); \
        R[4] = AT_TRD(v_rd_off(D0, 2, 0)); R[5] = AT_TRD(v_rd_off(D0, 2, 1)); R[6] = AT_TRD(v_rd_off(D0, 3, 0)); R[7] = AT_TRD(v_rd_off(D0, 3, 1)); } while (0)
#define AT_PKV(L, H) (bf16x8){L[0], L[1], L[2], L[3], H[0], H[1], H[2], H[3]}
#define AT_MF(OD, R) do { OD = __builtin_amdgcn_mfma_f32_32x32x16_bf16(AT_PKV(R[0], R[1]), pa0, OD, 0, 0, 0); OD = __builtin_amdgcn_mfma_f32_32x32x16_bf16(AT_PKV(R[2], R[3]), pa1, OD, 0, 0, 0); \
        OD = __builtin_amdgcn_mfma_f32_32x32x16_bf16(AT_PKV(R[4], R[5]), pa2, OD, 0, 0, 0); OD = __builtin_amdgcn_mfma_f32_32x32x16_bf16(AT_PKV(R[6], R[7]), pa3, OD, 0, 0, 0); } while (0)
#define AT_PV(VB) do { const int vb_ = vb0 + (VB) * 16384; s16x4 RA[8], RB[8]; \
        AT_PVR(0, RA); AT_PVR(1, RB); SBAR(); AT_MF(o[0], RA); SBAR(); AT_PVR(2, RA); SBAR(); AT_MF(o[1], RB); SBAR(); AT_PVR(3, RB); SBAR(); AT_MF(o[2], RA); AT_MF(o[3], RB); } while (0)
#define AT_EPI(P_, Q0_) do { \
            unsigned char* Op = (P_.p == 0 ? (unsigned char*)F.out + OUT_OP0 : F.wsb + (P_.p == 1 ? WS_OP1 : WS_OP2)); \
            const float lt = l_reg + __shfl_xor(l_reg, 32), rl_ = __builtin_amdgcn_rcpf(lt);                      \
            LAS unsigned char* stg = F.lds + AT_O + wid * AT_OSZ; \
            if (hi == 0) F.lp_()[((size_t)P_.p * T + P_.tokbase + (size_t)P_.dil * ((Q0_) + r32)) * NHD + P_.head] = lt; \
            _Pragma("unroll") for (int d0 = 0; d0 < 4; ++d0) _Pragma("unroll") for (int k = 0; k < 4; ++k) { \
                int w_ = __builtin_amdgcn_cvt_pk_fp8_f32(o[d0][4 * k] * rl_, o[d0][4 * k + 1] * rl_, 0, false); w_ = __builtin_amdgcn_cvt_pk_fp8_f32(o[d0][4 * k + 2] * rl_, o[d0][4 * k + 3] * rl_, w_, true); \
                *(LAS int*)(stg + r32 * 144 + d0 * 32 + k * 8 + hi * 4) = w_; }                                     \
            LDS_WAIT(); asm volatile("" ::: "memory"); \
            _Pragma("unroll") for (int i_ = 0; i_ < 4; ++i_) { const int row = 8 * i_ + (lane >> 3), ch = lane & 7; const u32x4 w = *(const LAS u32x4*)(stg + row * 144 + ch * 16); \
                *(u32x4*)(Op + (P_.tokbase + (size_t)P_.dil * ((Q0_) + row)) * (NHD * 128) + P_.head * 128 + ch * 16) = w; } \
            LDS_WAIT(); asm volatile("" ::: "memory"); \
            _Pragma("unroll") for (int d0 = 0; d0 < 4; ++d0) o[d0] = (f32x16){}; l_reg = 0.f; } while (0)
#define AT_STEP(KB, VB) do { \
        if (rot && pend) AT_PV(vprev);                                                           \
        if (pend_last) AT_EPI(prv, prvQ0);                                                       \
        if (rc == 0) { _Pragma("unroll") for (int d0 = 0; d0 < 8; ++d0) qr[d0] = qn[d0]; } \
        const int Q0 = cur.m0 + 32 * wid, T0 = cur.Tf + 64 * rc; \
        const bool act = T0 + 63 >= Q0 - 64 && T0 <= Q0 + 95;                                \
        if (act) { \
            const LAS unsigned char* Ks = F.lds + AT_K + (KB) * 16384; f32x16 p0 = {}, p1 = {}; \
            _Pragma("unroll") for (int d0 = 0; d0 < 8; ++d0) { const int cb = (d0 * 16 + hi * 8) * 2; \
                const bf16x8 k0 = *(const LAS bf16x8*)(Ks + KSWZ(r32, cb)), k1 = *(const LAS bf16x8*)(Ks + KSWZ(32 + r32, cb)); \
                p0 = __builtin_amdgcn_mfma_f32_32x32x16_bf16(k0, qr[d0], p0, 0, 0, 0); p1 = __builtin_amdgcn_mfma_f32_32x32x16_bf16(k1, qr[d0], p1, 0, 0, 0); } \
            const int dq = T0 - (Q0 + r32); float ps = 0.f;                                \
            _Pragma("unroll") for (int r = 0; r < 16; ++r) { const int e0 = dq + crow(r, hi), e1 = e0 + 32; \
                p0[r] = (e0 >= -64 && e0 <= 64) ? __builtin_amdgcn_exp2f(p0[r]) : 0.f; p1[r] = (e1 >= -64 && e1 <= 64) ? __builtin_amdgcn_exp2f(p1[r]) : 0.f; ps += p0[r] + p1[r]; } \
            l_reg += ps; \
            PK4(p0, 0, pa0); PK4(p0, 8, pa1); PK4(p1, 0, pa2); PK4(p1, 8, pa3); } \
        const bool last = rc + 1 == cur.nt; \
        if (!rot) { if (act) AT_PV(VB); } else { pend = act; vprev = (VB); } \
        pend_last = last; if (last) { prv = cur; prvQ0 = Q0; } \
        if (last) { rc = 0; it_c += G; if (it_c < 4608) cur = at_decode(it_c); } else ++rc; } while (0)
    AT_QLOAD();
    AT_SLOAD(sA); AT_SLOAD(sB); AT_SWRITE(sA, 0, 0); AT_SLOAD(sA); __syncthreads();
    int v3 = 0;
    for (int g = 0; g < ntot; g += 2) { int v3n = v3 == 2 ? 0 : v3 + 1;
        AT_STEP(0, v3);
        if (g + 1 < ntot) AT_SWRITE(sB, 1, v3n);
        if (it_ld < 4608) AT_SLOAD(sB);
        v3 = v3n; v3n = v3 == 2 ? 0 : v3 + 1;
        __syncthreads();
        if (g + 1 < ntot) {
            AT_STEP(1, v3);
            if (g + 2 < ntot) AT_SWRITE(sA, 0, v3n);
            if (it_ld < 4608) AT_SLOAD(sA);
            v3 = v3n;
            __syncthreads(); }
    }
    if (rot && pend) AT_PV(vprev);
    if (pend_last) AT_EPI(prv, prvQ0);
#undef AT_QLOAD
#undef AT_SLOAD
#undef AT_SWRITE
#undef PK4
#undef AT_PV
#undef AT_TRD
#undef AT_PVR
#undef AT_PKV
#undef AT_MF
#undef AT_EPI
#undef AT_STEP
}
__device__ __forceinline__ void dil_combine(const Frame& F) {
    const int gw = F.vcu * 8 + F.wave, NGW = F.G * 8, lane = F.lane, c = lane & 15;
    const unsigned char* o0 = (const unsigned char*)F.op0_(); const unsigned char* o1 = (const unsigned char*)F.op1_(); const unsigned char* o2 = (const unsigned char*)F.op2_();
    for (long it = gw; it < (long)T * NHD / 4; it += NGW) { const long row = it * 4 + (lane >> 4); const size_t tok = (size_t)(row / NHD); const int head = (int)(row % NHD);
        const float l0 = F.lp_()[tok * NHD + head], l1 = F.lp_()[((size_t)T + tok) * NHD + head], l2 = F.lp_()[((size_t)2 * T + tok) * NHD + head]; const float inv = 1.f / (l0 + l1 + l2), w0 = l0 * inv, w1 = l1 * inv, w2 = l2 * inv;
        const size_t off = tok * (NHD * 128) + head * 128 + 8 * c; const u32x2 a = *(const u32x2*)(o0 + off), b = *(const u32x2*)(o1 + off), d = *(const u32x2*)(o2 + off);
#define DC2(AW, BW, DW, SEL) ({ const f32x2 x_ = __builtin_amdgcn_cvt_pk_f32_fp8((int)(AW), SEL), y_ = __builtin_amdgcn_cvt_pk_f32_fp8((int)(BW), SEL), z_ = __builtin_amdgcn_cvt_pk_f32_fp8((int)(DW), SEL); \
            pk2(w0 * x_[0] + w1 * y_[0] + w2 * z_[0], w0 * x_[1] + w1 * y_[1] + w2 * z_[1]); })
        u32x4 o; o.x = DC2(a.x, b.x, d.x, false); o.y = DC2(a.x, b.x, d.x, true); o.z = DC2(a.y, b.y, d.y, false); o.w = DC2(a.y, b.y, d.y, true);
#undef DC2
        *(u32x4*)(F.mixed_() + tok * DM + 512 + head * 128 + 8 * c) = o; }
}

__device__ __forceinline__ unsigned fl_flip(float x) { const unsigned u = __float_as_uint(x); return u ^ ((unsigned)((int)u >> 31) | 0x80000000u); }
__device__ __forceinline__ float fl_unflip(unsigned w) { return __uint_as_float((w & 0x80000000u) ? (w ^ 0x80000000u) : ~w); }
#define CE_DESC(a, b) do { const unsigned x_ = max(a, b), y_ = min(a, b); a = x_; b = y_; } while (0)
__device__ __forceinline__ void sort16_desc(unsigned (&a)[16]) {
#pragma unroll
    for (int k = 2; k <= 16; k <<= 1)
#pragma unroll
        for (int j = k >> 1; j > 0; j >>= 1)
#pragma unroll
            for (int i = 0; i < 16; ++i) { const int l = i ^ j; if (l > i) { const unsigned x = max(a[i], a[l]), y = min(a[i], a[l]); if ((i & k) == 0) { a[i] = x; a[l] = y; } else { a[i] = y; a[l] = x; } } }
}
__device__ __forceinline__ void bmerge16_desc(unsigned (&a)[16]) {
#pragma unroll
    for (int j = 8; j > 0; j >>= 1)
#pragma unroll
        for (int i = 0; i < 16; ++i) { const int l = i ^ j; if (l > i) CE_DESC(a[i], a[l]); }
}
__device__ __forceinline__ void top16_merge(unsigned (&a)[16], const unsigned (&b)[16]) {
#pragma unroll
    for (int i = 0; i < 16; ++i) a[i] = max(a[i], b[15 - i]);
    bmerge16_desc(a);
}
__device__ __forceinline__ void top16_partner(unsigned (&a)[16]) {
    unsigned b[16];
#pragma unroll
    for (int i = 0; i < 16; ++i) b[i] = (unsigned)__shfl_xor((int)a[i], 32);
    top16_merge(a, b);
}
__device__ constexpr unsigned char stair(int n) {
    constexpr unsigned char L[64] = {0x00,0x01,0x02,0x03,0x04,0x05,0x06,0x07,0x08,0x09,0x0a,0x0b,0x0c,0x0d,0x0e,0x0f,0x10,0x11,0x12,0x13,0x14,0x15,0x16,0x17,0x20,0x21,0x22,0x23,0x24,0x30,0x31,0x32,
                                     0x33,0x40,0x41,0x42,0x50,0x51,0x60,0x61,0x70,0x71,0x80,0x90,0xa0,0xb0,0xc0,0xd0,0xe0,0xf0,0xff,0xff,0xff,0xff,0xff,0xff,0xff,0xff,0xff,0xff,0xff,0xff,0xff,0xff};
    return L[n];
}
constexpr int TK_KEYS = 32768;
__device__ __forceinline__ void topk_item(const Frame& F, int hh, int tg) {
    const int lane = F.lane, r32 = lane & 31, hi = lane >> 5, tok0 = tg * 32; const size_t tok = (size_t)tok0 + r32;
    LAS int* ktab = (LAS int*)(F.lds + F.wave * 4096) + r32 * 32;
    float ss = 0.f;
    { const f32x4* sp = (const f32x4*)(F.ssp_() + tok * 32 + hi * 16);
#pragma unroll
      for (int j = 0; j < 4; ++j) { const f32x4 v = sp[j]; ss += (v[0] + v[1]) + (v[2] + v[3]); } }
    ss += __shfl_xor(ss, 32);
    const float rs2 = __builtin_amdgcn_rsqf(ss * (1.f / DM) + EPS);
    if (hh == 0 && hi == 0) F.rs2_()[tok] = rs2;
    unsigned top[2][16];
#pragma unroll
    for (int cc = 0; cc < 2; ++cc) {
        f32x16 acc[4] = {};
        const bf16_t* qp = F.qry_() + tok * DM + hh * 256 + cc * 128 + hi * 8; const LAS unsigned char* kl = F.lds + TK_KEYS + cc * 32768;
        bf16x8 qf[8];
#pragma unroll
        for (int s = 0; s < 8; ++s) qf[s] = *(const bf16x8*)(qp + 16 * s);
#pragma unroll
        for (int s = 0; s < 8; ++s) {
#pragma unroll
            for (int kt = 0; kt < 4; ++kt) { const bf16x8 kf = *(const LAS bf16x8*)(kl + KSWZ(kt * 32 + r32, (16 * s + 8 * hi) * 2)); acc[kt] = __builtin_amdgcn_mfma_f32_32x32x16_bf16(kf, qf[s], acc[kt], 0, 0, 0); } }
        unsigned g[4][16];
#pragma unroll
        for (int kt = 0; kt < 4; ++kt) {
#pragma unroll
            for (int r = 0; r < 16; ++r) g[kt][r] = (fl_flip(acc[kt][r]) & ~127u) | (unsigned)(127 - (32 * kt + crow(r, hi)));
            sort16_desc(g[kt]); }
        top16_merge(g[0], g[1]); top16_merge(g[2], g[3]); top16_merge(g[0], g[2]); top16_partner(g[0]);
#pragma unroll
        for (int i = 0; i < 16; ++i) top[cc][i] = g[0][i];
    }
#pragma unroll
    for (int i = 0; i < 16; ++i) ktab[hi * 16 + i] = 127 - (int)((hi ? top[1][i] : top[0][i]) & 127u);
    float s0[16], s1[16];
#pragma unroll
    for (int i = 0; i < 16; ++i) { s0[i] = fl_unflip(top[0][i] & ~127u); s1[i] = fl_unflip(top[1][i] & ~127u); }
    unsigned ca[16], cb[16];
#pragma unroll
    for (int n = 0; n < 32; ++n) { const int A = stair(n), B = stair(25 + n); unsigned va = 0u, vb = 0u;
        if (n < 25) { va = (fl_flip(s0[A >> 4] + s1[A & 15]) & ~255u) | (unsigned)(255 - A); vb = (fl_flip(s0[B >> 4] + s1[B & 15]) & ~255u) | (unsigned)(255 - B); }
        const unsigned v = hi ? vb : va; if (n < 16) ca[n] = v; else cb[n - 16] = v; }
    sort16_desc(ca); sort16_desc(cb); top16_merge(ca, cb); top16_partner(ca);
    float e[16], sum = 0.f; const float mx = fl_unflip(ca[0] & ~255u) * rs2;
#pragma unroll
    for (int i = 0; i < 16; ++i) { e[i] = fexp(fl_unflip(ca[i] & ~255u) * rs2 - mx); sum += e[i]; }
    const float inv = 1.f / sum;
    LDS_WAIT(); asm volatile("" ::: "memory");
    int oi[8]; float og[8];
#pragma unroll
    for (int k = 0; k < 8; ++k) { const unsigned cv = hi ? ca[8 + k] : ca[k]; const int code = 255 - (int)(cv & 255u); og[k] = (hi ? e[8 + k] : e[k]) * inv; oi[k] = ktab[code >> 4] * 128 + ktab[16 + (code & 15)]; }
    { unsigned short* ip = F.idx_() + tok * 128 + hh * 16 + hi * 8; float* gp = F.gate_() + tok * 128 + hh * 16 + hi * 8;
      *(u32x4*)ip = (u32x4){(unsigned)oi[0] | ((unsigned)oi[1] << 16), (unsigned)oi[2] | ((unsigned)oi[3] << 16), (unsigned)oi[4] | ((unsigned)oi[5] << 16), (unsigned)oi[6] | ((unsigned)oi[7] << 16)};
      { const int g0 = hh * 4 + hi * 2;
        *(u32x2*)(F.idxT_() + ((size_t)g0 * T + tok) * 4) = (u32x2){(unsigned)oi[0] | ((unsigned)oi[1] << 16), (unsigned)oi[2] | ((unsigned)oi[3] << 16)};
        *(u32x2*)(F.idxT_() + ((size_t)(g0 + 1) * T + tok) * 4) = (u32x2){(unsigned)oi[4] | ((unsigned)oi[5] << 16), (unsigned)oi[6] | ((unsigned)oi[7] << 16)}; }
      *(f32x4*)gp = (f32x4){og[0], og[1], og[2], og[3]}; *(f32x4*)(gp + 4) = (f32x4){og[4], og[5], og[6], og[7]}; }
    LDS_WAIT(); asm volatile("" ::: "memory");
}

constexpr int PS_NSL = 8, PS_CW = DM / PS_NSL, PS_SUB = PS_NSL / 8, PS_TG = 32, PS_NTG = T / PS_TG;
__device__ __forceinline__ float gelu_tanh(float x) { const float u = 0.7978845608028654f * (x + 0.044715f * x * x * x); const float t = 1.f - 2.f * __builtin_amdgcn_rcpf(1.f + fexp(2.f * u)); return 0.5f * x * (1.f + t); }
__device__ __forceinline__ int dot32n(u32x4 w, u32x4 xh, u32x4 xl) {
    int ph = __builtin_amdgcn_sdot8((int)w.x, (int)xh.x, 0, false); ph = __builtin_amdgcn_sdot8((int)w.y, (int)xh.y, ph, false); ph = __builtin_amdgcn_sdot8((int)w.z, (int)xh.z, ph, false); ph = __builtin_amdgcn_sdot8((int)w.w, (int)xh.w, ph, false);
    int pl = __builtin_amdgcn_sdot8((int)w.x, (int)xl.x, 0, false); pl = __builtin_amdgcn_sdot8((int)w.y, (int)xl.y, pl, false); pl = __builtin_amdgcn_sdot8((int)w.z, (int)xl.z, pl, false); pl = __builtin_amdgcn_sdot8((int)w.w, (int)xl.w, pl, false);
    return (ph << 4) + pl; }
__device__ __forceinline__ unsigned xcc_id() { return (unsigned)__builtin_amdgcn_s_getreg((3 << 11) | 20) & 7u; }
__device__ __forceinline__ bool peer_claim(unsigned* cnt, unsigned x, unsigned& d, int lane, int& q, int& tg) {
    while (d < 8u) { const unsigned xq = (x + d) & 7u; unsigned u = 0u;
        if (lane == 0) u = __hip_atomic_fetch_add(cnt + 64 * xq, 1u, __ATOMIC_RELAXED, __HIP_MEMORY_SCOPE_AGENT);
        u = (unsigned)__builtin_amdgcn_readfirstlane((int)u);
        if (u < (unsigned)(PS_SUB * PS_NTG)) { q = (int)(u / PS_NTG) * 8 + (int)xq; tg = (int)(u % PS_NTG); return true; }
        ++d; }
    return false;
}
template <int CTRL> __device__ __forceinline__ float dppmov(float x) { return __int_as_float(__builtin_amdgcn_update_dpp(0, __float_as_int(x), CTRL, 0xf, 0xf, true)); }
template <int CTRL> __device__ __forceinline__ int dppmovi(int x) { return __builtin_amdgcn_update_dpp(0, x, CTRL, 0xf, 0xf, true); }
__device__ __forceinline__ int bperm(int srclane, int v) { return __builtin_amdgcn_ds_bpermute(srclane << 2, v); }
__device__ __forceinline__ unsigned swar_add8(unsigned q) { return ((q & 0x7f7f7f7fu) + 0x08080808u) ^ (q & 0x80808080u); }
__device__ __forceinline__ void peer_quant_x(const Frame& F) {
    const int gw = F.vcu * 8 + F.wave, NGW = F.G * 8, lane = F.lane;
    for (int tok = gw; tok < T; tok += NGW) { const u32x4* xr = (const u32x4*)(F.x1b_() + (size_t)tok * DM) + lane; f32x4 v[4][2]; float m = 0.f;
#pragma unroll
        for (int j = 0; j < 4; ++j) { const u32x4 w = xr[64 * j]; v[j][0] = (f32x4){bflo(w.x), bfhi(w.x), bflo(w.y), bfhi(w.y)}; v[j][1] = (f32x4){bflo(w.z), bfhi(w.z), bflo(w.w), bfhi(w.w)};
#pragma unroll
            for (int i = 0; i < 4; ++i) m = fmaxf(m, fmaxf(fabsf(v[j][0][i]), fabsf(v[j][1][i]))); }
#pragma unroll
        for (int o = 1; o < 64; o <<= 1) m = fmaxf(m, __shfl_xor(m, o));
        const float inv = m > 0.f ? 119.f / m : 0.f;
#pragma unroll
        for (int j = 0; j < 4; ++j) { const unsigned qa = pack_i8x4(v[j][0], inv, 119.f), qb = pack_i8x4(v[j][1], inv, 119.f);
            const unsigned wl = pack_nib(qa, qb), wh = pack_nib(swar_add8(qa) >> 4, swar_add8(qb) >> 4);
            const int col = 8 * lane + 512 * j; unsigned char* p = F.xq8_() + (size_t)tok * DM + (col >> 8) * 256 + ((col & 255) >> 5) * 32 + ((col & 31) >> 3) * 4;
            *(unsigned*)p = wh; *(unsigned*)(p + 16) = wl; }
        if (lane == 0) F.sx_()[tok] = m * (1.f / 119.f); }
}
__device__ __forceinline__ void peer_down(const Frame& F, int cntw = 1024) {
    const int lane = F.lane, g = lane >> 3, c = lane & 7; const unsigned x = xcc_id(); unsigned d = 0u; int q, tg; unsigned* cnt = (unsigned*)(F.wsb + WS_CTL) + cntw;
    const unsigned char* tab = F.down8_(); const unsigned char* xb = F.xq6_();
    while (peer_claim(cnt, x, d, lane, q, tg)) {
        const unsigned colb = (unsigned)(q * PS_CW + 32 * c), slb = (unsigned)q * (16384u * 128u) + 16u * c; short* part = F.part_() + (size_t)q * T * 128; const size_t tok0 = (size_t)tg * PS_TG;
        u32x4 wA[16], wB[16], xA, xB, yA, yB; int iA0, iA1, iB0, iB1;
#define PD_IDX(i0, i1, tok) do { const unsigned short* ip_ = F.idx_() + (tok) * 128 + lane; i0 = ip_[0]; i1 = ip_[64]; } while (0)
#define PD_ROWS(W_, X_, Y_, i0, i1, tok) do { _Pragma("unroll") for (int j = 0; j < 16; ++j) { const unsigned e_ = (unsigned)bperm(8 * (j & 7) + g, j < 8 ? i0 : i1); \
            W_[j] = *(const u32x4*)(tab + (e_ * 128u + slb)); } X_ = *(const u32x4*)(xb + (tok) * DM + colb); Y_ = *(const u32x4*)(xb + (tok) * DM + colb + 16); } while (0)
#define PD_COMP(W_, X_, Y_, tok) do { u32x4 xh_, xl_;                   \
            xl_.x = pack_nib(X_.x, X_.y); xl_.y = pack_nib(X_.z, X_.w); xl_.z = pack_nib(Y_.x, Y_.y); xl_.w = pack_nib(Y_.z, Y_.w); \
            xh_.x = pack_nib(swar_add8(X_.x) >> 4, swar_add8(X_.y) >> 4); xh_.y = pack_nib(swar_add8(X_.z) >> 4, swar_add8(X_.w) >> 4); xh_.z = pack_nib(swar_add8(Y_.x) >> 4, swar_add8(Y_.y) >> 4); xh_.w = pack_nib(swar_add8(Y_.z) >> 4, swar_add8(Y_.w) >> 4); \
            int p[16]; _Pragma("unroll") for (int j = 0; j < 16; ++j) p[j] = dot32n(W_[j], xh_, xl_); \
            int a1[8], a2[4], a3[2]; \
            _Pragma("unroll") for (int i = 0; i < 8; ++i) { const int keep = (c & 1) ? p[2 * i + 1] : p[2 * i], give = (c & 1) ? p[2 * i] : p[2 * i + 1]; a1[i] = keep + dppmovi<0xB1>(give); } \
            _Pragma("unroll") for (int i = 0; i < 4; ++i) { const int keep = (c & 2) ? a1[2 * i + 1] : a1[2 * i], give = (c & 2) ? a1[2 * i] : a1[2 * i + 1]; a2[i] = keep + dppmovi<0x4E>(give); } \
            _Pragma("unroll") for (int i = 0; i < 2; ++i) { const int keep = (c & 4) ? a2[2 * i + 1] : a2[2 * i], give = (c & 4) ? a2[2 * i] : a2[2 * i + 1]; a3[i] = keep + __shfl_xor(give, 4); } \
            part[(tok) * 128 + 8 * c + g] = (short)min(max(a3[0], -32768), 32767); part[(tok) * 128 + 64 + 8 * c + g] = (short)min(max(a3[1], -32768), 32767); } while (0)
        PD_IDX(iA0, iA1, tok0); PD_IDX(iB0, iB1, tok0 + 1);
        PD_ROWS(wA, xA, yA, iA0, iA1, tok0);
        for (int tt = 0; tt < PS_TG; tt += 2) { const size_t tok = tok0 + tt;
            PD_ROWS(wB, xB, yB, iB0, iB1, tok + 1);
            const size_t t2 = tok + (tt + 2 < PS_TG ? 2 : 0), t3 = tok + (tt + 2 < PS_TG ? 3 : 1);
            PD_IDX(iA0, iA1, t2);
            PD_COMP(wA, xA, yA, tok);
            if (tt + 2 < PS_TG) PD_ROWS(wA, xA, yA, iA0, iA1, t2);
            PD_IDX(iB0, iB1, t3);
            PD_COMP(wB, xB, yB, tok + 1);
        }
#undef PD_IDX
#undef PD_ROWS
#undef PD_COMP
    }
}
__device__ __forceinline__ void peer_coef_probe(const Frame& F, bool dry) {
    typedef short s16x8 __attribute__((ext_vector_type(8)));
    const int gw = F.vcu * 8 + F.wave, NGW = F.G * 8, lane = F.lane, kq = lane & 15, k0 = kq * 8;
    for (int tg = gw; tg < T / 4; tg += NGW) { const int tok = tg * 4 + (lane >> 4); int a[8] = {0, 0, 0, 0, 0, 0, 0, 0};
#pragma unroll
        for (int q = 0; q < PS_NSL; ++q) { const s16x8 v = *(const s16x8*)(F.part_() + ((size_t)q * T + tok) * 128 + k0);
#pragma unroll
            for (int i = 0; i < 8; ++i) a[i] += v[i]; }
        const u32x4 iw = *(const u32x4*)(F.idx_() + (size_t)tok * 128 + k0); const f32x4 g0 = *(const f32x4*)(F.gate_() + (size_t)tok * 128 + k0), g1 = *(const f32x4*)(F.gate_() + (size_t)tok * 128 + k0 + 4);
        const float sc = F.rs2_()[tok] * F.sx_()[tok]; float c[8], m = 0.f;
#pragma unroll
        for (int i = 0; i < 8; ++i) { const unsigned w = iw[i >> 1]; const int e = (i & 1) ? (int)(w >> 16) : (int)(w & 0xffffu); const float g = i < 4 ? g0[i & 3] : g1[i & 3];
            c[i] = g * gelu_tanh((float)a[i] * sc * F.sd_()[e]) * F.su_()[e]; m = fmaxf(m, fabsf(c[i])); }
        m = fmaxf(m, __shfl_xor(m, 1)); m = fmaxf(m, __shfl_xor(m, 2)); m = fmaxf(m, __shfl_xor(m, 4)); m = fmaxf(m, __shfl_xor(m, 8));
        const float inv = m > 0.f ? 127.f / m : 0.f; unsigned lo = 0u, hi = 0u;
#pragma unroll
        for (int i = 0; i < 4; ++i) { lo |= ((unsigned)(int)rintf(c[i] * inv) & 0xffu) << (8 * i); hi |= ((unsigned)(int)rintf(c[4 + i] * inv) & 0xffu) << (8 * i); }
        unsigned* fp = dry ? (unsigned*)(F.wsb + WS_PART + 256 * MiB) : F.fqT_();
        fp[(size_t)(2 * kq) * T + tok] = lo; fp[(size_t)(2 * kq + 1) * T + tok] = hi;
        if (kq == 0 && !dry) F.csum_()[tok] = m * (1.f / 127.f); }
}
#ifndef PROBE_PHASE
#define PROBE_PHASE -1
#endif
#define UP_NREP ((PROBE_PHASE == 10) ? 2 : 1)
constexpr int U2_XO = 131072 + 2048, U2_SF = U2_XO + 8192;
#define PU_T4(ACC_, R0, R1, R2, R3, FQ_) do { const unsigned t0_ = __builtin_amdgcn_perm(R1, R0, 0x05010400u), t1_ = __builtin_amdgcn_perm(R1, R0, 0x07030602u), t2_ = __builtin_amdgcn_perm(R3, R2, 0x05010400u), t3_ = __builtin_amdgcn_perm(R3, R2, 0x07030602u); \
            ACC_[0] = __builtin_amdgcn_sdot4((int)__builtin_amdgcn_perm(t2_, t0_, 0x05040100u), FQ_, ACC_[0], false); ACC_[1] = __builtin_amdgcn_sdot4((int)__builtin_amdgcn_perm(t2_, t0_, 0x07060302u), FQ_, ACC_[1], false); \
            ACC_[2] = __builtin_amdgcn_sdot4((int)__builtin_amdgcn_perm(t3_, t1_, 0x05040100u), FQ_, ACC_[2], false); ACC_[3] = __builtin_amdgcn_sdot4((int)__builtin_amdgcn_perm(t3_, t1_, 0x07060302u), FQ_, ACC_[3], false); } while (0)
__device__ __forceinline__ unsigned u2_addr_lo(unsigned w, unsigned base) { unsigned a; asm("v_mad_u32_u16 %0, %1, 8, %2" : "=v"(a) : "v"(w), "s"(base)); return a; }
__device__ __forceinline__ unsigned u2_addr_hi(unsigned w, unsigned base) { unsigned a; asm("v_mad_u32_u16 %0, %1, 8, %2 op_sel:[1,0,0,0]" : "=v"(a) : "v"(w), "s"(base)); return a; }
__device__ __forceinline__ void peer_up(const Frame& F) {
    const int lane = F.lane;
    for (int cgi = F.vcu; cgi < 256 * UP_NREP; cgi += F.G) { const int cg = cgi & 255; const bool dry = cgi >= 256; float* const ob_ = dry ? (float*)(F.wsb + WS_PART) : F.out; const unsigned tmask_ = dry ? 16383u : 0xffffffffu;
        __syncthreads();
        { const unsigned char* src = F.up8_() + (size_t)(cg >> 3) * (16384 * 64) + (cg & 7) * 8;
#pragma unroll 8
          for (int i = 0; i < 32; ++i) { const int e = F.tid + 512 * i; *(LAS u32x2*)(F.lds + e * 8) = *(const u32x2*)(src + (size_t)e * 64); } }
        __syncthreads();
        u32x2 S0i[8], S1i[8], S2i[8], S3i[8]; int S0f[8], S1f[8], S2f[8], S3f[8]; u32x2 R0[16], R1[16];
        const __amdgpu_buffer_rsrc_t rsI = __builtin_amdgcn_make_buffer_rsrc((void*)F.idxT_(), 0, 32 * T * 8, 0x00020000), rsF = __builtin_amdgcn_make_buffer_rsrc((void*)F.fqT_(), 0, 32 * T * 4, 0x00020000),
            rsX = __builtin_amdgcn_make_buffer_rsrc((void*)F.x1b_(), 0, T * DM * 2, 0x00020000), rsC = __builtin_amdgcn_make_buffer_rsrc((void*)F.csum_(), 0, T * 4, 0x00020000);
#define U2_FENCE() do { asm volatile("" ::: "memory"); SBAR(); } while (0)
#ifdef UP_PROBE_NOCONF
#define U2_IDMASK(id) do { id.x &= idmask_; id.y &= idmask_; } while (0)
        const unsigned idmask_ = dry ? 0u : 0xffffffffu;
#else
#define U2_IDMASK(id) do { } while (0)
#endif
#define U2_LOAD(S_, tok_, s_) do { const unsigned vo_ = (unsigned)(tok_) * 8u; _Pragma("unroll") for (int g = 0; g < 8; ++g) { S_##i[g] = __builtin_amdgcn_raw_buffer_load_b64(rsI, vo_, ((s_) * 8 + g) * (T * 8), 0); \
            S_##f[g] = (int)__builtin_amdgcn_raw_buffer_load_b32(rsF, vo_ >> 1, ((s_) * 8 + g) * (T * 4), 0); } U2_FENCE(); } while (0)
#define U2_ISSUE(R_, S_, h_) do { _Pragma("unroll") for (int g = 0; g < 4; ++g) { u32x2 id = S_##i[(h_) * 4 + g]; U2_IDMASK(id); \
                R_[4 * g + 0] = *(const LAS u32x2*)(uintptr_t)u2_addr_lo(id.x, lbase_); R_[4 * g + 1] = *(const LAS u32x2*)(uintptr_t)u2_addr_hi(id.x, lbase_); \
                R_[4 * g + 2] = *(const LAS u32x2*)(uintptr_t)u2_addr_lo(id.y, lbase_); R_[4 * g + 3] = *(const LAS u32x2*)(uintptr_t)u2_addr_hi(id.y, lbase_); } U2_FENCE(); } while (0)
#define U2_FOLD(R_, S_, h_) do { _Pragma("unroll") for (int g = 0; g < 4; ++g) { const int fq = S_##f[(h_) * 4 + g]; \
                int* a_ = acc; PU_T4(a_, R_[4 * g + 0].x, R_[4 * g + 1].x, R_[4 * g + 2].x, R_[4 * g + 3].x, fq); a_ = acc + 4; PU_T4(a_, R_[4 * g + 0].y, R_[4 * g + 1].y, R_[4 * g + 2].y, R_[4 * g + 3].y, fq); } U2_FENCE(); } while (0)
        const int nb = (T / 64 - F.wave + 7) / 8;
        const unsigned lbase_ = (unsigned)__builtin_amdgcn_readfirstlane((int)(unsigned)(uintptr_t)F.ldsg);
        unsigned lane_; asm volatile("v_mbcnt_lo_u32_b32 %0, -1, 0\n\tv_mbcnt_hi_u32_b32 %0, -1, %0" : "=v"(lane_));
        { const unsigned t0_ = (unsigned)F.wave * 64u + lane_; U2_LOAD(S0, t0_, 0); U2_LOAD(S1, t0_, 1); U2_LOAD(S2, t0_, 2); U2_LOAD(S3, t0_, 3); U2_ISSUE(R0, S0, 0); }
#pragma unroll 1
        for (int i = 0; i < nb; ++i) { const unsigned tok = (unsigned)(F.wave + 8 * i) * 64u + lane_; const unsigned tokn = tok + (i + 1 < nb ? 512u : 0u); int acc[8] = {0, 0, 0, 0, 0, 0, 0, 0};
            __builtin_amdgcn_raw_ptr_buffer_load_lds(rsX, (LAS unsigned*)(F.lds + U2_XO + F.wave * 1024), 16, tok << 12, cg * 16, 0, 0);
            __builtin_amdgcn_raw_ptr_buffer_load_lds(rsC, (LAS unsigned*)(F.lds + U2_SF + F.wave * 256), 4, tok << 2, 0, 0, 0);
            U2_FENCE();
            U2_ISSUE(R1, S0, 1); U2_FOLD(R0, S0, 0);
            U2_ISSUE(R0, S1, 0); U2_FOLD(R1, S0, 1); U2_LOAD(S0, tokn, 0);
            U2_ISSUE(R1, S1, 1); U2_FOLD(R0, S1, 0);
            U2_ISSUE(R0, S2, 0); U2_FOLD(R1, S1, 1); U2_LOAD(S1, tokn, 1);
            U2_ISSUE(R1, S2, 1); U2_FOLD(R0, S2, 0);
            U2_ISSUE(R0, S3, 0); U2_FOLD(R1, S2, 1); U2_LOAD(S2, tokn, 2);
            U2_ISSUE(R1, S3, 1); U2_FOLD(R0, S3, 0);
            U2_ISSUE(R0, S0, 0); U2_FOLD(R1, S3, 1); U2_LOAD(S3, tokn, 3);
            asm volatile("s_waitcnt vmcnt(48)" ::: "memory");
            const u32x4 xo = *(const LAS u32x4*)(F.lds + U2_XO + F.wave * 1024 + lane_ * 16); const float sf = *(const LAS float*)(F.lds + U2_SF + F.wave * 256 + lane_ * 4);
            f32x4 v0 = {bflo(xo.x), bfhi(xo.x), bflo(xo.y), bfhi(xo.y)}, v1 = {bflo(xo.z), bfhi(xo.z), bflo(xo.w), bfhi(xo.w)};
            v0[0] += sf * (float)acc[0]; v0[1] += sf * (float)acc[1]; v0[2] += sf * (float)acc[2]; v0[3] += sf * (float)acc[3]; v1[0] += sf * (float)acc[4]; v1[1] += sf * (float)acc[5]; v1[2] += sf * (float)acc[6]; v1[3] += sf * (float)acc[7];
            float* dp = ob_ + (size_t)((tok & tmask_) * DM) + cg * 8; *(f32x4*)dp = v0; *(f32x4*)(dp + 4) = v1; U2_FENCE(); }
        LDS_WAIT();
#undef U2_ISSUE
#undef U2_FOLD
#undef U2_FENCE
#undef U2_LOAD
    }
}
#undef PU_T4


#ifdef VALU_PROBE
__device__ __forceinline__ void valu_probe(const Frame& F) {
    unsigned a[16];
#pragma unroll
    for (int j = 0; j < 16; ++j) a[j] = F.tid * 17u + j * 0x01010101u;
    unsigned b = F.tid * 3u + 0x05040100u, c = 0x3c003c00u ^ F.tid;
#pragma unroll 1
    for (int it = 0; it < 1024; ++it) {
#pragma unroll
        for (int r = 0; r < 4; ++r) {
#pragma unroll
            for (int j = 0; j < 16; ++j) {
#if VALU_PROBE == 0
                asm volatile("v_add_u32 %0, %0, %1" : "+v"(a[j]) : "v"(b));
#elif VALU_PROBE == 1
                asm volatile("v_perm_b32 %0, %0, %1, %2" : "+v"(a[j]) : "v"(b), "v"(c));
#elif VALU_PROBE == 2
                asm volatile("v_dot4c_i32_i8 %0, %1, %2" : "+v"(a[j]) : "v"(b), "v"(c));
#elif VALU_PROBE == 3
                asm volatile("v_mad_u32_u16 %0, %1, %2, %0 op_sel:[1,0,0,0]" : "+v"(a[j]) : "v"(b), "v"(c));
#elif VALU_PROBE == 4
                asm volatile("v_and_b32 %0, %0, %1" : "+v"(a[j]) : "v"(b));
#elif VALU_PROBE == 5
                asm volatile("v_lshl_add_u32 %0, %0, 3, %1" : "+v"(a[j]) : "v"(b));
#elif VALU_PROBE == 6
                asm volatile("v_bfe_u32 %0, %0, 3, 14" : "+v"(a[j]));
#elif VALU_PROBE == 7
                asm volatile("v_dot4_i32_i8 %0, %1, %2, %0" : "+v"(a[j]) : "v"(b), "v"(c));
#endif
            } } }
    unsigned s = 0;
#pragma unroll
    for (int j = 0; j < 16; ++j) s ^= a[j];
    ((unsigned*)(F.wsb + WS_PART))[(size_t)F.vcu * 512 + F.tid] = s;
}
#endif

#define XB_TMO      128
#define XB_XCNT(j)  (256  + 64 * (j))
#define XB_XSUB(j)  (1280 + 64 * (j))
#define XB_XGEN(j)  (2304 + 64 * (j))
#define XB_TOP      3328
#define XB_TOPGEN   3392
#define XCD_BAR_WORDS 3456
#define XB_SPIN_CAP (1u << 18)

__device__ __forceinline__ unsigned xb_ld(unsigned* p)              { return __hip_atomic_load(p, __ATOMIC_RELAXED, __HIP_MEMORY_SCOPE_AGENT); }
__device__ __forceinline__ unsigned xb_add(unsigned* p, unsigned v) { return __hip_atomic_fetch_add(p, v, __ATOMIC_RELAXED, __HIP_MEMORY_SCOPE_AGENT); }
__device__ __forceinline__ unsigned xb_xcc_id() { return (unsigned)__builtin_amdgcn_s_getreg((3 << 11) | 20) & 0xFu; }
#define XB_SPIN(cond, bar) do { unsigned _sp = 0; while (cond) { __builtin_amdgcn_s_sleep(1); \
    if ((++_sp & 255u) == 0u) { if (xb_ld(&(bar)[XB_TMO])) break; if (_sp > XB_SPIN_CAP) { atomicAdd(&(bar)[XB_TMO], 1u); break; } } } } while (0)

struct XcdBarrier {
    unsigned* bar; unsigned x;
    volatile LAS unsigned* st;
};

__device__ __forceinline__ XcdBarrier xcd_barrier_post(unsigned* bar, volatile LAS unsigned* st) {
    XcdBarrier b; b.bar = bar; b.x = xb_xcc_id(); b.st = st;
    if (threadIdx.x == 0) (void)xb_add(&bar[XB_XCNT(b.x)], 1u);
    return b;
}
__device__ __forceinline__ void xcd_barrier_complete(unsigned* bar, unsigned x, unsigned& nloc, unsigned& nx) {
    const unsigned G = gridDim.x * gridDim.y * gridDim.z;
    unsigned sum, cnt, mine, sp = 0u;
    for (;;) {
        sum = 0u; cnt = 0u; mine = 0u;
#pragma unroll
        for (unsigned j = 0; j < 16; ++j) { const unsigned c = xb_ld(&bar[XB_XCNT(j)]); sum += c; cnt += (c > 0u) ? 1u : 0u; mine = (j == x) ? c : mine; }
        if (sum == G) break;
        __builtin_amdgcn_s_sleep(1);
        if ((++sp & 255u) == 0u) { if (xb_ld(&bar[XB_TMO])) break; if (sp > XB_SPIN_CAP) { atomicAdd(&bar[XB_TMO], 1u); break; } }
    }
    nloc = mine > 0u ? mine : 1u; nx = cnt > 0u ? cnt : 1u;
}

__device__ __forceinline__ void xcd_barrier(const XcdBarrier& b) {
    asm volatile("s_waitcnt vmcnt(0)" ::: "memory");
    __syncthreads();
    if (threadIdx.x == 0) {
        unsigned* bar = b.bar;
        __builtin_amdgcn_s_waitcnt(0);
        unsigned nloc = b.st[0], nx = b.st[1];
        if (nloc == 0u) { xcd_barrier_complete(bar, b.x, nloc, nx); b.st[0] = nloc; b.st[1] = nx; }
        const unsigned old = xb_add(&bar[XB_XSUB(b.x)], 1u);
        const unsigned gen = old / nloc;
        if (old + 1u == (gen + 1u) * nloc) {
            __builtin_amdgcn_fence(__ATOMIC_RELEASE, "agent");
            asm volatile("s_waitcnt vmcnt(0)" ::: "memory");
            const unsigned og = xb_add(&bar[XB_TOP], 1u);
            const unsigned tg = og / nx;
            if (og + 1u == (tg + 1u) * nx) xb_add(&bar[XB_TOPGEN], 1u);
            else XB_SPIN(xb_ld(&bar[XB_TOPGEN]) == tg, bar);
            __builtin_amdgcn_fence(__ATOMIC_ACQUIRE, "agent");
            xb_add(&bar[XB_XGEN(b.x)], 1u);
            asm volatile("s_waitcnt vmcnt(0)" ::: "memory");
        } else {
            XB_SPIN(xb_ld(&bar[XB_XGEN(b.x)]) == gen, bar);
            __builtin_amdgcn_fence(__ATOMIC_ACQUIRE, "agent");
            asm volatile("s_waitcnt vmcnt(0)" ::: "memory");
        }
    }
    __syncthreads();
}

struct Args { const float* in[16]; float* out; unsigned char* ws; int ph_lo, ph_hi, coop, pad; };
__global__ void __launch_bounds__(512, 2) fwd_kernel(Args args) {
    extern __shared__ __attribute__((aligned(16))) unsigned char lds_raw[];
    Frame F;
    F.lds = (LAS unsigned char*)lds_raw; F.ldsg = (char*)lds_raw;
    F.tid = threadIdx.x; F.lane = F.tid & 63; F.wave = __builtin_amdgcn_readfirstlane(F.tid >> 6);
    F.G = gridDim.x; { const int bx = blockIdx.x; F.vcu = (F.G % 8 == 0) ? (bx % 8) * (F.G / 8) + bx / 8 : bx; }
    F.x = args.in[0]; F.norm1_g = args.in[1]; F.w_in = args.in[2]; F.up_f = args.in[3]; F.bias_f = args.in[4]; F.up_b = args.in[5]; F.bias_b = args.in[6]; F.out_g = args.in[7];
    F.qn_g = args.in[8]; F.kn_g = args.in[9]; F.w_out = args.in[10]; F.norm2_g = args.in[11]; F.w_query = args.in[12]; F.sub_keys = args.in[13]; F.peer_down = args.in[14]; F.peer_up = args.in[15];
    F.out = args.out; unsigned char* ws = args.ws; F.wsb = ws;
    constexpr int MISC_OFF = 131072 + 320;
    for (int u = F.tid; u < 64; u += 512) ((LAS unsigned*)(F.lds + MISC_OFF))[u] = 0u;
    __syncthreads();
    XcdBarrier bar = xcd_barrier_post((unsigned*)(ws + WS_CTL) + 8192, (volatile LAS unsigned*)(F.lds + MISC_OFF) + 8);
    const int lo = args.ph_lo, hi = args.ph_hi;
#ifndef PH_MASK
#define PH_MASK 0x7ff
#endif
#ifndef PROBE_PHASE
#define PROBE_PHASE -1
#endif
#define REP(k) for (int rep_ = 0; rep_ < ((PROBE_PHASE == (k)) ? 2 : 1); ++rep_)
#define IN(k) (((PH_MASK >> (k)) & 1) && lo <= (k) && (k) < hi)
#define SEAM(k) do { if (IN(k) && IN((k) + 1)) { if (args.coop) { if ((k) == 0) cg::this_grid().sync(); else xcd_barrier(bar); } } } while (0)
    if (IN(0)) { REP(0) phase0(F); } SEAM(0);
#define GEMM1_BODY { pg8::Gemm g{(const pg8::bf16_t*)F.xq1_(), (const pg8::bf16_t*)F.Win8_(), T, HP, DM / 2}; pg8::StaticOrder S; S.init(T, HP, F.G, (int)blockIdx.x); \
        pg8::EpiI8Qk E{F.h_(), HP, F.rs1_(), F.sw_(), F.qn_g, F.kn_g, (LAS float*)(F.lds + 131072 + 1024), C_QD / 256, C_KD / 256, C_VD / 256, SEQ - 1, QSCALE}; \
        pg8::gemm_phase<pg8::EpiI8Qk, pg8::StaticOrder, PG8_ALIGN, PG8_SP2, true>(F.lds, g, S, E); }
    if (IN(1)) { wq_quant_transpose(F); GEMM1_BODY; if (PROBE_PHASE == 1) GEMM1_BODY; } SEAM(1);
    if (IN(2)) { REP(2) for (int it = F.vcu; it < 2048; it += F.G) gla_passA(F, it); } SEAM(2);
    if (IN(3)) { for (int it = F.vcu; it < 256; it += F.G) gla_scan(F, it); REP(3) attn_phase(F); } SEAM(3);
    if (IN(4)) REP(4) { for (int it = F.vcu; it < 2048; it += F.G) gla_passC(F, it); dil_combine(F); } SEAM(4);
#define GEMM5_BODY { pg8::Gemm g{F.mixed_(), F.WoT_(), T, DM, DM}; pg8::StaticOrder S; S.init(T, DM, F.G, (int)blockIdx.x); pg8::EpiResid E{F.x, F.out, F.x1b_(), F.ssp_(), DM, F.sx_(), F.xq6_()}; \
        pg8::gemm_phase<pg8::EpiResid, pg8::StaticOrder, PG8_ALIGN, PG8_SP2>(F.lds, g, S, E); }
#define GEMM6_BODY { pg8::Gemm g{(const pg8::bf16_t*)F.xq6_(), (const pg8::bf16_t*)F.Wq8_(), T, DM, DM / 2}; pg8::StaticOrder S; S.init(T, DM, F.G, (int)blockIdx.x); \
        pg8::EpiI8Qk E{F.qry_(), DM, F.sx_(), F.swq_(), nullptr, nullptr, (LAS float*)(F.lds + 131072 + 1024), 0, 0, 0, 0, 0.f}; \
        pg8::gemm_phase<pg8::EpiI8Qk, pg8::StaticOrder, PG8_ALIGN, PG8_SP2, true>(F.lds, g, S, E); }
    if (IN(5)) { GEMM5_BODY; if (PROBE_PHASE == 5) GEMM5_BODY; } SEAM(5);
    if (IN(6)) { GEMM6_BODY; if (PROBE_PHASE == 6) GEMM6_BODY; } SEAM(6);
    if (IN(7)) REP(7) { const int gw = F.vcu * 8 + F.wave, NGW = F.G * 8; for (int u = F.vcu; u < 256; u += F.G) { const int hh = u & 7, chunk = u >> 3;
            __syncthreads();
            for (int i = F.tid; i < 4096; i += 512) { const int row = i >> 4, ch = i & 15; *(LAS u32x4*)(F.lds + TK_KEYS + KSWZ(row, ch * 16)) = *(const u32x4*)(F.SK_() + ((size_t)hh * 256 + row) * 128 + ch * 8); }
            __syncthreads();
            for (int j = 0; j < 4; ++j) topk_item(F, hh, chunk * 32 + F.wave * 4 + j); }
    } SEAM(7);
    if (IN(8)) { if (PROBE_PHASE == 8) peer_down(F, 3072); peer_down(F); } SEAM(8);
    if (IN(9)) { REP(9) peer_coef_probe(F, (PROBE_PHASE == 9) && rep_ == 0); } SEAM(9);
    if (IN(10)) peer_up(F);
#ifdef VALU_PROBE
    valu_probe(F);
#endif
#undef IN
#undef SEAM
}

#ifndef MK_N_LAUNCHES
#define MK_N_LAUNCHES 1
#endif
extern "C" void kernel_launch(void* const* d_in, const int* in_sizes, int n_in, void* d_out, int out_size, void* d_ws, size_t ws_size, hipStream_t stream) {
    static int grid = 0;
    if (grid == 0) {
        if (n_in != 16 || in_sizes[0] != T * DM || out_size != T * DM || ws_size < WS_END) { fprintf(stderr, "kernel_launch: unexpected shapes (n_in %d, in0 %d, out %d, ws %zu)\n", n_in, n_in > 0 ? in_sizes[0] : -1, out_size, ws_size); grid = -1; return; }
        int dev = 0, cus = 0, per_cu = 0;
        if (hipGetDevice(&dev) != hipSuccess || hipDeviceGetAttribute(&cus, hipDeviceAttributeMultiprocessorCount, dev) != hipSuccess) { grid = -1; return; }
        if (hipFuncSetAttribute((const void*)fwd_kernel, hipFuncAttributeMaxDynamicSharedMemorySize, LDS_BYTES) != hipSuccess) { fprintf(stderr, "kernel_launch: hipFuncSetAttribute failed\n"); grid = -1; return; }
        if (hipOccupancyMaxActiveBlocksPerMultiprocessor(&per_cu, (const void*)fwd_kernel, 512, LDS_BYTES) != hipSuccess || per_cu < 1) { fprintf(stderr, "kernel_launch: occupancy query says %d\n", per_cu); per_cu = 1; }
        (void)hipGetLastError();
        grid = cus;
    }
    if (grid < 0) return;
    if (hipMemsetAsync(d_ws, 0, 65536, stream) != hipSuccess) { fprintf(stderr, "kernel_launch: hipMemsetAsync failed\n"); return; }
    Args a{};
    for (int i = 0; i < 16; ++i) a.in[i] = (const float*)d_in[i];
    a.out = (float*)d_out; a.ws = (unsigned char*)d_ws;
    if (MK_N_LAUNCHES == 1) {
        a.ph_lo = 0; a.ph_hi = NPHASE; a.coop = 1; void* kargs[] = {&a};
        hipError_t e = hipLaunchCooperativeKernel((const void*)fwd_kernel, dim3(grid), dim3(512), kargs, LDS_BYTES, stream);
        if (e != hipSuccess) fprintf(stderr, "kernel_launch: cooperative launch failed: %s (grid %d)\n", hipGetErrorString(e), grid);
    } else {
        for (int p = 0; p < NPHASE; ++p) { a.ph_lo = p; a.ph_hi = p + 1; a.coop = 0; hipLaunchKernelGGL(fwd_kernel, dim3(grid), dim3(512), LDS_BYTES, stream, a); }
        const hipError_t le = hipPeekAtLastError(); if (le != hipSuccess) fprintf(stderr, "kernel_launch: launch failed: %s\n", hipGetErrorName(le));
    }
}
```

```cpp
#include <hip/hip_runtime.h>
#include <hip/hip_cooperative_groups.h>
#include <cstdio>
#include <cstdint>
namespace cg = cooperative_groups;
namespace pg8 {
#define PG8_LAS __attribute__((address_space(3)))
typedef unsigned short bf16_t;
typedef short bf16x8 __attribute__((ext_vector_type(8)));
typedef float f32x4 __attribute__((ext_vector_type(4)));
typedef unsigned u32x4 __attribute__((ext_vector_type(4)));
constexpr int BM = 256, BK = 64, HALF = 128, HTB = HALF * BK * 2  , STAGE_BYTES = 8 * HTB, NXCD = 8, WGM = 8;

__host__ __device__ __forceinline__ int lds_byte(int r, int c) { const int st = (r >> 4) * 2 + (c >> 5), rr = r & 15, cc = c & 31, ob = rr * 64 + cc * 2; return st * 1024 + (ob ^ (((ob >> 9) & 1) << 5)); }
__host__ __device__ __forceinline__ void stage_rc(int b, int& R, int& C) { const int st = b / 1024, sb = b % 1024, swz = sb ^ (((sb >> 9) & 1) << 5); R = (st >> 1) * 16 + swz / 64; C = (st & 1) * 32 + (swz % 64) / 2; }
__host__ __device__ __forceinline__ int perm32(int rho) { const int n = rho >> 4, i = rho & 15; return 8 * (i >> 2) + 4 * n + (i & 3); }

struct Unit { int pm, pn; };
struct Gemm { const bf16_t* A; const bf16_t* Bt; int M, N, K; };

struct StaticOrder {
    int nM, nN, nwg, G, c;
    __host__ __device__ void init(int M, int N, int G_, int c_) { nM = M / BM; nN = N / BM; nwg = nM * nN; G = G_; c = c_; }
    __host__ __device__ bool next(int i, Unit& u) const {
        const long L = (long)i * G + c; if (L >= nwg) return false;
        int wgid = (int)L; { const int q = nwg / NXCD, r = nwg % NXCD, xcd = wgid % NXCD, off = wgid / NXCD; wgid = (xcd < r ? xcd * (q + 1) : r * (q + 1) + (xcd - r) * q) + off; }
        const int nig = WGM * nN, gid = wgid / nig, fm = gid * WGM, gsz = (nM - fm) < WGM ? (nM - fm) : WGM;
        u.pm = fm + ((wgid % nig) % gsz); u.pn = (wgid % nig) / gsz; return true;
    }
    __device__ __forceinline__ void a_ready(const Unit&) const {}
    __device__ __forceinline__ void done(const Unit&) const {}
};
__device__ __forceinline__ unsigned cvt_pk_bf16(float lo, float hi) { unsigned r; asm volatile("v_cvt_pk_bf16_f32 %0, %1, %2" : "=v"(r) : "v"(lo), "v"(hi)); return r; }
typedef int i32x4 __attribute__((ext_vector_type(4)));
template <bool I8> struct AccT { typedef f32x4 type; };
template <> struct AccT<true> { typedef i32x4 type; };
struct EpiRowScaleBf16 {
    static constexpr bool PERM = true, AFTER_DRAIN = false;
    bf16_t* O; int ldc; const float* rs;
    __device__ __forceinline__ void operator()(const f32x4 (&acc)[2][2][4][2], const Unit& u, int wr, int wc, int fr, int fq) const {
        const int row0 = u.pm * BM + wr * 64 + fr, col0 = u.pn * BM + wc * 32 + 8 * fq;
#pragma unroll
        for (int ai = 0; ai < 2; ++ai)
#pragma unroll
            for (int m = 0; m < 4; ++m) { const int row = row0 + ai * HALF + m * 16; const float s = rs ? rs[row] : 1.f; bf16_t* rowp = O + (size_t)row * ldc + col0;
#pragma unroll
                for (int bj = 0; bj < 2; ++bj) { const f32x4 v0 = acc[ai][bj][m][0] * s, v1 = acc[ai][bj][m][1] * s;
                    u32x4 w; w.x = cvt_pk_bf16(v0[0], v0[1]); w.y = cvt_pk_bf16(v0[2], v0[3]); w.z = cvt_pk_bf16(v1[0], v1[1]); w.w = cvt_pk_bf16(v1[2], v1[3]);
                    *(u32x4*)(rowp + bj * HALF) = w; } }
    }
};
struct EpiI8Qk {
    static constexpr bool PERM = true, AFTER_DRAIN = false;
    bf16_t* O; int ldc; const float* rs; const float* cs; const float* qg; const float* kg; PG8_LAS float* P; int qk_lo, q_hi, qk_hi, seqmask; float qscale;
    __device__ __forceinline__ void operator()(const i32x4 (&acc)[2][2][4][2], const Unit& u, int wr, int wc, int fr, int fq) const {
        const int row0 = u.pm * BM + wr * 64 + fr, col0 = u.pn * BM + wc * 32 + 8 * fq;
        f32x4 cv[2][2];
#pragma unroll
        for (int bj = 0; bj < 2; ++bj) { cv[bj][0] = *(const f32x4*)(cs + col0 + bj * HALF); cv[bj][1] = *(const f32x4*)(cs + col0 + bj * HALF + 4); }
        const bool qk = u.pn >= qk_lo && u.pn < qk_hi;
        float rq[2][4][2];
        if (qk) {
#pragma unroll
            for (int ai = 0; ai < 2; ++ai)
#pragma unroll
                for (int m = 0; m < 4; ++m) { const float s = rs[row0 + ai * HALF + m * 16]; const int rl = ai * HALF + wr * 64 + m * 16 + fr;
#pragma unroll
                    for (int bj = 0; bj < 2; ++bj) { const i32x4 a0 = acc[ai][bj][m][0], a1 = acc[ai][bj][m][1]; const f32x4 c0 = cv[bj][0] * s, c1 = cv[bj][1] * s; float ss = 0.f;
#pragma unroll
                        for (int i = 0; i < 4; ++i) { const float x0 = (float)a0[i] * c0[i], x1 = (float)a1[i] * c1[i]; ss += x0 * x0 + x1 * x1; }
                        ss += __shfl_xor(ss, 16); ss += __shfl_xor(ss, 32);
                        if (fq == 0) P[rl * 8 + bj * 4 + wc] = ss; } }
            asm volatile("s_waitcnt lgkmcnt(0)" ::: "memory"); __builtin_amdgcn_s_barrier(); asm volatile("" ::: "memory");
#pragma unroll
            for (int ai = 0; ai < 2; ++ai)
#pragma unroll
                for (int m = 0; m < 4; ++m) { const int rl = ai * HALF + wr * 64 + m * 16 + fr;
#pragma unroll
                    for (int bj = 0; bj < 2; ++bj) { const f32x4 p = *(const PG8_LAS f32x4*)(P + rl * 8 + bj * 4); rq[ai][m][bj] = __builtin_amdgcn_rsqf(((p[0] + p[1]) + (p[2] + p[3])) * (1.f / 128.f) + 1e-6f); } }
        }
        const bool isq = u.pn < q_hi; const float* gp = (isq ? qg : kg) + wc * 32 + 8 * fq; f32x4 g0 = {1.f, 1.f, 1.f, 1.f}, g1 = g0;
        if (qk) { g0 = *(const f32x4*)gp; g1 = *(const f32x4*)(gp + 4); if (isq) { g0 = g0 * qscale; g1 = g1 * qscale; } }
        constexpr float RV[16] = {1.591549431e-01f, 7.008652159e-02f, 3.086376340e-02f, 1.359137064e-02f, 5.985185713e-03f, 2.635675899e-03f, 1.160663641e-03f, 5.111175045e-04f, 2.250790790e-04f, 9.911730937e-05f, 4.364795279e-05f, 1.922110068e-05f, 8.464330808e-06f, 3.727408602e-06f, 1.641426263e-06f, 7.228293069e-07f};
#pragma unroll
        for (int ai = 0; ai < 2; ++ai)
#pragma unroll
            for (int m = 0; m < 4; ++m) { const int row = row0 + ai * HALF + m * 16; const float s = rs[row]; bf16_t* rowp = O + (size_t)row * ldc + col0;
                float cs8[8], sn8[8];
                if (qk && wc == 0) { const float pos = (float)(row & seqmask);
#pragma unroll
                    for (int e8 = 0; e8 < 8; ++e8) { const float rev = pos * ((fq & 1) ? RV[8 + e8] : RV[e8]); const float fr_ = rev - __builtin_floorf(rev); cs8[e8] = __builtin_amdgcn_cosf(fr_); sn8[e8] = __builtin_amdgcn_sinf(fr_); } }
#pragma unroll
                for (int bj = 0; bj < 2; ++bj) { const i32x4 a0 = acc[ai][bj][m][0], a1 = acc[ai][bj][m][1]; const float sq = qk ? s * rq[ai][m][bj] : s; const f32x4 c0 = cv[bj][0] * sq * g0, c1 = cv[bj][1] * sq * g1;
                    float v[8];
#pragma unroll
                    for (int i = 0; i < 4; ++i) { v[i] = (float)a0[i] * c0[i]; v[4 + i] = (float)a1[i] * c1[i]; }
                    if (qk && wc == 0) {
#pragma unroll
                        for (int e8 = 0; e8 < 8; ++e8) { const float pr = __shfl_xor(v[e8], 32); v[e8] = (fq < 2) ? (v[e8] * cs8[e8] - pr * sn8[e8]) : (v[e8] * cs8[e8] + pr * sn8[e8]); } }
                    u32x4 w; w.x = cvt_pk_bf16(v[0], v[1]); w.y = cvt_pk_bf16(v[2], v[3]); w.z = cvt_pk_bf16(v[4], v[5]); w.w = cvt_pk_bf16(v[6], v[7]);
                    *(u32x4*)(rowp + bj * HALF) = w; } }
    }
};
__device__ __forceinline__ unsigned epi_pack8(const f32x4 v, float inv) { unsigned w = 0u;
#pragma unroll
    for (int i = 0; i < 4; ++i) { const int qv = (int)fminf(fmaxf(rintf(v[i] * inv), -119.f), 119.f); w |= ((unsigned)qv & 0xffu) << (8 * i); }
    return w; }
__device__ __forceinline__ unsigned epi_add8(unsigned q) { return ((q & 0x7f7f7f7fu) + 0x08080808u) ^ (q & 0x80808080u); }
__device__ __forceinline__ unsigned epi_nib(unsigned a, unsigned b) { return (a & 0x0F0F0F0Fu) | ((b & 0x0F0F0F0Fu) << 4); }
struct EpiResid {
    static constexpr bool PERM = true, AFTER_DRAIN = false;
    const float* x; float* out; bf16_t* xb; float* ssp; int ldc; const float* sx; unsigned char* xq;
    __device__ __forceinline__ void operator()(const f32x4 (&acc)[2][2][4][2], const Unit& u, int wr, int wc, int fr, int fq) const {
        const int row0 = u.pm * BM + wr * 64 + fr, col0 = u.pn * BM + wc * 32 + 8 * fq;
#pragma unroll
        for (int ai = 0; ai < 2; ++ai)
#pragma unroll
            for (int m = 0; m < 4; ++m) { const int row = row0 + ai * HALF + m * 16; const size_t off = (size_t)row * ldc + col0; float ss = 0.f; const float sxr = sx[row], inv = sxr > 0.f ? 1.f / sxr : 0.f;
#pragma unroll
                for (int bj = 0; bj < 2; ++bj) { const f32x4 xa = *(const f32x4*)(x + off + bj * HALF), xc = *(const f32x4*)(x + off + bj * HALF + 4);
                    const f32x4 v0 = acc[ai][bj][m][0] + xa, v1 = acc[ai][bj][m][1] + xc;
                    u32x4 w; w.x = cvt_pk_bf16(v0[0], v0[1]); w.y = cvt_pk_bf16(v0[2], v0[3]); w.z = cvt_pk_bf16(v1[0], v1[1]); w.w = cvt_pk_bf16(v1[2], v1[3]);
                    *(u32x4*)(xb + off + bj * HALF) = w;
                    const unsigned qa = epi_pack8(v0, inv), qb = epi_pack8(v1, inv);
                    { typedef unsigned u32x2e __attribute__((ext_vector_type(2))); *(u32x2e*)(xq + off + bj * HALF) = (u32x2e){qa, qb}; }
                    ss += (v0[0] * v0[0] + v0[1] * v0[1]) + (v0[2] * v0[2] + v0[3] * v0[3]) + (v1[0] * v1[0] + v1[1] * v1[1]) + (v1[2] * v1[2] + v1[3] * v1[3]); }
                ss += __shfl_xor(ss, 16); ss += __shfl_xor(ss, 32);
                if (fq == 0) ssp[(size_t)row * 32 + u.pn * 4 + wc] = ss; }
    }
};
template <class Epi, class Sched, bool ALIGN_EPI = false, bool SP2 = false, bool I8 = false>
__device__ __forceinline__ void gemm_phase(PG8_LAS unsigned char* lds, const Gemm g, const Sched& S, const Epi& E) {
    const int tid = threadIdx.x, wid = __builtin_amdgcn_readfirstlane(tid >> 6), lane = tid & 63, wr = wid >> 2, wc = wid & 3, fr = lane & 15, fq = lane >> 4;
    const int K = g.K, nt = K / BK;
    unsigned voffA[2], voffB[2];
#pragma unroll
    for (int i = 0; i < 2; ++i) { int R, C; stage_rc(tid * 16 + i * 8192, R, C); const int Rb = Epi::PERM ? ((R & ~31) + perm32(R & 31)) : R;
        voffA[i] = (unsigned)(R * K + C) * 2u; voffB[i] = (unsigned)(Rb * K + C) * 2u; }
    const size_t kstep = (size_t)(BK * 2);
    const size_t hstep = (size_t)HALF * K * 2;
    const size_t tstep = 2 * hstep;
    const unsigned ldsw = (unsigned)wid * 1024u;
    const int aoff = lds_byte(wr * 64 + fr, fq * 8), boff = lds_byte(wc * 32 + fr, fq * 8);
#define PG8_SA(b, h) (((b) * 2 + (h)) * HTB)
#define PG8_SB(b, h) ((4 + (b) * 2 + (h)) * HTB)
#define PG8_STAGE(bufoff, gbase, voff) do { _Pragma("unroll") for (int _i = 0; _i < 2; ++_i) \
        __builtin_amdgcn_global_load_lds((const unsigned*)((const char*)(gbase) + (voff)[_i]), (PG8_LAS unsigned*)(lds + (bufoff) + ldsw + _i * 8192), 16, 0, 0); } while (0)
#define PG8_LDA(dst, b, h) do { _Pragma("unroll") for (int m = 0; m < 4; ++m) _Pragma("unroll") for (int k = 0; k < 2; ++k) dst[m][k] = *(const PG8_LAS bf16x8*)(lds + PG8_SA(b, h) + aoff + m * 2048 + k * 1024); } while (0)
#define PG8_LDB(dst, b, h) do { _Pragma("unroll") for (int n = 0; n < 2; ++n) _Pragma("unroll") for (int k = 0; k < 2; ++k) dst[n][k] = *(const PG8_LAS bf16x8*)(lds + PG8_SB(b, h) + boff + n * 2048 + k * 1024); } while (0)
#define PG8_MMA(ai, bj, At, Bt) do { __builtin_amdgcn_s_setprio(1); _Pragma("unroll") for (int m = 0; m < 4; ++m) _Pragma("unroll") for (int n = 0; n < 2; ++n) _Pragma("unroll") for (int k = 0; k < 2; ++k) { \
        if constexpr (I8) acc[ai][bj][m][n] = __builtin_amdgcn_mfma_i32_16x16x64_i8(__builtin_bit_cast(i32x4, Bt[n][k]), __builtin_bit_cast(i32x4, At[m][k]), acc[ai][bj][m][n], 0, 0, 0); \
        else acc[ai][bj][m][n] = __builtin_amdgcn_mfma_f32_16x16x32_bf16(Bt[n][k], At[m][k], acc[ai][bj][m][n], 0, 0, 0); } __builtin_amdgcn_s_setprio(0); } while (0)
#define PG8_WAIT_V(n) asm volatile("s_waitcnt vmcnt(" #n ")" ::: "memory")
#define PG8_WAIT_L(n) asm volatile("s_waitcnt lgkmcnt(" #n ")" ::: "memory")
#define PG8_BAR __builtin_amdgcn_s_barrier()
#define PG8_SCHED __builtin_amdgcn_sched_barrier(0)
    Unit cur, nxt; int ui = 0;
    if (!S.next(0, cur)) return;
    typename AccT<I8>::type acc[2][2][4][2];
#pragma unroll
    for (int a = 0; a < 2; ++a)
#pragma unroll
        for (int b = 0; b < 2; ++b)
#pragma unroll
            for (int m = 0; m < 4; ++m)
#pragma unroll
                for (int n = 0; n < 2; ++n) acc[a][b][m][n] = (typename AccT<I8>::type){};
    bf16x8 At[4][2], B0[2][2], B1[2][2];
    const char* cA = (const char*)g.A + (size_t)cur.pm * tstep; const char* cB = (const char*)g.Bt + (size_t)cur.pn * tstep;
    S.a_ready(cur);
    if constexpr (SP2) {
        PG8_STAGE(PG8_SB(0, 0), cB, voffB); PG8_STAGE(PG8_SB(0, 1), cB + hstep, voffB); PG8_STAGE(PG8_SA(0, 0), cA, voffA); PG8_STAGE(PG8_SA(0, 1), cA + hstep, voffA);
        if (wr == 1) PG8_BAR;
        PG8_WAIT_V(2); PG8_BAR;
        PG8_STAGE(PG8_SB(1, 0), cB + kstep, voffB); PG8_STAGE(PG8_SA(1, 0), cA + kstep, voffA); PG8_STAGE(PG8_SB(1, 1), cB + hstep + kstep, voffB);
        PG8_WAIT_V(6); PG8_BAR;
    } else {
        PG8_STAGE(PG8_SB(0, 0), cB, voffB); PG8_STAGE(PG8_SA(0, 0), cA, voffA); PG8_STAGE(PG8_SB(0, 1), cB + hstep, voffB); PG8_STAGE(PG8_SA(0, 1), cA + hstep, voffA);
        if (wr == 1) PG8_BAR;
        PG8_WAIT_V(4); PG8_BAR;
        PG8_STAGE(PG8_SB(1, 0), cB + kstep, voffB); PG8_STAGE(PG8_SA(1, 0), cA + kstep, voffA); PG8_STAGE(PG8_SB(1, 1), cB + hstep + kstep, voffB);
        PG8_WAIT_V(6); PG8_BAR;
    }
    for (;;) {
        const bool has_next = S.next(ui + 1, nxt);
        const char* nA = has_next ? (const char*)g.A + (size_t)nxt.pm * tstep : cA; const char* nB = has_next ? (const char*)g.Bt + (size_t)nxt.pn * tstep : cB;
        for (int t = 0; t < nt; t += 2) {
            const bool last = (t == nt - 2);
            const char* a1 = cA + (size_t)(t + 1) * kstep;
            const char* a2 = last ? nA : cA + (size_t)(t + 2) * kstep; const char* b2 = last ? nB : cB + (size_t)(t + 2) * kstep;
            const char* a3 = a2 + kstep; const char* b3 = b2 + kstep;
            if (last && has_next) S.a_ready(nxt);
            if constexpr (SP2) {
            PG8_LDB(B0, 0, 0); PG8_LDB(B1, 0, 1); PG8_SCHED; PG8_LDA(At, 0, 0); PG8_STAGE(PG8_SA(1, 1), a1 + hstep, voffA);
            PG8_WAIT_V(8); PG8_WAIT_L(0); PG8_BAR; PG8_MMA(0, 0, At, B0); PG8_MMA(0, 1, At, B1); PG8_BAR; PG8_SCHED;
            PG8_LDA(At, 0, 1); PG8_STAGE(PG8_SB(0, 0), b2, voffB); PG8_STAGE(PG8_SB(0, 1), b2 + hstep, voffB); PG8_STAGE(PG8_SA(0, 0), a2, voffA);
            PG8_WAIT_V(8); PG8_WAIT_L(0); PG8_BAR; PG8_MMA(1, 0, At, B0); PG8_MMA(1, 1, At, B1); PG8_BAR; PG8_SCHED;
            PG8_LDB(B0, 1, 0); PG8_LDB(B1, 1, 1); PG8_SCHED; PG8_LDA(At, 1, 0); PG8_STAGE(PG8_SA(0, 1), a2 + hstep, voffA);
            PG8_WAIT_V(8); PG8_WAIT_L(0); PG8_BAR; PG8_MMA(0, 0, At, B0); PG8_MMA(0, 1, At, B1); PG8_BAR; PG8_SCHED;
            PG8_LDA(At, 1, 1); PG8_STAGE(PG8_SB(1, 0), b3, voffB); PG8_STAGE(PG8_SB(1, 1), b3 + hstep, voffB); PG8_STAGE(PG8_SA(1, 0), a3, voffA);
            PG8_WAIT_V(8); PG8_WAIT_L(0); PG8_BAR; PG8_MMA(1, 0, At, B0); PG8_MMA(1, 1, At, B1); PG8_BAR; PG8_SCHED;
            } else {
            PG8_LDB(B0, 0, 0); PG8_SCHED; PG8_LDA(At, 0, 0); PG8_STAGE(PG8_SA(1, 1), a1 + hstep, voffA);
            PG8_WAIT_L(8); PG8_BAR; PG8_WAIT_L(0); PG8_MMA(0, 0, At, B0); PG8_BAR; PG8_SCHED;
            PG8_LDB(B1, 0, 1); PG8_STAGE(PG8_SB(0, 0), b2, voffB);
            PG8_BAR; PG8_WAIT_L(0); PG8_MMA(0, 1, At, B1); PG8_BAR;
            PG8_LDA(At, 0, 1); PG8_STAGE(PG8_SA(0, 0), a2, voffA);
            PG8_BAR; PG8_WAIT_L(0); PG8_MMA(1, 0, At, B0); PG8_BAR; PG8_SCHED;
            PG8_STAGE(PG8_SB(0, 1), b2 + hstep, voffB);
            PG8_WAIT_V(6); PG8_BAR; PG8_MMA(1, 1, At, B1); PG8_BAR;
            PG8_LDB(B0, 1, 0); PG8_SCHED; PG8_LDA(At, 1, 0); PG8_STAGE(PG8_SA(0, 1), a2 + hstep, voffA);
            PG8_WAIT_L(8); PG8_BAR; PG8_WAIT_L(0); PG8_MMA(0, 0, At, B0); PG8_BAR; PG8_SCHED;
            PG8_LDB(B1, 1, 1); PG8_STAGE(PG8_SB(1, 0), b3, voffB);
            PG8_BAR; PG8_WAIT_L(0); PG8_MMA(0, 1, At, B1); PG8_BAR;
            PG8_LDA(At, 1, 1); PG8_STAGE(PG8_SA(1, 0), a3, voffA);
            PG8_BAR; PG8_WAIT_L(0); PG8_MMA(1, 0, At, B0); PG8_BAR; PG8_SCHED;
            PG8_STAGE(PG8_SB(1, 1), b3 + hstep, voffB);
            PG8_WAIT_V(6); PG8_BAR; PG8_MMA(1, 1, At, B1); PG8_BAR;
            }
        }
        if constexpr (ALIGN_EPI) { if (wr == 0) PG8_BAR; }
        if constexpr (!Epi::AFTER_DRAIN) { E(acc, cur, wr, wc, fr, fq); S.done(cur); }
        if (!has_next) break;
#pragma unroll
        for (int a = 0; a < 2; ++a)
#pragma unroll
            for (int b = 0; b < 2; ++b)
#pragma unroll
                for (int m = 0; m < 4; ++m)
#pragma unroll
                    for (int n = 0; n < 2; ++n) acc[a][b][m][n] = (typename AccT<I8>::type){};
        cur = nxt; cA = nA; cB = nB; ++ui;
        if constexpr (ALIGN_EPI) { if (wr == 1) PG8_BAR; }
    }
    PG8_WAIT_V(0);
    if constexpr (!ALIGN_EPI) { if (wr == 0) PG8_BAR; }
    PG8_BAR;
    if constexpr (Epi::AFTER_DRAIN) { E.fused(acc, cur, wr, wc, fr, fq, lds, wid, lane); S.done(cur); }
#undef PG8_SA
#undef PG8_SB
#undef PG8_STAGE
#undef PG8_LDA
#undef PG8_LDB
#undef PG8_MMA
#undef PG8_WAIT_V
#undef PG8_WAIT_L
#undef PG8_BAR
#undef PG8_SCHED
}
}
#ifndef PG8_SP2
#define PG8_SP2 true
#endif
#ifndef PG8_ALIGN
#define PG8_ALIGN true
#endif

constexpr int BATCH = 2, SEQ = 16384, DM = 2048, T = BATCH * SEQ;
constexpr int INW = 6176, HP = 6400;
constexpr int C_QA = 0, C_KA = 256, C_VA = 512, C_RA = 1024, C_QD = 1536, C_KD = 3072, C_VD = 4608, C_GF = 6144;
constexpr int NHD = 12;
constexpr float EPS = 1e-6f;
constexpr float LOG2E = 1.4426950408889634f;
constexpr float QSCALE = 0.08838834764831845f * LOG2E;
constexpr int NPHASE = 11;

constexpr size_t MiB = 1u << 20;
constexpr size_t WS_CTL = 0, WS_ROPE = 1 * MiB, WS_RS1 = 3 * MiB, WS_RS2 = 3 * MiB + 512 * 1024, WS_SSP = 4 * MiB, WS_WIN = 8 * MiB, WS_WO = 33 * MiB, WS_WQ = 41 * MiB,
                 WS_SK = 49 * MiB, WS_DEC = 50 * MiB, WS_LP = 51 * MiB, WS_IDX = 56 * MiB, WS_GATE = 72 * MiB, WS_DOWN = 88 * MiB, WS_UP = 152 * MiB, WS_XB = 216 * MiB,
                 WS_H = 344 * MiB, WS_X1B = WS_H, WS_QRY = WS_H + 128 * MiB, WS_OP1 = 744 * MiB, WS_OP2 = 840 * MiB, WS_PART = 472 * MiB  , WS_END = 984 * MiB;
constexpr size_t OUT_ST = 0, OUT_OP0 = 128 * MiB;
constexpr int LDS_BYTES = 147456;

#define LAS __attribute__((address_space(3)))
typedef unsigned short bf16_t;
typedef short bf16x8 __attribute__((ext_vector_type(8)));
typedef short s16x4 __attribute__((ext_vector_type(4)));
typedef float f32x4 __attribute__((ext_vector_type(4)));
typedef float f32x2 __attribute__((ext_vector_type(2)));
typedef float f32x16 __attribute__((ext_vector_type(16)));
typedef unsigned u32x4 __attribute__((ext_vector_type(4)));
typedef unsigned u32x2 __attribute__((ext_vector_type(2)));
#define LDS_WAIT() asm volatile("s_waitcnt lgkmcnt(0)" ::: "memory")
#define SBAR() __builtin_amdgcn_sched_barrier(0)

__device__ __forceinline__ float bf2f(unsigned short b) { return __uint_as_float(((unsigned)b) << 16); }
__device__ __forceinline__ float bflo(unsigned w) { return __uint_as_float(w << 16); }
__device__ __forceinline__ float bfhi(unsigned w) { return __uint_as_float(w & 0xffff0000u); }
__device__ __forceinline__ unsigned f2bf(float f) { unsigned u = __float_as_uint(f); return (u + 0x7fffu + ((u >> 16) & 1u)) >> 16; }
__device__ __forceinline__ unsigned pk2(float lo, float hi) { return pg8::cvt_pk_bf16(lo, hi); }
__device__ __forceinline__ float fexp(float x) { return __builtin_amdgcn_exp2f(x * LOG2E); }
__device__ __forceinline__ float flog(float x) { return __builtin_amdgcn_logf(x) * 0.6931471805599453f; }
__device__ __forceinline__ float wave_sum(float v) {
#pragma unroll
    for (int o = 1; o < 64; o <<= 1) v += __shfl_xor(v, o);
    return v;
}
__device__ __forceinline__ int crow(int r, int hi) { return (r & 3) + 8 * (r >> 2) + 4 * hi; }

struct Frame {
    LAS unsigned char* lds; char* ldsg; unsigned char* wsb;
    int tid, lane, wave, vcu, G;
    const float *x, *norm1_g, *w_in, *up_f, *bias_f, *up_b, *bias_b, *out_g, *qn_g, *kn_g, *w_out, *norm2_g, *w_query, *sub_keys, *peer_down, *peer_up;
    float* out;
    __device__ __forceinline__ f32x2* rope_() const { return (f32x2*)((f32x2*)(wsb + WS_ROPE)); }
    __device__ __forceinline__ float* rs1_() const { return (float*)((float*)(wsb + WS_RS1)); }
    __device__ __forceinline__ float* rs2_() const { return (float*)((float*)(wsb + WS_RS2)); }
    __device__ __forceinline__ float* ssp_() const { return (float*)((float*)(wsb + WS_SSP)); }
    __device__ __forceinline__ float* dec_() const { return (float*)((float*)(wsb + WS_DEC)); }
    __device__ __forceinline__ float* lp_() const { return (float*)((float*)(wsb + WS_LP)); }
    __device__ __forceinline__ float* gate_() const { return (float*)((float*)(wsb + WS_GATE)); }
    __device__ __forceinline__ short* part_() const { return (short*)(wsb + WS_PART); }
    __device__ __forceinline__ float* sd_() const { return (float*)((float*)(wsb + WS_CTL + 65536)); }
    __device__ __forceinline__ float* su_() const { return (float*)((float*)(wsb + WS_CTL + 131072)); }
    __device__ __forceinline__ float* sx_() const { return (float*)((float*)(wsb + WS_RS2 + 131072)); }
    __device__ __forceinline__ float* csum_() const { return (float*)((float*)(wsb + WS_RS2 + 262144)); }
    __device__ __forceinline__ unsigned char* down8_() const { return (unsigned char*)(wsb + WS_DOWN); }
    __device__ __forceinline__ unsigned char* up8_() const { return (unsigned char*)(wsb + WS_UP); }
    __device__ __forceinline__ unsigned char* xq8_() const { return (unsigned char*)(wsb + WS_OP2); }
    __device__ __forceinline__ unsigned char* fq8_() const { return (unsigned char*)(wsb + WS_XB + 64 * MiB); }
    __device__ __forceinline__ unsigned short* idxT_() const { return (unsigned short*)((unsigned short*)(wsb + WS_XB + 72 * MiB)); }
    __device__ __forceinline__ unsigned* fqT_() const { return (unsigned*)((unsigned*)(wsb + WS_XB + 80 * MiB)); }
    __device__ __forceinline__ unsigned short* idx_() const { return (unsigned short*)(wsb + WS_IDX); }
    __device__ __forceinline__ unsigned short* state_() const { return (unsigned short*)((unsigned short*)((unsigned char*)out + OUT_ST)); }
    __device__ __forceinline__ bf16_t* WinT_() const { return (bf16_t*)((bf16_t*)(wsb + WS_WIN)); }
    __device__ __forceinline__ unsigned char* Win8_() const { return (unsigned char*)(wsb + WS_WIN); }
    __device__ __forceinline__ unsigned char* xq1_() const { return (unsigned char*)(wsb + WS_OP1); }
    __device__ __forceinline__ float* sw_() const { return (float*)((float*)(wsb + WS_CTL + 196608)); }
    __device__ __forceinline__ unsigned* wqmax_() const { return (unsigned*)(wsb + WS_CTL) + 4608; }
    __device__ __forceinline__ float* swq_() const { return (float*)(wsb + WS_CTL + 229376); }
    __device__ __forceinline__ unsigned char* Wq8_() const { return (unsigned char*)(wsb + WS_WQ); }
    __device__ __forceinline__ unsigned char* xq6_() const { return (unsigned char*)(wsb + WS_OP1); }
    __device__ __forceinline__ bf16_t* WoT_() const { return (bf16_t*)((bf16_t*)(wsb + WS_WO)); }
    __device__ __forceinline__ bf16_t* WqT_() const { return (bf16_t*)((bf16_t*)(wsb + WS_WQ)); }
    __device__ __forceinline__ bf16_t* SK_() const { return (bf16_t*)((bf16_t*)(wsb + WS_SK)); }
    __device__ __forceinline__ bf16_t* down16_() const { return (bf16_t*)((bf16_t*)(wsb + WS_DOWN)); }
    __device__ __forceinline__ bf16_t* up16_() const { return (bf16_t*)((bf16_t*)(wsb + WS_UP)); }
    __device__ __forceinline__ bf16_t* xb_() const { return (bf16_t*)((bf16_t*)(wsb + WS_XB)); }
    __device__ __forceinline__ bf16_t* mixed_() const { return (bf16_t*)((bf16_t*)(wsb + WS_XB)); }
    __device__ __forceinline__ bf16_t* h_() const { return (bf16_t*)((bf16_t*)(wsb + WS_H)); }
    __device__ __forceinline__ bf16_t* x1b_() const { return (bf16_t*)((bf16_t*)(wsb + WS_X1B)); }
    __device__ __forceinline__ bf16_t* qry_() const { return (bf16_t*)((bf16_t*)(wsb + WS_QRY)); }
    __device__ __forceinline__ bf16_t* op0_() const { return (bf16_t*)((bf16_t*)((unsigned char*)out + OUT_OP0)); }
    __device__ __forceinline__ bf16_t* op1_() const { return (bf16_t*)((bf16_t*)(wsb + WS_OP1)); }
    __device__ __forceinline__ bf16_t* op2_() const { return (bf16_t*)((bf16_t*)(wsb + WS_OP2)); }
};

__device__ __forceinline__ void p0_transpose_item(const float* W, int K, int N, bf16_t* WT, int k0, int n0, int dst_row0, const float* g, LAS float* scr, int lane) {
#pragma unroll 8
    for (int i = 0; i < 32; ++i) { const int kk = 2 * i + (lane >> 5); float w = W[(size_t)(k0 + kk) * N + n0 + (lane & 31)]; if (g) w *= g[k0 + kk]; scr[kk * 33 + (lane & 31)] = w; }
    LDS_WAIT(); asm volatile("" ::: "memory");
    const int c = lane & 7;
#pragma unroll
    for (int j = 0; j < 4; ++j) { const int n = (lane >> 3) + 8 * j; const LAS float* s = scr + (8 * c) * 33 + n;
        u32x4 o; o.x = pk2(s[0 * 33], s[1 * 33]); o.y = pk2(s[2 * 33], s[3 * 33]); o.z = pk2(s[4 * 33], s[5 * 33]); o.w = pk2(s[6 * 33], s[7 * 33]);
        *(u32x4*)(WT + (size_t)(dst_row0 + n) * K + k0 + 8 * c) = o; }
    LDS_WAIT(); asm volatile("" ::: "memory");
}
__device__ __forceinline__ unsigned pack_nib(unsigned a, unsigned b) { return (a & 0x0F0F0F0Fu) | ((b & 0x0F0F0F0Fu) << 4); }
__device__ __forceinline__ unsigned pack_i8x4(const f32x4 v, float inv, float lim) { unsigned w = 0u;
#pragma unroll
    for (int i = 0; i < 4; ++i) { const int qv = (int)fminf(fmaxf(rintf(v[i] * inv), -lim), lim); w |= ((unsigned)qv & 0xffu) << (8 * i); }
    return w; }
template <bool isup> __device__ __forceinline__ void peer_quant_row(const Frame& F, int e) {
    const int lane = F.lane;
    if constexpr (isup) {
        const f32x4* src = (const f32x4*)(F.peer_up + (size_t)e * DM) + lane;
        f32x4 v[8]; float m = 0.f;
#pragma unroll
        for (int j = 0; j < 8; ++j) { v[j] = src[64 * j];
            m = fmaxf(fmaxf(m, fmaxf(fabsf(v[j][0]), fabsf(v[j][1]))), fmaxf(fabsf(v[j][2]), fabsf(v[j][3]))); }
#pragma unroll
        for (int o = 1; o < 64; o <<= 1) m = fmaxf(m, __shfl_xor(m, o));
        const float inv = m > 0.f ? 127.f / m : 0.f; unsigned char* dst = F.up8_();
#pragma unroll
        for (int j = 0; j < 8; ++j) { const unsigned w = pack_i8x4(v[j], inv, 127.f);
            const int col = 4 * lane + 256 * j; *(unsigned*)(dst + ((size_t)(col >> 6) * 16384 + e) * 64 + (col & 63)) = w; }
        if (lane == 0) F.su_()[e] = m * (1.f / 127.f);
    } else {
        const f32x4* src = (const f32x4*)(F.peer_down + (size_t)e * DM) + 2 * lane; const f32x4* gs = (const f32x4*)F.norm2_g + 2 * lane;
        f32x4 v[8]; float ss = 0.f;
#pragma unroll
        for (int j = 0; j < 4; ++j) { v[2 * j] = src[128 * j] * gs[128 * j]; v[2 * j + 1] = src[128 * j + 1] * gs[128 * j + 1];
#pragma unroll
            for (int i = 0; i < 4; ++i) ss += v[2 * j][i] * v[2 * j][i] + v[2 * j + 1][i] * v[2 * j + 1][i]; }
        ss = wave_sum(ss);
        const float step = 0.345f * sqrtf(ss * (1.f / DM)), inv = step > 0.f ? 1.f / step : 0.f; unsigned char* dst = F.down8_();
#pragma unroll
        for (int j = 0; j < 4; ++j) { const unsigned w = pack_nib(pack_i8x4(v[2 * j], inv, 7.f), pack_i8x4(v[2 * j + 1], inv, 7.f));
            const int col = 8 * lane + 512 * j; *(unsigned*)(dst + ((size_t)(col >> 8) * 16384 + e) * 128 + ((col & 255) >> 3) * 4) = w; }
        if (lane == 0) F.sd_()[e] = step;
    }
}
__device__ __forceinline__ void w_quant_item(const Frame& F, const float* W, int ldw, int n0, const float* gain, unsigned char* W8, int drow, float* sw) {
    LAS float* scr = (LAS float*)(F.lds + F.wave * 16384); LAS float* cmx = (LAS float*)(F.lds + 12288);
    const int lane = F.lane, kw = F.wave * 256;
    float m = 0.f;
#pragma unroll 16
    for (int i = 0; i < 128; ++i) { const int k = kw + 2 * i + (lane >> 5); m = fmaxf(m, fabsf(W[(size_t)k * ldw + n0 + (lane & 31)] * gain[k])); }
    m = fmaxf(m, __shfl_xor(m, 32)); if (lane < 32) cmx[F.wave * 32 + lane] = m;
    __syncthreads();
    if (F.tid < 32) { float mm = 0.f;
#pragma unroll
        for (int w = 0; w < 8; ++w) mm = fmaxf(mm, cmx[w * 32 + F.tid]);
        cmx[256 + F.tid] = mm > 0.f ? 127.f / mm : 0.f; sw[drow + F.tid] = mm * (1.f / 127.f); }
    __syncthreads();
    for (int ch = 0; ch < 4; ++ch) { const int k0 = kw + 64 * ch;
#pragma unroll 8
        for (int i = 0; i < 32; ++i) { const int kk = 2 * i + (lane >> 5); scr[kk * 33 + (lane & 31)] = W[(size_t)(k0 + kk) * ldw + n0 + (lane & 31)] * gain[k0 + kk] * cmx[256 + (lane & 31)]; }
        LDS_WAIT(); asm volatile("" ::: "memory");
        const int c = lane & 7;
#pragma unroll
        for (int j = 0; j < 4; ++j) { const int n = (lane >> 3) + 8 * j; const LAS float* sp = scr + (8 * c) * 33 + n; u32x2 w = {0u, 0u};
#pragma unroll
            for (int i = 0; i < 4; ++i) { w.x |= ((unsigned)(int)rintf(sp[i * 33]) & 0xffu) << (8 * i); w.y |= ((unsigned)(int)rintf(sp[(4 + i) * 33]) & 0xffu) << (8 * i); }
            *(u32x2*)(W8 + (size_t)(drow + n) * DM + k0 + 8 * c) = w; }
        LDS_WAIT(); asm volatile("" ::: "memory"); }
    __syncthreads();
}
__device__ __forceinline__ void x_quant_row(const Frame& F, int m) {
    const int lane = F.lane; const f32x4* xr = (const f32x4*)(F.x + (size_t)m * DM) + lane; f32x4 v[8]; float s = 0.f, mx = 0.f;
#pragma unroll
    for (int j = 0; j < 8; ++j) { v[j] = xr[64 * j]; s += (v[j][0] * v[j][0] + v[j][1] * v[j][1]) + (v[j][2] * v[j][2] + v[j][3] * v[j][3]);
        mx = fmaxf(fmaxf(mx, fmaxf(fabsf(v[j][0]), fabsf(v[j][1]))), fmaxf(fabsf(v[j][2]), fabsf(v[j][3]))); }
    s = wave_sum(s);
#pragma unroll
    for (int o = 1; o < 64; o <<= 1) mx = fmaxf(mx, __shfl_xor(mx, o));
    const float inv = mx > 0.f ? 127.f / mx : 0.f; unsigned* o4 = (unsigned*)(F.xq1_() + (size_t)m * DM) + lane;
#pragma unroll
    for (int j = 0; j < 8; ++j) o4[64 * j] = pack_i8x4(v[j], inv, 127.f);
    if (lane == 0) { F.rs1_()[m] = __builtin_amdgcn_rsqf(s * (1.f / DM) + EPS) * (mx * (1.f / 127.f)); F.sx_()[m] = mx * (1.25f / 119.f); }
}
__device__ __forceinline__ void phase0(const Frame& F) {
    LAS float* scr = (LAS float*)(F.lds + F.wave * 16384);
    const int gw = F.vcu * 8 + F.wave, NGW = F.G * 8, lane = F.lane;
    for (int nb = F.vcu; nb < 193; nb += F.G) w_quant_item(F, F.w_in, INW, nb * 32, F.norm1_g, F.Win8_(), nb < 32 ? nb * 32 : (nb == 32 ? C_GF : nb * 32 - 32), F.sw_());
    { LAS float* rm = (LAS float*)(F.lds);
      for (int k0 = F.vcu * 8; k0 < DM; k0 += F.G * 8) { const int k = k0 + F.wave; const float g = F.norm2_g[k]; const f32x4* wr = (const f32x4*)(F.w_query + (size_t)k * DM) + lane;
          __syncthreads();
#pragma unroll
          for (int j = 0; j < 8; ++j) { const f32x4 v = wr[64 * j]; *(LAS f32x4*)(rm + F.wave * 2048 + 4 * (lane + 64 * j)) = (f32x4){fabsf(v[0] * g), fabsf(v[1] * g), fabsf(v[2] * g), fabsf(v[3] * g)}; }
          __syncthreads();
          { f32x4 m = *(const LAS f32x4*)(rm + 4 * F.tid);
#pragma unroll
            for (int w = 1; w < 8; ++w) { const f32x4 o = *(const LAS f32x4*)(rm + w * 2048 + 4 * F.tid); m[0] = fmaxf(m[0], o[0]); m[1] = fmaxf(m[1], o[1]); m[2] = fmaxf(m[2], o[2]); m[3] = fmaxf(m[3], o[3]); }
            unsigned* cm = F.wqmax_() + 4 * F.tid;
#pragma unroll
            for (int i = 0; i < 4; ++i) (void)__hip_atomic_fetch_max(cm + i, __float_as_uint(m[i]), __ATOMIC_RELAXED, __HIP_MEMORY_SCOPE_AGENT); } }
      __syncthreads(); }
    for (int it = gw; it < 32 * 64; it += NGW) { const int kb = it / 64, nb = it % 64; p0_transpose_item(F.w_out, DM, DM, F.WoT_(), kb * 64, nb * 32, nb * 32, nullptr, scr, lane); }
    const size_t gt = (size_t)gw * 64 + lane, NT = (size_t)NGW * 64;
    { u32x4* z = (u32x4*)(F.Win8_() + (size_t)INW * DM); const u32x4 zero = {0u, 0u, 0u, 0u}; for (size_t i = gt; i < (size_t)(HP - INW) * DM / 16; i += NT) z[i] = zero; if (gt < (size_t)(HP - INW)) F.sw_()[INW + gt] = 0.f; }
    for (int r = gw; r < 16384; r += NGW) peer_quant_row<false>(F, r);
    for (int r = gw; r < 16384; r += NGW) peer_quant_row<true>(F, r);
    for (size_t i = gt; i < (size_t)8 * 2 * 128 * 128 / 8; i += NT) { const f32x4 a = *(const f32x4*)(F.sub_keys + i * 8), b = *(const f32x4*)(F.sub_keys + i * 8 + 4);
        u32x4 o; o.x = pk2(a[0], a[1]); o.y = pk2(a[2], a[3]); o.z = pk2(b[0], b[1]); o.w = pk2(b[2], b[3]); *(u32x4*)(F.SK_() + i * 8) = o; }
    for (int m = gw; m < T; m += NGW) x_quant_row(F, m);
}
__device__ __forceinline__ void wq_quant_transpose(const Frame& F) {
    LAS float* scr = (LAS float*)(F.lds + F.wave * 16384); const int gw = F.vcu * 8 + F.wave, NGW = F.G * 8, lane = F.lane;
    for (int it = gw; it < 32 * 64; it += NGW) { const int k0 = (it / 64) * 64, n0 = (it % 64) * 32;
        const float cmx = __uint_as_float(F.wqmax_()[n0 + (lane & 31)]), inv = cmx > 0.f ? 127.f / cmx : 0.f;
        if (k0 == 0 && lane < 32) F.swq_()[n0 + lane] = cmx * (1.f / 127.f);
#pragma unroll 8
        for (int i = 0; i < 32; ++i) { const int kk = 2 * i + (lane >> 5); scr[kk * 33 + (lane & 31)] = F.w_query[(size_t)(k0 + kk) * DM + n0 + (lane & 31)] * F.norm2_g[k0 + kk] * inv; }
        LDS_WAIT(); asm volatile("" ::: "memory");
        const int c = lane & 7;
#pragma unroll
        for (int j = 0; j < 4; ++j) { const int n = (lane >> 3) + 8 * j; const LAS float* sp = scr + (8 * c) * 33 + n; u32x2 w = {0u, 0u};
#pragma unroll
            for (int i = 0; i < 4; ++i) { w.x |= ((unsigned)(int)rintf(sp[i * 33]) & 0xffu) << (8 * i); w.y |= ((unsigned)(int)rintf(sp[(4 + i) * 33]) & 0xffu) << (8 * i); }
            *(u32x2*)(F.Wq8_() + (size_t)(n0 + n) * DM + k0 + 8 * c) = w; }
        LDS_WAIT(); asm volatile("" ::: "memory"); }
    __syncthreads();
}

constexpr int GL_GDS = 0, GL_TOT = 8192, GL_QF = 12288, GL_QB = 21504, GL_KF = 30720, GL_KB = 39936, GL_VT = 49152, GL_P = 67584, GL_SF = 76800, GL_SB = 95232, GL_OB = 12288;
constexpr int RS72 = 144;
__device__ __forceinline__ float logsig(float z) { return fminf(z, 0.f) - flog(1.f + fexp(-fabsf(z))); }
__device__ __forceinline__ void gla_gates(const Frame& F, int b, int hh, int n, float (&bf)[8], float (&bb)[8], float& totf, float& totb) {
    const int tid = F.tid, c = tid & 63, ig = F.wave; LAS float* gds = (LAS float*)(F.lds + GL_GDS); LAS float* tot = (LAS float*)(F.lds + GL_TOT);
    const size_t t0 = (size_t)b * SEQ + (size_t)n * 64;
    if (tid < 256) { const int tk = tid >> 2, part = tid & 3; const u32x4 w = *(const u32x4*)(F.h_() + (t0 + tk) * HP + C_GF + part * 8); LAS float* d = gds + tk * 32 + part * 8;
        d[0] = bflo(w.x); d[1] = bfhi(w.x); d[2] = bflo(w.y); d[3] = bfhi(w.y); d[4] = bflo(w.z); d[5] = bfhi(w.z); d[6] = bflo(w.w); d[7] = bfhi(w.w); }
    __syncthreads();
    const int hc = hh * 64 + c; float upf[16], upb[16];
#pragma unroll
    for (int r = 0; r < 16; ++r) { upf[r] = F.up_f[r * 256 + hc]; upb[r] = F.up_b[r * 256 + hc]; }
    const float biasf = F.bias_f[hc], biasb = F.bias_b[hc]; float laf[8], lab[8];
#pragma unroll
    for (int e = 0; e < 8; ++e) { const LAS float* gr = gds + (ig * 8 + e) * 32; float zf = biasf, zb = biasb;
#pragma unroll
        for (int r = 0; r < 16; ++r) { zf += gr[r] * upf[r]; zb += gr[16 + r] * upb[r]; }
        laf[e] = logsig(zf) * 0.0625f; lab[e] = logsig(zb) * 0.0625f; }
    bf[0] = laf[0];
#pragma unroll
    for (int e = 1; e < 8; ++e) bf[e] = bf[e - 1] + laf[e];
    bb[7] = lab[7];
#pragma unroll
    for (int e = 6; e >= 0; --e) bb[e] = bb[e + 1] + lab[e];
    tot[ig * 64 + c] = bf[7]; tot[512 + ig * 64 + c] = bb[0];
    __syncthreads();
    float offf = 0.f, offb = 0.f; totf = 0.f; totb = 0.f;
#pragma unroll
    for (int g = 0; g < 8; ++g) { const float tf = tot[g * 64 + c], tb = tot[512 + g * 64 + c]; totf += tf; totb += tb; offf += (g < ig) ? tf : 0.f; offb += (g > ig) ? tb : 0.f; }
#pragma unroll
    for (int e = 0; e < 8; ++e) { bf[e] += offf; bb[e] += offb; }
}
__device__ __forceinline__ void gla_stage_vT(const Frame& F, const bf16x8 (&vraw)[2]) {
#pragma unroll
    for (int j = 0; j < 2; ++j) { const int q = F.tid + 512 * j, tk = q >> 4, vc = (q & 15) * 8; LAS short* d = (LAS short*)(F.lds + GL_VT) + vc * 72 + tk;
#pragma unroll
        for (int e = 0; e < 8; ++e) d[e * 72] = vraw[j][e]; }
}
__device__ __forceinline__ bf16x8 ldfrag(const LAS unsigned char* base, int row, int s, int hi) { return *(const LAS bf16x8*)(base + row * RS72 + (16 * s + 8 * hi) * 2); }

__device__ __forceinline__ void gla_passA(const Frame& F, int item) {
    const int bh = item >> 8, n = item & 255, b = bh >> 2, hh = bh & 3, tid = F.tid, c = tid & 63, ig = F.wave, lane = F.lane, r32 = lane & 31, hi = lane >> 5;
    const size_t t0 = (size_t)b * SEQ + (size_t)n * 64;
    unsigned short kraw[8]; bf16x8 vraw[2];
#pragma unroll
    for (int e = 0; e < 8; ++e) kraw[e] = F.h_()[(t0 + ig * 8 + e) * HP + C_KA + hh * 64 + c];
#pragma unroll
    for (int j = 0; j < 2; ++j) { const int q = tid + 512 * j; vraw[j] = *(const bf16x8*)(F.h_() + (t0 + (q >> 4)) * HP + C_VA + hh * 128 + (q & 15) * 8); }
    float bf[8], bb[8], totf, totb; gla_gates(F, b, hh, n, bf, bb, totf, totb);
    float kf[8], kb[8];
#pragma unroll
    for (int e = 0; e < 8; ++e) { const float k = bf2f(kraw[e]); kf[e] = k * fexp(totf - bf[e]); kb[e] = k * fexp(totb - bb[e]); }
    { u32x4 o; o.x = pk2(kf[0], kf[1]); o.y = pk2(kf[2], kf[3]); o.z = pk2(kf[4], kf[5]); o.w = pk2(kf[6], kf[7]); *(LAS u32x4*)(F.lds + GL_KF + c * RS72 + ig * 16) = o;
      o.x = pk2(kb[0], kb[1]); o.y = pk2(kb[2], kb[3]); o.z = pk2(kb[4], kb[5]); o.w = pk2(kb[6], kb[7]); *(LAS u32x4*)(F.lds + GL_KB + c * RS72 + ig * 16) = o; }
    gla_stage_vT(F, vraw);
    if (ig == 0) { F.dec_()[((size_t)(0 * 8 + bh) * 256 + n) * 64 + c] = fexp(totf); F.dec_()[((size_t)(1 * 8 + bh) * 256 + n) * 64 + c] = fexp(totb); }
    __syncthreads();
    const int dir = F.wave >> 2, vt = F.wave & 3; const LAS unsigned char* kimg = F.lds + (dir ? GL_KB : GL_KF);
    f32x16 a0 = {}, a1 = {};
#pragma unroll
    for (int s = 0; s < 4; ++s) { const bf16x8 av = ldfrag(F.lds + GL_VT, 32 * vt + r32, s, hi), b0 = ldfrag(kimg, r32, s, hi), b1 = ldfrag(kimg, 32 + r32, s, hi);
        a0 = __builtin_amdgcn_mfma_f32_32x32x16_bf16(av, b0, a0, 0, 0, 0); a1 = __builtin_amdgcn_mfma_f32_32x32x16_bf16(av, b1, a1, 0, 0, 0); }
    unsigned short* st = F.state_() + ((size_t)(dir * 8 + bh) * 256 + n) * 8192;
#pragma unroll
    for (int r = 0; r < 16; ++r) { const int v = 32 * vt + crow(r, hi); st[v * 64 + r32] = (unsigned short)f2bf(a0[r]); st[v * 64 + 32 + r32] = (unsigned short)f2bf(a1[r]); }
    __syncthreads();
}
__device__ __forceinline__ void gla_scan(const Frame& F, int item) {
    const int dir = item >> 7, bh = (item >> 4) & 7, e = (item & 15) * 512 + F.tid, c = e & 63;
    unsigned short* st = F.state_() + (size_t)(dir * 8 + bh) * 256 * 8192 + e; const float* dc = F.dec_() + (size_t)(dir * 8 + bh) * 256 * 64 + c; float S = 0.f;
    float iA[16], dA[16], iB[16], dB[16];
#define SC_N(g, j) (dir ? 255 - ((g) * 16 + (j)) : (g) * 16 + (j))
#define SC_LOAD(I_, D_, g) do { _Pragma("unroll") for (int j = 0; j < 16; ++j) { const int n_ = SC_N(g, j); I_[j] = bf2f(st[(size_t)n_ * 8192]); D_[j] = dc[n_ * 64]; } } while (0)
#define SC_RUN(I_, D_, g) do { _Pragma("unroll") for (int j = 0; j < 16; ++j) { const int n_ = SC_N(g, j); st[(size_t)n_ * 8192] = (unsigned short)f2bf(S); S = D_[j] * S + I_[j]; } } while (0)
    SC_LOAD(iA, dA, 0);
    for (int g = 0; g < 16; g += 2) { SC_LOAD(iB, dB, g + 1); SC_RUN(iA, dA, g); if (g + 2 < 16) SC_LOAD(iA, dA, g + 2); SC_RUN(iB, dB, g + 1); }
#undef SC_N
#undef SC_LOAD
#undef SC_RUN
}
__device__ __forceinline__ void gla_passC(const Frame& F, int item) {
    const int bh = item >> 8, n = item & 255, b = bh >> 2, hh = bh & 3, tid = F.tid, c = tid & 63, ig = F.wave, lane = F.lane, r32 = lane & 31, hi = lane >> 5;
    const size_t t0 = (size_t)b * SEQ + (size_t)n * 64;
    unsigned short qraw[8], kraw[8]; bf16x8 vraw[2]; u32x4 sraw[2][2];
#pragma unroll
    for (int e = 0; e < 8; ++e) { const bf16_t* hr = F.h_() + (t0 + ig * 8 + e) * HP + hh * 64 + c; qraw[e] = hr[C_QA]; kraw[e] = hr[C_KA]; }
#pragma unroll
    for (int j = 0; j < 2; ++j) { const int q = tid + 512 * j; vraw[j] = *(const bf16x8*)(F.h_() + (t0 + (q >> 4)) * HP + C_VA + hh * 128 + (q & 15) * 8);
#pragma unroll
        for (int dir = 0; dir < 2; ++dir) sraw[dir][j] = *(const u32x4*)(F.state_() + ((size_t)(dir * 8 + bh) * 256 + n) * 8192 + (q >> 3) * 64 + (q & 7) * 8); }
    float bf[8], bb[8], totf, totb; gla_gates(F, b, hh, n, bf, bb, totf, totb);
#pragma unroll
    for (int e = 0; e < 8; ++e) { const int i = ig * 8 + e; const float q = bf2f(qraw[e]) * 0.125f, k = bf2f(kraw[e]);
        const float ef = fexp(bf[e]), eb = fexp(bb[e]), nf = fexp(-bf[e]), nb = fexp(-bb[e]);
        *(LAS unsigned short*)(F.lds + GL_QF + i * RS72 + c * 2) = (unsigned short)f2bf(q * ef); *(LAS unsigned short*)(F.lds + GL_QB + i * RS72 + c * 2) = (unsigned short)f2bf(q * eb);
        *(LAS unsigned short*)(F.lds + GL_KF + i * RS72 + c * 2) = (unsigned short)f2bf(k * nf); *(LAS unsigned short*)(F.lds + GL_KB + i * RS72 + c * 2) = (unsigned short)f2bf(k * nb); }
    gla_stage_vT(F, vraw);
#pragma unroll
    for (int dir = 0; dir < 2; ++dir)
#pragma unroll
        for (int j = 0; j < 2; ++j) { const int q = tid + 512 * j; *(LAS u32x4*)(F.lds + (dir ? GL_SB : GL_SF) + (q >> 3) * RS72 + (q & 7) * 16) = sraw[dir][j]; }
    __syncthreads();
    if (F.wave < 4) { const int ti = F.wave >> 1, tj = F.wave & 1; f32x16 sf = {}, sb = {};
#pragma unroll
        for (int s = 0; s < 4; ++s) {
            sf = __builtin_amdgcn_mfma_f32_32x32x16_bf16(ldfrag(F.lds + GL_QF, 32 * ti + r32, s, hi), ldfrag(F.lds + GL_KF, 32 * tj + r32, s, hi), sf, 0, 0, 0);
            sb = __builtin_amdgcn_mfma_f32_32x32x16_bf16(ldfrag(F.lds + GL_QB, 32 * ti + r32, s, hi), ldfrag(F.lds + GL_KB, 32 * tj + r32, s, hi), sb, 0, 0, 0); }
#pragma unroll
        for (int r = 0; r < 16; ++r) { const int i = 32 * ti + crow(r, hi), j = 32 * tj + r32; const float p = (j <= i) ? sf[r] : sb[r];
            *(LAS unsigned short*)(F.lds + GL_P + i * RS72 + j * 2) = (unsigned short)f2bf(p); } }
    __syncthreads();
    const int ti = F.wave & 1, tv = F.wave >> 1; f32x16 o = {};
#pragma unroll
    for (int s = 0; s < 4; ++s) o = __builtin_amdgcn_mfma_f32_32x32x16_bf16(ldfrag(F.lds + GL_P, 32 * ti + r32, s, hi), ldfrag(F.lds + GL_VT, 32 * tv + r32, s, hi), o, 0, 0, 0);
#pragma unroll
    for (int s = 0; s < 4; ++s) o = __builtin_amdgcn_mfma_f32_32x32x16_bf16(ldfrag(F.lds + GL_QF, 32 * ti + r32, s, hi), ldfrag(F.lds + GL_SF, 32 * tv + r32, s, hi), o, 0, 0, 0);
#pragma unroll
    for (int s = 0; s < 4; ++s) o = __builtin_amdgcn_mfma_f32_32x32x16_bf16(ldfrag(F.lds + GL_QB, 32 * ti + r32, s, hi), ldfrag(F.lds + GL_SB, 32 * tv + r32, s, hi), o, 0, 0, 0);
    __syncthreads();
    LAS float* ob = (LAS float*)(F.lds + GL_OB);
#pragma unroll
    for (int r = 0; r < 16; ++r) ob[(32 * ti + crow(r, hi)) * 132 + 32 * tv + r32] = o[r];
    __syncthreads();
    { const int i = tid >> 3, part = tid & 7, v0 = part * 16; float ov[16], ss = 0.f;
#pragma unroll
      for (int e = 0; e < 16; ++e) { ov[e] = ob[i * 132 + v0 + e]; ss += ov[e] * ov[e]; }
      ss += __shfl_xor(ss, 1); ss += __shfl_xor(ss, 2); ss += __shfl_xor(ss, 4);
      const float rs = __builtin_amdgcn_rsqf(ss * (1.f / 128.f) + EPS); const size_t tok = t0 + i;
      const u32x4 r0 = *(const u32x4*)(F.h_() + tok * HP + C_RA + hh * 128 + v0), r1 = *(const u32x4*)(F.h_() + tok * HP + C_RA + hh * 128 + v0 + 8);
      const float rr[16] = {bflo(r0.x), bfhi(r0.x), bflo(r0.y), bfhi(r0.y), bflo(r0.z), bfhi(r0.z), bflo(r0.w), bfhi(r0.w), bflo(r1.x), bfhi(r1.x), bflo(r1.y), bfhi(r1.y), bflo(r1.z), bfhi(r1.z), bflo(r1.w), bfhi(r1.w)};
      float y[16];
#pragma unroll
      for (int e = 0; e < 16; ++e) { const float g = F.out_g[hh * 128 + v0 + e]; const float sil = rr[e] * __builtin_amdgcn_rcpf(1.f + fexp(-rr[e])); y[e] = ov[e] * rs * g * sil; }
      u32x4 w0, w1; w0.x = pk2(y[0], y[1]); w0.y = pk2(y[2], y[3]); w0.z = pk2(y[4], y[5]); w0.w = pk2(y[6], y[7]); w1.x = pk2(y[8], y[9]); w1.y = pk2(y[10], y[11]); w1.z = pk2(y[12], y[13]); w1.w = pk2(y[14], y[15]);
      bf16_t* mp = F.mixed_() + tok * DM + hh * 128 + v0; *(u32x4*)mp = w0; *(u32x4*)(mp + 8) = w1; }
    __syncthreads();
}

constexpr int AT_V = 0, AT_K = 49152, AT_O = 81920, AT_OSZ = 4608;
#define KSWZ(row, colB) ((row) * 256 + ((colB) ^ (((row) & 7) << 4)))
__device__ __forceinline__ int v_st(int k, int c) { const int kk = (k & ~0xC) | ((k & 4) << 1) | ((k & 8) >> 1); return ((kk >> 3) * 4 + (c >> 5)) * 512 + ((kk & 7) * 32 + (c & 31)) * 2; }
__device__ __forceinline__ int v_rd_base(int lane) { return ((lane & 3) << 3) | (((lane >> 2) & 3) << 6) | (((lane >> 4) & 1) << 5) | (((lane >> 5) & 1) << 8); }
constexpr int v_rd_off(int d0, int ks, int half) { return d0 * 512 + ks * 4096 + half * 2048; }
struct AtP { size_t tokbase; int dil, m0, Tf, nt, head, p; };
__device__ __forceinline__ AtP at_decode(int item) {
    AtP P; const int round = item >> 8, w = item & 255, p = round % 3, bh = round / 3, b = bh / 3, u = w & 63; P.p = p; P.head = (bh % 3) * 4 + (w >> 6);
    const int dsh = 2 * p, L = SEQ >> dsh, runs = 64 >> dsh, res = u / runs; P.dil = 1 << dsh; P.m0 = (u % runs) * 256; P.tokbase = (size_t)b * SEQ + res;
    const int kt_lo = (P.m0 == 0) ? 1 : 0, kt_hi = (P.m0 + 256 >= L) ? 4 : 5; P.Tf = P.m0 - 64 + 64 * kt_lo; P.nt = kt_hi - kt_lo + 1; return P;
}
__device__ __forceinline__ void attn_phase(const Frame& F) {
    const int tid = F.tid, wid = F.wave, lane = F.lane, r32 = lane & 31, hi = lane >> 5, G = F.G;
    int ntot = 0; for (int it = F.vcu; it < 4608; it += G) ntot += at_decode(it).nt;
    if (ntot == 0) return;
    const int sr = tid >> 4, sc = (tid & 15) * 8, vst0 = v_st(sr, sc), vst1 = v_st(32 + sr, sc), kc = sc * 2;
    const int vb0 = (int)(unsigned)(uintptr_t)(F.ldsg + AT_V) + v_rd_base(lane);
    int it_ld = F.vcu, rl = 0, it_c = F.vcu, rc = 0; AtP ld = at_decode(it_ld), cur = ld;
    bf16x8 qr[8], qn[8]; f32x16 o[4]; float l_reg = 0.f;
    bf16x8 sA0, sA1, sA2, sA3, sB0, sB1, sB2, sB3;
    const bool rot = false;
    bf16x8 pa0, pa1, pa2, pa3;
    bool pend = false, pend_last = false; int vprev = 0, prvQ0 = 0; AtP prv = cur;
#pragma unroll
    for (int d0 = 0; d0 < 4; ++d0) o[d0] = (f32x16){};
#define AT_QLOAD() do { const bf16_t* qp_ = F.h_() + C_QD + ld.head * 128 + (ld.tokbase + (size_t)ld.dil * (ld.m0 + 32 * wid + r32)) * HP + hi * 8; \
        _Pragma("unroll") for (int d0 = 0; d0 < 8; ++d0) qn[d0] = *(const bf16x8*)(qp_ + d0 * 16); } while (0)
#define AT_SLOAD(S) do { const int T0_ = ld.Tf + 64 * rl; const size_t ra = (ld.tokbase + (size_t)ld.dil * (T0_ + sr)) * HP + ld.head * 128 + sc, rb = ra + (size_t)ld.dil * 32 * HP; \
        S##0 = *(const bf16x8*)(F.h_() + C_VD + ra); S##1 = *(const bf16x8*)(F.h_() + C_VD + rb); S##2 = *(const bf16x8*)(F.h_() + C_KD + ra); S##3 = *(const bf16x8*)(F.h_() + C_KD + rb); \
        if (++rl == ld.nt) { it_ld += G; rl = 0; if (it_ld < 4608) { ld = at_decode(it_ld); AT_QLOAD(); } } } while (0)
#define AT_SWRITE(S, KB, VB) do { *(LAS bf16x8*)(F.lds + AT_V + (VB) * 16384 + vst0) = S##0; *(LAS bf16x8*)(F.lds + AT_V + (VB) * 16384 + vst1) = S##1; \
        *(LAS bf16x8*)(F.lds + AT_K + (KB) * 16384 + KSWZ(sr, kc)) = S##2; *(LAS bf16x8*)(F.lds + AT_K + (KB) * 16384 + KSWZ(32 + sr, kc)) = S##3; } while (0)
#define PK4(P, BASE, OUT) do { unsigned a0_ = pk2(P[BASE + 0], P[BASE + 1]), a1_ = pk2(P[BASE + 2], P[BASE + 3]); unsigned b0_ = pk2(P[BASE + 4], P[BASE + 5]), b1_ = pk2(P[BASE + 6], P[BASE + 7]); \
        auto r0_ = __builtin_amdgcn_permlane32_swap(a0_, b0_, false, false); auto r1_ = __builtin_amdgcn_permlane32_swap(a1_, b1_, false, false); \
        u32x4 w_ = {r0_[0], r1_[0], r0_[1], r1_[1]}; OUT = __builtin_bit_cast(bf16x8, w_); } while (0)
#define AT_TRD(OFF) __builtin_amdgcn_ds_read_tr16_b64_v4i16((LAS s16x4*)(uintptr_t)(unsigned)(vb_ + (OFF)))
#define AT_PVR(D0, R) do { R[0] = AT_TRD(v_rd_off(D0, 0, 0)); R[1] = AT_TRD(v_rd_off(D0, 0, 1)); R[2] = AT_TRD(v_rd_off(D0, 1, 0)); R[3] = AT_TRD(v_rd_off(D0, 1, 1)); \
        R[4] = AT_TRD(v_rd_off(D0, 2, 0)); R[5] = AT_TRD(v_rd_off(D0, 2, 1)); R[6] = AT_TRD(v_rd_off(D0, 3, 0)); R[7] = AT_TRD(v_rd_off(D0, 3, 1)); } while (0)
#define AT_PKV(L, H) (bf16x8){L[0], L[1], L[2], L[3], H[0], H[1], H[2], H[3]}
#define AT_MF(OD, R) do { OD = __builtin_amdgcn_mfma_f32_32x32x16_bf16(AT_PKV(R[0], R[1]), pa0, OD, 0, 0, 0); OD = __builtin_amdgcn_mfma_f32_32x32x16_bf16(AT_PKV(R[2], R[3]), pa1, OD, 0, 0, 0); \
        OD = __builtin_amdgcn_mfma_f32_32x32x16_bf16(AT_PKV(R[4], R[5]), pa2, OD, 0, 0, 0); OD = __builtin_amdgcn_mfma_f32_32x32x16_bf16(AT_PKV(R[6], R[7]), pa3, OD, 0, 0, 0); } while (0)
#define AT_PV(VB) do { const int vb_ = vb0 + (VB) * 16384; s16x4 RA[8], RB[8]; \
        AT_PVR(0, RA); AT_PVR(1, RB); SBAR(); AT_MF(o[0], RA); SBAR(); AT_PVR(2, RA); SBAR(); AT_MF(o[1], RB); SBAR(); AT_PVR(3, RB); SBAR(); AT_MF(o[2], RA); AT_MF(o[3], RB); } while (0)
#define AT_EPI(P_, Q0_) do { \
            unsigned char* Op = (P_.p == 0 ? (unsigned char*)F.out + OUT_OP0 : F.wsb + (P_.p == 1 ? WS_OP1 : WS_OP2)); \
            const float lt = l_reg + __shfl_xor(l_reg, 32), rl_ = __builtin_amdgcn_rcpf(lt);                      \
            LAS unsigned char* stg = F.lds + AT_O + wid * AT_OSZ; \
            if (hi == 0) F.lp_()[((size_t)P_.p * T + P_.tokbase + (size_t)P_.dil * ((Q0_) + r32)) * NHD + P_.head] = lt; \
            _Pragma("unroll") for (int d0 = 0; d0 < 4; ++d0) _Pragma("unroll") for (int k = 0; k < 4; ++k) { \
                int w_ = __builtin_amdgcn_cvt_pk_fp8_f32(o[d0][4 * k] * rl_, o[d0][4 * k + 1] * rl_, 0, false); w_ = __builtin_amdgcn_cvt_pk_fp8_f32(o[d0][4 * k + 2] * rl_, o[d0][4 * k + 3] * rl_, w_, true); \
                *(LAS int*)(stg + r32 * 144 + d0 * 32 + k * 8 + hi * 4) = w_; }                                     \
            LDS_WAIT(); asm volatile("" ::: "memory"); \
            _Pragma("unroll") for (int i_ = 0; i_ < 4; ++i_) { const int row = 8 * i_ + (lane >> 3), ch = lane & 7; const u32x4 w = *(const LAS u32x4*)(stg + row * 144 + ch * 16); \
                *(u32x4*)(Op + (P_.tokbase + (size_t)P_.dil * ((Q0_) + row)) * (NHD * 128) + P_.head * 128 + ch * 16) = w; } \
            LDS_WAIT(); asm volatile("" ::: "memory"); \
            _Pragma("unroll") for (int d0 = 0; d0 < 4; ++d0) o[d0] = (f32x16){}; l_reg = 0.f; } while (0)
#define AT_STEP(KB, VB) do { \
        if (rot && pend) AT_PV(vprev);                                                           \
        if (pend_last) AT_EPI(prv, prvQ0);                                                       \
        if (rc == 0) { _Pragma("unroll") for (int d0 = 0; d0 < 8; ++d0) qr[d0] = qn[d0]; } \
        const int Q0 = cur.m0 + 32 * wid, T0 = cur.Tf + 64 * rc; \
        const bool act = T0 + 63 >= Q0 - 64 && T0 <= Q0 + 95;                                \
        if (act) { \
            const LAS unsigned char* Ks = F.lds + AT_K + (KB) * 16384; f32x16 p0 = {}, p1 = {}; \
            _Pragma("unroll") for (int d0 = 0; d0 < 8; ++d0) { const int cb = (d0 * 16 + hi * 8) * 2; \
                const bf16x8 k0 = *(const LAS bf16x8*)(Ks + KSWZ(r32, cb)), k1 = *(const LAS bf16x8*)(Ks + KSWZ(32 + r32, cb)); \
                p0 = __builtin_amdgcn_mfma_f32_32x32x16_bf16(k0, qr[d0], p0, 0, 0, 0); p1 = __builtin_amdgcn_mfma_f32_32x32x16_bf16(k1, qr[d0], p1, 0, 0, 0); } \
            const int dq = T0 - (Q0 + r32); float ps = 0.f;                                \
            _Pragma("unroll") for (int r = 0; r < 16; ++r) { const int e0 = dq + crow(r, hi), e1 = e0 + 32; \
                p0[r] = (e0 >= -64 && e0 <= 64) ? __builtin_amdgcn_exp2f(p0[r]) : 0.f; p1[r] = (e1 >= -64 && e1 <= 64) ? __builtin_amdgcn_exp2f(p1[r]) : 0.f; ps += p0[r] + p1[r]; } \
            l_reg += ps; \
            PK4(p0, 0, pa0); PK4(p0, 8, pa1); PK4(p1, 0, pa2); PK4(p1, 8, pa3); } \
        const bool last = rc + 1 == cur.nt; \
        if (!rot) { if (act) AT_PV(VB); } else { pend = act; vprev = (VB); } \
        pend_last = last; if (last) { prv = cur; prvQ0 = Q0; } \
        if (last) { rc = 0; it_c += G; if (it_c < 4608) cur = at_decode(it_c); } else ++rc; } while (0)
    AT_QLOAD();
    AT_SLOAD(sA); AT_SLOAD(sB); AT_SWRITE(sA, 0, 0); AT_SLOAD(sA); __syncthreads();
    int v3 = 0;
    for (int g = 0; g < ntot; g += 2) { int v3n = v3 == 2 ? 0 : v3 + 1;
        AT_STEP(0, v3);
        if (g + 1 < ntot) AT_SWRITE(sB, 1, v3n);
        if (it_ld < 4608) AT_SLOAD(sB);
        v3 = v3n; v3n = v3 == 2 ? 0 : v3 + 1;
        __syncthreads();
        if (g + 1 < ntot) {
            AT_STEP(1, v3);
            if (g + 2 < ntot) AT_SWRITE(sA, 0, v3n);
            if (it_ld < 4608) AT_SLOAD(sA);
            v3 = v3n;
            __syncthreads(); }
    }
    if (rot && pend) AT_PV(vprev);
    if (pend_last) AT_EPI(prv, prvQ0);
#undef AT_QLOAD
#undef AT_SLOAD
#undef AT_SWRITE
#undef PK4
#undef AT_PV
#undef AT_TRD
#undef AT_PVR
#undef AT_PKV
#undef AT_MF
#undef AT_EPI
#undef AT_STEP
}
__device__ __forceinline__ void dil_combine(const Frame& F) {
    const int gw = F.vcu * 8 + F.wave, NGW = F.G * 8, lane = F.lane, c = lane & 15;
    const unsigned char* o0 = (const unsigned char*)F.op0_(); const unsigned char* o1 = (const unsigned char*)F.op1_(); const unsigned char* o2 = (const unsigned char*)F.op2_();
    for (long it = gw; it < (long)T * NHD / 4; it += NGW) { const long row = it * 4 + (lane >> 4); const size_t tok = (size_t)(row / NHD); const int head = (int)(row % NHD);
        const float l0 = F.lp_()[tok * NHD + head], l1 = F.lp_()[((size_t)T + tok) * NHD + head], l2 = F.lp_()[((size_t)2 * T + tok) * NHD + head]; const float inv = 1.f / (l0 + l1 + l2), w0 = l0 * inv, w1 = l1 * inv, w2 = l2 * inv;
        const size_t off = tok * (NHD * 128) + head * 128 + 8 * c; const u32x2 a = *(const u32x2*)(o0 + off), b = *(const u32x2*)(o1 + off), d = *(const u32x2*)(o2 + off);
#define DC2(AW, BW, DW, SEL) ({ const f32x2 x_ = __builtin_amdgcn_cvt_pk_f32_fp8((int)(AW), SEL), y_ = __builtin_amdgcn_cvt_pk_f32_fp8((int)(BW), SEL), z_ = __builtin_amdgcn_cvt_pk_f32_fp8((int)(DW), SEL); \
            pk2(w0 * x_[0] + w1 * y_[0] + w2 * z_[0], w0 * x_[1] + w1 * y_[1] + w2 * z_[1]); })
        u32x4 o; o.x = DC2(a.x, b.x, d.x, false); o.y = DC2(a.x, b.x, d.x, true); o.z = DC2(a.y, b.y, d.y, false); o.w = DC2(a.y, b.y, d.y, true);
#undef DC2
        *(u32x4*)(F.mixed_() + tok * DM + 512 + head * 128 + 8 * c) = o; }
}

__device__ __forceinline__ unsigned fl_flip(float x) { const unsigned u = __float_as_uint(x); return u ^ ((unsigned)((int)u >> 31) | 0x80000000u); }
__device__ __forceinline__ float fl_unflip(unsigned w) { return __uint_as_float((w & 0x80000000u) ? (w ^ 0x80000000u) : ~w); }
#define CE_DESC(a, b) do { const unsigned x_ = max(a, b), y_ = min(a, b); a = x_; b = y_; } while (0)
__device__ __forceinline__ void sort16_desc(unsigned (&a)[16]) {
#pragma unroll
    for (int k = 2; k <= 16; k <<= 1)
#pragma unroll
        for (int j = k >> 1; j > 0; j >>= 1)
#pragma unroll
            for (int i = 0; i < 16; ++i) { const int l = i ^ j; if (l > i) { const unsigned x = max(a[i], a[l]), y = min(a[i], a[l]); if ((i & k) == 0) { a[i] = x; a[l] = y; } else { a[i] = y; a[l] = x; } } }
}
__device__ __forceinline__ void bmerge16_desc(unsigned (&a)[16]) {
#pragma unroll
    for (int j = 8; j > 0; j >>= 1)
#pragma unroll
        for (int i = 0; i < 16; ++i) { const int l = i ^ j; if (l > i) CE_DESC(a[i], a[l]); }
}
__device__ __forceinline__ void top16_merge(unsigned (&a)[16], const unsigned (&b)[16]) {
#pragma unroll
    for (int i = 0; i < 16; ++i) a[i] = max(a[i], b[15 - i]);
    bmerge16_desc(a);
}
__device__ __forceinline__ void top16_partner(unsigned (&a)[16]) {
    unsigned b[16];
#pragma unroll
    for (int i = 0; i < 16; ++i) b[i] = (unsigned)__shfl_xor((int)a[i], 32);
    top16_merge(a, b);
}
__device__ constexpr unsigned char stair(int n) {
    constexpr unsigned char L[64] = {0x00,0x01,0x02,0x03,0x04,0x05,0x06,0x07,0x08,0x09,0x0a,0x0b,0x0c,0x0d,0x0e,0x0f,0x10,0x11,0x12,0x13,0x14,0x15,0x16,0x17,0x20,0x21,0x22,0x23,0x24,0x30,0x31,0x32,
                                     0x33,0x40,0x41,0x42,0x50,0x51,0x60,0x61,0x70,0x71,0x80,0x90,0xa0,0xb0,0xc0,0xd0,0xe0,0xf0,0xff,0xff,0xff,0xff,0xff,0xff,0xff,0xff,0xff,0xff,0xff,0xff,0xff,0xff};
    return L[n];
}
constexpr int TK_KEYS = 32768;
__device__ __forceinline__ void topk_item(const Frame& F, int hh, int tg) {
    const int lane = F.lane, r32 = lane & 31, hi = lane >> 5, tok0 = tg * 32; const size_t tok = (size_t)tok0 + r32;
    LAS int* ktab = (LAS int*)(F.lds + F.wave * 4096) + r32 * 32;
    float ss = 0.f;
    { const f32x4* sp = (const f32x4*)(F.ssp_() + tok * 32 + hi * 16);
#pragma unroll
      for (int j = 0; j < 4; ++j) { const f32x4 v = sp[j]; ss += (v[0] + v[1]) + (v[2] + v[3]); } }
    ss += __shfl_xor(ss, 32);
    const float rs2 = __builtin_amdgcn_rsqf(ss * (1.f / DM) + EPS);
    if (hh == 0 && hi == 0) F.rs2_()[tok] = rs2;
    unsigned top[2][16];
#pragma unroll
    for (int cc = 0; cc < 2; ++cc) {
        f32x16 acc[4] = {};
        const bf16_t* qp = F.qry_() + tok * DM + hh * 256 + cc * 128 + hi * 8; const LAS unsigned char* kl = F.lds + TK_KEYS + cc * 32768;
        bf16x8 qf[8];
#pragma unroll
        for (int s = 0; s < 8; ++s) qf[s] = *(const bf16x8*)(qp + 16 * s);
#pragma unroll
        for (int s = 0; s < 8; ++s) {
#pragma unroll
            for (int kt = 0; kt < 4; ++kt) { const bf16x8 kf = *(const LAS bf16x8*)(kl + KSWZ(kt * 32 + r32, (16 * s + 8 * hi) * 2)); acc[kt] = __builtin_amdgcn_mfma_f32_32x32x16_bf16(kf, qf[s], acc[kt], 0, 0, 0); } }
        unsigned g[4][16];
#pragma unroll
        for (int kt = 0; kt < 4; ++kt) {
#pragma unroll
            for (int r = 0; r < 16; ++r) g[kt][r] = (fl_flip(acc[kt][r]) & ~127u) | (unsigned)(127 - (32 * kt + crow(r, hi)));
            sort16_desc(g[kt]); }
        top16_merge(g[0], g[1]); top16_merge(g[2], g[3]); top16_merge(g[0], g[2]); top16_partner(g[0]);
#pragma unroll
        for (int i = 0; i < 16; ++i) top[cc][i] = g[0][i];
    }
#pragma unroll
    for (int i = 0; i < 16; ++i) ktab[hi * 16 + i] = 127 - (int)((hi ? top[1][i] : top[0][i]) & 127u);
    float s0[16], s1[16];
#pragma unroll
    for (int i = 0; i < 16; ++i) { s0[i] = fl_unflip(top[0][i] & ~127u); s1[i] = fl_unflip(top[1][i] & ~127u); }
    unsigned ca[16], cb[16];
#pragma unroll
    for (int n = 0; n < 32; ++n) { const int A = stair(n), B = stair(25 + n); unsigned va = 0u, vb = 0u;
        if (n < 25) { va = (fl_flip(s0[A >> 4] + s1[A & 15]) & ~255u) | (unsigned)(255 - A); vb = (fl_flip(s0[B >> 4] + s1[B & 15]) & ~255u) | (unsigned)(255 - B); }
        const unsigned v = hi ? vb : va; if (n < 16) ca[n] = v; else cb[n - 16] = v; }
    sort16_desc(ca); sort16_desc(cb); top16_merge(ca, cb); top16_partner(ca);
    float e[16], sum = 0.f; const float mx = fl_unflip(ca[0] & ~255u) * rs2;
#pragma unroll
    for (int i = 0; i < 16; ++i) { e[i] = fexp(fl_unflip(ca[i] & ~255u) * rs2 - mx); sum += e[i]; }
    const float inv = 1.f / sum;
    LDS_WAIT(); asm volatile("" ::: "memory");
    int oi[8]; float og[8];
#pragma unroll
    for (int k = 0; k < 8; ++k) { const unsigned cv = hi ? ca[8 + k] : ca[k]; const int code = 255 - (int)(cv & 255u); og[k] = (hi ? e[8 + k] : e[k]) * inv; oi[k] = ktab[code >> 4] * 128 + ktab[16 + (code & 15)]; }
    { unsigned short* ip = F.idx_() + tok * 128 + hh * 16 + hi * 8; float* gp = F.gate_() + tok * 128 + hh * 16 + hi * 8;
      *(u32x4*)ip = (u32x4){(unsigned)oi[0] | ((unsigned)oi[1] << 16), (unsigned)oi[2] | ((unsigned)oi[3] << 16), (unsigned)oi[4] | ((unsigned)oi[5] << 16), (unsigned)oi[6] | ((unsigned)oi[7] << 16)};
      { const int g0 = hh * 4 + hi * 2;
        *(u32x2*)(F.idxT_() + ((size_t)g0 * T + tok) * 4) = (u32x2){(unsigned)oi[0] | ((unsigned)oi[1] << 16), (unsigned)oi[2] | ((unsigned)oi[3] << 16)};
        *(u32x2*)(F.idxT_() + ((size_t)(g0 + 1) * T + tok) * 4) = (u32x2){(unsigned)oi[4] | ((unsigned)oi[5] << 16), (unsigned)oi[6] | ((unsigned)oi[7] << 16)}; }
      *(f32x4*)gp = (f32x4){og[0], og[1], og[2], og[3]}; *(f32x4*)(gp + 4) = (f32x4){og[4], og[5], og[6], og[7]}; }
    LDS_WAIT(); asm volatile("" ::: "memory");
}

constexpr int PS_NSL = 8, PS_CW = DM / PS_NSL, PS_SUB = PS_NSL / 8, PS_TG = 32, PS_NTG = T / PS_TG;
__device__ __forceinline__ float gelu_tanh(float x) { const float u = 0.7978845608028654f * (x + 0.044715f * x * x * x); const float t = 1.f - 2.f * __builtin_amdgcn_rcpf(1.f + fexp(2.f * u)); return 0.5f * x * (1.f + t); }
__device__ __forceinline__ int dot32n(u32x4 w, u32x4 xh, u32x4 xl) {
    int ph = __builtin_amdgcn_sdot8((int)w.x, (int)xh.x, 0, false); ph = __builtin_amdgcn_sdot8((int)w.y, (int)xh.y, ph, false); ph = __builtin_amdgcn_sdot8((int)w.z, (int)xh.z, ph, false); ph = __builtin_amdgcn_sdot8((int)w.w, (int)xh.w, ph, false);
    int pl = __builtin_amdgcn_sdot8((int)w.x, (int)xl.x, 0, false); pl = __builtin_amdgcn_sdot8((int)w.y, (int)xl.y, pl, false); pl = __builtin_amdgcn_sdot8((int)w.z, (int)xl.z, pl, false); pl = __builtin_amdgcn_sdot8((int)w.w, (int)xl.w, pl, false);
    return (ph << 4) + pl; }
__device__ __forceinline__ unsigned xcc_id() { return (unsigned)__builtin_amdgcn_s_getreg((3 << 11) | 20) & 7u; }
__device__ __forceinline__ bool peer_claim(unsigned* cnt, unsigned x, unsigned& d, int lane, int& q, int& tg) {
    while (d < 8u) { const unsigned xq = (x + d) & 7u; unsigned u = 0u;
        if (lane == 0) u = __hip_atomic_fetch_add(cnt + 64 * xq, 1u, __ATOMIC_RELAXED, __HIP_MEMORY_SCOPE_AGENT);
        u = (unsigned)__builtin_amdgcn_readfirstlane((int)u);
        if (u < (unsigned)(PS_SUB * PS_NTG)) { q = (int)(u / PS_NTG) * 8 + (int)xq; tg = (int)(u % PS_NTG); return true; }
        ++d; }
    return false;
}
template <int CTRL> __device__ __forceinline__ float dppmov(float x) { return __int_as_float(__builtin_amdgcn_update_dpp(0, __float_as_int(x), CTRL, 0xf, 0xf, true)); }
template <int CTRL> __device__ __forceinline__ int dppmovi(int x) { return __builtin_amdgcn_update_dpp(0, x, CTRL, 0xf, 0xf, true); }
__device__ __forceinline__ int bperm(int srclane, int v) { return __builtin_amdgcn_ds_bpermute(srclane << 2, v); }
__device__ __forceinline__ unsigned swar_add8(unsigned q) { return ((q & 0x7f7f7f7fu) + 0x08080808u) ^ (q & 0x80808080u); }
__device__ __forceinline__ void peer_down(const Frame& F, int cntw = 1024) {
    const int lane = F.lane, g = lane >> 3, c = lane & 7; const unsigned x = xcc_id(); unsigned d = 0u; int q, tg; unsigned* cnt = (unsigned*)(F.wsb + WS_CTL) + cntw;
    const unsigned char* tab = F.down8_(); const unsigned char* xb = F.xq6_();
    while (peer_claim(cnt, x, d, lane, q, tg)) {
        const unsigned colb = (unsigned)(q * PS_CW + 32 * c), slb = (unsigned)q * (16384u * 128u) + 16u * c; short* part = F.part_() + (size_t)q * T * 128; const size_t tok0 = (size_t)tg * PS_TG;
        u32x4 wA[16], wB[16], xA, xB, yA, yB; int iA0, iA1, iB0, iB1;
#define PD_IDX(i0, i1, tok) do { const unsigned short* ip_ = F.idx_() + (tok) * 128 + lane; i0 = ip_[0]; i1 = ip_[64]; } while (0)
#define PD_ROWS(W_, X_, Y_, i0, i1, tok) do { _Pragma("unroll") for (int j = 0; j < 16; ++j) { const unsigned e_ = (unsigned)bperm(8 * (j & 7) + g, j < 8 ? i0 : i1); \
            W_[j] = *(const u32x4*)(tab + (e_ * 128u + slb)); } X_ = *(const u32x4*)(xb + (tok) * DM + colb); Y_ = *(const u32x4*)(xb + (tok) * DM + colb + 16); } while (0)
#define PD_COMP(W_, X_, Y_, tok) do { u32x4 xh_, xl_;                   \
            xl_.x = pack_nib(X_.x, X_.y); xl_.y = pack_nib(X_.z, X_.w); xl_.z = pack_nib(Y_.x, Y_.y); xl_.w = pack_nib(Y_.z, Y_.w); \
            xh_.x = pack_nib(swar_add8(X_.x) >> 4, swar_add8(X_.y) >> 4); xh_.y = pack_nib(swar_add8(X_.z) >> 4, swar_add8(X_.w) >> 4); xh_.z = pack_nib(swar_add8(Y_.x) >> 4, swar_add8(Y_.y) >> 4); xh_.w = pack_nib(swar_add8(Y_.z) >> 4, swar_add8(Y_.w) >> 4); \
            int p[16]; _Pragma("unroll") for (int j = 0; j < 16; ++j) p[j] = dot32n(W_[j], xh_, xl_); \
            int a1[8], a2[4], a3[2]; \
            _Pragma("unroll") for (int i = 0; i < 8; ++i) { const int keep = (c & 1) ? p[2 * i + 1] : p[2 * i], give = (c & 1) ? p[2 * i] : p[2 * i + 1]; a1[i] = keep + dppmovi<0xB1>(give); } \
            _Pragma("unroll") for (int i = 0; i < 4; ++i) { const int keep = (c & 2) ? a1[2 * i + 1] : a1[2 * i], give = (c & 2) ? a1[2 * i] : a1[2 * i + 1]; a2[i] = keep + dppmovi<0x4E>(give); } \
            _Pragma("unroll") for (int i = 0; i < 2; ++i) { const int keep = (c & 4) ? a2[2 * i + 1] : a2[2 * i], give = (c & 4) ? a2[2 * i] : a2[2 * i + 1]; a3[i] = keep + __shfl_xor(give, 4); } \
            part[(tok) * 128 + 8 * c + g] = (short)min(max(a3[0], -32768), 32767); part[(tok) * 128 + 64 + 8 * c + g] = (short)min(max(a3[1], -32768), 32767); } while (0)
        PD_IDX(iA0, iA1, tok0); PD_IDX(iB0, iB1, tok0 + 1);
        PD_ROWS(wA, xA, yA, iA0, iA1, tok0);
        for (int tt = 0; tt < PS_TG; tt += 2) { const size_t tok = tok0 + tt;
            PD_ROWS(wB, xB, yB, iB0, iB1, tok + 1);
            const size_t t2 = tok + (tt + 2 < PS_TG ? 2 : 0), t3 = tok + (tt + 2 < PS_TG ? 3 : 1);
            PD_IDX(iA0, iA1, t2);
            PD_COMP(wA, xA, yA, tok);
            if (tt + 2 < PS_TG) PD_ROWS(wA, xA, yA, iA0, iA1, t2);
            PD_IDX(iB0, iB1, t3);
            PD_COMP(wB, xB, yB, tok + 1);
        }
#undef PD_IDX
#undef PD_ROWS
#undef PD_COMP
    }
}
__device__ __forceinline__ void peer_coef_probe(const Frame& F, bool dry) {
    typedef short s16x8 __attribute__((ext_vector_type(8)));
    const int gw = F.vcu * 8 + F.wave, NGW = F.G * 8, lane = F.lane, kq = lane & 15, k0 = kq * 8;
    for (int tg = gw; tg < T / 4; tg += NGW) { const int tok = tg * 4 + (lane >> 4); int a[8] = {0, 0, 0, 0, 0, 0, 0, 0};
#pragma unroll
        for (int q = 0; q < PS_NSL; ++q) { const s16x8 v = *(const s16x8*)(F.part_() + ((size_t)q * T + tok) * 128 + k0);
#pragma unroll
            for (int i = 0; i < 8; ++i) a[i] += v[i]; }
        const u32x4 iw = *(const u32x4*)(F.idx_() + (size_t)tok * 128 + k0); const f32x4 g0 = *(const f32x4*)(F.gate_() + (size_t)tok * 128 + k0), g1 = *(const f32x4*)(F.gate_() + (size_t)tok * 128 + k0 + 4);
        const float sc = F.rs2_()[tok] * F.sx_()[tok]; float c[8], m = 0.f;
#pragma unroll
        for (int i = 0; i < 8; ++i) { const unsigned w = iw[i >> 1]; const int e = (i & 1) ? (int)(w >> 16) : (int)(w & 0xffffu); const float g = i < 4 ? g0[i & 3] : g1[i & 3];
            c[i] = g * gelu_tanh((float)a[i] * sc * F.sd_()[e]) * F.su_()[e]; m = fmaxf(m, fabsf(c[i])); }
        m = fmaxf(m, __shfl_xor(m, 1)); m = fmaxf(m, __shfl_xor(m, 2)); m = fmaxf(m, __shfl_xor(m, 4)); m = fmaxf(m, __shfl_xor(m, 8));
        const float inv = m > 0.f ? 127.f / m : 0.f; unsigned lo = 0u, hi = 0u;
#pragma unroll
        for (int i = 0; i < 4; ++i) { lo |= ((unsigned)(int)rintf(c[i] * inv) & 0xffu) << (8 * i); hi |= ((unsigned)(int)rintf(c[4 + i] * inv) & 0xffu) << (8 * i); }
        unsigned* fp = dry ? (unsigned*)(F.wsb + WS_PART + 256 * MiB) : F.fqT_();
        fp[(size_t)(2 * kq) * T + tok] = lo; fp[(size_t)(2 * kq + 1) * T + tok] = hi;
        if (kq == 0 && !dry) F.csum_()[tok] = m * (1.f / 127.f); }
}
#ifndef PROBE_PHASE
#define PROBE_PHASE -1
#endif
#define UP_NREP ((PROBE_PHASE == 10) ? 2 : 1)
constexpr int U2_XO = 131072 + 2048, U2_SF = U2_XO + 8192;
#define PU_T4(ACC_, R0, R1, R2, R3, FQ_) do { const unsigned t0_ = __builtin_amdgcn_perm(R1, R0, 0x05010400u), t1_ = __builtin_amdgcn_perm(R1, R0, 0x07030602u), t2_ = __builtin_amdgcn_perm(R3, R2, 0x05010400u), t3_ = __builtin_amdgcn_perm(R3, R2, 0x07030602u); \
            ACC_[0] = __builtin_amdgcn_sdot4((int)__builtin_amdgcn_perm(t2_, t0_, 0x05040100u), FQ_, ACC_[0], false); ACC_[1] = __builtin_amdgcn_sdot4((int)__builtin_amdgcn_perm(t2_, t0_, 0x07060302u), FQ_, ACC_[1], false); \
            ACC_[2] = __builtin_amdgcn_sdot4((int)__builtin_amdgcn_perm(t3_, t1_, 0x05040100u), FQ_, ACC_[2], false); ACC_[3] = __builtin_amdgcn_sdot4((int)__builtin_amdgcn_perm(t3_, t1_, 0x07060302u), FQ_, ACC_[3], false); } while (0)
__device__ __forceinline__ unsigned u2_addr_lo(unsigned w, unsigned base) { unsigned a; asm("v_mad_u32_u16 %0, %1, 8, %2" : "=v"(a) : "v"(w), "s"(base)); return a; }
__device__ __forceinline__ unsigned u2_addr_hi(unsigned w, unsigned base) { unsigned a; asm("v_mad_u32_u16 %0, %1, 8, %2 op_sel:[1,0,0,0]" : "=v"(a) : "v"(w), "s"(base)); return a; }
__device__ __forceinline__ void peer_up(const Frame& F) {
    const int lane = F.lane;
    for (int cgi = F.vcu; cgi < 256 * UP_NREP; cgi += F.G) { const int cg = cgi & 255; const bool dry = cgi >= 256; float* const ob_ = dry ? (float*)(F.wsb + WS_PART) : F.out; const unsigned tmask_ = dry ? 16383u : 0xffffffffu;
        __syncthreads();
        { const unsigned char* src = F.up8_() + (size_t)(cg >> 3) * (16384 * 64) + (cg & 7) * 8;
#pragma unroll 8
          for (int i = 0; i < 32; ++i) { const int e = F.tid + 512 * i; *(LAS u32x2*)(F.lds + e * 8) = *(const u32x2*)(src + (size_t)e * 64); } }
        __syncthreads();
        u32x2 S0i[8], S1i[8], S2i[8], S3i[8]; int S0f[8], S1f[8], S2f[8], S3f[8]; u32x2 R0[16], R1[16];
        const __amdgpu_buffer_rsrc_t rsI = __builtin_amdgcn_make_buffer_rsrc((void*)F.idxT_(), 0, 32 * T * 8, 0x00020000), rsF = __builtin_amdgcn_make_buffer_rsrc((void*)F.fqT_(), 0, 32 * T * 4, 0x00020000),
            rsX = __builtin_amdgcn_make_buffer_rsrc((void*)F.x1b_(), 0, T * DM * 2, 0x00020000), rsC = __builtin_amdgcn_make_buffer_rsrc((void*)F.csum_(), 0, T * 4, 0x00020000);
#define U2_FENCE() do { asm volatile("" ::: "memory"); SBAR(); } while (0)
#define U2_LOAD(S_, tok_, s_) do { const unsigned vo_ = (unsigned)(tok_) * 8u; _Pragma("unroll") for (int g = 0; g < 8; ++g) { S_##i[g] = __builtin_amdgcn_raw_buffer_load_b64(rsI, vo_, ((s_) * 8 + g) * (T * 8), 0); \
            S_##f[g] = (int)__builtin_amdgcn_raw_buffer_load_b32(rsF, vo_ >> 1, ((s_) * 8 + g) * (T * 4), 0); } U2_FENCE(); } while (0)
#define U2_ISSUE(R_, S_, h_) do { _Pragma("unroll") for (int g = 0; g < 4; ++g) { const u32x2 id = S_##i[(h_) * 4 + g]; \
                R_[4 * g + 0] = *(const LAS u32x2*)(uintptr_t)u2_addr_lo(id.x, lbase_); R_[4 * g + 1] = *(const LAS u32x2*)(uintptr_t)u2_addr_hi(id.x, lbase_); \
                R_[4 * g + 2] = *(const LAS u32x2*)(uintptr_t)u2_addr_lo(id.y, lbase_); R_[4 * g + 3] = *(const LAS u32x2*)(uintptr_t)u2_addr_hi(id.y, lbase_); } U2_FENCE(); } while (0)
#define U2_FOLD(R_, S_, h_) do { _Pragma("unroll") for (int g = 0; g < 4; ++g) { const int fq = S_##f[(h_) * 4 + g]; \
                int* a_ = acc; PU_T4(a_, R_[4 * g + 0].x, R_[4 * g + 1].x, R_[4 * g + 2].x, R_[4 * g + 3].x, fq); a_ = acc + 4; PU_T4(a_, R_[4 * g + 0].y, R_[4 * g + 1].y, R_[4 * g + 2].y, R_[4 * g + 3].y, fq); } U2_FENCE(); } while (0)
        const int nb = (T / 64 - F.wave + 7) / 8;
        const unsigned lbase_ = (unsigned)__builtin_amdgcn_readfirstlane((int)(unsigned)(uintptr_t)F.ldsg);
        unsigned lane_; asm volatile("v_mbcnt_lo_u32_b32 %0, -1, 0\n\tv_mbcnt_hi_u32_b32 %0, -1, %0" : "=v"(lane_));
        { const unsigned t0_ = (unsigned)F.wave * 64u + lane_; U2_LOAD(S0, t0_, 0); U2_LOAD(S1, t0_, 1); U2_LOAD(S2, t0_, 2); U2_LOAD(S3, t0_, 3); U2_ISSUE(R0, S0, 0); }
#pragma unroll 1
        for (int i = 0; i < nb; ++i) { const unsigned tok = (unsigned)(F.wave + 8 * i) * 64u + lane_; const unsigned tokn = tok + (i + 1 < nb ? 512u : 0u); int acc[8] = {0, 0, 0, 0, 0, 0, 0, 0};
            __builtin_amdgcn_raw_ptr_buffer_load_lds(rsX, (LAS unsigned*)(F.lds + U2_XO + F.wave * 1024), 16, tok << 12, cg * 16, 0, 0);
            __builtin_amdgcn_raw_ptr_buffer_load_lds(rsC, (LAS unsigned*)(F.lds + U2_SF + F.wave * 256), 4, tok << 2, 0, 0, 0);
            U2_FENCE();
            U2_ISSUE(R1, S0, 1); U2_FOLD(R0, S0, 0);
            U2_ISSUE(R0, S1, 0); U2_FOLD(R1, S0, 1); U2_LOAD(S0, tokn, 0);
            U2_ISSUE(R1, S1, 1); U2_FOLD(R0, S1, 0);
            U2_ISSUE(R0, S2, 0); U2_FOLD(R1, S1, 1); U2_LOAD(S1, tokn, 1);
            U2_ISSUE(R1, S2, 1); U2_FOLD(R0, S2, 0);
            U2_ISSUE(R0, S3, 0); U2_FOLD(R1, S2, 1); U2_LOAD(S2, tokn, 2);
            U2_ISSUE(R1, S3, 1); U2_FOLD(R0, S3, 0);
            U2_ISSUE(R0, S0, 0); U2_FOLD(R1, S3, 1); U2_LOAD(S3, tokn, 3);
            asm volatile("s_waitcnt vmcnt(48)" ::: "memory");
            const u32x4 xo = *(const LAS u32x4*)(F.lds + U2_XO + F.wave * 1024 + lane_ * 16); const float sf = *(const LAS float*)(F.lds + U2_SF + F.wave * 256 + lane_ * 4);
            f32x4 v0 = {bflo(xo.x), bfhi(xo.x), bflo(xo.y), bfhi(xo.y)}, v1 = {bflo(xo.z), bfhi(xo.z), bflo(xo.w), bfhi(xo.w)};
            v0[0] += sf * (float)acc[0]; v0[1] += sf * (float)acc[1]; v0[2] += sf * (float)acc[2]; v0[3] += sf * (float)acc[3]; v1[0] += sf * (float)acc[4]; v1[1] += sf * (float)acc[5]; v1[2] += sf * (float)acc[6]; v1[3] += sf * (float)acc[7];
            float* dp = ob_ + (size_t)((tok & tmask_) * DM) + cg * 8; *(f32x4*)dp = v0; *(f32x4*)(dp + 4) = v1; U2_FENCE(); }
        LDS_WAIT();
#undef U2_ISSUE
#undef U2_FOLD
#undef U2_FENCE
#undef U2_LOAD
    }
}
#undef PU_T4


#define XB_TMO      128
#define XB_XCNT(j)  (256  + 64 * (j))
#define XB_XSUB(j)  (1280 + 64 * (j))
#define XB_XGEN(j)  (2304 + 64 * (j))
#define XB_TOP      3328
#define XB_TOPGEN   3392
#define XCD_BAR_WORDS 3456
#define XB_SPIN_CAP (1u << 18)

__device__ __forceinline__ unsigned xb_ld(unsigned* p)              { return __hip_atomic_load(p, __ATOMIC_RELAXED, __HIP_MEMORY_SCOPE_AGENT); }
__device__ __forceinline__ unsigned xb_add(unsigned* p, unsigned v) { return __hip_atomic_fetch_add(p, v, __ATOMIC_RELAXED, __HIP_MEMORY_SCOPE_AGENT); }
__device__ __forceinline__ unsigned xb_xcc_id() { return (unsigned)__builtin_amdgcn_s_getreg((3 << 11) | 20) & 0xFu; }
#define XB_SPIN(cond, bar) do { unsigned _sp = 0; while (cond) { __builtin_amdgcn_s_sleep(1); \
    if ((++_sp & 255u) == 0u) { if (xb_ld(&(bar)[XB_TMO])) break; if (_sp > XB_SPIN_CAP) { atomicAdd(&(bar)[XB_TMO], 1u); break; } } } } while (0)

struct XcdBarrier {
    unsigned* bar; unsigned x;
    volatile LAS unsigned* st;
};

__device__ __forceinline__ XcdBarrier xcd_barrier_post(unsigned* bar, volatile LAS unsigned* st) {
    XcdBarrier b; b.bar = bar; b.x = xb_xcc_id(); b.st = st;
    if (threadIdx.x == 0) (void)xb_add(&bar[XB_XCNT(b.x)], 1u);
    return b;
}
__device__ __forceinline__ void xcd_barrier_complete(unsigned* bar, unsigned x, unsigned& nloc, unsigned& nx) {
    const unsigned G = gridDim.x * gridDim.y * gridDim.z;
    unsigned sum, cnt, mine, sp = 0u;
    for (;;) {
        sum = 0u; cnt = 0u; mine = 0u;
#pragma unroll
        for (unsigned j = 0; j < 16; ++j) { const unsigned c = xb_ld(&bar[XB_XCNT(j)]); sum += c; cnt += (c > 0u) ? 1u : 0u; mine = (j == x) ? c : mine; }
        if (sum == G) break;
        __builtin_amdgcn_s_sleep(1);
        if ((++sp & 255u) == 0u) { if (xb_ld(&bar[XB_TMO])) break; if (sp > XB_SPIN_CAP) { atomicAdd(&bar[XB_TMO], 1u); break; } }
    }
    nloc = mine > 0u ? mine : 1u; nx = cnt > 0u ? cnt : 1u;
}

__device__ __forceinline__ void xcd_barrier(const XcdBarrier& b) {
    asm volatile("s_waitcnt vmcnt(0)" ::: "memory");
    __syncthreads();
    if (threadIdx.x == 0) {
        unsigned* bar = b.bar;
        __builtin_amdgcn_s_waitcnt(0);
        unsigned nloc = b.st[0], nx = b.st[1];
        if (nloc == 0u) { xcd_barrier_complete(bar, b.x, nloc, nx); b.st[0] = nloc; b.st[1] = nx; }
        const unsigned old = xb_add(&bar[XB_XSUB(b.x)], 1u);
        const unsigned gen = old / nloc;
        if (old + 1u == (gen + 1u) * nloc) {
            __builtin_amdgcn_fence(__ATOMIC_RELEASE, "agent");
            asm volatile("s_waitcnt vmcnt(0)" ::: "memory");
            const unsigned og = xb_add(&bar[XB_TOP], 1u);
            const unsigned tg = og / nx;
            if (og + 1u == (tg + 1u) * nx) xb_add(&bar[XB_TOPGEN], 1u);
            else XB_SPIN(xb_ld(&bar[XB_TOPGEN]) == tg, bar);
            __builtin_amdgcn_fence(__ATOMIC_ACQUIRE, "agent");
            xb_add(&bar[XB_XGEN(b.x)], 1u);
            asm volatile("s_waitcnt vmcnt(0)" ::: "memory");
        } else {
            XB_SPIN(xb_ld(&bar[XB_XGEN(b.x)]) == gen, bar);
            __builtin_amdgcn_fence(__ATOMIC_ACQUIRE, "agent");
            asm volatile("s_waitcnt vmcnt(0)" ::: "memory");
        }
    }
    __syncthreads();
}

struct Args { const float* in[16]; float* out; unsigned char* ws; int ph_lo, ph_hi, coop, pad; };
__global__ void __launch_bounds__(512, 2) fwd_kernel(Args args) {
    extern __shared__ __attribute__((aligned(16))) unsigned char lds_raw[];
    Frame F;
    F.lds = (LAS unsigned char*)lds_raw; F.ldsg = (char*)lds_raw;
    F.tid = threadIdx.x; F.lane = F.tid & 63; F.wave = __builtin_amdgcn_readfirstlane(F.tid >> 6);
    F.G = gridDim.x; { const int bx = blockIdx.x; F.vcu = (F.G % 8 == 0) ? (bx % 8) * (F.G / 8) + bx / 8 : bx; }
    F.x = args.in[0]; F.norm1_g = args.in[1]; F.w_in = args.in[2]; F.up_f = args.in[3]; F.bias_f = args.in[4]; F.up_b = args.in[5]; F.bias_b = args.in[6]; F.out_g = args.in[7];
    F.qn_g = args.in[8]; F.kn_g = args.in[9]; F.w_out = args.in[10]; F.norm2_g = args.in[11]; F.w_query = args.in[12]; F.sub_keys = args.in[13]; F.peer_down = args.in[14]; F.peer_up = args.in[15];
    F.out = args.out; unsigned char* ws = args.ws; F.wsb = ws;
    constexpr int MISC_OFF = 131072 + 320;
    for (int u = F.tid; u < 64; u += 512) ((LAS unsigned*)(F.lds + MISC_OFF))[u] = 0u;
    __syncthreads();
    XcdBarrier bar = xcd_barrier_post((unsigned*)(ws + WS_CTL) + 8192, (volatile LAS unsigned*)(F.lds + MISC_OFF) + 8);
    const int lo = args.ph_lo, hi = args.ph_hi;
#ifndef PH_MASK
#define PH_MASK 0x7ff
#endif
#ifndef PROBE_PHASE
#define PROBE_PHASE -1
#endif
#define REP(k) for (int rep_ = 0; rep_ < ((PROBE_PHASE == (k)) ? 2 : 1); ++rep_)
#define IN(k) (((PH_MASK >> (k)) & 1) && lo <= (k) && (k) < hi)
#define SEAM(k) do { if (IN(k) && IN((k) + 1)) { if (args.coop) { if ((k) == 0) cg::this_grid().sync(); else xcd_barrier(bar); } } } while (0)
    if (IN(0)) { REP(0) phase0(F); } SEAM(0);
#define GEMM1_BODY { pg8::Gemm g{(const pg8::bf16_t*)F.xq1_(), (const pg8::bf16_t*)F.Win8_(), T, HP, DM / 2}; pg8::StaticOrder S; S.init(T, HP, F.G, (int)blockIdx.x); \
        pg8::EpiI8Qk E{F.h_(), HP, F.rs1_(), F.sw_(), F.qn_g, F.kn_g, (LAS float*)(F.lds + 131072 + 1024), C_QD / 256, C_KD / 256, C_VD / 256, SEQ - 1, QSCALE}; \
        pg8::gemm_phase<pg8::EpiI8Qk, pg8::StaticOrder, PG8_ALIGN, PG8_SP2, true>(F.lds, g, S, E); }
    if (IN(1)) { wq_quant_transpose(F); GEMM1_BODY; if (PROBE_PHASE == 1) GEMM1_BODY; } SEAM(1);
    if (IN(2)) { REP(2) for (int it = F.vcu; it < 2048; it += F.G) gla_passA(F, it); } SEAM(2);
    if (IN(3)) { for (int it = F.vcu; it < 256; it += F.G) gla_scan(F, it); REP(3) attn_phase(F); } SEAM(3);
    if (IN(4)) REP(4) { for (int it = F.vcu; it < 2048; it += F.G) gla_passC(F, it); dil_combine(F); } SEAM(4);
#define GEMM5_BODY { pg8::Gemm g{F.mixed_(), F.WoT_(), T, DM, DM}; pg8::StaticOrder S; S.init(T, DM, F.G, (int)blockIdx.x); pg8::EpiResid E{F.x, F.out, F.x1b_(), F.ssp_(), DM, F.sx_(), F.xq6_()}; \
        pg8::gemm_phase<pg8::EpiResid, pg8::StaticOrder, PG8_ALIGN, PG8_SP2>(F.lds, g, S, E); }
#define GEMM6_BODY { pg8::Gemm g{(const pg8::bf16_t*)F.xq6_(), (const pg8::bf16_t*)F.Wq8_(), T, DM, DM / 2}; pg8::StaticOrder S; S.init(T, DM, F.G, (int)blockIdx.x); \
        pg8::EpiI8Qk E{F.qry_(), DM, F.sx_(), F.swq_(), nullptr, nullptr, (LAS float*)(F.lds + 131072 + 1024), 0, 0, 0, 0, 0.f}; \
        pg8::gemm_phase<pg8::EpiI8Qk, pg8::StaticOrder, PG8_ALIGN, PG8_SP2, true>(F.lds, g, S, E); }
    if (IN(5)) { GEMM5_BODY; if (PROBE_PHASE == 5) GEMM5_BODY; } SEAM(5);
    if (IN(6)) { GEMM6_BODY; if (PROBE_PHASE == 6) GEMM6_BODY; } SEAM(6);
    if (IN(7)) REP(7) { const int gw = F.vcu * 8 + F.wave, NGW = F.G * 8; for (int u = F.vcu; u < 256; u += F.G) { const int hh = u & 7, chunk = u >> 3;
            __syncthreads();
            for (int i = F.tid; i < 4096; i += 512) { const int row = i >> 4, ch = i & 15; *(LAS u32x4*)(F.lds + TK_KEYS + KSWZ(row, ch * 16)) = *(const u32x4*)(F.SK_() + ((size_t)hh * 256 + row) * 128 + ch * 8); }
            __syncthreads();
            for (int j = 0; j < 4; ++j) topk_item(F, hh, chunk * 32 + F.wave * 4 + j); }
    } SEAM(7);
    if (IN(8)) { if (PROBE_PHASE == 8) peer_down(F, 3072); peer_down(F); } SEAM(8);
    if (IN(9)) { REP(9) peer_coef_probe(F, (PROBE_PHASE == 9) && rep_ == 0); } SEAM(9);
    if (IN(10)) peer_up(F);
#undef IN
#undef SEAM
}

#ifndef MK_N_LAUNCHES
#define MK_N_LAUNCHES 1
#endif
extern "C" void kernel_launch(void* const* d_in, const int* in_sizes, int n_in, void* d_out, int out_size, void* d_ws, size_t ws_size, hipStream_t stream) {
    static int grid = 0;
    if (grid == 0) {
        if (n_in != 16 || in_sizes[0] != T * DM || out_size != T * DM || ws_size < WS_END) { fprintf(stderr, "kernel_launch: unexpected shapes (n_in %d, in0 %d, out %d, ws %zu)\n", n_in, n_in > 0 ? in_sizes[0] : -1, out_size, ws_size); grid = -1; return; }
        int dev = 0, cus = 0, per_cu = 0;
        if (hipGetDevice(&dev) != hipSuccess || hipDeviceGetAttribute(&cus, hipDeviceAttributeMultiprocessorCount, dev) != hipSuccess) { grid = -1; return; }
        if (hipFuncSetAttribute((const void*)fwd_kernel, hipFuncAttributeMaxDynamicSharedMemorySize, LDS_BYTES) != hipSuccess) { fprintf(stderr, "kernel_launch: hipFuncSetAttribute failed\n"); grid = -1; return; }
        if (hipOccupancyMaxActiveBlocksPerMultiprocessor(&per_cu, (const void*)fwd_kernel, 512, LDS_BYTES) != hipSuccess || per_cu < 1) { fprintf(stderr, "kernel_launch: occupancy query says %d\n", per_cu); per_cu = 1; }
        (void)hipGetLastError();
        grid = cus;
    }
    if (grid < 0) return;
    if (hipMemsetAsync(d_ws, 0, 65536, stream) != hipSuccess) { fprintf(stderr, "kernel_launch: hipMemsetAsync failed\n"); return; }
    Args a{};
    for (int i = 0; i < 16; ++i) a.in[i] = (const float*)d_in[i];
    a.out = (float*)d_out; a.ws = (unsigned char*)d_ws;
    if (MK_N_LAUNCHES == 1) {
        a.ph_lo = 0; a.ph_hi = NPHASE; a.coop = 1; void* kargs[] = {&a};
        hipError_t e = hipLaunchCooperativeKernel((const void*)fwd_kernel, dim3(grid), dim3(512), kargs, LDS_BYTES, stream);
        if (e != hipSuccess) fprintf(stderr, "kernel_launch: cooperative launch failed: %s (grid %d)\n", hipGetErrorString(e), grid);
    } else {
        for (int p = 0; p < NPHASE; ++p) { a.ph_lo = p; a.ph_hi = p + 1; a.coop = 0; hipLaunchKernelGGL(fwd_kernel, dim3(grid), dim3(512), LDS_BYTES, stream, a); }
        const hipError_t le = hipPeekAtLastError(); if (le != hipSuccess) fprintf(stderr, "kernel_launch: launch failed: %s\n", hipGetErrorName(le));
    }
}
```

```cpp
#include <hip/hip_runtime.h>
#include <hip/hip_cooperative_groups.h>
#include <cstdio>
#include <cstdint>
namespace cg = cooperative_groups;
namespace pg8 {
#define PG8_LAS __attribute__((address_space(3)))
typedef unsigned short bf16_t;
typedef short bf16x8 __attribute__((ext_vector_type(8)));
typedef float f32x4 __attribute__((ext_vector_type(4)));
typedef unsigned u32x4 __attribute__((ext_vector_type(4)));
constexpr int BM = 256, BK = 64, HALF = 128, HTB = HALF * BK * 2  , STAGE_BYTES = 8 * HTB, NXCD = 8, WGM = 4;

__host__ __device__ __forceinline__ int lds_byte(int r, int c) { const int st = (r >> 4) * 2 + (c >> 5), rr = r & 15, cc = c & 31, ob = rr * 64 + cc * 2; return st * 1024 + (ob ^ (((ob >> 9) & 1) << 5)); }
__host__ __device__ __forceinline__ void stage_rc(int b, int& R, int& C) { const int st = b / 1024, sb = b % 1024, swz = sb ^ (((sb >> 9) & 1) << 5); R = (st >> 1) * 16 + swz / 64; C = (st & 1) * 32 + (swz % 64) / 2; }
__host__ __device__ __forceinline__ int perm32(int rho) { const int n = rho >> 4, i = rho & 15; return 8 * (i >> 2) + 4 * n + (i & 3); }

struct Unit { int pm, pn; };
struct Gemm { const bf16_t* A; const bf16_t* Bt; int M, N, K; };

struct StaticOrder {
    int nM, nN, nwg, G, c;
    __host__ __device__ void init(int M, int N, int G_, int c_) { nM = M / BM; nN = N / BM; nwg = nM * nN; G = G_; c = c_; }
    __host__ __device__ bool next(int i, Unit& u) const {
        const long L = (long)i * G + c; if (L >= nwg) return false;
        int wgid = (int)L; { const int q = nwg / NXCD, r = nwg % NXCD, xcd = wgid % NXCD, off = wgid / NXCD; wgid = (xcd < r ? xcd * (q + 1) : r * (q + 1) + (xcd - r) * q) + off; }
        const int nig = WGM * nN, gid = wgid / nig, fm = gid * WGM, gsz = (nM - fm) < WGM ? (nM - fm) : WGM;
        u.pm = fm + ((wgid % nig) % gsz); u.pn = (wgid % nig) / gsz; return true;
    }
    __device__ __forceinline__ void a_ready(const Unit&) const {}
    __device__ __forceinline__ void done(const Unit&) const {}
};
__device__ __forceinline__ unsigned cvt_pk_bf16(float lo, float hi) { unsigned r; asm volatile("v_cvt_pk_bf16_f32 %0, %1, %2" : "=v"(r) : "v"(lo), "v"(hi)); return r; }
typedef int i32x4 __attribute__((ext_vector_type(4)));
typedef int i32x8 __attribute__((ext_vector_type(8)));
template <bool I8> struct AccT { typedef f32x4 type; };
template <> struct AccT<true> { typedef i32x4 type; };
struct EpiRowScaleBf16 {
    static constexpr bool PERM = true, AFTER_DRAIN = false;
    bf16_t* O; int ldc; const float* rs;
    __device__ __forceinline__ void operator()(const f32x4 (&acc)[2][2][4][2], const Unit& u, int wr, int wc, int fr, int fq) const {
        const int row0 = u.pm * BM + wr * 64 + fr, col0 = u.pn * BM + wc * 32 + 8 * fq;
#pragma unroll
        for (int ai = 0; ai < 2; ++ai)
#pragma unroll
            for (int m = 0; m < 4; ++m) { const int row = row0 + ai * HALF + m * 16; const float s = rs ? rs[row] : 1.f; bf16_t* rowp = O + (size_t)row * ldc + col0;
#pragma unroll
                for (int bj = 0; bj < 2; ++bj) { const f32x4 v0 = acc[ai][bj][m][0] * s, v1 = acc[ai][bj][m][1] * s;
                    u32x4 w; w.x = cvt_pk_bf16(v0[0], v0[1]); w.y = cvt_pk_bf16(v0[2], v0[3]); w.z = cvt_pk_bf16(v1[0], v1[1]); w.w = cvt_pk_bf16(v1[2], v1[3]);
                    *(u32x4*)(rowp + bj * HALF) = w; } }
    }
};
struct EpiI8Qk {
    static constexpr bool PERM = true, AFTER_DRAIN = false;
    bf16_t* O; int ldc; const float* rs; const float* cs; const float* qg; const float* kg; PG8_LAS float* P; int qk_lo, q_hi, qk_hi, seqmask; float qscale; unsigned char* O8; bf16_t* G16;
    __device__ __forceinline__ void operator()(const i32x4 (&acc)[2][2][4][2], const Unit& u, int wr, int wc, int fr, int fq) const {
        const int row0 = u.pm * BM + wr * 64 + fr, col0 = u.pn * BM + wc * 32 + 8 * fq;
        f32x4 cv[2][2];
#pragma unroll
        for (int bj = 0; bj < 2; ++bj) { cv[bj][0] = *(const f32x4*)(cs + col0 + bj * HALF); cv[bj][1] = *(const f32x4*)(cs + col0 + bj * HALF + 4); }
        const bool qk = u.pn >= qk_lo && u.pn < qk_hi;
        float rq[2][4][2];
        if (qk) {
#pragma unroll
            for (int ai = 0; ai < 2; ++ai)
#pragma unroll
                for (int m = 0; m < 4; ++m) { const float s = rs[row0 + ai * HALF + m * 16]; const int rl = ai * HALF + wr * 64 + m * 16 + fr;
#pragma unroll
                    for (int bj = 0; bj < 2; ++bj) { const i32x4 a0 = acc[ai][bj][m][0], a1 = acc[ai][bj][m][1]; float ss = 0.f;
#pragma unroll
                        for (int i = 0; i < 4; ++i) { const float x0 = (float)a0[i] * cv[bj][0][i], x1 = (float)a1[i] * cv[bj][1][i]; ss += x0 * x0; ss += x1 * x1; }
                        ss *= s * s;
                        ss += __shfl_xor(ss, 16); ss += __shfl_xor(ss, 32);
                        if (fq == 0) P[rl * 8 + bj * 4 + wc] = ss; } }
            asm volatile("s_waitcnt lgkmcnt(0)" ::: "memory"); __builtin_amdgcn_s_barrier(); asm volatile("" ::: "memory");
#pragma unroll
            for (int ai = 0; ai < 2; ++ai)
#pragma unroll
                for (int m = 0; m < 4; ++m) { const int rl = ai * HALF + wr * 64 + m * 16 + fr;
#pragma unroll
                    for (int bj = 0; bj < 2; ++bj) { const f32x4 p = *(const PG8_LAS f32x4*)(P + rl * 8 + bj * 4); rq[ai][m][bj] = __builtin_amdgcn_rsqf(((p[0] + p[1]) + (p[2] + p[3])) * (1.f / 128.f) + 1e-6f); } }
        }
        const bool isq = u.pn < q_hi; const float* gp = (isq ? qg : kg) + wc * 32 + 8 * fq; f32x4 g0 = {1.f, 1.f, 1.f, 1.f}, g1 = g0;
        if (qk) { g0 = *(const f32x4*)gp; g1 = *(const f32x4*)(gp + 4); if (isq) { g0 = g0 * qscale; g1 = g1 * qscale; } }
        f32x4 cg[2][2];
#pragma unroll
        for (int bj = 0; bj < 2; ++bj) { cg[bj][0] = qk ? cv[bj][0] * g0 : cv[bj][0]; cg[bj][1] = qk ? cv[bj][1] * g1 : cv[bj][1]; }
        constexpr float RV[16] = {1.591549431e-01f, 7.008652159e-02f, 3.086376340e-02f, 1.359137064e-02f, 5.985185713e-03f, 2.635675899e-03f, 1.160663641e-03f, 5.111175045e-04f, 2.250790790e-04f, 9.911730937e-05f, 4.364795279e-05f, 1.922110068e-05f, 8.464330808e-06f, 3.727408602e-06f, 1.641426263e-06f, 7.228293069e-07f};
#pragma unroll
        for (int ai = 0; ai < 2; ++ai)
#pragma unroll
            for (int m = 0; m < 4; ++m) { const int row = row0 + ai * HALF + m * 16; const float s = rs[row]; bf16_t* rowp = O + (size_t)row * ldc + col0;
                float cs8[8], sn8[8];
                if (qk && wc == 0) { const float pos = (float)(row & seqmask);
#pragma unroll
                    for (int e8 = 0; e8 < 8; ++e8) { const float rev = pos * ((fq & 1) ? RV[8 + e8] : RV[e8]); const float fr_ = rev - __builtin_floorf(rev); cs8[e8] = __builtin_amdgcn_cosf(fr_); sn8[e8] = __builtin_amdgcn_sinf(fr_); } }
#pragma unroll
                for (int bj = 0; bj < 2; ++bj) { const i32x4 a0 = acc[ai][bj][m][0], a1 = acc[ai][bj][m][1]; const float sq = qk ? s * rq[ai][m][bj] : s;
                    float v[8];
#pragma unroll
                    for (int i = 0; i < 4; ++i) { v[i] = ((float)a0[i] * cg[bj][0][i]) * sq; v[4 + i] = ((float)a1[i] * cg[bj][1][i]) * sq; }
                    if (qk && wc == 0) {
#pragma unroll
                        for (int e8 = 0; e8 < 8; ++e8) { const float pr = __shfl_xor(v[e8], 32); v[e8] = (fq < 2) ? (v[e8] * cs8[e8] - pr * sn8[e8]) : (v[e8] * cs8[e8] + pr * sn8[e8]); } }
                    if (O8 != nullptr) {
                        if (u.pn < 2) { u32x4 w; w.x = cvt_pk_bf16(v[0], v[1]); w.y = cvt_pk_bf16(v[2], v[3]); w.z = cvt_pk_bf16(v[4], v[5]); w.w = cvt_pk_bf16(v[6], v[7]);
                            *(u32x4*)((bf16_t*)((unsigned char*)G16 + ((size_t)40 << 20)) + (size_t)row * 512 + u.pn * BM + wc * 32 + 8 * fq + bj * HALF) = w; }
                        else if (u.pn == 4 || u.pn == 5) { u32x4 w; w.x = cvt_pk_bf16(v[0], v[1]); w.y = cvt_pk_bf16(v[2], v[3]); w.z = cvt_pk_bf16(v[4], v[5]); w.w = cvt_pk_bf16(v[6], v[7]);
                            *(u32x4*)((bf16_t*)((unsigned char*)G16 + ((size_t)8 << 20)) + (size_t)row * 512 + (u.pn - 4) * BM + wc * 32 + 8 * fq + bj * HALF) = w; }
                        else if (u.pn < 24) {
                            int w0_ = __builtin_amdgcn_cvt_pk_fp8_f32(v[0], v[1], 0, false); w0_ = __builtin_amdgcn_cvt_pk_fp8_f32(v[2], v[3], w0_, true);
                            int w1_ = __builtin_amdgcn_cvt_pk_fp8_f32(v[4], v[5], 0, false); w1_ = __builtin_amdgcn_cvt_pk_fp8_f32(v[6], v[7], w1_, true);
                            typedef unsigned u32x2e __attribute__((ext_vector_type(2)));
                            *(u32x2e*)(O8 + (size_t)row * 6144 + u.pn * BM + wc * 32 + 8 * fq + bj * HALF) = (u32x2e){(unsigned)w0_, (unsigned)w1_}; }
                        else if (wc == 0 && bj == 0) { u32x4 w; w.x = cvt_pk_bf16(v[0], v[1]); w.y = cvt_pk_bf16(v[2], v[3]); w.z = cvt_pk_bf16(v[4], v[5]); w.w = cvt_pk_bf16(v[6], v[7]);
                            *(u32x4*)(G16 + (size_t)row * 32 + 8 * fq) = w; } }
                    else { u32x4 w; w.x = cvt_pk_bf16(v[0], v[1]); w.y = cvt_pk_bf16(v[2], v[3]); w.z = cvt_pk_bf16(v[4], v[5]); w.w = cvt_pk_bf16(v[6], v[7]);
                        *(u32x4*)(rowp + bj * HALF) = w; } } }
    }
};
__device__ __forceinline__ unsigned epi_pack8(const f32x4 v, float inv) { unsigned w = 0u;
#pragma unroll
    for (int i = 0; i < 4; ++i) { const int qv = (int)fminf(fmaxf(rintf(v[i] * inv), -119.f), 119.f); w |= ((unsigned)qv & 0xffu) << (8 * i); }
    return w; }
__device__ __forceinline__ unsigned epi_add8(unsigned q) { return ((q & 0x7f7f7f7fu) + 0x08080808u) ^ (q & 0x80808080u); }
__device__ __forceinline__ unsigned epi_nib(unsigned a, unsigned b) { return (a & 0x0F0F0F0Fu) | ((b & 0x0F0F0F0Fu) << 4); }
struct EpiResid {
    static constexpr bool PERM = true, AFTER_DRAIN = false;
    const float* x; float* out; bf16_t* xb; float* ssp; int ldc; const float* sx; unsigned char* xq; const float* cs;
    __device__ __forceinline__ void operator()(const f32x4 (&acc)[2][2][4][2], const Unit& u, int wr, int wc, int fr, int fq) const {
        const int row0 = u.pm * BM + wr * 64 + fr, col0 = u.pn * BM + wc * 32 + 8 * fq;
        f32x4 cv[2][2];
#pragma unroll
        for (int bj = 0; bj < 2; ++bj) { cv[bj][0] = *(const f32x4*)(cs + col0 + bj * HALF); cv[bj][1] = *(const f32x4*)(cs + col0 + bj * HALF + 4); }
#pragma unroll
        for (int g2 = 0; g2 < 4; ++g2) { const int ai = g2 >> 1, mb = (g2 & 1) * 2; f32x4 xv[4][2][2]; float sxr[4];
#pragma unroll
            for (int m = mb; m < mb + 2; ++m) { const int row = row0 + ai * HALF + m * 16; const size_t off = (size_t)row * ldc + col0; sxr[m] = sx[row];
#pragma unroll
                for (int bj = 0; bj < 2; ++bj) { xv[m][bj][0] = *(const f32x4*)(x + off + bj * HALF); xv[m][bj][1] = *(const f32x4*)(x + off + bj * HALF + 4); } }
#pragma unroll
            for (int m = mb; m < mb + 2; ++m) { const int row = row0 + ai * HALF + m * 16; const size_t off = (size_t)row * ldc + col0; float ss = 0.f; const float inv = sxr[m] > 0.f ? 1.f / sxr[m] : 0.f;
#pragma unroll
                for (int bj = 0; bj < 2; ++bj) {
                    const f32x4 v0 = acc[ai][bj][m][0] * cv[bj][0] + xv[m][bj][0], v1 = acc[ai][bj][m][1] * cv[bj][1] + xv[m][bj][1];
                    u32x4 w; w.x = cvt_pk_bf16(v0[0], v0[1]); w.y = cvt_pk_bf16(v0[2], v0[3]); w.z = cvt_pk_bf16(v1[0], v1[1]); w.w = cvt_pk_bf16(v1[2], v1[3]);
                    *(u32x4*)(xb + off + bj * HALF) = w;
                    const unsigned qa = epi_pack8(v0, inv), qb = epi_pack8(v1, inv);
                    { typedef unsigned u32x2e __attribute__((ext_vector_type(2))); *(u32x2e*)(xq + off + bj * HALF) = (u32x2e){qa, qb}; }
                    ss += (v0[0] * v0[0] + v0[1] * v0[1]) + (v0[2] * v0[2] + v0[3] * v0[3]) + (v1[0] * v1[0] + v1[1] * v1[1]) + (v1[2] * v1[2] + v1[3] * v1[3]); }
                ss += __shfl_xor(ss, 16); ss += __shfl_xor(ss, 32);
                if (fq == 0) ssp[(size_t)row * 32 + u.pn * 4 + wc] = ss; } }
    }
};
template <class Epi, class Sched, bool ALIGN_EPI = false, bool SP2 = false, bool I8 = false, bool F8 = false>
__device__ __forceinline__ void gemm_phase(PG8_LAS unsigned char* lds, const Gemm g, const Sched& S, const Epi& E) {
    const int tid = threadIdx.x, wid = __builtin_amdgcn_readfirstlane(tid >> 6), lane = tid & 63, wr = wid >> 2, wc = wid & 3, fr = lane & 15, fq = lane >> 4;
    const int K = g.K, nt = K / BK;
    unsigned voffA[2], voffB[2];
#pragma unroll
    for (int i = 0; i < 2; ++i) { int R, C; stage_rc(tid * 16 + i * 8192, R, C); const int Rb = Epi::PERM ? ((R & ~31) + perm32(R & 31)) : R;
        voffA[i] = (unsigned)(R * K + C) * 2u; voffB[i] = (unsigned)(Rb * K + C) * 2u; }
    const size_t kstep = (size_t)(BK * 2);
    const size_t hstep = (size_t)HALF * K * 2;
    const size_t tstep = 2 * hstep;
    const unsigned ldsw = (unsigned)wid * 1024u;
    const int aoff = lds_byte(wr * 64 + fr, fq * 8), boff = lds_byte(wc * 32 + fr, fq * 8);
#define PG8_SA(b, h) (((b) * 2 + (h)) * HTB)
#define PG8_SB(b, h) ((4 + (b) * 2 + (h)) * HTB)
#define PG8_STAGE(bufoff, gbase, voff) do { _Pragma("unroll") for (int _i = 0; _i < 2; ++_i) \
        __builtin_amdgcn_global_load_lds((const unsigned*)((const char*)(gbase) + (voff)[_i]), (PG8_LAS unsigned*)(lds + (bufoff) + ldsw + _i * 8192), 16, 0, 0); } while (0)
#define PG8_CAT(p) __builtin_shufflevector(*(const PG8_LAS i32x4*)(p), *(const PG8_LAS i32x4*)((p) + 1024), 0, 1, 2, 3, 4, 5, 6, 7)
#define PG8_LDA(dst, b, h) do { if constexpr (F8) { _Pragma("unroll") for (int m = 0; m < 4; ++m) { dst##8[m] = PG8_CAT(lds + PG8_SA(b, h) + aoff + m * 2048); } } else { \
        _Pragma("unroll") for (int m = 0; m < 4; ++m) _Pragma("unroll") for (int k = 0; k < 2; ++k) dst[m][k] = *(const PG8_LAS bf16x8*)(lds + PG8_SA(b, h) + aoff + m * 2048 + k * 1024); } } while (0)
#define PG8_LDB(dst, b, h) do { if constexpr (F8) { _Pragma("unroll") for (int n = 0; n < 2; ++n) { dst##8[n] = PG8_CAT(lds + PG8_SB(b, h) + boff + n * 2048); } } else { \
        _Pragma("unroll") for (int n = 0; n < 2; ++n) _Pragma("unroll") for (int k = 0; k < 2; ++k) dst[n][k] = *(const PG8_LAS bf16x8*)(lds + PG8_SB(b, h) + boff + n * 2048 + k * 1024); } } while (0)
#define PG8_MMA(ai, bj, At, Bt) do { __builtin_amdgcn_s_setprio(1); _Pragma("unroll") for (int m = 0; m < 4; ++m) _Pragma("unroll") for (int n = 0; n < 2; ++n) _Pragma("unroll") for (int k = 0; k < (F8 ? 1 : 2); ++k) { \
        if constexpr (F8) asm volatile("v_mfma_f32_16x16x128_f8f6f4 %0, %1, %2, %0" : "+v"(acc[ai][bj][m][n]) : "v"(Bt##8[n]), "v"(At##8[m]));   \
        else if constexpr (I8) acc[ai][bj][m][n] = __builtin_amdgcn_mfma_i32_16x16x64_i8(__builtin_bit_cast(i32x4, Bt[n][k]), __builtin_bit_cast(i32x4, At[m][k]), acc[ai][bj][m][n], 0, 0, 0); \
        else acc[ai][bj][m][n] = __builtin_amdgcn_mfma_f32_16x16x32_bf16(Bt[n][k], At[m][k], acc[ai][bj][m][n], 0, 0, 0); } __builtin_amdgcn_s_setprio(0); } while (0)
#define PG8_WAIT_V(n) asm volatile("s_waitcnt vmcnt(" #n ")" ::: "memory")
#define PG8_WAIT_L(n) asm volatile("s_waitcnt lgkmcnt(" #n ")" ::: "memory")
#define PG8_BAR __builtin_amdgcn_s_barrier()
#define PG8_SCHED __builtin_amdgcn_sched_barrier(0)
    Unit cur, nxt; int ui = 0;
    if (!S.next(0, cur)) return;
    typename AccT<I8>::type acc[2][2][4][2];
#pragma unroll
    for (int a = 0; a < 2; ++a)
#pragma unroll
        for (int b = 0; b < 2; ++b)
#pragma unroll
            for (int m = 0; m < 4; ++m)
#pragma unroll
                for (int n = 0; n < 2; ++n) acc[a][b][m][n] = (typename AccT<I8>::type){};
    bf16x8 At[4][2], B0[2][2], B1[2][2]; i32x8 At8[4], B08[2], B18[2];
    const char* cA = (const char*)g.A + (size_t)cur.pm * tstep; const char* cB = (const char*)g.Bt + (size_t)cur.pn * tstep;
    S.a_ready(cur);
    if constexpr (SP2) {
        PG8_STAGE(PG8_SB(0, 0), cB, voffB); PG8_STAGE(PG8_SB(0, 1), cB + hstep, voffB); PG8_STAGE(PG8_SA(0, 0), cA, voffA); PG8_STAGE(PG8_SA(0, 1), cA + hstep, voffA);
        if (wr == 1) PG8_BAR;
        PG8_WAIT_V(2); PG8_BAR;
        PG8_STAGE(PG8_SB(1, 0), cB + kstep, voffB); PG8_STAGE(PG8_SA(1, 0), cA + kstep, voffA); PG8_STAGE(PG8_SB(1, 1), cB + hstep + kstep, voffB);
        PG8_WAIT_V(6); PG8_BAR;
    } else {
        PG8_STAGE(PG8_SB(0, 0), cB, voffB); PG8_STAGE(PG8_SA(0, 0), cA, voffA); PG8_STAGE(PG8_SB(0, 1), cB + hstep, voffB); PG8_STAGE(PG8_SA(0, 1), cA + hstep, voffA);
        if (wr == 1) PG8_BAR;
        PG8_WAIT_V(4); PG8_BAR;
        PG8_STAGE(PG8_SB(1, 0), cB + kstep, voffB); PG8_STAGE(PG8_SA(1, 0), cA + kstep, voffA); PG8_STAGE(PG8_SB(1, 1), cB + hstep + kstep, voffB);
        PG8_WAIT_V(6); PG8_BAR;
    }
    for (;;) {
        const bool has_next = S.next(ui + 1, nxt);
        const char* nA = has_next ? (const char*)g.A + (size_t)nxt.pm * tstep : cA; const char* nB = has_next ? (const char*)g.Bt + (size_t)nxt.pn * tstep : cB;
        for (int t = 0; t < nt; t += 2) {
            const bool last = (t == nt - 2);
            const char* a1 = cA + (size_t)(t + 1) * kstep;
            const char* a2 = last ? nA : cA + (size_t)(t + 2) * kstep; const char* b2 = last ? nB : cB + (size_t)(t + 2) * kstep;
            const char* a3 = a2 + kstep; const char* b3 = b2 + kstep;
            if (last && has_next) S.a_ready(nxt);
            if constexpr (SP2) {
            PG8_LDB(B0, 0, 0); PG8_LDB(B1, 0, 1); PG8_SCHED; PG8_LDA(At, 0, 0); PG8_STAGE(PG8_SA(1, 1), a1 + hstep, voffA);
            PG8_WAIT_V(8); PG8_WAIT_L(0); PG8_BAR; PG8_MMA(0, 0, At, B0); PG8_MMA(0, 1, At, B1); PG8_BAR; PG8_SCHED;
            PG8_LDA(At, 0, 1); PG8_STAGE(PG8_SB(0, 0), b2, voffB); PG8_STAGE(PG8_SB(0, 1), b2 + hstep, voffB); PG8_STAGE(PG8_SA(0, 0), a2, voffA);
            PG8_WAIT_V(8); PG8_WAIT_L(0); PG8_BAR; PG8_MMA(1, 0, At, B0); PG8_MMA(1, 1, At, B1); PG8_BAR; PG8_SCHED;
            PG8_LDB(B0, 1, 0); PG8_LDB(B1, 1, 1); PG8_SCHED; PG8_LDA(At, 1, 0); PG8_STAGE(PG8_SA(0, 1), a2 + hstep, voffA);
            PG8_WAIT_V(8); PG8_WAIT_L(0); PG8_BAR; PG8_MMA(0, 0, At, B0); PG8_MMA(0, 1, At, B1); PG8_BAR; PG8_SCHED;
            PG8_LDA(At, 1, 1); PG8_STAGE(PG8_SB(1, 0), b3, voffB); PG8_STAGE(PG8_SB(1, 1), b3 + hstep, voffB); PG8_STAGE(PG8_SA(1, 0), a3, voffA);
            PG8_WAIT_V(8); PG8_WAIT_L(0); PG8_BAR; PG8_MMA(1, 0, At, B0); PG8_MMA(1, 1, At, B1); PG8_BAR; PG8_SCHED;
            } else {
            PG8_LDB(B0, 0, 0); PG8_SCHED; PG8_LDA(At, 0, 0); PG8_STAGE(PG8_SA(1, 1), a1 + hstep, voffA);
            PG8_WAIT_L(8); PG8_BAR; PG8_WAIT_L(0); PG8_MMA(0, 0, At, B0); PG8_BAR; PG8_SCHED;
            PG8_LDB(B1, 0, 1); PG8_STAGE(PG8_SB(0, 0), b2, voffB);
            PG8_BAR; PG8_WAIT_L(0); PG8_MMA(0, 1, At, B1); PG8_BAR;
            PG8_LDA(At, 0, 1); PG8_STAGE(PG8_SA(0, 0), a2, voffA);
            PG8_BAR; PG8_WAIT_L(0); PG8_MMA(1, 0, At, B0); PG8_BAR; PG8_SCHED;
            PG8_STAGE(PG8_SB(0, 1), b2 + hstep, voffB);
            PG8_WAIT_V(6); PG8_BAR; PG8_MMA(1, 1, At, B1); PG8_BAR;
            PG8_LDB(B0, 1, 0); PG8_SCHED; PG8_LDA(At, 1, 0); PG8_STAGE(PG8_SA(0, 1), a2 + hstep, voffA);
            PG8_WAIT_L(8); PG8_BAR; PG8_WAIT_L(0); PG8_MMA(0, 0, At, B0); PG8_BAR; PG8_SCHED;
            PG8_LDB(B1, 1, 1); PG8_STAGE(PG8_SB(1, 0), b3, voffB);
            PG8_BAR; PG8_WAIT_L(0); PG8_MMA(0, 1, At, B1); PG8_BAR;
            PG8_LDA(At, 1, 1); PG8_STAGE(PG8_SA(1, 0), a3, voffA);
            PG8_BAR; PG8_WAIT_L(0); PG8_MMA(1, 0, At, B0); PG8_BAR; PG8_SCHED;
            PG8_STAGE(PG8_SB(1, 1), b3 + hstep, voffB);
            PG8_WAIT_V(6); PG8_BAR; PG8_MMA(1, 1, At, B1); PG8_BAR;
            }
        }
        if constexpr (ALIGN_EPI) { if (wr == 0) PG8_BAR; }
        if constexpr (F8) {
            asm volatile("s_nop 15\n\ts_nop 15" ::: "memory");
#pragma unroll
            for (int a = 0; a < 2; ++a)
#pragma unroll
                for (int b = 0; b < 2; ++b)
                    asm volatile("" : "+v"(acc[a][b][0][0]), "+v"(acc[a][b][0][1]), "+v"(acc[a][b][1][0]), "+v"(acc[a][b][1][1]), "+v"(acc[a][b][2][0]), "+v"(acc[a][b][2][1]), "+v"(acc[a][b][3][0]), "+v"(acc[a][b][3][1])); }
        if constexpr (!Epi::AFTER_DRAIN) { E(acc, cur, wr, wc, fr, fq); S.done(cur); }
        if (!has_next) break;
#pragma unroll
        for (int a = 0; a < 2; ++a)
#pragma unroll
            for (int b = 0; b < 2; ++b)
#pragma unroll
                for (int m = 0; m < 4; ++m)
#pragma unroll
                    for (int n = 0; n < 2; ++n) acc[a][b][m][n] = (typename AccT<I8>::type){};
        cur = nxt; cA = nA; cB = nB; ++ui;
        if constexpr (ALIGN_EPI) { if (wr == 1) PG8_BAR; }
    }
    PG8_WAIT_V(0);
    if constexpr (!ALIGN_EPI) { if (wr == 0) PG8_BAR; }
    PG8_BAR;
    if constexpr (Epi::AFTER_DRAIN) { E.fused(acc, cur, wr, wc, fr, fq, lds, wid, lane); S.done(cur); }
#undef PG8_SA
#undef PG8_SB
#undef PG8_STAGE
#undef PG8_LDA
#undef PG8_CAT
#undef PG8_LDB
#undef PG8_MMA
#undef PG8_WAIT_V
#undef PG8_WAIT_L
#undef PG8_BAR
#undef PG8_SCHED
}
}
#ifndef PG8_SP2
#define PG8_SP2 true
#endif
#ifndef PG8_ALIGN
#define PG8_ALIGN true
#endif

constexpr int BATCH = 2, SEQ = 16384, DM = 2048, T = BATCH * SEQ;
constexpr int INW = 6176, HP = 6400;
constexpr int H8P = 6144; constexpr int C_QA = 0, C_KA = 256, C_VA = 512, C_RA = 1024, C_QD = 1536, C_KD = 3072, C_VD = 4608, C_GF = 6144;
constexpr int NHD = 12;
constexpr float EPS = 1e-6f;
constexpr float LOG2E = 1.4426950408889634f;
constexpr float QSCALE = 0.08838834764831845f * LOG2E;
constexpr int NPHASE = 11;

constexpr size_t MiB = 1u << 20;
constexpr size_t WS_CTL = 0, WS_ROPE = 1 * MiB, WS_RS1 = 3 * MiB, WS_RS2 = 3 * MiB + 512 * 1024, WS_SSP = 4 * MiB, WS_WIN = 8 * MiB, WS_WO = 33 * MiB, WS_WQ = 41 * MiB,
                 WS_SK = 49 * MiB, WS_DEC = 50 * MiB, WS_LP = 51 * MiB, WS_IDX = 56 * MiB, WS_GATE = 72 * MiB, WS_DOWN = 88 * MiB, WS_UP = 152 * MiB, WS_XB = 216 * MiB,
                 WS_H = 344 * MiB, WS_X1B = WS_H, WS_QRY = WS_H + 128 * MiB, WS_OP1 = 744 * MiB, WS_OP2 = 840 * MiB, WS_PART = 472 * MiB  , WS_END = 984 * MiB;
constexpr size_t OUT_ST = 0, OUT_OP0 = 128 * MiB;
constexpr int LDS_BYTES = 147456;

#define LAS __attribute__((address_space(3)))
typedef unsigned short bf16_t;
typedef short bf16x8 __attribute__((ext_vector_type(8)));
typedef short s16x4 __attribute__((ext_vector_type(4)));
typedef float f32x4 __attribute__((ext_vector_type(4)));
typedef float f32x2 __attribute__((ext_vector_type(2)));
typedef float f32x16 __attribute__((ext_vector_type(16)));
typedef unsigned u32x4 __attribute__((ext_vector_type(4)));
typedef unsigned u32x2 __attribute__((ext_vector_type(2)));
#define LDS_WAIT() asm volatile("s_waitcnt lgkmcnt(0)" ::: "memory")
#define SBAR() __builtin_amdgcn_sched_barrier(0)

__device__ __forceinline__ float bf2f(unsigned short b) { return __uint_as_float(((unsigned)b) << 16); }
__device__ __forceinline__ float bflo(unsigned w) { return __uint_as_float(w << 16); }
__device__ __forceinline__ float bfhi(unsigned w) { return __uint_as_float(w & 0xffff0000u); }
__device__ __forceinline__ unsigned f2bf(float f) { unsigned u = __float_as_uint(f); return (u + 0x7fffu + ((u >> 16) & 1u)) >> 16; }
__device__ __forceinline__ unsigned pk2(float lo, float hi) { return pg8::cvt_pk_bf16(lo, hi); }
__device__ __forceinline__ float fexp(float x) { return __builtin_amdgcn_exp2f(x * LOG2E); }
__device__ __forceinline__ float flog(float x) { return __builtin_amdgcn_logf(x) * 0.6931471805599453f; }
__device__ __forceinline__ float wave_sum(float v) {
#pragma unroll
    for (int o = 1; o < 64; o <<= 1) v += __shfl_xor(v, o);
    return v;
}
__device__ __forceinline__ int crow(int r, int hi) { return (r & 3) + 8 * (r >> 2) + 4 * hi; }

struct Frame {
    LAS unsigned char* lds; char* ldsg; unsigned char* wsb;
    int tid, lane, wave, vcu, G;
    const float *x, *norm1_g, *w_in, *up_f, *bias_f, *up_b, *bias_b, *out_g, *qn_g, *kn_g, *w_out, *norm2_g, *w_query, *sub_keys, *peer_down, *peer_up;
    float* out;
    __device__ __forceinline__ f32x2* rope_() const { return (f32x2*)((f32x2*)(wsb + WS_ROPE)); }
    __device__ __forceinline__ float* rs1_() const { return (float*)((float*)(wsb + WS_RS1)); }
    __device__ __forceinline__ float* rs2_() const { return (float*)((float*)(wsb + WS_RS2)); }
    __device__ __forceinline__ float* ssp_() const { return (float*)((float*)(wsb + WS_SSP)); }
    __device__ __forceinline__ float* dec_() const { return (float*)((float*)(wsb + WS_DEC)); }
    __device__ __forceinline__ float* lp_() const { return (float*)((float*)(wsb + WS_LP)); }
    __device__ __forceinline__ float* gate_() const { return (float*)((float*)(wsb + WS_GATE)); }
    __device__ __forceinline__ short* part_() const { return (short*)(wsb + WS_PART); }
    __device__ __forceinline__ float* sd_() const { return (float*)((float*)(wsb + WS_CTL + 65536)); }
    __device__ __forceinline__ float* su_() const { return (float*)((float*)(wsb + WS_CTL + 131072)); }
    __device__ __forceinline__ float* sx_() const { return (float*)((float*)(wsb + WS_RS2 + 131072)); }
    __device__ __forceinline__ float* csum_() const { return (float*)((float*)(wsb + WS_RS2 + 262144)); }
    __device__ __forceinline__ unsigned char* down8_() const { return (unsigned char*)(wsb + WS_DOWN); }
    __device__ __forceinline__ unsigned char* up8_() const { return (unsigned char*)(wsb + WS_UP); }
    __device__ __forceinline__ unsigned char* xq8_() const { return (unsigned char*)(wsb + WS_OP2); }
    __device__ __forceinline__ unsigned char* fq8_() const { return (unsigned char*)(wsb + WS_XB + 64 * MiB); }
    __device__ __forceinline__ unsigned short* idxT_() const { return (unsigned short*)((unsigned short*)(wsb + WS_XB + 72 * MiB)); }
    __device__ __forceinline__ unsigned* fqT_() const { return (unsigned*)((unsigned*)(wsb + WS_XB + 80 * MiB)); }
    __device__ __forceinline__ unsigned short* idx_() const { return (unsigned short*)(wsb + WS_IDX); }
    __device__ __forceinline__ unsigned short* state_() const { return (unsigned short*)((unsigned short*)((unsigned char*)out + OUT_ST)); }
    __device__ __forceinline__ bf16_t* WinT_() const { return (bf16_t*)((bf16_t*)(wsb + WS_WIN)); }
    __device__ __forceinline__ unsigned char* Win8_() const { return (unsigned char*)(wsb + WS_WIN); }
    __device__ __forceinline__ unsigned char* xq1_() const { return (unsigned char*)(wsb + WS_OP1); }
    __device__ __forceinline__ float* sw_() const { return (float*)((float*)(wsb + WS_CTL + 196608)); }
    __device__ __forceinline__ unsigned* wqmax_() const { return (unsigned*)(wsb + WS_CTL) + 4608; }
    __device__ __forceinline__ float* swq_() const { return (float*)(wsb + WS_CTL + 229376); }
    __device__ __forceinline__ unsigned char* Wq8_() const { return (unsigned char*)(wsb + WS_WQ); }
    __device__ __forceinline__ unsigned char* xq6_() const { return (unsigned char*)(wsb + WS_OP1); }
    __device__ __forceinline__ unsigned char* Wo8_() const { return (unsigned char*)(wsb + WS_WO); }
    __device__ __forceinline__ float* swo_() const { return (float*)(wsb + WS_CTL + 262144); }
    __device__ __forceinline__ unsigned char* mixed8_() const { return (unsigned char*)(wsb + WS_XB); }
    __device__ __forceinline__ bf16_t* WqT_() const { return (bf16_t*)((bf16_t*)(wsb + WS_WQ)); }
    __device__ __forceinline__ bf16_t* SK_() const { return (bf16_t*)((bf16_t*)(wsb + WS_SK)); }
    __device__ __forceinline__ bf16_t* down16_() const { return (bf16_t*)((bf16_t*)(wsb + WS_DOWN)); }
    __device__ __forceinline__ bf16_t* up16_() const { return (bf16_t*)((bf16_t*)(wsb + WS_UP)); }
    __device__ __forceinline__ bf16_t* xb_() const { return (bf16_t*)((bf16_t*)(wsb + WS_XB)); }
    __device__ __forceinline__ bf16_t* mixed_() const { return (bf16_t*)((bf16_t*)(wsb + WS_XB)); }
    __device__ __forceinline__ bf16_t* h_() const { return (bf16_t*)((bf16_t*)(wsb + WS_H)); }
    __device__ __forceinline__ unsigned char* h8_() const { return (unsigned char*)(wsb + WS_H); }
    __device__ __forceinline__ bf16_t* r16_() const { return (bf16_t*)(wsb + WS_H + 208 * MiB); }
    __device__ __forceinline__ bf16_t* qk16_() const { return (bf16_t*)(wsb + WS_H + 240 * MiB); }
    __device__ __forceinline__ bf16_t* g16_() const { return (bf16_t*)(wsb + WS_H + 200 * MiB); }
    __device__ __forceinline__ bf16_t* x1b_() const { return (bf16_t*)((bf16_t*)(wsb + WS_X1B)); }
    __device__ __forceinline__ bf16_t* qry_() const { return (bf16_t*)((bf16_t*)(wsb + WS_QRY)); }
    __device__ __forceinline__ u32x4* gcache_() const { return (u32x4*)((unsigned char*)out + 64 * MiB); }
    __device__ __forceinline__ unsigned char* st8_() const { return (unsigned char*)out + 96 * MiB; }
    __device__ __forceinline__ unsigned char* kv8_() const { return wsb + WS_XB; }
    __device__ __forceinline__ bf16_t* op0_() const { return (bf16_t*)((bf16_t*)((unsigned char*)out + OUT_OP0)); }
    __device__ __forceinline__ bf16_t* op1_() const { return (bf16_t*)((bf16_t*)(wsb + WS_OP1)); }
    __device__ __forceinline__ bf16_t* op2_() const { return (bf16_t*)((bf16_t*)(wsb + WS_OP2)); }
};

__device__ __forceinline__ void p0_transpose_item(const float* W, int K, int N, bf16_t* WT, int k0, int n0, int dst_row0, const float* g, LAS float* scr, int lane) {
#pragma unroll 8
    for (int i = 0; i < 32; ++i) { const int kk = 2 * i + (lane >> 5); float w = W[(size_t)(k0 + kk) * N + n0 + (lane & 31)]; if (g) w *= g[k0 + kk]; scr[kk * 33 + (lane & 31)] = w; }
    LDS_WAIT(); asm volatile("" ::: "memory");
    const int c = lane & 7;
#pragma unroll
    for (int j = 0; j < 4; ++j) { const int n = (lane >> 3) + 8 * j; const LAS float* s = scr + (8 * c) * 33 + n;
        u32x4 o; o.x = pk2(s[0 * 33], s[1 * 33]); o.y = pk2(s[2 * 33], s[3 * 33]); o.z = pk2(s[4 * 33], s[5 * 33]); o.w = pk2(s[6 * 33], s[7 * 33]);
        *(u32x4*)(WT + (size_t)(dst_row0 + n) * K + k0 + 8 * c) = o; }
    LDS_WAIT(); asm volatile("" ::: "memory");
}
__device__ __forceinline__ unsigned pack_nib(unsigned a, unsigned b) { return (a & 0x0F0F0F0Fu) | ((b & 0x0F0F0F0Fu) << 4); }
__device__ __forceinline__ unsigned pack_i8x4(const f32x4 v, float inv, float lim) { unsigned w = 0u;
#pragma unroll
    for (int i = 0; i < 4; ++i) { const int qv = (int)fminf(fmaxf(rintf(v[i] * inv), -lim), lim); w |= ((unsigned)qv & 0xffu) << (8 * i); }
    return w; }
template <bool isup> __device__ __forceinline__ void peer_quant_row(const Frame& F, int e) {
    const int lane = F.lane;
    if constexpr (isup) {
        const f32x4* src = (const f32x4*)(F.peer_up + (size_t)e * DM) + lane;
        f32x4 v[8]; float m = 0.f;
#pragma unroll
        for (int j = 0; j < 8; ++j) { v[j] = src[64 * j];
            m = fmaxf(fmaxf(m, fmaxf(fabsf(v[j][0]), fabsf(v[j][1]))), fmaxf(fabsf(v[j][2]), fabsf(v[j][3]))); }
#pragma unroll
        for (int o = 1; o < 64; o <<= 1) m = fmaxf(m, __shfl_xor(m, o));
        const float inv = m > 0.f ? 127.f / m : 0.f; unsigned char* dst = F.up8_();
#pragma unroll
        for (int j = 0; j < 8; ++j) { const unsigned w = pack_i8x4(v[j], inv, 127.f);
            const int col = 4 * lane + 256 * j; *(unsigned*)(dst + ((size_t)(col >> 6) * 16384 + e) * 64 + (col & 63)) = w; }
        if (lane == 0) F.su_()[e] = m * (1.f / 127.f);
    } else {
        const f32x4* src = (const f32x4*)(F.peer_down + (size_t)e * DM) + 2 * lane; const f32x4* gs = (const f32x4*)F.norm2_g + 2 * lane;
        f32x4 v[8]; float ss = 0.f;
#pragma unroll
        for (int j = 0; j < 4; ++j) { v[2 * j] = src[128 * j] * gs[128 * j]; v[2 * j + 1] = src[128 * j + 1] * gs[128 * j + 1];
#pragma unroll
            for (int i = 0; i < 4; ++i) ss += v[2 * j][i] * v[2 * j][i] + v[2 * j + 1][i] * v[2 * j + 1][i]; }
        ss = wave_sum(ss);
        const float step = 0.345f * sqrtf(ss * (1.f / DM)), inv = step > 0.f ? 1.f / step : 0.f; unsigned char* dst = F.down8_();
#pragma unroll
        for (int j = 0; j < 4; ++j) { const unsigned w = pack_nib(pack_i8x4(v[2 * j], inv, 7.f), pack_i8x4(v[2 * j + 1], inv, 7.f));
            const int col = 8 * lane + 512 * j; *(unsigned*)(dst + ((size_t)(col >> 8) * 16384 + e) * 128 + ((col & 255) >> 3) * 4) = w; }
        if (lane == 0) F.sd_()[e] = step;
    }
}
template <bool F8>
__device__ __forceinline__ void w_quant_item(const Frame& F, const float* W, int ldw, int n0, const float* gain, unsigned char* W8, int drow, float* sw) {
    LAS float* scr = (LAS float*)(F.lds + F.wave * 16384); LAS float* cmx = (LAS float*)(F.lds + 12288);
    const int lane = F.lane, kw = F.wave * 256;
    float m = 0.f;
#pragma unroll 16
    for (int i = 0; i < 128; ++i) { const int k = kw + 2 * i + (lane >> 5); m = fmaxf(m, fabsf(W[(size_t)k * ldw + n0 + (lane & 31)] * (F8 ? 1.f : gain[k]))); }
    m = fmaxf(m, __shfl_xor(m, 32)); if (lane < 32) cmx[F.wave * 32 + lane] = m;
    __syncthreads();
    if (F.tid < 32) { float mm = 0.f;
#pragma unroll
        for (int w = 0; w < 8; ++w) mm = fmaxf(mm, cmx[w * 32 + F.tid]);
        cmx[256 + F.tid] = mm > 0.f ? (F8 ? 256.f : 127.f) / mm : 0.f; sw[drow + F.tid] = mm * (F8 ? 1.f / 1024.f : 1.f / 127.f); }
    __syncthreads();
    for (int ch = 0; ch < 4; ++ch) { const int k0 = kw + 64 * ch;
#pragma unroll 8
        for (int i = 0; i < 32; ++i) { const int kk = 2 * i + (lane >> 5); scr[kk * 33 + (lane & 31)] = W[(size_t)(k0 + kk) * ldw + n0 + (lane & 31)] * (F8 ? 1.f : gain[k0 + kk]) * cmx[256 + (lane & 31)]; }
        LDS_WAIT(); asm volatile("" ::: "memory");
        const int c = lane & 7;
#pragma unroll
        for (int j = 0; j < 4; ++j) { const int n = (lane >> 3) + 8 * j; const LAS float* sp = scr + (8 * c) * 33 + n; u32x2 w = {0u, 0u};
            if constexpr (F8) { w.x = (unsigned)__builtin_amdgcn_cvt_pk_fp8_f32(sp[0], sp[33], 0, false); w.x = (unsigned)__builtin_amdgcn_cvt_pk_fp8_f32(sp[66], sp[99], (int)w.x, true);
                w.y = (unsigned)__builtin_amdgcn_cvt_pk_fp8_f32(sp[132], sp[165], 0, false); w.y = (unsigned)__builtin_amdgcn_cvt_pk_fp8_f32(sp[198], sp[231], (int)w.y, true); }
            else {
#pragma unroll
            for (int i = 0; i < 4; ++i) { w.x |= ((unsigned)(int)rintf(sp[i * 33]) & 0xffu) << (8 * i); w.y |= ((unsigned)(int)rintf(sp[(4 + i) * 33]) & 0xffu) << (8 * i); } }
            *(u32x2*)(W8 + (size_t)(drow + n) * DM + k0 + 8 * c) = w; }
        LDS_WAIT(); asm volatile("" ::: "memory"); }
    __syncthreads();
}
__device__ __forceinline__ void x_quant_row(const Frame& F, int m) {
    const int lane = F.lane; const f32x4* xr = (const f32x4*)(F.x + (size_t)m * DM) + lane; f32x4 v[8]; float s = 0.f, mx = 0.f;
#pragma unroll
    for (int j = 0; j < 8; ++j) { v[j] = xr[64 * j]; s += (v[j][0] * v[j][0] + v[j][1] * v[j][1]) + (v[j][2] * v[j][2] + v[j][3] * v[j][3]);
        mx = fmaxf(fmaxf(mx, fmaxf(fabsf(v[j][0]), fabsf(v[j][1]))), fmaxf(fabsf(v[j][2]), fabsf(v[j][3]))); }
    s = wave_sum(s);
#pragma unroll
    for (int o = 1; o < 64; o <<= 1) mx = fmaxf(mx, __shfl_xor(mx, o));
    const float inv = mx > 0.f ? 127.f / mx : 0.f; unsigned* o4 = (unsigned*)(F.xq1_() + (size_t)m * DM) + lane;
#pragma unroll
    for (int j = 0; j < 8; ++j) o4[64 * j] = pack_i8x4(v[j], inv, 127.f);
    if (lane == 0) { F.rs1_()[m] = __builtin_amdgcn_rsqf(s * (1.f / DM) + EPS) * (mx * (1.f / 127.f)); F.sx_()[m] = mx * (1.25f / 119.f); }
}
#ifndef WO_P0
#define WO_P0 63
#endif
#ifndef PQ2
#define PQ2 3072
#endif
#ifndef PQ_DEFER
#define PQ_DEFER 1536
#endif
__device__ __forceinline__ void phase0(const Frame& F) {
    LAS float* scr = (LAS float*)(F.lds + F.wave * 16384);
    const int gw = F.vcu * 8 + F.wave, NGW = F.G * 8, lane = F.lane;
    for (int nb = F.vcu; nb < 193; nb += F.G) w_quant_item<false>(F, F.w_in, INW, nb * 32, F.norm1_g, F.Win8_(), nb < 32 ? nb * 32 : (nb == 32 ? C_GF : nb * 32 - 32), F.sw_());
    for (int nb = F.vcu + (F.vcu < 193 ? F.G : 0); nb < 193 + WO_P0; nb += F.G) w_quant_item<true>(F, F.w_out, DM, (nb - 193) * 32, nullptr, F.Wo8_(), (nb - 193) * 32, F.swo_());
    { LAS float* rm = (LAS float*)(F.lds);
      for (int k0 = F.vcu * 8; k0 < DM; k0 += F.G * 8) { const int k = k0 + F.wave; const float g = F.norm2_g[k]; const f32x4* wr = (const f32x4*)(F.w_query + (size_t)k * DM) + lane;
          __syncthreads();
#pragma unroll
          for (int j = 0; j < 8; ++j) { const f32x4 v = wr[64 * j]; *(LAS f32x4*)(rm + F.wave * 2048 + 4 * (lane + 64 * j)) = (f32x4){fabsf(v[0] * g), fabsf(v[1] * g), fabsf(v[2] * g), fabsf(v[3] * g)}; }
          __syncthreads();
          { f32x4 m = *(const LAS f32x4*)(rm + 4 * F.tid);
#pragma unroll
            for (int w = 1; w < 8; ++w) { const f32x4 o = *(const LAS f32x4*)(rm + w * 2048 + 4 * F.tid); m[0] = fmaxf(m[0], o[0]); m[1] = fmaxf(m[1], o[1]); m[2] = fmaxf(m[2], o[2]); m[3] = fmaxf(m[3], o[3]); }
            unsigned* cm = F.wqmax_() + 4 * F.tid;
#pragma unroll
            for (int i = 0; i < 4; ++i) (void)__hip_atomic_fetch_max(cm + i, __float_as_uint(m[i]), __ATOMIC_RELAXED, __HIP_MEMORY_SCOPE_AGENT); } }
      __syncthreads(); }
    const size_t gt = (size_t)gw * 64 + lane, NT = (size_t)NGW * 64;
    { u32x4* z = (u32x4*)(F.Win8_() + (size_t)INW * DM); const u32x4 zero = {0u, 0u, 0u, 0u}; for (size_t i = gt; i < (size_t)(HP - INW) * DM / 16; i += NT) z[i] = zero; if (gt < (size_t)(HP - INW)) F.sw_()[INW + gt] = 0.f; }
    for (int r = gw; r < 16384 - PQ_DEFER; r += NGW) peer_quant_row<false>(F, r);
    for (int r = gw; r < 16384 - PQ_DEFER - PQ2; r += NGW) peer_quant_row<true>(F, r);
    for (size_t i = gt; i < (size_t)8 * 2 * 128 * 128 / 8; i += NT) { const f32x4 a = *(const f32x4*)(F.sub_keys + i * 8), b = *(const f32x4*)(F.sub_keys + i * 8 + 4);
        u32x4 o; o.x = pk2(a[0], a[1]); o.y = pk2(a[2], a[3]); o.z = pk2(b[0], b[1]); o.w = pk2(b[2], b[3]); *(u32x4*)(F.SK_() + i * 8) = o; }
    for (int m = gw; m < T; m += NGW) x_quant_row(F, m);
}
__device__ __forceinline__ void wq_quant_transpose(const Frame& F, const int gw, const int NGW) {
    LAS float* scr = (LAS float*)(F.lds + F.wave * 16384); const int lane = F.lane;
    for (int it = gw; it < 32 * 64; it += NGW) { const int k0 = (it / 64) * 64, n0 = (it % 64) * 32;
        const float cmx = __uint_as_float(F.wqmax_()[n0 + (lane & 31)]), inv = cmx > 0.f ? 127.f / cmx : 0.f;
        if (k0 == 0 && lane < 32) F.swq_()[n0 + lane] = cmx * (1.f / 127.f);
#pragma unroll 8
        for (int i = 0; i < 32; ++i) { const int kk = 2 * i + (lane >> 5); scr[kk * 33 + (lane & 31)] = F.w_query[(size_t)(k0 + kk) * DM + n0 + (lane & 31)] * F.norm2_g[k0 + kk] * inv; }
        LDS_WAIT(); asm volatile("" ::: "memory");
        const int c = lane & 7;
#pragma unroll
        for (int j = 0; j < 4; ++j) { const int n = (lane >> 3) + 8 * j; const LAS float* sp = scr + (8 * c) * 33 + n; u32x2 w = {0u, 0u};
#pragma unroll
            for (int i = 0; i < 4; ++i) { w.x |= ((unsigned)(int)rintf(sp[i * 33]) & 0xffu) << (8 * i); w.y |= ((unsigned)(int)rintf(sp[(4 + i) * 33]) & 0xffu) << (8 * i); }
            *(u32x2*)(F.Wq8_() + (size_t)(n0 + n) * DM + k0 + 8 * c) = w; }
        LDS_WAIT(); asm volatile("" ::: "memory"); }
    __syncthreads();
}

constexpr int GL_GDS = 0, GL_TOT = 8192, GL_QF = 12288, GL_QB = 21504, GL_KF = 30720, GL_KB = 39936, GL_VT = 49152, GL_P = 67584, GL_SF = 76800, GL_SB = 95232, GL_OB = 12288;
constexpr int RS72 = 144;
__device__ __forceinline__ float logsig(float z) { return fminf(z, 0.f) - flog(1.f + fexp(-fabsf(z))); }
__device__ __forceinline__ void gla_gates(const Frame& F, int b, int hh, int n, float (&bf)[8], float (&bb)[8], float& totf, float& totb) {
    const int tid = F.tid, c = tid & 63, ig = F.wave; LAS float* gds = (LAS float*)(F.lds + GL_GDS); LAS float* tot = (LAS float*)(F.lds + GL_TOT);
    const size_t t0 = (size_t)b * SEQ + (size_t)n * 64;
    if (tid < 256) { const int tk = tid >> 2, part = tid & 3; const u32x4 w = *(const u32x4*)(F.g16_() + (t0 + tk) * 32 + part * 8); LAS float* d = gds + tk * 32 + part * 8;
        d[0] = bflo(w.x); d[1] = bfhi(w.x); d[2] = bflo(w.y); d[3] = bfhi(w.y); d[4] = bflo(w.z); d[5] = bfhi(w.z); d[6] = bflo(w.w); d[7] = bfhi(w.w); }
    __syncthreads();
    const int hc = hh * 64 + c; float upf[16], upb[16];
#pragma unroll
    for (int r = 0; r < 16; ++r) { upf[r] = F.up_f[r * 256 + hc]; upb[r] = F.up_b[r * 256 + hc]; }
    const float biasf = F.bias_f[hc], biasb = F.bias_b[hc]; float laf[8], lab[8];
#pragma unroll
    for (int e = 0; e < 8; ++e) { const LAS float* gr = gds + (ig * 8 + e) * 32; float zf = biasf, zb = biasb;
#pragma unroll
        for (int r = 0; r < 16; ++r) { zf += gr[r] * upf[r]; zb += gr[16 + r] * upb[r]; }
        laf[e] = logsig(zf) * 0.0625f; lab[e] = logsig(zb) * 0.0625f; }
    bf[0] = laf[0];
#pragma unroll
    for (int e = 1; e < 8; ++e) bf[e] = bf[e - 1] + laf[e];
    bb[7] = lab[7];
#pragma unroll
    for (int e = 6; e >= 0; --e) bb[e] = bb[e + 1] + lab[e];
    tot[ig * 64 + c] = bf[7]; tot[512 + ig * 64 + c] = bb[0];
    __syncthreads();
    float offf = 0.f, offb = 0.f; totf = 0.f; totb = 0.f;
#pragma unroll
    for (int g = 0; g < 8; ++g) { const float tf = tot[g * 64 + c], tb = tot[512 + g * 64 + c]; totf += tf; totb += tb; offf += (g < ig) ? tf : 0.f; offb += (g > ig) ? tb : 0.f; }
#pragma unroll
    for (int e = 0; e < 8; ++e) { bf[e] += offf; bb[e] += offb; }
}
__device__ __forceinline__ float f8tof(unsigned char b) { return __builtin_amdgcn_cvt_f32_fp8((int)b, 0); }
__device__ __forceinline__ bf16x8 f8x8_bf16(u32x2 w) { const f32x2 a_ = __builtin_amdgcn_cvt_pk_f32_fp8((int)w.x, false), b_ = __builtin_amdgcn_cvt_pk_f32_fp8((int)w.x, true), c_ = __builtin_amdgcn_cvt_pk_f32_fp8((int)w.y, false), d_ = __builtin_amdgcn_cvt_pk_f32_fp8((int)w.y, true);
    const u32x4 o = {pk2(a_[0], a_[1]), pk2(b_[0], b_[1]), pk2(c_[0], c_[1]), pk2(d_[0], d_[1])}; return __builtin_bit_cast(bf16x8, o); }
__device__ __forceinline__ void gla_stage_vT(const Frame& F, const bf16x8 (&vraw)[2]) {
#pragma unroll
    for (int j = 0; j < 2; ++j) { const int q = F.tid + 512 * j, tk = q >> 4, vc = (q & 15) * 8; LAS short* d = (LAS short*)(F.lds + GL_VT) + vc * 72 + tk;
#pragma unroll
        for (int e = 0; e < 8; ++e) d[e * 72] = vraw[j][e]; }
}
__device__ __forceinline__ bf16x8 ldfrag(const LAS unsigned char* base, int row, int s, int hi) { return *(const LAS bf16x8*)(base + row * RS72 + (16 * s + 8 * hi) * 2); }

__device__ __forceinline__ void gla_passA(const Frame& F, int item) {
    const int bh = item >> 8, n = item & 255, b = bh >> 2, hh = bh & 3, tid = F.tid, c = tid & 63, ig = F.wave, lane = F.lane, r32 = lane & 31, hi = lane >> 5;
    const size_t t0 = (size_t)b * SEQ + (size_t)n * 64;
    unsigned short kraw[8]; u32x2 vraw8[2];
#pragma unroll
    for (int e = 0; e < 8; ++e) kraw[e] = F.qk16_()[(t0 + ig * 8 + e) * 512 + C_KA + hh * 64 + c];
#pragma unroll
    for (int j = 0; j < 2; ++j) { const int q = tid + 512 * j; vraw8[j] = *(const u32x2*)(F.h8_() + (t0 + (q >> 4)) * H8P + C_VA + hh * 128 + (q & 15) * 8); }
    float bf[8], bb[8], totf, totb; gla_gates(F, b, hh, n, bf, bb, totf, totb);
    { u32x4 w0, w1; w0.x = pk2(bf[0], bf[1]); w0.y = pk2(bf[2], bf[3]); w0.z = pk2(bf[4], bf[5]); w0.w = pk2(bf[6], bf[7]); w1.x = pk2(bb[0], bb[1]); w1.y = pk2(bb[2], bb[3]); w1.z = pk2(bb[4], bb[5]); w1.w = pk2(bb[6], bb[7]);
      u32x4* gc = F.gcache_() + ((size_t)item * 512 + tid) * 2; gc[0] = w0; gc[1] = w1; }
    float kf[8], kb[8];
#pragma unroll
    for (int e = 0; e < 8; ++e) { const float k = bf2f(kraw[e]); kf[e] = k * fexp(totf - bf[e]); kb[e] = k * fexp(totb - bb[e]); }
    { u32x4 o; o.x = pk2(kf[0], kf[1]); o.y = pk2(kf[2], kf[3]); o.z = pk2(kf[4], kf[5]); o.w = pk2(kf[6], kf[7]); *(LAS u32x4*)(F.lds + GL_KF + c * RS72 + ig * 16) = o;
      o.x = pk2(kb[0], kb[1]); o.y = pk2(kb[2], kb[3]); o.z = pk2(kb[4], kb[5]); o.w = pk2(kb[6], kb[7]); *(LAS u32x4*)(F.lds + GL_KB + c * RS72 + ig * 16) = o; }
    { const bf16x8 vraw[2] = {f8x8_bf16(vraw8[0]), f8x8_bf16(vraw8[1])}; gla_stage_vT(F, vraw); }
    if (ig == 0) { F.dec_()[((size_t)(0 * 8 + bh) * 256 + n) * 64 + c] = fexp(totf); F.dec_()[((size_t)(1 * 8 + bh) * 256 + n) * 64 + c] = fexp(totb); }
    __syncthreads();
    const int dir = F.wave >> 2, vt = F.wave & 3; const LAS unsigned char* kimg = F.lds + (dir ? GL_KB : GL_KF);
    f32x16 a0 = {}, a1 = {};
#pragma unroll
    for (int s = 0; s < 4; ++s) { const bf16x8 av = ldfrag(F.lds + GL_VT, 32 * vt + r32, s, hi), b0 = ldfrag(kimg, r32, s, hi), b1 = ldfrag(kimg, 32 + r32, s, hi);
        a0 = __builtin_amdgcn_mfma_f32_32x32x16_bf16(av, b0, a0, 0, 0, 0); a1 = __builtin_amdgcn_mfma_f32_32x32x16_bf16(av, b1, a1, 0, 0, 0); }
    unsigned short* st = F.state_() + ((size_t)(dir * 8 + bh) * 256 + n) * 8192;
#pragma unroll
    for (int r = 0; r < 16; ++r) { const int v = 32 * vt + crow(r, hi); st[v * 64 + r32] = (unsigned short)f2bf(a0[r]); st[v * 64 + 32 + r32] = (unsigned short)f2bf(a1[r]); }
    __syncthreads();
}
__device__ __forceinline__ void gla_scan(const Frame& F, int item) {
    const int dir = item >> 7, bh = (item >> 4) & 7, e = (item & 15) * 512 + F.tid, c = e & 63;
    const unsigned short* st = F.state_() + (size_t)(dir * 8 + bh) * 256 * 8192 + e; unsigned char* so = F.st8_() + (size_t)(dir * 8 + bh) * 256 * 8192 + e; const float* dc = F.dec_() + (size_t)(dir * 8 + bh) * 256 * 64 + c; float S = 0.f;
    float iA[16], dA[16], iB[16], dB[16];
#define SC_N(g, j) (dir ? 255 - ((g) * 16 + (j)) : (g) * 16 + (j))
#define SC_LOAD(I_, D_, g) do { _Pragma("unroll") for (int j = 0; j < 16; ++j) { const int n_ = SC_N(g, j); I_[j] = bf2f(st[(size_t)n_ * 8192]); D_[j] = dc[n_ * 64]; } } while (0)
#define SC_RUN(I_, D_, g) do { _Pragma("unroll") for (int j = 0; j < 16; ++j) { const int n_ = SC_N(g, j); so[(size_t)n_ * 8192] = (unsigned char)__builtin_amdgcn_cvt_pk_fp8_f32(S, 0.f, 0, false); S = D_[j] * S + I_[j]; } } while (0)
    SC_LOAD(iA, dA, 0);
    for (int g = 0; g < 16; g += 2) { SC_LOAD(iB, dB, g + 1); SC_RUN(iA, dA, g); if (g + 2 < 16) SC_LOAD(iA, dA, g + 2); SC_RUN(iB, dB, g + 1); }
#undef SC_N
#undef SC_LOAD
#undef SC_RUN
}
struct PCRaw { unsigned short qraw[8], kraw[8]; u32x2 vraw[2]; u32x2 sraw[2][2]; u32x4 g0, g1; };
__device__ __forceinline__ void gla_passC_load(const Frame& F, int item, PCRaw& R) {
    const int bh = item >> 8, n = item & 255, b = bh >> 2, hh = bh & 3, tid = F.tid, c = tid & 63, ig = F.wave;
    const size_t t0 = (size_t)b * SEQ + (size_t)n * 64;
#pragma unroll
    for (int e = 0; e < 8; ++e) { const bf16_t* hr = F.qk16_() + (t0 + ig * 8 + e) * 512 + hh * 64 + c; R.qraw[e] = hr[C_QA]; R.kraw[e] = hr[C_KA]; }
#pragma unroll
    for (int j = 0; j < 2; ++j) { const int q = tid + 512 * j; R.vraw[j] = *(const u32x2*)(F.h8_() + (t0 + (q >> 4)) * H8P + C_VA + hh * 128 + (q & 15) * 8);
#pragma unroll
        for (int dir = 0; dir < 2; ++dir) R.sraw[dir][j] = *(const u32x2*)(F.st8_() + ((size_t)(dir * 8 + bh) * 256 + n) * 8192 + (q >> 3) * 64 + (q & 7) * 8); }
    { const u32x4* gc = F.gcache_() + ((size_t)item * 512 + tid) * 2; R.g0 = gc[0]; R.g1 = gc[1]; }
}
__device__ __forceinline__ void gla_passC(const Frame& F, int item, PCRaw& R, int next_item) {
    const int bh = item >> 8, n = item & 255, b = bh >> 2, hh = bh & 3, tid = F.tid, c = tid & 63, ig = F.wave, lane = F.lane, r32 = lane & 31, hi = lane >> 5;
    const size_t t0 = (size_t)b * SEQ + (size_t)n * 64;
    float bf[8], bb[8];
    { const u32x4 w0 = R.g0, w1 = R.g1;
      bf[0] = bflo(w0.x); bf[1] = bfhi(w0.x); bf[2] = bflo(w0.y); bf[3] = bfhi(w0.y); bf[4] = bflo(w0.z); bf[5] = bfhi(w0.z); bf[6] = bflo(w0.w); bf[7] = bfhi(w0.w);
      bb[0] = bflo(w1.x); bb[1] = bfhi(w1.x); bb[2] = bflo(w1.y); bb[3] = bfhi(w1.y); bb[4] = bflo(w1.z); bb[5] = bfhi(w1.z); bb[6] = bflo(w1.w); bb[7] = bfhi(w1.w); }
#pragma unroll
    for (int e = 0; e < 8; ++e) { const int i = ig * 8 + e; const float q = bf2f(R.qraw[e]) * 0.125f, k = bf2f(R.kraw[e]);
        const float ef = fexp(bf[e]), eb = fexp(bb[e]), nf = fexp(-bf[e]), nb = fexp(-bb[e]);
        *(LAS unsigned short*)(F.lds + GL_QF + i * RS72 + c * 2) = (unsigned short)f2bf(q * ef); *(LAS unsigned short*)(F.lds + GL_QB + i * RS72 + c * 2) = (unsigned short)f2bf(q * eb);
        *(LAS unsigned short*)(F.lds + GL_KF + i * RS72 + c * 2) = (unsigned short)f2bf(k * nf); *(LAS unsigned short*)(F.lds + GL_KB + i * RS72 + c * 2) = (unsigned short)f2bf(k * nb); }
    { const bf16x8 vraw[2] = {f8x8_bf16(R.vraw[0]), f8x8_bf16(R.vraw[1])}; gla_stage_vT(F, vraw); }
#pragma unroll
    for (int dir = 0; dir < 2; ++dir)
#pragma unroll
        for (int j = 0; j < 2; ++j) { const int q = tid + 512 * j; const u32x2 w_ = R.sraw[dir][j];
            const f32x2 a_ = __builtin_amdgcn_cvt_pk_f32_fp8((int)w_.x, false), b_ = __builtin_amdgcn_cvt_pk_f32_fp8((int)w_.x, true), c_ = __builtin_amdgcn_cvt_pk_f32_fp8((int)w_.y, false), d_ = __builtin_amdgcn_cvt_pk_f32_fp8((int)w_.y, true);
            *(LAS u32x4*)(F.lds + (dir ? GL_SB : GL_SF) + (q >> 3) * RS72 + (q & 7) * 16) = (u32x4){pk2(a_[0], a_[1]), pk2(b_[0], b_[1]), pk2(c_[0], c_[1]), pk2(d_[0], d_[1])}; }
    if (next_item >= 0) gla_passC_load(F, next_item, R);
    __syncthreads();
    if (F.wave < 4) { const int ti = F.wave >> 1, tj = F.wave & 1; f32x16 sf = {}, sb = {};
#pragma unroll
        for (int s = 0; s < 4; ++s) {
            sf = __builtin_amdgcn_mfma_f32_32x32x16_bf16(ldfrag(F.lds + GL_QF, 32 * ti + r32, s, hi), ldfrag(F.lds + GL_KF, 32 * tj + r32, s, hi), sf, 0, 0, 0);
            sb = __builtin_amdgcn_mfma_f32_32x32x16_bf16(ldfrag(F.lds + GL_QB, 32 * ti + r32, s, hi), ldfrag(F.lds + GL_KB, 32 * tj + r32, s, hi), sb, 0, 0, 0); }
#pragma unroll
        for (int r = 0; r < 16; ++r) { const int i = 32 * ti + crow(r, hi), j = 32 * tj + r32; const float p = (j <= i) ? sf[r] : sb[r];
            *(LAS unsigned short*)(F.lds + GL_P + i * RS72 + j * 2) = (unsigned short)f2bf(p); } }
    __syncthreads();
    const int ti = F.wave & 1, tv = F.wave >> 1; f32x16 o = {};
#pragma unroll
    for (int s = 0; s < 4; ++s) o = __builtin_amdgcn_mfma_f32_32x32x16_bf16(ldfrag(F.lds + GL_P, 32 * ti + r32, s, hi), ldfrag(F.lds + GL_VT, 32 * tv + r32, s, hi), o, 0, 0, 0);
#pragma unroll
    for (int s = 0; s < 4; ++s) o = __builtin_amdgcn_mfma_f32_32x32x16_bf16(ldfrag(F.lds + GL_QF, 32 * ti + r32, s, hi), ldfrag(F.lds + GL_SF, 32 * tv + r32, s, hi), o, 0, 0, 0);
#pragma unroll
    for (int s = 0; s < 4; ++s) o = __builtin_amdgcn_mfma_f32_32x32x16_bf16(ldfrag(F.lds + GL_QB, 32 * ti + r32, s, hi), ldfrag(F.lds + GL_SB, 32 * tv + r32, s, hi), o, 0, 0, 0);
    __syncthreads();
    LAS float* ob = (LAS float*)(F.lds + GL_OB);
#pragma unroll
    for (int r = 0; r < 16; ++r) ob[(32 * ti + crow(r, hi)) * 132 + 32 * tv + r32] = o[r];
    __syncthreads();
    { const int i = tid >> 3, part = tid & 7, v0 = part * 16; float ov[16], ss = 0.f;
#pragma unroll
      for (int e = 0; e < 16; ++e) { ov[e] = ob[i * 132 + v0 + e]; ss += ov[e] * ov[e]; }
      ss += __shfl_xor(ss, 1); ss += __shfl_xor(ss, 2); ss += __shfl_xor(ss, 4);
      const float rs = __builtin_amdgcn_rsqf(ss * (1.f / 128.f) + EPS); const size_t tok = t0 + i;
      const u32x4 r0 = *(const u32x4*)(F.r16_() + tok * 512 + hh * 128 + v0), r1 = *(const u32x4*)(F.r16_() + tok * 512 + hh * 128 + v0 + 8);
      const float rr[16] = {bflo(r0.x), bfhi(r0.x), bflo(r0.y), bfhi(r0.y), bflo(r0.z), bfhi(r0.z), bflo(r0.w), bfhi(r0.w), bflo(r1.x), bfhi(r1.x), bflo(r1.y), bfhi(r1.y), bflo(r1.z), bfhi(r1.z), bflo(r1.w), bfhi(r1.w)};
      float y[16];
#pragma unroll
      for (int e = 0; e < 16; ++e) { const float g = F.out_g[hh * 128 + v0 + e]; const float sil = rr[e] * __builtin_amdgcn_rcpf(1.f + fexp(-rr[e])); y[e] = ov[e] * rs * g * sil; }
#pragma unroll
      for (int e = 0; e < 16; ++e) y[e] = __builtin_amdgcn_fmed3f(y[e] * 4.f, -448.f, 448.f);
      u32x4 w0;
#define GL_P4(a, b, c, d) ((unsigned)__builtin_amdgcn_cvt_pk_fp8_f32(c, d, __builtin_amdgcn_cvt_pk_fp8_f32(a, b, 0, false), true))
      w0.x = GL_P4(y[0], y[1], y[2], y[3]); w0.y = GL_P4(y[4], y[5], y[6], y[7]); w0.z = GL_P4(y[8], y[9], y[10], y[11]); w0.w = GL_P4(y[12], y[13], y[14], y[15]);
#undef GL_P4
      *(u32x4*)(F.mixed8_() + tok * DM + hh * 128 + v0) = w0; }
    __syncthreads();
}

constexpr int AT_V = 0, AT_K = 49152, AT_O = 81920, AT_OSZ = 4608;
#define KSWZ(row, colB) ((row) * 256 + ((colB) ^ (((row) & 7) << 4)))
__device__ __forceinline__ int v_st(int k, int c) { const int kk = (k & ~0xC) | ((k & 4) << 1) | ((k & 8) >> 1); return ((kk >> 3) * 4 + (c >> 5)) * 512 + ((kk & 7) * 32 + (c & 31)) * 2; }
__device__ __forceinline__ int v_rd_base(int lane) { return ((lane & 3) << 3) | (((lane >> 2) & 3) << 6) | (((lane >> 4) & 1) << 5) | (((lane >> 5) & 1) << 8); }
constexpr int v_rd_off(int d0, int ks, int half) { return d0 * 512 + ks * 4096 + half * 2048; }
struct AtP { size_t tokbase; int dil, m0, Tf, nt, head, p; };
__device__ __forceinline__ AtP at_decode(int item) {
    AtP P; const int round = item >> 8, w = item & 255, p = round % 3, bh = round / 3, b = bh / 3, u = w & 63; P.p = p; P.head = (bh % 3) * 4 + (w >> 6);
    const int dsh = 2 * p, L = SEQ >> dsh, runs = 64 >> dsh, res = u / runs; P.dil = 1 << dsh; P.m0 = (u % runs) * 256; P.tokbase = (size_t)b * SEQ + res;
    const int kt_lo = (P.m0 == 0) ? 1 : 0, kt_hi = (P.m0 + 256 >= L) ? 4 : 5; P.Tf = P.m0 - 64 + 64 * kt_lo; P.nt = kt_hi - kt_lo + 1; return P;
}
__device__ __forceinline__ void attn_phase(const Frame& F) {
    const int tid = F.tid, wid = F.wave, lane = F.lane, r32 = lane & 31, hi = lane >> 5, G = F.G;
    int ntot = 0; for (int it = F.vcu; it < 4608; it += G) ntot += at_decode(it).nt;
    if (ntot == 0) return;
    const int sr = tid >> 4, sc = (tid & 15) * 8, vst0 = v_st(sr, sc), vst1 = v_st(32 + sr, sc), kc = sc * 2;
    const int vb0 = (int)(unsigned)(uintptr_t)(F.ldsg + AT_V) + v_rd_base(lane);
    int it_ld = F.vcu, rl = 0, it_c = F.vcu, rc = 0; AtP ld = at_decode(it_ld), cur = ld;
    bf16x8 qr[8]; u32x2 qn[8]; f32x16 o[4]; float l_reg = 0.f;
    u32x2 sA0, sA1, sA2, sA3, sB0, sB1, sB2, sB3;
    const bool rot = false;
    bf16x8 pa0, pa1, pa2, pa3;
    bool pend = false, pend_last = false; int vprev = 0, prvQ0 = 0; AtP prv = cur;
#pragma unroll
    for (int d0 = 0; d0 < 4; ++d0) o[d0] = (f32x16){};
#define AT_QLOAD() do { const unsigned char* qp_ = F.h8_() + C_QD + ld.head * 128 + (ld.tokbase + (size_t)ld.dil * (ld.m0 + 32 * wid + r32)) * H8P + hi * 8; \
        _Pragma("unroll") for (int d0 = 0; d0 < 8; ++d0) qn[d0] = *(const u32x2*)(qp_ + d0 * 16); } while (0)
#define AT_SLOAD(S) do { const int T0_ = ld.Tf + 64 * rl; const size_t ra = (ld.tokbase + (size_t)ld.dil * (T0_ + sr)) * H8P + ld.head * 128 + sc, rb = ra + (size_t)ld.dil * 32 * H8P;     \
        S##0 = *(const u32x2*)(F.h8_() + C_VD + ra); S##1 = *(const u32x2*)(F.h8_() + C_VD + rb); S##2 = *(const u32x2*)(F.h8_() + C_KD + ra); S##3 = *(const u32x2*)(F.h8_() + C_KD + rb); \
        if (++rl == ld.nt) { it_ld += G; rl = 0; if (it_ld < 4608) { ld = at_decode(it_ld); AT_QLOAD(); } } } while (0)
#define AT_F8(W) ({ const f32x2 a_ = __builtin_amdgcn_cvt_pk_f32_fp8((int)(W).x, false), b_ = __builtin_amdgcn_cvt_pk_f32_fp8((int)(W).x, true), c_ = __builtin_amdgcn_cvt_pk_f32_fp8((int)(W).y, false), d_ = __builtin_amdgcn_cvt_pk_f32_fp8((int)(W).y, true); \
        (u32x4){pk2(a_[0], a_[1]), pk2(b_[0], b_[1]), pk2(c_[0], c_[1]), pk2(d_[0], d_[1])}; })
#define AT_SWRITE(S, KB, VB) do { *(LAS u32x4*)(F.lds + AT_V + (VB) * 16384 + vst0) = AT_F8(S##0); *(LAS u32x4*)(F.lds + AT_V + (VB) * 16384 + vst1) = AT_F8(S##1); \
        *(LAS u32x4*)(F.lds + AT_K + (KB) * 16384 + KSWZ(sr, kc)) = AT_F8(S##2); *(LAS u32x4*)(F.lds + AT_K + (KB) * 16384 + KSWZ(32 + sr, kc)) = AT_F8(S##3); } while (0)
#define PK4(P, BASE, OUT) do { unsigned a0_ = pk2(P[BASE + 0], P[BASE + 1]), a1_ = pk2(P[BASE + 2], P[BASE + 3]); unsigned b0_ = pk2(P[BASE + 4], P[BASE + 5]), b1_ = pk2(P[BASE + 6], P[BASE + 7]); \
        auto r0_ = __builtin_amdgcn_permlane32_swap(a0_, b0_, false, false); auto r1_ = __builtin_amdgcn_permlane32_swap(a1_, b1_, false, false); \
        u32x4 w_ = {r0_[0], r1_[0], r0_[1], r1_[1]}; OUT = __builtin_bit_cast(bf16x8, w_); } while (0)
#define AT_TRD(OFF) __builtin_amdgcn_ds_read_tr16_b64_v4i16((LAS s16x4*)(uintptr_t)(unsigned)(vb_ + (OFF)))
#define AT_PVR(D0, R) do { R[0] = AT_TRD(v_rd_off(D0, 0, 0)); R[1] = AT_TRD(v_rd_off(D0, 0, 1)); R[2] = AT_TRD(v_rd_off(D0, 1, 0)); R[3] = AT_TRD(v_rd_off(D0, 1, 1)); \
        R[4] = AT_TRD(v_rd_off(D0, 2, 0)); R[5] = AT_TRD(v_rd_off(D0, 2, 1)); R[6] = AT_TRD(v_rd_off(D0, 3, 0)); R[7] = AT_TRD(v_rd_off(D0, 3, 1)); } while (0)
#define AT_PKV(L, H) (bf16x8){L[0], L[1], L[2], L[3], H[0], H[1], H[2], H[3]}
#define AT_MF(OD, R) do { OD = __builtin_amdgcn_mfma_f32_32x32x16_bf16(AT_PKV(R[0], R[1]), pa0, OD, 0, 0, 0); OD = __builtin_amdgcn_mfma_f32_32x32x16_bf16(AT_PKV(R[2], R[3]), pa1, OD, 0, 0, 0); \
        OD = __builtin_amdgcn_mfma_f32_32x32x16_bf16(AT_PKV(R[4], R[5]), pa2, OD, 0, 0, 0); OD = __builtin_amdgcn_mfma_f32_32x32x16_bf16(AT_PKV(R[6], R[7]), pa3, OD, 0, 0, 0); } while (0)
#define AT_PV(VB) do { const int vb_ = vb0 + (VB) * 16384; s16x4 RA[8], RB[8]; \
        AT_PVR(0, RA); AT_PVR(1, RB); SBAR(); AT_MF(o[0], RA); SBAR(); AT_PVR(2, RA); SBAR(); AT_MF(o[1], RB); SBAR(); AT_PVR(3, RB); SBAR(); AT_MF(o[2], RA); AT_MF(o[3], RB); } while (0)
#define AT_EPI(P_, Q0_) do { \
            unsigned char* Op = (P_.p == 0 ? (unsigned char*)F.out + OUT_OP0 : F.wsb + (P_.p == 1 ? WS_OP1 : WS_OP2)); \
            const float lt = l_reg + __shfl_xor(l_reg, 32), rl_ = __builtin_amdgcn_rcpf(lt);                      \
            LAS unsigned char* stg = F.lds + AT_O + wid * AT_OSZ; \
            if (hi == 0) F.lp_()[((size_t)P_.p * T + P_.tokbase + (size_t)P_.dil * ((Q0_) + r32)) * NHD + P_.head] = lt; \
            _Pragma("unroll") for (int d0 = 0; d0 < 4; ++d0) _Pragma("unroll") for (int k = 0; k < 4; ++k) { \
                int w_ = __builtin_amdgcn_cvt_pk_fp8_f32(o[d0][4 * k] * rl_, o[d0][4 * k + 1] * rl_, 0, false); w_ = __builtin_amdgcn_cvt_pk_fp8_f32(o[d0][4 * k + 2] * rl_, o[d0][4 * k + 3] * rl_, w_, true); \
                *(LAS int*)(stg + r32 * 144 + d0 * 32 + k * 8 + hi * 4) = w_; }                                     \
            LDS_WAIT(); asm volatile("" ::: "memory"); \
            _Pragma("unroll") for (int i_ = 0; i_ < 4; ++i_) { const int row = 8 * i_ + (lane >> 3), ch = lane & 7; const u32x4 w = *(const LAS u32x4*)(stg + row * 144 + ch * 16); \
                *(u32x4*)(Op + (P_.tokbase + (size_t)P_.dil * ((Q0_) + row)) * (NHD * 128) + P_.head * 128 + ch * 16) = w; } \
            LDS_WAIT(); asm volatile("" ::: "memory"); \
            _Pragma("unroll") for (int d0 = 0; d0 < 4; ++d0) o[d0] = (f32x16){}; l_reg = 0.f; } while (0)
#define AT_STEP(KB, VB) do { \
        if (rot && pend) AT_PV(vprev);                                                           \
        if (pend_last) AT_EPI(prv, prvQ0);                                                       \
        if (rc == 0) { _Pragma("unroll") for (int d0 = 0; d0 < 8; ++d0) qr[d0] = f8x8_bf16(qn[d0]); } \
        const int Q0 = cur.m0 + 32 * wid, T0 = cur.Tf + 64 * rc; \
        const bool act = T0 + 63 >= Q0 - 64 && T0 <= Q0 + 95;                                \
        if (act) { \
            const LAS unsigned char* Ks = F.lds + AT_K + (KB) * 16384; f32x16 p0 = {}, p1 = {}; \
            _Pragma("unroll") for (int d0 = 0; d0 < 8; ++d0) { const int cb = (d0 * 16 + hi * 8) * 2; \
                const bf16x8 k0 = *(const LAS bf16x8*)(Ks + KSWZ(r32, cb)), k1 = *(const LAS bf16x8*)(Ks + KSWZ(32 + r32, cb)); \
                p0 = __builtin_amdgcn_mfma_f32_32x32x16_bf16(k0, qr[d0], p0, 0, 0, 0); p1 = __builtin_amdgcn_mfma_f32_32x32x16_bf16(k1, qr[d0], p1, 0, 0, 0); } \
            const int dq = T0 - (Q0 + r32); float ps = 0.f;                                \
            _Pragma("unroll") for (int r = 0; r < 16; ++r) { const int e0 = dq + crow(r, hi), e1 = e0 + 32; \
                p0[r] = (e0 >= -64 && e0 <= 64) ? __builtin_amdgcn_exp2f(p0[r]) : 0.f; p1[r] = (e1 >= -64 && e1 <= 64) ? __builtin_amdgcn_exp2f(p1[r]) : 0.f; ps += p0[r] + p1[r]; } \
            l_reg += ps; \
            PK4(p0, 0, pa0); PK4(p0, 8, pa1); PK4(p1, 0, pa2); PK4(p1, 8, pa3); } \
        const bool last = rc + 1 == cur.nt; \
        if (!rot) { if (act) AT_PV(VB); } else { pend = act; vprev = (VB); } \
        pend_last = last; if (last) { prv = cur; prvQ0 = Q0; } \
        if (last) { rc = 0; it_c += G; if (it_c < 4608) cur = at_decode(it_c); } else ++rc; } while (0)
    AT_QLOAD();
    AT_SLOAD(sA); AT_SLOAD(sB); AT_SWRITE(sA, 0, 0); AT_SLOAD(sA); __syncthreads();
    int v3 = 0;
    for (int g = 0; g < ntot; g += 2) { int v3n = v3 == 2 ? 0 : v3 + 1;
        AT_STEP(0, v3);
        if (g + 1 < ntot) AT_SWRITE(sB, 1, v3n);
        if (it_ld < 4608) AT_SLOAD(sB);
        v3 = v3n; v3n = v3 == 2 ? 0 : v3 + 1;
        __syncthreads();
        if (g + 1 < ntot) {
            AT_STEP(1, v3);
            if (g + 2 < ntot) AT_SWRITE(sA, 0, v3n);
            if (it_ld < 4608) AT_SLOAD(sA);
            v3 = v3n;
            __syncthreads(); }
    }
    if (rot && pend) AT_PV(vprev);
    if (pend_last) AT_EPI(prv, prvQ0);
#undef AT_QLOAD
#undef AT_SLOAD
#undef AT_SWRITE
#undef AT_F8
#undef PK4
#undef AT_PV
#undef AT_TRD
#undef AT_PVR
#undef AT_PKV
#undef AT_MF
#undef AT_EPI
#undef AT_STEP
}
struct DCIn { u32x2 a, b, d; float l0, l1, l2; };
__device__ __forceinline__ void dc_load(const Frame& F, long it, int lane, DCIn& I) {
    const long row = it * 4 + (lane >> 4); const size_t tok = (size_t)(row / NHD); const int head = (int)(row % NHD), c = lane & 15;
    I.l0 = F.lp_()[tok * NHD + head]; I.l1 = F.lp_()[((size_t)T + tok) * NHD + head]; I.l2 = F.lp_()[((size_t)2 * T + tok) * NHD + head];
    const size_t off = tok * (NHD * 128) + head * 128 + 8 * c;
    I.a = *(const u32x2*)((const unsigned char*)F.op0_() + off); I.b = *(const u32x2*)((const unsigned char*)F.op1_() + off); I.d = *(const u32x2*)((const unsigned char*)F.op2_() + off);
}
__device__ __forceinline__ void dc_finish(const Frame& F, long it, int lane, const DCIn& I) {
    const long row = it * 4 + (lane >> 4); const size_t tok = (size_t)(row / NHD); const int head = (int)(row % NHD), c = lane & 15;
    const float inv = 4.f / (I.l0 + I.l1 + I.l2), w0 = I.l0 * inv, w1 = I.l1 * inv, w2 = I.l2 * inv;
#define DC2(AW, BW, DW, SEL) ({ const f32x2 x_ = __builtin_amdgcn_cvt_pk_f32_fp8((int)(AW), SEL), y_ = __builtin_amdgcn_cvt_pk_f32_fp8((int)(BW), SEL), z_ = __builtin_amdgcn_cvt_pk_f32_fp8((int)(DW), SEL); \
        (f32x2){__builtin_amdgcn_fmed3f(w0 * x_[0] + w1 * y_[0] + w2 * z_[0], -448.f, 448.f), __builtin_amdgcn_fmed3f(w0 * x_[1] + w1 * y_[1] + w2 * z_[1], -448.f, 448.f)}; })
    const f32x2 e0 = DC2(I.a.x, I.b.x, I.d.x, false), e1 = DC2(I.a.x, I.b.x, I.d.x, true), e2 = DC2(I.a.y, I.b.y, I.d.y, false), e3 = DC2(I.a.y, I.b.y, I.d.y, true);
#undef DC2
    u32x2 o; o.x = (unsigned)__builtin_amdgcn_cvt_pk_fp8_f32(e1[0], e1[1], __builtin_amdgcn_cvt_pk_fp8_f32(e0[0], e0[1], 0, false), true); o.y = (unsigned)__builtin_amdgcn_cvt_pk_fp8_f32(e3[0], e3[1], __builtin_amdgcn_cvt_pk_fp8_f32(e2[0], e2[1], 0, false), true);
    *(u32x2*)(F.mixed8_() + tok * DM + 512 + head * 128 + 8 * c) = o;
}
__device__ __forceinline__ void dil_combine(const Frame& F) {
    const int gw = F.vcu * 8 + F.wave, NGW = F.G * 8, lane = F.lane; const long N = (long)T * NHD / 4;
    for (long it = gw; it < N; it += 4L * NGW) { DCIn I0, I1, I2, I3; const long i1 = it + NGW, i2 = i1 + NGW, i3 = i2 + NGW;
        dc_load(F, it, lane, I0); if (i1 < N) dc_load(F, i1, lane, I1); if (i2 < N) dc_load(F, i2, lane, I2); if (i3 < N) dc_load(F, i3, lane, I3);
        dc_finish(F, it, lane, I0); if (i1 < N) dc_finish(F, i1, lane, I1); if (i2 < N) dc_finish(F, i2, lane, I2); if (i3 < N) dc_finish(F, i3, lane, I3); }
}

__device__ __forceinline__ unsigned fl_flip(float x) { const unsigned u = __float_as_uint(x); return u ^ ((unsigned)((int)u >> 31) | 0x80000000u); }
__device__ __forceinline__ float fl_unflip(unsigned w) { return __uint_as_float((w & 0x80000000u) ? (w ^ 0x80000000u) : ~w); }
#define CE_DESC(a, b) do { const unsigned x_ = max(a, b), y_ = min(a, b); a = x_; b = y_; } while (0)
__device__ __forceinline__ void sort16_desc(unsigned (&a)[16]) {
#pragma unroll
    for (int k = 2; k <= 16; k <<= 1)
#pragma unroll
        for (int j = k >> 1; j > 0; j >>= 1)
#pragma unroll
            for (int i = 0; i < 16; ++i) { const int l = i ^ j; if (l > i) { const unsigned x = max(a[i], a[l]), y = min(a[i], a[l]); if ((i & k) == 0) { a[i] = x; a[l] = y; } else { a[i] = y; a[l] = x; } } }
}
__device__ __forceinline__ void bmerge16_desc(unsigned (&a)[16]) {
#pragma unroll
    for (int j = 8; j > 0; j >>= 1)
#pragma unroll
        for (int i = 0; i < 16; ++i) { const int l = i ^ j; if (l > i) CE_DESC(a[i], a[l]); }
}
__device__ __forceinline__ void top16_merge(unsigned (&a)[16], const unsigned (&b)[16]) {
#pragma unroll
    for (int i = 0; i < 16; ++i) a[i] = max(a[i], b[15 - i]);
    bmerge16_desc(a);
}
__device__ __forceinline__ void top16_partner(unsigned (&a)[16]) {
    unsigned b[16];
#pragma unroll
    for (int i = 0; i < 16; ++i) b[i] = (unsigned)__shfl_xor((int)a[i], 32);
    top16_merge(a, b);
}
__device__ constexpr unsigned char stair(int n) {
    constexpr unsigned char L[64] = {0x00,0x01,0x02,0x03,0x04,0x05,0x06,0x07,0x08,0x09,0x0a,0x0b,0x0c,0x0d,0x0e,0x0f,0x10,0x11,0x12,0x13,0x14,0x15,0x16,0x17,0x20,0x21,0x22,0x23,0x24,0x30,0x31,0x32,
                                     0x33,0x40,0x41,0x42,0x50,0x51,0x60,0x61,0x70,0x71,0x80,0x90,0xa0,0xb0,0xc0,0xd0,0xe0,0xf0,0xff,0xff,0xff,0xff,0xff,0xff,0xff,0xff,0xff,0xff,0xff,0xff,0xff,0xff};
    return L[n];
}
constexpr int TK_KEYS = 32768;
__device__ __forceinline__ void topk_item(const Frame& F, int hh, int tg) {
    const int lane = F.lane, r32 = lane & 31, hi = lane >> 5, tok0 = tg * 32; const size_t tok = (size_t)tok0 + r32;
    LAS int* ktab = (LAS int*)(F.lds + F.wave * 4096) + r32 * 32;
    float ss = 0.f;
    { const f32x4* sp = (const f32x4*)(F.ssp_() + tok * 32 + hi * 16);
#pragma unroll
      for (int j = 0; j < 4; ++j) { const f32x4 v = sp[j]; ss += (v[0] + v[1]) + (v[2] + v[3]); } }
    ss += __shfl_xor(ss, 32);
    const float rs2 = __builtin_amdgcn_rsqf(ss * (1.f / DM) + EPS);
    if (hh == 0 && hi == 0) F.rs2_()[tok] = rs2;
    unsigned top[2][16];
#pragma unroll
    for (int cc = 0; cc < 2; ++cc) {
        f32x16 acc[4] = {};
        const bf16_t* qp = F.qry_() + tok * DM + hh * 256 + cc * 128 + hi * 8; const LAS unsigned char* kl = F.lds + TK_KEYS + cc * 32768;
        bf16x8 qf[8];
#pragma unroll
        for (int s = 0; s < 8; ++s) qf[s] = *(const bf16x8*)(qp + 16 * s);
#pragma unroll
        for (int s = 0; s < 8; ++s) {
#pragma unroll
            for (int kt = 0; kt < 4; ++kt) { const bf16x8 kf = *(const LAS bf16x8*)(kl + KSWZ(kt * 32 + r32, (16 * s + 8 * hi) * 2)); acc[kt] = __builtin_amdgcn_mfma_f32_32x32x16_bf16(kf, qf[s], acc[kt], 0, 0, 0); } }
        unsigned g[4][16];
#pragma unroll
        for (int kt = 0; kt < 4; ++kt) {
#pragma unroll
            for (int r = 0; r < 16; ++r) g[kt][r] = (fl_flip(acc[kt][r]) & ~127u) | (unsigned)(127 - (32 * kt + crow(r, hi)));
            sort16_desc(g[kt]); }
        top16_merge(g[0], g[1]); top16_merge(g[2], g[3]); top16_merge(g[0], g[2]); top16_partner(g[0]);
#pragma unroll
        for (int i = 0; i < 16; ++i) top[cc][i] = g[0][i];
    }
#pragma unroll
    for (int i = 0; i < 16; ++i) ktab[hi * 16 + i] = 127 - (int)((hi ? top[1][i] : top[0][i]) & 127u);
    float s0[16], s1[16];
#pragma unroll
    for (int i = 0; i < 16; ++i) { s0[i] = fl_unflip(top[0][i] & ~127u); s1[i] = fl_unflip(top[1][i] & ~127u); }
    unsigned ca[16], cb[16];
#pragma unroll
    for (int n = 0; n < 32; ++n) { const int A = stair(n), B = stair(25 + n); unsigned va = 0u, vb = 0u;
        if (n < 25) { va = (fl_flip(s0[A >> 4] + s1[A & 15]) & ~255u) | (unsigned)(255 - A); vb = (fl_flip(s0[B >> 4] + s1[B & 15]) & ~255u) | (unsigned)(255 - B); }
        const unsigned v = hi ? vb : va; if (n < 16) ca[n] = v; else cb[n - 16] = v; }
    sort16_desc(ca); sort16_desc(cb); top16_merge(ca, cb); top16_partner(ca);
    float e[16], sum = 0.f; const float mx = fl_unflip(ca[0] & ~255u) * rs2;
#pragma unroll
    for (int i = 0; i < 16; ++i) { e[i] = fexp(fl_unflip(ca[i] & ~255u) * rs2 - mx); sum += e[i]; }
    const float inv = 1.f / sum;
    LDS_WAIT(); asm volatile("" ::: "memory");
    int oi[8]; float og[8];
#pragma unroll
    for (int k = 0; k < 8; ++k) { const unsigned cv = hi ? ca[8 + k] : ca[k]; const int code = 255 - (int)(cv & 255u); og[k] = (hi ? e[8 + k] : e[k]) * inv; oi[k] = ktab[code >> 4] * 128 + ktab[16 + (code & 15)]; }
    { unsigned short* ip = F.idx_() + tok * 128 + hh * 16 + hi * 8; float* gp = F.gate_() + tok * 128 + hh * 16 + hi * 8;
      *(u32x4*)ip = (u32x4){(unsigned)oi[0] | ((unsigned)oi[1] << 16), (unsigned)oi[2] | ((unsigned)oi[3] << 16), (unsigned)oi[4] | ((unsigned)oi[5] << 16), (unsigned)oi[6] | ((unsigned)oi[7] << 16)};
      { const int g0 = hh * 4 + hi * 2;
        *(u32x2*)(F.idxT_() + ((size_t)g0 * T + tok) * 4) = (u32x2){(unsigned)oi[0] | ((unsigned)oi[1] << 16), (unsigned)oi[2] | ((unsigned)oi[3] << 16)};
        *(u32x2*)(F.idxT_() + ((size_t)(g0 + 1) * T + tok) * 4) = (u32x2){(unsigned)oi[4] | ((unsigned)oi[5] << 16), (unsigned)oi[6] | ((unsigned)oi[7] << 16)}; }
      *(f32x4*)gp = (f32x4){og[0], og[1], og[2], og[3]}; *(f32x4*)(gp + 4) = (f32x4){og[4], og[5], og[6], og[7]}; }
    LDS_WAIT(); asm volatile("" ::: "memory");
}

constexpr int PS_NSL = 8, PS_CW = DM / PS_NSL, PS_SUB = PS_NSL / 8, PS_TG = 32, PS_NTG = T / PS_TG;
__device__ __forceinline__ float gelu_tanh(float x) { const float u = 0.7978845608028654f * (x + 0.044715f * x * x * x); const float t = 1.f - 2.f * __builtin_amdgcn_rcpf(1.f + fexp(2.f * u)); return 0.5f * x * (1.f + t); }
__device__ __forceinline__ int dot32n(u32x4 w, u32x4 xh, u32x4 xl) {
    int ph = __builtin_amdgcn_sdot8((int)w.x, (int)xh.x, 0, false); ph = __builtin_amdgcn_sdot8((int)w.y, (int)xh.y, ph, false); ph = __builtin_amdgcn_sdot8((int)w.z, (int)xh.z, ph, false); ph = __builtin_amdgcn_sdot8((int)w.w, (int)xh.w, ph, false);
    int pl = __builtin_amdgcn_sdot8((int)w.x, (int)xl.x, 0, false); pl = __builtin_amdgcn_sdot8((int)w.y, (int)xl.y, pl, false); pl = __builtin_amdgcn_sdot8((int)w.z, (int)xl.z, pl, false); pl = __builtin_amdgcn_sdot8((int)w.w, (int)xl.w, pl, false);
    return (ph << 4) + pl; }
__device__ __forceinline__ unsigned xcc_id() { return (unsigned)__builtin_amdgcn_s_getreg((3 << 11) | 20) & 7u; }
__device__ __forceinline__ bool peer_claim(unsigned* cnt, unsigned x, unsigned& d, int lane, int& q, int& tg) {
    while (d < 8u) { const unsigned xq = (x + d) & 7u; unsigned u = 0u;
        if (lane == 0) u = __hip_atomic_fetch_add(cnt + 64 * xq, 1u, __ATOMIC_RELAXED, __HIP_MEMORY_SCOPE_AGENT);
        u = (unsigned)__builtin_amdgcn_readfirstlane((int)u);
        if (u < (unsigned)(PS_SUB * PS_NTG)) { q = (int)(u / PS_NTG) * 8 + (int)xq; tg = (int)(u % PS_NTG); return true; }
        ++d; }
    return false;
}
template <int CTRL> __device__ __forceinline__ float dppmov(float x) { return __int_as_float(__builtin_amdgcn_update_dpp(0, __float_as_int(x), CTRL, 0xf, 0xf, true)); }
template <int CTRL> __device__ __forceinline__ int dppmovi(int x) { return __builtin_amdgcn_update_dpp(0, x, CTRL, 0xf, 0xf, true); }
__device__ __forceinline__ int bperm(int srclane, int v) { return __builtin_amdgcn_ds_bpermute(srclane << 2, v); }
__device__ __forceinline__ unsigned swar_add8(unsigned q) { return ((q & 0x7f7f7f7fu) + 0x08080808u) ^ (q & 0x80808080u); }
__device__ __forceinline__ void peer_down(const Frame& F, int cntw = 1024) {
    const int lane = F.lane, g = lane >> 3, c = lane & 7; const unsigned x = xcc_id(); unsigned d = 0u; int q, tg; unsigned* cnt = (unsigned*)(F.wsb + WS_CTL) + cntw;
    const unsigned char* tab = F.down8_(); const unsigned char* xb = F.xq6_();
    while (peer_claim(cnt, x, d, lane, q, tg)) {
        const unsigned colb = (unsigned)(q * PS_CW + 32 * c), slb = (unsigned)q * (16384u * 128u) + 16u * c; short* part = F.part_() + (size_t)q * T * 128; const size_t tok0 = (size_t)tg * PS_TG;
        u32x4 wA[16], wB[16], xA, xB, yA, yB; int iA0, iA1, iB0, iB1;
#define PD_IDX(i0, i1, tok) do { const unsigned short* ip_ = F.idx_() + (tok) * 128 + lane; i0 = ip_[0]; i1 = ip_[64]; } while (0)
#define PD_ROWS(W_, X_, Y_, i0, i1, tok) do { _Pragma("unroll") for (int j = 0; j < 16; ++j) { const unsigned e_ = (unsigned)bperm(8 * (j & 7) + g, j < 8 ? i0 : i1); \
            W_[j] = *(const u32x4*)(tab + (e_ * 128u + slb)); } X_ = *(const u32x4*)(xb + (tok) * DM + colb); Y_ = *(const u32x4*)(xb + (tok) * DM + colb + 16); } while (0)
#define PD_COMP(W_, X_, Y_, tok) do { u32x4 xh_, xl_;                   \
            xl_.x = pack_nib(X_.x, X_.y); xl_.y = pack_nib(X_.z, X_.w); xl_.z = pack_nib(Y_.x, Y_.y); xl_.w = pack_nib(Y_.z, Y_.w); \
            xh_.x = pack_nib(swar_add8(X_.x) >> 4, swar_add8(X_.y) >> 4); xh_.y = pack_nib(swar_add8(X_.z) >> 4, swar_add8(X_.w) >> 4); xh_.z = pack_nib(swar_add8(Y_.x) >> 4, swar_add8(Y_.y) >> 4); xh_.w = pack_nib(swar_add8(Y_.z) >> 4, swar_add8(Y_.w) >> 4); \
            int p[16]; _Pragma("unroll") for (int j = 0; j < 16; ++j) p[j] = dot32n(W_[j], xh_, xl_); \
            int a1[8], a2[4], a3[2]; \
            _Pragma("unroll") for (int i = 0; i < 8; ++i) { const int keep = (c & 1) ? p[2 * i + 1] : p[2 * i], give = (c & 1) ? p[2 * i] : p[2 * i + 1]; a1[i] = keep + dppmovi<0xB1>(give); } \
            _Pragma("unroll") for (int i = 0; i < 4; ++i) { const int keep = (c & 2) ? a1[2 * i + 1] : a1[2 * i], give = (c & 2) ? a1[2 * i] : a1[2 * i + 1]; a2[i] = keep + dppmovi<0x4E>(give); } \
            _Pragma("unroll") for (int i = 0; i < 2; ++i) { const int keep = (c & 4) ? a2[2 * i + 1] : a2[2 * i], give = (c & 4) ? a2[2 * i] : a2[2 * i + 1]; a3[i] = keep + __shfl_xor(give, 4); } \
            part[(tok) * 128 + 8 * c + g] = (short)min(max(a3[0], -32768), 32767); part[(tok) * 128 + 64 + 8 * c + g] = (short)min(max(a3[1], -32768), 32767); } while (0)
        PD_IDX(iA0, iA1, tok0); PD_IDX(iB0, iB1, tok0 + 1);
        PD_ROWS(wA, xA, yA, iA0, iA1, tok0);
        for (int tt = 0; tt < PS_TG; tt += 2) { const size_t tok = tok0 + tt;
            PD_ROWS(wB, xB, yB, iB0, iB1, tok + 1);
            const size_t t2 = tok + (tt + 2 < PS_TG ? 2 : 0), t3 = tok + (tt + 2 < PS_TG ? 3 : 1);
            PD_IDX(iA0, iA1, t2);
            PD_COMP(wA, xA, yA, tok);
            if (tt + 2 < PS_TG) PD_ROWS(wA, xA, yA, iA0, iA1, t2);
            PD_IDX(iB0, iB1, t3);
            PD_COMP(wB, xB, yB, tok + 1);
        }
#undef PD_IDX
#undef PD_ROWS
#undef PD_COMP
    }
}
__device__ __forceinline__ void peer_coef_probe(const Frame& F, bool dry) {
    typedef short s16x8 __attribute__((ext_vector_type(8)));
    const int gw = F.vcu * 8 + F.wave, NGW = F.G * 8, lane = F.lane, kq = lane & 15, k0 = kq * 8;
    for (int tg = gw; tg < T / 4; tg += NGW) { const int tok = tg * 4 + (lane >> 4); int a[8] = {0, 0, 0, 0, 0, 0, 0, 0};
#pragma unroll
        for (int q = 0; q < PS_NSL; ++q) { const s16x8 v = *(const s16x8*)(F.part_() + ((size_t)q * T + tok) * 128 + k0);
#pragma unroll
            for (int i = 0; i < 8; ++i) a[i] += v[i]; }
        const u32x4 iw = *(const u32x4*)(F.idx_() + (size_t)tok * 128 + k0); const f32x4 g0 = *(const f32x4*)(F.gate_() + (size_t)tok * 128 + k0), g1 = *(const f32x4*)(F.gate_() + (size_t)tok * 128 + k0 + 4);
        const float sc = F.rs2_()[tok] * F.sx_()[tok]; float c[8], m = 0.f;
#pragma unroll
        for (int i = 0; i < 8; ++i) { const unsigned w = iw[i >> 1]; const int e = (i & 1) ? (int)(w >> 16) : (int)(w & 0xffffu); const float g = i < 4 ? g0[i & 3] : g1[i & 3];
            c[i] = g * gelu_tanh((float)a[i] * sc * F.sd_()[e]) * F.su_()[e]; m = fmaxf(m, fabsf(c[i])); }
        m = fmaxf(m, __shfl_xor(m, 1)); m = fmaxf(m, __shfl_xor(m, 2)); m = fmaxf(m, __shfl_xor(m, 4)); m = fmaxf(m, __shfl_xor(m, 8));
        const float inv = m > 0.f ? 127.f / m : 0.f; unsigned lo = 0u, hi = 0u;
#pragma unroll
        for (int i = 0; i < 4; ++i) { lo |= ((unsigned)(int)rintf(c[i] * inv) & 0xffu) << (8 * i); hi |= ((unsigned)(int)rintf(c[4 + i] * inv) & 0xffu) << (8 * i); }
        unsigned* fp = dry ? (unsigned*)(F.wsb + WS_PART + 256 * MiB) : F.fqT_();
        fp[(size_t)(2 * kq) * T + tok] = lo; fp[(size_t)(2 * kq + 1) * T + tok] = hi;
        if (kq == 0 && !dry) F.csum_()[tok] = m * (1.f / 127.f); }
}
#ifndef PROBE_PHASE
#define PROBE_PHASE -1
#endif
#define UP_NREP ((PROBE_PHASE == 10) ? 2 : 1)
constexpr int U2_XO = 131072 + 2048, U2_SF = U2_XO + 8192;
#define PU_T4(ACC_, R0, R1, R2, R3, FQ_) do { const unsigned t0_ = __builtin_amdgcn_perm(R1, R0, 0x05010400u), t1_ = __builtin_amdgcn_perm(R1, R0, 0x07030602u), t2_ = __builtin_amdgcn_perm(R3, R2, 0x05010400u), t3_ = __builtin_amdgcn_perm(R3, R2, 0x07030602u); \
            ACC_[0] = __builtin_amdgcn_sdot4((int)__builtin_amdgcn_perm(t2_, t0_, 0x05040100u), FQ_, ACC_[0], false); ACC_[1] = __builtin_amdgcn_sdot4((int)__builtin_amdgcn_perm(t2_, t0_, 0x07060302u), FQ_, ACC_[1], false); \
            ACC_[2] = __builtin_amdgcn_sdot4((int)__builtin_amdgcn_perm(t3_, t1_, 0x05040100u), FQ_, ACC_[2], false); ACC_[3] = __builtin_amdgcn_sdot4((int)__builtin_amdgcn_perm(t3_, t1_, 0x07060302u), FQ_, ACC_[3], false); } while (0)
__device__ __forceinline__ unsigned u2_addr_lo(unsigned w, unsigned base) { unsigned a; asm("v_mad_u32_u16 %0, %1, 8, %2" : "=v"(a) : "v"(w), "s"(base)); return a; }
__device__ __forceinline__ unsigned u2_addr_hi(unsigned w, unsigned base) { unsigned a; asm("v_mad_u32_u16 %0, %1, 8, %2 op_sel:[1,0,0,0]" : "=v"(a) : "v"(w), "s"(base)); return a; }
__device__ __forceinline__ void peer_up(const Frame& F) {
    const int lane = F.lane;
    for (int cgi = F.vcu; cgi < 256 * UP_NREP; cgi += F.G) { const int cg = cgi & 255; const bool dry = cgi >= 256; float* const ob_ = dry ? (float*)(F.wsb + WS_PART) : F.out; const unsigned tmask_ = dry ? 16383u : 0xffffffffu;
        __syncthreads();
        { const unsigned char* src = F.up8_() + (size_t)(cg >> 3) * (16384 * 64) + (cg & 7) * 8;
#pragma unroll 8
          for (int i = 0; i < 32; ++i) { const int e = F.tid + 512 * i; *(LAS u32x2*)(F.lds + e * 8) = *(const u32x2*)(src + (size_t)e * 64); } }
        __syncthreads();
        u32x2 S0i[8], S1i[8], S2i[8], S3i[8]; int S0f[8], S1f[8], S2f[8], S3f[8]; u32x2 R0[16], R1[16];
        const __amdgpu_buffer_rsrc_t rsI = __builtin_amdgcn_make_buffer_rsrc((void*)F.idxT_(), 0, 32 * T * 8, 0x00020000), rsF = __builtin_amdgcn_make_buffer_rsrc((void*)F.fqT_(), 0, 32 * T * 4, 0x00020000),
            rsX = __builtin_amdgcn_make_buffer_rsrc((void*)F.x1b_(), 0, T * DM * 2, 0x00020000), rsC = __builtin_amdgcn_make_buffer_rsrc((void*)F.csum_(), 0, T * 4, 0x00020000);
#define U2_FENCE() do { asm volatile("" ::: "memory"); SBAR(); } while (0)
#define U2_LOAD(S_, tok_, s_) do { const unsigned vo_ = (unsigned)(tok_) * 8u; _Pragma("unroll") for (int g = 0; g < 8; ++g) { S_##i[g] = __builtin_amdgcn_raw_buffer_load_b64(rsI, vo_, ((s_) * 8 + g) * (T * 8), 0); \
            S_##f[g] = (int)__builtin_amdgcn_raw_buffer_load_b32(rsF, vo_ >> 1, ((s_) * 8 + g) * (T * 4), 0); } U2_FENCE(); } while (0)
#define U2_ISSUE(R_, S_, h_) do { _Pragma("unroll") for (int g = 0; g < 4; ++g) { const u32x2 id = S_##i[(h_) * 4 + g]; \
                R_[4 * g + 0] = *(const LAS u32x2*)(uintptr_t)u2_addr_lo(id.x, lbase_); R_[4 * g + 1] = *(const LAS u32x2*)(uintptr_t)u2_addr_hi(id.x, lbase_); \
                R_[4 * g + 2] = *(const LAS u32x2*)(uintptr_t)u2_addr_lo(id.y, lbase_); R_[4 * g + 3] = *(const LAS u32x2*)(uintptr_t)u2_addr_hi(id.y, lbase_); } U2_FENCE(); } while (0)
#define U2_FOLD(R_, S_, h_) do { _Pragma("unroll") for (int g = 0; g < 4; ++g) { const int fq = S_##f[(h_) * 4 + g]; \
                int* a_ = acc; PU_T4(a_, R_[4 * g + 0].x, R_[4 * g + 1].x, R_[4 * g + 2].x, R_[4 * g + 3].x, fq); a_ = acc + 4; PU_T4(a_, R_[4 * g + 0].y, R_[4 * g + 1].y, R_[4 * g + 2].y, R_[4 * g + 3].y, fq); } U2_FENCE(); } while (0)
        const int nb = (T / 64 - F.wave + 7) / 8;
        const unsigned lbase_ = (unsigned)__builtin_amdgcn_readfirstlane((int)(unsigned)(uintptr_t)F.ldsg);
        unsigned lane_; asm volatile("v_mbcnt_lo_u32_b32 %0, -1, 0\n\tv_mbcnt_hi_u32_b32 %0, -1, %0" : "=v"(lane_));
        { const unsigned t0_ = (unsigned)F.wave * 64u + lane_; U2_LOAD(S0, t0_, 0); U2_LOAD(S1, t0_, 1); U2_LOAD(S2, t0_, 2); U2_LOAD(S3, t0_, 3); U2_ISSUE(R0, S0, 0); }
#pragma unroll 1
        for (int i = 0; i < nb; ++i) { const unsigned tok = (unsigned)(F.wave + 8 * i) * 64u + lane_; const unsigned tokn = tok + (i + 1 < nb ? 512u : 0u); int acc[8] = {0, 0, 0, 0, 0, 0, 0, 0};
            __builtin_amdgcn_raw_ptr_buffer_load_lds(rsX, (LAS unsigned*)(F.lds + U2_XO + F.wave * 1024), 16, tok << 12, cg * 16, 0, 0);
            __builtin_amdgcn_raw_ptr_buffer_load_lds(rsC, (LAS unsigned*)(F.lds + U2_SF + F.wave * 256), 4, tok << 2, 0, 0, 0);
            U2_FENCE();
            U2_ISSUE(R1, S0, 1); U2_FOLD(R0, S0, 0);
            U2_ISSUE(R0, S1, 0); U2_FOLD(R1, S0, 1); U2_LOAD(S0, tokn, 0);
            U2_ISSUE(R1, S1, 1); U2_FOLD(R0, S1, 0);
            U2_ISSUE(R0, S2, 0); U2_FOLD(R1, S1, 1); U2_LOAD(S1, tokn, 1);
            U2_ISSUE(R1, S2, 1); U2_FOLD(R0, S2, 0);
            U2_ISSUE(R0, S3, 0); U2_FOLD(R1, S2, 1); U2_LOAD(S2, tokn, 2);
            U2_ISSUE(R1, S3, 1); U2_FOLD(R0, S3, 0);
            U2_ISSUE(R0, S0, 0); U2_FOLD(R1, S3, 1); U2_LOAD(S3, tokn, 3);
            asm volatile("s_waitcnt vmcnt(48)" ::: "memory");
            const u32x4 xo = *(const LAS u32x4*)(F.lds + U2_XO + F.wave * 1024 + lane_ * 16); const float sf = *(const LAS float*)(F.lds + U2_SF + F.wave * 256 + lane_ * 4);
            f32x4 v0 = {bflo(xo.x), bfhi(xo.x), bflo(xo.y), bfhi(xo.y)}, v1 = {bflo(xo.z), bfhi(xo.z), bflo(xo.w), bfhi(xo.w)};
            v0[0] += sf * (float)acc[0]; v0[1] += sf * (float)acc[1]; v0[2] += sf * (float)acc[2]; v0[3] += sf * (float)acc[3]; v1[0] += sf * (float)acc[4]; v1[1] += sf * (float)acc[5]; v1[2] += sf * (float)acc[6]; v1[3] += sf * (float)acc[7];
            float* dp = ob_ + (size_t)((tok & tmask_) * DM) + cg * 8; *(f32x4*)dp = v0; *(f32x4*)(dp + 4) = v1; U2_FENCE(); }
        LDS_WAIT();
#undef U2_ISSUE
#undef U2_FOLD
#undef U2_FENCE
#undef U2_LOAD
    }
}
#undef PU_T4


#define XB_TMO      128
#define XB_XCNT(j)  (256  + 64 * (j))
#define XB_XSUB(j)  (1280 + 64 * (j))
#define XB_XGEN(j)  (2304 + 64 * (j))
#define XB_TOP      3328
#define XB_TOPGEN   3392
#define XCD_BAR_WORDS 3456
#define XB_SPIN_CAP (1u << 18)

__device__ __forceinline__ unsigned xb_ld(unsigned* p)              { return __hip_atomic_load(p, __ATOMIC_RELAXED, __HIP_MEMORY_SCOPE_AGENT); }
__device__ __forceinline__ unsigned xb_add(unsigned* p, unsigned v) { return __hip_atomic_fetch_add(p, v, __ATOMIC_RELAXED, __HIP_MEMORY_SCOPE_AGENT); }
__device__ __forceinline__ unsigned xb_xcc_id() { return (unsigned)__builtin_amdgcn_s_getreg((3 << 11) | 20) & 0xFu; }
#define XB_SPIN(cond, bar) do { unsigned _sp = 0; while (cond) { __builtin_amdgcn_s_sleep(1); \
    if ((++_sp & 255u) == 0u) { if (xb_ld(&(bar)[XB_TMO])) break; if (_sp > XB_SPIN_CAP) { atomicAdd(&(bar)[XB_TMO], 1u); break; } } } } while (0)

struct XcdBarrier {
    unsigned* bar; unsigned x;
    volatile LAS unsigned* st;
};

__device__ __forceinline__ XcdBarrier xcd_barrier_post(unsigned* bar, volatile LAS unsigned* st) {
    XcdBarrier b; b.bar = bar; b.x = xb_xcc_id(); b.st = st;
    if (threadIdx.x == 0) (void)xb_add(&bar[XB_XCNT(b.x)], 1u);
    return b;
}
__device__ __forceinline__ void xcd_barrier_complete(unsigned* bar, unsigned x, unsigned& nloc, unsigned& nx) {
    const unsigned G = gridDim.x * gridDim.y * gridDim.z;
    unsigned sum, cnt, mine, sp = 0u;
    for (;;) {
        sum = 0u; cnt = 0u; mine = 0u;
#pragma unroll
        for (unsigned j = 0; j < 16; ++j) { const unsigned c = xb_ld(&bar[XB_XCNT(j)]); sum += c; cnt += (c > 0u) ? 1u : 0u; mine = (j == x) ? c : mine; }
        if (sum == G) break;
        __builtin_amdgcn_s_sleep(1);
        if ((++sp & 255u) == 0u) { if (xb_ld(&bar[XB_TMO])) break; if (sp > XB_SPIN_CAP) { atomicAdd(&bar[XB_TMO], 1u); break; } }
    }
    nloc = mine > 0u ? mine : 1u; nx = cnt > 0u ? cnt : 1u;
}

__device__ __forceinline__ void xcd_barrier(const XcdBarrier& b) {
    asm volatile("s_waitcnt vmcnt(0)" ::: "memory");
    __syncthreads();
    if (threadIdx.x == 0) {
        unsigned* bar = b.bar;
        __builtin_amdgcn_s_waitcnt(0);
        unsigned nloc = b.st[0], nx = b.st[1];
        if (nloc == 0u) { xcd_barrier_complete(bar, b.x, nloc, nx); b.st[0] = nloc; b.st[1] = nx; }
        const unsigned old = xb_add(&bar[XB_XSUB(b.x)], 1u);
        const unsigned gen = old / nloc;
        if (old + 1u == (gen + 1u) * nloc) {
            __builtin_amdgcn_fence(__ATOMIC_RELEASE, "agent");
            asm volatile("s_waitcnt vmcnt(0)" ::: "memory");
            const unsigned og = xb_add(&bar[XB_TOP], 1u);
            const unsigned tg = og / nx;
            if (og + 1u == (tg + 1u) * nx) xb_add(&bar[XB_TOPGEN], 1u);
            else XB_SPIN(xb_ld(&bar[XB_TOPGEN]) == tg, bar);
            __builtin_amdgcn_fence(__ATOMIC_ACQUIRE, "agent");
            xb_add(&bar[XB_XGEN(b.x)], 1u);
            asm volatile("s_waitcnt vmcnt(0)" ::: "memory");
        } else {
            XB_SPIN(xb_ld(&bar[XB_XGEN(b.x)]) == gen, bar);
            __builtin_amdgcn_fence(__ATOMIC_ACQUIRE, "agent");
            asm volatile("s_waitcnt vmcnt(0)" ::: "memory");
        }
    }
    __syncthreads();
}

struct Args { const float* in[16]; float* out; unsigned char* ws; int ph_lo, ph_hi, coop, pad; };
__global__ void __launch_bounds__(512, 2) fwd_kernel(Args args) {
    extern __shared__ __attribute__((aligned(16))) unsigned char lds_raw[];
    Frame F;
    F.lds = (LAS unsigned char*)lds_raw; F.ldsg = (char*)lds_raw;
    F.tid = threadIdx.x; F.lane = F.tid & 63; F.wave = __builtin_amdgcn_readfirstlane(F.tid >> 6);
    F.G = gridDim.x; { const int bx = blockIdx.x; F.vcu = (F.G % 8 == 0) ? (bx % 8) * (F.G / 8) + bx / 8 : bx; }
    F.x = args.in[0]; F.norm1_g = args.in[1]; F.w_in = args.in[2]; F.up_f = args.in[3]; F.bias_f = args.in[4]; F.up_b = args.in[5]; F.bias_b = args.in[6]; F.out_g = args.in[7];
    F.qn_g = args.in[8]; F.kn_g = args.in[9]; F.w_out = args.in[10]; F.norm2_g = args.in[11]; F.w_query = args.in[12]; F.sub_keys = args.in[13]; F.peer_down = args.in[14]; F.peer_up = args.in[15];
    F.out = args.out; unsigned char* ws = args.ws; F.wsb = ws;
    constexpr int MISC_OFF = 131072 + 320;
    for (int u = F.tid; u < 64; u += 512) ((LAS unsigned*)(F.lds + MISC_OFF))[u] = 0u;
    __syncthreads();
    XcdBarrier bar = xcd_barrier_post((unsigned*)(ws + WS_CTL) + 8192, (volatile LAS unsigned*)(F.lds + MISC_OFF) + 8);
    const int lo = args.ph_lo, hi = args.ph_hi;
#ifndef PH_MASK
#define PH_MASK 0x7ff
#endif
#ifndef PROBE_PHASE
#define PROBE_PHASE -1
#endif
#define REP(k) for (int rep_ = 0; rep_ < ((PROBE_PHASE == (k)) ? 2 : 1); ++rep_)
#define IN(k) (((PH_MASK >> (k)) & 1) && lo <= (k) && (k) < hi)
#define SEAM(k) do { if (IN(k) && IN((k) + 1)) { if (args.coop) { if ((k) == 0 && args.coop == 2) cg::this_grid().sync(); else xcd_barrier(bar); } } } while (0)
    if (IN(0)) { REP(0) phase0(F); } SEAM(0);
#define GEMM1_BODY { pg8::Gemm g{(const pg8::bf16_t*)F.xq1_(), (const pg8::bf16_t*)F.Win8_(), T, HP, DM / 2}; pg8::StaticOrder S; S.init(T, HP, F.G, (int)blockIdx.x); \
        pg8::EpiI8Qk E{F.h_(), HP, F.rs1_(), F.sw_(), F.qn_g, F.kn_g, (LAS float*)(F.lds + 131072 + 1024), C_QD / 256, C_KD / 256, C_VD / 256, SEQ - 1, QSCALE, F.h8_(), F.g16_()}; \
        pg8::gemm_phase<pg8::EpiI8Qk, pg8::StaticOrder, PG8_ALIGN, PG8_SP2, true>(F.lds, g, S, E); }
    if (IN(1)) {
        { const int c0_ = ((T / 256) * (HP / 256)) % F.G, bx_ = (int)blockIdx.x;
          if (bx_ >= c0_) { const int wi_ = bx_ - c0_, NX_ = 64 - WO_P0;
              if (wi_ < NX_) w_quant_item<true>(F, F.w_out, DM, (WO_P0 + wi_) * 32, nullptr, F.Wo8_(), (WO_P0 + wi_) * 32, F.swo_());
              else { const int gw_ = (wi_ - NX_) * 8 + F.wave, NGW_ = (F.G - c0_ - NX_) * 8; wq_quant_transpose(F, gw_, NGW_);
                  for (int r = 16384 - PQ_DEFER + gw_; r < 16384; r += NGW_) peer_quant_row<false>(F, r);
                  for (int r = 16384 - PQ_DEFER + gw_; r < 16384; r += NGW_) peer_quant_row<true>(F, r); } } }
        __syncthreads();
        GEMM1_BODY; } SEAM(1);
    if (IN(2)) { REP(2) for (int it = F.vcu; it < 2048; it += F.G) gla_passA(F, it); } SEAM(2);
    if (IN(3)) { for (int it = F.vcu; it < 256; it += F.G) gla_scan(F, it); REP(3) attn_phase(F); } SEAM(3);
    if (IN(4)) REP(4) { dil_combine(F);
        PCRaw R_; if (F.vcu < 2048) gla_passC_load(F, F.vcu, R_); for (int it = F.vcu; it < 2048; it += F.G) gla_passC(F, it, R_, it + F.G < 2048 ? it + F.G : -1); } SEAM(4);
#define GEMM5_BODY { pg8::Gemm g{(const pg8::bf16_t*)F.mixed8_(), (const pg8::bf16_t*)F.Wo8_(), T, DM, DM / 2}; pg8::StaticOrder S; S.init(T, DM, F.G, (int)blockIdx.x); pg8::EpiResid E{F.x, F.out, F.x1b_(), F.ssp_(), DM, F.sx_(), F.xq6_(), F.swo_()}; \
        pg8::gemm_phase<pg8::EpiResid, pg8::StaticOrder, PG8_ALIGN, PG8_SP2, false, true>(F.lds, g, S, E); }
#define GEMM6_BODY { pg8::Gemm g{(const pg8::bf16_t*)F.xq6_(), (const pg8::bf16_t*)F.Wq8_(), T, DM, DM / 2}; pg8::StaticOrder S; S.init(T, DM, F.G, (int)blockIdx.x); \
        pg8::EpiI8Qk E{F.qry_(), DM, F.sx_(), F.swq_(), nullptr, nullptr, (LAS float*)(F.lds + 131072 + 1024), 0, 0, 0, 0, 0.f, nullptr, nullptr}; \
        pg8::gemm_phase<pg8::EpiI8Qk, pg8::StaticOrder, PG8_ALIGN, PG8_SP2, true>(F.lds, g, S, E); \
          \
        for (int i_ = 0; ; ++i_) { pg8::Unit u_; if (!S.next(i_, u_)) break; __syncthreads(); \
            for (int i = F.tid; i < 4096; i += 512) { const int row = i >> 4, ch = i & 15; *(LAS u32x4*)(F.lds + TK_KEYS + KSWZ(row, ch * 16)) = *(const u32x4*)(F.SK_() + ((size_t)u_.pn * 256 + row) * 128 + ch * 8); } \
            __syncthreads(); topk_item(F, u_.pn, u_.pm * 8 + F.wave); } }
#define LATE_ROWS(k_) { const int h_ = F.G - F.G / 2, bx_ = (int)blockIdx.x; if (bx_ >= h_) { const int gw_ = (bx_ - h_) * 8 + F.wave, NGW_ = (F.G / 2) * 8, b_ = 16384 - PQ_DEFER - (1 - (k_)) * PQ2; \
        for (int r = b_ + gw_; r < b_ + PQ2; r += NGW_) peer_quant_row<true>(F, r); __syncthreads(); } }
    if (IN(5)) { LATE_ROWS(0); GEMM5_BODY; } SEAM(5);
    if (IN(6)) { GEMM6_BODY; }
    SEAM(7);
    if (IN(8)) { if (PROBE_PHASE == 8) peer_down(F, 3072); peer_down(F); } SEAM(8);
    if (IN(9)) { REP(9) peer_coef_probe(F, (PROBE_PHASE == 9) && rep_ == 0); } SEAM(9);
    if (IN(10)) peer_up(F);
#undef IN
#undef SEAM
}

#ifndef MK_N_LAUNCHES
#define MK_N_LAUNCHES 1
#endif
extern "C" void kernel_launch(void* const* d_in, const int* in_sizes, int n_in, void* d_out, int out_size, void* d_ws, size_t ws_size, hipStream_t stream) {
    static int grid = 0;
    if (grid == 0) {
        if (n_in != 16 || in_sizes[0] != T * DM || out_size != T * DM || ws_size < WS_END) { fprintf(stderr, "kernel_launch: unexpected shapes (n_in %d, in0 %d, out %d, ws %zu)\n", n_in, n_in > 0 ? in_sizes[0] : -1, out_size, ws_size); grid = -1; return; }
        int dev = 0, cus = 0, per_cu = 0;
        if (hipGetDevice(&dev) != hipSuccess || hipDeviceGetAttribute(&cus, hipDeviceAttributeMultiprocessorCount, dev) != hipSuccess) { grid = -1; return; }
        if (hipFuncSetAttribute((const void*)fwd_kernel, hipFuncAttributeMaxDynamicSharedMemorySize, LDS_BYTES) != hipSuccess) { fprintf(stderr, "kernel_launch: hipFuncSetAttribute failed\n"); grid = -1; return; }
        if (hipOccupancyMaxActiveBlocksPerMultiprocessor(&per_cu, (const void*)fwd_kernel, 512, LDS_BYTES) != hipSuccess || per_cu < 1) { fprintf(stderr, "kernel_launch: occupancy query says %d\n", per_cu); per_cu = 1; }
        (void)hipGetLastError();
        grid = cus;
    }
    if (grid < 0) return;
    if (hipMemsetAsync(d_ws, 0, 65536, stream) != hipSuccess) { fprintf(stderr, "kernel_launch: hipMemsetAsync failed\n"); return; }
    Args a{};
    for (int i = 0; i < 16; ++i) a.in[i] = (const float*)d_in[i];
    a.out = (float*)d_out; a.ws = (unsigned char*)d_ws;
    if (MK_N_LAUNCHES == 1) {
        a.ph_lo = 0; a.ph_hi = NPHASE; a.coop = 1; void* kargs[] = {&a};
        hipError_t e = hipLaunchCooperativeKernel((const void*)fwd_kernel, dim3(grid), dim3(512), kargs, LDS_BYTES, stream);
        if (e != hipSuccess) fprintf(stderr, "kernel_launch: cooperative launch failed: %s (grid %d)\n", hipGetErrorString(e), grid);
    } else {
        for (int p = 0; p < NPHASE; ++p) { a.ph_lo = p; a.ph_hi = p + 1; a.coop = 0; hipLaunchKernelGGL(fwd_kernel, dim3(grid), dim3(512), LDS_BYTES, stream, a); }
        const hipError_t le = hipPeekAtLastError(); if (le != hipSuccess) fprintf(stderr, "kernel_launch: launch failed: %s\n", hipGetErrorName(le));
    }
}
```
